# Optimizing an MI355X kernel written in HIP

```python
import math
import jax, jax.numpy as jnp
from jax import lax
import numpy as np

D_MODEL = 2048
BATCH = 4
SEQ = 2048
DEPTH = 4
DEC_BATCH = 128
DEC_SEQ = 4
PAST_LEN = 16384
PAGE_SIZE = 128

PLE_DIM = 256
CONV_W = 4
EPS = 1e-6
N_EVEN = (DEPTH + 1) // 2
N_ODD = DEPTH // 2
DN_HEADS = 8
DN_DK = 128
DN_DV = 128
DN_W = DN_HEADS * DN_DV
DN_QKV = 2 * DN_HEADS * DN_DK + DN_W
DN_CHUNK = 64
GLA_HEADS = 4
GLA_DK = 128
GLA_DV = 256
GLA_KW = GLA_HEADS * GLA_DK
GLA_W = GLA_HEADS * GLA_DV
GLA_RANK = 16
GLA_GATE_NORM = 16.0
GLA_CHUNK = 16
AB_SIZES = (DN_QKV, DN_HEADS, DN_HEADS, DN_W, GLA_KW, GLA_KW, GLA_W, GLA_RANK, GLA_W)
AB_IN = sum(AB_SIZES)
AB_OUT = DN_W + GLA_W
SSD_HEADS = 16
SSD_HEADDIM = 64
SSD_W = SSD_HEADS * SSD_HEADDIM
SSD_GROUPS = 4
SSD_STATE = 64
SSD_XBC = SSD_W + 2 * SSD_GROUPS * SSD_STATE
SSD_CHUNK = 64
LRU_W = 1024
LRU_BLOCKS = 16
LRU_BS = LRU_W // LRU_BLOCKS
LRU_C = 8.0
CD_SIZES = (SSD_W, SSD_XBC, SSD_HEADS, LRU_W, LRU_W)
CD_IN = sum(CD_SIZES)
CD_OUT = SSD_W + LRU_W

kernel_name = 'hybrid_deltanet_gla_ssd_rglru_step'


def _rmsnorm(x, g):
    xf = x.astype(jnp.float32)
    y = xf * lax.rsqrt(jnp.mean(xf * xf, axis=-1, keepdims=True) + EPS)
    return (y * g.astype(jnp.float32)).astype(x.dtype)


def _l2norm(x):
    xf = x.astype(jnp.float32)
    return (xf * lax.rsqrt(jnp.sum(xf * xf, axis=-1, keepdims=True) + EPS)).astype(x.dtype)


def _split(u, sizes):
    idx = np.cumsum(sizes)[:-1].tolist()
    return jnp.split(u, idx, axis=-1)


def _causal_conv(x, buf, w, b=None):
    L = x.shape[1]
    xx = jnp.concatenate([buf.astype(x.dtype), x], axis=1)
    out = xx[:, 0:L] * w[0]
    for tap in range(1, w.shape[0]):
        out = out + xx[:, tap:tap + L] * w[tap]
    if b is not None:
        out = out + b
    return out, xx[:, L:]


def _chunk_len(L, c):
    return c if L % c == 0 else L


def _to_chunks(t, C):
    B_, L = t.shape[:2]
    return jnp.moveaxis(t.reshape(B_, L // C, C, *t.shape[2:]), 2, 3)


def _from_chunks(o):
    B_, N, H, C = o.shape[:4]
    return jnp.moveaxis(o, 2, 3).reshape(B_, N * C, H, *o.shape[4:])


def _inter_chunk(s0, qg, kend, gend, A, v):
    def step(S, inp):
        qg_n, kend_n, gend_n, A_n, v_n = inp
        o = jnp.einsum('bhid,bhde->bhie', qg_n, S) + jnp.einsum('bhij,bhje->bhie', A_n, v_n)
        S = gend_n * S + jnp.einsum('bhid,bhie->bhde', kend_n, v_n)
        return S, o
    xs = tuple(jnp.moveaxis(t, 1, 0) for t in (qg, kend, gend, A, v))
    S, o = lax.scan(step, s0.astype(v.dtype), xs)
    return _from_chunks(jnp.moveaxis(o, 0, 1)), S


def _gated_delta(q, k, v, beta, g, s0):
    f32 = jnp.float32
    dt_ = v.dtype
    DV = v.shape[-1]
    C = _chunk_len(q.shape[1], DN_CHUNK)
    q, k, v, beta, g = (_to_chunks(t, C) for t in (q, k, v, beta, g))
    G = jnp.cumsum(g.astype(f32), axis=-1)
    causal = jnp.tril(jnp.ones((C, C), dtype=bool))
    strict = causal & ~jnp.eye(C, dtype=bool)
    decay = jnp.exp(jnp.where(causal, G[..., :, None] - G[..., None, :], -jnp.inf))
    bf = beta.astype(f32)
    kk = jnp.einsum('bnhid,bnhjd->bnhij', k, k).astype(f32)
    A = jnp.where(strict, bf[..., :, None] * kk * decay, 0.0)
    M = A + jnp.eye(C, dtype=f32)
    rhs = jnp.concatenate([bf[..., None] * v.astype(f32),
                           (bf * jnp.exp(G))[..., None] * k.astype(f32)], axis=-1)
    sol = lax.linalg.triangular_solve(M, rhs, left_side=True, lower=True)
    u0 = sol[..., :DV].astype(dt_)
    wk = sol[..., DV:].astype(dt_)
    qk = (jnp.einsum('bnhid,bnhjd->bnhij', q, k).astype(f32) * decay).astype(dt_)
    qg = q * jnp.exp(G)[..., None].astype(dt_)
    kend = k * jnp.exp(G[..., -1:] - G)[..., None].astype(dt_)
    gend = jnp.exp(G[..., -1]).astype(dt_)[..., None, None]

    def step(S, inp):
        u0_n, wk_n, qk_n, qg_n, kend_n, gend_n = inp
        u = u0_n - jnp.einsum('bhid,bhde->bhie', wk_n, S)
        o = jnp.einsum('bhid,bhde->bhie', qg_n, S) + jnp.einsum('bhij,bhje->bhie', qk_n, u)
        S = gend_n * S + jnp.einsum('bhid,bhie->bhde', kend_n, u)
        return S, o
    xs = tuple(jnp.moveaxis(t, 1, 0) for t in (u0, wk, qk, qg, kend, gend))
    S, o = lax.scan(step, s0.astype(dt_), xs)
    return _from_chunks(jnp.moveaxis(o, 0, 1)), S


def _gla(q, k, v, glog, s0):
    f32 = jnp.float32
    dt_ = v.dtype
    C = _chunk_len(q.shape[1], GLA_CHUNK)
    q, k, v, glog = (_to_chunks(t, C) for t in (q, k, v, glog))
    G = jnp.cumsum(glog.astype(f32), axis=3)
    causal = jnp.tril(jnp.ones((C, C), dtype=bool))
    decay = jnp.exp(jnp.where(causal[:, :, None], G[..., :, None, :] - G[..., None, :, :], -jnp.inf))
    A = jnp.einsum('bnhid,bnhjd,bnhijd->bnhij', q.astype(f32), k.astype(f32), decay).astype(dt_)
    qg = q * jnp.exp(G).astype(dt_)
    kend = k * jnp.exp(G[..., -1:, :] - G).astype(dt_)
    gend = jnp.exp(G[..., -1, :]).astype(dt_)[..., :, None]
    return _inter_chunk(s0, qg, kend, gend, A, v)


def _scalar_decay(q, k, v, g, s0):
    f32 = jnp.float32
    dt_ = v.dtype
    C = _chunk_len(q.shape[1], SSD_CHUNK)
    q, k, v, g = (_to_chunks(t, C) for t in (q, k, v, g))
    G = jnp.cumsum(g.astype(f32), axis=-1)
    causal = jnp.tril(jnp.ones((C, C), dtype=bool))
    decay = jnp.exp(jnp.where(causal, G[..., :, None] - G[..., None, :], -jnp.inf))
    A = (jnp.einsum('bnhid,bnhjd->bnhij', q, k).astype(f32) * decay).astype(dt_)
    qg = q * jnp.exp(G)[..., None].astype(dt_)
    kend = k * jnp.exp(G[..., -1:] - G)[..., None].astype(dt_)
    gend = jnp.exp(G[..., -1]).astype(dt_)[..., None, None]
    return _inter_chunk(s0, qg, kend, gend, A, v)


def _lin_combine(l, r):
    return (l[0] * r[0], r[0] * l[1] + r[1])


def _mixer_ab(xn, st_dn, st_conv, st_gla, w, j):
    B_, L, _ = xn.shape
    u = xn @ w['ab_w_in'][j]
    qkv, beta_in, a_in, z_dn, gq, gk, gv, g_lr, z_gla = _split(u, AB_SIZES)
    qkv, conv_new = _causal_conv(qkv, st_conv, w['dn_conv_w'][j])
    qkv = jax.nn.silu(qkv)
    q, k, v = _split(qkv, (DN_HEADS * DN_DK, DN_HEADS * DN_DK, DN_W))
    q = _l2norm(q.reshape(B_, L, DN_HEADS, DN_DK)) * (DN_DK ** -0.5)
    k = _l2norm(k.reshape(B_, L, DN_HEADS, DN_DK))
    v = v.reshape(B_, L, DN_HEADS, DN_DV)
    beta = jax.nn.sigmoid(beta_in)
    g = -jnp.exp(w['dn_a_log'][j]) * jax.nn.softplus(a_in + w['dn_dt_bias'][j])
    o_dn, dn_new = _gated_delta(q, k, v, beta, g, st_dn)
    o_dn = _rmsnorm(o_dn, w['dn_norm'][j]).reshape(B_, L, DN_W) * jax.nn.silu(z_dn)
    gq = gq.reshape(B_, L, GLA_HEADS, GLA_DK) * (GLA_DK ** -0.5)
    gk = gk.reshape(B_, L, GLA_HEADS, GLA_DK)
    gv = gv.reshape(B_, L, GLA_HEADS, GLA_DV)
    glog = jax.nn.log_sigmoid(g_lr @ w['gla_wa2'][j] + w['gla_ba'][j]) / GLA_GATE_NORM
    glog = glog.reshape(B_, L, GLA_HEADS, GLA_DK)
    o_gla, gla_new = _gla(gq, gk, gv, glog, st_gla)
    o_gla = _rmsnorm(o_gla, w['gla_norm'][j]).reshape(B_, L, GLA_W) * jax.nn.silu(z_gla)
    y = jnp.concatenate([o_dn, o_gla], axis=-1) @ w['ab_w_out'][j]
    return y, dn_new, conv_new, gla_new


def _mixer_cd(xn, st_ssd, st_sconv, st_lru, st_lconv, w, j):
    B_, L, _ = xn.shape
    u = xn @ w['cd_w_in'][j]
    z, xbc, dt_in, z_lru, x_lru = _split(u, CD_SIZES)
    xbc, sconv_new = _causal_conv(xbc, st_sconv, w['ssd_conv_w'][j], w['ssd_conv_b'][j])
    xbc = jax.nn.silu(xbc)
    xs, bm, cm = _split(xbc, (SSD_W, SSD_GROUPS * SSD_STATE, SSD_GROUPS * SSD_STATE))
    xs = xs.reshape(B_, L, SSD_HEADS, SSD_HEADDIM)
    rep = SSD_HEADS // SSD_GROUPS
    bm = jnp.repeat(bm.reshape(B_, L, SSD_GROUPS, SSD_STATE), rep, axis=2)
    cm = jnp.repeat(cm.reshape(B_, L, SSD_GROUPS, SSD_STATE), rep, axis=2)
    dt = jax.nn.softplus(dt_in + w['ssd_dt_bias'][j])
    g = -jnp.exp(w['ssd_a_log'][j]) * dt
    y, ssd_new = _scalar_decay(cm, bm, xs * dt[..., None], g, st_ssd)
    y = y + w['ssd_d'][j][:, None] * xs
    y = (y.reshape(B_, L, SSD_W) * jax.nn.silu(z)).reshape(B_, L, SSD_GROUPS, SSD_W // SSD_GROUPS)
    y_ssd = _rmsnorm(y, w['ssd_norm'][j].reshape(SSD_GROUPS, -1)).reshape(B_, L, SSD_W)
    xc, lconv_new = _causal_conv(x_lru, st_lconv, w['lru_conv_w'][j], w['lru_conv_b'][j])
    xb = xc.reshape(B_, L, LRU_BLOCKS, LRU_BS)
    r = jax.nn.sigmoid(jnp.einsum('blnc,ncd->blnd', xb, w['lru_wa'][j]).reshape(B_, L, LRU_W) + w['lru_ba'][j])
    i = jax.nn.sigmoid(jnp.einsum('blnc,ncd->blnd', xb, w['lru_wx'][j]).reshape(B_, L, LRU_W) + w['lru_bx'][j])
    log_a = -LRU_C * r * jax.nn.softplus(-w['lru_lambda'][j])
    a = jnp.exp(log_a)
    b = jnp.sqrt(-jnp.expm1(2.0 * log_a)) * (i * xc)
    b = b.at[:, 0].add(a[:, 0] * st_lru.astype(b.dtype))
    _, hs = lax.associative_scan(_lin_combine, (a, b), axis=1)
    y_lru = hs * jax.nn.silu(z_lru)
    y = jnp.concatenate([y_ssd, y_lru], axis=-1) @ w['cd_w_out'][j]
    return y, ssd_new, sconv_new, hs[:, -1], lconv_new


def _trunk(x, p, states, w):
    st_dn, st_dnc, st_gla, st_ssd, st_ssdc, st_lru, st_lruc = states
    outs = [[] for _ in range(7)]
    h = x
    for li in range(DEPTH):
        xn = _rmsnorm(h, w['norm_g'][li])
        j = li // 2
        if li % 2 == 0:
            y, *new = _mixer_ab(xn, st_dn[j], st_dnc[j], st_gla[j], w, j)
            slots = (0, 1, 2)
        else:
            y, *new = _mixer_cd(xn, st_ssd[j], st_ssdc[j], st_lru[j], st_lruc[j], w, j)
            slots = (3, 4, 5, 6)
        for s, n in zip(slots, new):
            outs[s].append(n)
        h = h + y
        gate = jax.nn.sigmoid(_rmsnorm(h, w['ple_norm'][li]) @ w['ple_w_gate'][li])
        h = h + gate * (p[li] @ w['ple_w_proj'][li])
    return _rmsnorm(h, w['final_norm']), [jnp.stack(o) for o in outs]


def setup_inputs(seed: int = 0) -> dict:
    key = jax.random.key(seed)
    ks = iter(jax.random.split(key, 64))

    def nrm(shape, scale):
        return scale * jax.random.normal(next(ks), shape, jnp.float32)

    def unif(shape, lo, hi):
        return jax.random.uniform(next(ks), shape, jnp.float32, lo, hi)

    def dt_bias(shape):
        dt = jnp.exp(unif(shape, math.log(1e-3), math.log(1e-1)))
        return dt + jnp.log(-jnp.expm1(-dt))

    s_lam = unif((N_ODD, LRU_W), 0.9, 0.999) ** (1.0 / LRU_C)
    return {
        'x_prompt': nrm((BATCH, SEQ, D_MODEL), 1.0),
        'x_sample': nrm((DEC_BATCH, DEC_SEQ, D_MODEL), 1.0),
        'state_dn': nrm((N_EVEN, DEC_BATCH, DN_HEADS, DN_DK, DN_DV), 0.1),
        'state_dn_conv': nrm((N_EVEN, DEC_BATCH, CONV_W - 1, DN_QKV), 1.0),
        'state_gla': nrm((N_EVEN, DEC_BATCH, GLA_HEADS, GLA_DK, GLA_DV), 0.3),
        'state_ssd': nrm((N_ODD, DEC_BATCH, SSD_HEADS, SSD_STATE, SSD_HEADDIM), 0.3),
        'state_ssd_conv': nrm((N_ODD, DEC_BATCH, CONV_W - 1, SSD_XBC), 1.0),
        'state_lru': nrm((N_ODD, DEC_BATCH, LRU_W), 0.5),
        'state_lru_conv': nrm((N_ODD, DEC_BATCH, CONV_W - 1, LRU_W), 1.0),
        'p_prompt': nrm((DEPTH, BATCH, SEQ, PLE_DIM), 1.0),
        'p_sample': nrm((DEPTH, DEC_BATCH, DEC_SEQ, PLE_DIM), 1.0),
        'norm_g': 1.0 + nrm((DEPTH, D_MODEL), 0.05),
        'final_norm': 1.0 + nrm((D_MODEL,), 0.05),
        'ab_w_in': nrm((N_EVEN, D_MODEL, AB_IN), D_MODEL ** -0.5),
        'dn_conv_w': nrm((N_EVEN, CONV_W, DN_QKV), 0.5),
        'dn_a_log': jnp.log(unif((N_EVEN, DN_HEADS), 1.0, 16.0)),
        'dn_dt_bias': dt_bias((N_EVEN, DN_HEADS)),
        'dn_norm': 1.0 + nrm((N_EVEN, DN_DV), 0.05),
        'gla_wa2': nrm((N_EVEN, GLA_RANK, GLA_KW), GLA_RANK ** -0.5),
        'gla_ba': nrm((N_EVEN, GLA_KW), 0.01),
        'gla_norm': 1.0 + nrm((N_EVEN, GLA_DV), 0.05),
        'ab_w_out': nrm((N_EVEN, AB_OUT, D_MODEL), AB_OUT ** -0.5),
        'cd_w_in': nrm((N_ODD, D_MODEL, CD_IN), D_MODEL ** -0.5),
        'ssd_conv_w': nrm((N_ODD, CONV_W, SSD_XBC), 0.5),
        'ssd_conv_b': nrm((N_ODD, SSD_XBC), 0.01),
        'ssd_a_log': jnp.log(unif((N_ODD, SSD_HEADS), 1.0, 16.0)),
        'ssd_dt_bias': dt_bias((N_ODD, SSD_HEADS)),
        'ssd_d': 1.0 + nrm((N_ODD, SSD_HEADS), 0.05),
        'ssd_norm': 1.0 + nrm((N_ODD, SSD_W), 0.05),
        'lru_conv_w': nrm((N_ODD, CONV_W, LRU_W), 0.5),
        'lru_conv_b': nrm((N_ODD, LRU_W), 0.01),
        'lru_wa': nrm((N_ODD, LRU_BLOCKS, LRU_BS, LRU_BS), LRU_BS ** -0.5),
        'lru_ba': nrm((N_ODD, LRU_W), 0.01),
        'lru_wx': nrm((N_ODD, LRU_BLOCKS, LRU_BS, LRU_BS), LRU_BS ** -0.5),
        'lru_bx': nrm((N_ODD, LRU_W), 0.01),
        'lru_lambda': jnp.log(s_lam) - jnp.log1p(-s_lam),
        'cd_w_out': nrm((N_ODD, CD_OUT, D_MODEL), CD_OUT ** -0.5),
        'ple_w_proj': nrm((DEPTH, PLE_DIM, D_MODEL), 0.5 * PLE_DIM ** -0.5),
        'ple_norm': 1.0 + nrm((DEPTH, D_MODEL), 0.05),
        'ple_w_gate': nrm((DEPTH, D_MODEL, D_MODEL), D_MODEL ** -0.5),
    }


def reference(x_prompt, x_sample, state_dn, state_dn_conv, state_gla, state_ssd, state_ssd_conv,
              state_lru, state_lru_conv, p_prompt, p_sample, norm_g, final_norm, ab_w_in, dn_conv_w,
              dn_a_log, dn_dt_bias, dn_norm, gla_wa2, gla_ba, gla_norm, ab_w_out, cd_w_in, ssd_conv_w,
              ssd_conv_b, ssd_a_log, ssd_dt_bias, ssd_d, ssd_norm, lru_conv_w, lru_conv_b, lru_wa, lru_ba,
              lru_wx, lru_bx, lru_lambda, cd_w_out, ple_w_proj, ple_norm, ple_w_gate):
    w = {
        'norm_g': norm_g, 'final_norm': final_norm,
        'ab_w_in': ab_w_in, 'dn_conv_w': dn_conv_w, 'dn_a_log': dn_a_log, 'dn_dt_bias': dn_dt_bias,
        'dn_norm': dn_norm, 'gla_wa2': gla_wa2, 'gla_ba': gla_ba, 'gla_norm': gla_norm, 'ab_w_out': ab_w_out,
        'cd_w_in': cd_w_in, 'ssd_conv_w': ssd_conv_w, 'ssd_conv_b': ssd_conv_b, 'ssd_a_log': ssd_a_log,
        'ssd_dt_bias': ssd_dt_bias, 'ssd_d': ssd_d, 'ssd_norm': ssd_norm,
        'lru_conv_w': lru_conv_w, 'lru_conv_b': lru_conv_b, 'lru_wa': lru_wa, 'lru_ba': lru_ba,
        'lru_wx': lru_wx, 'lru_bx': lru_bx, 'lru_lambda': lru_lambda, 'cd_w_out': cd_w_out,
        'ple_w_proj': ple_w_proj, 'ple_norm': ple_norm, 'ple_w_gate': ple_w_gate,
    }
    B_ = x_prompt.shape[0]
    dt_ = x_prompt.dtype
    zero_states = (
        jnp.zeros((N_EVEN, B_, DN_HEADS, DN_DK, DN_DV), dt_),
        jnp.zeros((N_EVEN, B_, CONV_W - 1, DN_QKV), dt_),
        jnp.zeros((N_EVEN, B_, GLA_HEADS, GLA_DK, GLA_DV), dt_),
        jnp.zeros((N_ODD, B_, SSD_HEADS, SSD_STATE, SSD_HEADDIM), dt_),
        jnp.zeros((N_ODD, B_, CONV_W - 1, SSD_XBC), dt_),
        jnp.zeros((N_ODD, B_, LRU_W), dt_),
        jnp.zeros((N_ODD, B_, CONV_W - 1, LRU_W), dt_),
    )
    y_prompt, (dn_p, dnc_p, gla_p, ssd_p, ssdc_p, lru_p, lruc_p) = _trunk(x_prompt, p_prompt, zero_states, w)
    sample_states = (state_dn, state_dn_conv, state_gla, state_ssd, state_ssd_conv, state_lru, state_lru_conv)
    y_sample, (dn_s, dnc_s, gla_s, ssd_s, ssdc_s, lru_s, lruc_s) = _trunk(x_sample, p_sample, sample_states, w)
    return (y_prompt, y_sample, dn_p, dnc_p, gla_p, ssd_p, ssdc_p, lru_p, lruc_p,
            dn_s, dnc_s, gla_s, ssd_s, ssdc_s, lru_s, lruc_s)
```

```cpp
#include <hip/hip_runtime.h>
#include <hip/hip_cooperative_groups.h>
#include <cstdio>
#include <cstdint>
namespace cg = cooperative_groups;

#ifndef MK_N_LAUNCHES
#define MK_N_LAUNCHES 1
#endif

namespace pg8 {
#define PG8_LAS __attribute__((address_space(3)))
typedef unsigned short bf16_t;
typedef short bf16x8 __attribute__((ext_vector_type(8)));
typedef float f32x4 __attribute__((ext_vector_type(4)));
typedef unsigned u32x4 __attribute__((ext_vector_type(4)));
constexpr int BM = 256, BK = 64, HALF = 128, HTB = HALF * BK * 2  , STAGE_BYTES = 8 * HTB, NXCD = 8, WGM = 8;

__host__ __device__ __forceinline__ int lds_byte(int r, int c) { const int st = (r >> 4) * 2 + (c >> 5), rr = r & 15, cc = c & 31, ob = rr * 64 + cc * 2; return st * 1024 + (ob ^ (((ob >> 9) & 1) << 5)); }
__host__ __device__ __forceinline__ void stage_rc(int b, int& R, int& C) { const int st = b / 1024, sb = b % 1024, swz = sb ^ (((sb >> 9) & 1) << 5); R = (st >> 1) * 16 + swz / 64; C = (st & 1) * 32 + (swz % 64) / 2; }
__host__ __device__ __forceinline__ int perm32(int rho) { const int n = rho >> 4, i = rho & 15; return 8 * (i >> 2) + 4 * n + (i & 3); }

struct Unit { int pm, pn; };
struct Gemm { const bf16_t* A; const bf16_t* Bt; int M, N, K; };

struct StaticOrder {
    int nM, nN, nwg, G, c;
    __host__ __device__ void init(int M, int N, int G_, int c_) { nM = M / BM; nN = N / BM; nwg = nM * nN; G = G_; c = c_; }
    __host__ __device__ bool next(int i, Unit& u) const {
        const long L = (long)i * G + c; if (L >= nwg) return false;
        int wgid = (int)L; { const int q = nwg / NXCD, r = nwg % NXCD, xcd = wgid % NXCD, off = wgid / NXCD; wgid = (xcd < r ? xcd * (q + 1) : r * (q + 1) + (xcd - r) * q) + off; }
        const int nig = WGM * nN, gid = wgid / nig, fm = gid * WGM, gsz = (nM - fm) < WGM ? (nM - fm) : WGM;
        u.pm = fm + ((wgid % nig) % gsz); u.pn = (wgid % nig) / gsz; return true;
    }
    __device__ __forceinline__ void a_ready(const Unit&) const {}
    __device__ __forceinline__ void done(const Unit&) const {}
};

__device__ __forceinline__ unsigned cvt_pk_bf16(float lo, float hi) { unsigned r; asm volatile("v_cvt_pk_bf16_f32 %0, %1, %2" : "=v"(r) : "v"(lo), "v"(hi)); return r; }
struct EpiF32 {
    static constexpr bool PERM = false, AFTER_DRAIN = false;
    float* C; int ldc;
    __device__ __forceinline__ void operator()(const f32x4 (&acc)[2][2][4][2], const Unit& u, int wr, int wc, int fr, int fq) const {
        const int row0 = u.pm * BM + wr * 64 + fr, col0 = u.pn * BM + wc * 32 + 4 * fq;
#pragma unroll
        for (int ai = 0; ai < 2; ++ai)
#pragma unroll
            for (int m = 0; m < 4; ++m) { float* rowp = C + (size_t)(row0 + ai * HALF + m * 16) * ldc + col0;
#pragma unroll
                for (int bj = 0; bj < 2; ++bj)
#pragma unroll
                    for (int n = 0; n < 2; ++n) *(f32x4*)(rowp + bj * HALF + n * 16) = acc[ai][bj][m][n]; }
    }
};
struct EpiBf16 {
    static constexpr bool PERM = true, AFTER_DRAIN = false;
    bf16_t* O; int ldc;
    __device__ __forceinline__ void operator()(const f32x4 (&acc)[2][2][4][2], const Unit& u, int wr, int wc, int fr, int fq) const {
        const int row0 = u.pm * BM + wr * 64 + fr; const int col0 = u.pn * BM + wc * 32 + 8 * fq;
#pragma unroll
        for (int ai = 0; ai < 2; ++ai)
#pragma unroll
            for (int m = 0; m < 4; ++m) { bf16_t* rowp = O + (size_t)(row0 + ai * HALF + m * 16) * ldc + col0;
#pragma unroll
                for (int bj = 0; bj < 2; ++bj) { const f32x4 v0 = acc[ai][bj][m][0], v1 = acc[ai][bj][m][1];
                    u32x4 w; w.x = cvt_pk_bf16(v0[0], v0[1]); w.y = cvt_pk_bf16(v0[2], v0[3]); w.z = cvt_pk_bf16(v1[0], v1[1]); w.w = cvt_pk_bf16(v1[2], v1[3]);
                    *(u32x4*)(rowp + bj * HALF) = w; } }
    }
};
template <class Epi, class Sched, bool ALIGN_EPI = false, bool SP2 = false>
__device__ __forceinline__ void gemm_phase(PG8_LAS unsigned char* lds, const Gemm g, const Sched& S, const Epi& E, const int tid) {
    const int wid = __builtin_amdgcn_readfirstlane(tid >> 6), lane = tid & 63, wr = wid >> 2, wc = wid & 3, fr = lane & 15, fq = lane >> 4;
    const int K = g.K, nt = K / BK;
    unsigned voffA[2], voffB[2];
#pragma unroll
    for (int i = 0; i < 2; ++i) { int R, C; stage_rc(tid * 16 + i * 8192, R, C); const int Rb = Epi::PERM ? ((R & ~31) + perm32(R & 31)) : R;
        voffA[i] = (unsigned)(R * K + C) * 2u; voffB[i] = (unsigned)(Rb * K + C) * 2u; }
    const size_t kstep = (size_t)(BK * 2);
    const size_t hstep = (size_t)HALF * K * 2;
    const size_t tstep = 2 * hstep;
    const unsigned ldsw = (unsigned)wid * 1024u;
    const int aoff = lds_byte(wr * 64 + fr, fq * 8), boff = lds_byte(wc * 32 + fr, fq * 8);
#define PG8_SA(b, h) (((b) * 2 + (h)) * HTB)
#define PG8_SB(b, h) ((4 + (b) * 2 + (h)) * HTB)
#define PG8_STAGE(bufoff, gbase, voff) do { _Pragma("unroll") for (int _i = 0; _i < 2; ++_i) \
        __builtin_amdgcn_global_load_lds((const unsigned*)((const char*)(gbase) + (voff)[_i]), (PG8_LAS unsigned*)(lds + (bufoff) + ldsw + _i * 8192), 16, 0, 0); } while (0)
#define PG8_LDA(dst, b, h) do { _Pragma("unroll") for (int m = 0; m < 4; ++m) _Pragma("unroll") for (int k = 0; k < 2; ++k) dst[m][k] = *(const PG8_LAS bf16x8*)(lds + PG8_SA(b, h) + aoff + m * 2048 + k * 1024); } while (0)
#define PG8_LDB(dst, b, h) do { _Pragma("unroll") for (int n = 0; n < 2; ++n) _Pragma("unroll") for (int k = 0; k < 2; ++k) dst[n][k] = *(const PG8_LAS bf16x8*)(lds + PG8_SB(b, h) + boff + n * 2048 + k * 1024); } while (0)
#define PG8_MMA(ai, bj, At, Bt) do { __builtin_amdgcn_s_setprio(1); _Pragma("unroll") for (int m = 0; m < 4; ++m) _Pragma("unroll") for (int n = 0; n < 2; ++n) _Pragma("unroll") for (int k = 0; k < 2; ++k) \
        acc[ai][bj][m][n] = __builtin_amdgcn_mfma_f32_16x16x32_bf16(Bt[n][k], At[m][k], acc[ai][bj][m][n], 0, 0, 0); __builtin_amdgcn_s_setprio(0); } while (0)
#define PG8_WAIT_V(n) asm volatile("s_waitcnt vmcnt(" #n ")" ::: "memory")
#define PG8_WAIT_L(n) asm volatile("s_waitcnt lgkmcnt(" #n ")" ::: "memory")
#define PG8_BAR __builtin_amdgcn_s_barrier()
#define PG8_SCHED __builtin_amdgcn_sched_barrier(0)
    Unit cur, nxt; int ui = 0;
    if (!S.next(0, cur)) return;
    f32x4 acc[2][2][4][2];
#pragma unroll
    for (int a = 0; a < 2; ++a)
#pragma unroll
        for (int b = 0; b < 2; ++b)
#pragma unroll
            for (int m = 0; m < 4; ++m)
#pragma unroll
                for (int n = 0; n < 2; ++n) acc[a][b][m][n] = (f32x4){0.f, 0.f, 0.f, 0.f};
    bf16x8 At[4][2], B0[2][2], B1[2][2];
    const char* cA = (const char*)g.A + (size_t)cur.pm * tstep; const char* cB = (const char*)g.Bt + (size_t)cur.pn * tstep;
    S.a_ready(cur);
    if constexpr (SP2) {
        PG8_STAGE(PG8_SB(0, 0), cB, voffB); PG8_STAGE(PG8_SB(0, 1), cB + hstep, voffB); PG8_STAGE(PG8_SA(0, 0), cA, voffA); PG8_STAGE(PG8_SA(0, 1), cA + hstep, voffA);
        if (wr == 1) PG8_BAR;
        PG8_WAIT_V(2); PG8_BAR;
        PG8_STAGE(PG8_SB(1, 0), cB + kstep, voffB); PG8_STAGE(PG8_SA(1, 0), cA + kstep, voffA); PG8_STAGE(PG8_SB(1, 1), cB + hstep + kstep, voffB);
        PG8_WAIT_V(6); PG8_BAR;
    } else {
        PG8_STAGE(PG8_SB(0, 0), cB, voffB); PG8_STAGE(PG8_SA(0, 0), cA, voffA); PG8_STAGE(PG8_SB(0, 1), cB + hstep, voffB); PG8_STAGE(PG8_SA(0, 1), cA + hstep, voffA);
        if (wr == 1) PG8_BAR;
        PG8_WAIT_V(4); PG8_BAR;
        PG8_STAGE(PG8_SB(1, 0), cB + kstep, voffB); PG8_STAGE(PG8_SA(1, 0), cA + kstep, voffA); PG8_STAGE(PG8_SB(1, 1), cB + hstep + kstep, voffB);
        PG8_WAIT_V(6); PG8_BAR;
    }
    for (;;) {
        const bool has_next = S.next(ui + 1, nxt);
        const char* nA = has_next ? (const char*)g.A + (size_t)nxt.pm * tstep : cA; const char* nB = has_next ? (const char*)g.Bt + (size_t)nxt.pn * tstep : cB;
        for (int t = 0; t < nt; t += 2) {
            const bool last = (t == nt - 2);
            const char* a1 = cA + (size_t)(t + 1) * kstep;
            const char* a2 = last ? nA : cA + (size_t)(t + 2) * kstep; const char* b2 = last ? nB : cB + (size_t)(t + 2) * kstep;
            const char* a3 = a2 + kstep; const char* b3 = b2 + kstep;
            if (last && has_next) S.a_ready(nxt);
            if constexpr (SP2) {
            PG8_LDB(B0, 0, 0); PG8_LDB(B1, 0, 1); PG8_SCHED; PG8_LDA(At, 0, 0); PG8_STAGE(PG8_SA(1, 1), a1 + hstep, voffA);
            PG8_WAIT_V(8); PG8_WAIT_L(0); PG8_BAR; PG8_MMA(0, 0, At, B0); PG8_MMA(0, 1, At, B1); PG8_BAR; PG8_SCHED;
            PG8_LDA(At, 0, 1); PG8_STAGE(PG8_SB(0, 0), b2, voffB); PG8_STAGE(PG8_SB(0, 1), b2 + hstep, voffB); PG8_STAGE(PG8_SA(0, 0), a2, voffA);
            PG8_WAIT_V(8); PG8_WAIT_L(0); PG8_BAR; PG8_MMA(1, 0, At, B0); PG8_MMA(1, 1, At, B1); PG8_BAR; PG8_SCHED;
            PG8_LDB(B0, 1, 0); PG8_LDB(B1, 1, 1); PG8_SCHED; PG8_LDA(At, 1, 0); PG8_STAGE(PG8_SA(0, 1), a2 + hstep, voffA);
            PG8_WAIT_V(8); PG8_WAIT_L(0); PG8_BAR; PG8_MMA(0, 0, At, B0); PG8_MMA(0, 1, At, B1); PG8_BAR; PG8_SCHED;
            PG8_LDA(At, 1, 1); PG8_STAGE(PG8_SB(1, 0), b3, voffB); PG8_STAGE(PG8_SB(1, 1), b3 + hstep, voffB); PG8_STAGE(PG8_SA(1, 0), a3, voffA);
            PG8_WAIT_V(8); PG8_WAIT_L(0); PG8_BAR; PG8_MMA(1, 0, At, B0); PG8_MMA(1, 1, At, B1); PG8_BAR; PG8_SCHED;
            } else {
            PG8_LDB(B0, 0, 0); PG8_SCHED; PG8_LDA(At, 0, 0); PG8_STAGE(PG8_SA(1, 1), a1 + hstep, voffA);
            PG8_WAIT_L(8); PG8_BAR; PG8_WAIT_L(0); PG8_MMA(0, 0, At, B0); PG8_BAR; PG8_SCHED;
            PG8_LDB(B1, 0, 1); PG8_STAGE(PG8_SB(0, 0), b2, voffB);
            PG8_BAR; PG8_WAIT_L(0); PG8_MMA(0, 1, At, B1); PG8_BAR;
            PG8_LDA(At, 0, 1); PG8_STAGE(PG8_SA(0, 0), a2, voffA);
            PG8_BAR; PG8_WAIT_L(0); PG8_MMA(1, 0, At, B0); PG8_BAR; PG8_SCHED;
            PG8_STAGE(PG8_SB(0, 1), b2 + hstep, voffB);
            PG8_WAIT_V(6); PG8_BAR; PG8_MMA(1, 1, At, B1); PG8_BAR;
            PG8_LDB(B0, 1, 0); PG8_SCHED; PG8_LDA(At, 1, 0); PG8_STAGE(PG8_SA(0, 1), a2 + hstep, voffA);
            PG8_WAIT_L(8); PG8_BAR; PG8_WAIT_L(0); PG8_MMA(0, 0, At, B0); PG8_BAR; PG8_SCHED;
            PG8_LDB(B1, 1, 1); PG8_STAGE(PG8_SB(1, 0), b3, voffB);
            PG8_BAR; PG8_WAIT_L(0); PG8_MMA(0, 1, At, B1); PG8_BAR;
            PG8_LDA(At, 1, 1); PG8_STAGE(PG8_SA(1, 0), a3, voffA);
            PG8_BAR; PG8_WAIT_L(0); PG8_MMA(1, 0, At, B0); PG8_BAR; PG8_SCHED;
            PG8_STAGE(PG8_SB(1, 1), b3 + hstep, voffB);
            PG8_WAIT_V(6); PG8_BAR; PG8_MMA(1, 1, At, B1); PG8_BAR;
            }
        }
        if constexpr (ALIGN_EPI) { if (wr == 0) PG8_BAR; }
        if constexpr (!Epi::AFTER_DRAIN) { E(acc, cur, wr, wc, fr, fq); S.done(cur); }
        if (!has_next) break;
#pragma unroll
        for (int a = 0; a < 2; ++a)
#pragma unroll
            for (int b = 0; b < 2; ++b)
#pragma unroll
                for (int m = 0; m < 4; ++m)
#pragma unroll
                    for (int n = 0; n < 2; ++n) acc[a][b][m][n] = (f32x4){0.f, 0.f, 0.f, 0.f};
        cur = nxt; cA = nA; cB = nB; ++ui;
        if constexpr (ALIGN_EPI) { if (wr == 1) PG8_BAR; }
    }
    PG8_WAIT_V(0);
    if constexpr (!ALIGN_EPI) { if (wr == 0) PG8_BAR; }
    PG8_BAR;
    if constexpr (Epi::AFTER_DRAIN) { E.fused(acc, cur, wr, wc, fr, fq, lds, wid, lane); S.done(cur); }
#undef PG8_SA
#undef PG8_SB
#undef PG8_STAGE
#undef PG8_LDA
#undef PG8_LDB
#undef PG8_MMA
#undef PG8_WAIT_V
#undef PG8_WAIT_L
#undef PG8_BAR
#undef PG8_SCHED
}
}

constexpr int TP = 8192, TS = 512, T = TP + TS, DM = 2048, NSEQ = 132;
constexpr int NAB = 7424, NCD = 4864;
constexpr int NWAVES = 8, NTHR = 512;
constexpr size_t MiB = 1u << 20;
constexpr size_t WS_CTL = 0, CTL_ZERO_BYTES = 1 * MiB;
constexpr size_t WS_WABIN = 2 * MiB, WS_WABOUT = 60 * MiB, WS_WCDIN = 76 * MiB, WS_WCDOUT = 114 * MiB, WS_WGATE = 130 * MiB, WS_WPROJ = 162 * MiB;
constexpr size_t WS_H = 166 * MiB, WS_XN = 234 * MiB, WS_YM = 268 * MiB, WS_PB = 302 * MiB, WS_U = 320 * MiB, WS_SCR = 444 * MiB, WS_END = 644 * MiB;
constexpr size_t SC_C = 0, SC_C2 = 68 * MiB;
constexpr size_t SC_QN = 0, SC_KN = 34 * MiB, SC_VV = 68 * MiB, SC_ODN = 102 * MiB, SC_OGLA = 136 * MiB, SC_GLOG = 170 * MiB, SC_BETA = 187 * MiB, SC_GDEC = 188 * MiB;
constexpr size_t SC_XBC = 0, SC_LA = 52 * MiB, SC_LB = 86 * MiB, SC_YS = 120 * MiB, SC_HS = 154 * MiB, SC_DT = 188 * MiB;
constexpr int LDS_BYTES = 147456;
constexpr size_t O_Y_P = 0, O_Y_S = O_Y_P + (size_t)4 * 2048 * 2048, O_DN_P = O_Y_S + (size_t)128 * 4 * 2048,
    O_DNC_P = O_DN_P + (size_t)2 * 4 * 8 * 128 * 128, O_GLA_P = O_DNC_P + (size_t)2 * 4 * 3 * 3072, O_SSD_P = O_GLA_P + (size_t)2 * 4 * 4 * 128 * 256,
    O_SSDC_P = O_SSD_P + (size_t)2 * 4 * 16 * 64 * 64, O_LRU_P = O_SSDC_P + (size_t)2 * 4 * 3 * 1536, O_LRUC_P = O_LRU_P + (size_t)2 * 4 * 1024,
    O_DN_S = O_LRUC_P + (size_t)2 * 4 * 3 * 1024, O_DNC_S = O_DN_S + (size_t)2 * 128 * 8 * 128 * 128, O_GLA_S = O_DNC_S + (size_t)2 * 128 * 3 * 3072,
    O_SSD_S = O_GLA_S + (size_t)2 * 128 * 4 * 128 * 256, O_SSDC_S = O_SSD_S + (size_t)2 * 128 * 16 * 64 * 64, O_LRU_S = O_SSDC_S + (size_t)2 * 128 * 3 * 1536,
    O_LRUC_S = O_LRU_S + (size_t)2 * 128 * 1024, O_END = O_LRUC_S + (size_t)2 * 128 * 3 * 1024;
static_assert(O_END == 109064192, "output size");

#define LAS __attribute__((address_space(3)))
typedef unsigned short bf16;
typedef float f32x4 __attribute__((ext_vector_type(4)));
typedef unsigned u32x2 __attribute__((ext_vector_type(2)));
typedef unsigned u32x4 __attribute__((ext_vector_type(4)));
#define LDS_WAIT() asm volatile("s_waitcnt lgkmcnt(0)" ::: "memory")

__device__ __forceinline__ float bf2f(bf16 b) { return __uint_as_float(((unsigned)b) << 16); }
__device__ __forceinline__ unsigned f2bf(float f) { unsigned u = __float_as_uint(f); return (u + 0x7fffu + ((u >> 16) & 1u)) >> 16; }
__device__ __forceinline__ unsigned pk2(float lo, float hi) { return f2bf(lo) | (f2bf(hi) << 16); }
__device__ __forceinline__ float sigmoid_(float x) { return 1.f / (1.f + expf(-x)); }
__device__ __forceinline__ float silu_(float x) { return x / (1.f + expf(-x)); }
__device__ __forceinline__ float softplus_(float x) { return x > 20.f ? x : log1pf(expf(x)); }
__device__ __forceinline__ float wave_sum(float v) {
#pragma unroll
    for (int o = 1; o < 64; o <<= 1) v += __shfl_xor(v, o);
    return v;
}
__device__ __forceinline__ void row_to_seq(int r, int& s, int& t) { if (r < TP) { s = r >> 11; t = r & 2047; } else { s = 4 + ((r - TP) >> 2); t = (r - TP) & 3; } }
__device__ __forceinline__ void seq_info(int s, int& row0, int& L) { if (s < 4) { row0 = s << 11; L = 2048; } else { row0 = TP + ((s - 4) << 2); L = 4; } }
__device__ __forceinline__ float pre_val(const bf16* U, int ldu, int ucol, int row0, int tt, int s, const float* stc, int W, int c) {
    if (tt >= 0) return bf2f(U[(size_t)(row0 + tt) * ldu + ucol]);
    if (s < 4) return 0.f;
    return stc[((size_t)(s - 4) * 3 + (3 + tt)) * W + c];
}
__device__ __forceinline__ int map_col(int mapid, int n) {
    if (mapid == 0) return n;
    if (mapid == 1) { if (n < 3072) return n; if (n < 6144) return n + 16; if (n < 7168) return n + 32; if (n < 7184) return n - 4096; if (n < 7200) return n - 1024; return -1; }
    if (n < 2560) return n; if (n < 4608) return n + 16; if (n < 4624) return n - 2048; return -1;
}
__device__ __forceinline__ void transpose_item(const float* W, int K, int Nsrc, bf16* WT, int Npad, int mapid, LAS float* scr, int item, int lane) {
    const int nblk = Npad / 32, kb = item / nblk, nb = item % nblk, k0 = 64 * kb, n0 = 32 * nb;
    const int src = map_col(mapid, n0 + (lane & 31));
#pragma unroll 8
    for (int i = 0; i < 32; ++i) { const int kk = 2 * i + (lane >> 5); scr[kk * 33 + (lane & 31)] = src >= 0 ? W[(size_t)(k0 + kk) * Nsrc + src] : 0.f; }
    LDS_WAIT(); asm volatile("" ::: "memory");
    const int c = lane & 7;
#pragma unroll
    for (int j = 0; j < 4; ++j) { const int n = (lane >> 3) + 8 * j; const LAS float* s = scr + (8 * c) * 33 + n;
        u32x4 o; o.x = pk2(s[0 * 33], s[1 * 33]); o.y = pk2(s[2 * 33], s[3 * 33]); o.z = pk2(s[4 * 33], s[5 * 33]); o.w = pk2(s[6 * 33], s[7 * 33]);
        *(u32x4*)(WT + (size_t)(n0 + n) * K + k0 + 8 * c) = o; }
    LDS_WAIT(); asm volatile("" ::: "memory");
}
__device__ __forceinline__ void norm_row_bf16(const f32x4 (&v)[8], const float* g, bf16* orow, int lane) {
    float ss = 0.f;
#pragma unroll
    for (int j = 0; j < 8; ++j) ss += (v[j].x * v[j].x + v[j].y * v[j].y) + (v[j].z * v[j].z + v[j].w * v[j].w);
    const float rstd = rsqrtf(wave_sum(ss) * (1.f / DM) + 1e-6f);
#pragma unroll
    for (int j = 0; j < 8; ++j) { const int col = 4 * (lane + 64 * j); const f32x4 gg = *(const f32x4*)(g + col);
        u32x2 o; o.x = pk2(v[j].x * rstd * gg.x, v[j].y * rstd * gg.y); o.y = pk2(v[j].z * rstd * gg.z, v[j].w * rstd * gg.w);
        *(u32x2*)(orow + col) = o; }
}

struct Args { const float* in[40]; float* out; unsigned char* ws; int ph_lo, ph_hi; };
constexpr int N_PHASES = 37;
#ifndef PH_MASK
#define PH_MASK 2047
#endif
#define AS4 __attribute__((address_space(4)))
struct KP { const char AS4* p;
    __device__ __forceinline__ const float* in(int i) const { return *(const float* const AS4*)(p + 8 * i); }
    __device__ __forceinline__ float* out() const { return *(float* const AS4*)(p + 320); }
    __device__ __forceinline__ unsigned char* ws() const { return *(unsigned char* const AS4*)(p + 328); }
};
static_assert(sizeof(Args) == 344, "Args layout");

__device__ __forceinline__ void phase_prologue(const KP kp, LAS unsigned char* lds, int gw, int NGW, int wave, int lane) {
    unsigned char* ws = kp.ws();
    LAS float* scr = (LAS float*)(lds + wave * 16384);
    for (int job = 0; job < 16; ++job) {
        const float* W; int K = 2048, Nsrc = 2048, Npad = 2048, mapid = 0; bf16* WT;
        if (job < 2)       { W = kp.in(13) + (size_t)job * 2048 * 7200; Nsrc = 7200; Npad = NAB; mapid = 1; WT = (bf16*)(ws + WS_WABIN) + (size_t)job * NAB * 2048; }
        else if (job < 4)  { W = kp.in(21) + (size_t)(job - 2) * 2048 * 2048; WT = (bf16*)(ws + WS_WABOUT) + (size_t)(job - 2) * 2048 * 2048; }
        else if (job < 6)  { W = kp.in(22) + (size_t)(job - 4) * 2048 * 4624; Nsrc = 4624; Npad = NCD; mapid = 2; WT = (bf16*)(ws + WS_WCDIN) + (size_t)(job - 4) * NCD * 2048; }
        else if (job < 8)  { W = kp.in(36) + (size_t)(job - 6) * 2048 * 2048; WT = (bf16*)(ws + WS_WCDOUT) + (size_t)(job - 6) * 2048 * 2048; }
        else if (job < 12) { W = kp.in(39) + (size_t)(job - 8) * 2048 * 2048; WT = (bf16*)(ws + WS_WGATE) + (size_t)(job - 8) * 2048 * 2048; }
        else               { W = kp.in(37) + (size_t)(job - 12) * 256 * 2048; K = 256; WT = (bf16*)(ws + WS_WPROJ) + (size_t)(job - 12) * 2048 * 256; }
        const int nitems = (K / 64) * (Npad / 32);
        for (int it = gw; it < nitems; it += NGW) transpose_item(W, K, Nsrc, WT, Npad, mapid, scr, it, lane);
    }
    float* H = (float*)(ws + WS_H); bf16* XN = (bf16*)(ws + WS_XN);
    for (int m = gw; m < T; m += NGW) {
        const float* src = m < TP ? kp.in(0) + (size_t)m * DM : kp.in(1) + (size_t)(m - TP) * DM;
        f32x4 v[8];
#pragma unroll
        for (int j = 0; j < 8; ++j) { v[j] = *(const f32x4*)(src + 4 * (lane + 64 * j)); *(f32x4*)(H + (size_t)m * DM + 4 * (lane + 64 * j)) = v[j]; }
        norm_row_bf16(v, kp.in(11), XN + (size_t)m * DM, lane);
    }
    bf16* PB = (bf16*)(ws + WS_PB);
    const int gt = gw * 64 + lane, NGT = NGW * 64;
    for (int i = gt; i < 4 * T * 64; i += NGT) {
        const int c4 = i & 63, r = (i >> 6) % T, li = (i >> 6) / T;
        const float* src = r < TP ? kp.in(9) + ((size_t)li * TP + r) * 256 + 4 * c4 : kp.in(10) + ((size_t)li * TS + (r - TP)) * 256 + 4 * c4;
        const f32x4 v = *(const f32x4*)src;
        u32x2 o; o.x = pk2(v.x, v.y); o.y = pk2(v.z, v.w);
        *(u32x2*)(PB + ((size_t)li * T + r) * 256 + 4 * c4) = o;
    }
}

__device__ __forceinline__ void phase_res1(const KP kp, int li, int gw, int NGW, int lane) {
    float* H = (float*)(kp.ws() + WS_H); bf16* XN = (bf16*)(kp.ws() + WS_XN); const float* C = (const float*)(kp.ws() + WS_SCR + SC_C);
    for (int m = gw; m < T; m += NGW) {
        f32x4 v[8];
#pragma unroll
        for (int j = 0; j < 8; ++j) { const size_t o = (size_t)m * DM + 4 * (lane + 64 * j); v[j] = *(const f32x4*)(H + o) + *(const f32x4*)(C + o); *(f32x4*)(H + o) = v[j]; }
        norm_row_bf16(v, kp.in(38) + (size_t)li * DM, XN + (size_t)m * DM, lane);
    }
}
__device__ __forceinline__ void phase_res2(const KP kp, int li, int gw, int NGW, int lane) {
    float* H = (float*)(kp.ws() + WS_H); bf16* XN = (bf16*)(kp.ws() + WS_XN); const float* C = (const float*)(kp.ws() + WS_SCR + SC_C); const float* C2 = (const float*)(kp.ws() + WS_SCR + SC_C2);
    for (int m = gw; m < T; m += NGW) {
        f32x4 v[8];
#pragma unroll
        for (int j = 0; j < 8; ++j) { const size_t o = (size_t)m * DM + 4 * (lane + 64 * j); const f32x4 c = *(const f32x4*)(C + o), c2 = *(const f32x4*)(C2 + o); f32x4 h = *(const f32x4*)(H + o);
            h.x += sigmoid_(c.x) * c2.x; h.y += sigmoid_(c.y) * c2.y; h.z += sigmoid_(c.z) * c2.z; h.w += sigmoid_(c.w) * c2.w; v[j] = h; *(f32x4*)(H + o) = h; }
        if (li < 3) norm_row_bf16(v, kp.in(11) + (size_t)(li + 1) * DM, XN + (size_t)m * DM, lane);
        else {
            float ss = 0.f;
#pragma unroll
            for (int j = 0; j < 8; ++j) ss += (v[j].x * v[j].x + v[j].y * v[j].y) + (v[j].z * v[j].z + v[j].w * v[j].w);
            const float rstd = rsqrtf(wave_sum(ss) * (1.f / DM) + 1e-6f);
#pragma unroll
            for (int j = 0; j < 8; ++j) { const int col = 4 * (lane + 64 * j); const f32x4 gg = *(const f32x4*)(kp.in(12) + col);
                f32x4 o; o.x = v[j].x * rstd * gg.x; o.y = v[j].y * rstd * gg.y; o.z = v[j].z * rstd * gg.z; o.w = v[j].w * rstd * gg.w;
                *(f32x4*)(kp.out() + (size_t)m * DM + col) = o; }
        }
    }
}

__device__ __forceinline__ void phase_ab_pre(const KP kp, const int bid, const int G, int j, int tid, int wave, int lane) {
    unsigned char* scr = kp.ws() + WS_SCR; const bf16* U = (const bf16*)(kp.ws() + WS_U);
    float* QN = (float*)(scr + SC_QN); float* KN = (float*)(scr + SC_KN); float* VV = (float*)(scr + SC_VV);
    float* GLOG = (float*)(scr + SC_GLOG); float* BETA = (float*)(scr + SC_BETA); float* GDEC = (float*)(scr + SC_GDEC);
    const float* cw = kp.in(14) + (size_t)j * 4 * 3072; const float* stc = kp.in(3) + (size_t)j * 128 * 3 * 3072;
    const float* wa2 = kp.in(18) + (size_t)j * 16 * 512; const float* ba = kp.in(19) + (size_t)j * 512;
    for (int r = bid; r < T; r += G) {
        int s, t; row_to_seq(r, s, t); const int row0 = r - t;
#pragma unroll
        for (int part = 0; part < 3; ++part) {
            float val[2];
#pragma unroll
            for (int i = 0; i < 2; ++i) { const int c = part * 1024 + wave * 128 + lane + 64 * i; float acc = 0.f;
#pragma unroll
                for (int tap = 0; tap < 4; ++tap) acc += cw[tap * 3072 + c] * pre_val(U, NAB, c, row0, t - 3 + tap, s, stc, 3072, c);
                val[i] = silu_(acc); }
            if (part < 2) { const float ss = wave_sum(val[0] * val[0] + val[1] * val[1]); const float sc = rsqrtf(ss + 1e-6f) * (part == 0 ? 0.08838834764831845f : 1.f); val[0] *= sc; val[1] *= sc; }
            float* dst = part == 0 ? QN : (part == 1 ? KN : VV);
            dst[(size_t)r * 1024 + wave * 128 + lane] = val[0]; dst[(size_t)r * 1024 + wave * 128 + lane + 64] = val[1];
        }
        if (tid < 8) {
            BETA[(size_t)r * 8 + tid] = sigmoid_(bf2f(U[(size_t)r * NAB + 7168 + tid]));
            GDEC[(size_t)r * 8 + tid] = -expf(kp.in(15)[j * 8 + tid]) * softplus_(bf2f(U[(size_t)r * NAB + 7176 + tid]) + kp.in(16)[j * 8 + tid]);
        }
        { float x = ba[tid];
#pragma unroll
          for (int rr = 0; rr < 16; ++rr) x += bf2f(U[(size_t)r * NAB + 7184 + rr]) * wa2[rr * 512 + tid];
          GLOG[(size_t)r * 512 + tid] = -softplus_(-x) * (1.f / 16.f); }
    }
}

__device__ __forceinline__ void phase_ab_rec(const KP kp, const int bid, const int G, int j, LAS unsigned char* lds, int tid) {
    unsigned char* scr = kp.ws() + WS_SCR; const bf16* U = (const bf16*)(kp.ws() + WS_U);
    const float* QN = (const float*)(scr + SC_QN); const float* KN = (const float*)(scr + SC_KN); const float* VV = (const float*)(scr + SC_VV);
    const float* GLOG = (const float*)(scr + SC_GLOG); const float* BETA = (const float*)(scr + SC_BETA); const float* GDEC = (const float*)(scr + SC_GDEC);
    float* ODN = (float*)(scr + SC_ODN); float* OGLA = (float*)(scr + SC_OGLA);
    LAS float* SL = (LAS float*)lds;
    for (int item = bid; item < 1584; item += G) {
        int s, h; bool isdn;
        if (item < 32) { isdn = true; s = item >> 3; h = item & 7; }
        else if (item < 48) { isdn = false; s = (item - 32) >> 2; h = (item - 32) & 3; }
        else if (item < 1072) { isdn = true; s = 4 + ((item - 48) >> 3); h = (item - 48) & 7; }
        else { isdn = false; s = 4 + ((item - 1072) >> 2); h = (item - 1072) & 3; }
        int row0, L; seq_info(s, row0, L);
        __syncthreads();
        if (isdn) {
            LAS float* kL = SL + 16384; LAS float* qL = kL + 128; LAS float* red = kL + 256; LAS float* red2 = kL + 768;
            const int e = tid & 127, dq = tid >> 7;
            const size_t SZ = (size_t)8 * 128 * 128;
            const float* st = kp.in(2) + ((size_t)j * 128 + (s < 4 ? 0 : s - 4)) * SZ + (size_t)h * 128 * 128;
#pragma unroll 4
            for (int i = 0; i < 32; ++i) { const int d = dq * 32 + i; SL[d * 128 + e] = s < 4 ? 0.f : st[(size_t)d * 128 + e]; }
            for (int t = 0; t < L; ++t) {
                const size_t r = (size_t)(row0 + t);
                if (tid < 128) kL[tid] = KN[r * 1024 + h * 128 + tid]; else if (tid < 256) qL[tid - 128] = QN[r * 1024 + h * 128 + (tid - 128)];
                const float ve = VV[r * 1024 + h * 128 + e], beta = BETA[r * 8 + h], a = expf(GDEC[r * 8 + h]);
                __syncthreads();
                float part = 0.f;
#pragma unroll 4
                for (int i = 0; i < 32; ++i) { const int d = dq * 32 + i; const float sv = SL[d * 128 + e] * a; SL[d * 128 + e] = sv; part += kL[d] * sv; }
                red[dq * 128 + e] = part;
                __syncthreads();
                const float kS = (red[e] + red[128 + e]) + (red[256 + e] + red[384 + e]);
                const float u = beta * (ve - kS);
                float part2 = 0.f;
#pragma unroll 4
                for (int i = 0; i < 32; ++i) { const int d = dq * 32 + i; const float sv = SL[d * 128 + e] + kL[d] * u; SL[d * 128 + e] = sv; part2 += qL[d] * sv; }
                red2[dq * 128 + e] = part2;
                __syncthreads();
                if (dq == 0) ODN[r * 1024 + h * 128 + e] = (red2[e] + red2[128 + e]) + (red2[256 + e] + red2[384 + e]);
            }
            float* dst = s < 4 ? kp.out() + O_DN_P + ((size_t)j * 4 + s) * SZ + (size_t)h * 128 * 128 : kp.out() + O_DN_S + ((size_t)j * 128 + (s - 4)) * SZ + (size_t)h * 128 * 128;
#pragma unroll 4
            for (int i = 0; i < 32; ++i) { const int d = dq * 32 + i; dst[(size_t)d * 128 + e] = SL[d * 128 + e]; }
        } else {
            LAS float* kL = SL + 32768; LAS float* qL = kL + 128; LAS float* aL = kL + 256; LAS float* red = kL + 384;
            const int e = tid & 255, dh = tid >> 8;
            const size_t SZ = (size_t)4 * 128 * 256;
            const float* st = kp.in(4) + ((size_t)j * 128 + (s < 4 ? 0 : s - 4)) * SZ + (size_t)h * 128 * 256;
#pragma unroll 4
            for (int i = 0; i < 64; ++i) { const int d = dh * 64 + i; SL[d * 256 + e] = s < 4 ? 0.f : st[(size_t)d * 256 + e]; }
            for (int t = 0; t < L; ++t) {
                const size_t r = (size_t)(row0 + t);
                if (tid < 128) kL[tid] = bf2f(U[r * NAB + 4608 + h * 128 + tid]);
                else if (tid < 256) qL[tid - 128] = bf2f(U[r * NAB + 4096 + h * 128 + (tid - 128)]) * 0.08838834764831845f;
                else if (tid < 384) aL[tid - 256] = expf(GLOG[r * 512 + h * 128 + (tid - 256)]);
                const float ve = bf2f(U[r * NAB + 5120 + h * 256 + e]);
                __syncthreads();
                float part = 0.f;
#pragma unroll 4
                for (int i = 0; i < 64; ++i) { const int d = dh * 64 + i; const float sv = aL[d] * SL[d * 256 + e] + kL[d] * ve; SL[d * 256 + e] = sv; part += qL[d] * sv; }
                red[dh * 256 + e] = part;
                __syncthreads();
                if (dh == 0) OGLA[r * 1024 + h * 256 + e] = red[e] + red[256 + e];
            }
            float* dst = s < 4 ? kp.out() + O_GLA_P + ((size_t)j * 4 + s) * SZ + (size_t)h * 128 * 256 : kp.out() + O_GLA_S + ((size_t)j * 128 + (s - 4)) * SZ + (size_t)h * 128 * 256;
#pragma unroll 4
            for (int i = 0; i < 64; ++i) { const int d = dh * 64 + i; dst[(size_t)d * 256 + e] = SL[d * 256 + e]; }
        }
    }
}

__device__ __forceinline__ void phase_ab_post(const KP kp, const int bid, const int G, int j, int tid, int wave, int lane) {
    unsigned char* scr = kp.ws() + WS_SCR; const bf16* U = (const bf16*)(kp.ws() + WS_U); bf16* YM = (bf16*)(kp.ws() + WS_YM);
    const float* ODN = (const float*)(scr + SC_ODN); const float* OGLA = (const float*)(scr + SC_OGLA);
    const float* dnn = kp.in(17) + (size_t)j * 128; const float* glan = kp.in(20) + (size_t)j * 256;
    for (int r = bid; r < T; r += G) {
        int s, t; row_to_seq(r, s, t); int row0, L; seq_info(s, row0, L);
        { float o[2];
#pragma unroll
          for (int i = 0; i < 2; ++i) o[i] = ODN[(size_t)r * 1024 + wave * 128 + lane + 64 * i];
          const float rstd = rsqrtf(wave_sum(o[0] * o[0] + o[1] * o[1]) * (1.f / 128.f) + 1e-6f);
#pragma unroll
          for (int i = 0; i < 2; ++i) { const int e = lane + 64 * i; const float z = bf2f(U[(size_t)r * NAB + 3072 + wave * 128 + e]);
              YM[(size_t)r * DM + wave * 128 + e] = (bf16)f2bf(o[i] * rstd * dnn[e] * silu_(z)); } }
        if (wave < 4) { float o[4]; float ss = 0.f;
#pragma unroll
          for (int i = 0; i < 4; ++i) { o[i] = OGLA[(size_t)r * 1024 + wave * 256 + lane + 64 * i]; ss += o[i] * o[i]; }
          const float rstd = rsqrtf(wave_sum(ss) * (1.f / 256.f) + 1e-6f);
#pragma unroll
          for (int i = 0; i < 4; ++i) { const int e = lane + 64 * i; const float z = bf2f(U[(size_t)r * NAB + 6144 + wave * 256 + e]);
              YM[(size_t)r * DM + 1024 + wave * 256 + e] = (bf16)f2bf(o[i] * rstd * glan[e] * silu_(z)); } }
        if (t >= L - 3) { const int rr = t - (L - 3);
            float* dst = s < 4 ? kp.out() + O_DNC_P + (((size_t)j * 4 + s) * 3 + rr) * 3072 : kp.out() + O_DNC_S + (((size_t)j * 128 + (s - 4)) * 3 + rr) * 3072;
            for (int c = tid; c < 3072; c += NTHR) dst[c] = bf2f(U[(size_t)r * NAB + c]); }
    }
}

__device__ __forceinline__ void phase_cd_pre(const KP kp, const int bid, const int G, int j, LAS unsigned char* lds, int tid) {
    unsigned char* scr = kp.ws() + WS_SCR; const bf16* U = (const bf16*)(kp.ws() + WS_U);
    float* XBC = (float*)(scr + SC_XBC); float* LA = (float*)(scr + SC_LA); float* LB = (float*)(scr + SC_LB); float* DT = (float*)(scr + SC_DT);
    const float* cw = kp.in(23) + (size_t)j * 4 * 1536; const float* cb = kp.in(24) + (size_t)j * 1536; const float* stc = kp.in(6) + (size_t)j * 128 * 3 * 1536;
    const float* lcw = kp.in(29) + (size_t)j * 4 * 1024; const float* lcb = kp.in(30) + (size_t)j * 1024; const float* lstc = kp.in(8) + (size_t)j * 128 * 3 * 1024;
    const float* wa = kp.in(31) + (size_t)j * 16 * 64 * 64; const float* wx = kp.in(33) + (size_t)j * 16 * 64 * 64;
    const float* lba = kp.in(32) + (size_t)j * 1024; const float* lbx = kp.in(34) + (size_t)j * 1024; const float* lam = kp.in(35) + (size_t)j * 1024;
    LAS float* xcL = (LAS float*)lds;
    for (int r = bid; r < T; r += G) {
        int s, t; row_to_seq(r, s, t); const int row0 = r - t;
#pragma unroll
        for (int i = 0; i < 3; ++i) { const int c = tid + NTHR * i; float acc = cb[c];
#pragma unroll
            for (int tap = 0; tap < 4; ++tap) acc += cw[tap * 1536 + c] * pre_val(U, NCD, 1024 + c, row0, t - 3 + tap, s, stc, 1536, c);
            XBC[(size_t)r * 1536 + c] = silu_(acc); }
        if (tid < 16) DT[(size_t)r * 16 + tid] = softplus_(bf2f(U[(size_t)r * NCD + 4608 + tid]) + kp.in(26)[j * 16 + tid]);
        float xc[2];
#pragma unroll
        for (int i = 0; i < 2; ++i) { const int ch = tid + NTHR * i; float acc = lcb[ch];
#pragma unroll
            for (int tap = 0; tap < 4; ++tap) acc += lcw[tap * 1024 + ch] * pre_val(U, NCD, 3584 + ch, row0, t - 3 + tap, s, lstc, 1024, ch);
            xc[i] = acc; xcL[ch] = acc; }
        __syncthreads();
#pragma unroll
        for (int i = 0; i < 2; ++i) { const int ch = tid + NTHR * i, n = ch >> 6, d = ch & 63; float ra = lba[ch], ix = lbx[ch];
#pragma unroll 8
            for (int c = 0; c < 64; ++c) { const float x = xcL[n * 64 + c]; ra += x * wa[(size_t)(n * 64 + c) * 64 + d]; ix += x * wx[(size_t)(n * 64 + c) * 64 + d]; }
            const float rg = sigmoid_(ra), ig = sigmoid_(ix);
            const float log_a = -8.f * rg * softplus_(-lam[ch]);
            LA[(size_t)r * 1024 + ch] = expf(log_a);
            LB[(size_t)r * 1024 + ch] = sqrtf(-expm1f(2.f * log_a)) * (ig * xc[i]); }
        __syncthreads();
    }
}

__device__ __forceinline__ void phase_cd_rec(const KP kp, const int bid, const int G, int j, LAS unsigned char* lds, int tid) {
    unsigned char* scr = kp.ws() + WS_SCR;
    const float* XBC = (const float*)(scr + SC_XBC); const float* LA = (const float*)(scr + SC_LA); const float* LB = (const float*)(scr + SC_LB); const float* DT = (const float*)(scr + SC_DT);
    float* YS = (float*)(scr + SC_YS); float* HS = (float*)(scr + SC_HS);
    LAS float* bL = (LAS float*)lds; LAS float* cL = bL + 64; LAS float* red = bL + 128;
    for (int item = bid; item < 2376; item += G) {
        int kind, s, h;
        if (item < 64) { kind = 0; s = item >> 4; h = item & 15; }
        else if (item < 72) { kind = 1; s = (item - 64) >> 1; h = (item - 64) & 1; }
        else if (item < 2120) { kind = 0; s = 4 + ((item - 72) >> 4); h = (item - 72) & 15; }
        else { kind = 1; s = 4 + ((item - 2120) >> 1); h = (item - 2120) & 1; }
        int row0, L; seq_info(s, row0, L);
        __syncthreads();
        if (kind == 0) {
            const int p = tid & 63, ng = tid >> 6, grp = h >> 2;
            const size_t SZ = (size_t)16 * 64 * 64;
            float S[8];
            if (s < 4) {
#pragma unroll
                for (int i = 0; i < 8; ++i) S[i] = 0.f;
            } else { const float* st = kp.in(5) + ((size_t)j * 128 + (s - 4)) * SZ + (size_t)h * 64 * 64;
#pragma unroll
                for (int i = 0; i < 8; ++i) S[i] = st[(size_t)(ng * 8 + i) * 64 + p]; }
            const float negA = -expf(kp.in(25)[j * 16 + h]), Dh = kp.in(27)[j * 16 + h];
            for (int t = 0; t < L; ++t) {
                const size_t r = (size_t)(row0 + t);
                if (tid < 64) bL[tid] = XBC[r * 1536 + 1024 + grp * 64 + tid]; else if (tid < 128) cL[tid - 64] = XBC[r * 1536 + 1280 + grp * 64 + (tid - 64)];
                const float xp = XBC[r * 1536 + h * 64 + p], dt = DT[r * 16 + h], a = expf(negA * dt), xdt = xp * dt;
                __syncthreads();
                float part = 0.f;
#pragma unroll
                for (int i = 0; i < 8; ++i) { const int n = ng * 8 + i; S[i] = a * S[i] + bL[n] * xdt; part += cL[n] * S[i]; }
                red[ng * 64 + p] = part;
                __syncthreads();
                if (ng == 0) { float y = 0.f;
#pragma unroll
                    for (int g = 0; g < 8; ++g) y += red[g * 64 + p];
                    YS[r * 1024 + h * 64 + p] = y + Dh * xp; }
            }
            float* dst = s < 4 ? kp.out() + O_SSD_P + ((size_t)j * 4 + s) * SZ + (size_t)h * 64 * 64 : kp.out() + O_SSD_S + ((size_t)j * 128 + (s - 4)) * SZ + (size_t)h * 64 * 64;
#pragma unroll
            for (int i = 0; i < 8; ++i) dst[(size_t)(ng * 8 + i) * 64 + p] = S[i];
        } else {
            const int ch = h * 512 + tid;
            float hh = s < 4 ? 0.f : kp.in(7)[((size_t)j * 128 + (s - 4)) * 1024 + ch];
#pragma unroll 8
            for (int t = 0; t < L; ++t) { const size_t r = (size_t)(row0 + t); hh = LA[r * 1024 + ch] * hh + LB[r * 1024 + ch]; HS[r * 1024 + ch] = hh; }
            float* dst = s < 4 ? kp.out() + O_LRU_P + ((size_t)j * 4 + s) * 1024 : kp.out() + O_LRU_S + ((size_t)j * 128 + (s - 4)) * 1024;
            dst[ch] = hh;
        }
    }
}

__device__ __forceinline__ void phase_cd_post(const KP kp, const int bid, const int G, int j, int tid, int wave, int lane) {
    unsigned char* scr = kp.ws() + WS_SCR; const bf16* U = (const bf16*)(kp.ws() + WS_U); bf16* YM = (bf16*)(kp.ws() + WS_YM);
    const float* YS = (const float*)(scr + SC_YS); const float* HS = (const float*)(scr + SC_HS);
    const float* sn = kp.in(28) + (size_t)j * 1024;
    for (int r = bid; r < T; r += G) {
        int s, t; row_to_seq(r, s, t); int row0, L; seq_info(s, row0, L);
        if (wave < 4) { float y[4]; float ss = 0.f;
#pragma unroll
            for (int i = 0; i < 4; ++i) { const int e = wave * 256 + lane + 64 * i; y[i] = YS[(size_t)r * 1024 + e] * silu_(bf2f(U[(size_t)r * NCD + e])); ss += y[i] * y[i]; }
            const float rstd = rsqrtf(wave_sum(ss) * (1.f / 256.f) + 1e-6f);
#pragma unroll
            for (int i = 0; i < 4; ++i) { const int e = wave * 256 + lane + 64 * i; YM[(size_t)r * DM + e] = (bf16)f2bf(y[i] * rstd * sn[e]); }
        } else {
#pragma unroll
            for (int i = 0; i < 4; ++i) { const int ch = (wave - 4) * 256 + lane + 64 * i;
                YM[(size_t)r * DM + 1024 + ch] = (bf16)f2bf(HS[(size_t)r * 1024 + ch] * silu_(bf2f(U[(size_t)r * NCD + 2560 + ch]))); }
        }
        if (t >= L - 3) { const int rr = t - (L - 3);
            float* d1 = s < 4 ? kp.out() + O_SSDC_P + (((size_t)j * 4 + s) * 3 + rr) * 1536 : kp.out() + O_SSDC_S + (((size_t)j * 128 + (s - 4)) * 3 + rr) * 1536;
            for (int c = tid; c < 1536; c += NTHR) d1[c] = bf2f(U[(size_t)r * NCD + 1024 + c]);
            float* d2 = s < 4 ? kp.out() + O_LRUC_P + (((size_t)j * 4 + s) * 3 + rr) * 1024 : kp.out() + O_LRUC_S + (((size_t)j * 128 + (s - 4)) * 3 + rr) * 1024;
            for (int c = tid; c < 1024; c += NTHR) d2[c] = bf2f(U[(size_t)r * NCD + 3584 + c]); }
    }
}

__global__ void __launch_bounds__(NTHR, 2) mega_fwd(Args A) {
    extern __shared__ __attribute__((aligned(16))) unsigned char lds_raw[];
    LAS unsigned char* lds = (LAS unsigned char*)lds_raw;
    const int G = gridDim.x;
    for (int ph = A.ph_lo; ph < A.ph_hi; ++ph) {
        KP kp; kp.p = (const char AS4*)__builtin_amdgcn_kernarg_segment_ptr(); asm volatile("" : "+s"(kp.p));
        unsigned char* ws = kp.ws();
        int tid = threadIdx.x; asm volatile("" : "+v"(tid));
        int bid = blockIdx.x; asm volatile("" : "+s"(bid));
        const int lane = tid & 63, wave = __builtin_amdgcn_readfirstlane(tid >> 6), gw = bid * NWAVES + wave, NGW = G * NWAVES;
        if (ph == 0) { if (PH_MASK & 1) phase_prologue(kp, lds, gw, NGW, wave, lane); }
        else {
            const int li = (ph - 1) / 9, sub = (ph - 1) % 9, j = li >> 1; const bool ab = (li & 1) == 0;
            if (sub == 0) {
                const int N = ab ? NAB : NCD;
                const bf16* Bt = ab ? (const bf16*)(ws + WS_WABIN) + (size_t)j * NAB * 2048 : (const bf16*)(ws + WS_WCDIN) + (size_t)j * NCD * 2048;
                pg8::Gemm g{(const bf16*)(ws + WS_XN), Bt, T, N, 2048}; pg8::StaticOrder S; S.init(T, N, G, bid);
                pg8::EpiBf16 E{(bf16*)(ws + WS_U), N};
                if (PH_MASK & 2) pg8::gemm_phase<pg8::EpiBf16, pg8::StaticOrder, true, true>(lds, g, S, E, tid);
            } else if (sub == 4 || sub == 6 || sub == 7) {
                const bf16* Am; const bf16* Bt; int K = 2048; float* C = (float*)(ws + WS_SCR + SC_C);
                if (sub == 4) { Am = (const bf16*)(ws + WS_YM); Bt = ab ? (const bf16*)(ws + WS_WABOUT) + (size_t)j * 2048 * 2048 : (const bf16*)(ws + WS_WCDOUT) + (size_t)j * 2048 * 2048; }
                else if (sub == 6) { Am = (const bf16*)(ws + WS_XN); Bt = (const bf16*)(ws + WS_WGATE) + (size_t)li * 2048 * 2048; }
                else { Am = (const bf16*)(ws + WS_PB) + (size_t)li * T * 256; Bt = (const bf16*)(ws + WS_WPROJ) + (size_t)li * 2048 * 256; K = 256; C = (float*)(ws + WS_SCR + SC_C2); }
                pg8::Gemm g{Am, Bt, T, 2048, K}; pg8::StaticOrder S; S.init(T, 2048, G, bid);
                pg8::EpiF32 E{C, 2048};
                if (PH_MASK & 4) pg8::gemm_phase<pg8::EpiF32, pg8::StaticOrder, true, true>(lds, g, S, E, tid);
            } else if (sub == 1) { if (ab) { if (PH_MASK & 8) phase_ab_pre(kp, bid, G, j, tid, wave, lane); } else { if (PH_MASK & 16) phase_cd_pre(kp, bid, G, j, lds, tid); } }
            else if (sub == 2) { if (ab) { if (PH_MASK & 32) phase_ab_rec(kp, bid, G, j, lds, tid); } else { if (PH_MASK & 64) phase_cd_rec(kp, bid, G, j, lds, tid); } }
            else if (sub == 3) { if (ab) { if (PH_MASK & 128) phase_ab_post(kp, bid, G, j, tid, wave, lane); } else { if (PH_MASK & 256) phase_cd_post(kp, bid, G, j, tid, wave, lane); } }
            else if (sub == 5) { if (PH_MASK & 512) phase_res1(kp, li, gw, NGW, lane); }
            else { if (PH_MASK & 1024) phase_res2(kp, li, gw, NGW, lane); }
        }
        if (ph + 1 < A.ph_hi) { cg::this_grid().sync(); }
    }
}

extern "C" void kernel_launch(void* const* d_in, const int* in_sizes, int n_in, void* d_out, int out_size, void* d_ws, size_t ws_size, hipStream_t stream) {
    static int grid = 0;
    if (grid == 0) {
        if (n_in != 40 || (size_t)out_size != O_END || ws_size < WS_END) { fprintf(stderr, "kernel_launch: unexpected shapes: n_in %d out %d ws %zu\n", n_in, out_size, ws_size); grid = -1; return; }
        int dev = 0, cus = 0, per_cu = 0;
        if (hipGetDevice(&dev) != hipSuccess || hipDeviceGetAttribute(&cus, hipDeviceAttributeMultiprocessorCount, dev) != hipSuccess) { grid = -1; return; }
        if (hipFuncSetAttribute((const void*)mega_fwd, hipFuncAttributeMaxDynamicSharedMemorySize, LDS_BYTES) != hipSuccess) { fprintf(stderr, "kernel_launch: hipFuncSetAttribute failed\n"); grid = -1; return; }
        if (hipOccupancyMaxActiveBlocksPerMultiprocessor(&per_cu, (const void*)mega_fwd, NTHR, LDS_BYTES) != hipSuccess || per_cu < 1) { fprintf(stderr, "kernel_launch: occupancy query says %d\n", per_cu); per_cu = 1; }
        (void)hipGetLastError();
        grid = cus;
    }
    if (grid < 0) return;
    Args a{};
    for (int i = 0; i < 40; ++i) a.in[i] = (const float*)d_in[i];
    a.out = (float*)d_out; a.ws = (unsigned char*)d_ws;
#if MK_N_LAUNCHES == 1
    a.ph_lo = 0; a.ph_hi = N_PHASES;
    void* args[] = {&a};
    hipError_t e = hipLaunchCooperativeKernel((const void*)mega_fwd, dim3(grid), dim3(NTHR), args, LDS_BYTES, stream);
    if (e != hipSuccess) fprintf(stderr, "cooperative launch failed: %s (grid %d)\n", hipGetErrorString(e), grid);
#else
    for (int ph = 0; ph < N_PHASES; ++ph) { a.ph_lo = ph; a.ph_hi = ph + 1; mega_fwd<<<dim3(grid), dim3(NTHR), LDS_BYTES, stream>>>(a); }
#endif
}
```

```cpp
#include <hip/hip_runtime.h>
#include <hip/hip_cooperative_groups.h>
#include <cstdio>
#include <cstdint>
namespace cg = cooperative_groups;

#ifndef MK_N_LAUNCHES
#define MK_N_LAUNCHES 1
#endif

namespace pg8 {
#define PG8_LAS __attribute__((address_space(3)))
typedef unsigned short bf16_t;
typedef short bf16x8 __attribute__((ext_vector_type(8)));
typedef float f32x4 __attribute__((ext_vector_type(4)));
typedef unsigned u32x4 __attribute__((ext_vector_type(4)));
constexpr int BM = 256, BK = 64, HALF = 128, HTB = HALF * BK * 2  , STAGE_BYTES = 8 * HTB, NXCD = 8, WGM = 8;

__host__ __device__ __forceinline__ int lds_byte(int r, int c) { const int st = (r >> 4) * 2 + (c >> 5), rr = r & 15, cc = c & 31, ob = rr * 64 + cc * 2; return st * 1024 + (ob ^ (((ob >> 9) & 1) << 5)); }
__host__ __device__ __forceinline__ void stage_rc(int b, int& R, int& C) { const int st = b / 1024, sb = b % 1024, swz = sb ^ (((sb >> 9) & 1) << 5); R = (st >> 1) * 16 + swz / 64; C = (st & 1) * 32 + (swz % 64) / 2; }
__host__ __device__ __forceinline__ int perm32(int rho) { const int n = rho >> 4, i = rho & 15; return 8 * (i >> 2) + 4 * n + (i & 3); }

struct Unit { int pm, pn; };
struct Gemm { const bf16_t* A; const bf16_t* Bt; int M, N, K; };

struct StaticOrder {
    int nM, nN, nwg, G, c;
    __host__ __device__ void init(int M, int N, int G_, int c_) { nM = M / BM; nN = N / BM; nwg = nM * nN; G = G_; c = c_; }
    __host__ __device__ bool next(int i, Unit& u) const {
        const long L = (long)i * G + c; if (L >= nwg) return false;
        int wgid = (int)L; { const int q = nwg / NXCD, r = nwg % NXCD, xcd = wgid % NXCD, off = wgid / NXCD; wgid = (xcd < r ? xcd * (q + 1) : r * (q + 1) + (xcd - r) * q) + off; }
        const int nig = WGM * nN, gid = wgid / nig, fm = gid * WGM, gsz = (nM - fm) < WGM ? (nM - fm) : WGM;
        u.pm = fm + ((wgid % nig) % gsz); u.pn = (wgid % nig) / gsz; return true;
    }
    __device__ __forceinline__ void a_ready(const Unit&) const {}
    __device__ __forceinline__ void done(const Unit&) const {}
};

__device__ __forceinline__ unsigned cvt_pk_bf16(float lo, float hi) { unsigned r; asm volatile("v_cvt_pk_bf16_f32 %0, %1, %2" : "=v"(r) : "v"(lo), "v"(hi)); return r; }
struct EpiF32 {
    static constexpr bool PERM = false, AFTER_DRAIN = false;
    float* C; int ldc;
    __device__ __forceinline__ void operator()(const f32x4 (&acc)[2][2][4][2], const Unit& u, int wr, int wc, int fr, int fq) const {
        const int row0 = u.pm * BM + wr * 64 + fr, col0 = u.pn * BM + wc * 32 + 4 * fq;
#pragma unroll
        for (int ai = 0; ai < 2; ++ai)
#pragma unroll
            for (int m = 0; m < 4; ++m) { float* rowp = C + (size_t)(row0 + ai * HALF + m * 16) * ldc + col0;
#pragma unroll
                for (int bj = 0; bj < 2; ++bj)
#pragma unroll
                    for (int n = 0; n < 2; ++n) *(f32x4*)(rowp + bj * HALF + n * 16) = acc[ai][bj][m][n]; }
    }
};
struct EpiBf16 {
    static constexpr bool PERM = true, AFTER_DRAIN = false;
    bf16_t* O; int ldc;
    __device__ __forceinline__ void operator()(const f32x4 (&acc)[2][2][4][2], const Unit& u, int wr, int wc, int fr, int fq) const {
        const int row0 = u.pm * BM + wr * 64 + fr; const int col0 = u.pn * BM + wc * 32 + 8 * fq;
#pragma unroll
        for (int ai = 0; ai < 2; ++ai)
#pragma unroll
            for (int m = 0; m < 4; ++m) { bf16_t* rowp = O + (size_t)(row0 + ai * HALF + m * 16) * ldc + col0;
#pragma unroll
                for (int bj = 0; bj < 2; ++bj) { const f32x4 v0 = acc[ai][bj][m][0], v1 = acc[ai][bj][m][1];
                    u32x4 w; w.x = cvt_pk_bf16(v0[0], v0[1]); w.y = cvt_pk_bf16(v0[2], v0[3]); w.z = cvt_pk_bf16(v1[0], v1[1]); w.w = cvt_pk_bf16(v1[2], v1[3]);
                    *(u32x4*)(rowp + bj * HALF) = w; } }
    }
};
template <class Epi, class Sched, bool ALIGN_EPI = false, bool SP2 = false>
__device__ __forceinline__ void gemm_phase(PG8_LAS unsigned char* lds, const Gemm g, const Sched& S, const Epi& E, const int tid) {
    const int wid = __builtin_amdgcn_readfirstlane(tid >> 6), lane = tid & 63, wr = wid >> 2, wc = wid & 3, fr = lane & 15, fq = lane >> 4;
    const int K = g.K, nt = K / BK;
    unsigned voffA[2], voffB[2];
#pragma unroll
    for (int i = 0; i < 2; ++i) { int R, C; stage_rc(tid * 16 + i * 8192, R, C); const int Rb = Epi::PERM ? ((R & ~31) + perm32(R & 31)) : R;
        voffA[i] = (unsigned)(R * K + C) * 2u; voffB[i] = (unsigned)(Rb * K + C) * 2u; }
    const size_t kstep = (size_t)(BK * 2);
    const size_t hstep = (size_t)HALF * K * 2;
    const size_t tstep = 2 * hstep;
    const unsigned ldsw = (unsigned)wid * 1024u;
    const int aoff = lds_byte(wr * 64 + fr, fq * 8), boff = lds_byte(wc * 32 + fr, fq * 8);
#define PG8_SA(b, h) (((b) * 2 + (h)) * HTB)
#define PG8_SB(b, h) ((4 + (b) * 2 + (h)) * HTB)
#define PG8_STAGE(bufoff, gbase, voff) do { _Pragma("unroll") for (int _i = 0; _i < 2; ++_i) \
        __builtin_amdgcn_global_load_lds((const unsigned*)((const char*)(gbase) + (voff)[_i]), (PG8_LAS unsigned*)(lds + (bufoff) + ldsw + _i * 8192), 16, 0, 0); } while (0)
#define PG8_LDA(dst, b, h) do { _Pragma("unroll") for (int m = 0; m < 4; ++m) _Pragma("unroll") for (int k = 0; k < 2; ++k) dst[m][k] = *(const PG8_LAS bf16x8*)(lds + PG8_SA(b, h) + aoff + m * 2048 + k * 1024); } while (0)
#define PG8_LDB(dst, b, h) do { _Pragma("unroll") for (int n = 0; n < 2; ++n) _Pragma("unroll") for (int k = 0; k < 2; ++k) dst[n][k] = *(const PG8_LAS bf16x8*)(lds + PG8_SB(b, h) + boff + n * 2048 + k * 1024); } while (0)
#define PG8_MMA(ai, bj, At, Bt) do { __builtin_amdgcn_s_setprio(1); _Pragma("unroll") for (int m = 0; m < 4; ++m) _Pragma("unroll") for (int n = 0; n < 2; ++n) _Pragma("unroll") for (int k = 0; k < 2; ++k) \
        acc[ai][bj][m][n] = __builtin_amdgcn_mfma_f32_16x16x32_bf16(Bt[n][k], At[m][k], acc[ai][bj][m][n], 0, 0, 0); __builtin_amdgcn_s_setprio(0); } while (0)
#define PG8_WAIT_V(n) asm volatile("s_waitcnt vmcnt(" #n ")" ::: "memory")
#define PG8_WAIT_L(n) asm volatile("s_waitcnt lgkmcnt(" #n ")" ::: "memory")
#define PG8_BAR __builtin_amdgcn_s_barrier()
#define PG8_SCHED __builtin_amdgcn_sched_barrier(0)
    Unit cur, nxt; int ui = 0;
    if (!S.next(0, cur)) return;
    f32x4 acc[2][2][4][2];
#pragma unroll
    for (int a = 0; a < 2; ++a)
#pragma unroll
        for (int b = 0; b < 2; ++b)
#pragma unroll
            for (int m = 0; m < 4; ++m)
#pragma unroll
                for (int n = 0; n < 2; ++n) acc[a][b][m][n] = (f32x4){0.f, 0.f, 0.f, 0.f};
    bf16x8 At[4][2], B0[2][2], B1[2][2];
    const char* cA = (const char*)g.A + (size_t)cur.pm * tstep; const char* cB = (const char*)g.Bt + (size_t)cur.pn * tstep;
    S.a_ready(cur);
    if constexpr (SP2) {
        PG8_STAGE(PG8_SB(0, 0), cB, voffB); PG8_STAGE(PG8_SB(0, 1), cB + hstep, voffB); PG8_STAGE(PG8_SA(0, 0), cA, voffA); PG8_STAGE(PG8_SA(0, 1), cA + hstep, voffA);
        if (wr == 1) PG8_BAR;
        PG8_WAIT_V(2); PG8_BAR;
        PG8_STAGE(PG8_SB(1, 0), cB + kstep, voffB); PG8_STAGE(PG8_SA(1, 0), cA + kstep, voffA); PG8_STAGE(PG8_SB(1, 1), cB + hstep + kstep, voffB);
        PG8_WAIT_V(6); PG8_BAR;
    } else {
        PG8_STAGE(PG8_SB(0, 0), cB, voffB); PG8_STAGE(PG8_SA(0, 0), cA, voffA); PG8_STAGE(PG8_SB(0, 1), cB + hstep, voffB); PG8_STAGE(PG8_SA(0, 1), cA + hstep, voffA);
        if (wr == 1) PG8_BAR;
        PG8_WAIT_V(4); PG8_BAR;
        PG8_STAGE(PG8_SB(1, 0), cB + kstep, voffB); PG8_STAGE(PG8_SA(1, 0), cA + kstep, voffA); PG8_STAGE(PG8_SB(1, 1), cB + hstep + kstep, voffB);
        PG8_WAIT_V(6); PG8_BAR;
    }
    for (;;) {
        const bool has_next = S.next(ui + 1, nxt);
        const char* nA = has_next ? (const char*)g.A + (size_t)nxt.pm * tstep : cA; const char* nB = has_next ? (const char*)g.Bt + (size_t)nxt.pn * tstep : cB;
        for (int t = 0; t < nt; t += 2) {
            const bool last = (t == nt - 2);
            const char* a1 = cA + (size_t)(t + 1) * kstep;
            const char* a2 = last ? nA : cA + (size_t)(t + 2) * kstep; const char* b2 = last ? nB : cB + (size_t)(t + 2) * kstep;
            const char* a3 = a2 + kstep; const char* b3 = b2 + kstep;
            if (last && has_next) S.a_ready(nxt);
            if constexpr (SP2) {
            PG8_LDB(B0, 0, 0); PG8_LDB(B1, 0, 1); PG8_SCHED; PG8_LDA(At, 0, 0); PG8_STAGE(PG8_SA(1, 1), a1 + hstep, voffA);
            PG8_WAIT_V(8); PG8_WAIT_L(0); PG8_BAR; PG8_MMA(0, 0, At, B0); PG8_MMA(0, 1, At, B1); PG8_BAR; PG8_SCHED;
            PG8_LDA(At, 0, 1); PG8_STAGE(PG8_SB(0, 0), b2, voffB); PG8_STAGE(PG8_SB(0, 1), b2 + hstep, voffB); PG8_STAGE(PG8_SA(0, 0), a2, voffA);
            PG8_WAIT_V(8); PG8_WAIT_L(0); PG8_BAR; PG8_MMA(1, 0, At, B0); PG8_MMA(1, 1, At, B1); PG8_BAR; PG8_SCHED;
            PG8_LDB(B0, 1, 0); PG8_LDB(B1, 1, 1); PG8_SCHED; PG8_LDA(At, 1, 0); PG8_STAGE(PG8_SA(0, 1), a2 + hstep, voffA);
            PG8_WAIT_V(8); PG8_WAIT_L(0); PG8_BAR; PG8_MMA(0, 0, At, B0); PG8_MMA(0, 1, At, B1); PG8_BAR; PG8_SCHED;
            PG8_LDA(At, 1, 1); PG8_STAGE(PG8_SB(1, 0), b3, voffB); PG8_STAGE(PG8_SB(1, 1), b3 + hstep, voffB); PG8_STAGE(PG8_SA(1, 0), a3, voffA);
            PG8_WAIT_V(8); PG8_WAIT_L(0); PG8_BAR; PG8_MMA(1, 0, At, B0); PG8_MMA(1, 1, At, B1); PG8_BAR; PG8_SCHED;
            } else {
            PG8_LDB(B0, 0, 0); PG8_SCHED; PG8_LDA(At, 0, 0); PG8_STAGE(PG8_SA(1, 1), a1 + hstep, voffA);
            PG8_WAIT_L(8); PG8_BAR; PG8_WAIT_L(0); PG8_MMA(0, 0, At, B0); PG8_BAR; PG8_SCHED;
            PG8_LDB(B1, 0, 1); PG8_STAGE(PG8_SB(0, 0), b2, voffB);
            PG8_BAR; PG8_WAIT_L(0); PG8_MMA(0, 1, At, B1); PG8_BAR;
            PG8_LDA(At, 0, 1); PG8_STAGE(PG8_SA(0, 0), a2, voffA);
            PG8_BAR; PG8_WAIT_L(0); PG8_MMA(1, 0, At, B0); PG8_BAR; PG8_SCHED;
            PG8_STAGE(PG8_SB(0, 1), b2 + hstep, voffB);
            PG8_WAIT_V(6); PG8_BAR; PG8_MMA(1, 1, At, B1); PG8_BAR;
            PG8_LDB(B0, 1, 0); PG8_SCHED; PG8_LDA(At, 1, 0); PG8_STAGE(PG8_SA(0, 1), a2 + hstep, voffA);
            PG8_WAIT_L(8); PG8_BAR; PG8_WAIT_L(0); PG8_MMA(0, 0, At, B0); PG8_BAR; PG8_SCHED;
            PG8_LDB(B1, 1, 1); PG8_STAGE(PG8_SB(1, 0), b3, voffB);
            PG8_BAR; PG8_WAIT_L(0); PG8_MMA(0, 1, At, B1); PG8_BAR;
            PG8_LDA(At, 1, 1); PG8_STAGE(PG8_SA(1, 0), a3, voffA);
            PG8_BAR; PG8_WAIT_L(0); PG8_MMA(1, 0, At, B0); PG8_BAR; PG8_SCHED;
            PG8_STAGE(PG8_SB(1, 1), b3 + hstep, voffB);
            PG8_WAIT_V(6); PG8_BAR; PG8_MMA(1, 1, At, B1); PG8_BAR;
            }
        }
        if constexpr (ALIGN_EPI) { if (wr == 0) PG8_BAR; }
        if constexpr (!Epi::AFTER_DRAIN) { E(acc, cur, wr, wc, fr, fq); S.done(cur); }
        if (!has_next) break;
#pragma unroll
        for (int a = 0; a < 2; ++a)
#pragma unroll
            for (int b = 0; b < 2; ++b)
#pragma unroll
                for (int m = 0; m < 4; ++m)
#pragma unroll
                    for (int n = 0; n < 2; ++n) acc[a][b][m][n] = (f32x4){0.f, 0.f, 0.f, 0.f};
        cur = nxt; cA = nA; cB = nB; ++ui;
        if constexpr (ALIGN_EPI) { if (wr == 1) PG8_BAR; }
    }
    PG8_WAIT_V(0);
    if constexpr (!ALIGN_EPI) { if (wr == 0) PG8_BAR; }
    PG8_BAR;
    if constexpr (Epi::AFTER_DRAIN) { E.fused(acc, cur, wr, wc, fr, fq, lds, wid, lane); S.done(cur); }
#undef PG8_SA
#undef PG8_SB
#undef PG8_STAGE
#undef PG8_LDA
#undef PG8_LDB
#undef PG8_MMA
#undef PG8_WAIT_V
#undef PG8_WAIT_L
#undef PG8_BAR
#undef PG8_SCHED
}
}

constexpr int TP = 8192, TS = 512, T = TP + TS, DM = 2048, NSEQ = 132;
constexpr int NAB = 7424, NCD = 4864;
constexpr int NWAVES = 8, NTHR = 512;
constexpr size_t MiB = 1u << 20;
constexpr size_t WS_CTL = 0, CTL_ZERO_BYTES = 1 * MiB;
constexpr size_t WS_WABIN = 2 * MiB, WS_WABOUT = 60 * MiB, WS_WCDIN = 76 * MiB, WS_WCDOUT = 114 * MiB, WS_WGATE = 130 * MiB, WS_WPROJ = 162 * MiB;
constexpr size_t WS_H = 166 * MiB, WS_XN = 234 * MiB, WS_YM = 268 * MiB, WS_PB = 302 * MiB, WS_U = 320 * MiB, WS_SCR = 444 * MiB, WS_END = 704 * MiB;
constexpr size_t SC_C = 0, SC_C2 = 68 * MiB;
constexpr size_t SC_QN = 0, SC_KN = 34 * MiB, SC_VV = 68 * MiB, SC_ODN = 102 * MiB, SC_OGLA = 136 * MiB, SC_GLOG = 170 * MiB, SC_BETA = 187 * MiB, SC_GDEC = 188 * MiB;
constexpr size_t SC_XBC = 0, SC_LA = 52 * MiB, SC_LB = 86 * MiB, SC_YS = 120 * MiB, SC_HS = 154 * MiB, SC_DT = 188 * MiB, SC_SSDOP = 192 * MiB, SC_GEND = 256 * MiB;
constexpr int LDS_BYTES = 147456;
constexpr size_t O_Y_P = 0, O_Y_S = O_Y_P + (size_t)4 * 2048 * 2048, O_DN_P = O_Y_S + (size_t)128 * 4 * 2048,
    O_DNC_P = O_DN_P + (size_t)2 * 4 * 8 * 128 * 128, O_GLA_P = O_DNC_P + (size_t)2 * 4 * 3 * 3072, O_SSD_P = O_GLA_P + (size_t)2 * 4 * 4 * 128 * 256,
    O_SSDC_P = O_SSD_P + (size_t)2 * 4 * 16 * 64 * 64, O_LRU_P = O_SSDC_P + (size_t)2 * 4 * 3 * 1536, O_LRUC_P = O_LRU_P + (size_t)2 * 4 * 1024,
    O_DN_S = O_LRUC_P + (size_t)2 * 4 * 3 * 1024, O_DNC_S = O_DN_S + (size_t)2 * 128 * 8 * 128 * 128, O_GLA_S = O_DNC_S + (size_t)2 * 128 * 3 * 3072,
    O_SSD_S = O_GLA_S + (size_t)2 * 128 * 4 * 128 * 256, O_SSDC_S = O_SSD_S + (size_t)2 * 128 * 16 * 64 * 64, O_LRU_S = O_SSDC_S + (size_t)2 * 128 * 3 * 1536,
    O_LRUC_S = O_LRU_S + (size_t)2 * 128 * 1024, O_END = O_LRUC_S + (size_t)2 * 128 * 3 * 1024;
static_assert(O_END == 109064192, "output size");

#define LAS __attribute__((address_space(3)))
typedef unsigned short bf16;
typedef float f32x4 __attribute__((ext_vector_type(4)));
typedef unsigned u32x2 __attribute__((ext_vector_type(2)));
typedef unsigned u32x4 __attribute__((ext_vector_type(4)));
#define LDS_WAIT() asm volatile("s_waitcnt lgkmcnt(0)" ::: "memory")

__device__ __forceinline__ float bf2f(bf16 b) { return __uint_as_float(((unsigned)b) << 16); }
__device__ __forceinline__ unsigned f2bf(float f) { unsigned u = __float_as_uint(f); return (u + 0x7fffu + ((u >> 16) & 1u)) >> 16; }
__device__ __forceinline__ unsigned pk2(float lo, float hi) { return f2bf(lo) | (f2bf(hi) << 16); }
__device__ __forceinline__ float sigmoid_(float x) { return 1.f / (1.f + expf(-x)); }
__device__ __forceinline__ float silu_(float x) { return x / (1.f + expf(-x)); }
__device__ __forceinline__ float softplus_(float x) { return x > 20.f ? x : log1pf(expf(x)); }
__device__ __forceinline__ float wave_sum(float v) {
#pragma unroll
    for (int o = 1; o < 64; o <<= 1) v += __shfl_xor(v, o);
    return v;
}
__device__ __forceinline__ void row_to_seq(int r, int& s, int& t) { if (r < TP) { s = r >> 11; t = r & 2047; } else { s = 4 + ((r - TP) >> 2); t = (r - TP) & 3; } }
__device__ __forceinline__ void seq_info(int s, int& row0, int& L) { if (s < 4) { row0 = s << 11; L = 2048; } else { row0 = TP + ((s - 4) << 2); L = 4; } }
__device__ __forceinline__ float pre_val(const bf16* U, int ldu, int ucol, int row0, int tt, int s, const float* stc, int W, int c) {
    if (tt >= 0) return bf2f(U[(size_t)(row0 + tt) * ldu + ucol]);
    if (s < 4) return 0.f;
    return stc[((size_t)(s - 4) * 3 + (3 + tt)) * W + c];
}
__device__ __forceinline__ int map_col(int mapid, int n) {
    if (mapid == 0) return n;
    if (mapid == 1) { if (n < 3072) return n; if (n < 6144) return n + 16; if (n < 7168) return n + 32; if (n < 7184) return n - 4096; if (n < 7200) return n - 1024; return -1; }
    if (n < 2560) return n; if (n < 4608) return n + 16; if (n < 4624) return n - 2048; return -1;
}
__device__ __forceinline__ void transpose_item(const float* W, int K, int Nsrc, bf16* WT, int Npad, int mapid, LAS float* scr, int item, int lane) {
    const int nblk = Npad / 32, kb = item / nblk, nb = item % nblk, k0 = 64 * kb, n0 = 32 * nb;
    const int src = map_col(mapid, n0 + (lane & 31));
#pragma unroll 8
    for (int i = 0; i < 32; ++i) { const int kk = 2 * i + (lane >> 5); scr[kk * 33 + (lane & 31)] = src >= 0 ? W[(size_t)(k0 + kk) * Nsrc + src] : 0.f; }
    LDS_WAIT(); asm volatile("" ::: "memory");
    const int c = lane & 7;
#pragma unroll
    for (int j = 0; j < 4; ++j) { const int n = (lane >> 3) + 8 * j; const LAS float* s = scr + (8 * c) * 33 + n;
        u32x4 o; o.x = pk2(s[0 * 33], s[1 * 33]); o.y = pk2(s[2 * 33], s[3 * 33]); o.z = pk2(s[4 * 33], s[5 * 33]); o.w = pk2(s[6 * 33], s[7 * 33]);
        *(u32x4*)(WT + (size_t)(n0 + n) * K + k0 + 8 * c) = o; }
    LDS_WAIT(); asm volatile("" ::: "memory");
}
__device__ __forceinline__ void norm_row_bf16(const f32x4 (&v)[8], const float* g, bf16* orow, int lane) {
    float ss = 0.f;
#pragma unroll
    for (int j = 0; j < 8; ++j) ss += (v[j].x * v[j].x + v[j].y * v[j].y) + (v[j].z * v[j].z + v[j].w * v[j].w);
    const float rstd = rsqrtf(wave_sum(ss) * (1.f / DM) + 1e-6f);
#pragma unroll
    for (int j = 0; j < 8; ++j) { const int col = 4 * (lane + 64 * j); const f32x4 gg = *(const f32x4*)(g + col);
        u32x2 o; o.x = pk2(v[j].x * rstd * gg.x, v[j].y * rstd * gg.y); o.y = pk2(v[j].z * rstd * gg.z, v[j].w * rstd * gg.w);
        *(u32x2*)(orow + col) = o; }
}

typedef __bf16 bf16x2_t __attribute__((ext_vector_type(2)));
typedef float f32x2_t __attribute__((ext_vector_type(2)));
typedef short bf16x8 __attribute__((ext_vector_type(8)));
typedef float f32x16 __attribute__((ext_vector_type(16)));
__device__ __forceinline__ unsigned cvtpk(float lo, float hi) { f32x2_t v = {lo, hi}; bf16x2_t b = __builtin_convertvector(v, bf16x2_t); return __builtin_bit_cast(unsigned, b); }
#define MFMA32(a, b, c) __builtin_amdgcn_mfma_f32_32x32x16_bf16((a), (b), (c), 0, 0, 0)
#define PACK_ACC(x, S_) __builtin_bit_cast(bf16x8, (u32x4){cvtpk((x)[8 * (S_)], (x)[8 * (S_) + 1]), cvtpk((x)[8 * (S_) + 2], (x)[8 * (S_) + 3]), cvtpk((x)[8 * (S_) + 4], (x)[8 * (S_) + 5]), cvtpk((x)[8 * (S_) + 6], (x)[8 * (S_) + 7])})
__device__ __forceinline__ int crow(int reg, int h) { return (reg & 3) + 8 * (reg >> 2) + 4 * h; }
__device__ __forceinline__ bf16x8 pack8(const float (&v)[8]) { return __builtin_bit_cast(bf16x8, (u32x4){cvtpk(v[0], v[1]), cvtpk(v[2], v[3]), cvtpk(v[4], v[5]), cvtpk(v[6], v[7])}); }

struct Args { const float* in[40]; float* out; unsigned char* ws; int ph_lo, ph_hi; };
constexpr int N_PHASES = 41, SUBS = 10;
#ifndef PH_MASK
#define PH_MASK 4095
#endif
#define AS4 __attribute__((address_space(4)))
struct KP { const char AS4* p;
    __device__ __forceinline__ const float* in(int i) const { return *(const float* const AS4*)(p + 8 * i); }
    __device__ __forceinline__ float* out() const { return *(float* const AS4*)(p + 320); }
    __device__ __forceinline__ unsigned char* ws() const { return *(unsigned char* const AS4*)(p + 328); }
};
static_assert(sizeof(Args) == 344, "Args layout");

__device__ __forceinline__ void phase_prologue(const KP kp, LAS unsigned char* lds, int gw, int NGW, int wave, int lane) {
    unsigned char* ws = kp.ws();
    LAS float* scr = (LAS float*)(lds + wave * 16384);
    for (int job = 0; job < 16; ++job) {
        const float* W; int K = 2048, Nsrc = 2048, Npad = 2048, mapid = 0; bf16* WT;
        if (job < 2)       { W = kp.in(13) + (size_t)job * 2048 * 7200; Nsrc = 7200; Npad = NAB; mapid = 1; WT = (bf16*)(ws + WS_WABIN) + (size_t)job * NAB * 2048; }
        else if (job < 4)  { W = kp.in(21) + (size_t)(job - 2) * 2048 * 2048; WT = (bf16*)(ws + WS_WABOUT) + (size_t)(job - 2) * 2048 * 2048; }
        else if (job < 6)  { W = kp.in(22) + (size_t)(job - 4) * 2048 * 4624; Nsrc = 4624; Npad = NCD; mapid = 2; WT = (bf16*)(ws + WS_WCDIN) + (size_t)(job - 4) * NCD * 2048; }
        else if (job < 8)  { W = kp.in(36) + (size_t)(job - 6) * 2048 * 2048; WT = (bf16*)(ws + WS_WCDOUT) + (size_t)(job - 6) * 2048 * 2048; }
        else if (job < 12) { W = kp.in(39) + (size_t)(job - 8) * 2048 * 2048; WT = (bf16*)(ws + WS_WGATE) + (size_t)(job - 8) * 2048 * 2048; }
        else               { W = kp.in(37) + (size_t)(job - 12) * 256 * 2048; K = 256; WT = (bf16*)(ws + WS_WPROJ) + (size_t)(job - 12) * 2048 * 256; }
        const int nitems = (K / 64) * (Npad / 32);
        for (int it = gw; it < nitems; it += NGW) transpose_item(W, K, Nsrc, WT, Npad, mapid, scr, it, lane);
    }
    float* H = (float*)(ws + WS_H); bf16* XN = (bf16*)(ws + WS_XN);
    for (int m = gw; m < T; m += NGW) {
        const float* src = m < TP ? kp.in(0) + (size_t)m * DM : kp.in(1) + (size_t)(m - TP) * DM;
        f32x4 v[8];
#pragma unroll
        for (int j = 0; j < 8; ++j) { v[j] = *(const f32x4*)(src + 4 * (lane + 64 * j)); *(f32x4*)(H + (size_t)m * DM + 4 * (lane + 64 * j)) = v[j]; }
        norm_row_bf16(v, kp.in(11), XN + (size_t)m * DM, lane);
    }
    bf16* PB = (bf16*)(ws + WS_PB);
    const int gt = gw * 64 + lane, NGT = NGW * 64;
    for (int i = gt; i < 4 * T * 64; i += NGT) {
        const int c4 = i & 63, r = (i >> 6) % T, li = (i >> 6) / T;
        const float* src = r < TP ? kp.in(9) + ((size_t)li * TP + r) * 256 + 4 * c4 : kp.in(10) + ((size_t)li * TS + (r - TP)) * 256 + 4 * c4;
        const f32x4 v = *(const f32x4*)src;
        u32x2 o; o.x = pk2(v.x, v.y); o.y = pk2(v.z, v.w);
        *(u32x2*)(PB + ((size_t)li * T + r) * 256 + 4 * c4) = o;
    }
}

__device__ __forceinline__ void phase_res1(const KP kp, int li, int gw, int NGW, int lane) {
    float* H = (float*)(kp.ws() + WS_H); bf16* XN = (bf16*)(kp.ws() + WS_XN); const float* C = (const float*)(kp.ws() + WS_SCR + SC_C);
    for (int m = gw; m < T; m += NGW) {
        f32x4 v[8];
#pragma unroll
        for (int j = 0; j < 8; ++j) { const size_t o = (size_t)m * DM + 4 * (lane + 64 * j); v[j] = *(const f32x4*)(H + o) + *(const f32x4*)(C + o); *(f32x4*)(H + o) = v[j]; }
        norm_row_bf16(v, kp.in(38) + (size_t)li * DM, XN + (size_t)m * DM, lane);
    }
}
__device__ __forceinline__ void phase_res2(const KP kp, int li, int gw, int NGW, int lane) {
    float* H = (float*)(kp.ws() + WS_H); bf16* XN = (bf16*)(kp.ws() + WS_XN); const float* C = (const float*)(kp.ws() + WS_SCR + SC_C); const float* C2 = (const float*)(kp.ws() + WS_SCR + SC_C2);
    for (int m = gw; m < T; m += NGW) {
        f32x4 v[8];
#pragma unroll
        for (int j = 0; j < 8; ++j) { const size_t o = (size_t)m * DM + 4 * (lane + 64 * j); const f32x4 c = *(const f32x4*)(C + o), c2 = *(const f32x4*)(C2 + o); f32x4 h = *(const f32x4*)(H + o);
            h.x += sigmoid_(c.x) * c2.x; h.y += sigmoid_(c.y) * c2.y; h.z += sigmoid_(c.z) * c2.z; h.w += sigmoid_(c.w) * c2.w; v[j] = h; *(f32x4*)(H + o) = h; }
        if (li < 3) norm_row_bf16(v, kp.in(11) + (size_t)(li + 1) * DM, XN + (size_t)m * DM, lane);
        else {
            float ss = 0.f;
#pragma unroll
            for (int j = 0; j < 8; ++j) ss += (v[j].x * v[j].x + v[j].y * v[j].y) + (v[j].z * v[j].z + v[j].w * v[j].w);
            const float rstd = rsqrtf(wave_sum(ss) * (1.f / DM) + 1e-6f);
#pragma unroll
            for (int j = 0; j < 8; ++j) { const int col = 4 * (lane + 64 * j); const f32x4 gg = *(const f32x4*)(kp.in(12) + col);
                f32x4 o; o.x = v[j].x * rstd * gg.x; o.y = v[j].y * rstd * gg.y; o.z = v[j].z * rstd * gg.z; o.w = v[j].w * rstd * gg.w;
                *(f32x4*)(kp.out() + (size_t)m * DM + col) = o; }
        }
    }
}

__device__ __forceinline__ void phase_ab_pre(const KP kp, const int bid, const int G, int j, int tid, int wave, int lane) {
    unsigned char* scr = kp.ws() + WS_SCR; const bf16* U = (const bf16*)(kp.ws() + WS_U);
    float* QN = (float*)(scr + SC_QN); float* KN = (float*)(scr + SC_KN); float* VV = (float*)(scr + SC_VV);
    float* GLOG = (float*)(scr + SC_GLOG); float* BETA = (float*)(scr + SC_BETA); float* GDEC = (float*)(scr + SC_GDEC);
    const float* cw = kp.in(14) + (size_t)j * 4 * 3072; const float* stc = kp.in(3) + (size_t)j * 128 * 3 * 3072;
    const float* wa2 = kp.in(18) + (size_t)j * 16 * 512; const float* ba = kp.in(19) + (size_t)j * 512;
    for (int r = bid; r < T; r += G) {
        int s, t; row_to_seq(r, s, t); const int row0 = r - t;
#pragma unroll
        for (int part = 0; part < 3; ++part) {
            float val[2];
#pragma unroll
            for (int i = 0; i < 2; ++i) { const int c = part * 1024 + wave * 128 + lane + 64 * i; float acc = 0.f;
#pragma unroll
                for (int tap = 0; tap < 4; ++tap) acc += cw[tap * 3072 + c] * pre_val(U, NAB, c, row0, t - 3 + tap, s, stc, 3072, c);
                val[i] = silu_(acc); }
            if (part < 2) { const float ss = wave_sum(val[0] * val[0] + val[1] * val[1]); const float sc = rsqrtf(ss + 1e-6f) * (part == 0 ? 0.08838834764831845f : 1.f); val[0] *= sc; val[1] *= sc; }
            float* dst = part == 0 ? QN : (part == 1 ? KN : VV);
            dst[(size_t)r * 1024 + wave * 128 + lane] = val[0]; dst[(size_t)r * 1024 + wave * 128 + lane + 64] = val[1];
        }
        if (tid < 8) {
            BETA[(size_t)r * 8 + tid] = sigmoid_(bf2f(U[(size_t)r * NAB + 7168 + tid]));
            GDEC[(size_t)r * 8 + tid] = -expf(kp.in(15)[j * 8 + tid]) * softplus_(bf2f(U[(size_t)r * NAB + 7176 + tid]) + kp.in(16)[j * 8 + tid]);
        }
        { float x = ba[tid];
#pragma unroll
          for (int rr = 0; rr < 16; ++rr) x += bf2f(U[(size_t)r * NAB + 7184 + rr]) * wa2[rr * 512 + tid];
          GLOG[(size_t)r * 512 + tid] = -softplus_(-x) * (1.f / 16.f); }
    }
}

__device__ __forceinline__ void phase_ab_rec(const KP kp, const int bid, const int G, int j, LAS unsigned char* lds, int tid) {
    unsigned char* scr = kp.ws() + WS_SCR; const bf16* U = (const bf16*)(kp.ws() + WS_U);
    const float* QN = (const float*)(scr + SC_QN); const float* KN = (const float*)(scr + SC_KN); const float* VV = (const float*)(scr + SC_VV);
    const float* GLOG = (const float*)(scr + SC_GLOG); const float* BETA = (const float*)(scr + SC_BETA); const float* GDEC = (const float*)(scr + SC_GDEC);
    float* ODN = (float*)(scr + SC_ODN); float* OGLA = (float*)(scr + SC_OGLA);
    LAS float* SL = (LAS float*)lds;
    for (int item = bid; item < 1584; item += G) {
        int s, h; bool isdn;
        if (item < 32) { isdn = true; s = item >> 3; h = item & 7; }
        else if (item < 48) { isdn = false; s = (item - 32) >> 2; h = (item - 32) & 3; }
        else if (item < 1072) { isdn = true; s = 4 + ((item - 48) >> 3); h = (item - 48) & 7; }
        else { isdn = false; s = 4 + ((item - 1072) >> 2); h = (item - 1072) & 3; }
        int row0, L; seq_info(s, row0, L);
        __syncthreads();
        if (isdn) {
            LAS float* kL = SL + 16384; LAS float* qL = kL + 128; LAS float* red = kL + 256; LAS float* red2 = kL + 768;
            const int e = tid & 127, dq = tid >> 7;
            const size_t SZ = (size_t)8 * 128 * 128;
            const float* st = kp.in(2) + ((size_t)j * 128 + (s < 4 ? 0 : s - 4)) * SZ + (size_t)h * 128 * 128;
#pragma unroll 4
            for (int i = 0; i < 32; ++i) { const int d = dq * 32 + i; SL[d * 128 + e] = s < 4 ? 0.f : st[(size_t)d * 128 + e]; }
            for (int t = 0; t < L; ++t) {
                const size_t r = (size_t)(row0 + t);
                if (tid < 128) kL[tid] = KN[r * 1024 + h * 128 + tid]; else if (tid < 256) qL[tid - 128] = QN[r * 1024 + h * 128 + (tid - 128)];
                const float ve = VV[r * 1024 + h * 128 + e], beta = BETA[r * 8 + h], a = expf(GDEC[r * 8 + h]);
                __syncthreads();
                float part = 0.f;
#pragma unroll 4
                for (int i = 0; i < 32; ++i) { const int d = dq * 32 + i; const float sv = SL[d * 128 + e] * a; SL[d * 128 + e] = sv; part += kL[d] * sv; }
                red[dq * 128 + e] = part;
                __syncthreads();
                const float kS = (red[e] + red[128 + e]) + (red[256 + e] + red[384 + e]);
                const float u = beta * (ve - kS);
                float part2 = 0.f;
#pragma unroll 4
                for (int i = 0; i < 32; ++i) { const int d = dq * 32 + i; const float sv = SL[d * 128 + e] + kL[d] * u; SL[d * 128 + e] = sv; part2 += qL[d] * sv; }
                red2[dq * 128 + e] = part2;
                __syncthreads();
                if (dq == 0) ODN[r * 1024 + h * 128 + e] = (red2[e] + red2[128 + e]) + (red2[256 + e] + red2[384 + e]);
            }
            float* dst = s < 4 ? kp.out() + O_DN_P + ((size_t)j * 4 + s) * SZ + (size_t)h * 128 * 128 : kp.out() + O_DN_S + ((size_t)j * 128 + (s - 4)) * SZ + (size_t)h * 128 * 128;
#pragma unroll 4
            for (int i = 0; i < 32; ++i) { const int d = dq * 32 + i; dst[(size_t)d * 128 + e] = SL[d * 128 + e]; }
        } else {
            LAS float* kL = SL + 32768; LAS float* qL = kL + 128; LAS float* aL = kL + 256; LAS float* red = kL + 384;
            const int e = tid & 255, dh = tid >> 8;
            const size_t SZ = (size_t)4 * 128 * 256;
            const float* st = kp.in(4) + ((size_t)j * 128 + (s < 4 ? 0 : s - 4)) * SZ + (size_t)h * 128 * 256;
#pragma unroll 4
            for (int i = 0; i < 64; ++i) { const int d = dh * 64 + i; SL[d * 256 + e] = s < 4 ? 0.f : st[(size_t)d * 256 + e]; }
            for (int t = 0; t < L; ++t) {
                const size_t r = (size_t)(row0 + t);
                if (tid < 128) kL[tid] = bf2f(U[r * NAB + 4608 + h * 128 + tid]);
                else if (tid < 256) qL[tid - 128] = bf2f(U[r * NAB + 4096 + h * 128 + (tid - 128)]) * 0.08838834764831845f;
                else if (tid < 384) aL[tid - 256] = expf(GLOG[r * 512 + h * 128 + (tid - 256)]);
                const float ve = bf2f(U[r * NAB + 5120 + h * 256 + e]);
                __syncthreads();
                float part = 0.f;
#pragma unroll 4
                for (int i = 0; i < 64; ++i) { const int d = dh * 64 + i; const float sv = aL[d] * SL[d * 256 + e] + kL[d] * ve; SL[d * 256 + e] = sv; part += qL[d] * sv; }
                red[dh * 256 + e] = part;
                __syncthreads();
                if (dh == 0) OGLA[r * 1024 + h * 256 + e] = red[e] + red[256 + e];
            }
            float* dst = s < 4 ? kp.out() + O_GLA_P + ((size_t)j * 4 + s) * SZ + (size_t)h * 128 * 256 : kp.out() + O_GLA_S + ((size_t)j * 128 + (s - 4)) * SZ + (size_t)h * 128 * 256;
#pragma unroll 4
            for (int i = 0; i < 64; ++i) { const int d = dh * 64 + i; dst[(size_t)d * 256 + e] = SL[d * 256 + e]; }
        }
    }
}

__device__ __forceinline__ void phase_ab_post(const KP kp, const int bid, const int G, int j, int tid, int wave, int lane) {
    unsigned char* scr = kp.ws() + WS_SCR; const bf16* U = (const bf16*)(kp.ws() + WS_U); bf16* YM = (bf16*)(kp.ws() + WS_YM);
    const float* ODN = (const float*)(scr + SC_ODN); const float* OGLA = (const float*)(scr + SC_OGLA);
    const float* dnn = kp.in(17) + (size_t)j * 128; const float* glan = kp.in(20) + (size_t)j * 256;
    for (int r = bid; r < T; r += G) {
        int s, t; row_to_seq(r, s, t); int row0, L; seq_info(s, row0, L);
        { float o[2];
#pragma unroll
          for (int i = 0; i < 2; ++i) o[i] = ODN[(size_t)r * 1024 + wave * 128 + lane + 64 * i];
          const float rstd = rsqrtf(wave_sum(o[0] * o[0] + o[1] * o[1]) * (1.f / 128.f) + 1e-6f);
#pragma unroll
          for (int i = 0; i < 2; ++i) { const int e = lane + 64 * i; const float z = bf2f(U[(size_t)r * NAB + 3072 + wave * 128 + e]);
              YM[(size_t)r * DM + wave * 128 + e] = (bf16)f2bf(o[i] * rstd * dnn[e] * silu_(z)); } }
        if (wave < 4) { float o[4]; float ss = 0.f;
#pragma unroll
          for (int i = 0; i < 4; ++i) { o[i] = OGLA[(size_t)r * 1024 + wave * 256 + lane + 64 * i]; ss += o[i] * o[i]; }
          const float rstd = rsqrtf(wave_sum(ss) * (1.f / 256.f) + 1e-6f);
#pragma unroll
          for (int i = 0; i < 4; ++i) { const int e = lane + 64 * i; const float z = bf2f(U[(size_t)r * NAB + 6144 + wave * 256 + e]);
              YM[(size_t)r * DM + 1024 + wave * 256 + e] = (bf16)f2bf(o[i] * rstd * glan[e] * silu_(z)); } }
        if (t >= L - 3) { const int rr = t - (L - 3);
            float* dst = s < 4 ? kp.out() + O_DNC_P + (((size_t)j * 4 + s) * 3 + rr) * 3072 : kp.out() + O_DNC_S + (((size_t)j * 128 + (s - 4)) * 3 + rr) * 3072;
            for (int c = tid; c < 3072; c += NTHR) dst[c] = bf2f(U[(size_t)r * NAB + c]); }
    }
}

__device__ __forceinline__ void phase_cd_pre(const KP kp, const int bid, const int G, int j, LAS unsigned char* lds, int tid) {
    unsigned char* scr = kp.ws() + WS_SCR; const bf16* U = (const bf16*)(kp.ws() + WS_U);
    float* XBC = (float*)(scr + SC_XBC); float* LA = (float*)(scr + SC_LA); float* LB = (float*)(scr + SC_LB); float* DT = (float*)(scr + SC_DT);
    const float* cw = kp.in(23) + (size_t)j * 4 * 1536; const float* cb = kp.in(24) + (size_t)j * 1536; const float* stc = kp.in(6) + (size_t)j * 128 * 3 * 1536;
    const float* lcw = kp.in(29) + (size_t)j * 4 * 1024; const float* lcb = kp.in(30) + (size_t)j * 1024; const float* lstc = kp.in(8) + (size_t)j * 128 * 3 * 1024;
    const float* wa = kp.in(31) + (size_t)j * 16 * 64 * 64; const float* wx = kp.in(33) + (size_t)j * 16 * 64 * 64;
    const float* lba = kp.in(32) + (size_t)j * 1024; const float* lbx = kp.in(34) + (size_t)j * 1024; const float* lam = kp.in(35) + (size_t)j * 1024;
    LAS float* xcL = (LAS float*)lds;
    for (int r = bid; r < T; r += G) {
        int s, t; row_to_seq(r, s, t); const int row0 = r - t;
#pragma unroll
        for (int i = 0; i < 3; ++i) { const int c = tid + NTHR * i; float acc = cb[c];
#pragma unroll
            for (int tap = 0; tap < 4; ++tap) acc += cw[tap * 1536 + c] * pre_val(U, NCD, 1024 + c, row0, t - 3 + tap, s, stc, 1536, c);
            XBC[(size_t)r * 1536 + c] = silu_(acc); }
        if (tid < 16) DT[(size_t)r * 16 + tid] = softplus_(bf2f(U[(size_t)r * NCD + 4608 + tid]) + kp.in(26)[j * 16 + tid]);
        float xc[2];
#pragma unroll
        for (int i = 0; i < 2; ++i) { const int ch = tid + NTHR * i; float acc = lcb[ch];
#pragma unroll
            for (int tap = 0; tap < 4; ++tap) acc += lcw[tap * 1024 + ch] * pre_val(U, NCD, 3584 + ch, row0, t - 3 + tap, s, lstc, 1024, ch);
            xc[i] = acc; xcL[ch] = acc; }
        __syncthreads();
#pragma unroll
        for (int i = 0; i < 2; ++i) { const int ch = tid + NTHR * i, n = ch >> 6, d = ch & 63; float ra = lba[ch], ix = lbx[ch];
#pragma unroll 8
            for (int c = 0; c < 64; ++c) { const float x = xcL[n * 64 + c]; ra += x * wa[(size_t)(n * 64 + c) * 64 + d]; ix += x * wx[(size_t)(n * 64 + c) * 64 + d]; }
            const float rg = sigmoid_(ra), ig = sigmoid_(ix);
            const float log_a = -8.f * rg * softplus_(-lam[ch]);
            LA[(size_t)r * 1024 + ch] = expf(log_a);
            LB[(size_t)r * 1024 + ch] = sqrtf(-expm1f(2.f * log_a)) * (ig * xc[i]); }
        __syncthreads();
    }
}


__device__ __forceinline__ void phase_ssd_prep(const KP kp, const int bid, const int G, int j, LAS unsigned char* lds, int tid) {
    unsigned char* scr = kp.ws() + WS_SCR;
    const float* XBC = (const float*)(scr + SC_XBC); const float* DT = (const float*)(scr + SC_DT);
    unsigned char* OPS = scr + SC_SSDOP; float* GEND = (float*)(scr + SC_GEND);
    LAS float* CL = (LAS float*)lds; LAS float* BL = CL + 64 * 65; LAS float* QK = BL + 64 * 65; LAS float* GL = QK + 64 * 65;
    const float* alog = kp.in(25) + j * 16;
    const int wave = tid >> 6, lane = tid & 63;
    for (int item = bid; item < 512; item += G) {
        const int b = item >> 7, n = (item >> 2) & 31, g = item & 3;
        const int row0 = b * 2048 + n * 64;
        __syncthreads();
        for (int i = tid; i < 4096; i += NTHR) { const int t = i >> 6, d = i & 63;
            BL[t * 65 + d] = XBC[(size_t)(row0 + t) * 1536 + 1024 + g * 64 + d];
            CL[t * 65 + d] = XBC[(size_t)(row0 + t) * 1536 + 1280 + g * 64 + d]; }
        if (wave < 4) { const int h = g * 4 + wave; float gv = -expf(alog[h]) * DT[(size_t)(row0 + lane) * 16 + h];
#pragma unroll
            for (int o = 1; o < 64; o <<= 1) { const float tt = __shfl_up(gv, o); if (lane >= o) gv += tt; }
            GL[wave * 64 + lane] = gv; }
        __syncthreads();
        { const int i = tid >> 3, jg = tid & 7; float acc[8];
#pragma unroll
          for (int jj = 0; jj < 8; ++jj) acc[jj] = 0.f;
#pragma unroll 4
          for (int d = 0; d < 64; ++d) { const float c = CL[i * 65 + d];
#pragma unroll
              for (int jj = 0; jj < 8; ++jj) acc[jj] += c * BL[(jg * 8 + jj) * 65 + d]; }
#pragma unroll
          for (int jj = 0; jj < 8; ++jj) QK[i * 65 + jg * 8 + jj] = acc[jj]; }
        __syncthreads();
        const int f = wave, r = lane & 31, hp = lane >> 5, mt = f >> 2, ks = f & 3;
        for (int hh = 0; hh < 4; ++hh) {
            const int h = g * 4 + hh; const LAS float* Gh = GL + hh * 64; const float Gend = Gh[63];
            bf16x8* base = (bf16x8*)(OPS + ((size_t)((b * 32 + n) * 16 + h)) * 32768);
            float v[8];
            { const int i = 32 * mt + r; const float eg = expf(Gh[i]);
#pragma unroll
              for (int jp = 0; jp < 8; ++jp) { const int d = 16 * ks + 8 * (jp >> 2) + 4 * hp + (jp & 3); v[jp] = CL[i * 65 + d] * eg; }
              base[0 * 512 + f * 64 + lane] = pack8(v); }
            { const int d = 32 * mt + r;
#pragma unroll
              for (int jp = 0; jp < 8; ++jp) { const int tk = 16 * ks + 8 * (jp >> 2) + 4 * hp + (jp & 3); v[jp] = BL[tk * 65 + d] * expf(Gend - Gh[tk]); }
              base[1 * 512 + f * 64 + lane] = pack8(v); }
            { const int i = 32 * mt + r; const float gi = Gh[i];
#pragma unroll
              for (int jp = 0; jp < 8; ++jp) { const int jt = 16 * ks + 8 * (jp >> 2) + 4 * hp + (jp & 3); v[jp] = jt <= i ? QK[i * 65 + jt] * expf(gi - Gh[jt]) : 0.f; }
              base[2 * 512 + f * 64 + lane] = pack8(v); }
            { const int p = 32 * mt + r;
#pragma unroll
              for (int jp = 0; jp < 8; ++jp) { const int tk = 16 * ks + 8 * (jp >> 2) + 4 * hp + (jp & 3);
                  v[jp] = XBC[(size_t)(row0 + tk) * 1536 + h * 64 + p] * DT[(size_t)(row0 + tk) * 16 + h]; }
              base[3 * 512 + f * 64 + lane] = pack8(v); }
            if (tid == 0) GEND[(b * 32 + n) * 16 + h] = expf(Gend);
        }
    }
}

__device__ __forceinline__ void phase_cd_rec(const KP kp, const int bid, const int G, int j, LAS unsigned char* lds, int tid) {
    unsigned char* scr = kp.ws() + WS_SCR;
    const float* XBC = (const float*)(scr + SC_XBC); const float* LA = (const float*)(scr + SC_LA); const float* LB = (const float*)(scr + SC_LB); const float* DT = (const float*)(scr + SC_DT);
    float* YS = (float*)(scr + SC_YS); float* HS = (float*)(scr + SC_HS);
    LAS float* bL = (LAS float*)lds; LAS float* cL = bL + 64; LAS float* red = bL + 128;
    for (int item = bid; item < 2328; item += G) {
        int kind, s, h;
        if (item < 16) { kind = 2; s = item >> 2; h = item & 3; }
        else if (item < 24) { kind = 1; s = (item - 16) >> 1; h = (item - 16) & 1; }
        else if (item < 2072) { kind = 0; s = 4 + ((item - 24) >> 4); h = (item - 24) & 15; }
        else { kind = 1; s = 4 + ((item - 2072) >> 1); h = (item - 2072) & 1; }
        int row0, L; seq_info(s, row0, L);
        __syncthreads();
        if (kind == 2) {
            const int wave = __builtin_amdgcn_readfirstlane(tid >> 6), lane = tid & 63, r = lane & 31, hp = lane >> 5;
            const int b = s, hd = h * 4 + (wave >> 1), nt = wave & 1;
            const unsigned char* OPS = scr + SC_SSDOP; const float* GEND = (const float*)(scr + SC_GEND);
            f32x16 S0, S1;
#pragma unroll
            for (int i = 0; i < 16; ++i) { S0[i] = 0.f; S1[i] = 0.f; }
            for (int n = 0; n < 32; ++n) {
                const bf16x8* F = (const bf16x8*)(OPS + ((size_t)((b * 32 + n) * 16 + hd)) * 32768) + lane;
                bf16x8 qg[2][4], kT[2][4], Am[2][4], vb[4];
#pragma unroll
                for (int mt = 0; mt < 2; ++mt)
#pragma unroll
                    for (int ks = 0; ks < 4; ++ks) { qg[mt][ks] = F[(0 * 8 + mt * 4 + ks) * 64]; kT[mt][ks] = F[(1 * 8 + mt * 4 + ks) * 64]; Am[mt][ks] = F[(2 * 8 + mt * 4 + ks) * 64]; }
#pragma unroll
                for (int ks = 0; ks < 4; ++ks) vb[ks] = F[(3 * 8 + nt * 4 + ks) * 64];
                const float gend = GEND[(b * 32 + n) * 16 + hd];
                const bf16x8 sb00 = PACK_ACC(S0, 0), sb01 = PACK_ACC(S0, 1), sb10 = PACK_ACC(S1, 0), sb11 = PACK_ACC(S1, 1);
                f32x16 O0, O1;
#pragma unroll
                for (int i = 0; i < 16; ++i) { O0[i] = 0.f; O1[i] = 0.f; }
                O0 = MFMA32(qg[0][0], sb00, O0); O0 = MFMA32(qg[0][1], sb01, O0); O0 = MFMA32(qg[0][2], sb10, O0); O0 = MFMA32(qg[0][3], sb11, O0);
                O1 = MFMA32(qg[1][0], sb00, O1); O1 = MFMA32(qg[1][1], sb01, O1); O1 = MFMA32(qg[1][2], sb10, O1); O1 = MFMA32(qg[1][3], sb11, O1);
                O0 = MFMA32(Am[0][0], vb[0], O0); O0 = MFMA32(Am[0][1], vb[1], O0);
#pragma unroll
                for (int ks = 0; ks < 4; ++ks) O1 = MFMA32(Am[1][ks], vb[ks], O1);
#pragma unroll
                for (int i = 0; i < 16; ++i) { S0[i] *= gend; S1[i] *= gend; }
#pragma unroll
                for (int ks = 0; ks < 4; ++ks) { S0 = MFMA32(kT[0][ks], vb[ks], S0); S1 = MFMA32(kT[1][ks], vb[ks], S1); }
                float* yo = YS + (size_t)(b * 2048 + n * 64) * 1024 + hd * 64 + 32 * nt + r;
#pragma unroll
                for (int i = 0; i < 16; ++i) { yo[(size_t)crow(i, hp) * 1024] = O0[i]; yo[(size_t)(32 + crow(i, hp)) * 1024] = O1[i]; }
            }
            float* dst = kp.out() + O_SSD_P + ((size_t)j * 4 + b) * ((size_t)16 * 64 * 64) + (size_t)hd * 64 * 64 + 32 * nt + r;
#pragma unroll
            for (int i = 0; i < 16; ++i) { dst[(size_t)crow(i, hp) * 64] = S0[i]; dst[(size_t)(32 + crow(i, hp)) * 64] = S1[i]; }
        } else if (kind == 0) {
            const int p = tid & 63, ng = tid >> 6, grp = h >> 2;
            const size_t SZ = (size_t)16 * 64 * 64;
            float S[8];
            if (s < 4) {
#pragma unroll
                for (int i = 0; i < 8; ++i) S[i] = 0.f;
            } else { const float* st = kp.in(5) + ((size_t)j * 128 + (s - 4)) * SZ + (size_t)h * 64 * 64;
#pragma unroll
                for (int i = 0; i < 8; ++i) S[i] = st[(size_t)(ng * 8 + i) * 64 + p]; }
            const float negA = -expf(kp.in(25)[j * 16 + h]);
            for (int t = 0; t < L; ++t) {
                const size_t r = (size_t)(row0 + t);
                if (tid < 64) bL[tid] = XBC[r * 1536 + 1024 + grp * 64 + tid]; else if (tid < 128) cL[tid - 64] = XBC[r * 1536 + 1280 + grp * 64 + (tid - 64)];
                const float xp = XBC[r * 1536 + h * 64 + p], dt = DT[r * 16 + h], a = expf(negA * dt), xdt = xp * dt;
                __syncthreads();
                float part = 0.f;
#pragma unroll
                for (int i = 0; i < 8; ++i) { const int n = ng * 8 + i; S[i] = a * S[i] + bL[n] * xdt; part += cL[n] * S[i]; }
                red[ng * 64 + p] = part;
                __syncthreads();
                if (ng == 0) { float y = 0.f;
#pragma unroll
                    for (int g = 0; g < 8; ++g) y += red[g * 64 + p];
                    YS[r * 1024 + h * 64 + p] = y; }
            }
            float* dst = s < 4 ? kp.out() + O_SSD_P + ((size_t)j * 4 + s) * SZ + (size_t)h * 64 * 64 : kp.out() + O_SSD_S + ((size_t)j * 128 + (s - 4)) * SZ + (size_t)h * 64 * 64;
#pragma unroll
            for (int i = 0; i < 8; ++i) dst[(size_t)(ng * 8 + i) * 64 + p] = S[i];
        } else {
            const int ch = h * 512 + tid;
            float hh = s < 4 ? 0.f : kp.in(7)[((size_t)j * 128 + (s - 4)) * 1024 + ch];
#pragma unroll 8
            for (int t = 0; t < L; ++t) { const size_t r = (size_t)(row0 + t); hh = LA[r * 1024 + ch] * hh + LB[r * 1024 + ch]; HS[r * 1024 + ch] = hh; }
            float* dst = s < 4 ? kp.out() + O_LRU_P + ((size_t)j * 4 + s) * 1024 : kp.out() + O_LRU_S + ((size_t)j * 128 + (s - 4)) * 1024;
            dst[ch] = hh;
        }
    }
}

__device__ __forceinline__ void phase_cd_post(const KP kp, const int bid, const int G, int j, int tid, int wave, int lane) {
    unsigned char* scr = kp.ws() + WS_SCR; const bf16* U = (const bf16*)(kp.ws() + WS_U); bf16* YM = (bf16*)(kp.ws() + WS_YM);
    const float* YS = (const float*)(scr + SC_YS); const float* HS = (const float*)(scr + SC_HS); const float* XBC = (const float*)(scr + SC_XBC);
    const float* sn = kp.in(28) + (size_t)j * 1024;
    for (int r = bid; r < T; r += G) {
        int s, t; row_to_seq(r, s, t); int row0, L; seq_info(s, row0, L);
        if (wave < 4) { float y[4]; float ss = 0.f;
#pragma unroll
            for (int i = 0; i < 4; ++i) { const int e = wave * 256 + lane + 64 * i; y[i] = (YS[(size_t)r * 1024 + e] + kp.in(27)[j * 16 + (e >> 6)] * XBC[(size_t)r * 1536 + e]) * silu_(bf2f(U[(size_t)r * NCD + e])); ss += y[i] * y[i]; }
            const float rstd = rsqrtf(wave_sum(ss) * (1.f / 256.f) + 1e-6f);
#pragma unroll
            for (int i = 0; i < 4; ++i) { const int e = wave * 256 + lane + 64 * i; YM[(size_t)r * DM + e] = (bf16)f2bf(y[i] * rstd * sn[e]); }
        } else {
#pragma unroll
            for (int i = 0; i < 4; ++i) { const int ch = (wave - 4) * 256 + lane + 64 * i;
                YM[(size_t)r * DM + 1024 + ch] = (bf16)f2bf(HS[(size_t)r * 1024 + ch] * silu_(bf2f(U[(size_t)r * NCD + 2560 + ch]))); }
        }
        if (t >= L - 3) { const int rr = t - (L - 3);
            float* d1 = s < 4 ? kp.out() + O_SSDC_P + (((size_t)j * 4 + s) * 3 + rr) * 1536 : kp.out() + O_SSDC_S + (((size_t)j * 128 + (s - 4)) * 3 + rr) * 1536;
            for (int c = tid; c < 1536; c += NTHR) d1[c] = bf2f(U[(size_t)r * NCD + 1024 + c]);
            float* d2 = s < 4 ? kp.out() + O_LRUC_P + (((size_t)j * 4 + s) * 3 + rr) * 1024 : kp.out() + O_LRUC_S + (((size_t)j * 128 + (s - 4)) * 3 + rr) * 1024;
            for (int c = tid; c < 1024; c += NTHR) d2[c] = bf2f(U[(size_t)r * NCD + 3584 + c]); }
    }
}

__global__ void __launch_bounds__(NTHR, 2) mega_fwd(Args A) {
    extern __shared__ __attribute__((aligned(16))) unsigned char lds_raw[];
    LAS unsigned char* lds = (LAS unsigned char*)lds_raw;
    const int G = gridDim.x;
    for (int ph = A.ph_lo; ph < A.ph_hi; ++ph) {
        KP kp; kp.p = (const char AS4*)__builtin_amdgcn_kernarg_segment_ptr(); asm volatile("" : "+s"(kp.p));
        unsigned char* ws = kp.ws();
        int tid = threadIdx.x; asm volatile("" : "+v"(tid));
        int bid = blockIdx.x; asm volatile("" : "+s"(bid));
        const int lane = tid & 63, wave = __builtin_amdgcn_readfirstlane(tid >> 6), gw = bid * NWAVES + wave, NGW = G * NWAVES;
        if (ph == 0) { if (PH_MASK & 1) phase_prologue(kp, lds, gw, NGW, wave, lane); }
        else {
            const int li = (ph - 1) / SUBS, sub = (ph - 1) % SUBS, j = li >> 1; const bool ab = (li & 1) == 0;
            if (sub == 0) {
                const int N = ab ? NAB : NCD;
                const bf16* Bt = ab ? (const bf16*)(ws + WS_WABIN) + (size_t)j * NAB * 2048 : (const bf16*)(ws + WS_WCDIN) + (size_t)j * NCD * 2048;
                pg8::Gemm g{(const bf16*)(ws + WS_XN), Bt, T, N, 2048}; pg8::StaticOrder S; S.init(T, N, G, bid);
                pg8::EpiBf16 E{(bf16*)(ws + WS_U), N};
                if (PH_MASK & 2) pg8::gemm_phase<pg8::EpiBf16, pg8::StaticOrder, true, true>(lds, g, S, E, tid);
            } else if (sub == 5 || sub == 7 || sub == 8) {
                const bf16* Am; const bf16* Bt; int K = 2048; float* C = (float*)(ws + WS_SCR + SC_C);
                if (sub == 5) { Am = (const bf16*)(ws + WS_YM); Bt = ab ? (const bf16*)(ws + WS_WABOUT) + (size_t)j * 2048 * 2048 : (const bf16*)(ws + WS_WCDOUT) + (size_t)j * 2048 * 2048; }
                else if (sub == 7) { Am = (const bf16*)(ws + WS_XN); Bt = (const bf16*)(ws + WS_WGATE) + (size_t)li * 2048 * 2048; }
                else { Am = (const bf16*)(ws + WS_PB) + (size_t)li * T * 256; Bt = (const bf16*)(ws + WS_WPROJ) + (size_t)li * 2048 * 256; K = 256; C = (float*)(ws + WS_SCR + SC_C2); }
                pg8::Gemm g{Am, Bt, T, 2048, K}; pg8::StaticOrder S; S.init(T, 2048, G, bid);
                pg8::EpiF32 E{C, 2048};
                if (PH_MASK & 4) pg8::gemm_phase<pg8::EpiF32, pg8::StaticOrder, true, true>(lds, g, S, E, tid);
            } else if (sub == 1) { if (ab) { if (PH_MASK & 8) phase_ab_pre(kp, bid, G, j, tid, wave, lane); } else { if (PH_MASK & 16) phase_cd_pre(kp, bid, G, j, lds, tid); } }
            else if (sub == 2) { if (!ab) { if (PH_MASK & 2048) phase_ssd_prep(kp, bid, G, j, lds, tid); } }
            else if (sub == 3) { if (ab) { if (PH_MASK & 32) phase_ab_rec(kp, bid, G, j, lds, tid); } else { if (PH_MASK & 64) phase_cd_rec(kp, bid, G, j, lds, tid); } }
            else if (sub == 4) { if (ab) { if (PH_MASK & 128) phase_ab_post(kp, bid, G, j, tid, wave, lane); } else { if (PH_MASK & 256) phase_cd_post(kp, bid, G, j, tid, wave, lane); } }
            else if (sub == 6) { if (PH_MASK & 512) phase_res1(kp, li, gw, NGW, lane); }
            else { if (PH_MASK & 1024) phase_res2(kp, li, gw, NGW, lane); }
        }
        if (ph + 1 < A.ph_hi) { cg::this_grid().sync(); }
    }
}

extern "C" void kernel_launch(void* const* d_in, const int* in_sizes, int n_in, void* d_out, int out_size, void* d_ws, size_t ws_size, hipStream_t stream) {
    static int grid = 0;
    if (grid == 0) {
        if (n_in != 40 || (size_t)out_size != O_END || ws_size < WS_END) { fprintf(stderr, "kernel_launch: unexpected shapes: n_in %d out %d ws %zu\n", n_in, out_size, ws_size); grid = -1; return; }
        int dev = 0, cus = 0, per_cu = 0;
        if (hipGetDevice(&dev) != hipSuccess || hipDeviceGetAttribute(&cus, hipDeviceAttributeMultiprocessorCount, dev) != hipSuccess) { grid = -1; return; }
        if (hipFuncSetAttribute((const void*)mega_fwd, hipFuncAttributeMaxDynamicSharedMemorySize, LDS_BYTES) != hipSuccess) { fprintf(stderr, "kernel_launch: hipFuncSetAttribute failed\n"); grid = -1; return; }
        if (hipOccupancyMaxActiveBlocksPerMultiprocessor(&per_cu, (const void*)mega_fwd, NTHR, LDS_BYTES) != hipSuccess || per_cu < 1) { fprintf(stderr, "kernel_launch: occupancy query says %d\n", per_cu); per_cu = 1; }
        (void)hipGetLastError();
        grid = cus;
    }
    if (grid < 0) return;
    Args a{};
    for (int i = 0; i < 40; ++i) a.in[i] = (const float*)d_in[i];
    a.out = (float*)d_out; a.ws = (unsigned char*)d_ws;
#if MK_N_LAUNCHES == 1
    a.ph_lo = 0; a.ph_hi = N_PHASES;
    void* args[] = {&a};
    hipError_t e = hipLaunchCooperativeKernel((const void*)mega_fwd, dim3(grid), dim3(NTHR), args, LDS_BYTES, stream);
    if (e != hipSuccess) fprintf(stderr, "cooperative launch failed: %s (grid %d)\n", hipGetErrorString(e), grid);
#else
    for (int ph = 0; ph < N_PHASES; ++ph) { a.ph_lo = ph; a.ph_hi = ph + 1; mega_fwd<<<dim3(grid), dim3(NTHR), LDS_BYTES, stream>>>(a); }
#endif
}
```

```cpp
#include <hip/hip_runtime.h>
#include <hip/hip_cooperative_groups.h>
#include <cstdio>
#include <cstdint>
namespace cg = cooperative_groups;

#ifndef MK_N_LAUNCHES
#define MK_N_LAUNCHES 1
#endif

namespace pg8 {
#define PG8_LAS __attribute__((address_space(3)))
typedef unsigned short bf16_t;
typedef short bf16x8 __attribute__((ext_vector_type(8)));
typedef float f32x4 __attribute__((ext_vector_type(4)));
typedef unsigned u32x4 __attribute__((ext_vector_type(4)));
constexpr int BM = 256, BK = 64, HALF = 128, HTB = HALF * BK * 2  , STAGE_BYTES = 8 * HTB, NXCD = 8, WGM = 8;

__host__ __device__ __forceinline__ int lds_byte(int r, int c) { const int st = (r >> 4) * 2 + (c >> 5), rr = r & 15, cc = c & 31, ob = rr * 64 + cc * 2; return st * 1024 + (ob ^ (((ob >> 9) & 1) << 5)); }
__host__ __device__ __forceinline__ void stage_rc(int b, int& R, int& C) { const int st = b / 1024, sb = b % 1024, swz = sb ^ (((sb >> 9) & 1) << 5); R = (st >> 1) * 16 + swz / 64; C = (st & 1) * 32 + (swz % 64) / 2; }
__host__ __device__ __forceinline__ int perm32(int rho) { const int n = rho >> 4, i = rho & 15; return 8 * (i >> 2) + 4 * n + (i & 3); }

struct Unit { int pm, pn; };
struct Gemm { const bf16_t* A; const bf16_t* Bt; int M, N, K; };

struct StaticOrder {
    int nM, nN, nwg, G, c;
    __host__ __device__ void init(int M, int N, int G_, int c_) { nM = M / BM; nN = N / BM; nwg = nM * nN; G = G_; c = c_; }
    __host__ __device__ bool next(int i, Unit& u) const {
        const long L = (long)i * G + c; if (L >= nwg) return false;
        int wgid = (int)L; { const int q = nwg / NXCD, r = nwg % NXCD, xcd = wgid % NXCD, off = wgid / NXCD; wgid = (xcd < r ? xcd * (q + 1) : r * (q + 1) + (xcd - r) * q) + off; }
        const int nig = WGM * nN, gid = wgid / nig, fm = gid * WGM, gsz = (nM - fm) < WGM ? (nM - fm) : WGM;
        u.pm = fm + ((wgid % nig) % gsz); u.pn = (wgid % nig) / gsz; return true;
    }
    __device__ __forceinline__ void a_ready(const Unit&) const {}
    __device__ __forceinline__ void done(const Unit&) const {}
};

__device__ __forceinline__ unsigned cvt_pk_bf16(float lo, float hi) { unsigned r; asm volatile("v_cvt_pk_bf16_f32 %0, %1, %2" : "=v"(r) : "v"(lo), "v"(hi)); return r; }
struct EpiF32 {
    static constexpr bool PERM = false, AFTER_DRAIN = false;
    float* C; int ldc;
    __device__ __forceinline__ void operator()(const f32x4 (&acc)[2][2][4][2], const Unit& u, int wr, int wc, int fr, int fq) const {
        const int row0 = u.pm * BM + wr * 64 + fr, col0 = u.pn * BM + wc * 32 + 4 * fq;
#pragma unroll
        for (int ai = 0; ai < 2; ++ai)
#pragma unroll
            for (int m = 0; m < 4; ++m) { float* rowp = C + (size_t)(row0 + ai * HALF + m * 16) * ldc + col0;
#pragma unroll
                for (int bj = 0; bj < 2; ++bj)
#pragma unroll
                    for (int n = 0; n < 2; ++n) *(f32x4*)(rowp + bj * HALF + n * 16) = acc[ai][bj][m][n]; }
    }
};
struct EpiBf16 {
    static constexpr bool PERM = true, AFTER_DRAIN = false;
    bf16_t* O; int ldc;
    __device__ __forceinline__ void operator()(const f32x4 (&acc)[2][2][4][2], const Unit& u, int wr, int wc, int fr, int fq) const {
        const int row0 = u.pm * BM + wr * 64 + fr; const int col0 = u.pn * BM + wc * 32 + 8 * fq;
#pragma unroll
        for (int ai = 0; ai < 2; ++ai)
#pragma unroll
            for (int m = 0; m < 4; ++m) { bf16_t* rowp = O + (size_t)(row0 + ai * HALF + m * 16) * ldc + col0;
#pragma unroll
                for (int bj = 0; bj < 2; ++bj) { const f32x4 v0 = acc[ai][bj][m][0], v1 = acc[ai][bj][m][1];
                    u32x4 w; w.x = cvt_pk_bf16(v0[0], v0[1]); w.y = cvt_pk_bf16(v0[2], v0[3]); w.z = cvt_pk_bf16(v1[0], v1[1]); w.w = cvt_pk_bf16(v1[2], v1[3]);
                    *(u32x4*)(rowp + bj * HALF) = w; } }
    }
};
template <class Epi, class Sched, bool ALIGN_EPI = false, bool SP2 = false>
__device__ __forceinline__ void gemm_phase(PG8_LAS unsigned char* lds, const Gemm g, const Sched& S, const Epi& E, const int tid) {
    const int wid = __builtin_amdgcn_readfirstlane(tid >> 6), lane = tid & 63, wr = wid >> 2, wc = wid & 3, fr = lane & 15, fq = lane >> 4;
    const int K = g.K, nt = K / BK;
    unsigned voffA[2], voffB[2];
#pragma unroll
    for (int i = 0; i < 2; ++i) { int R, C; stage_rc(tid * 16 + i * 8192, R, C); const int Rb = Epi::PERM ? ((R & ~31) + perm32(R & 31)) : R;
        voffA[i] = (unsigned)(R * K + C) * 2u; voffB[i] = (unsigned)(Rb * K + C) * 2u; }
    const size_t kstep = (size_t)(BK * 2);
    const size_t hstep = (size_t)HALF * K * 2;
    const size_t tstep = 2 * hstep;
    const unsigned ldsw = (unsigned)wid * 1024u;
    const int aoff = lds_byte(wr * 64 + fr, fq * 8), boff = lds_byte(wc * 32 + fr, fq * 8);
#define PG8_SA(b, h) (((b) * 2 + (h)) * HTB)
#define PG8_SB(b, h) ((4 + (b) * 2 + (h)) * HTB)
#define PG8_STAGE(bufoff, gbase, voff) do { _Pragma("unroll") for (int _i = 0; _i < 2; ++_i) \
        __builtin_amdgcn_global_load_lds((const unsigned*)((const char*)(gbase) + (voff)[_i]), (PG8_LAS unsigned*)(lds + (bufoff) + ldsw + _i * 8192), 16, 0, 0); } while (0)
#define PG8_LDA(dst, b, h) do { _Pragma("unroll") for (int m = 0; m < 4; ++m) _Pragma("unroll") for (int k = 0; k < 2; ++k) dst[m][k] = *(const PG8_LAS bf16x8*)(lds + PG8_SA(b, h) + aoff + m * 2048 + k * 1024); } while (0)
#define PG8_LDB(dst, b, h) do { _Pragma("unroll") for (int n = 0; n < 2; ++n) _Pragma("unroll") for (int k = 0; k < 2; ++k) dst[n][k] = *(const PG8_LAS bf16x8*)(lds + PG8_SB(b, h) + boff + n * 2048 + k * 1024); } while (0)
#define PG8_MMA(ai, bj, At, Bt) do { __builtin_amdgcn_s_setprio(1); _Pragma("unroll") for (int m = 0; m < 4; ++m) _Pragma("unroll") for (int n = 0; n < 2; ++n) _Pragma("unroll") for (int k = 0; k < 2; ++k) \
        acc[ai][bj][m][n] = __builtin_amdgcn_mfma_f32_16x16x32_bf16(Bt[n][k], At[m][k], acc[ai][bj][m][n], 0, 0, 0); __builtin_amdgcn_s_setprio(0); } while (0)
#define PG8_WAIT_V(n) asm volatile("s_waitcnt vmcnt(" #n ")" ::: "memory")
#define PG8_WAIT_L(n) asm volatile("s_waitcnt lgkmcnt(" #n ")" ::: "memory")
#define PG8_BAR __builtin_amdgcn_s_barrier()
#define PG8_SCHED __builtin_amdgcn_sched_barrier(0)
    Unit cur, nxt; int ui = 0;
    if (!S.next(0, cur)) return;
    f32x4 acc[2][2][4][2];
#pragma unroll
    for (int a = 0; a < 2; ++a)
#pragma unroll
        for (int b = 0; b < 2; ++b)
#pragma unroll
            for (int m = 0; m < 4; ++m)
#pragma unroll
                for (int n = 0; n < 2; ++n) acc[a][b][m][n] = (f32x4){0.f, 0.f, 0.f, 0.f};
    bf16x8 At[4][2], B0[2][2], B1[2][2];
    const char* cA = (const char*)g.A + (size_t)cur.pm * tstep; const char* cB = (const char*)g.Bt + (size_t)cur.pn * tstep;
    S.a_ready(cur);
    if constexpr (SP2) {
        PG8_STAGE(PG8_SB(0, 0), cB, voffB); PG8_STAGE(PG8_SB(0, 1), cB + hstep, voffB); PG8_STAGE(PG8_SA(0, 0), cA, voffA); PG8_STAGE(PG8_SA(0, 1), cA + hstep, voffA);
        if (wr == 1) PG8_BAR;
        PG8_WAIT_V(2); PG8_BAR;
        PG8_STAGE(PG8_SB(1, 0), cB + kstep, voffB); PG8_STAGE(PG8_SA(1, 0), cA + kstep, voffA); PG8_STAGE(PG8_SB(1, 1), cB + hstep + kstep, voffB);
        PG8_WAIT_V(6); PG8_BAR;
    } else {
        PG8_STAGE(PG8_SB(0, 0), cB, voffB); PG8_STAGE(PG8_SA(0, 0), cA, voffA); PG8_STAGE(PG8_SB(0, 1), cB + hstep, voffB); PG8_STAGE(PG8_SA(0, 1), cA + hstep, voffA);
        if (wr == 1) PG8_BAR;
        PG8_WAIT_V(4); PG8_BAR;
        PG8_STAGE(PG8_SB(1, 0), cB + kstep, voffB); PG8_STAGE(PG8_SA(1, 0), cA + kstep, voffA); PG8_STAGE(PG8_SB(1, 1), cB + hstep + kstep, voffB);
        PG8_WAIT_V(6); PG8_BAR;
    }
    for (;;) {
        const bool has_next = S.next(ui + 1, nxt);
        const char* nA = has_next ? (const char*)g.A + (size_t)nxt.pm * tstep : cA; const char* nB = has_next ? (const char*)g.Bt + (size_t)nxt.pn * tstep : cB;
        for (int t = 0; t < nt; t += 2) {
            const bool last = (t == nt - 2);
            const char* a1 = cA + (size_t)(t + 1) * kstep;
            const char* a2 = last ? nA : cA + (size_t)(t + 2) * kstep; const char* b2 = last ? nB : cB + (size_t)(t + 2) * kstep;
            const char* a3 = a2 + kstep; const char* b3 = b2 + kstep;
            if (last && has_next) S.a_ready(nxt);
            if constexpr (SP2) {
            PG8_LDB(B0, 0, 0); PG8_LDB(B1, 0, 1); PG8_SCHED; PG8_LDA(At, 0, 0); PG8_STAGE(PG8_SA(1, 1), a1 + hstep, voffA);
            PG8_WAIT_V(8); PG8_WAIT_L(0); PG8_BAR; PG8_MMA(0, 0, At, B0); PG8_MMA(0, 1, At, B1); PG8_BAR; PG8_SCHED;
            PG8_LDA(At, 0, 1); PG8_STAGE(PG8_SB(0, 0), b2, voffB); PG8_STAGE(PG8_SB(0, 1), b2 + hstep, voffB); PG8_STAGE(PG8_SA(0, 0), a2, voffA);
            PG8_WAIT_V(8); PG8_WAIT_L(0); PG8_BAR; PG8_MMA(1, 0, At, B0); PG8_MMA(1, 1, At, B1); PG8_BAR; PG8_SCHED;
            PG8_LDB(B0, 1, 0); PG8_LDB(B1, 1, 1); PG8_SCHED; PG8_LDA(At, 1, 0); PG8_STAGE(PG8_SA(0, 1), a2 + hstep, voffA);
            PG8_WAIT_V(8); PG8_WAIT_L(0); PG8_BAR; PG8_MMA(0, 0, At, B0); PG8_MMA(0, 1, At, B1); PG8_BAR; PG8_SCHED;
            PG8_LDA(At, 1, 1); PG8_STAGE(PG8_SB(1, 0), b3, voffB); PG8_STAGE(PG8_SB(1, 1), b3 + hstep, voffB); PG8_STAGE(PG8_SA(1, 0), a3, voffA);
            PG8_WAIT_V(8); PG8_WAIT_L(0); PG8_BAR; PG8_MMA(1, 0, At, B0); PG8_MMA(1, 1, At, B1); PG8_BAR; PG8_SCHED;
            } else {
            PG8_LDB(B0, 0, 0); PG8_SCHED; PG8_LDA(At, 0, 0); PG8_STAGE(PG8_SA(1, 1), a1 + hstep, voffA);
            PG8_WAIT_L(8); PG8_BAR; PG8_WAIT_L(0); PG8_MMA(0, 0, At, B0); PG8_BAR; PG8_SCHED;
            PG8_LDB(B1, 0, 1); PG8_STAGE(PG8_SB(0, 0), b2, voffB);
            PG8_BAR; PG8_WAIT_L(0); PG8_MMA(0, 1, At, B1); PG8_BAR;
            PG8_LDA(At, 0, 1); PG8_STAGE(PG8_SA(0, 0), a2, voffA);
            PG8_BAR; PG8_WAIT_L(0); PG8_MMA(1, 0, At, B0); PG8_BAR; PG8_SCHED;
            PG8_STAGE(PG8_SB(0, 1), b2 + hstep, voffB);
            PG8_WAIT_V(6); PG8_BAR; PG8_MMA(1, 1, At, B1); PG8_BAR;
            PG8_LDB(B0, 1, 0); PG8_SCHED; PG8_LDA(At, 1, 0); PG8_STAGE(PG8_SA(0, 1), a2 + hstep, voffA);
            PG8_WAIT_L(8); PG8_BAR; PG8_WAIT_L(0); PG8_MMA(0, 0, At, B0); PG8_BAR; PG8_SCHED;
            PG8_LDB(B1, 1, 1); PG8_STAGE(PG8_SB(1, 0), b3, voffB);
            PG8_BAR; PG8_WAIT_L(0); PG8_MMA(0, 1, At, B1); PG8_BAR;
            PG8_LDA(At, 1, 1); PG8_STAGE(PG8_SA(1, 0), a3, voffA);
            PG8_BAR; PG8_WAIT_L(0); PG8_MMA(1, 0, At, B0); PG8_BAR; PG8_SCHED;
            PG8_STAGE(PG8_SB(1, 1), b3 + hstep, voffB);
            PG8_WAIT_V(6); PG8_BAR; PG8_MMA(1, 1, At, B1); PG8_BAR;
            }
        }
        if constexpr (ALIGN_EPI) { if (wr == 0) PG8_BAR; }
        if constexpr (!Epi::AFTER_DRAIN) { E(acc, cur, wr, wc, fr, fq); S.done(cur); }
        if (!has_next) break;
#pragma unroll
        for (int a = 0; a < 2; ++a)
#pragma unroll
            for (int b = 0; b < 2; ++b)
#pragma unroll
                for (int m = 0; m < 4; ++m)
#pragma unroll
                    for (int n = 0; n < 2; ++n) acc[a][b][m][n] = (f32x4){0.f, 0.f, 0.f, 0.f};
        cur = nxt; cA = nA; cB = nB; ++ui;
        if constexpr (ALIGN_EPI) { if (wr == 1) PG8_BAR; }
    }
    PG8_WAIT_V(0);
    if constexpr (!ALIGN_EPI) { if (wr == 0) PG8_BAR; }
    PG8_BAR;
    if constexpr (Epi::AFTER_DRAIN) { E.fused(acc, cur, wr, wc, fr, fq, lds, wid, lane); S.done(cur); }
#undef PG8_SA
#undef PG8_SB
#undef PG8_STAGE
#undef PG8_LDA
#undef PG8_LDB
#undef PG8_MMA
#undef PG8_WAIT_V
#undef PG8_WAIT_L
#undef PG8_BAR
#undef PG8_SCHED
}
}

constexpr int TP = 8192, TS = 512, T = TP + TS, DM = 2048, NSEQ = 132;
constexpr int NAB = 7424, NCD = 4864;
constexpr int NWAVES = 8, NTHR = 512;
constexpr size_t MiB = 1u << 20;
constexpr size_t WS_CTL = 0, CTL_ZERO_BYTES = 1 * MiB;
constexpr size_t WS_WABIN = 2 * MiB, WS_WABOUT = 60 * MiB, WS_WCDIN = 76 * MiB, WS_WCDOUT = 114 * MiB, WS_WGATE = 130 * MiB, WS_WPROJ = 162 * MiB;
constexpr size_t WS_H = 166 * MiB, WS_XN = 234 * MiB, WS_YM = 268 * MiB, WS_PB = 302 * MiB, WS_U = 320 * MiB, WS_SCR = 444 * MiB, WS_END = 704 * MiB;
constexpr size_t SC_C = 0, SC_C2 = 68 * MiB;
constexpr size_t SC_QN = 0, SC_KN = 34 * MiB, SC_VV = 68 * MiB, SC_ODN = 102 * MiB, SC_OGLA = 136 * MiB, SC_GLOG = 170 * MiB, SC_BETA = 187 * MiB, SC_GDEC = 188 * MiB;
constexpr size_t SC_XBC = 0, SC_LA = 52 * MiB, SC_LB = 86 * MiB, SC_YS = 120 * MiB, SC_HS = 154 * MiB, SC_DT = 188 * MiB, SC_SSDOP = 192 * MiB, SC_GEND = 256 * MiB;
constexpr int LDS_BYTES = 147456;
constexpr size_t O_Y_P = 0, O_Y_S = O_Y_P + (size_t)4 * 2048 * 2048, O_DN_P = O_Y_S + (size_t)128 * 4 * 2048,
    O_DNC_P = O_DN_P + (size_t)2 * 4 * 8 * 128 * 128, O_GLA_P = O_DNC_P + (size_t)2 * 4 * 3 * 3072, O_SSD_P = O_GLA_P + (size_t)2 * 4 * 4 * 128 * 256,
    O_SSDC_P = O_SSD_P + (size_t)2 * 4 * 16 * 64 * 64, O_LRU_P = O_SSDC_P + (size_t)2 * 4 * 3 * 1536, O_LRUC_P = O_LRU_P + (size_t)2 * 4 * 1024,
    O_DN_S = O_LRUC_P + (size_t)2 * 4 * 3 * 1024, O_DNC_S = O_DN_S + (size_t)2 * 128 * 8 * 128 * 128, O_GLA_S = O_DNC_S + (size_t)2 * 128 * 3 * 3072,
    O_SSD_S = O_GLA_S + (size_t)2 * 128 * 4 * 128 * 256, O_SSDC_S = O_SSD_S + (size_t)2 * 128 * 16 * 64 * 64, O_LRU_S = O_SSDC_S + (size_t)2 * 128 * 3 * 1536,
    O_LRUC_S = O_LRU_S + (size_t)2 * 128 * 1024, O_END = O_LRUC_S + (size_t)2 * 128 * 3 * 1024;
static_assert(O_END == 109064192, "output size");

#define LAS __attribute__((address_space(3)))
typedef unsigned short bf16;
typedef float f32x4 __attribute__((ext_vector_type(4)));
typedef unsigned u32x2 __attribute__((ext_vector_type(2)));
typedef unsigned u32x4 __attribute__((ext_vector_type(4)));
#define LDS_WAIT() asm volatile("s_waitcnt lgkmcnt(0)" ::: "memory")

__device__ __forceinline__ float bf2f(bf16 b) { return __uint_as_float(((unsigned)b) << 16); }
__device__ __forceinline__ unsigned f2bf(float f) { unsigned u = __float_as_uint(f); return (u + 0x7fffu + ((u >> 16) & 1u)) >> 16; }
__device__ __forceinline__ unsigned pk2(float lo, float hi) { return f2bf(lo) | (f2bf(hi) << 16); }
__device__ __forceinline__ float sigmoid_(float x) { return 1.f / (1.f + expf(-x)); }
__device__ __forceinline__ float silu_(float x) { return x / (1.f + expf(-x)); }
__device__ __forceinline__ float softplus_(float x) { return x > 20.f ? x : log1pf(expf(x)); }
__device__ __forceinline__ float wave_sum(float v) {
#pragma unroll
    for (int o = 1; o < 64; o <<= 1) v += __shfl_xor(v, o);
    return v;
}
__device__ __forceinline__ void row_to_seq(int r, int& s, int& t) { if (r < TP) { s = r >> 11; t = r & 2047; } else { s = 4 + ((r - TP) >> 2); t = (r - TP) & 3; } }
__device__ __forceinline__ void seq_info(int s, int& row0, int& L) { if (s < 4) { row0 = s << 11; L = 2048; } else { row0 = TP + ((s - 4) << 2); L = 4; } }
__device__ __forceinline__ float pre_val(const bf16* U, int ldu, int ucol, int row0, int tt, int s, const float* stc, int W, int c) {
    if (tt >= 0) return bf2f(U[(size_t)(row0 + tt) * ldu + ucol]);
    if (s < 4) return 0.f;
    return stc[((size_t)(s - 4) * 3 + (3 + tt)) * W + c];
}
__device__ __forceinline__ int map_col(int mapid, int n) {
    if (mapid == 0) return n;
    if (mapid == 1) { if (n < 3072) return n; if (n < 6144) return n + 16; if (n < 7168) return n + 32; if (n < 7184) return n - 4096; if (n < 7200) return n - 1024; return -1; }
    if (n < 2560) return n; if (n < 4608) return n + 16; if (n < 4624) return n - 2048; return -1;
}
__device__ __forceinline__ void transpose_item(const float* W, int K, int Nsrc, bf16* WT, int Npad, int mapid, LAS float* scr, int item, int lane) {
    const int nblk = Npad / 32, kb = item / nblk, nb = item % nblk, k0 = 64 * kb, n0 = 32 * nb;
    const int src = map_col(mapid, n0 + (lane & 31));
#pragma unroll 8
    for (int i = 0; i < 32; ++i) { const int kk = 2 * i + (lane >> 5); scr[kk * 33 + (lane & 31)] = src >= 0 ? W[(size_t)(k0 + kk) * Nsrc + src] : 0.f; }
    LDS_WAIT(); asm volatile("" ::: "memory");
    const int c = lane & 7;
#pragma unroll
    for (int j = 0; j < 4; ++j) { const int n = (lane >> 3) + 8 * j; const LAS float* s = scr + (8 * c) * 33 + n;
        u32x4 o; o.x = pk2(s[0 * 33], s[1 * 33]); o.y = pk2(s[2 * 33], s[3 * 33]); o.z = pk2(s[4 * 33], s[5 * 33]); o.w = pk2(s[6 * 33], s[7 * 33]);
        *(u32x4*)(WT + (size_t)(n0 + n) * K + k0 + 8 * c) = o; }
    LDS_WAIT(); asm volatile("" ::: "memory");
}
__device__ __forceinline__ void norm_row_bf16(const f32x4 (&v)[8], const float* g, bf16* orow, int lane) {
    float ss = 0.f;
#pragma unroll
    for (int j = 0; j < 8; ++j) ss += (v[j].x * v[j].x + v[j].y * v[j].y) + (v[j].z * v[j].z + v[j].w * v[j].w);
    const float rstd = rsqrtf(wave_sum(ss) * (1.f / DM) + 1e-6f);
#pragma unroll
    for (int j = 0; j < 8; ++j) { const int col = 4 * (lane + 64 * j); const f32x4 gg = *(const f32x4*)(g + col);
        u32x2 o; o.x = pk2(v[j].x * rstd * gg.x, v[j].y * rstd * gg.y); o.y = pk2(v[j].z * rstd * gg.z, v[j].w * rstd * gg.w);
        *(u32x2*)(orow + col) = o; }
}

typedef __bf16 bf16x2_t __attribute__((ext_vector_type(2)));
typedef float f32x2_t __attribute__((ext_vector_type(2)));
typedef short bf16x8 __attribute__((ext_vector_type(8)));
typedef float f32x16 __attribute__((ext_vector_type(16)));
__device__ __forceinline__ unsigned cvtpk(float lo, float hi) { f32x2_t v = {lo, hi}; bf16x2_t b = __builtin_convertvector(v, bf16x2_t); return __builtin_bit_cast(unsigned, b); }
#define MFMA32(a, b, c) __builtin_amdgcn_mfma_f32_32x32x16_bf16((a), (b), (c), 0, 0, 0)
#define PACK_ACC(x, S_) __builtin_bit_cast(bf16x8, (u32x4){cvtpk((x)[8 * (S_)], (x)[8 * (S_) + 1]), cvtpk((x)[8 * (S_) + 2], (x)[8 * (S_) + 3]), cvtpk((x)[8 * (S_) + 4], (x)[8 * (S_) + 5]), cvtpk((x)[8 * (S_) + 6], (x)[8 * (S_) + 7])})
__device__ __forceinline__ int crow(int reg, int h) { return (reg & 3) + 8 * (reg >> 2) + 4 * h; }
__device__ __forceinline__ bf16x8 pack8(const float (&v)[8]) { return __builtin_bit_cast(bf16x8, (u32x4){cvtpk(v[0], v[1]), cvtpk(v[2], v[3]), cvtpk(v[4], v[5]), cvtpk(v[6], v[7])}); }

struct Args { const float* in[40]; float* out; unsigned char* ws; int ph_lo, ph_hi; };
constexpr int N_PHASES = 41, SUBS = 10;
#ifndef PH_MASK
#define PH_MASK 8191
#endif
#define AS4 __attribute__((address_space(4)))
struct KP { const char AS4* p;
    __device__ __forceinline__ const float* in(int i) const { return *(const float* const AS4*)(p + 8 * i); }
    __device__ __forceinline__ float* out() const { return *(float* const AS4*)(p + 320); }
    __device__ __forceinline__ unsigned char* ws() const { return *(unsigned char* const AS4*)(p + 328); }
};
static_assert(sizeof(Args) == 344, "Args layout");

__device__ __forceinline__ void phase_prologue(const KP kp, LAS unsigned char* lds, int gw, int NGW, int wave, int lane) {
    unsigned char* ws = kp.ws();
    LAS float* scr = (LAS float*)(lds + wave * 16384);
    for (int job = 0; job < 16; ++job) {
        const float* W; int K = 2048, Nsrc = 2048, Npad = 2048, mapid = 0; bf16* WT;
        if (job < 2)       { W = kp.in(13) + (size_t)job * 2048 * 7200; Nsrc = 7200; Npad = NAB; mapid = 1; WT = (bf16*)(ws + WS_WABIN) + (size_t)job * NAB * 2048; }
        else if (job < 4)  { W = kp.in(21) + (size_t)(job - 2) * 2048 * 2048; WT = (bf16*)(ws + WS_WABOUT) + (size_t)(job - 2) * 2048 * 2048; }
        else if (job < 6)  { W = kp.in(22) + (size_t)(job - 4) * 2048 * 4624; Nsrc = 4624; Npad = NCD; mapid = 2; WT = (bf16*)(ws + WS_WCDIN) + (size_t)(job - 4) * NCD * 2048; }
        else if (job < 8)  { W = kp.in(36) + (size_t)(job - 6) * 2048 * 2048; WT = (bf16*)(ws + WS_WCDOUT) + (size_t)(job - 6) * 2048 * 2048; }
        else if (job < 12) { W = kp.in(39) + (size_t)(job - 8) * 2048 * 2048; WT = (bf16*)(ws + WS_WGATE) + (size_t)(job - 8) * 2048 * 2048; }
        else               { W = kp.in(37) + (size_t)(job - 12) * 256 * 2048; K = 256; WT = (bf16*)(ws + WS_WPROJ) + (size_t)(job - 12) * 2048 * 256; }
        const int nitems = (K / 64) * (Npad / 32);
        for (int it = gw; it < nitems; it += NGW) transpose_item(W, K, Nsrc, WT, Npad, mapid, scr, it, lane);
    }
    float* H = (float*)(ws + WS_H); bf16* XN = (bf16*)(ws + WS_XN);
    for (int m = gw; m < T; m += NGW) {
        const float* src = m < TP ? kp.in(0) + (size_t)m * DM : kp.in(1) + (size_t)(m - TP) * DM;
        f32x4 v[8];
#pragma unroll
        for (int j = 0; j < 8; ++j) { v[j] = *(const f32x4*)(src + 4 * (lane + 64 * j)); *(f32x4*)(H + (size_t)m * DM + 4 * (lane + 64 * j)) = v[j]; }
        norm_row_bf16(v, kp.in(11), XN + (size_t)m * DM, lane);
    }
    bf16* PB = (bf16*)(ws + WS_PB);
    const int gt = gw * 64 + lane, NGT = NGW * 64;
    for (int i = gt; i < 4 * T * 64; i += NGT) {
        const int c4 = i & 63, r = (i >> 6) % T, li = (i >> 6) / T;
        const float* src = r < TP ? kp.in(9) + ((size_t)li * TP + r) * 256 + 4 * c4 : kp.in(10) + ((size_t)li * TS + (r - TP)) * 256 + 4 * c4;
        const f32x4 v = *(const f32x4*)src;
        u32x2 o; o.x = pk2(v.x, v.y); o.y = pk2(v.z, v.w);
        *(u32x2*)(PB + ((size_t)li * T + r) * 256 + 4 * c4) = o;
    }
}

__device__ __forceinline__ void phase_res1(const KP kp, int li, int gw, int NGW, int lane) {
    float* H = (float*)(kp.ws() + WS_H); bf16* XN = (bf16*)(kp.ws() + WS_XN); const float* C = (const float*)(kp.ws() + WS_SCR + SC_C);
    for (int m = gw; m < T; m += NGW) {
        f32x4 v[8];
#pragma unroll
        for (int j = 0; j < 8; ++j) { const size_t o = (size_t)m * DM + 4 * (lane + 64 * j); v[j] = *(const f32x4*)(H + o) + *(const f32x4*)(C + o); *(f32x4*)(H + o) = v[j]; }
        norm_row_bf16(v, kp.in(38) + (size_t)li * DM, XN + (size_t)m * DM, lane);
    }
}
__device__ __forceinline__ void phase_res2(const KP kp, int li, int gw, int NGW, int lane) {
    float* H = (float*)(kp.ws() + WS_H); bf16* XN = (bf16*)(kp.ws() + WS_XN); const float* C = (const float*)(kp.ws() + WS_SCR + SC_C); const float* C2 = (const float*)(kp.ws() + WS_SCR + SC_C2);
    for (int m = gw; m < T; m += NGW) {
        f32x4 v[8];
#pragma unroll
        for (int j = 0; j < 8; ++j) { const size_t o = (size_t)m * DM + 4 * (lane + 64 * j); const f32x4 c = *(const f32x4*)(C + o), c2 = *(const f32x4*)(C2 + o); f32x4 h = *(const f32x4*)(H + o);
            h.x += sigmoid_(c.x) * c2.x; h.y += sigmoid_(c.y) * c2.y; h.z += sigmoid_(c.z) * c2.z; h.w += sigmoid_(c.w) * c2.w; v[j] = h; *(f32x4*)(H + o) = h; }
        if (li < 3) norm_row_bf16(v, kp.in(11) + (size_t)(li + 1) * DM, XN + (size_t)m * DM, lane);
        else {
            float ss = 0.f;
#pragma unroll
            for (int j = 0; j < 8; ++j) ss += (v[j].x * v[j].x + v[j].y * v[j].y) + (v[j].z * v[j].z + v[j].w * v[j].w);
            const float rstd = rsqrtf(wave_sum(ss) * (1.f / DM) + 1e-6f);
#pragma unroll
            for (int j = 0; j < 8; ++j) { const int col = 4 * (lane + 64 * j); const f32x4 gg = *(const f32x4*)(kp.in(12) + col);
                f32x4 o; o.x = v[j].x * rstd * gg.x; o.y = v[j].y * rstd * gg.y; o.z = v[j].z * rstd * gg.z; o.w = v[j].w * rstd * gg.w;
                *(f32x4*)(kp.out() + (size_t)m * DM + col) = o; }
        }
    }
}

__device__ __forceinline__ void phase_ab_pre(const KP kp, const int bid, const int G, int j, int tid, int wave, int lane) {
    unsigned char* scr = kp.ws() + WS_SCR; const bf16* U = (const bf16*)(kp.ws() + WS_U);
    float* QN = (float*)(scr + SC_QN); float* KN = (float*)(scr + SC_KN); float* VV = (float*)(scr + SC_VV);
    float* GLOG = (float*)(scr + SC_GLOG); float* BETA = (float*)(scr + SC_BETA); float* GDEC = (float*)(scr + SC_GDEC);
    const float* cw = kp.in(14) + (size_t)j * 4 * 3072; const float* stc = kp.in(3) + (size_t)j * 128 * 3 * 3072;
    const float* wa2 = kp.in(18) + (size_t)j * 16 * 512; const float* ba = kp.in(19) + (size_t)j * 512;
    for (int r = bid; r < T; r += G) {
        int s, t; row_to_seq(r, s, t); const int row0 = r - t;
#pragma unroll
        for (int part = 0; part < 3; ++part) {
            float val[2];
#pragma unroll
            for (int i = 0; i < 2; ++i) { const int c = part * 1024 + wave * 128 + lane + 64 * i; float acc = 0.f;
#pragma unroll
                for (int tap = 0; tap < 4; ++tap) acc += cw[tap * 3072 + c] * pre_val(U, NAB, c, row0, t - 3 + tap, s, stc, 3072, c);
                val[i] = silu_(acc); }
            if (part < 2) { const float ss = wave_sum(val[0] * val[0] + val[1] * val[1]); const float sc = rsqrtf(ss + 1e-6f) * (part == 0 ? 0.08838834764831845f : 1.f); val[0] *= sc; val[1] *= sc; }
            float* dst = part == 0 ? QN : (part == 1 ? KN : VV);
            dst[(size_t)r * 1024 + wave * 128 + lane] = val[0]; dst[(size_t)r * 1024 + wave * 128 + lane + 64] = val[1];
        }
        if (tid < 8) {
            BETA[(size_t)r * 8 + tid] = sigmoid_(bf2f(U[(size_t)r * NAB + 7168 + tid]));
            GDEC[(size_t)r * 8 + tid] = -expf(kp.in(15)[j * 8 + tid]) * softplus_(bf2f(U[(size_t)r * NAB + 7176 + tid]) + kp.in(16)[j * 8 + tid]);
        }
        { float x = ba[tid];
#pragma unroll
          for (int rr = 0; rr < 16; ++rr) x += bf2f(U[(size_t)r * NAB + 7184 + rr]) * wa2[rr * 512 + tid];
          GLOG[(size_t)r * 512 + tid] = -softplus_(-x) * (1.f / 16.f); }
    }
}


constexpr size_t GLA_ITEM_BYTES = 74752, WS_GLAOPS = WS_XN;
__device__ __forceinline__ void phase_gla_prep(const KP kp, const int bid, const int G, int j, LAS unsigned char* lds, int tid) {
    const bf16* U = (const bf16*)(kp.ws() + WS_U); const float* GLOG = (const float*)(kp.ws() + WS_SCR + SC_GLOG);
    unsigned char* OPS = kp.ws() + WS_GLAOPS;
    LAS float* GL = (LAS float*)lds; LAS float* QL = GL + 64 * 129; LAS float* KL = QL + 64 * 129; LAS float* AL = KL + 64 * 129;
    const int lane = tid & 63, r = lane & 31, hp = lane >> 5;
    for (int item = bid; item < 512; item += G) {
        const int b = item >> 7, n = (item >> 2) & 31, h = item & 3;
        const int row0 = b * 2048 + n * 64;
        __syncthreads();
        for (int i = tid; i < 8192; i += NTHR) { const int t = i >> 7, d = i & 127; const size_t ro = (size_t)(row0 + t) * NAB;
            QL[t * 129 + d] = bf2f(U[ro + 4096 + h * 128 + d]) * 0.08838834764831845f; KL[t * 129 + d] = bf2f(U[ro + 4608 + h * 128 + d]);
            GL[t * 129 + d] = GLOG[(size_t)(row0 + t) * 512 + h * 128 + d]; }
        __syncthreads();
        if (tid < 128) { float acc = 0.f;
#pragma unroll 4
            for (int t = 0; t < 64; ++t) { acc += GL[t * 129 + tid]; GL[t * 129 + tid] = acc; } }
        __syncthreads();
        for (int i = tid; i < 8192; i += NTHR) { const int t = i >> 7, d = i & 127; const float gg = GL[t * 129 + d]; QL[t * 129 + d] *= expf(gg); KL[t * 129 + d] *= expf(-gg); }
        __syncthreads();
        { const int i = tid >> 3, jg = tid & 7; float acc[8];
#pragma unroll
          for (int jj = 0; jj < 8; ++jj) acc[jj] = 0.f;
#pragma unroll 4
          for (int d = 0; d < 128; ++d) { const float c = QL[i * 129 + d];
#pragma unroll
              for (int jj = 0; jj < 8; ++jj) acc[jj] += c * KL[(jg * 8 + jj) * 129 + d]; }
#pragma unroll
          for (int jj = 0; jj < 8; ++jj) AL[i * 65 + jg * 8 + jj] = (jg * 8 + jj) <= i ? acc[jj] : 0.f; }
        __syncthreads();
        bf16x8* base = (bf16x8*)(OPS + (size_t)item * GLA_ITEM_BYTES);
        float v[8];
#pragma unroll
        for (int q = 0; q < 2; ++q) { const int f = (tid >> 6) + 8 * q;
            { const int mt = f >> 3, ks = f & 7, i = 32 * mt + r;
#pragma unroll
              for (int jp = 0; jp < 8; ++jp) v[jp] = QL[i * 129 + 16 * ks + 8 * (jp >> 2) + 4 * hp + (jp & 3)];
              base[f * 64 + lane] = pack8(v); }
            { const int mt = f >> 2, ks = f & 3, d = 32 * mt + r; const float eg = expf(GL[63 * 129 + d]);
#pragma unroll
              for (int jp = 0; jp < 8; ++jp) v[jp] = KL[(16 * ks + 8 * (jp >> 2) + 4 * hp + (jp & 3)) * 129 + d] * eg;
              base[(16 + f) * 64 + lane] = pack8(v); } }
        { const int f = tid >> 6, mt = f >> 2, ks = f & 3, i = 32 * mt + r;
#pragma unroll
          for (int jp = 0; jp < 8; ++jp) v[jp] = AL[i * 65 + 16 * ks + 8 * (jp >> 2) + 4 * hp + (jp & 3)];
          base[(32 + f) * 64 + lane] = pack8(v); }
#pragma unroll
        for (int q = 0; q < 4; ++q) { const int f = (tid >> 6) + 8 * q, nt = f >> 2, ks = f & 3, p = 32 * nt + r;
            unsigned w[4];
#pragma unroll
            for (int jp = 0; jp < 8; jp += 2) { const int t0 = 16 * ks + 8 * (jp >> 2) + 4 * hp + (jp & 3);
                w[jp >> 1] = (unsigned)U[(size_t)(row0 + t0) * NAB + 5120 + h * 256 + p] | ((unsigned)U[(size_t)(row0 + t0 + 1) * NAB + 5120 + h * 256 + p] << 16); }
            base[(40 + f) * 64 + lane] = __builtin_bit_cast(bf16x8, (u32x4){w[0], w[1], w[2], w[3]}); }
        if (tid < 128) ((float*)(base + 72 * 64))[tid] = expf(GL[63 * 129 + tid]);
    }
}

__device__ __forceinline__ void phase_ab_rec(const KP kp, const int bid, const int G, int j, LAS unsigned char* lds, int tid0) {
    unsigned char* scr = kp.ws() + WS_SCR; const bf16* U = (const bf16*)(kp.ws() + WS_U);
    const float* QN = (const float*)(scr + SC_QN); const float* KN = (const float*)(scr + SC_KN); const float* VV = (const float*)(scr + SC_VV);
    const float* GLOG = (const float*)(scr + SC_GLOG); const float* BETA = (const float*)(scr + SC_BETA); const float* GDEC = (const float*)(scr + SC_GDEC);
    float* ODN = (float*)(scr + SC_ODN); float* OGLA = (float*)(scr + SC_OGLA);
    LAS float* SL = (LAS float*)lds;
    for (int item = bid; item < 1600; item += G) {
        int tid = tid0; asm volatile("" : "+v"(tid));
        int s, h; bool isdn; int half = -1;
        if (item < 32) { isdn = false; s = item >> 3; h = (item >> 1) & 3; half = item & 1; }
        else if (item < 64) { isdn = true; s = (item - 32) >> 3; h = (item - 32) & 7; }
        else if (item < 1088) { isdn = true; s = 4 + ((item - 64) >> 3); h = (item - 64) & 7; }
        else { isdn = false; s = 4 + ((item - 1088) >> 2); h = (item - 1088) & 3; }
        int row0, L; seq_info(s, row0, L);
        __syncthreads();
        if (half >= 0) {
            const int wave = __builtin_amdgcn_readfirstlane(tid >> 6), lane = tid & 63, r = lane & 31, hp = lane >> 5;
            const int b = s, nt = half * 4 + wave;
            const unsigned char* OPS = kp.ws() + WS_GLAOPS;
            constexpr int GBUF = 57 * 1024;
#define GLA_DMA(n_, bufi_) do { const unsigned char* gi_ = OPS + (size_t)((b * 32 + (n_)) * 4 + h) * GLA_ITEM_BYTES + lane * 16; \
                _Pragma("unroll") for (int q_ = 0; q_ < 8; ++q_) { const int lf_ = wave + 8 * q_; if (lf_ < 57) { const int gf_ = lf_ < 40 ? lf_ : (lf_ < 56 ? lf_ + half * 16 : 72); \
                    __builtin_amdgcn_global_load_lds((const unsigned*)(gi_ + gf_ * 1024), (LAS unsigned*)(lds + (bufi_) * GBUF + lf_ * 1024), 16, 0, 0); } } } while (0)
            f32x16 S0, S1, S2, S3;
#pragma unroll
            for (int i = 0; i < 16; ++i) { S0[i] = 0.f; S1[i] = 0.f; S2[i] = 0.f; S3[i] = 0.f; }
            GLA_DMA(0, 0);
            asm volatile("s_waitcnt vmcnt(0)" ::: "memory"); __syncthreads();
            for (int n = 0; n < 32; ++n) {
                if (n + 1 < 32) GLA_DMA(n + 1, (n + 1) & 1);
                if (wave < 4) {
                    const LAS bf16x8* F = (const LAS bf16x8*)(lds + (n & 1) * GBUF) + lane;
                    const LAS float* ge = (const LAS float*)(lds + (n & 1) * GBUF + 56 * 1024) + 4 * hp;
                    const bf16x8 sb0 = PACK_ACC(S0, 0), sb1 = PACK_ACC(S0, 1), sb2 = PACK_ACC(S1, 0), sb3 = PACK_ACC(S1, 1), sb4 = PACK_ACC(S2, 0), sb5 = PACK_ACC(S2, 1), sb6 = PACK_ACC(S3, 0), sb7 = PACK_ACC(S3, 1);
                    f32x16 O0, O1;
#pragma unroll
                    for (int i = 0; i < 16; ++i) { O0[i] = 0.f; O1[i] = 0.f; }
                    O0 = MFMA32(F[0 * 64], sb0, O0); O0 = MFMA32(F[1 * 64], sb1, O0); O0 = MFMA32(F[2 * 64], sb2, O0); O0 = MFMA32(F[3 * 64], sb3, O0);
                    O0 = MFMA32(F[4 * 64], sb4, O0); O0 = MFMA32(F[5 * 64], sb5, O0); O0 = MFMA32(F[6 * 64], sb6, O0); O0 = MFMA32(F[7 * 64], sb7, O0);
                    O1 = MFMA32(F[8 * 64], sb0, O1); O1 = MFMA32(F[9 * 64], sb1, O1); O1 = MFMA32(F[10 * 64], sb2, O1); O1 = MFMA32(F[11 * 64], sb3, O1);
                    O1 = MFMA32(F[12 * 64], sb4, O1); O1 = MFMA32(F[13 * 64], sb5, O1); O1 = MFMA32(F[14 * 64], sb6, O1); O1 = MFMA32(F[15 * 64], sb7, O1);
                    bf16x8 vb[4];
#pragma unroll
                    for (int ks = 0; ks < 4; ++ks) vb[ks] = F[(40 + wave * 4 + ks) * 64];
                    O0 = MFMA32(F[32 * 64], vb[0], O0); O0 = MFMA32(F[33 * 64], vb[1], O0);
#pragma unroll
                    for (int ks = 0; ks < 4; ++ks) O1 = MFMA32(F[(36 + ks) * 64], vb[ks], O1);
#pragma unroll
                    for (int q = 0; q < 4; ++q) { const f32x4 g0 = *(const LAS f32x4*)(ge + 8 * q), g1 = *(const LAS f32x4*)(ge + 32 + 8 * q), g2 = *(const LAS f32x4*)(ge + 64 + 8 * q), g3 = *(const LAS f32x4*)(ge + 96 + 8 * q);
#pragma unroll
                        for (int c = 0; c < 4; ++c) { S0[4 * q + c] *= g0[c]; S1[4 * q + c] *= g1[c]; S2[4 * q + c] *= g2[c]; S3[4 * q + c] *= g3[c]; } }
#pragma unroll
                    for (int ks = 0; ks < 4; ++ks) { S0 = MFMA32(F[(16 + ks) * 64], vb[ks], S0); S1 = MFMA32(F[(20 + ks) * 64], vb[ks], S1); S2 = MFMA32(F[(24 + ks) * 64], vb[ks], S2); S3 = MFMA32(F[(28 + ks) * 64], vb[ks], S3); }
                    float* yo = OGLA + (size_t)(b * 2048 + n * 64) * 1024 + h * 256 + 32 * nt + r;
#pragma unroll
                    for (int i = 0; i < 16; ++i) { yo[(size_t)crow(i, hp) * 1024] = O0[i]; yo[(size_t)(32 + crow(i, hp)) * 1024] = O1[i]; }
                }
                asm volatile("s_waitcnt vmcnt(0)" ::: "memory"); __syncthreads();
            }
#undef GLA_DMA
            if (wave < 4) {
                float* dst = kp.out() + O_GLA_P + ((size_t)j * 4 + b) * ((size_t)4 * 128 * 256) + (size_t)h * 128 * 256 + 32 * nt + r;
#pragma unroll
                for (int i = 0; i < 16; ++i) { dst[(size_t)crow(i, hp) * 256] = S0[i]; dst[(size_t)(32 + crow(i, hp)) * 256] = S1[i]; dst[(size_t)(64 + crow(i, hp)) * 256] = S2[i]; dst[(size_t)(96 + crow(i, hp)) * 256] = S3[i]; }
            }
        } else
        if (isdn) {
            LAS float* kL = SL + 16384; LAS float* qL = kL + 128; LAS float* red = kL + 256; LAS float* red2 = kL + 768;
            const int e = tid & 127, dq = tid >> 7;
            const size_t SZ = (size_t)8 * 128 * 128;
            const float* st = kp.in(2) + ((size_t)j * 128 + (s < 4 ? 0 : s - 4)) * SZ + (size_t)h * 128 * 128;
#pragma unroll 4
            for (int i = 0; i < 32; ++i) { const int d = dq * 32 + i; SL[d * 128 + e] = s < 4 ? 0.f : st[(size_t)d * 128 + e]; }
            for (int t = 0; t < L; ++t) {
                const size_t r = (size_t)(row0 + t);
                if (tid < 128) kL[tid] = KN[r * 1024 + h * 128 + tid]; else if (tid < 256) qL[tid - 128] = QN[r * 1024 + h * 128 + (tid - 128)];
                const float ve = VV[r * 1024 + h * 128 + e], beta = BETA[r * 8 + h], a = expf(GDEC[r * 8 + h]);
                __syncthreads();
                float part = 0.f;
#pragma unroll 4
                for (int i = 0; i < 32; ++i) { const int d = dq * 32 + i; const float sv = SL[d * 128 + e] * a; SL[d * 128 + e] = sv; part += kL[d] * sv; }
                red[dq * 128 + e] = part;
                __syncthreads();
                const float kS = (red[e] + red[128 + e]) + (red[256 + e] + red[384 + e]);
                const float u = beta * (ve - kS);
                float part2 = 0.f;
#pragma unroll 4
                for (int i = 0; i < 32; ++i) { const int d = dq * 32 + i; const float sv = SL[d * 128 + e] + kL[d] * u; SL[d * 128 + e] = sv; part2 += qL[d] * sv; }
                red2[dq * 128 + e] = part2;
                __syncthreads();
                if (dq == 0) ODN[r * 1024 + h * 128 + e] = (red2[e] + red2[128 + e]) + (red2[256 + e] + red2[384 + e]);
            }
            float* dst = s < 4 ? kp.out() + O_DN_P + ((size_t)j * 4 + s) * SZ + (size_t)h * 128 * 128 : kp.out() + O_DN_S + ((size_t)j * 128 + (s - 4)) * SZ + (size_t)h * 128 * 128;
#pragma unroll 4
            for (int i = 0; i < 32; ++i) { const int d = dq * 32 + i; dst[(size_t)d * 128 + e] = SL[d * 128 + e]; }
        } else {
            LAS float* kL = SL + 32768; LAS float* qL = kL + 128; LAS float* aL = kL + 256; LAS float* red = kL + 384;
            const int e = tid & 255, dh = tid >> 8;
            const size_t SZ = (size_t)4 * 128 * 256;
            const float* st = kp.in(4) + ((size_t)j * 128 + (s < 4 ? 0 : s - 4)) * SZ + (size_t)h * 128 * 256;
#pragma unroll 4
            for (int i = 0; i < 64; ++i) { const int d = dh * 64 + i; SL[d * 256 + e] = s < 4 ? 0.f : st[(size_t)d * 256 + e]; }
            for (int t = 0; t < L; ++t) {
                const size_t r = (size_t)(row0 + t);
                if (tid < 128) kL[tid] = bf2f(U[r * NAB + 4608 + h * 128 + tid]);
                else if (tid < 256) qL[tid - 128] = bf2f(U[r * NAB + 4096 + h * 128 + (tid - 128)]) * 0.08838834764831845f;
                else if (tid < 384) aL[tid - 256] = expf(GLOG[r * 512 + h * 128 + (tid - 256)]);
                const float ve = bf2f(U[r * NAB + 5120 + h * 256 + e]);
                __syncthreads();
                float part = 0.f;
#pragma unroll 4
                for (int i = 0; i < 64; ++i) { const int d = dh * 64 + i; const float sv = aL[d] * SL[d * 256 + e] + kL[d] * ve; SL[d * 256 + e] = sv; part += qL[d] * sv; }
                red[dh * 256 + e] = part;
                __syncthreads();
                if (dh == 0) OGLA[r * 1024 + h * 256 + e] = red[e] + red[256 + e];
            }
            float* dst = s < 4 ? kp.out() + O_GLA_P + ((size_t)j * 4 + s) * SZ + (size_t)h * 128 * 256 : kp.out() + O_GLA_S + ((size_t)j * 128 + (s - 4)) * SZ + (size_t)h * 128 * 256;
#pragma unroll 4
            for (int i = 0; i < 64; ++i) { const int d = dh * 64 + i; dst[(size_t)d * 256 + e] = SL[d * 256 + e]; }
        }
    }
}

__device__ __forceinline__ void phase_ab_post(const KP kp, const int bid, const int G, int j, int tid, int wave, int lane) {
    unsigned char* scr = kp.ws() + WS_SCR; const bf16* U = (const bf16*)(kp.ws() + WS_U); bf16* YM = (bf16*)(kp.ws() + WS_YM);
    const float* ODN = (const float*)(scr + SC_ODN); const float* OGLA = (const float*)(scr + SC_OGLA);
    const float* dnn = kp.in(17) + (size_t)j * 128; const float* glan = kp.in(20) + (size_t)j * 256;
    for (int r = bid; r < T; r += G) {
        int s, t; row_to_seq(r, s, t); int row0, L; seq_info(s, row0, L);
        { float o[2];
#pragma unroll
          for (int i = 0; i < 2; ++i) o[i] = ODN[(size_t)r * 1024 + wave * 128 + lane + 64 * i];
          const float rstd = rsqrtf(wave_sum(o[0] * o[0] + o[1] * o[1]) * (1.f / 128.f) + 1e-6f);
#pragma unroll
          for (int i = 0; i < 2; ++i) { const int e = lane + 64 * i; const float z = bf2f(U[(size_t)r * NAB + 3072 + wave * 128 + e]);
              YM[(size_t)r * DM + wave * 128 + e] = (bf16)f2bf(o[i] * rstd * dnn[e] * silu_(z)); } }
        if (wave < 4) { float o[4]; float ss = 0.f;
#pragma unroll
          for (int i = 0; i < 4; ++i) { o[i] = OGLA[(size_t)r * 1024 + wave * 256 + lane + 64 * i]; ss += o[i] * o[i]; }
          const float rstd = rsqrtf(wave_sum(ss) * (1.f / 256.f) + 1e-6f);
#pragma unroll
          for (int i = 0; i < 4; ++i) { const int e = lane + 64 * i; const float z = bf2f(U[(size_t)r * NAB + 6144 + wave * 256 + e]);
              YM[(size_t)r * DM + 1024 + wave * 256 + e] = (bf16)f2bf(o[i] * rstd * glan[e] * silu_(z)); } }
        if (t >= L - 3) { const int rr = t - (L - 3);
            float* dst = s < 4 ? kp.out() + O_DNC_P + (((size_t)j * 4 + s) * 3 + rr) * 3072 : kp.out() + O_DNC_S + (((size_t)j * 128 + (s - 4)) * 3 + rr) * 3072;
            for (int c = tid; c < 3072; c += NTHR) dst[c] = bf2f(U[(size_t)r * NAB + c]); }
    }
}

__device__ __forceinline__ void phase_cd_pre(const KP kp, const int bid, const int G, int j, LAS unsigned char* lds, int tid) {
    unsigned char* scr = kp.ws() + WS_SCR; const bf16* U = (const bf16*)(kp.ws() + WS_U);
    float* XBC = (float*)(scr + SC_XBC); float* LA = (float*)(scr + SC_LA); float* LB = (float*)(scr + SC_LB); float* DT = (float*)(scr + SC_DT);
    const float* cw = kp.in(23) + (size_t)j * 4 * 1536; const float* cb = kp.in(24) + (size_t)j * 1536; const float* stc = kp.in(6) + (size_t)j * 128 * 3 * 1536;
    const float* lcw = kp.in(29) + (size_t)j * 4 * 1024; const float* lcb = kp.in(30) + (size_t)j * 1024; const float* lstc = kp.in(8) + (size_t)j * 128 * 3 * 1024;
    const float* wa = kp.in(31) + (size_t)j * 16 * 64 * 64; const float* wx = kp.in(33) + (size_t)j * 16 * 64 * 64;
    const float* lba = kp.in(32) + (size_t)j * 1024; const float* lbx = kp.in(34) + (size_t)j * 1024; const float* lam = kp.in(35) + (size_t)j * 1024;
    LAS float* xcL = (LAS float*)lds;
    for (int r = bid; r < T; r += G) {
        int s, t; row_to_seq(r, s, t); const int row0 = r - t;
#pragma unroll
        for (int i = 0; i < 3; ++i) { const int c = tid + NTHR * i; float acc = cb[c];
#pragma unroll
            for (int tap = 0; tap < 4; ++tap) acc += cw[tap * 1536 + c] * pre_val(U, NCD, 1024 + c, row0, t - 3 + tap, s, stc, 1536, c);
            XBC[(size_t)r * 1536 + c] = silu_(acc); }
        if (tid < 16) DT[(size_t)r * 16 + tid] = softplus_(bf2f(U[(size_t)r * NCD + 4608 + tid]) + kp.in(26)[j * 16 + tid]);
        float xc[2];
#pragma unroll
        for (int i = 0; i < 2; ++i) { const int ch = tid + NTHR * i; float acc = lcb[ch];
#pragma unroll
            for (int tap = 0; tap < 4; ++tap) acc += lcw[tap * 1024 + ch] * pre_val(U, NCD, 3584 + ch, row0, t - 3 + tap, s, lstc, 1024, ch);
            xc[i] = acc; xcL[ch] = acc; }
        __syncthreads();
#pragma unroll
        for (int i = 0; i < 2; ++i) { const int ch = tid + NTHR * i, n = ch >> 6, d = ch & 63; float ra = lba[ch], ix = lbx[ch];
#pragma unroll 8
            for (int c = 0; c < 64; ++c) { const float x = xcL[n * 64 + c]; ra += x * wa[(size_t)(n * 64 + c) * 64 + d]; ix += x * wx[(size_t)(n * 64 + c) * 64 + d]; }
            const float rg = sigmoid_(ra), ig = sigmoid_(ix);
            const float log_a = -8.f * rg * softplus_(-lam[ch]);
            LA[(size_t)r * 1024 + ch] = expf(log_a);
            LB[(size_t)r * 1024 + ch] = sqrtf(-expm1f(2.f * log_a)) * (ig * xc[i]); }
        __syncthreads();
    }
}


__device__ __forceinline__ void phase_ssd_prep(const KP kp, const int bid, const int G, int j, LAS unsigned char* lds, int tid) {
    unsigned char* scr = kp.ws() + WS_SCR;
    const float* XBC = (const float*)(scr + SC_XBC); const float* DT = (const float*)(scr + SC_DT);
    unsigned char* OPS = scr + SC_SSDOP; float* GEND = (float*)(scr + SC_GEND);
    LAS float* CL = (LAS float*)lds; LAS float* BL = CL + 64 * 65; LAS float* QK = BL + 64 * 65; LAS float* GL = QK + 64 * 65;
    const float* alog = kp.in(25) + j * 16;
    const int wave = tid >> 6, lane = tid & 63;
    for (int item = bid; item < 512; item += G) {
        const int b = item >> 7, n = (item >> 2) & 31, g = item & 3;
        const int row0 = b * 2048 + n * 64;
        __syncthreads();
        for (int i = tid; i < 4096; i += NTHR) { const int t = i >> 6, d = i & 63;
            BL[t * 65 + d] = XBC[(size_t)(row0 + t) * 1536 + 1024 + g * 64 + d];
            CL[t * 65 + d] = XBC[(size_t)(row0 + t) * 1536 + 1280 + g * 64 + d]; }
        if (wave < 4) { const int h = g * 4 + wave; float gv = -expf(alog[h]) * DT[(size_t)(row0 + lane) * 16 + h];
#pragma unroll
            for (int o = 1; o < 64; o <<= 1) { const float tt = __shfl_up(gv, o); if (lane >= o) gv += tt; }
            GL[wave * 64 + lane] = gv; }
        __syncthreads();
        { const int i = tid >> 3, jg = tid & 7; float acc[8];
#pragma unroll
          for (int jj = 0; jj < 8; ++jj) acc[jj] = 0.f;
#pragma unroll 4
          for (int d = 0; d < 64; ++d) { const float c = CL[i * 65 + d];
#pragma unroll
              for (int jj = 0; jj < 8; ++jj) acc[jj] += c * BL[(jg * 8 + jj) * 65 + d]; }
#pragma unroll
          for (int jj = 0; jj < 8; ++jj) QK[i * 65 + jg * 8 + jj] = acc[jj]; }
        __syncthreads();
        const int f = wave, r = lane & 31, hp = lane >> 5, mt = f >> 2, ks = f & 3;
        for (int hh = 0; hh < 4; ++hh) {
            const int h = g * 4 + hh; const LAS float* Gh = GL + hh * 64; const float Gend = Gh[63];
            bf16x8* base = (bf16x8*)(OPS + ((size_t)((b * 32 + n) * 16 + h)) * 32768);
            float v[8];
            { const int i = 32 * mt + r; const float eg = expf(Gh[i]);
#pragma unroll
              for (int jp = 0; jp < 8; ++jp) { const int d = 16 * ks + 8 * (jp >> 2) + 4 * hp + (jp & 3); v[jp] = CL[i * 65 + d] * eg; }
              base[0 * 512 + f * 64 + lane] = pack8(v); }
            { const int d = 32 * mt + r;
#pragma unroll
              for (int jp = 0; jp < 8; ++jp) { const int tk = 16 * ks + 8 * (jp >> 2) + 4 * hp + (jp & 3); v[jp] = BL[tk * 65 + d] * expf(Gend - Gh[tk]); }
              base[1 * 512 + f * 64 + lane] = pack8(v); }
            { const int i = 32 * mt + r; const float gi = Gh[i];
#pragma unroll
              for (int jp = 0; jp < 8; ++jp) { const int jt = 16 * ks + 8 * (jp >> 2) + 4 * hp + (jp & 3); v[jp] = jt <= i ? QK[i * 65 + jt] * expf(gi - Gh[jt]) : 0.f; }
              base[2 * 512 + f * 64 + lane] = pack8(v); }
            { const int p = 32 * mt + r;
#pragma unroll
              for (int jp = 0; jp < 8; ++jp) { const int tk = 16 * ks + 8 * (jp >> 2) + 4 * hp + (jp & 3);
                  v[jp] = XBC[(size_t)(row0 + tk) * 1536 + h * 64 + p] * DT[(size_t)(row0 + tk) * 16 + h]; }
              base[3 * 512 + f * 64 + lane] = pack8(v); }
            if (tid == 0) GEND[(b * 32 + n) * 16 + h] = expf(Gend);
        }
    }
}

__device__ __forceinline__ void phase_cd_rec(const KP kp, const int bid, const int G, int j, LAS unsigned char* lds, int tid0) {
    unsigned char* scr = kp.ws() + WS_SCR;
    const float* XBC = (const float*)(scr + SC_XBC); const float* LA = (const float*)(scr + SC_LA); const float* LB = (const float*)(scr + SC_LB); const float* DT = (const float*)(scr + SC_DT);
    float* YS = (float*)(scr + SC_YS); float* HS = (float*)(scr + SC_HS);
    LAS float* bL = (LAS float*)lds; LAS float* cL = bL + 64; LAS float* red = bL + 128;
    for (int item = bid; item < 2328; item += G) {
        int tid = tid0; asm volatile("" : "+v"(tid));
        int kind, s, h;
        if (item < 16) { kind = 2; s = item >> 2; h = item & 3; }
        else if (item < 24) { kind = 1; s = (item - 16) >> 1; h = (item - 16) & 1; }
        else if (item < 2072) { kind = 0; s = 4 + ((item - 24) >> 4); h = (item - 24) & 15; }
        else { kind = 1; s = 4 + ((item - 2072) >> 1); h = (item - 2072) & 1; }
        int row0, L; seq_info(s, row0, L);
        __syncthreads();
        if (kind == 2) {
            const int wave = __builtin_amdgcn_readfirstlane(tid >> 6), lane = tid & 63, r = lane & 31, hp = lane >> 5;
            const int b = s, hd = h * 4 + (wave >> 1), nt = wave & 1;
            const unsigned char* OPS = scr + SC_SSDOP; const float* GEND = (const float*)(scr + SC_GEND);
            f32x16 S0, S1;
#pragma unroll
            for (int i = 0; i < 16; ++i) { S0[i] = 0.f; S1[i] = 0.f; }
            for (int n = 0; n < 32; ++n) {
                const bf16x8* F = (const bf16x8*)(OPS + ((size_t)((b * 32 + n) * 16 + hd)) * 32768) + lane;
                bf16x8 qg[2][4], kT[2][4], Am[2][4], vb[4];
#pragma unroll
                for (int mt = 0; mt < 2; ++mt)
#pragma unroll
                    for (int ks = 0; ks < 4; ++ks) { qg[mt][ks] = F[(0 * 8 + mt * 4 + ks) * 64]; kT[mt][ks] = F[(1 * 8 + mt * 4 + ks) * 64]; Am[mt][ks] = F[(2 * 8 + mt * 4 + ks) * 64]; }
#pragma unroll
                for (int ks = 0; ks < 4; ++ks) vb[ks] = F[(3 * 8 + nt * 4 + ks) * 64];
                const float gend = GEND[(b * 32 + n) * 16 + hd];
                const bf16x8 sb00 = PACK_ACC(S0, 0), sb01 = PACK_ACC(S0, 1), sb10 = PACK_ACC(S1, 0), sb11 = PACK_ACC(S1, 1);
                f32x16 O0, O1;
#pragma unroll
                for (int i = 0; i < 16; ++i) { O0[i] = 0.f; O1[i] = 0.f; }
                O0 = MFMA32(qg[0][0], sb00, O0); O0 = MFMA32(qg[0][1], sb01, O0); O0 = MFMA32(qg[0][2], sb10, O0); O0 = MFMA32(qg[0][3], sb11, O0);
                O1 = MFMA32(qg[1][0], sb00, O1); O1 = MFMA32(qg[1][1], sb01, O1); O1 = MFMA32(qg[1][2], sb10, O1); O1 = MFMA32(qg[1][3], sb11, O1);
                O0 = MFMA32(Am[0][0], vb[0], O0); O0 = MFMA32(Am[0][1], vb[1], O0);
#pragma unroll
                for (int ks = 0; ks < 4; ++ks) O1 = MFMA32(Am[1][ks], vb[ks], O1);
#pragma unroll
                for (int i = 0; i < 16; ++i) { S0[i] *= gend; S1[i] *= gend; }
#pragma unroll
                for (int ks = 0; ks < 4; ++ks) { S0 = MFMA32(kT[0][ks], vb[ks], S0); S1 = MFMA32(kT[1][ks], vb[ks], S1); }
                float* yo = YS + (size_t)(b * 2048 + n * 64) * 1024 + hd * 64 + 32 * nt + r;
#pragma unroll
                for (int i = 0; i < 16; ++i) { yo[(size_t)crow(i, hp) * 1024] = O0[i]; yo[(size_t)(32 + crow(i, hp)) * 1024] = O1[i]; }
            }
            float* dst = kp.out() + O_SSD_P + ((size_t)j * 4 + b) * ((size_t)16 * 64 * 64) + (size_t)hd * 64 * 64 + 32 * nt + r;
#pragma unroll
            for (int i = 0; i < 16; ++i) { dst[(size_t)crow(i, hp) * 64] = S0[i]; dst[(size_t)(32 + crow(i, hp)) * 64] = S1[i]; }
        } else if (kind == 0) {
            const int p = tid & 63, ng = tid >> 6, grp = h >> 2;
            const size_t SZ = (size_t)16 * 64 * 64;
            float S[8];
            if (s < 4) {
#pragma unroll
                for (int i = 0; i < 8; ++i) S[i] = 0.f;
            } else { const float* st = kp.in(5) + ((size_t)j * 128 + (s - 4)) * SZ + (size_t)h * 64 * 64;
#pragma unroll
                for (int i = 0; i < 8; ++i) S[i] = st[(size_t)(ng * 8 + i) * 64 + p]; }
            const float negA = -expf(kp.in(25)[j * 16 + h]);
            for (int t = 0; t < L; ++t) {
                const size_t r = (size_t)(row0 + t);
                if (tid < 64) bL[tid] = XBC[r * 1536 + 1024 + grp * 64 + tid]; else if (tid < 128) cL[tid - 64] = XBC[r * 1536 + 1280 + grp * 64 + (tid - 64)];
                const float xp = XBC[r * 1536 + h * 64 + p], dt = DT[r * 16 + h], a = expf(negA * dt), xdt = xp * dt;
                __syncthreads();
                float part = 0.f;
#pragma unroll
                for (int i = 0; i < 8; ++i) { const int n = ng * 8 + i; S[i] = a * S[i] + bL[n] * xdt; part += cL[n] * S[i]; }
                red[ng * 64 + p] = part;
                __syncthreads();
                if (ng == 0) { float y = 0.f;
#pragma unroll
                    for (int g = 0; g < 8; ++g) y += red[g * 64 + p];
                    YS[r * 1024 + h * 64 + p] = y; }
            }
            float* dst = s < 4 ? kp.out() + O_SSD_P + ((size_t)j * 4 + s) * SZ + (size_t)h * 64 * 64 : kp.out() + O_SSD_S + ((size_t)j * 128 + (s - 4)) * SZ + (size_t)h * 64 * 64;
#pragma unroll
            for (int i = 0; i < 8; ++i) dst[(size_t)(ng * 8 + i) * 64 + p] = S[i];
        } else {
            const int ch = h * 512 + tid;
            float hh = s < 4 ? 0.f : kp.in(7)[((size_t)j * 128 + (s - 4)) * 1024 + ch];
#pragma unroll 8
            for (int t = 0; t < L; ++t) { const size_t r = (size_t)(row0 + t); hh = LA[r * 1024 + ch] * hh + LB[r * 1024 + ch]; HS[r * 1024 + ch] = hh; }
            float* dst = s < 4 ? kp.out() + O_LRU_P + ((size_t)j * 4 + s) * 1024 : kp.out() + O_LRU_S + ((size_t)j * 128 + (s - 4)) * 1024;
            dst[ch] = hh;
        }
    }
}

__device__ __forceinline__ void phase_cd_post(const KP kp, const int bid, const int G, int j, int tid, int wave, int lane) {
    unsigned char* scr = kp.ws() + WS_SCR; const bf16* U = (const bf16*)(kp.ws() + WS_U); bf16* YM = (bf16*)(kp.ws() + WS_YM);
    const float* YS = (const float*)(scr + SC_YS); const float* HS = (const float*)(scr + SC_HS); const float* XBC = (const float*)(scr + SC_XBC);
    const float* sn = kp.in(28) + (size_t)j * 1024;
    for (int r = bid; r < T; r += G) {
        int s, t; row_to_seq(r, s, t); int row0, L; seq_info(s, row0, L);
        if (wave < 4) { float y[4]; float ss = 0.f;
#pragma unroll
            for (int i = 0; i < 4; ++i) { const int e = wave * 256 + lane + 64 * i; y[i] = (YS[(size_t)r * 1024 + e] + kp.in(27)[j * 16 + (e >> 6)] * XBC[(size_t)r * 1536 + e]) * silu_(bf2f(U[(size_t)r * NCD + e])); ss += y[i] * y[i]; }
            const float rstd = rsqrtf(wave_sum(ss) * (1.f / 256.f) + 1e-6f);
#pragma unroll
            for (int i = 0; i < 4; ++i) { const int e = wave * 256 + lane + 64 * i; YM[(size_t)r * DM + e] = (bf16)f2bf(y[i] * rstd * sn[e]); }
        } else {
#pragma unroll
            for (int i = 0; i < 4; ++i) { const int ch = (wave - 4) * 256 + lane + 64 * i;
                YM[(size_t)r * DM + 1024 + ch] = (bf16)f2bf(HS[(size_t)r * 1024 + ch] * silu_(bf2f(U[(size_t)r * NCD + 2560 + ch]))); }
        }
        if (t >= L - 3) { const int rr = t - (L - 3);
            float* d1 = s < 4 ? kp.out() + O_SSDC_P + (((size_t)j * 4 + s) * 3 + rr) * 1536 : kp.out() + O_SSDC_S + (((size_t)j * 128 + (s - 4)) * 3 + rr) * 1536;
            for (int c = tid; c < 1536; c += NTHR) d1[c] = bf2f(U[(size_t)r * NCD + 1024 + c]);
            float* d2 = s < 4 ? kp.out() + O_LRUC_P + (((size_t)j * 4 + s) * 3 + rr) * 1024 : kp.out() + O_LRUC_S + (((size_t)j * 128 + (s - 4)) * 3 + rr) * 1024;
            for (int c = tid; c < 1024; c += NTHR) d2[c] = bf2f(U[(size_t)r * NCD + 3584 + c]); }
    }
}

__global__ void __launch_bounds__(NTHR, 2) mega_fwd(Args A) {
    extern __shared__ __attribute__((aligned(16))) unsigned char lds_raw[];
    LAS unsigned char* lds = (LAS unsigned char*)lds_raw;
    const int G = gridDim.x;
    for (int ph = A.ph_lo; ph < A.ph_hi; ++ph) {
        KP kp; kp.p = (const char AS4*)__builtin_amdgcn_kernarg_segment_ptr(); asm volatile("" : "+s"(kp.p));
        unsigned char* ws = kp.ws();
        int tid = threadIdx.x; asm volatile("" : "+v"(tid));
        int bid = blockIdx.x; asm volatile("" : "+s"(bid));
        const int lane = tid & 63, wave = __builtin_amdgcn_readfirstlane(tid >> 6), gw = bid * NWAVES + wave, NGW = G * NWAVES;
        if (ph == 0) { if (PH_MASK & 1) phase_prologue(kp, lds, gw, NGW, wave, lane); }
        else {
            const int li = (ph - 1) / SUBS, sub = (ph - 1) % SUBS, j = li >> 1; const bool ab = (li & 1) == 0;
            if (sub == 0) {
                const int N = ab ? NAB : NCD;
                const bf16* Bt = ab ? (const bf16*)(ws + WS_WABIN) + (size_t)j * NAB * 2048 : (const bf16*)(ws + WS_WCDIN) + (size_t)j * NCD * 2048;
                pg8::Gemm g{(const bf16*)(ws + WS_XN), Bt, T, N, 2048}; pg8::StaticOrder S; S.init(T, N, G, bid);
                pg8::EpiBf16 E{(bf16*)(ws + WS_U), N};
                if (PH_MASK & 2) pg8::gemm_phase<pg8::EpiBf16, pg8::StaticOrder, true, true>(lds, g, S, E, tid);
            } else if (sub == 5 || sub == 7 || sub == 8) {
                const bf16* Am; const bf16* Bt; int K = 2048; float* C = (float*)(ws + WS_SCR + SC_C);
                if (sub == 5) { Am = (const bf16*)(ws + WS_YM); Bt = ab ? (const bf16*)(ws + WS_WABOUT) + (size_t)j * 2048 * 2048 : (const bf16*)(ws + WS_WCDOUT) + (size_t)j * 2048 * 2048; }
                else if (sub == 7) { Am = (const bf16*)(ws + WS_XN); Bt = (const bf16*)(ws + WS_WGATE) + (size_t)li * 2048 * 2048; }
                else { Am = (const bf16*)(ws + WS_PB) + (size_t)li * T * 256; Bt = (const bf16*)(ws + WS_WPROJ) + (size_t)li * 2048 * 256; K = 256; C = (float*)(ws + WS_SCR + SC_C2); }
                pg8::Gemm g{Am, Bt, T, 2048, K}; pg8::StaticOrder S; S.init(T, 2048, G, bid);
                pg8::EpiF32 E{C, 2048};
                if (PH_MASK & 4) pg8::gemm_phase<pg8::EpiF32, pg8::StaticOrder, true, true>(lds, g, S, E, tid);
            } else if (sub == 1) { if (ab) { if (PH_MASK & 8) phase_ab_pre(kp, bid, G, j, tid, wave, lane); } else { if (PH_MASK & 16) phase_cd_pre(kp, bid, G, j, lds, tid); } }
            else if (sub == 2) { if (!ab) { if (PH_MASK & 2048) phase_ssd_prep(kp, bid, G, j, lds, tid); } else { if (PH_MASK & 4096) phase_gla_prep(kp, bid, G, j, lds, tid); } }
            else if (sub == 3) { if (ab) { if (PH_MASK & 32) phase_ab_rec(kp, bid, G, j, lds, tid); } else { if (PH_MASK & 64) phase_cd_rec(kp, bid, G, j, lds, tid); } }
            else if (sub == 4) { if (ab) { if (PH_MASK & 128) phase_ab_post(kp, bid, G, j, tid, wave, lane); } else { if (PH_MASK & 256) phase_cd_post(kp, bid, G, j, tid, wave, lane); } }
            else if (sub == 6) { if (PH_MASK & 512) phase_res1(kp, li, gw, NGW, lane); }
            else { if (PH_MASK & 1024) phase_res2(kp, li, gw, NGW, lane); }
        }
        if (ph + 1 < A.ph_hi) { cg::this_grid().sync(); }
    }
}

extern "C" void kernel_launch(void* const* d_in, const int* in_sizes, int n_in, void* d_out, int out_size, void* d_ws, size_t ws_size, hipStream_t stream) {
    static int grid = 0;
    if (grid == 0) {
        if (n_in != 40 || (size_t)out_size != O_END || ws_size < WS_END) { fprintf(stderr, "kernel_launch: unexpected shapes: n_in %d out %d ws %zu\n", n_in, out_size, ws_size); grid = -1; return; }
        int dev = 0, cus = 0, per_cu = 0;
        if (hipGetDevice(&dev) != hipSuccess || hipDeviceGetAttribute(&cus, hipDeviceAttributeMultiprocessorCount, dev) != hipSuccess) { grid = -1; return; }
        if (hipFuncSetAttribute((const void*)mega_fwd, hipFuncAttributeMaxDynamicSharedMemorySize, LDS_BYTES) != hipSuccess) { fprintf(stderr, "kernel_launch: hipFuncSetAttribute failed\n"); grid = -1; return; }
        if (hipOccupancyMaxActiveBlocksPerMultiprocessor(&per_cu, (const void*)mega_fwd, NTHR, LDS_BYTES) != hipSuccess || per_cu < 1) { fprintf(stderr, "kernel_launch: occupancy query says %d\n", per_cu); per_cu = 1; }
        (void)hipGetLastError();
        grid = cus;
    }
    if (grid < 0) return;
    Args a{};
    for (int i = 0; i < 40; ++i) a.in[i] = (const float*)d_in[i];
    a.out = (float*)d_out; a.ws = (unsigned char*)d_ws;
#if MK_N_LAUNCHES == 1
    a.ph_lo = 0; a.ph_hi = N_PHASES;
    void* args[] = {&a};
    hipError_t e = hipLaunchCooperativeKernel((const void*)mega_fwd, dim3(grid), dim3(NTHR), args, LDS_BYTES, stream);
    if (e != hipSuccess) fprintf(stderr, "cooperative launch failed: %s (grid %d)\n", hipGetErrorString(e), grid);
#else
    for (int ph = 0; ph < N_PHASES; ++ph) { a.ph_lo = ph; a.ph_hi = ph + 1; mega_fwd<<<dim3(grid), dim3(NTHR), LDS_BYTES, stream>>>(a); }
#endif
}
```

```cpp
#include <hip/hip_runtime.h>
#include <hip/hip_cooperative_groups.h>
#include <cstdio>
#include <cstdint>
namespace cg = cooperative_groups;

#ifndef MK_N_LAUNCHES
#define MK_N_LAUNCHES 1
#endif

namespace pg8 {
#define PG8_LAS __attribute__((address_space(3)))
typedef unsigned short bf16_t;
typedef short bf16x8 __attribute__((ext_vector_type(8)));
typedef float f32x4 __attribute__((ext_vector_type(4)));
typedef unsigned u32x4 __attribute__((ext_vector_type(4)));
constexpr int BM = 256, BK = 64, HALF = 128, HTB = HALF * BK * 2  , STAGE_BYTES = 8 * HTB, NXCD = 8, WGM = 8;

__host__ __device__ __forceinline__ int lds_byte(int r, int c) { const int st = (r >> 4) * 2 + (c >> 5), rr = r & 15, cc = c & 31, ob = rr * 64 + cc * 2; return st * 1024 + (ob ^ (((ob >> 9) & 1) << 5)); }
__host__ __device__ __forceinline__ void stage_rc(int b, int& R, int& C) { const int st = b / 1024, sb = b % 1024, swz = sb ^ (((sb >> 9) & 1) << 5); R = (st >> 1) * 16 + swz / 64; C = (st & 1) * 32 + (swz % 64) / 2; }
__host__ __device__ __forceinline__ int perm32(int rho) { const int n = rho >> 4, i = rho & 15; return 8 * (i >> 2) + 4 * n + (i & 3); }

struct Unit { int pm, pn; };
struct Gemm { const bf16_t* A; const bf16_t* Bt; int M, N, K; };

struct StaticOrder {
    int nM, nN, nwg, G, c;
    __host__ __device__ void init(int M, int N, int G_, int c_) { nM = M / BM; nN = N / BM; nwg = nM * nN; G = G_; c = c_; }
    __host__ __device__ bool next(int i, Unit& u) const {
        const long L = (long)i * G + c; if (L >= nwg) return false;
        int wgid = (int)L; { const int q = nwg / NXCD, r = nwg % NXCD, xcd = wgid % NXCD, off = wgid / NXCD; wgid = (xcd < r ? xcd * (q + 1) : r * (q + 1) + (xcd - r) * q) + off; }
        const int nig = WGM * nN, gid = wgid / nig, fm = gid * WGM, gsz = (nM - fm) < WGM ? (nM - fm) : WGM;
        u.pm = fm + ((wgid % nig) % gsz); u.pn = (wgid % nig) / gsz; return true;
    }
    __device__ __forceinline__ void a_ready(const Unit&) const {}
    __device__ __forceinline__ void done(const Unit&) const {}
};

__device__ __forceinline__ unsigned cvt_pk_bf16(float lo, float hi) { unsigned r; asm volatile("v_cvt_pk_bf16_f32 %0, %1, %2" : "=v"(r) : "v"(lo), "v"(hi)); return r; }
struct EpiF32 {
    static constexpr bool PERM = false, AFTER_DRAIN = false;
    float* C; int ldc;
    __device__ __forceinline__ void operator()(const f32x4 (&acc)[2][2][4][2], const Unit& u, int wr, int wc, int fr, int fq) const {
        const int row0 = u.pm * BM + wr * 64 + fr, col0 = u.pn * BM + wc * 32 + 4 * fq;
#pragma unroll
        for (int ai = 0; ai < 2; ++ai)
#pragma unroll
            for (int m = 0; m < 4; ++m) { float* rowp = C + (size_t)(row0 + ai * HALF + m * 16) * ldc + col0;
#pragma unroll
                for (int bj = 0; bj < 2; ++bj)
#pragma unroll
                    for (int n = 0; n < 2; ++n) *(f32x4*)(rowp + bj * HALF + n * 16) = acc[ai][bj][m][n]; }
    }
};
struct EpiBf16 {
    static constexpr bool PERM = true, AFTER_DRAIN = false;
    bf16_t* O; int ldc;
    __device__ __forceinline__ void operator()(const f32x4 (&acc)[2][2][4][2], const Unit& u, int wr, int wc, int fr, int fq) const {
        const int row0 = u.pm * BM + wr * 64 + fr; const int col0 = u.pn * BM + wc * 32 + 8 * fq;
#pragma unroll
        for (int ai = 0; ai < 2; ++ai)
#pragma unroll
            for (int m = 0; m < 4; ++m) { bf16_t* rowp = O + (size_t)(row0 + ai * HALF + m * 16) * ldc + col0;
#pragma unroll
                for (int bj = 0; bj < 2; ++bj) { const f32x4 v0 = acc[ai][bj][m][0], v1 = acc[ai][bj][m][1];
                    u32x4 w; w.x = cvt_pk_bf16(v0[0], v0[1]); w.y = cvt_pk_bf16(v0[2], v0[3]); w.z = cvt_pk_bf16(v1[0], v1[1]); w.w = cvt_pk_bf16(v1[2], v1[3]);
                    *(u32x4*)(rowp + bj * HALF) = w; } }
    }
};
template <class Epi, class Sched, bool ALIGN_EPI = false, bool SP2 = false>
__device__ __forceinline__ void gemm_phase(PG8_LAS unsigned char* lds, const Gemm g, const Sched& S, const Epi& E, const int tid) {
    const int wid = __builtin_amdgcn_readfirstlane(tid >> 6), lane = tid & 63, wr = wid >> 2, wc = wid & 3, fr = lane & 15, fq = lane >> 4;
    const int K = g.K, nt = K / BK;
    unsigned voffA[2], voffB[2];
#pragma unroll
    for (int i = 0; i < 2; ++i) { int R, C; stage_rc(tid * 16 + i * 8192, R, C); const int Rb = Epi::PERM ? ((R & ~31) + perm32(R & 31)) : R;
        voffA[i] = (unsigned)(R * K + C) * 2u; voffB[i] = (unsigned)(Rb * K + C) * 2u; }
    const size_t kstep = (size_t)(BK * 2);
    const size_t hstep = (size_t)HALF * K * 2;
    const size_t tstep = 2 * hstep;
    const unsigned ldsw = (unsigned)wid * 1024u;
    const int aoff = lds_byte(wr * 64 + fr, fq * 8), boff = lds_byte(wc * 32 + fr, fq * 8);
#define PG8_SA(b, h) (((b) * 2 + (h)) * HTB)
#define PG8_SB(b, h) ((4 + (b) * 2 + (h)) * HTB)
#define PG8_STAGE(bufoff, gbase, voff) do { _Pragma("unroll") for (int _i = 0; _i < 2; ++_i) \
        __builtin_amdgcn_global_load_lds((const unsigned*)((const char*)(gbase) + (voff)[_i]), (PG8_LAS unsigned*)(lds + (bufoff) + ldsw + _i * 8192), 16, 0, 0); } while (0)
#define PG8_LDA(dst, b, h) do { _Pragma("unroll") for (int m = 0; m < 4; ++m) _Pragma("unroll") for (int k = 0; k < 2; ++k) dst[m][k] = *(const PG8_LAS bf16x8*)(lds + PG8_SA(b, h) + aoff + m * 2048 + k * 1024); } while (0)
#define PG8_LDB(dst, b, h) do { _Pragma("unroll") for (int n = 0; n < 2; ++n) _Pragma("unroll") for (int k = 0; k < 2; ++k) dst[n][k] = *(const PG8_LAS bf16x8*)(lds + PG8_SB(b, h) + boff + n * 2048 + k * 1024); } while (0)
#define PG8_MMA(ai, bj, At, Bt) do { __builtin_amdgcn_s_setprio(1); _Pragma("unroll") for (int m = 0; m < 4; ++m) _Pragma("unroll") for (int n = 0; n < 2; ++n) _Pragma("unroll") for (int k = 0; k < 2; ++k) \
        acc[ai][bj][m][n] = __builtin_amdgcn_mfma_f32_16x16x32_bf16(Bt[n][k], At[m][k], acc[ai][bj][m][n], 0, 0, 0); __builtin_amdgcn_s_setprio(0); } while (0)
#define PG8_WAIT_V(n) asm volatile("s_waitcnt vmcnt(" #n ")" ::: "memory")
#define PG8_WAIT_L(n) asm volatile("s_waitcnt lgkmcnt(" #n ")" ::: "memory")
#define PG8_BAR __builtin_amdgcn_s_barrier()
#define PG8_SCHED __builtin_amdgcn_sched_barrier(0)
    Unit cur, nxt; int ui = 0;
    if (!S.next(0, cur)) return;
    f32x4 acc[2][2][4][2];
#pragma unroll
    for (int a = 0; a < 2; ++a)
#pragma unroll
        for (int b = 0; b < 2; ++b)
#pragma unroll
            for (int m = 0; m < 4; ++m)
#pragma unroll
                for (int n = 0; n < 2; ++n) acc[a][b][m][n] = (f32x4){0.f, 0.f, 0.f, 0.f};
    bf16x8 At[4][2], B0[2][2], B1[2][2];
    const char* cA = (const char*)g.A + (size_t)cur.pm * tstep; const char* cB = (const char*)g.Bt + (size_t)cur.pn * tstep;
    S.a_ready(cur);
    if constexpr (SP2) {
        PG8_STAGE(PG8_SB(0, 0), cB, voffB); PG8_STAGE(PG8_SB(0, 1), cB + hstep, voffB); PG8_STAGE(PG8_SA(0, 0), cA, voffA); PG8_STAGE(PG8_SA(0, 1), cA + hstep, voffA);
        if (wr == 1) PG8_BAR;
        PG8_WAIT_V(2); PG8_BAR;
        PG8_STAGE(PG8_SB(1, 0), cB + kstep, voffB); PG8_STAGE(PG8_SA(1, 0), cA + kstep, voffA); PG8_STAGE(PG8_SB(1, 1), cB + hstep + kstep, voffB);
        PG8_WAIT_V(6); PG8_BAR;
    } else {
        PG8_STAGE(PG8_SB(0, 0), cB, voffB); PG8_STAGE(PG8_SA(0, 0), cA, voffA); PG8_STAGE(PG8_SB(0, 1), cB + hstep, voffB); PG8_STAGE(PG8_SA(0, 1), cA + hstep, voffA);
        if (wr == 1) PG8_BAR;
        PG8_WAIT_V(4); PG8_BAR;
        PG8_STAGE(PG8_SB(1, 0), cB + kstep, voffB); PG8_STAGE(PG8_SA(1, 0), cA + kstep, voffA); PG8_STAGE(PG8_SB(1, 1), cB + hstep + kstep, voffB);
        PG8_WAIT_V(6); PG8_BAR;
    }
    for (;;) {
        const bool has_next = S.next(ui + 1, nxt);
        const char* nA = has_next ? (const char*)g.A + (size_t)nxt.pm * tstep : cA; const char* nB = has_next ? (const char*)g.Bt + (size_t)nxt.pn * tstep : cB;
        for (int t = 0; t < nt; t += 2) {
            const bool last = (t == nt - 2);
            const char* a1 = cA + (size_t)(t + 1) * kstep;
            const char* a2 = last ? nA : cA + (size_t)(t + 2) * kstep; const char* b2 = last ? nB : cB + (size_t)(t + 2) * kstep;
            const char* a3 = a2 + kstep; const char* b3 = b2 + kstep;
            if (last && has_next) S.a_ready(nxt);
            if constexpr (SP2) {
            PG8_LDB(B0, 0, 0); PG8_LDB(B1, 0, 1); PG8_SCHED; PG8_LDA(At, 0, 0); PG8_STAGE(PG8_SA(1, 1), a1 + hstep, voffA);
            PG8_WAIT_V(8); PG8_WAIT_L(0); PG8_BAR; PG8_MMA(0, 0, At, B0); PG8_MMA(0, 1, At, B1); PG8_BAR; PG8_SCHED;
            PG8_LDA(At, 0, 1); PG8_STAGE(PG8_SB(0, 0), b2, voffB); PG8_STAGE(PG8_SB(0, 1), b2 + hstep, voffB); PG8_STAGE(PG8_SA(0, 0), a2, voffA);
            PG8_WAIT_V(8); PG8_WAIT_L(0); PG8_BAR; PG8_MMA(1, 0, At, B0); PG8_MMA(1, 1, At, B1); PG8_BAR; PG8_SCHED;
            PG8_LDB(B0, 1, 0); PG8_LDB(B1, 1, 1); PG8_SCHED; PG8_LDA(At, 1, 0); PG8_STAGE(PG8_SA(0, 1), a2 + hstep, voffA);
            PG8_WAIT_V(8); PG8_WAIT_L(0); PG8_BAR; PG8_MMA(0, 0, At, B0); PG8_MMA(0, 1, At, B1); PG8_BAR; PG8_SCHED;
            PG8_LDA(At, 1, 1); PG8_STAGE(PG8_SB(1, 0), b3, voffB); PG8_STAGE(PG8_SB(1, 1), b3 + hstep, voffB); PG8_STAGE(PG8_SA(1, 0), a3, voffA);
            PG8_WAIT_V(8); PG8_WAIT_L(0); PG8_BAR; PG8_MMA(1, 0, At, B0); PG8_MMA(1, 1, At, B1); PG8_BAR; PG8_SCHED;
            } else {
            PG8_LDB(B0, 0, 0); PG8_SCHED; PG8_LDA(At, 0, 0); PG8_STAGE(PG8_SA(1, 1), a1 + hstep, voffA);
            PG8_WAIT_L(8); PG8_BAR; PG8_WAIT_L(0); PG8_MMA(0, 0, At, B0); PG8_BAR; PG8_SCHED;
            PG8_LDB(B1, 0, 1); PG8_STAGE(PG8_SB(0, 0), b2, voffB);
            PG8_BAR; PG8_WAIT_L(0); PG8_MMA(0, 1, At, B1); PG8_BAR;
            PG8_LDA(At, 0, 1); PG8_STAGE(PG8_SA(0, 0), a2, voffA);
            PG8_BAR; PG8_WAIT_L(0); PG8_MMA(1, 0, At, B0); PG8_BAR; PG8_SCHED;
            PG8_STAGE(PG8_SB(0, 1), b2 + hstep, voffB);
            PG8_WAIT_V(6); PG8_BAR; PG8_MMA(1, 1, At, B1); PG8_BAR;
            PG8_LDB(B0, 1, 0); PG8_SCHED; PG8_LDA(At, 1, 0); PG8_STAGE(PG8_SA(0, 1), a2 + hstep, voffA);
            PG8_WAIT_L(8); PG8_BAR; PG8_WAIT_L(0); PG8_MMA(0, 0, At, B0); PG8_BAR; PG8_SCHED;
            PG8_LDB(B1, 1, 1); PG8_STAGE(PG8_SB(1, 0), b3, voffB);
            PG8_BAR; PG8_WAIT_L(0); PG8_MMA(0, 1, At, B1); PG8_BAR;
            PG8_LDA(At, 1, 1); PG8_STAGE(PG8_SA(1, 0), a3, voffA);
            PG8_BAR; PG8_WAIT_L(0); PG8_MMA(1, 0, At, B0); PG8_BAR; PG8_SCHED;
            PG8_STAGE(PG8_SB(1, 1), b3 + hstep, voffB);
            PG8_WAIT_V(6); PG8_BAR; PG8_MMA(1, 1, At, B1); PG8_BAR;
            }
        }
        if constexpr (ALIGN_EPI) { if (wr == 0) PG8_BAR; }
        if constexpr (!Epi::AFTER_DRAIN) { E(acc, cur, wr, wc, fr, fq); S.done(cur); }
        if (!has_next) break;
#pragma unroll
        for (int a = 0; a < 2; ++a)
#pragma unroll
            for (int b = 0; b < 2; ++b)
#pragma unroll
                for (int m = 0; m < 4; ++m)
#pragma unroll
                    for (int n = 0; n < 2; ++n) acc[a][b][m][n] = (f32x4){0.f, 0.f, 0.f, 0.f};
        cur = nxt; cA = nA; cB = nB; ++ui;
        if constexpr (ALIGN_EPI) { if (wr == 1) PG8_BAR; }
    }
    PG8_WAIT_V(0);
    if constexpr (!ALIGN_EPI) { if (wr == 0) PG8_BAR; }
    PG8_BAR;
    if constexpr (Epi::AFTER_DRAIN) { E.fused(acc, cur, wr, wc, fr, fq, lds, wid, lane); S.done(cur); }
#undef PG8_SA
#undef PG8_SB
#undef PG8_STAGE
#undef PG8_LDA
#undef PG8_LDB
#undef PG8_MMA
#undef PG8_WAIT_V
#undef PG8_WAIT_L
#undef PG8_BAR
#undef PG8_SCHED
}
}

constexpr int TP = 8192, TS = 512, T = TP + TS, DM = 2048, NSEQ = 132;
constexpr int NAB = 7424, NCD = 4864;
constexpr int NWAVES = 8, NTHR = 512;
constexpr size_t MiB = 1u << 20;
constexpr size_t WS_CTL = 0, CTL_ZERO_BYTES = 1 * MiB;
constexpr size_t WS_WABIN = 2 * MiB, WS_WABOUT = 60 * MiB, WS_WCDIN = 76 * MiB, WS_WCDOUT = 114 * MiB, WS_WGATE = 130 * MiB, WS_WPROJ = 162 * MiB;
constexpr size_t WS_H = 166 * MiB, WS_XN = 234 * MiB, WS_YM = 268 * MiB, WS_PB = 302 * MiB, WS_U = 320 * MiB, WS_SCR = 444 * MiB, WS_END = 712 * MiB;
constexpr size_t SC_C = 0, SC_C2 = 68 * MiB;
constexpr size_t SC_QN = 0, SC_KN = 34 * MiB, SC_VV = 68 * MiB, SC_ODN = 102 * MiB, SC_OGLA = 136 * MiB, SC_GLOG = 170 * MiB, SC_BETA = 187 * MiB, SC_GDEC = 188 * MiB, SC_DNOPS = 192 * MiB, SC_DNGEND = 264 * MiB;
constexpr size_t SC_XBC = 0, SC_LA = 52 * MiB, SC_LB = 86 * MiB, SC_YS = 120 * MiB, SC_HS = 154 * MiB, SC_DT = 188 * MiB, SC_SSDOP = 192 * MiB, SC_GEND = 256 * MiB;
constexpr int LDS_BYTES = 163840;
constexpr size_t O_Y_P = 0, O_Y_S = O_Y_P + (size_t)4 * 2048 * 2048, O_DN_P = O_Y_S + (size_t)128 * 4 * 2048,
    O_DNC_P = O_DN_P + (size_t)2 * 4 * 8 * 128 * 128, O_GLA_P = O_DNC_P + (size_t)2 * 4 * 3 * 3072, O_SSD_P = O_GLA_P + (size_t)2 * 4 * 4 * 128 * 256,
    O_SSDC_P = O_SSD_P + (size_t)2 * 4 * 16 * 64 * 64, O_LRU_P = O_SSDC_P + (size_t)2 * 4 * 3 * 1536, O_LRUC_P = O_LRU_P + (size_t)2 * 4 * 1024,
    O_DN_S = O_LRUC_P + (size_t)2 * 4 * 3 * 1024, O_DNC_S = O_DN_S + (size_t)2 * 128 * 8 * 128 * 128, O_GLA_S = O_DNC_S + (size_t)2 * 128 * 3 * 3072,
    O_SSD_S = O_GLA_S + (size_t)2 * 128 * 4 * 128 * 256, O_SSDC_S = O_SSD_S + (size_t)2 * 128 * 16 * 64 * 64, O_LRU_S = O_SSDC_S + (size_t)2 * 128 * 3 * 1536,
    O_LRUC_S = O_LRU_S + (size_t)2 * 128 * 1024, O_END = O_LRUC_S + (size_t)2 * 128 * 3 * 1024;
static_assert(O_END == 109064192, "output size");

#define LAS __attribute__((address_space(3)))
typedef unsigned short bf16;
typedef float f32x4 __attribute__((ext_vector_type(4)));
typedef unsigned u32x2 __attribute__((ext_vector_type(2)));
typedef unsigned u32x4 __attribute__((ext_vector_type(4)));
#define LDS_WAIT() asm volatile("s_waitcnt lgkmcnt(0)" ::: "memory")

__device__ __forceinline__ float bf2f(bf16 b) { return __uint_as_float(((unsigned)b) << 16); }
__device__ __forceinline__ unsigned f2bf(float f) { unsigned u = __float_as_uint(f); return (u + 0x7fffu + ((u >> 16) & 1u)) >> 16; }
__device__ __forceinline__ unsigned pk2(float lo, float hi) { return f2bf(lo) | (f2bf(hi) << 16); }
__device__ __forceinline__ float sigmoid_(float x) { return 1.f / (1.f + expf(-x)); }
__device__ __forceinline__ float silu_(float x) { return x / (1.f + expf(-x)); }
__device__ __forceinline__ float softplus_(float x) { return x > 20.f ? x : log1pf(expf(x)); }
__device__ __forceinline__ float wave_sum(float v) {
#pragma unroll
    for (int o = 1; o < 64; o <<= 1) v += __shfl_xor(v, o);
    return v;
}
__device__ __forceinline__ void row_to_seq(int r, int& s, int& t) { if (r < TP) { s = r >> 11; t = r & 2047; } else { s = 4 + ((r - TP) >> 2); t = (r - TP) & 3; } }
__device__ __forceinline__ void seq_info(int s, int& row0, int& L) { if (s < 4) { row0 = s << 11; L = 2048; } else { row0 = TP + ((s - 4) << 2); L = 4; } }
__device__ __forceinline__ float pre_val(const bf16* U, int ldu, int ucol, int row0, int tt, int s, const float* stc, int W, int c) {
    if (tt >= 0) return bf2f(U[(size_t)(row0 + tt) * ldu + ucol]);
    if (s < 4) return 0.f;
    return stc[((size_t)(s - 4) * 3 + (3 + tt)) * W + c];
}
__device__ __forceinline__ int map_col(int mapid, int n) {
    if (mapid == 0) return n;
    if (mapid == 1) { if (n < 3072) return n; if (n < 6144) return n + 16; if (n < 7168) return n + 32; if (n < 7184) return n - 4096; if (n < 7200) return n - 1024; return -1; }
    if (n < 2560) return n; if (n < 4608) return n + 16; if (n < 4624) return n - 2048; return -1;
}
__device__ __forceinline__ void transpose_item(const float* W, int K, int Nsrc, bf16* WT, int Npad, int mapid, LAS float* scr, int item, int lane) {
    const int nblk = Npad / 32, kb = item / nblk, nb = item % nblk, k0 = 64 * kb, n0 = 32 * nb;
    const int src = map_col(mapid, n0 + (lane & 31));
#pragma unroll 8
    for (int i = 0; i < 32; ++i) { const int kk = 2 * i + (lane >> 5); scr[kk * 33 + (lane & 31)] = src >= 0 ? W[(size_t)(k0 + kk) * Nsrc + src] : 0.f; }
    LDS_WAIT(); asm volatile("" ::: "memory");
    const int c = lane & 7;
#pragma unroll
    for (int j = 0; j < 4; ++j) { const int n = (lane >> 3) + 8 * j; const LAS float* s = scr + (8 * c) * 33 + n;
        u32x4 o; o.x = pk2(s[0 * 33], s[1 * 33]); o.y = pk2(s[2 * 33], s[3 * 33]); o.z = pk2(s[4 * 33], s[5 * 33]); o.w = pk2(s[6 * 33], s[7 * 33]);
        *(u32x4*)(WT + (size_t)(n0 + n) * K + k0 + 8 * c) = o; }
    LDS_WAIT(); asm volatile("" ::: "memory");
}
__device__ __forceinline__ void norm_row_bf16(const f32x4 (&v)[8], const float* g, bf16* orow, int lane) {
    float ss = 0.f;
#pragma unroll
    for (int j = 0; j < 8; ++j) ss += (v[j].x * v[j].x + v[j].y * v[j].y) + (v[j].z * v[j].z + v[j].w * v[j].w);
    const float rstd = rsqrtf(wave_sum(ss) * (1.f / DM) + 1e-6f);
#pragma unroll
    for (int j = 0; j < 8; ++j) { const int col = 4 * (lane + 64 * j); const f32x4 gg = *(const f32x4*)(g + col);
        u32x2 o; o.x = pk2(v[j].x * rstd * gg.x, v[j].y * rstd * gg.y); o.y = pk2(v[j].z * rstd * gg.z, v[j].w * rstd * gg.w);
        *(u32x2*)(orow + col) = o; }
}

typedef __bf16 bf16x2_t __attribute__((ext_vector_type(2)));
typedef float f32x2_t __attribute__((ext_vector_type(2)));
typedef short bf16x8 __attribute__((ext_vector_type(8)));
typedef float f32x16 __attribute__((ext_vector_type(16)));
__device__ __forceinline__ unsigned cvtpk(float lo, float hi) { f32x2_t v = {lo, hi}; bf16x2_t b = __builtin_convertvector(v, bf16x2_t); return __builtin_bit_cast(unsigned, b); }
#define MFMA32(a, b, c) __builtin_amdgcn_mfma_f32_32x32x16_bf16((a), (b), (c), 0, 0, 0)
#define PACK_ACC(x, S_) __builtin_bit_cast(bf16x8, (u32x4){cvtpk((x)[8 * (S_)], (x)[8 * (S_) + 1]), cvtpk((x)[8 * (S_) + 2], (x)[8 * (S_) + 3]), cvtpk((x)[8 * (S_) + 4], (x)[8 * (S_) + 5]), cvtpk((x)[8 * (S_) + 6], (x)[8 * (S_) + 7])})
__device__ __forceinline__ int crow(int reg, int h) { return (reg & 3) + 8 * (reg >> 2) + 4 * h; }
__device__ __forceinline__ bf16x8 pack8(const float (&v)[8]) { return __builtin_bit_cast(bf16x8, (u32x4){cvtpk(v[0], v[1]), cvtpk(v[2], v[3]), cvtpk(v[4], v[5]), cvtpk(v[6], v[7])}); }

struct Args { const float* in[40]; float* out; unsigned char* ws; int ph_lo, ph_hi; };
constexpr int N_PHASES = 41, SUBS = 10;
#ifndef PH_MASK
#define PH_MASK 16383
#endif
#define AS4 __attribute__((address_space(4)))
struct KP { const char AS4* p;
    __device__ __forceinline__ const float* in(int i) const { return *(const float* const AS4*)(p + 8 * i); }
    __device__ __forceinline__ float* out() const { return *(float* const AS4*)(p + 320); }
    __device__ __forceinline__ unsigned char* ws() const { return *(unsigned char* const AS4*)(p + 328); }
};
static_assert(sizeof(Args) == 344, "Args layout");

__device__ __forceinline__ void phase_prologue(const KP kp, LAS unsigned char* lds, int gw, int NGW, int wave, int lane) {
    unsigned char* ws = kp.ws();
    LAS float* scr = (LAS float*)(lds + wave * 16384);
    for (int job = 0; job < 16; ++job) {
        const float* W; int K = 2048, Nsrc = 2048, Npad = 2048, mapid = 0; bf16* WT;
        if (job < 2)       { W = kp.in(13) + (size_t)job * 2048 * 7200; Nsrc = 7200; Npad = NAB; mapid = 1; WT = (bf16*)(ws + WS_WABIN) + (size_t)job * NAB * 2048; }
        else if (job < 4)  { W = kp.in(21) + (size_t)(job - 2) * 2048 * 2048; WT = (bf16*)(ws + WS_WABOUT) + (size_t)(job - 2) * 2048 * 2048; }
        else if (job < 6)  { W = kp.in(22) + (size_t)(job - 4) * 2048 * 4624; Nsrc = 4624; Npad = NCD; mapid = 2; WT = (bf16*)(ws + WS_WCDIN) + (size_t)(job - 4) * NCD * 2048; }
        else if (job < 8)  { W = kp.in(36) + (size_t)(job - 6) * 2048 * 2048; WT = (bf16*)(ws + WS_WCDOUT) + (size_t)(job - 6) * 2048 * 2048; }
        else if (job < 12) { W = kp.in(39) + (size_t)(job - 8) * 2048 * 2048; WT = (bf16*)(ws + WS_WGATE) + (size_t)(job - 8) * 2048 * 2048; }
        else               { W = kp.in(37) + (size_t)(job - 12) * 256 * 2048; K = 256; WT = (bf16*)(ws + WS_WPROJ) + (size_t)(job - 12) * 2048 * 256; }
        const int nitems = (K / 64) * (Npad / 32);
        for (int it = gw; it < nitems; it += NGW) transpose_item(W, K, Nsrc, WT, Npad, mapid, scr, it, lane);
    }
    float* H = (float*)(ws + WS_H); bf16* XN = (bf16*)(ws + WS_XN);
    for (int m = gw; m < T; m += NGW) {
        const float* src = m < TP ? kp.in(0) + (size_t)m * DM : kp.in(1) + (size_t)(m - TP) * DM;
        f32x4 v[8];
#pragma unroll
        for (int j = 0; j < 8; ++j) { v[j] = *(const f32x4*)(src + 4 * (lane + 64 * j)); *(f32x4*)(H + (size_t)m * DM + 4 * (lane + 64 * j)) = v[j]; }
        norm_row_bf16(v, kp.in(11), XN + (size_t)m * DM, lane);
    }
    bf16* PB = (bf16*)(ws + WS_PB);
    const int gt = gw * 64 + lane, NGT = NGW * 64;
    for (int i = gt; i < 4 * T * 64; i += NGT) {
        const int c4 = i & 63, r = (i >> 6) % T, li = (i >> 6) / T;
        const float* src = r < TP ? kp.in(9) + ((size_t)li * TP + r) * 256 + 4 * c4 : kp.in(10) + ((size_t)li * TS + (r - TP)) * 256 + 4 * c4;
        const f32x4 v = *(const f32x4*)src;
        u32x2 o; o.x = pk2(v.x, v.y); o.y = pk2(v.z, v.w);
        *(u32x2*)(PB + ((size_t)li * T + r) * 256 + 4 * c4) = o;
    }
}

__device__ __forceinline__ void phase_res1(const KP kp, int li, int gw, int NGW, int lane) {
    float* H = (float*)(kp.ws() + WS_H); bf16* XN = (bf16*)(kp.ws() + WS_XN); const float* C = (const float*)(kp.ws() + WS_SCR + SC_C);
    for (int m = gw; m < T; m += NGW) {
        f32x4 v[8];
#pragma unroll
        for (int j = 0; j < 8; ++j) { const size_t o = (size_t)m * DM + 4 * (lane + 64 * j); v[j] = *(const f32x4*)(H + o) + *(const f32x4*)(C + o); *(f32x4*)(H + o) = v[j]; }
        norm_row_bf16(v, kp.in(38) + (size_t)li * DM, XN + (size_t)m * DM, lane);
    }
}
__device__ __forceinline__ void phase_res2(const KP kp, int li, int gw, int NGW, int lane) {
    float* H = (float*)(kp.ws() + WS_H); bf16* XN = (bf16*)(kp.ws() + WS_XN); const float* C = (const float*)(kp.ws() + WS_SCR + SC_C); const float* C2 = (const float*)(kp.ws() + WS_SCR + SC_C2);
    for (int m = gw; m < T; m += NGW) {
        f32x4 v[8];
#pragma unroll
        for (int j = 0; j < 8; ++j) { const size_t o = (size_t)m * DM + 4 * (lane + 64 * j); const f32x4 c = *(const f32x4*)(C + o), c2 = *(const f32x4*)(C2 + o); f32x4 h = *(const f32x4*)(H + o);
            h.x += sigmoid_(c.x) * c2.x; h.y += sigmoid_(c.y) * c2.y; h.z += sigmoid_(c.z) * c2.z; h.w += sigmoid_(c.w) * c2.w; v[j] = h; *(f32x4*)(H + o) = h; }
        if (li < 3) norm_row_bf16(v, kp.in(11) + (size_t)(li + 1) * DM, XN + (size_t)m * DM, lane);
        else {
            float ss = 0.f;
#pragma unroll
            for (int j = 0; j < 8; ++j) ss += (v[j].x * v[j].x + v[j].y * v[j].y) + (v[j].z * v[j].z + v[j].w * v[j].w);
            const float rstd = rsqrtf(wave_sum(ss) * (1.f / DM) + 1e-6f);
#pragma unroll
            for (int j = 0; j < 8; ++j) { const int col = 4 * (lane + 64 * j); const f32x4 gg = *(const f32x4*)(kp.in(12) + col);
                f32x4 o; o.x = v[j].x * rstd * gg.x; o.y = v[j].y * rstd * gg.y; o.z = v[j].z * rstd * gg.z; o.w = v[j].w * rstd * gg.w;
                *(f32x4*)(kp.out() + (size_t)m * DM + col) = o; }
        }
    }
}

__device__ __forceinline__ void phase_ab_pre(const KP kp, const int bid, const int G, int j, int tid, int wave, int lane) {
    unsigned char* scr = kp.ws() + WS_SCR; const bf16* U = (const bf16*)(kp.ws() + WS_U);
    float* QN = (float*)(scr + SC_QN); float* KN = (float*)(scr + SC_KN); float* VV = (float*)(scr + SC_VV);
    float* GLOG = (float*)(scr + SC_GLOG); float* BETA = (float*)(scr + SC_BETA); float* GDEC = (float*)(scr + SC_GDEC);
    const float* cw = kp.in(14) + (size_t)j * 4 * 3072; const float* stc = kp.in(3) + (size_t)j * 128 * 3 * 3072;
    const float* wa2 = kp.in(18) + (size_t)j * 16 * 512; const float* ba = kp.in(19) + (size_t)j * 512;
    for (int r = bid; r < T; r += G) {
        int s, t; row_to_seq(r, s, t); const int row0 = r - t;
#pragma unroll
        for (int part = 0; part < 3; ++part) {
            float val[2];
#pragma unroll
            for (int i = 0; i < 2; ++i) { const int c = part * 1024 + wave * 128 + lane + 64 * i; float acc = 0.f;
#pragma unroll
                for (int tap = 0; tap < 4; ++tap) acc += cw[tap * 3072 + c] * pre_val(U, NAB, c, row0, t - 3 + tap, s, stc, 3072, c);
                val[i] = silu_(acc); }
            if (part < 2) { const float ss = wave_sum(val[0] * val[0] + val[1] * val[1]); const float sc = rsqrtf(ss + 1e-6f) * (part == 0 ? 0.08838834764831845f : 1.f); val[0] *= sc; val[1] *= sc; }
            float* dst = part == 0 ? QN : (part == 1 ? KN : VV);
            dst[(size_t)r * 1024 + wave * 128 + lane] = val[0]; dst[(size_t)r * 1024 + wave * 128 + lane + 64] = val[1];
        }
        if (tid < 8) {
            BETA[(size_t)r * 8 + tid] = sigmoid_(bf2f(U[(size_t)r * NAB + 7168 + tid]));
            GDEC[(size_t)r * 8 + tid] = -expf(kp.in(15)[j * 8 + tid]) * softplus_(bf2f(U[(size_t)r * NAB + 7176 + tid]) + kp.in(16)[j * 8 + tid]);
        }
        { float x = ba[tid];
#pragma unroll
          for (int rr = 0; rr < 16; ++rr) x += bf2f(U[(size_t)r * NAB + 7184 + rr]) * wa2[rr * 512 + tid];
          GLOG[(size_t)r * 512 + tid] = -softplus_(-x) * (1.f / 16.f); }
    }
}


constexpr size_t GLA_ITEM_BYTES = 74752, WS_GLAOPS = WS_XN;
__device__ __forceinline__ void phase_gla_prep(const KP kp, const int bid, const int G, int j, LAS unsigned char* lds, int tid) {
    const bf16* U = (const bf16*)(kp.ws() + WS_U); const float* GLOG = (const float*)(kp.ws() + WS_SCR + SC_GLOG);
    unsigned char* OPS = kp.ws() + WS_GLAOPS;
    LAS float* GL = (LAS float*)lds; LAS float* QL = GL + 64 * 129; LAS float* KL = QL + 64 * 129; LAS float* AL = KL + 64 * 129;
    const int lane = tid & 63, r = lane & 31, hp = lane >> 5;
    for (int item = bid; item < 512; item += G) {
        const int b = item >> 7, n = (item >> 2) & 31, h = item & 3;
        const int row0 = b * 2048 + n * 64;
        __syncthreads();
        for (int i = tid; i < 8192; i += NTHR) { const int t = i >> 7, d = i & 127; const size_t ro = (size_t)(row0 + t) * NAB;
            QL[t * 129 + d] = bf2f(U[ro + 4096 + h * 128 + d]) * 0.08838834764831845f; KL[t * 129 + d] = bf2f(U[ro + 4608 + h * 128 + d]);
            GL[t * 129 + d] = GLOG[(size_t)(row0 + t) * 512 + h * 128 + d]; }
        __syncthreads();
        if (tid < 128) { float acc = 0.f;
#pragma unroll 4
            for (int t = 0; t < 64; ++t) { acc += GL[t * 129 + tid]; GL[t * 129 + tid] = acc; } }
        __syncthreads();
        for (int i = tid; i < 8192; i += NTHR) { const int t = i >> 7, d = i & 127; const float gg = GL[t * 129 + d]; QL[t * 129 + d] *= expf(gg); KL[t * 129 + d] *= expf(-gg); }
        __syncthreads();
        { const int i = tid >> 3, jg = tid & 7; float acc[8];
#pragma unroll
          for (int jj = 0; jj < 8; ++jj) acc[jj] = 0.f;
#pragma unroll 4
          for (int d = 0; d < 128; ++d) { const float c = QL[i * 129 + d];
#pragma unroll
              for (int jj = 0; jj < 8; ++jj) acc[jj] += c * KL[(jg * 8 + jj) * 129 + d]; }
#pragma unroll
          for (int jj = 0; jj < 8; ++jj) AL[i * 65 + jg * 8 + jj] = (jg * 8 + jj) <= i ? acc[jj] : 0.f; }
        __syncthreads();
        bf16x8* base = (bf16x8*)(OPS + (size_t)item * GLA_ITEM_BYTES);
        float v[8];
#pragma unroll
        for (int q = 0; q < 2; ++q) { const int f = (tid >> 6) + 8 * q;
            { const int mt = f >> 3, ks = f & 7, i = 32 * mt + r;
#pragma unroll
              for (int jp = 0; jp < 8; ++jp) v[jp] = QL[i * 129 + 16 * ks + 8 * (jp >> 2) + 4 * hp + (jp & 3)];
              base[f * 64 + lane] = pack8(v); }
            { const int mt = f >> 2, ks = f & 3, d = 32 * mt + r; const float eg = expf(GL[63 * 129 + d]);
#pragma unroll
              for (int jp = 0; jp < 8; ++jp) v[jp] = KL[(16 * ks + 8 * (jp >> 2) + 4 * hp + (jp & 3)) * 129 + d] * eg;
              base[(16 + f) * 64 + lane] = pack8(v); } }
        { const int f = tid >> 6, mt = f >> 2, ks = f & 3, i = 32 * mt + r;
#pragma unroll
          for (int jp = 0; jp < 8; ++jp) v[jp] = AL[i * 65 + 16 * ks + 8 * (jp >> 2) + 4 * hp + (jp & 3)];
          base[(32 + f) * 64 + lane] = pack8(v); }
#pragma unroll
        for (int q = 0; q < 4; ++q) { const int f = (tid >> 6) + 8 * q, nt = f >> 2, ks = f & 3, p = 32 * nt + r;
            unsigned w[4];
#pragma unroll
            for (int jp = 0; jp < 8; jp += 2) { const int t0 = 16 * ks + 8 * (jp >> 2) + 4 * hp + (jp & 3);
                w[jp >> 1] = (unsigned)U[(size_t)(row0 + t0) * NAB + 5120 + h * 256 + p] | ((unsigned)U[(size_t)(row0 + t0 + 1) * NAB + 5120 + h * 256 + p] << 16); }
            base[(40 + f) * 64 + lane] = __builtin_bit_cast(bf16x8, (u32x4){w[0], w[1], w[2], w[3]}); }
        if (tid < 128) ((float*)(base + 72 * 64))[tid] = expf(GL[63 * 129 + tid]);
    }
}


constexpr size_t DN_ITEM_BYTES = 73728;
__device__ __forceinline__ void phase_dn_prep(const KP kp, const int bid, const int G, int j, LAS unsigned char* lds, int tid0) {
    unsigned char* scr = kp.ws() + WS_SCR;
    const float* QN = (const float*)(scr + SC_QN); const float* KN = (const float*)(scr + SC_KN); const float* VV = (const float*)(scr + SC_VV);
    const float* BETA = (const float*)(scr + SC_BETA); const float* GDEC = (const float*)(scr + SC_GDEC);
    unsigned char* OPS = scr + SC_DNOPS; float* GENDD = (float*)(scr + SC_DNGEND);
    LAS float* AMT = (LAS float*)lds; LAS float* GLs = AMT + 64 * 68; LAS float* BLs = GLs + 64; LAS float* KL = BLs + 64; LAS float* QL = KL + 64 * 129; LAS float* XL = QL + 64 * 129;
    for (int item = bid; item < 1024; item += G) {
        int tid = tid0; asm volatile("" : "+v"(tid));
        const int lane = tid & 63, r = lane & 31, hp = lane >> 5, wave = tid >> 6;
        const int b = item >> 8, n = (item >> 3) & 31, h = item & 7;
        const int row0 = b * 2048 + n * 64;
        __syncthreads();
        for (int i = tid; i < 8192; i += NTHR) { const int t = i >> 7, d = i & 127; const size_t ro = (size_t)(row0 + t) * 1024 + h * 128 + d; KL[t * 129 + d] = KN[ro]; QL[t * 129 + d] = QN[ro]; }
        if (wave == 0) { float gv = GDEC[(size_t)(row0 + lane) * 8 + h];
#pragma unroll
            for (int o = 1; o < 64; o <<= 1) { const float tt = __shfl_up(gv, o); if (lane >= o) gv += tt; }
            GLs[lane] = gv; BLs[lane] = BETA[(size_t)(row0 + lane) * 8 + h]; }
        __syncthreads();
        bf16x8* base = (bf16x8*)(OPS + (size_t)item * DN_ITEM_BYTES);
        { const int i = tid >> 3, ks = (tid >> 1) & 3, hk = tid & 1; float kk[8], qk[8];
#pragma unroll
          for (int jp = 0; jp < 8; ++jp) { kk[jp] = 0.f; qk[jp] = 0.f; }
#pragma unroll 2
          for (int d = 0; d < 128; ++d) { const float kc = KL[i * 129 + d], qc = QL[i * 129 + d];
#pragma unroll
              for (int jp = 0; jp < 8; ++jp) { const float kj = KL[(16 * ks + 8 * (jp >> 2) + 4 * hk + (jp & 3)) * 129 + d]; kk[jp] += kc * kj; qk[jp] += qc * kj; } }
          const float gi = GLs[i], bi = BLs[i]; float v[8];
#pragma unroll
          for (int jp = 0; jp < 8; ++jp) { const int jt = 16 * ks + 8 * (jp >> 2) + 4 * hk + (jp & 3); const float dec = expf(gi - GLs[jt]);
              AMT[jt * 68 + i] = jt < i ? bi * kk[jp] * dec : 0.f; v[jp] = jt <= i ? qk[jp] * dec : 0.f; }
          base[(48 + (i >> 5) * 4 + ks) * 64 + (i & 31) + 32 * hk] = pack8(v); }
        __syncthreads();
        if (tid < 256) {
            const int c = tid;
#pragma unroll
            for (int bi = 0; bi < 4; ++bi) {
                float acc[16];
#pragma unroll
                for (int ii = 0; ii < 16; ++ii) { const int i = 16 * bi + ii; const float be = BLs[i];
                    acc[ii] = c < 128 ? be * VV[(size_t)(row0 + i) * 1024 + h * 128 + c] : be * expf(GLs[i]) * KL[i * 129 + (c - 128)]; }
                for (int jj = 0; jj < 16 * bi; ++jj) { const float xj = XL[jj * 257 + c];
#pragma unroll
                    for (int q = 0; q < 4; ++q) { const f32x4 a = *(const LAS f32x4*)(AMT + jj * 68 + 16 * bi + 4 * q);
                        acc[4 * q + 0] -= a[0] * xj; acc[4 * q + 1] -= a[1] * xj; acc[4 * q + 2] -= a[2] * xj; acc[4 * q + 3] -= a[3] * xj; } }
#pragma unroll
                for (int ii = 0; ii < 16; ++ii) { float x = acc[ii];
#pragma unroll
                    for (int jj = 0; jj < ii; ++jj) x -= AMT[(16 * bi + jj) * 68 + 16 * bi + ii] * acc[jj];
                    acc[ii] = x; XL[(16 * bi + ii) * 257 + c] = x; }
            }
        }
        __syncthreads();
        float v[8];
#pragma unroll
        for (int q = 0; q < 2; ++q) { const int f = wave + 8 * q;
            { const int mt = f >> 3, ks = f & 7, i = 32 * mt + r;
#pragma unroll
              for (int jp = 0; jp < 8; ++jp) v[jp] = -XL[i * 257 + 128 + 16 * ks + 8 * (jp >> 2) + 4 * hp + (jp & 3)];
              base[f * 64 + lane] = pack8(v);
              const float eg = expf(GLs[i]);
#pragma unroll
              for (int jp = 0; jp < 8; ++jp) v[jp] = QL[i * 129 + 16 * ks + 8 * (jp >> 2) + 4 * hp + (jp & 3)] * eg;
              base[(16 + f) * 64 + lane] = pack8(v); }
            { const int mt = f >> 2, ks = f & 3, d = 32 * mt + r; const float Gend = GLs[63];
#pragma unroll
              for (int jp = 0; jp < 8; ++jp) { const int tk = 16 * ks + 8 * (jp >> 2) + 4 * hp + (jp & 3); v[jp] = KL[tk * 129 + d] * expf(Gend - GLs[tk]); }
              base[(32 + f) * 64 + lane] = pack8(v); }
            { const int pq = f & 1, tl = f >> 1, mt = tl >> 2, nt = tl & 3;
#pragma unroll
              for (int e = 0; e < 8; ++e) v[e] = XL[(32 * mt + crow(8 * pq + e, hp)) * 257 + 32 * nt + r];
              base[(56 + f) * 64 + lane] = pack8(v); } }
        if (tid == 0) GENDD[item] = expf(GLs[63]);
    }
}

__device__ __forceinline__ void phase_ab_rec(const KP kp, const int bid, const int G, int j, LAS unsigned char* lds, int tid0) {
    unsigned char* scr = kp.ws() + WS_SCR; const bf16* U = (const bf16*)(kp.ws() + WS_U);
    const float* QN = (const float*)(scr + SC_QN); const float* KN = (const float*)(scr + SC_KN); const float* VV = (const float*)(scr + SC_VV);
    const float* GLOG = (const float*)(scr + SC_GLOG); const float* BETA = (const float*)(scr + SC_BETA); const float* GDEC = (const float*)(scr + SC_GDEC);
    float* ODN = (float*)(scr + SC_ODN); float* OGLA = (float*)(scr + SC_OGLA);
    LAS float* SL = (LAS float*)lds;
    for (int item = bid; item < 1600; item += G) {
        int tid = tid0; asm volatile("" : "+v"(tid));
        int s, h; bool isdn; int half = -1;
        if (item < 32) { isdn = false; s = item >> 3; h = (item >> 1) & 3; half = item & 1; }
        else if (item < 64) { isdn = true; s = (item - 32) >> 3; h = (item - 32) & 7; half = -2; }
        else if (item < 1088) { isdn = true; s = 4 + ((item - 64) >> 3); h = (item - 64) & 7; }
        else { isdn = false; s = 4 + ((item - 1088) >> 2); h = (item - 1088) & 3; }
        int row0, L; seq_info(s, row0, L);
        __syncthreads();
        if (half == -2) {
            const int wave = __builtin_amdgcn_readfirstlane(tid >> 6), lane = tid & 63, r = lane & 31, hp = lane >> 5;
            const int b = s, nt = wave;
            const unsigned char* OPS = scr + SC_DNOPS; const float* GENDD = (const float*)(scr + SC_DNGEND);
            constexpr int DBUF = 72 * 1024;
#define DN_DMA(n_, bufi_) do { const unsigned char* gi_ = OPS + (size_t)((b * 32 + (n_)) * 8 + h) * DN_ITEM_BYTES + lane * 16; \
                _Pragma("unroll") for (int q_ = 0; q_ < 9; ++q_) { const int lf_ = wave + 8 * q_; \
                    __builtin_amdgcn_global_load_lds((const unsigned*)(gi_ + lf_ * 1024), (LAS unsigned*)(lds + (bufi_) * DBUF + lf_ * 1024), 16, 0, 0); } } while (0)
            f32x16 S0, S1, S2, S3;
#pragma unroll
            for (int i = 0; i < 16; ++i) { S0[i] = 0.f; S1[i] = 0.f; S2[i] = 0.f; S3[i] = 0.f; }
            DN_DMA(0, 0);
            asm volatile("s_waitcnt vmcnt(0)" ::: "memory"); __syncthreads();
            for (int n = 0; n < 32; ++n) {
                if (n + 1 < 32) DN_DMA(n + 1, (n + 1) & 1);
                if (wave < 4) {
                    const LAS bf16x8* F = (const LAS bf16x8*)(lds + (n & 1) * DBUF) + lane;
                    const float gend = GENDD[(b * 32 + n) * 8 + h];
                    const bf16x8 sb0 = PACK_ACC(S0, 0), sb1 = PACK_ACC(S0, 1), sb2 = PACK_ACC(S1, 0), sb3 = PACK_ACC(S1, 1), sb4 = PACK_ACC(S2, 0), sb5 = PACK_ACC(S2, 1), sb6 = PACK_ACC(S3, 0), sb7 = PACK_ACC(S3, 1);
                    f32x16 U0t, U1t;
                    { const bf16x8 a0 = F[(56 + nt * 2 + 0) * 64], a1 = F[(56 + nt * 2 + 1) * 64], c0 = F[(56 + (4 + nt) * 2 + 0) * 64], c1 = F[(56 + (4 + nt) * 2 + 1) * 64];
#pragma unroll
                      for (int e = 0; e < 8; ++e) { U0t[e] = bf2f((bf16)a0[e]); U0t[8 + e] = bf2f((bf16)a1[e]); U1t[e] = bf2f((bf16)c0[e]); U1t[8 + e] = bf2f((bf16)c1[e]); } }
                    U0t = MFMA32(F[0 * 64], sb0, U0t); U0t = MFMA32(F[1 * 64], sb1, U0t); U0t = MFMA32(F[2 * 64], sb2, U0t); U0t = MFMA32(F[3 * 64], sb3, U0t);
                    U0t = MFMA32(F[4 * 64], sb4, U0t); U0t = MFMA32(F[5 * 64], sb5, U0t); U0t = MFMA32(F[6 * 64], sb6, U0t); U0t = MFMA32(F[7 * 64], sb7, U0t);
                    U1t = MFMA32(F[8 * 64], sb0, U1t); U1t = MFMA32(F[9 * 64], sb1, U1t); U1t = MFMA32(F[10 * 64], sb2, U1t); U1t = MFMA32(F[11 * 64], sb3, U1t);
                    U1t = MFMA32(F[12 * 64], sb4, U1t); U1t = MFMA32(F[13 * 64], sb5, U1t); U1t = MFMA32(F[14 * 64], sb6, U1t); U1t = MFMA32(F[15 * 64], sb7, U1t);
                    const bf16x8 ub0 = PACK_ACC(U0t, 0), ub1 = PACK_ACC(U0t, 1), ub2 = PACK_ACC(U1t, 0), ub3 = PACK_ACC(U1t, 1);
                    f32x16 O0, O1;
#pragma unroll
                    for (int i = 0; i < 16; ++i) { O0[i] = 0.f; O1[i] = 0.f; }
                    O0 = MFMA32(F[16 * 64], sb0, O0); O0 = MFMA32(F[17 * 64], sb1, O0); O0 = MFMA32(F[18 * 64], sb2, O0); O0 = MFMA32(F[19 * 64], sb3, O0);
                    O0 = MFMA32(F[20 * 64], sb4, O0); O0 = MFMA32(F[21 * 64], sb5, O0); O0 = MFMA32(F[22 * 64], sb6, O0); O0 = MFMA32(F[23 * 64], sb7, O0);
                    O1 = MFMA32(F[24 * 64], sb0, O1); O1 = MFMA32(F[25 * 64], sb1, O1); O1 = MFMA32(F[26 * 64], sb2, O1); O1 = MFMA32(F[27 * 64], sb3, O1);
                    O1 = MFMA32(F[28 * 64], sb4, O1); O1 = MFMA32(F[29 * 64], sb5, O1); O1 = MFMA32(F[30 * 64], sb6, O1); O1 = MFMA32(F[31 * 64], sb7, O1);
                    O0 = MFMA32(F[48 * 64], ub0, O0); O0 = MFMA32(F[49 * 64], ub1, O0);
                    O1 = MFMA32(F[52 * 64], ub0, O1); O1 = MFMA32(F[53 * 64], ub1, O1); O1 = MFMA32(F[54 * 64], ub2, O1); O1 = MFMA32(F[55 * 64], ub3, O1);
#pragma unroll
                    for (int i = 0; i < 16; ++i) { S0[i] *= gend; S1[i] *= gend; S2[i] *= gend; S3[i] *= gend; }
                    S0 = MFMA32(F[32 * 64], ub0, S0); S0 = MFMA32(F[33 * 64], ub1, S0); S0 = MFMA32(F[34 * 64], ub2, S0); S0 = MFMA32(F[35 * 64], ub3, S0);
                    S1 = MFMA32(F[36 * 64], ub0, S1); S1 = MFMA32(F[37 * 64], ub1, S1); S1 = MFMA32(F[38 * 64], ub2, S1); S1 = MFMA32(F[39 * 64], ub3, S1);
                    S2 = MFMA32(F[40 * 64], ub0, S2); S2 = MFMA32(F[41 * 64], ub1, S2); S2 = MFMA32(F[42 * 64], ub2, S2); S2 = MFMA32(F[43 * 64], ub3, S2);
                    S3 = MFMA32(F[44 * 64], ub0, S3); S3 = MFMA32(F[45 * 64], ub1, S3); S3 = MFMA32(F[46 * 64], ub2, S3); S3 = MFMA32(F[47 * 64], ub3, S3);
                    float* yo = ODN + (size_t)(b * 2048 + n * 64) * 1024 + h * 128 + 32 * nt + r;
#pragma unroll
                    for (int i = 0; i < 16; ++i) { yo[(size_t)crow(i, hp) * 1024] = O0[i]; yo[(size_t)(32 + crow(i, hp)) * 1024] = O1[i]; }
                }
                asm volatile("s_waitcnt vmcnt(0)" ::: "memory"); __syncthreads();
            }
#undef DN_DMA
            if (wave < 4) {
                float* dst = kp.out() + O_DN_P + ((size_t)j * 4 + b) * ((size_t)8 * 128 * 128) + (size_t)h * 128 * 128 + 32 * nt + r;
#pragma unroll
                for (int i = 0; i < 16; ++i) { dst[(size_t)crow(i, hp) * 128] = S0[i]; dst[(size_t)(32 + crow(i, hp)) * 128] = S1[i]; dst[(size_t)(64 + crow(i, hp)) * 128] = S2[i]; dst[(size_t)(96 + crow(i, hp)) * 128] = S3[i]; }
            }
        } else if (half >= 0) {
            const int wave = __builtin_amdgcn_readfirstlane(tid >> 6), lane = tid & 63, r = lane & 31, hp = lane >> 5;
            const int b = s, nt = half * 4 + wave;
            const unsigned char* OPS = kp.ws() + WS_GLAOPS;
            constexpr int GBUF = 57 * 1024;
#define GLA_DMA(n_, bufi_) do { const unsigned char* gi_ = OPS + (size_t)((b * 32 + (n_)) * 4 + h) * GLA_ITEM_BYTES + lane * 16; \
                _Pragma("unroll") for (int q_ = 0; q_ < 8; ++q_) { const int lf_ = wave + 8 * q_; if (lf_ < 57) { const int gf_ = lf_ < 40 ? lf_ : (lf_ < 56 ? lf_ + half * 16 : 72); \
                    __builtin_amdgcn_global_load_lds((const unsigned*)(gi_ + gf_ * 1024), (LAS unsigned*)(lds + (bufi_) * GBUF + lf_ * 1024), 16, 0, 0); } } } while (0)
            f32x16 S0, S1, S2, S3;
#pragma unroll
            for (int i = 0; i < 16; ++i) { S0[i] = 0.f; S1[i] = 0.f; S2[i] = 0.f; S3[i] = 0.f; }
            GLA_DMA(0, 0);
            asm volatile("s_waitcnt vmcnt(0)" ::: "memory"); __syncthreads();
            for (int n = 0; n < 32; ++n) {
                if (n + 1 < 32) GLA_DMA(n + 1, (n + 1) & 1);
                if (wave < 4) {
                    const LAS bf16x8* F = (const LAS bf16x8*)(lds + (n & 1) * GBUF) + lane;
                    const LAS float* ge = (const LAS float*)(lds + (n & 1) * GBUF + 56 * 1024) + 4 * hp;
                    const bf16x8 sb0 = PACK_ACC(S0, 0), sb1 = PACK_ACC(S0, 1), sb2 = PACK_ACC(S1, 0), sb3 = PACK_ACC(S1, 1), sb4 = PACK_ACC(S2, 0), sb5 = PACK_ACC(S2, 1), sb6 = PACK_ACC(S3, 0), sb7 = PACK_ACC(S3, 1);
                    f32x16 O0, O1;
#pragma unroll
                    for (int i = 0; i < 16; ++i) { O0[i] = 0.f; O1[i] = 0.f; }
                    O0 = MFMA32(F[0 * 64], sb0, O0); O0 = MFMA32(F[1 * 64], sb1, O0); O0 = MFMA32(F[2 * 64], sb2, O0); O0 = MFMA32(F[3 * 64], sb3, O0);
                    O0 = MFMA32(F[4 * 64], sb4, O0); O0 = MFMA32(F[5 * 64], sb5, O0); O0 = MFMA32(F[6 * 64], sb6, O0); O0 = MFMA32(F[7 * 64], sb7, O0);
                    O1 = MFMA32(F[8 * 64], sb0, O1); O1 = MFMA32(F[9 * 64], sb1, O1); O1 = MFMA32(F[10 * 64], sb2, O1); O1 = MFMA32(F[11 * 64], sb3, O1);
                    O1 = MFMA32(F[12 * 64], sb4, O1); O1 = MFMA32(F[13 * 64], sb5, O1); O1 = MFMA32(F[14 * 64], sb6, O1); O1 = MFMA32(F[15 * 64], sb7, O1);
                    bf16x8 vb[4];
#pragma unroll
                    for (int ks = 0; ks < 4; ++ks) vb[ks] = F[(40 + wave * 4 + ks) * 64];
                    O0 = MFMA32(F[32 * 64], vb[0], O0); O0 = MFMA32(F[33 * 64], vb[1], O0);
#pragma unroll
                    for (int ks = 0; ks < 4; ++ks) O1 = MFMA32(F[(36 + ks) * 64], vb[ks], O1);
#pragma unroll
                    for (int q = 0; q < 4; ++q) { const f32x4 g0 = *(const LAS f32x4*)(ge + 8 * q), g1 = *(const LAS f32x4*)(ge + 32 + 8 * q), g2 = *(const LAS f32x4*)(ge + 64 + 8 * q), g3 = *(const LAS f32x4*)(ge + 96 + 8 * q);
#pragma unroll
                        for (int c = 0; c < 4; ++c) { S0[4 * q + c] *= g0[c]; S1[4 * q + c] *= g1[c]; S2[4 * q + c] *= g2[c]; S3[4 * q + c] *= g3[c]; } }
#pragma unroll
                    for (int ks = 0; ks < 4; ++ks) { S0 = MFMA32(F[(16 + ks) * 64], vb[ks], S0); S1 = MFMA32(F[(20 + ks) * 64], vb[ks], S1); S2 = MFMA32(F[(24 + ks) * 64], vb[ks], S2); S3 = MFMA32(F[(28 + ks) * 64], vb[ks], S3); }
                    float* yo = OGLA + (size_t)(b * 2048 + n * 64) * 1024 + h * 256 + 32 * nt + r;
#pragma unroll
                    for (int i = 0; i < 16; ++i) { yo[(size_t)crow(i, hp) * 1024] = O0[i]; yo[(size_t)(32 + crow(i, hp)) * 1024] = O1[i]; }
                }
                asm volatile("s_waitcnt vmcnt(0)" ::: "memory"); __syncthreads();
            }
#undef GLA_DMA
            if (wave < 4) {
                float* dst = kp.out() + O_GLA_P + ((size_t)j * 4 + b) * ((size_t)4 * 128 * 256) + (size_t)h * 128 * 256 + 32 * nt + r;
#pragma unroll
                for (int i = 0; i < 16; ++i) { dst[(size_t)crow(i, hp) * 256] = S0[i]; dst[(size_t)(32 + crow(i, hp)) * 256] = S1[i]; dst[(size_t)(64 + crow(i, hp)) * 256] = S2[i]; dst[(size_t)(96 + crow(i, hp)) * 256] = S3[i]; }
            }
        } else
        if (isdn) {
            LAS float* kL = SL + 16384; LAS float* qL = kL + 128; LAS float* red = kL + 256; LAS float* red2 = kL + 768;
            const int e = tid & 127, dq = tid >> 7;
            const size_t SZ = (size_t)8 * 128 * 128;
            const float* st = kp.in(2) + ((size_t)j * 128 + (s < 4 ? 0 : s - 4)) * SZ + (size_t)h * 128 * 128;
#pragma unroll 4
            for (int i = 0; i < 32; ++i) { const int d = dq * 32 + i; SL[d * 128 + e] = s < 4 ? 0.f : st[(size_t)d * 128 + e]; }
            for (int t = 0; t < L; ++t) {
                const size_t r = (size_t)(row0 + t);
                if (tid < 128) kL[tid] = KN[r * 1024 + h * 128 + tid]; else if (tid < 256) qL[tid - 128] = QN[r * 1024 + h * 128 + (tid - 128)];
                const float ve = VV[r * 1024 + h * 128 + e], beta = BETA[r * 8 + h], a = expf(GDEC[r * 8 + h]);
                __syncthreads();
                float part = 0.f;
#pragma unroll 4
                for (int i = 0; i < 32; ++i) { const int d = dq * 32 + i; const float sv = SL[d * 128 + e] * a; SL[d * 128 + e] = sv; part += kL[d] * sv; }
                red[dq * 128 + e] = part;
                __syncthreads();
                const float kS = (red[e] + red[128 + e]) + (red[256 + e] + red[384 + e]);
                const float u = beta * (ve - kS);
                float part2 = 0.f;
#pragma unroll 4
                for (int i = 0; i < 32; ++i) { const int d = dq * 32 + i; const float sv = SL[d * 128 + e] + kL[d] * u; SL[d * 128 + e] = sv; part2 += qL[d] * sv; }
                red2[dq * 128 + e] = part2;
                __syncthreads();
                if (dq == 0) ODN[r * 1024 + h * 128 + e] = (red2[e] + red2[128 + e]) + (red2[256 + e] + red2[384 + e]);
            }
            float* dst = s < 4 ? kp.out() + O_DN_P + ((size_t)j * 4 + s) * SZ + (size_t)h * 128 * 128 : kp.out() + O_DN_S + ((size_t)j * 128 + (s - 4)) * SZ + (size_t)h * 128 * 128;
#pragma unroll 4
            for (int i = 0; i < 32; ++i) { const int d = dq * 32 + i; dst[(size_t)d * 128 + e] = SL[d * 128 + e]; }
        } else {
            LAS float* kL = SL + 32768; LAS float* qL = kL + 128; LAS float* aL = kL + 256; LAS float* red = kL + 384;
            const int e = tid & 255, dh = tid >> 8;
            const size_t SZ = (size_t)4 * 128 * 256;
            const float* st = kp.in(4) + ((size_t)j * 128 + (s < 4 ? 0 : s - 4)) * SZ + (size_t)h * 128 * 256;
#pragma unroll 4
            for (int i = 0; i < 64; ++i) { const int d = dh * 64 + i; SL[d * 256 + e] = s < 4 ? 0.f : st[(size_t)d * 256 + e]; }
            for (int t = 0; t < L; ++t) {
                const size_t r = (size_t)(row0 + t);
                if (tid < 128) kL[tid] = bf2f(U[r * NAB + 4608 + h * 128 + tid]);
                else if (tid < 256) qL[tid - 128] = bf2f(U[r * NAB + 4096 + h * 128 + (tid - 128)]) * 0.08838834764831845f;
                else if (tid < 384) aL[tid - 256] = expf(GLOG[r * 512 + h * 128 + (tid - 256)]);
                const float ve = bf2f(U[r * NAB + 5120 + h * 256 + e]);
                __syncthreads();
                float part = 0.f;
#pragma unroll 4
                for (int i = 0; i < 64; ++i) { const int d = dh * 64 + i; const float sv = aL[d] * SL[d * 256 + e] + kL[d] * ve; SL[d * 256 + e] = sv; part += qL[d] * sv; }
                red[dh * 256 + e] = part;
                __syncthreads();
                if (dh == 0) OGLA[r * 1024 + h * 256 + e] = red[e] + red[256 + e];
            }
            float* dst = s < 4 ? kp.out() + O_GLA_P + ((size_t)j * 4 + s) * SZ + (size_t)h * 128 * 256 : kp.out() + O_GLA_S + ((size_t)j * 128 + (s - 4)) * SZ + (size_t)h * 128 * 256;
#pragma unroll 4
            for (int i = 0; i < 64; ++i) { const int d = dh * 64 + i; dst[(size_t)d * 256 + e] = SL[d * 256 + e]; }
        }
    }
}

__device__ __forceinline__ void phase_ab_post(const KP kp, const int bid, const int G, int j, int tid, int wave, int lane) {
    unsigned char* scr = kp.ws() + WS_SCR; const bf16* U = (const bf16*)(kp.ws() + WS_U); bf16* YM = (bf16*)(kp.ws() + WS_YM);
    const float* ODN = (const float*)(scr + SC_ODN); const float* OGLA = (const float*)(scr + SC_OGLA);
    const float* dnn = kp.in(17) + (size_t)j * 128; const float* glan = kp.in(20) + (size_t)j * 256;
    for (int r = bid; r < T; r += G) {
        int s, t; row_to_seq(r, s, t); int row0, L; seq_info(s, row0, L);
        { float o[2];
#pragma unroll
          for (int i = 0; i < 2; ++i) o[i] = ODN[(size_t)r * 1024 + wave * 128 + lane + 64 * i];
          const float rstd = rsqrtf(wave_sum(o[0] * o[0] + o[1] * o[1]) * (1.f / 128.f) + 1e-6f);
#pragma unroll
          for (int i = 0; i < 2; ++i) { const int e = lane + 64 * i; const float z = bf2f(U[(size_t)r * NAB + 3072 + wave * 128 + e]);
              YM[(size_t)r * DM + wave * 128 + e] = (bf16)f2bf(o[i] * rstd * dnn[e] * silu_(z)); } }
        if (wave < 4) { float o[4]; float ss = 0.f;
#pragma unroll
          for (int i = 0; i < 4; ++i) { o[i] = OGLA[(size_t)r * 1024 + wave * 256 + lane + 64 * i]; ss += o[i] * o[i]; }
          const float rstd = rsqrtf(wave_sum(ss) * (1.f / 256.f) + 1e-6f);
#pragma unroll
          for (int i = 0; i < 4; ++i) { const int e = lane + 64 * i; const float z = bf2f(U[(size_t)r * NAB + 6144 + wave * 256 + e]);
              YM[(size_t)r * DM + 1024 + wave * 256 + e] = (bf16)f2bf(o[i] * rstd * glan[e] * silu_(z)); } }
        if (t >= L - 3) { const int rr = t - (L - 3);
            float* dst = s < 4 ? kp.out() + O_DNC_P + (((size_t)j * 4 + s) * 3 + rr) * 3072 : kp.out() + O_DNC_S + (((size_t)j * 128 + (s - 4)) * 3 + rr) * 3072;
            for (int c = tid; c < 3072; c += NTHR) dst[c] = bf2f(U[(size_t)r * NAB + c]); }
    }
}

__device__ __forceinline__ void phase_cd_pre(const KP kp, const int bid, const int G, int j, LAS unsigned char* lds, int tid) {
    unsigned char* scr = kp.ws() + WS_SCR; const bf16* U = (const bf16*)(kp.ws() + WS_U);
    float* XBC = (float*)(scr + SC_XBC); float* LA = (float*)(scr + SC_LA); float* LB = (float*)(scr + SC_LB); float* DT = (float*)(scr + SC_DT);
    const float* cw = kp.in(23) + (size_t)j * 4 * 1536; const float* cb = kp.in(24) + (size_t)j * 1536; const float* stc = kp.in(6) + (size_t)j * 128 * 3 * 1536;
    const float* lcw = kp.in(29) + (size_t)j * 4 * 1024; const float* lcb = kp.in(30) + (size_t)j * 1024; const float* lstc = kp.in(8) + (size_t)j * 128 * 3 * 1024;
    const float* wa = kp.in(31) + (size_t)j * 16 * 64 * 64; const float* wx = kp.in(33) + (size_t)j * 16 * 64 * 64;
    const float* lba = kp.in(32) + (size_t)j * 1024; const float* lbx = kp.in(34) + (size_t)j * 1024; const float* lam = kp.in(35) + (size_t)j * 1024;
    LAS float* xcL = (LAS float*)lds;
    for (int r = bid; r < T; r += G) {
        int s, t; row_to_seq(r, s, t); const int row0 = r - t;
#pragma unroll
        for (int i = 0; i < 3; ++i) { const int c = tid + NTHR * i; float acc = cb[c];
#pragma unroll
            for (int tap = 0; tap < 4; ++tap) acc += cw[tap * 1536 + c] * pre_val(U, NCD, 1024 + c, row0, t - 3 + tap, s, stc, 1536, c);
            XBC[(size_t)r * 1536 + c] = silu_(acc); }
        if (tid < 16) DT[(size_t)r * 16 + tid] = softplus_(bf2f(U[(size_t)r * NCD + 4608 + tid]) + kp.in(26)[j * 16 + tid]);
        float xc[2];
#pragma unroll
        for (int i = 0; i < 2; ++i) { const int ch = tid + NTHR * i; float acc = lcb[ch];
#pragma unroll
            for (int tap = 0; tap < 4; ++tap) acc += lcw[tap * 1024 + ch] * pre_val(U, NCD, 3584 + ch, row0, t - 3 + tap, s, lstc, 1024, ch);
            xc[i] = acc; xcL[ch] = acc; }
        __syncthreads();
#pragma unroll
        for (int i = 0; i < 2; ++i) { const int ch = tid + NTHR * i, n = ch >> 6, d = ch & 63; float ra = lba[ch], ix = lbx[ch];
#pragma unroll 8
            for (int c = 0; c < 64; ++c) { const float x = xcL[n * 64 + c]; ra += x * wa[(size_t)(n * 64 + c) * 64 + d]; ix += x * wx[(size_t)(n * 64 + c) * 64 + d]; }
            const float rg = sigmoid_(ra), ig = sigmoid_(ix);
            const float log_a = -8.f * rg * softplus_(-lam[ch]);
            LA[(size_t)r * 1024 + ch] = expf(log_a);
            LB[(size_t)r * 1024 + ch] = sqrtf(-expm1f(2.f * log_a)) * (ig * xc[i]); }
        __syncthreads();
    }
}


__device__ __forceinline__ void phase_ssd_prep(const KP kp, const int bid, const int G, int j, LAS unsigned char* lds, int tid) {
    unsigned char* scr = kp.ws() + WS_SCR;
    const float* XBC = (const float*)(scr + SC_XBC); const float* DT = (const float*)(scr + SC_DT);
    unsigned char* OPS = scr + SC_SSDOP; float* GEND = (float*)(scr + SC_GEND);
    LAS float* CL = (LAS float*)lds; LAS float* BL = CL + 64 * 65; LAS float* QK = BL + 64 * 65; LAS float* GL = QK + 64 * 65;
    const float* alog = kp.in(25) + j * 16;
    const int wave = tid >> 6, lane = tid & 63;
    for (int item = bid; item < 512; item += G) {
        const int b = item >> 7, n = (item >> 2) & 31, g = item & 3;
        const int row0 = b * 2048 + n * 64;
        __syncthreads();
        for (int i = tid; i < 4096; i += NTHR) { const int t = i >> 6, d = i & 63;
            BL[t * 65 + d] = XBC[(size_t)(row0 + t) * 1536 + 1024 + g * 64 + d];
            CL[t * 65 + d] = XBC[(size_t)(row0 + t) * 1536 + 1280 + g * 64 + d]; }
        if (wave < 4) { const int h = g * 4 + wave; float gv = -expf(alog[h]) * DT[(size_t)(row0 + lane) * 16 + h];
#pragma unroll
            for (int o = 1; o < 64; o <<= 1) { const float tt = __shfl_up(gv, o); if (lane >= o) gv += tt; }
            GL[wave * 64 + lane] = gv; }
        __syncthreads();
        { const int i = tid >> 3, jg = tid & 7; float acc[8];
#pragma unroll
          for (int jj = 0; jj < 8; ++jj) acc[jj] = 0.f;
#pragma unroll 4
          for (int d = 0; d < 64; ++d) { const float c = CL[i * 65 + d];
#pragma unroll
              for (int jj = 0; jj < 8; ++jj) acc[jj] += c * BL[(jg * 8 + jj) * 65 + d]; }
#pragma unroll
          for (int jj = 0; jj < 8; ++jj) QK[i * 65 + jg * 8 + jj] = acc[jj]; }
        __syncthreads();
        const int f = wave, r = lane & 31, hp = lane >> 5, mt = f >> 2, ks = f & 3;
        for (int hh = 0; hh < 4; ++hh) {
            const int h = g * 4 + hh; const LAS float* Gh = GL + hh * 64; const float Gend = Gh[63];
            bf16x8* base = (bf16x8*)(OPS + ((size_t)((b * 32 + n) * 16 + h)) * 32768);
            float v[8];
            { const int i = 32 * mt + r; const float eg = expf(Gh[i]);
#pragma unroll
              for (int jp = 0; jp < 8; ++jp) { const int d = 16 * ks + 8 * (jp >> 2) + 4 * hp + (jp & 3); v[jp] = CL[i * 65 + d] * eg; }
              base[0 * 512 + f * 64 + lane] = pack8(v); }
            { const int d = 32 * mt + r;
#pragma unroll
              for (int jp = 0; jp < 8; ++jp) { const int tk = 16 * ks + 8 * (jp >> 2) + 4 * hp + (jp & 3); v[jp] = BL[tk * 65 + d] * expf(Gend - Gh[tk]); }
              base[1 * 512 + f * 64 + lane] = pack8(v); }
            { const int i = 32 * mt + r; const float gi = Gh[i];
#pragma unroll
              for (int jp = 0; jp < 8; ++jp) { const int jt = 16 * ks + 8 * (jp >> 2) + 4 * hp + (jp & 3); v[jp] = jt <= i ? QK[i * 65 + jt] * expf(gi - Gh[jt]) : 0.f; }
              base[2 * 512 + f * 64 + lane] = pack8(v); }
            { const int p = 32 * mt + r;
#pragma unroll
              for (int jp = 0; jp < 8; ++jp) { const int tk = 16 * ks + 8 * (jp >> 2) + 4 * hp + (jp & 3);
                  v[jp] = XBC[(size_t)(row0 + tk) * 1536 + h * 64 + p] * DT[(size_t)(row0 + tk) * 16 + h]; }
              base[3 * 512 + f * 64 + lane] = pack8(v); }
            if (tid == 0) GEND[(b * 32 + n) * 16 + h] = expf(Gend);
        }
    }
}

__device__ __forceinline__ void phase_cd_rec(const KP kp, const int bid, const int G, int j, LAS unsigned char* lds, int tid0) {
    unsigned char* scr = kp.ws() + WS_SCR;
    const float* XBC = (const float*)(scr + SC_XBC); const float* LA = (const float*)(scr + SC_LA); const float* LB = (const float*)(scr + SC_LB); const float* DT = (const float*)(scr + SC_DT);
    float* YS = (float*)(scr + SC_YS); float* HS = (float*)(scr + SC_HS);
    LAS float* bL = (LAS float*)lds; LAS float* cL = bL + 64; LAS float* red = bL + 128;
    for (int item = bid; item < 2328; item += G) {
        int tid = tid0; asm volatile("" : "+v"(tid));
        int kind, s, h;
        if (item < 16) { kind = 2; s = item >> 2; h = item & 3; }
        else if (item < 24) { kind = 1; s = (item - 16) >> 1; h = (item - 16) & 1; }
        else if (item < 2072) { kind = 0; s = 4 + ((item - 24) >> 4); h = (item - 24) & 15; }
        else { kind = 1; s = 4 + ((item - 2072) >> 1); h = (item - 2072) & 1; }
        int row0, L; seq_info(s, row0, L);
        __syncthreads();
        if (kind == 2) {
            const int wave = __builtin_amdgcn_readfirstlane(tid >> 6), lane = tid & 63, r = lane & 31, hp = lane >> 5;
            const int b = s, hd = h * 4 + (wave >> 1), nt = wave & 1;
            const unsigned char* OPS = scr + SC_SSDOP; const float* GEND = (const float*)(scr + SC_GEND);
            f32x16 S0, S1;
#pragma unroll
            for (int i = 0; i < 16; ++i) { S0[i] = 0.f; S1[i] = 0.f; }
            for (int n = 0; n < 32; ++n) {
                const bf16x8* F = (const bf16x8*)(OPS + ((size_t)((b * 32 + n) * 16 + hd)) * 32768) + lane;
                bf16x8 qg[2][4], kT[2][4], Am[2][4], vb[4];
#pragma unroll
                for (int mt = 0; mt < 2; ++mt)
#pragma unroll
                    for (int ks = 0; ks < 4; ++ks) { qg[mt][ks] = F[(0 * 8 + mt * 4 + ks) * 64]; kT[mt][ks] = F[(1 * 8 + mt * 4 + ks) * 64]; Am[mt][ks] = F[(2 * 8 + mt * 4 + ks) * 64]; }
#pragma unroll
                for (int ks = 0; ks < 4; ++ks) vb[ks] = F[(3 * 8 + nt * 4 + ks) * 64];
                const float gend = GEND[(b * 32 + n) * 16 + hd];
                const bf16x8 sb00 = PACK_ACC(S0, 0), sb01 = PACK_ACC(S0, 1), sb10 = PACK_ACC(S1, 0), sb11 = PACK_ACC(S1, 1);
                f32x16 O0, O1;
#pragma unroll
                for (int i = 0; i < 16; ++i) { O0[i] = 0.f; O1[i] = 0.f; }
                O0 = MFMA32(qg[0][0], sb00, O0); O0 = MFMA32(qg[0][1], sb01, O0); O0 = MFMA32(qg[0][2], sb10, O0); O0 = MFMA32(qg[0][3], sb11, O0);
                O1 = MFMA32(qg[1][0], sb00, O1); O1 = MFMA32(qg[1][1], sb01, O1); O1 = MFMA32(qg[1][2], sb10, O1); O1 = MFMA32(qg[1][3], sb11, O1);
                O0 = MFMA32(Am[0][0], vb[0], O0); O0 = MFMA32(Am[0][1], vb[1], O0);
#pragma unroll
                for (int ks = 0; ks < 4; ++ks) O1 = MFMA32(Am[1][ks], vb[ks], O1);
#pragma unroll
                for (int i = 0; i < 16; ++i) { S0[i] *= gend; S1[i] *= gend; }
#pragma unroll
                for (int ks = 0; ks < 4; ++ks) { S0 = MFMA32(kT[0][ks], vb[ks], S0); S1 = MFMA32(kT[1][ks], vb[ks], S1); }
                float* yo = YS + (size_t)(b * 2048 + n * 64) * 1024 + hd * 64 + 32 * nt + r;
#pragma unroll
                for (int i = 0; i < 16; ++i) { yo[(size_t)crow(i, hp) * 1024] = O0[i]; yo[(size_t)(32 + crow(i, hp)) * 1024] = O1[i]; }
            }
            float* dst = kp.out() + O_SSD_P + ((size_t)j * 4 + b) * ((size_t)16 * 64 * 64) + (size_t)hd * 64 * 64 + 32 * nt + r;
#pragma unroll
            for (int i = 0; i < 16; ++i) { dst[(size_t)crow(i, hp) * 64] = S0[i]; dst[(size_t)(32 + crow(i, hp)) * 64] = S1[i]; }
        } else if (kind == 0) {
            const int p = tid & 63, ng = tid >> 6, grp = h >> 2;
            const size_t SZ = (size_t)16 * 64 * 64;
            float S[8];
            if (s < 4) {
#pragma unroll
                for (int i = 0; i < 8; ++i) S[i] = 0.f;
            } else { const float* st = kp.in(5) + ((size_t)j * 128 + (s - 4)) * SZ + (size_t)h * 64 * 64;
#pragma unroll
                for (int i = 0; i < 8; ++i) S[i] = st[(size_t)(ng * 8 + i) * 64 + p]; }
            const float negA = -expf(kp.in(25)[j * 16 + h]);
            for (int t = 0; t < L; ++t) {
                const size_t r = (size_t)(row0 + t);
                if (tid < 64) bL[tid] = XBC[r * 1536 + 1024 + grp * 64 + tid]; else if (tid < 128) cL[tid - 64] = XBC[r * 1536 + 1280 + grp * 64 + (tid - 64)];
                const float xp = XBC[r * 1536 + h * 64 + p], dt = DT[r * 16 + h], a = expf(negA * dt), xdt = xp * dt;
                __syncthreads();
                float part = 0.f;
#pragma unroll
                for (int i = 0; i < 8; ++i) { const int n = ng * 8 + i; S[i] = a * S[i] + bL[n] * xdt; part += cL[n] * S[i]; }
                red[ng * 64 + p] = part;
                __syncthreads();
                if (ng == 0) { float y = 0.f;
#pragma unroll
                    for (int g = 0; g < 8; ++g) y += red[g * 64 + p];
                    YS[r * 1024 + h * 64 + p] = y; }
            }
            float* dst = s < 4 ? kp.out() + O_SSD_P + ((size_t)j * 4 + s) * SZ + (size_t)h * 64 * 64 : kp.out() + O_SSD_S + ((size_t)j * 128 + (s - 4)) * SZ + (size_t)h * 64 * 64;
#pragma unroll
            for (int i = 0; i < 8; ++i) dst[(size_t)(ng * 8 + i) * 64 + p] = S[i];
        } else {
            const int ch = h * 512 + tid;
            float hh = s < 4 ? 0.f : kp.in(7)[((size_t)j * 128 + (s - 4)) * 1024 + ch];
#pragma unroll 8
            for (int t = 0; t < L; ++t) { const size_t r = (size_t)(row0 + t); hh = LA[r * 1024 + ch] * hh + LB[r * 1024 + ch]; HS[r * 1024 + ch] = hh; }
            float* dst = s < 4 ? kp.out() + O_LRU_P + ((size_t)j * 4 + s) * 1024 : kp.out() + O_LRU_S + ((size_t)j * 128 + (s - 4)) * 1024;
            dst[ch] = hh;
        }
    }
}

__device__ __forceinline__ void phase_cd_post(const KP kp, const int bid, const int G, int j, int tid, int wave, int lane) {
    unsigned char* scr = kp.ws() + WS_SCR; const bf16* U = (const bf16*)(kp.ws() + WS_U); bf16* YM = (bf16*)(kp.ws() + WS_YM);
    const float* YS = (const float*)(scr + SC_YS); const float* HS = (const float*)(scr + SC_HS); const float* XBC = (const float*)(scr + SC_XBC);
    const float* sn = kp.in(28) + (size_t)j * 1024;
    for (int r = bid; r < T; r += G) {
        int s, t; row_to_seq(r, s, t); int row0, L; seq_info(s, row0, L);
        if (wave < 4) { float y[4]; float ss = 0.f;
#pragma unroll
            for (int i = 0; i < 4; ++i) { const int e = wave * 256 + lane + 64 * i; y[i] = (YS[(size_t)r * 1024 + e] + kp.in(27)[j * 16 + (e >> 6)] * XBC[(size_t)r * 1536 + e]) * silu_(bf2f(U[(size_t)r * NCD + e])); ss += y[i] * y[i]; }
            const float rstd = rsqrtf(wave_sum(ss) * (1.f / 256.f) + 1e-6f);
#pragma unroll
            for (int i = 0; i < 4; ++i) { const int e = wave * 256 + lane + 64 * i; YM[(size_t)r * DM + e] = (bf16)f2bf(y[i] * rstd * sn[e]); }
        } else {
#pragma unroll
            for (int i = 0; i < 4; ++i) { const int ch = (wave - 4) * 256 + lane + 64 * i;
                YM[(size_t)r * DM + 1024 + ch] = (bf16)f2bf(HS[(size_t)r * 1024 + ch] * silu_(bf2f(U[(size_t)r * NCD + 2560 + ch]))); }
        }
        if (t >= L - 3) { const int rr = t - (L - 3);
            float* d1 = s < 4 ? kp.out() + O_SSDC_P + (((size_t)j * 4 + s) * 3 + rr) * 1536 : kp.out() + O_SSDC_S + (((size_t)j * 128 + (s - 4)) * 3 + rr) * 1536;
            for (int c = tid; c < 1536; c += NTHR) d1[c] = bf2f(U[(size_t)r * NCD + 1024 + c]);
            float* d2 = s < 4 ? kp.out() + O_LRUC_P + (((size_t)j * 4 + s) * 3 + rr) * 1024 : kp.out() + O_LRUC_S + (((size_t)j * 128 + (s - 4)) * 3 + rr) * 1024;
            for (int c = tid; c < 1024; c += NTHR) d2[c] = bf2f(U[(size_t)r * NCD + 3584 + c]); }
    }
}

__global__ void __launch_bounds__(NTHR, 2) mega_fwd(Args A) {
    extern __shared__ __attribute__((aligned(16))) unsigned char lds_raw[];
    LAS unsigned char* lds = (LAS unsigned char*)lds_raw;
    const int G = gridDim.x;
    for (int ph = A.ph_lo; ph < A.ph_hi; ++ph) {
        KP kp; kp.p = (const char AS4*)__builtin_amdgcn_kernarg_segment_ptr(); asm volatile("" : "+s"(kp.p));
        unsigned char* ws = kp.ws();
        int tid = threadIdx.x; asm volatile("" : "+v"(tid));
        int bid = blockIdx.x; asm volatile("" : "+s"(bid));
        const int lane = tid & 63, wave = __builtin_amdgcn_readfirstlane(tid >> 6), gw = bid * NWAVES + wave, NGW = G * NWAVES;
        if (ph == 0) { if (PH_MASK & 1) phase_prologue(kp, lds, gw, NGW, wave, lane); }
        else {
            const int li = (ph - 1) / SUBS, sub = (ph - 1) % SUBS, j = li >> 1; const bool ab = (li & 1) == 0;
            if (sub == 0) {
                const int N = ab ? NAB : NCD;
                const bf16* Bt = ab ? (const bf16*)(ws + WS_WABIN) + (size_t)j * NAB * 2048 : (const bf16*)(ws + WS_WCDIN) + (size_t)j * NCD * 2048;
                pg8::Gemm g{(const bf16*)(ws + WS_XN), Bt, T, N, 2048}; pg8::StaticOrder S; S.init(T, N, G, bid);
                pg8::EpiBf16 E{(bf16*)(ws + WS_U), N};
                if (PH_MASK & 2) pg8::gemm_phase<pg8::EpiBf16, pg8::StaticOrder, true, true>(lds, g, S, E, tid);
            } else if (sub == 5 || sub == 7 || sub == 8) {
                const bf16* Am; const bf16* Bt; int K = 2048; float* C = (float*)(ws + WS_SCR + SC_C);
                if (sub == 5) { Am = (const bf16*)(ws + WS_YM); Bt = ab ? (const bf16*)(ws + WS_WABOUT) + (size_t)j * 2048 * 2048 : (const bf16*)(ws + WS_WCDOUT) + (size_t)j * 2048 * 2048; }
                else if (sub == 7) { Am = (const bf16*)(ws + WS_XN); Bt = (const bf16*)(ws + WS_WGATE) + (size_t)li * 2048 * 2048; }
                else { Am = (const bf16*)(ws + WS_PB) + (size_t)li * T * 256; Bt = (const bf16*)(ws + WS_WPROJ) + (size_t)li * 2048 * 256; K = 256; C = (float*)(ws + WS_SCR + SC_C2); }
                pg8::Gemm g{Am, Bt, T, 2048, K}; pg8::StaticOrder S; S.init(T, 2048, G, bid);
                pg8::EpiF32 E{C, 2048};
                if (PH_MASK & 4) pg8::gemm_phase<pg8::EpiF32, pg8::StaticOrder, true, true>(lds, g, S, E, tid);
            } else if (sub == 1) { if (ab) { if (PH_MASK & 8) phase_ab_pre(kp, bid, G, j, tid, wave, lane); } else { if (PH_MASK & 16) phase_cd_pre(kp, bid, G, j, lds, tid); } }
            else if (sub == 2) { if (!ab) { if (PH_MASK & 2048) phase_ssd_prep(kp, bid, G, j, lds, tid); } else { if (PH_MASK & 4096) phase_gla_prep(kp, bid, G, j, lds, tid); if (PH_MASK & 8192) phase_dn_prep(kp, bid, G, j, lds, tid); } }
            else if (sub == 3) { if (ab) { if (PH_MASK & 32) phase_ab_rec(kp, bid, G, j, lds, tid); } else { if (PH_MASK & 64) phase_cd_rec(kp, bid, G, j, lds, tid); } }
            else if (sub == 4) { if (ab) { if (PH_MASK & 128) phase_ab_post(kp, bid, G, j, tid, wave, lane); } else { if (PH_MASK & 256) phase_cd_post(kp, bid, G, j, tid, wave, lane); } }
            else if (sub == 6) { if (PH_MASK & 512) phase_res1(kp, li, gw, NGW, lane); }
            else { if (PH_MASK & 1024) phase_res2(kp, li, gw, NGW, lane); }
        }
        if (ph + 1 < A.ph_hi) { cg::this_grid().sync(); }
    }
}

extern "C" void kernel_launch(void* const* d_in, const int* in_sizes, int n_in, void* d_out, int out_size, void* d_ws, size_t ws_size, hipStream_t stream) {
    static int grid = 0;
    if (grid == 0) {
        if (n_in != 40 || (size_t)out_size != O_END || ws_size < WS_END) { fprintf(stderr, "kernel_launch: unexpected shapes: n_in %d out %d ws %zu\n", n_in, out_size, ws_size); grid = -1; return; }
        int dev = 0, cus = 0, per_cu = 0;
        if (hipGetDevice(&dev) != hipSuccess || hipDeviceGetAttribute(&cus, hipDeviceAttributeMultiprocessorCount, dev) != hipSuccess) { grid = -1; return; }
        if (hipFuncSetAttribute((const void*)mega_fwd, hipFuncAttributeMaxDynamicSharedMemorySize, LDS_BYTES) != hipSuccess) { fprintf(stderr, "kernel_launch: hipFuncSetAttribute failed\n"); grid = -1; return; }
        if (hipOccupancyMaxActiveBlocksPerMultiprocessor(&per_cu, (const void*)mega_fwd, NTHR, LDS_BYTES) != hipSuccess || per_cu < 1) { fprintf(stderr, "kernel_launch: occupancy query says %d\n", per_cu); per_cu = 1; }
        (void)hipGetLastError();
        grid = cus;
    }
    if (grid < 0) return;
    Args a{};
    for (int i = 0; i < 40; ++i) a.in[i] = (const float*)d_in[i];
    a.out = (float*)d_out; a.ws = (unsigned char*)d_ws;
#if MK_N_LAUNCHES == 1
    a.ph_lo = 0; a.ph_hi = N_PHASES;
    void* args[] = {&a};
    hipError_t e = hipLaunchCooperativeKernel((const void*)mega_fwd, dim3(grid), dim3(NTHR), args, LDS_BYTES, stream);
    if (e != hipSuccess) fprintf(stderr, "cooperative launch failed: %s (grid %d)\n", hipGetErrorString(e), grid);
#else
    for (int ph = 0; ph < N_PHASES; ++ph) { a.ph_lo = ph; a.ph_hi = ph + 1; mega_fwd<<<dim3(grid), dim3(NTHR), LDS_BYTES, stream>>>(a); }
#endif
}
```

```cpp
#include <hip/hip_runtime.h>
#include <hip/hip_cooperative_groups.h>
#include <cstdio>
#include <cstdint>
namespace cg = cooperative_groups;

#ifndef MK_N_LAUNCHES
#define MK_N_LAUNCHES 1
#endif

namespace pg8 {
#define PG8_LAS __attribute__((address_space(3)))
typedef unsigned short bf16_t;
typedef short bf16x8 __attribute__((ext_vector_type(8)));
typedef float f32x4 __attribute__((ext_vector_type(4)));
typedef unsigned u32x4 __attribute__((ext_vector_type(4)));
constexpr int BM = 256, BK = 64, HALF = 128, HTB = HALF * BK * 2  , STAGE_BYTES = 8 * HTB, NXCD = 8, WGM = 8;

__host__ __device__ __forceinline__ int lds_byte(int r, int c) { const int st = (r >> 4) * 2 + (c >> 5), rr = r & 15, cc = c & 31, ob = rr * 64 + cc * 2; return st * 1024 + (ob ^ (((ob >> 9) & 1) << 5)); }
__host__ __device__ __forceinline__ void stage_rc(int b, int& R, int& C) { const int st = b / 1024, sb = b % 1024, swz = sb ^ (((sb >> 9) & 1) << 5); R = (st >> 1) * 16 + swz / 64; C = (st & 1) * 32 + (swz % 64) / 2; }
__host__ __device__ __forceinline__ int perm32(int rho) { const int n = rho >> 4, i = rho & 15; return 8 * (i >> 2) + 4 * n + (i & 3); }

struct Unit { int pm, pn; };
struct Gemm { const bf16_t* A; const bf16_t* Bt; int M, N, K; };

struct StaticOrder {
    int nM, nN, nwg, G, c;
    __host__ __device__ void init(int M, int N, int G_, int c_) { nM = M / BM; nN = N / BM; nwg = nM * nN; G = G_; c = c_; }
    __host__ __device__ bool next(int i, Unit& u) const {
        const long L = (long)i * G + c; if (L >= nwg) return false;
        int wgid = (int)L; { const int q = nwg / NXCD, r = nwg % NXCD, xcd = wgid % NXCD, off = wgid / NXCD; wgid = (xcd < r ? xcd * (q + 1) : r * (q + 1) + (xcd - r) * q) + off; }
        const int nig = WGM * nN, gid = wgid / nig, fm = gid * WGM, gsz = (nM - fm) < WGM ? (nM - fm) : WGM;
        u.pm = fm + ((wgid % nig) % gsz); u.pn = (wgid % nig) / gsz; return true;
    }
    __device__ __forceinline__ void a_ready(const Unit&) const {}
    __device__ __forceinline__ void done(const Unit&) const {}
};

__device__ __forceinline__ unsigned cvt_pk_bf16(float lo, float hi) { unsigned r; asm volatile("v_cvt_pk_bf16_f32 %0, %1, %2" : "=v"(r) : "v"(lo), "v"(hi)); return r; }
struct EpiF32 {
    static constexpr bool PERM = false, AFTER_DRAIN = false;
    float* C; int ldc;
    __device__ __forceinline__ void operator()(const f32x4 (&acc)[2][2][4][2], const Unit& u, int wr, int wc, int fr, int fq) const {
        const int row0 = u.pm * BM + wr * 64 + fr, col0 = u.pn * BM + wc * 32 + 4 * fq;
#pragma unroll
        for (int ai = 0; ai < 2; ++ai)
#pragma unroll
            for (int m = 0; m < 4; ++m) { float* rowp = C + (size_t)(row0 + ai * HALF + m * 16) * ldc + col0;
#pragma unroll
                for (int bj = 0; bj < 2; ++bj)
#pragma unroll
                    for (int n = 0; n < 2; ++n) *(f32x4*)(rowp + bj * HALF + n * 16) = acc[ai][bj][m][n]; }
    }
};
struct EpiBf16 {
    static constexpr bool PERM = true, AFTER_DRAIN = false;
    bf16_t* O; int ldc;
    __device__ __forceinline__ void operator()(const f32x4 (&acc)[2][2][4][2], const Unit& u, int wr, int wc, int fr, int fq) const {
        const int row0 = u.pm * BM + wr * 64 + fr; const int col0 = u.pn * BM + wc * 32 + 8 * fq;
#pragma unroll
        for (int ai = 0; ai < 2; ++ai)
#pragma unroll
            for (int m = 0; m < 4; ++m) { bf16_t* rowp = O + (size_t)(row0 + ai * HALF + m * 16) * ldc + col0;
#pragma unroll
                for (int bj = 0; bj < 2; ++bj) { const f32x4 v0 = acc[ai][bj][m][0], v1 = acc[ai][bj][m][1];
                    u32x4 w; w.x = cvt_pk_bf16(v0[0], v0[1]); w.y = cvt_pk_bf16(v0[2], v0[3]); w.z = cvt_pk_bf16(v1[0], v1[1]); w.w = cvt_pk_bf16(v1[2], v1[3]);
                    *(u32x4*)(rowp + bj * HALF) = w; } }
    }
};
template <class Epi, class Sched, bool ALIGN_EPI = false, bool SP2 = false>
__device__ __forceinline__ void gemm_phase(PG8_LAS unsigned char* lds, const Gemm g, const Sched& S, const Epi& E, const int tid) {
    const int wid = __builtin_amdgcn_readfirstlane(tid >> 6), lane = tid & 63, wr = wid >> 2, wc = wid & 3, fr = lane & 15, fq = lane >> 4;
    const int K = g.K, nt = K / BK;
    unsigned voffA[2], voffB[2];
#pragma unroll
    for (int i = 0; i < 2; ++i) { int R, C; stage_rc(tid * 16 + i * 8192, R, C); const int Rb = Epi::PERM ? ((R & ~31) + perm32(R & 31)) : R;
        voffA[i] = (unsigned)(R * K + C) * 2u; voffB[i] = (unsigned)(Rb * K + C) * 2u; }
    const size_t kstep = (size_t)(BK * 2);
    const size_t hstep = (size_t)HALF * K * 2;
    const size_t tstep = 2 * hstep;
    const unsigned ldsw = (unsigned)wid * 1024u;
    const int aoff = lds_byte(wr * 64 + fr, fq * 8), boff = lds_byte(wc * 32 + fr, fq * 8);
#define PG8_SA(b, h) (((b) * 2 + (h)) * HTB)
#define PG8_SB(b, h) ((4 + (b) * 2 + (h)) * HTB)
#define PG8_STAGE(bufoff, gbase, voff) do { _Pragma("unroll") for (int _i = 0; _i < 2; ++_i) \
        __builtin_amdgcn_global_load_lds((const unsigned*)((const char*)(gbase) + (voff)[_i]), (PG8_LAS unsigned*)(lds + (bufoff) + ldsw + _i * 8192), 16, 0, 0); } while (0)
#define PG8_LDA(dst, b, h) do { _Pragma("unroll") for (int m = 0; m < 4; ++m) _Pragma("unroll") for (int k = 0; k < 2; ++k) dst[m][k] = *(const PG8_LAS bf16x8*)(lds + PG8_SA(b, h) + aoff + m * 2048 + k * 1024); } while (0)
#define PG8_LDB(dst, b, h) do { _Pragma("unroll") for (int n = 0; n < 2; ++n) _Pragma("unroll") for (int k = 0; k < 2; ++k) dst[n][k] = *(const PG8_LAS bf16x8*)(lds + PG8_SB(b, h) + boff + n * 2048 + k * 1024); } while (0)
#define PG8_MMA(ai, bj, At, Bt) do { __builtin_amdgcn_s_setprio(1); _Pragma("unroll") for (int m = 0; m < 4; ++m) _Pragma("unroll") for (int n = 0; n < 2; ++n) _Pragma("unroll") for (int k = 0; k < 2; ++k) \
        acc[ai][bj][m][n] = __builtin_amdgcn_mfma_f32_16x16x32_bf16(Bt[n][k], At[m][k], acc[ai][bj][m][n], 0, 0, 0); __builtin_amdgcn_s_setprio(0); } while (0)
#define PG8_WAIT_V(n) asm volatile("s_waitcnt vmcnt(" #n ")" ::: "memory")
#define PG8_WAIT_L(n) asm volatile("s_waitcnt lgkmcnt(" #n ")" ::: "memory")
#define PG8_BAR __builtin_amdgcn_s_barrier()
#define PG8_SCHED __builtin_amdgcn_sched_barrier(0)
    Unit cur, nxt; int ui = 0;
    if (!S.next(0, cur)) return;
    f32x4 acc[2][2][4][2];
#pragma unroll
    for (int a = 0; a < 2; ++a)
#pragma unroll
        for (int b = 0; b < 2; ++b)
#pragma unroll
            for (int m = 0; m < 4; ++m)
#pragma unroll
                for (int n = 0; n < 2; ++n) acc[a][b][m][n] = (f32x4){0.f, 0.f, 0.f, 0.f};
    bf16x8 At[4][2], B0[2][2], B1[2][2];
    const char* cA = (const char*)g.A + (size_t)cur.pm * tstep; const char* cB = (const char*)g.Bt + (size_t)cur.pn * tstep;
    S.a_ready(cur);
    if constexpr (SP2) {
        PG8_STAGE(PG8_SB(0, 0), cB, voffB); PG8_STAGE(PG8_SB(0, 1), cB + hstep, voffB); PG8_STAGE(PG8_SA(0, 0), cA, voffA); PG8_STAGE(PG8_SA(0, 1), cA + hstep, voffA);
        if (wr == 1) PG8_BAR;
        PG8_WAIT_V(2); PG8_BAR;
        PG8_STAGE(PG8_SB(1, 0), cB + kstep, voffB); PG8_STAGE(PG8_SA(1, 0), cA + kstep, voffA); PG8_STAGE(PG8_SB(1, 1), cB + hstep + kstep, voffB);
        PG8_WAIT_V(6); PG8_BAR;
    } else {
        PG8_STAGE(PG8_SB(0, 0), cB, voffB); PG8_STAGE(PG8_SA(0, 0), cA, voffA); PG8_STAGE(PG8_SB(0, 1), cB + hstep, voffB); PG8_STAGE(PG8_SA(0, 1), cA + hstep, voffA);
        if (wr == 1) PG8_BAR;
        PG8_WAIT_V(4); PG8_BAR;
        PG8_STAGE(PG8_SB(1, 0), cB + kstep, voffB); PG8_STAGE(PG8_SA(1, 0), cA + kstep, voffA); PG8_STAGE(PG8_SB(1, 1), cB + hstep + kstep, voffB);
        PG8_WAIT_V(6); PG8_BAR;
    }
    for (;;) {
        const bool has_next = S.next(ui + 1, nxt);
        const char* nA = has_next ? (const char*)g.A + (size_t)nxt.pm * tstep : cA; const char* nB = has_next ? (const char*)g.Bt + (size_t)nxt.pn * tstep : cB;
        for (int t = 0; t < nt; t += 2) {
            const bool last = (t == nt - 2);
            const char* a1 = cA + (size_t)(t + 1) * kstep;
            const char* a2 = last ? nA : cA + (size_t)(t + 2) * kstep; const char* b2 = last ? nB : cB + (size_t)(t + 2) * kstep;
            const char* a3 = a2 + kstep; const char* b3 = b2 + kstep;
            if (last && has_next) S.a_ready(nxt);
            if constexpr (SP2) {
            PG8_LDB(B0, 0, 0); PG8_LDB(B1, 0, 1); PG8_SCHED; PG8_LDA(At, 0, 0); PG8_STAGE(PG8_SA(1, 1), a1 + hstep, voffA);
            PG8_WAIT_V(8); PG8_WAIT_L(0); PG8_BAR; PG8_MMA(0, 0, At, B0); PG8_MMA(0, 1, At, B1); PG8_BAR; PG8_SCHED;
            PG8_LDA(At, 0, 1); PG8_STAGE(PG8_SB(0, 0), b2, voffB); PG8_STAGE(PG8_SB(0, 1), b2 + hstep, voffB); PG8_STAGE(PG8_SA(0, 0), a2, voffA);
            PG8_WAIT_V(8); PG8_WAIT_L(0); PG8_BAR; PG8_MMA(1, 0, At, B0); PG8_MMA(1, 1, At, B1); PG8_BAR; PG8_SCHED;
            PG8_LDB(B0, 1, 0); PG8_LDB(B1, 1, 1); PG8_SCHED; PG8_LDA(At, 1, 0); PG8_STAGE(PG8_SA(0, 1), a2 + hstep, voffA);
            PG8_WAIT_V(8); PG8_WAIT_L(0); PG8_BAR; PG8_MMA(0, 0, At, B0); PG8_MMA(0, 1, At, B1); PG8_BAR; PG8_SCHED;
            PG8_LDA(At, 1, 1); PG8_STAGE(PG8_SB(1, 0), b3, voffB); PG8_STAGE(PG8_SB(1, 1), b3 + hstep, voffB); PG8_STAGE(PG8_SA(1, 0), a3, voffA);
            PG8_WAIT_V(8); PG8_WAIT_L(0); PG8_BAR; PG8_MMA(1, 0, At, B0); PG8_MMA(1, 1, At, B1); PG8_BAR; PG8_SCHED;
            } else {
            PG8_LDB(B0, 0, 0); PG8_SCHED; PG8_LDA(At, 0, 0); PG8_STAGE(PG8_SA(1, 1), a1 + hstep, voffA);
            PG8_WAIT_L(8); PG8_BAR; PG8_WAIT_L(0); PG8_MMA(0, 0, At, B0); PG8_BAR; PG8_SCHED;
            PG8_LDB(B1, 0, 1); PG8_STAGE(PG8_SB(0, 0), b2, voffB);
            PG8_BAR; PG8_WAIT_L(0); PG8_MMA(0, 1, At, B1); PG8_BAR;
            PG8_LDA(At, 0, 1); PG8_STAGE(PG8_SA(0, 0), a2, voffA);
            PG8_BAR; PG8_WAIT_L(0); PG8_MMA(1, 0, At, B0); PG8_BAR; PG8_SCHED;
            PG8_STAGE(PG8_SB(0, 1), b2 + hstep, voffB);
            PG8_WAIT_V(6); PG8_BAR; PG8_MMA(1, 1, At, B1); PG8_BAR;
            PG8_LDB(B0, 1, 0); PG8_SCHED; PG8_LDA(At, 1, 0); PG8_STAGE(PG8_SA(0, 1), a2 + hstep, voffA);
            PG8_WAIT_L(8); PG8_BAR; PG8_WAIT_L(0); PG8_MMA(0, 0, At, B0); PG8_BAR; PG8_SCHED;
            PG8_LDB(B1, 1, 1); PG8_STAGE(PG8_SB(1, 0), b3, voffB);
            PG8_BAR; PG8_WAIT_L(0); PG8_MMA(0, 1, At, B1); PG8_BAR;
            PG8_LDA(At, 1, 1); PG8_STAGE(PG8_SA(1, 0), a3, voffA);
            PG8_BAR; PG8_WAIT_L(0); PG8_MMA(1, 0, At, B0); PG8_BAR; PG8_SCHED;
            PG8_STAGE(PG8_SB(1, 1), b3 + hstep, voffB);
            PG8_WAIT_V(6); PG8_BAR; PG8_MMA(1, 1, At, B1); PG8_BAR;
            }
        }
        if constexpr (ALIGN_EPI) { if (wr == 0) PG8_BAR; }
        if constexpr (!Epi::AFTER_DRAIN) { E(acc, cur, wr, wc, fr, fq); S.done(cur); }
        if (!has_next) break;
#pragma unroll
        for (int a = 0; a < 2; ++a)
#pragma unroll
            for (int b = 0; b < 2; ++b)
#pragma unroll
                for (int m = 0; m < 4; ++m)
#pragma unroll
                    for (int n = 0; n < 2; ++n) acc[a][b][m][n] = (f32x4){0.f, 0.f, 0.f, 0.f};
        cur = nxt; cA = nA; cB = nB; ++ui;
        if constexpr (ALIGN_EPI) { if (wr == 1) PG8_BAR; }
    }
    PG8_WAIT_V(0);
    if constexpr (!ALIGN_EPI) { if (wr == 0) PG8_BAR; }
    PG8_BAR;
    if constexpr (Epi::AFTER_DRAIN) { E.fused(acc, cur, wr, wc, fr, fq, lds, wid, lane); S.done(cur); }
#undef PG8_SA
#undef PG8_SB
#undef PG8_STAGE
#undef PG8_LDA
#undef PG8_LDB
#undef PG8_MMA
#undef PG8_WAIT_V
#undef PG8_WAIT_L
#undef PG8_BAR
#undef PG8_SCHED
}
}

constexpr int TP = 8192, TS = 512, T = TP + TS, DM = 2048, NSEQ = 132;
constexpr int NAB = 7424, NCD = 4864;
constexpr int NWAVES = 8, NTHR = 512;
constexpr size_t MiB = 1u << 20;
constexpr size_t WS_CTL = 0, CTL_ZERO_BYTES = 65536;
constexpr int CW_BAR = 4096;
constexpr size_t WS_WABIN = 2 * MiB, WS_WABOUT = 60 * MiB, WS_WCDIN = 76 * MiB, WS_WCDOUT = 114 * MiB, WS_WGATE = 130 * MiB, WS_WPROJ = 162 * MiB;
constexpr size_t WS_H = 166 * MiB, WS_XN = 234 * MiB, WS_YM = 268 * MiB, WS_PB = 302 * MiB, WS_U = 320 * MiB, WS_SCR = 444 * MiB, WS_END = 712 * MiB;
constexpr size_t SC_C = 0, SC_C2 = 68 * MiB;
constexpr size_t SC_QN = 0, SC_KN = 34 * MiB, SC_VV = 68 * MiB, SC_ODN = 102 * MiB, SC_OGLA = 136 * MiB, SC_GLOG = 170 * MiB, SC_BETA = 187 * MiB, SC_GDEC = 188 * MiB, SC_DNOPS = 192 * MiB, SC_DNGEND = 264 * MiB;
constexpr size_t SC_XBC = 0, SC_LA = 52 * MiB, SC_LB = 86 * MiB, SC_YS = 120 * MiB, SC_HS = 154 * MiB, SC_DT = 188 * MiB, SC_SSDOP = 192 * MiB, SC_GEND = 256 * MiB;
constexpr int LDS_BYTES = 163840;
constexpr size_t O_Y_P = 0, O_Y_S = O_Y_P + (size_t)4 * 2048 * 2048, O_DN_P = O_Y_S + (size_t)128 * 4 * 2048,
    O_DNC_P = O_DN_P + (size_t)2 * 4 * 8 * 128 * 128, O_GLA_P = O_DNC_P + (size_t)2 * 4 * 3 * 3072, O_SSD_P = O_GLA_P + (size_t)2 * 4 * 4 * 128 * 256,
    O_SSDC_P = O_SSD_P + (size_t)2 * 4 * 16 * 64 * 64, O_LRU_P = O_SSDC_P + (size_t)2 * 4 * 3 * 1536, O_LRUC_P = O_LRU_P + (size_t)2 * 4 * 1024,
    O_DN_S = O_LRUC_P + (size_t)2 * 4 * 3 * 1024, O_DNC_S = O_DN_S + (size_t)2 * 128 * 8 * 128 * 128, O_GLA_S = O_DNC_S + (size_t)2 * 128 * 3 * 3072,
    O_SSD_S = O_GLA_S + (size_t)2 * 128 * 4 * 128 * 256, O_SSDC_S = O_SSD_S + (size_t)2 * 128 * 16 * 64 * 64, O_LRU_S = O_SSDC_S + (size_t)2 * 128 * 3 * 1536,
    O_LRUC_S = O_LRU_S + (size_t)2 * 128 * 1024, O_END = O_LRUC_S + (size_t)2 * 128 * 3 * 1024;
static_assert(O_END == 109064192, "output size");

#define LAS __attribute__((address_space(3)))
typedef unsigned short bf16;
typedef float f32x4 __attribute__((ext_vector_type(4)));
typedef unsigned u32x2 __attribute__((ext_vector_type(2)));
typedef unsigned u32x4 __attribute__((ext_vector_type(4)));
#define LDS_WAIT() asm volatile("s_waitcnt lgkmcnt(0)" ::: "memory")

__device__ __forceinline__ float bf2f(bf16 b) { return __uint_as_float(((unsigned)b) << 16); }
__device__ __forceinline__ unsigned f2bf(float f) { unsigned u = __float_as_uint(f); return (u + 0x7fffu + ((u >> 16) & 1u)) >> 16; }
__device__ __forceinline__ unsigned pk2(float lo, float hi) { return f2bf(lo) | (f2bf(hi) << 16); }
__device__ __forceinline__ float sigmoid_(float x) { return 1.f / (1.f + expf(-x)); }
__device__ __forceinline__ float silu_(float x) { return x / (1.f + expf(-x)); }
__device__ __forceinline__ float softplus_(float x) { return x > 20.f ? x : log1pf(expf(x)); }
__device__ __forceinline__ float wave_sum(float v) {
#pragma unroll
    for (int o = 1; o < 64; o <<= 1) v += __shfl_xor(v, o);
    return v;
}
__device__ __forceinline__ void row_to_seq(int r, int& s, int& t) { if (r < TP) { s = r >> 11; t = r & 2047; } else { s = 4 + ((r - TP) >> 2); t = (r - TP) & 3; } }
__device__ __forceinline__ void seq_info(int s, int& row0, int& L) { if (s < 4) { row0 = s << 11; L = 2048; } else { row0 = TP + ((s - 4) << 2); L = 4; } }
__device__ __forceinline__ float pre_val(const bf16* U, int ldu, int ucol, int row0, int tt, int s, const float* stc, int W, int c) {
    if (tt >= 0) return bf2f(U[(size_t)(row0 + tt) * ldu + ucol]);
    if (s < 4) return 0.f;
    return stc[((size_t)(s - 4) * 3 + (3 + tt)) * W + c];
}
__device__ __forceinline__ int map_col(int mapid, int n) {
    if (mapid == 0) return n;
    if (mapid == 1) { if (n < 3072) return n; if (n < 6144) return n + 16; if (n < 7168) return n + 32; if (n < 7184) return n - 4096; if (n < 7200) return n - 1024; return -1; }
    if (n < 2560) return n; if (n < 4608) return n + 16; if (n < 4624) return n - 2048; return -1;
}
__device__ __forceinline__ void transpose_item(const float* W, int K, int Nsrc, bf16* WT, int Npad, int mapid, LAS float* scr, int item, int lane) {
    const int nblk = Npad / 32, kb = item / nblk, nb = item % nblk, k0 = 64 * kb, n0 = 32 * nb;
    const int src = map_col(mapid, n0 + (lane & 31));
#pragma unroll 8
    for (int i = 0; i < 32; ++i) { const int kk = 2 * i + (lane >> 5); scr[kk * 33 + (lane & 31)] = src >= 0 ? W[(size_t)(k0 + kk) * Nsrc + src] : 0.f; }
    LDS_WAIT(); asm volatile("" ::: "memory");
    const int c = lane & 7;
#pragma unroll
    for (int j = 0; j < 4; ++j) { const int n = (lane >> 3) + 8 * j; const LAS float* s = scr + (8 * c) * 33 + n;
        u32x4 o; o.x = pk2(s[0 * 33], s[1 * 33]); o.y = pk2(s[2 * 33], s[3 * 33]); o.z = pk2(s[4 * 33], s[5 * 33]); o.w = pk2(s[6 * 33], s[7 * 33]);
        *(u32x4*)(WT + (size_t)(n0 + n) * K + k0 + 8 * c) = o; }
    LDS_WAIT(); asm volatile("" ::: "memory");
}
__device__ __forceinline__ void norm_row_bf16(const f32x4 (&v)[8], const float* g, bf16* orow, int lane) {
    float ss = 0.f;
#pragma unroll
    for (int j = 0; j < 8; ++j) ss += (v[j].x * v[j].x + v[j].y * v[j].y) + (v[j].z * v[j].z + v[j].w * v[j].w);
    const float rstd = rsqrtf(wave_sum(ss) * (1.f / DM) + 1e-6f);
#pragma unroll
    for (int j = 0; j < 8; ++j) { const int col = 4 * (lane + 64 * j); const f32x4 gg = *(const f32x4*)(g + col);
        u32x2 o; o.x = pk2(v[j].x * rstd * gg.x, v[j].y * rstd * gg.y); o.y = pk2(v[j].z * rstd * gg.z, v[j].w * rstd * gg.w);
        *(u32x2*)(orow + col) = o; }
}

typedef __bf16 bf16x2_t __attribute__((ext_vector_type(2)));
typedef float f32x2_t __attribute__((ext_vector_type(2)));
typedef short bf16x8 __attribute__((ext_vector_type(8)));
typedef float f32x16 __attribute__((ext_vector_type(16)));
__device__ __forceinline__ unsigned cvtpk(float lo, float hi) { f32x2_t v = {lo, hi}; bf16x2_t b = __builtin_convertvector(v, bf16x2_t); return __builtin_bit_cast(unsigned, b); }
#define MFMA32(a, b, c) __builtin_amdgcn_mfma_f32_32x32x16_bf16((a), (b), (c), 0, 0, 0)
#define PACK_ACC(x, S_) __builtin_bit_cast(bf16x8, (u32x4){cvtpk((x)[8 * (S_)], (x)[8 * (S_) + 1]), cvtpk((x)[8 * (S_) + 2], (x)[8 * (S_) + 3]), cvtpk((x)[8 * (S_) + 4], (x)[8 * (S_) + 5]), cvtpk((x)[8 * (S_) + 6], (x)[8 * (S_) + 7])})
__device__ __forceinline__ int crow(int reg, int h) { return (reg & 3) + 8 * (reg >> 2) + 4 * h; }
__device__ __forceinline__ bf16x8 pack8(const float (&v)[8]) { return __builtin_bit_cast(bf16x8, (u32x4){cvtpk(v[0], v[1]), cvtpk(v[2], v[3]), cvtpk(v[4], v[5]), cvtpk(v[6], v[7])}); }

#define XB_TMO      128
#define XB_XCNT(j)  (256  + 64 * (j))
#define XB_XSUB(j)  (1280 + 64 * (j))
#define XB_XGEN(j)  (2304 + 64 * (j))
#define XB_TOP      3328
#define XB_TOPGEN   3392
#define XCD_BAR_WORDS 3456
#define XB_SPIN_CAP (1u << 18)

__device__ __forceinline__ unsigned xb_ld(unsigned* p)              { return __hip_atomic_load(p, __ATOMIC_RELAXED, __HIP_MEMORY_SCOPE_AGENT); }
__device__ __forceinline__ unsigned xb_add(unsigned* p, unsigned v) { return __hip_atomic_fetch_add(p, v, __ATOMIC_RELAXED, __HIP_MEMORY_SCOPE_AGENT); }
__device__ __forceinline__ unsigned xb_xcc_id() { return (unsigned)__builtin_amdgcn_s_getreg((3 << 11) | 20) & 0xFu; }
#define XB_SPIN(cond, bar) do { unsigned _sp = 0; while (cond) { __builtin_amdgcn_s_sleep(1); \
    if ((++_sp & 255u) == 0u) { if (xb_ld(&(bar)[XB_TMO])) break; if (_sp > XB_SPIN_CAP) { atomicAdd(&(bar)[XB_TMO], 1u); break; } } } } while (0)

struct XcdBarrier {
    unsigned* bar; unsigned x;
    volatile LAS unsigned* st;
};

__device__ __forceinline__ XcdBarrier xcd_barrier_post(unsigned* bar, volatile LAS unsigned* st) {
    XcdBarrier b; b.bar = bar; b.x = xb_xcc_id(); b.st = st;
    if (threadIdx.x == 0) (void)xb_add(&bar[XB_XCNT(b.x)], 1u);
    return b;
}
__device__ __forceinline__ void xcd_barrier_complete(unsigned* bar, unsigned x, unsigned& nloc, unsigned& nx) {
    const unsigned G = gridDim.x * gridDim.y * gridDim.z;
    unsigned sum, cnt, mine, sp = 0u;
    for (;;) {
        sum = 0u; cnt = 0u; mine = 0u;
#pragma unroll
        for (unsigned j = 0; j < 16; ++j) { const unsigned c = xb_ld(&bar[XB_XCNT(j)]); sum += c; cnt += (c > 0u) ? 1u : 0u; mine = (j == x) ? c : mine; }
        if (sum == G) break;
        __builtin_amdgcn_s_sleep(1);
        if ((++sp & 255u) == 0u) { if (xb_ld(&bar[XB_TMO])) break; if (sp > XB_SPIN_CAP) { atomicAdd(&bar[XB_TMO], 1u); break; } }
    }
    nloc = mine > 0u ? mine : 1u; nx = cnt > 0u ? cnt : 1u;
}

__device__ __forceinline__ void xcd_barrier(const XcdBarrier& b) {
    asm volatile("s_waitcnt vmcnt(0)" ::: "memory");
    __syncthreads();
    if (threadIdx.x == 0) {
        unsigned* bar = b.bar;
        __builtin_amdgcn_s_waitcnt(0);
        unsigned nloc = b.st[0], nx = b.st[1];
        if (nloc == 0u) { xcd_barrier_complete(bar, b.x, nloc, nx); b.st[0] = nloc; b.st[1] = nx; }
        const unsigned old = xb_add(&bar[XB_XSUB(b.x)], 1u);
        const unsigned gen = old / nloc;
        if (old + 1u == (gen + 1u) * nloc) {
            __builtin_amdgcn_fence(__ATOMIC_RELEASE, "agent");
            asm volatile("s_waitcnt vmcnt(0)" ::: "memory");
            const unsigned og = xb_add(&bar[XB_TOP], 1u);
            const unsigned tg = og / nx;
            if (og + 1u == (tg + 1u) * nx) xb_add(&bar[XB_TOPGEN], 1u);
            else XB_SPIN(xb_ld(&bar[XB_TOPGEN]) == tg, bar);
            __builtin_amdgcn_fence(__ATOMIC_ACQUIRE, "agent");
            xb_add(&bar[XB_XGEN(b.x)], 1u);
            asm volatile("s_waitcnt vmcnt(0)" ::: "memory");
        } else {
            XB_SPIN(xb_ld(&bar[XB_XGEN(b.x)]) == gen, bar);
            __builtin_amdgcn_fence(__ATOMIC_ACQUIRE, "agent");
            asm volatile("s_waitcnt vmcnt(0)" ::: "memory");
        }
    }
    __syncthreads();
}


struct Args { const float* in[40]; float* out; unsigned char* ws; int ph_lo, ph_hi; };
constexpr int N_PHASES = 41, SUBS = 10;
#ifndef PH_MASK
#define PH_MASK 16383
#endif
#define AS4 __attribute__((address_space(4)))
struct KP { const char AS4* p;
    __device__ __forceinline__ const float* in(int i) const { return *(const float* const AS4*)(p + 8 * i); }
    __device__ __forceinline__ float* out() const { return *(float* const AS4*)(p + 320); }
    __device__ __forceinline__ unsigned char* ws() const { return *(unsigned char* const AS4*)(p + 328); }
};
static_assert(sizeof(Args) == 344, "Args layout");

__device__ __forceinline__ void phase_prologue(const KP kp, LAS unsigned char* lds, int gw, int NGW, int wave, int lane) {
    unsigned char* ws = kp.ws();
    LAS float* scr = (LAS float*)(lds + wave * 16384);
    for (int job = 0; job < 16; ++job) {
        const float* W; int K = 2048, Nsrc = 2048, Npad = 2048, mapid = 0; bf16* WT;
        if (job < 2)       { W = kp.in(13) + (size_t)job * 2048 * 7200; Nsrc = 7200; Npad = NAB; mapid = 1; WT = (bf16*)(ws + WS_WABIN) + (size_t)job * NAB * 2048; }
        else if (job < 4)  { W = kp.in(21) + (size_t)(job - 2) * 2048 * 2048; WT = (bf16*)(ws + WS_WABOUT) + (size_t)(job - 2) * 2048 * 2048; }
        else if (job < 6)  { W = kp.in(22) + (size_t)(job - 4) * 2048 * 4624; Nsrc = 4624; Npad = NCD; mapid = 2; WT = (bf16*)(ws + WS_WCDIN) + (size_t)(job - 4) * NCD * 2048; }
        else if (job < 8)  { W = kp.in(36) + (size_t)(job - 6) * 2048 * 2048; WT = (bf16*)(ws + WS_WCDOUT) + (size_t)(job - 6) * 2048 * 2048; }
        else if (job < 12) { W = kp.in(39) + (size_t)(job - 8) * 2048 * 2048; WT = (bf16*)(ws + WS_WGATE) + (size_t)(job - 8) * 2048 * 2048; }
        else               { W = kp.in(37) + (size_t)(job - 12) * 256 * 2048; K = 256; WT = (bf16*)(ws + WS_WPROJ) + (size_t)(job - 12) * 2048 * 256; }
        const int nitems = (K / 64) * (Npad / 32);
        for (int it = gw; it < nitems; it += NGW) transpose_item(W, K, Nsrc, WT, Npad, mapid, scr, it, lane);
    }
    float* H = (float*)(ws + WS_H); bf16* XN = (bf16*)(ws + WS_XN);
    for (int m = gw; m < T; m += NGW) {
        const float* src = m < TP ? kp.in(0) + (size_t)m * DM : kp.in(1) + (size_t)(m - TP) * DM;
        f32x4 v[8];
#pragma unroll
        for (int j = 0; j < 8; ++j) { v[j] = *(const f32x4*)(src + 4 * (lane + 64 * j)); *(f32x4*)(H + (size_t)m * DM + 4 * (lane + 64 * j)) = v[j]; }
        norm_row_bf16(v, kp.in(11), XN + (size_t)m * DM, lane);
    }
    bf16* PB = (bf16*)(ws + WS_PB);
    const int gt = gw * 64 + lane, NGT = NGW * 64;
    for (int i = gt; i < 4 * T * 64; i += NGT) {
        const int c4 = i & 63, r = (i >> 6) % T, li = (i >> 6) / T;
        const float* src = r < TP ? kp.in(9) + ((size_t)li * TP + r) * 256 + 4 * c4 : kp.in(10) + ((size_t)li * TS + (r - TP)) * 256 + 4 * c4;
        const f32x4 v = *(const f32x4*)src;
        u32x2 o; o.x = pk2(v.x, v.y); o.y = pk2(v.z, v.w);
        *(u32x2*)(PB + ((size_t)li * T + r) * 256 + 4 * c4) = o;
    }
}

__device__ __forceinline__ void phase_res1(const KP kp, int li, int gw, int NGW, int lane) {
    float* H = (float*)(kp.ws() + WS_H); bf16* XN = (bf16*)(kp.ws() + WS_XN); const float* C = (const float*)(kp.ws() + WS_SCR + SC_C);
    for (int m = gw; m < T; m += NGW) {
        f32x4 v[8];
#pragma unroll
        for (int j = 0; j < 8; ++j) { const size_t o = (size_t)m * DM + 4 * (lane + 64 * j); v[j] = *(const f32x4*)(H + o) + *(const f32x4*)(C + o); *(f32x4*)(H + o) = v[j]; }
        norm_row_bf16(v, kp.in(38) + (size_t)li * DM, XN + (size_t)m * DM, lane);
    }
}
__device__ __forceinline__ void phase_res2(const KP kp, int li, int gw, int NGW, int lane) {
    float* H = (float*)(kp.ws() + WS_H); bf16* XN = (bf16*)(kp.ws() + WS_XN); const float* C = (const float*)(kp.ws() + WS_SCR + SC_C); const float* C2 = (const float*)(kp.ws() + WS_SCR + SC_C2);
    for (int m = gw; m < T; m += NGW) {
        f32x4 v[8];
#pragma unroll
        for (int j = 0; j < 8; ++j) { const size_t o = (size_t)m * DM + 4 * (lane + 64 * j); const f32x4 c = *(const f32x4*)(C + o), c2 = *(const f32x4*)(C2 + o); f32x4 h = *(const f32x4*)(H + o);
            h.x += sigmoid_(c.x) * c2.x; h.y += sigmoid_(c.y) * c2.y; h.z += sigmoid_(c.z) * c2.z; h.w += sigmoid_(c.w) * c2.w; v[j] = h; *(f32x4*)(H + o) = h; }
        if (li < 3) norm_row_bf16(v, kp.in(11) + (size_t)(li + 1) * DM, XN + (size_t)m * DM, lane);
        else {
            float ss = 0.f;
#pragma unroll
            for (int j = 0; j < 8; ++j) ss += (v[j].x * v[j].x + v[j].y * v[j].y) + (v[j].z * v[j].z + v[j].w * v[j].w);
            const float rstd = rsqrtf(wave_sum(ss) * (1.f / DM) + 1e-6f);
#pragma unroll
            for (int j = 0; j < 8; ++j) { const int col = 4 * (lane + 64 * j); const f32x4 gg = *(const f32x4*)(kp.in(12) + col);
                f32x4 o; o.x = v[j].x * rstd * gg.x; o.y = v[j].y * rstd * gg.y; o.z = v[j].z * rstd * gg.z; o.w = v[j].w * rstd * gg.w;
                *(f32x4*)(kp.out() + (size_t)m * DM + col) = o; }
        }
    }
}

__device__ __forceinline__ void phase_ab_pre(const KP kp, const int bid, const int G, int j, int tid, int wave, int lane) {
    unsigned char* scr = kp.ws() + WS_SCR; const bf16* U = (const bf16*)(kp.ws() + WS_U);
    float* QN = (float*)(scr + SC_QN); float* KN = (float*)(scr + SC_KN); float* VV = (float*)(scr + SC_VV);
    float* GLOG = (float*)(scr + SC_GLOG); float* BETA = (float*)(scr + SC_BETA); float* GDEC = (float*)(scr + SC_GDEC);
    const float* cw = kp.in(14) + (size_t)j * 4 * 3072; const float* stc = kp.in(3) + (size_t)j * 128 * 3 * 3072;
    const float* wa2 = kp.in(18) + (size_t)j * 16 * 512; const float* ba = kp.in(19) + (size_t)j * 512;
    for (int r = bid; r < T; r += G) {
        int s, t; row_to_seq(r, s, t); const int row0 = r - t;
#pragma unroll
        for (int part = 0; part < 3; ++part) {
            float val[2];
#pragma unroll
            for (int i = 0; i < 2; ++i) { const int c = part * 1024 + wave * 128 + lane + 64 * i; float acc = 0.f;
#pragma unroll
                for (int tap = 0; tap < 4; ++tap) acc += cw[tap * 3072 + c] * pre_val(U, NAB, c, row0, t - 3 + tap, s, stc, 3072, c);
                val[i] = silu_(acc); }
            if (part < 2) { const float ss = wave_sum(val[0] * val[0] + val[1] * val[1]); const float sc = rsqrtf(ss + 1e-6f) * (part == 0 ? 0.08838834764831845f : 1.f); val[0] *= sc; val[1] *= sc; }
            float* dst = part == 0 ? QN : (part == 1 ? KN : VV);
            dst[(size_t)r * 1024 + wave * 128 + lane] = val[0]; dst[(size_t)r * 1024 + wave * 128 + lane + 64] = val[1];
        }
        if (tid < 8) {
            BETA[(size_t)r * 8 + tid] = sigmoid_(bf2f(U[(size_t)r * NAB + 7168 + tid]));
            GDEC[(size_t)r * 8 + tid] = -expf(kp.in(15)[j * 8 + tid]) * softplus_(bf2f(U[(size_t)r * NAB + 7176 + tid]) + kp.in(16)[j * 8 + tid]);
        }
        { float x = ba[tid];
#pragma unroll
          for (int rr = 0; rr < 16; ++rr) x += bf2f(U[(size_t)r * NAB + 7184 + rr]) * wa2[rr * 512 + tid];
          GLOG[(size_t)r * 512 + tid] = -softplus_(-x) * (1.f / 16.f); }
    }
}


constexpr size_t GLA_ITEM_BYTES = 74752, WS_GLAOPS = WS_XN;
__device__ __forceinline__ void phase_gla_prep(const KP kp, const int bid, const int G, int j, LAS unsigned char* lds, int tid) {
    const bf16* U = (const bf16*)(kp.ws() + WS_U); const float* GLOG = (const float*)(kp.ws() + WS_SCR + SC_GLOG);
    unsigned char* OPS = kp.ws() + WS_GLAOPS;
    LAS float* GL = (LAS float*)lds; LAS float* QL = GL + 64 * 129; LAS float* KL = QL + 64 * 129; LAS float* AL = KL + 64 * 129;
    const int lane = tid & 63, r = lane & 31, hp = lane >> 5;
    for (int item = bid; item < 512; item += G) {
        const int b = item >> 7, n = (item >> 2) & 31, h = item & 3;
        const int row0 = b * 2048 + n * 64;
        __syncthreads();
        for (int i = tid; i < 8192; i += NTHR) { const int t = i >> 7, d = i & 127; const size_t ro = (size_t)(row0 + t) * NAB;
            QL[t * 129 + d] = bf2f(U[ro + 4096 + h * 128 + d]) * 0.08838834764831845f; KL[t * 129 + d] = bf2f(U[ro + 4608 + h * 128 + d]);
            GL[t * 129 + d] = GLOG[(size_t)(row0 + t) * 512 + h * 128 + d]; }
        __syncthreads();
        if (tid < 128) { float acc = 0.f;
#pragma unroll 4
            for (int t = 0; t < 64; ++t) { acc += GL[t * 129 + tid]; GL[t * 129 + tid] = acc; } }
        __syncthreads();
        for (int i = tid; i < 8192; i += NTHR) { const int t = i >> 7, d = i & 127; const float gg = GL[t * 129 + d]; QL[t * 129 + d] *= expf(gg); KL[t * 129 + d] *= expf(-gg); }
        __syncthreads();
        { const int i = tid >> 3, jg = tid & 7; float acc[8];
#pragma unroll
          for (int jj = 0; jj < 8; ++jj) acc[jj] = 0.f;
#pragma unroll 4
          for (int d = 0; d < 128; ++d) { const float c = QL[i * 129 + d];
#pragma unroll
              for (int jj = 0; jj < 8; ++jj) acc[jj] += c * KL[(jg * 8 + jj) * 129 + d]; }
#pragma unroll
          for (int jj = 0; jj < 8; ++jj) AL[i * 65 + jg * 8 + jj] = (jg * 8 + jj) <= i ? acc[jj] : 0.f; }
        __syncthreads();
        bf16x8* base = (bf16x8*)(OPS + (size_t)item * GLA_ITEM_BYTES);
        float v[8];
#pragma unroll
        for (int q = 0; q < 2; ++q) { const int f = (tid >> 6) + 8 * q;
            { const int mt = f >> 3, ks = f & 7, i = 32 * mt + r;
#pragma unroll
              for (int jp = 0; jp < 8; ++jp) v[jp] = QL[i * 129 + 16 * ks + 8 * (jp >> 2) + 4 * hp + (jp & 3)];
              base[f * 64 + lane] = pack8(v); }
            { const int mt = f >> 2, ks = f & 3, d = 32 * mt + r; const float eg = expf(GL[63 * 129 + d]);
#pragma unroll
              for (int jp = 0; jp < 8; ++jp) v[jp] = KL[(16 * ks + 8 * (jp >> 2) + 4 * hp + (jp & 3)) * 129 + d] * eg;
              base[(16 + f) * 64 + lane] = pack8(v); } }
        { const int f = tid >> 6, mt = f >> 2, ks = f & 3, i = 32 * mt + r;
#pragma unroll
          for (int jp = 0; jp < 8; ++jp) v[jp] = AL[i * 65 + 16 * ks + 8 * (jp >> 2) + 4 * hp + (jp & 3)];
          base[(32 + f) * 64 + lane] = pack8(v); }
#pragma unroll
        for (int q = 0; q < 4; ++q) { const int f = (tid >> 6) + 8 * q, nt = f >> 2, ks = f & 3, p = 32 * nt + r;
            unsigned w[4];
#pragma unroll
            for (int jp = 0; jp < 8; jp += 2) { const int t0 = 16 * ks + 8 * (jp >> 2) + 4 * hp + (jp & 3);
                w[jp >> 1] = (unsigned)U[(size_t)(row0 + t0) * NAB + 5120 + h * 256 + p] | ((unsigned)U[(size_t)(row0 + t0 + 1) * NAB + 5120 + h * 256 + p] << 16); }
            base[(40 + f) * 64 + lane] = __builtin_bit_cast(bf16x8, (u32x4){w[0], w[1], w[2], w[3]}); }
        if (tid < 128) ((float*)(base + 72 * 64))[tid] = expf(GL[63 * 129 + tid]);
    }
}


constexpr size_t DN_ITEM_BYTES = 73728;
__device__ __forceinline__ void phase_dn_prep(const KP kp, const int bid, const int G, int j, LAS unsigned char* lds, int tid0) {
    unsigned char* scr = kp.ws() + WS_SCR;
    const float* QN = (const float*)(scr + SC_QN); const float* KN = (const float*)(scr + SC_KN); const float* VV = (const float*)(scr + SC_VV);
    const float* BETA = (const float*)(scr + SC_BETA); const float* GDEC = (const float*)(scr + SC_GDEC);
    unsigned char* OPS = scr + SC_DNOPS; float* GENDD = (float*)(scr + SC_DNGEND);
    LAS float* AMT = (LAS float*)lds; LAS float* GLs = AMT + 64 * 68; LAS float* BLs = GLs + 64; LAS float* KL = BLs + 64; LAS float* QL = KL + 64 * 129; LAS float* XL = QL + 64 * 129;
    for (int item = bid; item < 1024; item += G) {
        int tid = tid0; asm volatile("" : "+v"(tid));
        const int lane = tid & 63, r = lane & 31, hp = lane >> 5, wave = tid >> 6;
        const int b = item >> 8, n = (item >> 3) & 31, h = item & 7;
        const int row0 = b * 2048 + n * 64;
        __syncthreads();
        for (int i = tid; i < 8192; i += NTHR) { const int t = i >> 7, d = i & 127; const size_t ro = (size_t)(row0 + t) * 1024 + h * 128 + d; KL[t * 129 + d] = KN[ro]; QL[t * 129 + d] = QN[ro]; }
        if (wave == 0) { float gv = GDEC[(size_t)(row0 + lane) * 8 + h];
#pragma unroll
            for (int o = 1; o < 64; o <<= 1) { const float tt = __shfl_up(gv, o); if (lane >= o) gv += tt; }
            GLs[lane] = gv; BLs[lane] = BETA[(size_t)(row0 + lane) * 8 + h]; }
        __syncthreads();
        bf16x8* base = (bf16x8*)(OPS + (size_t)item * DN_ITEM_BYTES);
        { const int i = tid >> 3, ks = (tid >> 1) & 3, hk = tid & 1; float kk[8], qk[8];
#pragma unroll
          for (int jp = 0; jp < 8; ++jp) { kk[jp] = 0.f; qk[jp] = 0.f; }
#pragma unroll 2
          for (int d = 0; d < 128; ++d) { const float kc = KL[i * 129 + d], qc = QL[i * 129 + d];
#pragma unroll
              for (int jp = 0; jp < 8; ++jp) { const float kj = KL[(16 * ks + 8 * (jp >> 2) + 4 * hk + (jp & 3)) * 129 + d]; kk[jp] += kc * kj; qk[jp] += qc * kj; } }
          const float gi = GLs[i], bi = BLs[i]; float v[8];
#pragma unroll
          for (int jp = 0; jp < 8; ++jp) { const int jt = 16 * ks + 8 * (jp >> 2) + 4 * hk + (jp & 3); const float dec = expf(gi - GLs[jt]);
              AMT[jt * 68 + i] = jt < i ? bi * kk[jp] * dec : 0.f; v[jp] = jt <= i ? qk[jp] * dec : 0.f; }
          base[(48 + (i >> 5) * 4 + ks) * 64 + (i & 31) + 32 * hk] = pack8(v); }
        __syncthreads();
        if (tid < 256) {
            const int c = tid;
#pragma unroll
            for (int bi = 0; bi < 4; ++bi) {
                float acc[16];
#pragma unroll
                for (int ii = 0; ii < 16; ++ii) { const int i = 16 * bi + ii; const float be = BLs[i];
                    acc[ii] = c < 128 ? be * VV[(size_t)(row0 + i) * 1024 + h * 128 + c] : be * expf(GLs[i]) * KL[i * 129 + (c - 128)]; }
                for (int jj = 0; jj < 16 * bi; ++jj) { const float xj = XL[jj * 257 + c];
#pragma unroll
                    for (int q = 0; q < 4; ++q) { const f32x4 a = *(const LAS f32x4*)(AMT + jj * 68 + 16 * bi + 4 * q);
                        acc[4 * q + 0] -= a[0] * xj; acc[4 * q + 1] -= a[1] * xj; acc[4 * q + 2] -= a[2] * xj; acc[4 * q + 3] -= a[3] * xj; } }
#pragma unroll
                for (int ii = 0; ii < 16; ++ii) { float x = acc[ii];
#pragma unroll
                    for (int jj = 0; jj < ii; ++jj) x -= AMT[(16 * bi + jj) * 68 + 16 * bi + ii] * acc[jj];
                    acc[ii] = x; XL[(16 * bi + ii) * 257 + c] = x; }
            }
        }
        __syncthreads();
        float v[8];
#pragma unroll
        for (int q = 0; q < 2; ++q) { const int f = wave + 8 * q;
            { const int mt = f >> 3, ks = f & 7, i = 32 * mt + r;
#pragma unroll
              for (int jp = 0; jp < 8; ++jp) v[jp] = -XL[i * 257 + 128 + 16 * ks + 8 * (jp >> 2) + 4 * hp + (jp & 3)];
              base[f * 64 + lane] = pack8(v);
              const float eg = expf(GLs[i]);
#pragma unroll
              for (int jp = 0; jp < 8; ++jp) v[jp] = QL[i * 129 + 16 * ks + 8 * (jp >> 2) + 4 * hp + (jp & 3)] * eg;
              base[(16 + f) * 64 + lane] = pack8(v); }
            { const int mt = f >> 2, ks = f & 3, d = 32 * mt + r; const float Gend = GLs[63];
#pragma unroll
              for (int jp = 0; jp < 8; ++jp) { const int tk = 16 * ks + 8 * (jp >> 2) + 4 * hp + (jp & 3); v[jp] = KL[tk * 129 + d] * expf(Gend - GLs[tk]); }
              base[(32 + f) * 64 + lane] = pack8(v); }
            { const int pq = f & 1, tl = f >> 1, mt = tl >> 2, nt = tl & 3;
#pragma unroll
              for (int e = 0; e < 8; ++e) v[e] = XL[(32 * mt + crow(8 * pq + e, hp)) * 257 + 32 * nt + r];
              base[(56 + f) * 64 + lane] = pack8(v); } }
        if (tid == 0) GENDD[item] = expf(GLs[63]);
    }
}

__device__ __forceinline__ void phase_ab_rec(const KP kp, const int bid, const int G, int j, LAS unsigned char* lds, int tid0) {
    unsigned char* scr = kp.ws() + WS_SCR; const bf16* U = (const bf16*)(kp.ws() + WS_U);
    const float* QN = (const float*)(scr + SC_QN); const float* KN = (const float*)(scr + SC_KN); const float* VV = (const float*)(scr + SC_VV);
    const float* GLOG = (const float*)(scr + SC_GLOG); const float* BETA = (const float*)(scr + SC_BETA); const float* GDEC = (const float*)(scr + SC_GDEC);
    float* ODN = (float*)(scr + SC_ODN); float* OGLA = (float*)(scr + SC_OGLA);
    LAS float* SL = (LAS float*)lds;
    for (int item = bid; item < 1600; item += G) {
        int tid = tid0; asm volatile("" : "+v"(tid));
        int s, h; bool isdn; int half = -1;
        if (item < 32) { isdn = false; s = item >> 3; h = (item >> 1) & 3; half = item & 1; }
        else if (item < 64) { isdn = true; s = (item - 32) >> 3; h = (item - 32) & 7; half = -2; }
        else if (item < 1088) { isdn = true; s = 4 + ((item - 64) >> 3); h = (item - 64) & 7; }
        else { isdn = false; s = 4 + ((item - 1088) >> 2); h = (item - 1088) & 3; }
        int row0, L; seq_info(s, row0, L);
        __syncthreads();
        if (half == -2) {
            const int wave = __builtin_amdgcn_readfirstlane(tid >> 6), lane = tid & 63, r = lane & 31, hp = lane >> 5;
            const int b = s, nt = wave;
            const unsigned char* OPS = scr + SC_DNOPS; const float* GENDD = (const float*)(scr + SC_DNGEND);
            constexpr int DBUF = 72 * 1024;
#define DN_DMA(n_, bufi_) do { const unsigned char* gi_ = OPS + (size_t)((b * 32 + (n_)) * 8 + h) * DN_ITEM_BYTES + lane * 16; \
                _Pragma("unroll") for (int q_ = 0; q_ < 9; ++q_) { const int lf_ = wave + 8 * q_; \
                    __builtin_amdgcn_global_load_lds((const unsigned*)(gi_ + lf_ * 1024), (LAS unsigned*)(lds + (bufi_) * DBUF + lf_ * 1024), 16, 0, 0); } } while (0)
            f32x16 S0, S1, S2, S3;
#pragma unroll
            for (int i = 0; i < 16; ++i) { S0[i] = 0.f; S1[i] = 0.f; S2[i] = 0.f; S3[i] = 0.f; }
            DN_DMA(0, 0);
            asm volatile("s_waitcnt vmcnt(0)" ::: "memory"); __syncthreads();
            for (int n = 0; n < 32; ++n) {
                if (n + 1 < 32) DN_DMA(n + 1, (n + 1) & 1);
                if (wave < 4) {
                    const LAS bf16x8* F = (const LAS bf16x8*)(lds + (n & 1) * DBUF) + lane;
                    const float gend = GENDD[(b * 32 + n) * 8 + h];
                    const bf16x8 sb0 = PACK_ACC(S0, 0), sb1 = PACK_ACC(S0, 1), sb2 = PACK_ACC(S1, 0), sb3 = PACK_ACC(S1, 1), sb4 = PACK_ACC(S2, 0), sb5 = PACK_ACC(S2, 1), sb6 = PACK_ACC(S3, 0), sb7 = PACK_ACC(S3, 1);
                    f32x16 U0t, U1t;
                    { const bf16x8 a0 = F[(56 + nt * 2 + 0) * 64], a1 = F[(56 + nt * 2 + 1) * 64], c0 = F[(56 + (4 + nt) * 2 + 0) * 64], c1 = F[(56 + (4 + nt) * 2 + 1) * 64];
#pragma unroll
                      for (int e = 0; e < 8; ++e) { U0t[e] = bf2f((bf16)a0[e]); U0t[8 + e] = bf2f((bf16)a1[e]); U1t[e] = bf2f((bf16)c0[e]); U1t[8 + e] = bf2f((bf16)c1[e]); } }
                    U0t = MFMA32(F[0 * 64], sb0, U0t); U0t = MFMA32(F[1 * 64], sb1, U0t); U0t = MFMA32(F[2 * 64], sb2, U0t); U0t = MFMA32(F[3 * 64], sb3, U0t);
                    U0t = MFMA32(F[4 * 64], sb4, U0t); U0t = MFMA32(F[5 * 64], sb5, U0t); U0t = MFMA32(F[6 * 64], sb6, U0t); U0t = MFMA32(F[7 * 64], sb7, U0t);
                    U1t = MFMA32(F[8 * 64], sb0, U1t); U1t = MFMA32(F[9 * 64], sb1, U1t); U1t = MFMA32(F[10 * 64], sb2, U1t); U1t = MFMA32(F[11 * 64], sb3, U1t);
                    U1t = MFMA32(F[12 * 64], sb4, U1t); U1t = MFMA32(F[13 * 64], sb5, U1t); U1t = MFMA32(F[14 * 64], sb6, U1t); U1t = MFMA32(F[15 * 64], sb7, U1t);
                    const bf16x8 ub0 = PACK_ACC(U0t, 0), ub1 = PACK_ACC(U0t, 1), ub2 = PACK_ACC(U1t, 0), ub3 = PACK_ACC(U1t, 1);
                    f32x16 O0, O1;
#pragma unroll
                    for (int i = 0; i < 16; ++i) { O0[i] = 0.f; O1[i] = 0.f; }
                    O0 = MFMA32(F[16 * 64], sb0, O0); O0 = MFMA32(F[17 * 64], sb1, O0); O0 = MFMA32(F[18 * 64], sb2, O0); O0 = MFMA32(F[19 * 64], sb3, O0);
                    O0 = MFMA32(F[20 * 64], sb4, O0); O0 = MFMA32(F[21 * 64], sb5, O0); O0 = MFMA32(F[22 * 64], sb6, O0); O0 = MFMA32(F[23 * 64], sb7, O0);
                    O1 = MFMA32(F[24 * 64], sb0, O1); O1 = MFMA32(F[25 * 64], sb1, O1); O1 = MFMA32(F[26 * 64], sb2, O1); O1 = MFMA32(F[27 * 64], sb3, O1);
                    O1 = MFMA32(F[28 * 64], sb4, O1); O1 = MFMA32(F[29 * 64], sb5, O1); O1 = MFMA32(F[30 * 64], sb6, O1); O1 = MFMA32(F[31 * 64], sb7, O1);
                    O0 = MFMA32(F[48 * 64], ub0, O0); O0 = MFMA32(F[49 * 64], ub1, O0);
                    O1 = MFMA32(F[52 * 64], ub0, O1); O1 = MFMA32(F[53 * 64], ub1, O1); O1 = MFMA32(F[54 * 64], ub2, O1); O1 = MFMA32(F[55 * 64], ub3, O1);
#pragma unroll
                    for (int i = 0; i < 16; ++i) { S0[i] *= gend; S1[i] *= gend; S2[i] *= gend; S3[i] *= gend; }
                    S0 = MFMA32(F[32 * 64], ub0, S0); S0 = MFMA32(F[33 * 64], ub1, S0); S0 = MFMA32(F[34 * 64], ub2, S0); S0 = MFMA32(F[35 * 64], ub3, S0);
                    S1 = MFMA32(F[36 * 64], ub0, S1); S1 = MFMA32(F[37 * 64], ub1, S1); S1 = MFMA32(F[38 * 64], ub2, S1); S1 = MFMA32(F[39 * 64], ub3, S1);
                    S2 = MFMA32(F[40 * 64], ub0, S2); S2 = MFMA32(F[41 * 64], ub1, S2); S2 = MFMA32(F[42 * 64], ub2, S2); S2 = MFMA32(F[43 * 64], ub3, S2);
                    S3 = MFMA32(F[44 * 64], ub0, S3); S3 = MFMA32(F[45 * 64], ub1, S3); S3 = MFMA32(F[46 * 64], ub2, S3); S3 = MFMA32(F[47 * 64], ub3, S3);
                    float* yo = ODN + (size_t)(b * 2048 + n * 64) * 1024 + h * 128 + 32 * nt + r;
#pragma unroll
                    for (int i = 0; i < 16; ++i) { yo[(size_t)crow(i, hp) * 1024] = O0[i]; yo[(size_t)(32 + crow(i, hp)) * 1024] = O1[i]; }
                }
                asm volatile("s_waitcnt vmcnt(0)" ::: "memory"); __syncthreads();
            }
#undef DN_DMA
            if (wave < 4) {
                float* dst = kp.out() + O_DN_P + ((size_t)j * 4 + b) * ((size_t)8 * 128 * 128) + (size_t)h * 128 * 128 + 32 * nt + r;
#pragma unroll
                for (int i = 0; i < 16; ++i) { dst[(size_t)crow(i, hp) * 128] = S0[i]; dst[(size_t)(32 + crow(i, hp)) * 128] = S1[i]; dst[(size_t)(64 + crow(i, hp)) * 128] = S2[i]; dst[(size_t)(96 + crow(i, hp)) * 128] = S3[i]; }
            }
        } else if (half >= 0) {
            const int wave = __builtin_amdgcn_readfirstlane(tid >> 6), lane = tid & 63, r = lane & 31, hp = lane >> 5;
            const int b = s, nt = half * 4 + wave;
            const unsigned char* OPS = kp.ws() + WS_GLAOPS;
            constexpr int GBUF = 57 * 1024;
#define GLA_DMA(n_, bufi_) do { const unsigned char* gi_ = OPS + (size_t)((b * 32 + (n_)) * 4 + h) * GLA_ITEM_BYTES + lane * 16; \
                _Pragma("unroll") for (int q_ = 0; q_ < 8; ++q_) { const int lf_ = wave + 8 * q_; if (lf_ < 57) { const int gf_ = lf_ < 40 ? lf_ : (lf_ < 56 ? lf_ + half * 16 : 72); \
                    __builtin_amdgcn_global_load_lds((const unsigned*)(gi_ + gf_ * 1024), (LAS unsigned*)(lds + (bufi_) * GBUF + lf_ * 1024), 16, 0, 0); } } } while (0)
            f32x16 S0, S1, S2, S3;
#pragma unroll
            for (int i = 0; i < 16; ++i) { S0[i] = 0.f; S1[i] = 0.f; S2[i] = 0.f; S3[i] = 0.f; }
            GLA_DMA(0, 0);
            asm volatile("s_waitcnt vmcnt(0)" ::: "memory"); __syncthreads();
            for (int n = 0; n < 32; ++n) {
                if (n + 1 < 32) GLA_DMA(n + 1, (n + 1) & 1);
                if (wave < 4) {
                    const LAS bf16x8* F = (const LAS bf16x8*)(lds + (n & 1) * GBUF) + lane;
                    const LAS float* ge = (const LAS float*)(lds + (n & 1) * GBUF + 56 * 1024) + 4 * hp;
                    const bf16x8 sb0 = PACK_ACC(S0, 0), sb1 = PACK_ACC(S0, 1), sb2 = PACK_ACC(S1, 0), sb3 = PACK_ACC(S1, 1), sb4 = PACK_ACC(S2, 0), sb5 = PACK_ACC(S2, 1), sb6 = PACK_ACC(S3, 0), sb7 = PACK_ACC(S3, 1);
                    f32x16 O0, O1;
#pragma unroll
                    for (int i = 0; i < 16; ++i) { O0[i] = 0.f; O1[i] = 0.f; }
                    O0 = MFMA32(F[0 * 64], sb0, O0); O0 = MFMA32(F[1 * 64], sb1, O0); O0 = MFMA32(F[2 * 64], sb2, O0); O0 = MFMA32(F[3 * 64], sb3, O0);
                    O0 = MFMA32(F[4 * 64], sb4, O0); O0 = MFMA32(F[5 * 64], sb5, O0); O0 = MFMA32(F[6 * 64], sb6, O0); O0 = MFMA32(F[7 * 64], sb7, O0);
                    O1 = MFMA32(F[8 * 64], sb0, O1); O1 = MFMA32(F[9 * 64], sb1, O1); O1 = MFMA32(F[10 * 64], sb2, O1); O1 = MFMA32(F[11 * 64], sb3, O1);
                    O1 = MFMA32(F[12 * 64], sb4, O1); O1 = MFMA32(F[13 * 64], sb5, O1); O1 = MFMA32(F[14 * 64], sb6, O1); O1 = MFMA32(F[15 * 64], sb7, O1);
                    bf16x8 vb[4];
#pragma unroll
                    for (int ks = 0; ks < 4; ++ks) vb[ks] = F[(40 + wave * 4 + ks) * 64];
                    O0 = MFMA32(F[32 * 64], vb[0], O0); O0 = MFMA32(F[33 * 64], vb[1], O0);
#pragma unroll
                    for (int ks = 0; ks < 4; ++ks) O1 = MFMA32(F[(36 + ks) * 64], vb[ks], O1);
#pragma unroll
                    for (int q = 0; q < 4; ++q) { const f32x4 g0 = *(const LAS f32x4*)(ge + 8 * q), g1 = *(const LAS f32x4*)(ge + 32 + 8 * q), g2 = *(const LAS f32x4*)(ge + 64 + 8 * q), g3 = *(const LAS f32x4*)(ge + 96 + 8 * q);
#pragma unroll
                        for (int c = 0; c < 4; ++c) { S0[4 * q + c] *= g0[c]; S1[4 * q + c] *= g1[c]; S2[4 * q + c] *= g2[c]; S3[4 * q + c] *= g3[c]; } }
#pragma unroll
                    for (int ks = 0; ks < 4; ++ks) { S0 = MFMA32(F[(16 + ks) * 64], vb[ks], S0); S1 = MFMA32(F[(20 + ks) * 64], vb[ks], S1); S2 = MFMA32(F[(24 + ks) * 64], vb[ks], S2); S3 = MFMA32(F[(28 + ks) * 64], vb[ks], S3); }
                    float* yo = OGLA + (size_t)(b * 2048 + n * 64) * 1024 + h * 256 + 32 * nt + r;
#pragma unroll
                    for (int i = 0; i < 16; ++i) { yo[(size_t)crow(i, hp) * 1024] = O0[i]; yo[(size_t)(32 + crow(i, hp)) * 1024] = O1[i]; }
                }
                asm volatile("s_waitcnt vmcnt(0)" ::: "memory"); __syncthreads();
            }
#undef GLA_DMA
            if (wave < 4) {
                float* dst = kp.out() + O_GLA_P + ((size_t)j * 4 + b) * ((size_t)4 * 128 * 256) + (size_t)h * 128 * 256 + 32 * nt + r;
#pragma unroll
                for (int i = 0; i < 16; ++i) { dst[(size_t)crow(i, hp) * 256] = S0[i]; dst[(size_t)(32 + crow(i, hp)) * 256] = S1[i]; dst[(size_t)(64 + crow(i, hp)) * 256] = S2[i]; dst[(size_t)(96 + crow(i, hp)) * 256] = S3[i]; }
            }
        } else
        if (isdn) {
            LAS float* kL = SL + 16384; LAS float* qL = kL + 128; LAS float* red = kL + 256; LAS float* red2 = kL + 768;
            const int e = tid & 127, dq = tid >> 7;
            const size_t SZ = (size_t)8 * 128 * 128;
            const float* st = kp.in(2) + ((size_t)j * 128 + (s < 4 ? 0 : s - 4)) * SZ + (size_t)h * 128 * 128;
#pragma unroll 4
            for (int i = 0; i < 32; ++i) { const int d = dq * 32 + i; SL[d * 128 + e] = s < 4 ? 0.f : st[(size_t)d * 128 + e]; }
            for (int t = 0; t < L; ++t) {
                const size_t r = (size_t)(row0 + t);
                if (tid < 128) kL[tid] = KN[r * 1024 + h * 128 + tid]; else if (tid < 256) qL[tid - 128] = QN[r * 1024 + h * 128 + (tid - 128)];
                const float ve = VV[r * 1024 + h * 128 + e], beta = BETA[r * 8 + h], a = expf(GDEC[r * 8 + h]);
                __syncthreads();
                float part = 0.f;
#pragma unroll 4
                for (int i = 0; i < 32; ++i) { const int d = dq * 32 + i; const float sv = SL[d * 128 + e] * a; SL[d * 128 + e] = sv; part += kL[d] * sv; }
                red[dq * 128 + e] = part;
                __syncthreads();
                const float kS = (red[e] + red[128 + e]) + (red[256 + e] + red[384 + e]);
                const float u = beta * (ve - kS);
                float part2 = 0.f;
#pragma unroll 4
                for (int i = 0; i < 32; ++i) { const int d = dq * 32 + i; const float sv = SL[d * 128 + e] + kL[d] * u; SL[d * 128 + e] = sv; part2 += qL[d] * sv; }
                red2[dq * 128 + e] = part2;
                __syncthreads();
                if (dq == 0) ODN[r * 1024 + h * 128 + e] = (red2[e] + red2[128 + e]) + (red2[256 + e] + red2[384 + e]);
            }
            float* dst = s < 4 ? kp.out() + O_DN_P + ((size_t)j * 4 + s) * SZ + (size_t)h * 128 * 128 : kp.out() + O_DN_S + ((size_t)j * 128 + (s - 4)) * SZ + (size_t)h * 128 * 128;
#pragma unroll 4
            for (int i = 0; i < 32; ++i) { const int d = dq * 32 + i; dst[(size_t)d * 128 + e] = SL[d * 128 + e]; }
        } else {
            LAS float* kL = SL + 32768; LAS float* qL = kL + 128; LAS float* aL = kL + 256; LAS float* red = kL + 384;
            const int e = tid & 255, dh = tid >> 8;
            const size_t SZ = (size_t)4 * 128 * 256;
            const float* st = kp.in(4) + ((size_t)j * 128 + (s < 4 ? 0 : s - 4)) * SZ + (size_t)h * 128 * 256;
#pragma unroll 4
            for (int i = 0; i < 64; ++i) { const int d = dh * 64 + i; SL[d * 256 + e] = s < 4 ? 0.f : st[(size_t)d * 256 + e]; }
            for (int t = 0; t < L; ++t) {
                const size_t r = (size_t)(row0 + t);
                if (tid < 128) kL[tid] = bf2f(U[r * NAB + 4608 + h * 128 + tid]);
                else if (tid < 256) qL[tid - 128] = bf2f(U[r * NAB + 4096 + h * 128 + (tid - 128)]) * 0.08838834764831845f;
                else if (tid < 384) aL[tid - 256] = expf(GLOG[r * 512 + h * 128 + (tid - 256)]);
                const float ve = bf2f(U[r * NAB + 5120 + h * 256 + e]);
                __syncthreads();
                float part = 0.f;
#pragma unroll 4
                for (int i = 0; i < 64; ++i) { const int d = dh * 64 + i; const float sv = aL[d] * SL[d * 256 + e] + kL[d] * ve; SL[d * 256 + e] = sv; part += qL[d] * sv; }
                red[dh * 256 + e] = part;
                __syncthreads();
                if (dh == 0) OGLA[r * 1024 + h * 256 + e] = red[e] + red[256 + e];
            }
            float* dst = s < 4 ? kp.out() + O_GLA_P + ((size_t)j * 4 + s) * SZ + (size_t)h * 128 * 256 : kp.out() + O_GLA_S + ((size_t)j * 128 + (s - 4)) * SZ + (size_t)h * 128 * 256;
#pragma unroll 4
            for (int i = 0; i < 64; ++i) { const int d = dh * 64 + i; dst[(size_t)d * 256 + e] = SL[d * 256 + e]; }
        }
    }
}

__device__ __forceinline__ void phase_ab_post(const KP kp, const int bid, const int G, int j, int tid, int wave, int lane) {
    unsigned char* scr = kp.ws() + WS_SCR; const bf16* U = (const bf16*)(kp.ws() + WS_U); bf16* YM = (bf16*)(kp.ws() + WS_YM);
    const float* ODN = (const float*)(scr + SC_ODN); const float* OGLA = (const float*)(scr + SC_OGLA);
    const float* dnn = kp.in(17) + (size_t)j * 128; const float* glan = kp.in(20) + (size_t)j * 256;
    for (int r = bid; r < T; r += G) {
        int s, t; row_to_seq(r, s, t); int row0, L; seq_info(s, row0, L);
        { float o[2];
#pragma unroll
          for (int i = 0; i < 2; ++i) o[i] = ODN[(size_t)r * 1024 + wave * 128 + lane + 64 * i];
          const float rstd = rsqrtf(wave_sum(o[0] * o[0] + o[1] * o[1]) * (1.f / 128.f) + 1e-6f);
#pragma unroll
          for (int i = 0; i < 2; ++i) { const int e = lane + 64 * i; const float z = bf2f(U[(size_t)r * NAB + 3072 + wave * 128 + e]);
              YM[(size_t)r * DM + wave * 128 + e] = (bf16)f2bf(o[i] * rstd * dnn[e] * silu_(z)); } }
        if (wave < 4) { float o[4]; float ss = 0.f;
#pragma unroll
          for (int i = 0; i < 4; ++i) { o[i] = OGLA[(size_t)r * 1024 + wave * 256 + lane + 64 * i]; ss += o[i] * o[i]; }
          const float rstd = rsqrtf(wave_sum(ss) * (1.f / 256.f) + 1e-6f);
#pragma unroll
          for (int i = 0; i < 4; ++i) { const int e = lane + 64 * i; const float z = bf2f(U[(size_t)r * NAB + 6144 + wave * 256 + e]);
              YM[(size_t)r * DM + 1024 + wave * 256 + e] = (bf16)f2bf(o[i] * rstd * glan[e] * silu_(z)); } }
        if (t >= L - 3) { const int rr = t - (L - 3);
            float* dst = s < 4 ? kp.out() + O_DNC_P + (((size_t)j * 4 + s) * 3 + rr) * 3072 : kp.out() + O_DNC_S + (((size_t)j * 128 + (s - 4)) * 3 + rr) * 3072;
            for (int c = tid; c < 3072; c += NTHR) dst[c] = bf2f(U[(size_t)r * NAB + c]); }
    }
}

__device__ __forceinline__ void phase_cd_pre(const KP kp, const int bid, const int G, int j, LAS unsigned char* lds, int tid) {
    unsigned char* scr = kp.ws() + WS_SCR; const bf16* U = (const bf16*)(kp.ws() + WS_U);
    float* XBC = (float*)(scr + SC_XBC); float* LA = (float*)(scr + SC_LA); float* LB = (float*)(scr + SC_LB); float* DT = (float*)(scr + SC_DT);
    const float* cw = kp.in(23) + (size_t)j * 4 * 1536; const float* cb = kp.in(24) + (size_t)j * 1536; const float* stc = kp.in(6) + (size_t)j * 128 * 3 * 1536;
    const float* lcw = kp.in(29) + (size_t)j * 4 * 1024; const float* lcb = kp.in(30) + (size_t)j * 1024; const float* lstc = kp.in(8) + (size_t)j * 128 * 3 * 1024;
    const float* wa = kp.in(31) + (size_t)j * 16 * 64 * 64; const float* wx = kp.in(33) + (size_t)j * 16 * 64 * 64;
    const float* lba = kp.in(32) + (size_t)j * 1024; const float* lbx = kp.in(34) + (size_t)j * 1024; const float* lam = kp.in(35) + (size_t)j * 1024;
    LAS float* xcL = (LAS float*)lds;
    for (int r = bid; r < T; r += G) {
        int s, t; row_to_seq(r, s, t); const int row0 = r - t;
#pragma unroll
        for (int i = 0; i < 3; ++i) { const int c = tid + NTHR * i; float acc = cb[c];
#pragma unroll
            for (int tap = 0; tap < 4; ++tap) acc += cw[tap * 1536 + c] * pre_val(U, NCD, 1024 + c, row0, t - 3 + tap, s, stc, 1536, c);
            XBC[(size_t)r * 1536 + c] = silu_(acc); }
        if (tid < 16) DT[(size_t)r * 16 + tid] = softplus_(bf2f(U[(size_t)r * NCD + 4608 + tid]) + kp.in(26)[j * 16 + tid]);
        float xc[2];
#pragma unroll
        for (int i = 0; i < 2; ++i) { const int ch = tid + NTHR * i; float acc = lcb[ch];
#pragma unroll
            for (int tap = 0; tap < 4; ++tap) acc += lcw[tap * 1024 + ch] * pre_val(U, NCD, 3584 + ch, row0, t - 3 + tap, s, lstc, 1024, ch);
            xc[i] = acc; xcL[ch] = acc; }
        __syncthreads();
#pragma unroll
        for (int i = 0; i < 2; ++i) { const int ch = tid + NTHR * i, n = ch >> 6, d = ch & 63; float ra = lba[ch], ix = lbx[ch];
#pragma unroll 8
            for (int c = 0; c < 64; ++c) { const float x = xcL[n * 64 + c]; ra += x * wa[(size_t)(n * 64 + c) * 64 + d]; ix += x * wx[(size_t)(n * 64 + c) * 64 + d]; }
            const float rg = sigmoid_(ra), ig = sigmoid_(ix);
            const float log_a = -8.f * rg * softplus_(-lam[ch]);
            LA[(size_t)r * 1024 + ch] = expf(log_a);
            LB[(size_t)r * 1024 + ch] = sqrtf(-expm1f(2.f * log_a)) * (ig * xc[i]); }
        __syncthreads();
    }
}


__device__ __forceinline__ void phase_ssd_prep(const KP kp, const int bid, const int G, int j, LAS unsigned char* lds, int tid) {
    unsigned char* scr = kp.ws() + WS_SCR;
    const float* XBC = (const float*)(scr + SC_XBC); const float* DT = (const float*)(scr + SC_DT);
    unsigned char* OPS = scr + SC_SSDOP; float* GEND = (float*)(scr + SC_GEND);
    LAS float* CL = (LAS float*)lds; LAS float* BL = CL + 64 * 65; LAS float* QK = BL + 64 * 65; LAS float* GL = QK + 64 * 65;
    const float* alog = kp.in(25) + j * 16;
    const int wave = tid >> 6, lane = tid & 63;
    for (int item = bid; item < 512; item += G) {
        const int b = item >> 7, n = (item >> 2) & 31, g = item & 3;
        const int row0 = b * 2048 + n * 64;
        __syncthreads();
        for (int i = tid; i < 4096; i += NTHR) { const int t = i >> 6, d = i & 63;
            BL[t * 65 + d] = XBC[(size_t)(row0 + t) * 1536 + 1024 + g * 64 + d];
            CL[t * 65 + d] = XBC[(size_t)(row0 + t) * 1536 + 1280 + g * 64 + d]; }
        if (wave < 4) { const int h = g * 4 + wave; float gv = -expf(alog[h]) * DT[(size_t)(row0 + lane) * 16 + h];
#pragma unroll
            for (int o = 1; o < 64; o <<= 1) { const float tt = __shfl_up(gv, o); if (lane >= o) gv += tt; }
            GL[wave * 64 + lane] = gv; }
        __syncthreads();
        { const int i = tid >> 3, jg = tid & 7; float acc[8];
#pragma unroll
          for (int jj = 0; jj < 8; ++jj) acc[jj] = 0.f;
#pragma unroll 4
          for (int d = 0; d < 64; ++d) { const float c = CL[i * 65 + d];
#pragma unroll
              for (int jj = 0; jj < 8; ++jj) acc[jj] += c * BL[(jg * 8 + jj) * 65 + d]; }
#pragma unroll
          for (int jj = 0; jj < 8; ++jj) QK[i * 65 + jg * 8 + jj] = acc[jj]; }
        __syncthreads();
        const int f = wave, r = lane & 31, hp = lane >> 5, mt = f >> 2, ks = f & 3;
        for (int hh = 0; hh < 4; ++hh) {
            const int h = g * 4 + hh; const LAS float* Gh = GL + hh * 64; const float Gend = Gh[63];
            bf16x8* base = (bf16x8*)(OPS + ((size_t)((b * 32 + n) * 16 + h)) * 32768);
            float v[8];
            { const int i = 32 * mt + r; const float eg = expf(Gh[i]);
#pragma unroll
              for (int jp = 0; jp < 8; ++jp) { const int d = 16 * ks + 8 * (jp >> 2) + 4 * hp + (jp & 3); v[jp] = CL[i * 65 + d] * eg; }
              base[0 * 512 + f * 64 + lane] = pack8(v); }
            { const int d = 32 * mt + r;
#pragma unroll
              for (int jp = 0; jp < 8; ++jp) { const int tk = 16 * ks + 8 * (jp >> 2) + 4 * hp + (jp & 3); v[jp] = BL[tk * 65 + d] * expf(Gend - Gh[tk]); }
              base[1 * 512 + f * 64 + lane] = pack8(v); }
            { const int i = 32 * mt + r; const float gi = Gh[i];
#pragma unroll
              for (int jp = 0; jp < 8; ++jp) { const int jt = 16 * ks + 8 * (jp >> 2) + 4 * hp + (jp & 3); v[jp] = jt <= i ? QK[i * 65 + jt] * expf(gi - Gh[jt]) : 0.f; }
              base[2 * 512 + f * 64 + lane] = pack8(v); }
            { const int p = 32 * mt + r;
#pragma unroll
              for (int jp = 0; jp < 8; ++jp) { const int tk = 16 * ks + 8 * (jp >> 2) + 4 * hp + (jp & 3);
                  v[jp] = XBC[(size_t)(row0 + tk) * 1536 + h * 64 + p] * DT[(size_t)(row0 + tk) * 16 + h]; }
              base[3 * 512 + f * 64 + lane] = pack8(v); }
            if (tid == 0) GEND[(b * 32 + n) * 16 + h] = expf(Gend);
        }
    }
}

__device__ __forceinline__ void phase_cd_rec(const KP kp, const int bid, const int G, int j, LAS unsigned char* lds, int tid0) {
    unsigned char* scr = kp.ws() + WS_SCR;
    const float* XBC = (const float*)(scr + SC_XBC); const float* LA = (const float*)(scr + SC_LA); const float* LB = (const float*)(scr + SC_LB); const float* DT = (const float*)(scr + SC_DT);
    float* YS = (float*)(scr + SC_YS); float* HS = (float*)(scr + SC_HS);
    LAS float* bL = (LAS float*)lds; LAS float* cL = bL + 64; LAS float* red = bL + 128;
    for (int item = bid; item < 2328; item += G) {
        int tid = tid0; asm volatile("" : "+v"(tid));
        int kind, s, h;
        if (item < 16) { kind = 2; s = item >> 2; h = item & 3; }
        else if (item < 24) { kind = 1; s = (item - 16) >> 1; h = (item - 16) & 1; }
        else if (item < 2072) { kind = 0; s = 4 + ((item - 24) >> 4); h = (item - 24) & 15; }
        else { kind = 1; s = 4 + ((item - 2072) >> 1); h = (item - 2072) & 1; }
        int row0, L; seq_info(s, row0, L);
        __syncthreads();
        if (kind == 2) {
            const int wave = __builtin_amdgcn_readfirstlane(tid >> 6), lane = tid & 63, r = lane & 31, hp = lane >> 5;
            const int b = s, hd = h * 4 + (wave >> 1), nt = wave & 1;
            const unsigned char* OPS = scr + SC_SSDOP; const float* GEND = (const float*)(scr + SC_GEND);
            f32x16 S0, S1;
#pragma unroll
            for (int i = 0; i < 16; ++i) { S0[i] = 0.f; S1[i] = 0.f; }
            for (int n = 0; n < 32; ++n) {
                const bf16x8* F = (const bf16x8*)(OPS + ((size_t)((b * 32 + n) * 16 + hd)) * 32768) + lane;
                bf16x8 qg[2][4], kT[2][4], Am[2][4], vb[4];
#pragma unroll
                for (int mt = 0; mt < 2; ++mt)
#pragma unroll
                    for (int ks = 0; ks < 4; ++ks) { qg[mt][ks] = F[(0 * 8 + mt * 4 + ks) * 64]; kT[mt][ks] = F[(1 * 8 + mt * 4 + ks) * 64]; Am[mt][ks] = F[(2 * 8 + mt * 4 + ks) * 64]; }
#pragma unroll
                for (int ks = 0; ks < 4; ++ks) vb[ks] = F[(3 * 8 + nt * 4 + ks) * 64];
                const float gend = GEND[(b * 32 + n) * 16 + hd];
                const bf16x8 sb00 = PACK_ACC(S0, 0), sb01 = PACK_ACC(S0, 1), sb10 = PACK_ACC(S1, 0), sb11 = PACK_ACC(S1, 1);
                f32x16 O0, O1;
#pragma unroll
                for (int i = 0; i < 16; ++i) { O0[i] = 0.f; O1[i] = 0.f; }
                O0 = MFMA32(qg[0][0], sb00, O0); O0 = MFMA32(qg[0][1], sb01, O0); O0 = MFMA32(qg[0][2], sb10, O0); O0 = MFMA32(qg[0][3], sb11, O0);
                O1 = MFMA32(qg[1][0], sb00, O1); O1 = MFMA32(qg[1][1], sb01, O1); O1 = MFMA32(qg[1][2], sb10, O1); O1 = MFMA32(qg[1][3], sb11, O1);
                O0 = MFMA32(Am[0][0], vb[0], O0); O0 = MFMA32(Am[0][1], vb[1], O0);
#pragma unroll
                for (int ks = 0; ks < 4; ++ks) O1 = MFMA32(Am[1][ks], vb[ks], O1);
#pragma unroll
                for (int i = 0; i < 16; ++i) { S0[i] *= gend; S1[i] *= gend; }
#pragma unroll
                for (int ks = 0; ks < 4; ++ks) { S0 = MFMA32(kT[0][ks], vb[ks], S0); S1 = MFMA32(kT[1][ks], vb[ks], S1); }
                float* yo = YS + (size_t)(b * 2048 + n * 64) * 1024 + hd * 64 + 32 * nt + r;
#pragma unroll
                for (int i = 0; i < 16; ++i) { yo[(size_t)crow(i, hp) * 1024] = O0[i]; yo[(size_t)(32 + crow(i, hp)) * 1024] = O1[i]; }
            }
            float* dst = kp.out() + O_SSD_P + ((size_t)j * 4 + b) * ((size_t)16 * 64 * 64) + (size_t)hd * 64 * 64 + 32 * nt + r;
#pragma unroll
            for (int i = 0; i < 16; ++i) { dst[(size_t)crow(i, hp) * 64] = S0[i]; dst[(size_t)(32 + crow(i, hp)) * 64] = S1[i]; }
        } else if (kind == 0) {
            const int p = tid & 63, ng = tid >> 6, grp = h >> 2;
            const size_t SZ = (size_t)16 * 64 * 64;
            float S[8];
            if (s < 4) {
#pragma unroll
                for (int i = 0; i < 8; ++i) S[i] = 0.f;
            } else { const float* st = kp.in(5) + ((size_t)j * 128 + (s - 4)) * SZ + (size_t)h * 64 * 64;
#pragma unroll
                for (int i = 0; i < 8; ++i) S[i] = st[(size_t)(ng * 8 + i) * 64 + p]; }
            const float negA = -expf(kp.in(25)[j * 16 + h]);
            for (int t = 0; t < L; ++t) {
                const size_t r = (size_t)(row0 + t);
                if (tid < 64) bL[tid] = XBC[r * 1536 + 1024 + grp * 64 + tid]; else if (tid < 128) cL[tid - 64] = XBC[r * 1536 + 1280 + grp * 64 + (tid - 64)];
                const float xp = XBC[r * 1536 + h * 64 + p], dt = DT[r * 16 + h], a = expf(negA * dt), xdt = xp * dt;
                __syncthreads();
                float part = 0.f;
#pragma unroll
                for (int i = 0; i < 8; ++i) { const int n = ng * 8 + i; S[i] = a * S[i] + bL[n] * xdt; part += cL[n] * S[i]; }
                red[ng * 64 + p] = part;
                __syncthreads();
                if (ng == 0) { float y = 0.f;
#pragma unroll
                    for (int g = 0; g < 8; ++g) y += red[g * 64 + p];
                    YS[r * 1024 + h * 64 + p] = y; }
            }
            float* dst = s < 4 ? kp.out() + O_SSD_P + ((size_t)j * 4 + s) * SZ + (size_t)h * 64 * 64 : kp.out() + O_SSD_S + ((size_t)j * 128 + (s - 4)) * SZ + (size_t)h * 64 * 64;
#pragma unroll
            for (int i = 0; i < 8; ++i) dst[(size_t)(ng * 8 + i) * 64 + p] = S[i];
        } else {
            const int ch = h * 512 + tid;
            float hh = s < 4 ? 0.f : kp.in(7)[((size_t)j * 128 + (s - 4)) * 1024 + ch];
#pragma unroll 8
            for (int t = 0; t < L; ++t) { const size_t r = (size_t)(row0 + t); hh = LA[r * 1024 + ch] * hh + LB[r * 1024 + ch]; HS[r * 1024 + ch] = hh; }
            float* dst = s < 4 ? kp.out() + O_LRU_P + ((size_t)j * 4 + s) * 1024 : kp.out() + O_LRU_S + ((size_t)j * 128 + (s - 4)) * 1024;
            dst[ch] = hh;
        }
    }
}

__device__ __forceinline__ void phase_cd_post(const KP kp, const int bid, const int G, int j, int tid, int wave, int lane) {
    unsigned char* scr = kp.ws() + WS_SCR; const bf16* U = (const bf16*)(kp.ws() + WS_U); bf16* YM = (bf16*)(kp.ws() + WS_YM);
    const float* YS = (const float*)(scr + SC_YS); const float* HS = (const float*)(scr + SC_HS); const float* XBC = (const float*)(scr + SC_XBC);
    const float* sn = kp.in(28) + (size_t)j * 1024;
    for (int r = bid; r < T; r += G) {
        int s, t; row_to_seq(r, s, t); int row0, L; seq_info(s, row0, L);
        if (wave < 4) { float y[4]; float ss = 0.f;
#pragma unroll
            for (int i = 0; i < 4; ++i) { const int e = wave * 256 + lane + 64 * i; y[i] = (YS[(size_t)r * 1024 + e] + kp.in(27)[j * 16 + (e >> 6)] * XBC[(size_t)r * 1536 + e]) * silu_(bf2f(U[(size_t)r * NCD + e])); ss += y[i] * y[i]; }
            const float rstd = rsqrtf(wave_sum(ss) * (1.f / 256.f) + 1e-6f);
#pragma unroll
            for (int i = 0; i < 4; ++i) { const int e = wave * 256 + lane + 64 * i; YM[(size_t)r * DM + e] = (bf16)f2bf(y[i] * rstd * sn[e]); }
        } else {
#pragma unroll
            for (int i = 0; i < 4; ++i) { const int ch = (wave - 4) * 256 + lane + 64 * i;
                YM[(size_t)r * DM + 1024 + ch] = (bf16)f2bf(HS[(size_t)r * 1024 + ch] * silu_(bf2f(U[(size_t)r * NCD + 2560 + ch]))); }
        }
        if (t >= L - 3) { const int rr = t - (L - 3);
            float* d1 = s < 4 ? kp.out() + O_SSDC_P + (((size_t)j * 4 + s) * 3 + rr) * 1536 : kp.out() + O_SSDC_S + (((size_t)j * 128 + (s - 4)) * 3 + rr) * 1536;
            for (int c = tid; c < 1536; c += NTHR) d1[c] = bf2f(U[(size_t)r * NCD + 1024 + c]);
            float* d2 = s < 4 ? kp.out() + O_LRUC_P + (((size_t)j * 4 + s) * 3 + rr) * 1024 : kp.out() + O_LRUC_S + (((size_t)j * 128 + (s - 4)) * 3 + rr) * 1024;
            for (int c = tid; c < 1024; c += NTHR) d2[c] = bf2f(U[(size_t)r * NCD + 3584 + c]); }
    }
}

__global__ void __launch_bounds__(NTHR, 2) mega_fwd(Args A) {
    extern __shared__ __attribute__((aligned(16))) unsigned char lds_raw[];
    LAS unsigned char* lds = (LAS unsigned char*)lds_raw;
    const int G = gridDim.x;
    volatile LAS unsigned* bst = (volatile LAS unsigned*)(lds + LDS_BYTES - 16);
    if (threadIdx.x == 0) { bst[0] = 0u; bst[1] = 0u; }
    __syncthreads();
    XcdBarrier xbar = xcd_barrier_post((unsigned*)(A.ws + WS_CTL) + CW_BAR, bst);
#ifdef PROBE_GROUP
    unsigned long long t_prev = __builtin_amdgcn_s_memrealtime(), t_sel = 0;
#endif
    for (int ph = A.ph_lo; ph < A.ph_hi; ++ph) {
        KP kp; kp.p = (const char AS4*)__builtin_amdgcn_kernarg_segment_ptr(); asm volatile("" : "+s"(kp.p));
        unsigned char* ws = kp.ws();
        int tid = threadIdx.x; asm volatile("" : "+v"(tid));
        int bid = blockIdx.x; asm volatile("" : "+s"(bid));
        const int lane = tid & 63, wave = __builtin_amdgcn_readfirstlane(tid >> 6), gw = bid * NWAVES + wave, NGW = G * NWAVES;
        if (ph == 0) { if (PH_MASK & 1) phase_prologue(kp, lds, gw, NGW, wave, lane); }
        else {
            const int li = (ph - 1) / SUBS, sub = (ph - 1) % SUBS, j = li >> 1; const bool ab = (li & 1) == 0;
            if (sub == 0) {
                const int N = ab ? NAB : NCD;
                const bf16* Bt = ab ? (const bf16*)(ws + WS_WABIN) + (size_t)j * NAB * 2048 : (const bf16*)(ws + WS_WCDIN) + (size_t)j * NCD * 2048;
                pg8::Gemm g{(const bf16*)(ws + WS_XN), Bt, T, N, 2048}; pg8::StaticOrder S; S.init(T, N, G, bid);
                pg8::EpiBf16 E{(bf16*)(ws + WS_U), N};
                if (PH_MASK & 2) pg8::gemm_phase<pg8::EpiBf16, pg8::StaticOrder, true, true>(lds, g, S, E, tid);
            } else if (sub == 5 || sub == 7 || sub == 8) {
                const bf16* Am; const bf16* Bt; int K = 2048; float* C = (float*)(ws + WS_SCR + SC_C);
                if (sub == 5) { Am = (const bf16*)(ws + WS_YM); Bt = ab ? (const bf16*)(ws + WS_WABOUT) + (size_t)j * 2048 * 2048 : (const bf16*)(ws + WS_WCDOUT) + (size_t)j * 2048 * 2048; }
                else if (sub == 7) { Am = (const bf16*)(ws + WS_XN); Bt = (const bf16*)(ws + WS_WGATE) + (size_t)li * 2048 * 2048; }
                else { Am = (const bf16*)(ws + WS_PB) + (size_t)li * T * 256; Bt = (const bf16*)(ws + WS_WPROJ) + (size_t)li * 2048 * 256; K = 256; C = (float*)(ws + WS_SCR + SC_C2); }
                pg8::Gemm g{Am, Bt, T, 2048, K}; pg8::StaticOrder S; S.init(T, 2048, G, bid);
                pg8::EpiF32 E{C, 2048};
                if (PH_MASK & 4) pg8::gemm_phase<pg8::EpiF32, pg8::StaticOrder, true, true>(lds, g, S, E, tid);
            } else if (sub == 1) { if (ab) { if (PH_MASK & 8) phase_ab_pre(kp, bid, G, j, tid, wave, lane); } else { if (PH_MASK & 16) phase_cd_pre(kp, bid, G, j, lds, tid); } }
            else if (sub == 2) { if (!ab) { if (PH_MASK & 2048) phase_ssd_prep(kp, bid, G, j, lds, tid); } else { if (PH_MASK & 4096) phase_gla_prep(kp, bid, G, j, lds, tid); if (PH_MASK & 8192) phase_dn_prep(kp, bid, G, j, lds, tid); } }
            else if (sub == 3) { if (ab) { if (PH_MASK & 32) phase_ab_rec(kp, bid, G, j, lds, tid); } else { if (PH_MASK & 64) phase_cd_rec(kp, bid, G, j, lds, tid); } }
            else if (sub == 4) { if (ab) { if (PH_MASK & 128) phase_ab_post(kp, bid, G, j, tid, wave, lane); } else { if (PH_MASK & 256) phase_cd_post(kp, bid, G, j, tid, wave, lane); } }
            else if (sub == 6) { if (PH_MASK & 512) phase_res1(kp, li, gw, NGW, lane); }
            else { if (PH_MASK & 1024) phase_res2(kp, li, gw, NGW, lane); }
        }
        if (ph + 1 < A.ph_hi) { if (ph == A.ph_lo) cg::this_grid().sync(); else xcd_barrier(xbar); }
#ifdef PROBE_GROUP
        { const unsigned long long t_now = __builtin_amdgcn_s_memrealtime(); const int li_ = (ph - 1) / SUBS, sub_ = (ph - 1) % SUBS; const bool ab_ = (li_ & 1) == 0;
          int grp = 9; if (ph > 0) { if (sub_ == 0 || sub_ == 5 || sub_ == 7 || sub_ == 8) grp = 1; else if (sub_ == 1) grp = ab_ ? 2 : 3; else if (sub_ == 2) grp = ab_ ? 4 : 5; else if (sub_ == 3) grp = ab_ ? 6 : 7; else grp = 8; }
          if (grp == PROBE_GROUP) t_sel += t_now - t_prev; t_prev = t_now; }
#endif
    }
#ifdef PROBE_GROUP
    if (blockIdx.x == 0 && threadIdx.x == 0) { const unsigned long long t0 = __builtin_amdgcn_s_memrealtime(); while (__builtin_amdgcn_s_memrealtime() - t0 < 3 * t_sel) __builtin_amdgcn_s_sleep(8); }
#endif
}

extern "C" void kernel_launch(void* const* d_in, const int* in_sizes, int n_in, void* d_out, int out_size, void* d_ws, size_t ws_size, hipStream_t stream) {
    static int grid = 0;
    if (grid == 0) {
        if (n_in != 40 || (size_t)out_size != O_END || ws_size < WS_END) { fprintf(stderr, "kernel_launch: unexpected shapes: n_in %d out %d ws %zu\n", n_in, out_size, ws_size); grid = -1; return; }
        int dev = 0, cus = 0, per_cu = 0;
        if (hipGetDevice(&dev) != hipSuccess || hipDeviceGetAttribute(&cus, hipDeviceAttributeMultiprocessorCount, dev) != hipSuccess) { grid = -1; return; }
        if (hipFuncSetAttribute((const void*)mega_fwd, hipFuncAttributeMaxDynamicSharedMemorySize, LDS_BYTES) != hipSuccess) { fprintf(stderr, "kernel_launch: hipFuncSetAttribute failed\n"); grid = -1; return; }
        if (hipOccupancyMaxActiveBlocksPerMultiprocessor(&per_cu, (const void*)mega_fwd, NTHR, LDS_BYTES) != hipSuccess || per_cu < 1) { fprintf(stderr, "kernel_launch: occupancy query says %d\n", per_cu); per_cu = 1; }
        (void)hipGetLastError();
        grid = cus;
    }
    if (grid < 0) return;
    if (hipMemsetAsync((char*)d_ws + WS_CTL, 0, CTL_ZERO_BYTES, stream) != hipSuccess) { fprintf(stderr, "kernel_launch: memset of the control words failed\n"); return; }
    Args a{};
    for (int i = 0; i < 40; ++i) a.in[i] = (const float*)d_in[i];
    a.out = (float*)d_out; a.ws = (unsigned char*)d_ws;
#if MK_N_LAUNCHES == 1
    a.ph_lo = 0; a.ph_hi = N_PHASES;
    void* args[] = {&a};
    hipError_t e = hipLaunchCooperativeKernel((const void*)mega_fwd, dim3(grid), dim3(NTHR), args, LDS_BYTES, stream);
    if (e != hipSuccess) fprintf(stderr, "cooperative launch failed: %s (grid %d)\n", hipGetErrorString(e), grid);
#else
    for (int ph = 0; ph < N_PHASES; ++ph) { a.ph_lo = ph; a.ph_hi = ph + 1; mega_fwd<<<dim3(grid), dim3(NTHR), LDS_BYTES, stream>>>(a); }
#endif
}
```

```cpp
#include <hip/hip_runtime.h>
#include <hip/hip_cooperative_groups.h>
#include <cstdio>
#include <cstdint>
namespace cg = cooperative_groups;

#ifndef MK_N_LAUNCHES
#define MK_N_LAUNCHES 1
#endif

namespace pg8 {
#define PG8_LAS __attribute__((address_space(3)))
typedef unsigned short bf16_t;
typedef short bf16x8 __attribute__((ext_vector_type(8)));
typedef float f32x4 __attribute__((ext_vector_type(4)));
typedef unsigned u32x4 __attribute__((ext_vector_type(4)));
constexpr int BM = 256, BK = 64, HALF = 128, HTB = HALF * BK * 2  , STAGE_BYTES = 8 * HTB, NXCD = 8, WGM = 8;

__host__ __device__ __forceinline__ int lds_byte(int r, int c) { const int st = (r >> 4) * 2 + (c >> 5), rr = r & 15, cc = c & 31, ob = rr * 64 + cc * 2; return st * 1024 + (ob ^ (((ob >> 9) & 1) << 5)); }
__host__ __device__ __forceinline__ void stage_rc(int b, int& R, int& C) { const int st = b / 1024, sb = b % 1024, swz = sb ^ (((sb >> 9) & 1) << 5); R = (st >> 1) * 16 + swz / 64; C = (st & 1) * 32 + (swz % 64) / 2; }
__host__ __device__ __forceinline__ int perm32(int rho) { const int n = rho >> 4, i = rho & 15; return 8 * (i >> 2) + 4 * n + (i & 3); }

struct Unit { int pm, pn; };
struct Gemm { const bf16_t* A; const bf16_t* Bt; int M, N, K; };

struct StaticOrder {
    int nM, nN, nwg, G, c;
    __host__ __device__ void init(int M, int N, int G_, int c_) { nM = M / BM; nN = N / BM; nwg = nM * nN; G = G_; c = c_; }
    __host__ __device__ bool next(int i, Unit& u) const {
        const long L = (long)i * G + c; if (L >= nwg) return false;
        int wgid = (int)L; { const int q = nwg / NXCD, r = nwg % NXCD, xcd = wgid % NXCD, off = wgid / NXCD; wgid = (xcd < r ? xcd * (q + 1) : r * (q + 1) + (xcd - r) * q) + off; }
        const int nig = WGM * nN, gid = wgid / nig, fm = gid * WGM, gsz = (nM - fm) < WGM ? (nM - fm) : WGM;
        u.pm = fm + ((wgid % nig) % gsz); u.pn = (wgid % nig) / gsz; return true;
    }
    __device__ __forceinline__ void a_ready(const Unit&) const {}
    __device__ __forceinline__ void done(const Unit&) const {}
};

__device__ __forceinline__ unsigned cvt_pk_bf16(float lo, float hi) { unsigned r; asm volatile("v_cvt_pk_bf16_f32 %0, %1, %2" : "=v"(r) : "v"(lo), "v"(hi)); return r; }
struct EpiF32 {
    static constexpr bool PERM = false, AFTER_DRAIN = false;
    float* C; int ldc;
    __device__ __forceinline__ void operator()(const f32x4 (&acc)[2][2][4][2], const Unit& u, int wr, int wc, int fr, int fq) const {
        const int row0 = u.pm * BM + wr * 64 + fr, col0 = u.pn * BM + wc * 32 + 4 * fq;
#pragma unroll
        for (int ai = 0; ai < 2; ++ai)
#pragma unroll
            for (int m = 0; m < 4; ++m) { float* rowp = C + (size_t)(row0 + ai * HALF + m * 16) * ldc + col0;
#pragma unroll
                for (int bj = 0; bj < 2; ++bj)
#pragma unroll
                    for (int n = 0; n < 2; ++n) *(f32x4*)(rowp + bj * HALF + n * 16) = acc[ai][bj][m][n]; }
    }
};
struct EpiBf16 {
    static constexpr bool PERM = true, AFTER_DRAIN = false;
    bf16_t* O; int ldc;
    __device__ __forceinline__ void operator()(const f32x4 (&acc)[2][2][4][2], const Unit& u, int wr, int wc, int fr, int fq) const {
        const int row0 = u.pm * BM + wr * 64 + fr; const int col0 = u.pn * BM + wc * 32 + 8 * fq;
#pragma unroll
        for (int ai = 0; ai < 2; ++ai)
#pragma unroll
            for (int m = 0; m < 4; ++m) { bf16_t* rowp = O + (size_t)(row0 + ai * HALF + m * 16) * ldc + col0;
#pragma unroll
                for (int bj = 0; bj < 2; ++bj) { const f32x4 v0 = acc[ai][bj][m][0], v1 = acc[ai][bj][m][1];
                    u32x4 w; w.x = cvt_pk_bf16(v0[0], v0[1]); w.y = cvt_pk_bf16(v0[2], v0[3]); w.z = cvt_pk_bf16(v1[0], v1[1]); w.w = cvt_pk_bf16(v1[2], v1[3]);
                    *(u32x4*)(rowp + bj * HALF) = w; } }
    }
};
template <class Epi, class Sched, bool ALIGN_EPI = false, bool SP2 = false>
__device__ __forceinline__ void gemm_phase(PG8_LAS unsigned char* lds, const Gemm g, const Sched& S, const Epi& E, const int tid) {
    const int wid = __builtin_amdgcn_readfirstlane(tid >> 6), lane = tid & 63, wr = wid >> 2, wc = wid & 3, fr = lane & 15, fq = lane >> 4;
    const int K = g.K, nt = K / BK;
    unsigned voffA[2], voffB[2];
#pragma unroll
    for (int i = 0; i < 2; ++i) { int R, C; stage_rc(tid * 16 + i * 8192, R, C); const int Rb = Epi::PERM ? ((R & ~31) + perm32(R & 31)) : R;
        voffA[i] = (unsigned)(R * K + C) * 2u; voffB[i] = (unsigned)(Rb * K + C) * 2u; }
    const size_t kstep = (size_t)(BK * 2);
    const size_t hstep = (size_t)HALF * K * 2;
    const size_t tstep = 2 * hstep;
    const unsigned ldsw = (unsigned)wid * 1024u;
    const int aoff = lds_byte(wr * 64 + fr, fq * 8), boff = lds_byte(wc * 32 + fr, fq * 8);
#define PG8_SA(b, h) (((b) * 2 + (h)) * HTB)
#define PG8_SB(b, h) ((4 + (b) * 2 + (h)) * HTB)
#define PG8_STAGE(bufoff, gbase, voff) do { _Pragma("unroll") for (int _i = 0; _i < 2; ++_i) \
        __builtin_amdgcn_global_load_lds((const unsigned*)((const char*)(gbase) + (voff)[_i]), (PG8_LAS unsigned*)(lds + (bufoff) + ldsw + _i * 8192), 16, 0, 0); } while (0)
#define PG8_LDA(dst, b, h) do { _Pragma("unroll") for (int m = 0; m < 4; ++m) _Pragma("unroll") for (int k = 0; k < 2; ++k) dst[m][k] = *(const PG8_LAS bf16x8*)(lds + PG8_SA(b, h) + aoff + m * 2048 + k * 1024); } while (0)
#define PG8_LDB(dst, b, h) do { _Pragma("unroll") for (int n = 0; n < 2; ++n) _Pragma("unroll") for (int k = 0; k < 2; ++k) dst[n][k] = *(const PG8_LAS bf16x8*)(lds + PG8_SB(b, h) + boff + n * 2048 + k * 1024); } while (0)
#define PG8_MMA(ai, bj, At, Bt) do { __builtin_amdgcn_s_setprio(1); _Pragma("unroll") for (int m = 0; m < 4; ++m) _Pragma("unroll") for (int n = 0; n < 2; ++n) _Pragma("unroll") for (int k = 0; k < 2; ++k) \
        acc[ai][bj][m][n] = __builtin_amdgcn_mfma_f32_16x16x32_bf16(Bt[n][k], At[m][k], acc[ai][bj][m][n], 0, 0, 0); __builtin_amdgcn_s_setprio(0); } while (0)
#define PG8_WAIT_V(n) asm volatile("s_waitcnt vmcnt(" #n ")" ::: "memory")
#define PG8_WAIT_L(n) asm volatile("s_waitcnt lgkmcnt(" #n ")" ::: "memory")
#define PG8_BAR __builtin_amdgcn_s_barrier()
#define PG8_SCHED __builtin_amdgcn_sched_barrier(0)
    Unit cur, nxt; int ui = 0;
    if (!S.next(0, cur)) return;
    f32x4 acc[2][2][4][2];
#pragma unroll
    for (int a = 0; a < 2; ++a)
#pragma unroll
        for (int b = 0; b < 2; ++b)
#pragma unroll
            for (int m = 0; m < 4; ++m)
#pragma unroll
                for (int n = 0; n < 2; ++n) acc[a][b][m][n] = (f32x4){0.f, 0.f, 0.f, 0.f};
    bf16x8 At[4][2], B0[2][2], B1[2][2];
    const char* cA = (const char*)g.A + (size_t)cur.pm * tstep; const char* cB = (const char*)g.Bt + (size_t)cur.pn * tstep;
    S.a_ready(cur);
    if constexpr (SP2) {
        PG8_STAGE(PG8_SB(0, 0), cB, voffB); PG8_STAGE(PG8_SB(0, 1), cB + hstep, voffB); PG8_STAGE(PG8_SA(0, 0), cA, voffA); PG8_STAGE(PG8_SA(0, 1), cA + hstep, voffA);
        if (wr == 1) PG8_BAR;
        PG8_WAIT_V(2); PG8_BAR;
        PG8_STAGE(PG8_SB(1, 0), cB + kstep, voffB); PG8_STAGE(PG8_SA(1, 0), cA + kstep, voffA); PG8_STAGE(PG8_SB(1, 1), cB + hstep + kstep, voffB);
        PG8_WAIT_V(6); PG8_BAR;
    } else {
        PG8_STAGE(PG8_SB(0, 0), cB, voffB); PG8_STAGE(PG8_SA(0, 0), cA, voffA); PG8_STAGE(PG8_SB(0, 1), cB + hstep, voffB); PG8_STAGE(PG8_SA(0, 1), cA + hstep, voffA);
        if (wr == 1) PG8_BAR;
        PG8_WAIT_V(4); PG8_BAR;
        PG8_STAGE(PG8_SB(1, 0), cB + kstep, voffB); PG8_STAGE(PG8_SA(1, 0), cA + kstep, voffA); PG8_STAGE(PG8_SB(1, 1), cB + hstep + kstep, voffB);
        PG8_WAIT_V(6); PG8_BAR;
    }
    for (;;) {
        const bool has_next = S.next(ui + 1, nxt);
        const char* nA = has_next ? (const char*)g.A + (size_t)nxt.pm * tstep : cA; const char* nB = has_next ? (const char*)g.Bt + (size_t)nxt.pn * tstep : cB;
        for (int t = 0; t < nt; t += 2) {
            const bool last = (t == nt - 2);
            const char* a1 = cA + (size_t)(t + 1) * kstep;
            const char* a2 = last ? nA : cA + (size_t)(t + 2) * kstep; const char* b2 = last ? nB : cB + (size_t)(t + 2) * kstep;
            const char* a3 = a2 + kstep; const char* b3 = b2 + kstep;
            if (last && has_next) S.a_ready(nxt);
            if constexpr (SP2) {
            PG8_LDB(B0, 0, 0); PG8_LDB(B1, 0, 1); PG8_SCHED; PG8_LDA(At, 0, 0); PG8_STAGE(PG8_SA(1, 1), a1 + hstep, voffA);
            PG8_WAIT_V(8); PG8_WAIT_L(0); PG8_BAR; PG8_MMA(0, 0, At, B0); PG8_MMA(0, 1, At, B1); PG8_BAR; PG8_SCHED;
            PG8_LDA(At, 0, 1); PG8_STAGE(PG8_SB(0, 0), b2, voffB); PG8_STAGE(PG8_SB(0, 1), b2 + hstep, voffB); PG8_STAGE(PG8_SA(0, 0), a2, voffA);
            PG8_WAIT_V(8); PG8_WAIT_L(0); PG8_BAR; PG8_MMA(1, 0, At, B0); PG8_MMA(1, 1, At, B1); PG8_BAR; PG8_SCHED;
            PG8_LDB(B0, 1, 0); PG8_LDB(B1, 1, 1); PG8_SCHED; PG8_LDA(At, 1, 0); PG8_STAGE(PG8_SA(0, 1), a2 + hstep, voffA);
            PG8_WAIT_V(8); PG8_WAIT_L(0); PG8_BAR; PG8_MMA(0, 0, At, B0); PG8_MMA(0, 1, At, B1); PG8_BAR; PG8_SCHED;
            PG8_LDA(At, 1, 1); PG8_STAGE(PG8_SB(1, 0), b3, voffB); PG8_STAGE(PG8_SB(1, 1), b3 + hstep, voffB); PG8_STAGE(PG8_SA(1, 0), a3, voffA);
            PG8_WAIT_V(8); PG8_WAIT_L(0); PG8_BAR; PG8_MMA(1, 0, At, B0); PG8_MMA(1, 1, At, B1); PG8_BAR; PG8_SCHED;
            } else {
            PG8_LDB(B0, 0, 0); PG8_SCHED; PG8_LDA(At, 0, 0); PG8_STAGE(PG8_SA(1, 1), a1 + hstep, voffA);
            PG8_WAIT_L(8); PG8_BAR; PG8_WAIT_L(0); PG8_MMA(0, 0, At, B0); PG8_BAR; PG8_SCHED;
            PG8_LDB(B1, 0, 1); PG8_STAGE(PG8_SB(0, 0), b2, voffB);
            PG8_BAR; PG8_WAIT_L(0); PG8_MMA(0, 1, At, B1); PG8_BAR;
            PG8_LDA(At, 0, 1); PG8_STAGE(PG8_SA(0, 0), a2, voffA);
            PG8_BAR; PG8_WAIT_L(0); PG8_MMA(1, 0, At, B0); PG8_BAR; PG8_SCHED;
            PG8_STAGE(PG8_SB(0, 1), b2 + hstep, voffB);
            PG8_WAIT_V(6); PG8_BAR; PG8_MMA(1, 1, At, B1); PG8_BAR;
            PG8_LDB(B0, 1, 0); PG8_SCHED; PG8_LDA(At, 1, 0); PG8_STAGE(PG8_SA(0, 1), a2 + hstep, voffA);
            PG8_WAIT_L(8); PG8_BAR; PG8_WAIT_L(0); PG8_MMA(0, 0, At, B0); PG8_BAR; PG8_SCHED;
            PG8_LDB(B1, 1, 1); PG8_STAGE(PG8_SB(1, 0), b3, voffB);
            PG8_BAR; PG8_WAIT_L(0); PG8_MMA(0, 1, At, B1); PG8_BAR;
            PG8_LDA(At, 1, 1); PG8_STAGE(PG8_SA(1, 0), a3, voffA);
            PG8_BAR; PG8_WAIT_L(0); PG8_MMA(1, 0, At, B0); PG8_BAR; PG8_SCHED;
            PG8_STAGE(PG8_SB(1, 1), b3 + hstep, voffB);
            PG8_WAIT_V(6); PG8_BAR; PG8_MMA(1, 1, At, B1); PG8_BAR;
            }
        }
        if constexpr (ALIGN_EPI) { if (wr == 0) PG8_BAR; }
        if constexpr (!Epi::AFTER_DRAIN) { E(acc, cur, wr, wc, fr, fq); S.done(cur); }
        if (!has_next) break;
#pragma unroll
        for (int a = 0; a < 2; ++a)
#pragma unroll
            for (int b = 0; b < 2; ++b)
#pragma unroll
                for (int m = 0; m < 4; ++m)
#pragma unroll
                    for (int n = 0; n < 2; ++n) acc[a][b][m][n] = (f32x4){0.f, 0.f, 0.f, 0.f};
        cur = nxt; cA = nA; cB = nB; ++ui;
        if constexpr (ALIGN_EPI) { if (wr == 1) PG8_BAR; }
    }
    PG8_WAIT_V(0);
    if constexpr (!ALIGN_EPI) { if (wr == 0) PG8_BAR; }
    PG8_BAR;
    if constexpr (Epi::AFTER_DRAIN) { E.fused(acc, cur, wr, wc, fr, fq, lds, wid, lane); S.done(cur); }
#undef PG8_SA
#undef PG8_SB
#undef PG8_STAGE
#undef PG8_LDA
#undef PG8_LDB
#undef PG8_MMA
#undef PG8_WAIT_V
#undef PG8_WAIT_L
#undef PG8_BAR
#undef PG8_SCHED
}
}

constexpr int TP = 8192, TS = 512, T = TP + TS, DM = 2048, NSEQ = 132;
constexpr int NAB = 7424, NCD = 4864;
constexpr int NWAVES = 8, NTHR = 512;
constexpr size_t MiB = 1u << 20;
constexpr size_t WS_CTL = 0, CTL_ZERO_BYTES = 65536;
constexpr int CW_BAR = 4096;
constexpr size_t WS_WABIN = 2 * MiB, WS_WABOUT = 60 * MiB, WS_WCDIN = 76 * MiB, WS_WCDOUT = 114 * MiB, WS_WGATE = 130 * MiB, WS_WPROJ = 162 * MiB;
constexpr size_t WS_H = 166 * MiB, WS_XN = 234 * MiB, WS_YM = 268 * MiB, WS_PB = 302 * MiB, WS_U = 320 * MiB, WS_SCR = 444 * MiB, WS_END = 712 * MiB;
constexpr size_t SC_C = 0, SC_C2 = 68 * MiB;
constexpr size_t SC_QN = 0, SC_KN = 34 * MiB, SC_VV = 68 * MiB, SC_ODN = 102 * MiB, SC_OGLA = 136 * MiB, SC_GLOG = 170 * MiB, SC_BETA = 187 * MiB, SC_GDEC = 188 * MiB, SC_DNOPS = 192 * MiB, SC_DNGEND = 264 * MiB;
constexpr size_t SC_XBC = 0, SC_LA = 52 * MiB, SC_LB = 86 * MiB, SC_YS = 120 * MiB, SC_HS = 154 * MiB, SC_DT = 188 * MiB, SC_SSDOP = 192 * MiB, SC_GEND = 256 * MiB;
constexpr int LDS_BYTES = 163840;
constexpr size_t O_Y_P = 0, O_Y_S = O_Y_P + (size_t)4 * 2048 * 2048, O_DN_P = O_Y_S + (size_t)128 * 4 * 2048,
    O_DNC_P = O_DN_P + (size_t)2 * 4 * 8 * 128 * 128, O_GLA_P = O_DNC_P + (size_t)2 * 4 * 3 * 3072, O_SSD_P = O_GLA_P + (size_t)2 * 4 * 4 * 128 * 256,
    O_SSDC_P = O_SSD_P + (size_t)2 * 4 * 16 * 64 * 64, O_LRU_P = O_SSDC_P + (size_t)2 * 4 * 3 * 1536, O_LRUC_P = O_LRU_P + (size_t)2 * 4 * 1024,
    O_DN_S = O_LRUC_P + (size_t)2 * 4 * 3 * 1024, O_DNC_S = O_DN_S + (size_t)2 * 128 * 8 * 128 * 128, O_GLA_S = O_DNC_S + (size_t)2 * 128 * 3 * 3072,
    O_SSD_S = O_GLA_S + (size_t)2 * 128 * 4 * 128 * 256, O_SSDC_S = O_SSD_S + (size_t)2 * 128 * 16 * 64 * 64, O_LRU_S = O_SSDC_S + (size_t)2 * 128 * 3 * 1536,
    O_LRUC_S = O_LRU_S + (size_t)2 * 128 * 1024, O_END = O_LRUC_S + (size_t)2 * 128 * 3 * 1024;
static_assert(O_END == 109064192, "output size");

#define LAS __attribute__((address_space(3)))
typedef unsigned short bf16;
typedef float f32x4 __attribute__((ext_vector_type(4)));
typedef unsigned u32x2 __attribute__((ext_vector_type(2)));
typedef unsigned u32x4 __attribute__((ext_vector_type(4)));
#define LDS_WAIT() asm volatile("s_waitcnt lgkmcnt(0)" ::: "memory")

__device__ __forceinline__ float bf2f(bf16 b) { return __uint_as_float(((unsigned)b) << 16); }
__device__ __forceinline__ unsigned f2bf(float f) { unsigned u = __float_as_uint(f); return (u + 0x7fffu + ((u >> 16) & 1u)) >> 16; }
__device__ __forceinline__ unsigned pk2(float lo, float hi) { return f2bf(lo) | (f2bf(hi) << 16); }
__device__ __forceinline__ float sigmoid_(float x) { return 1.f / (1.f + expf(-x)); }
__device__ __forceinline__ float silu_(float x) { return x / (1.f + expf(-x)); }
__device__ __forceinline__ float softplus_(float x) { return x > 20.f ? x : log1pf(expf(x)); }
__device__ __forceinline__ float wave_sum(float v) {
#pragma unroll
    for (int o = 1; o < 64; o <<= 1) v += __shfl_xor(v, o);
    return v;
}
__device__ __forceinline__ void row_to_seq(int r, int& s, int& t) { if (r < TP) { s = r >> 11; t = r & 2047; } else { s = 4 + ((r - TP) >> 2); t = (r - TP) & 3; } }
__device__ __forceinline__ void seq_info(int s, int& row0, int& L) { if (s < 4) { row0 = s << 11; L = 2048; } else { row0 = TP + ((s - 4) << 2); L = 4; } }
__device__ __forceinline__ float pre_val(const bf16* U, int ldu, int ucol, int row0, int tt, int s, const float* stc, int W, int c) {
    if (tt >= 0) return bf2f(U[(size_t)(row0 + tt) * ldu + ucol]);
    if (s < 4) return 0.f;
    return stc[((size_t)(s - 4) * 3 + (3 + tt)) * W + c];
}
__device__ __forceinline__ int map_col(int mapid, int n) {
    if (mapid == 0) return n;
    if (mapid == 1) { if (n < 3072) return n; if (n < 6144) return n + 16; if (n < 7168) return n + 32; if (n < 7184) return n - 4096; if (n < 7200) return n - 1024; return -1; }
    if (n < 2560) return n; if (n < 4608) return n + 16; if (n < 4624) return n - 2048; return -1;
}
__device__ __forceinline__ void transpose_item(const float* W, int K, int Nsrc, bf16* WT, int Npad, int mapid, LAS float* scr, int item, int lane) {
    const int nblk = Npad / 32, kb = item / nblk, nb = item % nblk, k0 = 64 * kb, n0 = 32 * nb;
    const int src = map_col(mapid, n0 + (lane & 31));
#pragma unroll 8
    for (int i = 0; i < 32; ++i) { const int kk = 2 * i + (lane >> 5); scr[kk * 33 + (lane & 31)] = src >= 0 ? W[(size_t)(k0 + kk) * Nsrc + src] : 0.f; }
    LDS_WAIT(); asm volatile("" ::: "memory");
    const int c = lane & 7;
#pragma unroll
    for (int j = 0; j < 4; ++j) { const int n = (lane >> 3) + 8 * j; const LAS float* s = scr + (8 * c) * 33 + n;
        u32x4 o; o.x = pk2(s[0 * 33], s[1 * 33]); o.y = pk2(s[2 * 33], s[3 * 33]); o.z = pk2(s[4 * 33], s[5 * 33]); o.w = pk2(s[6 * 33], s[7 * 33]);
        *(u32x4*)(WT + (size_t)(n0 + n) * K + k0 + 8 * c) = o; }
    LDS_WAIT(); asm volatile("" ::: "memory");
}
__device__ __forceinline__ void norm_row_bf16(const f32x4 (&v)[8], const float* g, bf16* orow, int lane) {
    float ss = 0.f;
#pragma unroll
    for (int j = 0; j < 8; ++j) ss += (v[j].x * v[j].x + v[j].y * v[j].y) + (v[j].z * v[j].z + v[j].w * v[j].w);
    const float rstd = rsqrtf(wave_sum(ss) * (1.f / DM) + 1e-6f);
#pragma unroll
    for (int j = 0; j < 8; ++j) { const int col = 4 * (lane + 64 * j); const f32x4 gg = *(const f32x4*)(g + col);
        u32x2 o; o.x = pk2(v[j].x * rstd * gg.x, v[j].y * rstd * gg.y); o.y = pk2(v[j].z * rstd * gg.z, v[j].w * rstd * gg.w);
        *(u32x2*)(orow + col) = o; }
}

typedef __bf16 bf16x2_t __attribute__((ext_vector_type(2)));
typedef float f32x2_t __attribute__((ext_vector_type(2)));
typedef short bf16x8 __attribute__((ext_vector_type(8)));
typedef float f32x16 __attribute__((ext_vector_type(16)));
__device__ __forceinline__ unsigned cvtpk(float lo, float hi) { f32x2_t v = {lo, hi}; bf16x2_t b = __builtin_convertvector(v, bf16x2_t); return __builtin_bit_cast(unsigned, b); }
#define MFMA32(a, b, c) __builtin_amdgcn_mfma_f32_32x32x16_bf16((a), (b), (c), 0, 0, 0)
#define PACK_ACC(x, S_) __builtin_bit_cast(bf16x8, (u32x4){cvtpk((x)[8 * (S_)], (x)[8 * (S_) + 1]), cvtpk((x)[8 * (S_) + 2], (x)[8 * (S_) + 3]), cvtpk((x)[8 * (S_) + 4], (x)[8 * (S_) + 5]), cvtpk((x)[8 * (S_) + 6], (x)[8 * (S_) + 7])})
__device__ __forceinline__ int crow(int reg, int h) { return (reg & 3) + 8 * (reg >> 2) + 4 * h; }
__device__ __forceinline__ bf16x8 pack8(const float (&v)[8]) { return __builtin_bit_cast(bf16x8, (u32x4){cvtpk(v[0], v[1]), cvtpk(v[2], v[3]), cvtpk(v[4], v[5]), cvtpk(v[6], v[7])}); }

#define XB_TMO      128
#define XB_XCNT(j)  (256  + 64 * (j))
#define XB_XSUB(j)  (1280 + 64 * (j))
#define XB_XGEN(j)  (2304 + 64 * (j))
#define XB_TOP      3328
#define XB_TOPGEN   3392
#define XCD_BAR_WORDS 3456
#define XB_SPIN_CAP (1u << 18)

__device__ __forceinline__ unsigned xb_ld(unsigned* p)              { return __hip_atomic_load(p, __ATOMIC_RELAXED, __HIP_MEMORY_SCOPE_AGENT); }
__device__ __forceinline__ unsigned xb_add(unsigned* p, unsigned v) { return __hip_atomic_fetch_add(p, v, __ATOMIC_RELAXED, __HIP_MEMORY_SCOPE_AGENT); }
__device__ __forceinline__ unsigned xb_xcc_id() { return (unsigned)__builtin_amdgcn_s_getreg((3 << 11) | 20) & 0xFu; }
#define XB_SPIN(cond, bar) do { unsigned _sp = 0; while (cond) { __builtin_amdgcn_s_sleep(1); \
    if ((++_sp & 255u) == 0u) { if (xb_ld(&(bar)[XB_TMO])) break; if (_sp > XB_SPIN_CAP) { atomicAdd(&(bar)[XB_TMO], 1u); break; } } } } while (0)

struct XcdBarrier {
    unsigned* bar; unsigned x;
    volatile LAS unsigned* st;
};

__device__ __forceinline__ XcdBarrier xcd_barrier_post(unsigned* bar, volatile LAS unsigned* st) {
    XcdBarrier b; b.bar = bar; b.x = xb_xcc_id(); b.st = st;
    if (threadIdx.x == 0) (void)xb_add(&bar[XB_XCNT(b.x)], 1u);
    return b;
}
__device__ __forceinline__ void xcd_barrier_complete(unsigned* bar, unsigned x, unsigned& nloc, unsigned& nx) {
    const unsigned G = gridDim.x * gridDim.y * gridDim.z;
    unsigned sum, cnt, mine, sp = 0u;
    for (;;) {
        sum = 0u; cnt = 0u; mine = 0u;
#pragma unroll
        for (unsigned j = 0; j < 16; ++j) { const unsigned c = xb_ld(&bar[XB_XCNT(j)]); sum += c; cnt += (c > 0u) ? 1u : 0u; mine = (j == x) ? c : mine; }
        if (sum == G) break;
        __builtin_amdgcn_s_sleep(1);
        if ((++sp & 255u) == 0u) { if (xb_ld(&bar[XB_TMO])) break; if (sp > XB_SPIN_CAP) { atomicAdd(&bar[XB_TMO], 1u); break; } }
    }
    nloc = mine > 0u ? mine : 1u; nx = cnt > 0u ? cnt : 1u;
}

__device__ __forceinline__ void xcd_barrier(const XcdBarrier& b) {
    asm volatile("s_waitcnt vmcnt(0)" ::: "memory");
    __syncthreads();
    if (threadIdx.x == 0) {
        unsigned* bar = b.bar;
        __builtin_amdgcn_s_waitcnt(0);
        unsigned nloc = b.st[0], nx = b.st[1];
        if (nloc == 0u) { xcd_barrier_complete(bar, b.x, nloc, nx); b.st[0] = nloc; b.st[1] = nx; }
        const unsigned old = xb_add(&bar[XB_XSUB(b.x)], 1u);
        const unsigned gen = old / nloc;
        if (old + 1u == (gen + 1u) * nloc) {
            __builtin_amdgcn_fence(__ATOMIC_RELEASE, "agent");
            asm volatile("s_waitcnt vmcnt(0)" ::: "memory");
            const unsigned og = xb_add(&bar[XB_TOP], 1u);
            const unsigned tg = og / nx;
            if (og + 1u == (tg + 1u) * nx) xb_add(&bar[XB_TOPGEN], 1u);
            else XB_SPIN(xb_ld(&bar[XB_TOPGEN]) == tg, bar);
            __builtin_amdgcn_fence(__ATOMIC_ACQUIRE, "agent");
            xb_add(&bar[XB_XGEN(b.x)], 1u);
            asm volatile("s_waitcnt vmcnt(0)" ::: "memory");
        } else {
            XB_SPIN(xb_ld(&bar[XB_XGEN(b.x)]) == gen, bar);
            __builtin_amdgcn_fence(__ATOMIC_ACQUIRE, "agent");
            asm volatile("s_waitcnt vmcnt(0)" ::: "memory");
        }
    }
    __syncthreads();
}


struct Args { const float* in[40]; float* out; unsigned char* ws; int ph_lo, ph_hi; };
constexpr int N_PHASES = 41, SUBS = 10;
#ifndef PH_MASK
#define PH_MASK 16383
#endif
#define AS4 __attribute__((address_space(4)))
struct KP { const char AS4* p;
    __device__ __forceinline__ const float* in(int i) const { return *(const float* const AS4*)(p + 8 * i); }
    __device__ __forceinline__ float* out() const { return *(float* const AS4*)(p + 320); }
    __device__ __forceinline__ unsigned char* ws() const { return *(unsigned char* const AS4*)(p + 328); }
};
static_assert(sizeof(Args) == 344, "Args layout");

__device__ __forceinline__ void phase_prologue(const KP kp, LAS unsigned char* lds, int gw, int NGW, int wave, int lane) {
    unsigned char* ws = kp.ws();
    LAS float* scr = (LAS float*)(lds + wave * 16384);
    for (int job = 0; job < 16; ++job) {
        const float* W; int K = 2048, Nsrc = 2048, Npad = 2048, mapid = 0; bf16* WT;
        if (job < 2)       { W = kp.in(13) + (size_t)job * 2048 * 7200; Nsrc = 7200; Npad = NAB; mapid = 1; WT = (bf16*)(ws + WS_WABIN) + (size_t)job * NAB * 2048; }
        else if (job < 4)  { W = kp.in(21) + (size_t)(job - 2) * 2048 * 2048; WT = (bf16*)(ws + WS_WABOUT) + (size_t)(job - 2) * 2048 * 2048; }
        else if (job < 6)  { W = kp.in(22) + (size_t)(job - 4) * 2048 * 4624; Nsrc = 4624; Npad = NCD; mapid = 2; WT = (bf16*)(ws + WS_WCDIN) + (size_t)(job - 4) * NCD * 2048; }
        else if (job < 8)  { W = kp.in(36) + (size_t)(job - 6) * 2048 * 2048; WT = (bf16*)(ws + WS_WCDOUT) + (size_t)(job - 6) * 2048 * 2048; }
        else if (job < 12) { W = kp.in(39) + (size_t)(job - 8) * 2048 * 2048; WT = (bf16*)(ws + WS_WGATE) + (size_t)(job - 8) * 2048 * 2048; }
        else               { W = kp.in(37) + (size_t)(job - 12) * 256 * 2048; K = 256; WT = (bf16*)(ws + WS_WPROJ) + (size_t)(job - 12) * 2048 * 256; }
        const int nitems = (K / 64) * (Npad / 32);
        for (int it = gw; it < nitems; it += NGW) transpose_item(W, K, Nsrc, WT, Npad, mapid, scr, it, lane);
    }
    float* H = (float*)(ws + WS_H); bf16* XN = (bf16*)(ws + WS_XN);
    for (int m = gw; m < T; m += NGW) {
        const float* src = m < TP ? kp.in(0) + (size_t)m * DM : kp.in(1) + (size_t)(m - TP) * DM;
        f32x4 v[8];
#pragma unroll
        for (int j = 0; j < 8; ++j) { v[j] = *(const f32x4*)(src + 4 * (lane + 64 * j)); *(f32x4*)(H + (size_t)m * DM + 4 * (lane + 64 * j)) = v[j]; }
        norm_row_bf16(v, kp.in(11), XN + (size_t)m * DM, lane);
    }
    bf16* PB = (bf16*)(ws + WS_PB);
    const int gt = gw * 64 + lane, NGT = NGW * 64;
    for (int i = gt; i < 4 * T * 64; i += NGT) {
        const int c4 = i & 63, r = (i >> 6) % T, li = (i >> 6) / T;
        const float* src = r < TP ? kp.in(9) + ((size_t)li * TP + r) * 256 + 4 * c4 : kp.in(10) + ((size_t)li * TS + (r - TP)) * 256 + 4 * c4;
        const f32x4 v = *(const f32x4*)src;
        u32x2 o; o.x = pk2(v.x, v.y); o.y = pk2(v.z, v.w);
        *(u32x2*)(PB + ((size_t)li * T + r) * 256 + 4 * c4) = o;
    }
}

__device__ __forceinline__ void phase_res1(const KP kp, int li, int gw, int NGW, int lane) {
    float* H = (float*)(kp.ws() + WS_H); bf16* XN = (bf16*)(kp.ws() + WS_XN); const float* C = (const float*)(kp.ws() + WS_SCR + SC_C);
    for (int m = gw; m < T; m += NGW) {
        f32x4 v[8];
#pragma unroll
        for (int j = 0; j < 8; ++j) { const size_t o = (size_t)m * DM + 4 * (lane + 64 * j); v[j] = *(const f32x4*)(H + o) + *(const f32x4*)(C + o); *(f32x4*)(H + o) = v[j]; }
        norm_row_bf16(v, kp.in(38) + (size_t)li * DM, XN + (size_t)m * DM, lane);
    }
}
__device__ __forceinline__ void phase_res2(const KP kp, int li, int gw, int NGW, int lane) {
    float* H = (float*)(kp.ws() + WS_H); bf16* XN = (bf16*)(kp.ws() + WS_XN); const float* C = (const float*)(kp.ws() + WS_SCR + SC_C); const float* C2 = (const float*)(kp.ws() + WS_SCR + SC_C2);
    for (int m = gw; m < T; m += NGW) {
        f32x4 v[8];
#pragma unroll
        for (int j = 0; j < 8; ++j) { const size_t o = (size_t)m * DM + 4 * (lane + 64 * j); const f32x4 c = *(const f32x4*)(C + o), c2 = *(const f32x4*)(C2 + o); f32x4 h = *(const f32x4*)(H + o);
            h.x += sigmoid_(c.x) * c2.x; h.y += sigmoid_(c.y) * c2.y; h.z += sigmoid_(c.z) * c2.z; h.w += sigmoid_(c.w) * c2.w; v[j] = h; *(f32x4*)(H + o) = h; }
        if (li < 3) norm_row_bf16(v, kp.in(11) + (size_t)(li + 1) * DM, XN + (size_t)m * DM, lane);
        else {
            float ss = 0.f;
#pragma unroll
            for (int j = 0; j < 8; ++j) ss += (v[j].x * v[j].x + v[j].y * v[j].y) + (v[j].z * v[j].z + v[j].w * v[j].w);
            const float rstd = rsqrtf(wave_sum(ss) * (1.f / DM) + 1e-6f);
#pragma unroll
            for (int j = 0; j < 8; ++j) { const int col = 4 * (lane + 64 * j); const f32x4 gg = *(const f32x4*)(kp.in(12) + col);
                f32x4 o; o.x = v[j].x * rstd * gg.x; o.y = v[j].y * rstd * gg.y; o.z = v[j].z * rstd * gg.z; o.w = v[j].w * rstd * gg.w;
                *(f32x4*)(kp.out() + (size_t)m * DM + col) = o; }
        }
    }
}

__device__ __forceinline__ void phase_ab_pre(const KP kp, const int bid, const int G, int j, int tid, int wave, int lane) {
    unsigned char* scr = kp.ws() + WS_SCR; const bf16* U = (const bf16*)(kp.ws() + WS_U);
    float* QN = (float*)(scr + SC_QN); float* KN = (float*)(scr + SC_KN); float* VV = (float*)(scr + SC_VV);
    float* GLOG = (float*)(scr + SC_GLOG); float* BETA = (float*)(scr + SC_BETA); float* GDEC = (float*)(scr + SC_GDEC);
    const float* cw = kp.in(14) + (size_t)j * 4 * 3072; const float* stc = kp.in(3) + (size_t)j * 128 * 3 * 3072;
    const float* wa2 = kp.in(18) + (size_t)j * 16 * 512; const float* ba = kp.in(19) + (size_t)j * 512;
    for (int r = bid; r < T; r += G) {
        int s, t; row_to_seq(r, s, t); const int row0 = r - t;
#pragma unroll
        for (int part = 0; part < 3; ++part) {
            float val[2];
#pragma unroll
            for (int i = 0; i < 2; ++i) { const int c = part * 1024 + wave * 128 + lane + 64 * i; float acc = 0.f;
#pragma unroll
                for (int tap = 0; tap < 4; ++tap) acc += cw[tap * 3072 + c] * pre_val(U, NAB, c, row0, t - 3 + tap, s, stc, 3072, c);
                val[i] = silu_(acc); }
            if (part < 2) { const float ss = wave_sum(val[0] * val[0] + val[1] * val[1]); const float sc = rsqrtf(ss + 1e-6f) * (part == 0 ? 0.08838834764831845f : 1.f); val[0] *= sc; val[1] *= sc; }
            float* dst = part == 0 ? QN : (part == 1 ? KN : VV);
            dst[(size_t)r * 1024 + wave * 128 + lane] = val[0]; dst[(size_t)r * 1024 + wave * 128 + lane + 64] = val[1];
        }
        if (tid < 8) {
            BETA[(size_t)r * 8 + tid] = sigmoid_(bf2f(U[(size_t)r * NAB + 7168 + tid]));
            GDEC[(size_t)r * 8 + tid] = -expf(kp.in(15)[j * 8 + tid]) * softplus_(bf2f(U[(size_t)r * NAB + 7176 + tid]) + kp.in(16)[j * 8 + tid]);
        }
        { float x = ba[tid];
#pragma unroll
          for (int rr = 0; rr < 16; ++rr) x += bf2f(U[(size_t)r * NAB + 7184 + rr]) * wa2[rr * 512 + tid];
          GLOG[(size_t)r * 512 + tid] = -softplus_(-x) * (1.f / 16.f); }
    }
}


constexpr size_t GLA_ITEM_BYTES = 74752, WS_GLAOPS = WS_XN;
__device__ __forceinline__ void phase_gla_prep(const KP kp, const int bid, const int G, int j, LAS unsigned char* lds, int tid) {
    const bf16* U = (const bf16*)(kp.ws() + WS_U); const float* GLOG = (const float*)(kp.ws() + WS_SCR + SC_GLOG);
    unsigned char* OPS = kp.ws() + WS_GLAOPS;
    LAS float* GL = (LAS float*)lds; LAS float* QL = GL + 64 * 129; LAS float* KL = QL + 64 * 129; LAS float* AL = KL + 64 * 129;
    const int lane = tid & 63, r = lane & 31, hp = lane >> 5;
    for (int item = bid; item < 512; item += G) {
        const int b = item >> 7, n = (item >> 2) & 31, h = item & 3;
        const int row0 = b * 2048 + n * 64;
        __syncthreads();
        for (int i = tid; i < 8192; i += NTHR) { const int t = i >> 7, d = i & 127; const size_t ro = (size_t)(row0 + t) * NAB;
            QL[t * 129 + d] = bf2f(U[ro + 4096 + h * 128 + d]) * 0.08838834764831845f; KL[t * 129 + d] = bf2f(U[ro + 4608 + h * 128 + d]);
            GL[t * 129 + d] = GLOG[(size_t)(row0 + t) * 512 + h * 128 + d]; }
        __syncthreads();
        if (tid < 128) { float acc = 0.f;
#pragma unroll 4
            for (int t = 0; t < 64; ++t) { acc += GL[t * 129 + tid]; GL[t * 129 + tid] = acc; } }
        __syncthreads();
        for (int i = tid; i < 8192; i += NTHR) { const int t = i >> 7, d = i & 127; const float gg = GL[t * 129 + d]; QL[t * 129 + d] *= expf(gg); KL[t * 129 + d] *= expf(-gg); }
        __syncthreads();
        { const int i = tid >> 3, jg = tid & 7; float acc[8];
#pragma unroll
          for (int jj = 0; jj < 8; ++jj) acc[jj] = 0.f;
#pragma unroll 4
          for (int d = 0; d < 128; ++d) { const float c = QL[i * 129 + d];
#pragma unroll
              for (int jj = 0; jj < 8; ++jj) acc[jj] += c * KL[(jg * 8 + jj) * 129 + d]; }
#pragma unroll
          for (int jj = 0; jj < 8; ++jj) AL[i * 65 + jg * 8 + jj] = (jg * 8 + jj) <= i ? acc[jj] : 0.f; }
        __syncthreads();
        bf16x8* base = (bf16x8*)(OPS + (size_t)item * GLA_ITEM_BYTES);
        float v[8];
#pragma unroll
        for (int q = 0; q < 2; ++q) { const int f = (tid >> 6) + 8 * q;
            { const int mt = f >> 3, ks = f & 7, i = 32 * mt + r;
#pragma unroll
              for (int jp = 0; jp < 8; ++jp) v[jp] = QL[i * 129 + 16 * ks + 8 * (jp >> 2) + 4 * hp + (jp & 3)];
              base[f * 64 + lane] = pack8(v); }
            { const int mt = f >> 2, ks = f & 3, d = 32 * mt + r; const float eg = expf(GL[63 * 129 + d]);
#pragma unroll
              for (int jp = 0; jp < 8; ++jp) v[jp] = KL[(16 * ks + 8 * (jp >> 2) + 4 * hp + (jp & 3)) * 129 + d] * eg;
              base[(16 + f) * 64 + lane] = pack8(v); } }
        { const int f = tid >> 6, mt = f >> 2, ks = f & 3, i = 32 * mt + r;
#pragma unroll
          for (int jp = 0; jp < 8; ++jp) v[jp] = AL[i * 65 + 16 * ks + 8 * (jp >> 2) + 4 * hp + (jp & 3)];
          base[(32 + f) * 64 + lane] = pack8(v); }
#pragma unroll
        for (int q = 0; q < 4; ++q) { const int f = (tid >> 6) + 8 * q, nt = f >> 2, ks = f & 3, p = 32 * nt + r;
            unsigned w[4];
#pragma unroll
            for (int jp = 0; jp < 8; jp += 2) { const int t0 = 16 * ks + 8 * (jp >> 2) + 4 * hp + (jp & 3);
                w[jp >> 1] = (unsigned)U[(size_t)(row0 + t0) * NAB + 5120 + h * 256 + p] | ((unsigned)U[(size_t)(row0 + t0 + 1) * NAB + 5120 + h * 256 + p] << 16); }
            base[(40 + f) * 64 + lane] = __builtin_bit_cast(bf16x8, (u32x4){w[0], w[1], w[2], w[3]}); }
        if (tid < 128) ((float*)(base + 72 * 64))[tid] = expf(GL[63 * 129 + tid]);
    }
}


constexpr size_t DN_ITEM_BYTES = 73728;
__device__ __forceinline__ void phase_dn_prep(const KP kp, const int bid, const int G, int j, LAS unsigned char* lds, int tid0) {
    unsigned char* scr = kp.ws() + WS_SCR;
    const float* QN = (const float*)(scr + SC_QN); const float* KN = (const float*)(scr + SC_KN); const float* VV = (const float*)(scr + SC_VV);
    const float* BETA = (const float*)(scr + SC_BETA); const float* GDEC = (const float*)(scr + SC_GDEC);
    unsigned char* OPS = scr + SC_DNOPS; float* GENDD = (float*)(scr + SC_DNGEND);
    LAS float* AMT = (LAS float*)lds; LAS float* GLs = AMT + 64 * 68; LAS float* BLs = GLs + 64; LAS float* KL = BLs + 64; LAS float* QL = KL + 64 * 129; LAS float* XL = QL + 64 * 129;
    for (int item = bid; item < 1024; item += G) {
        int tid = tid0; asm volatile("" : "+v"(tid));
        const int lane = tid & 63, r = lane & 31, hp = lane >> 5, wave = tid >> 6;
        const int b = item >> 8, n = (item >> 3) & 31, h = item & 7;
        const int row0 = b * 2048 + n * 64;
        __syncthreads();
        for (int i = tid; i < 8192; i += NTHR) { const int t = i >> 7, d = i & 127; const size_t ro = (size_t)(row0 + t) * 1024 + h * 128 + d; KL[t * 129 + d] = KN[ro]; QL[t * 129 + d] = QN[ro]; }
        if (wave == 0) { float gv = GDEC[(size_t)(row0 + lane) * 8 + h];
#pragma unroll
            for (int o = 1; o < 64; o <<= 1) { const float tt = __shfl_up(gv, o); if (lane >= o) gv += tt; }
            GLs[lane] = gv; BLs[lane] = BETA[(size_t)(row0 + lane) * 8 + h]; }
        __syncthreads();
        bf16x8* base = (bf16x8*)(OPS + (size_t)item * DN_ITEM_BYTES);
        { const int i = tid >> 3, ks = (tid >> 1) & 3, hk = tid & 1; float kk[8], qk[8];
#pragma unroll
          for (int jp = 0; jp < 8; ++jp) { kk[jp] = 0.f; qk[jp] = 0.f; }
#pragma unroll 2
          for (int d = 0; d < 128; ++d) { const float kc = KL[i * 129 + d], qc = QL[i * 129 + d];
#pragma unroll
              for (int jp = 0; jp < 8; ++jp) { const float kj = KL[(16 * ks + 8 * (jp >> 2) + 4 * hk + (jp & 3)) * 129 + d]; kk[jp] += kc * kj; qk[jp] += qc * kj; } }
          const float gi = GLs[i], bi = BLs[i]; float v[8];
#pragma unroll
          for (int jp = 0; jp < 8; ++jp) { const int jt = 16 * ks + 8 * (jp >> 2) + 4 * hk + (jp & 3); const float dec = expf(gi - GLs[jt]);
              AMT[jt * 68 + i] = jt < i ? bi * kk[jp] * dec : 0.f; v[jp] = jt <= i ? qk[jp] * dec : 0.f; }
          base[(48 + (i >> 5) * 4 + ks) * 64 + (i & 31) + 32 * hk] = pack8(v); }
        __syncthreads();
        if (tid < 256) {
            const int c = tid;
#pragma unroll
            for (int bi = 0; bi < 4; ++bi) {
                float acc[16];
#pragma unroll
                for (int ii = 0; ii < 16; ++ii) { const int i = 16 * bi + ii; const float be = BLs[i];
                    acc[ii] = c < 128 ? be * VV[(size_t)(row0 + i) * 1024 + h * 128 + c] : be * expf(GLs[i]) * KL[i * 129 + (c - 128)]; }
                for (int jj = 0; jj < 16 * bi; ++jj) { const float xj = XL[jj * 257 + c];
#pragma unroll
                    for (int q = 0; q < 4; ++q) { const f32x4 a = *(const LAS f32x4*)(AMT + jj * 68 + 16 * bi + 4 * q);
                        acc[4 * q + 0] -= a[0] * xj; acc[4 * q + 1] -= a[1] * xj; acc[4 * q + 2] -= a[2] * xj; acc[4 * q + 3] -= a[3] * xj; } }
#pragma unroll
                for (int ii = 0; ii < 16; ++ii) { float x = acc[ii];
#pragma unroll
                    for (int jj = 0; jj < ii; ++jj) x -= AMT[(16 * bi + jj) * 68 + 16 * bi + ii] * acc[jj];
                    acc[ii] = x; XL[(16 * bi + ii) * 257 + c] = x; }
            }
        }
        __syncthreads();
        float v[8];
#pragma unroll
        for (int q = 0; q < 2; ++q) { const int f = wave + 8 * q;
            { const int mt = f >> 3, ks = f & 7, i = 32 * mt + r;
#pragma unroll
              for (int jp = 0; jp < 8; ++jp) v[jp] = -XL[i * 257 + 128 + 16 * ks + 8 * (jp >> 2) + 4 * hp + (jp & 3)];
              base[f * 64 + lane] = pack8(v);
              const float eg = expf(GLs[i]);
#pragma unroll
              for (int jp = 0; jp < 8; ++jp) v[jp] = QL[i * 129 + 16 * ks + 8 * (jp >> 2) + 4 * hp + (jp & 3)] * eg;
              base[(16 + f) * 64 + lane] = pack8(v); }
            { const int mt = f >> 2, ks = f & 3, d = 32 * mt + r; const float Gend = GLs[63];
#pragma unroll
              for (int jp = 0; jp < 8; ++jp) { const int tk = 16 * ks + 8 * (jp >> 2) + 4 * hp + (jp & 3); v[jp] = KL[tk * 129 + d] * expf(Gend - GLs[tk]); }
              base[(32 + f) * 64 + lane] = pack8(v); }
            { const int pq = f & 1, tl = f >> 1, mt = tl >> 2, nt = tl & 3;
#pragma unroll
              for (int e = 0; e < 8; ++e) v[e] = XL[(32 * mt + crow(8 * pq + e, hp)) * 257 + 32 * nt + r];
              base[(56 + f) * 64 + lane] = pack8(v); } }
        if (tid == 0) GENDD[item] = expf(GLs[63]);
    }
}

__device__ __forceinline__ void phase_ab_rec(const KP kp, const int bid, const int G, int j, LAS unsigned char* lds, int tid0) {
    unsigned char* scr = kp.ws() + WS_SCR; const bf16* U = (const bf16*)(kp.ws() + WS_U);
    const float* QN = (const float*)(scr + SC_QN); const float* KN = (const float*)(scr + SC_KN); const float* VV = (const float*)(scr + SC_VV);
    const float* GLOG = (const float*)(scr + SC_GLOG); const float* BETA = (const float*)(scr + SC_BETA); const float* GDEC = (const float*)(scr + SC_GDEC);
    float* ODN = (float*)(scr + SC_ODN); float* OGLA = (float*)(scr + SC_OGLA);
    LAS float* SL = (LAS float*)lds;
    for (int item = bid; item < 1600; item += G) {
        int tid = tid0; asm volatile("" : "+v"(tid));
        int s, h; bool isdn; int half = -1;
        if (item < 32) { isdn = false; s = item >> 3; h = (item >> 1) & 3; half = item & 1; }
        else if (item < 64) { isdn = true; s = (item - 32) >> 3; h = (item - 32) & 7; half = -2; }
        else if (item < 1088) { isdn = true; s = 4 + ((item - 64) >> 3); h = (item - 64) & 7; }
        else { isdn = false; s = 4 + ((item - 1088) >> 2); h = (item - 1088) & 3; }
        int row0, L; seq_info(s, row0, L);
        __syncthreads();
        if (half == -2) {
            const int wave = __builtin_amdgcn_readfirstlane(tid >> 6), lane = tid & 63, r = lane & 31, hp = lane >> 5;
            const int b = s, nt = wave;
            const unsigned char* OPS = scr + SC_DNOPS; const float* GENDD = (const float*)(scr + SC_DNGEND);
            constexpr int DBUF = 72 * 1024;
#define DN_DMA(n_, bufi_) do { const unsigned char* gi_ = OPS + (size_t)((b * 32 + (n_)) * 8 + h) * DN_ITEM_BYTES + lane * 16; \
                _Pragma("unroll") for (int q_ = 0; q_ < 9; ++q_) { const int lf_ = wave + 8 * q_; \
                    __builtin_amdgcn_global_load_lds((const unsigned*)(gi_ + lf_ * 1024), (LAS unsigned*)(lds + (bufi_) * DBUF + lf_ * 1024), 16, 0, 0); } } while (0)
            f32x16 S0, S1, S2, S3;
#pragma unroll
            for (int i = 0; i < 16; ++i) { S0[i] = 0.f; S1[i] = 0.f; S2[i] = 0.f; S3[i] = 0.f; }
            DN_DMA(0, 0);
            asm volatile("s_waitcnt vmcnt(0)" ::: "memory"); __syncthreads();
            for (int n = 0; n < 32; ++n) {
                if (n + 1 < 32) DN_DMA(n + 1, (n + 1) & 1);
                if (wave < 4) {
                    const LAS bf16x8* F = (const LAS bf16x8*)(lds + (n & 1) * DBUF) + lane;
                    const float gend = GENDD[(b * 32 + n) * 8 + h];
                    const bf16x8 sb0 = PACK_ACC(S0, 0), sb1 = PACK_ACC(S0, 1), sb2 = PACK_ACC(S1, 0), sb3 = PACK_ACC(S1, 1), sb4 = PACK_ACC(S2, 0), sb5 = PACK_ACC(S2, 1), sb6 = PACK_ACC(S3, 0), sb7 = PACK_ACC(S3, 1);
                    f32x16 U0t, U1t;
                    { const bf16x8 a0 = F[(56 + nt * 2 + 0) * 64], a1 = F[(56 + nt * 2 + 1) * 64], c0 = F[(56 + (4 + nt) * 2 + 0) * 64], c1 = F[(56 + (4 + nt) * 2 + 1) * 64];
#pragma unroll
                      for (int e = 0; e < 8; ++e) { U0t[e] = bf2f((bf16)a0[e]); U0t[8 + e] = bf2f((bf16)a1[e]); U1t[e] = bf2f((bf16)c0[e]); U1t[8 + e] = bf2f((bf16)c1[e]); } }
                    U0t = MFMA32(F[0 * 64], sb0, U0t); U0t = MFMA32(F[1 * 64], sb1, U0t); U0t = MFMA32(F[2 * 64], sb2, U0t); U0t = MFMA32(F[3 * 64], sb3, U0t);
                    U0t = MFMA32(F[4 * 64], sb4, U0t); U0t = MFMA32(F[5 * 64], sb5, U0t); U0t = MFMA32(F[6 * 64], sb6, U0t); U0t = MFMA32(F[7 * 64], sb7, U0t);
                    U1t = MFMA32(F[8 * 64], sb0, U1t); U1t = MFMA32(F[9 * 64], sb1, U1t); U1t = MFMA32(F[10 * 64], sb2, U1t); U1t = MFMA32(F[11 * 64], sb3, U1t);
                    U1t = MFMA32(F[12 * 64], sb4, U1t); U1t = MFMA32(F[13 * 64], sb5, U1t); U1t = MFMA32(F[14 * 64], sb6, U1t); U1t = MFMA32(F[15 * 64], sb7, U1t);
                    const bf16x8 ub0 = PACK_ACC(U0t, 0), ub1 = PACK_ACC(U0t, 1), ub2 = PACK_ACC(U1t, 0), ub3 = PACK_ACC(U1t, 1);
                    f32x16 O0, O1;
#pragma unroll
                    for (int i = 0; i < 16; ++i) { O0[i] = 0.f; O1[i] = 0.f; }
                    O0 = MFMA32(F[16 * 64], sb0, O0); O0 = MFMA32(F[17 * 64], sb1, O0); O0 = MFMA32(F[18 * 64], sb2, O0); O0 = MFMA32(F[19 * 64], sb3, O0);
                    O0 = MFMA32(F[20 * 64], sb4, O0); O0 = MFMA32(F[21 * 64], sb5, O0); O0 = MFMA32(F[22 * 64], sb6, O0); O0 = MFMA32(F[23 * 64], sb7, O0);
                    O1 = MFMA32(F[24 * 64], sb0, O1); O1 = MFMA32(F[25 * 64], sb1, O1); O1 = MFMA32(F[26 * 64], sb2, O1); O1 = MFMA32(F[27 * 64], sb3, O1);
                    O1 = MFMA32(F[28 * 64], sb4, O1); O1 = MFMA32(F[29 * 64], sb5, O1); O1 = MFMA32(F[30 * 64], sb6, O1); O1 = MFMA32(F[31 * 64], sb7, O1);
                    O0 = MFMA32(F[48 * 64], ub0, O0); O0 = MFMA32(F[49 * 64], ub1, O0);
                    O1 = MFMA32(F[52 * 64], ub0, O1); O1 = MFMA32(F[53 * 64], ub1, O1); O1 = MFMA32(F[54 * 64], ub2, O1); O1 = MFMA32(F[55 * 64], ub3, O1);
#pragma unroll
                    for (int i = 0; i < 16; ++i) { S0[i] *= gend; S1[i] *= gend; S2[i] *= gend; S3[i] *= gend; }
                    S0 = MFMA32(F[32 * 64], ub0, S0); S0 = MFMA32(F[33 * 64], ub1, S0); S0 = MFMA32(F[34 * 64], ub2, S0); S0 = MFMA32(F[35 * 64], ub3, S0);
                    S1 = MFMA32(F[36 * 64], ub0, S1); S1 = MFMA32(F[37 * 64], ub1, S1); S1 = MFMA32(F[38 * 64], ub2, S1); S1 = MFMA32(F[39 * 64], ub3, S1);
                    S2 = MFMA32(F[40 * 64], ub0, S2); S2 = MFMA32(F[41 * 64], ub1, S2); S2 = MFMA32(F[42 * 64], ub2, S2); S2 = MFMA32(F[43 * 64], ub3, S2);
                    S3 = MFMA32(F[44 * 64], ub0, S3); S3 = MFMA32(F[45 * 64], ub1, S3); S3 = MFMA32(F[46 * 64], ub2, S3); S3 = MFMA32(F[47 * 64], ub3, S3);
                    float* yo = ODN + (size_t)(b * 2048 + n * 64) * 1024 + h * 128 + 32 * nt + r;
#pragma unroll
                    for (int i = 0; i < 16; ++i) { yo[(size_t)crow(i, hp) * 1024] = O0[i]; yo[(size_t)(32 + crow(i, hp)) * 1024] = O1[i]; }
                }
                asm volatile("s_waitcnt vmcnt(0)" ::: "memory"); __syncthreads();
            }
#undef DN_DMA
            if (wave < 4) {
                float* dst = kp.out() + O_DN_P + ((size_t)j * 4 + b) * ((size_t)8 * 128 * 128) + (size_t)h * 128 * 128 + 32 * nt + r;
#pragma unroll
                for (int i = 0; i < 16; ++i) { dst[(size_t)crow(i, hp) * 128] = S0[i]; dst[(size_t)(32 + crow(i, hp)) * 128] = S1[i]; dst[(size_t)(64 + crow(i, hp)) * 128] = S2[i]; dst[(size_t)(96 + crow(i, hp)) * 128] = S3[i]; }
            }
        } else if (half >= 0) {
            const int wave = __builtin_amdgcn_readfirstlane(tid >> 6), lane = tid & 63, r = lane & 31, hp = lane >> 5;
            const int b = s, nt = half * 4 + wave;
            const unsigned char* OPS = kp.ws() + WS_GLAOPS;
            constexpr int GBUF = 57 * 1024;
#define GLA_DMA(n_, bufi_) do { const unsigned char* gi_ = OPS + (size_t)((b * 32 + (n_)) * 4 + h) * GLA_ITEM_BYTES + lane * 16; \
                _Pragma("unroll") for (int q_ = 0; q_ < 8; ++q_) { const int lf_ = wave + 8 * q_; if (lf_ < 57) { const int gf_ = lf_ < 40 ? lf_ : (lf_ < 56 ? lf_ + half * 16 : 72); \
                    __builtin_amdgcn_global_load_lds((const unsigned*)(gi_ + gf_ * 1024), (LAS unsigned*)(lds + (bufi_) * GBUF + lf_ * 1024), 16, 0, 0); } } } while (0)
            f32x16 S0, S1, S2, S3;
#pragma unroll
            for (int i = 0; i < 16; ++i) { S0[i] = 0.f; S1[i] = 0.f; S2[i] = 0.f; S3[i] = 0.f; }
            GLA_DMA(0, 0);
            asm volatile("s_waitcnt vmcnt(0)" ::: "memory"); __syncthreads();
            for (int n = 0; n < 32; ++n) {
                if (n + 1 < 32) GLA_DMA(n + 1, (n + 1) & 1);
                if (wave < 4) {
                    const LAS bf16x8* F = (const LAS bf16x8*)(lds + (n & 1) * GBUF) + lane;
                    const LAS float* ge = (const LAS float*)(lds + (n & 1) * GBUF + 56 * 1024) + 4 * hp;
                    const bf16x8 sb0 = PACK_ACC(S0, 0), sb1 = PACK_ACC(S0, 1), sb2 = PACK_ACC(S1, 0), sb3 = PACK_ACC(S1, 1), sb4 = PACK_ACC(S2, 0), sb5 = PACK_ACC(S2, 1), sb6 = PACK_ACC(S3, 0), sb7 = PACK_ACC(S3, 1);
                    f32x16 O0, O1;
#pragma unroll
                    for (int i = 0; i < 16; ++i) { O0[i] = 0.f; O1[i] = 0.f; }
                    O0 = MFMA32(F[0 * 64], sb0, O0); O0 = MFMA32(F[1 * 64], sb1, O0); O0 = MFMA32(F[2 * 64], sb2, O0); O0 = MFMA32(F[3 * 64], sb3, O0);
                    O0 = MFMA32(F[4 * 64], sb4, O0); O0 = MFMA32(F[5 * 64], sb5, O0); O0 = MFMA32(F[6 * 64], sb6, O0); O0 = MFMA32(F[7 * 64], sb7, O0);
                    O1 = MFMA32(F[8 * 64], sb0, O1); O1 = MFMA32(F[9 * 64], sb1, O1); O1 = MFMA32(F[10 * 64], sb2, O1); O1 = MFMA32(F[11 * 64], sb3, O1);
                    O1 = MFMA32(F[12 * 64], sb4, O1); O1 = MFMA32(F[13 * 64], sb5, O1); O1 = MFMA32(F[14 * 64], sb6, O1); O1 = MFMA32(F[15 * 64], sb7, O1);
                    bf16x8 vb[4];
#pragma unroll
                    for (int ks = 0; ks < 4; ++ks) vb[ks] = F[(40 + wave * 4 + ks) * 64];
                    O0 = MFMA32(F[32 * 64], vb[0], O0); O0 = MFMA32(F[33 * 64], vb[1], O0);
#pragma unroll
                    for (int ks = 0; ks < 4; ++ks) O1 = MFMA32(F[(36 + ks) * 64], vb[ks], O1);
#pragma unroll
                    for (int q = 0; q < 4; ++q) { const f32x4 g0 = *(const LAS f32x4*)(ge + 8 * q), g1 = *(const LAS f32x4*)(ge + 32 + 8 * q), g2 = *(const LAS f32x4*)(ge + 64 + 8 * q), g3 = *(const LAS f32x4*)(ge + 96 + 8 * q);
#pragma unroll
                        for (int c = 0; c < 4; ++c) { S0[4 * q + c] *= g0[c]; S1[4 * q + c] *= g1[c]; S2[4 * q + c] *= g2[c]; S3[4 * q + c] *= g3[c]; } }
#pragma unroll
                    for (int ks = 0; ks < 4; ++ks) { S0 = MFMA32(F[(16 + ks) * 64], vb[ks], S0); S1 = MFMA32(F[(20 + ks) * 64], vb[ks], S1); S2 = MFMA32(F[(24 + ks) * 64], vb[ks], S2); S3 = MFMA32(F[(28 + ks) * 64], vb[ks], S3); }
                    float* yo = OGLA + (size_t)(b * 2048 + n * 64) * 1024 + h * 256 + 32 * nt + r;
#pragma unroll
                    for (int i = 0; i < 16; ++i) { yo[(size_t)crow(i, hp) * 1024] = O0[i]; yo[(size_t)(32 + crow(i, hp)) * 1024] = O1[i]; }
                }
                asm volatile("s_waitcnt vmcnt(0)" ::: "memory"); __syncthreads();
            }
#undef GLA_DMA
            if (wave < 4) {
                float* dst = kp.out() + O_GLA_P + ((size_t)j * 4 + b) * ((size_t)4 * 128 * 256) + (size_t)h * 128 * 256 + 32 * nt + r;
#pragma unroll
                for (int i = 0; i < 16; ++i) { dst[(size_t)crow(i, hp) * 256] = S0[i]; dst[(size_t)(32 + crow(i, hp)) * 256] = S1[i]; dst[(size_t)(64 + crow(i, hp)) * 256] = S2[i]; dst[(size_t)(96 + crow(i, hp)) * 256] = S3[i]; }
            }
        } else
        if (isdn) {
            LAS float* kL = SL + 16384; LAS float* qL = kL + 128; LAS float* red = kL + 256; LAS float* red2 = kL + 768;
            const int e = tid & 127, dq = tid >> 7;
            const size_t SZ = (size_t)8 * 128 * 128;
            const float* st = kp.in(2) + ((size_t)j * 128 + (s < 4 ? 0 : s - 4)) * SZ + (size_t)h * 128 * 128;
#pragma unroll 4
            for (int i = 0; i < 32; ++i) { const int d = dq * 32 + i; SL[d * 128 + e] = s < 4 ? 0.f : st[(size_t)d * 128 + e]; }
            for (int t = 0; t < L; ++t) {
                const size_t r = (size_t)(row0 + t);
                if (tid < 128) kL[tid] = KN[r * 1024 + h * 128 + tid]; else if (tid < 256) qL[tid - 128] = QN[r * 1024 + h * 128 + (tid - 128)];
                const float ve = VV[r * 1024 + h * 128 + e], beta = BETA[r * 8 + h], a = expf(GDEC[r * 8 + h]);
                __syncthreads();
                float part = 0.f;
#pragma unroll 4
                for (int i = 0; i < 32; ++i) { const int d = dq * 32 + i; const float sv = SL[d * 128 + e] * a; SL[d * 128 + e] = sv; part += kL[d] * sv; }
                red[dq * 128 + e] = part;
                __syncthreads();
                const float kS = (red[e] + red[128 + e]) + (red[256 + e] + red[384 + e]);
                const float u = beta * (ve - kS);
                float part2 = 0.f;
#pragma unroll 4
                for (int i = 0; i < 32; ++i) { const int d = dq * 32 + i; const float sv = SL[d * 128 + e] + kL[d] * u; SL[d * 128 + e] = sv; part2 += qL[d] * sv; }
                red2[dq * 128 + e] = part2;
                __syncthreads();
                if (dq == 0) ODN[r * 1024 + h * 128 + e] = (red2[e] + red2[128 + e]) + (red2[256 + e] + red2[384 + e]);
            }
            float* dst = s < 4 ? kp.out() + O_DN_P + ((size_t)j * 4 + s) * SZ + (size_t)h * 128 * 128 : kp.out() + O_DN_S + ((size_t)j * 128 + (s - 4)) * SZ + (size_t)h * 128 * 128;
#pragma unroll 4
            for (int i = 0; i < 32; ++i) { const int d = dq * 32 + i; dst[(size_t)d * 128 + e] = SL[d * 128 + e]; }
        } else {
            LAS float* kL = SL + 32768; LAS float* qL = kL + 128; LAS float* aL = kL + 256; LAS float* red = kL + 384;
            const int e = tid & 255, dh = tid >> 8;
            const size_t SZ = (size_t)4 * 128 * 256;
            const float* st = kp.in(4) + ((size_t)j * 128 + (s < 4 ? 0 : s - 4)) * SZ + (size_t)h * 128 * 256;
#pragma unroll 4
            for (int i = 0; i < 64; ++i) { const int d = dh * 64 + i; SL[d * 256 + e] = s < 4 ? 0.f : st[(size_t)d * 256 + e]; }
            for (int t = 0; t < L; ++t) {
                const size_t r = (size_t)(row0 + t);
                if (tid < 128) kL[tid] = bf2f(U[r * NAB + 4608 + h * 128 + tid]);
                else if (tid < 256) qL[tid - 128] = bf2f(U[r * NAB + 4096 + h * 128 + (tid - 128)]) * 0.08838834764831845f;
                else if (tid < 384) aL[tid - 256] = expf(GLOG[r * 512 + h * 128 + (tid - 256)]);
                const float ve = bf2f(U[r * NAB + 5120 + h * 256 + e]);
                __syncthreads();
                float part = 0.f;
#pragma unroll 4
                for (int i = 0; i < 64; ++i) { const int d = dh * 64 + i; const float sv = aL[d] * SL[d * 256 + e] + kL[d] * ve; SL[d * 256 + e] = sv; part += qL[d] * sv; }
                red[dh * 256 + e] = part;
                __syncthreads();
                if (dh == 0) OGLA[r * 1024 + h * 256 + e] = red[e] + red[256 + e];
            }
            float* dst = s < 4 ? kp.out() + O_GLA_P + ((size_t)j * 4 + s) * SZ + (size_t)h * 128 * 256 : kp.out() + O_GLA_S + ((size_t)j * 128 + (s - 4)) * SZ + (size_t)h * 128 * 256;
#pragma unroll 4
            for (int i = 0; i < 64; ++i) { const int d = dh * 64 + i; dst[(size_t)d * 256 + e] = SL[d * 256 + e]; }
        }
    }
}

__device__ __forceinline__ void phase_ab_post(const KP kp, const int bid, const int G, int j, int tid, int wave, int lane) {
    unsigned char* scr = kp.ws() + WS_SCR; const bf16* U = (const bf16*)(kp.ws() + WS_U); bf16* YM = (bf16*)(kp.ws() + WS_YM);
    const float* ODN = (const float*)(scr + SC_ODN); const float* OGLA = (const float*)(scr + SC_OGLA);
    const float* dnn = kp.in(17) + (size_t)j * 128; const float* glan = kp.in(20) + (size_t)j * 256;
    for (int r = bid; r < T; r += G) {
        int s, t; row_to_seq(r, s, t); int row0, L; seq_info(s, row0, L);
        { float o[2];
#pragma unroll
          for (int i = 0; i < 2; ++i) o[i] = ODN[(size_t)r * 1024 + wave * 128 + lane + 64 * i];
          const float rstd = rsqrtf(wave_sum(o[0] * o[0] + o[1] * o[1]) * (1.f / 128.f) + 1e-6f);
#pragma unroll
          for (int i = 0; i < 2; ++i) { const int e = lane + 64 * i; const float z = bf2f(U[(size_t)r * NAB + 3072 + wave * 128 + e]);
              YM[(size_t)r * DM + wave * 128 + e] = (bf16)f2bf(o[i] * rstd * dnn[e] * silu_(z)); } }
        if (wave < 4) { float o[4]; float ss = 0.f;
#pragma unroll
          for (int i = 0; i < 4; ++i) { o[i] = OGLA[(size_t)r * 1024 + wave * 256 + lane + 64 * i]; ss += o[i] * o[i]; }
          const float rstd = rsqrtf(wave_sum(ss) * (1.f / 256.f) + 1e-6f);
#pragma unroll
          for (int i = 0; i < 4; ++i) { const int e = lane + 64 * i; const float z = bf2f(U[(size_t)r * NAB + 6144 + wave * 256 + e]);
              YM[(size_t)r * DM + 1024 + wave * 256 + e] = (bf16)f2bf(o[i] * rstd * glan[e] * silu_(z)); } }
        if (t >= L - 3) { const int rr = t - (L - 3);
            float* dst = s < 4 ? kp.out() + O_DNC_P + (((size_t)j * 4 + s) * 3 + rr) * 3072 : kp.out() + O_DNC_S + (((size_t)j * 128 + (s - 4)) * 3 + rr) * 3072;
            for (int c = tid; c < 3072; c += NTHR) dst[c] = bf2f(U[(size_t)r * NAB + c]); }
    }
}

__device__ __forceinline__ void phase_cd_pre(const KP kp, const int bid, const int G, int j, LAS unsigned char* lds, int tid) {
    unsigned char* scr = kp.ws() + WS_SCR; const bf16* U = (const bf16*)(kp.ws() + WS_U);
    float* XBC = (float*)(scr + SC_XBC); float* LA = (float*)(scr + SC_LA); float* LB = (float*)(scr + SC_LB); float* DT = (float*)(scr + SC_DT);
    const float* cw = kp.in(23) + (size_t)j * 4 * 1536; const float* cb = kp.in(24) + (size_t)j * 1536; const float* stc = kp.in(6) + (size_t)j * 128 * 3 * 1536;
    const float* lcw = kp.in(29) + (size_t)j * 4 * 1024; const float* lcb = kp.in(30) + (size_t)j * 1024; const float* lstc = kp.in(8) + (size_t)j * 128 * 3 * 1024;
    const float* wa = kp.in(31) + (size_t)j * 16 * 64 * 64; const float* wx = kp.in(33) + (size_t)j * 16 * 64 * 64;
    const float* lba = kp.in(32) + (size_t)j * 1024; const float* lbx = kp.in(34) + (size_t)j * 1024; const float* lam = kp.in(35) + (size_t)j * 1024;
    LAS float* xcL = (LAS float*)lds;
    for (int r = bid; r < T; r += G) {
        int s, t; row_to_seq(r, s, t); const int row0 = r - t;
#pragma unroll
        for (int i = 0; i < 3; ++i) { const int c = tid + NTHR * i; float acc = cb[c];
#pragma unroll
            for (int tap = 0; tap < 4; ++tap) acc += cw[tap * 1536 + c] * pre_val(U, NCD, 1024 + c, row0, t - 3 + tap, s, stc, 1536, c);
            XBC[(size_t)r * 1536 + c] = silu_(acc); }
        if (tid < 16) DT[(size_t)r * 16 + tid] = softplus_(bf2f(U[(size_t)r * NCD + 4608 + tid]) + kp.in(26)[j * 16 + tid]);
        float xc[2];
#pragma unroll
        for (int i = 0; i < 2; ++i) { const int ch = tid + NTHR * i; float acc = lcb[ch];
#pragma unroll
            for (int tap = 0; tap < 4; ++tap) acc += lcw[tap * 1024 + ch] * pre_val(U, NCD, 3584 + ch, row0, t - 3 + tap, s, lstc, 1024, ch);
            xc[i] = acc; xcL[ch] = acc; }
        __syncthreads();
#pragma unroll
        for (int i = 0; i < 2; ++i) { const int ch = tid + NTHR * i, n = ch >> 6, d = ch & 63; float ra = lba[ch], ix = lbx[ch];
#pragma unroll 8
            for (int c = 0; c < 64; ++c) { const float x = xcL[n * 64 + c]; ra += x * wa[(size_t)(n * 64 + c) * 64 + d]; ix += x * wx[(size_t)(n * 64 + c) * 64 + d]; }
            const float rg = sigmoid_(ra), ig = sigmoid_(ix);
            const float log_a = -8.f * rg * softplus_(-lam[ch]);
            LA[(size_t)r * 1024 + ch] = expf(log_a);
            LB[(size_t)r * 1024 + ch] = sqrtf(-expm1f(2.f * log_a)) * (ig * xc[i]); }
        __syncthreads();
    }
}


__device__ __forceinline__ void phase_ssd_prep(const KP kp, const int bid, const int G, int j, LAS unsigned char* lds, int tid) {
    unsigned char* scr = kp.ws() + WS_SCR;
    const float* XBC = (const float*)(scr + SC_XBC); const float* DT = (const float*)(scr + SC_DT);
    unsigned char* OPS = scr + SC_SSDOP; float* GEND = (float*)(scr + SC_GEND);
    LAS float* CL = (LAS float*)lds; LAS float* BL = CL + 64 * 65; LAS float* QK = BL + 64 * 65; LAS float* GL = QK + 64 * 65;
    const float* alog = kp.in(25) + j * 16;
    const int wave = tid >> 6, lane = tid & 63;
    for (int item = bid; item < 512; item += G) {
        const int b = item >> 7, n = (item >> 2) & 31, g = item & 3;
        const int row0 = b * 2048 + n * 64;
        __syncthreads();
        for (int i = tid; i < 4096; i += NTHR) { const int t = i >> 6, d = i & 63;
            BL[t * 65 + d] = XBC[(size_t)(row0 + t) * 1536 + 1024 + g * 64 + d];
            CL[t * 65 + d] = XBC[(size_t)(row0 + t) * 1536 + 1280 + g * 64 + d]; }
        if (wave < 4) { const int h = g * 4 + wave; float gv = -expf(alog[h]) * DT[(size_t)(row0 + lane) * 16 + h];
#pragma unroll
            for (int o = 1; o < 64; o <<= 1) { const float tt = __shfl_up(gv, o); if (lane >= o) gv += tt; }
            GL[wave * 64 + lane] = gv; }
        __syncthreads();
        { const int i = tid >> 3, jg = tid & 7; float acc[8];
#pragma unroll
          for (int jj = 0; jj < 8; ++jj) acc[jj] = 0.f;
#pragma unroll 4
          for (int d = 0; d < 64; ++d) { const float c = CL[i * 65 + d];
#pragma unroll
              for (int jj = 0; jj < 8; ++jj) acc[jj] += c * BL[(jg * 8 + jj) * 65 + d]; }
#pragma unroll
          for (int jj = 0; jj < 8; ++jj) QK[i * 65 + jg * 8 + jj] = acc[jj]; }
        __syncthreads();
        const int f = wave, r = lane & 31, hp = lane >> 5, mt = f >> 2, ks = f & 3;
        for (int hh = 0; hh < 4; ++hh) {
            const int h = g * 4 + hh; const LAS float* Gh = GL + hh * 64; const float Gend = Gh[63];
            bf16x8* base = (bf16x8*)(OPS + ((size_t)((b * 32 + n) * 16 + h)) * 32768);
            float v[8];
            { const int i = 32 * mt + r; const float eg = expf(Gh[i]);
#pragma unroll
              for (int jp = 0; jp < 8; ++jp) { const int d = 16 * ks + 8 * (jp >> 2) + 4 * hp + (jp & 3); v[jp] = CL[i * 65 + d] * eg; }
              base[0 * 512 + f * 64 + lane] = pack8(v); }
            { const int d = 32 * mt + r;
#pragma unroll
              for (int jp = 0; jp < 8; ++jp) { const int tk = 16 * ks + 8 * (jp >> 2) + 4 * hp + (jp & 3); v[jp] = BL[tk * 65 + d] * expf(Gend - Gh[tk]); }
              base[1 * 512 + f * 64 + lane] = pack8(v); }
            { const int i = 32 * mt + r; const float gi = Gh[i];
#pragma unroll
              for (int jp = 0; jp < 8; ++jp) { const int jt = 16 * ks + 8 * (jp >> 2) + 4 * hp + (jp & 3); v[jp] = jt <= i ? QK[i * 65 + jt] * expf(gi - Gh[jt]) : 0.f; }
              base[2 * 512 + f * 64 + lane] = pack8(v); }
            { const int p = 32 * mt + r;
#pragma unroll
              for (int jp = 0; jp < 8; ++jp) { const int tk = 16 * ks + 8 * (jp >> 2) + 4 * hp + (jp & 3);
                  v[jp] = XBC[(size_t)(row0 + tk) * 1536 + h * 64 + p] * DT[(size_t)(row0 + tk) * 16 + h]; }
              base[3 * 512 + f * 64 + lane] = pack8(v); }
            if (tid == 0) GEND[(b * 32 + n) * 16 + h] = expf(Gend);
        }
    }
}

__device__ __forceinline__ void phase_cd_rec(const KP kp, const int bid, const int G, int j, LAS unsigned char* lds, int tid0) {
    unsigned char* scr = kp.ws() + WS_SCR;
    const float* XBC = (const float*)(scr + SC_XBC); const float* LA = (const float*)(scr + SC_LA); const float* LB = (const float*)(scr + SC_LB); const float* DT = (const float*)(scr + SC_DT);
    float* YS = (float*)(scr + SC_YS); float* HS = (float*)(scr + SC_HS);
    LAS float* bL = (LAS float*)lds; LAS float* cL = bL + 64; LAS float* red = bL + 128;
    for (int item = bid; item < 2576; item += G) {
        int tid = tid0; asm volatile("" : "+v"(tid));
        int kind, s, h;
        if (item < 16) { kind = 2; s = item >> 2; h = item & 3; }
        else if (item < 272) { kind = 3; s = (item - 16) >> 6; h = (item - 16) & 63; }
        else if (item < 2320) { kind = 0; s = 4 + ((item - 272) >> 4); h = (item - 272) & 15; }
        else { kind = 1; s = 4 + ((item - 2320) >> 1); h = (item - 2320) & 1; }
        int row0, L; seq_info(s, row0, L);
        __syncthreads();
        if (kind == 3) {
            LAS float* Al = (LAS float*)lds; LAS float* Bl = Al + 512;
            const int chunk = tid >> 4, c16 = tid & 15, ch = h * 16 + c16;
            const size_t ro = (size_t)(row0 + chunk * 64) * 1024 + ch;
            float Ap = 1.f, Bp = 0.f;
#pragma unroll 8
            for (int t = 0; t < 64; ++t) { const float a = LA[ro + (size_t)t * 1024], bb = LB[ro + (size_t)t * 1024]; Bp = a * Bp + bb; Ap *= a; }
            Al[tid] = Ap; Bl[tid] = Bp;
            __syncthreads();
            float hh = 0.f;
            for (int m = 0; m < chunk; ++m) hh = Al[m * 16 + c16] * hh + Bl[m * 16 + c16];
#pragma unroll 8
            for (int t = 0; t < 64; ++t) { hh = LA[ro + (size_t)t * 1024] * hh + LB[ro + (size_t)t * 1024]; HS[ro + (size_t)t * 1024] = hh; }
            if (chunk == 31) kp.out()[O_LRU_P + ((size_t)j * 4 + s) * 1024 + ch] = hh;
        } else
        if (kind == 2) {
            const int wave = __builtin_amdgcn_readfirstlane(tid >> 6), lane = tid & 63, r = lane & 31, hp = lane >> 5;
            const int b = s, hd = h * 4 + (wave >> 1), nt = wave & 1;
            const unsigned char* OPS = scr + SC_SSDOP; const float* GEND = (const float*)(scr + SC_GEND);
            f32x16 S0, S1;
#pragma unroll
            for (int i = 0; i < 16; ++i) { S0[i] = 0.f; S1[i] = 0.f; }
            for (int n = 0; n < 32; ++n) {
                const bf16x8* F = (const bf16x8*)(OPS + ((size_t)((b * 32 + n) * 16 + hd)) * 32768) + lane;
                bf16x8 qg[2][4], kT[2][4], Am[2][4], vb[4];
#pragma unroll
                for (int mt = 0; mt < 2; ++mt)
#pragma unroll
                    for (int ks = 0; ks < 4; ++ks) { qg[mt][ks] = F[(0 * 8 + mt * 4 + ks) * 64]; kT[mt][ks] = F[(1 * 8 + mt * 4 + ks) * 64]; Am[mt][ks] = F[(2 * 8 + mt * 4 + ks) * 64]; }
#pragma unroll
                for (int ks = 0; ks < 4; ++ks) vb[ks] = F[(3 * 8 + nt * 4 + ks) * 64];
                const float gend = GEND[(b * 32 + n) * 16 + hd];
                const bf16x8 sb00 = PACK_ACC(S0, 0), sb01 = PACK_ACC(S0, 1), sb10 = PACK_ACC(S1, 0), sb11 = PACK_ACC(S1, 1);
                f32x16 O0, O1;
#pragma unroll
                for (int i = 0; i < 16; ++i) { O0[i] = 0.f; O1[i] = 0.f; }
                O0 = MFMA32(qg[0][0], sb00, O0); O0 = MFMA32(qg[0][1], sb01, O0); O0 = MFMA32(qg[0][2], sb10, O0); O0 = MFMA32(qg[0][3], sb11, O0);
                O1 = MFMA32(qg[1][0], sb00, O1); O1 = MFMA32(qg[1][1], sb01, O1); O1 = MFMA32(qg[1][2], sb10, O1); O1 = MFMA32(qg[1][3], sb11, O1);
                O0 = MFMA32(Am[0][0], vb[0], O0); O0 = MFMA32(Am[0][1], vb[1], O0);
#pragma unroll
                for (int ks = 0; ks < 4; ++ks) O1 = MFMA32(Am[1][ks], vb[ks], O1);
#pragma unroll
                for (int i = 0; i < 16; ++i) { S0[i] *= gend; S1[i] *= gend; }
#pragma unroll
                for (int ks = 0; ks < 4; ++ks) { S0 = MFMA32(kT[0][ks], vb[ks], S0); S1 = MFMA32(kT[1][ks], vb[ks], S1); }
                float* yo = YS + (size_t)(b * 2048 + n * 64) * 1024 + hd * 64 + 32 * nt + r;
#pragma unroll
                for (int i = 0; i < 16; ++i) { yo[(size_t)crow(i, hp) * 1024] = O0[i]; yo[(size_t)(32 + crow(i, hp)) * 1024] = O1[i]; }
            }
            float* dst = kp.out() + O_SSD_P + ((size_t)j * 4 + b) * ((size_t)16 * 64 * 64) + (size_t)hd * 64 * 64 + 32 * nt + r;
#pragma unroll
            for (int i = 0; i < 16; ++i) { dst[(size_t)crow(i, hp) * 64] = S0[i]; dst[(size_t)(32 + crow(i, hp)) * 64] = S1[i]; }
        } else if (kind == 0) {
            const int p = tid & 63, ng = tid >> 6, grp = h >> 2;
            const size_t SZ = (size_t)16 * 64 * 64;
            float S[8];
            if (s < 4) {
#pragma unroll
                for (int i = 0; i < 8; ++i) S[i] = 0.f;
            } else { const float* st = kp.in(5) + ((size_t)j * 128 + (s - 4)) * SZ + (size_t)h * 64 * 64;
#pragma unroll
                for (int i = 0; i < 8; ++i) S[i] = st[(size_t)(ng * 8 + i) * 64 + p]; }
            const float negA = -expf(kp.in(25)[j * 16 + h]);
            for (int t = 0; t < L; ++t) {
                const size_t r = (size_t)(row0 + t);
                if (tid < 64) bL[tid] = XBC[r * 1536 + 1024 + grp * 64 + tid]; else if (tid < 128) cL[tid - 64] = XBC[r * 1536 + 1280 + grp * 64 + (tid - 64)];
                const float xp = XBC[r * 1536 + h * 64 + p], dt = DT[r * 16 + h], a = expf(negA * dt), xdt = xp * dt;
                __syncthreads();
                float part = 0.f;
#pragma unroll
                for (int i = 0; i < 8; ++i) { const int n = ng * 8 + i; S[i] = a * S[i] + bL[n] * xdt; part += cL[n] * S[i]; }
                red[ng * 64 + p] = part;
                __syncthreads();
                if (ng == 0) { float y = 0.f;
#pragma unroll
                    for (int g = 0; g < 8; ++g) y += red[g * 64 + p];
                    YS[r * 1024 + h * 64 + p] = y; }
            }
            float* dst = s < 4 ? kp.out() + O_SSD_P + ((size_t)j * 4 + s) * SZ + (size_t)h * 64 * 64 : kp.out() + O_SSD_S + ((size_t)j * 128 + (s - 4)) * SZ + (size_t)h * 64 * 64;
#pragma unroll
            for (int i = 0; i < 8; ++i) dst[(size_t)(ng * 8 + i) * 64 + p] = S[i];
        } else {
            const int ch = h * 512 + tid;
            float hh = s < 4 ? 0.f : kp.in(7)[((size_t)j * 128 + (s - 4)) * 1024 + ch];
#pragma unroll 8
            for (int t = 0; t < L; ++t) { const size_t r = (size_t)(row0 + t); hh = LA[r * 1024 + ch] * hh + LB[r * 1024 + ch]; HS[r * 1024 + ch] = hh; }
            float* dst = s < 4 ? kp.out() + O_LRU_P + ((size_t)j * 4 + s) * 1024 : kp.out() + O_LRU_S + ((size_t)j * 128 + (s - 4)) * 1024;
            dst[ch] = hh;
        }
    }
}

__device__ __forceinline__ void phase_cd_post(const KP kp, const int bid, const int G, int j, int tid, int wave, int lane) {
    unsigned char* scr = kp.ws() + WS_SCR; const bf16* U = (const bf16*)(kp.ws() + WS_U); bf16* YM = (bf16*)(kp.ws() + WS_YM);
    const float* YS = (const float*)(scr + SC_YS); const float* HS = (const float*)(scr + SC_HS); const float* XBC = (const float*)(scr + SC_XBC);
    const float* sn = kp.in(28) + (size_t)j * 1024;
    for (int r = bid; r < T; r += G) {
        int s, t; row_to_seq(r, s, t); int row0, L; seq_info(s, row0, L);
        if (wave < 4) { float y[4]; float ss = 0.f;
#pragma unroll
            for (int i = 0; i < 4; ++i) { const int e = wave * 256 + lane + 64 * i; y[i] = (YS[(size_t)r * 1024 + e] + kp.in(27)[j * 16 + (e >> 6)] * XBC[(size_t)r * 1536 + e]) * silu_(bf2f(U[(size_t)r * NCD + e])); ss += y[i] * y[i]; }
            const float rstd = rsqrtf(wave_sum(ss) * (1.f / 256.f) + 1e-6f);
#pragma unroll
            for (int i = 0; i < 4; ++i) { const int e = wave * 256 + lane + 64 * i; YM[(size_t)r * DM + e] = (bf16)f2bf(y[i] * rstd * sn[e]); }
        } else {
#pragma unroll
            for (int i = 0; i < 4; ++i) { const int ch = (wave - 4) * 256 + lane + 64 * i;
                YM[(size_t)r * DM + 1024 + ch] = (bf16)f2bf(HS[(size_t)r * 1024 + ch] * silu_(bf2f(U[(size_t)r * NCD + 2560 + ch]))); }
        }
        if (t >= L - 3) { const int rr = t - (L - 3);
            float* d1 = s < 4 ? kp.out() + O_SSDC_P + (((size_t)j * 4 + s) * 3 + rr) * 1536 : kp.out() + O_SSDC_S + (((size_t)j * 128 + (s - 4)) * 3 + rr) * 1536;
            for (int c = tid; c < 1536; c += NTHR) d1[c] = bf2f(U[(size_t)r * NCD + 1024 + c]);
            float* d2 = s < 4 ? kp.out() + O_LRUC_P + (((size_t)j * 4 + s) * 3 + rr) * 1024 : kp.out() + O_LRUC_S + (((size_t)j * 128 + (s - 4)) * 3 + rr) * 1024;
            for (int c = tid; c < 1024; c += NTHR) d2[c] = bf2f(U[(size_t)r * NCD + 3584 + c]); }
    }
}

__global__ void __launch_bounds__(NTHR, 2) mega_fwd(Args A) {
    extern __shared__ __attribute__((aligned(16))) unsigned char lds_raw[];
    LAS unsigned char* lds = (LAS unsigned char*)lds_raw;
    const int G = gridDim.x;
    volatile LAS unsigned* bst = (volatile LAS unsigned*)(lds + LDS_BYTES - 16);
    if (threadIdx.x == 0) { bst[0] = 0u; bst[1] = 0u; }
    __syncthreads();
    XcdBarrier xbar = xcd_barrier_post((unsigned*)(A.ws + WS_CTL) + CW_BAR, bst);
#ifdef PROBE_GROUP
    unsigned long long t_prev = __builtin_amdgcn_s_memrealtime(), t_sel = 0;
#endif
    for (int ph = A.ph_lo; ph < A.ph_hi; ++ph) {
        KP kp; kp.p = (const char AS4*)__builtin_amdgcn_kernarg_segment_ptr(); asm volatile("" : "+s"(kp.p));
        unsigned char* ws = kp.ws();
        int tid = threadIdx.x; asm volatile("" : "+v"(tid));
        int bid = blockIdx.x; asm volatile("" : "+s"(bid));
        const int lane = tid & 63, wave = __builtin_amdgcn_readfirstlane(tid >> 6), gw = bid * NWAVES + wave, NGW = G * NWAVES;
        if (ph == 0) { if (PH_MASK & 1) phase_prologue(kp, lds, gw, NGW, wave, lane); }
        else {
            const int li = (ph - 1) / SUBS, sub = (ph - 1) % SUBS, j = li >> 1; const bool ab = (li & 1) == 0;
            if (sub == 0) {
                const int N = ab ? NAB : NCD;
                const bf16* Bt = ab ? (const bf16*)(ws + WS_WABIN) + (size_t)j * NAB * 2048 : (const bf16*)(ws + WS_WCDIN) + (size_t)j * NCD * 2048;
                pg8::Gemm g{(const bf16*)(ws + WS_XN), Bt, T, N, 2048}; pg8::StaticOrder S; S.init(T, N, G, bid);
                pg8::EpiBf16 E{(bf16*)(ws + WS_U), N};
                if (PH_MASK & 2) pg8::gemm_phase<pg8::EpiBf16, pg8::StaticOrder, true, true>(lds, g, S, E, tid);
            } else if (sub == 5 || sub == 7 || sub == 8) {
                const bf16* Am; const bf16* Bt; int K = 2048; float* C = (float*)(ws + WS_SCR + SC_C);
                if (sub == 5) { Am = (const bf16*)(ws + WS_YM); Bt = ab ? (const bf16*)(ws + WS_WABOUT) + (size_t)j * 2048 * 2048 : (const bf16*)(ws + WS_WCDOUT) + (size_t)j * 2048 * 2048; }
                else if (sub == 7) { Am = (const bf16*)(ws + WS_XN); Bt = (const bf16*)(ws + WS_WGATE) + (size_t)li * 2048 * 2048; }
                else { Am = (const bf16*)(ws + WS_PB) + (size_t)li * T * 256; Bt = (const bf16*)(ws + WS_WPROJ) + (size_t)li * 2048 * 256; K = 256; C = (float*)(ws + WS_SCR + SC_C2); }
                pg8::Gemm g{Am, Bt, T, 2048, K}; pg8::StaticOrder S; S.init(T, 2048, G, bid);
                pg8::EpiF32 E{C, 2048};
                if (PH_MASK & 4) pg8::gemm_phase<pg8::EpiF32, pg8::StaticOrder, true, true>(lds, g, S, E, tid);
            } else if (sub == 1) { if (ab) { if (PH_MASK & 8) phase_ab_pre(kp, bid, G, j, tid, wave, lane); } else { if (PH_MASK & 16) phase_cd_pre(kp, bid, G, j, lds, tid); } }
            else if (sub == 2) { if (!ab) { if (PH_MASK & 2048) phase_ssd_prep(kp, bid, G, j, lds, tid); } else { if (PH_MASK & 4096) phase_gla_prep(kp, bid, G, j, lds, tid); if (PH_MASK & 8192) phase_dn_prep(kp, bid, G, j, lds, tid); } }
            else if (sub == 3) { if (ab) { if (PH_MASK & 32) phase_ab_rec(kp, bid, G, j, lds, tid); } else { if (PH_MASK & 64) phase_cd_rec(kp, bid, G, j, lds, tid); } }
            else if (sub == 4) { if (ab) { if (PH_MASK & 128) phase_ab_post(kp, bid, G, j, tid, wave, lane); } else { if (PH_MASK & 256) phase_cd_post(kp, bid, G, j, tid, wave, lane); } }
            else if (sub == 6) { if (PH_MASK & 512) phase_res1(kp, li, gw, NGW, lane); }
            else { if (PH_MASK & 1024) phase_res2(kp, li, gw, NGW, lane); }
        }
        if (ph + 1 < A.ph_hi) { if (ph == A.ph_lo) cg::this_grid().sync(); else xcd_barrier(xbar); }
#ifdef PROBE_GROUP
        { const unsigned long long t_now = __builtin_amdgcn_s_memrealtime(); const int li_ = (ph - 1) / SUBS, sub_ = (ph - 1) % SUBS; const bool ab_ = (li_ & 1) == 0;
          int grp = 9; if (ph > 0) { if (sub_ == 0 || sub_ == 5 || sub_ == 7 || sub_ == 8) grp = 1; else if (sub_ == 1) grp = ab_ ? 2 : 3; else if (sub_ == 2) grp = ab_ ? 4 : 5; else if (sub_ == 3) grp = ab_ ? 6 : 7; else grp = 8; }
          if (grp == PROBE_GROUP) t_sel += t_now - t_prev; t_prev = t_now; }
#endif
    }
#ifdef PROBE_GROUP
    if (blockIdx.x == 0 && threadIdx.x == 0) { const unsigned long long t0 = __builtin_amdgcn_s_memrealtime(); while (__builtin_amdgcn_s_memrealtime() - t0 < 3 * t_sel) __builtin_amdgcn_s_sleep(8); }
#endif
}

extern "C" void kernel_launch(void* const* d_in, const int* in_sizes, int n_in, void* d_out, int out_size, void* d_ws, size_t ws_size, hipStream_t stream) {
    static int grid = 0;
    if (grid == 0) {
        if (n_in != 40 || (size_t)out_size != O_END || ws_size < WS_END) { fprintf(stderr, "kernel_launch: unexpected shapes: n_in %d out %d ws %zu\n", n_in, out_size, ws_size); grid = -1; return; }
        int dev = 0, cus = 0, per_cu = 0;
        if (hipGetDevice(&dev) != hipSuccess || hipDeviceGetAttribute(&cus, hipDeviceAttributeMultiprocessorCount, dev) != hipSuccess) { grid = -1; return; }
        if (hipFuncSetAttribute((const void*)mega_fwd, hipFuncAttributeMaxDynamicSharedMemorySize, LDS_BYTES) != hipSuccess) { fprintf(stderr, "kernel_launch: hipFuncSetAttribute failed\n"); grid = -1; return; }
        if (hipOccupancyMaxActiveBlocksPerMultiprocessor(&per_cu, (const void*)mega_fwd, NTHR, LDS_BYTES) != hipSuccess || per_cu < 1) { fprintf(stderr, "kernel_launch: occupancy query says %d\n", per_cu); per_cu = 1; }
        (void)hipGetLastError();
        grid = cus;
    }
    if (grid < 0) return;
    if (hipMemsetAsync((char*)d_ws + WS_CTL, 0, CTL_ZERO_BYTES, stream) != hipSuccess) { fprintf(stderr, "kernel_launch: memset of the control words failed\n"); return; }
    Args a{};
    for (int i = 0; i < 40; ++i) a.in[i] = (const float*)d_in[i];
    a.out = (float*)d_out; a.ws = (unsigned char*)d_ws;
#if MK_N_LAUNCHES == 1
    a.ph_lo = 0; a.ph_hi = N_PHASES;
    void* args[] = {&a};
    hipError_t e = hipLaunchCooperativeKernel((const void*)mega_fwd, dim3(grid), dim3(NTHR), args, LDS_BYTES, stream);
    if (e != hipSuccess) fprintf(stderr, "cooperative launch failed: %s (grid %d)\n", hipGetErrorString(e), grid);
#else
    for (int ph = 0; ph < N_PHASES; ++ph) { a.ph_lo = ph; a.ph_hi = ph + 1; mega_fwd<<<dim3(grid), dim3(NTHR), LDS_BYTES, stream>>>(a); }
#endif
}
```

```cpp
#include <hip/hip_runtime.h>
#include <hip/hip_cooperative_groups.h>
#include <cstdio>
#include <cstdint>
namespace cg = cooperative_groups;

#ifndef MK_N_LAUNCHES
#define MK_N_LAUNCHES 1
#endif

namespace pg8 {
#define PG8_LAS __attribute__((address_space(3)))
typedef unsigned short bf16_t;
typedef short bf16x8 __attribute__((ext_vector_type(8)));
typedef float f32x4 __attribute__((ext_vector_type(4)));
typedef unsigned u32x4 __attribute__((ext_vector_type(4)));
constexpr int BM = 256, BK = 64, HALF = 128, HTB = HALF * BK * 2  , STAGE_BYTES = 8 * HTB, NXCD = 8, WGM = 8;

__host__ __device__ __forceinline__ int lds_byte(int r, int c) { const int st = (r >> 4) * 2 + (c >> 5), rr = r & 15, cc = c & 31, ob = rr * 64 + cc * 2; return st * 1024 + (ob ^ (((ob >> 9) & 1) << 5)); }
__host__ __device__ __forceinline__ void stage_rc(int b, int& R, int& C) { const int st = b / 1024, sb = b % 1024, swz = sb ^ (((sb >> 9) & 1) << 5); R = (st >> 1) * 16 + swz / 64; C = (st & 1) * 32 + (swz % 64) / 2; }
__host__ __device__ __forceinline__ int perm32(int rho) { const int n = rho >> 4, i = rho & 15; return 8 * (i >> 2) + 4 * n + (i & 3); }

struct Unit { int pm, pn; };
struct Gemm { const bf16_t* A; const bf16_t* Bt; int M, N, K; };

struct StaticOrder {
    int nM, nN, nwg, G, c;
    __host__ __device__ void init(int M, int N, int G_, int c_) { nM = M / BM; nN = N / BM; nwg = nM * nN; G = G_; c = c_; }
    __host__ __device__ bool next(int i, Unit& u) const {
        const long L = (long)i * G + c; if (L >= nwg) return false;
        int wgid = (int)L; { const int q = nwg / NXCD, r = nwg % NXCD, xcd = wgid % NXCD, off = wgid / NXCD; wgid = (xcd < r ? xcd * (q + 1) : r * (q + 1) + (xcd - r) * q) + off; }
        const int nig = WGM * nN, gid = wgid / nig, fm = gid * WGM, gsz = (nM - fm) < WGM ? (nM - fm) : WGM;
        u.pm = fm + ((wgid % nig) % gsz); u.pn = (wgid % nig) / gsz; return true;
    }
    __device__ __forceinline__ void a_ready(const Unit&) const {}
    __device__ __forceinline__ void done(const Unit&) const {}
};

__device__ __forceinline__ unsigned cvt_pk_bf16(float lo, float hi) { unsigned r; asm volatile("v_cvt_pk_bf16_f32 %0, %1, %2" : "=v"(r) : "v"(lo), "v"(hi)); return r; }
struct EpiF32 {
    static constexpr bool PERM = false, AFTER_DRAIN = false;
    float* C; int ldc;
    __device__ __forceinline__ void operator()(const f32x4 (&acc)[2][2][4][2], const Unit& u, int wr, int wc, int fr, int fq) const {
        const int row0 = u.pm * BM + wr * 64 + fr, col0 = u.pn * BM + wc * 32 + 4 * fq;
#pragma unroll
        for (int ai = 0; ai < 2; ++ai)
#pragma unroll
            for (int m = 0; m < 4; ++m) { float* rowp = C + (size_t)(row0 + ai * HALF + m * 16) * ldc + col0;
#pragma unroll
                for (int bj = 0; bj < 2; ++bj)
#pragma unroll
                    for (int n = 0; n < 2; ++n) *(f32x4*)(rowp + bj * HALF + n * 16) = acc[ai][bj][m][n]; }
    }
};
struct EpiBf16 {
    static constexpr bool PERM = true, AFTER_DRAIN = false;
    bf16_t* O; int ldc;
    __device__ __forceinline__ void operator()(const f32x4 (&acc)[2][2][4][2], const Unit& u, int wr, int wc, int fr, int fq) const {
        const int row0 = u.pm * BM + wr * 64 + fr; const int col0 = u.pn * BM + wc * 32 + 8 * fq;
#pragma unroll
        for (int ai = 0; ai < 2; ++ai)
#pragma unroll
            for (int m = 0; m < 4; ++m) { bf16_t* rowp = O + (size_t)(row0 + ai * HALF + m * 16) * ldc + col0;
#pragma unroll
                for (int bj = 0; bj < 2; ++bj) { const f32x4 v0 = acc[ai][bj][m][0], v1 = acc[ai][bj][m][1];
                    u32x4 w; w.x = cvt_pk_bf16(v0[0], v0[1]); w.y = cvt_pk_bf16(v0[2], v0[3]); w.z = cvt_pk_bf16(v1[0], v1[1]); w.w = cvt_pk_bf16(v1[2], v1[3]);
                    *(u32x4*)(rowp + bj * HALF) = w; } }
    }
};
template <class Epi, class Sched, bool ALIGN_EPI = false, bool SP2 = false>
__device__ __forceinline__ void gemm_phase(PG8_LAS unsigned char* lds, const Gemm g, const Sched& S, const Epi& E, const int tid) {
    const int wid = __builtin_amdgcn_readfirstlane(tid >> 6), lane = tid & 63, wr = wid >> 2, wc = wid & 3, fr = lane & 15, fq = lane >> 4;
    const int K = g.K, nt = K / BK;
    unsigned voffA[2], voffB[2];
#pragma unroll
    for (int i = 0; i < 2; ++i) { int R, C; stage_rc(tid * 16 + i * 8192, R, C); const int Rb = Epi::PERM ? ((R & ~31) + perm32(R & 31)) : R;
        voffA[i] = (unsigned)(R * K + C) * 2u; voffB[i] = (unsigned)(Rb * K + C) * 2u; }
    const size_t kstep = (size_t)(BK * 2);
    const size_t hstep = (size_t)HALF * K * 2;
    const size_t tstep = 2 * hstep;
    const unsigned ldsw = (unsigned)wid * 1024u;
    const int aoff = lds_byte(wr * 64 + fr, fq * 8), boff = lds_byte(wc * 32 + fr, fq * 8);
#define PG8_SA(b, h) (((b) * 2 + (h)) * HTB)
#define PG8_SB(b, h) ((4 + (b) * 2 + (h)) * HTB)
#define PG8_STAGE(bufoff, gbase, voff) do { _Pragma("unroll") for (int _i = 0; _i < 2; ++_i) \
        __builtin_amdgcn_global_load_lds((const unsigned*)((const char*)(gbase) + (voff)[_i]), (PG8_LAS unsigned*)(lds + (bufoff) + ldsw + _i * 8192), 16, 0, 0); } while (0)
#define PG8_LDA(dst, b, h) do { _Pragma("unroll") for (int m = 0; m < 4; ++m) _Pragma("unroll") for (int k = 0; k < 2; ++k) dst[m][k] = *(const PG8_LAS bf16x8*)(lds + PG8_SA(b, h) + aoff + m * 2048 + k * 1024); } while (0)
#define PG8_LDB(dst, b, h) do { _Pragma("unroll") for (int n = 0; n < 2; ++n) _Pragma("unroll") for (int k = 0; k < 2; ++k) dst[n][k] = *(const PG8_LAS bf16x8*)(lds + PG8_SB(b, h) + boff + n * 2048 + k * 1024); } while (0)
#define PG8_MMA(ai, bj, At, Bt) do { __builtin_amdgcn_s_setprio(1); _Pragma("unroll") for (int m = 0; m < 4; ++m) _Pragma("unroll") for (int n = 0; n < 2; ++n) _Pragma("unroll") for (int k = 0; k < 2; ++k) \
        acc[ai][bj][m][n] = __builtin_amdgcn_mfma_f32_16x16x32_bf16(Bt[n][k], At[m][k], acc[ai][bj][m][n], 0, 0, 0); __builtin_amdgcn_s_setprio(0); } while (0)
#define PG8_WAIT_V(n) asm volatile("s_waitcnt vmcnt(" #n ")" ::: "memory")
#define PG8_WAIT_L(n) asm volatile("s_waitcnt lgkmcnt(" #n ")" ::: "memory")
#define PG8_BAR __builtin_amdgcn_s_barrier()
#define PG8_SCHED __builtin_amdgcn_sched_barrier(0)
    Unit cur, nxt; int ui = 0;
    if (!S.next(0, cur)) return;
    f32x4 acc[2][2][4][2];
#pragma unroll
    for (int a = 0; a < 2; ++a)
#pragma unroll
        for (int b = 0; b < 2; ++b)
#pragma unroll
            for (int m = 0; m < 4; ++m)
#pragma unroll
                for (int n = 0; n < 2; ++n) acc[a][b][m][n] = (f32x4){0.f, 0.f, 0.f, 0.f};
    bf16x8 At[4][2], B0[2][2], B1[2][2];
    const char* cA = (const char*)g.A + (size_t)cur.pm * tstep; const char* cB = (const char*)g.Bt + (size_t)cur.pn * tstep;
    S.a_ready(cur);
    if constexpr (SP2) {
        PG8_STAGE(PG8_SB(0, 0), cB, voffB); PG8_STAGE(PG8_SB(0, 1), cB + hstep, voffB); PG8_STAGE(PG8_SA(0, 0), cA, voffA); PG8_STAGE(PG8_SA(0, 1), cA + hstep, voffA);
        if (wr == 1) PG8_BAR;
        PG8_WAIT_V(2); PG8_BAR;
        PG8_STAGE(PG8_SB(1, 0), cB + kstep, voffB); PG8_STAGE(PG8_SA(1, 0), cA + kstep, voffA); PG8_STAGE(PG8_SB(1, 1), cB + hstep + kstep, voffB);
        PG8_WAIT_V(6); PG8_BAR;
    } else {
        PG8_STAGE(PG8_SB(0, 0), cB, voffB); PG8_STAGE(PG8_SA(0, 0), cA, voffA); PG8_STAGE(PG8_SB(0, 1), cB + hstep, voffB); PG8_STAGE(PG8_SA(0, 1), cA + hstep, voffA);
        if (wr == 1) PG8_BAR;
        PG8_WAIT_V(4); PG8_BAR;
        PG8_STAGE(PG8_SB(1, 0), cB + kstep, voffB); PG8_STAGE(PG8_SA(1, 0), cA + kstep, voffA); PG8_STAGE(PG8_SB(1, 1), cB + hstep + kstep, voffB);
        PG8_WAIT_V(6); PG8_BAR;
    }
    for (;;) {
        const bool has_next = S.next(ui + 1, nxt);
        const char* nA = has_next ? (const char*)g.A + (size_t)nxt.pm * tstep : cA; const char* nB = has_next ? (const char*)g.Bt + (size_t)nxt.pn * tstep : cB;
        for (int t = 0; t < nt; t += 2) {
            const bool last = (t == nt - 2);
            const char* a1 = cA + (size_t)(t + 1) * kstep;
            const char* a2 = last ? nA : cA + (size_t)(t + 2) * kstep; const char* b2 = last ? nB : cB + (size_t)(t + 2) * kstep;
            const char* a3 = a2 + kstep; const char* b3 = b2 + kstep;
            if (last && has_next) S.a_ready(nxt);
            if constexpr (SP2) {
            PG8_LDB(B0, 0, 0); PG8_LDB(B1, 0, 1); PG8_SCHED; PG8_LDA(At, 0, 0); PG8_STAGE(PG8_SA(1, 1), a1 + hstep, voffA);
            PG8_WAIT_V(8); PG8_WAIT_L(0); PG8_BAR; PG8_MMA(0, 0, At, B0); PG8_MMA(0, 1, At, B1); PG8_BAR; PG8_SCHED;
            PG8_LDA(At, 0, 1); PG8_STAGE(PG8_SB(0, 0), b2, voffB); PG8_STAGE(PG8_SB(0, 1), b2 + hstep, voffB); PG8_STAGE(PG8_SA(0, 0), a2, voffA);
            PG8_WAIT_V(8); PG8_WAIT_L(0); PG8_BAR; PG8_MMA(1, 0, At, B0); PG8_MMA(1, 1, At, B1); PG8_BAR; PG8_SCHED;
            PG8_LDB(B0, 1, 0); PG8_LDB(B1, 1, 1); PG8_SCHED; PG8_LDA(At, 1, 0); PG8_STAGE(PG8_SA(0, 1), a2 + hstep, voffA);
            PG8_WAIT_V(8); PG8_WAIT_L(0); PG8_BAR; PG8_MMA(0, 0, At, B0); PG8_MMA(0, 1, At, B1); PG8_BAR; PG8_SCHED;
            PG8_LDA(At, 1, 1); PG8_STAGE(PG8_SB(1, 0), b3, voffB); PG8_STAGE(PG8_SB(1, 1), b3 + hstep, voffB); PG8_STAGE(PG8_SA(1, 0), a3, voffA);
            PG8_WAIT_V(8); PG8_WAIT_L(0); PG8_BAR; PG8_MMA(1, 0, At, B0); PG8_MMA(1, 1, At, B1); PG8_BAR; PG8_SCHED;
            } else {
            PG8_LDB(B0, 0, 0); PG8_SCHED; PG8_LDA(At, 0, 0); PG8_STAGE(PG8_SA(1, 1), a1 + hstep, voffA);
            PG8_WAIT_L(8); PG8_BAR; PG8_WAIT_L(0); PG8_MMA(0, 0, At, B0); PG8_BAR; PG8_SCHED;
            PG8_LDB(B1, 0, 1); PG8_STAGE(PG8_SB(0, 0), b2, voffB);
            PG8_BAR; PG8_WAIT_L(0); PG8_MMA(0, 1, At, B1); PG8_BAR;
            PG8_LDA(At, 0, 1); PG8_STAGE(PG8_SA(0, 0), a2, voffA);
            PG8_BAR; PG8_WAIT_L(0); PG8_MMA(1, 0, At, B0); PG8_BAR; PG8_SCHED;
            PG8_STAGE(PG8_SB(0, 1), b2 + hstep, voffB);
            PG8_WAIT_V(6); PG8_BAR; PG8_MMA(1, 1, At, B1); PG8_BAR;
            PG8_LDB(B0, 1, 0); PG8_SCHED; PG8_LDA(At, 1, 0); PG8_STAGE(PG8_SA(0, 1), a2 + hstep, voffA);
            PG8_WAIT_L(8); PG8_BAR; PG8_WAIT_L(0); PG8_MMA(0, 0, At, B0); PG8_BAR; PG8_SCHED;
            PG8_LDB(B1, 1, 1); PG8_STAGE(PG8_SB(1, 0), b3, voffB);
            PG8_BAR; PG8_WAIT_L(0); PG8_MMA(0, 1, At, B1); PG8_BAR;
            PG8_LDA(At, 1, 1); PG8_STAGE(PG8_SA(1, 0), a3, voffA);
            PG8_BAR; PG8_WAIT_L(0); PG8_MMA(1, 0, At, B0); PG8_BAR; PG8_SCHED;
            PG8_STAGE(PG8_SB(1, 1), b3 + hstep, voffB);
            PG8_WAIT_V(6); PG8_BAR; PG8_MMA(1, 1, At, B1); PG8_BAR;
            }
        }
        if constexpr (ALIGN_EPI) { if (wr == 0) PG8_BAR; }
        if constexpr (!Epi::AFTER_DRAIN) { E(acc, cur, wr, wc, fr, fq); S.done(cur); }
        if (!has_next) break;
#pragma unroll
        for (int a = 0; a < 2; ++a)
#pragma unroll
            for (int b = 0; b < 2; ++b)
#pragma unroll
                for (int m = 0; m < 4; ++m)
#pragma unroll
                    for (int n = 0; n < 2; ++n) acc[a][b][m][n] = (f32x4){0.f, 0.f, 0.f, 0.f};
        cur = nxt; cA = nA; cB = nB; ++ui;
        if constexpr (ALIGN_EPI) { if (wr == 1) PG8_BAR; }
    }
    PG8_WAIT_V(0);
    if constexpr (!ALIGN_EPI) { if (wr == 0) PG8_BAR; }
    PG8_BAR;
    if constexpr (Epi::AFTER_DRAIN) { E.fused(acc, cur, wr, wc, fr, fq, lds, wid, lane); S.done(cur); }
#undef PG8_SA
#undef PG8_SB
#undef PG8_STAGE
#undef PG8_LDA
#undef PG8_LDB
#undef PG8_MMA
#undef PG8_WAIT_V
#undef PG8_WAIT_L
#undef PG8_BAR
#undef PG8_SCHED
}
}

constexpr int TP = 8192, TS = 512, T = TP + TS, DM = 2048, NSEQ = 132;
constexpr int NAB = 7424, NCD = 4864;
constexpr int NWAVES = 8, NTHR = 512;
constexpr size_t MiB = 1u << 20;
constexpr size_t WS_CTL = 0, CTL_ZERO_BYTES = 65536;
constexpr int CW_BAR = 4096;
constexpr size_t WS_WABIN = 2 * MiB, WS_WABOUT = 60 * MiB, WS_WCDIN = 76 * MiB, WS_WCDOUT = 114 * MiB, WS_WGATE = 130 * MiB, WS_WPROJ = 162 * MiB;
constexpr size_t WS_H = 166 * MiB, WS_XN = 234 * MiB, WS_YM = 268 * MiB, WS_PB = 302 * MiB, WS_U = 320 * MiB, WS_SCR = 444 * MiB, WS_END = 732 * MiB;
constexpr size_t SC_C = 0, SC_C2 = 68 * MiB;
constexpr size_t SC_QN = 0, SC_KN = 34 * MiB, SC_VV = 68 * MiB, SC_ODN = 102 * MiB, SC_OGLA = 136 * MiB, SC_GLOG = 170 * MiB, SC_BETA = 187 * MiB, SC_GDEC = 188 * MiB, SC_DNOPS = 192 * MiB, SC_DNGEND = 264 * MiB;
constexpr size_t SC_XBC = 0, SC_LA = 52 * MiB, SC_LB = 86 * MiB, SC_YS = 120 * MiB, SC_HS = 154 * MiB, SC_DT = 188 * MiB, SC_SSDOP = 192 * MiB, SC_GEND = 256 * MiB, SC_XS = 270 * MiB;
constexpr int LDS_BYTES = 163840;
constexpr size_t O_Y_P = 0, O_Y_S = O_Y_P + (size_t)4 * 2048 * 2048, O_DN_P = O_Y_S + (size_t)128 * 4 * 2048,
    O_DNC_P = O_DN_P + (size_t)2 * 4 * 8 * 128 * 128, O_GLA_P = O_DNC_P + (size_t)2 * 4 * 3 * 3072, O_SSD_P = O_GLA_P + (size_t)2 * 4 * 4 * 128 * 256,
    O_SSDC_P = O_SSD_P + (size_t)2 * 4 * 16 * 64 * 64, O_LRU_P = O_SSDC_P + (size_t)2 * 4 * 3 * 1536, O_LRUC_P = O_LRU_P + (size_t)2 * 4 * 1024,
    O_DN_S = O_LRUC_P + (size_t)2 * 4 * 3 * 1024, O_DNC_S = O_DN_S + (size_t)2 * 128 * 8 * 128 * 128, O_GLA_S = O_DNC_S + (size_t)2 * 128 * 3 * 3072,
    O_SSD_S = O_GLA_S + (size_t)2 * 128 * 4 * 128 * 256, O_SSDC_S = O_SSD_S + (size_t)2 * 128 * 16 * 64 * 64, O_LRU_S = O_SSDC_S + (size_t)2 * 128 * 3 * 1536,
    O_LRUC_S = O_LRU_S + (size_t)2 * 128 * 1024, O_END = O_LRUC_S + (size_t)2 * 128 * 3 * 1024;
static_assert(O_END == 109064192, "output size");

#define LAS __attribute__((address_space(3)))
typedef unsigned short bf16;
typedef float f32x4 __attribute__((ext_vector_type(4)));
typedef unsigned u32x2 __attribute__((ext_vector_type(2)));
typedef unsigned u32x4 __attribute__((ext_vector_type(4)));
#define LDS_WAIT() asm volatile("s_waitcnt lgkmcnt(0)" ::: "memory")

__device__ __forceinline__ float bf2f(bf16 b) { return __uint_as_float(((unsigned)b) << 16); }
__device__ __forceinline__ unsigned f2bf(float f) { unsigned u = __float_as_uint(f); return (u + 0x7fffu + ((u >> 16) & 1u)) >> 16; }
__device__ __forceinline__ unsigned pk2(float lo, float hi) { return f2bf(lo) | (f2bf(hi) << 16); }
__device__ __forceinline__ float sigmoid_(float x) { return 1.f / (1.f + expf(-x)); }
__device__ __forceinline__ float silu_(float x) { return x / (1.f + expf(-x)); }
__device__ __forceinline__ float softplus_(float x) { return x > 20.f ? x : log1pf(expf(x)); }
__device__ __forceinline__ float wave_sum(float v) {
#pragma unroll
    for (int o = 1; o < 64; o <<= 1) v += __shfl_xor(v, o);
    return v;
}
__device__ __forceinline__ void row_to_seq(int r, int& s, int& t) { if (r < TP) { s = r >> 11; t = r & 2047; } else { s = 4 + ((r - TP) >> 2); t = (r - TP) & 3; } }
__device__ __forceinline__ void seq_info(int s, int& row0, int& L) { if (s < 4) { row0 = s << 11; L = 2048; } else { row0 = TP + ((s - 4) << 2); L = 4; } }
__device__ __forceinline__ float pre_val(const bf16* U, int ldu, int ucol, int row0, int tt, int s, const float* stc, int W, int c) {
    if (tt >= 0) return bf2f(U[(size_t)(row0 + tt) * ldu + ucol]);
    if (s < 4) return 0.f;
    return stc[((size_t)(s - 4) * 3 + (3 + tt)) * W + c];
}
__device__ __forceinline__ int map_col(int mapid, int n) {
    if (mapid == 0) return n;
    if (mapid == 1) { if (n < 3072) return n; if (n < 6144) return n + 16; if (n < 7168) return n + 32; if (n < 7184) return n - 4096; if (n < 7200) return n - 1024; return -1; }
    if (n < 2560) return n; if (n < 4608) return n + 16; if (n < 4624) return n - 2048; return -1;
}
__device__ __forceinline__ void transpose_item(const float* W, int K, int Nsrc, bf16* WT, int Npad, int mapid, LAS float* scr, int item, int lane) {
    const int nblk = Npad / 32, kb = item / nblk, nb = item % nblk, k0 = 64 * kb, n0 = 32 * nb;
    const int src = map_col(mapid, n0 + (lane & 31));
#pragma unroll 8
    for (int i = 0; i < 32; ++i) { const int kk = 2 * i + (lane >> 5); scr[kk * 33 + (lane & 31)] = src >= 0 ? W[(size_t)(k0 + kk) * Nsrc + src] : 0.f; }
    LDS_WAIT(); asm volatile("" ::: "memory");
    const int c = lane & 7;
#pragma unroll
    for (int j = 0; j < 4; ++j) { const int n = (lane >> 3) + 8 * j; const LAS float* s = scr + (8 * c) * 33 + n;
        u32x4 o; o.x = pk2(s[0 * 33], s[1 * 33]); o.y = pk2(s[2 * 33], s[3 * 33]); o.z = pk2(s[4 * 33], s[5 * 33]); o.w = pk2(s[6 * 33], s[7 * 33]);
        *(u32x4*)(WT + (size_t)(n0 + n) * K + k0 + 8 * c) = o; }
    LDS_WAIT(); asm volatile("" ::: "memory");
}
__device__ __forceinline__ void norm_row_bf16(const f32x4 (&v)[8], const float* g, bf16* orow, int lane) {
    float ss = 0.f;
#pragma unroll
    for (int j = 0; j < 8; ++j) ss += (v[j].x * v[j].x + v[j].y * v[j].y) + (v[j].z * v[j].z + v[j].w * v[j].w);
    const float rstd = rsqrtf(wave_sum(ss) * (1.f / DM) + 1e-6f);
#pragma unroll
    for (int j = 0; j < 8; ++j) { const int col = 4 * (lane + 64 * j); const f32x4 gg = *(const f32x4*)(g + col);
        u32x2 o; o.x = pk2(v[j].x * rstd * gg.x, v[j].y * rstd * gg.y); o.y = pk2(v[j].z * rstd * gg.z, v[j].w * rstd * gg.w);
        *(u32x2*)(orow + col) = o; }
}

typedef __bf16 bf16x2_t __attribute__((ext_vector_type(2)));
typedef float f32x2_t __attribute__((ext_vector_type(2)));
typedef short bf16x8 __attribute__((ext_vector_type(8)));
typedef float f32x16 __attribute__((ext_vector_type(16)));
__device__ __forceinline__ unsigned cvtpk(float lo, float hi) { f32x2_t v = {lo, hi}; bf16x2_t b = __builtin_convertvector(v, bf16x2_t); return __builtin_bit_cast(unsigned, b); }
#define MFMA32(a, b, c) __builtin_amdgcn_mfma_f32_32x32x16_bf16((a), (b), (c), 0, 0, 0)
#define PACK_ACC(x, S_) __builtin_bit_cast(bf16x8, (u32x4){cvtpk((x)[8 * (S_)], (x)[8 * (S_) + 1]), cvtpk((x)[8 * (S_) + 2], (x)[8 * (S_) + 3]), cvtpk((x)[8 * (S_) + 4], (x)[8 * (S_) + 5]), cvtpk((x)[8 * (S_) + 6], (x)[8 * (S_) + 7])})
__device__ __forceinline__ int crow(int reg, int h) { return (reg & 3) + 8 * (reg >> 2) + 4 * h; }
__device__ __forceinline__ bf16x8 pack8(const float (&v)[8]) { return __builtin_bit_cast(bf16x8, (u32x4){cvtpk(v[0], v[1]), cvtpk(v[2], v[3]), cvtpk(v[4], v[5]), cvtpk(v[6], v[7])}); }

#define XB_TMO      128
#define XB_XCNT(j)  (256  + 64 * (j))
#define XB_XSUB(j)  (1280 + 64 * (j))
#define XB_XGEN(j)  (2304 + 64 * (j))
#define XB_TOP      3328
#define XB_TOPGEN   3392
#define XCD_BAR_WORDS 3456
#define XB_SPIN_CAP (1u << 18)

__device__ __forceinline__ unsigned xb_ld(unsigned* p)              { return __hip_atomic_load(p, __ATOMIC_RELAXED, __HIP_MEMORY_SCOPE_AGENT); }
__device__ __forceinline__ unsigned xb_add(unsigned* p, unsigned v) { return __hip_atomic_fetch_add(p, v, __ATOMIC_RELAXED, __HIP_MEMORY_SCOPE_AGENT); }
__device__ __forceinline__ unsigned xb_xcc_id() { return (unsigned)__builtin_amdgcn_s_getreg((3 << 11) | 20) & 0xFu; }
#define XB_SPIN(cond, bar) do { unsigned _sp = 0; while (cond) { __builtin_amdgcn_s_sleep(1); \
    if ((++_sp & 255u) == 0u) { if (xb_ld(&(bar)[XB_TMO])) break; if (_sp > XB_SPIN_CAP) { atomicAdd(&(bar)[XB_TMO], 1u); break; } } } } while (0)

struct XcdBarrier {
    unsigned* bar; unsigned x;
    volatile LAS unsigned* st;
};

__device__ __forceinline__ XcdBarrier xcd_barrier_post(unsigned* bar, volatile LAS unsigned* st) {
    XcdBarrier b; b.bar = bar; b.x = xb_xcc_id(); b.st = st;
    if (threadIdx.x == 0) (void)xb_add(&bar[XB_XCNT(b.x)], 1u);
    return b;
}
__device__ __forceinline__ void xcd_barrier_complete(unsigned* bar, unsigned x, unsigned& nloc, unsigned& nx) {
    const unsigned G = gridDim.x * gridDim.y * gridDim.z;
    unsigned sum, cnt, mine, sp = 0u;
    for (;;) {
        sum = 0u; cnt = 0u; mine = 0u;
#pragma unroll
        for (unsigned j = 0; j < 16; ++j) { const unsigned c = xb_ld(&bar[XB_XCNT(j)]); sum += c; cnt += (c > 0u) ? 1u : 0u; mine = (j == x) ? c : mine; }
        if (sum == G) break;
        __builtin_amdgcn_s_sleep(1);
        if ((++sp & 255u) == 0u) { if (xb_ld(&bar[XB_TMO])) break; if (sp > XB_SPIN_CAP) { atomicAdd(&bar[XB_TMO], 1u); break; } }
    }
    nloc = mine > 0u ? mine : 1u; nx = cnt > 0u ? cnt : 1u;
}

__device__ __forceinline__ void xcd_barrier(const XcdBarrier& b) {
    asm volatile("s_waitcnt vmcnt(0)" ::: "memory");
    __syncthreads();
    if (threadIdx.x == 0) {
        unsigned* bar = b.bar;
        __builtin_amdgcn_s_waitcnt(0);
        unsigned nloc = b.st[0], nx = b.st[1];
        if (nloc == 0u) { xcd_barrier_complete(bar, b.x, nloc, nx); b.st[0] = nloc; b.st[1] = nx; }
        const unsigned old = xb_add(&bar[XB_XSUB(b.x)], 1u);
        const unsigned gen = old / nloc;
        if (old + 1u == (gen + 1u) * nloc) {
            __builtin_amdgcn_fence(__ATOMIC_RELEASE, "agent");
            asm volatile("s_waitcnt vmcnt(0)" ::: "memory");
            const unsigned og = xb_add(&bar[XB_TOP], 1u);
            const unsigned tg = og / nx;
            if (og + 1u == (tg + 1u) * nx) xb_add(&bar[XB_TOPGEN], 1u);
            else XB_SPIN(xb_ld(&bar[XB_TOPGEN]) == tg, bar);
            __builtin_amdgcn_fence(__ATOMIC_ACQUIRE, "agent");
            xb_add(&bar[XB_XGEN(b.x)], 1u);
            asm volatile("s_waitcnt vmcnt(0)" ::: "memory");
        } else {
            XB_SPIN(xb_ld(&bar[XB_XGEN(b.x)]) == gen, bar);
            __builtin_amdgcn_fence(__ATOMIC_ACQUIRE, "agent");
            asm volatile("s_waitcnt vmcnt(0)" ::: "memory");
        }
    }
    __syncthreads();
}


struct Args { const float* in[40]; float* out; unsigned char* ws; int ph_lo, ph_hi; };
constexpr int N_PHASES = 41, SUBS = 10;
#ifndef PH_MASK
#define PH_MASK 16383
#endif
#define AS4 __attribute__((address_space(4)))
struct KP { const char AS4* p;
    __device__ __forceinline__ const float* in(int i) const { return *(const float* const AS4*)(p + 8 * i); }
    __device__ __forceinline__ float* out() const { return *(float* const AS4*)(p + 320); }
    __device__ __forceinline__ unsigned char* ws() const { return *(unsigned char* const AS4*)(p + 328); }
};
static_assert(sizeof(Args) == 344, "Args layout");

__device__ __forceinline__ void phase_prologue(const KP kp, LAS unsigned char* lds, int gw, int NGW, int wave, int lane) {
    unsigned char* ws = kp.ws();
    LAS float* scr = (LAS float*)(lds + wave * 16384);
    for (int job = 0; job < 16; ++job) {
        const float* W; int K = 2048, Nsrc = 2048, Npad = 2048, mapid = 0; bf16* WT;
        if (job < 2)       { W = kp.in(13) + (size_t)job * 2048 * 7200; Nsrc = 7200; Npad = NAB; mapid = 1; WT = (bf16*)(ws + WS_WABIN) + (size_t)job * NAB * 2048; }
        else if (job < 4)  { W = kp.in(21) + (size_t)(job - 2) * 2048 * 2048; WT = (bf16*)(ws + WS_WABOUT) + (size_t)(job - 2) * 2048 * 2048; }
        else if (job < 6)  { W = kp.in(22) + (size_t)(job - 4) * 2048 * 4624; Nsrc = 4624; Npad = NCD; mapid = 2; WT = (bf16*)(ws + WS_WCDIN) + (size_t)(job - 4) * NCD * 2048; }
        else if (job < 8)  { W = kp.in(36) + (size_t)(job - 6) * 2048 * 2048; WT = (bf16*)(ws + WS_WCDOUT) + (size_t)(job - 6) * 2048 * 2048; }
        else if (job < 12) { W = kp.in(39) + (size_t)(job - 8) * 2048 * 2048; WT = (bf16*)(ws + WS_WGATE) + (size_t)(job - 8) * 2048 * 2048; }
        else               { W = kp.in(37) + (size_t)(job - 12) * 256 * 2048; K = 256; WT = (bf16*)(ws + WS_WPROJ) + (size_t)(job - 12) * 2048 * 256; }
        const int nitems = (K / 64) * (Npad / 32);
        for (int it = gw; it < nitems; it += NGW) transpose_item(W, K, Nsrc, WT, Npad, mapid, scr, it, lane);
    }
    float* H = (float*)(ws + WS_H); bf16* XN = (bf16*)(ws + WS_XN);
    for (int m = gw; m < T; m += NGW) {
        const float* src = m < TP ? kp.in(0) + (size_t)m * DM : kp.in(1) + (size_t)(m - TP) * DM;
        f32x4 v[8];
#pragma unroll
        for (int j = 0; j < 8; ++j) { v[j] = *(const f32x4*)(src + 4 * (lane + 64 * j)); *(f32x4*)(H + (size_t)m * DM + 4 * (lane + 64 * j)) = v[j]; }
        norm_row_bf16(v, kp.in(11), XN + (size_t)m * DM, lane);
    }
    bf16* PB = (bf16*)(ws + WS_PB);
    const int gt = gw * 64 + lane, NGT = NGW * 64;
    for (int i = gt; i < 4 * T * 64; i += NGT) {
        const int c4 = i & 63, r = (i >> 6) % T, li = (i >> 6) / T;
        const float* src = r < TP ? kp.in(9) + ((size_t)li * TP + r) * 256 + 4 * c4 : kp.in(10) + ((size_t)li * TS + (r - TP)) * 256 + 4 * c4;
        const f32x4 v = *(const f32x4*)src;
        u32x2 o; o.x = pk2(v.x, v.y); o.y = pk2(v.z, v.w);
        *(u32x2*)(PB + ((size_t)li * T + r) * 256 + 4 * c4) = o;
    }
}

__device__ __forceinline__ void phase_res1(const KP kp, int li, int gw, int NGW, int lane) {
    float* H = (float*)(kp.ws() + WS_H); bf16* XN = (bf16*)(kp.ws() + WS_XN); const float* C = (const float*)(kp.ws() + WS_SCR + SC_C);
    for (int m = gw; m < T; m += NGW) {
        f32x4 v[8];
#pragma unroll
        for (int j = 0; j < 8; ++j) { const size_t o = (size_t)m * DM + 4 * (lane + 64 * j); v[j] = *(const f32x4*)(H + o) + *(const f32x4*)(C + o); *(f32x4*)(H + o) = v[j]; }
        norm_row_bf16(v, kp.in(38) + (size_t)li * DM, XN + (size_t)m * DM, lane);
    }
}
__device__ __forceinline__ void phase_res2(const KP kp, int li, int gw, int NGW, int lane) {
    float* H = (float*)(kp.ws() + WS_H); bf16* XN = (bf16*)(kp.ws() + WS_XN); const float* C = (const float*)(kp.ws() + WS_SCR + SC_C); const float* C2 = (const float*)(kp.ws() + WS_SCR + SC_C2);
    for (int m = gw; m < T; m += NGW) {
        f32x4 v[8];
#pragma unroll
        for (int j = 0; j < 8; ++j) { const size_t o = (size_t)m * DM + 4 * (lane + 64 * j); const f32x4 c = *(const f32x4*)(C + o), c2 = *(const f32x4*)(C2 + o); f32x4 h = *(const f32x4*)(H + o);
            h.x += sigmoid_(c.x) * c2.x; h.y += sigmoid_(c.y) * c2.y; h.z += sigmoid_(c.z) * c2.z; h.w += sigmoid_(c.w) * c2.w; v[j] = h; *(f32x4*)(H + o) = h; }
        if (li < 3) norm_row_bf16(v, kp.in(11) + (size_t)(li + 1) * DM, XN + (size_t)m * DM, lane);
        else {
            float ss = 0.f;
#pragma unroll
            for (int j = 0; j < 8; ++j) ss += (v[j].x * v[j].x + v[j].y * v[j].y) + (v[j].z * v[j].z + v[j].w * v[j].w);
            const float rstd = rsqrtf(wave_sum(ss) * (1.f / DM) + 1e-6f);
#pragma unroll
            for (int j = 0; j < 8; ++j) { const int col = 4 * (lane + 64 * j); const f32x4 gg = *(const f32x4*)(kp.in(12) + col);
                f32x4 o; o.x = v[j].x * rstd * gg.x; o.y = v[j].y * rstd * gg.y; o.z = v[j].z * rstd * gg.z; o.w = v[j].w * rstd * gg.w;
                *(f32x4*)(kp.out() + (size_t)m * DM + col) = o; }
        }
    }
}

__device__ __forceinline__ void phase_ab_pre(const KP kp, const int bid, const int G, int j, int tid, int wave, int lane) {
    unsigned char* scr = kp.ws() + WS_SCR; const bf16* U = (const bf16*)(kp.ws() + WS_U);
    float* QN = (float*)(scr + SC_QN); float* KN = (float*)(scr + SC_KN); float* VV = (float*)(scr + SC_VV);
    float* GLOG = (float*)(scr + SC_GLOG); float* BETA = (float*)(scr + SC_BETA); float* GDEC = (float*)(scr + SC_GDEC);
    const float* cw = kp.in(14) + (size_t)j * 4 * 3072; const float* stc = kp.in(3) + (size_t)j * 128 * 3 * 3072;
    const float* wa2 = kp.in(18) + (size_t)j * 16 * 512; const float* ba = kp.in(19) + (size_t)j * 512;
    for (int r = TP + bid; r < T; r += G) {
        int s, t; row_to_seq(r, s, t); const int row0 = r - t;
#pragma unroll
        for (int part = 0; part < 3; ++part) {
            float val[2];
#pragma unroll
            for (int i = 0; i < 2; ++i) { const int c = part * 1024 + wave * 128 + lane + 64 * i; float acc = 0.f;
#pragma unroll
                for (int tap = 0; tap < 4; ++tap) acc += cw[tap * 3072 + c] * pre_val(U, NAB, c, row0, t - 3 + tap, s, stc, 3072, c);
                val[i] = silu_(acc); }
            if (part < 2) { const float ss = wave_sum(val[0] * val[0] + val[1] * val[1]); const float sc = rsqrtf(ss + 1e-6f) * (part == 0 ? 0.08838834764831845f : 1.f); val[0] *= sc; val[1] *= sc; }
            float* dst = part == 0 ? QN : (part == 1 ? KN : VV);
            dst[(size_t)r * 1024 + wave * 128 + lane] = val[0]; dst[(size_t)r * 1024 + wave * 128 + lane + 64] = val[1];
        }
        if (tid < 8) {
            BETA[(size_t)r * 8 + tid] = sigmoid_(bf2f(U[(size_t)r * NAB + 7168 + tid]));
            GDEC[(size_t)r * 8 + tid] = -expf(kp.in(15)[j * 8 + tid]) * softplus_(bf2f(U[(size_t)r * NAB + 7176 + tid]) + kp.in(16)[j * 8 + tid]);
        }
        { float x = ba[tid];
#pragma unroll
          for (int rr = 0; rr < 16; ++rr) x += bf2f(U[(size_t)r * NAB + 7184 + rr]) * wa2[rr * 512 + tid];
          GLOG[(size_t)r * 512 + tid] = -softplus_(-x) * (1.f / 16.f); }
    }
}


constexpr size_t GLA_ITEM_BYTES = 74752, WS_GLAOPS = WS_XN;
__device__ __forceinline__ void phase_gla_prep(const KP kp, const int bid, const int G, int j, LAS unsigned char* lds, int tid) {
    const bf16* U = (const bf16*)(kp.ws() + WS_U);
    const float* wa2 = kp.in(18) + (size_t)j * 16 * 512; const float* ba = kp.in(19) + (size_t)j * 512;
    unsigned char* OPS = kp.ws() + WS_GLAOPS;
    LAS float* GL = (LAS float*)lds; LAS float* QL = GL + 64 * 129; LAS float* KL = QL + 64 * 129; LAS float* AL = KL + 64 * 129;
    const int lane = tid & 63, r = lane & 31, hp = lane >> 5;
    for (int item = bid; item < 512; item += G) {
        const int b = item >> 7, n = (item >> 2) & 31, h = item & 3;
        const int row0 = b * 2048 + n * 64;
        __syncthreads();
        for (int i = tid; i < 8192; i += NTHR) { const int t = i >> 7, d = i & 127; const size_t ro = (size_t)(row0 + t) * NAB;
            QL[t * 129 + d] = bf2f(U[ro + 4096 + h * 128 + d]) * 0.08838834764831845f; KL[t * 129 + d] = bf2f(U[ro + 4608 + h * 128 + d]);
            float x = ba[h * 128 + d];
#pragma unroll
            for (int rr = 0; rr < 16; ++rr) x += bf2f(U[ro + 7184 + rr]) * wa2[rr * 512 + h * 128 + d];
            GL[t * 129 + d] = -softplus_(-x) * (1.f / 16.f); }
        __syncthreads();
        if (tid < 128) { float acc = 0.f;
#pragma unroll 4
            for (int t = 0; t < 64; ++t) { acc += GL[t * 129 + tid]; GL[t * 129 + tid] = acc; } }
        __syncthreads();
        for (int i = tid; i < 8192; i += NTHR) { const int t = i >> 7, d = i & 127; const float gg = GL[t * 129 + d]; QL[t * 129 + d] *= expf(gg); KL[t * 129 + d] *= expf(-gg); }
        __syncthreads();
        { const int i = tid >> 3, jg = tid & 7; float acc[8];
#pragma unroll
          for (int jj = 0; jj < 8; ++jj) acc[jj] = 0.f;
#pragma unroll 4
          for (int d = 0; d < 128; ++d) { const float c = QL[i * 129 + d];
#pragma unroll
              for (int jj = 0; jj < 8; ++jj) acc[jj] += c * KL[(jg * 8 + jj) * 129 + d]; }
#pragma unroll
          for (int jj = 0; jj < 8; ++jj) AL[i * 65 + jg * 8 + jj] = (jg * 8 + jj) <= i ? acc[jj] : 0.f; }
        __syncthreads();
        bf16x8* base = (bf16x8*)(OPS + (size_t)item * GLA_ITEM_BYTES);
        float v[8];
#pragma unroll
        for (int q = 0; q < 2; ++q) { const int f = (tid >> 6) + 8 * q;
            { const int mt = f >> 3, ks = f & 7, i = 32 * mt + r;
#pragma unroll
              for (int jp = 0; jp < 8; ++jp) v[jp] = QL[i * 129 + 16 * ks + 8 * (jp >> 2) + 4 * hp + (jp & 3)];
              base[f * 64 + lane] = pack8(v); }
            { const int mt = f >> 2, ks = f & 3, d = 32 * mt + r; const float eg = expf(GL[63 * 129 + d]);
#pragma unroll
              for (int jp = 0; jp < 8; ++jp) v[jp] = KL[(16 * ks + 8 * (jp >> 2) + 4 * hp + (jp & 3)) * 129 + d] * eg;
              base[(16 + f) * 64 + lane] = pack8(v); } }
        { const int f = tid >> 6, mt = f >> 2, ks = f & 3, i = 32 * mt + r;
#pragma unroll
          for (int jp = 0; jp < 8; ++jp) v[jp] = AL[i * 65 + 16 * ks + 8 * (jp >> 2) + 4 * hp + (jp & 3)];
          base[(32 + f) * 64 + lane] = pack8(v); }
#pragma unroll
        for (int q = 0; q < 4; ++q) { const int f = (tid >> 6) + 8 * q, nt = f >> 2, ks = f & 3, p = 32 * nt + r;
            unsigned w[4];
#pragma unroll
            for (int jp = 0; jp < 8; jp += 2) { const int t0 = 16 * ks + 8 * (jp >> 2) + 4 * hp + (jp & 3);
                w[jp >> 1] = (unsigned)U[(size_t)(row0 + t0) * NAB + 5120 + h * 256 + p] | ((unsigned)U[(size_t)(row0 + t0 + 1) * NAB + 5120 + h * 256 + p] << 16); }
            base[(40 + f) * 64 + lane] = __builtin_bit_cast(bf16x8, (u32x4){w[0], w[1], w[2], w[3]}); }
        if (tid < 128) ((float*)(base + 72 * 64))[tid] = expf(GL[63 * 129 + tid]);
    }
}


constexpr size_t DN_ITEM_BYTES = 73728;
__device__ __forceinline__ void phase_dn_prep(const KP kp, const int bid, const int G, int j, LAS unsigned char* lds, int tid0) {
    unsigned char* scr = kp.ws() + WS_SCR;
    const bf16* U = (const bf16*)(kp.ws() + WS_U); const float* cw = kp.in(14) + (size_t)j * 4 * 3072;
    unsigned char* OPS = scr + SC_DNOPS; float* GENDD = (float*)(scr + SC_DNGEND);
    LAS float* AMT = (LAS float*)lds; LAS float* GLs = AMT + 64 * 68; LAS float* BLs = GLs + 64; LAS float* SCL = BLs + 64; LAS float* KL = SCL + 128; LAS float* QL = KL + 64 * 129; LAS float* XL = QL + 64 * 129;
    for (int item = bid; item < 1024; item += G) {
        int tid = tid0; asm volatile("" : "+v"(tid));
        const int lane = tid & 63, r = lane & 31, hp = lane >> 5, wave = tid >> 6;
        const int b = item >> 8, n = (item >> 3) & 31, h = item & 7;
        const int row0 = b * 2048 + n * 64;
        __syncthreads();
        { const int d = tid & 127, tg = tid >> 7, t0 = 16 * tg;
#pragma unroll
          for (int part = 0; part < 3; ++part) { const int c = part * 1024 + h * 128 + d;
              const float w0 = cw[c], w1 = cw[3072 + c], w2 = cw[2 * 3072 + c], w3 = cw[3 * 3072 + c];
              const bf16* up = U + (size_t)(row0 + t0) * NAB + c;
              const bool first = (n == 0 && tg == 0);
              float x0 = first ? 0.f : bf2f(up[-3 * (long)NAB]), x1 = first ? 0.f : bf2f(up[-2 * (long)NAB]), x2 = first ? 0.f : bf2f(up[-1 * (long)NAB]);
              LAS float* dst = part == 0 ? QL : (part == 1 ? KL : XL);
              const int dstr = part == 2 ? 257 : 129;
#pragma unroll 4
              for (int t = 0; t < 16; ++t) { const float x3 = bf2f(up[(size_t)t * NAB]); dst[(t0 + t) * dstr + d] = silu_(w0 * x0 + w1 * x1 + w2 * x2 + w3 * x3); x0 = x1; x1 = x2; x2 = x3; } } }
        if (wave == 0) { const size_t ro = (size_t)(row0 + lane) * NAB;
            float gv = -expf(kp.in(15)[j * 8 + h]) * softplus_(bf2f(U[ro + 7176 + h]) + kp.in(16)[j * 8 + h]);
#pragma unroll
            for (int o = 1; o < 64; o <<= 1) { const float tt = __shfl_up(gv, o); if (lane >= o) gv += tt; }
            GLs[lane] = gv; BLs[lane] = sigmoid_(bf2f(U[ro + 7168 + h])); }
        __syncthreads();
        if (tid < 128) { const int t = tid & 63, which = tid >> 6; const LAS float* src = which ? KL : QL; float ss = 0.f;
#pragma unroll 8
            for (int d = 0; d < 128; ++d) { const float x = src[t * 129 + d]; ss += x * x; }
            SCL[which * 64 + t] = rsqrtf(ss + 1e-6f) * (which ? 1.f : 0.08838834764831845f); }
        __syncthreads();
        { const int d = tid & 127, t0 = 16 * (tid >> 7);
#pragma unroll 4
          for (int t = 0; t < 16; ++t) { QL[(t0 + t) * 129 + d] *= SCL[t0 + t]; KL[(t0 + t) * 129 + d] *= SCL[64 + t0 + t]; } }
        __syncthreads();
        bf16x8* base = (bf16x8*)(OPS + (size_t)item * DN_ITEM_BYTES);
        { const int i = tid >> 3, ks = (tid >> 1) & 3, hk = tid & 1; float kk[8], qk[8];
#pragma unroll
          for (int jp = 0; jp < 8; ++jp) { kk[jp] = 0.f; qk[jp] = 0.f; }
#pragma unroll 2
          for (int d = 0; d < 128; ++d) { const float kc = KL[i * 129 + d], qc = QL[i * 129 + d];
#pragma unroll
              for (int jp = 0; jp < 8; ++jp) { const float kj = KL[(16 * ks + 8 * (jp >> 2) + 4 * hk + (jp & 3)) * 129 + d]; kk[jp] += kc * kj; qk[jp] += qc * kj; } }
          const float gi = GLs[i], bi = BLs[i]; float v[8];
#pragma unroll
          for (int jp = 0; jp < 8; ++jp) { const int jt = 16 * ks + 8 * (jp >> 2) + 4 * hk + (jp & 3); const float dec = expf(gi - GLs[jt]);
              AMT[jt * 68 + i] = jt < i ? bi * kk[jp] * dec : 0.f; v[jp] = jt <= i ? qk[jp] * dec : 0.f; }
          base[(48 + (i >> 5) * 4 + ks) * 64 + (i & 31) + 32 * hk] = pack8(v); }
        __syncthreads();
        if (tid < 256) {
            const int c = tid;
#pragma unroll
            for (int bi = 0; bi < 4; ++bi) {
                float acc[16];
#pragma unroll
                for (int ii = 0; ii < 16; ++ii) { const int i = 16 * bi + ii; const float be = BLs[i];
                    acc[ii] = c < 128 ? be * XL[i * 257 + c] : be * expf(GLs[i]) * KL[i * 129 + (c - 128)]; }
                for (int jj = 0; jj < 16 * bi; ++jj) { const float xj = XL[jj * 257 + c];
#pragma unroll
                    for (int q = 0; q < 4; ++q) { const f32x4 a = *(const LAS f32x4*)(AMT + jj * 68 + 16 * bi + 4 * q);
                        acc[4 * q + 0] -= a[0] * xj; acc[4 * q + 1] -= a[1] * xj; acc[4 * q + 2] -= a[2] * xj; acc[4 * q + 3] -= a[3] * xj; } }
#pragma unroll
                for (int ii = 0; ii < 16; ++ii) { float x = acc[ii];
#pragma unroll
                    for (int jj = 0; jj < ii; ++jj) x -= AMT[(16 * bi + jj) * 68 + 16 * bi + ii] * acc[jj];
                    acc[ii] = x; XL[(16 * bi + ii) * 257 + c] = x; }
            }
        }
        __syncthreads();
        float v[8];
#pragma unroll
        for (int q = 0; q < 2; ++q) { const int f = wave + 8 * q;
            { const int mt = f >> 3, ks = f & 7, i = 32 * mt + r;
#pragma unroll
              for (int jp = 0; jp < 8; ++jp) v[jp] = -XL[i * 257 + 128 + 16 * ks + 8 * (jp >> 2) + 4 * hp + (jp & 3)];
              base[f * 64 + lane] = pack8(v);
              const float eg = expf(GLs[i]);
#pragma unroll
              for (int jp = 0; jp < 8; ++jp) v[jp] = QL[i * 129 + 16 * ks + 8 * (jp >> 2) + 4 * hp + (jp & 3)] * eg;
              base[(16 + f) * 64 + lane] = pack8(v); }
            { const int mt = f >> 2, ks = f & 3, d = 32 * mt + r; const float Gend = GLs[63];
#pragma unroll
              for (int jp = 0; jp < 8; ++jp) { const int tk = 16 * ks + 8 * (jp >> 2) + 4 * hp + (jp & 3); v[jp] = KL[tk * 129 + d] * expf(Gend - GLs[tk]); }
              base[(32 + f) * 64 + lane] = pack8(v); }
            { const int pq = f & 1, tl = f >> 1, mt = tl >> 2, nt = tl & 3;
#pragma unroll
              for (int e = 0; e < 8; ++e) v[e] = XL[(32 * mt + crow(8 * pq + e, hp)) * 257 + 32 * nt + r];
              base[(56 + f) * 64 + lane] = pack8(v); } }
        if (tid == 0) GENDD[item] = expf(GLs[63]);
    }
}

__device__ __forceinline__ void phase_ab_rec(const KP kp, const int bid, const int G, int j, LAS unsigned char* lds, int tid0) {
    unsigned char* scr = kp.ws() + WS_SCR; const bf16* U = (const bf16*)(kp.ws() + WS_U);
    const float* QN = (const float*)(scr + SC_QN); const float* KN = (const float*)(scr + SC_KN); const float* VV = (const float*)(scr + SC_VV);
    const float* GLOG = (const float*)(scr + SC_GLOG); const float* BETA = (const float*)(scr + SC_BETA); const float* GDEC = (const float*)(scr + SC_GDEC);
    float* ODN = (float*)(scr + SC_ODN); float* OGLA = (float*)(scr + SC_OGLA);
    LAS float* SL = (LAS float*)lds;
    for (int item = bid; item < 1600; item += G) {
        int tid = tid0; asm volatile("" : "+v"(tid));
        int s, h; bool isdn; int half = -1;
        if (item < 32) { isdn = false; s = item >> 3; h = (item >> 1) & 3; half = item & 1; }
        else if (item < 64) { isdn = true; s = (item - 32) >> 3; h = (item - 32) & 7; half = -2; }
        else if (item < 1088) { isdn = true; s = 4 + ((item - 64) >> 3); h = (item - 64) & 7; }
        else { isdn = false; s = 4 + ((item - 1088) >> 2); h = (item - 1088) & 3; }
        int row0, L; seq_info(s, row0, L);
        __syncthreads();
        if (half == -2) {
            const int wave = __builtin_amdgcn_readfirstlane(tid >> 6), lane = tid & 63, r = lane & 31, hp = lane >> 5;
            const int b = s, nt = wave;
            const unsigned char* OPS = scr + SC_DNOPS; const float* GENDD = (const float*)(scr + SC_DNGEND);
            constexpr int DBUF = 72 * 1024;
#define DN_DMA(n_, bufi_) do { const unsigned char* gi_ = OPS + (size_t)((b * 32 + (n_)) * 8 + h) * DN_ITEM_BYTES + lane * 16; \
                _Pragma("unroll") for (int q_ = 0; q_ < 9; ++q_) { const int lf_ = wave + 8 * q_; \
                    __builtin_amdgcn_global_load_lds((const unsigned*)(gi_ + lf_ * 1024), (LAS unsigned*)(lds + (bufi_) * DBUF + lf_ * 1024), 16, 0, 0); } } while (0)
            f32x16 S0, S1, S2, S3;
#pragma unroll
            for (int i = 0; i < 16; ++i) { S0[i] = 0.f; S1[i] = 0.f; S2[i] = 0.f; S3[i] = 0.f; }
            DN_DMA(0, 0);
            asm volatile("s_waitcnt vmcnt(0)" ::: "memory"); __syncthreads();
            for (int n = 0; n < 32; ++n) {
                if (n + 1 < 32) DN_DMA(n + 1, (n + 1) & 1);
                if (wave < 4) {
                    const LAS bf16x8* F = (const LAS bf16x8*)(lds + (n & 1) * DBUF) + lane;
                    const float gend = GENDD[(b * 32 + n) * 8 + h];
                    const bf16x8 sb0 = PACK_ACC(S0, 0), sb1 = PACK_ACC(S0, 1), sb2 = PACK_ACC(S1, 0), sb3 = PACK_ACC(S1, 1), sb4 = PACK_ACC(S2, 0), sb5 = PACK_ACC(S2, 1), sb6 = PACK_ACC(S3, 0), sb7 = PACK_ACC(S3, 1);
                    f32x16 U0t, U1t;
                    { const bf16x8 a0 = F[(56 + nt * 2 + 0) * 64], a1 = F[(56 + nt * 2 + 1) * 64], c0 = F[(56 + (4 + nt) * 2 + 0) * 64], c1 = F[(56 + (4 + nt) * 2 + 1) * 64];
#pragma unroll
                      for (int e = 0; e < 8; ++e) { U0t[e] = bf2f((bf16)a0[e]); U0t[8 + e] = bf2f((bf16)a1[e]); U1t[e] = bf2f((bf16)c0[e]); U1t[8 + e] = bf2f((bf16)c1[e]); } }
                    U0t = MFMA32(F[0 * 64], sb0, U0t); U0t = MFMA32(F[1 * 64], sb1, U0t); U0t = MFMA32(F[2 * 64], sb2, U0t); U0t = MFMA32(F[3 * 64], sb3, U0t);
                    U0t = MFMA32(F[4 * 64], sb4, U0t); U0t = MFMA32(F[5 * 64], sb5, U0t); U0t = MFMA32(F[6 * 64], sb6, U0t); U0t = MFMA32(F[7 * 64], sb7, U0t);
                    U1t = MFMA32(F[8 * 64], sb0, U1t); U1t = MFMA32(F[9 * 64], sb1, U1t); U1t = MFMA32(F[10 * 64], sb2, U1t); U1t = MFMA32(F[11 * 64], sb3, U1t);
                    U1t = MFMA32(F[12 * 64], sb4, U1t); U1t = MFMA32(F[13 * 64], sb5, U1t); U1t = MFMA32(F[14 * 64], sb6, U1t); U1t = MFMA32(F[15 * 64], sb7, U1t);
                    const bf16x8 ub0 = PACK_ACC(U0t, 0), ub1 = PACK_ACC(U0t, 1), ub2 = PACK_ACC(U1t, 0), ub3 = PACK_ACC(U1t, 1);
                    f32x16 O0, O1;
#pragma unroll
                    for (int i = 0; i < 16; ++i) { O0[i] = 0.f; O1[i] = 0.f; }
                    O0 = MFMA32(F[16 * 64], sb0, O0); O0 = MFMA32(F[17 * 64], sb1, O0); O0 = MFMA32(F[18 * 64], sb2, O0); O0 = MFMA32(F[19 * 64], sb3, O0);
                    O0 = MFMA32(F[20 * 64], sb4, O0); O0 = MFMA32(F[21 * 64], sb5, O0); O0 = MFMA32(F[22 * 64], sb6, O0); O0 = MFMA32(F[23 * 64], sb7, O0);
                    O1 = MFMA32(F[24 * 64], sb0, O1); O1 = MFMA32(F[25 * 64], sb1, O1); O1 = MFMA32(F[26 * 64], sb2, O1); O1 = MFMA32(F[27 * 64], sb3, O1);
                    O1 = MFMA32(F[28 * 64], sb4, O1); O1 = MFMA32(F[29 * 64], sb5, O1); O1 = MFMA32(F[30 * 64], sb6, O1); O1 = MFMA32(F[31 * 64], sb7, O1);
                    O0 = MFMA32(F[48 * 64], ub0, O0); O0 = MFMA32(F[49 * 64], ub1, O0);
                    O1 = MFMA32(F[52 * 64], ub0, O1); O1 = MFMA32(F[53 * 64], ub1, O1); O1 = MFMA32(F[54 * 64], ub2, O1); O1 = MFMA32(F[55 * 64], ub3, O1);
#pragma unroll
                    for (int i = 0; i < 16; ++i) { S0[i] *= gend; S1[i] *= gend; S2[i] *= gend; S3[i] *= gend; }
                    S0 = MFMA32(F[32 * 64], ub0, S0); S0 = MFMA32(F[33 * 64], ub1, S0); S0 = MFMA32(F[34 * 64], ub2, S0); S0 = MFMA32(F[35 * 64], ub3, S0);
                    S1 = MFMA32(F[36 * 64], ub0, S1); S1 = MFMA32(F[37 * 64], ub1, S1); S1 = MFMA32(F[38 * 64], ub2, S1); S1 = MFMA32(F[39 * 64], ub3, S1);
                    S2 = MFMA32(F[40 * 64], ub0, S2); S2 = MFMA32(F[41 * 64], ub1, S2); S2 = MFMA32(F[42 * 64], ub2, S2); S2 = MFMA32(F[43 * 64], ub3, S2);
                    S3 = MFMA32(F[44 * 64], ub0, S3); S3 = MFMA32(F[45 * 64], ub1, S3); S3 = MFMA32(F[46 * 64], ub2, S3); S3 = MFMA32(F[47 * 64], ub3, S3);
                    float* yo = ODN + (size_t)(b * 2048 + n * 64) * 1024 + h * 128 + 32 * nt + r;
#pragma unroll
                    for (int i = 0; i < 16; ++i) { yo[(size_t)crow(i, hp) * 1024] = O0[i]; yo[(size_t)(32 + crow(i, hp)) * 1024] = O1[i]; }
                }
                asm volatile("s_waitcnt vmcnt(0)" ::: "memory"); __syncthreads();
            }
#undef DN_DMA
            if (wave < 4) {
                float* dst = kp.out() + O_DN_P + ((size_t)j * 4 + b) * ((size_t)8 * 128 * 128) + (size_t)h * 128 * 128 + 32 * nt + r;
#pragma unroll
                for (int i = 0; i < 16; ++i) { dst[(size_t)crow(i, hp) * 128] = S0[i]; dst[(size_t)(32 + crow(i, hp)) * 128] = S1[i]; dst[(size_t)(64 + crow(i, hp)) * 128] = S2[i]; dst[(size_t)(96 + crow(i, hp)) * 128] = S3[i]; }
            }
        } else if (half >= 0) {
            const int wave = __builtin_amdgcn_readfirstlane(tid >> 6), lane = tid & 63, r = lane & 31, hp = lane >> 5;
            const int b = s, nt = half * 4 + wave;
            const unsigned char* OPS = kp.ws() + WS_GLAOPS;
            constexpr int GBUF = 57 * 1024;
#define GLA_DMA(n_, bufi_) do { const unsigned char* gi_ = OPS + (size_t)((b * 32 + (n_)) * 4 + h) * GLA_ITEM_BYTES + lane * 16; \
                _Pragma("unroll") for (int q_ = 0; q_ < 8; ++q_) { const int lf_ = wave + 8 * q_; if (lf_ < 57) { const int gf_ = lf_ < 40 ? lf_ : (lf_ < 56 ? lf_ + half * 16 : 72); \
                    __builtin_amdgcn_global_load_lds((const unsigned*)(gi_ + gf_ * 1024), (LAS unsigned*)(lds + (bufi_) * GBUF + lf_ * 1024), 16, 0, 0); } } } while (0)
            f32x16 S0, S1, S2, S3;
#pragma unroll
            for (int i = 0; i < 16; ++i) { S0[i] = 0.f; S1[i] = 0.f; S2[i] = 0.f; S3[i] = 0.f; }
            GLA_DMA(0, 0);
            asm volatile("s_waitcnt vmcnt(0)" ::: "memory"); __syncthreads();
            for (int n = 0; n < 32; ++n) {
                if (n + 1 < 32) GLA_DMA(n + 1, (n + 1) & 1);
                if (wave < 4) {
                    const LAS bf16x8* F = (const LAS bf16x8*)(lds + (n & 1) * GBUF) + lane;
                    const LAS float* ge = (const LAS float*)(lds + (n & 1) * GBUF + 56 * 1024) + 4 * hp;
                    const bf16x8 sb0 = PACK_ACC(S0, 0), sb1 = PACK_ACC(S0, 1), sb2 = PACK_ACC(S1, 0), sb3 = PACK_ACC(S1, 1), sb4 = PACK_ACC(S2, 0), sb5 = PACK_ACC(S2, 1), sb6 = PACK_ACC(S3, 0), sb7 = PACK_ACC(S3, 1);
                    f32x16 O0, O1;
#pragma unroll
                    for (int i = 0; i < 16; ++i) { O0[i] = 0.f; O1[i] = 0.f; }
                    O0 = MFMA32(F[0 * 64], sb0, O0); O0 = MFMA32(F[1 * 64], sb1, O0); O0 = MFMA32(F[2 * 64], sb2, O0); O0 = MFMA32(F[3 * 64], sb3, O0);
                    O0 = MFMA32(F[4 * 64], sb4, O0); O0 = MFMA32(F[5 * 64], sb5, O0); O0 = MFMA32(F[6 * 64], sb6, O0); O0 = MFMA32(F[7 * 64], sb7, O0);
                    O1 = MFMA32(F[8 * 64], sb0, O1); O1 = MFMA32(F[9 * 64], sb1, O1); O1 = MFMA32(F[10 * 64], sb2, O1); O1 = MFMA32(F[11 * 64], sb3, O1);
                    O1 = MFMA32(F[12 * 64], sb4, O1); O1 = MFMA32(F[13 * 64], sb5, O1); O1 = MFMA32(F[14 * 64], sb6, O1); O1 = MFMA32(F[15 * 64], sb7, O1);
                    bf16x8 vb[4];
#pragma unroll
                    for (int ks = 0; ks < 4; ++ks) vb[ks] = F[(40 + wave * 4 + ks) * 64];
                    O0 = MFMA32(F[32 * 64], vb[0], O0); O0 = MFMA32(F[33 * 64], vb[1], O0);
#pragma unroll
                    for (int ks = 0; ks < 4; ++ks) O1 = MFMA32(F[(36 + ks) * 64], vb[ks], O1);
#pragma unroll
                    for (int q = 0; q < 4; ++q) { const f32x4 g0 = *(const LAS f32x4*)(ge + 8 * q), g1 = *(const LAS f32x4*)(ge + 32 + 8 * q), g2 = *(const LAS f32x4*)(ge + 64 + 8 * q), g3 = *(const LAS f32x4*)(ge + 96 + 8 * q);
#pragma unroll
                        for (int c = 0; c < 4; ++c) { S0[4 * q + c] *= g0[c]; S1[4 * q + c] *= g1[c]; S2[4 * q + c] *= g2[c]; S3[4 * q + c] *= g3[c]; } }
#pragma unroll
                    for (int ks = 0; ks < 4; ++ks) { S0 = MFMA32(F[(16 + ks) * 64], vb[ks], S0); S1 = MFMA32(F[(20 + ks) * 64], vb[ks], S1); S2 = MFMA32(F[(24 + ks) * 64], vb[ks], S2); S3 = MFMA32(F[(28 + ks) * 64], vb[ks], S3); }
                    float* yo = OGLA + (size_t)(b * 2048 + n * 64) * 1024 + h * 256 + 32 * nt + r;
#pragma unroll
                    for (int i = 0; i < 16; ++i) { yo[(size_t)crow(i, hp) * 1024] = O0[i]; yo[(size_t)(32 + crow(i, hp)) * 1024] = O1[i]; }
                }
                asm volatile("s_waitcnt vmcnt(0)" ::: "memory"); __syncthreads();
            }
#undef GLA_DMA
            if (wave < 4) {
                float* dst = kp.out() + O_GLA_P + ((size_t)j * 4 + b) * ((size_t)4 * 128 * 256) + (size_t)h * 128 * 256 + 32 * nt + r;
#pragma unroll
                for (int i = 0; i < 16; ++i) { dst[(size_t)crow(i, hp) * 256] = S0[i]; dst[(size_t)(32 + crow(i, hp)) * 256] = S1[i]; dst[(size_t)(64 + crow(i, hp)) * 256] = S2[i]; dst[(size_t)(96 + crow(i, hp)) * 256] = S3[i]; }
            }
        } else
        if (isdn) {
            LAS float* kL = SL + 16384; LAS float* qL = kL + 128; LAS float* red = kL + 256; LAS float* red2 = kL + 768;
            const int e = tid & 127, dq = tid >> 7;
            const size_t SZ = (size_t)8 * 128 * 128;
            const float* st = kp.in(2) + ((size_t)j * 128 + (s < 4 ? 0 : s - 4)) * SZ + (size_t)h * 128 * 128;
#pragma unroll 4
            for (int i = 0; i < 32; ++i) { const int d = dq * 32 + i; SL[d * 128 + e] = s < 4 ? 0.f : st[(size_t)d * 128 + e]; }
            for (int t = 0; t < L; ++t) {
                const size_t r = (size_t)(row0 + t);
                if (tid < 128) kL[tid] = KN[r * 1024 + h * 128 + tid]; else if (tid < 256) qL[tid - 128] = QN[r * 1024 + h * 128 + (tid - 128)];
                const float ve = VV[r * 1024 + h * 128 + e], beta = BETA[r * 8 + h], a = expf(GDEC[r * 8 + h]);
                __syncthreads();
                float part = 0.f;
#pragma unroll 4
                for (int i = 0; i < 32; ++i) { const int d = dq * 32 + i; const float sv = SL[d * 128 + e] * a; SL[d * 128 + e] = sv; part += kL[d] * sv; }
                red[dq * 128 + e] = part;
                __syncthreads();
                const float kS = (red[e] + red[128 + e]) + (red[256 + e] + red[384 + e]);
                const float u = beta * (ve - kS);
                float part2 = 0.f;
#pragma unroll 4
                for (int i = 0; i < 32; ++i) { const int d = dq * 32 + i; const float sv = SL[d * 128 + e] + kL[d] * u; SL[d * 128 + e] = sv; part2 += qL[d] * sv; }
                red2[dq * 128 + e] = part2;
                __syncthreads();
                if (dq == 0) ODN[r * 1024 + h * 128 + e] = (red2[e] + red2[128 + e]) + (red2[256 + e] + red2[384 + e]);
            }
            float* dst = s < 4 ? kp.out() + O_DN_P + ((size_t)j * 4 + s) * SZ + (size_t)h * 128 * 128 : kp.out() + O_DN_S + ((size_t)j * 128 + (s - 4)) * SZ + (size_t)h * 128 * 128;
#pragma unroll 4
            for (int i = 0; i < 32; ++i) { const int d = dq * 32 + i; dst[(size_t)d * 128 + e] = SL[d * 128 + e]; }
        } else {
            LAS float* kL = SL + 32768; LAS float* qL = kL + 128; LAS float* aL = kL + 256; LAS float* red = kL + 384;
            const int e = tid & 255, dh = tid >> 8;
            const size_t SZ = (size_t)4 * 128 * 256;
            const float* st = kp.in(4) + ((size_t)j * 128 + (s < 4 ? 0 : s - 4)) * SZ + (size_t)h * 128 * 256;
#pragma unroll 4
            for (int i = 0; i < 64; ++i) { const int d = dh * 64 + i; SL[d * 256 + e] = s < 4 ? 0.f : st[(size_t)d * 256 + e]; }
            for (int t = 0; t < L; ++t) {
                const size_t r = (size_t)(row0 + t);
                if (tid < 128) kL[tid] = bf2f(U[r * NAB + 4608 + h * 128 + tid]);
                else if (tid < 256) qL[tid - 128] = bf2f(U[r * NAB + 4096 + h * 128 + (tid - 128)]) * 0.08838834764831845f;
                else if (tid < 384) aL[tid - 256] = expf(GLOG[r * 512 + h * 128 + (tid - 256)]);
                const float ve = bf2f(U[r * NAB + 5120 + h * 256 + e]);
                __syncthreads();
                float part = 0.f;
#pragma unroll 4
                for (int i = 0; i < 64; ++i) { const int d = dh * 64 + i; const float sv = aL[d] * SL[d * 256 + e] + kL[d] * ve; SL[d * 256 + e] = sv; part += qL[d] * sv; }
                red[dh * 256 + e] = part;
                __syncthreads();
                if (dh == 0) OGLA[r * 1024 + h * 256 + e] = red[e] + red[256 + e];
            }
            float* dst = s < 4 ? kp.out() + O_GLA_P + ((size_t)j * 4 + s) * SZ + (size_t)h * 128 * 256 : kp.out() + O_GLA_S + ((size_t)j * 128 + (s - 4)) * SZ + (size_t)h * 128 * 256;
#pragma unroll 4
            for (int i = 0; i < 64; ++i) { const int d = dh * 64 + i; dst[(size_t)d * 256 + e] = SL[d * 256 + e]; }
        }
    }
}

__device__ __forceinline__ void phase_ab_post(const KP kp, const int bid, const int G, int j, int tid, int wave, int lane) {
    unsigned char* scr = kp.ws() + WS_SCR; const bf16* U = (const bf16*)(kp.ws() + WS_U); bf16* YM = (bf16*)(kp.ws() + WS_YM);
    const float* ODN = (const float*)(scr + SC_ODN); const float* OGLA = (const float*)(scr + SC_OGLA);
    const float* dnn = kp.in(17) + (size_t)j * 128; const float* glan = kp.in(20) + (size_t)j * 256;
    for (int r = bid; r < T; r += G) {
        int s, t; row_to_seq(r, s, t); int row0, L; seq_info(s, row0, L);
        { float o[2];
#pragma unroll
          for (int i = 0; i < 2; ++i) o[i] = ODN[(size_t)r * 1024 + wave * 128 + lane + 64 * i];
          const float rstd = rsqrtf(wave_sum(o[0] * o[0] + o[1] * o[1]) * (1.f / 128.f) + 1e-6f);
#pragma unroll
          for (int i = 0; i < 2; ++i) { const int e = lane + 64 * i; const float z = bf2f(U[(size_t)r * NAB + 3072 + wave * 128 + e]);
              YM[(size_t)r * DM + wave * 128 + e] = (bf16)f2bf(o[i] * rstd * dnn[e] * silu_(z)); } }
        if (wave < 4) { float o[4]; float ss = 0.f;
#pragma unroll
          for (int i = 0; i < 4; ++i) { o[i] = OGLA[(size_t)r * 1024 + wave * 256 + lane + 64 * i]; ss += o[i] * o[i]; }
          const float rstd = rsqrtf(wave_sum(ss) * (1.f / 256.f) + 1e-6f);
#pragma unroll
          for (int i = 0; i < 4; ++i) { const int e = lane + 64 * i; const float z = bf2f(U[(size_t)r * NAB + 6144 + wave * 256 + e]);
              YM[(size_t)r * DM + 1024 + wave * 256 + e] = (bf16)f2bf(o[i] * rstd * glan[e] * silu_(z)); } }
        if (t >= L - 3) { const int rr = t - (L - 3);
            float* dst = s < 4 ? kp.out() + O_DNC_P + (((size_t)j * 4 + s) * 3 + rr) * 3072 : kp.out() + O_DNC_S + (((size_t)j * 128 + (s - 4)) * 3 + rr) * 3072;
            for (int c = tid; c < 3072; c += NTHR) dst[c] = bf2f(U[(size_t)r * NAB + c]); }
    }
}

__device__ __forceinline__ void phase_cd_pre(const KP kp, const int bid, const int G, int j, LAS unsigned char* lds, int tid) {
    unsigned char* scr = kp.ws() + WS_SCR; const bf16* U = (const bf16*)(kp.ws() + WS_U);
    float* XBC = (float*)(scr + SC_XBC); float* DT = (float*)(scr + SC_DT); bf16* XS = (bf16*)(scr + SC_XS);
    const float* cw = kp.in(23) + (size_t)j * 4 * 1536; const float* cb = kp.in(24) + (size_t)j * 1536; const float* stc = kp.in(6) + (size_t)j * 128 * 3 * 1536;
    for (int r = TP + bid; r < T; r += G) {
        int s, t; row_to_seq(r, s, t); const int row0 = r - t;
#pragma unroll
        for (int i = 0; i < 3; ++i) { const int c = tid + NTHR * i; float acc = cb[c];
#pragma unroll
            for (int tap = 0; tap < 4; ++tap) acc += cw[tap * 1536 + c] * pre_val(U, NCD, 1024 + c, row0, t - 3 + tap, s, stc, 1536, c);
            const float v = silu_(acc); XBC[(size_t)r * 1536 + c] = v; if (c < 1024) XS[(size_t)r * 1024 + c] = (bf16)f2bf(v); }
        if (tid < 16) DT[(size_t)r * 16 + tid] = softplus_(bf2f(U[(size_t)r * NCD + 4608 + tid]) + kp.in(26)[j * 16 + tid]);
    }
}

__device__ __forceinline__ void phase_lru_gates(const KP kp, const int bid, const int G, int j, LAS unsigned char* lds, int tid0) {
    unsigned char* scr = kp.ws() + WS_SCR; const bf16* U = (const bf16*)(kp.ws() + WS_U);
    float* LA = (float*)(scr + SC_LA); float* LB = (float*)(scr + SC_LB);
    const float* lcw = kp.in(29) + (size_t)j * 4 * 1024; const float* lcb = kp.in(30) + (size_t)j * 1024; const float* lstc = kp.in(8) + (size_t)j * 128 * 3 * 1024;
    const int n = bid & 15;
    const float* wa = kp.in(31) + ((size_t)j * 16 + n) * 4096; const float* wx = kp.in(33) + ((size_t)j * 16 + n) * 4096;
    const float* lba = kp.in(32) + (size_t)j * 1024; const float* lbx = kp.in(34) + (size_t)j * 1024; const float* lam = kp.in(35) + (size_t)j * 1024;
    LAS float* waL = (LAS float*)lds; LAS float* wxL = waL + 4096; LAS float* xcL = wxL + 4096;
    __syncthreads();
    for (int i = tid0; i < 4096; i += NTHR) { waL[i] = wa[i]; wxL[i] = wx[i]; }
    for (int tile = bid >> 4; tile < T / 64; tile += (G >> 4)) {
        int tid = tid0; asm volatile("" : "+v"(tid));
        const int c = tid & 63, tq = tid >> 6, ch = n * 64 + c, rowbase = tile * 64;
        __syncthreads();
#pragma unroll 2
        for (int tt = 0; tt < 8; ++tt) { const int r = rowbase + tq * 8 + tt; int s, t; row_to_seq(r, s, t); const int row0 = r - t; float acc = lcb[ch];
#pragma unroll
            for (int tap = 0; tap < 4; ++tap) acc += lcw[tap * 1024 + ch] * pre_val(U, NCD, 3584 + ch, row0, t - 3 + tap, s, lstc, 1024, ch);
            xcL[(tq * 8 + tt) * 65 + c] = acc; }
        __syncthreads();
        float ra[8], ix[8];
#pragma unroll
        for (int tt = 0; tt < 8; ++tt) { ra[tt] = lba[ch]; ix[tt] = lbx[ch]; }
#pragma unroll 4
        for (int cc = 0; cc < 64; ++cc) { const float wA = waL[cc * 64 + c], wX = wxL[cc * 64 + c];
#pragma unroll
            for (int tt = 0; tt < 8; ++tt) { const float x = xcL[(tq * 8 + tt) * 65 + cc]; ra[tt] += x * wA; ix[tt] += x * wX; } }
        const float spl = softplus_(-lam[ch]);
#pragma unroll
        for (int tt = 0; tt < 8; ++tt) { const size_t r = (size_t)(rowbase + tq * 8 + tt); const float rg = sigmoid_(ra[tt]), ig = sigmoid_(ix[tt]);
            const float log_a = -8.f * rg * spl;
            LA[r * 1024 + ch] = expf(log_a); LB[r * 1024 + ch] = sqrtf(-expm1f(2.f * log_a)) * (ig * xcL[(tq * 8 + tt) * 65 + c]); }
    }
}

__device__ __forceinline__ void phase_ssd_prep(const KP kp, const int bid, const int G, int j, LAS unsigned char* lds, int tid0) {
    unsigned char* scr = kp.ws() + WS_SCR;
    const bf16* U = (const bf16*)(kp.ws() + WS_U); bf16* XS = (bf16*)(scr + SC_XS);
    const float* cw = kp.in(23) + (size_t)j * 4 * 1536; const float* cb = kp.in(24) + (size_t)j * 1536;
    unsigned char* OPS = scr + SC_SSDOP; float* GEND = (float*)(scr + SC_GEND);
    LAS float* CL = (LAS float*)lds; LAS float* BL = CL + 64 * 65; LAS float* QK = BL + 64 * 65; LAS float* GL = QK + 64 * 65; LAS float* DTL = GL + 256; LAS float* XLs = DTL + 256;
    const float* alog = kp.in(25) + j * 16;
    for (int item = bid; item < 512; item += G) {
        int tid = tid0; asm volatile("" : "+v"(tid));
        const int wave = tid >> 6, lane = tid & 63;
        const int b = item >> 7, n = (item >> 2) & 31, g = item & 3;
        const int row0 = b * 2048 + n * 64;
        __syncthreads();
        { const int ci = tid & 127, tg = tid >> 7, t0 = 16 * tg;
          const bool first = (n == 0 && tg == 0);
#pragma unroll
          for (int q = 0; q < 3; ++q) { const int k = ci + 128 * q;
              int cidx; LAS float* dst; int dstr, dcol;
              if (k < 64) { cidx = 1024 + g * 64 + k; dst = BL; dstr = 65; dcol = k; }
              else if (k < 128) { cidx = 1280 + g * 64 + (k - 64); dst = CL; dstr = 65; dcol = k - 64; }
              else { cidx = g * 256 + (k - 128); dst = XLs; dstr = 257; dcol = k - 128; }
              const float w0 = cw[cidx], w1 = cw[1536 + cidx], w2 = cw[2 * 1536 + cidx], w3 = cw[3 * 1536 + cidx], bb = cb[cidx];
              const bf16* up = U + (size_t)(row0 + t0) * NCD + 1024 + cidx;
              float x0 = first ? 0.f : bf2f(up[-3 * (long)NCD]), x1 = first ? 0.f : bf2f(up[-2 * (long)NCD]), x2 = first ? 0.f : bf2f(up[-1 * (long)NCD]);
#pragma unroll 4
              for (int t = 0; t < 16; ++t) { const float x3 = bf2f(up[(size_t)t * NCD]); dst[(t0 + t) * dstr + dcol] = silu_(bb + w0 * x0 + w1 * x1 + w2 * x2 + w3 * x3); x0 = x1; x1 = x2; x2 = x3; } } }
        if (wave < 4) { const int h = g * 4 + wave; const float dt = softplus_(bf2f(U[(size_t)(row0 + lane) * NCD + 4608 + h]) + kp.in(26)[j * 16 + h]);
            DTL[wave * 64 + lane] = dt; float gv = -expf(alog[h]) * dt;
#pragma unroll
            for (int o = 1; o < 64; o <<= 1) { const float tt = __shfl_up(gv, o); if (lane >= o) gv += tt; }
            GL[wave * 64 + lane] = gv; }
        __syncthreads();
        for (int i = tid; i < 8192; i += NTHR) { const int t = i >> 7, k2 = i & 127;
            ((unsigned*)XS)[((size_t)(row0 + t) * 1024 + g * 256) / 2 + k2] = pk2(XLs[t * 257 + 2 * k2], XLs[t * 257 + 2 * k2 + 1]); }
        { const int i = tid >> 3, jg = tid & 7; float acc[8];
#pragma unroll
          for (int jj = 0; jj < 8; ++jj) acc[jj] = 0.f;
#pragma unroll 4
          for (int d = 0; d < 64; ++d) { const float c = CL[i * 65 + d];
#pragma unroll
              for (int jj = 0; jj < 8; ++jj) acc[jj] += c * BL[(jg * 8 + jj) * 65 + d]; }
#pragma unroll
          for (int jj = 0; jj < 8; ++jj) QK[i * 65 + jg * 8 + jj] = acc[jj]; }
        __syncthreads();
        const int f = wave, r = lane & 31, hp = lane >> 5, mt = f >> 2, ks = f & 3;
        for (int hh = 0; hh < 4; ++hh) {
            const int h = g * 4 + hh; const LAS float* Gh = GL + hh * 64; const float Gend = Gh[63];
            bf16x8* base = (bf16x8*)(OPS + ((size_t)((b * 32 + n) * 16 + h)) * 32768);
            float v[8];
            { const int i = 32 * mt + r; const float eg = expf(Gh[i]);
#pragma unroll
              for (int jp = 0; jp < 8; ++jp) { const int d = 16 * ks + 8 * (jp >> 2) + 4 * hp + (jp & 3); v[jp] = CL[i * 65 + d] * eg; }
              base[0 * 512 + f * 64 + lane] = pack8(v); }
            { const int d = 32 * mt + r;
#pragma unroll
              for (int jp = 0; jp < 8; ++jp) { const int tk = 16 * ks + 8 * (jp >> 2) + 4 * hp + (jp & 3); v[jp] = BL[tk * 65 + d] * expf(Gend - Gh[tk]); }
              base[1 * 512 + f * 64 + lane] = pack8(v); }
            { const int i = 32 * mt + r; const float gi = Gh[i];
#pragma unroll
              for (int jp = 0; jp < 8; ++jp) { const int jt = 16 * ks + 8 * (jp >> 2) + 4 * hp + (jp & 3); v[jp] = jt <= i ? QK[i * 65 + jt] * expf(gi - Gh[jt]) : 0.f; }
              base[2 * 512 + f * 64 + lane] = pack8(v); }
            { const int p = 32 * mt + r;
#pragma unroll
              for (int jp = 0; jp < 8; ++jp) { const int tk = 16 * ks + 8 * (jp >> 2) + 4 * hp + (jp & 3);
                  v[jp] = XLs[tk * 257 + hh * 64 + p] * DTL[hh * 64 + tk]; }
              base[3 * 512 + f * 64 + lane] = pack8(v); }
            if (tid == 0) GEND[(b * 32 + n) * 16 + h] = expf(Gend);
        }
    }
}

__device__ __forceinline__ void phase_cd_rec(const KP kp, const int bid, const int G, int j, LAS unsigned char* lds, int tid0) {
    unsigned char* scr = kp.ws() + WS_SCR;
    const float* XBC = (const float*)(scr + SC_XBC); const float* LA = (const float*)(scr + SC_LA); const float* LB = (const float*)(scr + SC_LB); const float* DT = (const float*)(scr + SC_DT);
    float* YS = (float*)(scr + SC_YS); float* HS = (float*)(scr + SC_HS);
    LAS float* bL = (LAS float*)lds; LAS float* cL = bL + 64; LAS float* red = bL + 128;
    for (int item = bid; item < 2576; item += G) {
        int tid = tid0; asm volatile("" : "+v"(tid));
        int kind, s, h;
        if (item < 16) { kind = 2; s = item >> 2; h = item & 3; }
        else if (item < 272) { kind = 3; s = (item - 16) >> 6; h = (item - 16) & 63; }
        else if (item < 2320) { kind = 0; s = 4 + ((item - 272) >> 4); h = (item - 272) & 15; }
        else { kind = 1; s = 4 + ((item - 2320) >> 1); h = (item - 2320) & 1; }
        int row0, L; seq_info(s, row0, L);
        __syncthreads();
        if (kind == 3) {
            LAS float* Al = (LAS float*)lds; LAS float* Bl = Al + 512;
            const int chunk = tid >> 4, c16 = tid & 15, ch = h * 16 + c16;
            const size_t ro = (size_t)(row0 + chunk * 64) * 1024 + ch;
            float Ap = 1.f, Bp = 0.f;
#pragma unroll 8
            for (int t = 0; t < 64; ++t) { const float a = LA[ro + (size_t)t * 1024], bb = LB[ro + (size_t)t * 1024]; Bp = a * Bp + bb; Ap *= a; }
            Al[tid] = Ap; Bl[tid] = Bp;
            __syncthreads();
            float hh = 0.f;
            for (int m = 0; m < chunk; ++m) hh = Al[m * 16 + c16] * hh + Bl[m * 16 + c16];
#pragma unroll 8
            for (int t = 0; t < 64; ++t) { hh = LA[ro + (size_t)t * 1024] * hh + LB[ro + (size_t)t * 1024]; HS[ro + (size_t)t * 1024] = hh; }
            if (chunk == 31) kp.out()[O_LRU_P + ((size_t)j * 4 + s) * 1024 + ch] = hh;
        } else
        if (kind == 2) {
            const int wave = __builtin_amdgcn_readfirstlane(tid >> 6), lane = tid & 63, r = lane & 31, hp = lane >> 5;
            const int b = s, hd = h * 4 + (wave >> 1), nt = wave & 1;
            const unsigned char* OPS = scr + SC_SSDOP; const float* GEND = (const float*)(scr + SC_GEND);
            f32x16 S0, S1;
#pragma unroll
            for (int i = 0; i < 16; ++i) { S0[i] = 0.f; S1[i] = 0.f; }
            for (int n = 0; n < 32; ++n) {
                const bf16x8* F = (const bf16x8*)(OPS + ((size_t)((b * 32 + n) * 16 + hd)) * 32768) + lane;
                bf16x8 qg[2][4], kT[2][4], Am[2][4], vb[4];
#pragma unroll
                for (int mt = 0; mt < 2; ++mt)
#pragma unroll
                    for (int ks = 0; ks < 4; ++ks) { qg[mt][ks] = F[(0 * 8 + mt * 4 + ks) * 64]; kT[mt][ks] = F[(1 * 8 + mt * 4 + ks) * 64]; Am[mt][ks] = F[(2 * 8 + mt * 4 + ks) * 64]; }
#pragma unroll
                for (int ks = 0; ks < 4; ++ks) vb[ks] = F[(3 * 8 + nt * 4 + ks) * 64];
                const float gend = GEND[(b * 32 + n) * 16 + hd];
                const bf16x8 sb00 = PACK_ACC(S0, 0), sb01 = PACK_ACC(S0, 1), sb10 = PACK_ACC(S1, 0), sb11 = PACK_ACC(S1, 1);
                f32x16 O0, O1;
#pragma unroll
                for (int i = 0; i < 16; ++i) { O0[i] = 0.f; O1[i] = 0.f; }
                O0 = MFMA32(qg[0][0], sb00, O0); O0 = MFMA32(qg[0][1], sb01, O0); O0 = MFMA32(qg[0][2], sb10, O0); O0 = MFMA32(qg[0][3], sb11, O0);
                O1 = MFMA32(qg[1][0], sb00, O1); O1 = MFMA32(qg[1][1], sb01, O1); O1 = MFMA32(qg[1][2], sb10, O1); O1 = MFMA32(qg[1][3], sb11, O1);
                O0 = MFMA32(Am[0][0], vb[0], O0); O0 = MFMA32(Am[0][1], vb[1], O0);
#pragma unroll
                for (int ks = 0; ks < 4; ++ks) O1 = MFMA32(Am[1][ks], vb[ks], O1);
#pragma unroll
                for (int i = 0; i < 16; ++i) { S0[i] *= gend; S1[i] *= gend; }
#pragma unroll
                for (int ks = 0; ks < 4; ++ks) { S0 = MFMA32(kT[0][ks], vb[ks], S0); S1 = MFMA32(kT[1][ks], vb[ks], S1); }
                float* yo = YS + (size_t)(b * 2048 + n * 64) * 1024 + hd * 64 + 32 * nt + r;
#pragma unroll
                for (int i = 0; i < 16; ++i) { yo[(size_t)crow(i, hp) * 1024] = O0[i]; yo[(size_t)(32 + crow(i, hp)) * 1024] = O1[i]; }
            }
            float* dst = kp.out() + O_SSD_P + ((size_t)j * 4 + b) * ((size_t)16 * 64 * 64) + (size_t)hd * 64 * 64 + 32 * nt + r;
#pragma unroll
            for (int i = 0; i < 16; ++i) { dst[(size_t)crow(i, hp) * 64] = S0[i]; dst[(size_t)(32 + crow(i, hp)) * 64] = S1[i]; }
        } else if (kind == 0) {
            const int p = tid & 63, ng = tid >> 6, grp = h >> 2;
            const size_t SZ = (size_t)16 * 64 * 64;
            float S[8];
            if (s < 4) {
#pragma unroll
                for (int i = 0; i < 8; ++i) S[i] = 0.f;
            } else { const float* st = kp.in(5) + ((size_t)j * 128 + (s - 4)) * SZ + (size_t)h * 64 * 64;
#pragma unroll
                for (int i = 0; i < 8; ++i) S[i] = st[(size_t)(ng * 8 + i) * 64 + p]; }
            const float negA = -expf(kp.in(25)[j * 16 + h]);
            for (int t = 0; t < L; ++t) {
                const size_t r = (size_t)(row0 + t);
                if (tid < 64) bL[tid] = XBC[r * 1536 + 1024 + grp * 64 + tid]; else if (tid < 128) cL[tid - 64] = XBC[r * 1536 + 1280 + grp * 64 + (tid - 64)];
                const float xp = XBC[r * 1536 + h * 64 + p], dt = DT[r * 16 + h], a = expf(negA * dt), xdt = xp * dt;
                __syncthreads();
                float part = 0.f;
#pragma unroll
                for (int i = 0; i < 8; ++i) { const int n = ng * 8 + i; S[i] = a * S[i] + bL[n] * xdt; part += cL[n] * S[i]; }
                red[ng * 64 + p] = part;
                __syncthreads();
                if (ng == 0) { float y = 0.f;
#pragma unroll
                    for (int g = 0; g < 8; ++g) y += red[g * 64 + p];
                    YS[r * 1024 + h * 64 + p] = y; }
            }
            float* dst = s < 4 ? kp.out() + O_SSD_P + ((size_t)j * 4 + s) * SZ + (size_t)h * 64 * 64 : kp.out() + O_SSD_S + ((size_t)j * 128 + (s - 4)) * SZ + (size_t)h * 64 * 64;
#pragma unroll
            for (int i = 0; i < 8; ++i) dst[(size_t)(ng * 8 + i) * 64 + p] = S[i];
        } else {
            const int ch = h * 512 + tid;
            float hh = s < 4 ? 0.f : kp.in(7)[((size_t)j * 128 + (s - 4)) * 1024 + ch];
#pragma unroll 8
            for (int t = 0; t < L; ++t) { const size_t r = (size_t)(row0 + t); hh = LA[r * 1024 + ch] * hh + LB[r * 1024 + ch]; HS[r * 1024 + ch] = hh; }
            float* dst = s < 4 ? kp.out() + O_LRU_P + ((size_t)j * 4 + s) * 1024 : kp.out() + O_LRU_S + ((size_t)j * 128 + (s - 4)) * 1024;
            dst[ch] = hh;
        }
    }
}

__device__ __forceinline__ void phase_cd_post(const KP kp, const int bid, const int G, int j, int tid, int wave, int lane) {
    unsigned char* scr = kp.ws() + WS_SCR; const bf16* U = (const bf16*)(kp.ws() + WS_U); bf16* YM = (bf16*)(kp.ws() + WS_YM);
    const float* YS = (const float*)(scr + SC_YS); const float* HS = (const float*)(scr + SC_HS); const bf16* XS = (const bf16*)(scr + SC_XS);
    const float* sn = kp.in(28) + (size_t)j * 1024;
    for (int r = bid; r < T; r += G) {
        int s, t; row_to_seq(r, s, t); int row0, L; seq_info(s, row0, L);
        if (wave < 4) { float y[4]; float ss = 0.f;
#pragma unroll
            for (int i = 0; i < 4; ++i) { const int e = wave * 256 + lane + 64 * i; y[i] = (YS[(size_t)r * 1024 + e] + kp.in(27)[j * 16 + (e >> 6)] * bf2f(XS[(size_t)r * 1024 + e])) * silu_(bf2f(U[(size_t)r * NCD + e])); ss += y[i] * y[i]; }
            const float rstd = rsqrtf(wave_sum(ss) * (1.f / 256.f) + 1e-6f);
#pragma unroll
            for (int i = 0; i < 4; ++i) { const int e = wave * 256 + lane + 64 * i; YM[(size_t)r * DM + e] = (bf16)f2bf(y[i] * rstd * sn[e]); }
        } else {
#pragma unroll
            for (int i = 0; i < 4; ++i) { const int ch = (wave - 4) * 256 + lane + 64 * i;
                YM[(size_t)r * DM + 1024 + ch] = (bf16)f2bf(HS[(size_t)r * 1024 + ch] * silu_(bf2f(U[(size_t)r * NCD + 2560 + ch]))); }
        }
        if (t >= L - 3) { const int rr = t - (L - 3);
            float* d1 = s < 4 ? kp.out() + O_SSDC_P + (((size_t)j * 4 + s) * 3 + rr) * 1536 : kp.out() + O_SSDC_S + (((size_t)j * 128 + (s - 4)) * 3 + rr) * 1536;
            for (int c = tid; c < 1536; c += NTHR) d1[c] = bf2f(U[(size_t)r * NCD + 1024 + c]);
            float* d2 = s < 4 ? kp.out() + O_LRUC_P + (((size_t)j * 4 + s) * 3 + rr) * 1024 : kp.out() + O_LRUC_S + (((size_t)j * 128 + (s - 4)) * 3 + rr) * 1024;
            for (int c = tid; c < 1024; c += NTHR) d2[c] = bf2f(U[(size_t)r * NCD + 3584 + c]); }
    }
}

__global__ void __launch_bounds__(NTHR, 2) mega_fwd(Args A) {
    extern __shared__ __attribute__((aligned(16))) unsigned char lds_raw[];
    LAS unsigned char* lds = (LAS unsigned char*)lds_raw;
    const int G = gridDim.x;
    volatile LAS unsigned* bst = (volatile LAS unsigned*)(lds + LDS_BYTES - 16);
    if (threadIdx.x == 0) { bst[0] = 0u; bst[1] = 0u; }
    __syncthreads();
    XcdBarrier xbar = xcd_barrier_post((unsigned*)(A.ws + WS_CTL) + CW_BAR, bst);
#ifdef PROBE_GROUP
    unsigned long long t_prev = __builtin_amdgcn_s_memrealtime(), t_sel = 0;
#endif
    for (int ph = A.ph_lo; ph < A.ph_hi; ++ph) {
        KP kp; kp.p = (const char AS4*)__builtin_amdgcn_kernarg_segment_ptr(); asm volatile("" : "+s"(kp.p));
        unsigned char* ws = kp.ws();
        int tid = threadIdx.x; asm volatile("" : "+v"(tid));
        int bid = blockIdx.x; asm volatile("" : "+s"(bid));
        const int lane = tid & 63, wave = __builtin_amdgcn_readfirstlane(tid >> 6), gw = bid * NWAVES + wave, NGW = G * NWAVES;
        if (ph == 0) { if (PH_MASK & 1) phase_prologue(kp, lds, gw, NGW, wave, lane); }
        else {
            const int li = (ph - 1) / SUBS, sub = (ph - 1) % SUBS, j = li >> 1; const bool ab = (li & 1) == 0;
            if (sub == 0) {
                const int N = ab ? NAB : NCD;
                const bf16* Bt = ab ? (const bf16*)(ws + WS_WABIN) + (size_t)j * NAB * 2048 : (const bf16*)(ws + WS_WCDIN) + (size_t)j * NCD * 2048;
                pg8::Gemm g{(const bf16*)(ws + WS_XN), Bt, T, N, 2048}; pg8::StaticOrder S; S.init(T, N, G, bid);
                pg8::EpiBf16 E{(bf16*)(ws + WS_U), N};
                if (PH_MASK & 2) pg8::gemm_phase<pg8::EpiBf16, pg8::StaticOrder, true, true>(lds, g, S, E, tid);
            } else if (sub == 5 || sub == 7 || sub == 8) {
                const bf16* Am; const bf16* Bt; int K = 2048; float* C = (float*)(ws + WS_SCR + SC_C);
                if (sub == 5) { Am = (const bf16*)(ws + WS_YM); Bt = ab ? (const bf16*)(ws + WS_WABOUT) + (size_t)j * 2048 * 2048 : (const bf16*)(ws + WS_WCDOUT) + (size_t)j * 2048 * 2048; }
                else if (sub == 7) { Am = (const bf16*)(ws + WS_XN); Bt = (const bf16*)(ws + WS_WGATE) + (size_t)li * 2048 * 2048; }
                else { Am = (const bf16*)(ws + WS_PB) + (size_t)li * T * 256; Bt = (const bf16*)(ws + WS_WPROJ) + (size_t)li * 2048 * 256; K = 256; C = (float*)(ws + WS_SCR + SC_C2); }
                pg8::Gemm g{Am, Bt, T, 2048, K}; pg8::StaticOrder S; S.init(T, 2048, G, bid);
                pg8::EpiF32 E{C, 2048};
                if (PH_MASK & 4) pg8::gemm_phase<pg8::EpiF32, pg8::StaticOrder, true, true>(lds, g, S, E, tid);
            } else if (sub == 1) { if (ab) { if (PH_MASK & 8) phase_ab_pre(kp, bid, G, j, tid, wave, lane); } else { if (PH_MASK & 16) phase_cd_pre(kp, bid, G, j, lds, tid); } }
            else if (sub == 2) { if (!ab) { if (PH_MASK & 2048) { phase_ssd_prep(kp, bid, G, j, lds, tid); phase_lru_gates(kp, bid, G, j, lds, tid); } } else { if (PH_MASK & 4096) phase_gla_prep(kp, bid, G, j, lds, tid); if (PH_MASK & 8192) phase_dn_prep(kp, bid, G, j, lds, tid); } }
            else if (sub == 3) { if (ab) { if (PH_MASK & 32) phase_ab_rec(kp, bid, G, j, lds, tid); } else { if (PH_MASK & 64) phase_cd_rec(kp, bid, G, j, lds, tid); } }
            else if (sub == 4) { if (ab) { if (PH_MASK & 128) phase_ab_post(kp, bid, G, j, tid, wave, lane); } else { if (PH_MASK & 256) phase_cd_post(kp, bid, G, j, tid, wave, lane); } }
            else if (sub == 6) { if (PH_MASK & 512) phase_res1(kp, li, gw, NGW, lane); }
            else { if (PH_MASK & 1024) phase_res2(kp, li, gw, NGW, lane); }
        }
        if (ph + 1 < A.ph_hi) { if (ph == A.ph_lo) cg::this_grid().sync(); else xcd_barrier(xbar); }
#ifdef PROBE_GROUP
        { const unsigned long long t_now = __builtin_amdgcn_s_memrealtime(); const int li_ = (ph - 1) / SUBS, sub_ = (ph - 1) % SUBS; const bool ab_ = (li_ & 1) == 0;
          int grp = 9; if (ph > 0) { if (sub_ == 0 || sub_ == 5 || sub_ == 7 || sub_ == 8) grp = 1; else if (sub_ == 1) grp = ab_ ? 2 : 3; else if (sub_ == 2) grp = ab_ ? 4 : 5; else if (sub_ == 3) grp = ab_ ? 6 : 7; else grp = 8; }
          if (grp == PROBE_GROUP) t_sel += t_now - t_prev; t_prev = t_now; }
#endif
    }
#ifdef PROBE_GROUP
    if (blockIdx.x == 0 && threadIdx.x == 0) { const unsigned long long t0 = __builtin_amdgcn_s_memrealtime(); while (__builtin_amdgcn_s_memrealtime() - t0 < 3 * t_sel) __builtin_amdgcn_s_sleep(8); }
#endif
}

extern "C" void kernel_launch(void* const* d_in, const int* in_sizes, int n_in, void* d_out, int out_size, void* d_ws, size_t ws_size, hipStream_t stream) {
    static int grid = 0;
    if (grid == 0) {
        if (n_in != 40 || (size_t)out_size != O_END || ws_size < WS_END) { fprintf(stderr, "kernel_launch: unexpected shapes: n_in %d out %d ws %zu\n", n_in, out_size, ws_size); grid = -1; return; }
        int dev = 0, cus = 0, per_cu = 0;
        if (hipGetDevice(&dev) != hipSuccess || hipDeviceGetAttribute(&cus, hipDeviceAttributeMultiprocessorCount, dev) != hipSuccess) { grid = -1; return; }
        if (hipFuncSetAttribute((const void*)mega_fwd, hipFuncAttributeMaxDynamicSharedMemorySize, LDS_BYTES) != hipSuccess) { fprintf(stderr, "kernel_launch: hipFuncSetAttribute failed\n"); grid = -1; return; }
        if (hipOccupancyMaxActiveBlocksPerMultiprocessor(&per_cu, (const void*)mega_fwd, NTHR, LDS_BYTES) != hipSuccess || per_cu < 1) { fprintf(stderr, "kernel_launch: occupancy query says %d\n", per_cu); per_cu = 1; }
        (void)hipGetLastError();
        grid = cus;
    }
    if (grid < 0) return;
    if (hipMemsetAsync((char*)d_ws + WS_CTL, 0, CTL_ZERO_BYTES, stream) != hipSuccess) { fprintf(stderr, "kernel_launch: memset of the control words failed\n"); return; }
    Args a{};
    for (int i = 0; i < 40; ++i) a.in[i] = (const float*)d_in[i];
    a.out = (float*)d_out; a.ws = (unsigned char*)d_ws;
#if MK_N_LAUNCHES == 1
    a.ph_lo = 0; a.ph_hi = N_PHASES;
    void* args[] = {&a};
    hipError_t e = hipLaunchCooperativeKernel((const void*)mega_fwd, dim3(grid), dim3(NTHR), args, LDS_BYTES, stream);
    if (e != hipSuccess) fprintf(stderr, "cooperative launch failed: %s (grid %d)\n", hipGetErrorString(e), grid);
#else
    for (int ph = 0; ph < N_PHASES; ++ph) { a.ph_lo = ph; a.ph_hi = ph + 1; mega_fwd<<<dim3(grid), dim3(NTHR), LDS_BYTES, stream>>>(a); }
#endif
}
```

```cpp
#include <hip/hip_runtime.h>
#include <hip/hip_cooperative_groups.h>
#include <cstdio>
#include <cstdint>
namespace cg = cooperative_groups;

#ifndef MK_N_LAUNCHES
#define MK_N_LAUNCHES 1
#endif

namespace pg8 {
#define PG8_LAS __attribute__((address_space(3)))
typedef unsigned short bf16_t;
typedef short bf16x8 __attribute__((ext_vector_type(8)));
typedef float f32x4 __attribute__((ext_vector_type(4)));
typedef unsigned u32x4 __attribute__((ext_vector_type(4)));
constexpr int BM = 256, BK = 64, HALF = 128, HTB = HALF * BK * 2  , STAGE_BYTES = 8 * HTB, NXCD = 8, WGM = 8;

__host__ __device__ __forceinline__ int lds_byte(int r, int c) { const int st = (r >> 4) * 2 + (c >> 5), rr = r & 15, cc = c & 31, ob = rr * 64 + cc * 2; return st * 1024 + (ob ^ (((ob >> 9) & 1) << 5)); }
__host__ __device__ __forceinline__ void stage_rc(int b, int& R, int& C) { const int st = b / 1024, sb = b % 1024, swz = sb ^ (((sb >> 9) & 1) << 5); R = (st >> 1) * 16 + swz / 64; C = (st & 1) * 32 + (swz % 64) / 2; }
__host__ __device__ __forceinline__ int perm32(int rho) { const int n = rho >> 4, i = rho & 15; return 8 * (i >> 2) + 4 * n + (i & 3); }

struct Unit { int pm, pn; };
struct Gemm { const bf16_t* A; const bf16_t* Bt; int M, N, K; };

struct StaticOrder {
    int nM, nN, nwg, G, c;
    __host__ __device__ void init(int M, int N, int G_, int c_) { nM = M / BM; nN = N / BM; nwg = nM * nN; G = G_; c = c_; }
    __host__ __device__ bool next(int i, Unit& u) const {
        const long L = (long)i * G + c; if (L >= nwg) return false;
        int wgid = (int)L; { const int q = nwg / NXCD, r = nwg % NXCD, xcd = wgid % NXCD, off = wgid / NXCD; wgid = (xcd < r ? xcd * (q + 1) : r * (q + 1) + (xcd - r) * q) + off; }
        const int nig = WGM * nN, gid = wgid / nig, fm = gid * WGM, gsz = (nM - fm) < WGM ? (nM - fm) : WGM;
        u.pm = fm + ((wgid % nig) % gsz); u.pn = (wgid % nig) / gsz; return true;
    }
    __device__ __forceinline__ void a_ready(const Unit&) const {}
    __device__ __forceinline__ void done(const Unit&) const {}
};

__device__ __forceinline__ unsigned cvt_pk_bf16(float lo, float hi) { unsigned r; asm volatile("v_cvt_pk_bf16_f32 %0, %1, %2" : "=v"(r) : "v"(lo), "v"(hi)); return r; }
struct EpiF32 {
    static constexpr bool PERM = false, AFTER_DRAIN = false;
    float* C; int ldc;
    __device__ __forceinline__ void operator()(const f32x4 (&acc)[2][2][4][2], const Unit& u, int wr, int wc, int fr, int fq) const {
        const int row0 = u.pm * BM + wr * 64 + fr, col0 = u.pn * BM + wc * 32 + 4 * fq;
#pragma unroll
        for (int ai = 0; ai < 2; ++ai)
#pragma unroll
            for (int m = 0; m < 4; ++m) { float* rowp = C + (size_t)(row0 + ai * HALF + m * 16) * ldc + col0;
#pragma unroll
                for (int bj = 0; bj < 2; ++bj)
#pragma unroll
                    for (int n = 0; n < 2; ++n) *(f32x4*)(rowp + bj * HALF + n * 16) = acc[ai][bj][m][n]; }
    }
};
struct EpiBf16 {
    static constexpr bool PERM = true, AFTER_DRAIN = false;
    bf16_t* O; int ldc;
    __device__ __forceinline__ void operator()(const f32x4 (&acc)[2][2][4][2], const Unit& u, int wr, int wc, int fr, int fq) const {
        const int row0 = u.pm * BM + wr * 64 + fr; const int col0 = u.pn * BM + wc * 32 + 8 * fq;
#pragma unroll
        for (int ai = 0; ai < 2; ++ai)
#pragma unroll
            for (int m = 0; m < 4; ++m) { bf16_t* rowp = O + (size_t)(row0 + ai * HALF + m * 16) * ldc + col0;
#pragma unroll
                for (int bj = 0; bj < 2; ++bj) { const f32x4 v0 = acc[ai][bj][m][0], v1 = acc[ai][bj][m][1];
                    u32x4 w; w.x = cvt_pk_bf16(v0[0], v0[1]); w.y = cvt_pk_bf16(v0[2], v0[3]); w.z = cvt_pk_bf16(v1[0], v1[1]); w.w = cvt_pk_bf16(v1[2], v1[3]);
                    *(u32x4*)(rowp + bj * HALF) = w; } }
    }
};

struct EpiU {
    static constexpr bool PERM = true, AFTER_DRAIN = false;
    bf16_t* O; int ldc; const float* rss;
    __device__ __forceinline__ void operator()(const f32x4 (&acc)[2][2][4][2], const Unit& u, int wr, int wc, int fr, int fq) const {
        const int row0 = u.pm * BM + wr * 64 + fr; const int col0 = u.pn * BM + wc * 32 + 8 * fq;
#pragma unroll
        for (int ai = 0; ai < 2; ++ai)
#pragma unroll
            for (int m = 0; m < 4; ++m) { const int row = row0 + ai * HALF + m * 16; const float sc = rss ? rsqrtf(rss[row] * (1.f / 2048.f) + 1e-6f) : 1.f;
                bf16_t* rowp = O + (size_t)row * ldc + col0;
#pragma unroll
                for (int bj = 0; bj < 2; ++bj) { const f32x4 v0 = acc[ai][bj][m][0] * sc, v1 = acc[ai][bj][m][1] * sc;
                    u32x4 w; w.x = cvt_pk_bf16(v0[0], v0[1]); w.y = cvt_pk_bf16(v0[2], v0[3]); w.z = cvt_pk_bf16(v1[0], v1[1]); w.w = cvt_pk_bf16(v1[2], v1[3]);
                    *(u32x4*)(rowp + bj * HALF) = w; } }
    }
};
typedef unsigned u32x2e __attribute__((ext_vector_type(2)));
template <bool GATE> struct EpiRes {
    static constexpr bool PERM = false, AFTER_DRAIN = false;
    const bf16_t* Hin; bf16_t* Hout; float* rss_out; const bf16_t* PP; const float* rss_in;
    __device__ __forceinline__ void operator()(const f32x4 (&acc)[2][2][4][2], const Unit& u, int wr, int wc, int fr, int fq) const {
        const int row0 = u.pm * BM + wr * 64 + fr, col0 = u.pn * BM + wc * 32 + 4 * fq;
#pragma unroll
        for (int ai = 0; ai < 2; ++ai)
#pragma unroll
            for (int m = 0; m < 4; ++m) { const int row = row0 + ai * HALF + m * 16; const size_t ro = (size_t)row * 2048 + col0;
                float sc = 1.f; if (GATE) sc = rsqrtf(rss_in[row] * (1.f / 2048.f) + 1e-6f);
                float s = 0.f;
#pragma unroll
                for (int bj = 0; bj < 2; ++bj)
#pragma unroll
                    for (int n = 0; n < 2; ++n) { const size_t p = ro + bj * HALF + n * 16; const u32x2e hw = *(const u32x2e*)(Hin + p); const f32x4 a = acc[ai][bj][m][n];
                        f32x4 h; h[0] = __uint_as_float(hw.x << 16); h[1] = __uint_as_float(hw.x & 0xffff0000u); h[2] = __uint_as_float(hw.y << 16); h[3] = __uint_as_float(hw.y & 0xffff0000u);
                        if (GATE) { const u32x2e pw = *(const u32x2e*)(PP + p);
                            h[0] += __builtin_amdgcn_rcpf(1.f + __expf(-sc * a[0])) * __uint_as_float(pw.x << 16); h[1] += __builtin_amdgcn_rcpf(1.f + __expf(-sc * a[1])) * __uint_as_float(pw.x & 0xffff0000u);
                            h[2] += __builtin_amdgcn_rcpf(1.f + __expf(-sc * a[2])) * __uint_as_float(pw.y << 16); h[3] += __builtin_amdgcn_rcpf(1.f + __expf(-sc * a[3])) * __uint_as_float(pw.y & 0xffff0000u); }
                        else h = h + a;
                        s += (h[0] * h[0] + h[1] * h[1]) + (h[2] * h[2] + h[3] * h[3]);
                        u32x2e o; o.x = cvt_pk_bf16(h[0], h[1]); o.y = cvt_pk_bf16(h[2], h[3]); *(u32x2e*)(Hout + p) = o; }
                s += __shfl_xor(s, 16); s += __shfl_xor(s, 32);
                if (fq == 0) atomicAdd(rss_out + row, s);
                asm volatile("" ::: "memory"); }
    }
};
template <class Epi, class Sched, bool ALIGN_EPI = false, bool SP2 = false>
__device__ __forceinline__ void gemm_phase(PG8_LAS unsigned char* lds, const Gemm g, const Sched& S, const Epi& E, const int tid) {
    const int wid = __builtin_amdgcn_readfirstlane(tid >> 6), lane = tid & 63, wr = wid >> 2, wc = wid & 3, fr = lane & 15, fq = lane >> 4;
    const int K = g.K, nt = K / BK;
    unsigned voffA[2], voffB[2];
#pragma unroll
    for (int i = 0; i < 2; ++i) { int R, C; stage_rc(tid * 16 + i * 8192, R, C); const int Rb = Epi::PERM ? ((R & ~31) + perm32(R & 31)) : R;
        voffA[i] = (unsigned)(R * K + C) * 2u; voffB[i] = (unsigned)(Rb * K + C) * 2u; }
    const size_t kstep = (size_t)(BK * 2);
    const size_t hstep = (size_t)HALF * K * 2;
    const size_t tstep = 2 * hstep;
    const unsigned ldsw = (unsigned)wid * 1024u;
    const int aoff = lds_byte(wr * 64 + fr, fq * 8), boff = lds_byte(wc * 32 + fr, fq * 8);
#define PG8_SA(b, h) (((b) * 2 + (h)) * HTB)
#define PG8_SB(b, h) ((4 + (b) * 2 + (h)) * HTB)
#define PG8_STAGE(bufoff, gbase, voff) do { _Pragma("unroll") for (int _i = 0; _i < 2; ++_i) \
        __builtin_amdgcn_global_load_lds((const unsigned*)((const char*)(gbase) + (voff)[_i]), (PG8_LAS unsigned*)(lds + (bufoff) + ldsw + _i * 8192), 16, 0, 0); } while (0)
#define PG8_LDA(dst, b, h) do { _Pragma("unroll") for (int m = 0; m < 4; ++m) _Pragma("unroll") for (int k = 0; k < 2; ++k) dst[m][k] = *(const PG8_LAS bf16x8*)(lds + PG8_SA(b, h) + aoff + m * 2048 + k * 1024); } while (0)
#define PG8_LDB(dst, b, h) do { _Pragma("unroll") for (int n = 0; n < 2; ++n) _Pragma("unroll") for (int k = 0; k < 2; ++k) dst[n][k] = *(const PG8_LAS bf16x8*)(lds + PG8_SB(b, h) + boff + n * 2048 + k * 1024); } while (0)
#define PG8_MMA(ai, bj, At, Bt) do { __builtin_amdgcn_s_setprio(1); _Pragma("unroll") for (int m = 0; m < 4; ++m) _Pragma("unroll") for (int n = 0; n < 2; ++n) _Pragma("unroll") for (int k = 0; k < 2; ++k) \
        acc[ai][bj][m][n] = __builtin_amdgcn_mfma_f32_16x16x32_bf16(Bt[n][k], At[m][k], acc[ai][bj][m][n], 0, 0, 0); __builtin_amdgcn_s_setprio(0); } while (0)
#define PG8_WAIT_V(n) asm volatile("s_waitcnt vmcnt(" #n ")" ::: "memory")
#define PG8_WAIT_L(n) asm volatile("s_waitcnt lgkmcnt(" #n ")" ::: "memory")
#define PG8_BAR __builtin_amdgcn_s_barrier()
#define PG8_SCHED __builtin_amdgcn_sched_barrier(0)
    Unit cur, nxt; int ui = 0;
    if (!S.next(0, cur)) return;
    f32x4 acc[2][2][4][2];
#pragma unroll
    for (int a = 0; a < 2; ++a)
#pragma unroll
        for (int b = 0; b < 2; ++b)
#pragma unroll
            for (int m = 0; m < 4; ++m)
#pragma unroll
                for (int n = 0; n < 2; ++n) acc[a][b][m][n] = (f32x4){0.f, 0.f, 0.f, 0.f};
    bf16x8 At[4][2], B0[2][2], B1[2][2];
    const char* cA = (const char*)g.A + (size_t)cur.pm * tstep; const char* cB = (const char*)g.Bt + (size_t)cur.pn * tstep;
    S.a_ready(cur);
    if constexpr (SP2) {
        PG8_STAGE(PG8_SB(0, 0), cB, voffB); PG8_STAGE(PG8_SB(0, 1), cB + hstep, voffB); PG8_STAGE(PG8_SA(0, 0), cA, voffA); PG8_STAGE(PG8_SA(0, 1), cA + hstep, voffA);
        if (wr == 1) PG8_BAR;
        PG8_WAIT_V(2); PG8_BAR;
        PG8_STAGE(PG8_SB(1, 0), cB + kstep, voffB); PG8_STAGE(PG8_SA(1, 0), cA + kstep, voffA); PG8_STAGE(PG8_SB(1, 1), cB + hstep + kstep, voffB);
        PG8_WAIT_V(6); PG8_BAR;
    } else {
        PG8_STAGE(PG8_SB(0, 0), cB, voffB); PG8_STAGE(PG8_SA(0, 0), cA, voffA); PG8_STAGE(PG8_SB(0, 1), cB + hstep, voffB); PG8_STAGE(PG8_SA(0, 1), cA + hstep, voffA);
        if (wr == 1) PG8_BAR;
        PG8_WAIT_V(4); PG8_BAR;
        PG8_STAGE(PG8_SB(1, 0), cB + kstep, voffB); PG8_STAGE(PG8_SA(1, 0), cA + kstep, voffA); PG8_STAGE(PG8_SB(1, 1), cB + hstep + kstep, voffB);
        PG8_WAIT_V(6); PG8_BAR;
    }
    for (;;) {
        const bool has_next = S.next(ui + 1, nxt);
        const char* nA = has_next ? (const char*)g.A + (size_t)nxt.pm * tstep : cA; const char* nB = has_next ? (const char*)g.Bt + (size_t)nxt.pn * tstep : cB;
        for (int t = 0; t < nt; t += 2) {
            const bool last = (t == nt - 2);
            const char* a1 = cA + (size_t)(t + 1) * kstep;
            const char* a2 = last ? nA : cA + (size_t)(t + 2) * kstep; const char* b2 = last ? nB : cB + (size_t)(t + 2) * kstep;
            const char* a3 = a2 + kstep; const char* b3 = b2 + kstep;
            if (last && has_next) S.a_ready(nxt);
            if constexpr (SP2) {
            PG8_LDB(B0, 0, 0); PG8_LDB(B1, 0, 1); PG8_SCHED; PG8_LDA(At, 0, 0); PG8_STAGE(PG8_SA(1, 1), a1 + hstep, voffA);
            PG8_WAIT_V(8); PG8_WAIT_L(0); PG8_BAR; PG8_MMA(0, 0, At, B0); PG8_MMA(0, 1, At, B1); PG8_BAR; PG8_SCHED;
            PG8_LDA(At, 0, 1); PG8_STAGE(PG8_SB(0, 0), b2, voffB); PG8_STAGE(PG8_SB(0, 1), b2 + hstep, voffB); PG8_STAGE(PG8_SA(0, 0), a2, voffA);
            PG8_WAIT_V(8); PG8_WAIT_L(0); PG8_BAR; PG8_MMA(1, 0, At, B0); PG8_MMA(1, 1, At, B1); PG8_BAR; PG8_SCHED;
            PG8_LDB(B0, 1, 0); PG8_LDB(B1, 1, 1); PG8_SCHED; PG8_LDA(At, 1, 0); PG8_STAGE(PG8_SA(0, 1), a2 + hstep, voffA);
            PG8_WAIT_V(8); PG8_WAIT_L(0); PG8_BAR; PG8_MMA(0, 0, At, B0); PG8_MMA(0, 1, At, B1); PG8_BAR; PG8_SCHED;
            PG8_LDA(At, 1, 1); PG8_STAGE(PG8_SB(1, 0), b3, voffB); PG8_STAGE(PG8_SB(1, 1), b3 + hstep, voffB); PG8_STAGE(PG8_SA(1, 0), a3, voffA);
            PG8_WAIT_V(8); PG8_WAIT_L(0); PG8_BAR; PG8_MMA(1, 0, At, B0); PG8_MMA(1, 1, At, B1); PG8_BAR; PG8_SCHED;
            } else {
            PG8_LDB(B0, 0, 0); PG8_SCHED; PG8_LDA(At, 0, 0); PG8_STAGE(PG8_SA(1, 1), a1 + hstep, voffA);
            PG8_WAIT_L(8); PG8_BAR; PG8_WAIT_L(0); PG8_MMA(0, 0, At, B0); PG8_BAR; PG8_SCHED;
            PG8_LDB(B1, 0, 1); PG8_STAGE(PG8_SB(0, 0), b2, voffB);
            PG8_BAR; PG8_WAIT_L(0); PG8_MMA(0, 1, At, B1); PG8_BAR;
            PG8_LDA(At, 0, 1); PG8_STAGE(PG8_SA(0, 0), a2, voffA);
            PG8_BAR; PG8_WAIT_L(0); PG8_MMA(1, 0, At, B0); PG8_BAR; PG8_SCHED;
            PG8_STAGE(PG8_SB(0, 1), b2 + hstep, voffB);
            PG8_WAIT_V(6); PG8_BAR; PG8_MMA(1, 1, At, B1); PG8_BAR;
            PG8_LDB(B0, 1, 0); PG8_SCHED; PG8_LDA(At, 1, 0); PG8_STAGE(PG8_SA(0, 1), a2 + hstep, voffA);
            PG8_WAIT_L(8); PG8_BAR; PG8_WAIT_L(0); PG8_MMA(0, 0, At, B0); PG8_BAR; PG8_SCHED;
            PG8_LDB(B1, 1, 1); PG8_STAGE(PG8_SB(1, 0), b3, voffB);
            PG8_BAR; PG8_WAIT_L(0); PG8_MMA(0, 1, At, B1); PG8_BAR;
            PG8_LDA(At, 1, 1); PG8_STAGE(PG8_SA(1, 0), a3, voffA);
            PG8_BAR; PG8_WAIT_L(0); PG8_MMA(1, 0, At, B0); PG8_BAR; PG8_SCHED;
            PG8_STAGE(PG8_SB(1, 1), b3 + hstep, voffB);
            PG8_WAIT_V(6); PG8_BAR; PG8_MMA(1, 1, At, B1); PG8_BAR;
            }
        }
        if constexpr (ALIGN_EPI) { if (wr == 0) PG8_BAR; }
        if constexpr (!Epi::AFTER_DRAIN) { E(acc, cur, wr, wc, fr, fq); S.done(cur); }
        if (!has_next) break;
#pragma unroll
        for (int a = 0; a < 2; ++a)
#pragma unroll
            for (int b = 0; b < 2; ++b)
#pragma unroll
                for (int m = 0; m < 4; ++m)
#pragma unroll
                    for (int n = 0; n < 2; ++n) acc[a][b][m][n] = (f32x4){0.f, 0.f, 0.f, 0.f};
        cur = nxt; cA = nA; cB = nB; ++ui;
        if constexpr (ALIGN_EPI) { if (wr == 1) PG8_BAR; }
    }
    PG8_WAIT_V(0);
    if constexpr (!ALIGN_EPI) { if (wr == 0) PG8_BAR; }
    PG8_BAR;
    if constexpr (Epi::AFTER_DRAIN) { E.fused(acc, cur, wr, wc, fr, fq, lds, wid, lane); S.done(cur); }
#undef PG8_SA
#undef PG8_SB
#undef PG8_STAGE
#undef PG8_LDA
#undef PG8_LDB
#undef PG8_MMA
#undef PG8_WAIT_V
#undef PG8_WAIT_L
#undef PG8_BAR
#undef PG8_SCHED
}
}

constexpr int TP = 8192, TS = 512, T = TP + TS, DM = 2048, NSEQ = 132;
constexpr int NAB = 7424, NCD = 4864;
constexpr int NWAVES = 8, NTHR = 512;
constexpr size_t MiB = 1u << 20;
constexpr size_t WS_CTL = 0, CTL_ZERO_BYTES = 1 * MiB;
constexpr int CW_BAR = 4096;
constexpr size_t WS_RSS = 65536;
constexpr size_t WS_WABIN = 2 * MiB, WS_WABOUT = 60 * MiB, WS_WCDIN = 76 * MiB, WS_WCDOUT = 114 * MiB, WS_WGATE = 130 * MiB, WS_WPROJ = 162 * MiB;
constexpr size_t WS_H = 166 * MiB, WS_XN = 234 * MiB, WS_YM = 268 * MiB, WS_PB = 302 * MiB, WS_U = 320 * MiB, WS_SCR = 444 * MiB, WS_END = 732 * MiB;
constexpr size_t SC_HB1 = 102 * MiB;
constexpr size_t SC_PP = 8 * MiB;
constexpr size_t SC_QN = 0, SC_KN = 2 * MiB, SC_VV = 4 * MiB, SC_GLOG = 6 * MiB, SC_BETA = 7 * MiB, SC_GDEC = 7 * MiB + 65536, SC_ODN = 102 * MiB, SC_OGLA = 136 * MiB,
    SC_DNOPS = 192 * MiB, SC_DNGEND = 264 * MiB;
constexpr size_t SC_XBC = 0, SC_DT = 3 * MiB, SC_LA = 52 * MiB, SC_LB = 86 * MiB, SC_YS = 120 * MiB, SC_HS = 154 * MiB, SC_SSDOP = 192 * MiB, SC_GEND = 256 * MiB, SC_XS = 270 * MiB;
constexpr int LDS_BYTES = 163840;
constexpr size_t O_Y_P = 0, O_Y_S = O_Y_P + (size_t)4 * 2048 * 2048, O_DN_P = O_Y_S + (size_t)128 * 4 * 2048,
    O_DNC_P = O_DN_P + (size_t)2 * 4 * 8 * 128 * 128, O_GLA_P = O_DNC_P + (size_t)2 * 4 * 3 * 3072, O_SSD_P = O_GLA_P + (size_t)2 * 4 * 4 * 128 * 256,
    O_SSDC_P = O_SSD_P + (size_t)2 * 4 * 16 * 64 * 64, O_LRU_P = O_SSDC_P + (size_t)2 * 4 * 3 * 1536, O_LRUC_P = O_LRU_P + (size_t)2 * 4 * 1024,
    O_DN_S = O_LRUC_P + (size_t)2 * 4 * 3 * 1024, O_DNC_S = O_DN_S + (size_t)2 * 128 * 8 * 128 * 128, O_GLA_S = O_DNC_S + (size_t)2 * 128 * 3 * 3072,
    O_SSD_S = O_GLA_S + (size_t)2 * 128 * 4 * 128 * 256, O_SSDC_S = O_SSD_S + (size_t)2 * 128 * 16 * 64 * 64, O_LRU_S = O_SSDC_S + (size_t)2 * 128 * 3 * 1536,
    O_LRUC_S = O_LRU_S + (size_t)2 * 128 * 1024, O_END = O_LRUC_S + (size_t)2 * 128 * 3 * 1024;
static_assert(O_END == 109064192, "output size");

#define LAS __attribute__((address_space(3)))
typedef unsigned short bf16;
typedef float f32x4 __attribute__((ext_vector_type(4)));
typedef unsigned u32x2 __attribute__((ext_vector_type(2)));
typedef unsigned u32x4 __attribute__((ext_vector_type(4)));
#define LDS_WAIT() asm volatile("s_waitcnt lgkmcnt(0)" ::: "memory")

__device__ __forceinline__ float bf2f(bf16 b) { return __uint_as_float(((unsigned)b) << 16); }
__device__ __forceinline__ unsigned f2bf(float f) { unsigned u = __float_as_uint(f); return (u + 0x7fffu + ((u >> 16) & 1u)) >> 16; }
__device__ __forceinline__ unsigned pk2(float lo, float hi) { return f2bf(lo) | (f2bf(hi) << 16); }
__device__ __forceinline__ float sigmoid_(float x) { return 1.f / (1.f + expf(-x)); }
__device__ __forceinline__ float silu_(float x) { return x / (1.f + expf(-x)); }
__device__ __forceinline__ float softplus_(float x) { return x > 20.f ? x : log1pf(expf(x)); }
__device__ __forceinline__ float wave_sum(float v) {
#pragma unroll
    for (int o = 1; o < 64; o <<= 1) v += __shfl_xor(v, o);
    return v;
}
__device__ __forceinline__ void row_to_seq(int r, int& s, int& t) { if (r < TP) { s = r >> 11; t = r & 2047; } else { s = 4 + ((r - TP) >> 2); t = (r - TP) & 3; } }
__device__ __forceinline__ void seq_info(int s, int& row0, int& L) { if (s < 4) { row0 = s << 11; L = 2048; } else { row0 = TP + ((s - 4) << 2); L = 4; } }
__device__ __forceinline__ float pre_val(const bf16* U, int ldu, int ucol, int row0, int tt, int s, const float* stc, int W, int c) {
    if (tt >= 0) return bf2f(U[(size_t)(row0 + tt) * ldu + ucol]);
    if (s < 4) return 0.f;
    return stc[((size_t)(s - 4) * 3 + (3 + tt)) * W + c];
}
__device__ __forceinline__ int map_col(int mapid, int n) {
    if (mapid == 0) return n;
    if (mapid == 1) { if (n < 3072) return n; if (n < 6144) return n + 16; if (n < 7168) return n + 32; if (n < 7184) return n - 4096; if (n < 7200) return n - 1024; return -1; }
    if (n < 2560) return n; if (n < 4608) return n + 16; if (n < 4624) return n - 2048; return -1;
}
__device__ __forceinline__ void transpose_item(const float* W, int K, int Nsrc, bf16* WT, int Npad, int mapid, const float* gain, LAS float* scr, int item, int lane) {
    const int nblk = Npad / 64, kb = item / nblk, nb = item % nblk, k0 = 64 * kb, n0 = 64 * nb;
    const int n4 = (lane & 15) * 4, src = map_col(mapid, n0 + n4);
#pragma unroll 8
    for (int i = 0; i < 16; ++i) { const int kk = 4 * i + (lane >> 4);
        f32x4 v = (f32x4){0.f, 0.f, 0.f, 0.f};
        if (src >= 0) { v = *(const f32x4*)(W + (size_t)(k0 + kk) * Nsrc + src); if (gain) v = v * gain[k0 + kk]; }
        scr[kk * 65 + n4] = v.x; scr[kk * 65 + n4 + 1] = v.y; scr[kk * 65 + n4 + 2] = v.z; scr[kk * 65 + n4 + 3] = v.w; }
    LDS_WAIT(); asm volatile("" ::: "memory");
    const int c = lane & 7;
#pragma unroll
    for (int jj = 0; jj < 8; ++jj) { const int n = (lane >> 3) + 8 * jj; const LAS float* p = scr + (8 * c) * 65 + n;
        u32x4 o; o.x = pk2(p[0 * 65], p[1 * 65]); o.y = pk2(p[2 * 65], p[3 * 65]); o.z = pk2(p[4 * 65], p[5 * 65]); o.w = pk2(p[6 * 65], p[7 * 65]);
        *(u32x4*)(WT + (size_t)(n0 + n) * K + k0 + 8 * c) = o; }
    LDS_WAIT(); asm volatile("" ::: "memory");
}
__device__ __forceinline__ void norm_row_bf16(const f32x4 (&v)[8], const float* g, bf16* orow, int lane) {
    float ss = 0.f;
#pragma unroll
    for (int j = 0; j < 8; ++j) ss += (v[j].x * v[j].x + v[j].y * v[j].y) + (v[j].z * v[j].z + v[j].w * v[j].w);
    const float rstd = rsqrtf(wave_sum(ss) * (1.f / DM) + 1e-6f);
#pragma unroll
    for (int j = 0; j < 8; ++j) { const int col = 4 * (lane + 64 * j); const f32x4 gg = *(const f32x4*)(g + col);
        u32x2 o; o.x = pk2(v[j].x * rstd * gg.x, v[j].y * rstd * gg.y); o.y = pk2(v[j].z * rstd * gg.z, v[j].w * rstd * gg.w);
        *(u32x2*)(orow + col) = o; }
}

typedef __bf16 bf16x2_t __attribute__((ext_vector_type(2)));
typedef float f32x2_t __attribute__((ext_vector_type(2)));
typedef short bf16x8 __attribute__((ext_vector_type(8)));
typedef float f32x16 __attribute__((ext_vector_type(16)));
__device__ __forceinline__ unsigned cvtpk(float lo, float hi) { f32x2_t v = {lo, hi}; bf16x2_t b = __builtin_convertvector(v, bf16x2_t); return __builtin_bit_cast(unsigned, b); }
#define MFMA32(a, b, c) __builtin_amdgcn_mfma_f32_32x32x16_bf16((a), (b), (c), 0, 0, 0)
#define PACK_ACC(x, S_) __builtin_bit_cast(bf16x8, (u32x4){cvtpk((x)[8 * (S_)], (x)[8 * (S_) + 1]), cvtpk((x)[8 * (S_) + 2], (x)[8 * (S_) + 3]), cvtpk((x)[8 * (S_) + 4], (x)[8 * (S_) + 5]), cvtpk((x)[8 * (S_) + 6], (x)[8 * (S_) + 7])})
__device__ __forceinline__ int crow(int reg, int h) { return (reg & 3) + 8 * (reg >> 2) + 4 * h; }
__device__ __forceinline__ bf16x8 pack8(const float (&v)[8]) { return __builtin_bit_cast(bf16x8, (u32x4){cvtpk(v[0], v[1]), cvtpk(v[2], v[3]), cvtpk(v[4], v[5]), cvtpk(v[6], v[7])}); }

#define XB_TMO      128
#define XB_XCNT(j)  (256  + 64 * (j))
#define XB_XSUB(j)  (1280 + 64 * (j))
#define XB_XGEN(j)  (2304 + 64 * (j))
#define XB_TOP      3328
#define XB_TOPGEN   3392
#define XCD_BAR_WORDS 3456
#define XB_SPIN_CAP (1u << 18)

__device__ __forceinline__ unsigned xb_ld(unsigned* p)              { return __hip_atomic_load(p, __ATOMIC_RELAXED, __HIP_MEMORY_SCOPE_AGENT); }
__device__ __forceinline__ unsigned xb_add(unsigned* p, unsigned v) { return __hip_atomic_fetch_add(p, v, __ATOMIC_RELAXED, __HIP_MEMORY_SCOPE_AGENT); }
__device__ __forceinline__ unsigned xb_xcc_id() { return (unsigned)__builtin_amdgcn_s_getreg((3 << 11) | 20) & 0xFu; }
#define XB_SPIN(cond, bar) do { unsigned _sp = 0; while (cond) { __builtin_amdgcn_s_sleep(1); \
    if ((++_sp & 255u) == 0u) { if (xb_ld(&(bar)[XB_TMO])) break; if (_sp > XB_SPIN_CAP) { atomicAdd(&(bar)[XB_TMO], 1u); break; } } } } while (0)

struct XcdBarrier {
    unsigned* bar; unsigned x;
    volatile LAS unsigned* st;
};

__device__ __forceinline__ XcdBarrier xcd_barrier_post(unsigned* bar, volatile LAS unsigned* st) {
    XcdBarrier b; b.bar = bar; b.x = xb_xcc_id(); b.st = st;
    if (threadIdx.x == 0) (void)xb_add(&bar[XB_XCNT(b.x)], 1u);
    return b;
}
__device__ __forceinline__ void xcd_barrier_complete(unsigned* bar, unsigned x, unsigned& nloc, unsigned& nx) {
    const unsigned G = gridDim.x * gridDim.y * gridDim.z;
    unsigned sum, cnt, mine, sp = 0u;
    for (;;) {
        sum = 0u; cnt = 0u; mine = 0u;
#pragma unroll
        for (unsigned j = 0; j < 16; ++j) { const unsigned c = xb_ld(&bar[XB_XCNT(j)]); sum += c; cnt += (c > 0u) ? 1u : 0u; mine = (j == x) ? c : mine; }
        if (sum == G) break;
        __builtin_amdgcn_s_sleep(1);
        if ((++sp & 255u) == 0u) { if (xb_ld(&bar[XB_TMO])) break; if (sp > XB_SPIN_CAP) { atomicAdd(&bar[XB_TMO], 1u); break; } }
    }
    nloc = mine > 0u ? mine : 1u; nx = cnt > 0u ? cnt : 1u;
}

__device__ __forceinline__ void xcd_barrier(const XcdBarrier& b) {
    asm volatile("s_waitcnt vmcnt(0)" ::: "memory");
    __syncthreads();
    if (threadIdx.x == 0) {
        unsigned* bar = b.bar;
        __builtin_amdgcn_s_waitcnt(0);
        unsigned nloc = b.st[0], nx = b.st[1];
        if (nloc == 0u) { xcd_barrier_complete(bar, b.x, nloc, nx); b.st[0] = nloc; b.st[1] = nx; }
        const unsigned old = xb_add(&bar[XB_XSUB(b.x)], 1u);
        const unsigned gen = old / nloc;
        if (old + 1u == (gen + 1u) * nloc) {
            __builtin_amdgcn_fence(__ATOMIC_RELEASE, "agent");
            asm volatile("s_waitcnt vmcnt(0)" ::: "memory");
            const unsigned og = xb_add(&bar[XB_TOP], 1u);
            const unsigned tg = og / nx;
            if (og + 1u == (tg + 1u) * nx) xb_add(&bar[XB_TOPGEN], 1u);
            else XB_SPIN(xb_ld(&bar[XB_TOPGEN]) == tg, bar);
            __builtin_amdgcn_fence(__ATOMIC_ACQUIRE, "agent");
            xb_add(&bar[XB_XGEN(b.x)], 1u);
            asm volatile("s_waitcnt vmcnt(0)" ::: "memory");
        } else {
            XB_SPIN(xb_ld(&bar[XB_XGEN(b.x)]) == gen, bar);
            __builtin_amdgcn_fence(__ATOMIC_ACQUIRE, "agent");
            asm volatile("s_waitcnt vmcnt(0)" ::: "memory");
        }
    }
    __syncthreads();
}


struct Args { const float* in[40]; float* out; unsigned char* ws; int ph_lo, ph_hi; };
constexpr int N_PHASES = 26, SUBS = 6;
#ifndef PH_MASK
#define PH_MASK 16383
#endif
#define AS4 __attribute__((address_space(4)))
struct KP { const char AS4* p;
    __device__ __forceinline__ const float* in(int i) const { return *(const float* const AS4*)(p + 8 * i); }
    __device__ __forceinline__ float* out() const { return *(float* const AS4*)(p + 320); }
    __device__ __forceinline__ unsigned char* ws() const { return *(unsigned char* const AS4*)(p + 328); }
};
static_assert(sizeof(Args) == 344, "Args layout");

__device__ __forceinline__ void phase_prologue(const KP kp, LAS unsigned char* lds, int gw, int NGW, int wave, int lane) {
    unsigned char* ws = kp.ws();
    LAS float* scr = (LAS float*)(lds + wave * 17408);
    for (int job = 0; job < 16; ++job) {
        const float* W; int K = 2048, Nsrc = 2048, Npad = 2048, mapid = 0; bf16* WT; const float* gain = nullptr;
        if (job < 2)       { W = kp.in(13) + (size_t)job * 2048 * 7200; Nsrc = 7200; Npad = NAB; mapid = 1; WT = (bf16*)(ws + WS_WABIN) + (size_t)job * NAB * 2048; gain = kp.in(11) + (size_t)(2 * job) * DM; }
        else if (job < 4)  { W = kp.in(21) + (size_t)(job - 2) * 2048 * 2048; WT = (bf16*)(ws + WS_WABOUT) + (size_t)(job - 2) * 2048 * 2048; }
        else if (job < 6)  { W = kp.in(22) + (size_t)(job - 4) * 2048 * 4624; Nsrc = 4624; Npad = NCD; mapid = 2; WT = (bf16*)(ws + WS_WCDIN) + (size_t)(job - 4) * NCD * 2048; gain = kp.in(11) + (size_t)(2 * (job - 4) + 1) * DM; }
        else if (job < 8)  { W = kp.in(36) + (size_t)(job - 6) * 2048 * 2048; WT = (bf16*)(ws + WS_WCDOUT) + (size_t)(job - 6) * 2048 * 2048; }
        else if (job < 12) { W = kp.in(39) + (size_t)(job - 8) * 2048 * 2048; WT = (bf16*)(ws + WS_WGATE) + (size_t)(job - 8) * 2048 * 2048; gain = kp.in(38) + (size_t)(job - 8) * DM; }
        else               { W = kp.in(37) + (size_t)(job - 12) * 256 * 2048; K = 256; WT = (bf16*)(ws + WS_WPROJ) + (size_t)(job - 12) * 2048 * 256; }
        const int nitems = (K / 64) * (Npad / 64);
        for (int it = gw; it < nitems; it += NGW) transpose_item(W, K, Nsrc, WT, Npad, mapid, gain, scr, it, lane);
    }
    bf16* HB = (bf16*)(ws + WS_XN); float* RSS = (float*)(ws + WS_RSS);
    for (int m = gw; m < T; m += NGW) {
        const float* src = m < TP ? kp.in(0) + (size_t)m * DM : kp.in(1) + (size_t)(m - TP) * DM;
        float ss = 0.f;
#pragma unroll
        for (int jj = 0; jj < 8; ++jj) { const int col = 4 * (lane + 64 * jj); const f32x4 v = *(const f32x4*)(src + col);
            u32x2 o; o.x = pk2(v.x, v.y); o.y = pk2(v.z, v.w); *(u32x2*)(HB + (size_t)m * DM + col) = o; ss += (v.x * v.x + v.y * v.y) + (v.z * v.z + v.w * v.w); }
        ss = wave_sum(ss); if (lane == 0) RSS[m] = ss;
    }
    bf16* PB = (bf16*)(ws + WS_PB);
    const int gt = gw * 64 + lane, NGT = NGW * 64;
    for (int i = gt; i < 4 * T * 64; i += NGT) {
        const int c4 = i & 63, rr = i >> 6, li = rr / T, r = rr - li * T;
        const float* src = r < TP ? kp.in(9) + ((size_t)li * TP + r) * 256 + 4 * c4 : kp.in(10) + ((size_t)li * TS + (r - TP)) * 256 + 4 * c4;
        const f32x4 v = *(const f32x4*)src;
        u32x2 o; o.x = pk2(v.x, v.y); o.y = pk2(v.z, v.w);
        *(u32x2*)(PB + ((size_t)li * T + r) * 256 + 4 * c4) = o;
    }
}
__device__ __forceinline__ void phase_final(const KP kp, int gw, int NGW, int lane) {
    const bf16* HB = (const bf16*)(kp.ws() + WS_XN); const float* RSS = (const float*)(kp.ws() + WS_RSS) + (size_t)8 * T; const float* g = kp.in(12); float* out = kp.out();
    for (int m = gw; m < T; m += NGW) { const float rstd = rsqrtf(RSS[m] * (1.f / DM) + 1e-6f);
#pragma unroll
        for (int jj = 0; jj < 8; ++jj) { const int col = 4 * (lane + 64 * jj); const u32x2 hv = *(const u32x2*)(HB + (size_t)m * DM + col); const f32x4 gg = *(const f32x4*)(g + col);
            f32x4 o; o.x = __uint_as_float(hv.x << 16) * rstd * gg.x; o.y = __uint_as_float(hv.x & 0xffff0000u) * rstd * gg.y; o.z = __uint_as_float(hv.y << 16) * rstd * gg.z; o.w = __uint_as_float(hv.y & 0xffff0000u) * rstd * gg.w;
            *(f32x4*)(out + (size_t)m * DM + col) = o; } }
}

__device__ __forceinline__ void phase_ab_pre(const KP kp, const int bid, const int G, int j, int tid, int wave, int lane) {
    unsigned char* scr = kp.ws() + WS_SCR; const bf16* U = (const bf16*)(kp.ws() + WS_U);
    float* QN = (float*)(scr + SC_QN) - (size_t)TP * 1024; float* KN = (float*)(scr + SC_KN) - (size_t)TP * 1024; float* VV = (float*)(scr + SC_VV) - (size_t)TP * 1024;
    float* GLOG = (float*)(scr + SC_GLOG) - (size_t)TP * 512; float* BETA = (float*)(scr + SC_BETA) - (size_t)TP * 8; float* GDEC = (float*)(scr + SC_GDEC) - (size_t)TP * 8;
    const float* cw = kp.in(14) + (size_t)j * 4 * 3072; const float* stc = kp.in(3) + (size_t)j * 128 * 3 * 3072;
    const float* wa2 = kp.in(18) + (size_t)j * 16 * 512; const float* ba = kp.in(19) + (size_t)j * 512;
    for (int r = TP + bid; r < T; r += G) {
        int s, t; row_to_seq(r, s, t); const int row0 = r - t;
#pragma unroll
        for (int part = 0; part < 3; ++part) {
            float val[2];
#pragma unroll
            for (int i = 0; i < 2; ++i) { const int c = part * 1024 + wave * 128 + lane + 64 * i; float acc = 0.f;
#pragma unroll
                for (int tap = 0; tap < 4; ++tap) acc += cw[tap * 3072 + c] * pre_val(U, NAB, c, row0, t - 3 + tap, s, stc, 3072, c);
                val[i] = silu_(acc); }
            if (part < 2) { const float ss = wave_sum(val[0] * val[0] + val[1] * val[1]); const float sc = rsqrtf(ss + 1e-6f) * (part == 0 ? 0.08838834764831845f : 1.f); val[0] *= sc; val[1] *= sc; }
            float* dst = part == 0 ? QN : (part == 1 ? KN : VV);
            dst[(size_t)r * 1024 + wave * 128 + lane] = val[0]; dst[(size_t)r * 1024 + wave * 128 + lane + 64] = val[1];
        }
        if (tid < 8) {
            BETA[(size_t)r * 8 + tid] = sigmoid_(bf2f(U[(size_t)r * NAB + 7168 + tid]));
            GDEC[(size_t)r * 8 + tid] = -expf(kp.in(15)[j * 8 + tid]) * softplus_(bf2f(U[(size_t)r * NAB + 7176 + tid]) + kp.in(16)[j * 8 + tid]);
        }
        { float x = ba[tid];
#pragma unroll
          for (int rr = 0; rr < 16; ++rr) x += bf2f(U[(size_t)r * NAB + 7184 + rr]) * wa2[rr * 512 + tid];
          GLOG[(size_t)r * 512 + tid] = -softplus_(-x) * (1.f / 16.f); }
    }
}


constexpr size_t GLA_ITEM_BYTES = 74752, WS_GLAOPS = WS_H;
__device__ __forceinline__ void phase_gla_prep(const KP kp, const int bid, const int G, int j, LAS unsigned char* lds, int tid) {
    const bf16* U = (const bf16*)(kp.ws() + WS_U);
    const float* wa2 = kp.in(18) + (size_t)j * 16 * 512; const float* ba = kp.in(19) + (size_t)j * 512;
    unsigned char* OPS = kp.ws() + WS_GLAOPS;
    LAS float* GL = (LAS float*)lds; LAS float* QL = GL + 64 * 129; LAS float* KL = QL + 64 * 129; LAS float* AL = KL + 64 * 129;
    const int lane = tid & 63, r = lane & 31, hp = lane >> 5;
    for (int item = bid; item < 512; item += G) {
        const int b = item >> 7, n = (item >> 2) & 31, h = item & 3;
        const int row0 = b * 2048 + n * 64;
        __syncthreads();
        for (int i = tid; i < 8192; i += NTHR) { const int t = i >> 7, d = i & 127; const size_t ro = (size_t)(row0 + t) * NAB;
            QL[t * 129 + d] = bf2f(U[ro + 4096 + h * 128 + d]) * 0.08838834764831845f; KL[t * 129 + d] = bf2f(U[ro + 4608 + h * 128 + d]);
            float x = ba[h * 128 + d];
#pragma unroll
            for (int rr = 0; rr < 16; ++rr) x += bf2f(U[ro + 7184 + rr]) * wa2[rr * 512 + h * 128 + d];
            GL[t * 129 + d] = -softplus_(-x) * (1.f / 16.f); }
        __syncthreads();
        if (tid < 128) { float acc = 0.f;
#pragma unroll 4
            for (int t = 0; t < 64; ++t) { acc += GL[t * 129 + tid]; GL[t * 129 + tid] = acc; } }
        __syncthreads();
        for (int i = tid; i < 8192; i += NTHR) { const int t = i >> 7, d = i & 127; const float gg = GL[t * 129 + d]; QL[t * 129 + d] *= expf(gg); KL[t * 129 + d] *= expf(-gg); }
        __syncthreads();
        { const int i = tid >> 3, jg = tid & 7; float acc[8];
#pragma unroll
          for (int jj = 0; jj < 8; ++jj) acc[jj] = 0.f;
#pragma unroll 4
          for (int d = 0; d < 128; ++d) { const float c = QL[i * 129 + d];
#pragma unroll
              for (int jj = 0; jj < 8; ++jj) acc[jj] += c * KL[(jg * 8 + jj) * 129 + d]; }
#pragma unroll
          for (int jj = 0; jj < 8; ++jj) AL[i * 65 + jg * 8 + jj] = (jg * 8 + jj) <= i ? acc[jj] : 0.f; }
        __syncthreads();
        bf16x8* base = (bf16x8*)(OPS + (size_t)item * GLA_ITEM_BYTES);
        float v[8];
#pragma unroll
        for (int q = 0; q < 2; ++q) { const int f = (tid >> 6) + 8 * q;
            { const int mt = f >> 3, ks = f & 7, i = 32 * mt + r;
#pragma unroll
              for (int jp = 0; jp < 8; ++jp) v[jp] = QL[i * 129 + 16 * ks + 8 * (jp >> 2) + 4 * hp + (jp & 3)];
              base[f * 64 + lane] = pack8(v); }
            { const int mt = f >> 2, ks = f & 3, d = 32 * mt + r; const float eg = expf(GL[63 * 129 + d]);
#pragma unroll
              for (int jp = 0; jp < 8; ++jp) v[jp] = KL[(16 * ks + 8 * (jp >> 2) + 4 * hp + (jp & 3)) * 129 + d] * eg;
              base[(16 + f) * 64 + lane] = pack8(v); } }
        { const int f = tid >> 6, mt = f >> 2, ks = f & 3, i = 32 * mt + r;
#pragma unroll
          for (int jp = 0; jp < 8; ++jp) v[jp] = AL[i * 65 + 16 * ks + 8 * (jp >> 2) + 4 * hp + (jp & 3)];
          base[(32 + f) * 64 + lane] = pack8(v); }
#pragma unroll
        for (int q = 0; q < 4; ++q) { const int f = (tid >> 6) + 8 * q, nt = f >> 2, ks = f & 3, p = 32 * nt + r;
            unsigned w[4];
#pragma unroll
            for (int jp = 0; jp < 8; jp += 2) { const int t0 = 16 * ks + 8 * (jp >> 2) + 4 * hp + (jp & 3);
                w[jp >> 1] = (unsigned)U[(size_t)(row0 + t0) * NAB + 5120 + h * 256 + p] | ((unsigned)U[(size_t)(row0 + t0 + 1) * NAB + 5120 + h * 256 + p] << 16); }
            base[(40 + f) * 64 + lane] = __builtin_bit_cast(bf16x8, (u32x4){w[0], w[1], w[2], w[3]}); }
        if (tid < 128) ((float*)(base + 72 * 64))[tid] = expf(GL[63 * 129 + tid]);
    }
}


constexpr size_t DN_ITEM_BYTES = 73728;
__device__ __forceinline__ void phase_dn_prep(const KP kp, const int bid, const int G, int j, LAS unsigned char* lds, int tid0) {
    unsigned char* scr = kp.ws() + WS_SCR;
    const bf16* U = (const bf16*)(kp.ws() + WS_U); const float* cw = kp.in(14) + (size_t)j * 4 * 3072;
    unsigned char* OPS = scr + SC_DNOPS; float* GENDD = (float*)(scr + SC_DNGEND);
    LAS float* AMT = (LAS float*)lds; LAS float* GLs = AMT + 64 * 68; LAS float* BLs = GLs + 64; LAS float* SCL = BLs + 64; LAS float* KL = SCL + 128; LAS float* QL = KL + 64 * 129; LAS float* XL = QL + 64 * 129;
    for (int item = bid; item < 1024; item += G) {
        int tid = tid0; asm volatile("" : "+v"(tid));
        const int lane = tid & 63, r = lane & 31, hp = lane >> 5, wave = tid >> 6;
        const int b = item >> 8, n = (item >> 3) & 31, h = item & 7;
        const int row0 = b * 2048 + n * 64;
        __syncthreads();
        { const int d = tid & 127, tg = tid >> 7, t0 = 16 * tg;
#pragma unroll
          for (int part = 0; part < 3; ++part) { const int c = part * 1024 + h * 128 + d;
              const float w0 = cw[c], w1 = cw[3072 + c], w2 = cw[2 * 3072 + c], w3 = cw[3 * 3072 + c];
              const bf16* up = U + (size_t)(row0 + t0) * NAB + c;
              const bool first = (n == 0 && tg == 0);
              float x0 = first ? 0.f : bf2f(up[-3 * (long)NAB]), x1 = first ? 0.f : bf2f(up[-2 * (long)NAB]), x2 = first ? 0.f : bf2f(up[-1 * (long)NAB]);
              LAS float* dst = part == 0 ? QL : (part == 1 ? KL : XL);
              const int dstr = part == 2 ? 257 : 129;
#pragma unroll 4
              for (int t = 0; t < 16; ++t) { const float x3 = bf2f(up[(size_t)t * NAB]); dst[(t0 + t) * dstr + d] = silu_(w0 * x0 + w1 * x1 + w2 * x2 + w3 * x3); x0 = x1; x1 = x2; x2 = x3; } } }
        if (wave == 0) { const size_t ro = (size_t)(row0 + lane) * NAB;
            float gv = -expf(kp.in(15)[j * 8 + h]) * softplus_(bf2f(U[ro + 7176 + h]) + kp.in(16)[j * 8 + h]);
#pragma unroll
            for (int o = 1; o < 64; o <<= 1) { const float tt = __shfl_up(gv, o); if (lane >= o) gv += tt; }
            GLs[lane] = gv; BLs[lane] = sigmoid_(bf2f(U[ro + 7168 + h])); }
        __syncthreads();
        if (tid < 128) { const int t = tid & 63, which = tid >> 6; const LAS float* src = which ? KL : QL; float ss = 0.f;
#pragma unroll 8
            for (int d = 0; d < 128; ++d) { const float x = src[t * 129 + d]; ss += x * x; }
            SCL[which * 64 + t] = rsqrtf(ss + 1e-6f) * (which ? 1.f : 0.08838834764831845f); }
        __syncthreads();
        { const int d = tid & 127, t0 = 16 * (tid >> 7);
#pragma unroll 4
          for (int t = 0; t < 16; ++t) { QL[(t0 + t) * 129 + d] *= SCL[t0 + t]; KL[(t0 + t) * 129 + d] *= SCL[64 + t0 + t]; } }
        __syncthreads();
        bf16x8* base = (bf16x8*)(OPS + (size_t)item * DN_ITEM_BYTES);
        { const int i = tid >> 3, ks = (tid >> 1) & 3, hk = tid & 1; float kk[8], qk[8];
#pragma unroll
          for (int jp = 0; jp < 8; ++jp) { kk[jp] = 0.f; qk[jp] = 0.f; }
#pragma unroll 2
          for (int d = 0; d < 128; ++d) { const float kc = KL[i * 129 + d], qc = QL[i * 129 + d];
#pragma unroll
              for (int jp = 0; jp < 8; ++jp) { const float kj = KL[(16 * ks + 8 * (jp >> 2) + 4 * hk + (jp & 3)) * 129 + d]; kk[jp] += kc * kj; qk[jp] += qc * kj; } }
          const float gi = GLs[i], bi = BLs[i]; float v[8];
#pragma unroll
          for (int jp = 0; jp < 8; ++jp) { const int jt = 16 * ks + 8 * (jp >> 2) + 4 * hk + (jp & 3); const float dec = expf(gi - GLs[jt]);
              AMT[jt * 68 + i] = jt < i ? bi * kk[jp] * dec : 0.f; v[jp] = jt <= i ? qk[jp] * dec : 0.f; }
          base[(48 + (i >> 5) * 4 + ks) * 64 + (i & 31) + 32 * hk] = pack8(v); }
        __syncthreads();
        if (tid < 256) {
            const int c = tid;
#pragma unroll
            for (int bi = 0; bi < 4; ++bi) {
                float acc[16];
#pragma unroll
                for (int ii = 0; ii < 16; ++ii) { const int i = 16 * bi + ii; const float be = BLs[i];
                    acc[ii] = c < 128 ? be * XL[i * 257 + c] : be * expf(GLs[i]) * KL[i * 129 + (c - 128)]; }
                for (int jj = 0; jj < 16 * bi; ++jj) { const float xj = XL[jj * 257 + c];
#pragma unroll
                    for (int q = 0; q < 4; ++q) { const f32x4 a = *(const LAS f32x4*)(AMT + jj * 68 + 16 * bi + 4 * q);
                        acc[4 * q + 0] -= a[0] * xj; acc[4 * q + 1] -= a[1] * xj; acc[4 * q + 2] -= a[2] * xj; acc[4 * q + 3] -= a[3] * xj; } }
#pragma unroll
                for (int ii = 0; ii < 16; ++ii) { float x = acc[ii];
#pragma unroll
                    for (int jj = 0; jj < ii; ++jj) x -= AMT[(16 * bi + jj) * 68 + 16 * bi + ii] * acc[jj];
                    acc[ii] = x; XL[(16 * bi + ii) * 257 + c] = x; }
            }
        }
        __syncthreads();
        float v[8];
#pragma unroll
        for (int q = 0; q < 2; ++q) { const int f = wave + 8 * q;
            { const int mt = f >> 3, ks = f & 7, i = 32 * mt + r;
#pragma unroll
              for (int jp = 0; jp < 8; ++jp) v[jp] = -XL[i * 257 + 128 + 16 * ks + 8 * (jp >> 2) + 4 * hp + (jp & 3)];
              base[f * 64 + lane] = pack8(v);
              const float eg = expf(GLs[i]);
#pragma unroll
              for (int jp = 0; jp < 8; ++jp) v[jp] = QL[i * 129 + 16 * ks + 8 * (jp >> 2) + 4 * hp + (jp & 3)] * eg;
              base[(16 + f) * 64 + lane] = pack8(v); }
            { const int mt = f >> 2, ks = f & 3, d = 32 * mt + r; const float Gend = GLs[63];
#pragma unroll
              for (int jp = 0; jp < 8; ++jp) { const int tk = 16 * ks + 8 * (jp >> 2) + 4 * hp + (jp & 3); v[jp] = KL[tk * 129 + d] * expf(Gend - GLs[tk]); }
              base[(32 + f) * 64 + lane] = pack8(v); }
            { const int pq = f & 1, tl = f >> 1, mt = tl >> 2, nt = tl & 3;
#pragma unroll
              for (int e = 0; e < 8; ++e) v[e] = XL[(32 * mt + crow(8 * pq + e, hp)) * 257 + 32 * nt + r];
              base[(56 + f) * 64 + lane] = pack8(v); } }
        if (tid == 0) GENDD[item] = expf(GLs[63]);
    }
}

__device__ __forceinline__ void phase_ab_rec(const KP kp, const int bid, const int G, int j, LAS unsigned char* lds, int tid0) {
    unsigned char* scr = kp.ws() + WS_SCR; const bf16* U = (const bf16*)(kp.ws() + WS_U);
    const float* QN = (const float*)(scr + SC_QN) - (size_t)TP * 1024; const float* KN = (const float*)(scr + SC_KN) - (size_t)TP * 1024; const float* VV = (const float*)(scr + SC_VV) - (size_t)TP * 1024;
    const float* GLOG = (const float*)(scr + SC_GLOG) - (size_t)TP * 512; const float* BETA = (const float*)(scr + SC_BETA) - (size_t)TP * 8; const float* GDEC = (const float*)(scr + SC_GDEC) - (size_t)TP * 8;
    float* ODN = (float*)(scr + SC_ODN); float* OGLA = (float*)(scr + SC_OGLA);
    LAS float* SL = (LAS float*)lds;
    for (int item = bid; item < 1600; item += G) {
        int tid = tid0; asm volatile("" : "+v"(tid));
        int s, h; bool isdn; int half = -1;
        if (item < 32) { isdn = false; s = item >> 3; h = (item >> 1) & 3; half = item & 1; }
        else if (item < 64) { isdn = true; s = (item - 32) >> 3; h = (item - 32) & 7; half = -2; }
        else if (item < 1088) { isdn = true; s = 4 + ((item - 64) >> 3); h = (item - 64) & 7; }
        else { isdn = false; s = 4 + ((item - 1088) >> 2); h = (item - 1088) & 3; }
        int row0, L; seq_info(s, row0, L);
        __syncthreads();
        if (half == -2) {
            const int wave = __builtin_amdgcn_readfirstlane(tid >> 6), lane = tid & 63, r = lane & 31, hp = lane >> 5;
            const int b = s, nt = wave;
            const unsigned char* OPS = scr + SC_DNOPS; const float* GENDD = (const float*)(scr + SC_DNGEND);
            constexpr int DBUF = 72 * 1024;
#define DN_DMA(n_, bufi_) do { const unsigned char* gi_ = OPS + (size_t)((b * 32 + (n_)) * 8 + h) * DN_ITEM_BYTES + lane * 16; \
                _Pragma("unroll") for (int q_ = 0; q_ < 9; ++q_) { const int lf_ = wave + 8 * q_; \
                    __builtin_amdgcn_global_load_lds((const unsigned*)(gi_ + lf_ * 1024), (LAS unsigned*)(lds + (bufi_) * DBUF + lf_ * 1024), 16, 0, 0); } } while (0)
            f32x16 S0, S1, S2, S3;
#pragma unroll
            for (int i = 0; i < 16; ++i) { S0[i] = 0.f; S1[i] = 0.f; S2[i] = 0.f; S3[i] = 0.f; }
            DN_DMA(0, 0);
            asm volatile("s_waitcnt vmcnt(0)" ::: "memory"); __syncthreads();
            for (int n = 0; n < 32; ++n) {
                if (n + 1 < 32) DN_DMA(n + 1, (n + 1) & 1);
                if (wave < 4) {
                    const LAS bf16x8* F = (const LAS bf16x8*)(lds + (n & 1) * DBUF) + lane;
                    const float gend = GENDD[(b * 32 + n) * 8 + h];
                    const bf16x8 sb0 = PACK_ACC(S0, 0), sb1 = PACK_ACC(S0, 1), sb2 = PACK_ACC(S1, 0), sb3 = PACK_ACC(S1, 1), sb4 = PACK_ACC(S2, 0), sb5 = PACK_ACC(S2, 1), sb6 = PACK_ACC(S3, 0), sb7 = PACK_ACC(S3, 1);
                    f32x16 U0t, U1t;
                    { const bf16x8 a0 = F[(56 + nt * 2 + 0) * 64], a1 = F[(56 + nt * 2 + 1) * 64], c0 = F[(56 + (4 + nt) * 2 + 0) * 64], c1 = F[(56 + (4 + nt) * 2 + 1) * 64];
#pragma unroll
                      for (int e = 0; e < 8; ++e) { U0t[e] = bf2f((bf16)a0[e]); U0t[8 + e] = bf2f((bf16)a1[e]); U1t[e] = bf2f((bf16)c0[e]); U1t[8 + e] = bf2f((bf16)c1[e]); } }
                    U0t = MFMA32(F[0 * 64], sb0, U0t); U0t = MFMA32(F[1 * 64], sb1, U0t); U0t = MFMA32(F[2 * 64], sb2, U0t); U0t = MFMA32(F[3 * 64], sb3, U0t);
                    U0t = MFMA32(F[4 * 64], sb4, U0t); U0t = MFMA32(F[5 * 64], sb5, U0t); U0t = MFMA32(F[6 * 64], sb6, U0t); U0t = MFMA32(F[7 * 64], sb7, U0t);
                    U1t = MFMA32(F[8 * 64], sb0, U1t); U1t = MFMA32(F[9 * 64], sb1, U1t); U1t = MFMA32(F[10 * 64], sb2, U1t); U1t = MFMA32(F[11 * 64], sb3, U1t);
                    U1t = MFMA32(F[12 * 64], sb4, U1t); U1t = MFMA32(F[13 * 64], sb5, U1t); U1t = MFMA32(F[14 * 64], sb6, U1t); U1t = MFMA32(F[15 * 64], sb7, U1t);
                    const bf16x8 ub0 = PACK_ACC(U0t, 0), ub1 = PACK_ACC(U0t, 1), ub2 = PACK_ACC(U1t, 0), ub3 = PACK_ACC(U1t, 1);
                    f32x16 O0, O1;
#pragma unroll
                    for (int i = 0; i < 16; ++i) { O0[i] = 0.f; O1[i] = 0.f; }
                    O0 = MFMA32(F[16 * 64], sb0, O0); O0 = MFMA32(F[17 * 64], sb1, O0); O0 = MFMA32(F[18 * 64], sb2, O0); O0 = MFMA32(F[19 * 64], sb3, O0);
                    O0 = MFMA32(F[20 * 64], sb4, O0); O0 = MFMA32(F[21 * 64], sb5, O0); O0 = MFMA32(F[22 * 64], sb6, O0); O0 = MFMA32(F[23 * 64], sb7, O0);
                    O1 = MFMA32(F[24 * 64], sb0, O1); O1 = MFMA32(F[25 * 64], sb1, O1); O1 = MFMA32(F[26 * 64], sb2, O1); O1 = MFMA32(F[27 * 64], sb3, O1);
                    O1 = MFMA32(F[28 * 64], sb4, O1); O1 = MFMA32(F[29 * 64], sb5, O1); O1 = MFMA32(F[30 * 64], sb6, O1); O1 = MFMA32(F[31 * 64], sb7, O1);
                    O0 = MFMA32(F[48 * 64], ub0, O0); O0 = MFMA32(F[49 * 64], ub1, O0);
                    O1 = MFMA32(F[52 * 64], ub0, O1); O1 = MFMA32(F[53 * 64], ub1, O1); O1 = MFMA32(F[54 * 64], ub2, O1); O1 = MFMA32(F[55 * 64], ub3, O1);
#pragma unroll
                    for (int i = 0; i < 16; ++i) { S0[i] *= gend; S1[i] *= gend; S2[i] *= gend; S3[i] *= gend; }
                    S0 = MFMA32(F[32 * 64], ub0, S0); S0 = MFMA32(F[33 * 64], ub1, S0); S0 = MFMA32(F[34 * 64], ub2, S0); S0 = MFMA32(F[35 * 64], ub3, S0);
                    S1 = MFMA32(F[36 * 64], ub0, S1); S1 = MFMA32(F[37 * 64], ub1, S1); S1 = MFMA32(F[38 * 64], ub2, S1); S1 = MFMA32(F[39 * 64], ub3, S1);
                    S2 = MFMA32(F[40 * 64], ub0, S2); S2 = MFMA32(F[41 * 64], ub1, S2); S2 = MFMA32(F[42 * 64], ub2, S2); S2 = MFMA32(F[43 * 64], ub3, S2);
                    S3 = MFMA32(F[44 * 64], ub0, S3); S3 = MFMA32(F[45 * 64], ub1, S3); S3 = MFMA32(F[46 * 64], ub2, S3); S3 = MFMA32(F[47 * 64], ub3, S3);
                    float* yo = ODN + (size_t)(b * 2048 + n * 64) * 1024 + h * 128 + 32 * nt + r;
#pragma unroll
                    for (int i = 0; i < 16; ++i) { yo[(size_t)crow(i, hp) * 1024] = O0[i]; yo[(size_t)(32 + crow(i, hp)) * 1024] = O1[i]; }
                }
                asm volatile("s_waitcnt vmcnt(0)" ::: "memory"); __syncthreads();
            }
#undef DN_DMA
            if (wave < 4) {
                float* dst = kp.out() + O_DN_P + ((size_t)j * 4 + b) * ((size_t)8 * 128 * 128) + (size_t)h * 128 * 128 + 32 * nt + r;
#pragma unroll
                for (int i = 0; i < 16; ++i) { dst[(size_t)crow(i, hp) * 128] = S0[i]; dst[(size_t)(32 + crow(i, hp)) * 128] = S1[i]; dst[(size_t)(64 + crow(i, hp)) * 128] = S2[i]; dst[(size_t)(96 + crow(i, hp)) * 128] = S3[i]; }
            }
        } else if (half >= 0) {
            const int wave = __builtin_amdgcn_readfirstlane(tid >> 6), lane = tid & 63, r = lane & 31, hp = lane >> 5;
            const int b = s, nt = half * 4 + wave;
            const unsigned char* OPS = kp.ws() + WS_GLAOPS;
            constexpr int GBUF = 57 * 1024;
#define GLA_DMA(n_, bufi_) do { const unsigned char* gi_ = OPS + (size_t)((b * 32 + (n_)) * 4 + h) * GLA_ITEM_BYTES + lane * 16; \
                _Pragma("unroll") for (int q_ = 0; q_ < 8; ++q_) { const int lf_ = wave + 8 * q_; if (lf_ < 57) { const int gf_ = lf_ < 40 ? lf_ : (lf_ < 56 ? lf_ + half * 16 : 72); \
                    __builtin_amdgcn_global_load_lds((const unsigned*)(gi_ + gf_ * 1024), (LAS unsigned*)(lds + (bufi_) * GBUF + lf_ * 1024), 16, 0, 0); } } } while (0)
            f32x16 S0, S1, S2, S3;
#pragma unroll
            for (int i = 0; i < 16; ++i) { S0[i] = 0.f; S1[i] = 0.f; S2[i] = 0.f; S3[i] = 0.f; }
            GLA_DMA(0, 0);
            asm volatile("s_waitcnt vmcnt(0)" ::: "memory"); __syncthreads();
            for (int n = 0; n < 32; ++n) {
                if (n + 1 < 32) GLA_DMA(n + 1, (n + 1) & 1);
                if (wave < 4) {
                    const LAS bf16x8* F = (const LAS bf16x8*)(lds + (n & 1) * GBUF) + lane;
                    const LAS float* ge = (const LAS float*)(lds + (n & 1) * GBUF + 56 * 1024) + 4 * hp;
                    const bf16x8 sb0 = PACK_ACC(S0, 0), sb1 = PACK_ACC(S0, 1), sb2 = PACK_ACC(S1, 0), sb3 = PACK_ACC(S1, 1), sb4 = PACK_ACC(S2, 0), sb5 = PACK_ACC(S2, 1), sb6 = PACK_ACC(S3, 0), sb7 = PACK_ACC(S3, 1);
                    f32x16 O0, O1;
#pragma unroll
                    for (int i = 0; i < 16; ++i) { O0[i] = 0.f; O1[i] = 0.f; }
                    O0 = MFMA32(F[0 * 64], sb0, O0); O0 = MFMA32(F[1 * 64], sb1, O0); O0 = MFMA32(F[2 * 64], sb2, O0); O0 = MFMA32(F[3 * 64], sb3, O0);
                    O0 = MFMA32(F[4 * 64], sb4, O0); O0 = MFMA32(F[5 * 64], sb5, O0); O0 = MFMA32(F[6 * 64], sb6, O0); O0 = MFMA32(F[7 * 64], sb7, O0);
                    O1 = MFMA32(F[8 * 64], sb0, O1); O1 = MFMA32(F[9 * 64], sb1, O1); O1 = MFMA32(F[10 * 64], sb2, O1); O1 = MFMA32(F[11 * 64], sb3, O1);
                    O1 = MFMA32(F[12 * 64], sb4, O1); O1 = MFMA32(F[13 * 64], sb5, O1); O1 = MFMA32(F[14 * 64], sb6, O1); O1 = MFMA32(F[15 * 64], sb7, O1);
                    bf16x8 vb[4];
#pragma unroll
                    for (int ks = 0; ks < 4; ++ks) vb[ks] = F[(40 + wave * 4 + ks) * 64];
                    O0 = MFMA32(F[32 * 64], vb[0], O0); O0 = MFMA32(F[33 * 64], vb[1], O0);
#pragma unroll
                    for (int ks = 0; ks < 4; ++ks) O1 = MFMA32(F[(36 + ks) * 64], vb[ks], O1);
#pragma unroll
                    for (int q = 0; q < 4; ++q) { const f32x4 g0 = *(const LAS f32x4*)(ge + 8 * q), g1 = *(const LAS f32x4*)(ge + 32 + 8 * q), g2 = *(const LAS f32x4*)(ge + 64 + 8 * q), g3 = *(const LAS f32x4*)(ge + 96 + 8 * q);
#pragma unroll
                        for (int c = 0; c < 4; ++c) { S0[4 * q + c] *= g0[c]; S1[4 * q + c] *= g1[c]; S2[4 * q + c] *= g2[c]; S3[4 * q + c] *= g3[c]; } }
#pragma unroll
                    for (int ks = 0; ks < 4; ++ks) { S0 = MFMA32(F[(16 + ks) * 64], vb[ks], S0); S1 = MFMA32(F[(20 + ks) * 64], vb[ks], S1); S2 = MFMA32(F[(24 + ks) * 64], vb[ks], S2); S3 = MFMA32(F[(28 + ks) * 64], vb[ks], S3); }
                    float* yo = OGLA + (size_t)(b * 2048 + n * 64) * 1024 + h * 256 + 32 * nt + r;
#pragma unroll
                    for (int i = 0; i < 16; ++i) { yo[(size_t)crow(i, hp) * 1024] = O0[i]; yo[(size_t)(32 + crow(i, hp)) * 1024] = O1[i]; }
                }
                asm volatile("s_waitcnt vmcnt(0)" ::: "memory"); __syncthreads();
            }
#undef GLA_DMA
            if (wave < 4) {
                float* dst = kp.out() + O_GLA_P + ((size_t)j * 4 + b) * ((size_t)4 * 128 * 256) + (size_t)h * 128 * 256 + 32 * nt + r;
#pragma unroll
                for (int i = 0; i < 16; ++i) { dst[(size_t)crow(i, hp) * 256] = S0[i]; dst[(size_t)(32 + crow(i, hp)) * 256] = S1[i]; dst[(size_t)(64 + crow(i, hp)) * 256] = S2[i]; dst[(size_t)(96 + crow(i, hp)) * 256] = S3[i]; }
            }
        } else
        if (isdn) {
            LAS float* kL = SL + 16384; LAS float* qL = kL + 128; LAS float* red = kL + 256; LAS float* red2 = kL + 768;
            const int e = tid & 127, dq = tid >> 7;
            const size_t SZ = (size_t)8 * 128 * 128;
            const float* st = kp.in(2) + ((size_t)j * 128 + (s < 4 ? 0 : s - 4)) * SZ + (size_t)h * 128 * 128;
#pragma unroll 4
            for (int i = 0; i < 32; ++i) { const int d = dq * 32 + i; SL[d * 128 + e] = s < 4 ? 0.f : st[(size_t)d * 128 + e]; }
            for (int t = 0; t < L; ++t) {
                const size_t r = (size_t)(row0 + t);
                if (tid < 128) kL[tid] = KN[r * 1024 + h * 128 + tid]; else if (tid < 256) qL[tid - 128] = QN[r * 1024 + h * 128 + (tid - 128)];
                const float ve = VV[r * 1024 + h * 128 + e], beta = BETA[r * 8 + h], a = expf(GDEC[r * 8 + h]);
                __syncthreads();
                float part = 0.f;
#pragma unroll 4
                for (int i = 0; i < 32; ++i) { const int d = dq * 32 + i; const float sv = SL[d * 128 + e] * a; SL[d * 128 + e] = sv; part += kL[d] * sv; }
                red[dq * 128 + e] = part;
                __syncthreads();
                const float kS = (red[e] + red[128 + e]) + (red[256 + e] + red[384 + e]);
                const float u = beta * (ve - kS);
                float part2 = 0.f;
#pragma unroll 4
                for (int i = 0; i < 32; ++i) { const int d = dq * 32 + i; const float sv = SL[d * 128 + e] + kL[d] * u; SL[d * 128 + e] = sv; part2 += qL[d] * sv; }
                red2[dq * 128 + e] = part2;
                __syncthreads();
                if (dq == 0) ODN[r * 1024 + h * 128 + e] = (red2[e] + red2[128 + e]) + (red2[256 + e] + red2[384 + e]);
            }
            float* dst = s < 4 ? kp.out() + O_DN_P + ((size_t)j * 4 + s) * SZ + (size_t)h * 128 * 128 : kp.out() + O_DN_S + ((size_t)j * 128 + (s - 4)) * SZ + (size_t)h * 128 * 128;
#pragma unroll 4
            for (int i = 0; i < 32; ++i) { const int d = dq * 32 + i; dst[(size_t)d * 128 + e] = SL[d * 128 + e]; }
        } else {
            LAS float* kL = SL + 32768; LAS float* qL = kL + 128; LAS float* aL = kL + 256; LAS float* red = kL + 384;
            const int e = tid & 255, dh = tid >> 8;
            const size_t SZ = (size_t)4 * 128 * 256;
            const float* st = kp.in(4) + ((size_t)j * 128 + (s < 4 ? 0 : s - 4)) * SZ + (size_t)h * 128 * 256;
#pragma unroll 4
            for (int i = 0; i < 64; ++i) { const int d = dh * 64 + i; SL[d * 256 + e] = s < 4 ? 0.f : st[(size_t)d * 256 + e]; }
            for (int t = 0; t < L; ++t) {
                const size_t r = (size_t)(row0 + t);
                if (tid < 128) kL[tid] = bf2f(U[r * NAB + 4608 + h * 128 + tid]);
                else if (tid < 256) qL[tid - 128] = bf2f(U[r * NAB + 4096 + h * 128 + (tid - 128)]) * 0.08838834764831845f;
                else if (tid < 384) aL[tid - 256] = expf(GLOG[r * 512 + h * 128 + (tid - 256)]);
                const float ve = bf2f(U[r * NAB + 5120 + h * 256 + e]);
                __syncthreads();
                float part = 0.f;
#pragma unroll 4
                for (int i = 0; i < 64; ++i) { const int d = dh * 64 + i; const float sv = aL[d] * SL[d * 256 + e] + kL[d] * ve; SL[d * 256 + e] = sv; part += qL[d] * sv; }
                red[dh * 256 + e] = part;
                __syncthreads();
                if (dh == 0) OGLA[r * 1024 + h * 256 + e] = red[e] + red[256 + e];
            }
            float* dst = s < 4 ? kp.out() + O_GLA_P + ((size_t)j * 4 + s) * SZ + (size_t)h * 128 * 256 : kp.out() + O_GLA_S + ((size_t)j * 128 + (s - 4)) * SZ + (size_t)h * 128 * 256;
#pragma unroll 4
            for (int i = 0; i < 64; ++i) { const int d = dh * 64 + i; dst[(size_t)d * 256 + e] = SL[d * 256 + e]; }
        }
    }
}

__device__ __forceinline__ void phase_ab_post(const KP kp, const int bid, const int G, int j, int tid, int wave, int lane) {
    unsigned char* scr = kp.ws() + WS_SCR; const bf16* U = (const bf16*)(kp.ws() + WS_U); bf16* YM = (bf16*)(kp.ws() + WS_YM);
    const float* ODN = (const float*)(scr + SC_ODN); const float* OGLA = (const float*)(scr + SC_OGLA);
    const float* dnn = kp.in(17) + (size_t)j * 128; const float* glan = kp.in(20) + (size_t)j * 256;
    typedef float f32x2v __attribute__((ext_vector_type(2)));
    const f32x2v dg = *(const f32x2v*)(dnn + 2 * lane); const f32x4 gg = *(const f32x4*)(glan + 4 * lane);
    for (int r = bid * NWAVES + wave; r < T; r += G * NWAVES) {
        int s, t; row_to_seq(r, s, t); int row0, L; seq_info(s, row0, L);
        const bf16* ur = U + (size_t)r * NAB; bf16* yr = YM + (size_t)r * DM;
#pragma unroll
        for (int hh = 0; hh < 8; ++hh) { const f32x2v o = *(const f32x2v*)(ODN + (size_t)r * 1024 + hh * 128 + 2 * lane);
            const float rstd = rsqrtf(wave_sum(o.x * o.x + o.y * o.y) * (1.f / 128.f) + 1e-6f);
            const unsigned zz = *(const unsigned*)(ur + 3072 + hh * 128 + 2 * lane);
            *(unsigned*)(yr + hh * 128 + 2 * lane) = pk2(o.x * rstd * dg.x * silu_(__uint_as_float(zz << 16)), o.y * rstd * dg.y * silu_(__uint_as_float(zz & 0xffff0000u))); }
#pragma unroll
        for (int hh = 0; hh < 4; ++hh) { const f32x4 o = *(const f32x4*)(OGLA + (size_t)r * 1024 + hh * 256 + 4 * lane);
            const float rstd = rsqrtf(wave_sum((o.x * o.x + o.y * o.y) + (o.z * o.z + o.w * o.w)) * (1.f / 256.f) + 1e-6f);
            const u32x2 zz = *(const u32x2*)(ur + 6144 + hh * 256 + 4 * lane);
            u32x2 w; w.x = pk2(o.x * rstd * gg.x * silu_(__uint_as_float(zz.x << 16)), o.y * rstd * gg.y * silu_(__uint_as_float(zz.x & 0xffff0000u)));
            w.y = pk2(o.z * rstd * gg.z * silu_(__uint_as_float(zz.y << 16)), o.w * rstd * gg.w * silu_(__uint_as_float(zz.y & 0xffff0000u)));
            *(u32x2*)(yr + 1024 + hh * 256 + 4 * lane) = w; }
        if (t >= L - 3) { const int rr = t - (L - 3);
            float* dst = s < 4 ? kp.out() + O_DNC_P + (((size_t)j * 4 + s) * 3 + rr) * 3072 : kp.out() + O_DNC_S + (((size_t)j * 128 + (s - 4)) * 3 + rr) * 3072;
            for (int c = 2 * lane; c < 3072; c += 128) { const unsigned uu = *(const unsigned*)(ur + c); *(f32x2v*)(dst + c) = (f32x2v){__uint_as_float(uu << 16), __uint_as_float(uu & 0xffff0000u)}; } }
    }
}

__device__ __forceinline__ void phase_cd_pre(const KP kp, const int bid, const int G, int j, LAS unsigned char* lds, int tid) {
    unsigned char* scr = kp.ws() + WS_SCR; const bf16* U = (const bf16*)(kp.ws() + WS_U);
    float* XBC = (float*)(scr + SC_XBC) - (size_t)TP * 1536; float* DT = (float*)(scr + SC_DT) - (size_t)TP * 16; bf16* XS = (bf16*)(scr + SC_XS);
    const float* cw = kp.in(23) + (size_t)j * 4 * 1536; const float* cb = kp.in(24) + (size_t)j * 1536; const float* stc = kp.in(6) + (size_t)j * 128 * 3 * 1536;
    for (int r = TP + bid; r < T; r += G) {
        int s, t; row_to_seq(r, s, t); const int row0 = r - t;
#pragma unroll
        for (int i = 0; i < 3; ++i) { const int c = tid + NTHR * i; float acc = cb[c];
#pragma unroll
            for (int tap = 0; tap < 4; ++tap) acc += cw[tap * 1536 + c] * pre_val(U, NCD, 1024 + c, row0, t - 3 + tap, s, stc, 1536, c);
            const float v = silu_(acc); XBC[(size_t)r * 1536 + c] = v; if (c < 1024) XS[(size_t)r * 1024 + c] = (bf16)f2bf(v); }
        if (tid < 16) DT[(size_t)r * 16 + tid] = softplus_(bf2f(U[(size_t)r * NCD + 4608 + tid]) + kp.in(26)[j * 16 + tid]);
    }
}

__device__ __forceinline__ void phase_lru_gates(const KP kp, const int bid, const int G, int j, LAS unsigned char* lds, int tid0) {
    unsigned char* scr = kp.ws() + WS_SCR; const bf16* U = (const bf16*)(kp.ws() + WS_U);
    float* LA = (float*)(scr + SC_LA); float* LB = (float*)(scr + SC_LB);
    const float* lcw = kp.in(29) + (size_t)j * 4 * 1024; const float* lcb = kp.in(30) + (size_t)j * 1024; const float* lstc = kp.in(8) + (size_t)j * 128 * 3 * 1024;
    const int n = bid & 15;
    const float* wa = kp.in(31) + ((size_t)j * 16 + n) * 4096; const float* wx = kp.in(33) + ((size_t)j * 16 + n) * 4096;
    const float* lba = kp.in(32) + (size_t)j * 1024; const float* lbx = kp.in(34) + (size_t)j * 1024; const float* lam = kp.in(35) + (size_t)j * 1024;
    LAS float* waL = (LAS float*)lds; LAS float* wxL = waL + 4096; LAS float* xcL = wxL + 4096;
    __syncthreads();
    for (int i = tid0; i < 4096; i += NTHR) { waL[i] = wa[i]; wxL[i] = wx[i]; }
    for (int tile = bid >> 4; tile < T / 64; tile += (G >> 4)) {
        int tid = tid0; asm volatile("" : "+v"(tid));
        const int c = tid & 63, tq = tid >> 6, ch = n * 64 + c, rowbase = tile * 64;
        __syncthreads();
#pragma unroll 2
        for (int tt = 0; tt < 8; ++tt) { const int r = rowbase + tq * 8 + tt; int s, t; row_to_seq(r, s, t); const int row0 = r - t; float acc = lcb[ch];
#pragma unroll
            for (int tap = 0; tap < 4; ++tap) acc += lcw[tap * 1024 + ch] * pre_val(U, NCD, 3584 + ch, row0, t - 3 + tap, s, lstc, 1024, ch);
            xcL[(tq * 8 + tt) * 65 + c] = acc; }
        __syncthreads();
        float ra[8], ix[8];
#pragma unroll
        for (int tt = 0; tt < 8; ++tt) { ra[tt] = lba[ch]; ix[tt] = lbx[ch]; }
#pragma unroll 4
        for (int cc = 0; cc < 64; ++cc) { const float wA = waL[cc * 64 + c], wX = wxL[cc * 64 + c];
#pragma unroll
            for (int tt = 0; tt < 8; ++tt) { const float x = xcL[(tq * 8 + tt) * 65 + cc]; ra[tt] += x * wA; ix[tt] += x * wX; } }
        const float spl = softplus_(-lam[ch]);
#pragma unroll
        for (int tt = 0; tt < 8; ++tt) { const size_t r = (size_t)(rowbase + tq * 8 + tt); const float rg = sigmoid_(ra[tt]), ig = sigmoid_(ix[tt]);
            const float log_a = -8.f * rg * spl;
            LA[r * 1024 + ch] = expf(log_a); LB[r * 1024 + ch] = sqrtf(-expm1f(2.f * log_a)) * (ig * xcL[(tq * 8 + tt) * 65 + c]); }
    }
}

__device__ __forceinline__ void phase_ssd_prep(const KP kp, const int bid, const int G, int j, LAS unsigned char* lds, int tid0) {
    unsigned char* scr = kp.ws() + WS_SCR;
    const bf16* U = (const bf16*)(kp.ws() + WS_U); bf16* XS = (bf16*)(scr + SC_XS);
    const float* cw = kp.in(23) + (size_t)j * 4 * 1536; const float* cb = kp.in(24) + (size_t)j * 1536;
    unsigned char* OPS = scr + SC_SSDOP; float* GEND = (float*)(scr + SC_GEND);
    LAS float* CL = (LAS float*)lds; LAS float* BL = CL + 64 * 65; LAS float* QK = BL + 64 * 65; LAS float* GL = QK + 64 * 65; LAS float* DTL = GL + 256; LAS float* XLs = DTL + 256;
    const float* alog = kp.in(25) + j * 16;
    for (int item = bid; item < 512; item += G) {
        int tid = tid0; asm volatile("" : "+v"(tid));
        const int wave = tid >> 6, lane = tid & 63;
        const int b = item >> 7, n = (item >> 2) & 31, g = item & 3;
        const int row0 = b * 2048 + n * 64;
        __syncthreads();
        { const int ci = tid & 127, tg = tid >> 7, t0 = 16 * tg;
          const bool first = (n == 0 && tg == 0);
#pragma unroll
          for (int q = 0; q < 3; ++q) { const int k = ci + 128 * q;
              int cidx; LAS float* dst; int dstr, dcol;
              if (k < 64) { cidx = 1024 + g * 64 + k; dst = BL; dstr = 65; dcol = k; }
              else if (k < 128) { cidx = 1280 + g * 64 + (k - 64); dst = CL; dstr = 65; dcol = k - 64; }
              else { cidx = g * 256 + (k - 128); dst = XLs; dstr = 257; dcol = k - 128; }
              const float w0 = cw[cidx], w1 = cw[1536 + cidx], w2 = cw[2 * 1536 + cidx], w3 = cw[3 * 1536 + cidx], bb = cb[cidx];
              const bf16* up = U + (size_t)(row0 + t0) * NCD + 1024 + cidx;
              float x0 = first ? 0.f : bf2f(up[-3 * (long)NCD]), x1 = first ? 0.f : bf2f(up[-2 * (long)NCD]), x2 = first ? 0.f : bf2f(up[-1 * (long)NCD]);
#pragma unroll 4
              for (int t = 0; t < 16; ++t) { const float x3 = bf2f(up[(size_t)t * NCD]); dst[(t0 + t) * dstr + dcol] = silu_(bb + w0 * x0 + w1 * x1 + w2 * x2 + w3 * x3); x0 = x1; x1 = x2; x2 = x3; } } }
        if (wave < 4) { const int h = g * 4 + wave; const float dt = softplus_(bf2f(U[(size_t)(row0 + lane) * NCD + 4608 + h]) + kp.in(26)[j * 16 + h]);
            DTL[wave * 64 + lane] = dt; float gv = -expf(alog[h]) * dt;
#pragma unroll
            for (int o = 1; o < 64; o <<= 1) { const float tt = __shfl_up(gv, o); if (lane >= o) gv += tt; }
            GL[wave * 64 + lane] = gv; }
        __syncthreads();
        for (int i = tid; i < 8192; i += NTHR) { const int t = i >> 7, k2 = i & 127;
            ((unsigned*)XS)[((size_t)(row0 + t) * 1024 + g * 256) / 2 + k2] = pk2(XLs[t * 257 + 2 * k2], XLs[t * 257 + 2 * k2 + 1]); }
        { const int i = tid >> 3, jg = tid & 7; float acc[8];
#pragma unroll
          for (int jj = 0; jj < 8; ++jj) acc[jj] = 0.f;
#pragma unroll 4
          for (int d = 0; d < 64; ++d) { const float c = CL[i * 65 + d];
#pragma unroll
              for (int jj = 0; jj < 8; ++jj) acc[jj] += c * BL[(jg * 8 + jj) * 65 + d]; }
#pragma unroll
          for (int jj = 0; jj < 8; ++jj) QK[i * 65 + jg * 8 + jj] = acc[jj]; }
        __syncthreads();
        const int f = wave, r = lane & 31, hp = lane >> 5, mt = f >> 2, ks = f & 3;
        for (int hh = 0; hh < 4; ++hh) {
            const int h = g * 4 + hh; const LAS float* Gh = GL + hh * 64; const float Gend = Gh[63];
            bf16x8* base = (bf16x8*)(OPS + ((size_t)((b * 32 + n) * 16 + h)) * 32768);
            float v[8];
            { const int i = 32 * mt + r; const float eg = expf(Gh[i]);
#pragma unroll
              for (int jp = 0; jp < 8; ++jp) { const int d = 16 * ks + 8 * (jp >> 2) + 4 * hp + (jp & 3); v[jp] = CL[i * 65 + d] * eg; }
              base[0 * 512 + f * 64 + lane] = pack8(v); }
            { const int d = 32 * mt + r;
#pragma unroll
              for (int jp = 0; jp < 8; ++jp) { const int tk = 16 * ks + 8 * (jp >> 2) + 4 * hp + (jp & 3); v[jp] = BL[tk * 65 + d] * expf(Gend - Gh[tk]); }
              base[1 * 512 + f * 64 + lane] = pack8(v); }
            { const int i = 32 * mt + r; const float gi = Gh[i];
#pragma unroll
              for (int jp = 0; jp < 8; ++jp) { const int jt = 16 * ks + 8 * (jp >> 2) + 4 * hp + (jp & 3); v[jp] = jt <= i ? QK[i * 65 + jt] * expf(gi - Gh[jt]) : 0.f; }
              base[2 * 512 + f * 64 + lane] = pack8(v); }
            { const int p = 32 * mt + r;
#pragma unroll
              for (int jp = 0; jp < 8; ++jp) { const int tk = 16 * ks + 8 * (jp >> 2) + 4 * hp + (jp & 3);
                  v[jp] = XLs[tk * 257 + hh * 64 + p] * DTL[hh * 64 + tk]; }
              base[3 * 512 + f * 64 + lane] = pack8(v); }
            if (tid == 0) GEND[(b * 32 + n) * 16 + h] = expf(Gend);
        }
    }
}

__device__ __forceinline__ void phase_cd_rec(const KP kp, const int bid, const int G, int j, LAS unsigned char* lds, int tid0) {
    unsigned char* scr = kp.ws() + WS_SCR;
    const float* XBC = (const float*)(scr + SC_XBC) - (size_t)TP * 1536; const float* LA = (const float*)(scr + SC_LA); const float* LB = (const float*)(scr + SC_LB); const float* DT = (const float*)(scr + SC_DT) - (size_t)TP * 16;
    float* YS = (float*)(scr + SC_YS); float* HS = (float*)(scr + SC_HS);
    LAS float* bL = (LAS float*)lds; LAS float* cL = bL + 64; LAS float* red = bL + 128;
    for (int item = bid; item < 2576; item += G) {
        int tid = tid0; asm volatile("" : "+v"(tid));
        int kind, s, h;
        if (item < 16) { kind = 2; s = item >> 2; h = item & 3; }
        else if (item < 272) { kind = 3; s = (item - 16) >> 6; h = (item - 16) & 63; }
        else if (item < 2320) { kind = 0; s = 4 + ((item - 272) >> 4); h = (item - 272) & 15; }
        else { kind = 1; s = 4 + ((item - 2320) >> 1); h = (item - 2320) & 1; }
        int row0, L; seq_info(s, row0, L);
        __syncthreads();
        if (kind == 3) {
            LAS float* Al = (LAS float*)lds; LAS float* Bl = Al + 512;
            const int chunk = tid >> 4, c16 = tid & 15, ch = h * 16 + c16;
            const size_t ro = (size_t)(row0 + chunk * 64) * 1024 + ch;
            float Ap = 1.f, Bp = 0.f;
#pragma unroll 8
            for (int t = 0; t < 64; ++t) { const float a = LA[ro + (size_t)t * 1024], bb = LB[ro + (size_t)t * 1024]; Bp = a * Bp + bb; Ap *= a; }
            Al[tid] = Ap; Bl[tid] = Bp;
            __syncthreads();
            float hh = 0.f;
            for (int m = 0; m < chunk; ++m) hh = Al[m * 16 + c16] * hh + Bl[m * 16 + c16];
#pragma unroll 8
            for (int t = 0; t < 64; ++t) { hh = LA[ro + (size_t)t * 1024] * hh + LB[ro + (size_t)t * 1024]; HS[ro + (size_t)t * 1024] = hh; }
            if (chunk == 31) kp.out()[O_LRU_P + ((size_t)j * 4 + s) * 1024 + ch] = hh;
        } else
        if (kind == 2) {
            const int wave = __builtin_amdgcn_readfirstlane(tid >> 6), lane = tid & 63, r = lane & 31, hp = lane >> 5;
            const int b = s, hd = h * 4 + (wave >> 1), nt = wave & 1;
            const unsigned char* OPS = scr + SC_SSDOP; const float* GEND = (const float*)(scr + SC_GEND);
            f32x16 S0, S1;
#pragma unroll
            for (int i = 0; i < 16; ++i) { S0[i] = 0.f; S1[i] = 0.f; }
            for (int n = 0; n < 32; ++n) {
                const bf16x8* F = (const bf16x8*)(OPS + ((size_t)((b * 32 + n) * 16 + hd)) * 32768) + lane;
                bf16x8 qg[2][4], kT[2][4], Am[2][4], vb[4];
#pragma unroll
                for (int mt = 0; mt < 2; ++mt)
#pragma unroll
                    for (int ks = 0; ks < 4; ++ks) { qg[mt][ks] = F[(0 * 8 + mt * 4 + ks) * 64]; kT[mt][ks] = F[(1 * 8 + mt * 4 + ks) * 64]; Am[mt][ks] = F[(2 * 8 + mt * 4 + ks) * 64]; }
#pragma unroll
                for (int ks = 0; ks < 4; ++ks) vb[ks] = F[(3 * 8 + nt * 4 + ks) * 64];
                const float gend = GEND[(b * 32 + n) * 16 + hd];
                const bf16x8 sb00 = PACK_ACC(S0, 0), sb01 = PACK_ACC(S0, 1), sb10 = PACK_ACC(S1, 0), sb11 = PACK_ACC(S1, 1);
                f32x16 O0, O1;
#pragma unroll
                for (int i = 0; i < 16; ++i) { O0[i] = 0.f; O1[i] = 0.f; }
                O0 = MFMA32(qg[0][0], sb00, O0); O0 = MFMA32(qg[0][1], sb01, O0); O0 = MFMA32(qg[0][2], sb10, O0); O0 = MFMA32(qg[0][3], sb11, O0);
                O1 = MFMA32(qg[1][0], sb00, O1); O1 = MFMA32(qg[1][1], sb01, O1); O1 = MFMA32(qg[1][2], sb10, O1); O1 = MFMA32(qg[1][3], sb11, O1);
                O0 = MFMA32(Am[0][0], vb[0], O0); O0 = MFMA32(Am[0][1], vb[1], O0);
#pragma unroll
                for (int ks = 0; ks < 4; ++ks) O1 = MFMA32(Am[1][ks], vb[ks], O1);
#pragma unroll
                for (int i = 0; i < 16; ++i) { S0[i] *= gend; S1[i] *= gend; }
#pragma unroll
                for (int ks = 0; ks < 4; ++ks) { S0 = MFMA32(kT[0][ks], vb[ks], S0); S1 = MFMA32(kT[1][ks], vb[ks], S1); }
                float* yo = YS + (size_t)(b * 2048 + n * 64) * 1024 + hd * 64 + 32 * nt + r;
#pragma unroll
                for (int i = 0; i < 16; ++i) { yo[(size_t)crow(i, hp) * 1024] = O0[i]; yo[(size_t)(32 + crow(i, hp)) * 1024] = O1[i]; }
            }
            float* dst = kp.out() + O_SSD_P + ((size_t)j * 4 + b) * ((size_t)16 * 64 * 64) + (size_t)hd * 64 * 64 + 32 * nt + r;
#pragma unroll
            for (int i = 0; i < 16; ++i) { dst[(size_t)crow(i, hp) * 64] = S0[i]; dst[(size_t)(32 + crow(i, hp)) * 64] = S1[i]; }
        } else if (kind == 0) {
            const int p = tid & 63, ng = tid >> 6, grp = h >> 2;
            const size_t SZ = (size_t)16 * 64 * 64;
            float S[8];
            if (s < 4) {
#pragma unroll
                for (int i = 0; i < 8; ++i) S[i] = 0.f;
            } else { const float* st = kp.in(5) + ((size_t)j * 128 + (s - 4)) * SZ + (size_t)h * 64 * 64;
#pragma unroll
                for (int i = 0; i < 8; ++i) S[i] = st[(size_t)(ng * 8 + i) * 64 + p]; }
            const float negA = -expf(kp.in(25)[j * 16 + h]);
            for (int t = 0; t < L; ++t) {
                const size_t r = (size_t)(row0 + t);
                if (tid < 64) bL[tid] = XBC[r * 1536 + 1024 + grp * 64 + tid]; else if (tid < 128) cL[tid - 64] = XBC[r * 1536 + 1280 + grp * 64 + (tid - 64)];
                const float xp = XBC[r * 1536 + h * 64 + p], dt = DT[r * 16 + h], a = expf(negA * dt), xdt = xp * dt;
                __syncthreads();
                float part = 0.f;
#pragma unroll
                for (int i = 0; i < 8; ++i) { const int n = ng * 8 + i; S[i] = a * S[i] + bL[n] * xdt; part += cL[n] * S[i]; }
                red[ng * 64 + p] = part;
                __syncthreads();
                if (ng == 0) { float y = 0.f;
#pragma unroll
                    for (int g = 0; g < 8; ++g) y += red[g * 64 + p];
                    YS[r * 1024 + h * 64 + p] = y; }
            }
            float* dst = s < 4 ? kp.out() + O_SSD_P + ((size_t)j * 4 + s) * SZ + (size_t)h * 64 * 64 : kp.out() + O_SSD_S + ((size_t)j * 128 + (s - 4)) * SZ + (size_t)h * 64 * 64;
#pragma unroll
            for (int i = 0; i < 8; ++i) dst[(size_t)(ng * 8 + i) * 64 + p] = S[i];
        } else {
            const int ch = h * 512 + tid;
            float hh = s < 4 ? 0.f : kp.in(7)[((size_t)j * 128 + (s - 4)) * 1024 + ch];
#pragma unroll 8
            for (int t = 0; t < L; ++t) { const size_t r = (size_t)(row0 + t); hh = LA[r * 1024 + ch] * hh + LB[r * 1024 + ch]; HS[r * 1024 + ch] = hh; }
            float* dst = s < 4 ? kp.out() + O_LRU_P + ((size_t)j * 4 + s) * 1024 : kp.out() + O_LRU_S + ((size_t)j * 128 + (s - 4)) * 1024;
            dst[ch] = hh;
        }
    }
}

__device__ __forceinline__ void phase_cd_post(const KP kp, const int bid, const int G, int j, int tid, int wave, int lane) {
    unsigned char* scr = kp.ws() + WS_SCR; const bf16* U = (const bf16*)(kp.ws() + WS_U); bf16* YM = (bf16*)(kp.ws() + WS_YM);
    const float* YS = (const float*)(scr + SC_YS); const float* HS = (const float*)(scr + SC_HS); const bf16* XS = (const bf16*)(scr + SC_XS);
    const float* sn = kp.in(28) + (size_t)j * 1024; const float* Dv = kp.in(27) + (size_t)j * 16;
    typedef float f32x2v __attribute__((ext_vector_type(2)));
    for (int r = bid * NWAVES + wave; r < T; r += G * NWAVES) {
        int s, t; row_to_seq(r, s, t); int row0, L; seq_info(s, row0, L);
        const bf16* ur = U + (size_t)r * NCD; bf16* yr = YM + (size_t)r * DM;
#pragma unroll
        for (int gq = 0; gq < 4; ++gq) { const int e = gq * 256 + 4 * lane; const f32x4 ys = *(const f32x4*)(YS + (size_t)r * 1024 + e);
            const u32x2 xx = *(const u32x2*)(XS + (size_t)r * 1024 + e), zz = *(const u32x2*)(ur + e); const float Dh = Dv[e >> 6];
            f32x4 y; y.x = (ys.x + Dh * __uint_as_float(xx.x << 16)) * silu_(__uint_as_float(zz.x << 16)); y.y = (ys.y + Dh * __uint_as_float(xx.x & 0xffff0000u)) * silu_(__uint_as_float(zz.x & 0xffff0000u));
            y.z = (ys.z + Dh * __uint_as_float(xx.y << 16)) * silu_(__uint_as_float(zz.y << 16)); y.w = (ys.w + Dh * __uint_as_float(xx.y & 0xffff0000u)) * silu_(__uint_as_float(zz.y & 0xffff0000u));
            const float rstd = rsqrtf(wave_sum((y.x * y.x + y.y * y.y) + (y.z * y.z + y.w * y.w)) * (1.f / 256.f) + 1e-6f);
            const f32x4 g4 = *(const f32x4*)(sn + e);
            u32x2 w; w.x = pk2(y.x * rstd * g4.x, y.y * rstd * g4.y); w.y = pk2(y.z * rstd * g4.z, y.w * rstd * g4.w); *(u32x2*)(yr + e) = w; }
#pragma unroll
        for (int gq = 0; gq < 4; ++gq) { const int ch = gq * 256 + 4 * lane; const f32x4 hs = *(const f32x4*)(HS + (size_t)r * 1024 + ch); const u32x2 zz = *(const u32x2*)(ur + 2560 + ch);
            u32x2 w; w.x = pk2(hs.x * silu_(__uint_as_float(zz.x << 16)), hs.y * silu_(__uint_as_float(zz.x & 0xffff0000u))); w.y = pk2(hs.z * silu_(__uint_as_float(zz.y << 16)), hs.w * silu_(__uint_as_float(zz.y & 0xffff0000u)));
            *(u32x2*)(yr + 1024 + ch) = w; }
        if (t >= L - 3) { const int rr = t - (L - 3);
            float* d1 = s < 4 ? kp.out() + O_SSDC_P + (((size_t)j * 4 + s) * 3 + rr) * 1536 : kp.out() + O_SSDC_S + (((size_t)j * 128 + (s - 4)) * 3 + rr) * 1536;
            for (int c = 2 * lane; c < 1536; c += 128) { const unsigned uu = *(const unsigned*)(ur + 1024 + c); *(f32x2v*)(d1 + c) = (f32x2v){__uint_as_float(uu << 16), __uint_as_float(uu & 0xffff0000u)}; }
            float* d2 = s < 4 ? kp.out() + O_LRUC_P + (((size_t)j * 4 + s) * 3 + rr) * 1024 : kp.out() + O_LRUC_S + (((size_t)j * 128 + (s - 4)) * 3 + rr) * 1024;
            for (int c = 2 * lane; c < 1024; c += 128) { const unsigned uu = *(const unsigned*)(ur + 3584 + c); *(f32x2v*)(d2 + c) = (f32x2v){__uint_as_float(uu << 16), __uint_as_float(uu & 0xffff0000u)}; } }
    }
}

__global__ void __launch_bounds__(NTHR, 2) mega_fwd(Args A) {
    extern __shared__ __attribute__((aligned(16))) unsigned char lds_raw[];
    LAS unsigned char* lds = (LAS unsigned char*)lds_raw;
    const int G = gridDim.x;
    volatile LAS unsigned* bst = (volatile LAS unsigned*)(lds + LDS_BYTES - 16);
    if (threadIdx.x == 0) { bst[0] = 0u; bst[1] = 0u; }
    __syncthreads();
    XcdBarrier xbar = xcd_barrier_post((unsigned*)(A.ws + WS_CTL) + CW_BAR, bst);
#ifdef PROBE_GROUP
    unsigned long long t_prev = __builtin_amdgcn_s_memrealtime(), t_sel = 0;
#endif
    for (int ph = A.ph_lo; ph < A.ph_hi; ++ph) {
        KP kp; kp.p = (const char AS4*)__builtin_amdgcn_kernarg_segment_ptr(); asm volatile("" : "+s"(kp.p));
        unsigned char* ws = kp.ws();
        int tid = threadIdx.x; asm volatile("" : "+v"(tid));
        int bid = blockIdx.x; asm volatile("" : "+s"(bid));
        const int lane = tid & 63, wave = __builtin_amdgcn_readfirstlane(tid >> 6), gw = bid * NWAVES + wave, NGW = G * NWAVES;
        if (ph == 0) { if (PH_MASK & 1) phase_prologue(kp, lds, gw, NGW, wave, lane); }
        else if (ph == N_PHASES - 1) phase_final(kp, gw, NGW, lane);
        else {
            const int li = (ph - 1) / SUBS, sub = (ph - 1) % SUBS, j = li >> 1; const bool ab = (li & 1) == 0;
            float* RSS = (float*)(ws + WS_RSS);
            if (sub == 0) {
                const int N = ab ? NAB : NCD;
                const bf16* Bt = ab ? (const bf16*)(ws + WS_WABIN) + (size_t)j * NAB * 2048 : (const bf16*)(ws + WS_WCDIN) + (size_t)j * NCD * 2048;
                { pg8::Gemm g{(const bf16*)(ws + WS_XN), Bt, T, N, 2048}; pg8::StaticOrder S; S.init(T, N, G, bid);
                  pg8::EpiU E{(bf16*)(ws + WS_U), N, RSS + (size_t)(2 * li) * T};
                  if (PH_MASK & 2) pg8::gemm_phase<pg8::EpiU, pg8::StaticOrder, true, true>(lds, g, S, E, tid); }
                { int tid2 = tid; asm volatile("" : "+v"(tid2));
                  pg8::Gemm g{(const bf16*)(ws + WS_PB) + (size_t)li * T * 256, (const bf16*)(ws + WS_WPROJ) + (size_t)li * 2048 * 256, T, 2048, 256}; pg8::StaticOrder S; S.init(T, 2048, G, (bid + 37) % G);
                  pg8::EpiU E{(bf16*)(ws + WS_SCR + SC_PP), 2048, nullptr};
                  if (PH_MASK & 2) pg8::gemm_phase<pg8::EpiU, pg8::StaticOrder, true, true>(lds, g, S, E, tid2); }
            } else if (sub == 4) {
                const bf16* Bt = ab ? (const bf16*)(ws + WS_WABOUT) + (size_t)j * 2048 * 2048 : (const bf16*)(ws + WS_WCDOUT) + (size_t)j * 2048 * 2048;
                pg8::Gemm g{(const bf16*)(ws + WS_YM), Bt, T, 2048, 2048}; pg8::StaticOrder S; S.init(T, 2048, G, bid);
                pg8::EpiRes<false> E{(const bf16*)(ws + WS_XN), (bf16*)(ws + WS_SCR + SC_HB1), RSS + (size_t)(2 * li + 1) * T, nullptr, nullptr};
                if (PH_MASK & 4) pg8::gemm_phase<pg8::EpiRes<false>, pg8::StaticOrder, true, true>(lds, g, S, E, tid);
            } else if (sub == 5) {
                pg8::Gemm g{(const bf16*)(ws + WS_SCR + SC_HB1), (const bf16*)(ws + WS_WGATE) + (size_t)li * 2048 * 2048, T, 2048, 2048}; pg8::StaticOrder S; S.init(T, 2048, G, bid);
                pg8::EpiRes<true> E{(const bf16*)(ws + WS_SCR + SC_HB1), (bf16*)(ws + WS_XN), RSS + (size_t)(2 * li + 2) * T, (const bf16*)(ws + WS_SCR + SC_PP), RSS + (size_t)(2 * li + 1) * T};
                if (PH_MASK & 4) pg8::gemm_phase<pg8::EpiRes<true>, pg8::StaticOrder, true, true>(lds, g, S, E, tid);
            } else if (sub == 1) {
                if (ab) { if (PH_MASK & 8) phase_ab_pre(kp, bid, G, j, tid, wave, lane); if (PH_MASK & 4096) phase_gla_prep(kp, bid, G, j, lds, tid); if (PH_MASK & 8192) phase_dn_prep(kp, bid, G, j, lds, tid); }
                else { if (PH_MASK & 16) phase_cd_pre(kp, bid, G, j, lds, tid); if (PH_MASK & 2048) { phase_ssd_prep(kp, bid, G, j, lds, tid); phase_lru_gates(kp, bid, G, j, lds, tid); } }
            }
            else if (sub == 2) { if (ab) { if (PH_MASK & 32) phase_ab_rec(kp, bid, G, j, lds, tid); } else { if (PH_MASK & 64) phase_cd_rec(kp, bid, G, j, lds, tid); } }
            else { if (ab) { if (PH_MASK & 128) phase_ab_post(kp, bid, G, j, tid, wave, lane); } else { if (PH_MASK & 256) phase_cd_post(kp, bid, G, j, tid, wave, lane); } }
        }
        if (ph + 1 < A.ph_hi) { if (ph == A.ph_lo) cg::this_grid().sync(); else xcd_barrier(xbar); }
#ifdef PROBE_GROUP
        { const unsigned long long t_now = __builtin_amdgcn_s_memrealtime(); const int li_ = (ph - 1) / SUBS, sub_ = (ph - 1) % SUBS; const bool ab_ = (li_ & 1) == 0;
          int grp = 9; if (ph == N_PHASES - 1) grp = 8; else if (ph > 0) { if (sub_ == 0 || sub_ == 4 || sub_ == 5) grp = 1; else if (sub_ == 1) grp = ab_ ? 4 : 5; else if (sub_ == 2) grp = ab_ ? 6 : 7; else grp = 8; }
          if (grp == PROBE_GROUP) t_sel += t_now - t_prev; t_prev = t_now; }
#endif
    }
#ifdef PROBE_GROUP
    if (blockIdx.x == 0 && threadIdx.x == 0) { const unsigned long long t0 = __builtin_amdgcn_s_memrealtime(); while (__builtin_amdgcn_s_memrealtime() - t0 < 3 * t_sel) __builtin_amdgcn_s_sleep(8); }
#endif
}

extern "C" void kernel_launch(void* const* d_in, const int* in_sizes, int n_in, void* d_out, int out_size, void* d_ws, size_t ws_size, hipStream_t stream) {
    static int grid = 0;
    if (grid == 0) {
        if (n_in != 40 || (size_t)out_size != O_END || ws_size < WS_END) { fprintf(stderr, "kernel_launch: unexpected shapes: n_in %d out %d ws %zu\n", n_in, out_size, ws_size); grid = -1; return; }
        int dev = 0, cus = 0, per_cu = 0;
        if (hipGetDevice(&dev) != hipSuccess || hipDeviceGetAttribute(&cus, hipDeviceAttributeMultiprocessorCount, dev) != hipSuccess) { grid = -1; return; }
        if (hipFuncSetAttribute((const void*)mega_fwd, hipFuncAttributeMaxDynamicSharedMemorySize, LDS_BYTES) != hipSuccess) { fprintf(stderr, "kernel_launch: hipFuncSetAttribute failed\n"); grid = -1; return; }
        if (hipOccupancyMaxActiveBlocksPerMultiprocessor(&per_cu, (const void*)mega_fwd, NTHR, LDS_BYTES) != hipSuccess || per_cu < 1) { fprintf(stderr, "kernel_launch: occupancy query says %d\n", per_cu); per_cu = 1; }
        (void)hipGetLastError();
        grid = cus;
    }
    if (grid < 0) return;
    if (hipMemsetAsync((char*)d_ws + WS_CTL, 0, CTL_ZERO_BYTES, stream) != hipSuccess) { fprintf(stderr, "kernel_launch: memset of the control words failed\n"); return; }
    Args a{};
    for (int i = 0; i < 40; ++i) a.in[i] = (const float*)d_in[i];
    a.out = (float*)d_out; a.ws = (unsigned char*)d_ws;
#if MK_N_LAUNCHES == 1
    a.ph_lo = 0; a.ph_hi = N_PHASES;
    void* args[] = {&a};
    hipError_t e = hipLaunchCooperativeKernel((const void*)mega_fwd, dim3(grid), dim3(NTHR), args, LDS_BYTES, stream);
    if (e != hipSuccess) fprintf(stderr, "cooperative launch failed: %s (grid %d)\n", hipGetErrorString(e), grid);
#else
    for (int ph = 0; ph < N_PHASES; ++ph) { a.ph_lo = ph; a.ph_hi = ph + 1; mega_fwd<<<dim3(grid), dim3(NTHR), LDS_BYTES, stream>>>(a); }
#endif
}
```

```cpp
#include <hip/hip_runtime.h>
#include <hip/hip_cooperative_groups.h>
#include <cstdio>
#include <cstdint>
namespace cg = cooperative_groups;

#ifndef MK_N_LAUNCHES
#define MK_N_LAUNCHES 1
#endif

namespace pg8 {
#define PG8_LAS __attribute__((address_space(3)))
typedef unsigned short bf16_t;
typedef short bf16x8 __attribute__((ext_vector_type(8)));
typedef float f32x4 __attribute__((ext_vector_type(4)));
typedef unsigned u32x4 __attribute__((ext_vector_type(4)));
constexpr int BM = 256, BK = 64, HALF = 128, HTB = HALF * BK * 2  , STAGE_BYTES = 8 * HTB, NXCD = 8, WGM = 8;

__host__ __device__ __forceinline__ int lds_byte(int r, int c) { const int st = (r >> 4) * 2 + (c >> 5), rr = r & 15, cc = c & 31, ob = rr * 64 + cc * 2; return st * 1024 + (ob ^ (((ob >> 9) & 1) << 5)); }
__host__ __device__ __forceinline__ void stage_rc(int b, int& R, int& C) { const int st = b / 1024, sb = b % 1024, swz = sb ^ (((sb >> 9) & 1) << 5); R = (st >> 1) * 16 + swz / 64; C = (st & 1) * 32 + (swz % 64) / 2; }
__host__ __device__ __forceinline__ int perm32(int rho) { const int n = rho >> 4, i = rho & 15; return 8 * (i >> 2) + 4 * n + (i & 3); }

struct Unit { int pm, pn; };
struct Gemm { const bf16_t* A; const bf16_t* Bt; int M, N, K; };

struct StaticOrder {
    int nM, nN, nwg, G, c;
    __host__ __device__ void init(int M, int N, int G_, int c_) { nM = M / BM; nN = N / BM; nwg = nM * nN; G = G_; c = c_; }
    __host__ __device__ bool next(int i, Unit& u) const {
        const long L = (long)i * G + c; if (L >= nwg) return false;
        int wgid = (int)L; { const int q = nwg / NXCD, r = nwg % NXCD, xcd = wgid % NXCD, off = wgid / NXCD; wgid = (xcd < r ? xcd * (q + 1) : r * (q + 1) + (xcd - r) * q) + off; }
        const int nig = WGM * nN, gid = wgid / nig, fm = gid * WGM, gsz = (nM - fm) < WGM ? (nM - fm) : WGM;
        u.pm = fm + ((wgid % nig) % gsz); u.pn = (wgid % nig) / gsz; return true;
    }
    __device__ __forceinline__ void a_ready(const Unit&) const {}
    __device__ __forceinline__ void done(const Unit&) const {}
};

__device__ __forceinline__ unsigned cvt_pk_bf16(float lo, float hi) { unsigned r; asm volatile("v_cvt_pk_bf16_f32 %0, %1, %2" : "=v"(r) : "v"(lo), "v"(hi)); return r; }
struct EpiF32 {
    static constexpr bool PERM = false, AFTER_DRAIN = false;
    float* C; int ldc;
    __device__ __forceinline__ void operator()(const f32x4 (&acc)[2][2][4][2], const Unit& u, int wr, int wc, int fr, int fq) const {
        const int row0 = u.pm * BM + wr * 64 + fr, col0 = u.pn * BM + wc * 32 + 4 * fq;
#pragma unroll
        for (int ai = 0; ai < 2; ++ai)
#pragma unroll
            for (int m = 0; m < 4; ++m) { float* rowp = C + (size_t)(row0 + ai * HALF + m * 16) * ldc + col0;
#pragma unroll
                for (int bj = 0; bj < 2; ++bj)
#pragma unroll
                    for (int n = 0; n < 2; ++n) *(f32x4*)(rowp + bj * HALF + n * 16) = acc[ai][bj][m][n]; }
    }
};
struct EpiBf16 {
    static constexpr bool PERM = true, AFTER_DRAIN = false;
    bf16_t* O; int ldc;
    __device__ __forceinline__ void operator()(const f32x4 (&acc)[2][2][4][2], const Unit& u, int wr, int wc, int fr, int fq) const {
        const int row0 = u.pm * BM + wr * 64 + fr; const int col0 = u.pn * BM + wc * 32 + 8 * fq;
#pragma unroll
        for (int ai = 0; ai < 2; ++ai)
#pragma unroll
            for (int m = 0; m < 4; ++m) { bf16_t* rowp = O + (size_t)(row0 + ai * HALF + m * 16) * ldc + col0;
#pragma unroll
                for (int bj = 0; bj < 2; ++bj) { const f32x4 v0 = acc[ai][bj][m][0], v1 = acc[ai][bj][m][1];
                    u32x4 w; w.x = cvt_pk_bf16(v0[0], v0[1]); w.y = cvt_pk_bf16(v0[2], v0[3]); w.z = cvt_pk_bf16(v1[0], v1[1]); w.w = cvt_pk_bf16(v1[2], v1[3]);
                    *(u32x4*)(rowp + bj * HALF) = w; } }
    }
};

struct EpiU {
    static constexpr bool PERM = true, AFTER_DRAIN = false;
    bf16_t* O; int ldc; const float* rss;
    __device__ __forceinline__ void operator()(const f32x4 (&acc)[2][2][4][2], const Unit& u, int wr, int wc, int fr, int fq) const {
        const int row0 = u.pm * BM + wr * 64 + fr; const int col0 = u.pn * BM + wc * 32 + 8 * fq;
#pragma unroll
        for (int ai = 0; ai < 2; ++ai)
#pragma unroll
            for (int m = 0; m < 4; ++m) { const int row = row0 + ai * HALF + m * 16; const float sc = rss ? rsqrtf(rss[row] * (1.f / 2048.f) + 1e-6f) : 1.f;
                bf16_t* rowp = O + (size_t)row * ldc + col0;
#pragma unroll
                for (int bj = 0; bj < 2; ++bj) { const f32x4 v0 = acc[ai][bj][m][0] * sc, v1 = acc[ai][bj][m][1] * sc;
                    u32x4 w; w.x = cvt_pk_bf16(v0[0], v0[1]); w.y = cvt_pk_bf16(v0[2], v0[3]); w.z = cvt_pk_bf16(v1[0], v1[1]); w.w = cvt_pk_bf16(v1[2], v1[3]);
                    *(u32x4*)(rowp + bj * HALF) = w; } }
    }
};
typedef unsigned u32x2e __attribute__((ext_vector_type(2)));
template <bool GATE> struct EpiRes {
    static constexpr bool PERM = false, AFTER_DRAIN = false;
    const bf16_t* Hin; bf16_t* Hout; float* rss_out; const bf16_t* PP; const float* rss_in;
    __device__ __forceinline__ void operator()(const f32x4 (&acc)[2][2][4][2], const Unit& u, int wr, int wc, int fr, int fq) const {
        const int row0 = u.pm * BM + wr * 64 + fr, col0 = u.pn * BM + wc * 32 + 4 * fq;
#pragma unroll
        for (int ai = 0; ai < 2; ++ai)
#pragma unroll
            for (int m = 0; m < 4; ++m) { const int row = row0 + ai * HALF + m * 16; const size_t ro = (size_t)row * 2048 + col0;
                float sc = 1.f; if (GATE) sc = rsqrtf(rss_in[row] * (1.f / 2048.f) + 1e-6f);
                float s = 0.f;
#pragma unroll
                for (int bj = 0; bj < 2; ++bj)
#pragma unroll
                    for (int n = 0; n < 2; ++n) { const size_t p = ro + bj * HALF + n * 16; const u32x2e hw = *(const u32x2e*)(Hin + p); const f32x4 a = acc[ai][bj][m][n];
                        f32x4 h; h[0] = __uint_as_float(hw.x << 16); h[1] = __uint_as_float(hw.x & 0xffff0000u); h[2] = __uint_as_float(hw.y << 16); h[3] = __uint_as_float(hw.y & 0xffff0000u);
                        if (GATE) { const u32x2e pw = *(const u32x2e*)(PP + p);
                            h[0] += __builtin_amdgcn_rcpf(1.f + __expf(-sc * a[0])) * __uint_as_float(pw.x << 16); h[1] += __builtin_amdgcn_rcpf(1.f + __expf(-sc * a[1])) * __uint_as_float(pw.x & 0xffff0000u);
                            h[2] += __builtin_amdgcn_rcpf(1.f + __expf(-sc * a[2])) * __uint_as_float(pw.y << 16); h[3] += __builtin_amdgcn_rcpf(1.f + __expf(-sc * a[3])) * __uint_as_float(pw.y & 0xffff0000u); }
                        else h = h + a;
                        s += (h[0] * h[0] + h[1] * h[1]) + (h[2] * h[2] + h[3] * h[3]);
                        u32x2e o; o.x = cvt_pk_bf16(h[0], h[1]); o.y = cvt_pk_bf16(h[2], h[3]); *(u32x2e*)(Hout + p) = o; }
                s += __shfl_xor(s, 16); s += __shfl_xor(s, 32);
                if (fq == 0) atomicAdd(rss_out + row, s);
                asm volatile("" ::: "memory"); }
    }
};
template <class Epi, class Sched, bool ALIGN_EPI = false, bool SP2 = false>
__device__ __forceinline__ void gemm_phase(PG8_LAS unsigned char* lds, const Gemm g, const Sched& S, const Epi& E, const int tid) {
    const int wid = __builtin_amdgcn_readfirstlane(tid >> 6), lane = tid & 63, wr = wid >> 2, wc = wid & 3, fr = lane & 15, fq = lane >> 4;
    const int K = g.K, nt = K / BK;
    unsigned voffA[2], voffB[2];
#pragma unroll
    for (int i = 0; i < 2; ++i) { int R, C; stage_rc(tid * 16 + i * 8192, R, C); const int Rb = Epi::PERM ? ((R & ~31) + perm32(R & 31)) : R;
        voffA[i] = (unsigned)(R * K + C) * 2u; voffB[i] = (unsigned)(Rb * K + C) * 2u; }
    const size_t kstep = (size_t)(BK * 2);
    const size_t hstep = (size_t)HALF * K * 2;
    const size_t tstep = 2 * hstep;
    const unsigned ldsw = (unsigned)wid * 1024u;
    const int aoff = lds_byte(wr * 64 + fr, fq * 8), boff = lds_byte(wc * 32 + fr, fq * 8);
#define PG8_SA(b, h) (((b) * 2 + (h)) * HTB)
#define PG8_SB(b, h) ((4 + (b) * 2 + (h)) * HTB)
#define PG8_STAGE(bufoff, gbase, voff) do { _Pragma("unroll") for (int _i = 0; _i < 2; ++_i) \
        __builtin_amdgcn_global_load_lds((const unsigned*)((const char*)(gbase) + (voff)[_i]), (PG8_LAS unsigned*)(lds + (bufoff) + ldsw + _i * 8192), 16, 0, 0); } while (0)
#define PG8_LDA(dst, b, h) do { _Pragma("unroll") for (int m = 0; m < 4; ++m) _Pragma("unroll") for (int k = 0; k < 2; ++k) dst[m][k] = *(const PG8_LAS bf16x8*)(lds + PG8_SA(b, h) + aoff + m * 2048 + k * 1024); } while (0)
#define PG8_LDB(dst, b, h) do { _Pragma("unroll") for (int n = 0; n < 2; ++n) _Pragma("unroll") for (int k = 0; k < 2; ++k) dst[n][k] = *(const PG8_LAS bf16x8*)(lds + PG8_SB(b, h) + boff + n * 2048 + k * 1024); } while (0)
#define PG8_MMA(ai, bj, At, Bt) do { __builtin_amdgcn_s_setprio(1); _Pragma("unroll") for (int m = 0; m < 4; ++m) _Pragma("unroll") for (int n = 0; n < 2; ++n) _Pragma("unroll") for (int k = 0; k < 2; ++k) \
        acc[ai][bj][m][n] = __builtin_amdgcn_mfma_f32_16x16x32_bf16(Bt[n][k], At[m][k], acc[ai][bj][m][n], 0, 0, 0); __builtin_amdgcn_s_setprio(0); } while (0)
#define PG8_WAIT_V(n) asm volatile("s_waitcnt vmcnt(" #n ")" ::: "memory")
#define PG8_WAIT_L(n) asm volatile("s_waitcnt lgkmcnt(" #n ")" ::: "memory")
#define PG8_BAR __builtin_amdgcn_s_barrier()
#define PG8_SCHED __builtin_amdgcn_sched_barrier(0)
    Unit cur, nxt; int ui = 0;
    if (!S.next(0, cur)) return;
    f32x4 acc[2][2][4][2];
#pragma unroll
    for (int a = 0; a < 2; ++a)
#pragma unroll
        for (int b = 0; b < 2; ++b)
#pragma unroll
            for (int m = 0; m < 4; ++m)
#pragma unroll
                for (int n = 0; n < 2; ++n) acc[a][b][m][n] = (f32x4){0.f, 0.f, 0.f, 0.f};
    bf16x8 At[4][2], B0[2][2], B1[2][2];
    const char* cA = (const char*)g.A + (size_t)cur.pm * tstep; const char* cB = (const char*)g.Bt + (size_t)cur.pn * tstep;
    S.a_ready(cur);
    if constexpr (SP2) {
        PG8_STAGE(PG8_SB(0, 0), cB, voffB); PG8_STAGE(PG8_SB(0, 1), cB + hstep, voffB); PG8_STAGE(PG8_SA(0, 0), cA, voffA); PG8_STAGE(PG8_SA(0, 1), cA + hstep, voffA);
        if (wr == 1) PG8_BAR;
        PG8_WAIT_V(2); PG8_BAR;
        PG8_STAGE(PG8_SB(1, 0), cB + kstep, voffB); PG8_STAGE(PG8_SA(1, 0), cA + kstep, voffA); PG8_STAGE(PG8_SB(1, 1), cB + hstep + kstep, voffB);
        PG8_WAIT_V(6); PG8_BAR;
    } else {
        PG8_STAGE(PG8_SB(0, 0), cB, voffB); PG8_STAGE(PG8_SA(0, 0), cA, voffA); PG8_STAGE(PG8_SB(0, 1), cB + hstep, voffB); PG8_STAGE(PG8_SA(0, 1), cA + hstep, voffA);
        if (wr == 1) PG8_BAR;
        PG8_WAIT_V(4); PG8_BAR;
        PG8_STAGE(PG8_SB(1, 0), cB + kstep, voffB); PG8_STAGE(PG8_SA(1, 0), cA + kstep, voffA); PG8_STAGE(PG8_SB(1, 1), cB + hstep + kstep, voffB);
        PG8_WAIT_V(6); PG8_BAR;
    }
    for (;;) {
        const bool has_next = S.next(ui + 1, nxt);
        const char* nA = has_next ? (const char*)g.A + (size_t)nxt.pm * tstep : cA; const char* nB = has_next ? (const char*)g.Bt + (size_t)nxt.pn * tstep : cB;
        for (int t = 0; t < nt; t += 2) {
            const bool last = (t == nt - 2);
            const char* a1 = cA + (size_t)(t + 1) * kstep;
            const char* a2 = last ? nA : cA + (size_t)(t + 2) * kstep; const char* b2 = last ? nB : cB + (size_t)(t + 2) * kstep;
            const char* a3 = a2 + kstep; const char* b3 = b2 + kstep;
            if (last && has_next) S.a_ready(nxt);
            if constexpr (SP2) {
            PG8_LDB(B0, 0, 0); PG8_LDB(B1, 0, 1); PG8_SCHED; PG8_LDA(At, 0, 0); PG8_STAGE(PG8_SA(1, 1), a1 + hstep, voffA);
            PG8_WAIT_V(8); PG8_WAIT_L(0); PG8_BAR; PG8_MMA(0, 0, At, B0); PG8_MMA(0, 1, At, B1); PG8_BAR; PG8_SCHED;
            PG8_LDA(At, 0, 1); PG8_STAGE(PG8_SB(0, 0), b2, voffB); PG8_STAGE(PG8_SB(0, 1), b2 + hstep, voffB); PG8_STAGE(PG8_SA(0, 0), a2, voffA);
            PG8_WAIT_V(8); PG8_WAIT_L(0); PG8_BAR; PG8_MMA(1, 0, At, B0); PG8_MMA(1, 1, At, B1); PG8_BAR; PG8_SCHED;
            PG8_LDB(B0, 1, 0); PG8_LDB(B1, 1, 1); PG8_SCHED; PG8_LDA(At, 1, 0); PG8_STAGE(PG8_SA(0, 1), a2 + hstep, voffA);
            PG8_WAIT_V(8); PG8_WAIT_L(0); PG8_BAR; PG8_MMA(0, 0, At, B0); PG8_MMA(0, 1, At, B1); PG8_BAR; PG8_SCHED;
            PG8_LDA(At, 1, 1); PG8_STAGE(PG8_SB(1, 0), b3, voffB); PG8_STAGE(PG8_SB(1, 1), b3 + hstep, voffB); PG8_STAGE(PG8_SA(1, 0), a3, voffA);
            PG8_WAIT_V(8); PG8_WAIT_L(0); PG8_BAR; PG8_MMA(1, 0, At, B0); PG8_MMA(1, 1, At, B1); PG8_BAR; PG8_SCHED;
            } else {
            PG8_LDB(B0, 0, 0); PG8_SCHED; PG8_LDA(At, 0, 0); PG8_STAGE(PG8_SA(1, 1), a1 + hstep, voffA);
            PG8_WAIT_L(8); PG8_BAR; PG8_WAIT_L(0); PG8_MMA(0, 0, At, B0); PG8_BAR; PG8_SCHED;
            PG8_LDB(B1, 0, 1); PG8_STAGE(PG8_SB(0, 0), b2, voffB);
            PG8_BAR; PG8_WAIT_L(0); PG8_MMA(0, 1, At, B1); PG8_BAR;
            PG8_LDA(At, 0, 1); PG8_STAGE(PG8_SA(0, 0), a2, voffA);
            PG8_BAR; PG8_WAIT_L(0); PG8_MMA(1, 0, At, B0); PG8_BAR; PG8_SCHED;
            PG8_STAGE(PG8_SB(0, 1), b2 + hstep, voffB);
            PG8_WAIT_V(6); PG8_BAR; PG8_MMA(1, 1, At, B1); PG8_BAR;
            PG8_LDB(B0, 1, 0); PG8_SCHED; PG8_LDA(At, 1, 0); PG8_STAGE(PG8_SA(0, 1), a2 + hstep, voffA);
            PG8_WAIT_L(8); PG8_BAR; PG8_WAIT_L(0); PG8_MMA(0, 0, At, B0); PG8_BAR; PG8_SCHED;
            PG8_LDB(B1, 1, 1); PG8_STAGE(PG8_SB(1, 0), b3, voffB);
            PG8_BAR; PG8_WAIT_L(0); PG8_MMA(0, 1, At, B1); PG8_BAR;
            PG8_LDA(At, 1, 1); PG8_STAGE(PG8_SA(1, 0), a3, voffA);
            PG8_BAR; PG8_WAIT_L(0); PG8_MMA(1, 0, At, B0); PG8_BAR; PG8_SCHED;
            PG8_STAGE(PG8_SB(1, 1), b3 + hstep, voffB);
            PG8_WAIT_V(6); PG8_BAR; PG8_MMA(1, 1, At, B1); PG8_BAR;
            }
        }
        if constexpr (ALIGN_EPI) { if (wr == 0) PG8_BAR; }
        if constexpr (!Epi::AFTER_DRAIN) { E(acc, cur, wr, wc, fr, fq); S.done(cur); }
        if (!has_next) break;
#pragma unroll
        for (int a = 0; a < 2; ++a)
#pragma unroll
            for (int b = 0; b < 2; ++b)
#pragma unroll
                for (int m = 0; m < 4; ++m)
#pragma unroll
                    for (int n = 0; n < 2; ++n) acc[a][b][m][n] = (f32x4){0.f, 0.f, 0.f, 0.f};
        cur = nxt; cA = nA; cB = nB; ++ui;
        if constexpr (ALIGN_EPI) { if (wr == 1) PG8_BAR; }
    }
    PG8_WAIT_V(0);
    if constexpr (!ALIGN_EPI) { if (wr == 0) PG8_BAR; }
    PG8_BAR;
    if constexpr (Epi::AFTER_DRAIN) { E.fused(acc, cur, wr, wc, fr, fq, lds, wid, lane); S.done(cur); }
#undef PG8_SA
#undef PG8_SB
#undef PG8_STAGE
#undef PG8_LDA
#undef PG8_LDB
#undef PG8_MMA
#undef PG8_WAIT_V
#undef PG8_WAIT_L
#undef PG8_BAR
#undef PG8_SCHED
}
}

constexpr int TP = 8192, TS = 512, T = TP + TS, DM = 2048, NSEQ = 132;
constexpr int NAB = 7424, NCD = 4864;
constexpr int NWAVES = 8, NTHR = 512;
constexpr size_t MiB = 1u << 20;
constexpr size_t WS_CTL = 0, CTL_ZERO_BYTES = 1 * MiB;
constexpr int CW_BAR = 4096, CW_CNT = 8192;
constexpr size_t WS_RSS = 65536;
constexpr size_t WS_WABIN = 2 * MiB, WS_WABOUT = 60 * MiB, WS_WCDIN = 76 * MiB, WS_WCDOUT = 114 * MiB, WS_WGATE = 130 * MiB, WS_WPROJ = 162 * MiB;
constexpr size_t WS_H = 166 * MiB, WS_XN = 234 * MiB, WS_YM = 268 * MiB, WS_PB = 302 * MiB, WS_U = 320 * MiB, WS_SCR = 444 * MiB, WS_END = 732 * MiB;
constexpr size_t SC_HB1 = 102 * MiB;
constexpr size_t SC_PP = 8 * MiB;
constexpr size_t SC_QN = 0, SC_KN = 2 * MiB, SC_VV = 4 * MiB, SC_GLOG = 6 * MiB, SC_BETA = 7 * MiB, SC_GDEC = 7 * MiB + 65536, SC_ODN = 102 * MiB, SC_OGLA = 136 * MiB,
    SC_DNOPS = 192 * MiB, SC_DNGEND = 264 * MiB;
constexpr size_t SC_XBC = 0, SC_DT = 3 * MiB, SC_LA = 52 * MiB, SC_LB = 86 * MiB, SC_YS = 120 * MiB, SC_HS = 154 * MiB, SC_SSDOP = 192 * MiB, SC_GEND = 256 * MiB, SC_XS = 270 * MiB;
constexpr int LDS_BYTES = 163840;
constexpr size_t O_Y_P = 0, O_Y_S = O_Y_P + (size_t)4 * 2048 * 2048, O_DN_P = O_Y_S + (size_t)128 * 4 * 2048,
    O_DNC_P = O_DN_P + (size_t)2 * 4 * 8 * 128 * 128, O_GLA_P = O_DNC_P + (size_t)2 * 4 * 3 * 3072, O_SSD_P = O_GLA_P + (size_t)2 * 4 * 4 * 128 * 256,
    O_SSDC_P = O_SSD_P + (size_t)2 * 4 * 16 * 64 * 64, O_LRU_P = O_SSDC_P + (size_t)2 * 4 * 3 * 1536, O_LRUC_P = O_LRU_P + (size_t)2 * 4 * 1024,
    O_DN_S = O_LRUC_P + (size_t)2 * 4 * 3 * 1024, O_DNC_S = O_DN_S + (size_t)2 * 128 * 8 * 128 * 128, O_GLA_S = O_DNC_S + (size_t)2 * 128 * 3 * 3072,
    O_SSD_S = O_GLA_S + (size_t)2 * 128 * 4 * 128 * 256, O_SSDC_S = O_SSD_S + (size_t)2 * 128 * 16 * 64 * 64, O_LRU_S = O_SSDC_S + (size_t)2 * 128 * 3 * 1536,
    O_LRUC_S = O_LRU_S + (size_t)2 * 128 * 1024, O_END = O_LRUC_S + (size_t)2 * 128 * 3 * 1024;
static_assert(O_END == 109064192, "output size");

#define LAS __attribute__((address_space(3)))
typedef unsigned short bf16;
typedef float f32x4 __attribute__((ext_vector_type(4)));
typedef unsigned u32x2 __attribute__((ext_vector_type(2)));
typedef unsigned u32x4 __attribute__((ext_vector_type(4)));
#define LDS_WAIT() asm volatile("s_waitcnt lgkmcnt(0)" ::: "memory")

__device__ __forceinline__ float bf2f(bf16 b) { return __uint_as_float(((unsigned)b) << 16); }
__device__ __forceinline__ unsigned f2bf(float f) { unsigned u = __float_as_uint(f); return (u + 0x7fffu + ((u >> 16) & 1u)) >> 16; }
__device__ __forceinline__ unsigned pk2(float lo, float hi) { return f2bf(lo) | (f2bf(hi) << 16); }
__device__ __forceinline__ float sigmoid_(float x) { return 1.f / (1.f + expf(-x)); }
__device__ __forceinline__ float silu_(float x) { return x / (1.f + expf(-x)); }
__device__ __forceinline__ float softplus_(float x) { return x > 20.f ? x : log1pf(expf(x)); }
__device__ __forceinline__ float wave_sum(float v) {
#pragma unroll
    for (int o = 1; o < 64; o <<= 1) v += __shfl_xor(v, o);
    return v;
}
__device__ __forceinline__ void row_to_seq(int r, int& s, int& t) { if (r < TP) { s = r >> 11; t = r & 2047; } else { s = 4 + ((r - TP) >> 2); t = (r - TP) & 3; } }
__device__ __forceinline__ void seq_info(int s, int& row0, int& L) { if (s < 4) { row0 = s << 11; L = 2048; } else { row0 = TP + ((s - 4) << 2); L = 4; } }
__device__ __forceinline__ float pre_val(const bf16* U, int ldu, int ucol, int row0, int tt, int s, const float* stc, int W, int c) {
    if (tt >= 0) return bf2f(U[(size_t)(row0 + tt) * ldu + ucol]);
    if (s < 4) return 0.f;
    return stc[((size_t)(s - 4) * 3 + (3 + tt)) * W + c];
}
__device__ __forceinline__ int map_col(int mapid, int n) {
    if (mapid == 0) return n;
    if (mapid == 1) { if (n < 3072) return n; if (n < 6144) return n + 16; if (n < 7168) return n + 32; if (n < 7184) return n - 4096; if (n < 7200) return n - 1024; return -1; }
    if (n < 2560) return n; if (n < 4608) return n + 16; if (n < 4624) return n - 2048; return -1;
}
__device__ __forceinline__ void transpose_item(const float* W, int K, int Nsrc, bf16* WT, int Npad, int mapid, const float* gain, LAS float* scr, int item, int lane) {
    const int nblk = Npad / 64, kb = item / nblk, nb = item % nblk, k0 = 64 * kb, n0 = 64 * nb;
    const int n4 = (lane & 15) * 4, src = map_col(mapid, n0 + n4);
#pragma unroll 8
    for (int i = 0; i < 16; ++i) { const int kk = 4 * i + (lane >> 4);
        f32x4 v = (f32x4){0.f, 0.f, 0.f, 0.f};
        if (src >= 0) { v = *(const f32x4*)(W + (size_t)(k0 + kk) * Nsrc + src); if (gain) v = v * gain[k0 + kk]; }
        scr[kk * 65 + n4] = v.x; scr[kk * 65 + n4 + 1] = v.y; scr[kk * 65 + n4 + 2] = v.z; scr[kk * 65 + n4 + 3] = v.w; }
    LDS_WAIT(); asm volatile("" ::: "memory");
    const int c = lane & 7;
#pragma unroll
    for (int jj = 0; jj < 8; ++jj) { const int n = (lane >> 3) + 8 * jj; const LAS float* p = scr + (8 * c) * 65 + n;
        u32x4 o; o.x = pk2(p[0 * 65], p[1 * 65]); o.y = pk2(p[2 * 65], p[3 * 65]); o.z = pk2(p[4 * 65], p[5 * 65]); o.w = pk2(p[6 * 65], p[7 * 65]);
        *(u32x4*)(WT + (size_t)(n0 + n) * K + k0 + 8 * c) = o; }
    LDS_WAIT(); asm volatile("" ::: "memory");
}
__device__ __forceinline__ void norm_row_bf16(const f32x4 (&v)[8], const float* g, bf16* orow, int lane) {
    float ss = 0.f;
#pragma unroll
    for (int j = 0; j < 8; ++j) ss += (v[j].x * v[j].x + v[j].y * v[j].y) + (v[j].z * v[j].z + v[j].w * v[j].w);
    const float rstd = rsqrtf(wave_sum(ss) * (1.f / DM) + 1e-6f);
#pragma unroll
    for (int j = 0; j < 8; ++j) { const int col = 4 * (lane + 64 * j); const f32x4 gg = *(const f32x4*)(g + col);
        u32x2 o; o.x = pk2(v[j].x * rstd * gg.x, v[j].y * rstd * gg.y); o.y = pk2(v[j].z * rstd * gg.z, v[j].w * rstd * gg.w);
        *(u32x2*)(orow + col) = o; }
}

typedef __bf16 bf16x2_t __attribute__((ext_vector_type(2)));
typedef float f32x2_t __attribute__((ext_vector_type(2)));
typedef short bf16x8 __attribute__((ext_vector_type(8)));
typedef float f32x16 __attribute__((ext_vector_type(16)));
__device__ __forceinline__ unsigned cvtpk(float lo, float hi) { f32x2_t v = {lo, hi}; bf16x2_t b = __builtin_convertvector(v, bf16x2_t); return __builtin_bit_cast(unsigned, b); }
#define MFMA32(a, b, c) __builtin_amdgcn_mfma_f32_32x32x16_bf16((a), (b), (c), 0, 0, 0)
#define PACK_ACC(x, S_) __builtin_bit_cast(bf16x8, (u32x4){cvtpk((x)[8 * (S_)], (x)[8 * (S_) + 1]), cvtpk((x)[8 * (S_) + 2], (x)[8 * (S_) + 3]), cvtpk((x)[8 * (S_) + 4], (x)[8 * (S_) + 5]), cvtpk((x)[8 * (S_) + 6], (x)[8 * (S_) + 7])})
__device__ __forceinline__ int crow(int reg, int h) { return (reg & 3) + 8 * (reg >> 2) + 4 * h; }
__device__ __forceinline__ bf16x8 pack8(const float (&v)[8]) { return __builtin_bit_cast(bf16x8, (u32x4){cvtpk(v[0], v[1]), cvtpk(v[2], v[3]), cvtpk(v[4], v[5]), cvtpk(v[6], v[7])}); }

#define XB_TMO      128
#define XB_XCNT(j)  (256  + 64 * (j))
#define XB_XSUB(j)  (1280 + 64 * (j))
#define XB_XGEN(j)  (2304 + 64 * (j))
#define XB_TOP      3328
#define XB_TOPGEN   3392
#define XCD_BAR_WORDS 3456
#define XB_SPIN_CAP (1u << 18)

__device__ __forceinline__ unsigned xb_ld(unsigned* p)              { return __hip_atomic_load(p, __ATOMIC_RELAXED, __HIP_MEMORY_SCOPE_AGENT); }
__device__ __forceinline__ unsigned xb_add(unsigned* p, unsigned v) { return __hip_atomic_fetch_add(p, v, __ATOMIC_RELAXED, __HIP_MEMORY_SCOPE_AGENT); }
__device__ __forceinline__ unsigned xb_xcc_id() { return (unsigned)__builtin_amdgcn_s_getreg((3 << 11) | 20) & 0xFu; }
#define XB_SPIN(cond, bar) do { unsigned _sp = 0; while (cond) { __builtin_amdgcn_s_sleep(1); \
    if ((++_sp & 255u) == 0u) { if (xb_ld(&(bar)[XB_TMO])) break; if (_sp > XB_SPIN_CAP) { atomicAdd(&(bar)[XB_TMO], 1u); break; } } } } while (0)

struct XcdBarrier {
    unsigned* bar; unsigned x;
    volatile LAS unsigned* st;
};

__device__ __forceinline__ XcdBarrier xcd_barrier_post(unsigned* bar, volatile LAS unsigned* st) {
    XcdBarrier b; b.bar = bar; b.x = xb_xcc_id(); b.st = st;
    if (threadIdx.x == 0) (void)xb_add(&bar[XB_XCNT(b.x)], 1u);
    return b;
}
__device__ __forceinline__ void xcd_barrier_complete(unsigned* bar, unsigned x, unsigned& nloc, unsigned& nx) {
    const unsigned G = gridDim.x * gridDim.y * gridDim.z;
    unsigned sum, cnt, mine, sp = 0u;
    for (;;) {
        sum = 0u; cnt = 0u; mine = 0u;
#pragma unroll
        for (unsigned j = 0; j < 16; ++j) { const unsigned c = xb_ld(&bar[XB_XCNT(j)]); sum += c; cnt += (c > 0u) ? 1u : 0u; mine = (j == x) ? c : mine; }
        if (sum == G) break;
        __builtin_amdgcn_s_sleep(1);
        if ((++sp & 255u) == 0u) { if (xb_ld(&bar[XB_TMO])) break; if (sp > XB_SPIN_CAP) { atomicAdd(&bar[XB_TMO], 1u); break; } }
    }
    nloc = mine > 0u ? mine : 1u; nx = cnt > 0u ? cnt : 1u;
}

__device__ __forceinline__ void xcd_barrier(const XcdBarrier& b) {
    asm volatile("s_waitcnt vmcnt(0)" ::: "memory");
    __syncthreads();
    if (threadIdx.x == 0) {
        unsigned* bar = b.bar;
        __builtin_amdgcn_s_waitcnt(0);
        unsigned nloc = b.st[0], nx = b.st[1];
        if (nloc == 0u) { xcd_barrier_complete(bar, b.x, nloc, nx); b.st[0] = nloc; b.st[1] = nx; }
        const unsigned old = xb_add(&bar[XB_XSUB(b.x)], 1u);
        const unsigned gen = old / nloc;
        if (old + 1u == (gen + 1u) * nloc) {
            __builtin_amdgcn_fence(__ATOMIC_RELEASE, "agent");
            asm volatile("s_waitcnt vmcnt(0)" ::: "memory");
            const unsigned og = xb_add(&bar[XB_TOP], 1u);
            const unsigned tg = og / nx;
            if (og + 1u == (tg + 1u) * nx) xb_add(&bar[XB_TOPGEN], 1u);
            else XB_SPIN(xb_ld(&bar[XB_TOPGEN]) == tg, bar);
            __builtin_amdgcn_fence(__ATOMIC_ACQUIRE, "agent");
            xb_add(&bar[XB_XGEN(b.x)], 1u);
            asm volatile("s_waitcnt vmcnt(0)" ::: "memory");
        } else {
            XB_SPIN(xb_ld(&bar[XB_XGEN(b.x)]) == gen, bar);
            __builtin_amdgcn_fence(__ATOMIC_ACQUIRE, "agent");
            asm volatile("s_waitcnt vmcnt(0)" ::: "memory");
        }
    }
    __syncthreads();
}


struct Args { const float* in[40]; float* out; unsigned char* ws; int ph_lo, ph_hi; };
constexpr int N_PHASES = 26, SUBS = 6;
#ifndef PH_MASK
#define PH_MASK 16383
#endif
#define AS4 __attribute__((address_space(4)))
struct KP { const char AS4* p;
    __device__ __forceinline__ const float* in(int i) const { return *(const float* const AS4*)(p + 8 * i); }
    __device__ __forceinline__ float* out() const { return *(float* const AS4*)(p + 320); }
    __device__ __forceinline__ unsigned char* ws() const { return *(unsigned char* const AS4*)(p + 328); }
};
static_assert(sizeof(Args) == 344, "Args layout");

__device__ __forceinline__ void phase_prologue(const KP kp, LAS unsigned char* lds, int gw, int NGW, int wave, int lane) {
    unsigned char* ws = kp.ws();
    LAS float* scr = (LAS float*)(lds + wave * 17408);
    for (int job = 0; job < 16; ++job) {
        const float* W; int K = 2048, Nsrc = 2048, Npad = 2048, mapid = 0; bf16* WT; const float* gain = nullptr;
        if (job < 2)       { W = kp.in(13) + (size_t)job * 2048 * 7200; Nsrc = 7200; Npad = NAB; mapid = 1; WT = (bf16*)(ws + WS_WABIN) + (size_t)job * NAB * 2048; gain = kp.in(11) + (size_t)(2 * job) * DM; }
        else if (job < 4)  { W = kp.in(21) + (size_t)(job - 2) * 2048 * 2048; WT = (bf16*)(ws + WS_WABOUT) + (size_t)(job - 2) * 2048 * 2048; }
        else if (job < 6)  { W = kp.in(22) + (size_t)(job - 4) * 2048 * 4624; Nsrc = 4624; Npad = NCD; mapid = 2; WT = (bf16*)(ws + WS_WCDIN) + (size_t)(job - 4) * NCD * 2048; gain = kp.in(11) + (size_t)(2 * (job - 4) + 1) * DM; }
        else if (job < 8)  { W = kp.in(36) + (size_t)(job - 6) * 2048 * 2048; WT = (bf16*)(ws + WS_WCDOUT) + (size_t)(job - 6) * 2048 * 2048; }
        else if (job < 12) { W = kp.in(39) + (size_t)(job - 8) * 2048 * 2048; WT = (bf16*)(ws + WS_WGATE) + (size_t)(job - 8) * 2048 * 2048; gain = kp.in(38) + (size_t)(job - 8) * DM; }
        else               { W = kp.in(37) + (size_t)(job - 12) * 256 * 2048; K = 256; WT = (bf16*)(ws + WS_WPROJ) + (size_t)(job - 12) * 2048 * 256; }
        const int nitems = (K / 64) * (Npad / 64);
        for (int it = gw; it < nitems; it += NGW) transpose_item(W, K, Nsrc, WT, Npad, mapid, gain, scr, it, lane);
    }
    bf16* HB = (bf16*)(ws + WS_XN); float* RSS = (float*)(ws + WS_RSS);
    for (int m = gw; m < T; m += NGW) {
        const float* src = m < TP ? kp.in(0) + (size_t)m * DM : kp.in(1) + (size_t)(m - TP) * DM;
        float ss = 0.f;
#pragma unroll
        for (int jj = 0; jj < 8; ++jj) { const int col = 4 * (lane + 64 * jj); const f32x4 v = *(const f32x4*)(src + col);
            u32x2 o; o.x = pk2(v.x, v.y); o.y = pk2(v.z, v.w); *(u32x2*)(HB + (size_t)m * DM + col) = o; ss += (v.x * v.x + v.y * v.y) + (v.z * v.z + v.w * v.w); }
        ss = wave_sum(ss); if (lane == 0) RSS[m] = ss;
    }
    bf16* PB = (bf16*)(ws + WS_PB);
    const int gt = gw * 64 + lane, NGT = NGW * 64;
    for (int i = gt; i < 4 * T * 64; i += NGT) {
        const int c4 = i & 63, rr = i >> 6, li = rr / T, r = rr - li * T;
        const float* src = r < TP ? kp.in(9) + ((size_t)li * TP + r) * 256 + 4 * c4 : kp.in(10) + ((size_t)li * TS + (r - TP)) * 256 + 4 * c4;
        const f32x4 v = *(const f32x4*)src;
        u32x2 o; o.x = pk2(v.x, v.y); o.y = pk2(v.z, v.w);
        *(u32x2*)(PB + ((size_t)li * T + r) * 256 + 4 * c4) = o;
    }
}
__device__ __forceinline__ void phase_final(const KP kp, int gw, int NGW, int lane) {
    const bf16* HB = (const bf16*)(kp.ws() + WS_XN); const float* RSS = (const float*)(kp.ws() + WS_RSS) + (size_t)8 * T; const float* g = kp.in(12); float* out = kp.out();
    for (int m = gw; m < T; m += NGW) { const float rstd = rsqrtf(RSS[m] * (1.f / DM) + 1e-6f);
#pragma unroll
        for (int jj = 0; jj < 8; ++jj) { const int col = 4 * (lane + 64 * jj); const u32x2 hv = *(const u32x2*)(HB + (size_t)m * DM + col); const f32x4 gg = *(const f32x4*)(g + col);
            f32x4 o; o.x = __uint_as_float(hv.x << 16) * rstd * gg.x; o.y = __uint_as_float(hv.x & 0xffff0000u) * rstd * gg.y; o.z = __uint_as_float(hv.y << 16) * rstd * gg.z; o.w = __uint_as_float(hv.y & 0xffff0000u) * rstd * gg.w;
            *(f32x4*)(out + (size_t)m * DM + col) = o; } }
}

__device__ __forceinline__ void phase_ab_pre(const KP kp, const int bid, const int G, int j, int tid, int wave, int lane) {
    unsigned char* scr = kp.ws() + WS_SCR; const bf16* U = (const bf16*)(kp.ws() + WS_U);
    float* QN = (float*)(scr + SC_QN) - (size_t)TP * 1024; float* KN = (float*)(scr + SC_KN) - (size_t)TP * 1024; float* VV = (float*)(scr + SC_VV) - (size_t)TP * 1024;
    float* GLOG = (float*)(scr + SC_GLOG) - (size_t)TP * 512; float* BETA = (float*)(scr + SC_BETA) - (size_t)TP * 8; float* GDEC = (float*)(scr + SC_GDEC) - (size_t)TP * 8;
    const float* cw = kp.in(14) + (size_t)j * 4 * 3072; const float* stc = kp.in(3) + (size_t)j * 128 * 3 * 3072;
    const float* wa2 = kp.in(18) + (size_t)j * 16 * 512; const float* ba = kp.in(19) + (size_t)j * 512;
    for (int r = TP + bid; r < T; r += G) {
        int s, t; row_to_seq(r, s, t); const int row0 = r - t;
#pragma unroll
        for (int part = 0; part < 3; ++part) {
            float val[2];
#pragma unroll
            for (int i = 0; i < 2; ++i) { const int c = part * 1024 + wave * 128 + lane + 64 * i; float acc = 0.f;
#pragma unroll
                for (int tap = 0; tap < 4; ++tap) acc += cw[tap * 3072 + c] * pre_val(U, NAB, c, row0, t - 3 + tap, s, stc, 3072, c);
                val[i] = silu_(acc); }
            if (part < 2) { const float ss = wave_sum(val[0] * val[0] + val[1] * val[1]); const float sc = rsqrtf(ss + 1e-6f) * (part == 0 ? 0.08838834764831845f : 1.f); val[0] *= sc; val[1] *= sc; }
            float* dst = part == 0 ? QN : (part == 1 ? KN : VV);
            dst[(size_t)r * 1024 + wave * 128 + lane] = val[0]; dst[(size_t)r * 1024 + wave * 128 + lane + 64] = val[1];
        }
        if (tid < 8) {
            BETA[(size_t)r * 8 + tid] = sigmoid_(bf2f(U[(size_t)r * NAB + 7168 + tid]));
            GDEC[(size_t)r * 8 + tid] = -expf(kp.in(15)[j * 8 + tid]) * softplus_(bf2f(U[(size_t)r * NAB + 7176 + tid]) + kp.in(16)[j * 8 + tid]);
        }
        { float x = ba[tid];
#pragma unroll
          for (int rr = 0; rr < 16; ++rr) x += bf2f(U[(size_t)r * NAB + 7184 + rr]) * wa2[rr * 512 + tid];
          GLOG[(size_t)r * 512 + tid] = -softplus_(-x) * (1.f / 16.f); }
    }
}


constexpr size_t GLA_ITEM_BYTES = 74752, WS_GLAOPS = WS_H;
__device__ __forceinline__ void phase_gla_prep(const KP kp, const int bid, const int G, int j, LAS unsigned char* lds, int tid) {
    const bf16* U = (const bf16*)(kp.ws() + WS_U);
    const float* wa2 = kp.in(18) + (size_t)j * 16 * 512; const float* ba = kp.in(19) + (size_t)j * 512;
    unsigned char* OPS = kp.ws() + WS_GLAOPS;
    LAS float* GL = (LAS float*)lds; LAS float* QL = GL + 64 * 129; LAS float* KL = QL + 64 * 129; LAS float* AL = KL + 64 * 129;
    const int lane = tid & 63, r = lane & 31, hp = lane >> 5;
    for (int item = bid; item < 512; item += G) {
        const int b = item >> 7, n = (item >> 2) & 31, h = item & 3;
        const int row0 = b * 2048 + n * 64;
        __syncthreads();
        for (int i = tid; i < 8192; i += NTHR) { const int t = i >> 7, d = i & 127; const size_t ro = (size_t)(row0 + t) * NAB;
            QL[t * 129 + d] = bf2f(U[ro + 4096 + h * 128 + d]) * 0.08838834764831845f; KL[t * 129 + d] = bf2f(U[ro + 4608 + h * 128 + d]);
            float x = ba[h * 128 + d];
#pragma unroll
            for (int rr = 0; rr < 16; ++rr) x += bf2f(U[ro + 7184 + rr]) * wa2[rr * 512 + h * 128 + d];
            GL[t * 129 + d] = -softplus_(-x) * (1.f / 16.f); }
        __syncthreads();
        if (tid < 128) { float acc = 0.f;
#pragma unroll 4
            for (int t = 0; t < 64; ++t) { acc += GL[t * 129 + tid]; GL[t * 129 + tid] = acc; } }
        __syncthreads();
        for (int i = tid; i < 8192; i += NTHR) { const int t = i >> 7, d = i & 127; const float gg = GL[t * 129 + d]; QL[t * 129 + d] *= expf(gg); KL[t * 129 + d] *= expf(-gg); }
        __syncthreads();
        { const int i = tid >> 3, jg = tid & 7; float acc[8];
#pragma unroll
          for (int jj = 0; jj < 8; ++jj) acc[jj] = 0.f;
#pragma unroll 4
          for (int d = 0; d < 128; ++d) { const float c = QL[i * 129 + d];
#pragma unroll
              for (int jj = 0; jj < 8; ++jj) acc[jj] += c * KL[(jg * 8 + jj) * 129 + d]; }
#pragma unroll
          for (int jj = 0; jj < 8; ++jj) AL[i * 65 + jg * 8 + jj] = (jg * 8 + jj) <= i ? acc[jj] : 0.f; }
        __syncthreads();
        bf16x8* base = (bf16x8*)(OPS + (size_t)item * GLA_ITEM_BYTES);
        float v[8];
#pragma unroll
        for (int q = 0; q < 2; ++q) { const int f = (tid >> 6) + 8 * q;
            { const int mt = f >> 3, ks = f & 7, i = 32 * mt + r;
#pragma unroll
              for (int jp = 0; jp < 8; ++jp) v[jp] = QL[i * 129 + 16 * ks + 8 * (jp >> 2) + 4 * hp + (jp & 3)];
              base[f * 64 + lane] = pack8(v); }
            { const int mt = f >> 2, ks = f & 3, d = 32 * mt + r; const float eg = expf(GL[63 * 129 + d]);
#pragma unroll
              for (int jp = 0; jp < 8; ++jp) v[jp] = KL[(16 * ks + 8 * (jp >> 2) + 4 * hp + (jp & 3)) * 129 + d] * eg;
              base[(16 + f) * 64 + lane] = pack8(v); } }
        { const int f = tid >> 6, mt = f >> 2, ks = f & 3, i = 32 * mt + r;
#pragma unroll
          for (int jp = 0; jp < 8; ++jp) v[jp] = AL[i * 65 + 16 * ks + 8 * (jp >> 2) + 4 * hp + (jp & 3)];
          base[(32 + f) * 64 + lane] = pack8(v); }
#pragma unroll
        for (int q = 0; q < 4; ++q) { const int f = (tid >> 6) + 8 * q, nt = f >> 2, ks = f & 3, p = 32 * nt + r;
            unsigned w[4];
#pragma unroll
            for (int jp = 0; jp < 8; jp += 2) { const int t0 = 16 * ks + 8 * (jp >> 2) + 4 * hp + (jp & 3);
                w[jp >> 1] = (unsigned)U[(size_t)(row0 + t0) * NAB + 5120 + h * 256 + p] | ((unsigned)U[(size_t)(row0 + t0 + 1) * NAB + 5120 + h * 256 + p] << 16); }
            base[(40 + f) * 64 + lane] = __builtin_bit_cast(bf16x8, (u32x4){w[0], w[1], w[2], w[3]}); }
        if (tid < 128) ((float*)(base + 72 * 64))[tid] = expf(GL[63 * 129 + tid]);
    }
}


constexpr size_t DN_ITEM_BYTES = 73728;
__device__ __forceinline__ void phase_dn_prep(const KP kp, const int bid, const int G, int j, LAS unsigned char* lds, int tid0) {
    unsigned char* scr = kp.ws() + WS_SCR;
    const bf16* U = (const bf16*)(kp.ws() + WS_U); const float* cw = kp.in(14) + (size_t)j * 4 * 3072;
    unsigned char* OPS = scr + SC_DNOPS; float* GENDD = (float*)(scr + SC_DNGEND);
    LAS float* AMT = (LAS float*)lds; LAS float* GLs = AMT + 64 * 68; LAS float* BLs = GLs + 64; LAS float* SCL = BLs + 64; LAS float* KL = SCL + 128; LAS float* QL = KL + 64 * 129; LAS float* XL = QL + 64 * 129;
    for (int item = bid; item < 1024; item += G) {
        int tid = tid0; asm volatile("" : "+v"(tid));
        const int lane = tid & 63, r = lane & 31, hp = lane >> 5, wave = tid >> 6;
        const int b = item >> 8, n = (item >> 3) & 31, h = item & 7;
        const int row0 = b * 2048 + n * 64;
        __syncthreads();
        { const int d = tid & 127, tg = tid >> 7, t0 = 16 * tg;
#pragma unroll
          for (int part = 0; part < 3; ++part) { const int c = part * 1024 + h * 128 + d;
              const float w0 = cw[c], w1 = cw[3072 + c], w2 = cw[2 * 3072 + c], w3 = cw[3 * 3072 + c];
              const bf16* up = U + (size_t)(row0 + t0) * NAB + c;
              const bool first = (n == 0 && tg == 0);
              float x0 = first ? 0.f : bf2f(up[-3 * (long)NAB]), x1 = first ? 0.f : bf2f(up[-2 * (long)NAB]), x2 = first ? 0.f : bf2f(up[-1 * (long)NAB]);
              LAS float* dst = part == 0 ? QL : (part == 1 ? KL : XL);
              const int dstr = part == 2 ? 257 : 129;
#pragma unroll 4
              for (int t = 0; t < 16; ++t) { const float x3 = bf2f(up[(size_t)t * NAB]); dst[(t0 + t) * dstr + d] = silu_(w0 * x0 + w1 * x1 + w2 * x2 + w3 * x3); x0 = x1; x1 = x2; x2 = x3; } } }
        if (wave == 0) { const size_t ro = (size_t)(row0 + lane) * NAB;
            float gv = -expf(kp.in(15)[j * 8 + h]) * softplus_(bf2f(U[ro + 7176 + h]) + kp.in(16)[j * 8 + h]);
#pragma unroll
            for (int o = 1; o < 64; o <<= 1) { const float tt = __shfl_up(gv, o); if (lane >= o) gv += tt; }
            GLs[lane] = gv; BLs[lane] = sigmoid_(bf2f(U[ro + 7168 + h])); }
        __syncthreads();
        if (tid < 128) { const int t = tid & 63, which = tid >> 6; const LAS float* src = which ? KL : QL; float ss = 0.f;
#pragma unroll 8
            for (int d = 0; d < 128; ++d) { const float x = src[t * 129 + d]; ss += x * x; }
            SCL[which * 64 + t] = rsqrtf(ss + 1e-6f) * (which ? 1.f : 0.08838834764831845f); }
        __syncthreads();
        { const int d = tid & 127, t0 = 16 * (tid >> 7);
#pragma unroll 4
          for (int t = 0; t < 16; ++t) { QL[(t0 + t) * 129 + d] *= SCL[t0 + t]; KL[(t0 + t) * 129 + d] *= SCL[64 + t0 + t]; } }
        __syncthreads();
        bf16x8* base = (bf16x8*)(OPS + (size_t)item * DN_ITEM_BYTES);
        { const int i = tid >> 3, ks = (tid >> 1) & 3, hk = tid & 1; float kk[8], qk[8];
#pragma unroll
          for (int jp = 0; jp < 8; ++jp) { kk[jp] = 0.f; qk[jp] = 0.f; }
#pragma unroll 2
          for (int d = 0; d < 128; ++d) { const float kc = KL[i * 129 + d], qc = QL[i * 129 + d];
#pragma unroll
              for (int jp = 0; jp < 8; ++jp) { const float kj = KL[(16 * ks + 8 * (jp >> 2) + 4 * hk + (jp & 3)) * 129 + d]; kk[jp] += kc * kj; qk[jp] += qc * kj; } }
          const float gi = GLs[i], bi = BLs[i]; float v[8];
#pragma unroll
          for (int jp = 0; jp < 8; ++jp) { const int jt = 16 * ks + 8 * (jp >> 2) + 4 * hk + (jp & 3); const float dec = expf(gi - GLs[jt]);
              AMT[jt * 68 + i] = jt < i ? bi * kk[jp] * dec : 0.f; v[jp] = jt <= i ? qk[jp] * dec : 0.f; }
          base[(48 + (i >> 5) * 4 + ks) * 64 + (i & 31) + 32 * hk] = pack8(v); }
        __syncthreads();
        if (tid < 256) {
            const int c = tid;
#pragma unroll
            for (int bi = 0; bi < 4; ++bi) {
                float acc[16];
#pragma unroll
                for (int ii = 0; ii < 16; ++ii) { const int i = 16 * bi + ii; const float be = BLs[i];
                    acc[ii] = c < 128 ? be * XL[i * 257 + c] : be * expf(GLs[i]) * KL[i * 129 + (c - 128)]; }
                for (int jj = 0; jj < 16 * bi; ++jj) { const float xj = XL[jj * 257 + c];
#pragma unroll
                    for (int q = 0; q < 4; ++q) { const f32x4 a = *(const LAS f32x4*)(AMT + jj * 68 + 16 * bi + 4 * q);
                        acc[4 * q + 0] -= a[0] * xj; acc[4 * q + 1] -= a[1] * xj; acc[4 * q + 2] -= a[2] * xj; acc[4 * q + 3] -= a[3] * xj; } }
#pragma unroll
                for (int ii = 0; ii < 16; ++ii) { float x = acc[ii];
#pragma unroll
                    for (int jj = 0; jj < ii; ++jj) x -= AMT[(16 * bi + jj) * 68 + 16 * bi + ii] * acc[jj];
                    acc[ii] = x; XL[(16 * bi + ii) * 257 + c] = x; }
            }
        }
        __syncthreads();
        float v[8];
#pragma unroll
        for (int q = 0; q < 2; ++q) { const int f = wave + 8 * q;
            { const int mt = f >> 3, ks = f & 7, i = 32 * mt + r;
#pragma unroll
              for (int jp = 0; jp < 8; ++jp) v[jp] = -XL[i * 257 + 128 + 16 * ks + 8 * (jp >> 2) + 4 * hp + (jp & 3)];
              base[f * 64 + lane] = pack8(v);
              const float eg = expf(GLs[i]);
#pragma unroll
              for (int jp = 0; jp < 8; ++jp) v[jp] = QL[i * 129 + 16 * ks + 8 * (jp >> 2) + 4 * hp + (jp & 3)] * eg;
              base[(16 + f) * 64 + lane] = pack8(v); }
            { const int mt = f >> 2, ks = f & 3, d = 32 * mt + r; const float Gend = GLs[63];
#pragma unroll
              for (int jp = 0; jp < 8; ++jp) { const int tk = 16 * ks + 8 * (jp >> 2) + 4 * hp + (jp & 3); v[jp] = KL[tk * 129 + d] * expf(Gend - GLs[tk]); }
              base[(32 + f) * 64 + lane] = pack8(v); }
            { const int pq = f & 1, tl = f >> 1, mt = tl >> 2, nt = tl & 3;
#pragma unroll
              for (int e = 0; e < 8; ++e) v[e] = XL[(32 * mt + crow(8 * pq + e, hp)) * 257 + 32 * nt + r];
              base[(56 + f) * 64 + lane] = pack8(v); } }
        if (tid == 0) GENDD[item] = expf(GLs[63]);
    }
}

__device__ __forceinline__ void phase_ab_rec(const KP kp, const int bid, const int G, int j, int li, LAS unsigned char* lds, int tid0) {
    unsigned char* scr = kp.ws() + WS_SCR; const bf16* U = (const bf16*)(kp.ws() + WS_U);
    float* ODN = (float*)(scr + SC_ODN); float* OGLA = (float*)(scr + SC_OGLA);
    for (int item = bid; item < 64; item += G) {
        int tid = tid0; asm volatile("" : "+v"(tid));
        int s, h; bool isdn; int half = -1;
        if (item < 32) { isdn = false; s = item >> 3; h = (item >> 1) & 3; half = item & 1; }
        else if (item < 64) { isdn = true; s = (item - 32) >> 3; h = (item - 32) & 7; half = -2; }
        else if (item < 1088) { isdn = true; s = 4 + ((item - 64) >> 3); h = (item - 64) & 7; }
        else { isdn = false; s = 4 + ((item - 1088) >> 2); h = (item - 1088) & 3; }
        int row0, L; seq_info(s, row0, L);
        __syncthreads();
        if (half == -2) {
            const int wave = __builtin_amdgcn_readfirstlane(tid >> 6), lane = tid & 63, r = lane & 31, hp = lane >> 5;
            const int b = s, nt = wave;
            const unsigned char* OPS = scr + SC_DNOPS; const float* GENDD = (const float*)(scr + SC_DNGEND);
            constexpr int DBUF = 72 * 1024;
#define DN_DMA(n_, bufi_) do { const unsigned char* gi_ = OPS + (size_t)((b * 32 + (n_)) * 8 + h) * DN_ITEM_BYTES + lane * 16; \
                _Pragma("unroll") for (int q_ = 0; q_ < 9; ++q_) { const int lf_ = wave + 8 * q_; \
                    __builtin_amdgcn_global_load_lds((const unsigned*)(gi_ + lf_ * 1024), (LAS unsigned*)(lds + (bufi_) * DBUF + lf_ * 1024), 16, 0, 0); } } while (0)
            f32x16 S0, S1, S2, S3;
#pragma unroll
            for (int i = 0; i < 16; ++i) { S0[i] = 0.f; S1[i] = 0.f; S2[i] = 0.f; S3[i] = 0.f; }
            DN_DMA(0, 0);
            asm volatile("s_waitcnt vmcnt(0)" ::: "memory"); __syncthreads();
            for (int n = 0; n < 32; ++n) {
                if (n + 1 < 32) DN_DMA(n + 1, (n + 1) & 1);
                if (wave < 4) {
                    const LAS bf16x8* F = (const LAS bf16x8*)(lds + (n & 1) * DBUF) + lane;
                    const float gend = GENDD[(b * 32 + n) * 8 + h];
                    const bf16x8 sb0 = PACK_ACC(S0, 0), sb1 = PACK_ACC(S0, 1), sb2 = PACK_ACC(S1, 0), sb3 = PACK_ACC(S1, 1), sb4 = PACK_ACC(S2, 0), sb5 = PACK_ACC(S2, 1), sb6 = PACK_ACC(S3, 0), sb7 = PACK_ACC(S3, 1);
                    f32x16 U0t, U1t;
                    { const bf16x8 a0 = F[(56 + nt * 2 + 0) * 64], a1 = F[(56 + nt * 2 + 1) * 64], c0 = F[(56 + (4 + nt) * 2 + 0) * 64], c1 = F[(56 + (4 + nt) * 2 + 1) * 64];
#pragma unroll
                      for (int e = 0; e < 8; ++e) { U0t[e] = bf2f((bf16)a0[e]); U0t[8 + e] = bf2f((bf16)a1[e]); U1t[e] = bf2f((bf16)c0[e]); U1t[8 + e] = bf2f((bf16)c1[e]); } }
                    U0t = MFMA32(F[0 * 64], sb0, U0t); U0t = MFMA32(F[1 * 64], sb1, U0t); U0t = MFMA32(F[2 * 64], sb2, U0t); U0t = MFMA32(F[3 * 64], sb3, U0t);
                    U0t = MFMA32(F[4 * 64], sb4, U0t); U0t = MFMA32(F[5 * 64], sb5, U0t); U0t = MFMA32(F[6 * 64], sb6, U0t); U0t = MFMA32(F[7 * 64], sb7, U0t);
                    U1t = MFMA32(F[8 * 64], sb0, U1t); U1t = MFMA32(F[9 * 64], sb1, U1t); U1t = MFMA32(F[10 * 64], sb2, U1t); U1t = MFMA32(F[11 * 64], sb3, U1t);
                    U1t = MFMA32(F[12 * 64], sb4, U1t); U1t = MFMA32(F[13 * 64], sb5, U1t); U1t = MFMA32(F[14 * 64], sb6, U1t); U1t = MFMA32(F[15 * 64], sb7, U1t);
                    const bf16x8 ub0 = PACK_ACC(U0t, 0), ub1 = PACK_ACC(U0t, 1), ub2 = PACK_ACC(U1t, 0), ub3 = PACK_ACC(U1t, 1);
                    f32x16 O0, O1;
#pragma unroll
                    for (int i = 0; i < 16; ++i) { O0[i] = 0.f; O1[i] = 0.f; }
                    O0 = MFMA32(F[16 * 64], sb0, O0); O0 = MFMA32(F[17 * 64], sb1, O0); O0 = MFMA32(F[18 * 64], sb2, O0); O0 = MFMA32(F[19 * 64], sb3, O0);
                    O0 = MFMA32(F[20 * 64], sb4, O0); O0 = MFMA32(F[21 * 64], sb5, O0); O0 = MFMA32(F[22 * 64], sb6, O0); O0 = MFMA32(F[23 * 64], sb7, O0);
                    O1 = MFMA32(F[24 * 64], sb0, O1); O1 = MFMA32(F[25 * 64], sb1, O1); O1 = MFMA32(F[26 * 64], sb2, O1); O1 = MFMA32(F[27 * 64], sb3, O1);
                    O1 = MFMA32(F[28 * 64], sb4, O1); O1 = MFMA32(F[29 * 64], sb5, O1); O1 = MFMA32(F[30 * 64], sb6, O1); O1 = MFMA32(F[31 * 64], sb7, O1);
                    O0 = MFMA32(F[48 * 64], ub0, O0); O0 = MFMA32(F[49 * 64], ub1, O0);
                    O1 = MFMA32(F[52 * 64], ub0, O1); O1 = MFMA32(F[53 * 64], ub1, O1); O1 = MFMA32(F[54 * 64], ub2, O1); O1 = MFMA32(F[55 * 64], ub3, O1);
#pragma unroll
                    for (int i = 0; i < 16; ++i) { S0[i] *= gend; S1[i] *= gend; S2[i] *= gend; S3[i] *= gend; }
                    S0 = MFMA32(F[32 * 64], ub0, S0); S0 = MFMA32(F[33 * 64], ub1, S0); S0 = MFMA32(F[34 * 64], ub2, S0); S0 = MFMA32(F[35 * 64], ub3, S0);
                    S1 = MFMA32(F[36 * 64], ub0, S1); S1 = MFMA32(F[37 * 64], ub1, S1); S1 = MFMA32(F[38 * 64], ub2, S1); S1 = MFMA32(F[39 * 64], ub3, S1);
                    S2 = MFMA32(F[40 * 64], ub0, S2); S2 = MFMA32(F[41 * 64], ub1, S2); S2 = MFMA32(F[42 * 64], ub2, S2); S2 = MFMA32(F[43 * 64], ub3, S2);
                    S3 = MFMA32(F[44 * 64], ub0, S3); S3 = MFMA32(F[45 * 64], ub1, S3); S3 = MFMA32(F[46 * 64], ub2, S3); S3 = MFMA32(F[47 * 64], ub3, S3);
                    float* yo = ODN + (size_t)(b * 2048 + n * 64) * 1024 + h * 128 + 32 * nt + r;
#pragma unroll
                    for (int i = 0; i < 16; ++i) { yo[(size_t)crow(i, hp) * 1024] = O0[i]; yo[(size_t)(32 + crow(i, hp)) * 1024] = O1[i]; }
                }
                asm volatile("s_waitcnt vmcnt(0)" ::: "memory"); __syncthreads();
            }
#undef DN_DMA
            if (wave < 4) {
                float* dst = kp.out() + O_DN_P + ((size_t)j * 4 + b) * ((size_t)8 * 128 * 128) + (size_t)h * 128 * 128 + 32 * nt + r;
#pragma unroll
                for (int i = 0; i < 16; ++i) { dst[(size_t)crow(i, hp) * 128] = S0[i]; dst[(size_t)(32 + crow(i, hp)) * 128] = S1[i]; dst[(size_t)(64 + crow(i, hp)) * 128] = S2[i]; dst[(size_t)(96 + crow(i, hp)) * 128] = S3[i]; }
            }
        } else if (half >= 0) {
            const int wave = __builtin_amdgcn_readfirstlane(tid >> 6), lane = tid & 63, r = lane & 31, hp = lane >> 5;
            const int b = s, nt = half * 4 + wave;
            const unsigned char* OPS = kp.ws() + WS_GLAOPS;
            constexpr int GBUF = 57 * 1024;
#define GLA_DMA(n_, bufi_) do { const unsigned char* gi_ = OPS + (size_t)((b * 32 + (n_)) * 4 + h) * GLA_ITEM_BYTES + lane * 16; \
                _Pragma("unroll") for (int q_ = 0; q_ < 8; ++q_) { const int lf_ = wave + 8 * q_; if (lf_ < 57) { const int gf_ = lf_ < 40 ? lf_ : (lf_ < 56 ? lf_ + half * 16 : 72); \
                    __builtin_amdgcn_global_load_lds((const unsigned*)(gi_ + gf_ * 1024), (LAS unsigned*)(lds + (bufi_) * GBUF + lf_ * 1024), 16, 0, 0); } } } while (0)
            f32x16 S0, S1, S2, S3;
#pragma unroll
            for (int i = 0; i < 16; ++i) { S0[i] = 0.f; S1[i] = 0.f; S2[i] = 0.f; S3[i] = 0.f; }
            GLA_DMA(0, 0);
            asm volatile("s_waitcnt vmcnt(0)" ::: "memory"); __syncthreads();
            for (int n = 0; n < 32; ++n) {
                if (n + 1 < 32) GLA_DMA(n + 1, (n + 1) & 1);
                if (wave < 4) {
                    const LAS bf16x8* F = (const LAS bf16x8*)(lds + (n & 1) * GBUF) + lane;
                    const LAS float* ge = (const LAS float*)(lds + (n & 1) * GBUF + 56 * 1024) + 4 * hp;
                    const bf16x8 sb0 = PACK_ACC(S0, 0), sb1 = PACK_ACC(S0, 1), sb2 = PACK_ACC(S1, 0), sb3 = PACK_ACC(S1, 1), sb4 = PACK_ACC(S2, 0), sb5 = PACK_ACC(S2, 1), sb6 = PACK_ACC(S3, 0), sb7 = PACK_ACC(S3, 1);
                    f32x16 O0, O1;
#pragma unroll
                    for (int i = 0; i < 16; ++i) { O0[i] = 0.f; O1[i] = 0.f; }
                    O0 = MFMA32(F[0 * 64], sb0, O0); O0 = MFMA32(F[1 * 64], sb1, O0); O0 = MFMA32(F[2 * 64], sb2, O0); O0 = MFMA32(F[3 * 64], sb3, O0);
                    O0 = MFMA32(F[4 * 64], sb4, O0); O0 = MFMA32(F[5 * 64], sb5, O0); O0 = MFMA32(F[6 * 64], sb6, O0); O0 = MFMA32(F[7 * 64], sb7, O0);
                    O1 = MFMA32(F[8 * 64], sb0, O1); O1 = MFMA32(F[9 * 64], sb1, O1); O1 = MFMA32(F[10 * 64], sb2, O1); O1 = MFMA32(F[11 * 64], sb3, O1);
                    O1 = MFMA32(F[12 * 64], sb4, O1); O1 = MFMA32(F[13 * 64], sb5, O1); O1 = MFMA32(F[14 * 64], sb6, O1); O1 = MFMA32(F[15 * 64], sb7, O1);
                    bf16x8 vb[4];
#pragma unroll
                    for (int ks = 0; ks < 4; ++ks) vb[ks] = F[(40 + wave * 4 + ks) * 64];
                    O0 = MFMA32(F[32 * 64], vb[0], O0); O0 = MFMA32(F[33 * 64], vb[1], O0);
#pragma unroll
                    for (int ks = 0; ks < 4; ++ks) O1 = MFMA32(F[(36 + ks) * 64], vb[ks], O1);
#pragma unroll
                    for (int q = 0; q < 4; ++q) { const f32x4 g0 = *(const LAS f32x4*)(ge + 8 * q), g1 = *(const LAS f32x4*)(ge + 32 + 8 * q), g2 = *(const LAS f32x4*)(ge + 64 + 8 * q), g3 = *(const LAS f32x4*)(ge + 96 + 8 * q);
#pragma unroll
                        for (int c = 0; c < 4; ++c) { S0[4 * q + c] *= g0[c]; S1[4 * q + c] *= g1[c]; S2[4 * q + c] *= g2[c]; S3[4 * q + c] *= g3[c]; } }
#pragma unroll
                    for (int ks = 0; ks < 4; ++ks) { S0 = MFMA32(F[(16 + ks) * 64], vb[ks], S0); S1 = MFMA32(F[(20 + ks) * 64], vb[ks], S1); S2 = MFMA32(F[(24 + ks) * 64], vb[ks], S2); S3 = MFMA32(F[(28 + ks) * 64], vb[ks], S3); }
                    float* yo = OGLA + (size_t)(b * 2048 + n * 64) * 1024 + h * 256 + 32 * nt + r;
#pragma unroll
                    for (int i = 0; i < 16; ++i) { yo[(size_t)crow(i, hp) * 1024] = O0[i]; yo[(size_t)(32 + crow(i, hp)) * 1024] = O1[i]; }
                }
                asm volatile("s_waitcnt vmcnt(0)" ::: "memory"); __syncthreads();
            }
#undef GLA_DMA
            if (wave < 4) {
                float* dst = kp.out() + O_GLA_P + ((size_t)j * 4 + b) * ((size_t)4 * 128 * 256) + (size_t)h * 128 * 256 + 32 * nt + r;
#pragma unroll
                for (int i = 0; i < 16; ++i) { dst[(size_t)crow(i, hp) * 256] = S0[i]; dst[(size_t)(32 + crow(i, hp)) * 256] = S1[i]; dst[(size_t)(64 + crow(i, hp)) * 256] = S2[i]; dst[(size_t)(96 + crow(i, hp)) * 256] = S3[i]; }
            }
        } else
        {}
    }
    unsigned* qhead = (unsigned*)(kp.ws() + WS_CTL) + CW_CNT + 64 * li;
    volatile LAS unsigned* qslot = (volatile LAS unsigned*)(lds + LDS_BYTES - 8);
    const float* cw = kp.in(14) + (size_t)j * 4 * 3072; const float* stc = kp.in(3) + (size_t)j * 128 * 3 * 3072;
    const float* wa2 = kp.in(18) + (size_t)j * 16 * 512; const float* ba = kp.in(19) + (size_t)j * 512;
    for (;;) {
        __syncthreads();
        if (tid0 == 0) qslot[0] = __hip_atomic_fetch_add(qhead, 1u, __ATOMIC_RELAXED, __HIP_MEMORY_SCOPE_AGENT);
        __syncthreads();
        const int it = (int)qslot[0];
        if (it >= 1536) break;
        int tid = tid0; asm volatile("" : "+v"(tid));
        const int wave = tid >> 6, lane = tid & 63;
        if (it < 1024) {
            const int bs = it >> 3, h = it & 7, sq = 4 + bs, r0 = TP + bs * 4;
            LAS float* qL = (LAS float*)lds; LAS float* kL = qL + 512; LAS float* vL = kL + 512; LAS float* red = vL + 512; LAS float* sm = red + 4096;
            const int e = tid & 127, dq = tid >> 7;
            const size_t SZ = (size_t)8 * 128 * 128;
            const float* st = kp.in(2) + ((size_t)j * 128 + bs) * SZ + (size_t)h * 16384;
            float S[32];
            { const float* sp = st + (size_t)(dq * 32) * 128 + e;
#pragma unroll
              for (int i = 0; i < 32; ++i) { S[i] = *sp; sp += 128; asm volatile("" : "+v"(sp)); } }
#pragma unroll
            for (int part = 0; part < 3; ++part) { const int c = part * 1024 + h * 128 + e; float acc = 0.f;
#pragma unroll
                for (int tap = 0; tap < 4; ++tap) acc += cw[tap * 3072 + c] * pre_val(U, NAB, c, r0, dq - 3 + tap, sq, stc, 3072, c);
                (part == 0 ? qL : (part == 1 ? kL : vL))[dq * 128 + e] = silu_(acc); }
            if (tid < 4) { const size_t ro = (size_t)(r0 + tid) * NAB;
                sm[32 + tid] = -expf(kp.in(15)[j * 8 + h]) * softplus_(bf2f(U[ro + 7176 + h]) + kp.in(16)[j * 8 + h]); sm[36 + tid] = sigmoid_(bf2f(U[ro + 7168 + h])); }
            __syncthreads();
            { const int tk = wave & 3; LAS float* src = (wave >> 2) ? kL : qL; const float a = src[tk * 128 + lane], b = src[tk * 128 + lane + 64];
              const float sc = rsqrtf(wave_sum(a * a + b * b) + 1e-6f) * ((wave >> 2) ? 1.f : 0.08838834764831845f); src[tk * 128 + lane] = a * sc; src[tk * 128 + lane + 64] = b * sc; }
            __syncthreads();
#pragma unroll
            for (int q = 0; q < 4; ++q) { const int idx = wave * 4 + q, i = (idx >> 2) & 3, jj = idx & 3; const LAS float* src = idx < 16 ? kL : qL;
                const float dot = wave_sum(src[i * 128 + lane] * kL[jj * 128 + lane] + src[i * 128 + lane + 64] * kL[jj * 128 + lane + 64]); if (lane == 0) sm[idx] = dot; }
            float ks[4] = {0.f, 0.f, 0.f, 0.f}, qs[4] = {0.f, 0.f, 0.f, 0.f};
#pragma unroll
            for (int i = 0; i < 32; ++i) { const int d = dq * 32 + i; const float sv = S[i];
#pragma unroll
                for (int t = 0; t < 4; ++t) { ks[t] += kL[t * 128 + d] * sv; qs[t] += qL[t * 128 + d] * sv; } }
#pragma unroll
            for (int t = 0; t < 4; ++t) { red[(t * 4 + dq) * 128 + e] = ks[t]; red[((4 + t) * 4 + dq) * 128 + e] = qs[t]; }
            __syncthreads();
            float Gc[4]; Gc[0] = sm[32]; Gc[1] = Gc[0] + sm[33]; Gc[2] = Gc[1] + sm[34]; Gc[3] = Gc[2] + sm[35];
            float u[4];
#pragma unroll
            for (int i = 0; i < 4; ++i) { const float KSi = (red[(i * 4 + 0) * 128 + e] + red[(i * 4 + 1) * 128 + e]) + (red[(i * 4 + 2) * 128 + e] + red[(i * 4 + 3) * 128 + e]);
                float acc = vL[i * 128 + e] - expf(Gc[i]) * KSi;
#pragma unroll
                for (int jj = 0; jj < i; ++jj) acc -= sm[i * 4 + jj] * expf(Gc[i] - Gc[jj]) * u[jj];
                u[i] = sm[36 + i] * acc; }
            if (dq == 0) {
#pragma unroll
                for (int i = 0; i < 4; ++i) { const float QSi = (red[((4 + i) * 4 + 0) * 128 + e] + red[((4 + i) * 4 + 1) * 128 + e]) + (red[((4 + i) * 4 + 2) * 128 + e] + red[((4 + i) * 4 + 3) * 128 + e]);
                    float o = expf(Gc[i]) * QSi;
#pragma unroll
                    for (int jj = 0; jj <= i; ++jj) o += sm[16 + i * 4 + jj] * expf(Gc[i] - Gc[jj]) * u[jj];
                    ODN[(size_t)(r0 + i) * 1024 + h * 128 + e] = o; } }
            const float eg = expf(Gc[3]); float w[4];
#pragma unroll
            for (int jj = 0; jj < 4; ++jj) w[jj] = expf(Gc[3] - Gc[jj]) * u[jj];
            float* dst = kp.out() + O_DN_S + ((size_t)j * 128 + bs) * SZ + (size_t)h * 16384 + (size_t)(dq * 32) * 128 + e;
#pragma unroll
            for (int i = 0; i < 32; ++i) { const int d = dq * 32 + i; float sv = eg * S[i];
#pragma unroll
                for (int jj = 0; jj < 4; ++jj) sv += kL[jj * 128 + d] * w[jj];
                *dst = sv; dst += 128; asm volatile("" : "+v"(dst)); }
        } else {
            const int q_ = it - 1024, bs = q_ >> 2, h = q_ & 3, r0 = TP + bs * 4;
            LAS float* qgL = (LAS float*)lds; LAS float* kaL = qgL + 512; LAS float* glL = kaL + 512; LAS float* egL = glL + 512; LAS float* Am = egL + 128; LAS float* red = Am + 16;
            const int e = tid & 255, dh = tid >> 8;
            const size_t SZ = (size_t)4 * 128 * 256;
            const float* st = kp.in(4) + ((size_t)j * 128 + bs) * SZ + (size_t)h * 32768;
            float S[64];
            { const float* sp = st + (size_t)(dh * 64) * 256 + e;
#pragma unroll
              for (int i = 0; i < 64; ++i) { S[i] = *sp; sp += 256; asm volatile("" : "+v"(sp)); } }
            float v[4];
#pragma unroll
            for (int t = 0; t < 4; ++t) v[t] = bf2f(U[(size_t)(r0 + t) * NAB + 5120 + h * 256 + e]);
            { const int d = tid & 127, tk = tid >> 7; const size_t ro = (size_t)(r0 + tk) * NAB;
              qgL[tk * 128 + d] = bf2f(U[ro + 4096 + h * 128 + d]) * 0.08838834764831845f; kaL[tk * 128 + d] = bf2f(U[ro + 4608 + h * 128 + d]);
              float x = ba[h * 128 + d];
#pragma unroll
              for (int rr = 0; rr < 16; ++rr) x += bf2f(U[ro + 7184 + rr]) * wa2[rr * 512 + h * 128 + d];
              glL[tk * 128 + d] = -softplus_(-x) * (1.f / 16.f); }
            __syncthreads();
            if (tid < 128) { float Gq = 0.f;
#pragma unroll
                for (int t = 0; t < 4; ++t) { Gq += glL[t * 128 + tid]; qgL[t * 128 + tid] *= expf(Gq); kaL[t * 128 + tid] *= expf(-Gq); }
                egL[tid] = expf(Gq); }
            __syncthreads();
#pragma unroll
            for (int q = 0; q < 2; ++q) { const int idx = wave * 2 + q, i = idx >> 2, jj = idx & 3;
                const float dot = wave_sum(qgL[i * 128 + lane] * kaL[jj * 128 + lane] + qgL[i * 128 + lane + 64] * kaL[jj * 128 + lane + 64]); if (lane == 0) Am[idx] = dot; }
            float o[4] = {0.f, 0.f, 0.f, 0.f};
            float* dst = kp.out() + O_GLA_S + ((size_t)j * 128 + bs) * SZ + (size_t)h * 32768 + (size_t)(dh * 64) * 256 + e;
#pragma unroll
            for (int i = 0; i < 64; ++i) { const int d = dh * 64 + i; const float s0 = S[i]; float acc = s0;
#pragma unroll
                for (int t = 0; t < 4; ++t) { o[t] += qgL[t * 128 + d] * s0; acc += kaL[t * 128 + d] * v[t]; }
                *dst = egL[d] * acc; dst += 256; asm volatile("" : "+v"(dst)); }
#pragma unroll
            for (int t = 0; t < 4; ++t) red[(dh * 4 + t) * 256 + e] = o[t];
            __syncthreads();
            if (dh == 0) {
#pragma unroll
                for (int t = 0; t < 4; ++t) { float oo = red[t * 256 + e] + red[(4 + t) * 256 + e];
#pragma unroll
                    for (int jj = 0; jj <= t; ++jj) oo += Am[t * 4 + jj] * v[jj];
                    OGLA[(size_t)(r0 + t) * 1024 + h * 256 + e] = oo; } }
        }
    }
}

__device__ __forceinline__ void phase_ab_post(const KP kp, const int bid, const int G, int j, int tid, int wave, int lane) {
    unsigned char* scr = kp.ws() + WS_SCR; const bf16* U = (const bf16*)(kp.ws() + WS_U); bf16* YM = (bf16*)(kp.ws() + WS_YM);
    const float* ODN = (const float*)(scr + SC_ODN); const float* OGLA = (const float*)(scr + SC_OGLA);
    const float* dnn = kp.in(17) + (size_t)j * 128; const float* glan = kp.in(20) + (size_t)j * 256;
    typedef float f32x2v __attribute__((ext_vector_type(2)));
    const f32x2v dg = *(const f32x2v*)(dnn + 2 * lane); const f32x4 gg = *(const f32x4*)(glan + 4 * lane);
    for (int r = bid * NWAVES + wave; r < T; r += G * NWAVES) {
        int s, t; row_to_seq(r, s, t); int row0, L; seq_info(s, row0, L);
        const bf16* ur = U + (size_t)r * NAB; bf16* yr = YM + (size_t)r * DM;
#pragma unroll
        for (int hh = 0; hh < 8; ++hh) { const f32x2v o = *(const f32x2v*)(ODN + (size_t)r * 1024 + hh * 128 + 2 * lane);
            const float rstd = rsqrtf(wave_sum(o.x * o.x + o.y * o.y) * (1.f / 128.f) + 1e-6f);
            const unsigned zz = *(const unsigned*)(ur + 3072 + hh * 128 + 2 * lane);
            *(unsigned*)(yr + hh * 128 + 2 * lane) = pk2(o.x * rstd * dg.x * silu_(__uint_as_float(zz << 16)), o.y * rstd * dg.y * silu_(__uint_as_float(zz & 0xffff0000u))); }
#pragma unroll
        for (int hh = 0; hh < 4; ++hh) { const f32x4 o = *(const f32x4*)(OGLA + (size_t)r * 1024 + hh * 256 + 4 * lane);
            const float rstd = rsqrtf(wave_sum((o.x * o.x + o.y * o.y) + (o.z * o.z + o.w * o.w)) * (1.f / 256.f) + 1e-6f);
            const u32x2 zz = *(const u32x2*)(ur + 6144 + hh * 256 + 4 * lane);
            u32x2 w; w.x = pk2(o.x * rstd * gg.x * silu_(__uint_as_float(zz.x << 16)), o.y * rstd * gg.y * silu_(__uint_as_float(zz.x & 0xffff0000u)));
            w.y = pk2(o.z * rstd * gg.z * silu_(__uint_as_float(zz.y << 16)), o.w * rstd * gg.w * silu_(__uint_as_float(zz.y & 0xffff0000u)));
            *(u32x2*)(yr + 1024 + hh * 256 + 4 * lane) = w; }
        if (t >= L - 3) { const int rr = t - (L - 3);
            float* dst = s < 4 ? kp.out() + O_DNC_P + (((size_t)j * 4 + s) * 3 + rr) * 3072 : kp.out() + O_DNC_S + (((size_t)j * 128 + (s - 4)) * 3 + rr) * 3072;
            for (int c = 2 * lane; c < 3072; c += 128) { const unsigned uu = *(const unsigned*)(ur + c); *(f32x2v*)(dst + c) = (f32x2v){__uint_as_float(uu << 16), __uint_as_float(uu & 0xffff0000u)}; } }
    }
}

__device__ __forceinline__ void phase_cd_pre(const KP kp, const int bid, const int G, int j, LAS unsigned char* lds, int tid) {
    unsigned char* scr = kp.ws() + WS_SCR; const bf16* U = (const bf16*)(kp.ws() + WS_U);
    float* XBC = (float*)(scr + SC_XBC) - (size_t)TP * 1536; float* DT = (float*)(scr + SC_DT) - (size_t)TP * 16; bf16* XS = (bf16*)(scr + SC_XS);
    const float* cw = kp.in(23) + (size_t)j * 4 * 1536; const float* cb = kp.in(24) + (size_t)j * 1536; const float* stc = kp.in(6) + (size_t)j * 128 * 3 * 1536;
    for (int r = TP + bid; r < T; r += G) {
        int s, t; row_to_seq(r, s, t); const int row0 = r - t;
#pragma unroll
        for (int i = 0; i < 3; ++i) { const int c = tid + NTHR * i; float acc = cb[c];
#pragma unroll
            for (int tap = 0; tap < 4; ++tap) acc += cw[tap * 1536 + c] * pre_val(U, NCD, 1024 + c, row0, t - 3 + tap, s, stc, 1536, c);
            const float v = silu_(acc); XBC[(size_t)r * 1536 + c] = v; if (c < 1024) XS[(size_t)r * 1024 + c] = (bf16)f2bf(v); }
        if (tid < 16) DT[(size_t)r * 16 + tid] = softplus_(bf2f(U[(size_t)r * NCD + 4608 + tid]) + kp.in(26)[j * 16 + tid]);
    }
}

__device__ __forceinline__ void phase_lru_gates(const KP kp, const int bid, const int G, int j, LAS unsigned char* lds, int tid0) {
    unsigned char* scr = kp.ws() + WS_SCR; const bf16* U = (const bf16*)(kp.ws() + WS_U);
    float* LA = (float*)(scr + SC_LA); float* LB = (float*)(scr + SC_LB);
    const float* lcw = kp.in(29) + (size_t)j * 4 * 1024; const float* lcb = kp.in(30) + (size_t)j * 1024; const float* lstc = kp.in(8) + (size_t)j * 128 * 3 * 1024;
    const int n = bid & 15;
    const float* wa = kp.in(31) + ((size_t)j * 16 + n) * 4096; const float* wx = kp.in(33) + ((size_t)j * 16 + n) * 4096;
    const float* lba = kp.in(32) + (size_t)j * 1024; const float* lbx = kp.in(34) + (size_t)j * 1024; const float* lam = kp.in(35) + (size_t)j * 1024;
    LAS float* waL = (LAS float*)lds; LAS float* wxL = waL + 4096; LAS float* xcL = wxL + 4096;
    __syncthreads();
    for (int i = tid0; i < 4096; i += NTHR) { waL[i] = wa[i]; wxL[i] = wx[i]; }
    for (int tile = bid >> 4; tile < T / 64; tile += (G >> 4)) {
        int tid = tid0; asm volatile("" : "+v"(tid));
        const int c = tid & 63, tq = tid >> 6, ch = n * 64 + c, rowbase = tile * 64;
        __syncthreads();
#pragma unroll 2
        for (int tt = 0; tt < 8; ++tt) { const int r = rowbase + tq * 8 + tt; int s, t; row_to_seq(r, s, t); const int row0 = r - t; float acc = lcb[ch];
#pragma unroll
            for (int tap = 0; tap < 4; ++tap) acc += lcw[tap * 1024 + ch] * pre_val(U, NCD, 3584 + ch, row0, t - 3 + tap, s, lstc, 1024, ch);
            xcL[(tq * 8 + tt) * 65 + c] = acc; }
        __syncthreads();
        float ra[8], ix[8];
#pragma unroll
        for (int tt = 0; tt < 8; ++tt) { ra[tt] = lba[ch]; ix[tt] = lbx[ch]; }
#pragma unroll 4
        for (int cc = 0; cc < 64; ++cc) { const float wA = waL[cc * 64 + c], wX = wxL[cc * 64 + c];
#pragma unroll
            for (int tt = 0; tt < 8; ++tt) { const float x = xcL[(tq * 8 + tt) * 65 + cc]; ra[tt] += x * wA; ix[tt] += x * wX; } }
        const float spl = softplus_(-lam[ch]);
#pragma unroll
        for (int tt = 0; tt < 8; ++tt) { const size_t r = (size_t)(rowbase + tq * 8 + tt); const float rg = sigmoid_(ra[tt]), ig = sigmoid_(ix[tt]);
            const float log_a = -8.f * rg * spl;
            LA[r * 1024 + ch] = expf(log_a); LB[r * 1024 + ch] = sqrtf(-expm1f(2.f * log_a)) * (ig * xcL[(tq * 8 + tt) * 65 + c]); }
    }
}

__device__ __forceinline__ void phase_ssd_prep(const KP kp, const int bid, const int G, int j, LAS unsigned char* lds, int tid0) {
    unsigned char* scr = kp.ws() + WS_SCR;
    const bf16* U = (const bf16*)(kp.ws() + WS_U); bf16* XS = (bf16*)(scr + SC_XS);
    const float* cw = kp.in(23) + (size_t)j * 4 * 1536; const float* cb = kp.in(24) + (size_t)j * 1536;
    unsigned char* OPS = scr + SC_SSDOP; float* GEND = (float*)(scr + SC_GEND);
    LAS float* CL = (LAS float*)lds; LAS float* BL = CL + 64 * 65; LAS float* QK = BL + 64 * 65; LAS float* GL = QK + 64 * 65; LAS float* DTL = GL + 256; LAS float* XLs = DTL + 256;
    const float* alog = kp.in(25) + j * 16;
    for (int item = bid; item < 512; item += G) {
        int tid = tid0; asm volatile("" : "+v"(tid));
        const int wave = tid >> 6, lane = tid & 63;
        const int b = item >> 7, n = (item >> 2) & 31, g = item & 3;
        const int row0 = b * 2048 + n * 64;
        __syncthreads();
        { const int ci = tid & 127, tg = tid >> 7, t0 = 16 * tg;
          const bool first = (n == 0 && tg == 0);
#pragma unroll
          for (int q = 0; q < 3; ++q) { const int k = ci + 128 * q;
              int cidx; LAS float* dst; int dstr, dcol;
              if (k < 64) { cidx = 1024 + g * 64 + k; dst = BL; dstr = 65; dcol = k; }
              else if (k < 128) { cidx = 1280 + g * 64 + (k - 64); dst = CL; dstr = 65; dcol = k - 64; }
              else { cidx = g * 256 + (k - 128); dst = XLs; dstr = 257; dcol = k - 128; }
              const float w0 = cw[cidx], w1 = cw[1536 + cidx], w2 = cw[2 * 1536 + cidx], w3 = cw[3 * 1536 + cidx], bb = cb[cidx];
              const bf16* up = U + (size_t)(row0 + t0) * NCD + 1024 + cidx;
              float x0 = first ? 0.f : bf2f(up[-3 * (long)NCD]), x1 = first ? 0.f : bf2f(up[-2 * (long)NCD]), x2 = first ? 0.f : bf2f(up[-1 * (long)NCD]);
#pragma unroll 4
              for (int t = 0; t < 16; ++t) { const float x3 = bf2f(up[(size_t)t * NCD]); dst[(t0 + t) * dstr + dcol] = silu_(bb + w0 * x0 + w1 * x1 + w2 * x2 + w3 * x3); x0 = x1; x1 = x2; x2 = x3; } } }
        if (wave < 4) { const int h = g * 4 + wave; const float dt = softplus_(bf2f(U[(size_t)(row0 + lane) * NCD + 4608 + h]) + kp.in(26)[j * 16 + h]);
            DTL[wave * 64 + lane] = dt; float gv = -expf(alog[h]) * dt;
#pragma unroll
            for (int o = 1; o < 64; o <<= 1) { const float tt = __shfl_up(gv, o); if (lane >= o) gv += tt; }
            GL[wave * 64 + lane] = gv; }
        __syncthreads();
        for (int i = tid; i < 8192; i += NTHR) { const int t = i >> 7, k2 = i & 127;
            ((unsigned*)XS)[((size_t)(row0 + t) * 1024 + g * 256) / 2 + k2] = pk2(XLs[t * 257 + 2 * k2], XLs[t * 257 + 2 * k2 + 1]); }
        { const int i = tid >> 3, jg = tid & 7; float acc[8];
#pragma unroll
          for (int jj = 0; jj < 8; ++jj) acc[jj] = 0.f;
#pragma unroll 4
          for (int d = 0; d < 64; ++d) { const float c = CL[i * 65 + d];
#pragma unroll
              for (int jj = 0; jj < 8; ++jj) acc[jj] += c * BL[(jg * 8 + jj) * 65 + d]; }
#pragma unroll
          for (int jj = 0; jj < 8; ++jj) QK[i * 65 + jg * 8 + jj] = acc[jj]; }
        __syncthreads();
        const int f = wave, r = lane & 31, hp = lane >> 5, mt = f >> 2, ks = f & 3;
        for (int hh = 0; hh < 4; ++hh) {
            const int h = g * 4 + hh; const LAS float* Gh = GL + hh * 64; const float Gend = Gh[63];
            bf16x8* base = (bf16x8*)(OPS + ((size_t)((b * 32 + n) * 16 + h)) * 32768);
            float v[8];
            { const int i = 32 * mt + r; const float eg = expf(Gh[i]);
#pragma unroll
              for (int jp = 0; jp < 8; ++jp) { const int d = 16 * ks + 8 * (jp >> 2) + 4 * hp + (jp & 3); v[jp] = CL[i * 65 + d] * eg; }
              base[0 * 512 + f * 64 + lane] = pack8(v); }
            { const int d = 32 * mt + r;
#pragma unroll
              for (int jp = 0; jp < 8; ++jp) { const int tk = 16 * ks + 8 * (jp >> 2) + 4 * hp + (jp & 3); v[jp] = BL[tk * 65 + d] * expf(Gend - Gh[tk]); }
              base[1 * 512 + f * 64 + lane] = pack8(v); }
            { const int i = 32 * mt + r; const float gi = Gh[i];
#pragma unroll
              for (int jp = 0; jp < 8; ++jp) { const int jt = 16 * ks + 8 * (jp >> 2) + 4 * hp + (jp & 3); v[jp] = jt <= i ? QK[i * 65 + jt] * expf(gi - Gh[jt]) : 0.f; }
              base[2 * 512 + f * 64 + lane] = pack8(v); }
            { const int p = 32 * mt + r;
#pragma unroll
              for (int jp = 0; jp < 8; ++jp) { const int tk = 16 * ks + 8 * (jp >> 2) + 4 * hp + (jp & 3);
                  v[jp] = XLs[tk * 257 + hh * 64 + p] * DTL[hh * 64 + tk]; }
              base[3 * 512 + f * 64 + lane] = pack8(v); }
            if (tid == 0) GEND[(b * 32 + n) * 16 + h] = expf(Gend);
        }
    }
}

__device__ __forceinline__ void phase_cd_rec(const KP kp, const int bid, const int G, int j, int li, LAS unsigned char* lds, int tid0) {
    unsigned char* scr = kp.ws() + WS_SCR; const bf16* U = (const bf16*)(kp.ws() + WS_U);
    const float* LA = (const float*)(scr + SC_LA); const float* LB = (const float*)(scr + SC_LB);
    float* YS = (float*)(scr + SC_YS); float* HS = (float*)(scr + SC_HS); bf16* XS = (bf16*)(scr + SC_XS);
    for (int item = bid; item < 16; item += G) {
        int tid = tid0; asm volatile("" : "+v"(tid));
        const int s = item >> 2, h = item & 3;
        __syncthreads();
        {
            const int wave = __builtin_amdgcn_readfirstlane(tid >> 6), lane = tid & 63, r = lane & 31, hp = lane >> 5;
            const int b = s, hd = h * 4 + (wave >> 1), nt = wave & 1;
            const unsigned char* OPS = scr + SC_SSDOP; const float* GEND = (const float*)(scr + SC_GEND);
            f32x16 S0, S1;
#pragma unroll
            for (int i = 0; i < 16; ++i) { S0[i] = 0.f; S1[i] = 0.f; }
            for (int n = 0; n < 32; ++n) {
                const bf16x8* F = (const bf16x8*)(OPS + ((size_t)((b * 32 + n) * 16 + hd)) * 32768) + lane;
                bf16x8 qg[2][4], kT[2][4], Am[2][4], vb[4];
#pragma unroll
                for (int mt = 0; mt < 2; ++mt)
#pragma unroll
                    for (int ks = 0; ks < 4; ++ks) { qg[mt][ks] = F[(0 * 8 + mt * 4 + ks) * 64]; kT[mt][ks] = F[(1 * 8 + mt * 4 + ks) * 64]; Am[mt][ks] = F[(2 * 8 + mt * 4 + ks) * 64]; }
#pragma unroll
                for (int ks = 0; ks < 4; ++ks) vb[ks] = F[(3 * 8 + nt * 4 + ks) * 64];
                const float gend = GEND[(b * 32 + n) * 16 + hd];
                const bf16x8 sb00 = PACK_ACC(S0, 0), sb01 = PACK_ACC(S0, 1), sb10 = PACK_ACC(S1, 0), sb11 = PACK_ACC(S1, 1);
                f32x16 O0, O1;
#pragma unroll
                for (int i = 0; i < 16; ++i) { O0[i] = 0.f; O1[i] = 0.f; }
                O0 = MFMA32(qg[0][0], sb00, O0); O0 = MFMA32(qg[0][1], sb01, O0); O0 = MFMA32(qg[0][2], sb10, O0); O0 = MFMA32(qg[0][3], sb11, O0);
                O1 = MFMA32(qg[1][0], sb00, O1); O1 = MFMA32(qg[1][1], sb01, O1); O1 = MFMA32(qg[1][2], sb10, O1); O1 = MFMA32(qg[1][3], sb11, O1);
                O0 = MFMA32(Am[0][0], vb[0], O0); O0 = MFMA32(Am[0][1], vb[1], O0);
#pragma unroll
                for (int ks = 0; ks < 4; ++ks) O1 = MFMA32(Am[1][ks], vb[ks], O1);
#pragma unroll
                for (int i = 0; i < 16; ++i) { S0[i] *= gend; S1[i] *= gend; }
#pragma unroll
                for (int ks = 0; ks < 4; ++ks) { S0 = MFMA32(kT[0][ks], vb[ks], S0); S1 = MFMA32(kT[1][ks], vb[ks], S1); }
                float* yo = YS + (size_t)(b * 2048 + n * 64) * 1024 + hd * 64 + 32 * nt + r;
#pragma unroll
                for (int i = 0; i < 16; ++i) { yo[(size_t)crow(i, hp) * 1024] = O0[i]; yo[(size_t)(32 + crow(i, hp)) * 1024] = O1[i]; }
            }
            float* dst = kp.out() + O_SSD_P + ((size_t)j * 4 + b) * ((size_t)16 * 64 * 64) + (size_t)hd * 64 * 64 + 32 * nt + r;
#pragma unroll
            for (int i = 0; i < 16; ++i) { dst[(size_t)crow(i, hp) * 64] = S0[i]; dst[(size_t)(32 + crow(i, hp)) * 64] = S1[i]; }
        }
    }
    unsigned* qhead = (unsigned*)(kp.ws() + WS_CTL) + CW_CNT + 64 * li;
    volatile LAS unsigned* qslot = (volatile LAS unsigned*)(lds + LDS_BYTES - 8);
    const float* cw = kp.in(23) + (size_t)j * 4 * 1536; const float* cb = kp.in(24) + (size_t)j * 1536; const float* stc = kp.in(6) + (size_t)j * 128 * 3 * 1536;
    for (;;) {
        __syncthreads();
        if (tid0 == 0) qslot[0] = __hip_atomic_fetch_add(qhead, 1u, __ATOMIC_RELAXED, __HIP_MEMORY_SCOPE_AGENT);
        __syncthreads();
        const int it = (int)qslot[0];
        if (it >= 1024) break;
        int tid = tid0; asm volatile("" : "+v"(tid));
        if (it < 256) {
            const int s = it >> 6, h = it & 63; int row0, L; seq_info(s, row0, L);
            LAS float* Al = (LAS float*)lds; LAS float* Bl = Al + 512;
            const int chunk = tid >> 4, c16 = tid & 15, ch = h * 16 + c16;
            const size_t ro = (size_t)(row0 + chunk * 64) * 1024 + ch;
            float Ap = 1.f, Bp = 0.f;
#pragma unroll 8
            for (int t = 0; t < 64; ++t) { const float a = LA[ro + (size_t)t * 1024], bb = LB[ro + (size_t)t * 1024]; Bp = a * Bp + bb; Ap *= a; }
            Al[tid] = Ap; Bl[tid] = Bp;
            __syncthreads();
            float hh = 0.f;
            for (int m = 0; m < chunk; ++m) hh = Al[m * 16 + c16] * hh + Bl[m * 16 + c16];
#pragma unroll 8
            for (int t = 0; t < 64; ++t) { hh = LA[ro + (size_t)t * 1024] * hh + LB[ro + (size_t)t * 1024]; HS[ro + (size_t)t * 1024] = hh; }
            if (chunk == 31) kp.out()[O_LRU_P + ((size_t)j * 4 + s) * 1024 + ch] = hh;
        } else if (it < 768) {
            const int q_ = it - 256, bs = q_ >> 2, g = q_ & 3, sq = 4 + bs, r0 = TP + bs * 4;
            LAS float* BL = (LAS float*)lds; LAS float* CL = BL + 256; LAS float* XL = CL + 256; LAS float* DTL = XL + 1024; LAS float* QKs = DTL + 16; LAS float* red = QKs + 16;
            const int wave = tid >> 6, lane = tid & 63, hh = tid >> 7, nh = (tid >> 6) & 1, p = tid & 63, hd = 4 * g + hh;
            const size_t SZ = (size_t)16 * 64 * 64;
            const float* st = kp.in(5) + ((size_t)j * 128 + bs) * SZ + (size_t)hd * 4096;
            float S[32];
            { const float* sp = st + (size_t)(nh * 32) * 64 + p;
#pragma unroll
              for (int i = 0; i < 32; ++i) { S[i] = *sp; sp += 64; asm volatile("" : "+v"(sp)); } }
            { const int ci = tid & 127, tk = tid >> 7;
#pragma unroll
              for (int q = 0; q < 3; ++q) { const int k = ci + 128 * q; int cidx; LAS float* dst;
                  if (k < 64) { cidx = 1024 + g * 64 + k; dst = BL + tk * 64 + k; } else if (k < 128) { cidx = 1280 + g * 64 + (k - 64); dst = CL + tk * 64 + (k - 64); } else { cidx = g * 256 + (k - 128); dst = XL + tk * 256 + (k - 128); }
                  float acc = cb[cidx];
#pragma unroll
                  for (int tap = 0; tap < 4; ++tap) acc += cw[tap * 1536 + cidx] * pre_val(U, NCD, 1024 + cidx, r0, tk - 3 + tap, sq, stc, 1536, cidx);
                  *dst = silu_(acc); } }
            if (tid < 16) { const int tk = tid >> 2, h2 = tid & 3; DTL[tid] = softplus_(bf2f(U[(size_t)(r0 + tk) * NCD + 4608 + 4 * g + h2]) + kp.in(26)[j * 16 + 4 * g + h2]); }
            __syncthreads();
#pragma unroll
            for (int q = 0; q < 2; ++q) { const int idx = wave * 2 + q, i = idx >> 2, jj = idx & 3; const float dot = wave_sum(CL[i * 64 + lane] * BL[jj * 64 + lane]); if (lane == 0) QKs[idx] = dot; }
            { const int tk = tid >> 7, k2 = tid & 127; ((unsigned*)XS)[((size_t)(r0 + tk) * 1024 + g * 256) / 2 + k2] = pk2(XL[tk * 256 + 2 * k2], XL[tk * 256 + 2 * k2 + 1]); }
            const float negA = -expf(kp.in(25)[j * 16 + hd]);
            float Gc[4], xd[4], w[4];
            Gc[0] = negA * DTL[hh]; Gc[1] = Gc[0] + negA * DTL[4 + hh]; Gc[2] = Gc[1] + negA * DTL[8 + hh]; Gc[3] = Gc[2] + negA * DTL[12 + hh];
#pragma unroll
            for (int jj = 0; jj < 4; ++jj) { xd[jj] = XL[jj * 256 + hh * 64 + p] * DTL[jj * 4 + hh]; w[jj] = expf(Gc[3] - Gc[jj]) * xd[jj]; }
            const float eg = expf(Gc[3]);
            float o[4] = {0.f, 0.f, 0.f, 0.f};
            float* dst = kp.out() + O_SSD_S + ((size_t)j * 128 + bs) * SZ + (size_t)hd * 4096 + (size_t)(nh * 32) * 64 + p;
#pragma unroll
            for (int i = 0; i < 32; ++i) { const int n = nh * 32 + i; const float s0 = S[i]; float acc = eg * s0;
#pragma unroll
                for (int t = 0; t < 4; ++t) { o[t] += CL[t * 64 + n] * s0; acc += BL[t * 64 + n] * w[t]; }
                *dst = acc; dst += 64; asm volatile("" : "+v"(dst)); }
#pragma unroll
            for (int t = 0; t < 4; ++t) red[((hh * 2 + nh) * 4 + t) * 64 + p] = o[t];
            __syncthreads();
            if (nh == 0) {
#pragma unroll
                for (int t = 0; t < 4; ++t) { float y = expf(Gc[t]) * (red[((hh * 2) * 4 + t) * 64 + p] + red[((hh * 2 + 1) * 4 + t) * 64 + p]);
#pragma unroll
                    for (int jj = 0; jj <= t; ++jj) y += QKs[t * 4 + jj] * expf(Gc[t] - Gc[jj]) * xd[jj];
                    YS[(size_t)(r0 + t) * 1024 + hd * 64 + p] = y; } }
        } else {
            const int q_ = it - 768, s = 4 + (q_ >> 1), h = q_ & 1; int row0, L; seq_info(s, row0, L);
            const int ch = h * 512 + tid;
            float hh = s < 4 ? 0.f : kp.in(7)[((size_t)j * 128 + (s - 4)) * 1024 + ch];
#pragma unroll 8
            for (int t = 0; t < L; ++t) { const size_t r = (size_t)(row0 + t); hh = LA[r * 1024 + ch] * hh + LB[r * 1024 + ch]; HS[r * 1024 + ch] = hh; }
            float* dst = s < 4 ? kp.out() + O_LRU_P + ((size_t)j * 4 + s) * 1024 : kp.out() + O_LRU_S + ((size_t)j * 128 + (s - 4)) * 1024;
            dst[ch] = hh;
        }
    }
}

__device__ __forceinline__ void phase_cd_post(const KP kp, const int bid, const int G, int j, int tid, int wave, int lane) {
    unsigned char* scr = kp.ws() + WS_SCR; const bf16* U = (const bf16*)(kp.ws() + WS_U); bf16* YM = (bf16*)(kp.ws() + WS_YM);
    const float* YS = (const float*)(scr + SC_YS); const float* HS = (const float*)(scr + SC_HS); const bf16* XS = (const bf16*)(scr + SC_XS);
    const float* sn = kp.in(28) + (size_t)j * 1024; const float* Dv = kp.in(27) + (size_t)j * 16;
    typedef float f32x2v __attribute__((ext_vector_type(2)));
    for (int r = bid * NWAVES + wave; r < T; r += G * NWAVES) {
        int s, t; row_to_seq(r, s, t); int row0, L; seq_info(s, row0, L);
        const bf16* ur = U + (size_t)r * NCD; bf16* yr = YM + (size_t)r * DM;
#pragma unroll
        for (int gq = 0; gq < 4; ++gq) { const int e = gq * 256 + 4 * lane; const f32x4 ys = *(const f32x4*)(YS + (size_t)r * 1024 + e);
            const u32x2 xx = *(const u32x2*)(XS + (size_t)r * 1024 + e), zz = *(const u32x2*)(ur + e); const float Dh = Dv[e >> 6];
            f32x4 y; y.x = (ys.x + Dh * __uint_as_float(xx.x << 16)) * silu_(__uint_as_float(zz.x << 16)); y.y = (ys.y + Dh * __uint_as_float(xx.x & 0xffff0000u)) * silu_(__uint_as_float(zz.x & 0xffff0000u));
            y.z = (ys.z + Dh * __uint_as_float(xx.y << 16)) * silu_(__uint_as_float(zz.y << 16)); y.w = (ys.w + Dh * __uint_as_float(xx.y & 0xffff0000u)) * silu_(__uint_as_float(zz.y & 0xffff0000u));
            const float rstd = rsqrtf(wave_sum((y.x * y.x + y.y * y.y) + (y.z * y.z + y.w * y.w)) * (1.f / 256.f) + 1e-6f);
            const f32x4 g4 = *(const f32x4*)(sn + e);
            u32x2 w; w.x = pk2(y.x * rstd * g4.x, y.y * rstd * g4.y); w.y = pk2(y.z * rstd * g4.z, y.w * rstd * g4.w); *(u32x2*)(yr + e) = w; }
#pragma unroll
        for (int gq = 0; gq < 4; ++gq) { const int ch = gq * 256 + 4 * lane; const f32x4 hs = *(const f32x4*)(HS + (size_t)r * 1024 + ch); const u32x2 zz = *(const u32x2*)(ur + 2560 + ch);
            u32x2 w; w.x = pk2(hs.x * silu_(__uint_as_float(zz.x << 16)), hs.y * silu_(__uint_as_float(zz.x & 0xffff0000u))); w.y = pk2(hs.z * silu_(__uint_as_float(zz.y << 16)), hs.w * silu_(__uint_as_float(zz.y & 0xffff0000u)));
            *(u32x2*)(yr + 1024 + ch) = w; }
        if (t >= L - 3) { const int rr = t - (L - 3);
            float* d1 = s < 4 ? kp.out() + O_SSDC_P + (((size_t)j * 4 + s) * 3 + rr) * 1536 : kp.out() + O_SSDC_S + (((size_t)j * 128 + (s - 4)) * 3 + rr) * 1536;
            for (int c = 2 * lane; c < 1536; c += 128) { const unsigned uu = *(const unsigned*)(ur + 1024 + c); *(f32x2v*)(d1 + c) = (f32x2v){__uint_as_float(uu << 16), __uint_as_float(uu & 0xffff0000u)}; }
            float* d2 = s < 4 ? kp.out() + O_LRUC_P + (((size_t)j * 4 + s) * 3 + rr) * 1024 : kp.out() + O_LRUC_S + (((size_t)j * 128 + (s - 4)) * 3 + rr) * 1024;
            for (int c = 2 * lane; c < 1024; c += 128) { const unsigned uu = *(const unsigned*)(ur + 3584 + c); *(f32x2v*)(d2 + c) = (f32x2v){__uint_as_float(uu << 16), __uint_as_float(uu & 0xffff0000u)}; } }
    }
}


typedef float f32x4m __attribute__((ext_vector_type(4)));
template <bool GATE>
__device__ __forceinline__ void sample_gemm_res(const bf16* Amat, const bf16* Bt, const bf16* Hin, bf16* Hout, float* rss_out, const bf16* PP, const float* rss_in, int bid, int tid) {
    const int wave = tid >> 6, lane = tid & 63, lr = lane & 15, kg = lane >> 4;
    const int m0 = TP + (bid & 7) * 64 + (wave & 3) * 16, n0 = (bid >> 3) * 64 + (wave >> 2) * 32;
    if (bid >= 256) return;
    const bf16x8* ap = (const bf16x8*)(Amat + (size_t)(m0 + lr) * 2048 + 8 * kg);
    const bf16x8* bp0 = (const bf16x8*)(Bt + (size_t)(n0 + lr) * 2048 + 8 * kg);
    const bf16x8* bp1 = (const bf16x8*)(Bt + (size_t)(n0 + 16 + lr) * 2048 + 8 * kg);
    f32x4m c0 = {0.f, 0.f, 0.f, 0.f}, c1 = {0.f, 0.f, 0.f, 0.f};
#pragma unroll 8
    for (int ks = 0; ks < 64; ++ks) { const bf16x8 a = ap[ks * 4], b0 = bp0[ks * 4], b1 = bp1[ks * 4];
        c0 = __builtin_amdgcn_mfma_f32_16x16x32_bf16(a, b0, c0, 0, 0, 0); c1 = __builtin_amdgcn_mfma_f32_16x16x32_bf16(a, b1, c1, 0, 0, 0); }
#pragma unroll
    for (int i = 0; i < 4; ++i) { const int row = m0 + kg * 4 + i; float sc = 1.f; if (GATE) sc = rsqrtf(rss_in[row] * (1.f / 2048.f) + 1e-6f);
        float sq = 0.f;
#pragma unroll
        for (int nf = 0; nf < 2; ++nf) { const size_t p = (size_t)row * 2048 + n0 + 16 * nf + lr; const float a = nf ? c1[i] : c0[i];
            float h = bf2f(Hin[p]);
            if (GATE) h += __builtin_amdgcn_rcpf(1.f + __expf(-sc * a)) * bf2f(PP[p]); else h += a;
            sq += h * h; Hout[p] = (bf16)f2bf(h); }
        sq += __shfl_xor(sq, 1); sq += __shfl_xor(sq, 2); sq += __shfl_xor(sq, 4); sq += __shfl_xor(sq, 8);
        if (lr == 0) atomicAdd(rss_out + row, sq); }
}

__global__ void __launch_bounds__(NTHR, 2) mega_fwd(Args A) {
    extern __shared__ __attribute__((aligned(16))) unsigned char lds_raw[];
    LAS unsigned char* lds = (LAS unsigned char*)lds_raw;
    const int G = gridDim.x;
    volatile LAS unsigned* bst = (volatile LAS unsigned*)(lds + LDS_BYTES - 16);
    if (threadIdx.x == 0) { bst[0] = 0u; bst[1] = 0u; }
    __syncthreads();
    XcdBarrier xbar = xcd_barrier_post((unsigned*)(A.ws + WS_CTL) + CW_BAR, bst);
#ifdef PROBE_GROUP
    unsigned long long t_prev = __builtin_amdgcn_s_memrealtime(), t_sel = 0;
#endif
    for (int ph = A.ph_lo; ph < A.ph_hi; ++ph) {
        KP kp; kp.p = (const char AS4*)__builtin_amdgcn_kernarg_segment_ptr(); asm volatile("" : "+s"(kp.p));
        unsigned char* ws = kp.ws();
        int tid = threadIdx.x; asm volatile("" : "+v"(tid));
        int bid = blockIdx.x; asm volatile("" : "+s"(bid));
        const int lane = tid & 63, wave = __builtin_amdgcn_readfirstlane(tid >> 6), gw = bid * NWAVES + wave, NGW = G * NWAVES;
        if (ph == 0) { if (PH_MASK & 1) phase_prologue(kp, lds, gw, NGW, wave, lane); }
        else if (ph == N_PHASES - 1) phase_final(kp, gw, NGW, lane);
        else {
            const int li = (ph - 1) / SUBS, sub = (ph - 1) % SUBS, j = li >> 1; const bool ab = (li & 1) == 0;
            float* RSS = (float*)(ws + WS_RSS);
            if (sub == 0) {
                const int N = ab ? NAB : NCD;
                const bf16* Bt = ab ? (const bf16*)(ws + WS_WABIN) + (size_t)j * NAB * 2048 : (const bf16*)(ws + WS_WCDIN) + (size_t)j * NCD * 2048;
                { pg8::Gemm g{(const bf16*)(ws + WS_XN), Bt, T, N, 2048}; pg8::StaticOrder S; S.init(T, N, G, bid);
                  pg8::EpiU E{(bf16*)(ws + WS_U), N, RSS + (size_t)(2 * li) * T};
                  if (PH_MASK & 2) pg8::gemm_phase<pg8::EpiU, pg8::StaticOrder, true, true>(lds, g, S, E, tid); }
                { int tid2 = tid; asm volatile("" : "+v"(tid2));
                  pg8::Gemm g{(const bf16*)(ws + WS_PB) + (size_t)li * T * 256, (const bf16*)(ws + WS_WPROJ) + (size_t)li * 2048 * 256, T, 2048, 256}; pg8::StaticOrder S; S.init(T, 2048, G, (bid + 37) % G);
                  pg8::EpiU E{(bf16*)(ws + WS_SCR + SC_PP), 2048, nullptr};
                  if (PH_MASK & 2) pg8::gemm_phase<pg8::EpiU, pg8::StaticOrder, true, true>(lds, g, S, E, tid2); }
            } else if (sub == 4) {
                const bf16* Bt = ab ? (const bf16*)(ws + WS_WABOUT) + (size_t)j * 2048 * 2048 : (const bf16*)(ws + WS_WCDOUT) + (size_t)j * 2048 * 2048;
                pg8::Gemm g{(const bf16*)(ws + WS_YM), Bt, TP, 2048, 2048}; pg8::StaticOrder S; S.init(TP, 2048, G, bid);
                pg8::EpiRes<false> E{(const bf16*)(ws + WS_XN), (bf16*)(ws + WS_SCR + SC_HB1), RSS + (size_t)(2 * li + 1) * T, nullptr, nullptr};
                if (PH_MASK & 4) pg8::gemm_phase<pg8::EpiRes<false>, pg8::StaticOrder, true, true>(lds, g, S, E, tid);
                { int tid2 = tid; asm volatile("" : "+v"(tid2));
                  sample_gemm_res<false>((const bf16*)(ws + WS_YM), Bt, (const bf16*)(ws + WS_XN), (bf16*)(ws + WS_SCR + SC_HB1), RSS + (size_t)(2 * li + 1) * T, nullptr, nullptr, bid, tid2); }
            } else if (sub == 5) {
                pg8::Gemm g{(const bf16*)(ws + WS_SCR + SC_HB1), (const bf16*)(ws + WS_WGATE) + (size_t)li * 2048 * 2048, TP, 2048, 2048}; pg8::StaticOrder S; S.init(TP, 2048, G, bid);
                pg8::EpiRes<true> E{(const bf16*)(ws + WS_SCR + SC_HB1), (bf16*)(ws + WS_XN), RSS + (size_t)(2 * li + 2) * T, (const bf16*)(ws + WS_SCR + SC_PP), RSS + (size_t)(2 * li + 1) * T};
                if (PH_MASK & 4) pg8::gemm_phase<pg8::EpiRes<true>, pg8::StaticOrder, true, true>(lds, g, S, E, tid);
                { int tid2 = tid; asm volatile("" : "+v"(tid2));
                  sample_gemm_res<true>((const bf16*)(ws + WS_SCR + SC_HB1), (const bf16*)(ws + WS_WGATE) + (size_t)li * 2048 * 2048, (const bf16*)(ws + WS_SCR + SC_HB1), (bf16*)(ws + WS_XN), RSS + (size_t)(2 * li + 2) * T,
                                        (const bf16*)(ws + WS_SCR + SC_PP), RSS + (size_t)(2 * li + 1) * T, bid, tid2); }
            } else if (sub == 1) {
                if (ab) { if (PH_MASK & 4096) phase_gla_prep(kp, bid, G, j, lds, tid); if (PH_MASK & 8192) phase_dn_prep(kp, bid, G, j, lds, tid); }
                else { if (PH_MASK & 2048) { phase_ssd_prep(kp, bid, G, j, lds, tid); phase_lru_gates(kp, bid, G, j, lds, tid); } }
            }
            else if (sub == 2) { if (ab) { if (PH_MASK & 32) phase_ab_rec(kp, bid, G, j, li, lds, tid); } else { if (PH_MASK & 64) phase_cd_rec(kp, bid, G, j, li, lds, tid); } }
            else { if (ab) { if (PH_MASK & 128) phase_ab_post(kp, bid, G, j, tid, wave, lane); } else { if (PH_MASK & 256) phase_cd_post(kp, bid, G, j, tid, wave, lane); } }
        }
        if (ph + 1 < A.ph_hi) { if (ph == A.ph_lo) cg::this_grid().sync(); else xcd_barrier(xbar); }
#ifdef PROBE_GROUP
        { const unsigned long long t_now = __builtin_amdgcn_s_memrealtime(); const int li_ = (ph - 1) / SUBS, sub_ = (ph - 1) % SUBS; const bool ab_ = (li_ & 1) == 0;
          int grp = 9; if (ph == N_PHASES - 1) grp = 8; else if (ph > 0) { if (sub_ == 0 || sub_ == 4 || sub_ == 5) grp = 1; else if (sub_ == 1) grp = ab_ ? 4 : 5; else if (sub_ == 2) grp = ab_ ? 6 : 7; else grp = 8; }
          if (grp == PROBE_GROUP) t_sel += t_now - t_prev; t_prev = t_now; }
#endif
    }
#ifdef PROBE_GROUP
    if (blockIdx.x == 0 && threadIdx.x == 0) { const unsigned long long t0 = __builtin_amdgcn_s_memrealtime(); while (__builtin_amdgcn_s_memrealtime() - t0 < 3 * t_sel) __builtin_amdgcn_s_sleep(8); }
#endif
}

extern "C" void kernel_launch(void* const* d_in, const int* in_sizes, int n_in, void* d_out, int out_size, void* d_ws, size_t ws_size, hipStream_t stream) {
    static int grid = 0;
    if (grid == 0) {
        if (n_in != 40 || (size_t)out_size != O_END || ws_size < WS_END) { fprintf(stderr, "kernel_launch: unexpected shapes: n_in %d out %d ws %zu\n", n_in, out_size, ws_size); grid = -1; return; }
        int dev = 0, cus = 0, per_cu = 0;
        if (hipGetDevice(&dev) != hipSuccess || hipDeviceGetAttribute(&cus, hipDeviceAttributeMultiprocessorCount, dev) != hipSuccess) { grid = -1; return; }
        if (hipFuncSetAttribute((const void*)mega_fwd, hipFuncAttributeMaxDynamicSharedMemorySize, LDS_BYTES) != hipSuccess) { fprintf(stderr, "kernel_launch: hipFuncSetAttribute failed\n"); grid = -1; return; }
        if (hipOccupancyMaxActiveBlocksPerMultiprocessor(&per_cu, (const void*)mega_fwd, NTHR, LDS_BYTES) != hipSuccess || per_cu < 1) { fprintf(stderr, "kernel_launch: occupancy query says %d\n", per_cu); per_cu = 1; }
        (void)hipGetLastError();
        grid = cus;
    }
    if (grid < 0) return;
    if (hipMemsetAsync((char*)d_ws + WS_CTL, 0, CTL_ZERO_BYTES, stream) != hipSuccess) { fprintf(stderr, "kernel_launch: memset of the control words failed\n"); return; }
    Args a{};
    for (int i = 0; i < 40; ++i) a.in[i] = (const float*)d_in[i];
    a.out = (float*)d_out; a.ws = (unsigned char*)d_ws;
#if MK_N_LAUNCHES == 1
    a.ph_lo = 0; a.ph_hi = N_PHASES;
    void* args[] = {&a};
    hipError_t e = hipLaunchCooperativeKernel((const void*)mega_fwd, dim3(grid), dim3(NTHR), args, LDS_BYTES, stream);
    if (e != hipSuccess) fprintf(stderr, "cooperative launch failed: %s (grid %d)\n", hipGetErrorString(e), grid);
#else
    for (int ph = 0; ph < N_PHASES; ++ph) { a.ph_lo = ph; a.ph_hi = ph + 1; mega_fwd<<<dim3(grid), dim3(NTHR), LDS_BYTES, stream>>>(a); }
#endif
}
```

```cpp
#include <hip/hip_runtime.h>
#include <hip/hip_cooperative_groups.h>
#include <cstdio>
#include <cstdint>
namespace cg = cooperative_groups;

#ifndef MK_N_LAUNCHES
#define MK_N_LAUNCHES 1
#endif

namespace pg8 {
#define PG8_LAS __attribute__((address_space(3)))
typedef unsigned short bf16_t;
typedef short bf16x8 __attribute__((ext_vector_type(8)));
typedef float f32x4 __attribute__((ext_vector_type(4)));
typedef unsigned u32x4 __attribute__((ext_vector_type(4)));
constexpr int BM = 256, BK = 64, HALF = 128, HTB = HALF * BK * 2  , STAGE_BYTES = 8 * HTB, NXCD = 8, WGM = 8;

__host__ __device__ __forceinline__ int lds_byte(int r, int c) { const int st = (r >> 4) * 2 + (c >> 5), rr = r & 15, cc = c & 31, ob = rr * 64 + cc * 2; return st * 1024 + (ob ^ (((ob >> 9) & 1) << 5)); }
__host__ __device__ __forceinline__ void stage_rc(int b, int& R, int& C) { const int st = b / 1024, sb = b % 1024, swz = sb ^ (((sb >> 9) & 1) << 5); R = (st >> 1) * 16 + swz / 64; C = (st & 1) * 32 + (swz % 64) / 2; }
__host__ __device__ __forceinline__ int perm32(int rho) { const int n = rho >> 4, i = rho & 15; return 8 * (i >> 2) + 4 * n + (i & 3); }

struct Unit { int pm, pn; };
struct Gemm { const bf16_t* A; const bf16_t* Bt; int M, N, K; };

struct StaticOrder {
    int nM, nN, nwg, G, c;
    __host__ __device__ void init(int M, int N, int G_, int c_) { nM = M / BM; nN = N / BM; nwg = nM * nN; G = G_; c = c_; }
    __host__ __device__ bool next(int i, Unit& u) const {
        const long L = (long)i * G + c; if (L >= nwg) return false;
        int wgid = (int)L; { const int q = nwg / NXCD, r = nwg % NXCD, xcd = wgid % NXCD, off = wgid / NXCD; wgid = (xcd < r ? xcd * (q + 1) : r * (q + 1) + (xcd - r) * q) + off; }
        const int nig = WGM * nN, gid = wgid / nig, fm = gid * WGM, gsz = (nM - fm) < WGM ? (nM - fm) : WGM;
        u.pm = fm + ((wgid % nig) % gsz); u.pn = (wgid % nig) / gsz; return true;
    }
    __device__ __forceinline__ void a_ready(const Unit&) const {}
    __device__ __forceinline__ void done(const Unit&) const {}
};

__device__ __forceinline__ unsigned cvt_pk_bf16(float lo, float hi) { unsigned r; asm volatile("v_cvt_pk_bf16_f32 %0, %1, %2" : "=v"(r) : "v"(lo), "v"(hi)); return r; }
struct EpiF32 {
    static constexpr bool PERM = false, AFTER_DRAIN = false;
    float* C; int ldc;
    __device__ __forceinline__ void operator()(const f32x4 (&acc)[2][2][4][2], const Unit& u, int wr, int wc, int fr, int fq) const {
        const int row0 = u.pm * BM + wr * 64 + fr, col0 = u.pn * BM + wc * 32 + 4 * fq;
#pragma unroll
        for (int ai = 0; ai < 2; ++ai)
#pragma unroll
            for (int m = 0; m < 4; ++m) { float* rowp = C + (size_t)(row0 + ai * HALF + m * 16) * ldc + col0;
#pragma unroll
                for (int bj = 0; bj < 2; ++bj)
#pragma unroll
                    for (int n = 0; n < 2; ++n) *(f32x4*)(rowp + bj * HALF + n * 16) = acc[ai][bj][m][n]; }
    }
};
struct EpiBf16 {
    static constexpr bool PERM = true, AFTER_DRAIN = false;
    bf16_t* O; int ldc;
    __device__ __forceinline__ void operator()(const f32x4 (&acc)[2][2][4][2], const Unit& u, int wr, int wc, int fr, int fq) const {
        const int row0 = u.pm * BM + wr * 64 + fr; const int col0 = u.pn * BM + wc * 32 + 8 * fq;
#pragma unroll
        for (int ai = 0; ai < 2; ++ai)
#pragma unroll
            for (int m = 0; m < 4; ++m) { bf16_t* rowp = O + (size_t)(row0 + ai * HALF + m * 16) * ldc + col0;
#pragma unroll
                for (int bj = 0; bj < 2; ++bj) { const f32x4 v0 = acc[ai][bj][m][0], v1 = acc[ai][bj][m][1];
                    u32x4 w; w.x = cvt_pk_bf16(v0[0], v0[1]); w.y = cvt_pk_bf16(v0[2], v0[3]); w.z = cvt_pk_bf16(v1[0], v1[1]); w.w = cvt_pk_bf16(v1[2], v1[3]);
                    *(u32x4*)(rowp + bj * HALF) = w; } }
    }
};

struct EpiU {
    static constexpr bool PERM = true, AFTER_DRAIN = false;
    bf16_t* O; int ldc; const float* rss;
    __device__ __forceinline__ void operator()(const f32x4 (&acc)[2][2][4][2], const Unit& u, int wr, int wc, int fr, int fq) const {
        const int row0 = u.pm * BM + wr * 64 + fr; const int col0 = u.pn * BM + wc * 32 + 8 * fq;
#pragma unroll
        for (int ai = 0; ai < 2; ++ai)
#pragma unroll
            for (int m = 0; m < 4; ++m) { const int row = row0 + ai * HALF + m * 16; const float sc = rss ? rsqrtf(rss[row] * (1.f / 2048.f) + 1e-6f) : 1.f;
                bf16_t* rowp = O + (size_t)row * ldc + col0;
#pragma unroll
                for (int bj = 0; bj < 2; ++bj) { const f32x4 v0 = acc[ai][bj][m][0] * sc, v1 = acc[ai][bj][m][1] * sc;
                    u32x4 w; w.x = cvt_pk_bf16(v0[0], v0[1]); w.y = cvt_pk_bf16(v0[2], v0[3]); w.z = cvt_pk_bf16(v1[0], v1[1]); w.w = cvt_pk_bf16(v1[2], v1[3]);
                    *(u32x4*)(rowp + bj * HALF) = w; } }
    }
};
typedef unsigned u32x2e __attribute__((ext_vector_type(2)));
template <bool GATE> struct EpiRes {
    static constexpr bool PERM = false, AFTER_DRAIN = false;
    const bf16_t* Hin; bf16_t* Hout; float* rss_out; const bf16_t* PP; const float* rss_in;
    __device__ __forceinline__ void operator()(const f32x4 (&acc)[2][2][4][2], const Unit& u, int wr, int wc, int fr, int fq) const {
        const int row0 = u.pm * BM + wr * 64 + fr, col0 = u.pn * BM + wc * 32 + 4 * fq;
#pragma unroll
        for (int ai = 0; ai < 2; ++ai)
#pragma unroll
            for (int m = 0; m < 4; ++m) { const int row = row0 + ai * HALF + m * 16; const size_t ro = (size_t)row * 2048 + col0;
                float sc = 1.f; if (GATE) sc = rsqrtf(rss_in[row] * (1.f / 2048.f) + 1e-6f);
                float s = 0.f;
#pragma unroll
                for (int bj = 0; bj < 2; ++bj)
#pragma unroll
                    for (int n = 0; n < 2; ++n) { const size_t p = ro + bj * HALF + n * 16; const u32x2e hw = *(const u32x2e*)(Hin + p); const f32x4 a = acc[ai][bj][m][n];
                        f32x4 h; h[0] = __uint_as_float(hw.x << 16); h[1] = __uint_as_float(hw.x & 0xffff0000u); h[2] = __uint_as_float(hw.y << 16); h[3] = __uint_as_float(hw.y & 0xffff0000u);
                        if (GATE) { const u32x2e pw = *(const u32x2e*)(PP + p);
                            h[0] += __builtin_amdgcn_rcpf(1.f + __expf(-sc * a[0])) * __uint_as_float(pw.x << 16); h[1] += __builtin_amdgcn_rcpf(1.f + __expf(-sc * a[1])) * __uint_as_float(pw.x & 0xffff0000u);
                            h[2] += __builtin_amdgcn_rcpf(1.f + __expf(-sc * a[2])) * __uint_as_float(pw.y << 16); h[3] += __builtin_amdgcn_rcpf(1.f + __expf(-sc * a[3])) * __uint_as_float(pw.y & 0xffff0000u); }
                        else h = h + a;
                        s += (h[0] * h[0] + h[1] * h[1]) + (h[2] * h[2] + h[3] * h[3]);
                        u32x2e o; o.x = cvt_pk_bf16(h[0], h[1]); o.y = cvt_pk_bf16(h[2], h[3]); *(u32x2e*)(Hout + p) = o; }
                s += __shfl_xor(s, 16); s += __shfl_xor(s, 32);
                if (fq == 0) atomicAdd(rss_out + row, s);
                asm volatile("" ::: "memory"); }
    }
};
template <class Epi, class Sched, bool ALIGN_EPI = false, bool SP2 = false>
__device__ __forceinline__ void gemm_phase(PG8_LAS unsigned char* lds, const Gemm g, const Sched& S, const Epi& E, const int tid) {
    const int wid = __builtin_amdgcn_readfirstlane(tid >> 6), lane = tid & 63, wr = wid >> 2, wc = wid & 3, fr = lane & 15, fq = lane >> 4;
    const int K = g.K, nt = K / BK;
    unsigned voffA[2], voffB[2];
#pragma unroll
    for (int i = 0; i < 2; ++i) { int R, C; stage_rc(tid * 16 + i * 8192, R, C); const int Rb = Epi::PERM ? ((R & ~31) + perm32(R & 31)) : R;
        voffA[i] = (unsigned)(R * K + C) * 2u; voffB[i] = (unsigned)(Rb * K + C) * 2u; }
    const size_t kstep = (size_t)(BK * 2);
    const size_t hstep = (size_t)HALF * K * 2;
    const size_t tstep = 2 * hstep;
    const unsigned ldsw = (unsigned)wid * 1024u;
    const int aoff = lds_byte(wr * 64 + fr, fq * 8), boff = lds_byte(wc * 32 + fr, fq * 8);
#define PG8_SA(b, h) (((b) * 2 + (h)) * HTB)
#define PG8_SB(b, h) ((4 + (b) * 2 + (h)) * HTB)
#define PG8_STAGE(bufoff, gbase, voff) do { _Pragma("unroll") for (int _i = 0; _i < 2; ++_i) \
        __builtin_amdgcn_global_load_lds((const unsigned*)((const char*)(gbase) + (voff)[_i]), (PG8_LAS unsigned*)(lds + (bufoff) + ldsw + _i * 8192), 16, 0, 0); } while (0)
#define PG8_LDA(dst, b, h) do { _Pragma("unroll") for (int m = 0; m < 4; ++m) _Pragma("unroll") for (int k = 0; k < 2; ++k) dst[m][k] = *(const PG8_LAS bf16x8*)(lds + PG8_SA(b, h) + aoff + m * 2048 + k * 1024); } while (0)
#define PG8_LDB(dst, b, h) do { _Pragma("unroll") for (int n = 0; n < 2; ++n) _Pragma("unroll") for (int k = 0; k < 2; ++k) dst[n][k] = *(const PG8_LAS bf16x8*)(lds + PG8_SB(b, h) + boff + n * 2048 + k * 1024); } while (0)
#define PG8_MMA(ai, bj, At, Bt) do { __builtin_amdgcn_s_setprio(1); _Pragma("unroll") for (int m = 0; m < 4; ++m) _Pragma("unroll") for (int n = 0; n < 2; ++n) _Pragma("unroll") for (int k = 0; k < 2; ++k) \
        acc[ai][bj][m][n] = __builtin_amdgcn_mfma_f32_16x16x32_bf16(Bt[n][k], At[m][k], acc[ai][bj][m][n], 0, 0, 0); __builtin_amdgcn_s_setprio(0); } while (0)
#define PG8_WAIT_V(n) asm volatile("s_waitcnt vmcnt(" #n ")" ::: "memory")
#define PG8_WAIT_L(n) asm volatile("s_waitcnt lgkmcnt(" #n ")" ::: "memory")
#define PG8_BAR __builtin_amdgcn_s_barrier()
#define PG8_SCHED __builtin_amdgcn_sched_barrier(0)
    Unit cur, nxt; int ui = 0;
    if (!S.next(0, cur)) return;
    f32x4 acc[2][2][4][2];
#pragma unroll
    for (int a = 0; a < 2; ++a)
#pragma unroll
        for (int b = 0; b < 2; ++b)
#pragma unroll
            for (int m = 0; m < 4; ++m)
#pragma unroll
                for (int n = 0; n < 2; ++n) acc[a][b][m][n] = (f32x4){0.f, 0.f, 0.f, 0.f};
    bf16x8 At[4][2], B0[2][2], B1[2][2];
    const char* cA = (const char*)g.A + (size_t)cur.pm * tstep; const char* cB = (const char*)g.Bt + (size_t)cur.pn * tstep;
    S.a_ready(cur);
    if constexpr (SP2) {
        PG8_STAGE(PG8_SB(0, 0), cB, voffB); PG8_STAGE(PG8_SB(0, 1), cB + hstep, voffB); PG8_STAGE(PG8_SA(0, 0), cA, voffA); PG8_STAGE(PG8_SA(0, 1), cA + hstep, voffA);
        if (wr == 1) PG8_BAR;
        PG8_WAIT_V(2); PG8_BAR;
        PG8_STAGE(PG8_SB(1, 0), cB + kstep, voffB); PG8_STAGE(PG8_SA(1, 0), cA + kstep, voffA); PG8_STAGE(PG8_SB(1, 1), cB + hstep + kstep, voffB);
        PG8_WAIT_V(6); PG8_BAR;
    } else {
        PG8_STAGE(PG8_SB(0, 0), cB, voffB); PG8_STAGE(PG8_SA(0, 0), cA, voffA); PG8_STAGE(PG8_SB(0, 1), cB + hstep, voffB); PG8_STAGE(PG8_SA(0, 1), cA + hstep, voffA);
        if (wr == 1) PG8_BAR;
        PG8_WAIT_V(4); PG8_BAR;
        PG8_STAGE(PG8_SB(1, 0), cB + kstep, voffB); PG8_STAGE(PG8_SA(1, 0), cA + kstep, voffA); PG8_STAGE(PG8_SB(1, 1), cB + hstep + kstep, voffB);
        PG8_WAIT_V(6); PG8_BAR;
    }
    for (;;) {
        const bool has_next = S.next(ui + 1, nxt);
        const char* nA = has_next ? (const char*)g.A + (size_t)nxt.pm * tstep : cA; const char* nB = has_next ? (const char*)g.Bt + (size_t)nxt.pn * tstep : cB;
        for (int t = 0; t < nt; t += 2) {
            const bool last = (t == nt - 2);
            const char* a1 = cA + (size_t)(t + 1) * kstep;
            const char* a2 = last ? nA : cA + (size_t)(t + 2) * kstep; const char* b2 = last ? nB : cB + (size_t)(t + 2) * kstep;
            const char* a3 = a2 + kstep; const char* b3 = b2 + kstep;
            if (last && has_next) S.a_ready(nxt);
            if constexpr (SP2) {
            PG8_LDB(B0, 0, 0); PG8_LDB(B1, 0, 1); PG8_SCHED; PG8_LDA(At, 0, 0); PG8_STAGE(PG8_SA(1, 1), a1 + hstep, voffA);
            PG8_WAIT_V(8); PG8_WAIT_L(0); PG8_BAR; PG8_MMA(0, 0, At, B0); PG8_MMA(0, 1, At, B1); PG8_BAR; PG8_SCHED;
            PG8_LDA(At, 0, 1); PG8_STAGE(PG8_SB(0, 0), b2, voffB); PG8_STAGE(PG8_SB(0, 1), b2 + hstep, voffB); PG8_STAGE(PG8_SA(0, 0), a2, voffA);
            PG8_WAIT_V(8); PG8_WAIT_L(0); PG8_BAR; PG8_MMA(1, 0, At, B0); PG8_MMA(1, 1, At, B1); PG8_BAR; PG8_SCHED;
            PG8_LDB(B0, 1, 0); PG8_LDB(B1, 1, 1); PG8_SCHED; PG8_LDA(At, 1, 0); PG8_STAGE(PG8_SA(0, 1), a2 + hstep, voffA);
            PG8_WAIT_V(8); PG8_WAIT_L(0); PG8_BAR; PG8_MMA(0, 0, At, B0); PG8_MMA(0, 1, At, B1); PG8_BAR; PG8_SCHED;
            PG8_LDA(At, 1, 1); PG8_STAGE(PG8_SB(1, 0), b3, voffB); PG8_STAGE(PG8_SB(1, 1), b3 + hstep, voffB); PG8_STAGE(PG8_SA(1, 0), a3, voffA);
            PG8_WAIT_V(8); PG8_WAIT_L(0); PG8_BAR; PG8_MMA(1, 0, At, B0); PG8_MMA(1, 1, At, B1); PG8_BAR; PG8_SCHED;
            } else {
            PG8_LDB(B0, 0, 0); PG8_SCHED; PG8_LDA(At, 0, 0); PG8_STAGE(PG8_SA(1, 1), a1 + hstep, voffA);
            PG8_WAIT_L(8); PG8_BAR; PG8_WAIT_L(0); PG8_MMA(0, 0, At, B0); PG8_BAR; PG8_SCHED;
            PG8_LDB(B1, 0, 1); PG8_STAGE(PG8_SB(0, 0), b2, voffB);
            PG8_BAR; PG8_WAIT_L(0); PG8_MMA(0, 1, At, B1); PG8_BAR;
            PG8_LDA(At, 0, 1); PG8_STAGE(PG8_SA(0, 0), a2, voffA);
            PG8_BAR; PG8_WAIT_L(0); PG8_MMA(1, 0, At, B0); PG8_BAR; PG8_SCHED;
            PG8_STAGE(PG8_SB(0, 1), b2 + hstep, voffB);
            PG8_WAIT_V(6); PG8_BAR; PG8_MMA(1, 1, At, B1); PG8_BAR;
            PG8_LDB(B0, 1, 0); PG8_SCHED; PG8_LDA(At, 1, 0); PG8_STAGE(PG8_SA(0, 1), a2 + hstep, voffA);
            PG8_WAIT_L(8); PG8_BAR; PG8_WAIT_L(0); PG8_MMA(0, 0, At, B0); PG8_BAR; PG8_SCHED;
            PG8_LDB(B1, 1, 1); PG8_STAGE(PG8_SB(1, 0), b3, voffB);
            PG8_BAR; PG8_WAIT_L(0); PG8_MMA(0, 1, At, B1); PG8_BAR;
            PG8_LDA(At, 1, 1); PG8_STAGE(PG8_SA(1, 0), a3, voffA);
            PG8_BAR; PG8_WAIT_L(0); PG8_MMA(1, 0, At, B0); PG8_BAR; PG8_SCHED;
            PG8_STAGE(PG8_SB(1, 1), b3 + hstep, voffB);
            PG8_WAIT_V(6); PG8_BAR; PG8_MMA(1, 1, At, B1); PG8_BAR;
            }
        }
        if constexpr (ALIGN_EPI) { if (wr == 0) PG8_BAR; }
        if constexpr (!Epi::AFTER_DRAIN) { E(acc, cur, wr, wc, fr, fq); S.done(cur); }
        if (!has_next) break;
#pragma unroll
        for (int a = 0; a < 2; ++a)
#pragma unroll
            for (int b = 0; b < 2; ++b)
#pragma unroll
                for (int m = 0; m < 4; ++m)
#pragma unroll
                    for (int n = 0; n < 2; ++n) acc[a][b][m][n] = (f32x4){0.f, 0.f, 0.f, 0.f};
        cur = nxt; cA = nA; cB = nB; ++ui;
        if constexpr (ALIGN_EPI) { if (wr == 1) PG8_BAR; }
    }
    PG8_WAIT_V(0);
    if constexpr (!ALIGN_EPI) { if (wr == 0) PG8_BAR; }
    PG8_BAR;
    if constexpr (Epi::AFTER_DRAIN) { E.fused(acc, cur, wr, wc, fr, fq, lds, wid, lane); S.done(cur); }
#undef PG8_SA
#undef PG8_SB
#undef PG8_STAGE
#undef PG8_LDA
#undef PG8_LDB
#undef PG8_MMA
#undef PG8_WAIT_V
#undef PG8_WAIT_L
#undef PG8_BAR
#undef PG8_SCHED
}
}

constexpr int TP = 8192, TS = 512, T = TP + TS, DM = 2048, NSEQ = 132;
constexpr int NAB = 7424, NCD = 4864;
constexpr int NWAVES = 8, NTHR = 512;
constexpr size_t MiB = 1u << 20;
constexpr size_t WS_CTL = 0, CTL_ZERO_BYTES = 1 * MiB;
constexpr int CW_BAR = 4096, CW_CNT = 8192;
constexpr size_t WS_RSS = 65536;
constexpr size_t WS_WABIN = 2 * MiB, WS_WABOUT = 60 * MiB, WS_WCDIN = 76 * MiB, WS_WCDOUT = 114 * MiB, WS_WGATE = 130 * MiB, WS_WPROJ = 162 * MiB;
constexpr size_t WS_H = 166 * MiB, WS_XN = 234 * MiB, WS_YM = 268 * MiB, WS_PB = 302 * MiB, WS_U = 320 * MiB, WS_SCR = 444 * MiB, WS_END = 732 * MiB;
constexpr size_t SC_HB1 = 102 * MiB;
constexpr size_t SC_PP = 8 * MiB;
constexpr size_t SC_QN = 0, SC_KN = 2 * MiB, SC_VV = 4 * MiB, SC_GLOG = 6 * MiB, SC_BETA = 7 * MiB, SC_GDEC = 7 * MiB + 65536, SC_ODN = 102 * MiB, SC_OGLA = 136 * MiB,
    SC_DNOPS = 192 * MiB;
constexpr size_t SC_XBC = 0, SC_DT = 3 * MiB, SC_LA = 52 * MiB, SC_LB = 86 * MiB, SC_YS = 120 * MiB, SC_HS = 154 * MiB, SC_SSDOP = 192 * MiB, SC_XS = 270 * MiB;
constexpr int LDS_BYTES = 163840;
constexpr size_t O_Y_P = 0, O_Y_S = O_Y_P + (size_t)4 * 2048 * 2048, O_DN_P = O_Y_S + (size_t)128 * 4 * 2048,
    O_DNC_P = O_DN_P + (size_t)2 * 4 * 8 * 128 * 128, O_GLA_P = O_DNC_P + (size_t)2 * 4 * 3 * 3072, O_SSD_P = O_GLA_P + (size_t)2 * 4 * 4 * 128 * 256,
    O_SSDC_P = O_SSD_P + (size_t)2 * 4 * 16 * 64 * 64, O_LRU_P = O_SSDC_P + (size_t)2 * 4 * 3 * 1536, O_LRUC_P = O_LRU_P + (size_t)2 * 4 * 1024,
    O_DN_S = O_LRUC_P + (size_t)2 * 4 * 3 * 1024, O_DNC_S = O_DN_S + (size_t)2 * 128 * 8 * 128 * 128, O_GLA_S = O_DNC_S + (size_t)2 * 128 * 3 * 3072,
    O_SSD_S = O_GLA_S + (size_t)2 * 128 * 4 * 128 * 256, O_SSDC_S = O_SSD_S + (size_t)2 * 128 * 16 * 64 * 64, O_LRU_S = O_SSDC_S + (size_t)2 * 128 * 3 * 1536,
    O_LRUC_S = O_LRU_S + (size_t)2 * 128 * 1024, O_END = O_LRUC_S + (size_t)2 * 128 * 3 * 1024;
static_assert(O_END == 109064192, "output size");

#define LAS __attribute__((address_space(3)))
typedef unsigned short bf16;
typedef float f32x4 __attribute__((ext_vector_type(4)));
typedef unsigned u32x2 __attribute__((ext_vector_type(2)));
typedef unsigned u32x4 __attribute__((ext_vector_type(4)));
#define LDS_WAIT() asm volatile("s_waitcnt lgkmcnt(0)" ::: "memory")

__device__ __forceinline__ float bf2f(bf16 b) { return __uint_as_float(((unsigned)b) << 16); }
__device__ __forceinline__ unsigned f2bf(float f) { unsigned u = __float_as_uint(f); return (u + 0x7fffu + ((u >> 16) & 1u)) >> 16; }
__device__ __forceinline__ unsigned pk2(float lo, float hi) { return f2bf(lo) | (f2bf(hi) << 16); }
__device__ __forceinline__ float sigmoid_(float x) { return __builtin_amdgcn_rcpf(1.f + __expf(-x)); }
__device__ __forceinline__ float silu_(float x) { return x * __builtin_amdgcn_rcpf(1.f + __expf(-x)); }
__device__ __forceinline__ float softplus_(float x) { return x > 15.f ? x : (x < -15.f ? __expf(x) : __logf(1.f + __expf(x))); }
__device__ __forceinline__ float wave_sum(float v) {
#pragma unroll
    for (int o = 1; o < 64; o <<= 1) v += __shfl_xor(v, o);
    return v;
}
__device__ __forceinline__ void row_to_seq(int r, int& s, int& t) { if (r < TP) { s = r >> 11; t = r & 2047; } else { s = 4 + ((r - TP) >> 2); t = (r - TP) & 3; } }
__device__ __forceinline__ void seq_info(int s, int& row0, int& L) { if (s < 4) { row0 = s << 11; L = 2048; } else { row0 = TP + ((s - 4) << 2); L = 4; } }
__device__ __forceinline__ float pre_val(const bf16* U, int ldu, int ucol, int row0, int tt, int s, const float* stc, int W, int c) {
    if (tt >= 0) return bf2f(U[(size_t)(row0 + tt) * ldu + ucol]);
    if (s < 4) return 0.f;
    return stc[((size_t)(s - 4) * 3 + (3 + tt)) * W + c];
}
__device__ __forceinline__ int map_col(int mapid, int n) {
    if (mapid == 0) return n;
    if (mapid == 1) { if (n < 3072) return n; if (n < 6144) return n + 16; if (n < 7168) return n + 32; if (n < 7184) return n - 4096; if (n < 7200) return n - 1024; return -1; }
    if (n < 2560) return n; if (n < 4608) return n + 16; if (n < 4624) return n - 2048; return -1;
}
__device__ __forceinline__ void transpose_item(const float* W, int K, int Nsrc, bf16* WT, int Npad, int mapid, const float* gain, LAS float* scr, int item, int lane) {
    const int nblk = Npad / 64, kb = item / nblk, nb = item % nblk, k0 = 64 * kb, n0 = 64 * nb;
    const int n4 = (lane & 15) * 4, src = map_col(mapid, n0 + n4);
#pragma unroll 8
    for (int i = 0; i < 16; ++i) { const int kk = 4 * i + (lane >> 4);
        f32x4 v = (f32x4){0.f, 0.f, 0.f, 0.f};
        if (src >= 0) { v = *(const f32x4*)(W + (size_t)(k0 + kk) * Nsrc + src); if (gain) v = v * gain[k0 + kk]; }
        scr[kk * 65 + n4] = v.x; scr[kk * 65 + n4 + 1] = v.y; scr[kk * 65 + n4 + 2] = v.z; scr[kk * 65 + n4 + 3] = v.w; }
    LDS_WAIT(); asm volatile("" ::: "memory");
    const int c = lane & 7;
#pragma unroll
    for (int jj = 0; jj < 8; ++jj) { const int n = (lane >> 3) + 8 * jj; const LAS float* p = scr + (8 * c) * 65 + n;
        u32x4 o; o.x = pk2(p[0 * 65], p[1 * 65]); o.y = pk2(p[2 * 65], p[3 * 65]); o.z = pk2(p[4 * 65], p[5 * 65]); o.w = pk2(p[6 * 65], p[7 * 65]);
        *(u32x4*)(WT + (size_t)(n0 + n) * K + k0 + 8 * c) = o; }
    LDS_WAIT(); asm volatile("" ::: "memory");
}
__device__ __forceinline__ void norm_row_bf16(const f32x4 (&v)[8], const float* g, bf16* orow, int lane) {
    float ss = 0.f;
#pragma unroll
    for (int j = 0; j < 8; ++j) ss += (v[j].x * v[j].x + v[j].y * v[j].y) + (v[j].z * v[j].z + v[j].w * v[j].w);
    const float rstd = rsqrtf(wave_sum(ss) * (1.f / DM) + 1e-6f);
#pragma unroll
    for (int j = 0; j < 8; ++j) { const int col = 4 * (lane + 64 * j); const f32x4 gg = *(const f32x4*)(g + col);
        u32x2 o; o.x = pk2(v[j].x * rstd * gg.x, v[j].y * rstd * gg.y); o.y = pk2(v[j].z * rstd * gg.z, v[j].w * rstd * gg.w);
        *(u32x2*)(orow + col) = o; }
}

typedef __bf16 bf16x2_t __attribute__((ext_vector_type(2)));
typedef float f32x2_t __attribute__((ext_vector_type(2)));
typedef short bf16x8 __attribute__((ext_vector_type(8)));
typedef float f32x16 __attribute__((ext_vector_type(16)));
__device__ __forceinline__ unsigned cvtpk(float lo, float hi) { f32x2_t v = {lo, hi}; bf16x2_t b = __builtin_convertvector(v, bf16x2_t); return __builtin_bit_cast(unsigned, b); }
#define MFMA32(a, b, c) __builtin_amdgcn_mfma_f32_32x32x16_bf16((a), (b), (c), 0, 0, 0)
#define PACK_ACC(x, S_) __builtin_bit_cast(bf16x8, (u32x4){cvtpk((x)[8 * (S_)], (x)[8 * (S_) + 1]), cvtpk((x)[8 * (S_) + 2], (x)[8 * (S_) + 3]), cvtpk((x)[8 * (S_) + 4], (x)[8 * (S_) + 5]), cvtpk((x)[8 * (S_) + 6], (x)[8 * (S_) + 7])})
__device__ __forceinline__ int crow(int reg, int h) { return (reg & 3) + 8 * (reg >> 2) + 4 * h; }
__device__ __forceinline__ bf16x8 pack8(const float (&v)[8]) { return __builtin_bit_cast(bf16x8, (u32x4){cvtpk(v[0], v[1]), cvtpk(v[2], v[3]), cvtpk(v[4], v[5]), cvtpk(v[6], v[7])}); }

#define XB_TMO      128
#define XB_XCNT(j)  (256  + 64 * (j))
#define XB_XSUB(j)  (1280 + 64 * (j))
#define XB_XGEN(j)  (2304 + 64 * (j))
#define XB_TOP      3328
#define XB_TOPGEN   3392
#define XCD_BAR_WORDS 3456
#define XB_SPIN_CAP (1u << 18)

__device__ __forceinline__ unsigned xb_ld(unsigned* p)              { return __hip_atomic_load(p, __ATOMIC_RELAXED, __HIP_MEMORY_SCOPE_AGENT); }
__device__ __forceinline__ unsigned xb_add(unsigned* p, unsigned v) { return __hip_atomic_fetch_add(p, v, __ATOMIC_RELAXED, __HIP_MEMORY_SCOPE_AGENT); }
__device__ __forceinline__ unsigned xb_xcc_id() { return (unsigned)__builtin_amdgcn_s_getreg((3 << 11) | 20) & 0xFu; }
#define XB_SPIN(cond, bar) do { unsigned _sp = 0; while (cond) { __builtin_amdgcn_s_sleep(1); \
    if ((++_sp & 255u) == 0u) { if (xb_ld(&(bar)[XB_TMO])) break; if (_sp > XB_SPIN_CAP) { atomicAdd(&(bar)[XB_TMO], 1u); break; } } } } while (0)

struct XcdBarrier {
    unsigned* bar; unsigned x;
    volatile LAS unsigned* st;
};

__device__ __forceinline__ XcdBarrier xcd_barrier_post(unsigned* bar, volatile LAS unsigned* st) {
    XcdBarrier b; b.bar = bar; b.x = xb_xcc_id(); b.st = st;
    if (threadIdx.x == 0) (void)xb_add(&bar[XB_XCNT(b.x)], 1u);
    return b;
}
__device__ __forceinline__ void xcd_barrier_complete(unsigned* bar, unsigned x, unsigned& nloc, unsigned& nx) {
    const unsigned G = gridDim.x * gridDim.y * gridDim.z;
    unsigned sum, cnt, mine, sp = 0u;
    for (;;) {
        sum = 0u; cnt = 0u; mine = 0u;
#pragma unroll
        for (unsigned j = 0; j < 16; ++j) { const unsigned c = xb_ld(&bar[XB_XCNT(j)]); sum += c; cnt += (c > 0u) ? 1u : 0u; mine = (j == x) ? c : mine; }
        if (sum == G) break;
        __builtin_amdgcn_s_sleep(1);
        if ((++sp & 255u) == 0u) { if (xb_ld(&bar[XB_TMO])) break; if (sp > XB_SPIN_CAP) { atomicAdd(&bar[XB_TMO], 1u); break; } }
    }
    nloc = mine > 0u ? mine : 1u; nx = cnt > 0u ? cnt : 1u;
}

__device__ __forceinline__ void xcd_barrier(const XcdBarrier& b) {
    asm volatile("s_waitcnt vmcnt(0)" ::: "memory");
    __syncthreads();
    if (threadIdx.x == 0) {
        unsigned* bar = b.bar;
        __builtin_amdgcn_s_waitcnt(0);
        unsigned nloc = b.st[0], nx = b.st[1];
        if (nloc == 0u) { xcd_barrier_complete(bar, b.x, nloc, nx); b.st[0] = nloc; b.st[1] = nx; }
        const unsigned old = xb_add(&bar[XB_XSUB(b.x)], 1u);
        const unsigned gen = old / nloc;
        if (old + 1u == (gen + 1u) * nloc) {
            __builtin_amdgcn_fence(__ATOMIC_RELEASE, "agent");
            asm volatile("s_waitcnt vmcnt(0)" ::: "memory");
            const unsigned og = xb_add(&bar[XB_TOP], 1u);
            const unsigned tg = og / nx;
            if (og + 1u == (tg + 1u) * nx) xb_add(&bar[XB_TOPGEN], 1u);
            else XB_SPIN(xb_ld(&bar[XB_TOPGEN]) == tg, bar);
            __builtin_amdgcn_fence(__ATOMIC_ACQUIRE, "agent");
            xb_add(&bar[XB_XGEN(b.x)], 1u);
            asm volatile("s_waitcnt vmcnt(0)" ::: "memory");
        } else {
            XB_SPIN(xb_ld(&bar[XB_XGEN(b.x)]) == gen, bar);
            __builtin_amdgcn_fence(__ATOMIC_ACQUIRE, "agent");
            asm volatile("s_waitcnt vmcnt(0)" ::: "memory");
        }
    }
    __syncthreads();
}


#ifdef PROBE_SEC
#define SEC_BEGIN(id) unsigned long long _sec_t##id = 0; if ((id) == PROBE_SEC) { __builtin_amdgcn_s_barrier(); _sec_t##id = __builtin_amdgcn_s_memrealtime(); }
#define SEC_END(id, ldsp) if ((id) == PROBE_SEC) { __builtin_amdgcn_s_barrier(); if (threadIdx.x == 0) { volatile LAS unsigned long long* a_ = (volatile LAS unsigned long long*)((ldsp) + LDS_BYTES - 32); a_[0] = a_[0] + (__builtin_amdgcn_s_memrealtime() - _sec_t##id); } }
#else
#define SEC_BEGIN(id)
#define SEC_END(id, ldsp)
#endif
struct Args { const float* in[40]; float* out; unsigned char* ws; int ph_lo, ph_hi; };
constexpr int N_PHASES = 26, SUBS = 6;
#ifndef PH_MASK
#define PH_MASK 16383
#endif
#define AS4 __attribute__((address_space(4)))
struct KP { const char AS4* p;
    __device__ __forceinline__ const float* in(int i) const { return *(const float* const AS4*)(p + 8 * i); }
    __device__ __forceinline__ float* out() const { return *(float* const AS4*)(p + 320); }
    __device__ __forceinline__ unsigned char* ws() const { return *(unsigned char* const AS4*)(p + 328); }
};
static_assert(sizeof(Args) == 344, "Args layout");

__device__ __forceinline__ void phase_prologue(const KP kp, LAS unsigned char* lds, int gw, int NGW, int wave, int lane) {
    unsigned char* ws = kp.ws();
    LAS float* scr = (LAS float*)(lds + wave * 17408);
    SEC_BEGIN(1)
    for (int job = 0; job < 16; ++job) {
        const float* W; int K = 2048, Nsrc = 2048, Npad = 2048, mapid = 0; bf16* WT; const float* gain = nullptr;
        if (job < 2)       { W = kp.in(13) + (size_t)job * 2048 * 7200; Nsrc = 7200; Npad = NAB; mapid = 1; WT = (bf16*)(ws + WS_WABIN) + (size_t)job * NAB * 2048; gain = kp.in(11) + (size_t)(2 * job) * DM; }
        else if (job < 4)  { W = kp.in(21) + (size_t)(job - 2) * 2048 * 2048; WT = (bf16*)(ws + WS_WABOUT) + (size_t)(job - 2) * 2048 * 2048; }
        else if (job < 6)  { W = kp.in(22) + (size_t)(job - 4) * 2048 * 4624; Nsrc = 4624; Npad = NCD; mapid = 2; WT = (bf16*)(ws + WS_WCDIN) + (size_t)(job - 4) * NCD * 2048; gain = kp.in(11) + (size_t)(2 * (job - 4) + 1) * DM; }
        else if (job < 8)  { W = kp.in(36) + (size_t)(job - 6) * 2048 * 2048; WT = (bf16*)(ws + WS_WCDOUT) + (size_t)(job - 6) * 2048 * 2048; }
        else if (job < 12) { W = kp.in(39) + (size_t)(job - 8) * 2048 * 2048; WT = (bf16*)(ws + WS_WGATE) + (size_t)(job - 8) * 2048 * 2048; gain = kp.in(38) + (size_t)(job - 8) * DM; }
        else               { W = kp.in(37) + (size_t)(job - 12) * 256 * 2048; K = 256; WT = (bf16*)(ws + WS_WPROJ) + (size_t)(job - 12) * 2048 * 256; }
        const int nitems = (K / 64) * (Npad / 64), nblocks = NGW / NWAVES, ipb = (nitems + nblocks - 1) / nblocks, ib = (gw / NWAVES) * ipb, ie = ib + ipb < nitems ? ib + ipb : nitems;
        for (int it = ib + wave; it < ie; it += NWAVES) transpose_item(W, K, Nsrc, WT, Npad, mapid, gain, scr, it, lane);
    }
    SEC_END(1, lds)
    SEC_BEGIN(2)
    bf16* HB = (bf16*)(ws + WS_XN); float* RSS = (float*)(ws + WS_RSS);
    for (int m = gw; m < T; m += NGW) {
        const float* src = m < TP ? kp.in(0) + (size_t)m * DM : kp.in(1) + (size_t)(m - TP) * DM;
        float ss = 0.f;
#pragma unroll
        for (int jj = 0; jj < 8; ++jj) { const int col = 4 * (lane + 64 * jj); const f32x4 v = *(const f32x4*)(src + col);
            u32x2 o; o.x = pk2(v.x, v.y); o.y = pk2(v.z, v.w); *(u32x2*)(HB + (size_t)m * DM + col) = o; ss += (v.x * v.x + v.y * v.y) + (v.z * v.z + v.w * v.w); }
        ss = wave_sum(ss); if (lane == 0) RSS[m] = ss;
    }
    bf16* PB = (bf16*)(ws + WS_PB);
    const int gt = gw * 64 + lane, NGT = NGW * 64;
    for (int i = gt; i < 4 * T * 64; i += NGT) {
        const int c4 = i & 63, rr = i >> 6, li = rr / T, r = rr - li * T;
        const float* src = r < TP ? kp.in(9) + ((size_t)li * TP + r) * 256 + 4 * c4 : kp.in(10) + ((size_t)li * TS + (r - TP)) * 256 + 4 * c4;
        const f32x4 v = *(const f32x4*)src;
        u32x2 o; o.x = pk2(v.x, v.y); o.y = pk2(v.z, v.w);
        *(u32x2*)(PB + ((size_t)li * T + r) * 256 + 4 * c4) = o;
    }
    SEC_END(2, lds)
}
__device__ __forceinline__ void phase_final(const KP kp, int gw, int NGW, int lane) {
    const bf16* HB = (const bf16*)(kp.ws() + WS_XN); const float* RSS = (const float*)(kp.ws() + WS_RSS) + (size_t)8 * T; const float* g = kp.in(12); float* out = kp.out();
    for (int m = gw; m < T; m += NGW) { const float rstd = rsqrtf(RSS[m] * (1.f / DM) + 1e-6f);
#pragma unroll
        for (int jj = 0; jj < 8; ++jj) { const int col = 4 * (lane + 64 * jj); const u32x2 hv = *(const u32x2*)(HB + (size_t)m * DM + col); const f32x4 gg = *(const f32x4*)(g + col);
            f32x4 o; o.x = __uint_as_float(hv.x << 16) * rstd * gg.x; o.y = __uint_as_float(hv.x & 0xffff0000u) * rstd * gg.y; o.z = __uint_as_float(hv.y << 16) * rstd * gg.z; o.w = __uint_as_float(hv.y & 0xffff0000u) * rstd * gg.w;
            *(f32x4*)(out + (size_t)m * DM + col) = o; } }
}

__device__ __forceinline__ void phase_ab_pre(const KP kp, const int bid, const int G, int j, int tid, int wave, int lane) {
    unsigned char* scr = kp.ws() + WS_SCR; const bf16* U = (const bf16*)(kp.ws() + WS_U);
    float* QN = (float*)(scr + SC_QN) - (size_t)TP * 1024; float* KN = (float*)(scr + SC_KN) - (size_t)TP * 1024; float* VV = (float*)(scr + SC_VV) - (size_t)TP * 1024;
    float* GLOG = (float*)(scr + SC_GLOG) - (size_t)TP * 512; float* BETA = (float*)(scr + SC_BETA) - (size_t)TP * 8; float* GDEC = (float*)(scr + SC_GDEC) - (size_t)TP * 8;
    const float* cw = kp.in(14) + (size_t)j * 4 * 3072; const float* stc = kp.in(3) + (size_t)j * 128 * 3 * 3072;
    const float* wa2 = kp.in(18) + (size_t)j * 16 * 512; const float* ba = kp.in(19) + (size_t)j * 512;
    for (int r = TP + bid; r < T; r += G) {
        int s, t; row_to_seq(r, s, t); const int row0 = r - t;
#pragma unroll
        for (int part = 0; part < 3; ++part) {
            float val[2];
#pragma unroll
            for (int i = 0; i < 2; ++i) { const int c = part * 1024 + wave * 128 + lane + 64 * i; float acc = 0.f;
#pragma unroll
                for (int tap = 0; tap < 4; ++tap) acc += cw[tap * 3072 + c] * pre_val(U, NAB, c, row0, t - 3 + tap, s, stc, 3072, c);
                val[i] = silu_(acc); }
            if (part < 2) { const float ss = wave_sum(val[0] * val[0] + val[1] * val[1]); const float sc = rsqrtf(ss + 1e-6f) * (part == 0 ? 0.08838834764831845f : 1.f); val[0] *= sc; val[1] *= sc; }
            float* dst = part == 0 ? QN : (part == 1 ? KN : VV);
            dst[(size_t)r * 1024 + wave * 128 + lane] = val[0]; dst[(size_t)r * 1024 + wave * 128 + lane + 64] = val[1];
        }
        if (tid < 8) {
            BETA[(size_t)r * 8 + tid] = sigmoid_(bf2f(U[(size_t)r * NAB + 7168 + tid]));
            GDEC[(size_t)r * 8 + tid] = -__expf(kp.in(15)[j * 8 + tid]) * softplus_(bf2f(U[(size_t)r * NAB + 7176 + tid]) + kp.in(16)[j * 8 + tid]);
        }
        { float x = ba[tid];
#pragma unroll
          for (int rr = 0; rr < 16; ++rr) x += bf2f(U[(size_t)r * NAB + 7184 + rr]) * wa2[rr * 512 + tid];
          GLOG[(size_t)r * 512 + tid] = -softplus_(-x) * (1.f / 16.f); }
    }
}


constexpr size_t GLA_ITEM_BYTES = 74752, WS_GLAOPS = WS_H;
__device__ __forceinline__ void phase_gla_prep(const KP kp, const int bid, const int G, int j, LAS unsigned char* lds, int tid) {
    const bf16* U = (const bf16*)(kp.ws() + WS_U);
    const float* wa2 = kp.in(18) + (size_t)j * 16 * 512; const float* ba = kp.in(19) + (size_t)j * 512;
    unsigned char* OPS = kp.ws() + WS_GLAOPS;
    LAS float* GL = (LAS float*)lds; LAS float* QL = GL + 64 * 129; LAS float* KL = QL + 64 * 129; LAS float* AL = KL + 64 * 129;
    const int lane = tid & 63, r = lane & 31, hp = lane >> 5;
    for (int item = bid; item < 512; item += G) {
        const int b = item >> 7, n = (item >> 2) & 31, h = item & 3;
        const int row0 = b * 2048 + n * 64;
        __syncthreads();
        for (int i = tid; i < 8192; i += NTHR) { const int t = i >> 7, d = i & 127; const size_t ro = (size_t)(row0 + t) * NAB;
            QL[t * 129 + d] = bf2f(U[ro + 4096 + h * 128 + d]) * 0.08838834764831845f; KL[t * 129 + d] = bf2f(U[ro + 4608 + h * 128 + d]);
            float x = ba[h * 128 + d];
#pragma unroll
            for (int rr = 0; rr < 16; ++rr) x += bf2f(U[ro + 7184 + rr]) * wa2[rr * 512 + h * 128 + d];
            GL[t * 129 + d] = -softplus_(-x) * (1.f / 16.f); }
        __syncthreads();
        if (tid < 128) { float acc = 0.f;
#pragma unroll 4
            for (int t = 0; t < 64; ++t) { acc += GL[t * 129 + tid]; GL[t * 129 + tid] = acc; } }
        __syncthreads();
        for (int i = tid; i < 8192; i += NTHR) { const int t = i >> 7, d = i & 127; const float gg = GL[t * 129 + d]; QL[t * 129 + d] *= __expf(gg); KL[t * 129 + d] *= __expf(-gg); }
        __syncthreads();
        { const int i = tid >> 3, jg = tid & 7; float acc[8];
#pragma unroll
          for (int jj = 0; jj < 8; ++jj) acc[jj] = 0.f;
#pragma unroll 4
          for (int d = 0; d < 128; ++d) { const float c = QL[i * 129 + d];
#pragma unroll
              for (int jj = 0; jj < 8; ++jj) acc[jj] += c * KL[(jg * 8 + jj) * 129 + d]; }
#pragma unroll
          for (int jj = 0; jj < 8; ++jj) AL[i * 65 + jg * 8 + jj] = (jg * 8 + jj) <= i ? acc[jj] : 0.f; }
        __syncthreads();
        bf16x8* base = (bf16x8*)(OPS + (size_t)item * GLA_ITEM_BYTES);
        float v[8];
#pragma unroll
        for (int q = 0; q < 2; ++q) { const int f = (tid >> 6) + 8 * q;
            { const int mt = f >> 3, ks = f & 7, i = 32 * mt + r;
#pragma unroll
              for (int jp = 0; jp < 8; ++jp) v[jp] = QL[i * 129 + 16 * ks + 8 * (jp >> 2) + 4 * hp + (jp & 3)];
              base[f * 64 + lane] = pack8(v); }
            { const int mt = f >> 2, ks = f & 3, d = 32 * mt + r; const float eg = __expf(GL[63 * 129 + d]);
#pragma unroll
              for (int jp = 0; jp < 8; ++jp) v[jp] = KL[(16 * ks + 8 * (jp >> 2) + 4 * hp + (jp & 3)) * 129 + d] * eg;
              base[(16 + f) * 64 + lane] = pack8(v); } }
        { const int f = tid >> 6, mt = f >> 2, ks = f & 3, i = 32 * mt + r;
#pragma unroll
          for (int jp = 0; jp < 8; ++jp) v[jp] = AL[i * 65 + 16 * ks + 8 * (jp >> 2) + 4 * hp + (jp & 3)];
          base[(32 + f) * 64 + lane] = pack8(v); }
#pragma unroll
        for (int q = 0; q < 4; ++q) { const int f = (tid >> 6) + 8 * q, nt = f >> 2, ks = f & 3, p = 32 * nt + r;
            unsigned w[4];
#pragma unroll
            for (int jp = 0; jp < 8; jp += 2) { const int t0 = 16 * ks + 8 * (jp >> 2) + 4 * hp + (jp & 3);
                w[jp >> 1] = (unsigned)U[(size_t)(row0 + t0) * NAB + 5120 + h * 256 + p] | ((unsigned)U[(size_t)(row0 + t0 + 1) * NAB + 5120 + h * 256 + p] << 16); }
            base[(40 + f) * 64 + lane] = __builtin_bit_cast(bf16x8, (u32x4){w[0], w[1], w[2], w[3]}); }
        if (tid < 128) ((float*)(base + 72 * 64))[tid] = __expf(GL[63 * 129 + tid]);
    }
}


constexpr size_t DN_ITEM_BYTES = 74752;
__device__ __forceinline__ void phase_dn_prep(const KP kp, const int bid, const int G, int j, LAS unsigned char* lds, int tid0) {
    unsigned char* scr = kp.ws() + WS_SCR;
    const bf16* U = (const bf16*)(kp.ws() + WS_U); const float* cw = kp.in(14) + (size_t)j * 4 * 3072;
    unsigned char* OPS = scr + SC_DNOPS;
    LAS float* AMT = (LAS float*)lds; LAS float* GLs = AMT + 64 * 68; LAS float* BLs = GLs + 64; LAS float* SCL = BLs + 64; LAS float* KL = SCL + 128; LAS float* QL = KL + 64 * 129; LAS float* XL = QL + 64 * 129;
    for (int item = bid; item < 1024; item += G) {
        int tid = tid0; asm volatile("" : "+v"(tid));
        const int lane = tid & 63, r = lane & 31, hp = lane >> 5, wave = tid >> 6;
        const int b = item >> 8, n = (item >> 3) & 31, h = item & 7;
        const int row0 = b * 2048 + n * 64;
        __syncthreads();
        { const int d = tid & 127, tg = tid >> 7, t0 = 16 * tg;
#pragma unroll
          for (int part = 0; part < 3; ++part) { const int c = part * 1024 + h * 128 + d;
              const float w0 = cw[c], w1 = cw[3072 + c], w2 = cw[2 * 3072 + c], w3 = cw[3 * 3072 + c];
              const bf16* up = U + (size_t)(row0 + t0) * NAB + c;
              const bool first = (n == 0 && tg == 0);
              float x0 = first ? 0.f : bf2f(up[-3 * (long)NAB]), x1 = first ? 0.f : bf2f(up[-2 * (long)NAB]), x2 = first ? 0.f : bf2f(up[-1 * (long)NAB]);
              LAS float* dst = part == 0 ? QL : (part == 1 ? KL : XL);
              const int dstr = part == 2 ? 257 : 129;
#pragma unroll 4
              for (int t = 0; t < 16; ++t) { const float x3 = bf2f(up[(size_t)t * NAB]); dst[(t0 + t) * dstr + d] = silu_(w0 * x0 + w1 * x1 + w2 * x2 + w3 * x3); x0 = x1; x1 = x2; x2 = x3; } } }
        if (wave == 0) { const size_t ro = (size_t)(row0 + lane) * NAB;
            float gv = -__expf(kp.in(15)[j * 8 + h]) * softplus_(bf2f(U[ro + 7176 + h]) + kp.in(16)[j * 8 + h]);
#pragma unroll
            for (int o = 1; o < 64; o <<= 1) { const float tt = __shfl_up(gv, o); if (lane >= o) gv += tt; }
            GLs[lane] = gv; BLs[lane] = sigmoid_(bf2f(U[ro + 7168 + h])); }
        __syncthreads();
        if (tid < 128) { const int t = tid & 63, which = tid >> 6; const LAS float* src = which ? KL : QL; float ss = 0.f;
#pragma unroll 8
            for (int d = 0; d < 128; ++d) { const float x = src[t * 129 + d]; ss += x * x; }
            SCL[which * 64 + t] = rsqrtf(ss + 1e-6f) * (which ? 1.f : 0.08838834764831845f); }
        __syncthreads();
        { const int d = tid & 127, t0 = 16 * (tid >> 7);
#pragma unroll 4
          for (int t = 0; t < 16; ++t) { QL[(t0 + t) * 129 + d] *= SCL[t0 + t]; KL[(t0 + t) * 129 + d] *= SCL[64 + t0 + t]; } }
        __syncthreads();
        bf16x8* base = (bf16x8*)(OPS + (size_t)item * DN_ITEM_BYTES);
        { const int i = tid >> 3, ks = (tid >> 1) & 3, hk = tid & 1; float kk[8], qk[8];
#pragma unroll
          for (int jp = 0; jp < 8; ++jp) { kk[jp] = 0.f; qk[jp] = 0.f; }
#pragma unroll 2
          for (int d = 0; d < 128; ++d) { const float kc = KL[i * 129 + d], qc = QL[i * 129 + d];
#pragma unroll
              for (int jp = 0; jp < 8; ++jp) { const float kj = KL[(16 * ks + 8 * (jp >> 2) + 4 * hk + (jp & 3)) * 129 + d]; kk[jp] += kc * kj; qk[jp] += qc * kj; } }
          const float gi = GLs[i], bi = BLs[i]; float v[8];
#pragma unroll
          for (int jp = 0; jp < 8; ++jp) { const int jt = 16 * ks + 8 * (jp >> 2) + 4 * hk + (jp & 3); const float dec = __expf(gi - GLs[jt]);
              AMT[jt * 68 + i] = jt < i ? bi * kk[jp] * dec : 0.f; v[jp] = jt <= i ? qk[jp] * dec : 0.f; }
          base[(48 + (i >> 5) * 4 + ks) * 64 + (i & 31) + 32 * hk] = pack8(v); }
        __syncthreads();
        if (tid < 256) {
            const int c = tid;
#pragma unroll
            for (int bi = 0; bi < 4; ++bi) {
                float acc[16];
#pragma unroll
                for (int ii = 0; ii < 16; ++ii) { const int i = 16 * bi + ii; const float be = BLs[i];
                    acc[ii] = c < 128 ? be * XL[i * 257 + c] : be * __expf(GLs[i]) * KL[i * 129 + (c - 128)]; }
                for (int jj = 0; jj < 16 * bi; ++jj) { const float xj = XL[jj * 257 + c];
#pragma unroll
                    for (int q = 0; q < 4; ++q) { const f32x4 a = *(const LAS f32x4*)(AMT + jj * 68 + 16 * bi + 4 * q);
                        acc[4 * q + 0] -= a[0] * xj; acc[4 * q + 1] -= a[1] * xj; acc[4 * q + 2] -= a[2] * xj; acc[4 * q + 3] -= a[3] * xj; } }
#pragma unroll
                for (int ii = 0; ii < 16; ++ii) { float x = acc[ii];
#pragma unroll
                    for (int jj = 0; jj < ii; ++jj) x -= AMT[(16 * bi + jj) * 68 + 16 * bi + ii] * acc[jj];
                    acc[ii] = x; XL[(16 * bi + ii) * 257 + c] = x; }
            }
        }
        __syncthreads();
        float v[8];
#pragma unroll
        for (int q = 0; q < 2; ++q) { const int f = wave + 8 * q;
            { const int mt = f >> 3, ks = f & 7, i = 32 * mt + r;
#pragma unroll
              for (int jp = 0; jp < 8; ++jp) v[jp] = -XL[i * 257 + 128 + 16 * ks + 8 * (jp >> 2) + 4 * hp + (jp & 3)];
              base[f * 64 + lane] = pack8(v);
              const float eg = __expf(GLs[i]);
#pragma unroll
              for (int jp = 0; jp < 8; ++jp) v[jp] = QL[i * 129 + 16 * ks + 8 * (jp >> 2) + 4 * hp + (jp & 3)] * eg;
              base[(16 + f) * 64 + lane] = pack8(v); }
            { const int mt = f >> 2, ks = f & 3, d = 32 * mt + r; const float Gend = GLs[63];
#pragma unroll
              for (int jp = 0; jp < 8; ++jp) { const int tk = 16 * ks + 8 * (jp >> 2) + 4 * hp + (jp & 3); v[jp] = KL[tk * 129 + d] * __expf(Gend - GLs[tk]); }
              base[(32 + f) * 64 + lane] = pack8(v); }
            { const int pq = f & 1, tl = f >> 1, mt = tl >> 2, nt = tl & 3;
#pragma unroll
              for (int e = 0; e < 8; ++e) v[e] = XL[(32 * mt + crow(8 * pq + e, hp)) * 257 + 32 * nt + r];
              base[(56 + f) * 64 + lane] = pack8(v); } }
        if (tid == 0) *(float*)(base + 72 * 64) = __expf(GLs[63]);
    }
}

__device__ __forceinline__ void phase_ab_rec(const KP kp, const int bid, const int G, int j, int li, LAS unsigned char* lds, int tid0) {
    unsigned char* scr = kp.ws() + WS_SCR; const bf16* U = (const bf16*)(kp.ws() + WS_U);
    float* ODN = (float*)(scr + SC_ODN); float* OGLA = (float*)(scr + SC_OGLA);
    SEC_BEGIN(12)
    for (int item = bid; item < 64; item += G) {
        int tid = tid0; asm volatile("" : "+v"(tid));
        int s, h; bool isdn; int half = -1;
        if (item < 32) { isdn = false; s = item >> 3; h = (item >> 1) & 3; half = item & 1; }
        else if (item < 64) { isdn = true; s = (item - 32) >> 3; h = (item - 32) & 7; half = -2; }
        else if (item < 1088) { isdn = true; s = 4 + ((item - 64) >> 3); h = (item - 64) & 7; }
        else { isdn = false; s = 4 + ((item - 1088) >> 2); h = (item - 1088) & 3; }
        int row0, L; seq_info(s, row0, L);
        __syncthreads();
        if (half == -2) {
            const int wave = __builtin_amdgcn_readfirstlane(tid >> 6), lane = tid & 63, r = lane & 31, hp = lane >> 5;
            const int b = s, nt = wave;
            const unsigned char* OPS = scr + SC_DNOPS;
            constexpr int DBUF = 73 * 1024;
#define DN_DMA(n_, bufi_) do { const unsigned char* gi_ = OPS + (size_t)((b * 32 + (n_)) * 8 + h) * DN_ITEM_BYTES + lane * 16; \
                _Pragma("unroll") for (int q_ = 0; q_ < 10; ++q_) { const int lf_ = wave + 8 * q_; if (lf_ < 73) \
                    __builtin_amdgcn_global_load_lds((const unsigned*)(gi_ + lf_ * 1024), (LAS unsigned*)(lds + (bufi_) * DBUF + lf_ * 1024), 16, 0, 0); } } while (0)
            f32x16 S0, S1, S2, S3;
#pragma unroll
            for (int i = 0; i < 16; ++i) { S0[i] = 0.f; S1[i] = 0.f; S2[i] = 0.f; S3[i] = 0.f; }
            DN_DMA(0, 0);
            asm volatile("s_waitcnt vmcnt(0)" ::: "memory"); __syncthreads();
            for (int n = 0; n < 32; ++n) {
                if (n + 1 < 32) DN_DMA(n + 1, (n + 1) & 1);
                if (wave < 4) {
                    const LAS bf16x8* F = (const LAS bf16x8*)(lds + (n & 1) * DBUF) + lane;
                    const float gend = *(const LAS float*)(lds + (n & 1) * DBUF + 72 * 1024);
                    const bf16x8 sb0 = PACK_ACC(S0, 0), sb1 = PACK_ACC(S0, 1), sb2 = PACK_ACC(S1, 0), sb3 = PACK_ACC(S1, 1), sb4 = PACK_ACC(S2, 0), sb5 = PACK_ACC(S2, 1), sb6 = PACK_ACC(S3, 0), sb7 = PACK_ACC(S3, 1);
                    f32x16 U0t, U1t;
                    { const bf16x8 a0 = F[(56 + nt * 2 + 0) * 64], a1 = F[(56 + nt * 2 + 1) * 64], c0 = F[(56 + (4 + nt) * 2 + 0) * 64], c1 = F[(56 + (4 + nt) * 2 + 1) * 64];
#pragma unroll
                      for (int e = 0; e < 8; ++e) { U0t[e] = bf2f((bf16)a0[e]); U0t[8 + e] = bf2f((bf16)a1[e]); U1t[e] = bf2f((bf16)c0[e]); U1t[8 + e] = bf2f((bf16)c1[e]); } }
                    U0t = MFMA32(F[0 * 64], sb0, U0t); U0t = MFMA32(F[1 * 64], sb1, U0t); U0t = MFMA32(F[2 * 64], sb2, U0t); U0t = MFMA32(F[3 * 64], sb3, U0t);
                    U0t = MFMA32(F[4 * 64], sb4, U0t); U0t = MFMA32(F[5 * 64], sb5, U0t); U0t = MFMA32(F[6 * 64], sb6, U0t); U0t = MFMA32(F[7 * 64], sb7, U0t);
                    U1t = MFMA32(F[8 * 64], sb0, U1t); U1t = MFMA32(F[9 * 64], sb1, U1t); U1t = MFMA32(F[10 * 64], sb2, U1t); U1t = MFMA32(F[11 * 64], sb3, U1t);
                    U1t = MFMA32(F[12 * 64], sb4, U1t); U1t = MFMA32(F[13 * 64], sb5, U1t); U1t = MFMA32(F[14 * 64], sb6, U1t); U1t = MFMA32(F[15 * 64], sb7, U1t);
                    const bf16x8 ub0 = PACK_ACC(U0t, 0), ub1 = PACK_ACC(U0t, 1), ub2 = PACK_ACC(U1t, 0), ub3 = PACK_ACC(U1t, 1);
                    f32x16 O0, O1;
#pragma unroll
                    for (int i = 0; i < 16; ++i) { O0[i] = 0.f; O1[i] = 0.f; }
                    O0 = MFMA32(F[16 * 64], sb0, O0); O0 = MFMA32(F[17 * 64], sb1, O0); O0 = MFMA32(F[18 * 64], sb2, O0); O0 = MFMA32(F[19 * 64], sb3, O0);
                    O0 = MFMA32(F[20 * 64], sb4, O0); O0 = MFMA32(F[21 * 64], sb5, O0); O0 = MFMA32(F[22 * 64], sb6, O0); O0 = MFMA32(F[23 * 64], sb7, O0);
                    O1 = MFMA32(F[24 * 64], sb0, O1); O1 = MFMA32(F[25 * 64], sb1, O1); O1 = MFMA32(F[26 * 64], sb2, O1); O1 = MFMA32(F[27 * 64], sb3, O1);
                    O1 = MFMA32(F[28 * 64], sb4, O1); O1 = MFMA32(F[29 * 64], sb5, O1); O1 = MFMA32(F[30 * 64], sb6, O1); O1 = MFMA32(F[31 * 64], sb7, O1);
                    O0 = MFMA32(F[48 * 64], ub0, O0); O0 = MFMA32(F[49 * 64], ub1, O0);
                    O1 = MFMA32(F[52 * 64], ub0, O1); O1 = MFMA32(F[53 * 64], ub1, O1); O1 = MFMA32(F[54 * 64], ub2, O1); O1 = MFMA32(F[55 * 64], ub3, O1);
#pragma unroll
                    for (int i = 0; i < 16; ++i) { S0[i] *= gend; S1[i] *= gend; S2[i] *= gend; S3[i] *= gend; }
                    S0 = MFMA32(F[32 * 64], ub0, S0); S0 = MFMA32(F[33 * 64], ub1, S0); S0 = MFMA32(F[34 * 64], ub2, S0); S0 = MFMA32(F[35 * 64], ub3, S0);
                    S1 = MFMA32(F[36 * 64], ub0, S1); S1 = MFMA32(F[37 * 64], ub1, S1); S1 = MFMA32(F[38 * 64], ub2, S1); S1 = MFMA32(F[39 * 64], ub3, S1);
                    S2 = MFMA32(F[40 * 64], ub0, S2); S2 = MFMA32(F[41 * 64], ub1, S2); S2 = MFMA32(F[42 * 64], ub2, S2); S2 = MFMA32(F[43 * 64], ub3, S2);
                    S3 = MFMA32(F[44 * 64], ub0, S3); S3 = MFMA32(F[45 * 64], ub1, S3); S3 = MFMA32(F[46 * 64], ub2, S3); S3 = MFMA32(F[47 * 64], ub3, S3);
                    float* yo = ODN + (size_t)(b * 2048 + n * 64) * 1024 + h * 128 + 32 * nt + r;
#pragma unroll
                    for (int i = 0; i < 16; ++i) { yo[(size_t)crow(i, hp) * 1024] = O0[i]; yo[(size_t)(32 + crow(i, hp)) * 1024] = O1[i]; }
                }
                asm volatile("s_waitcnt vmcnt(0)" ::: "memory"); __syncthreads();
            }
#undef DN_DMA
            if (wave < 4) {
                float* dst = kp.out() + O_DN_P + ((size_t)j * 4 + b) * ((size_t)8 * 128 * 128) + (size_t)h * 128 * 128 + 32 * nt + r;
#pragma unroll
                for (int i = 0; i < 16; ++i) { dst[(size_t)crow(i, hp) * 128] = S0[i]; dst[(size_t)(32 + crow(i, hp)) * 128] = S1[i]; dst[(size_t)(64 + crow(i, hp)) * 128] = S2[i]; dst[(size_t)(96 + crow(i, hp)) * 128] = S3[i]; }
            }
        } else if (half >= 0) {
            const int wave = __builtin_amdgcn_readfirstlane(tid >> 6), lane = tid & 63, r = lane & 31, hp = lane >> 5;
            const int b = s, nt = half * 4 + wave;
            const unsigned char* OPS = kp.ws() + WS_GLAOPS;
            constexpr int GBUF = 57 * 1024;
#define GLA_DMA(n_, bufi_) do { const unsigned char* gi_ = OPS + (size_t)((b * 32 + (n_)) * 4 + h) * GLA_ITEM_BYTES + lane * 16; \
                _Pragma("unroll") for (int q_ = 0; q_ < 8; ++q_) { const int lf_ = wave + 8 * q_; if (lf_ < 57) { const int gf_ = lf_ < 40 ? lf_ : (lf_ < 56 ? lf_ + half * 16 : 72); \
                    __builtin_amdgcn_global_load_lds((const unsigned*)(gi_ + gf_ * 1024), (LAS unsigned*)(lds + (bufi_) * GBUF + lf_ * 1024), 16, 0, 0); } } } while (0)
            f32x16 S0, S1, S2, S3;
#pragma unroll
            for (int i = 0; i < 16; ++i) { S0[i] = 0.f; S1[i] = 0.f; S2[i] = 0.f; S3[i] = 0.f; }
            GLA_DMA(0, 0);
            asm volatile("s_waitcnt vmcnt(0)" ::: "memory"); __syncthreads();
            for (int n = 0; n < 32; ++n) {
                if (n + 1 < 32) GLA_DMA(n + 1, (n + 1) & 1);
                if (wave < 4) {
                    const LAS bf16x8* F = (const LAS bf16x8*)(lds + (n & 1) * GBUF) + lane;
                    const LAS float* ge = (const LAS float*)(lds + (n & 1) * GBUF + 56 * 1024) + 4 * hp;
                    const bf16x8 sb0 = PACK_ACC(S0, 0), sb1 = PACK_ACC(S0, 1), sb2 = PACK_ACC(S1, 0), sb3 = PACK_ACC(S1, 1), sb4 = PACK_ACC(S2, 0), sb5 = PACK_ACC(S2, 1), sb6 = PACK_ACC(S3, 0), sb7 = PACK_ACC(S3, 1);
                    f32x16 O0, O1;
#pragma unroll
                    for (int i = 0; i < 16; ++i) { O0[i] = 0.f; O1[i] = 0.f; }
                    O0 = MFMA32(F[0 * 64], sb0, O0); O0 = MFMA32(F[1 * 64], sb1, O0); O0 = MFMA32(F[2 * 64], sb2, O0); O0 = MFMA32(F[3 * 64], sb3, O0);
                    O0 = MFMA32(F[4 * 64], sb4, O0); O0 = MFMA32(F[5 * 64], sb5, O0); O0 = MFMA32(F[6 * 64], sb6, O0); O0 = MFMA32(F[7 * 64], sb7, O0);
                    O1 = MFMA32(F[8 * 64], sb0, O1); O1 = MFMA32(F[9 * 64], sb1, O1); O1 = MFMA32(F[10 * 64], sb2, O1); O1 = MFMA32(F[11 * 64], sb3, O1);
                    O1 = MFMA32(F[12 * 64], sb4, O1); O1 = MFMA32(F[13 * 64], sb5, O1); O1 = MFMA32(F[14 * 64], sb6, O1); O1 = MFMA32(F[15 * 64], sb7, O1);
                    bf16x8 vb[4];
#pragma unroll
                    for (int ks = 0; ks < 4; ++ks) vb[ks] = F[(40 + wave * 4 + ks) * 64];
                    O0 = MFMA32(F[32 * 64], vb[0], O0); O0 = MFMA32(F[33 * 64], vb[1], O0);
#pragma unroll
                    for (int ks = 0; ks < 4; ++ks) O1 = MFMA32(F[(36 + ks) * 64], vb[ks], O1);
#pragma unroll
                    for (int q = 0; q < 4; ++q) { const f32x4 g0 = *(const LAS f32x4*)(ge + 8 * q), g1 = *(const LAS f32x4*)(ge + 32 + 8 * q), g2 = *(const LAS f32x4*)(ge + 64 + 8 * q), g3 = *(const LAS f32x4*)(ge + 96 + 8 * q);
#pragma unroll
                        for (int c = 0; c < 4; ++c) { S0[4 * q + c] *= g0[c]; S1[4 * q + c] *= g1[c]; S2[4 * q + c] *= g2[c]; S3[4 * q + c] *= g3[c]; } }
#pragma unroll
                    for (int ks = 0; ks < 4; ++ks) { S0 = MFMA32(F[(16 + ks) * 64], vb[ks], S0); S1 = MFMA32(F[(20 + ks) * 64], vb[ks], S1); S2 = MFMA32(F[(24 + ks) * 64], vb[ks], S2); S3 = MFMA32(F[(28 + ks) * 64], vb[ks], S3); }
                    float* yo = OGLA + (size_t)(b * 2048 + n * 64) * 1024 + h * 256 + 32 * nt + r;
#pragma unroll
                    for (int i = 0; i < 16; ++i) { yo[(size_t)crow(i, hp) * 1024] = O0[i]; yo[(size_t)(32 + crow(i, hp)) * 1024] = O1[i]; }
                }
                asm volatile("s_waitcnt vmcnt(0)" ::: "memory"); __syncthreads();
            }
#undef GLA_DMA
            if (wave < 4) {
                float* dst = kp.out() + O_GLA_P + ((size_t)j * 4 + b) * ((size_t)4 * 128 * 256) + (size_t)h * 128 * 256 + 32 * nt + r;
#pragma unroll
                for (int i = 0; i < 16; ++i) { dst[(size_t)crow(i, hp) * 256] = S0[i]; dst[(size_t)(32 + crow(i, hp)) * 256] = S1[i]; dst[(size_t)(64 + crow(i, hp)) * 256] = S2[i]; dst[(size_t)(96 + crow(i, hp)) * 256] = S3[i]; }
            }
        } else
        {}
    }
    SEC_END(12, lds)
    SEC_BEGIN(13)
    unsigned* qhead = (unsigned*)(kp.ws() + WS_CTL) + CW_CNT + 64 * li;
    volatile LAS unsigned* qslot = (volatile LAS unsigned*)(lds + LDS_BYTES - 8);
    const float* cw = kp.in(14) + (size_t)j * 4 * 3072; const float* stc = kp.in(3) + (size_t)j * 128 * 3 * 3072;
    const float* wa2 = kp.in(18) + (size_t)j * 16 * 512; const float* ba = kp.in(19) + (size_t)j * 512;
    for (;;) {
        __syncthreads();
        if (tid0 == 0) qslot[0] = __hip_atomic_fetch_add(qhead, 1u, __ATOMIC_RELAXED, __HIP_MEMORY_SCOPE_AGENT);
        __syncthreads();
        const int it = (int)qslot[0];
        if (it >= 1536) break;
        int tid = tid0; asm volatile("" : "+v"(tid));
        const int wave = tid >> 6, lane = tid & 63;
        if (it < 1024) {
            const int bs = it >> 3, h = it & 7, sq = 4 + bs, r0 = TP + bs * 4;
            LAS float* qL = (LAS float*)lds; LAS float* kL = qL + 512; LAS float* vL = kL + 512; LAS float* red = vL + 512; LAS float* sm = red + 4096;
            const int e = tid & 127, dq = tid >> 7;
            const size_t SZ = (size_t)8 * 128 * 128;
            const float* st = kp.in(2) + ((size_t)j * 128 + bs) * SZ + (size_t)h * 16384;
            float S[32];
            { const float* sp = st + (size_t)(dq * 32) * 128 + e;
#pragma unroll
              for (int i = 0; i < 32; ++i) { S[i] = *sp; sp += 128; asm volatile("" : "+v"(sp)); } }
#pragma unroll
            for (int part = 0; part < 3; ++part) { const int c = part * 1024 + h * 128 + e; float acc = 0.f;
#pragma unroll
                for (int tap = 0; tap < 4; ++tap) acc += cw[tap * 3072 + c] * pre_val(U, NAB, c, r0, dq - 3 + tap, sq, stc, 3072, c);
                (part == 0 ? qL : (part == 1 ? kL : vL))[dq * 128 + e] = silu_(acc); }
            if (tid < 4) { const size_t ro = (size_t)(r0 + tid) * NAB;
                sm[32 + tid] = -__expf(kp.in(15)[j * 8 + h]) * softplus_(bf2f(U[ro + 7176 + h]) + kp.in(16)[j * 8 + h]); sm[36 + tid] = sigmoid_(bf2f(U[ro + 7168 + h])); }
            __syncthreads();
            { const int tk = wave & 3; LAS float* src = (wave >> 2) ? kL : qL; const float a = src[tk * 128 + lane], b = src[tk * 128 + lane + 64];
              const float sc = rsqrtf(wave_sum(a * a + b * b) + 1e-6f) * ((wave >> 2) ? 1.f : 0.08838834764831845f); src[tk * 128 + lane] = a * sc; src[tk * 128 + lane + 64] = b * sc; }
            __syncthreads();
#pragma unroll
            for (int q = 0; q < 4; ++q) { const int idx = wave * 4 + q, i = (idx >> 2) & 3, jj = idx & 3; const LAS float* src = idx < 16 ? kL : qL;
                const float dot = wave_sum(src[i * 128 + lane] * kL[jj * 128 + lane] + src[i * 128 + lane + 64] * kL[jj * 128 + lane + 64]); if (lane == 0) sm[idx] = dot; }
            float ks[4] = {0.f, 0.f, 0.f, 0.f}, qs[4] = {0.f, 0.f, 0.f, 0.f};
#pragma unroll
            for (int i = 0; i < 32; ++i) { const int d = dq * 32 + i; const float sv = S[i];
#pragma unroll
                for (int t = 0; t < 4; ++t) { ks[t] += kL[t * 128 + d] * sv; qs[t] += qL[t * 128 + d] * sv; } }
#pragma unroll
            for (int t = 0; t < 4; ++t) { red[(t * 4 + dq) * 128 + e] = ks[t]; red[((4 + t) * 4 + dq) * 128 + e] = qs[t]; }
            __syncthreads();
            float Gc[4]; Gc[0] = sm[32]; Gc[1] = Gc[0] + sm[33]; Gc[2] = Gc[1] + sm[34]; Gc[3] = Gc[2] + sm[35];
            float u[4];
#pragma unroll
            for (int i = 0; i < 4; ++i) { const float KSi = (red[(i * 4 + 0) * 128 + e] + red[(i * 4 + 1) * 128 + e]) + (red[(i * 4 + 2) * 128 + e] + red[(i * 4 + 3) * 128 + e]);
                float acc = vL[i * 128 + e] - __expf(Gc[i]) * KSi;
#pragma unroll
                for (int jj = 0; jj < i; ++jj) acc -= sm[i * 4 + jj] * __expf(Gc[i] - Gc[jj]) * u[jj];
                u[i] = sm[36 + i] * acc; }
            if (dq == 0) {
#pragma unroll
                for (int i = 0; i < 4; ++i) { const float QSi = (red[((4 + i) * 4 + 0) * 128 + e] + red[((4 + i) * 4 + 1) * 128 + e]) + (red[((4 + i) * 4 + 2) * 128 + e] + red[((4 + i) * 4 + 3) * 128 + e]);
                    float o = __expf(Gc[i]) * QSi;
#pragma unroll
                    for (int jj = 0; jj <= i; ++jj) o += sm[16 + i * 4 + jj] * __expf(Gc[i] - Gc[jj]) * u[jj];
                    ODN[(size_t)(r0 + i) * 1024 + h * 128 + e] = o; } }
            const float eg = __expf(Gc[3]); float w[4];
#pragma unroll
            for (int jj = 0; jj < 4; ++jj) w[jj] = __expf(Gc[3] - Gc[jj]) * u[jj];
            float* dst = kp.out() + O_DN_S + ((size_t)j * 128 + bs) * SZ + (size_t)h * 16384 + (size_t)(dq * 32) * 128 + e;
#pragma unroll
            for (int i = 0; i < 32; ++i) { const int d = dq * 32 + i; float sv = eg * S[i];
#pragma unroll
                for (int jj = 0; jj < 4; ++jj) sv += kL[jj * 128 + d] * w[jj];
                *dst = sv; dst += 128; asm volatile("" : "+v"(dst)); }
        } else {
            const int q_ = it - 1024, bs = q_ >> 2, h = q_ & 3, r0 = TP + bs * 4;
            LAS float* qgL = (LAS float*)lds; LAS float* kaL = qgL + 512; LAS float* glL = kaL + 512; LAS float* egL = glL + 512; LAS float* Am = egL + 128; LAS float* red = Am + 16;
            const int e = tid & 255, dh = tid >> 8;
            const size_t SZ = (size_t)4 * 128 * 256;
            const float* st = kp.in(4) + ((size_t)j * 128 + bs) * SZ + (size_t)h * 32768;
            float S[64];
            { const float* sp = st + (size_t)(dh * 64) * 256 + e;
#pragma unroll
              for (int i = 0; i < 64; ++i) { S[i] = *sp; sp += 256; asm volatile("" : "+v"(sp)); } }
            float v[4];
#pragma unroll
            for (int t = 0; t < 4; ++t) v[t] = bf2f(U[(size_t)(r0 + t) * NAB + 5120 + h * 256 + e]);
            { const int d = tid & 127, tk = tid >> 7; const size_t ro = (size_t)(r0 + tk) * NAB;
              qgL[tk * 128 + d] = bf2f(U[ro + 4096 + h * 128 + d]) * 0.08838834764831845f; kaL[tk * 128 + d] = bf2f(U[ro + 4608 + h * 128 + d]);
              float x = ba[h * 128 + d];
#pragma unroll
              for (int rr = 0; rr < 16; ++rr) x += bf2f(U[ro + 7184 + rr]) * wa2[rr * 512 + h * 128 + d];
              glL[tk * 128 + d] = -softplus_(-x) * (1.f / 16.f); }
            __syncthreads();
            if (tid < 128) { float Gq = 0.f;
#pragma unroll
                for (int t = 0; t < 4; ++t) { Gq += glL[t * 128 + tid]; qgL[t * 128 + tid] *= __expf(Gq); kaL[t * 128 + tid] *= __expf(-Gq); }
                egL[tid] = __expf(Gq); }
            __syncthreads();
#pragma unroll
            for (int q = 0; q < 2; ++q) { const int idx = wave * 2 + q, i = idx >> 2, jj = idx & 3;
                const float dot = wave_sum(qgL[i * 128 + lane] * kaL[jj * 128 + lane] + qgL[i * 128 + lane + 64] * kaL[jj * 128 + lane + 64]); if (lane == 0) Am[idx] = dot; }
            float o[4] = {0.f, 0.f, 0.f, 0.f};
            float* dst = kp.out() + O_GLA_S + ((size_t)j * 128 + bs) * SZ + (size_t)h * 32768 + (size_t)(dh * 64) * 256 + e;
#pragma unroll
            for (int i = 0; i < 64; ++i) { const int d = dh * 64 + i; const float s0 = S[i]; float acc = s0;
#pragma unroll
                for (int t = 0; t < 4; ++t) { o[t] += qgL[t * 128 + d] * s0; acc += kaL[t * 128 + d] * v[t]; }
                *dst = egL[d] * acc; dst += 256; asm volatile("" : "+v"(dst)); }
#pragma unroll
            for (int t = 0; t < 4; ++t) red[(dh * 4 + t) * 256 + e] = o[t];
            __syncthreads();
            if (dh == 0) {
#pragma unroll
                for (int t = 0; t < 4; ++t) { float oo = red[t * 256 + e] + red[(4 + t) * 256 + e];
#pragma unroll
                    for (int jj = 0; jj <= t; ++jj) oo += Am[t * 4 + jj] * v[jj];
                    OGLA[(size_t)(r0 + t) * 1024 + h * 256 + e] = oo; } }
        }
    }
    SEC_END(13, lds)
}

__device__ __forceinline__ void phase_ab_post(const KP kp, const int bid, const int G, int j, int tid, int wave, int lane) {
    unsigned char* scr = kp.ws() + WS_SCR; const bf16* U = (const bf16*)(kp.ws() + WS_U); bf16* YM = (bf16*)(kp.ws() + WS_YM);
    const float* ODN = (const float*)(scr + SC_ODN); const float* OGLA = (const float*)(scr + SC_OGLA);
    const float* dnn = kp.in(17) + (size_t)j * 128; const float* glan = kp.in(20) + (size_t)j * 256;
    typedef float f32x2v __attribute__((ext_vector_type(2)));
    const f32x2v dg = *(const f32x2v*)(dnn + 2 * lane); const f32x4 gg = *(const f32x4*)(glan + 4 * lane);
    for (int r = bid * NWAVES + wave; r < T; r += G * NWAVES) {
        int s, t; row_to_seq(r, s, t); int row0, L; seq_info(s, row0, L);
        const bf16* ur = U + (size_t)r * NAB; bf16* yr = YM + (size_t)r * DM;
#pragma unroll
        for (int hh = 0; hh < 8; ++hh) { const f32x2v o = *(const f32x2v*)(ODN + (size_t)r * 1024 + hh * 128 + 2 * lane);
            const float rstd = rsqrtf(wave_sum(o.x * o.x + o.y * o.y) * (1.f / 128.f) + 1e-6f);
            const unsigned zz = *(const unsigned*)(ur + 3072 + hh * 128 + 2 * lane);
            *(unsigned*)(yr + hh * 128 + 2 * lane) = pk2(o.x * rstd * dg.x * silu_(__uint_as_float(zz << 16)), o.y * rstd * dg.y * silu_(__uint_as_float(zz & 0xffff0000u))); }
#pragma unroll
        for (int hh = 0; hh < 4; ++hh) { const f32x4 o = *(const f32x4*)(OGLA + (size_t)r * 1024 + hh * 256 + 4 * lane);
            const float rstd = rsqrtf(wave_sum((o.x * o.x + o.y * o.y) + (o.z * o.z + o.w * o.w)) * (1.f / 256.f) + 1e-6f);
            const u32x2 zz = *(const u32x2*)(ur + 6144 + hh * 256 + 4 * lane);
            u32x2 w; w.x = pk2(o.x * rstd * gg.x * silu_(__uint_as_float(zz.x << 16)), o.y * rstd * gg.y * silu_(__uint_as_float(zz.x & 0xffff0000u)));
            w.y = pk2(o.z * rstd * gg.z * silu_(__uint_as_float(zz.y << 16)), o.w * rstd * gg.w * silu_(__uint_as_float(zz.y & 0xffff0000u)));
            *(u32x2*)(yr + 1024 + hh * 256 + 4 * lane) = w; }
        if (t >= L - 3) { const int rr = t - (L - 3);
            float* dst = s < 4 ? kp.out() + O_DNC_P + (((size_t)j * 4 + s) * 3 + rr) * 3072 : kp.out() + O_DNC_S + (((size_t)j * 128 + (s - 4)) * 3 + rr) * 3072;
            for (int c = 2 * lane; c < 3072; c += 128) { const unsigned uu = *(const unsigned*)(ur + c); *(f32x2v*)(dst + c) = (f32x2v){__uint_as_float(uu << 16), __uint_as_float(uu & 0xffff0000u)}; } }
    }
}

__device__ __forceinline__ void phase_cd_pre(const KP kp, const int bid, const int G, int j, LAS unsigned char* lds, int tid) {
    unsigned char* scr = kp.ws() + WS_SCR; const bf16* U = (const bf16*)(kp.ws() + WS_U);
    float* XBC = (float*)(scr + SC_XBC) - (size_t)TP * 1536; float* DT = (float*)(scr + SC_DT) - (size_t)TP * 16; bf16* XS = (bf16*)(scr + SC_XS);
    const float* cw = kp.in(23) + (size_t)j * 4 * 1536; const float* cb = kp.in(24) + (size_t)j * 1536; const float* stc = kp.in(6) + (size_t)j * 128 * 3 * 1536;
    for (int r = TP + bid; r < T; r += G) {
        int s, t; row_to_seq(r, s, t); const int row0 = r - t;
#pragma unroll
        for (int i = 0; i < 3; ++i) { const int c = tid + NTHR * i; float acc = cb[c];
#pragma unroll
            for (int tap = 0; tap < 4; ++tap) acc += cw[tap * 1536 + c] * pre_val(U, NCD, 1024 + c, row0, t - 3 + tap, s, stc, 1536, c);
            const float v = silu_(acc); XBC[(size_t)r * 1536 + c] = v; if (c < 1024) XS[(size_t)r * 1024 + c] = (bf16)f2bf(v); }
        if (tid < 16) DT[(size_t)r * 16 + tid] = softplus_(bf2f(U[(size_t)r * NCD + 4608 + tid]) + kp.in(26)[j * 16 + tid]);
    }
}

__device__ __forceinline__ void phase_lru_gates(const KP kp, const int bid, const int G, int j, LAS unsigned char* lds, int tid0) {
    unsigned char* scr = kp.ws() + WS_SCR; const bf16* U = (const bf16*)(kp.ws() + WS_U);
    float* LA = (float*)(scr + SC_LA); float* LB = (float*)(scr + SC_LB);
    const float* lcw = kp.in(29) + (size_t)j * 4 * 1024; const float* lcb = kp.in(30) + (size_t)j * 1024; const float* lstc = kp.in(8) + (size_t)j * 128 * 3 * 1024;
    const int n = bid & 15;
    const float* wa = kp.in(31) + ((size_t)j * 16 + n) * 4096; const float* wx = kp.in(33) + ((size_t)j * 16 + n) * 4096;
    const float* lba = kp.in(32) + (size_t)j * 1024; const float* lbx = kp.in(34) + (size_t)j * 1024; const float* lam = kp.in(35) + (size_t)j * 1024;
    LAS bf16x8* WF = (LAS bf16x8*)lds;
    LAS float* xcL = (LAS float*)(lds + 16384);
    LAS float* igL = xcL + 64 * 68;
    __syncthreads();
    { const int lane = tid0 & 63, f = tid0 >> 6, r = lane & 31, hp = lane >> 5, nt = f >> 2, ks = f & 3; float v[8];
#pragma unroll
      for (int jp = 0; jp < 8; ++jp) v[jp] = wa[(16 * ks + 8 * hp + jp) * 64 + 32 * nt + r];
      WF[f * 64 + lane] = pack8(v);
#pragma unroll
      for (int jp = 0; jp < 8; ++jp) v[jp] = wx[(16 * ks + 8 * hp + jp) * 64 + 32 * nt + r];
      WF[512 + f * 64 + lane] = pack8(v); }
    for (int tile = bid >> 4; tile < T / 64; tile += (G >> 4)) {
        int tid = tid0; asm volatile("" : "+v"(tid));
        const int c = tid & 63, tq = tid >> 6, ch = n * 64 + c, rowbase = tile * 64;
        __syncthreads();
        if (tile < TP / 64) {
            const int r0 = rowbase + tq * 8; const bool first = ((r0 & 2047) == 0);
            const float w0 = lcw[ch], w1 = lcw[1024 + ch], w2 = lcw[2048 + ch], w3 = lcw[3072 + ch], bb = lcb[ch];
            const bf16* up = U + (size_t)r0 * NCD + 3584 + ch;
            float x0 = first ? 0.f : bf2f(up[-3 * (long)NCD]), x1 = first ? 0.f : bf2f(up[-2 * (long)NCD]), x2 = first ? 0.f : bf2f(up[-1 * (long)NCD]);
#pragma unroll
            for (int tt = 0; tt < 8; ++tt) { const float x3 = bf2f(up[(size_t)tt * NCD]); xcL[(tq * 8 + tt) * 68 + c] = bb + w0 * x0 + w1 * x1 + w2 * x2 + w3 * x3; x0 = x1; x1 = x2; x2 = x3; }
        } else {
#pragma unroll 2
            for (int tt = 0; tt < 8; ++tt) { const int r = rowbase + tq * 8 + tt; int s, t; row_to_seq(r, s, t); const int row0 = r - t; float acc = lcb[ch];
#pragma unroll
                for (int tap = 0; tap < 4; ++tap) acc += lcw[tap * 1024 + ch] * pre_val(U, NCD, 3584 + ch, row0, t - 3 + tap, s, lstc, 1024, ch);
                xcL[(tq * 8 + tt) * 68 + c] = acc; }
        }
        __syncthreads();
        const int wave = __builtin_amdgcn_readfirstlane(tid >> 6), lane = tid & 63, r = lane & 31, hp = lane >> 5, mat = wave >> 2, mt = (wave >> 1) & 1, nt = wave & 1;
        f32x16 acc;
#pragma unroll
        for (int i = 0; i < 16; ++i) acc[i] = 0.f;
#pragma unroll
        for (int ks = 0; ks < 4; ++ks) { const LAS float* xp = xcL + (32 * mt + r) * 68 + 16 * ks + 8 * hp; const f32x4 xa = *(const LAS f32x4*)xp, xb = *(const LAS f32x4*)(xp + 4);
            const bf16x8 af = __builtin_bit_cast(bf16x8, (u32x4){cvtpk(xa.x, xa.y), cvtpk(xa.z, xa.w), cvtpk(xb.x, xb.y), cvtpk(xb.z, xb.w)});
            acc = MFMA32(af, WF[mat * 512 + (nt * 4 + ks) * 64 + lane], acc); }
        const int chh = n * 64 + 32 * nt + r;
        if (mat == 1) { const float bx = lbx[chh];
#pragma unroll
            for (int i = 0; i < 16; ++i) igL[(32 * mt + crow(i, hp)) * 65 + 32 * nt + r] = sigmoid_(acc[i] + bx); }
        __syncthreads();
        if (mat == 0) { const float ba = lba[chh], spl = softplus_(-lam[chh]);
#pragma unroll
            for (int i = 0; i < 16; ++i) { const int tk = 32 * mt + crow(i, hp); const size_t ro = (size_t)(rowbase + tk) * 1024 + chh;
                const float log_a = -8.f * sigmoid_(acc[i] + ba) * spl;
                LA[ro] = __expf(log_a); LB[ro] = __builtin_amdgcn_sqrtf(1.f - __expf(2.f * log_a)) * (igL[tk * 65 + 32 * nt + r] * xcL[tk * 68 + 32 * nt + r]); } }
    }
}

constexpr size_t SSD_ITEM_BYTES = 33792;
__device__ __forceinline__ void phase_ssd_prep(const KP kp, const int bid, const int G, int j, LAS unsigned char* lds, int tid0) {
    unsigned char* scr = kp.ws() + WS_SCR;
    const bf16* U = (const bf16*)(kp.ws() + WS_U); bf16* XS = (bf16*)(scr + SC_XS);
    const float* cw = kp.in(23) + (size_t)j * 4 * 1536; const float* cb = kp.in(24) + (size_t)j * 1536;
    unsigned char* OPS = scr + SC_SSDOP;
    LAS float* CL = (LAS float*)lds; LAS float* BL = CL + 64 * 65; LAS float* QK = BL + 64 * 65; LAS float* GL = QK + 64 * 65; LAS float* DTL = GL + 256; LAS float* XLs = DTL + 256;
    const float* alog = kp.in(25) + j * 16;
    for (int item = bid; item < 512; item += G) {
        int tid = tid0; asm volatile("" : "+v"(tid));
        const int wave = tid >> 6, lane = tid & 63;
        const int b = item >> 7, n = (item >> 2) & 31, g = item & 3;
        const int row0 = b * 2048 + n * 64;
        __syncthreads();
        { const int ci = tid & 127, tg = tid >> 7, t0 = 16 * tg;
          const bool first = (n == 0 && tg == 0);
#pragma unroll
          for (int q = 0; q < 3; ++q) { const int k = ci + 128 * q;
              int cidx; LAS float* dst; int dstr, dcol;
              if (k < 64) { cidx = 1024 + g * 64 + k; dst = BL; dstr = 65; dcol = k; }
              else if (k < 128) { cidx = 1280 + g * 64 + (k - 64); dst = CL; dstr = 65; dcol = k - 64; }
              else { cidx = g * 256 + (k - 128); dst = XLs; dstr = 257; dcol = k - 128; }
              const float w0 = cw[cidx], w1 = cw[1536 + cidx], w2 = cw[2 * 1536 + cidx], w3 = cw[3 * 1536 + cidx], bb = cb[cidx];
              const bf16* up = U + (size_t)(row0 + t0) * NCD + 1024 + cidx;
              float x0 = first ? 0.f : bf2f(up[-3 * (long)NCD]), x1 = first ? 0.f : bf2f(up[-2 * (long)NCD]), x2 = first ? 0.f : bf2f(up[-1 * (long)NCD]);
#pragma unroll 4
              for (int t = 0; t < 16; ++t) { const float x3 = bf2f(up[(size_t)t * NCD]); dst[(t0 + t) * dstr + dcol] = silu_(bb + w0 * x0 + w1 * x1 + w2 * x2 + w3 * x3); x0 = x1; x1 = x2; x2 = x3; } } }
        if (wave < 4) { const int h = g * 4 + wave; const float dt = softplus_(bf2f(U[(size_t)(row0 + lane) * NCD + 4608 + h]) + kp.in(26)[j * 16 + h]);
            DTL[wave * 64 + lane] = dt; float gv = -__expf(alog[h]) * dt;
#pragma unroll
            for (int o = 1; o < 64; o <<= 1) { const float tt = __shfl_up(gv, o); if (lane >= o) gv += tt; }
            GL[wave * 64 + lane] = gv; }
        __syncthreads();
        for (int i = tid; i < 8192; i += NTHR) { const int t = i >> 7, k2 = i & 127;
            ((unsigned*)XS)[((size_t)(row0 + t) * 1024 + g * 256) / 2 + k2] = pk2(XLs[t * 257 + 2 * k2], XLs[t * 257 + 2 * k2 + 1]); }
        { const int i = tid >> 3, jg = tid & 7; float acc[8];
#pragma unroll
          for (int jj = 0; jj < 8; ++jj) acc[jj] = 0.f;
#pragma unroll 4
          for (int d = 0; d < 64; ++d) { const float c = CL[i * 65 + d];
#pragma unroll
              for (int jj = 0; jj < 8; ++jj) acc[jj] += c * BL[(jg * 8 + jj) * 65 + d]; }
#pragma unroll
          for (int jj = 0; jj < 8; ++jj) QK[i * 65 + jg * 8 + jj] = acc[jj]; }
        __syncthreads();
        const int f = wave, r = lane & 31, hp = lane >> 5, mt = f >> 2, ks = f & 3;
        for (int hh = 0; hh < 4; ++hh) {
            const int h = g * 4 + hh; const LAS float* Gh = GL + hh * 64; const float Gend = Gh[63];
            bf16x8* base = (bf16x8*)(OPS + ((size_t)((b * 32 + n) * 16 + h)) * SSD_ITEM_BYTES);
            float v[8];
            { const int i = 32 * mt + r; const float eg = __expf(Gh[i]);
#pragma unroll
              for (int jp = 0; jp < 8; ++jp) { const int d = 16 * ks + 8 * (jp >> 2) + 4 * hp + (jp & 3); v[jp] = CL[i * 65 + d] * eg; }
              base[0 * 512 + f * 64 + lane] = pack8(v); }
            { const int d = 32 * mt + r;
#pragma unroll
              for (int jp = 0; jp < 8; ++jp) { const int tk = 16 * ks + 8 * (jp >> 2) + 4 * hp + (jp & 3); v[jp] = BL[tk * 65 + d] * __expf(Gend - Gh[tk]); }
              base[1 * 512 + f * 64 + lane] = pack8(v); }
            { const int i = 32 * mt + r; const float gi = Gh[i];
#pragma unroll
              for (int jp = 0; jp < 8; ++jp) { const int jt = 16 * ks + 8 * (jp >> 2) + 4 * hp + (jp & 3); v[jp] = jt <= i ? QK[i * 65 + jt] * __expf(gi - Gh[jt]) : 0.f; }
              base[2 * 512 + f * 64 + lane] = pack8(v); }
            { const int p = 32 * mt + r;
#pragma unroll
              for (int jp = 0; jp < 8; ++jp) { const int tk = 16 * ks + 8 * (jp >> 2) + 4 * hp + (jp & 3);
                  v[jp] = XLs[tk * 257 + hh * 64 + p] * DTL[hh * 64 + tk]; }
              base[3 * 512 + f * 64 + lane] = pack8(v); }
            if (tid == 0) *(float*)(base + 32 * 64) = __expf(Gend);
        }
    }
}

__device__ __forceinline__ void phase_cd_rec(const KP kp, const int bid, const int G, int j, int li, LAS unsigned char* lds, int tid0) {
    unsigned char* scr = kp.ws() + WS_SCR; const bf16* U = (const bf16*)(kp.ws() + WS_U);
    const float* LA = (const float*)(scr + SC_LA); const float* LB = (const float*)(scr + SC_LB);
    float* YS = (float*)(scr + SC_YS); float* HS = (float*)(scr + SC_HS); bf16* XS = (bf16*)(scr + SC_XS);
    SEC_BEGIN(10)
    for (int item = bid; item < 64; item += G) {
        int tid = tid0; asm volatile("" : "+v"(tid));
        const int b = item >> 4, hd = item & 15;
        __syncthreads();
        const int wave = __builtin_amdgcn_readfirstlane(tid >> 6), lane = tid & 63, r = lane & 31, hp = lane >> 5, nt = wave;
        const unsigned char* OPS = scr + SC_SSDOP;
        const bool dmaw = (wave >= 2 && wave < 6);
        constexpr int SLOT = 33 * 1024;
#define SSD_DMA(n_) do { if (dmaw) { const unsigned char* gi_ = OPS + ((size_t)((b * 32 + (n_)) * 16 + hd)) * SSD_ITEM_BYTES + lane * 16; \
            _Pragma("unroll") for (int q_ = 0; q_ < 9; ++q_) { const int lf_ = q_ < 8 ? (wave - 2) * 8 + q_ : 32; \
                __builtin_amdgcn_global_load_lds((const unsigned*)(gi_ + lf_ * 1024), (LAS unsigned*)(lds + ((n_) & 3) * SLOT + lf_ * 1024), 16, 0, 0); } } } while (0)
        f32x16 S0, S1;
#pragma unroll
        for (int i = 0; i < 16; ++i) { S0[i] = 0.f; S1[i] = 0.f; }
        SSD_DMA(0); SSD_DMA(1); SSD_DMA(2);
        if (dmaw) asm volatile("s_waitcnt vmcnt(18)" ::: "memory");
        asm volatile("" ::: "memory"); __builtin_amdgcn_s_barrier(); asm volatile("" ::: "memory");
        for (int n = 0; n < 32; ++n) {
            if (n + 3 < 32) SSD_DMA(n + 3);
            if (wave < 2) {
                const LAS bf16x8* F = (const LAS bf16x8*)(lds + (n & 3) * SLOT) + lane;
                bf16x8 vb[4];
#pragma unroll
                for (int ks = 0; ks < 4; ++ks) vb[ks] = F[(24 + nt * 4 + ks) * 64];
                const float gend = *(const LAS float*)(lds + (n & 3) * SLOT + 32 * 1024);
                const bf16x8 sb00 = PACK_ACC(S0, 0), sb01 = PACK_ACC(S0, 1), sb10 = PACK_ACC(S1, 0), sb11 = PACK_ACC(S1, 1);
                f32x16 O0, O1;
#pragma unroll
                for (int i = 0; i < 16; ++i) { O0[i] = 0.f; O1[i] = 0.f; }
                O0 = MFMA32(F[0 * 64], sb00, O0); O0 = MFMA32(F[1 * 64], sb01, O0); O0 = MFMA32(F[2 * 64], sb10, O0); O0 = MFMA32(F[3 * 64], sb11, O0);
                O1 = MFMA32(F[4 * 64], sb00, O1); O1 = MFMA32(F[5 * 64], sb01, O1); O1 = MFMA32(F[6 * 64], sb10, O1); O1 = MFMA32(F[7 * 64], sb11, O1);
                O0 = MFMA32(F[16 * 64], vb[0], O0); O0 = MFMA32(F[17 * 64], vb[1], O0);
#pragma unroll
                for (int ks = 0; ks < 4; ++ks) O1 = MFMA32(F[(20 + ks) * 64], vb[ks], O1);
#pragma unroll
                for (int i = 0; i < 16; ++i) { S0[i] *= gend; S1[i] *= gend; }
#pragma unroll
                for (int ks = 0; ks < 4; ++ks) { S0 = MFMA32(F[(8 + ks) * 64], vb[ks], S0); S1 = MFMA32(F[(12 + ks) * 64], vb[ks], S1); }
                float* yo = YS + (size_t)(b * 2048 + n * 64) * 1024 + hd * 64 + 32 * nt + r;
#pragma unroll
                for (int i = 0; i < 16; ++i) { yo[(size_t)crow(i, hp) * 1024] = O0[i]; yo[(size_t)(32 + crow(i, hp)) * 1024] = O1[i]; }
            }
            if (dmaw) { if (n + 3 < 32) asm volatile("s_waitcnt vmcnt(18)" ::: "memory"); else if (n + 2 < 32) asm volatile("s_waitcnt vmcnt(9)" ::: "memory"); else asm volatile("s_waitcnt vmcnt(0)" ::: "memory"); }
            asm volatile("s_waitcnt lgkmcnt(0)" ::: "memory"); __builtin_amdgcn_s_barrier(); asm volatile("" ::: "memory");
        }
#undef SSD_DMA
        if (wave < 2) {
            float* dst = kp.out() + O_SSD_P + ((size_t)j * 4 + b) * ((size_t)16 * 64 * 64) + (size_t)hd * 64 * 64 + 32 * nt + r;
#pragma unroll
            for (int i = 0; i < 16; ++i) { dst[(size_t)crow(i, hp) * 64] = S0[i]; dst[(size_t)(32 + crow(i, hp)) * 64] = S1[i]; }
        }
    }
    SEC_END(10, lds)
    SEC_BEGIN(11)
    unsigned* qhead = (unsigned*)(kp.ws() + WS_CTL) + CW_CNT + 64 * li;
    volatile LAS unsigned* qslot = (volatile LAS unsigned*)(lds + LDS_BYTES - 8);
    const float* cw = kp.in(23) + (size_t)j * 4 * 1536; const float* cb = kp.in(24) + (size_t)j * 1536; const float* stc = kp.in(6) + (size_t)j * 128 * 3 * 1536;
    for (;;) {
        __syncthreads();
        if (tid0 == 0) qslot[0] = __hip_atomic_fetch_add(qhead, 1u, __ATOMIC_RELAXED, __HIP_MEMORY_SCOPE_AGENT);
        __syncthreads();
        const int it = (int)qslot[0];
        if (it >= 1024) break;
        int tid = tid0; asm volatile("" : "+v"(tid));
        if (it < 256) {
            const int s = it >> 6, h = it & 63; int row0, L; seq_info(s, row0, L);
            LAS float* Al = (LAS float*)lds; LAS float* Bl = Al + 512;
            const int chunk = tid >> 4, c16 = tid & 15, ch = h * 16 + c16;
            const size_t ro = (size_t)(row0 + chunk * 64) * 1024 + ch;
            float Ap = 1.f, Bp = 0.f;
#pragma unroll 8
            for (int t = 0; t < 64; ++t) { const float a = LA[ro + (size_t)t * 1024], bb = LB[ro + (size_t)t * 1024]; Bp = a * Bp + bb; Ap *= a; }
            Al[tid] = Ap; Bl[tid] = Bp;
            __syncthreads();
            float hh = 0.f;
            for (int m = 0; m < chunk; ++m) hh = Al[m * 16 + c16] * hh + Bl[m * 16 + c16];
#pragma unroll 8
            for (int t = 0; t < 64; ++t) { hh = LA[ro + (size_t)t * 1024] * hh + LB[ro + (size_t)t * 1024]; HS[ro + (size_t)t * 1024] = hh; }
            if (chunk == 31) kp.out()[O_LRU_P + ((size_t)j * 4 + s) * 1024 + ch] = hh;
        } else if (it < 768) {
            const int q_ = it - 256, bs = q_ >> 2, g = q_ & 3, sq = 4 + bs, r0 = TP + bs * 4;
            LAS float* BL = (LAS float*)lds; LAS float* CL = BL + 256; LAS float* XL = CL + 256; LAS float* DTL = XL + 1024; LAS float* QKs = DTL + 16; LAS float* red = QKs + 16;
            const int wave = tid >> 6, lane = tid & 63, hh = tid >> 7, nh = (tid >> 6) & 1, p = tid & 63, hd = 4 * g + hh;
            const size_t SZ = (size_t)16 * 64 * 64;
            const float* st = kp.in(5) + ((size_t)j * 128 + bs) * SZ + (size_t)hd * 4096;
            float S[32];
            { const float* sp = st + (size_t)(nh * 32) * 64 + p;
#pragma unroll
              for (int i = 0; i < 32; ++i) { S[i] = *sp; sp += 64; asm volatile("" : "+v"(sp)); } }
            { const int ci = tid & 127, tk = tid >> 7;
#pragma unroll
              for (int q = 0; q < 3; ++q) { const int k = ci + 128 * q; int cidx; LAS float* dst;
                  if (k < 64) { cidx = 1024 + g * 64 + k; dst = BL + tk * 64 + k; } else if (k < 128) { cidx = 1280 + g * 64 + (k - 64); dst = CL + tk * 64 + (k - 64); } else { cidx = g * 256 + (k - 128); dst = XL + tk * 256 + (k - 128); }
                  float acc = cb[cidx];
#pragma unroll
                  for (int tap = 0; tap < 4; ++tap) acc += cw[tap * 1536 + cidx] * pre_val(U, NCD, 1024 + cidx, r0, tk - 3 + tap, sq, stc, 1536, cidx);
                  *dst = silu_(acc); } }
            if (tid < 16) { const int tk = tid >> 2, h2 = tid & 3; DTL[tid] = softplus_(bf2f(U[(size_t)(r0 + tk) * NCD + 4608 + 4 * g + h2]) + kp.in(26)[j * 16 + 4 * g + h2]); }
            __syncthreads();
#pragma unroll
            for (int q = 0; q < 2; ++q) { const int idx = wave * 2 + q, i = idx >> 2, jj = idx & 3; const float dot = wave_sum(CL[i * 64 + lane] * BL[jj * 64 + lane]); if (lane == 0) QKs[idx] = dot; }
            { const int tk = tid >> 7, k2 = tid & 127; ((unsigned*)XS)[((size_t)(r0 + tk) * 1024 + g * 256) / 2 + k2] = pk2(XL[tk * 256 + 2 * k2], XL[tk * 256 + 2 * k2 + 1]); }
            const float negA = -__expf(kp.in(25)[j * 16 + hd]);
            float Gc[4], xd[4], w[4];
            Gc[0] = negA * DTL[hh]; Gc[1] = Gc[0] + negA * DTL[4 + hh]; Gc[2] = Gc[1] + negA * DTL[8 + hh]; Gc[3] = Gc[2] + negA * DTL[12 + hh];
#pragma unroll
            for (int jj = 0; jj < 4; ++jj) { xd[jj] = XL[jj * 256 + hh * 64 + p] * DTL[jj * 4 + hh]; w[jj] = __expf(Gc[3] - Gc[jj]) * xd[jj]; }
            const float eg = __expf(Gc[3]);
            float o[4] = {0.f, 0.f, 0.f, 0.f};
            float* dst = kp.out() + O_SSD_S + ((size_t)j * 128 + bs) * SZ + (size_t)hd * 4096 + (size_t)(nh * 32) * 64 + p;
#pragma unroll
            for (int i = 0; i < 32; ++i) { const int n = nh * 32 + i; const float s0 = S[i]; float acc = eg * s0;
#pragma unroll
                for (int t = 0; t < 4; ++t) { o[t] += CL[t * 64 + n] * s0; acc += BL[t * 64 + n] * w[t]; }
                *dst = acc; dst += 64; asm volatile("" : "+v"(dst)); }
#pragma unroll
            for (int t = 0; t < 4; ++t) red[((hh * 2 + nh) * 4 + t) * 64 + p] = o[t];
            __syncthreads();
            if (nh == 0) {
#pragma unroll
                for (int t = 0; t < 4; ++t) { float y = __expf(Gc[t]) * (red[((hh * 2) * 4 + t) * 64 + p] + red[((hh * 2 + 1) * 4 + t) * 64 + p]);
#pragma unroll
                    for (int jj = 0; jj <= t; ++jj) y += QKs[t * 4 + jj] * __expf(Gc[t] - Gc[jj]) * xd[jj];
                    YS[(size_t)(r0 + t) * 1024 + hd * 64 + p] = y; } }
        } else {
            const int q_ = it - 768, s = 4 + (q_ >> 1), h = q_ & 1; int row0, L; seq_info(s, row0, L);
            const int ch = h * 512 + tid;
            float hh = s < 4 ? 0.f : kp.in(7)[((size_t)j * 128 + (s - 4)) * 1024 + ch];
#pragma unroll 8
            for (int t = 0; t < L; ++t) { const size_t r = (size_t)(row0 + t); hh = LA[r * 1024 + ch] * hh + LB[r * 1024 + ch]; HS[r * 1024 + ch] = hh; }
            float* dst = s < 4 ? kp.out() + O_LRU_P + ((size_t)j * 4 + s) * 1024 : kp.out() + O_LRU_S + ((size_t)j * 128 + (s - 4)) * 1024;
            dst[ch] = hh;
        }
    }
    SEC_END(11, lds)
}

__device__ __forceinline__ void phase_cd_post(const KP kp, const int bid, const int G, int j, int tid, int wave, int lane) {
    unsigned char* scr = kp.ws() + WS_SCR; const bf16* U = (const bf16*)(kp.ws() + WS_U); bf16* YM = (bf16*)(kp.ws() + WS_YM);
    const float* YS = (const float*)(scr + SC_YS); const float* HS = (const float*)(scr + SC_HS); const bf16* XS = (const bf16*)(scr + SC_XS);
    const float* sn = kp.in(28) + (size_t)j * 1024; const float* Dv = kp.in(27) + (size_t)j * 16;
    typedef float f32x2v __attribute__((ext_vector_type(2)));
    for (int r = bid * NWAVES + wave; r < T; r += G * NWAVES) {
        int s, t; row_to_seq(r, s, t); int row0, L; seq_info(s, row0, L);
        const bf16* ur = U + (size_t)r * NCD; bf16* yr = YM + (size_t)r * DM;
#pragma unroll
        for (int gq = 0; gq < 4; ++gq) { const int e = gq * 256 + 4 * lane; const f32x4 ys = *(const f32x4*)(YS + (size_t)r * 1024 + e);
            const u32x2 xx = *(const u32x2*)(XS + (size_t)r * 1024 + e), zz = *(const u32x2*)(ur + e); const float Dh = Dv[e >> 6];
            f32x4 y; y.x = (ys.x + Dh * __uint_as_float(xx.x << 16)) * silu_(__uint_as_float(zz.x << 16)); y.y = (ys.y + Dh * __uint_as_float(xx.x & 0xffff0000u)) * silu_(__uint_as_float(zz.x & 0xffff0000u));
            y.z = (ys.z + Dh * __uint_as_float(xx.y << 16)) * silu_(__uint_as_float(zz.y << 16)); y.w = (ys.w + Dh * __uint_as_float(xx.y & 0xffff0000u)) * silu_(__uint_as_float(zz.y & 0xffff0000u));
            const float rstd = rsqrtf(wave_sum((y.x * y.x + y.y * y.y) + (y.z * y.z + y.w * y.w)) * (1.f / 256.f) + 1e-6f);
            const f32x4 g4 = *(const f32x4*)(sn + e);
            u32x2 w; w.x = pk2(y.x * rstd * g4.x, y.y * rstd * g4.y); w.y = pk2(y.z * rstd * g4.z, y.w * rstd * g4.w); *(u32x2*)(yr + e) = w; }
#pragma unroll
        for (int gq = 0; gq < 4; ++gq) { const int ch = gq * 256 + 4 * lane; const f32x4 hs = *(const f32x4*)(HS + (size_t)r * 1024 + ch); const u32x2 zz = *(const u32x2*)(ur + 2560 + ch);
            u32x2 w; w.x = pk2(hs.x * silu_(__uint_as_float(zz.x << 16)), hs.y * silu_(__uint_as_float(zz.x & 0xffff0000u))); w.y = pk2(hs.z * silu_(__uint_as_float(zz.y << 16)), hs.w * silu_(__uint_as_float(zz.y & 0xffff0000u)));
            *(u32x2*)(yr + 1024 + ch) = w; }
        if (t >= L - 3) { const int rr = t - (L - 3);
            float* d1 = s < 4 ? kp.out() + O_SSDC_P + (((size_t)j * 4 + s) * 3 + rr) * 1536 : kp.out() + O_SSDC_S + (((size_t)j * 128 + (s - 4)) * 3 + rr) * 1536;
            for (int c = 2 * lane; c < 1536; c += 128) { const unsigned uu = *(const unsigned*)(ur + 1024 + c); *(f32x2v*)(d1 + c) = (f32x2v){__uint_as_float(uu << 16), __uint_as_float(uu & 0xffff0000u)}; }
            float* d2 = s < 4 ? kp.out() + O_LRUC_P + (((size_t)j * 4 + s) * 3 + rr) * 1024 : kp.out() + O_LRUC_S + (((size_t)j * 128 + (s - 4)) * 3 + rr) * 1024;
            for (int c = 2 * lane; c < 1024; c += 128) { const unsigned uu = *(const unsigned*)(ur + 3584 + c); *(f32x2v*)(d2 + c) = (f32x2v){__uint_as_float(uu << 16), __uint_as_float(uu & 0xffff0000u)}; } }
    }
}


typedef float f32x4m __attribute__((ext_vector_type(4)));
template <bool GATE>
__device__ __forceinline__ void sample_gemm_res(const bf16* Amat, const bf16* Bt, const bf16* Hin, bf16* Hout, float* rss_out, const bf16* PP, const float* rss_in, int bid, int tid) {
    const int wave = tid >> 6, lane = tid & 63, lr = lane & 15, kg = lane >> 4;
    const int m0 = TP + (bid & 7) * 64 + (wave & 3) * 16, n0 = (bid >> 3) * 64 + (wave >> 2) * 32;
    if (bid >= 256) return;
    const bf16x8* ap = (const bf16x8*)(Amat + (size_t)(m0 + lr) * 2048 + 8 * kg);
    const bf16x8* bp0 = (const bf16x8*)(Bt + (size_t)(n0 + lr) * 2048 + 8 * kg);
    const bf16x8* bp1 = (const bf16x8*)(Bt + (size_t)(n0 + 16 + lr) * 2048 + 8 * kg);
    f32x4m c0 = {0.f, 0.f, 0.f, 0.f}, c1 = {0.f, 0.f, 0.f, 0.f};
#pragma unroll 8
    for (int ks = 0; ks < 64; ++ks) { const bf16x8 a = ap[ks * 4], b0 = bp0[ks * 4], b1 = bp1[ks * 4];
        c0 = __builtin_amdgcn_mfma_f32_16x16x32_bf16(a, b0, c0, 0, 0, 0); c1 = __builtin_amdgcn_mfma_f32_16x16x32_bf16(a, b1, c1, 0, 0, 0); }
#pragma unroll
    for (int i = 0; i < 4; ++i) { const int row = m0 + kg * 4 + i; float sc = 1.f; if (GATE) sc = rsqrtf(rss_in[row] * (1.f / 2048.f) + 1e-6f);
        float sq = 0.f;
#pragma unroll
        for (int nf = 0; nf < 2; ++nf) { const size_t p = (size_t)row * 2048 + n0 + 16 * nf + lr; const float a = nf ? c1[i] : c0[i];
            float h = bf2f(Hin[p]);
            if (GATE) h += __builtin_amdgcn_rcpf(1.f + __expf(-sc * a)) * bf2f(PP[p]); else h += a;
            sq += h * h; Hout[p] = (bf16)f2bf(h); }
        sq += __shfl_xor(sq, 1); sq += __shfl_xor(sq, 2); sq += __shfl_xor(sq, 4); sq += __shfl_xor(sq, 8);
        if (lr == 0) atomicAdd(rss_out + row, sq); }
}

__global__ void __launch_bounds__(NTHR, 2) mega_fwd(Args A) {
    extern __shared__ __attribute__((aligned(16))) unsigned char lds_raw[];
    LAS unsigned char* lds = (LAS unsigned char*)lds_raw;
    const int G = gridDim.x;
    volatile LAS unsigned* bst = (volatile LAS unsigned*)(lds + LDS_BYTES - 16);
    if (threadIdx.x == 0) { bst[0] = 0u; bst[1] = 0u;
#ifdef PROBE_SEC
        *(volatile LAS unsigned long long*)(lds + LDS_BYTES - 32) = 0ull;
#endif
    }
    __syncthreads();
    XcdBarrier xbar = xcd_barrier_post((unsigned*)(A.ws + WS_CTL) + CW_BAR, bst);
#ifdef PROBE_GROUP
    unsigned long long t_prev = __builtin_amdgcn_s_memrealtime(), t_sel = 0;
#endif
    for (int ph = A.ph_lo; ph < A.ph_hi; ++ph) {
        KP kp; kp.p = (const char AS4*)__builtin_amdgcn_kernarg_segment_ptr(); asm volatile("" : "+s"(kp.p));
        unsigned char* ws = kp.ws();
        int tid = threadIdx.x; asm volatile("" : "+v"(tid));
        int bid = blockIdx.x; asm volatile("" : "+s"(bid));
        const int lane = tid & 63, wave = __builtin_amdgcn_readfirstlane(tid >> 6), gw = bid * NWAVES + wave, NGW = G * NWAVES;
        if (ph == 0) { if (PH_MASK & 1) phase_prologue(kp, lds, gw, NGW, wave, lane); }
        else if (ph == N_PHASES - 1) phase_final(kp, gw, NGW, lane);
        else {
            const int li = (ph - 1) / SUBS, sub = (ph - 1) % SUBS, j = li >> 1; const bool ab = (li & 1) == 0;
            float* RSS = (float*)(ws + WS_RSS);
            if (sub == 0) {
                const int N = ab ? NAB : NCD;
                const bf16* Bt = ab ? (const bf16*)(ws + WS_WABIN) + (size_t)j * NAB * 2048 : (const bf16*)(ws + WS_WCDIN) + (size_t)j * NCD * 2048;
                { pg8::Gemm g{(const bf16*)(ws + WS_XN), Bt, T, N, 2048}; pg8::StaticOrder S; S.init(T, N, G, bid);
                  pg8::EpiU E{(bf16*)(ws + WS_U), N, RSS + (size_t)(2 * li) * T};
                  if (PH_MASK & 2) pg8::gemm_phase<pg8::EpiU, pg8::StaticOrder, true, true>(lds, g, S, E, tid); }
                { int tid2 = tid; asm volatile("" : "+v"(tid2));
                  pg8::Gemm g{(const bf16*)(ws + WS_PB) + (size_t)li * T * 256, (const bf16*)(ws + WS_WPROJ) + (size_t)li * 2048 * 256, T, 2048, 256}; pg8::StaticOrder S; S.init(T, 2048, G, (bid + 37) % G);
                  pg8::EpiU E{(bf16*)(ws + WS_SCR + SC_PP), 2048, nullptr};
                  if (PH_MASK & 2) pg8::gemm_phase<pg8::EpiU, pg8::StaticOrder, true, true>(lds, g, S, E, tid2); }
            } else if (sub == 4) {
                const bf16* Bt = ab ? (const bf16*)(ws + WS_WABOUT) + (size_t)j * 2048 * 2048 : (const bf16*)(ws + WS_WCDOUT) + (size_t)j * 2048 * 2048;
                pg8::Gemm g{(const bf16*)(ws + WS_YM), Bt, TP, 2048, 2048}; pg8::StaticOrder S; S.init(TP, 2048, G, bid);
                pg8::EpiRes<false> E{(const bf16*)(ws + WS_XN), (bf16*)(ws + WS_SCR + SC_HB1), RSS + (size_t)(2 * li + 1) * T, nullptr, nullptr};
                if (PH_MASK & 4) pg8::gemm_phase<pg8::EpiRes<false>, pg8::StaticOrder, true, true>(lds, g, S, E, tid);
                { int tid2 = tid; asm volatile("" : "+v"(tid2));
                  sample_gemm_res<false>((const bf16*)(ws + WS_YM), Bt, (const bf16*)(ws + WS_XN), (bf16*)(ws + WS_SCR + SC_HB1), RSS + (size_t)(2 * li + 1) * T, nullptr, nullptr, bid, tid2); }
            } else if (sub == 5) {
                pg8::Gemm g{(const bf16*)(ws + WS_SCR + SC_HB1), (const bf16*)(ws + WS_WGATE) + (size_t)li * 2048 * 2048, TP, 2048, 2048}; pg8::StaticOrder S; S.init(TP, 2048, G, bid);
                pg8::EpiRes<true> E{(const bf16*)(ws + WS_SCR + SC_HB1), (bf16*)(ws + WS_XN), RSS + (size_t)(2 * li + 2) * T, (const bf16*)(ws + WS_SCR + SC_PP), RSS + (size_t)(2 * li + 1) * T};
                if (PH_MASK & 4) pg8::gemm_phase<pg8::EpiRes<true>, pg8::StaticOrder, true, true>(lds, g, S, E, tid);
                { int tid2 = tid; asm volatile("" : "+v"(tid2));
                  sample_gemm_res<true>((const bf16*)(ws + WS_SCR + SC_HB1), (const bf16*)(ws + WS_WGATE) + (size_t)li * 2048 * 2048, (const bf16*)(ws + WS_SCR + SC_HB1), (bf16*)(ws + WS_XN), RSS + (size_t)(2 * li + 2) * T,
                                        (const bf16*)(ws + WS_SCR + SC_PP), RSS + (size_t)(2 * li + 1) * T, bid, tid2); }
            } else if (sub == 1) {
                if (ab) { SEC_BEGIN(3) if (PH_MASK & 4096) phase_gla_prep(kp, bid, G, j, lds, tid); SEC_END(3, lds) SEC_BEGIN(4) if (PH_MASK & 8192) phase_dn_prep(kp, bid, G, j, lds, tid); SEC_END(4, lds) }
                else { if (PH_MASK & 2048) { SEC_BEGIN(8) phase_ssd_prep(kp, bid, G, j, lds, tid); SEC_END(8, lds) SEC_BEGIN(9) phase_lru_gates(kp, bid, G, j, lds, tid); SEC_END(9, lds) } }
            }
            else if (sub == 2) { if (ab) { if (PH_MASK & 32) phase_ab_rec(kp, bid, G, j, li, lds, tid); } else { if (PH_MASK & 64) phase_cd_rec(kp, bid, G, j, li, lds, tid); } }
            else { if (ab) { if (PH_MASK & 128) phase_ab_post(kp, bid, G, j, tid, wave, lane); } else { if (PH_MASK & 256) phase_cd_post(kp, bid, G, j, tid, wave, lane); } }
        }
        if (ph + 1 < A.ph_hi) { if (ph == A.ph_lo) cg::this_grid().sync(); else xcd_barrier(xbar); }
#ifdef PROBE_GROUP
        { const unsigned long long t_now = __builtin_amdgcn_s_memrealtime(); const int li_ = (ph - 1) / SUBS, sub_ = (ph - 1) % SUBS; const bool ab_ = (li_ & 1) == 0;
          int grp = 9; if (ph == N_PHASES - 1) grp = 8; else if (ph > 0) { if (sub_ == 0 || sub_ == 4 || sub_ == 5) grp = 1; else if (sub_ == 1) grp = ab_ ? 4 : 5; else if (sub_ == 2) grp = ab_ ? 6 : 7; else grp = 8; }
          if (grp == PROBE_GROUP) t_sel += t_now - t_prev; t_prev = t_now; }
#endif
    }
#ifdef PROBE_SEC
    if (blockIdx.x == PROBE_BLK && threadIdx.x == 0) { const unsigned long long t_s = *(volatile LAS unsigned long long*)(lds + LDS_BYTES - 32); const unsigned long long t0 = __builtin_amdgcn_s_memrealtime(); while (__builtin_amdgcn_s_memrealtime() - t0 < 3 * t_s) __builtin_amdgcn_s_sleep(8); }
#endif
#ifdef PROBE_GROUP
    if (blockIdx.x == 0 && threadIdx.x == 0) { const unsigned long long t0 = __builtin_amdgcn_s_memrealtime(); while (__builtin_amdgcn_s_memrealtime() - t0 < 3 * t_sel) __builtin_amdgcn_s_sleep(8); }
#endif
}

extern "C" void kernel_launch(void* const* d_in, const int* in_sizes, int n_in, void* d_out, int out_size, void* d_ws, size_t ws_size, hipStream_t stream) {
    static int grid = 0;
    if (grid == 0) {
        if (n_in != 40 || (size_t)out_size != O_END || ws_size < WS_END) { fprintf(stderr, "kernel_launch: unexpected shapes: n_in %d out %d ws %zu\n", n_in, out_size, ws_size); grid = -1; return; }
        int dev = 0, cus = 0, per_cu = 0;
        if (hipGetDevice(&dev) != hipSuccess || hipDeviceGetAttribute(&cus, hipDeviceAttributeMultiprocessorCount, dev) != hipSuccess) { grid = -1; return; }
        if (hipFuncSetAttribute((const void*)mega_fwd, hipFuncAttributeMaxDynamicSharedMemorySize, LDS_BYTES) != hipSuccess) { fprintf(stderr, "kernel_launch: hipFuncSetAttribute failed\n"); grid = -1; return; }
        if (hipOccupancyMaxActiveBlocksPerMultiprocessor(&per_cu, (const void*)mega_fwd, NTHR, LDS_BYTES) != hipSuccess || per_cu < 1) { fprintf(stderr, "kernel_launch: occupancy query says %d\n", per_cu); per_cu = 1; }
        (void)hipGetLastError();
        grid = cus;
    }
    if (grid < 0) return;
    if (hipMemsetAsync((char*)d_ws + WS_CTL, 0, CTL_ZERO_BYTES, stream) != hipSuccess) { fprintf(stderr, "kernel_launch: memset of the control words failed\n"); return; }
    Args a{};
    for (int i = 0; i < 40; ++i) a.in[i] = (const float*)d_in[i];
    a.out = (float*)d_out; a.ws = (unsigned char*)d_ws;
#if MK_N_LAUNCHES == 1
    a.ph_lo = 0; a.ph_hi = N_PHASES;
    void* args[] = {&a};
    hipError_t e = hipLaunchCooperativeKernel((const void*)mega_fwd, dim3(grid), dim3(NTHR), args, LDS_BYTES, stream);
    if (e != hipSuccess) fprintf(stderr, "cooperative launch failed: %s (grid %d)\n", hipGetErrorString(e), grid);
#else
    for (int ph = 0; ph < N_PHASES; ++ph) { a.ph_lo = ph; a.ph_hi = ph + 1; mega_fwd<<<dim3(grid), dim3(NTHR), LDS_BYTES, stream>>>(a); }
#endif
}
```

```cpp
#include <hip/hip_runtime.h>
#include <hip/hip_cooperative_groups.h>
#include <cstdio>
#include <cstdint>
namespace cg = cooperative_groups;

#ifndef MK_N_LAUNCHES
#define MK_N_LAUNCHES 1
#endif

namespace pg8 {
#define PG8_LAS __attribute__((address_space(3)))
typedef unsigned short bf16_t;
typedef short bf16x8 __attribute__((ext_vector_type(8)));
typedef float f32x4 __attribute__((ext_vector_type(4)));
typedef unsigned u32x4 __attribute__((ext_vector_type(4)));
constexpr int BM = 256, BK = 64, HALF = 128, HTB = HALF * BK * 2  , STAGE_BYTES = 8 * HTB, NXCD = 8, WGM = 8;

__host__ __device__ __forceinline__ int lds_byte(int r, int c) { const int st = (r >> 4) * 2 + (c >> 5), rr = r & 15, cc = c & 31, ob = rr * 64 + cc * 2; return st * 1024 + (ob ^ (((ob >> 9) & 1) << 5)); }
__host__ __device__ __forceinline__ void stage_rc(int b, int& R, int& C) { const int st = b / 1024, sb = b % 1024, swz = sb ^ (((sb >> 9) & 1) << 5); R = (st >> 1) * 16 + swz / 64; C = (st & 1) * 32 + (swz % 64) / 2; }
__host__ __device__ __forceinline__ int perm32(int rho) { const int n = rho >> 4, i = rho & 15; return 8 * (i >> 2) + 4 * n + (i & 3); }

struct Unit { int pm, pn; };
struct Gemm { const bf16_t* A; const bf16_t* Bt; int M, N, K; };

struct StaticOrder {
    int nM, nN, nwg, G, c;
    __host__ __device__ void init(int M, int N, int G_, int c_) { nM = M / BM; nN = N / BM; nwg = nM * nN; G = G_; c = c_; }
    __host__ __device__ bool next(int i, Unit& u) const {
        const long L = (long)i * G + c; if (L >= nwg) return false;
        int wgid = (int)L; { const int q = nwg / NXCD, r = nwg % NXCD, xcd = wgid % NXCD, off = wgid / NXCD; wgid = (xcd < r ? xcd * (q + 1) : r * (q + 1) + (xcd - r) * q) + off; }
        const int nig = WGM * nN, gid = wgid / nig, fm = gid * WGM, gsz = (nM - fm) < WGM ? (nM - fm) : WGM;
        u.pm = fm + ((wgid % nig) % gsz); u.pn = (wgid % nig) / gsz; return true;
    }
    __device__ __forceinline__ void a_ready(const Unit&) const {}
    __device__ __forceinline__ void done(const Unit&) const {}
};

__device__ __forceinline__ unsigned cvt_pk_bf16(float lo, float hi) { unsigned r; asm volatile("v_cvt_pk_bf16_f32 %0, %1, %2" : "=v"(r) : "v"(lo), "v"(hi)); return r; }
struct EpiF32 {
    static constexpr bool PERM = false, AFTER_DRAIN = false;
    float* C; int ldc;
    __device__ __forceinline__ void operator()(const f32x4 (&acc)[2][2][4][2], const Unit& u, int wr, int wc, int fr, int fq) const {
        const int row0 = u.pm * BM + wr * 64 + fr, col0 = u.pn * BM + wc * 32 + 4 * fq;
#pragma unroll
        for (int ai = 0; ai < 2; ++ai)
#pragma unroll
            for (int m = 0; m < 4; ++m) { float* rowp = C + (size_t)(row0 + ai * HALF + m * 16) * ldc + col0;
#pragma unroll
                for (int bj = 0; bj < 2; ++bj)
#pragma unroll
                    for (int n = 0; n < 2; ++n) *(f32x4*)(rowp + bj * HALF + n * 16) = acc[ai][bj][m][n]; }
    }
};
struct EpiBf16 {
    static constexpr bool PERM = true, AFTER_DRAIN = false;
    bf16_t* O; int ldc;
    __device__ __forceinline__ void operator()(const f32x4 (&acc)[2][2][4][2], const Unit& u, int wr, int wc, int fr, int fq) const {
        const int row0 = u.pm * BM + wr * 64 + fr; const int col0 = u.pn * BM + wc * 32 + 8 * fq;
#pragma unroll
        for (int ai = 0; ai < 2; ++ai)
#pragma unroll
            for (int m = 0; m < 4; ++m) { bf16_t* rowp = O + (size_t)(row0 + ai * HALF + m * 16) * ldc + col0;
#pragma unroll
                for (int bj = 0; bj < 2; ++bj) { const f32x4 v0 = acc[ai][bj][m][0], v1 = acc[ai][bj][m][1];
                    u32x4 w; w.x = cvt_pk_bf16(v0[0], v0[1]); w.y = cvt_pk_bf16(v0[2], v0[3]); w.z = cvt_pk_bf16(v1[0], v1[1]); w.w = cvt_pk_bf16(v1[2], v1[3]);
                    *(u32x4*)(rowp + bj * HALF) = w; } }
    }
};

struct EpiU {
    static constexpr bool PERM = true, AFTER_DRAIN = false;
    bf16_t* O; int ldc; const float* rss;
    __device__ __forceinline__ void operator()(const f32x4 (&acc)[2][2][4][2], const Unit& u, int wr, int wc, int fr, int fq) const {
        const int row0 = u.pm * BM + wr * 64 + fr; const int col0 = u.pn * BM + wc * 32 + 8 * fq;
#pragma unroll
        for (int ai = 0; ai < 2; ++ai)
#pragma unroll
            for (int m = 0; m < 4; ++m) { const int row = row0 + ai * HALF + m * 16; const float sc = rss ? rsqrtf(rss[row] * (1.f / 2048.f) + 1e-6f) : 1.f;
                bf16_t* rowp = O + (size_t)row * ldc + col0;
#pragma unroll
                for (int bj = 0; bj < 2; ++bj) { const f32x4 v0 = acc[ai][bj][m][0] * sc, v1 = acc[ai][bj][m][1] * sc;
                    u32x4 w; w.x = cvt_pk_bf16(v0[0], v0[1]); w.y = cvt_pk_bf16(v0[2], v0[3]); w.z = cvt_pk_bf16(v1[0], v1[1]); w.w = cvt_pk_bf16(v1[2], v1[3]);
                    *(u32x4*)(rowp + bj * HALF) = w; } }
    }
};
typedef unsigned u32x2e __attribute__((ext_vector_type(2)));
template <bool GATE> struct EpiRes {
    static constexpr bool PERM = false, AFTER_DRAIN = false;
    const bf16_t* Hin; bf16_t* Hout; float* rss_out; const bf16_t* PP; const float* rss_in;
    __device__ __forceinline__ void operator()(const f32x4 (&acc)[2][2][4][2], const Unit& u, int wr, int wc, int fr, int fq) const {
        const int row0 = u.pm * BM + wr * 64 + fr, col0 = u.pn * BM + wc * 32 + 4 * fq;
#pragma unroll
        for (int ai = 0; ai < 2; ++ai)
#pragma unroll
            for (int m = 0; m < 4; ++m) { const int row = row0 + ai * HALF + m * 16; const size_t ro = (size_t)row * 2048 + col0;
                float sc = 1.f; if (GATE) sc = rsqrtf(rss_in[row] * (1.f / 2048.f) + 1e-6f);
                float s = 0.f;
#pragma unroll
                for (int bj = 0; bj < 2; ++bj)
#pragma unroll
                    for (int n = 0; n < 2; ++n) { const size_t p = ro + bj * HALF + n * 16; const u32x2e hw = *(const u32x2e*)(Hin + p); const f32x4 a = acc[ai][bj][m][n];
                        f32x4 h; h[0] = __uint_as_float(hw.x << 16); h[1] = __uint_as_float(hw.x & 0xffff0000u); h[2] = __uint_as_float(hw.y << 16); h[3] = __uint_as_float(hw.y & 0xffff0000u);
                        if (GATE) { const u32x2e pw = *(const u32x2e*)(PP + p);
                            h[0] += __builtin_amdgcn_rcpf(1.f + __expf(-sc * a[0])) * __uint_as_float(pw.x << 16); h[1] += __builtin_amdgcn_rcpf(1.f + __expf(-sc * a[1])) * __uint_as_float(pw.x & 0xffff0000u);
                            h[2] += __builtin_amdgcn_rcpf(1.f + __expf(-sc * a[2])) * __uint_as_float(pw.y << 16); h[3] += __builtin_amdgcn_rcpf(1.f + __expf(-sc * a[3])) * __uint_as_float(pw.y & 0xffff0000u); }
                        else h = h + a;
                        s += (h[0] * h[0] + h[1] * h[1]) + (h[2] * h[2] + h[3] * h[3]);
                        u32x2e o; o.x = cvt_pk_bf16(h[0], h[1]); o.y = cvt_pk_bf16(h[2], h[3]); *(u32x2e*)(Hout + p) = o; }
                s += __shfl_xor(s, 16); s += __shfl_xor(s, 32);
                if (fq == 0) atomicAdd(rss_out + row, s);
                asm volatile("" ::: "memory"); }
    }
};
template <class Epi, class Sched, bool ALIGN_EPI = false, bool SP2 = false>
__device__ __forceinline__ void gemm_phase(PG8_LAS unsigned char* lds, const Gemm g, const Sched& S, const Epi& E, const int tid) {
    const int wid = __builtin_amdgcn_readfirstlane(tid >> 6), lane = tid & 63, wr = wid >> 2, wc = wid & 3, fr = lane & 15, fq = lane >> 4;
    const int K = g.K, nt = K / BK;
    unsigned voffA[2], voffB[2];
#pragma unroll
    for (int i = 0; i < 2; ++i) { int R, C; stage_rc(tid * 16 + i * 8192, R, C); const int Rb = Epi::PERM ? ((R & ~31) + perm32(R & 31)) : R;
        voffA[i] = (unsigned)(R * K + C) * 2u; voffB[i] = (unsigned)(Rb * K + C) * 2u; }
    const size_t kstep = (size_t)(BK * 2);
    const size_t hstep = (size_t)HALF * K * 2;
    const size_t tstep = 2 * hstep;
    const unsigned ldsw = (unsigned)wid * 1024u;
    const int aoff = lds_byte(wr * 64 + fr, fq * 8), boff = lds_byte(wc * 32 + fr, fq * 8);
#define PG8_SA(b, h) (((b) * 2 + (h)) * HTB)
#define PG8_SB(b, h) ((4 + (b) * 2 + (h)) * HTB)
#define PG8_STAGE(bufoff, gbase, voff) do { _Pragma("unroll") for (int _i = 0; _i < 2; ++_i) \
        __builtin_amdgcn_global_load_lds((const unsigned*)((const char*)(gbase) + (voff)[_i]), (PG8_LAS unsigned*)(lds + (bufoff) + ldsw + _i * 8192), 16, 0, 0); } while (0)
#define PG8_LDA(dst, b, h) do { _Pragma("unroll") for (int m = 0; m < 4; ++m) _Pragma("unroll") for (int k = 0; k < 2; ++k) dst[m][k] = *(const PG8_LAS bf16x8*)(lds + PG8_SA(b, h) + aoff + m * 2048 + k * 1024); } while (0)
#define PG8_LDB(dst, b, h) do { _Pragma("unroll") for (int n = 0; n < 2; ++n) _Pragma("unroll") for (int k = 0; k < 2; ++k) dst[n][k] = *(const PG8_LAS bf16x8*)(lds + PG8_SB(b, h) + boff + n * 2048 + k * 1024); } while (0)
#define PG8_MMA(ai, bj, At, Bt) do { __builtin_amdgcn_s_setprio(1); _Pragma("unroll") for (int m = 0; m < 4; ++m) _Pragma("unroll") for (int n = 0; n < 2; ++n) _Pragma("unroll") for (int k = 0; k < 2; ++k) \
        acc[ai][bj][m][n] = __builtin_amdgcn_mfma_f32_16x16x32_bf16(Bt[n][k], At[m][k], acc[ai][bj][m][n], 0, 0, 0); __builtin_amdgcn_s_setprio(0); } while (0)
#define PG8_WAIT_V(n) asm volatile("s_waitcnt vmcnt(" #n ")" ::: "memory")
#define PG8_WAIT_L(n) asm volatile("s_waitcnt lgkmcnt(" #n ")" ::: "memory")
#define PG8_BAR __builtin_amdgcn_s_barrier()
#define PG8_SCHED __builtin_amdgcn_sched_barrier(0)
    Unit cur, nxt; int ui = 0;
    if (!S.next(0, cur)) return;
    f32x4 acc[2][2][4][2];
#pragma unroll
    for (int a = 0; a < 2; ++a)
#pragma unroll
        for (int b = 0; b < 2; ++b)
#pragma unroll
            for (int m = 0; m < 4; ++m)
#pragma unroll
                for (int n = 0; n < 2; ++n) acc[a][b][m][n] = (f32x4){0.f, 0.f, 0.f, 0.f};
    bf16x8 At[4][2], B0[2][2], B1[2][2];
    const char* cA = (const char*)g.A + (size_t)cur.pm * tstep; const char* cB = (const char*)g.Bt + (size_t)cur.pn * tstep;
    S.a_ready(cur);
    if constexpr (SP2) {
        PG8_STAGE(PG8_SB(0, 0), cB, voffB); PG8_STAGE(PG8_SB(0, 1), cB + hstep, voffB); PG8_STAGE(PG8_SA(0, 0), cA, voffA); PG8_STAGE(PG8_SA(0, 1), cA + hstep, voffA);
        if (wr == 1) PG8_BAR;
        PG8_WAIT_V(2); PG8_BAR;
        PG8_STAGE(PG8_SB(1, 0), cB + kstep, voffB); PG8_STAGE(PG8_SA(1, 0), cA + kstep, voffA); PG8_STAGE(PG8_SB(1, 1), cB + hstep + kstep, voffB);
        PG8_WAIT_V(6); PG8_BAR;
    } else {
        PG8_STAGE(PG8_SB(0, 0), cB, voffB); PG8_STAGE(PG8_SA(0, 0), cA, voffA); PG8_STAGE(PG8_SB(0, 1), cB + hstep, voffB); PG8_STAGE(PG8_SA(0, 1), cA + hstep, voffA);
        if (wr == 1) PG8_BAR;
        PG8_WAIT_V(4); PG8_BAR;
        PG8_STAGE(PG8_SB(1, 0), cB + kstep, voffB); PG8_STAGE(PG8_SA(1, 0), cA + kstep, voffA); PG8_STAGE(PG8_SB(1, 1), cB + hstep + kstep, voffB);
        PG8_WAIT_V(6); PG8_BAR;
    }
    for (;;) {
        const bool has_next = S.next(ui + 1, nxt);
        const char* nA = has_next ? (const char*)g.A + (size_t)nxt.pm * tstep : cA; const char* nB = has_next ? (const char*)g.Bt + (size_t)nxt.pn * tstep : cB;
        for (int t = 0; t < nt; t += 2) {
            const bool last = (t == nt - 2);
            const char* a1 = cA + (size_t)(t + 1) * kstep;
            const char* a2 = last ? nA : cA + (size_t)(t + 2) * kstep; const char* b2 = last ? nB : cB + (size_t)(t + 2) * kstep;
            const char* a3 = a2 + kstep; const char* b3 = b2 + kstep;
            if (last && has_next) S.a_ready(nxt);
            if constexpr (SP2) {
            PG8_LDB(B0, 0, 0); PG8_LDB(B1, 0, 1); PG8_SCHED; PG8_LDA(At, 0, 0); PG8_STAGE(PG8_SA(1, 1), a1 + hstep, voffA);
            PG8_WAIT_V(8); PG8_WAIT_L(0); PG8_BAR; PG8_MMA(0, 0, At, B0); PG8_MMA(0, 1, At, B1); PG8_BAR; PG8_SCHED;
            PG8_LDA(At, 0, 1); PG8_STAGE(PG8_SB(0, 0), b2, voffB); PG8_STAGE(PG8_SB(0, 1), b2 + hstep, voffB); PG8_STAGE(PG8_SA(0, 0), a2, voffA);
            PG8_WAIT_V(8); PG8_WAIT_L(0); PG8_BAR; PG8_MMA(1, 0, At, B0); PG8_MMA(1, 1, At, B1); PG8_BAR; PG8_SCHED;
            PG8_LDB(B0, 1, 0); PG8_LDB(B1, 1, 1); PG8_SCHED; PG8_LDA(At, 1, 0); PG8_STAGE(PG8_SA(0, 1), a2 + hstep, voffA);
            PG8_WAIT_V(8); PG8_WAIT_L(0); PG8_BAR; PG8_MMA(0, 0, At, B0); PG8_MMA(0, 1, At, B1); PG8_BAR; PG8_SCHED;
            PG8_LDA(At, 1, 1); PG8_STAGE(PG8_SB(1, 0), b3, voffB); PG8_STAGE(PG8_SB(1, 1), b3 + hstep, voffB); PG8_STAGE(PG8_SA(1, 0), a3, voffA);
            PG8_WAIT_V(8); PG8_WAIT_L(0); PG8_BAR; PG8_MMA(1, 0, At, B0); PG8_MMA(1, 1, At, B1); PG8_BAR; PG8_SCHED;
            } else {
            PG8_LDB(B0, 0, 0); PG8_SCHED; PG8_LDA(At, 0, 0); PG8_STAGE(PG8_SA(1, 1), a1 + hstep, voffA);
            PG8_WAIT_L(8); PG8_BAR; PG8_WAIT_L(0); PG8_MMA(0, 0, At, B0); PG8_BAR; PG8_SCHED;
            PG8_LDB(B1, 0, 1); PG8_STAGE(PG8_SB(0, 0), b2, voffB);
            PG8_BAR; PG8_WAIT_L(0); PG8_MMA(0, 1, At, B1); PG8_BAR;
            PG8_LDA(At, 0, 1); PG8_STAGE(PG8_SA(0, 0), a2, voffA);
            PG8_BAR; PG8_WAIT_L(0); PG8_MMA(1, 0, At, B0); PG8_BAR; PG8_SCHED;
            PG8_STAGE(PG8_SB(0, 1), b2 + hstep, voffB);
            PG8_WAIT_V(6); PG8_BAR; PG8_MMA(1, 1, At, B1); PG8_BAR;
            PG8_LDB(B0, 1, 0); PG8_SCHED; PG8_LDA(At, 1, 0); PG8_STAGE(PG8_SA(0, 1), a2 + hstep, voffA);
            PG8_WAIT_L(8); PG8_BAR; PG8_WAIT_L(0); PG8_MMA(0, 0, At, B0); PG8_BAR; PG8_SCHED;
            PG8_LDB(B1, 1, 1); PG8_STAGE(PG8_SB(1, 0), b3, voffB);
            PG8_BAR; PG8_WAIT_L(0); PG8_MMA(0, 1, At, B1); PG8_BAR;
            PG8_LDA(At, 1, 1); PG8_STAGE(PG8_SA(1, 0), a3, voffA);
            PG8_BAR; PG8_WAIT_L(0); PG8_MMA(1, 0, At, B0); PG8_BAR; PG8_SCHED;
            PG8_STAGE(PG8_SB(1, 1), b3 + hstep, voffB);
            PG8_WAIT_V(6); PG8_BAR; PG8_MMA(1, 1, At, B1); PG8_BAR;
            }
        }
        if constexpr (ALIGN_EPI) { if (wr == 0) PG8_BAR; }
        if constexpr (!Epi::AFTER_DRAIN) { E(acc, cur, wr, wc, fr, fq); S.done(cur); }
        if (!has_next) break;
#pragma unroll
        for (int a = 0; a < 2; ++a)
#pragma unroll
            for (int b = 0; b < 2; ++b)
#pragma unroll
                for (int m = 0; m < 4; ++m)
#pragma unroll
                    for (int n = 0; n < 2; ++n) acc[a][b][m][n] = (f32x4){0.f, 0.f, 0.f, 0.f};
        cur = nxt; cA = nA; cB = nB; ++ui;
        if constexpr (ALIGN_EPI) { if (wr == 1) PG8_BAR; }
    }
    PG8_WAIT_V(0);
    if constexpr (!ALIGN_EPI) { if (wr == 0) PG8_BAR; }
    PG8_BAR;
    if constexpr (Epi::AFTER_DRAIN) { E.fused(acc, cur, wr, wc, fr, fq, lds, wid, lane); S.done(cur); }
#undef PG8_SA
#undef PG8_SB
#undef PG8_STAGE
#undef PG8_LDA
#undef PG8_LDB
#undef PG8_MMA
#undef PG8_WAIT_V
#undef PG8_WAIT_L
#undef PG8_BAR
#undef PG8_SCHED
}
}

constexpr int TP = 8192, TS = 512, T = TP + TS, DM = 2048, NSEQ = 132;
constexpr int NAB = 7424, NCD = 4864;
constexpr int NWAVES = 8, NTHR = 512;
constexpr size_t MiB = 1u << 20;
constexpr size_t WS_CTL = 0, CTL_ZERO_BYTES = 1 * MiB;
constexpr int CW_BAR = 4096, CW_CNT = 8192;
constexpr size_t WS_RSS = 65536;
constexpr size_t WS_WABIN = 2 * MiB, WS_WABOUT = 60 * MiB, WS_WCDIN = 76 * MiB, WS_WCDOUT = 114 * MiB, WS_WGATE = 130 * MiB, WS_WPROJ = 162 * MiB;
constexpr size_t WS_H = 166 * MiB, WS_XN = 234 * MiB, WS_YM = 268 * MiB, WS_PB = 302 * MiB, WS_U = 320 * MiB, WS_SCR = 444 * MiB, WS_END = 732 * MiB;
constexpr size_t SC_HB1 = 102 * MiB;
constexpr size_t SC_PP = 8 * MiB;
constexpr size_t SC_QN = 0, SC_KN = 2 * MiB, SC_VV = 4 * MiB, SC_GLOG = 6 * MiB, SC_BETA = 7 * MiB, SC_GDEC = 7 * MiB + 65536, SC_ODN = 102 * MiB, SC_OGLA = 136 * MiB,
    SC_DNOPS = 192 * MiB;
constexpr size_t SC_XBC = 0, SC_DT = 3 * MiB, SC_LA = 52 * MiB, SC_LB = 86 * MiB, SC_YS = 120 * MiB, SC_HS = 154 * MiB, SC_SSDOP = 192 * MiB, SC_XS = 270 * MiB;
constexpr int LDS_BYTES = 163840;
constexpr size_t O_Y_P = 0, O_Y_S = O_Y_P + (size_t)4 * 2048 * 2048, O_DN_P = O_Y_S + (size_t)128 * 4 * 2048,
    O_DNC_P = O_DN_P + (size_t)2 * 4 * 8 * 128 * 128, O_GLA_P = O_DNC_P + (size_t)2 * 4 * 3 * 3072, O_SSD_P = O_GLA_P + (size_t)2 * 4 * 4 * 128 * 256,
    O_SSDC_P = O_SSD_P + (size_t)2 * 4 * 16 * 64 * 64, O_LRU_P = O_SSDC_P + (size_t)2 * 4 * 3 * 1536, O_LRUC_P = O_LRU_P + (size_t)2 * 4 * 1024,
    O_DN_S = O_LRUC_P + (size_t)2 * 4 * 3 * 1024, O_DNC_S = O_DN_S + (size_t)2 * 128 * 8 * 128 * 128, O_GLA_S = O_DNC_S + (size_t)2 * 128 * 3 * 3072,
    O_SSD_S = O_GLA_S + (size_t)2 * 128 * 4 * 128 * 256, O_SSDC_S = O_SSD_S + (size_t)2 * 128 * 16 * 64 * 64, O_LRU_S = O_SSDC_S + (size_t)2 * 128 * 3 * 1536,
    O_LRUC_S = O_LRU_S + (size_t)2 * 128 * 1024, O_END = O_LRUC_S + (size_t)2 * 128 * 3 * 1024;
static_assert(O_END == 109064192, "output size");

#define LAS __attribute__((address_space(3)))
typedef unsigned short bf16;
typedef float f32x4 __attribute__((ext_vector_type(4)));
typedef unsigned u32x2 __attribute__((ext_vector_type(2)));
typedef unsigned u32x4 __attribute__((ext_vector_type(4)));
#define LDS_WAIT() asm volatile("s_waitcnt lgkmcnt(0)" ::: "memory")

__device__ __forceinline__ float bf2f(bf16 b) { return __uint_as_float(((unsigned)b) << 16); }
__device__ __forceinline__ unsigned f2bf(float f) { unsigned u = __float_as_uint(f); return (u + 0x7fffu + ((u >> 16) & 1u)) >> 16; }
__device__ __forceinline__ unsigned pk2(float lo, float hi) { return f2bf(lo) | (f2bf(hi) << 16); }
__device__ __forceinline__ float sigmoid_(float x) { return __builtin_amdgcn_rcpf(1.f + __expf(-x)); }
__device__ __forceinline__ float silu_(float x) { return x * __builtin_amdgcn_rcpf(1.f + __expf(-x)); }
__device__ __forceinline__ float softplus_(float x) { return x > 15.f ? x : (x < -15.f ? __expf(x) : __logf(1.f + __expf(x))); }
__device__ __forceinline__ float wave_sum(float v) {
#pragma unroll
    for (int o = 1; o < 64; o <<= 1) v += __shfl_xor(v, o);
    return v;
}
__device__ __forceinline__ void row_to_seq(int r, int& s, int& t) { if (r < TP) { s = r >> 11; t = r & 2047; } else { s = 4 + ((r - TP) >> 2); t = (r - TP) & 3; } }
__device__ __forceinline__ void seq_info(int s, int& row0, int& L) { if (s < 4) { row0 = s << 11; L = 2048; } else { row0 = TP + ((s - 4) << 2); L = 4; } }
__device__ __forceinline__ float pre_val(const bf16* U, int ldu, int ucol, int row0, int tt, int s, const float* stc, int W, int c) {
    if (tt >= 0) return bf2f(U[(size_t)(row0 + tt) * ldu + ucol]);
    if (s < 4) return 0.f;
    return stc[((size_t)(s - 4) * 3 + (3 + tt)) * W + c];
}
__device__ __forceinline__ int map_col(int mapid, int n) {
    if (mapid == 0) return n;
    if (mapid == 1) { if (n < 3072) return n; if (n < 6144) return n + 16; if (n < 7168) return n + 32; if (n < 7184) return n - 4096; if (n < 7200) return n - 1024; return -1; }
    if (n < 2560) return n; if (n < 4608) return n + 16; if (n < 4624) return n - 2048; return -1;
}
__device__ __forceinline__ void transpose_item(const float* W, int K, int Nsrc, bf16* WT, int Npad, int mapid, const float* gain, LAS float* scr, int item, int lane) {
    const int nblk = Npad / 64, kb = item / nblk, nb = item % nblk, k0 = 64 * kb, n0 = 64 * nb;
    const int n4 = (lane & 15) * 4, src = map_col(mapid, n0 + n4);
#pragma unroll 8
    for (int i = 0; i < 16; ++i) { const int kk = 4 * i + (lane >> 4);
        f32x4 v = (f32x4){0.f, 0.f, 0.f, 0.f};
        if (src >= 0) { v = *(const f32x4*)(W + (size_t)(k0 + kk) * Nsrc + src); if (gain) v = v * gain[k0 + kk]; }
        scr[kk * 65 + n4] = v.x; scr[kk * 65 + n4 + 1] = v.y; scr[kk * 65 + n4 + 2] = v.z; scr[kk * 65 + n4 + 3] = v.w; }
    LDS_WAIT(); asm volatile("" ::: "memory");
    const int c = lane & 7;
#pragma unroll
    for (int jj = 0; jj < 8; ++jj) { const int n = (lane >> 3) + 8 * jj; const LAS float* p = scr + (8 * c) * 65 + n;
        u32x4 o; o.x = pk2(p[0 * 65], p[1 * 65]); o.y = pk2(p[2 * 65], p[3 * 65]); o.z = pk2(p[4 * 65], p[5 * 65]); o.w = pk2(p[6 * 65], p[7 * 65]);
        *(u32x4*)(WT + (size_t)(n0 + n) * K + k0 + 8 * c) = o; }
    LDS_WAIT(); asm volatile("" ::: "memory");
}
__device__ __forceinline__ void norm_row_bf16(const f32x4 (&v)[8], const float* g, bf16* orow, int lane) {
    float ss = 0.f;
#pragma unroll
    for (int j = 0; j < 8; ++j) ss += (v[j].x * v[j].x + v[j].y * v[j].y) + (v[j].z * v[j].z + v[j].w * v[j].w);
    const float rstd = rsqrtf(wave_sum(ss) * (1.f / DM) + 1e-6f);
#pragma unroll
    for (int j = 0; j < 8; ++j) { const int col = 4 * (lane + 64 * j); const f32x4 gg = *(const f32x4*)(g + col);
        u32x2 o; o.x = pk2(v[j].x * rstd * gg.x, v[j].y * rstd * gg.y); o.y = pk2(v[j].z * rstd * gg.z, v[j].w * rstd * gg.w);
        *(u32x2*)(orow + col) = o; }
}

typedef __bf16 bf16x2_t __attribute__((ext_vector_type(2)));
typedef float f32x2_t __attribute__((ext_vector_type(2)));
typedef short bf16x8 __attribute__((ext_vector_type(8)));
typedef float f32x16 __attribute__((ext_vector_type(16)));
__device__ __forceinline__ unsigned cvtpk(float lo, float hi) { f32x2_t v = {lo, hi}; bf16x2_t b = __builtin_convertvector(v, bf16x2_t); return __builtin_bit_cast(unsigned, b); }
#define MFMA32(a, b, c) __builtin_amdgcn_mfma_f32_32x32x16_bf16((a), (b), (c), 0, 0, 0)
#define PACK_ACC(x, S_) __builtin_bit_cast(bf16x8, (u32x4){cvtpk((x)[8 * (S_)], (x)[8 * (S_) + 1]), cvtpk((x)[8 * (S_) + 2], (x)[8 * (S_) + 3]), cvtpk((x)[8 * (S_) + 4], (x)[8 * (S_) + 5]), cvtpk((x)[8 * (S_) + 6], (x)[8 * (S_) + 7])})
__device__ __forceinline__ int crow(int reg, int h) { return (reg & 3) + 8 * (reg >> 2) + 4 * h; }
__device__ __forceinline__ bf16x8 pack8(const float (&v)[8]) { return __builtin_bit_cast(bf16x8, (u32x4){cvtpk(v[0], v[1]), cvtpk(v[2], v[3]), cvtpk(v[4], v[5]), cvtpk(v[6], v[7])}); }

#define XB_TMO      128
#define XB_XCNT(j)  (256  + 64 * (j))
#define XB_XSUB(j)  (1280 + 64 * (j))
#define XB_XGEN(j)  (2304 + 64 * (j))
#define XB_TOP      3328
#define XB_TOPGEN   3392
#define XCD_BAR_WORDS 3456
#define XB_SPIN_CAP (1u << 18)

__device__ __forceinline__ unsigned xb_ld(unsigned* p)              { return __hip_atomic_load(p, __ATOMIC_RELAXED, __HIP_MEMORY_SCOPE_AGENT); }
__device__ __forceinline__ unsigned xb_add(unsigned* p, unsigned v) { return __hip_atomic_fetch_add(p, v, __ATOMIC_RELAXED, __HIP_MEMORY_SCOPE_AGENT); }
__device__ __forceinline__ unsigned xb_xcc_id() { return (unsigned)__builtin_amdgcn_s_getreg((3 << 11) | 20) & 0xFu; }
#define XB_SPIN(cond, bar) do { unsigned _sp = 0; while (cond) { __builtin_amdgcn_s_sleep(1); \
    if ((++_sp & 255u) == 0u) { if (xb_ld(&(bar)[XB_TMO])) break; if (_sp > XB_SPIN_CAP) { atomicAdd(&(bar)[XB_TMO], 1u); break; } } } } while (0)

struct XcdBarrier {
    unsigned* bar; unsigned x;
    volatile LAS unsigned* st;
};

__device__ __forceinline__ XcdBarrier xcd_barrier_post(unsigned* bar, volatile LAS unsigned* st) {
    XcdBarrier b; b.bar = bar; b.x = xb_xcc_id(); b.st = st;
    if (threadIdx.x == 0) (void)xb_add(&bar[XB_XCNT(b.x)], 1u);
    return b;
}
__device__ __forceinline__ void xcd_barrier_complete(unsigned* bar, unsigned x, unsigned& nloc, unsigned& nx) {
    const unsigned G = gridDim.x * gridDim.y * gridDim.z;
    unsigned sum, cnt, mine, sp = 0u;
    for (;;) {
        sum = 0u; cnt = 0u; mine = 0u;
#pragma unroll
        for (unsigned j = 0; j < 16; ++j) { const unsigned c = xb_ld(&bar[XB_XCNT(j)]); sum += c; cnt += (c > 0u) ? 1u : 0u; mine = (j == x) ? c : mine; }
        if (sum == G) break;
        __builtin_amdgcn_s_sleep(1);
        if ((++sp & 255u) == 0u) { if (xb_ld(&bar[XB_TMO])) break; if (sp > XB_SPIN_CAP) { atomicAdd(&bar[XB_TMO], 1u); break; } }
    }
    nloc = mine > 0u ? mine : 1u; nx = cnt > 0u ? cnt : 1u;
}

__device__ __forceinline__ void xcd_barrier(const XcdBarrier& b) {
    asm volatile("s_waitcnt vmcnt(0)" ::: "memory");
    __syncthreads();
    if (threadIdx.x == 0) {
        unsigned* bar = b.bar;
        __builtin_amdgcn_s_waitcnt(0);
        unsigned nloc = b.st[0], nx = b.st[1];
        if (nloc == 0u) { xcd_barrier_complete(bar, b.x, nloc, nx); b.st[0] = nloc; b.st[1] = nx; }
        const unsigned old = xb_add(&bar[XB_XSUB(b.x)], 1u);
        const unsigned gen = old / nloc;
        if (old + 1u == (gen + 1u) * nloc) {
            __builtin_amdgcn_fence(__ATOMIC_RELEASE, "agent");
            asm volatile("s_waitcnt vmcnt(0)" ::: "memory");
            const unsigned og = xb_add(&bar[XB_TOP], 1u);
            const unsigned tg = og / nx;
            if (og + 1u == (tg + 1u) * nx) xb_add(&bar[XB_TOPGEN], 1u);
            else XB_SPIN(xb_ld(&bar[XB_TOPGEN]) == tg, bar);
            __builtin_amdgcn_fence(__ATOMIC_ACQUIRE, "agent");
            xb_add(&bar[XB_XGEN(b.x)], 1u);
            asm volatile("s_waitcnt vmcnt(0)" ::: "memory");
        } else {
            XB_SPIN(xb_ld(&bar[XB_XGEN(b.x)]) == gen, bar);
            __builtin_amdgcn_fence(__ATOMIC_ACQUIRE, "agent");
            asm volatile("s_waitcnt vmcnt(0)" ::: "memory");
        }
    }
    __syncthreads();
}


#ifdef PROBE_SEC
#define SEC_BEGIN(id) unsigned long long _sec_t##id = 0; if ((id) == PROBE_SEC) { __builtin_amdgcn_s_barrier(); _sec_t##id = __builtin_amdgcn_s_memrealtime(); }
#define SEC_END(id, ldsp) if ((id) == PROBE_SEC) { __builtin_amdgcn_s_barrier(); if (threadIdx.x == 0) { volatile LAS unsigned long long* a_ = (volatile LAS unsigned long long*)((ldsp) + LDS_BYTES - 32); a_[0] = a_[0] + (__builtin_amdgcn_s_memrealtime() - _sec_t##id); } }
#else
#define SEC_BEGIN(id)
#define SEC_END(id, ldsp)
#endif
struct Args { const float* in[40]; float* out; unsigned char* ws; int ph_lo, ph_hi; };
constexpr int N_PHASES = 26, SUBS = 6;
#ifndef PH_MASK
#define PH_MASK 16383
#endif
#define AS4 __attribute__((address_space(4)))
struct KP { const char AS4* p;
    __device__ __forceinline__ const float* in(int i) const { return *(const float* const AS4*)(p + 8 * i); }
    __device__ __forceinline__ float* out() const { return *(float* const AS4*)(p + 320); }
    __device__ __forceinline__ unsigned char* ws() const { return *(unsigned char* const AS4*)(p + 328); }
};
static_assert(sizeof(Args) == 344, "Args layout");

__device__ __forceinline__ void phase_prologue(const KP kp, LAS unsigned char* lds, int gw, int NGW, int wave, int lane) {
    unsigned char* ws = kp.ws();
    LAS float* scr = (LAS float*)(lds + wave * 17408);
    SEC_BEGIN(1)
    for (int job = 0; job < 16; ++job) {
        const float* W; int K = 2048, Nsrc = 2048, Npad = 2048, mapid = 0; bf16* WT; const float* gain = nullptr;
        if (job < 2)       { W = kp.in(13) + (size_t)job * 2048 * 7200; Nsrc = 7200; Npad = NAB; mapid = 1; WT = (bf16*)(ws + WS_WABIN) + (size_t)job * NAB * 2048; gain = kp.in(11) + (size_t)(2 * job) * DM; }
        else if (job < 4)  { W = kp.in(21) + (size_t)(job - 2) * 2048 * 2048; WT = (bf16*)(ws + WS_WABOUT) + (size_t)(job - 2) * 2048 * 2048; }
        else if (job < 6)  { W = kp.in(22) + (size_t)(job - 4) * 2048 * 4624; Nsrc = 4624; Npad = NCD; mapid = 2; WT = (bf16*)(ws + WS_WCDIN) + (size_t)(job - 4) * NCD * 2048; gain = kp.in(11) + (size_t)(2 * (job - 4) + 1) * DM; }
        else if (job < 8)  { W = kp.in(36) + (size_t)(job - 6) * 2048 * 2048; WT = (bf16*)(ws + WS_WCDOUT) + (size_t)(job - 6) * 2048 * 2048; }
        else if (job < 12) { W = kp.in(39) + (size_t)(job - 8) * 2048 * 2048; WT = (bf16*)(ws + WS_WGATE) + (size_t)(job - 8) * 2048 * 2048; gain = kp.in(38) + (size_t)(job - 8) * DM; }
        else               { W = kp.in(37) + (size_t)(job - 12) * 256 * 2048; K = 256; WT = (bf16*)(ws + WS_WPROJ) + (size_t)(job - 12) * 2048 * 256; }
        const int nitems = (K / 64) * (Npad / 64), nblocks = NGW / NWAVES, ipb = (nitems + nblocks - 1) / nblocks, ib = (gw / NWAVES) * ipb, ie = ib + ipb < nitems ? ib + ipb : nitems;
        for (int it = ib + wave; it < ie; it += NWAVES) transpose_item(W, K, Nsrc, WT, Npad, mapid, gain, scr, it, lane);
    }
    SEC_END(1, lds)
    SEC_BEGIN(2)
    bf16* HB = (bf16*)(ws + WS_XN); float* RSS = (float*)(ws + WS_RSS);
    for (int m = gw; m < T; m += NGW) {
        const float* src = m < TP ? kp.in(0) + (size_t)m * DM : kp.in(1) + (size_t)(m - TP) * DM;
        float ss = 0.f;
#pragma unroll
        for (int jj = 0; jj < 8; ++jj) { const int col = 4 * (lane + 64 * jj); const f32x4 v = *(const f32x4*)(src + col);
            u32x2 o; o.x = pk2(v.x, v.y); o.y = pk2(v.z, v.w); *(u32x2*)(HB + (size_t)m * DM + col) = o; ss += (v.x * v.x + v.y * v.y) + (v.z * v.z + v.w * v.w); }
        ss = wave_sum(ss); if (lane == 0) RSS[m] = ss;
    }
    bf16* PB = (bf16*)(ws + WS_PB);
    const int gt = gw * 64 + lane, NGT = NGW * 64;
    for (int i = gt; i < 4 * T * 64; i += NGT) {
        const int c4 = i & 63, rr = i >> 6, li = rr / T, r = rr - li * T;
        const float* src = r < TP ? kp.in(9) + ((size_t)li * TP + r) * 256 + 4 * c4 : kp.in(10) + ((size_t)li * TS + (r - TP)) * 256 + 4 * c4;
        const f32x4 v = *(const f32x4*)src;
        u32x2 o; o.x = pk2(v.x, v.y); o.y = pk2(v.z, v.w);
        *(u32x2*)(PB + ((size_t)li * T + r) * 256 + 4 * c4) = o;
    }
    SEC_END(2, lds)
}
__device__ __forceinline__ void phase_final(const KP kp, int gw, int NGW, int lane) {
    const bf16* HB = (const bf16*)(kp.ws() + WS_XN); const float* RSS = (const float*)(kp.ws() + WS_RSS) + (size_t)8 * T; const float* g = kp.in(12); float* out = kp.out();
    for (int m = gw; m < T; m += NGW) { const float rstd = rsqrtf(RSS[m] * (1.f / DM) + 1e-6f);
#pragma unroll
        for (int jj = 0; jj < 8; ++jj) { const int col = 4 * (lane + 64 * jj); const u32x2 hv = *(const u32x2*)(HB + (size_t)m * DM + col); const f32x4 gg = *(const f32x4*)(g + col);
            f32x4 o; o.x = __uint_as_float(hv.x << 16) * rstd * gg.x; o.y = __uint_as_float(hv.x & 0xffff0000u) * rstd * gg.y; o.z = __uint_as_float(hv.y << 16) * rstd * gg.z; o.w = __uint_as_float(hv.y & 0xffff0000u) * rstd * gg.w;
            *(f32x4*)(out + (size_t)m * DM + col) = o; } }
}

__device__ __forceinline__ void phase_ab_pre(const KP kp, const int bid, const int G, int j, int tid, int wave, int lane) {
    unsigned char* scr = kp.ws() + WS_SCR; const bf16* U = (const bf16*)(kp.ws() + WS_U);
    float* QN = (float*)(scr + SC_QN) - (size_t)TP * 1024; float* KN = (float*)(scr + SC_KN) - (size_t)TP * 1024; float* VV = (float*)(scr + SC_VV) - (size_t)TP * 1024;
    float* GLOG = (float*)(scr + SC_GLOG) - (size_t)TP * 512; float* BETA = (float*)(scr + SC_BETA) - (size_t)TP * 8; float* GDEC = (float*)(scr + SC_GDEC) - (size_t)TP * 8;
    const float* cw = kp.in(14) + (size_t)j * 4 * 3072; const float* stc = kp.in(3) + (size_t)j * 128 * 3 * 3072;
    const float* wa2 = kp.in(18) + (size_t)j * 16 * 512; const float* ba = kp.in(19) + (size_t)j * 512;
    for (int r = TP + bid; r < T; r += G) {
        int s, t; row_to_seq(r, s, t); const int row0 = r - t;
#pragma unroll
        for (int part = 0; part < 3; ++part) {
            float val[2];
#pragma unroll
            for (int i = 0; i < 2; ++i) { const int c = part * 1024 + wave * 128 + lane + 64 * i; float acc = 0.f;
#pragma unroll
                for (int tap = 0; tap < 4; ++tap) acc += cw[tap * 3072 + c] * pre_val(U, NAB, c, row0, t - 3 + tap, s, stc, 3072, c);
                val[i] = silu_(acc); }
            if (part < 2) { const float ss = wave_sum(val[0] * val[0] + val[1] * val[1]); const float sc = rsqrtf(ss + 1e-6f) * (part == 0 ? 0.08838834764831845f : 1.f); val[0] *= sc; val[1] *= sc; }
            float* dst = part == 0 ? QN : (part == 1 ? KN : VV);
            dst[(size_t)r * 1024 + wave * 128 + lane] = val[0]; dst[(size_t)r * 1024 + wave * 128 + lane + 64] = val[1];
        }
        if (tid < 8) {
            BETA[(size_t)r * 8 + tid] = sigmoid_(bf2f(U[(size_t)r * NAB + 7168 + tid]));
            GDEC[(size_t)r * 8 + tid] = -__expf(kp.in(15)[j * 8 + tid]) * softplus_(bf2f(U[(size_t)r * NAB + 7176 + tid]) + kp.in(16)[j * 8 + tid]);
        }
        { float x = ba[tid];
#pragma unroll
          for (int rr = 0; rr < 16; ++rr) x += bf2f(U[(size_t)r * NAB + 7184 + rr]) * wa2[rr * 512 + tid];
          GLOG[(size_t)r * 512 + tid] = -softplus_(-x) * (1.f / 16.f); }
    }
}


constexpr size_t GLA_ITEM_BYTES = 74752, WS_GLAOPS = WS_H;
__device__ __forceinline__ void phase_gla_prep(const KP kp, const int bid, const int G, int j, LAS unsigned char* lds, int tid) {
    const bf16* U = (const bf16*)(kp.ws() + WS_U);
    const float* wa2 = kp.in(18) + (size_t)j * 16 * 512; const float* ba = kp.in(19) + (size_t)j * 512;
    unsigned char* OPS = kp.ws() + WS_GLAOPS;
    LAS float* GL = (LAS float*)lds; LAS float* QL = GL + 64 * 129; LAS float* KL = QL + 64 * 129; LAS float* AL = KL + 64 * 129;
    const int lane = tid & 63, r = lane & 31, hp = lane >> 5;
    for (int item = bid; item < 512; item += G) {
        const int b = item >> 7, n = (item >> 2) & 31, h = item & 3;
        const int row0 = b * 2048 + n * 64;
        __syncthreads();
        for (int i = tid; i < 8192; i += NTHR) { const int t = i >> 7, d = i & 127; const size_t ro = (size_t)(row0 + t) * NAB;
            QL[t * 129 + d] = bf2f(U[ro + 4096 + h * 128 + d]) * 0.08838834764831845f; KL[t * 129 + d] = bf2f(U[ro + 4608 + h * 128 + d]);
            float x = ba[h * 128 + d];
#pragma unroll
            for (int rr = 0; rr < 16; ++rr) x += bf2f(U[ro + 7184 + rr]) * wa2[rr * 512 + h * 128 + d];
            GL[t * 129 + d] = -softplus_(-x) * (1.f / 16.f); }
        __syncthreads();
        if (tid < 128) { float acc = 0.f;
#pragma unroll 4
            for (int t = 0; t < 64; ++t) { acc += GL[t * 129 + tid]; GL[t * 129 + tid] = acc; } }
        __syncthreads();
        for (int i = tid; i < 8192; i += NTHR) { const int t = i >> 7, d = i & 127; const float gg = GL[t * 129 + d]; QL[t * 129 + d] *= __expf(gg); KL[t * 129 + d] *= __expf(-gg); }
        __syncthreads();
        { const int i = tid >> 3, jg = tid & 7; float acc[8];
#pragma unroll
          for (int jj = 0; jj < 8; ++jj) acc[jj] = 0.f;
#pragma unroll 4
          for (int d = 0; d < 128; ++d) { const float c = QL[i * 129 + d];
#pragma unroll
              for (int jj = 0; jj < 8; ++jj) acc[jj] += c * KL[(jg * 8 + jj) * 129 + d]; }
#pragma unroll
          for (int jj = 0; jj < 8; ++jj) AL[i * 65 + jg * 8 + jj] = (jg * 8 + jj) <= i ? acc[jj] : 0.f; }
        __syncthreads();
        bf16x8* base = (bf16x8*)(OPS + (size_t)item * GLA_ITEM_BYTES);
        float v[8];
#pragma unroll
        for (int q = 0; q < 2; ++q) { const int f = (tid >> 6) + 8 * q;
            { const int mt = f >> 3, ks = f & 7, i = 32 * mt + r;
#pragma unroll
              for (int jp = 0; jp < 8; ++jp) v[jp] = QL[i * 129 + 16 * ks + 8 * (jp >> 2) + 4 * hp + (jp & 3)];
              base[f * 64 + lane] = pack8(v); }
            { const int mt = f >> 2, ks = f & 3, d = 32 * mt + r; const float eg = __expf(GL[63 * 129 + d]);
#pragma unroll
              for (int jp = 0; jp < 8; ++jp) v[jp] = KL[(16 * ks + 8 * (jp >> 2) + 4 * hp + (jp & 3)) * 129 + d] * eg;
              base[(16 + f) * 64 + lane] = pack8(v); } }
        { const int f = tid >> 6, mt = f >> 2, ks = f & 3, i = 32 * mt + r;
#pragma unroll
          for (int jp = 0; jp < 8; ++jp) v[jp] = AL[i * 65 + 16 * ks + 8 * (jp >> 2) + 4 * hp + (jp & 3)];
          base[(32 + f) * 64 + lane] = pack8(v); }
#pragma unroll
        for (int q = 0; q < 4; ++q) { const int f = (tid >> 6) + 8 * q, nt = f >> 2, ks = f & 3, p = 32 * nt + r;
            unsigned w[4];
#pragma unroll
            for (int jp = 0; jp < 8; jp += 2) { const int t0 = 16 * ks + 8 * (jp >> 2) + 4 * hp + (jp & 3);
                w[jp >> 1] = (unsigned)U[(size_t)(row0 + t0) * NAB + 5120 + h * 256 + p] | ((unsigned)U[(size_t)(row0 + t0 + 1) * NAB + 5120 + h * 256 + p] << 16); }
            base[(40 + f) * 64 + lane] = __builtin_bit_cast(bf16x8, (u32x4){w[0], w[1], w[2], w[3]}); }
        if (tid < 128) ((float*)(base + 72 * 64))[tid] = __expf(GL[63 * 129 + tid]);
    }
}


constexpr size_t DN_ITEM_BYTES = 74752;
__device__ __forceinline__ void phase_dn_prep(const KP kp, const int bid, const int G, int j, LAS unsigned char* lds, int tid0) {
    unsigned char* scr = kp.ws() + WS_SCR;
    const bf16* U = (const bf16*)(kp.ws() + WS_U); const float* cw = kp.in(14) + (size_t)j * 4 * 3072;
    unsigned char* OPS = scr + SC_DNOPS;
    LAS float* AMT = (LAS float*)lds; LAS float* GLs = AMT + 64 * 68; LAS float* BLs = GLs + 64; LAS float* SS = BLs + 64;
    LAS bf16* Kb = (LAS bf16*)(SS + 256); LAS bf16* Qb = Kb + 64 * 136; LAS float* QKm = (LAS float*)(Qb + 64 * 136); LAS float* XL = QKm + 64 * 65;
    for (int item = bid; item < 1024; item += G) {
        int tid = tid0; asm volatile("" : "+v"(tid));
        const int lane = tid & 63, r = lane & 31, hp = lane >> 5, wave = tid >> 6;
        const int b = item >> 8, n = (item >> 3) & 31, h = item & 7;
        const int row0 = b * 2048 + n * 64;
        __syncthreads();
        float qv[16], kv[16];
        { const int d = tid & 127, tg = tid >> 7, t0 = 16 * tg;
          const bool first = (n == 0 && tg == 0);
#pragma unroll
          for (int part = 0; part < 3; ++part) { const int c = part * 1024 + h * 128 + d;
              const float w0 = cw[c], w1 = cw[3072 + c], w2 = cw[2 * 3072 + c], w3 = cw[3 * 3072 + c];
              const bf16* up = U + (size_t)(row0 + t0) * NAB + c;
              float x0 = first ? 0.f : bf2f(up[-3 * (long)NAB]), x1 = first ? 0.f : bf2f(up[-2 * (long)NAB]), x2 = first ? 0.f : bf2f(up[-1 * (long)NAB]);
#pragma unroll
              for (int t = 0; t < 16; ++t) { const float x3 = bf2f(up[(size_t)t * NAB]); const float y = silu_(w0 * x0 + w1 * x1 + w2 * x2 + w3 * x3); x0 = x1; x1 = x2; x2 = x3;
                  if (part == 0) qv[t] = y; else if (part == 1) kv[t] = y; else XL[(t0 + t) * 257 + d] = y; } }
          const int half = (tid >> 6) & 1;
#pragma unroll
          for (int t = 0; t < 16; ++t) { const float sq = wave_sum(qv[t] * qv[t]), sk = wave_sum(kv[t] * kv[t]); if (lane == 0) { SS[half * 64 + t0 + t] = sq; SS[(2 + half) * 64 + t0 + t] = sk; } } }
        if (wave == 0) { const size_t ro = (size_t)(row0 + lane) * NAB;
            float gv = -__expf(kp.in(15)[j * 8 + h]) * softplus_(bf2f(U[ro + 7176 + h]) + kp.in(16)[j * 8 + h]);
#pragma unroll
            for (int o = 1; o < 64; o <<= 1) { const float tt = __shfl_up(gv, o); if (lane >= o) gv += tt; }
            GLs[lane] = gv; BLs[lane] = sigmoid_(bf2f(U[ro + 7168 + h])); }
        __syncthreads();
        { const int d = tid & 127, t0 = 16 * (tid >> 7);
#pragma unroll
          for (int t = 0; t < 16; ++t) { const float scq = rsqrtf(SS[t0 + t] + SS[64 + t0 + t] + 1e-6f) * 0.08838834764831845f, sck = rsqrtf(SS[128 + t0 + t] + SS[192 + t0 + t] + 1e-6f);
              Qb[(t0 + t) * 136 + d] = (bf16)f2bf(qv[t] * scq); Kb[(t0 + t) * 136 + d] = (bf16)f2bf(kv[t] * sck); } }
        __syncthreads();
        bf16x8* base = (bf16x8*)(OPS + (size_t)item * DN_ITEM_BYTES);
        { const int which = wave >> 2, mt = (wave >> 1) & 1, nt = wave & 1;
          const LAS bf16* Asrc = which ? Qb : Kb;
          f32x16 acc;
#pragma unroll
          for (int i = 0; i < 16; ++i) acc[i] = 0.f;
#pragma unroll
          for (int ks = 0; ks < 8; ++ks) acc = MFMA32(*(const LAS bf16x8*)(Asrc + (32 * mt + r) * 136 + 16 * ks + 8 * hp), *(const LAS bf16x8*)(Kb + (32 * nt + r) * 136 + 16 * ks + 8 * hp), acc);
          const int jt = 32 * nt + r; const float gj = GLs[jt];
#pragma unroll
          for (int i16 = 0; i16 < 16; ++i16) { const int i = 32 * mt + crow(i16, hp); const float dec = __expf(GLs[i] - gj);
              if (which == 0) AMT[jt * 68 + i] = jt < i ? BLs[i] * acc[i16] * dec : 0.f; else QKm[i * 65 + jt] = jt <= i ? acc[i16] * dec : 0.f; } }
        __syncthreads();
        if (tid < 256) {
            const int c = tid;
#pragma unroll
            for (int bi = 0; bi < 4; ++bi) {
                float acc[16];
#pragma unroll
                for (int ii = 0; ii < 16; ++ii) { const int i = 16 * bi + ii; const float be = BLs[i];
                    acc[ii] = c < 128 ? be * XL[i * 257 + c] : be * __expf(GLs[i]) * bf2f(Kb[i * 136 + (c - 128)]); }
                for (int jj = 0; jj < 16 * bi; ++jj) { const float xj = XL[jj * 257 + c];
#pragma unroll
                    for (int q = 0; q < 4; ++q) { const f32x4 a = *(const LAS f32x4*)(AMT + jj * 68 + 16 * bi + 4 * q);
                        acc[4 * q + 0] -= a[0] * xj; acc[4 * q + 1] -= a[1] * xj; acc[4 * q + 2] -= a[2] * xj; acc[4 * q + 3] -= a[3] * xj; } }
#pragma unroll
                for (int ii = 0; ii < 16; ++ii) { float x = acc[ii];
#pragma unroll
                    for (int jj = 0; jj < ii; ++jj) x -= AMT[(16 * bi + jj) * 68 + 16 * bi + ii] * acc[jj];
                    acc[ii] = x; XL[(16 * bi + ii) * 257 + c] = x; }
            }
        } else {
            const int w4 = wave - 4; float v[8];
#pragma unroll
            for (int q = 0; q < 4; ++q) { const int f = w4 + 4 * q;
                { const int mt = f >> 3, ks = f & 7, i = 32 * mt + r; const float eg = __expf(GLs[i]);
                  const bf16x8 qq = *(const LAS bf16x8*)(Qb + i * 136 + 16 * ks + 8 * hp);
#pragma unroll
                  for (int jp = 0; jp < 8; ++jp) v[jp] = bf2f(Qb[i * 136 + 16 * ks + 8 * (jp >> 2) + 4 * hp + (jp & 3)]) * eg;
                  (void)qq; base[(16 + f) * 64 + lane] = pack8(v); }
                { const int mt = f >> 2, ks = f & 3, d = 32 * mt + r; const float Gend = GLs[63];
#pragma unroll
                  for (int jp = 0; jp < 8; ++jp) { const int tk = 16 * ks + 8 * (jp >> 2) + 4 * hp + (jp & 3); v[jp] = bf2f(Kb[tk * 136 + d]) * __expf(Gend - GLs[tk]); }
                  base[(32 + f) * 64 + lane] = pack8(v); } }
#pragma unroll
            for (int q = 0; q < 2; ++q) { const int f = w4 + 4 * q, mt = f >> 2, ks = f & 3, i = 32 * mt + r;
#pragma unroll
                for (int jp = 0; jp < 8; ++jp) v[jp] = QKm[i * 65 + 16 * ks + 8 * (jp >> 2) + 4 * hp + (jp & 3)];
                base[(48 + f) * 64 + lane] = pack8(v); }
            if (tid == 256) *(float*)(base + 72 * 64) = __expf(GLs[63]);
        }
        __syncthreads();
        float v[8];
#pragma unroll
        for (int q = 0; q < 2; ++q) { const int f = wave + 8 * q;
            { const int mt = f >> 3, ks = f & 7, i = 32 * mt + r;
#pragma unroll
              for (int jp = 0; jp < 8; ++jp) v[jp] = -XL[i * 257 + 128 + 16 * ks + 8 * (jp >> 2) + 4 * hp + (jp & 3)];
              base[f * 64 + lane] = pack8(v); }
            { const int pq = f & 1, tl = f >> 1, mt = tl >> 2, nt = tl & 3;
#pragma unroll
              for (int e = 0; e < 8; ++e) v[e] = XL[(32 * mt + crow(8 * pq + e, hp)) * 257 + 32 * nt + r];
              base[(56 + f) * 64 + lane] = pack8(v); } }
    }
}

__device__ __forceinline__ void phase_ab_rec(const KP kp, const int bid, const int G, int j, int li, LAS unsigned char* lds, int tid0) {
    unsigned char* scr = kp.ws() + WS_SCR; const bf16* U = (const bf16*)(kp.ws() + WS_U);
    float* ODN = (float*)(scr + SC_ODN); float* OGLA = (float*)(scr + SC_OGLA);
    SEC_BEGIN(12)
    for (int item = bid; item < 64; item += G) {
        int tid = tid0; asm volatile("" : "+v"(tid));
        int s, h; bool isdn; int half = -1;
        if (item < 32) { isdn = false; s = item >> 3; h = (item >> 1) & 3; half = item & 1; }
        else if (item < 64) { isdn = true; s = (item - 32) >> 3; h = (item - 32) & 7; half = -2; }
        else if (item < 1088) { isdn = true; s = 4 + ((item - 64) >> 3); h = (item - 64) & 7; }
        else { isdn = false; s = 4 + ((item - 1088) >> 2); h = (item - 1088) & 3; }
        int row0, L; seq_info(s, row0, L);
        __syncthreads();
        if (half == -2) {
            const int wave = __builtin_amdgcn_readfirstlane(tid >> 6), lane = tid & 63, r = lane & 31, hp = lane >> 5;
            const int b = s, nt = wave;
            const unsigned char* OPS = scr + SC_DNOPS;
            constexpr int DBUF = 73 * 1024;
#define DN_DMA(n_, bufi_) do { const unsigned char* gi_ = OPS + (size_t)((b * 32 + (n_)) * 8 + h) * DN_ITEM_BYTES + lane * 16; \
                _Pragma("unroll") for (int q_ = 0; q_ < 10; ++q_) { const int lf_ = wave + 8 * q_; if (lf_ < 73) \
                    __builtin_amdgcn_global_load_lds((const unsigned*)(gi_ + lf_ * 1024), (LAS unsigned*)(lds + (bufi_) * DBUF + lf_ * 1024), 16, 0, 0); } } while (0)
            f32x16 S0, S1, S2, S3;
#pragma unroll
            for (int i = 0; i < 16; ++i) { S0[i] = 0.f; S1[i] = 0.f; S2[i] = 0.f; S3[i] = 0.f; }
            DN_DMA(0, 0);
            asm volatile("s_waitcnt vmcnt(0)" ::: "memory"); __syncthreads();
            for (int n = 0; n < 32; ++n) {
                if (n + 1 < 32) DN_DMA(n + 1, (n + 1) & 1);
                if (wave < 4) {
                    const LAS bf16x8* F = (const LAS bf16x8*)(lds + (n & 1) * DBUF) + lane;
                    const float gend = *(const LAS float*)(lds + (n & 1) * DBUF + 72 * 1024);
                    const bf16x8 sb0 = PACK_ACC(S0, 0), sb1 = PACK_ACC(S0, 1), sb2 = PACK_ACC(S1, 0), sb3 = PACK_ACC(S1, 1), sb4 = PACK_ACC(S2, 0), sb5 = PACK_ACC(S2, 1), sb6 = PACK_ACC(S3, 0), sb7 = PACK_ACC(S3, 1);
                    f32x16 U0t, U1t;
                    { const bf16x8 a0 = F[(56 + nt * 2 + 0) * 64], a1 = F[(56 + nt * 2 + 1) * 64], c0 = F[(56 + (4 + nt) * 2 + 0) * 64], c1 = F[(56 + (4 + nt) * 2 + 1) * 64];
#pragma unroll
                      for (int e = 0; e < 8; ++e) { U0t[e] = bf2f((bf16)a0[e]); U0t[8 + e] = bf2f((bf16)a1[e]); U1t[e] = bf2f((bf16)c0[e]); U1t[8 + e] = bf2f((bf16)c1[e]); } }
                    U0t = MFMA32(F[0 * 64], sb0, U0t); U0t = MFMA32(F[1 * 64], sb1, U0t); U0t = MFMA32(F[2 * 64], sb2, U0t); U0t = MFMA32(F[3 * 64], sb3, U0t);
                    U0t = MFMA32(F[4 * 64], sb4, U0t); U0t = MFMA32(F[5 * 64], sb5, U0t); U0t = MFMA32(F[6 * 64], sb6, U0t); U0t = MFMA32(F[7 * 64], sb7, U0t);
                    U1t = MFMA32(F[8 * 64], sb0, U1t); U1t = MFMA32(F[9 * 64], sb1, U1t); U1t = MFMA32(F[10 * 64], sb2, U1t); U1t = MFMA32(F[11 * 64], sb3, U1t);
                    U1t = MFMA32(F[12 * 64], sb4, U1t); U1t = MFMA32(F[13 * 64], sb5, U1t); U1t = MFMA32(F[14 * 64], sb6, U1t); U1t = MFMA32(F[15 * 64], sb7, U1t);
                    const bf16x8 ub0 = PACK_ACC(U0t, 0), ub1 = PACK_ACC(U0t, 1), ub2 = PACK_ACC(U1t, 0), ub3 = PACK_ACC(U1t, 1);
                    f32x16 O0, O1;
#pragma unroll
                    for (int i = 0; i < 16; ++i) { O0[i] = 0.f; O1[i] = 0.f; }
                    O0 = MFMA32(F[16 * 64], sb0, O0); O0 = MFMA32(F[17 * 64], sb1, O0); O0 = MFMA32(F[18 * 64], sb2, O0); O0 = MFMA32(F[19 * 64], sb3, O0);
                    O0 = MFMA32(F[20 * 64], sb4, O0); O0 = MFMA32(F[21 * 64], sb5, O0); O0 = MFMA32(F[22 * 64], sb6, O0); O0 = MFMA32(F[23 * 64], sb7, O0);
                    O1 = MFMA32(F[24 * 64], sb0, O1); O1 = MFMA32(F[25 * 64], sb1, O1); O1 = MFMA32(F[26 * 64], sb2, O1); O1 = MFMA32(F[27 * 64], sb3, O1);
                    O1 = MFMA32(F[28 * 64], sb4, O1); O1 = MFMA32(F[29 * 64], sb5, O1); O1 = MFMA32(F[30 * 64], sb6, O1); O1 = MFMA32(F[31 * 64], sb7, O1);
                    O0 = MFMA32(F[48 * 64], ub0, O0); O0 = MFMA32(F[49 * 64], ub1, O0);
                    O1 = MFMA32(F[52 * 64], ub0, O1); O1 = MFMA32(F[53 * 64], ub1, O1); O1 = MFMA32(F[54 * 64], ub2, O1); O1 = MFMA32(F[55 * 64], ub3, O1);
#pragma unroll
                    for (int i = 0; i < 16; ++i) { S0[i] *= gend; S1[i] *= gend; S2[i] *= gend; S3[i] *= gend; }
                    S0 = MFMA32(F[32 * 64], ub0, S0); S0 = MFMA32(F[33 * 64], ub1, S0); S0 = MFMA32(F[34 * 64], ub2, S0); S0 = MFMA32(F[35 * 64], ub3, S0);
                    S1 = MFMA32(F[36 * 64], ub0, S1); S1 = MFMA32(F[37 * 64], ub1, S1); S1 = MFMA32(F[38 * 64], ub2, S1); S1 = MFMA32(F[39 * 64], ub3, S1);
                    S2 = MFMA32(F[40 * 64], ub0, S2); S2 = MFMA32(F[41 * 64], ub1, S2); S2 = MFMA32(F[42 * 64], ub2, S2); S2 = MFMA32(F[43 * 64], ub3, S2);
                    S3 = MFMA32(F[44 * 64], ub0, S3); S3 = MFMA32(F[45 * 64], ub1, S3); S3 = MFMA32(F[46 * 64], ub2, S3); S3 = MFMA32(F[47 * 64], ub3, S3);
                    float* yo = ODN + (size_t)(b * 2048 + n * 64) * 1024 + h * 128 + 32 * nt + r;
#pragma unroll
                    for (int i = 0; i < 16; ++i) { yo[(size_t)crow(i, hp) * 1024] = O0[i]; yo[(size_t)(32 + crow(i, hp)) * 1024] = O1[i]; }
                }
                asm volatile("s_waitcnt vmcnt(0)" ::: "memory"); __syncthreads();
            }
#undef DN_DMA
            if (wave < 4) {
                float* dst = kp.out() + O_DN_P + ((size_t)j * 4 + b) * ((size_t)8 * 128 * 128) + (size_t)h * 128 * 128 + 32 * nt + r;
#pragma unroll
                for (int i = 0; i < 16; ++i) { dst[(size_t)crow(i, hp) * 128] = S0[i]; dst[(size_t)(32 + crow(i, hp)) * 128] = S1[i]; dst[(size_t)(64 + crow(i, hp)) * 128] = S2[i]; dst[(size_t)(96 + crow(i, hp)) * 128] = S3[i]; }
            }
        } else if (half >= 0) {
            const int wave = __builtin_amdgcn_readfirstlane(tid >> 6), lane = tid & 63, r = lane & 31, hp = lane >> 5;
            const int b = s, nt = half * 4 + wave;
            const unsigned char* OPS = kp.ws() + WS_GLAOPS;
            constexpr int GBUF = 57 * 1024;
#define GLA_DMA(n_, bufi_) do { const unsigned char* gi_ = OPS + (size_t)((b * 32 + (n_)) * 4 + h) * GLA_ITEM_BYTES + lane * 16; \
                _Pragma("unroll") for (int q_ = 0; q_ < 8; ++q_) { const int lf_ = wave + 8 * q_; if (lf_ < 57) { const int gf_ = lf_ < 40 ? lf_ : (lf_ < 56 ? lf_ + half * 16 : 72); \
                    __builtin_amdgcn_global_load_lds((const unsigned*)(gi_ + gf_ * 1024), (LAS unsigned*)(lds + (bufi_) * GBUF + lf_ * 1024), 16, 0, 0); } } } while (0)
            f32x16 S0, S1, S2, S3;
#pragma unroll
            for (int i = 0; i < 16; ++i) { S0[i] = 0.f; S1[i] = 0.f; S2[i] = 0.f; S3[i] = 0.f; }
            GLA_DMA(0, 0);
            asm volatile("s_waitcnt vmcnt(0)" ::: "memory"); __syncthreads();
            for (int n = 0; n < 32; ++n) {
                if (n + 1 < 32) GLA_DMA(n + 1, (n + 1) & 1);
                if (wave < 4) {
                    const LAS bf16x8* F = (const LAS bf16x8*)(lds + (n & 1) * GBUF) + lane;
                    const LAS float* ge = (const LAS float*)(lds + (n & 1) * GBUF + 56 * 1024) + 4 * hp;
                    const bf16x8 sb0 = PACK_ACC(S0, 0), sb1 = PACK_ACC(S0, 1), sb2 = PACK_ACC(S1, 0), sb3 = PACK_ACC(S1, 1), sb4 = PACK_ACC(S2, 0), sb5 = PACK_ACC(S2, 1), sb6 = PACK_ACC(S3, 0), sb7 = PACK_ACC(S3, 1);
                    f32x16 O0, O1;
#pragma unroll
                    for (int i = 0; i < 16; ++i) { O0[i] = 0.f; O1[i] = 0.f; }
                    O0 = MFMA32(F[0 * 64], sb0, O0); O0 = MFMA32(F[1 * 64], sb1, O0); O0 = MFMA32(F[2 * 64], sb2, O0); O0 = MFMA32(F[3 * 64], sb3, O0);
                    O0 = MFMA32(F[4 * 64], sb4, O0); O0 = MFMA32(F[5 * 64], sb5, O0); O0 = MFMA32(F[6 * 64], sb6, O0); O0 = MFMA32(F[7 * 64], sb7, O0);
                    O1 = MFMA32(F[8 * 64], sb0, O1); O1 = MFMA32(F[9 * 64], sb1, O1); O1 = MFMA32(F[10 * 64], sb2, O1); O1 = MFMA32(F[11 * 64], sb3, O1);
                    O1 = MFMA32(F[12 * 64], sb4, O1); O1 = MFMA32(F[13 * 64], sb5, O1); O1 = MFMA32(F[14 * 64], sb6, O1); O1 = MFMA32(F[15 * 64], sb7, O1);
                    bf16x8 vb[4];
#pragma unroll
                    for (int ks = 0; ks < 4; ++ks) vb[ks] = F[(40 + wave * 4 + ks) * 64];
                    O0 = MFMA32(F[32 * 64], vb[0], O0); O0 = MFMA32(F[33 * 64], vb[1], O0);
#pragma unroll
                    for (int ks = 0; ks < 4; ++ks) O1 = MFMA32(F[(36 + ks) * 64], vb[ks], O1);
#pragma unroll
                    for (int q = 0; q < 4; ++q) { const f32x4 g0 = *(const LAS f32x4*)(ge + 8 * q), g1 = *(const LAS f32x4*)(ge + 32 + 8 * q), g2 = *(const LAS f32x4*)(ge + 64 + 8 * q), g3 = *(const LAS f32x4*)(ge + 96 + 8 * q);
#pragma unroll
                        for (int c = 0; c < 4; ++c) { S0[4 * q + c] *= g0[c]; S1[4 * q + c] *= g1[c]; S2[4 * q + c] *= g2[c]; S3[4 * q + c] *= g3[c]; } }
#pragma unroll
                    for (int ks = 0; ks < 4; ++ks) { S0 = MFMA32(F[(16 + ks) * 64], vb[ks], S0); S1 = MFMA32(F[(20 + ks) * 64], vb[ks], S1); S2 = MFMA32(F[(24 + ks) * 64], vb[ks], S2); S3 = MFMA32(F[(28 + ks) * 64], vb[ks], S3); }
                    float* yo = OGLA + (size_t)(b * 2048 + n * 64) * 1024 + h * 256 + 32 * nt + r;
#pragma unroll
                    for (int i = 0; i < 16; ++i) { yo[(size_t)crow(i, hp) * 1024] = O0[i]; yo[(size_t)(32 + crow(i, hp)) * 1024] = O1[i]; }
                }
                asm volatile("s_waitcnt vmcnt(0)" ::: "memory"); __syncthreads();
            }
#undef GLA_DMA
            if (wave < 4) {
                float* dst = kp.out() + O_GLA_P + ((size_t)j * 4 + b) * ((size_t)4 * 128 * 256) + (size_t)h * 128 * 256 + 32 * nt + r;
#pragma unroll
                for (int i = 0; i < 16; ++i) { dst[(size_t)crow(i, hp) * 256] = S0[i]; dst[(size_t)(32 + crow(i, hp)) * 256] = S1[i]; dst[(size_t)(64 + crow(i, hp)) * 256] = S2[i]; dst[(size_t)(96 + crow(i, hp)) * 256] = S3[i]; }
            }
        } else
        {}
    }
    SEC_END(12, lds)
    SEC_BEGIN(13)
    unsigned* qhead = (unsigned*)(kp.ws() + WS_CTL) + CW_CNT + 64 * li;
    volatile LAS unsigned* qslot = (volatile LAS unsigned*)(lds + LDS_BYTES - 8);
    const float* cw = kp.in(14) + (size_t)j * 4 * 3072; const float* stc = kp.in(3) + (size_t)j * 128 * 3 * 3072;
    const float* wa2 = kp.in(18) + (size_t)j * 16 * 512; const float* ba = kp.in(19) + (size_t)j * 512;
    for (;;) {
        __syncthreads();
        if (tid0 == 0) qslot[0] = __hip_atomic_fetch_add(qhead, 1u, __ATOMIC_RELAXED, __HIP_MEMORY_SCOPE_AGENT);
        __syncthreads();
        const int it = (int)qslot[0];
        if (it >= 1536) break;
        int tid = tid0; asm volatile("" : "+v"(tid));
        const int wave = tid >> 6, lane = tid & 63;
        if (it < 1024) {
            const int bs = it >> 3, h = it & 7, sq = 4 + bs, r0 = TP + bs * 4;
            LAS float* qL = (LAS float*)lds; LAS float* kL = qL + 512; LAS float* vL = kL + 512; LAS float* red = vL + 512; LAS float* sm = red + 4096;
            const int e = tid & 127, dq = tid >> 7;
            const size_t SZ = (size_t)8 * 128 * 128;
            const float* st = kp.in(2) + ((size_t)j * 128 + bs) * SZ + (size_t)h * 16384;
            float S[32];
            { const float* sp = st + (size_t)(dq * 32) * 128 + e;
#pragma unroll
              for (int i = 0; i < 32; ++i) { S[i] = *sp; sp += 128; asm volatile("" : "+v"(sp)); } }
#pragma unroll
            for (int part = 0; part < 3; ++part) { const int c = part * 1024 + h * 128 + e; float acc = 0.f;
#pragma unroll
                for (int tap = 0; tap < 4; ++tap) acc += cw[tap * 3072 + c] * pre_val(U, NAB, c, r0, dq - 3 + tap, sq, stc, 3072, c);
                (part == 0 ? qL : (part == 1 ? kL : vL))[dq * 128 + e] = silu_(acc); }
            if (tid < 4) { const size_t ro = (size_t)(r0 + tid) * NAB;
                sm[32 + tid] = -__expf(kp.in(15)[j * 8 + h]) * softplus_(bf2f(U[ro + 7176 + h]) + kp.in(16)[j * 8 + h]); sm[36 + tid] = sigmoid_(bf2f(U[ro + 7168 + h])); }
            __syncthreads();
            { const int tk = wave & 3; LAS float* src = (wave >> 2) ? kL : qL; const float a = src[tk * 128 + lane], b = src[tk * 128 + lane + 64];
              const float sc = rsqrtf(wave_sum(a * a + b * b) + 1e-6f) * ((wave >> 2) ? 1.f : 0.08838834764831845f); src[tk * 128 + lane] = a * sc; src[tk * 128 + lane + 64] = b * sc; }
            __syncthreads();
#pragma unroll
            for (int q = 0; q < 4; ++q) { const int idx = wave * 4 + q, i = (idx >> 2) & 3, jj = idx & 3; const LAS float* src = idx < 16 ? kL : qL;
                const float dot = wave_sum(src[i * 128 + lane] * kL[jj * 128 + lane] + src[i * 128 + lane + 64] * kL[jj * 128 + lane + 64]); if (lane == 0) sm[idx] = dot; }
            float ks[4] = {0.f, 0.f, 0.f, 0.f}, qs[4] = {0.f, 0.f, 0.f, 0.f};
#pragma unroll
            for (int i = 0; i < 32; ++i) { const int d = dq * 32 + i; const float sv = S[i];
#pragma unroll
                for (int t = 0; t < 4; ++t) { ks[t] += kL[t * 128 + d] * sv; qs[t] += qL[t * 128 + d] * sv; } }
#pragma unroll
            for (int t = 0; t < 4; ++t) { red[(t * 4 + dq) * 128 + e] = ks[t]; red[((4 + t) * 4 + dq) * 128 + e] = qs[t]; }
            __syncthreads();
            float Gc[4]; Gc[0] = sm[32]; Gc[1] = Gc[0] + sm[33]; Gc[2] = Gc[1] + sm[34]; Gc[3] = Gc[2] + sm[35];
            float u[4];
#pragma unroll
            for (int i = 0; i < 4; ++i) { const float KSi = (red[(i * 4 + 0) * 128 + e] + red[(i * 4 + 1) * 128 + e]) + (red[(i * 4 + 2) * 128 + e] + red[(i * 4 + 3) * 128 + e]);
                float acc = vL[i * 128 + e] - __expf(Gc[i]) * KSi;
#pragma unroll
                for (int jj = 0; jj < i; ++jj) acc -= sm[i * 4 + jj] * __expf(Gc[i] - Gc[jj]) * u[jj];
                u[i] = sm[36 + i] * acc; }
            if (dq == 0) {
#pragma unroll
                for (int i = 0; i < 4; ++i) { const float QSi = (red[((4 + i) * 4 + 0) * 128 + e] + red[((4 + i) * 4 + 1) * 128 + e]) + (red[((4 + i) * 4 + 2) * 128 + e] + red[((4 + i) * 4 + 3) * 128 + e]);
                    float o = __expf(Gc[i]) * QSi;
#pragma unroll
                    for (int jj = 0; jj <= i; ++jj) o += sm[16 + i * 4 + jj] * __expf(Gc[i] - Gc[jj]) * u[jj];
                    ODN[(size_t)(r0 + i) * 1024 + h * 128 + e] = o; } }
            const float eg = __expf(Gc[3]); float w[4];
#pragma unroll
            for (int jj = 0; jj < 4; ++jj) w[jj] = __expf(Gc[3] - Gc[jj]) * u[jj];
            float* dst = kp.out() + O_DN_S + ((size_t)j * 128 + bs) * SZ + (size_t)h * 16384 + (size_t)(dq * 32) * 128 + e;
#pragma unroll
            for (int i = 0; i < 32; ++i) { const int d = dq * 32 + i; float sv = eg * S[i];
#pragma unroll
                for (int jj = 0; jj < 4; ++jj) sv += kL[jj * 128 + d] * w[jj];
                *dst = sv; dst += 128; asm volatile("" : "+v"(dst)); }
        } else {
            const int q_ = it - 1024, bs = q_ >> 2, h = q_ & 3, r0 = TP + bs * 4;
            LAS float* qgL = (LAS float*)lds; LAS float* kaL = qgL + 512; LAS float* glL = kaL + 512; LAS float* egL = glL + 512; LAS float* Am = egL + 128; LAS float* red = Am + 16;
            const int e = tid & 255, dh = tid >> 8;
            const size_t SZ = (size_t)4 * 128 * 256;
            const float* st = kp.in(4) + ((size_t)j * 128 + bs) * SZ + (size_t)h * 32768;
            float S[64];
            { const float* sp = st + (size_t)(dh * 64) * 256 + e;
#pragma unroll
              for (int i = 0; i < 64; ++i) { S[i] = *sp; sp += 256; asm volatile("" : "+v"(sp)); } }
            float v[4];
#pragma unroll
            for (int t = 0; t < 4; ++t) v[t] = bf2f(U[(size_t)(r0 + t) * NAB + 5120 + h * 256 + e]);
            { const int d = tid & 127, tk = tid >> 7; const size_t ro = (size_t)(r0 + tk) * NAB;
              qgL[tk * 128 + d] = bf2f(U[ro + 4096 + h * 128 + d]) * 0.08838834764831845f; kaL[tk * 128 + d] = bf2f(U[ro + 4608 + h * 128 + d]);
              float x = ba[h * 128 + d];
#pragma unroll
              for (int rr = 0; rr < 16; ++rr) x += bf2f(U[ro + 7184 + rr]) * wa2[rr * 512 + h * 128 + d];
              glL[tk * 128 + d] = -softplus_(-x) * (1.f / 16.f); }
            __syncthreads();
            if (tid < 128) { float Gq = 0.f;
#pragma unroll
                for (int t = 0; t < 4; ++t) { Gq += glL[t * 128 + tid]; qgL[t * 128 + tid] *= __expf(Gq); kaL[t * 128 + tid] *= __expf(-Gq); }
                egL[tid] = __expf(Gq); }
            __syncthreads();
#pragma unroll
            for (int q = 0; q < 2; ++q) { const int idx = wave * 2 + q, i = idx >> 2, jj = idx & 3;
                const float dot = wave_sum(qgL[i * 128 + lane] * kaL[jj * 128 + lane] + qgL[i * 128 + lane + 64] * kaL[jj * 128 + lane + 64]); if (lane == 0) Am[idx] = dot; }
            float o[4] = {0.f, 0.f, 0.f, 0.f};
            float* dst = kp.out() + O_GLA_S + ((size_t)j * 128 + bs) * SZ + (size_t)h * 32768 + (size_t)(dh * 64) * 256 + e;
#pragma unroll
            for (int i = 0; i < 64; ++i) { const int d = dh * 64 + i; const float s0 = S[i]; float acc = s0;
#pragma unroll
                for (int t = 0; t < 4; ++t) { o[t] += qgL[t * 128 + d] * s0; acc += kaL[t * 128 + d] * v[t]; }
                *dst = egL[d] * acc; dst += 256; asm volatile("" : "+v"(dst)); }
#pragma unroll
            for (int t = 0; t < 4; ++t) red[(dh * 4 + t) * 256 + e] = o[t];
            __syncthreads();
            if (dh == 0) {
#pragma unroll
                for (int t = 0; t < 4; ++t) { float oo = red[t * 256 + e] + red[(4 + t) * 256 + e];
#pragma unroll
                    for (int jj = 0; jj <= t; ++jj) oo += Am[t * 4 + jj] * v[jj];
                    OGLA[(size_t)(r0 + t) * 1024 + h * 256 + e] = oo; } }
        }
    }
    SEC_END(13, lds)
}

__device__ __forceinline__ void phase_ab_post(const KP kp, const int bid, const int G, int j, int tid, int wave, int lane) {
    unsigned char* scr = kp.ws() + WS_SCR; const bf16* U = (const bf16*)(kp.ws() + WS_U); bf16* YM = (bf16*)(kp.ws() + WS_YM);
    const float* ODN = (const float*)(scr + SC_ODN); const float* OGLA = (const float*)(scr + SC_OGLA);
    const float* dnn = kp.in(17) + (size_t)j * 128; const float* glan = kp.in(20) + (size_t)j * 256;
    typedef float f32x2v __attribute__((ext_vector_type(2)));
    const f32x2v dg = *(const f32x2v*)(dnn + 2 * lane); const f32x4 gg = *(const f32x4*)(glan + 4 * lane);
    for (int r = bid * NWAVES + wave; r < T; r += G * NWAVES) {
        int s, t; row_to_seq(r, s, t); int row0, L; seq_info(s, row0, L);
        const bf16* ur = U + (size_t)r * NAB; bf16* yr = YM + (size_t)r * DM;
#pragma unroll
        for (int hh = 0; hh < 8; ++hh) { const f32x2v o = *(const f32x2v*)(ODN + (size_t)r * 1024 + hh * 128 + 2 * lane);
            const float rstd = rsqrtf(wave_sum(o.x * o.x + o.y * o.y) * (1.f / 128.f) + 1e-6f);
            const unsigned zz = *(const unsigned*)(ur + 3072 + hh * 128 + 2 * lane);
            *(unsigned*)(yr + hh * 128 + 2 * lane) = pk2(o.x * rstd * dg.x * silu_(__uint_as_float(zz << 16)), o.y * rstd * dg.y * silu_(__uint_as_float(zz & 0xffff0000u))); }
#pragma unroll
        for (int hh = 0; hh < 4; ++hh) { const f32x4 o = *(const f32x4*)(OGLA + (size_t)r * 1024 + hh * 256 + 4 * lane);
            const float rstd = rsqrtf(wave_sum((o.x * o.x + o.y * o.y) + (o.z * o.z + o.w * o.w)) * (1.f / 256.f) + 1e-6f);
            const u32x2 zz = *(const u32x2*)(ur + 6144 + hh * 256 + 4 * lane);
            u32x2 w; w.x = pk2(o.x * rstd * gg.x * silu_(__uint_as_float(zz.x << 16)), o.y * rstd * gg.y * silu_(__uint_as_float(zz.x & 0xffff0000u)));
            w.y = pk2(o.z * rstd * gg.z * silu_(__uint_as_float(zz.y << 16)), o.w * rstd * gg.w * silu_(__uint_as_float(zz.y & 0xffff0000u)));
            *(u32x2*)(yr + 1024 + hh * 256 + 4 * lane) = w; }
        if (t >= L - 3) { const int rr = t - (L - 3);
            float* dst = s < 4 ? kp.out() + O_DNC_P + (((size_t)j * 4 + s) * 3 + rr) * 3072 : kp.out() + O_DNC_S + (((size_t)j * 128 + (s - 4)) * 3 + rr) * 3072;
            for (int c = 2 * lane; c < 3072; c += 128) { const unsigned uu = *(const unsigned*)(ur + c); *(f32x2v*)(dst + c) = (f32x2v){__uint_as_float(uu << 16), __uint_as_float(uu & 0xffff0000u)}; } }
    }
}

__device__ __forceinline__ void phase_cd_pre(const KP kp, const int bid, const int G, int j, LAS unsigned char* lds, int tid) {
    unsigned char* scr = kp.ws() + WS_SCR; const bf16* U = (const bf16*)(kp.ws() + WS_U);
    float* XBC = (float*)(scr + SC_XBC) - (size_t)TP * 1536; float* DT = (float*)(scr + SC_DT) - (size_t)TP * 16; bf16* XS = (bf16*)(scr + SC_XS);
    const float* cw = kp.in(23) + (size_t)j * 4 * 1536; const float* cb = kp.in(24) + (size_t)j * 1536; const float* stc = kp.in(6) + (size_t)j * 128 * 3 * 1536;
    for (int r = TP + bid; r < T; r += G) {
        int s, t; row_to_seq(r, s, t); const int row0 = r - t;
#pragma unroll
        for (int i = 0; i < 3; ++i) { const int c = tid + NTHR * i; float acc = cb[c];
#pragma unroll
            for (int tap = 0; tap < 4; ++tap) acc += cw[tap * 1536 + c] * pre_val(U, NCD, 1024 + c, row0, t - 3 + tap, s, stc, 1536, c);
            const float v = silu_(acc); XBC[(size_t)r * 1536 + c] = v; if (c < 1024) XS[(size_t)r * 1024 + c] = (bf16)f2bf(v); }
        if (tid < 16) DT[(size_t)r * 16 + tid] = softplus_(bf2f(U[(size_t)r * NCD + 4608 + tid]) + kp.in(26)[j * 16 + tid]);
    }
}

__device__ __forceinline__ void phase_lru_gates(const KP kp, const int bid, const int G, int j, LAS unsigned char* lds, int tid0) {
    unsigned char* scr = kp.ws() + WS_SCR; const bf16* U = (const bf16*)(kp.ws() + WS_U);
    float* LA = (float*)(scr + SC_LA); float* LB = (float*)(scr + SC_LB);
    const float* lcw = kp.in(29) + (size_t)j * 4 * 1024; const float* lcb = kp.in(30) + (size_t)j * 1024; const float* lstc = kp.in(8) + (size_t)j * 128 * 3 * 1024;
    const int n = bid & 15;
    const float* wa = kp.in(31) + ((size_t)j * 16 + n) * 4096; const float* wx = kp.in(33) + ((size_t)j * 16 + n) * 4096;
    const float* lba = kp.in(32) + (size_t)j * 1024; const float* lbx = kp.in(34) + (size_t)j * 1024; const float* lam = kp.in(35) + (size_t)j * 1024;
    LAS bf16x8* WF = (LAS bf16x8*)lds;
    LAS float* xcL = (LAS float*)(lds + 16384);
    LAS float* igL = xcL + 64 * 68;
    __syncthreads();
    { const int lane = tid0 & 63, f = tid0 >> 6, r = lane & 31, hp = lane >> 5, nt = f >> 2, ks = f & 3; float v[8];
#pragma unroll
      for (int jp = 0; jp < 8; ++jp) v[jp] = wa[(16 * ks + 8 * hp + jp) * 64 + 32 * nt + r];
      WF[f * 64 + lane] = pack8(v);
#pragma unroll
      for (int jp = 0; jp < 8; ++jp) v[jp] = wx[(16 * ks + 8 * hp + jp) * 64 + 32 * nt + r];
      WF[512 + f * 64 + lane] = pack8(v); }
    for (int tile = bid >> 4; tile < T / 64; tile += (G >> 4)) {
        int tid = tid0; asm volatile("" : "+v"(tid));
        const int c = tid & 63, tq = tid >> 6, ch = n * 64 + c, rowbase = tile * 64;
        __syncthreads();
        if (tile < TP / 64) {
            const int r0 = rowbase + tq * 8; const bool first = ((r0 & 2047) == 0);
            const float w0 = lcw[ch], w1 = lcw[1024 + ch], w2 = lcw[2048 + ch], w3 = lcw[3072 + ch], bb = lcb[ch];
            const bf16* up = U + (size_t)r0 * NCD + 3584 + ch;
            float x0 = first ? 0.f : bf2f(up[-3 * (long)NCD]), x1 = first ? 0.f : bf2f(up[-2 * (long)NCD]), x2 = first ? 0.f : bf2f(up[-1 * (long)NCD]);
#pragma unroll
            for (int tt = 0; tt < 8; ++tt) { const float x3 = bf2f(up[(size_t)tt * NCD]); xcL[(tq * 8 + tt) * 68 + c] = bb + w0 * x0 + w1 * x1 + w2 * x2 + w3 * x3; x0 = x1; x1 = x2; x2 = x3; }
        } else {
#pragma unroll 2
            for (int tt = 0; tt < 8; ++tt) { const int r = rowbase + tq * 8 + tt; int s, t; row_to_seq(r, s, t); const int row0 = r - t; float acc = lcb[ch];
#pragma unroll
                for (int tap = 0; tap < 4; ++tap) acc += lcw[tap * 1024 + ch] * pre_val(U, NCD, 3584 + ch, row0, t - 3 + tap, s, lstc, 1024, ch);
                xcL[(tq * 8 + tt) * 68 + c] = acc; }
        }
        __syncthreads();
        const int wave = __builtin_amdgcn_readfirstlane(tid >> 6), lane = tid & 63, r = lane & 31, hp = lane >> 5, mat = wave >> 2, mt = (wave >> 1) & 1, nt = wave & 1;
        f32x16 acc;
#pragma unroll
        for (int i = 0; i < 16; ++i) acc[i] = 0.f;
#pragma unroll
        for (int ks = 0; ks < 4; ++ks) { const LAS float* xp = xcL + (32 * mt + r) * 68 + 16 * ks + 8 * hp; const f32x4 xa = *(const LAS f32x4*)xp, xb = *(const LAS f32x4*)(xp + 4);
            const bf16x8 af = __builtin_bit_cast(bf16x8, (u32x4){cvtpk(xa.x, xa.y), cvtpk(xa.z, xa.w), cvtpk(xb.x, xb.y), cvtpk(xb.z, xb.w)});
            acc = MFMA32(af, WF[mat * 512 + (nt * 4 + ks) * 64 + lane], acc); }
        const int chh = n * 64 + 32 * nt + r;
        if (mat == 1) { const float bx = lbx[chh];
#pragma unroll
            for (int i = 0; i < 16; ++i) igL[(32 * mt + crow(i, hp)) * 65 + 32 * nt + r] = sigmoid_(acc[i] + bx); }
        __syncthreads();
        if (mat == 0) { const float ba = lba[chh], spl = softplus_(-lam[chh]);
#pragma unroll
            for (int i = 0; i < 16; ++i) { const int tk = 32 * mt + crow(i, hp); const size_t ro = (size_t)(rowbase + tk) * 1024 + chh;
                const float log_a = -8.f * sigmoid_(acc[i] + ba) * spl;
                LA[ro] = __expf(log_a); LB[ro] = __builtin_amdgcn_sqrtf(1.f - __expf(2.f * log_a)) * (igL[tk * 65 + 32 * nt + r] * xcL[tk * 68 + 32 * nt + r]); } }
    }
}

constexpr size_t SSD_ITEM_BYTES = 33792;
__device__ __forceinline__ void phase_ssd_prep(const KP kp, const int bid, const int G, int j, LAS unsigned char* lds, int tid0) {
    unsigned char* scr = kp.ws() + WS_SCR;
    const bf16* U = (const bf16*)(kp.ws() + WS_U); bf16* XS = (bf16*)(scr + SC_XS);
    const float* cw = kp.in(23) + (size_t)j * 4 * 1536; const float* cb = kp.in(24) + (size_t)j * 1536;
    unsigned char* OPS = scr + SC_SSDOP;
    LAS float* CL = (LAS float*)lds; LAS float* BL = CL + 64 * 65; LAS float* QK = BL + 64 * 65; LAS float* GL = QK + 64 * 65; LAS float* DTL = GL + 256; LAS float* XLs = DTL + 256;
    const float* alog = kp.in(25) + j * 16;
    for (int item = bid; item < 512; item += G) {
        int tid = tid0; asm volatile("" : "+v"(tid));
        const int wave = tid >> 6, lane = tid & 63;
        const int b = item >> 7, n = (item >> 2) & 31, g = item & 3;
        const int row0 = b * 2048 + n * 64;
        __syncthreads();
        { const int ci = tid & 127, tg = tid >> 7, t0 = 16 * tg;
          const bool first = (n == 0 && tg == 0);
#pragma unroll
          for (int q = 0; q < 3; ++q) { const int k = ci + 128 * q;
              int cidx; LAS float* dst; int dstr, dcol;
              if (k < 64) { cidx = 1024 + g * 64 + k; dst = BL; dstr = 65; dcol = k; }
              else if (k < 128) { cidx = 1280 + g * 64 + (k - 64); dst = CL; dstr = 65; dcol = k - 64; }
              else { cidx = g * 256 + (k - 128); dst = XLs; dstr = 257; dcol = k - 128; }
              const float w0 = cw[cidx], w1 = cw[1536 + cidx], w2 = cw[2 * 1536 + cidx], w3 = cw[3 * 1536 + cidx], bb = cb[cidx];
              const bf16* up = U + (size_t)(row0 + t0) * NCD + 1024 + cidx;
              float x0 = first ? 0.f : bf2f(up[-3 * (long)NCD]), x1 = first ? 0.f : bf2f(up[-2 * (long)NCD]), x2 = first ? 0.f : bf2f(up[-1 * (long)NCD]);
#pragma unroll 4
              for (int t = 0; t < 16; ++t) { const float x3 = bf2f(up[(size_t)t * NCD]); dst[(t0 + t) * dstr + dcol] = silu_(bb + w0 * x0 + w1 * x1 + w2 * x2 + w3 * x3); x0 = x1; x1 = x2; x2 = x3; } } }
        if (wave < 4) { const int h = g * 4 + wave; const float dt = softplus_(bf2f(U[(size_t)(row0 + lane) * NCD + 4608 + h]) + kp.in(26)[j * 16 + h]);
            DTL[wave * 64 + lane] = dt; float gv = -__expf(alog[h]) * dt;
#pragma unroll
            for (int o = 1; o < 64; o <<= 1) { const float tt = __shfl_up(gv, o); if (lane >= o) gv += tt; }
            GL[wave * 64 + lane] = gv; }
        __syncthreads();
        for (int i = tid; i < 8192; i += NTHR) { const int t = i >> 7, k2 = i & 127;
            ((unsigned*)XS)[((size_t)(row0 + t) * 1024 + g * 256) / 2 + k2] = pk2(XLs[t * 257 + 2 * k2], XLs[t * 257 + 2 * k2 + 1]); }
        { const int i = tid >> 3, jg = tid & 7; float acc[8];
#pragma unroll
          for (int jj = 0; jj < 8; ++jj) acc[jj] = 0.f;
#pragma unroll 4
          for (int d = 0; d < 64; ++d) { const float c = CL[i * 65 + d];
#pragma unroll
              for (int jj = 0; jj < 8; ++jj) acc[jj] += c * BL[(jg * 8 + jj) * 65 + d]; }
#pragma unroll
          for (int jj = 0; jj < 8; ++jj) QK[i * 65 + jg * 8 + jj] = acc[jj]; }
        __syncthreads();
        const int f = wave, r = lane & 31, hp = lane >> 5, mt = f >> 2, ks = f & 3;
        for (int hh = 0; hh < 4; ++hh) {
            const int h = g * 4 + hh; const LAS float* Gh = GL + hh * 64; const float Gend = Gh[63];
            bf16x8* base = (bf16x8*)(OPS + ((size_t)((b * 32 + n) * 16 + h)) * SSD_ITEM_BYTES);
            float v[8];
            { const int i = 32 * mt + r; const float eg = __expf(Gh[i]);
#pragma unroll
              for (int jp = 0; jp < 8; ++jp) { const int d = 16 * ks + 8 * (jp >> 2) + 4 * hp + (jp & 3); v[jp] = CL[i * 65 + d] * eg; }
              base[0 * 512 + f * 64 + lane] = pack8(v); }
            { const int d = 32 * mt + r;
#pragma unroll
              for (int jp = 0; jp < 8; ++jp) { const int tk = 16 * ks + 8 * (jp >> 2) + 4 * hp + (jp & 3); v[jp] = BL[tk * 65 + d] * __expf(Gend - Gh[tk]); }
              base[1 * 512 + f * 64 + lane] = pack8(v); }
            { const int i = 32 * mt + r; const float gi = Gh[i];
#pragma unroll
              for (int jp = 0; jp < 8; ++jp) { const int jt = 16 * ks + 8 * (jp >> 2) + 4 * hp + (jp & 3); v[jp] = jt <= i ? QK[i * 65 + jt] * __expf(gi - Gh[jt]) : 0.f; }
              base[2 * 512 + f * 64 + lane] = pack8(v); }
            { const int p = 32 * mt + r;
#pragma unroll
              for (int jp = 0; jp < 8; ++jp) { const int tk = 16 * ks + 8 * (jp >> 2) + 4 * hp + (jp & 3);
                  v[jp] = XLs[tk * 257 + hh * 64 + p] * DTL[hh * 64 + tk]; }
              base[3 * 512 + f * 64 + lane] = pack8(v); }
            if (tid == 0) *(float*)(base + 32 * 64) = __expf(Gend);
        }
    }
}

__device__ __forceinline__ void phase_cd_rec(const KP kp, const int bid, const int G, int j, int li, LAS unsigned char* lds, int tid0) {
    unsigned char* scr = kp.ws() + WS_SCR; const bf16* U = (const bf16*)(kp.ws() + WS_U);
    const float* LA = (const float*)(scr + SC_LA); const float* LB = (const float*)(scr + SC_LB);
    float* YS = (float*)(scr + SC_YS); float* HS = (float*)(scr + SC_HS); bf16* XS = (bf16*)(scr + SC_XS);
    SEC_BEGIN(10)
    for (int item = bid; item < 64; item += G) {
        int tid = tid0; asm volatile("" : "+v"(tid));
        const int b = item >> 4, hd = item & 15;
        __syncthreads();
        const int wave = __builtin_amdgcn_readfirstlane(tid >> 6), lane = tid & 63, r = lane & 31, hp = lane >> 5, nt = wave;
        const unsigned char* OPS = scr + SC_SSDOP;
        const bool dmaw = (wave >= 2 && wave < 6);
        constexpr int SLOT = 33 * 1024;
#define SSD_DMA(n_) do { if (dmaw) { const unsigned char* gi_ = OPS + ((size_t)((b * 32 + (n_)) * 16 + hd)) * SSD_ITEM_BYTES + lane * 16; \
            _Pragma("unroll") for (int q_ = 0; q_ < 9; ++q_) { const int lf_ = q_ < 8 ? (wave - 2) * 8 + q_ : 32; \
                __builtin_amdgcn_global_load_lds((const unsigned*)(gi_ + lf_ * 1024), (LAS unsigned*)(lds + ((n_) & 3) * SLOT + lf_ * 1024), 16, 0, 0); } } } while (0)
        f32x16 S0, S1;
#pragma unroll
        for (int i = 0; i < 16; ++i) { S0[i] = 0.f; S1[i] = 0.f; }
        SSD_DMA(0); SSD_DMA(1); SSD_DMA(2);
        if (dmaw) asm volatile("s_waitcnt vmcnt(18)" ::: "memory");
        asm volatile("" ::: "memory"); __builtin_amdgcn_s_barrier(); asm volatile("" ::: "memory");
        for (int n = 0; n < 32; ++n) {
            if (n + 3 < 32) SSD_DMA(n + 3);
            if (wave < 2) {
                const LAS bf16x8* F = (const LAS bf16x8*)(lds + (n & 3) * SLOT) + lane;
                bf16x8 vb[4];
#pragma unroll
                for (int ks = 0; ks < 4; ++ks) vb[ks] = F[(24 + nt * 4 + ks) * 64];
                const float gend = *(const LAS float*)(lds + (n & 3) * SLOT + 32 * 1024);
                const bf16x8 sb00 = PACK_ACC(S0, 0), sb01 = PACK_ACC(S0, 1), sb10 = PACK_ACC(S1, 0), sb11 = PACK_ACC(S1, 1);
                f32x16 O0, O1;
#pragma unroll
                for (int i = 0; i < 16; ++i) { O0[i] = 0.f; O1[i] = 0.f; }
                O0 = MFMA32(F[0 * 64], sb00, O0); O0 = MFMA32(F[1 * 64], sb01, O0); O0 = MFMA32(F[2 * 64], sb10, O0); O0 = MFMA32(F[3 * 64], sb11, O0);
                O1 = MFMA32(F[4 * 64], sb00, O1); O1 = MFMA32(F[5 * 64], sb01, O1); O1 = MFMA32(F[6 * 64], sb10, O1); O1 = MFMA32(F[7 * 64], sb11, O1);
                O0 = MFMA32(F[16 * 64], vb[0], O0); O0 = MFMA32(F[17 * 64], vb[1], O0);
#pragma unroll
                for (int ks = 0; ks < 4; ++ks) O1 = MFMA32(F[(20 + ks) * 64], vb[ks], O1);
#pragma unroll
                for (int i = 0; i < 16; ++i) { S0[i] *= gend; S1[i] *= gend; }
#pragma unroll
                for (int ks = 0; ks < 4; ++ks) { S0 = MFMA32(F[(8 + ks) * 64], vb[ks], S0); S1 = MFMA32(F[(12 + ks) * 64], vb[ks], S1); }
                float* yo = YS + (size_t)(b * 2048 + n * 64) * 1024 + hd * 64 + 32 * nt + r;
#pragma unroll
                for (int i = 0; i < 16; ++i) { yo[(size_t)crow(i, hp) * 1024] = O0[i]; yo[(size_t)(32 + crow(i, hp)) * 1024] = O1[i]; }
            }
            if (dmaw) { if (n + 3 < 32) asm volatile("s_waitcnt vmcnt(18)" ::: "memory"); else if (n + 2 < 32) asm volatile("s_waitcnt vmcnt(9)" ::: "memory"); else asm volatile("s_waitcnt vmcnt(0)" ::: "memory"); }
            asm volatile("s_waitcnt lgkmcnt(0)" ::: "memory"); __builtin_amdgcn_s_barrier(); asm volatile("" ::: "memory");
        }
#undef SSD_DMA
        if (wave < 2) {
            float* dst = kp.out() + O_SSD_P + ((size_t)j * 4 + b) * ((size_t)16 * 64 * 64) + (size_t)hd * 64 * 64 + 32 * nt + r;
#pragma unroll
            for (int i = 0; i < 16; ++i) { dst[(size_t)crow(i, hp) * 64] = S0[i]; dst[(size_t)(32 + crow(i, hp)) * 64] = S1[i]; }
        }
    }
    SEC_END(10, lds)
    SEC_BEGIN(11)
    unsigned* qhead = (unsigned*)(kp.ws() + WS_CTL) + CW_CNT + 64 * li;
    volatile LAS unsigned* qslot = (volatile LAS unsigned*)(lds + LDS_BYTES - 8);
    const float* cw = kp.in(23) + (size_t)j * 4 * 1536; const float* cb = kp.in(24) + (size_t)j * 1536; const float* stc = kp.in(6) + (size_t)j * 128 * 3 * 1536;
    for (;;) {
        __syncthreads();
        if (tid0 == 0) qslot[0] = __hip_atomic_fetch_add(qhead, 1u, __ATOMIC_RELAXED, __HIP_MEMORY_SCOPE_AGENT);
        __syncthreads();
        const int it = (int)qslot[0];
        if (it >= 1024) break;
        int tid = tid0; asm volatile("" : "+v"(tid));
        if (it < 256) {
            const int s = it >> 6, h = it & 63; int row0, L; seq_info(s, row0, L);
            LAS float* Al = (LAS float*)lds; LAS float* Bl = Al + 512;
            const int chunk = tid >> 4, c16 = tid & 15, ch = h * 16 + c16;
            const size_t ro = (size_t)(row0 + chunk * 64) * 1024 + ch;
            float Ap = 1.f, Bp = 0.f;
#pragma unroll 8
            for (int t = 0; t < 64; ++t) { const float a = LA[ro + (size_t)t * 1024], bb = LB[ro + (size_t)t * 1024]; Bp = a * Bp + bb; Ap *= a; }
            Al[tid] = Ap; Bl[tid] = Bp;
            __syncthreads();
            float hh = 0.f;
            for (int m = 0; m < chunk; ++m) hh = Al[m * 16 + c16] * hh + Bl[m * 16 + c16];
#pragma unroll 8
            for (int t = 0; t < 64; ++t) { hh = LA[ro + (size_t)t * 1024] * hh + LB[ro + (size_t)t * 1024]; HS[ro + (size_t)t * 1024] = hh; }
            if (chunk == 31) kp.out()[O_LRU_P + ((size_t)j * 4 + s) * 1024 + ch] = hh;
        } else if (it < 768) {
            const int q_ = it - 256, bs = q_ >> 2, g = q_ & 3, sq = 4 + bs, r0 = TP + bs * 4;
            LAS float* BL = (LAS float*)lds; LAS float* CL = BL + 256; LAS float* XL = CL + 256; LAS float* DTL = XL + 1024; LAS float* QKs = DTL + 16; LAS float* red = QKs + 16;
            const int wave = tid >> 6, lane = tid & 63, hh = tid >> 7, nh = (tid >> 6) & 1, p = tid & 63, hd = 4 * g + hh;
            const size_t SZ = (size_t)16 * 64 * 64;
            const float* st = kp.in(5) + ((size_t)j * 128 + bs) * SZ + (size_t)hd * 4096;
            float S[32];
            { const float* sp = st + (size_t)(nh * 32) * 64 + p;
#pragma unroll
              for (int i = 0; i < 32; ++i) { S[i] = *sp; sp += 64; asm volatile("" : "+v"(sp)); } }
            { const int ci = tid & 127, tk = tid >> 7;
#pragma unroll
              for (int q = 0; q < 3; ++q) { const int k = ci + 128 * q; int cidx; LAS float* dst;
                  if (k < 64) { cidx = 1024 + g * 64 + k; dst = BL + tk * 64 + k; } else if (k < 128) { cidx = 1280 + g * 64 + (k - 64); dst = CL + tk * 64 + (k - 64); } else { cidx = g * 256 + (k - 128); dst = XL + tk * 256 + (k - 128); }
                  float acc = cb[cidx];
#pragma unroll
                  for (int tap = 0; tap < 4; ++tap) acc += cw[tap * 1536 + cidx] * pre_val(U, NCD, 1024 + cidx, r0, tk - 3 + tap, sq, stc, 1536, cidx);
                  *dst = silu_(acc); } }
            if (tid < 16) { const int tk = tid >> 2, h2 = tid & 3; DTL[tid] = softplus_(bf2f(U[(size_t)(r0 + tk) * NCD + 4608 + 4 * g + h2]) + kp.in(26)[j * 16 + 4 * g + h2]); }
            __syncthreads();
#pragma unroll
            for (int q = 0; q < 2; ++q) { const int idx = wave * 2 + q, i = idx >> 2, jj = idx & 3; const float dot = wave_sum(CL[i * 64 + lane] * BL[jj * 64 + lane]); if (lane == 0) QKs[idx] = dot; }
            { const int tk = tid >> 7, k2 = tid & 127; ((unsigned*)XS)[((size_t)(r0 + tk) * 1024 + g * 256) / 2 + k2] = pk2(XL[tk * 256 + 2 * k2], XL[tk * 256 + 2 * k2 + 1]); }
            const float negA = -__expf(kp.in(25)[j * 16 + hd]);
            float Gc[4], xd[4], w[4];
            Gc[0] = negA * DTL[hh]; Gc[1] = Gc[0] + negA * DTL[4 + hh]; Gc[2] = Gc[1] + negA * DTL[8 + hh]; Gc[3] = Gc[2] + negA * DTL[12 + hh];
#pragma unroll
            for (int jj = 0; jj < 4; ++jj) { xd[jj] = XL[jj * 256 + hh * 64 + p] * DTL[jj * 4 + hh]; w[jj] = __expf(Gc[3] - Gc[jj]) * xd[jj]; }
            const float eg = __expf(Gc[3]);
            float o[4] = {0.f, 0.f, 0.f, 0.f};
            float* dst = kp.out() + O_SSD_S + ((size_t)j * 128 + bs) * SZ + (size_t)hd * 4096 + (size_t)(nh * 32) * 64 + p;
#pragma unroll
            for (int i = 0; i < 32; ++i) { const int n = nh * 32 + i; const float s0 = S[i]; float acc = eg * s0;
#pragma unroll
                for (int t = 0; t < 4; ++t) { o[t] += CL[t * 64 + n] * s0; acc += BL[t * 64 + n] * w[t]; }
                *dst = acc; dst += 64; asm volatile("" : "+v"(dst)); }
#pragma unroll
            for (int t = 0; t < 4; ++t) red[((hh * 2 + nh) * 4 + t) * 64 + p] = o[t];
            __syncthreads();
            if (nh == 0) {
#pragma unroll
                for (int t = 0; t < 4; ++t) { float y = __expf(Gc[t]) * (red[((hh * 2) * 4 + t) * 64 + p] + red[((hh * 2 + 1) * 4 + t) * 64 + p]);
#pragma unroll
                    for (int jj = 0; jj <= t; ++jj) y += QKs[t * 4 + jj] * __expf(Gc[t] - Gc[jj]) * xd[jj];
                    YS[(size_t)(r0 + t) * 1024 + hd * 64 + p] = y; } }
        } else {
            const int q_ = it - 768, s = 4 + (q_ >> 1), h = q_ & 1; int row0, L; seq_info(s, row0, L);
            const int ch = h * 512 + tid;
            float hh = s < 4 ? 0.f : kp.in(7)[((size_t)j * 128 + (s - 4)) * 1024 + ch];
#pragma unroll 8
            for (int t = 0; t < L; ++t) { const size_t r = (size_t)(row0 + t); hh = LA[r * 1024 + ch] * hh + LB[r * 1024 + ch]; HS[r * 1024 + ch] = hh; }
            float* dst = s < 4 ? kp.out() + O_LRU_P + ((size_t)j * 4 + s) * 1024 : kp.out() + O_LRU_S + ((size_t)j * 128 + (s - 4)) * 1024;
            dst[ch] = hh;
        }
    }
    SEC_END(11, lds)
}

__device__ __forceinline__ void phase_cd_post(const KP kp, const int bid, const int G, int j, int tid, int wave, int lane) {
    unsigned char* scr = kp.ws() + WS_SCR; const bf16* U = (const bf16*)(kp.ws() + WS_U); bf16* YM = (bf16*)(kp.ws() + WS_YM);
    const float* YS = (const float*)(scr + SC_YS); const float* HS = (const float*)(scr + SC_HS); const bf16* XS = (const bf16*)(scr + SC_XS);
    const float* sn = kp.in(28) + (size_t)j * 1024; const float* Dv = kp.in(27) + (size_t)j * 16;
    typedef float f32x2v __attribute__((ext_vector_type(2)));
    for (int r = bid * NWAVES + wave; r < T; r += G * NWAVES) {
        int s, t; row_to_seq(r, s, t); int row0, L; seq_info(s, row0, L);
        const bf16* ur = U + (size_t)r * NCD; bf16* yr = YM + (size_t)r * DM;
#pragma unroll
        for (int gq = 0; gq < 4; ++gq) { const int e = gq * 256 + 4 * lane; const f32x4 ys = *(const f32x4*)(YS + (size_t)r * 1024 + e);
            const u32x2 xx = *(const u32x2*)(XS + (size_t)r * 1024 + e), zz = *(const u32x2*)(ur + e); const float Dh = Dv[e >> 6];
            f32x4 y; y.x = (ys.x + Dh * __uint_as_float(xx.x << 16)) * silu_(__uint_as_float(zz.x << 16)); y.y = (ys.y + Dh * __uint_as_float(xx.x & 0xffff0000u)) * silu_(__uint_as_float(zz.x & 0xffff0000u));
            y.z = (ys.z + Dh * __uint_as_float(xx.y << 16)) * silu_(__uint_as_float(zz.y << 16)); y.w = (ys.w + Dh * __uint_as_float(xx.y & 0xffff0000u)) * silu_(__uint_as_float(zz.y & 0xffff0000u));
            const float rstd = rsqrtf(wave_sum((y.x * y.x + y.y * y.y) + (y.z * y.z + y.w * y.w)) * (1.f / 256.f) + 1e-6f);
            const f32x4 g4 = *(const f32x4*)(sn + e);
            u32x2 w; w.x = pk2(y.x * rstd * g4.x, y.y * rstd * g4.y); w.y = pk2(y.z * rstd * g4.z, y.w * rstd * g4.w); *(u32x2*)(yr + e) = w; }
#pragma unroll
        for (int gq = 0; gq < 4; ++gq) { const int ch = gq * 256 + 4 * lane; const f32x4 hs = *(const f32x4*)(HS + (size_t)r * 1024 + ch); const u32x2 zz = *(const u32x2*)(ur + 2560 + ch);
            u32x2 w; w.x = pk2(hs.x * silu_(__uint_as_float(zz.x << 16)), hs.y * silu_(__uint_as_float(zz.x & 0xffff0000u))); w.y = pk2(hs.z * silu_(__uint_as_float(zz.y << 16)), hs.w * silu_(__uint_as_float(zz.y & 0xffff0000u)));
            *(u32x2*)(yr + 1024 + ch) = w; }
        if (t >= L - 3) { const int rr = t - (L - 3);
            float* d1 = s < 4 ? kp.out() + O_SSDC_P + (((size_t)j * 4 + s) * 3 + rr) * 1536 : kp.out() + O_SSDC_S + (((size_t)j * 128 + (s - 4)) * 3 + rr) * 1536;
            for (int c = 2 * lane; c < 1536; c += 128) { const unsigned uu = *(const unsigned*)(ur + 1024 + c); *(f32x2v*)(d1 + c) = (f32x2v){__uint_as_float(uu << 16), __uint_as_float(uu & 0xffff0000u)}; }
            float* d2 = s < 4 ? kp.out() + O_LRUC_P + (((size_t)j * 4 + s) * 3 + rr) * 1024 : kp.out() + O_LRUC_S + (((size_t)j * 128 + (s - 4)) * 3 + rr) * 1024;
            for (int c = 2 * lane; c < 1024; c += 128) { const unsigned uu = *(const unsigned*)(ur + 3584 + c); *(f32x2v*)(d2 + c) = (f32x2v){__uint_as_float(uu << 16), __uint_as_float(uu & 0xffff0000u)}; } }
    }
}


typedef float f32x4m __attribute__((ext_vector_type(4)));
template <bool GATE>
__device__ __forceinline__ void sample_gemm_res(const bf16* Amat, const bf16* Bt, const bf16* Hin, bf16* Hout, float* rss_out, const bf16* PP, const float* rss_in, int bid, int tid) {
    const int wave = tid >> 6, lane = tid & 63, lr = lane & 15, kg = lane >> 4;
    const int m0 = TP + (bid & 7) * 64 + (wave & 3) * 16, n0 = (bid >> 3) * 64 + (wave >> 2) * 32;
    if (bid >= 256) return;
    const bf16x8* ap = (const bf16x8*)(Amat + (size_t)(m0 + lr) * 2048 + 8 * kg);
    const bf16x8* bp0 = (const bf16x8*)(Bt + (size_t)(n0 + lr) * 2048 + 8 * kg);
    const bf16x8* bp1 = (const bf16x8*)(Bt + (size_t)(n0 + 16 + lr) * 2048 + 8 * kg);
    f32x4m c0 = {0.f, 0.f, 0.f, 0.f}, c1 = {0.f, 0.f, 0.f, 0.f};
#pragma unroll 8
    for (int ks = 0; ks < 64; ++ks) { const bf16x8 a = ap[ks * 4], b0 = bp0[ks * 4], b1 = bp1[ks * 4];
        c0 = __builtin_amdgcn_mfma_f32_16x16x32_bf16(a, b0, c0, 0, 0, 0); c1 = __builtin_amdgcn_mfma_f32_16x16x32_bf16(a, b1, c1, 0, 0, 0); }
#pragma unroll
    for (int i = 0; i < 4; ++i) { const int row = m0 + kg * 4 + i; float sc = 1.f; if (GATE) sc = rsqrtf(rss_in[row] * (1.f / 2048.f) + 1e-6f);
        float sq = 0.f;
#pragma unroll
        for (int nf = 0; nf < 2; ++nf) { const size_t p = (size_t)row * 2048 + n0 + 16 * nf + lr; const float a = nf ? c1[i] : c0[i];
            float h = bf2f(Hin[p]);
            if (GATE) h += __builtin_amdgcn_rcpf(1.f + __expf(-sc * a)) * bf2f(PP[p]); else h += a;
            sq += h * h; Hout[p] = (bf16)f2bf(h); }
        sq += __shfl_xor(sq, 1); sq += __shfl_xor(sq, 2); sq += __shfl_xor(sq, 4); sq += __shfl_xor(sq, 8);
        if (lr == 0) atomicAdd(rss_out + row, sq); }
}

__global__ void __launch_bounds__(NTHR, 2) mega_fwd(Args A) {
    extern __shared__ __attribute__((aligned(16))) unsigned char lds_raw[];
    LAS unsigned char* lds = (LAS unsigned char*)lds_raw;
    const int G = gridDim.x;
    volatile LAS unsigned* bst = (volatile LAS unsigned*)(lds + LDS_BYTES - 16);
    if (threadIdx.x == 0) { bst[0] = 0u; bst[1] = 0u;
#ifdef PROBE_SEC
        *(volatile LAS unsigned long long*)(lds + LDS_BYTES - 32) = 0ull;
#endif
    }
    __syncthreads();
    XcdBarrier xbar = xcd_barrier_post((unsigned*)(A.ws + WS_CTL) + CW_BAR, bst);
#ifdef PROBE_GROUP
    unsigned long long t_prev = __builtin_amdgcn_s_memrealtime(), t_sel = 0;
#endif
    for (int ph = A.ph_lo; ph < A.ph_hi; ++ph) {
        KP kp; kp.p = (const char AS4*)__builtin_amdgcn_kernarg_segment_ptr(); asm volatile("" : "+s"(kp.p));
        unsigned char* ws = kp.ws();
        int tid = threadIdx.x; asm volatile("" : "+v"(tid));
        int bid = blockIdx.x; asm volatile("" : "+s"(bid));
        const int lane = tid & 63, wave = __builtin_amdgcn_readfirstlane(tid >> 6), gw = bid * NWAVES + wave, NGW = G * NWAVES;
        if (ph == 0) { if (PH_MASK & 1) phase_prologue(kp, lds, gw, NGW, wave, lane); }
        else if (ph == N_PHASES - 1) phase_final(kp, gw, NGW, lane);
        else {
            const int li = (ph - 1) / SUBS, sub = (ph - 1) % SUBS, j = li >> 1; const bool ab = (li & 1) == 0;
            float* RSS = (float*)(ws + WS_RSS);
            if (sub == 0) {
                const int N = ab ? NAB : NCD;
                const bf16* Bt = ab ? (const bf16*)(ws + WS_WABIN) + (size_t)j * NAB * 2048 : (const bf16*)(ws + WS_WCDIN) + (size_t)j * NCD * 2048;
                { pg8::Gemm g{(const bf16*)(ws + WS_XN), Bt, T, N, 2048}; pg8::StaticOrder S; S.init(T, N, G, bid);
                  pg8::EpiU E{(bf16*)(ws + WS_U), N, RSS + (size_t)(2 * li) * T};
                  if (PH_MASK & 2) pg8::gemm_phase<pg8::EpiU, pg8::StaticOrder, true, true>(lds, g, S, E, tid); }
                { int tid2 = tid; asm volatile("" : "+v"(tid2));
                  pg8::Gemm g{(const bf16*)(ws + WS_PB) + (size_t)li * T * 256, (const bf16*)(ws + WS_WPROJ) + (size_t)li * 2048 * 256, T, 2048, 256}; pg8::StaticOrder S; S.init(T, 2048, G, (bid + 37) % G);
                  pg8::EpiU E{(bf16*)(ws + WS_SCR + SC_PP), 2048, nullptr};
                  if (PH_MASK & 2) pg8::gemm_phase<pg8::EpiU, pg8::StaticOrder, true, true>(lds, g, S, E, tid2); }
            } else if (sub == 4) {
                const bf16* Bt = ab ? (const bf16*)(ws + WS_WABOUT) + (size_t)j * 2048 * 2048 : (const bf16*)(ws + WS_WCDOUT) + (size_t)j * 2048 * 2048;
                pg8::Gemm g{(const bf16*)(ws + WS_YM), Bt, TP, 2048, 2048}; pg8::StaticOrder S; S.init(TP, 2048, G, bid);
                pg8::EpiRes<false> E{(const bf16*)(ws + WS_XN), (bf16*)(ws + WS_SCR + SC_HB1), RSS + (size_t)(2 * li + 1) * T, nullptr, nullptr};
                if (PH_MASK & 4) pg8::gemm_phase<pg8::EpiRes<false>, pg8::StaticOrder, true, true>(lds, g, S, E, tid);
                { int tid2 = tid; asm volatile("" : "+v"(tid2));
                  sample_gemm_res<false>((const bf16*)(ws + WS_YM), Bt, (const bf16*)(ws + WS_XN), (bf16*)(ws + WS_SCR + SC_HB1), RSS + (size_t)(2 * li + 1) * T, nullptr, nullptr, bid, tid2); }
            } else if (sub == 5) {
                pg8::Gemm g{(const bf16*)(ws + WS_SCR + SC_HB1), (const bf16*)(ws + WS_WGATE) + (size_t)li * 2048 * 2048, TP, 2048, 2048}; pg8::StaticOrder S; S.init(TP, 2048, G, bid);
                pg8::EpiRes<true> E{(const bf16*)(ws + WS_SCR + SC_HB1), (bf16*)(ws + WS_XN), RSS + (size_t)(2 * li + 2) * T, (const bf16*)(ws + WS_SCR + SC_PP), RSS + (size_t)(2 * li + 1) * T};
                if (PH_MASK & 4) pg8::gemm_phase<pg8::EpiRes<true>, pg8::StaticOrder, true, true>(lds, g, S, E, tid);
                { int tid2 = tid; asm volatile("" : "+v"(tid2));
                  sample_gemm_res<true>((const bf16*)(ws + WS_SCR + SC_HB1), (const bf16*)(ws + WS_WGATE) + (size_t)li * 2048 * 2048, (const bf16*)(ws + WS_SCR + SC_HB1), (bf16*)(ws + WS_XN), RSS + (size_t)(2 * li + 2) * T,
                                        (const bf16*)(ws + WS_SCR + SC_PP), RSS + (size_t)(2 * li + 1) * T, bid, tid2); }
            } else if (sub == 1) {
                if (ab) { SEC_BEGIN(3) if (PH_MASK & 4096) phase_gla_prep(kp, bid, G, j, lds, tid); SEC_END(3, lds) SEC_BEGIN(4) if (PH_MASK & 8192) phase_dn_prep(kp, bid, G, j, lds, tid); SEC_END(4, lds) }
                else { if (PH_MASK & 2048) { SEC_BEGIN(8) phase_ssd_prep(kp, bid, G, j, lds, tid); SEC_END(8, lds) SEC_BEGIN(9) phase_lru_gates(kp, bid, G, j, lds, tid); SEC_END(9, lds) } }
            }
            else if (sub == 2) { if (ab) { if (PH_MASK & 32) phase_ab_rec(kp, bid, G, j, li, lds, tid); } else { if (PH_MASK & 64) phase_cd_rec(kp, bid, G, j, li, lds, tid); } }
            else { if (ab) { if (PH_MASK & 128) phase_ab_post(kp, bid, G, j, tid, wave, lane); } else { if (PH_MASK & 256) phase_cd_post(kp, bid, G, j, tid, wave, lane); } }
        }
        if (ph + 1 < A.ph_hi) { if (ph == A.ph_lo) cg::this_grid().sync(); else xcd_barrier(xbar); }
#ifdef PROBE_GROUP
        { const unsigned long long t_now = __builtin_amdgcn_s_memrealtime(); const int li_ = (ph - 1) / SUBS, sub_ = (ph - 1) % SUBS; const bool ab_ = (li_ & 1) == 0;
          int grp = 9; if (ph == N_PHASES - 1) grp = 8; else if (ph > 0) { if (sub_ == 0 || sub_ == 4 || sub_ == 5) grp = 1; else if (sub_ == 1) grp = ab_ ? 4 : 5; else if (sub_ == 2) grp = ab_ ? 6 : 7; else grp = 8; }
          if (grp == PROBE_GROUP) t_sel += t_now - t_prev; t_prev = t_now; }
#endif
    }
#ifdef PROBE_SEC
    if (blockIdx.x == PROBE_BLK && threadIdx.x == 0) { const unsigned long long t_s = *(volatile LAS unsigned long long*)(lds + LDS_BYTES - 32); const unsigned long long t0 = __builtin_amdgcn_s_memrealtime(); while (__builtin_amdgcn_s_memrealtime() - t0 < 3 * t_s) __builtin_amdgcn_s_sleep(8); }
#endif
#ifdef PROBE_GROUP
    if (blockIdx.x == 0 && threadIdx.x == 0) { const unsigned long long t0 = __builtin_amdgcn_s_memrealtime(); while (__builtin_amdgcn_s_memrealtime() - t0 < 3 * t_sel) __builtin_amdgcn_s_sleep(8); }
#endif
}

extern "C" void kernel_launch(void* const* d_in, const int* in_sizes, int n_in, void* d_out, int out_size, void* d_ws, size_t ws_size, hipStream_t stream) {
    static int grid = 0;
    if (grid == 0) {
        if (n_in != 40 || (size_t)out_size != O_END || ws_size < WS_END) { fprintf(stderr, "kernel_launch: unexpected shapes: n_in %d out %d ws %zu\n", n_in, out_size, ws_size); grid = -1; return; }
        int dev = 0, cus = 0, per_cu = 0;
        if (hipGetDevice(&dev) != hipSuccess || hipDeviceGetAttribute(&cus, hipDeviceAttributeMultiprocessorCount, dev) != hipSuccess) { grid = -1; return; }
        if (hipFuncSetAttribute((const void*)mega_fwd, hipFuncAttributeMaxDynamicSharedMemorySize, LDS_BYTES) != hipSuccess) { fprintf(stderr, "kernel_launch: hipFuncSetAttribute failed\n"); grid = -1; return; }
        if (hipOccupancyMaxActiveBlocksPerMultiprocessor(&per_cu, (const void*)mega_fwd, NTHR, LDS_BYTES) != hipSuccess || per_cu < 1) { fprintf(stderr, "kernel_launch: occupancy query says %d\n", per_cu); per_cu = 1; }
        (void)hipGetLastError();
        grid = cus;
    }
    if (grid < 0) return;
    if (hipMemsetAsync((char*)d_ws + WS_CTL, 0, CTL_ZERO_BYTES, stream) != hipSuccess) { fprintf(stderr, "kernel_launch: memset of the control words failed\n"); return; }
    Args a{};
    for (int i = 0; i < 40; ++i) a.in[i] = (const float*)d_in[i];
    a.out = (float*)d_out; a.ws = (unsigned char*)d_ws;
#if MK_N_LAUNCHES == 1
    a.ph_lo = 0; a.ph_hi = N_PHASES;
    void* args[] = {&a};
    hipError_t e = hipLaunchCooperativeKernel((const void*)mega_fwd, dim3(grid), dim3(NTHR), args, LDS_BYTES, stream);
    if (e != hipSuccess) fprintf(stderr, "cooperative launch failed: %s (grid %d)\n", hipGetErrorString(e), grid);
#else
    for (int ph = 0; ph < N_PHASES; ++ph) { a.ph_lo = ph; a.ph_hi = ph + 1; mega_fwd<<<dim3(grid), dim3(NTHR), LDS_BYTES, stream>>>(a); }
#endif
}
```

```cpp
#include <hip/hip_runtime.h>
#include <hip/hip_cooperative_groups.h>
#include <cstdio>
#include <cstdint>
namespace cg = cooperative_groups;

#ifndef MK_N_LAUNCHES
#define MK_N_LAUNCHES 1
#endif

namespace pg8 {
#define PG8_LAS __attribute__((address_space(3)))
typedef unsigned short bf16_t;
typedef short bf16x8 __attribute__((ext_vector_type(8)));
typedef float f32x4 __attribute__((ext_vector_type(4)));
typedef unsigned u32x4 __attribute__((ext_vector_type(4)));
constexpr int BM = 256, BK = 64, HALF = 128, HTB = HALF * BK * 2  , STAGE_BYTES = 8 * HTB, NXCD = 8, WGM = 8;

__host__ __device__ __forceinline__ int lds_byte(int r, int c) { const int st = (r >> 4) * 2 + (c >> 5), rr = r & 15, cc = c & 31, ob = rr * 64 + cc * 2; return st * 1024 + (ob ^ (((ob >> 9) & 1) << 5)); }
__host__ __device__ __forceinline__ void stage_rc(int b, int& R, int& C) { const int st = b / 1024, sb = b % 1024, swz = sb ^ (((sb >> 9) & 1) << 5); R = (st >> 1) * 16 + swz / 64; C = (st & 1) * 32 + (swz % 64) / 2; }
__host__ __device__ __forceinline__ int perm32(int rho) { const int n = rho >> 4, i = rho & 15; return 8 * (i >> 2) + 4 * n + (i & 3); }

struct Unit { int pm, pn; };
struct Gemm { const bf16_t* A; const bf16_t* Bt; int M, N, K; };

struct StaticOrder {
    int nM, nN, nwg, G, c;
    __host__ __device__ void init(int M, int N, int G_, int c_) { nM = M / BM; nN = N / BM; nwg = nM * nN; G = G_; c = c_; }
    __host__ __device__ bool next(int i, Unit& u) const {
        const long L = (long)i * G + c; if (L >= nwg) return false;
        int wgid = (int)L; { const int q = nwg / NXCD, r = nwg % NXCD, xcd = wgid % NXCD, off = wgid / NXCD; wgid = (xcd < r ? xcd * (q + 1) : r * (q + 1) + (xcd - r) * q) + off; }
        const int nig = WGM * nN, gid = wgid / nig, fm = gid * WGM, gsz = (nM - fm) < WGM ? (nM - fm) : WGM;
        u.pm = fm + ((wgid % nig) % gsz); u.pn = (wgid % nig) / gsz; return true;
    }
    __device__ __forceinline__ void a_ready(const Unit&) const {}
    __device__ __forceinline__ void done(const Unit&) const {}
};

__device__ __forceinline__ unsigned cvt_pk_bf16(float lo, float hi) { unsigned r; asm volatile("v_cvt_pk_bf16_f32 %0, %1, %2" : "=v"(r) : "v"(lo), "v"(hi)); return r; }
struct EpiF32 {
    static constexpr bool PERM = false, AFTER_DRAIN = false;
    float* C; int ldc;
    __device__ __forceinline__ void operator()(const f32x4 (&acc)[2][2][4][2], const Unit& u, int wr, int wc, int fr, int fq) const {
        const int row0 = u.pm * BM + wr * 64 + fr, col0 = u.pn * BM + wc * 32 + 4 * fq;
#pragma unroll
        for (int ai = 0; ai < 2; ++ai)
#pragma unroll
            for (int m = 0; m < 4; ++m) { float* rowp = C + (size_t)(row0 + ai * HALF + m * 16) * ldc + col0;
#pragma unroll
                for (int bj = 0; bj < 2; ++bj)
#pragma unroll
                    for (int n = 0; n < 2; ++n) *(f32x4*)(rowp + bj * HALF + n * 16) = acc[ai][bj][m][n]; }
    }
};
struct EpiBf16 {
    static constexpr bool PERM = true, AFTER_DRAIN = false;
    bf16_t* O; int ldc;
    __device__ __forceinline__ void operator()(const f32x4 (&acc)[2][2][4][2], const Unit& u, int wr, int wc, int fr, int fq) const {
        const int row0 = u.pm * BM + wr * 64 + fr; const int col0 = u.pn * BM + wc * 32 + 8 * fq;
#pragma unroll
        for (int ai = 0; ai < 2; ++ai)
#pragma unroll
            for (int m = 0; m < 4; ++m) { bf16_t* rowp = O + (size_t)(row0 + ai * HALF + m * 16) * ldc + col0;
#pragma unroll
                for (int bj = 0; bj < 2; ++bj) { const f32x4 v0 = acc[ai][bj][m][0], v1 = acc[ai][bj][m][1];
                    u32x4 w; w.x = cvt_pk_bf16(v0[0], v0[1]); w.y = cvt_pk_bf16(v0[2], v0[3]); w.z = cvt_pk_bf16(v1[0], v1[1]); w.w = cvt_pk_bf16(v1[2], v1[3]);
                    *(u32x4*)(rowp + bj * HALF) = w; } }
    }
};

struct EpiU {
    static constexpr bool PERM = true, AFTER_DRAIN = false;
    bf16_t* O; int ldc; const float* rss;
    __device__ __forceinline__ void operator()(const f32x4 (&acc)[2][2][4][2], const Unit& u, int wr, int wc, int fr, int fq) const {
        const int row0 = u.pm * BM + wr * 64 + fr; const int col0 = u.pn * BM + wc * 32 + 8 * fq;
#pragma unroll
        for (int ai = 0; ai < 2; ++ai)
#pragma unroll
            for (int m = 0; m < 4; ++m) { const int row = row0 + ai * HALF + m * 16; const float sc = rss ? rsqrtf(rss[row] * (1.f / 2048.f) + 1e-6f) : 1.f;
                bf16_t* rowp = O + (size_t)row * ldc + col0;
#pragma unroll
                for (int bj = 0; bj < 2; ++bj) { const f32x4 v0 = acc[ai][bj][m][0] * sc, v1 = acc[ai][bj][m][1] * sc;
                    u32x4 w; w.x = cvt_pk_bf16(v0[0], v0[1]); w.y = cvt_pk_bf16(v0[2], v0[3]); w.z = cvt_pk_bf16(v1[0], v1[1]); w.w = cvt_pk_bf16(v1[2], v1[3]);
                    *(u32x4*)(rowp + bj * HALF) = w; } }
    }
};
typedef unsigned u32x2e __attribute__((ext_vector_type(2)));
template <bool GATE> struct EpiRes {
    static constexpr bool PERM = false, AFTER_DRAIN = false;
    const bf16_t* Hin; bf16_t* Hout; float* rss_out; const bf16_t* PP; const float* rss_in;
    __device__ __forceinline__ void operator()(const f32x4 (&acc)[2][2][4][2], const Unit& u, int wr, int wc, int fr, int fq) const {
        const int row0 = u.pm * BM + wr * 64 + fr, col0 = u.pn * BM + wc * 32 + 4 * fq;
#pragma unroll
        for (int ai = 0; ai < 2; ++ai)
#pragma unroll
            for (int m = 0; m < 4; ++m) { const int row = row0 + ai * HALF + m * 16; const size_t ro = (size_t)row * 2048 + col0;
                float sc = 1.f; if (GATE) sc = rsqrtf(rss_in[row] * (1.f / 2048.f) + 1e-6f);
                float s = 0.f;
#pragma unroll
                for (int bj = 0; bj < 2; ++bj)
#pragma unroll
                    for (int n = 0; n < 2; ++n) { const size_t p = ro + bj * HALF + n * 16; const u32x2e hw = *(const u32x2e*)(Hin + p); const f32x4 a = acc[ai][bj][m][n];
                        f32x4 h; h[0] = __uint_as_float(hw.x << 16); h[1] = __uint_as_float(hw.x & 0xffff0000u); h[2] = __uint_as_float(hw.y << 16); h[3] = __uint_as_float(hw.y & 0xffff0000u);
                        if (GATE) { const u32x2e pw = *(const u32x2e*)(PP + p);
                            h[0] += __builtin_amdgcn_rcpf(1.f + __expf(-sc * a[0])) * __uint_as_float(pw.x << 16); h[1] += __builtin_amdgcn_rcpf(1.f + __expf(-sc * a[1])) * __uint_as_float(pw.x & 0xffff0000u);
                            h[2] += __builtin_amdgcn_rcpf(1.f + __expf(-sc * a[2])) * __uint_as_float(pw.y << 16); h[3] += __builtin_amdgcn_rcpf(1.f + __expf(-sc * a[3])) * __uint_as_float(pw.y & 0xffff0000u); }
                        else h = h + a;
                        s += (h[0] * h[0] + h[1] * h[1]) + (h[2] * h[2] + h[3] * h[3]);
                        u32x2e o; o.x = cvt_pk_bf16(h[0], h[1]); o.y = cvt_pk_bf16(h[2], h[3]); *(u32x2e*)(Hout + p) = o; }
                s += __shfl_xor(s, 16); s += __shfl_xor(s, 32);
                if (fq == 0) atomicAdd(rss_out + row, s);
                asm volatile("" ::: "memory"); }
    }
};
template <class Epi, class Sched, bool ALIGN_EPI = false, bool SP2 = false>
__device__ __forceinline__ void gemm_phase(PG8_LAS unsigned char* lds, const Gemm g, const Sched& S, const Epi& E, const int tid) {
    const int wid = __builtin_amdgcn_readfirstlane(tid >> 6), lane = tid & 63, wr = wid >> 2, wc = wid & 3, fr = lane & 15, fq = lane >> 4;
    const int K = g.K, nt = K / BK;
    unsigned voffA[2], voffB[2];
#pragma unroll
    for (int i = 0; i < 2; ++i) { int R, C; stage_rc(tid * 16 + i * 8192, R, C); const int Rb = Epi::PERM ? ((R & ~31) + perm32(R & 31)) : R;
        voffA[i] = (unsigned)(R * K + C) * 2u; voffB[i] = (unsigned)(Rb * K + C) * 2u; }
    const size_t kstep = (size_t)(BK * 2);
    const size_t hstep = (size_t)HALF * K * 2;
    const size_t tstep = 2 * hstep;
    const unsigned ldsw = (unsigned)wid * 1024u;
    const int aoff = lds_byte(wr * 64 + fr, fq * 8), boff = lds_byte(wc * 32 + fr, fq * 8);
#define PG8_SA(b, h) (((b) * 2 + (h)) * HTB)
#define PG8_SB(b, h) ((4 + (b) * 2 + (h)) * HTB)
#define PG8_STAGE(bufoff, gbase, voff) do { _Pragma("unroll") for (int _i = 0; _i < 2; ++_i) \
        __builtin_amdgcn_global_load_lds((const unsigned*)((const char*)(gbase) + (voff)[_i]), (PG8_LAS unsigned*)(lds + (bufoff) + ldsw + _i * 8192), 16, 0, 0); } while (0)
#define PG8_LDA(dst, b, h) do { _Pragma("unroll") for (int m = 0; m < 4; ++m) _Pragma("unroll") for (int k = 0; k < 2; ++k) dst[m][k] = *(const PG8_LAS bf16x8*)(lds + PG8_SA(b, h) + aoff + m * 2048 + k * 1024); } while (0)
#define PG8_LDB(dst, b, h) do { _Pragma("unroll") for (int n = 0; n < 2; ++n) _Pragma("unroll") for (int k = 0; k < 2; ++k) dst[n][k] = *(const PG8_LAS bf16x8*)(lds + PG8_SB(b, h) + boff + n * 2048 + k * 1024); } while (0)
#define PG8_MMA(ai, bj, At, Bt) do { __builtin_amdgcn_s_setprio(1); _Pragma("unroll") for (int m = 0; m < 4; ++m) _Pragma("unroll") for (int n = 0; n < 2; ++n) _Pragma("unroll") for (int k = 0; k < 2; ++k) \
        acc[ai][bj][m][n] = __builtin_amdgcn_mfma_f32_16x16x32_bf16(Bt[n][k], At[m][k], acc[ai][bj][m][n], 0, 0, 0); __builtin_amdgcn_s_setprio(0); } while (0)
#define PG8_WAIT_V(n) asm volatile("s_waitcnt vmcnt(" #n ")" ::: "memory")
#define PG8_WAIT_L(n) asm volatile("s_waitcnt lgkmcnt(" #n ")" ::: "memory")
#define PG8_BAR __builtin_amdgcn_s_barrier()
#define PG8_SCHED __builtin_amdgcn_sched_barrier(0)
    Unit cur, nxt; int ui = 0;
    if (!S.next(0, cur)) return;
    f32x4 acc[2][2][4][2];
#pragma unroll
    for (int a = 0; a < 2; ++a)
#pragma unroll
        for (int b = 0; b < 2; ++b)
#pragma unroll
            for (int m = 0; m < 4; ++m)
#pragma unroll
                for (int n = 0; n < 2; ++n) acc[a][b][m][n] = (f32x4){0.f, 0.f, 0.f, 0.f};
    bf16x8 At[4][2], B0[2][2], B1[2][2];
    const char* cA = (const char*)g.A + (size_t)cur.pm * tstep; const char* cB = (const char*)g.Bt + (size_t)cur.pn * tstep;
    S.a_ready(cur);
    if constexpr (SP2) {
        PG8_STAGE(PG8_SB(0, 0), cB, voffB); PG8_STAGE(PG8_SB(0, 1), cB + hstep, voffB); PG8_STAGE(PG8_SA(0, 0), cA, voffA); PG8_STAGE(PG8_SA(0, 1), cA + hstep, voffA);
        if (wr == 1) PG8_BAR;
        PG8_WAIT_V(2); PG8_BAR;
        PG8_STAGE(PG8_SB(1, 0), cB + kstep, voffB); PG8_STAGE(PG8_SA(1, 0), cA + kstep, voffA); PG8_STAGE(PG8_SB(1, 1), cB + hstep + kstep, voffB);
        PG8_WAIT_V(6); PG8_BAR;
    } else {
        PG8_STAGE(PG8_SB(0, 0), cB, voffB); PG8_STAGE(PG8_SA(0, 0), cA, voffA); PG8_STAGE(PG8_SB(0, 1), cB + hstep, voffB); PG8_STAGE(PG8_SA(0, 1), cA + hstep, voffA);
        if (wr == 1) PG8_BAR;
        PG8_WAIT_V(4); PG8_BAR;
        PG8_STAGE(PG8_SB(1, 0), cB + kstep, voffB); PG8_STAGE(PG8_SA(1, 0), cA + kstep, voffA); PG8_STAGE(PG8_SB(1, 1), cB + hstep + kstep, voffB);
        PG8_WAIT_V(6); PG8_BAR;
    }
    for (;;) {
        const bool has_next = S.next(ui + 1, nxt);
        const char* nA = has_next ? (const char*)g.A + (size_t)nxt.pm * tstep : cA; const char* nB = has_next ? (const char*)g.Bt + (size_t)nxt.pn * tstep : cB;
        for (int t = 0; t < nt; t += 2) {
            const bool last = (t == nt - 2);
            const char* a1 = cA + (size_t)(t + 1) * kstep;
            const char* a2 = last ? nA : cA + (size_t)(t + 2) * kstep; const char* b2 = last ? nB : cB + (size_t)(t + 2) * kstep;
            const char* a3 = a2 + kstep; const char* b3 = b2 + kstep;
            if (last && has_next) S.a_ready(nxt);
            if constexpr (SP2) {
            PG8_LDB(B0, 0, 0); PG8_LDB(B1, 0, 1); PG8_SCHED; PG8_LDA(At, 0, 0); PG8_STAGE(PG8_SA(1, 1), a1 + hstep, voffA);
            PG8_WAIT_V(8); PG8_WAIT_L(0); PG8_BAR; PG8_MMA(0, 0, At, B0); PG8_MMA(0, 1, At, B1); PG8_BAR; PG8_SCHED;
            PG8_LDA(At, 0, 1); PG8_STAGE(PG8_SB(0, 0), b2, voffB); PG8_STAGE(PG8_SB(0, 1), b2 + hstep, voffB); PG8_STAGE(PG8_SA(0, 0), a2, voffA);
            PG8_WAIT_V(8); PG8_WAIT_L(0); PG8_BAR; PG8_MMA(1, 0, At, B0); PG8_MMA(1, 1, At, B1); PG8_BAR; PG8_SCHED;
            PG8_LDB(B0, 1, 0); PG8_LDB(B1, 1, 1); PG8_SCHED; PG8_LDA(At, 1, 0); PG8_STAGE(PG8_SA(0, 1), a2 + hstep, voffA);
            PG8_WAIT_V(8); PG8_WAIT_L(0); PG8_BAR; PG8_MMA(0, 0, At, B0); PG8_MMA(0, 1, At, B1); PG8_BAR; PG8_SCHED;
            PG8_LDA(At, 1, 1); PG8_STAGE(PG8_SB(1, 0), b3, voffB); PG8_STAGE(PG8_SB(1, 1), b3 + hstep, voffB); PG8_STAGE(PG8_SA(1, 0), a3, voffA);
            PG8_WAIT_V(8); PG8_WAIT_L(0); PG8_BAR; PG8_MMA(1, 0, At, B0); PG8_MMA(1, 1, At, B1); PG8_BAR; PG8_SCHED;
            } else {
            PG8_LDB(B0, 0, 0); PG8_SCHED; PG8_LDA(At, 0, 0); PG8_STAGE(PG8_SA(1, 1), a1 + hstep, voffA);
            PG8_WAIT_L(8); PG8_BAR; PG8_WAIT_L(0); PG8_MMA(0, 0, At, B0); PG8_BAR; PG8_SCHED;
            PG8_LDB(B1, 0, 1); PG8_STAGE(PG8_SB(0, 0), b2, voffB);
            PG8_BAR; PG8_WAIT_L(0); PG8_MMA(0, 1, At, B1); PG8_BAR;
            PG8_LDA(At, 0, 1); PG8_STAGE(PG8_SA(0, 0), a2, voffA);
            PG8_BAR; PG8_WAIT_L(0); PG8_MMA(1, 0, At, B0); PG8_BAR; PG8_SCHED;
            PG8_STAGE(PG8_SB(0, 1), b2 + hstep, voffB);
            PG8_WAIT_V(6); PG8_BAR; PG8_MMA(1, 1, At, B1); PG8_BAR;
            PG8_LDB(B0, 1, 0); PG8_SCHED; PG8_LDA(At, 1, 0); PG8_STAGE(PG8_SA(0, 1), a2 + hstep, voffA);
            PG8_WAIT_L(8); PG8_BAR; PG8_WAIT_L(0); PG8_MMA(0, 0, At, B0); PG8_BAR; PG8_SCHED;
            PG8_LDB(B1, 1, 1); PG8_STAGE(PG8_SB(1, 0), b3, voffB);
            PG8_BAR; PG8_WAIT_L(0); PG8_MMA(0, 1, At, B1); PG8_BAR;
            PG8_LDA(At, 1, 1); PG8_STAGE(PG8_SA(1, 0), a3, voffA);
            PG8_BAR; PG8_WAIT_L(0); PG8_MMA(1, 0, At, B0); PG8_BAR; PG8_SCHED;
            PG8_STAGE(PG8_SB(1, 1), b3 + hstep, voffB);
            PG8_WAIT_V(6); PG8_BAR; PG8_MMA(1, 1, At, B1); PG8_BAR;
            }
        }
        if constexpr (ALIGN_EPI) { if (wr == 0) PG8_BAR; }
        if constexpr (!Epi::AFTER_DRAIN) { E(acc, cur, wr, wc, fr, fq); S.done(cur); }
        if (!has_next) break;
#pragma unroll
        for (int a = 0; a < 2; ++a)
#pragma unroll
            for (int b = 0; b < 2; ++b)
#pragma unroll
                for (int m = 0; m < 4; ++m)
#pragma unroll
                    for (int n = 0; n < 2; ++n) acc[a][b][m][n] = (f32x4){0.f, 0.f, 0.f, 0.f};
        cur = nxt; cA = nA; cB = nB; ++ui;
        if constexpr (ALIGN_EPI) { if (wr == 1) PG8_BAR; }
    }
    PG8_WAIT_V(0);
    if constexpr (!ALIGN_EPI) { if (wr == 0) PG8_BAR; }
    PG8_BAR;
    if constexpr (Epi::AFTER_DRAIN) { E.fused(acc, cur, wr, wc, fr, fq, lds, wid, lane); S.done(cur); }
#undef PG8_SA
#undef PG8_SB
#undef PG8_STAGE
#undef PG8_LDA
#undef PG8_LDB
#undef PG8_MMA
#undef PG8_WAIT_V
#undef PG8_WAIT_L
#undef PG8_BAR
#undef PG8_SCHED
}
}

constexpr int TP = 8192, TS = 512, T = TP + TS, DM = 2048, NSEQ = 132;
constexpr int NAB = 7424, NCD = 4864;
constexpr int NWAVES = 8, NTHR = 512;
constexpr size_t MiB = 1u << 20;
constexpr size_t WS_CTL = 0, CTL_ZERO_BYTES = 1 * MiB;
constexpr int CW_BAR = 4096, CW_CNT = 8192;
constexpr size_t WS_RSS = 65536;
constexpr size_t WS_WABIN = 2 * MiB, WS_WABOUT = 60 * MiB, WS_WCDIN = 76 * MiB, WS_WCDOUT = 114 * MiB, WS_WGATE = 130 * MiB, WS_WPROJ = 162 * MiB;
constexpr size_t WS_H = 166 * MiB, WS_XN = 234 * MiB, WS_YM = 268 * MiB, WS_PB = 302 * MiB, WS_U = 320 * MiB, WS_SCR = 444 * MiB, WS_END = 732 * MiB;
constexpr size_t SC_HB1 = 102 * MiB;
constexpr size_t SC_PP = 8 * MiB;
constexpr size_t SC_QN = 0, SC_KN = 2 * MiB, SC_VV = 4 * MiB, SC_GLOG = 6 * MiB, SC_BETA = 7 * MiB, SC_GDEC = 7 * MiB + 65536, SC_ODN = 102 * MiB, SC_OGLA = 136 * MiB,
    SC_DNOPS = 192 * MiB;
constexpr size_t SC_XBC = 0, SC_DT = 3 * MiB, SC_LA = 52 * MiB, SC_LB = 86 * MiB, SC_YS = 120 * MiB, SC_HS = 154 * MiB, SC_SSDOP = 192 * MiB, SC_XS = 270 * MiB;
constexpr int LDS_BYTES = 163840;
constexpr size_t O_Y_P = 0, O_Y_S = O_Y_P + (size_t)4 * 2048 * 2048, O_DN_P = O_Y_S + (size_t)128 * 4 * 2048,
    O_DNC_P = O_DN_P + (size_t)2 * 4 * 8 * 128 * 128, O_GLA_P = O_DNC_P + (size_t)2 * 4 * 3 * 3072, O_SSD_P = O_GLA_P + (size_t)2 * 4 * 4 * 128 * 256,
    O_SSDC_P = O_SSD_P + (size_t)2 * 4 * 16 * 64 * 64, O_LRU_P = O_SSDC_P + (size_t)2 * 4 * 3 * 1536, O_LRUC_P = O_LRU_P + (size_t)2 * 4 * 1024,
    O_DN_S = O_LRUC_P + (size_t)2 * 4 * 3 * 1024, O_DNC_S = O_DN_S + (size_t)2 * 128 * 8 * 128 * 128, O_GLA_S = O_DNC_S + (size_t)2 * 128 * 3 * 3072,
    O_SSD_S = O_GLA_S + (size_t)2 * 128 * 4 * 128 * 256, O_SSDC_S = O_SSD_S + (size_t)2 * 128 * 16 * 64 * 64, O_LRU_S = O_SSDC_S + (size_t)2 * 128 * 3 * 1536,
    O_LRUC_S = O_LRU_S + (size_t)2 * 128 * 1024, O_END = O_LRUC_S + (size_t)2 * 128 * 3 * 1024;
static_assert(O_END == 109064192, "output size");

#define LAS __attribute__((address_space(3)))
typedef unsigned short bf16;
typedef float f32x4 __attribute__((ext_vector_type(4)));
typedef unsigned u32x2 __attribute__((ext_vector_type(2)));
typedef unsigned u32x4 __attribute__((ext_vector_type(4)));
#define LDS_WAIT() asm volatile("s_waitcnt lgkmcnt(0)" ::: "memory")

__device__ __forceinline__ float bf2f(bf16 b) { return __uint_as_float(((unsigned)b) << 16); }
__device__ __forceinline__ unsigned f2bf(float f) { unsigned u = __float_as_uint(f); return (u + 0x7fffu + ((u >> 16) & 1u)) >> 16; }
__device__ __forceinline__ unsigned pk2(float lo, float hi) { return f2bf(lo) | (f2bf(hi) << 16); }
__device__ __forceinline__ float sigmoid_(float x) { return __builtin_amdgcn_rcpf(1.f + __expf(-x)); }
__device__ __forceinline__ float silu_(float x) { return x * __builtin_amdgcn_rcpf(1.f + __expf(-x)); }
__device__ __forceinline__ float softplus_(float x) { return x > 15.f ? x : (x < -15.f ? __expf(x) : __logf(1.f + __expf(x))); }
__device__ __forceinline__ float wave_sum(float v) {
#pragma unroll
    for (int o = 1; o < 64; o <<= 1) v += __shfl_xor(v, o);
    return v;
}
__device__ __forceinline__ void row_to_seq(int r, int& s, int& t) { if (r < TP) { s = r >> 11; t = r & 2047; } else { s = 4 + ((r - TP) >> 2); t = (r - TP) & 3; } }
__device__ __forceinline__ void seq_info(int s, int& row0, int& L) { if (s < 4) { row0 = s << 11; L = 2048; } else { row0 = TP + ((s - 4) << 2); L = 4; } }
__device__ __forceinline__ float pre_val(const bf16* U, int ldu, int ucol, int row0, int tt, int s, const float* stc, int W, int c) {
    const int tc = tt >= 0 ? tt : 0, sc = tt >= 0 ? 0 : 3 + tt;
    const float a = bf2f(U[(size_t)(row0 + tc) * ldu + ucol]), b = stc[((size_t)(s - 4) * 3 + sc) * W + c];
    return tt >= 0 ? a : b;
}
__device__ __forceinline__ int map_col(int mapid, int n) {
    if (mapid == 0) return n;
    if (mapid == 1) { if (n < 3072) return n; if (n < 6144) return n + 16; if (n < 7168) return n + 32; if (n < 7184) return n - 4096; if (n < 7200) return n - 1024; return -1; }
    if (n < 2560) return n; if (n < 4608) return n + 16; if (n < 4624) return n - 2048; return -1;
}
__device__ __forceinline__ void transpose_item(const float* W, int K, int Nsrc, bf16* WT, int Npad, int mapid, const float* gain, LAS float* scr, int item, int lane) {
    const int nblk = Npad / 64, kb = item / nblk, nb = item % nblk, k0 = 64 * kb, n0 = 64 * nb;
    const int n4 = (lane & 15) * 4, src = map_col(mapid, n0 + n4);
    const int srcc = src >= 0 ? src : 0; const float msk = src >= 0 ? 1.f : 0.f;
    f32x4 v[16];
#pragma unroll
    for (int i = 0; i < 16; ++i) v[i] = *(const f32x4*)(W + (size_t)(k0 + 4 * i + (lane >> 4)) * Nsrc + srcc);
    if (gain) {
#pragma unroll
        for (int i = 0; i < 16; ++i) v[i] = v[i] * (gain[k0 + 4 * i + (lane >> 4)] * msk);
    } else {
#pragma unroll
        for (int i = 0; i < 16; ++i) v[i] = v[i] * msk;
    }
#pragma unroll
    for (int i = 0; i < 16; ++i) { const int kk = 4 * i + (lane >> 4); scr[kk * 65 + n4] = v[i].x; scr[kk * 65 + n4 + 1] = v[i].y; scr[kk * 65 + n4 + 2] = v[i].z; scr[kk * 65 + n4 + 3] = v[i].w; }
    LDS_WAIT(); asm volatile("" ::: "memory");
    const int c = lane & 7;
#pragma unroll
    for (int jj = 0; jj < 8; ++jj) { const int n = (lane >> 3) + 8 * jj; const LAS float* p = scr + (8 * c) * 65 + n;
        u32x4 o; o.x = pk2(p[0 * 65], p[1 * 65]); o.y = pk2(p[2 * 65], p[3 * 65]); o.z = pk2(p[4 * 65], p[5 * 65]); o.w = pk2(p[6 * 65], p[7 * 65]);
        *(u32x4*)(WT + (size_t)(n0 + n) * K + k0 + 8 * c) = o; }
    LDS_WAIT(); asm volatile("" ::: "memory");
}
__device__ __forceinline__ void norm_row_bf16(const f32x4 (&v)[8], const float* g, bf16* orow, int lane) {
    float ss = 0.f;
#pragma unroll
    for (int j = 0; j < 8; ++j) ss += (v[j].x * v[j].x + v[j].y * v[j].y) + (v[j].z * v[j].z + v[j].w * v[j].w);
    const float rstd = rsqrtf(wave_sum(ss) * (1.f / DM) + 1e-6f);
#pragma unroll
    for (int j = 0; j < 8; ++j) { const int col = 4 * (lane + 64 * j); const f32x4 gg = *(const f32x4*)(g + col);
        u32x2 o; o.x = pk2(v[j].x * rstd * gg.x, v[j].y * rstd * gg.y); o.y = pk2(v[j].z * rstd * gg.z, v[j].w * rstd * gg.w);
        *(u32x2*)(orow + col) = o; }
}

typedef __bf16 bf16x2_t __attribute__((ext_vector_type(2)));
typedef float f32x2_t __attribute__((ext_vector_type(2)));
typedef short bf16x8 __attribute__((ext_vector_type(8)));
typedef float f32x16 __attribute__((ext_vector_type(16)));
__device__ __forceinline__ unsigned cvtpk(float lo, float hi) { f32x2_t v = {lo, hi}; bf16x2_t b = __builtin_convertvector(v, bf16x2_t); return __builtin_bit_cast(unsigned, b); }
#define MFMA32(a, b, c) __builtin_amdgcn_mfma_f32_32x32x16_bf16((a), (b), (c), 0, 0, 0)
#define PACK_ACC(x, S_) __builtin_bit_cast(bf16x8, (u32x4){cvtpk((x)[8 * (S_)], (x)[8 * (S_) + 1]), cvtpk((x)[8 * (S_) + 2], (x)[8 * (S_) + 3]), cvtpk((x)[8 * (S_) + 4], (x)[8 * (S_) + 5]), cvtpk((x)[8 * (S_) + 6], (x)[8 * (S_) + 7])})
__device__ __forceinline__ int crow(int reg, int h) { return (reg & 3) + 8 * (reg >> 2) + 4 * h; }
__device__ __forceinline__ bf16x8 pack8(const float (&v)[8]) { return __builtin_bit_cast(bf16x8, (u32x4){cvtpk(v[0], v[1]), cvtpk(v[2], v[3]), cvtpk(v[4], v[5]), cvtpk(v[6], v[7])}); }

#define XB_TMO      128
#define XB_XCNT(j)  (256  + 64 * (j))
#define XB_XSUB(j)  (1280 + 64 * (j))
#define XB_XGEN(j)  (2304 + 64 * (j))
#define XB_TOP      3328
#define XB_TOPGEN   3392
#define XCD_BAR_WORDS 3456
#define XB_SPIN_CAP (1u << 18)

__device__ __forceinline__ unsigned xb_ld(unsigned* p)              { return __hip_atomic_load(p, __ATOMIC_RELAXED, __HIP_MEMORY_SCOPE_AGENT); }
__device__ __forceinline__ unsigned xb_add(unsigned* p, unsigned v) { return __hip_atomic_fetch_add(p, v, __ATOMIC_RELAXED, __HIP_MEMORY_SCOPE_AGENT); }
__device__ __forceinline__ unsigned xb_xcc_id() { return (unsigned)__builtin_amdgcn_s_getreg((3 << 11) | 20) & 0xFu; }
#define XB_SPIN(cond, bar) do { unsigned _sp = 0; while (cond) { __builtin_amdgcn_s_sleep(1); \
    if ((++_sp & 255u) == 0u) { if (xb_ld(&(bar)[XB_TMO])) break; if (_sp > XB_SPIN_CAP) { atomicAdd(&(bar)[XB_TMO], 1u); break; } } } } while (0)

struct XcdBarrier {
    unsigned* bar; unsigned x;
    volatile LAS unsigned* st;
};

__device__ __forceinline__ XcdBarrier xcd_barrier_post(unsigned* bar, volatile LAS unsigned* st) {
    XcdBarrier b; b.bar = bar; b.x = xb_xcc_id(); b.st = st;
    if (threadIdx.x == 0) (void)xb_add(&bar[XB_XCNT(b.x)], 1u);
    return b;
}
__device__ __forceinline__ void xcd_barrier_complete(unsigned* bar, unsigned x, unsigned& nloc, unsigned& nx) {
    const unsigned G = gridDim.x * gridDim.y * gridDim.z;
    unsigned sum, cnt, mine, sp = 0u;
    for (;;) {
        sum = 0u; cnt = 0u; mine = 0u;
#pragma unroll
        for (unsigned j = 0; j < 16; ++j) { const unsigned c = xb_ld(&bar[XB_XCNT(j)]); sum += c; cnt += (c > 0u) ? 1u : 0u; mine = (j == x) ? c : mine; }
        if (sum == G) break;
        __builtin_amdgcn_s_sleep(1);
        if ((++sp & 255u) == 0u) { if (xb_ld(&bar[XB_TMO])) break; if (sp > XB_SPIN_CAP) { atomicAdd(&bar[XB_TMO], 1u); break; } }
    }
    nloc = mine > 0u ? mine : 1u; nx = cnt > 0u ? cnt : 1u;
}

__device__ __forceinline__ void xcd_barrier(const XcdBarrier& b) {
    asm volatile("s_waitcnt vmcnt(0)" ::: "memory");
    __syncthreads();
    if (threadIdx.x == 0) {
        unsigned* bar = b.bar;
        __builtin_amdgcn_s_waitcnt(0);
        unsigned nloc = b.st[0], nx = b.st[1];
        if (nloc == 0u) { xcd_barrier_complete(bar, b.x, nloc, nx); b.st[0] = nloc; b.st[1] = nx; }
        const unsigned old = xb_add(&bar[XB_XSUB(b.x)], 1u);
        const unsigned gen = old / nloc;
        if (old + 1u == (gen + 1u) * nloc) {
            __builtin_amdgcn_fence(__ATOMIC_RELEASE, "agent");
            asm volatile("s_waitcnt vmcnt(0)" ::: "memory");
            const unsigned og = xb_add(&bar[XB_TOP], 1u);
            const unsigned tg = og / nx;
            if (og + 1u == (tg + 1u) * nx) xb_add(&bar[XB_TOPGEN], 1u);
            else XB_SPIN(xb_ld(&bar[XB_TOPGEN]) == tg, bar);
            __builtin_amdgcn_fence(__ATOMIC_ACQUIRE, "agent");
            xb_add(&bar[XB_XGEN(b.x)], 1u);
            asm volatile("s_waitcnt vmcnt(0)" ::: "memory");
        } else {
            XB_SPIN(xb_ld(&bar[XB_XGEN(b.x)]) == gen, bar);
            __builtin_amdgcn_fence(__ATOMIC_ACQUIRE, "agent");
            asm volatile("s_waitcnt vmcnt(0)" ::: "memory");
        }
    }
    __syncthreads();
}


#ifdef PROBE_SEC
#define SEC_BEGIN(id) unsigned long long _sec_t##id = 0; if ((id) == PROBE_SEC) { __builtin_amdgcn_s_barrier(); _sec_t##id = __builtin_amdgcn_s_memrealtime(); }
#define SEC_END(id, ldsp) if ((id) == PROBE_SEC) { __builtin_amdgcn_s_barrier(); if (threadIdx.x == 0) { volatile LAS unsigned long long* a_ = (volatile LAS unsigned long long*)((ldsp) + LDS_BYTES - 32); a_[0] = a_[0] + (__builtin_amdgcn_s_memrealtime() - _sec_t##id); } }
#else
#define SEC_BEGIN(id)
#define SEC_END(id, ldsp)
#endif
struct Args { const float* in[40]; float* out; unsigned char* ws; int ph_lo, ph_hi; };
constexpr int N_PHASES = 26, SUBS = 6;
#ifndef PH_MASK
#define PH_MASK 16383
#endif
#define AS4 __attribute__((address_space(4)))
struct KP { const char AS4* p;
    __device__ __forceinline__ const float* in(int i) const { return *(const float* const AS4*)(p + 8 * i); }
    __device__ __forceinline__ float* out() const { return *(float* const AS4*)(p + 320); }
    __device__ __forceinline__ unsigned char* ws() const { return *(unsigned char* const AS4*)(p + 328); }
};
static_assert(sizeof(Args) == 344, "Args layout");

__device__ __forceinline__ void phase_prologue(const KP kp, LAS unsigned char* lds, int gw, int NGW, int wave, int lane) {
    unsigned char* ws = kp.ws();
    LAS float* scr = (LAS float*)(lds + wave * 17408);
    SEC_BEGIN(1)
    SEC_BEGIN(14)
    for (int job = 0; job < 16; ++job) {
        if (job == 2) { SEC_END(14, lds) }
        const float* W; int K = 2048, Nsrc = 2048, Npad = 2048, mapid = 0; bf16* WT; const float* gain = nullptr;
        if (job < 2)       { W = kp.in(13) + (size_t)job * 2048 * 7200; Nsrc = 7200; Npad = NAB; mapid = 1; WT = (bf16*)(ws + WS_WABIN) + (size_t)job * NAB * 2048; gain = kp.in(11) + (size_t)(2 * job) * DM; }
        else if (job < 4)  { W = kp.in(21) + (size_t)(job - 2) * 2048 * 2048; WT = (bf16*)(ws + WS_WABOUT) + (size_t)(job - 2) * 2048 * 2048; }
        else if (job < 6)  { W = kp.in(22) + (size_t)(job - 4) * 2048 * 4624; Nsrc = 4624; Npad = NCD; mapid = 2; WT = (bf16*)(ws + WS_WCDIN) + (size_t)(job - 4) * NCD * 2048; gain = kp.in(11) + (size_t)(2 * (job - 4) + 1) * DM; }
        else if (job < 8)  { W = kp.in(36) + (size_t)(job - 6) * 2048 * 2048; WT = (bf16*)(ws + WS_WCDOUT) + (size_t)(job - 6) * 2048 * 2048; }
        else if (job < 12) { W = kp.in(39) + (size_t)(job - 8) * 2048 * 2048; WT = (bf16*)(ws + WS_WGATE) + (size_t)(job - 8) * 2048 * 2048; gain = kp.in(38) + (size_t)(job - 8) * DM; }
        else               { W = kp.in(37) + (size_t)(job - 12) * 256 * 2048; K = 256; WT = (bf16*)(ws + WS_WPROJ) + (size_t)(job - 12) * 2048 * 256; }
        const int nitems = (K / 64) * (Npad / 64), nblocks = NGW / NWAVES, ipb = (nitems + nblocks - 1) / nblocks, ib = (gw / NWAVES) * ipb, ie = ib + ipb < nitems ? ib + ipb : nitems;
        for (int it = ib + wave; it < ie; it += NWAVES) transpose_item(W, K, Nsrc, WT, Npad, mapid, gain, scr, it, lane);
    }
    SEC_END(1, lds)
    SEC_BEGIN(2)
    bf16* HB = (bf16*)(ws + WS_XN); float* RSS = (float*)(ws + WS_RSS);
    for (int m = gw; m < T; m += NGW) {
        const float* src = m < TP ? kp.in(0) + (size_t)m * DM : kp.in(1) + (size_t)(m - TP) * DM;
        float ss = 0.f;
#pragma unroll
        for (int jj = 0; jj < 8; ++jj) { const int col = 4 * (lane + 64 * jj); const f32x4 v = *(const f32x4*)(src + col);
            u32x2 o; o.x = pk2(v.x, v.y); o.y = pk2(v.z, v.w); *(u32x2*)(HB + (size_t)m * DM + col) = o; ss += (v.x * v.x + v.y * v.y) + (v.z * v.z + v.w * v.w); }
        ss = wave_sum(ss); if (lane == 0) RSS[m] = ss;
    }
    bf16* PB = (bf16*)(ws + WS_PB);
    const int gt = gw * 64 + lane, NGT = NGW * 64;
    for (int i = gt; i < 4 * T * 64; i += NGT) {
        const int c4 = i & 63, rr = i >> 6, li = rr / T, r = rr - li * T;
        const float* src = r < TP ? kp.in(9) + ((size_t)li * TP + r) * 256 + 4 * c4 : kp.in(10) + ((size_t)li * TS + (r - TP)) * 256 + 4 * c4;
        const f32x4 v = *(const f32x4*)src;
        u32x2 o; o.x = pk2(v.x, v.y); o.y = pk2(v.z, v.w);
        *(u32x2*)(PB + ((size_t)li * T + r) * 256 + 4 * c4) = o;
    }
    SEC_END(2, lds)
}
__device__ __forceinline__ void phase_final(const KP kp, int gw, int NGW, int lane) {
    const bf16* HB = (const bf16*)(kp.ws() + WS_XN); const float* RSS = (const float*)(kp.ws() + WS_RSS) + (size_t)8 * T; const float* g = kp.in(12); float* out = kp.out();
    for (int m = gw; m < T; m += NGW) { const float rstd = rsqrtf(RSS[m] * (1.f / DM) + 1e-6f);
#pragma unroll
        for (int jj = 0; jj < 8; ++jj) { const int col = 4 * (lane + 64 * jj); const u32x2 hv = *(const u32x2*)(HB + (size_t)m * DM + col); const f32x4 gg = *(const f32x4*)(g + col);
            f32x4 o; o.x = __uint_as_float(hv.x << 16) * rstd * gg.x; o.y = __uint_as_float(hv.x & 0xffff0000u) * rstd * gg.y; o.z = __uint_as_float(hv.y << 16) * rstd * gg.z; o.w = __uint_as_float(hv.y & 0xffff0000u) * rstd * gg.w;
            *(f32x4*)(out + (size_t)m * DM + col) = o; } }
}

__device__ __forceinline__ void phase_ab_pre(const KP kp, const int bid, const int G, int j, int tid, int wave, int lane) {
    unsigned char* scr = kp.ws() + WS_SCR; const bf16* U = (const bf16*)(kp.ws() + WS_U);
    float* QN = (float*)(scr + SC_QN) - (size_t)TP * 1024; float* KN = (float*)(scr + SC_KN) - (size_t)TP * 1024; float* VV = (float*)(scr + SC_VV) - (size_t)TP * 1024;
    float* GLOG = (float*)(scr + SC_GLOG) - (size_t)TP * 512; float* BETA = (float*)(scr + SC_BETA) - (size_t)TP * 8; float* GDEC = (float*)(scr + SC_GDEC) - (size_t)TP * 8;
    const float* cw = kp.in(14) + (size_t)j * 4 * 3072; const float* stc = kp.in(3) + (size_t)j * 128 * 3 * 3072;
    const float* wa2 = kp.in(18) + (size_t)j * 16 * 512; const float* ba = kp.in(19) + (size_t)j * 512;
    for (int r = TP + bid; r < T; r += G) {
        int s, t; row_to_seq(r, s, t); const int row0 = r - t;
#pragma unroll
        for (int part = 0; part < 3; ++part) {
            float val[2];
#pragma unroll
            for (int i = 0; i < 2; ++i) { const int c = part * 1024 + wave * 128 + lane + 64 * i; float acc = 0.f;
#pragma unroll
                for (int tap = 0; tap < 4; ++tap) acc += cw[tap * 3072 + c] * pre_val(U, NAB, c, row0, t - 3 + tap, s, stc, 3072, c);
                val[i] = silu_(acc); }
            if (part < 2) { const float ss = wave_sum(val[0] * val[0] + val[1] * val[1]); const float sc = rsqrtf(ss + 1e-6f) * (part == 0 ? 0.08838834764831845f : 1.f); val[0] *= sc; val[1] *= sc; }
            float* dst = part == 0 ? QN : (part == 1 ? KN : VV);
            dst[(size_t)r * 1024 + wave * 128 + lane] = val[0]; dst[(size_t)r * 1024 + wave * 128 + lane + 64] = val[1];
        }
        if (tid < 8) {
            BETA[(size_t)r * 8 + tid] = sigmoid_(bf2f(U[(size_t)r * NAB + 7168 + tid]));
            GDEC[(size_t)r * 8 + tid] = -__expf(kp.in(15)[j * 8 + tid]) * softplus_(bf2f(U[(size_t)r * NAB + 7176 + tid]) + kp.in(16)[j * 8 + tid]);
        }
        { float x = ba[tid];
#pragma unroll
          for (int rr = 0; rr < 16; ++rr) x += bf2f(U[(size_t)r * NAB + 7184 + rr]) * wa2[rr * 512 + tid];
          GLOG[(size_t)r * 512 + tid] = -softplus_(-x) * (1.f / 16.f); }
    }
}


constexpr size_t GLA_ITEM_BYTES = 74752, WS_GLAOPS = WS_H;
__device__ __forceinline__ void phase_gla_prep(const KP kp, const int bid, const int G, int j, LAS unsigned char* lds, int tid) {
    const bf16* U = (const bf16*)(kp.ws() + WS_U);
    const float* wa2 = kp.in(18) + (size_t)j * 16 * 512; const float* ba = kp.in(19) + (size_t)j * 512;
    unsigned char* OPS = kp.ws() + WS_GLAOPS;
    LAS float* GL = (LAS float*)lds; LAS float* QL = GL + 64 * 129; LAS float* KL = QL + 64 * 129; LAS float* AL = KL + 64 * 129;
    const int lane = tid & 63, r = lane & 31, hp = lane >> 5;
    for (int item = bid; item < 512; item += G) {
        const int b = item >> 7, n = (item >> 2) & 31, h = item & 3;
        const int row0 = b * 2048 + n * 64;
        __syncthreads();
        for (int i = tid; i < 8192; i += NTHR) { const int t = i >> 7, d = i & 127; const size_t ro = (size_t)(row0 + t) * NAB;
            QL[t * 129 + d] = bf2f(U[ro + 4096 + h * 128 + d]) * 0.08838834764831845f; KL[t * 129 + d] = bf2f(U[ro + 4608 + h * 128 + d]);
            float x = ba[h * 128 + d];
#pragma unroll
            for (int rr = 0; rr < 16; ++rr) x += bf2f(U[ro + 7184 + rr]) * wa2[rr * 512 + h * 128 + d];
            GL[t * 129 + d] = -softplus_(-x) * (1.f / 16.f); }
        __syncthreads();
        if (tid < 128) { float acc = 0.f;
#pragma unroll 4
            for (int t = 0; t < 64; ++t) { acc += GL[t * 129 + tid]; GL[t * 129 + tid] = acc; } }
        __syncthreads();
        for (int i = tid; i < 8192; i += NTHR) { const int t = i >> 7, d = i & 127; const float gg = GL[t * 129 + d]; QL[t * 129 + d] *= __expf(gg); KL[t * 129 + d] *= __expf(-gg); }
        __syncthreads();
        { const int i = tid >> 3, jg = tid & 7; float acc[8];
#pragma unroll
          for (int jj = 0; jj < 8; ++jj) acc[jj] = 0.f;
#pragma unroll 4
          for (int d = 0; d < 128; ++d) { const float c = QL[i * 129 + d];
#pragma unroll
              for (int jj = 0; jj < 8; ++jj) acc[jj] += c * KL[(jg * 8 + jj) * 129 + d]; }
#pragma unroll
          for (int jj = 0; jj < 8; ++jj) AL[i * 65 + jg * 8 + jj] = (jg * 8 + jj) <= i ? acc[jj] : 0.f; }
        __syncthreads();
        bf16x8* base = (bf16x8*)(OPS + (size_t)item * GLA_ITEM_BYTES);
        float v[8];
#pragma unroll
        for (int q = 0; q < 2; ++q) { const int f = (tid >> 6) + 8 * q;
            { const int mt = f >> 3, ks = f & 7, i = 32 * mt + r;
#pragma unroll
              for (int jp = 0; jp < 8; ++jp) v[jp] = QL[i * 129 + 16 * ks + 8 * (jp >> 2) + 4 * hp + (jp & 3)];
              base[f * 64 + lane] = pack8(v); }
            { const int mt = f >> 2, ks = f & 3, d = 32 * mt + r; const float eg = __expf(GL[63 * 129 + d]);
#pragma unroll
              for (int jp = 0; jp < 8; ++jp) v[jp] = KL[(16 * ks + 8 * (jp >> 2) + 4 * hp + (jp & 3)) * 129 + d] * eg;
              base[(16 + f) * 64 + lane] = pack8(v); } }
        { const int f = tid >> 6, mt = f >> 2, ks = f & 3, i = 32 * mt + r;
#pragma unroll
          for (int jp = 0; jp < 8; ++jp) v[jp] = AL[i * 65 + 16 * ks + 8 * (jp >> 2) + 4 * hp + (jp & 3)];
          base[(32 + f) * 64 + lane] = pack8(v); }
#pragma unroll
        for (int q = 0; q < 4; ++q) { const int f = (tid >> 6) + 8 * q, nt = f >> 2, ks = f & 3, p = 32 * nt + r;
            unsigned w[4];
#pragma unroll
            for (int jp = 0; jp < 8; jp += 2) { const int t0 = 16 * ks + 8 * (jp >> 2) + 4 * hp + (jp & 3);
                w[jp >> 1] = (unsigned)U[(size_t)(row0 + t0) * NAB + 5120 + h * 256 + p] | ((unsigned)U[(size_t)(row0 + t0 + 1) * NAB + 5120 + h * 256 + p] << 16); }
            base[(40 + f) * 64 + lane] = __builtin_bit_cast(bf16x8, (u32x4){w[0], w[1], w[2], w[3]}); }
        if (tid < 128) ((float*)(base + 72 * 64))[tid] = __expf(GL[63 * 129 + tid]);
    }
}


constexpr size_t DN_ITEM_BYTES = 74752;
__device__ __forceinline__ void phase_dn_prep(const KP kp, const int bid, const int G, int j, LAS unsigned char* lds, int tid0) {
    unsigned char* scr = kp.ws() + WS_SCR;
    const bf16* U = (const bf16*)(kp.ws() + WS_U); const float* cw = kp.in(14) + (size_t)j * 4 * 3072;
    unsigned char* OPS = scr + SC_DNOPS;
    LAS float* AMT = (LAS float*)lds; LAS float* GLs = AMT + 64 * 68; LAS float* BLs = GLs + 64; LAS float* SS = BLs + 64;
    LAS bf16* Kb = (LAS bf16*)(SS + 256); LAS bf16* Qb = Kb + 64 * 136; LAS float* QKm = (LAS float*)(Qb + 64 * 136); LAS float* XL = QKm + 64 * 65;
    for (int item = bid; item < 1024; item += G) {
        int tid = tid0; asm volatile("" : "+v"(tid));
        const int lane = tid & 63, r = lane & 31, hp = lane >> 5, wave = tid >> 6;
        const int b = item >> 8, n = (item >> 3) & 31, h = item & 7;
        const int row0 = b * 2048 + n * 64;
        __syncthreads();
        float qv[16], kv[16];
        { const int d = tid & 127, tg = tid >> 7, t0 = 16 * tg;
          const bool first = (n == 0 && tg == 0);
#pragma unroll
          for (int part = 0; part < 3; ++part) { const int c = part * 1024 + h * 128 + d;
              const float w0 = cw[c], w1 = cw[3072 + c], w2 = cw[2 * 3072 + c], w3 = cw[3 * 3072 + c];
              const bf16* up = U + (size_t)(row0 + t0) * NAB + c;
              const long fo = first ? 0 : (long)NAB;
              float x0 = bf2f(up[-3 * fo]), x1 = bf2f(up[-2 * fo]), x2 = bf2f(up[-1 * fo]); if (first) { x0 = 0.f; x1 = 0.f; x2 = 0.f; }
#pragma unroll
              for (int t = 0; t < 16; ++t) { const float x3 = bf2f(up[(size_t)t * NAB]); const float y = silu_(w0 * x0 + w1 * x1 + w2 * x2 + w3 * x3); x0 = x1; x1 = x2; x2 = x3;
                  if (part == 0) qv[t] = y; else if (part == 1) kv[t] = y; else XL[(t0 + t) * 257 + d] = y; } }
          const int half = (tid >> 6) & 1;
#pragma unroll
          for (int t = 0; t < 16; ++t) { const float sq = wave_sum(qv[t] * qv[t]), sk = wave_sum(kv[t] * kv[t]); if (lane == 0) { SS[half * 64 + t0 + t] = sq; SS[(2 + half) * 64 + t0 + t] = sk; } } }
        if (wave == 0) { const size_t ro = (size_t)(row0 + lane) * NAB;
            float gv = -__expf(kp.in(15)[j * 8 + h]) * softplus_(bf2f(U[ro + 7176 + h]) + kp.in(16)[j * 8 + h]);
#pragma unroll
            for (int o = 1; o < 64; o <<= 1) { const float tt = __shfl_up(gv, o); if (lane >= o) gv += tt; }
            GLs[lane] = gv; BLs[lane] = sigmoid_(bf2f(U[ro + 7168 + h])); }
        __syncthreads();
        { const int d = tid & 127, t0 = 16 * (tid >> 7);
#pragma unroll
          for (int t = 0; t < 16; ++t) { const float scq = rsqrtf(SS[t0 + t] + SS[64 + t0 + t] + 1e-6f) * 0.08838834764831845f, sck = rsqrtf(SS[128 + t0 + t] + SS[192 + t0 + t] + 1e-6f);
              Qb[(t0 + t) * 136 + d] = (bf16)f2bf(qv[t] * scq); Kb[(t0 + t) * 136 + d] = (bf16)f2bf(kv[t] * sck); } }
        __syncthreads();
        bf16x8* base = (bf16x8*)(OPS + (size_t)item * DN_ITEM_BYTES);
        { const int which = wave >> 2, mt = (wave >> 1) & 1, nt = wave & 1;
          const LAS bf16* Asrc = which ? Qb : Kb;
          f32x16 acc;
#pragma unroll
          for (int i = 0; i < 16; ++i) acc[i] = 0.f;
#pragma unroll
          for (int ks = 0; ks < 8; ++ks) acc = MFMA32(*(const LAS bf16x8*)(Asrc + (32 * mt + r) * 136 + 16 * ks + 8 * hp), *(const LAS bf16x8*)(Kb + (32 * nt + r) * 136 + 16 * ks + 8 * hp), acc);
          const int jt = 32 * nt + r; const float gj = GLs[jt];
#pragma unroll
          for (int i16 = 0; i16 < 16; ++i16) { const int i = 32 * mt + crow(i16, hp); const float dec = __expf(GLs[i] - gj);
              if (which == 0) AMT[jt * 68 + i] = jt < i ? BLs[i] * acc[i16] * dec : 0.f; else QKm[i * 65 + jt] = jt <= i ? acc[i16] * dec : 0.f; } }
        __syncthreads();
        if (tid < 256) {
            const int c = tid;
#pragma unroll
            for (int bi = 0; bi < 4; ++bi) {
                float acc[16];
#pragma unroll
                for (int ii = 0; ii < 16; ++ii) { const int i = 16 * bi + ii; const float be = BLs[i];
                    acc[ii] = c < 128 ? be * XL[i * 257 + c] : be * __expf(GLs[i]) * bf2f(Kb[i * 136 + (c - 128)]); }
                for (int jj = 0; jj < 16 * bi; ++jj) { const float xj = XL[jj * 257 + c];
#pragma unroll
                    for (int q = 0; q < 4; ++q) { const f32x4 a = *(const LAS f32x4*)(AMT + jj * 68 + 16 * bi + 4 * q);
                        acc[4 * q + 0] -= a[0] * xj; acc[4 * q + 1] -= a[1] * xj; acc[4 * q + 2] -= a[2] * xj; acc[4 * q + 3] -= a[3] * xj; } }
#pragma unroll
                for (int ii = 0; ii < 16; ++ii) { float x = acc[ii];
#pragma unroll
                    for (int jj = 0; jj < ii; ++jj) x -= AMT[(16 * bi + jj) * 68 + 16 * bi + ii] * acc[jj];
                    acc[ii] = x; XL[(16 * bi + ii) * 257 + c] = x; }
            }
        } else {
            const int w4 = wave - 4; float v[8];
#pragma unroll
            for (int q = 0; q < 4; ++q) { const int f = w4 + 4 * q;
                { const int mt = f >> 3, ks = f & 7, i = 32 * mt + r; const float eg = __expf(GLs[i]);
                  const bf16x8 qq = *(const LAS bf16x8*)(Qb + i * 136 + 16 * ks + 8 * hp);
#pragma unroll
                  for (int jp = 0; jp < 8; ++jp) v[jp] = bf2f(Qb[i * 136 + 16 * ks + 8 * (jp >> 2) + 4 * hp + (jp & 3)]) * eg;
                  (void)qq; base[(16 + f) * 64 + lane] = pack8(v); }
                { const int mt = f >> 2, ks = f & 3, d = 32 * mt + r; const float Gend = GLs[63];
#pragma unroll
                  for (int jp = 0; jp < 8; ++jp) { const int tk = 16 * ks + 8 * (jp >> 2) + 4 * hp + (jp & 3); v[jp] = bf2f(Kb[tk * 136 + d]) * __expf(Gend - GLs[tk]); }
                  base[(32 + f) * 64 + lane] = pack8(v); } }
#pragma unroll
            for (int q = 0; q < 2; ++q) { const int f = w4 + 4 * q, mt = f >> 2, ks = f & 3, i = 32 * mt + r;
#pragma unroll
                for (int jp = 0; jp < 8; ++jp) v[jp] = QKm[i * 65 + 16 * ks + 8 * (jp >> 2) + 4 * hp + (jp & 3)];
                base[(48 + f) * 64 + lane] = pack8(v); }
            if (tid == 256) *(float*)(base + 72 * 64) = __expf(GLs[63]);
        }
        __syncthreads();
        float v[8];
#pragma unroll
        for (int q = 0; q < 2; ++q) { const int f = wave + 8 * q;
            { const int mt = f >> 3, ks = f & 7, i = 32 * mt + r;
#pragma unroll
              for (int jp = 0; jp < 8; ++jp) v[jp] = -XL[i * 257 + 128 + 16 * ks + 8 * (jp >> 2) + 4 * hp + (jp & 3)];
              base[f * 64 + lane] = pack8(v); }
            { const int pq = f & 1, tl = f >> 1, mt = tl >> 2, nt = tl & 3;
#pragma unroll
              for (int e = 0; e < 8; ++e) v[e] = XL[(32 * mt + crow(8 * pq + e, hp)) * 257 + 32 * nt + r];
              base[(56 + f) * 64 + lane] = pack8(v); } }
    }
}

__device__ __forceinline__ void phase_ab_rec(const KP kp, const int bid, const int G, int j, int li, LAS unsigned char* lds, int tid0) {
    unsigned char* scr = kp.ws() + WS_SCR; const bf16* U = (const bf16*)(kp.ws() + WS_U);
    float* ODN = (float*)(scr + SC_ODN); float* OGLA = (float*)(scr + SC_OGLA);
    SEC_BEGIN(12)
    for (int item = bid; item < 64; item += G) {
        int tid = tid0; asm volatile("" : "+v"(tid));
        int s, h; bool isdn; int half = -1;
        if (item < 32) { isdn = false; s = item >> 3; h = (item >> 1) & 3; half = item & 1; }
        else if (item < 64) { isdn = true; s = (item - 32) >> 3; h = (item - 32) & 7; half = -2; }
        else if (item < 1088) { isdn = true; s = 4 + ((item - 64) >> 3); h = (item - 64) & 7; }
        else { isdn = false; s = 4 + ((item - 1088) >> 2); h = (item - 1088) & 3; }
        int row0, L; seq_info(s, row0, L);
        __syncthreads();
        if (half == -2) {
            const int wave = __builtin_amdgcn_readfirstlane(tid >> 6), lane = tid & 63, r = lane & 31, hp = lane >> 5;
            const int b = s, nt = wave;
            const unsigned char* OPS = scr + SC_DNOPS;
            constexpr int DBUF = 73 * 1024;
#define DN_DMA(n_, bufi_) do { const unsigned char* gi_ = OPS + (size_t)((b * 32 + (n_)) * 8 + h) * DN_ITEM_BYTES + lane * 16; \
                _Pragma("unroll") for (int q_ = 0; q_ < 10; ++q_) { const int lf_ = wave + 8 * q_; if (lf_ < 73) \
                    __builtin_amdgcn_global_load_lds((const unsigned*)(gi_ + lf_ * 1024), (LAS unsigned*)(lds + (bufi_) * DBUF + lf_ * 1024), 16, 0, 0); } } while (0)
            f32x16 S0, S1, S2, S3;
#pragma unroll
            for (int i = 0; i < 16; ++i) { S0[i] = 0.f; S1[i] = 0.f; S2[i] = 0.f; S3[i] = 0.f; }
            DN_DMA(0, 0);
            asm volatile("s_waitcnt vmcnt(0)" ::: "memory"); __syncthreads();
            for (int n = 0; n < 32; ++n) {
                if (n + 1 < 32) DN_DMA(n + 1, (n + 1) & 1);
                if (wave < 4) {
                    const LAS bf16x8* F = (const LAS bf16x8*)(lds + (n & 1) * DBUF) + lane;
                    const float gend = *(const LAS float*)(lds + (n & 1) * DBUF + 72 * 1024);
                    const bf16x8 sb0 = PACK_ACC(S0, 0), sb1 = PACK_ACC(S0, 1), sb2 = PACK_ACC(S1, 0), sb3 = PACK_ACC(S1, 1), sb4 = PACK_ACC(S2, 0), sb5 = PACK_ACC(S2, 1), sb6 = PACK_ACC(S3, 0), sb7 = PACK_ACC(S3, 1);
                    f32x16 U0t, U1t;
                    { const bf16x8 a0 = F[(56 + nt * 2 + 0) * 64], a1 = F[(56 + nt * 2 + 1) * 64], c0 = F[(56 + (4 + nt) * 2 + 0) * 64], c1 = F[(56 + (4 + nt) * 2 + 1) * 64];
#pragma unroll
                      for (int e = 0; e < 8; ++e) { U0t[e] = bf2f((bf16)a0[e]); U0t[8 + e] = bf2f((bf16)a1[e]); U1t[e] = bf2f((bf16)c0[e]); U1t[8 + e] = bf2f((bf16)c1[e]); } }
                    U0t = MFMA32(F[0 * 64], sb0, U0t); U0t = MFMA32(F[1 * 64], sb1, U0t); U0t = MFMA32(F[2 * 64], sb2, U0t); U0t = MFMA32(F[3 * 64], sb3, U0t);
                    U0t = MFMA32(F[4 * 64], sb4, U0t); U0t = MFMA32(F[5 * 64], sb5, U0t); U0t = MFMA32(F[6 * 64], sb6, U0t); U0t = MFMA32(F[7 * 64], sb7, U0t);
                    U1t = MFMA32(F[8 * 64], sb0, U1t); U1t = MFMA32(F[9 * 64], sb1, U1t); U1t = MFMA32(F[10 * 64], sb2, U1t); U1t = MFMA32(F[11 * 64], sb3, U1t);
                    U1t = MFMA32(F[12 * 64], sb4, U1t); U1t = MFMA32(F[13 * 64], sb5, U1t); U1t = MFMA32(F[14 * 64], sb6, U1t); U1t = MFMA32(F[15 * 64], sb7, U1t);
                    const bf16x8 ub0 = PACK_ACC(U0t, 0), ub1 = PACK_ACC(U0t, 1), ub2 = PACK_ACC(U1t, 0), ub3 = PACK_ACC(U1t, 1);
                    f32x16 O0, O1;
#pragma unroll
                    for (int i = 0; i < 16; ++i) { O0[i] = 0.f; O1[i] = 0.f; }
                    O0 = MFMA32(F[16 * 64], sb0, O0); O0 = MFMA32(F[17 * 64], sb1, O0); O0 = MFMA32(F[18 * 64], sb2, O0); O0 = MFMA32(F[19 * 64], sb3, O0);
                    O0 = MFMA32(F[20 * 64], sb4, O0); O0 = MFMA32(F[21 * 64], sb5, O0); O0 = MFMA32(F[22 * 64], sb6, O0); O0 = MFMA32(F[23 * 64], sb7, O0);
                    O1 = MFMA32(F[24 * 64], sb0, O1); O1 = MFMA32(F[25 * 64], sb1, O1); O1 = MFMA32(F[26 * 64], sb2, O1); O1 = MFMA32(F[27 * 64], sb3, O1);
                    O1 = MFMA32(F[28 * 64], sb4, O1); O1 = MFMA32(F[29 * 64], sb5, O1); O1 = MFMA32(F[30 * 64], sb6, O1); O1 = MFMA32(F[31 * 64], sb7, O1);
                    O0 = MFMA32(F[48 * 64], ub0, O0); O0 = MFMA32(F[49 * 64], ub1, O0);
                    O1 = MFMA32(F[52 * 64], ub0, O1); O1 = MFMA32(F[53 * 64], ub1, O1); O1 = MFMA32(F[54 * 64], ub2, O1); O1 = MFMA32(F[55 * 64], ub3, O1);
#pragma unroll
                    for (int i = 0; i < 16; ++i) { S0[i] *= gend; S1[i] *= gend; S2[i] *= gend; S3[i] *= gend; }
                    S0 = MFMA32(F[32 * 64], ub0, S0); S0 = MFMA32(F[33 * 64], ub1, S0); S0 = MFMA32(F[34 * 64], ub2, S0); S0 = MFMA32(F[35 * 64], ub3, S0);
                    S1 = MFMA32(F[36 * 64], ub0, S1); S1 = MFMA32(F[37 * 64], ub1, S1); S1 = MFMA32(F[38 * 64], ub2, S1); S1 = MFMA32(F[39 * 64], ub3, S1);
                    S2 = MFMA32(F[40 * 64], ub0, S2); S2 = MFMA32(F[41 * 64], ub1, S2); S2 = MFMA32(F[42 * 64], ub2, S2); S2 = MFMA32(F[43 * 64], ub3, S2);
                    S3 = MFMA32(F[44 * 64], ub0, S3); S3 = MFMA32(F[45 * 64], ub1, S3); S3 = MFMA32(F[46 * 64], ub2, S3); S3 = MFMA32(F[47 * 64], ub3, S3);
                    float* yo = ODN + (size_t)(b * 2048 + n * 64) * 1024 + h * 128 + 32 * nt + r;
#pragma unroll
                    for (int i = 0; i < 16; ++i) { yo[(size_t)crow(i, hp) * 1024] = O0[i]; yo[(size_t)(32 + crow(i, hp)) * 1024] = O1[i]; }
                }
                asm volatile("s_waitcnt vmcnt(0)" ::: "memory"); __syncthreads();
            }
#undef DN_DMA
            if (wave < 4) {
                float* dst = kp.out() + O_DN_P + ((size_t)j * 4 + b) * ((size_t)8 * 128 * 128) + (size_t)h * 128 * 128 + 32 * nt + r;
#pragma unroll
                for (int i = 0; i < 16; ++i) { dst[(size_t)crow(i, hp) * 128] = S0[i]; dst[(size_t)(32 + crow(i, hp)) * 128] = S1[i]; dst[(size_t)(64 + crow(i, hp)) * 128] = S2[i]; dst[(size_t)(96 + crow(i, hp)) * 128] = S3[i]; }
            }
        } else if (half >= 0) {
            const int wave = __builtin_amdgcn_readfirstlane(tid >> 6), lane = tid & 63, r = lane & 31, hp = lane >> 5;
            const int b = s, nt = half * 4 + wave;
            const unsigned char* OPS = kp.ws() + WS_GLAOPS;
            constexpr int GBUF = 57 * 1024;
#define GLA_DMA(n_, bufi_) do { const unsigned char* gi_ = OPS + (size_t)((b * 32 + (n_)) * 4 + h) * GLA_ITEM_BYTES + lane * 16; \
                _Pragma("unroll") for (int q_ = 0; q_ < 8; ++q_) { const int lf_ = wave + 8 * q_; if (lf_ < 57) { const int gf_ = lf_ < 40 ? lf_ : (lf_ < 56 ? lf_ + half * 16 : 72); \
                    __builtin_amdgcn_global_load_lds((const unsigned*)(gi_ + gf_ * 1024), (LAS unsigned*)(lds + (bufi_) * GBUF + lf_ * 1024), 16, 0, 0); } } } while (0)
            f32x16 S0, S1, S2, S3;
#pragma unroll
            for (int i = 0; i < 16; ++i) { S0[i] = 0.f; S1[i] = 0.f; S2[i] = 0.f; S3[i] = 0.f; }
            GLA_DMA(0, 0);
            asm volatile("s_waitcnt vmcnt(0)" ::: "memory"); __syncthreads();
            for (int n = 0; n < 32; ++n) {
                if (n + 1 < 32) GLA_DMA(n + 1, (n + 1) & 1);
                if (wave < 4) {
                    const LAS bf16x8* F = (const LAS bf16x8*)(lds + (n & 1) * GBUF) + lane;
                    const LAS float* ge = (const LAS float*)(lds + (n & 1) * GBUF + 56 * 1024) + 4 * hp;
                    const bf16x8 sb0 = PACK_ACC(S0, 0), sb1 = PACK_ACC(S0, 1), sb2 = PACK_ACC(S1, 0), sb3 = PACK_ACC(S1, 1), sb4 = PACK_ACC(S2, 0), sb5 = PACK_ACC(S2, 1), sb6 = PACK_ACC(S3, 0), sb7 = PACK_ACC(S3, 1);
                    f32x16 O0, O1;
#pragma unroll
                    for (int i = 0; i < 16; ++i) { O0[i] = 0.f; O1[i] = 0.f; }
                    O0 = MFMA32(F[0 * 64], sb0, O0); O0 = MFMA32(F[1 * 64], sb1, O0); O0 = MFMA32(F[2 * 64], sb2, O0); O0 = MFMA32(F[3 * 64], sb3, O0);
                    O0 = MFMA32(F[4 * 64], sb4, O0); O0 = MFMA32(F[5 * 64], sb5, O0); O0 = MFMA32(F[6 * 64], sb6, O0); O0 = MFMA32(F[7 * 64], sb7, O0);
                    O1 = MFMA32(F[8 * 64], sb0, O1); O1 = MFMA32(F[9 * 64], sb1, O1); O1 = MFMA32(F[10 * 64], sb2, O1); O1 = MFMA32(F[11 * 64], sb3, O1);
                    O1 = MFMA32(F[12 * 64], sb4, O1); O1 = MFMA32(F[13 * 64], sb5, O1); O1 = MFMA32(F[14 * 64], sb6, O1); O1 = MFMA32(F[15 * 64], sb7, O1);
                    bf16x8 vb[4];
#pragma unroll
                    for (int ks = 0; ks < 4; ++ks) vb[ks] = F[(40 + wave * 4 + ks) * 64];
                    O0 = MFMA32(F[32 * 64], vb[0], O0); O0 = MFMA32(F[33 * 64], vb[1], O0);
#pragma unroll
                    for (int ks = 0; ks < 4; ++ks) O1 = MFMA32(F[(36 + ks) * 64], vb[ks], O1);
#pragma unroll
                    for (int q = 0; q < 4; ++q) { const f32x4 g0 = *(const LAS f32x4*)(ge + 8 * q), g1 = *(const LAS f32x4*)(ge + 32 + 8 * q), g2 = *(const LAS f32x4*)(ge + 64 + 8 * q), g3 = *(const LAS f32x4*)(ge + 96 + 8 * q);
#pragma unroll
                        for (int c = 0; c < 4; ++c) { S0[4 * q + c] *= g0[c]; S1[4 * q + c] *= g1[c]; S2[4 * q + c] *= g2[c]; S3[4 * q + c] *= g3[c]; } }
#pragma unroll
                    for (int ks = 0; ks < 4; ++ks) { S0 = MFMA32(F[(16 + ks) * 64], vb[ks], S0); S1 = MFMA32(F[(20 + ks) * 64], vb[ks], S1); S2 = MFMA32(F[(24 + ks) * 64], vb[ks], S2); S3 = MFMA32(F[(28 + ks) * 64], vb[ks], S3); }
                    float* yo = OGLA + (size_t)(b * 2048 + n * 64) * 1024 + h * 256 + 32 * nt + r;
#pragma unroll
                    for (int i = 0; i < 16; ++i) { yo[(size_t)crow(i, hp) * 1024] = O0[i]; yo[(size_t)(32 + crow(i, hp)) * 1024] = O1[i]; }
                }
                asm volatile("s_waitcnt vmcnt(0)" ::: "memory"); __syncthreads();
            }
#undef GLA_DMA
            if (wave < 4) {
                float* dst = kp.out() + O_GLA_P + ((size_t)j * 4 + b) * ((size_t)4 * 128 * 256) + (size_t)h * 128 * 256 + 32 * nt + r;
#pragma unroll
                for (int i = 0; i < 16; ++i) { dst[(size_t)crow(i, hp) * 256] = S0[i]; dst[(size_t)(32 + crow(i, hp)) * 256] = S1[i]; dst[(size_t)(64 + crow(i, hp)) * 256] = S2[i]; dst[(size_t)(96 + crow(i, hp)) * 256] = S3[i]; }
            }
        } else
        {}
    }
    SEC_END(12, lds)
    SEC_BEGIN(13)
    unsigned* qhead = (unsigned*)(kp.ws() + WS_CTL) + CW_CNT + 64 * li;
    volatile LAS unsigned* qslot = (volatile LAS unsigned*)(lds + LDS_BYTES - 8);
    const float* cw = kp.in(14) + (size_t)j * 4 * 3072; const float* stc = kp.in(3) + (size_t)j * 128 * 3 * 3072;
    const float* wa2 = kp.in(18) + (size_t)j * 16 * 512; const float* ba = kp.in(19) + (size_t)j * 512;
    for (;;) {
        __syncthreads();
        if (tid0 == 0) qslot[0] = __hip_atomic_fetch_add(qhead, 1u, __ATOMIC_RELAXED, __HIP_MEMORY_SCOPE_AGENT);
        __syncthreads();
        const int it = (int)qslot[0];
        if (it >= 1536) break;
        int tid = tid0; asm volatile("" : "+v"(tid));
        const int wave = tid >> 6, lane = tid & 63;
        if (it < 1024) {
            const int bs = it >> 3, h = it & 7, sq = 4 + bs, r0 = TP + bs * 4;
            LAS float* qL = (LAS float*)lds; LAS float* kL = qL + 512; LAS float* vL = kL + 512; LAS float* red = vL + 512; LAS float* sm = red + 4096;
            const int e = tid & 127, dq = tid >> 7;
            const size_t SZ = (size_t)8 * 128 * 128;
            const float* st = kp.in(2) + ((size_t)j * 128 + bs) * SZ + (size_t)h * 16384;
            float S[32];
            { const float* sp = st + (size_t)(dq * 32) * 128 + e;
#pragma unroll
              for (int i = 0; i < 32; ++i) { S[i] = *sp; sp += 128; asm volatile("" : "+v"(sp)); } }
#pragma unroll
            for (int part = 0; part < 3; ++part) { const int c = part * 1024 + h * 128 + e; float acc = 0.f;
#pragma unroll
                for (int tap = 0; tap < 4; ++tap) acc += cw[tap * 3072 + c] * pre_val(U, NAB, c, r0, dq - 3 + tap, sq, stc, 3072, c);
                (part == 0 ? qL : (part == 1 ? kL : vL))[dq * 128 + e] = silu_(acc); }
            if (tid < 4) { const size_t ro = (size_t)(r0 + tid) * NAB;
                sm[32 + tid] = -__expf(kp.in(15)[j * 8 + h]) * softplus_(bf2f(U[ro + 7176 + h]) + kp.in(16)[j * 8 + h]); sm[36 + tid] = sigmoid_(bf2f(U[ro + 7168 + h])); }
            __syncthreads();
            { const int tk = wave & 3; LAS float* src = (wave >> 2) ? kL : qL; const float a = src[tk * 128 + lane], b = src[tk * 128 + lane + 64];
              const float sc = rsqrtf(wave_sum(a * a + b * b) + 1e-6f) * ((wave >> 2) ? 1.f : 0.08838834764831845f); src[tk * 128 + lane] = a * sc; src[tk * 128 + lane + 64] = b * sc; }
            __syncthreads();
#pragma unroll
            for (int q = 0; q < 4; ++q) { const int idx = wave * 4 + q, i = (idx >> 2) & 3, jj = idx & 3; const LAS float* src = idx < 16 ? kL : qL;
                const float dot = wave_sum(src[i * 128 + lane] * kL[jj * 128 + lane] + src[i * 128 + lane + 64] * kL[jj * 128 + lane + 64]); if (lane == 0) sm[idx] = dot; }
            float ks[4] = {0.f, 0.f, 0.f, 0.f}, qs[4] = {0.f, 0.f, 0.f, 0.f};
#pragma unroll
            for (int i = 0; i < 32; ++i) { const int d = dq * 32 + i; const float sv = S[i];
#pragma unroll
                for (int t = 0; t < 4; ++t) { ks[t] += kL[t * 128 + d] * sv; qs[t] += qL[t * 128 + d] * sv; } }
#pragma unroll
            for (int t = 0; t < 4; ++t) { red[(t * 4 + dq) * 128 + e] = ks[t]; red[((4 + t) * 4 + dq) * 128 + e] = qs[t]; }
            __syncthreads();
            float Gc[4]; Gc[0] = sm[32]; Gc[1] = Gc[0] + sm[33]; Gc[2] = Gc[1] + sm[34]; Gc[3] = Gc[2] + sm[35];
            float u[4];
#pragma unroll
            for (int i = 0; i < 4; ++i) { const float KSi = (red[(i * 4 + 0) * 128 + e] + red[(i * 4 + 1) * 128 + e]) + (red[(i * 4 + 2) * 128 + e] + red[(i * 4 + 3) * 128 + e]);
                float acc = vL[i * 128 + e] - __expf(Gc[i]) * KSi;
#pragma unroll
                for (int jj = 0; jj < i; ++jj) acc -= sm[i * 4 + jj] * __expf(Gc[i] - Gc[jj]) * u[jj];
                u[i] = sm[36 + i] * acc; }
            if (dq == 0) {
#pragma unroll
                for (int i = 0; i < 4; ++i) { const float QSi = (red[((4 + i) * 4 + 0) * 128 + e] + red[((4 + i) * 4 + 1) * 128 + e]) + (red[((4 + i) * 4 + 2) * 128 + e] + red[((4 + i) * 4 + 3) * 128 + e]);
                    float o = __expf(Gc[i]) * QSi;
#pragma unroll
                    for (int jj = 0; jj <= i; ++jj) o += sm[16 + i * 4 + jj] * __expf(Gc[i] - Gc[jj]) * u[jj];
                    ODN[(size_t)(r0 + i) * 1024 + h * 128 + e] = o; } }
            const float eg = __expf(Gc[3]); float w[4];
#pragma unroll
            for (int jj = 0; jj < 4; ++jj) w[jj] = __expf(Gc[3] - Gc[jj]) * u[jj];
            float* dst = kp.out() + O_DN_S + ((size_t)j * 128 + bs) * SZ + (size_t)h * 16384 + (size_t)(dq * 32) * 128 + e;
#pragma unroll
            for (int i = 0; i < 32; ++i) { const int d = dq * 32 + i; float sv = eg * S[i];
#pragma unroll
                for (int jj = 0; jj < 4; ++jj) sv += kL[jj * 128 + d] * w[jj];
                *dst = sv; dst += 128; asm volatile("" : "+v"(dst)); }
        } else {
            const int q_ = it - 1024, bs = q_ >> 2, h = q_ & 3, r0 = TP + bs * 4;
            LAS float* qgL = (LAS float*)lds; LAS float* kaL = qgL + 512; LAS float* glL = kaL + 512; LAS float* egL = glL + 512; LAS float* Am = egL + 128; LAS float* red = Am + 16;
            const int e = tid & 255, dh = tid >> 8;
            const size_t SZ = (size_t)4 * 128 * 256;
            const float* st = kp.in(4) + ((size_t)j * 128 + bs) * SZ + (size_t)h * 32768;
            float S[64];
            { const float* sp = st + (size_t)(dh * 64) * 256 + e;
#pragma unroll
              for (int i = 0; i < 64; ++i) { S[i] = *sp; sp += 256; asm volatile("" : "+v"(sp)); } }
            float v[4];
#pragma unroll
            for (int t = 0; t < 4; ++t) v[t] = bf2f(U[(size_t)(r0 + t) * NAB + 5120 + h * 256 + e]);
            { const int d = tid & 127, tk = tid >> 7; const size_t ro = (size_t)(r0 + tk) * NAB;
              qgL[tk * 128 + d] = bf2f(U[ro + 4096 + h * 128 + d]) * 0.08838834764831845f; kaL[tk * 128 + d] = bf2f(U[ro + 4608 + h * 128 + d]);
              float x = ba[h * 128 + d];
#pragma unroll
              for (int rr = 0; rr < 16; ++rr) x += bf2f(U[ro + 7184 + rr]) * wa2[rr * 512 + h * 128 + d];
              glL[tk * 128 + d] = -softplus_(-x) * (1.f / 16.f); }
            __syncthreads();
            if (tid < 128) { float Gq = 0.f;
#pragma unroll
                for (int t = 0; t < 4; ++t) { Gq += glL[t * 128 + tid]; qgL[t * 128 + tid] *= __expf(Gq); kaL[t * 128 + tid] *= __expf(-Gq); }
                egL[tid] = __expf(Gq); }
            __syncthreads();
#pragma unroll
            for (int q = 0; q < 2; ++q) { const int idx = wave * 2 + q, i = idx >> 2, jj = idx & 3;
                const float dot = wave_sum(qgL[i * 128 + lane] * kaL[jj * 128 + lane] + qgL[i * 128 + lane + 64] * kaL[jj * 128 + lane + 64]); if (lane == 0) Am[idx] = dot; }
            float o[4] = {0.f, 0.f, 0.f, 0.f};
            float* dst = kp.out() + O_GLA_S + ((size_t)j * 128 + bs) * SZ + (size_t)h * 32768 + (size_t)(dh * 64) * 256 + e;
#pragma unroll
            for (int i = 0; i < 64; ++i) { const int d = dh * 64 + i; const float s0 = S[i]; float acc = s0;
#pragma unroll
                for (int t = 0; t < 4; ++t) { o[t] += qgL[t * 128 + d] * s0; acc += kaL[t * 128 + d] * v[t]; }
                *dst = egL[d] * acc; dst += 256; asm volatile("" : "+v"(dst)); }
#pragma unroll
            for (int t = 0; t < 4; ++t) red[(dh * 4 + t) * 256 + e] = o[t];
            __syncthreads();
            if (dh == 0) {
#pragma unroll
                for (int t = 0; t < 4; ++t) { float oo = red[t * 256 + e] + red[(4 + t) * 256 + e];
#pragma unroll
                    for (int jj = 0; jj <= t; ++jj) oo += Am[t * 4 + jj] * v[jj];
                    OGLA[(size_t)(r0 + t) * 1024 + h * 256 + e] = oo; } }
        }
    }
    SEC_END(13, lds)
}

__device__ __forceinline__ void phase_ab_post(const KP kp, const int bid, const int G, int j, int tid, int wave, int lane) {
    unsigned char* scr = kp.ws() + WS_SCR; const bf16* U = (const bf16*)(kp.ws() + WS_U); bf16* YM = (bf16*)(kp.ws() + WS_YM);
    const float* ODN = (const float*)(scr + SC_ODN); const float* OGLA = (const float*)(scr + SC_OGLA);
    const float* dnn = kp.in(17) + (size_t)j * 128; const float* glan = kp.in(20) + (size_t)j * 256;
    typedef float f32x2v __attribute__((ext_vector_type(2)));
    const f32x2v dg = *(const f32x2v*)(dnn + 2 * lane); const f32x4 gg = *(const f32x4*)(glan + 4 * lane);
    for (int r = bid * NWAVES + wave; r < T; r += G * NWAVES) {
        int s, t; row_to_seq(r, s, t); int row0, L; seq_info(s, row0, L);
        const bf16* ur = U + (size_t)r * NAB; bf16* yr = YM + (size_t)r * DM;
        f32x2v od[8]; unsigned zd[8]; f32x4 og[4]; u32x2 zg[4];
#pragma unroll
        for (int hh = 0; hh < 8; ++hh) { od[hh] = *(const f32x2v*)(ODN + (size_t)r * 1024 + hh * 128 + 2 * lane); zd[hh] = *(const unsigned*)(ur + 3072 + hh * 128 + 2 * lane); }
#pragma unroll
        for (int hh = 0; hh < 4; ++hh) { og[hh] = *(const f32x4*)(OGLA + (size_t)r * 1024 + hh * 256 + 4 * lane); zg[hh] = *(const u32x2*)(ur + 6144 + hh * 256 + 4 * lane); }
#pragma unroll
        for (int hh = 0; hh < 8; ++hh) { const f32x2v o = od[hh];
            const float rstd = rsqrtf(wave_sum(o.x * o.x + o.y * o.y) * (1.f / 128.f) + 1e-6f);
            const unsigned zz = zd[hh];
            *(unsigned*)(yr + hh * 128 + 2 * lane) = pk2(o.x * rstd * dg.x * silu_(__uint_as_float(zz << 16)), o.y * rstd * dg.y * silu_(__uint_as_float(zz & 0xffff0000u))); }
#pragma unroll
        for (int hh = 0; hh < 4; ++hh) { const f32x4 o = og[hh];
            const float rstd = rsqrtf(wave_sum((o.x * o.x + o.y * o.y) + (o.z * o.z + o.w * o.w)) * (1.f / 256.f) + 1e-6f);
            const u32x2 zz = zg[hh];
            u32x2 w; w.x = pk2(o.x * rstd * gg.x * silu_(__uint_as_float(zz.x << 16)), o.y * rstd * gg.y * silu_(__uint_as_float(zz.x & 0xffff0000u)));
            w.y = pk2(o.z * rstd * gg.z * silu_(__uint_as_float(zz.y << 16)), o.w * rstd * gg.w * silu_(__uint_as_float(zz.y & 0xffff0000u)));
            *(u32x2*)(yr + 1024 + hh * 256 + 4 * lane) = w; }
        if (t >= L - 3) { const int rr = t - (L - 3);
            float* dst = s < 4 ? kp.out() + O_DNC_P + (((size_t)j * 4 + s) * 3 + rr) * 3072 : kp.out() + O_DNC_S + (((size_t)j * 128 + (s - 4)) * 3 + rr) * 3072;
            for (int c = 2 * lane; c < 3072; c += 128) { const unsigned uu = *(const unsigned*)(ur + c); *(f32x2v*)(dst + c) = (f32x2v){__uint_as_float(uu << 16), __uint_as_float(uu & 0xffff0000u)}; } }
    }
}

__device__ __forceinline__ void phase_cd_pre(const KP kp, const int bid, const int G, int j, LAS unsigned char* lds, int tid) {
    unsigned char* scr = kp.ws() + WS_SCR; const bf16* U = (const bf16*)(kp.ws() + WS_U);
    float* XBC = (float*)(scr + SC_XBC) - (size_t)TP * 1536; float* DT = (float*)(scr + SC_DT) - (size_t)TP * 16; bf16* XS = (bf16*)(scr + SC_XS);
    const float* cw = kp.in(23) + (size_t)j * 4 * 1536; const float* cb = kp.in(24) + (size_t)j * 1536; const float* stc = kp.in(6) + (size_t)j * 128 * 3 * 1536;
    for (int r = TP + bid; r < T; r += G) {
        int s, t; row_to_seq(r, s, t); const int row0 = r - t;
#pragma unroll
        for (int i = 0; i < 3; ++i) { const int c = tid + NTHR * i; float acc = cb[c];
#pragma unroll
            for (int tap = 0; tap < 4; ++tap) acc += cw[tap * 1536 + c] * pre_val(U, NCD, 1024 + c, row0, t - 3 + tap, s, stc, 1536, c);
            const float v = silu_(acc); XBC[(size_t)r * 1536 + c] = v; if (c < 1024) XS[(size_t)r * 1024 + c] = (bf16)f2bf(v); }
        if (tid < 16) DT[(size_t)r * 16 + tid] = softplus_(bf2f(U[(size_t)r * NCD + 4608 + tid]) + kp.in(26)[j * 16 + tid]);
    }
}

__device__ __forceinline__ void phase_lru_gates(const KP kp, const int bid, const int G, int j, LAS unsigned char* lds, int tid0) {
    unsigned char* scr = kp.ws() + WS_SCR; const bf16* U = (const bf16*)(kp.ws() + WS_U);
    float* LA = (float*)(scr + SC_LA); float* LB = (float*)(scr + SC_LB);
    const float* lcw = kp.in(29) + (size_t)j * 4 * 1024; const float* lcb = kp.in(30) + (size_t)j * 1024; const float* lstc = kp.in(8) + (size_t)j * 128 * 3 * 1024;
    const int n = bid & 15;
    const float* wa = kp.in(31) + ((size_t)j * 16 + n) * 4096; const float* wx = kp.in(33) + ((size_t)j * 16 + n) * 4096;
    const float* lba = kp.in(32) + (size_t)j * 1024; const float* lbx = kp.in(34) + (size_t)j * 1024; const float* lam = kp.in(35) + (size_t)j * 1024;
    LAS bf16x8* WF = (LAS bf16x8*)lds;
    LAS float* xcL = (LAS float*)(lds + 16384);
    LAS float* igL = xcL + 64 * 68;
    __syncthreads();
    { const int lane = tid0 & 63, f = tid0 >> 6, r = lane & 31, hp = lane >> 5, nt = f >> 2, ks = f & 3; float v[8];
#pragma unroll
      for (int jp = 0; jp < 8; ++jp) v[jp] = wa[(16 * ks + 8 * hp + jp) * 64 + 32 * nt + r];
      WF[f * 64 + lane] = pack8(v);
#pragma unroll
      for (int jp = 0; jp < 8; ++jp) v[jp] = wx[(16 * ks + 8 * hp + jp) * 64 + 32 * nt + r];
      WF[512 + f * 64 + lane] = pack8(v); }
    for (int tile = bid >> 4; tile < T / 64; tile += (G >> 4)) {
        int tid = tid0; asm volatile("" : "+v"(tid));
        const int c = tid & 63, tq = tid >> 6, ch = n * 64 + c, rowbase = tile * 64;
        __syncthreads();
        if (tile < TP / 64) {
            const int r0 = rowbase + tq * 8; const bool first = ((r0 & 2047) == 0);
            const float w0 = lcw[ch], w1 = lcw[1024 + ch], w2 = lcw[2048 + ch], w3 = lcw[3072 + ch], bb = lcb[ch];
            const bf16* up = U + (size_t)r0 * NCD + 3584 + ch;
            const long fo = first ? 0 : (long)NCD;
              float x0 = bf2f(up[-3 * fo]), x1 = bf2f(up[-2 * fo]), x2 = bf2f(up[-1 * fo]); if (first) { x0 = 0.f; x1 = 0.f; x2 = 0.f; }
#pragma unroll
            for (int tt = 0; tt < 8; ++tt) { const float x3 = bf2f(up[(size_t)tt * NCD]); xcL[(tq * 8 + tt) * 68 + c] = bb + w0 * x0 + w1 * x1 + w2 * x2 + w3 * x3; x0 = x1; x1 = x2; x2 = x3; }
        } else {
#pragma unroll 2
            for (int tt = 0; tt < 8; ++tt) { const int r = rowbase + tq * 8 + tt; int s, t; row_to_seq(r, s, t); const int row0 = r - t; float acc = lcb[ch];
#pragma unroll
                for (int tap = 0; tap < 4; ++tap) acc += lcw[tap * 1024 + ch] * pre_val(U, NCD, 3584 + ch, row0, t - 3 + tap, s, lstc, 1024, ch);
                xcL[(tq * 8 + tt) * 68 + c] = acc; }
        }
        __syncthreads();
        const int wave = __builtin_amdgcn_readfirstlane(tid >> 6), lane = tid & 63, r = lane & 31, hp = lane >> 5, mat = wave >> 2, mt = (wave >> 1) & 1, nt = wave & 1;
        f32x16 acc;
#pragma unroll
        for (int i = 0; i < 16; ++i) acc[i] = 0.f;
#pragma unroll
        for (int ks = 0; ks < 4; ++ks) { const LAS float* xp = xcL + (32 * mt + r) * 68 + 16 * ks + 8 * hp; const f32x4 xa = *(const LAS f32x4*)xp, xb = *(const LAS f32x4*)(xp + 4);
            const bf16x8 af = __builtin_bit_cast(bf16x8, (u32x4){cvtpk(xa.x, xa.y), cvtpk(xa.z, xa.w), cvtpk(xb.x, xb.y), cvtpk(xb.z, xb.w)});
            acc = MFMA32(af, WF[mat * 512 + (nt * 4 + ks) * 64 + lane], acc); }
        const int chh = n * 64 + 32 * nt + r;
        if (mat == 1) { const float bx = lbx[chh];
#pragma unroll
            for (int i = 0; i < 16; ++i) igL[(32 * mt + crow(i, hp)) * 65 + 32 * nt + r] = sigmoid_(acc[i] + bx); }
        __syncthreads();
        if (mat == 0) { const float ba = lba[chh], spl = softplus_(-lam[chh]);
#pragma unroll
            for (int i = 0; i < 16; ++i) { const int tk = 32 * mt + crow(i, hp); const size_t ro = (size_t)(rowbase + tk) * 1024 + chh;
                const float log_a = -8.f * sigmoid_(acc[i] + ba) * spl;
                LA[ro] = __expf(log_a); LB[ro] = __builtin_amdgcn_sqrtf(1.f - __expf(2.f * log_a)) * (igL[tk * 65 + 32 * nt + r] * xcL[tk * 68 + 32 * nt + r]); } }
    }
}

constexpr size_t SSD_ITEM_BYTES = 33792;
__device__ __forceinline__ void phase_ssd_prep(const KP kp, const int bid, const int G, int j, LAS unsigned char* lds, int tid0) {
    unsigned char* scr = kp.ws() + WS_SCR;
    const bf16* U = (const bf16*)(kp.ws() + WS_U); bf16* XS = (bf16*)(scr + SC_XS);
    const float* cw = kp.in(23) + (size_t)j * 4 * 1536; const float* cb = kp.in(24) + (size_t)j * 1536;
    unsigned char* OPS = scr + SC_SSDOP;
    LAS float* CL = (LAS float*)lds; LAS float* BL = CL + 64 * 65; LAS float* QK = BL + 64 * 65; LAS float* GL = QK + 64 * 65; LAS float* DTL = GL + 256; LAS float* XLs = DTL + 256;
    const float* alog = kp.in(25) + j * 16;
    for (int item = bid; item < 512; item += G) {
        int tid = tid0; asm volatile("" : "+v"(tid));
        const int wave = tid >> 6, lane = tid & 63;
        const int b = item >> 7, n = (item >> 2) & 31, g = item & 3;
        const int row0 = b * 2048 + n * 64;
        __syncthreads();
        { const int ci = tid & 127, tg = tid >> 7, t0 = 16 * tg;
          const bool first = (n == 0 && tg == 0);
#pragma unroll
          for (int q = 0; q < 3; ++q) { const int k = ci + 128 * q;
              int cidx; LAS float* dst; int dstr, dcol;
              if (k < 64) { cidx = 1024 + g * 64 + k; dst = BL; dstr = 65; dcol = k; }
              else if (k < 128) { cidx = 1280 + g * 64 + (k - 64); dst = CL; dstr = 65; dcol = k - 64; }
              else { cidx = g * 256 + (k - 128); dst = XLs; dstr = 257; dcol = k - 128; }
              const float w0 = cw[cidx], w1 = cw[1536 + cidx], w2 = cw[2 * 1536 + cidx], w3 = cw[3 * 1536 + cidx], bb = cb[cidx];
              const bf16* up = U + (size_t)(row0 + t0) * NCD + 1024 + cidx;
              const long fo = first ? 0 : (long)NCD;
              float x0 = bf2f(up[-3 * fo]), x1 = bf2f(up[-2 * fo]), x2 = bf2f(up[-1 * fo]); if (first) { x0 = 0.f; x1 = 0.f; x2 = 0.f; }
#pragma unroll 4
              for (int t = 0; t < 16; ++t) { const float x3 = bf2f(up[(size_t)t * NCD]); dst[(t0 + t) * dstr + dcol] = silu_(bb + w0 * x0 + w1 * x1 + w2 * x2 + w3 * x3); x0 = x1; x1 = x2; x2 = x3; } } }
        if (wave < 4) { const int h = g * 4 + wave; const float dt = softplus_(bf2f(U[(size_t)(row0 + lane) * NCD + 4608 + h]) + kp.in(26)[j * 16 + h]);
            DTL[wave * 64 + lane] = dt; float gv = -__expf(alog[h]) * dt;
#pragma unroll
            for (int o = 1; o < 64; o <<= 1) { const float tt = __shfl_up(gv, o); if (lane >= o) gv += tt; }
            GL[wave * 64 + lane] = gv; }
        __syncthreads();
        for (int i = tid; i < 8192; i += NTHR) { const int t = i >> 7, k2 = i & 127;
            ((unsigned*)XS)[((size_t)(row0 + t) * 1024 + g * 256) / 2 + k2] = pk2(XLs[t * 257 + 2 * k2], XLs[t * 257 + 2 * k2 + 1]); }
        { const int i = tid >> 3, jg = tid & 7; float acc[8];
#pragma unroll
          for (int jj = 0; jj < 8; ++jj) acc[jj] = 0.f;
#pragma unroll 4
          for (int d = 0; d < 64; ++d) { const float c = CL[i * 65 + d];
#pragma unroll
              for (int jj = 0; jj < 8; ++jj) acc[jj] += c * BL[(jg * 8 + jj) * 65 + d]; }
#pragma unroll
          for (int jj = 0; jj < 8; ++jj) QK[i * 65 + jg * 8 + jj] = acc[jj]; }
        __syncthreads();
        const int f = wave, r = lane & 31, hp = lane >> 5, mt = f >> 2, ks = f & 3;
        for (int hh = 0; hh < 4; ++hh) {
            const int h = g * 4 + hh; const LAS float* Gh = GL + hh * 64; const float Gend = Gh[63];
            bf16x8* base = (bf16x8*)(OPS + ((size_t)((b * 32 + n) * 16 + h)) * SSD_ITEM_BYTES);
            float v[8];
            { const int i = 32 * mt + r; const float eg = __expf(Gh[i]);
#pragma unroll
              for (int jp = 0; jp < 8; ++jp) { const int d = 16 * ks + 8 * (jp >> 2) + 4 * hp + (jp & 3); v[jp] = CL[i * 65 + d] * eg; }
              base[0 * 512 + f * 64 + lane] = pack8(v); }
            { const int d = 32 * mt + r;
#pragma unroll
              for (int jp = 0; jp < 8; ++jp) { const int tk = 16 * ks + 8 * (jp >> 2) + 4 * hp + (jp & 3); v[jp] = BL[tk * 65 + d] * __expf(Gend - Gh[tk]); }
              base[1 * 512 + f * 64 + lane] = pack8(v); }
            { const int i = 32 * mt + r; const float gi = Gh[i];
#pragma unroll
              for (int jp = 0; jp < 8; ++jp) { const int jt = 16 * ks + 8 * (jp >> 2) + 4 * hp + (jp & 3); v[jp] = jt <= i ? QK[i * 65 + jt] * __expf(gi - Gh[jt]) : 0.f; }
              base[2 * 512 + f * 64 + lane] = pack8(v); }
            { const int p = 32 * mt + r;
#pragma unroll
              for (int jp = 0; jp < 8; ++jp) { const int tk = 16 * ks + 8 * (jp >> 2) + 4 * hp + (jp & 3);
                  v[jp] = XLs[tk * 257 + hh * 64 + p] * DTL[hh * 64 + tk]; }
              base[3 * 512 + f * 64 + lane] = pack8(v); }
            if (tid == 0) *(float*)(base + 32 * 64) = __expf(Gend);
        }
    }
}

__device__ __forceinline__ void phase_cd_rec(const KP kp, const int bid, const int G, int j, int li, LAS unsigned char* lds, int tid0) {
    unsigned char* scr = kp.ws() + WS_SCR; const bf16* U = (const bf16*)(kp.ws() + WS_U);
    const float* LA = (const float*)(scr + SC_LA); const float* LB = (const float*)(scr + SC_LB);
    float* YS = (float*)(scr + SC_YS); float* HS = (float*)(scr + SC_HS); bf16* XS = (bf16*)(scr + SC_XS);
    SEC_BEGIN(10)
    for (int item = bid; item < 64; item += G) {
        int tid = tid0; asm volatile("" : "+v"(tid));
        const int b = item >> 4, hd = item & 15;
        __syncthreads();
        const int wave = __builtin_amdgcn_readfirstlane(tid >> 6), lane = tid & 63, r = lane & 31, hp = lane >> 5, nt = wave;
        const unsigned char* OPS = scr + SC_SSDOP;
        const bool dmaw = (wave >= 2 && wave < 6);
        constexpr int SLOT = 33 * 1024;
#define SSD_DMA(n_) do { if (dmaw) { const unsigned char* gi_ = OPS + ((size_t)((b * 32 + (n_)) * 16 + hd)) * SSD_ITEM_BYTES + lane * 16; \
            _Pragma("unroll") for (int q_ = 0; q_ < 9; ++q_) { const int lf_ = q_ < 8 ? (wave - 2) * 8 + q_ : 32; \
                __builtin_amdgcn_global_load_lds((const unsigned*)(gi_ + lf_ * 1024), (LAS unsigned*)(lds + ((n_) & 3) * SLOT + lf_ * 1024), 16, 0, 0); } } } while (0)
        f32x16 S0, S1;
#pragma unroll
        for (int i = 0; i < 16; ++i) { S0[i] = 0.f; S1[i] = 0.f; }
        SSD_DMA(0); SSD_DMA(1); SSD_DMA(2);
        if (dmaw) asm volatile("s_waitcnt vmcnt(18)" ::: "memory");
        asm volatile("" ::: "memory"); __builtin_amdgcn_s_barrier(); asm volatile("" ::: "memory");
        for (int n = 0; n < 32; ++n) {
            if (n + 3 < 32) SSD_DMA(n + 3);
            if (wave < 2) {
                const LAS bf16x8* F = (const LAS bf16x8*)(lds + (n & 3) * SLOT) + lane;
                bf16x8 vb[4];
#pragma unroll
                for (int ks = 0; ks < 4; ++ks) vb[ks] = F[(24 + nt * 4 + ks) * 64];
                const float gend = *(const LAS float*)(lds + (n & 3) * SLOT + 32 * 1024);
                const bf16x8 sb00 = PACK_ACC(S0, 0), sb01 = PACK_ACC(S0, 1), sb10 = PACK_ACC(S1, 0), sb11 = PACK_ACC(S1, 1);
                f32x16 O0, O1;
#pragma unroll
                for (int i = 0; i < 16; ++i) { O0[i] = 0.f; O1[i] = 0.f; }
                O0 = MFMA32(F[0 * 64], sb00, O0); O0 = MFMA32(F[1 * 64], sb01, O0); O0 = MFMA32(F[2 * 64], sb10, O0); O0 = MFMA32(F[3 * 64], sb11, O0);
                O1 = MFMA32(F[4 * 64], sb00, O1); O1 = MFMA32(F[5 * 64], sb01, O1); O1 = MFMA32(F[6 * 64], sb10, O1); O1 = MFMA32(F[7 * 64], sb11, O1);
                O0 = MFMA32(F[16 * 64], vb[0], O0); O0 = MFMA32(F[17 * 64], vb[1], O0);
#pragma unroll
                for (int ks = 0; ks < 4; ++ks) O1 = MFMA32(F[(20 + ks) * 64], vb[ks], O1);
#pragma unroll
                for (int i = 0; i < 16; ++i) { S0[i] *= gend; S1[i] *= gend; }
#pragma unroll
                for (int ks = 0; ks < 4; ++ks) { S0 = MFMA32(F[(8 + ks) * 64], vb[ks], S0); S1 = MFMA32(F[(12 + ks) * 64], vb[ks], S1); }
                float* yo = YS + (size_t)(b * 2048 + n * 64) * 1024 + hd * 64 + 32 * nt + r;
#pragma unroll
                for (int i = 0; i < 16; ++i) { yo[(size_t)crow(i, hp) * 1024] = O0[i]; yo[(size_t)(32 + crow(i, hp)) * 1024] = O1[i]; }
            }
            if (dmaw) { if (n + 3 < 32) asm volatile("s_waitcnt vmcnt(18)" ::: "memory"); else if (n + 2 < 32) asm volatile("s_waitcnt vmcnt(9)" ::: "memory"); else asm volatile("s_waitcnt vmcnt(0)" ::: "memory"); }
            asm volatile("s_waitcnt lgkmcnt(0)" ::: "memory"); __builtin_amdgcn_s_barrier(); asm volatile("" ::: "memory");
        }
#undef SSD_DMA
        if (wave < 2) {
            float* dst = kp.out() + O_SSD_P + ((size_t)j * 4 + b) * ((size_t)16 * 64 * 64) + (size_t)hd * 64 * 64 + 32 * nt + r;
#pragma unroll
            for (int i = 0; i < 16; ++i) { dst[(size_t)crow(i, hp) * 64] = S0[i]; dst[(size_t)(32 + crow(i, hp)) * 64] = S1[i]; }
        }
    }
    SEC_END(10, lds)
    SEC_BEGIN(11)
    unsigned* qhead = (unsigned*)(kp.ws() + WS_CTL) + CW_CNT + 64 * li;
    volatile LAS unsigned* qslot = (volatile LAS unsigned*)(lds + LDS_BYTES - 8);
    const float* cw = kp.in(23) + (size_t)j * 4 * 1536; const float* cb = kp.in(24) + (size_t)j * 1536; const float* stc = kp.in(6) + (size_t)j * 128 * 3 * 1536;
    for (;;) {
        __syncthreads();
        if (tid0 == 0) qslot[0] = __hip_atomic_fetch_add(qhead, 1u, __ATOMIC_RELAXED, __HIP_MEMORY_SCOPE_AGENT);
        __syncthreads();
        const int it = (int)qslot[0];
        if (it >= 1024) break;
        int tid = tid0; asm volatile("" : "+v"(tid));
        if (it < 256) {
            const int s = it >> 6, h = it & 63; int row0, L; seq_info(s, row0, L);
            LAS float* Al = (LAS float*)lds; LAS float* Bl = Al + 512;
            const int chunk = tid >> 4, c16 = tid & 15, ch = h * 16 + c16;
            const size_t ro = (size_t)(row0 + chunk * 64) * 1024 + ch;
            float Ap = 1.f, Bp = 0.f;
#pragma unroll 8
            for (int t = 0; t < 64; ++t) { const float a = LA[ro + (size_t)t * 1024], bb = LB[ro + (size_t)t * 1024]; Bp = a * Bp + bb; Ap *= a; }
            Al[tid] = Ap; Bl[tid] = Bp;
            __syncthreads();
            float hh = 0.f;
            for (int m = 0; m < chunk; ++m) hh = Al[m * 16 + c16] * hh + Bl[m * 16 + c16];
#pragma unroll 8
            for (int t = 0; t < 64; ++t) { hh = LA[ro + (size_t)t * 1024] * hh + LB[ro + (size_t)t * 1024]; HS[ro + (size_t)t * 1024] = hh; }
            if (chunk == 31) kp.out()[O_LRU_P + ((size_t)j * 4 + s) * 1024 + ch] = hh;
        } else if (it < 768) {
            const int q_ = it - 256, bs = q_ >> 2, g = q_ & 3, sq = 4 + bs, r0 = TP + bs * 4;
            LAS float* BL = (LAS float*)lds; LAS float* CL = BL + 256; LAS float* XL = CL + 256; LAS float* DTL = XL + 1024; LAS float* QKs = DTL + 16; LAS float* red = QKs + 16;
            const int wave = tid >> 6, lane = tid & 63, hh = tid >> 7, nh = (tid >> 6) & 1, p = tid & 63, hd = 4 * g + hh;
            const size_t SZ = (size_t)16 * 64 * 64;
            const float* st = kp.in(5) + ((size_t)j * 128 + bs) * SZ + (size_t)hd * 4096;
            float S[32];
            { const float* sp = st + (size_t)(nh * 32) * 64 + p;
#pragma unroll
              for (int i = 0; i < 32; ++i) { S[i] = *sp; sp += 64; asm volatile("" : "+v"(sp)); } }
            { const int ci = tid & 127, tk = tid >> 7;
#pragma unroll
              for (int q = 0; q < 3; ++q) { const int k = ci + 128 * q; int cidx; LAS float* dst;
                  if (k < 64) { cidx = 1024 + g * 64 + k; dst = BL + tk * 64 + k; } else if (k < 128) { cidx = 1280 + g * 64 + (k - 64); dst = CL + tk * 64 + (k - 64); } else { cidx = g * 256 + (k - 128); dst = XL + tk * 256 + (k - 128); }
                  float acc = cb[cidx];
#pragma unroll
                  for (int tap = 0; tap < 4; ++tap) acc += cw[tap * 1536 + cidx] * pre_val(U, NCD, 1024 + cidx, r0, tk - 3 + tap, sq, stc, 1536, cidx);
                  *dst = silu_(acc); } }
            if (tid < 16) { const int tk = tid >> 2, h2 = tid & 3; DTL[tid] = softplus_(bf2f(U[(size_t)(r0 + tk) * NCD + 4608 + 4 * g + h2]) + kp.in(26)[j * 16 + 4 * g + h2]); }
            __syncthreads();
#pragma unroll
            for (int q = 0; q < 2; ++q) { const int idx = wave * 2 + q, i = idx >> 2, jj = idx & 3; const float dot = wave_sum(CL[i * 64 + lane] * BL[jj * 64 + lane]); if (lane == 0) QKs[idx] = dot; }
            { const int tk = tid >> 7, k2 = tid & 127; ((unsigned*)XS)[((size_t)(r0 + tk) * 1024 + g * 256) / 2 + k2] = pk2(XL[tk * 256 + 2 * k2], XL[tk * 256 + 2 * k2 + 1]); }
            const float negA = -__expf(kp.in(25)[j * 16 + hd]);
            float Gc[4], xd[4], w[4];
            Gc[0] = negA * DTL[hh]; Gc[1] = Gc[0] + negA * DTL[4 + hh]; Gc[2] = Gc[1] + negA * DTL[8 + hh]; Gc[3] = Gc[2] + negA * DTL[12 + hh];
#pragma unroll
            for (int jj = 0; jj < 4; ++jj) { xd[jj] = XL[jj * 256 + hh * 64 + p] * DTL[jj * 4 + hh]; w[jj] = __expf(Gc[3] - Gc[jj]) * xd[jj]; }
            const float eg = __expf(Gc[3]);
            float o[4] = {0.f, 0.f, 0.f, 0.f};
            float* dst = kp.out() + O_SSD_S + ((size_t)j * 128 + bs) * SZ + (size_t)hd * 4096 + (size_t)(nh * 32) * 64 + p;
#pragma unroll
            for (int i = 0; i < 32; ++i) { const int n = nh * 32 + i; const float s0 = S[i]; float acc = eg * s0;
#pragma unroll
                for (int t = 0; t < 4; ++t) { o[t] += CL[t * 64 + n] * s0; acc += BL[t * 64 + n] * w[t]; }
                *dst = acc; dst += 64; asm volatile("" : "+v"(dst)); }
#pragma unroll
            for (int t = 0; t < 4; ++t) red[((hh * 2 + nh) * 4 + t) * 64 + p] = o[t];
            __syncthreads();
            if (nh == 0) {
#pragma unroll
                for (int t = 0; t < 4; ++t) { float y = __expf(Gc[t]) * (red[((hh * 2) * 4 + t) * 64 + p] + red[((hh * 2 + 1) * 4 + t) * 64 + p]);
#pragma unroll
                    for (int jj = 0; jj <= t; ++jj) y += QKs[t * 4 + jj] * __expf(Gc[t] - Gc[jj]) * xd[jj];
                    YS[(size_t)(r0 + t) * 1024 + hd * 64 + p] = y; } }
        } else {
            const int q_ = it - 768, s = 4 + (q_ >> 1), h = q_ & 1; int row0, L; seq_info(s, row0, L);
            const int ch = h * 512 + tid;
            float hh = s < 4 ? 0.f : kp.in(7)[((size_t)j * 128 + (s - 4)) * 1024 + ch];
#pragma unroll 8
            for (int t = 0; t < L; ++t) { const size_t r = (size_t)(row0 + t); hh = LA[r * 1024 + ch] * hh + LB[r * 1024 + ch]; HS[r * 1024 + ch] = hh; }
            float* dst = s < 4 ? kp.out() + O_LRU_P + ((size_t)j * 4 + s) * 1024 : kp.out() + O_LRU_S + ((size_t)j * 128 + (s - 4)) * 1024;
            dst[ch] = hh;
        }
    }
    SEC_END(11, lds)
}

__device__ __forceinline__ void phase_cd_post(const KP kp, const int bid, const int G, int j, int tid, int wave, int lane) {
    unsigned char* scr = kp.ws() + WS_SCR; const bf16* U = (const bf16*)(kp.ws() + WS_U); bf16* YM = (bf16*)(kp.ws() + WS_YM);
    const float* YS = (const float*)(scr + SC_YS); const float* HS = (const float*)(scr + SC_HS); const bf16* XS = (const bf16*)(scr + SC_XS);
    const float* sn = kp.in(28) + (size_t)j * 1024; const float* Dv = kp.in(27) + (size_t)j * 16;
    typedef float f32x2v __attribute__((ext_vector_type(2)));
    for (int r = bid * NWAVES + wave; r < T; r += G * NWAVES) {
        int s, t; row_to_seq(r, s, t); int row0, L; seq_info(s, row0, L);
        const bf16* ur = U + (size_t)r * NCD; bf16* yr = YM + (size_t)r * DM;
        f32x4 ysv[4], hsv[4]; u32x2 xxv[4], zzv[4], zlv[4];
#pragma unroll
        for (int gq = 0; gq < 4; ++gq) { const int e = gq * 256 + 4 * lane; ysv[gq] = *(const f32x4*)(YS + (size_t)r * 1024 + e); xxv[gq] = *(const u32x2*)(XS + (size_t)r * 1024 + e); zzv[gq] = *(const u32x2*)(ur + e);
            hsv[gq] = *(const f32x4*)(HS + (size_t)r * 1024 + e); zlv[gq] = *(const u32x2*)(ur + 2560 + e); }
#pragma unroll
        for (int gq = 0; gq < 4; ++gq) { const int e = gq * 256 + 4 * lane; const f32x4 ys = ysv[gq];
            const u32x2 xx = xxv[gq], zz = zzv[gq]; const float Dh = Dv[e >> 6];
            f32x4 y; y.x = (ys.x + Dh * __uint_as_float(xx.x << 16)) * silu_(__uint_as_float(zz.x << 16)); y.y = (ys.y + Dh * __uint_as_float(xx.x & 0xffff0000u)) * silu_(__uint_as_float(zz.x & 0xffff0000u));
            y.z = (ys.z + Dh * __uint_as_float(xx.y << 16)) * silu_(__uint_as_float(zz.y << 16)); y.w = (ys.w + Dh * __uint_as_float(xx.y & 0xffff0000u)) * silu_(__uint_as_float(zz.y & 0xffff0000u));
            const float rstd = rsqrtf(wave_sum((y.x * y.x + y.y * y.y) + (y.z * y.z + y.w * y.w)) * (1.f / 256.f) + 1e-6f);
            const f32x4 g4 = *(const f32x4*)(sn + e);
            u32x2 w; w.x = pk2(y.x * rstd * g4.x, y.y * rstd * g4.y); w.y = pk2(y.z * rstd * g4.z, y.w * rstd * g4.w); *(u32x2*)(yr + e) = w; }
#pragma unroll
        for (int gq = 0; gq < 4; ++gq) { const int ch = gq * 256 + 4 * lane; const f32x4 hs = hsv[gq]; const u32x2 zz = zlv[gq];
            u32x2 w; w.x = pk2(hs.x * silu_(__uint_as_float(zz.x << 16)), hs.y * silu_(__uint_as_float(zz.x & 0xffff0000u))); w.y = pk2(hs.z * silu_(__uint_as_float(zz.y << 16)), hs.w * silu_(__uint_as_float(zz.y & 0xffff0000u)));
            *(u32x2*)(yr + 1024 + ch) = w; }
        if (t >= L - 3) { const int rr = t - (L - 3);
            float* d1 = s < 4 ? kp.out() + O_SSDC_P + (((size_t)j * 4 + s) * 3 + rr) * 1536 : kp.out() + O_SSDC_S + (((size_t)j * 128 + (s - 4)) * 3 + rr) * 1536;
            for (int c = 2 * lane; c < 1536; c += 128) { const unsigned uu = *(const unsigned*)(ur + 1024 + c); *(f32x2v*)(d1 + c) = (f32x2v){__uint_as_float(uu << 16), __uint_as_float(uu & 0xffff0000u)}; }
            float* d2 = s < 4 ? kp.out() + O_LRUC_P + (((size_t)j * 4 + s) * 3 + rr) * 1024 : kp.out() + O_LRUC_S + (((size_t)j * 128 + (s - 4)) * 3 + rr) * 1024;
            for (int c = 2 * lane; c < 1024; c += 128) { const unsigned uu = *(const unsigned*)(ur + 3584 + c); *(f32x2v*)(d2 + c) = (f32x2v){__uint_as_float(uu << 16), __uint_as_float(uu & 0xffff0000u)}; } }
    }
}


typedef float f32x4m __attribute__((ext_vector_type(4)));
template <bool GATE>
__device__ __forceinline__ void sample_gemm_res(const bf16* Amat, const bf16* Bt, const bf16* Hin, bf16* Hout, float* rss_out, const bf16* PP, const float* rss_in, int bid, int tid) {
    const int wave = tid >> 6, lane = tid & 63, lr = lane & 15, kg = lane >> 4;
    const int m0 = TP + (bid & 7) * 64 + (wave & 3) * 16, n0 = (bid >> 3) * 64 + (wave >> 2) * 32;
    if (bid >= 256) return;
    const bf16x8* ap = (const bf16x8*)(Amat + (size_t)(m0 + lr) * 2048 + 8 * kg);
    const bf16x8* bp0 = (const bf16x8*)(Bt + (size_t)(n0 + lr) * 2048 + 8 * kg);
    const bf16x8* bp1 = (const bf16x8*)(Bt + (size_t)(n0 + 16 + lr) * 2048 + 8 * kg);
    f32x4m c0 = {0.f, 0.f, 0.f, 0.f}, c1 = {0.f, 0.f, 0.f, 0.f};
#pragma unroll 8
    for (int ks = 0; ks < 64; ++ks) { const bf16x8 a = ap[ks * 4], b0 = bp0[ks * 4], b1 = bp1[ks * 4];
        c0 = __builtin_amdgcn_mfma_f32_16x16x32_bf16(a, b0, c0, 0, 0, 0); c1 = __builtin_amdgcn_mfma_f32_16x16x32_bf16(a, b1, c1, 0, 0, 0); }
#pragma unroll
    for (int i = 0; i < 4; ++i) { const int row = m0 + kg * 4 + i; float sc = 1.f; if (GATE) sc = rsqrtf(rss_in[row] * (1.f / 2048.f) + 1e-6f);
        float sq = 0.f;
#pragma unroll
        for (int nf = 0; nf < 2; ++nf) { const size_t p = (size_t)row * 2048 + n0 + 16 * nf + lr; const float a = nf ? c1[i] : c0[i];
            float h = bf2f(Hin[p]);
            if (GATE) h += __builtin_amdgcn_rcpf(1.f + __expf(-sc * a)) * bf2f(PP[p]); else h += a;
            sq += h * h; Hout[p] = (bf16)f2bf(h); }
        sq += __shfl_xor(sq, 1); sq += __shfl_xor(sq, 2); sq += __shfl_xor(sq, 4); sq += __shfl_xor(sq, 8);
        if (lr == 0) atomicAdd(rss_out + row, sq); }
}

__global__ void __launch_bounds__(NTHR, 2) mega_fwd(Args A) {
    extern __shared__ __attribute__((aligned(16))) unsigned char lds_raw[];
    LAS unsigned char* lds = (LAS unsigned char*)lds_raw;
    const int G = gridDim.x;
    volatile LAS unsigned* bst = (volatile LAS unsigned*)(lds + LDS_BYTES - 16);
    if (threadIdx.x == 0) { bst[0] = 0u; bst[1] = 0u;
#ifdef PROBE_SEC
        *(volatile LAS unsigned long long*)(lds + LDS_BYTES - 32) = 0ull;
#endif
    }
    __syncthreads();
    XcdBarrier xbar = xcd_barrier_post((unsigned*)(A.ws + WS_CTL) + CW_BAR, bst);
#ifdef PROBE_GROUP
    unsigned long long t_prev = __builtin_amdgcn_s_memrealtime(), t_sel = 0;
#endif
    for (int ph = A.ph_lo; ph < A.ph_hi; ++ph) {
        KP kp; kp.p = (const char AS4*)__builtin_amdgcn_kernarg_segment_ptr(); asm volatile("" : "+s"(kp.p));
        unsigned char* ws = kp.ws();
        int tid = threadIdx.x; asm volatile("" : "+v"(tid));
        int bid = blockIdx.x; asm volatile("" : "+s"(bid));
        const int lane = tid & 63, wave = __builtin_amdgcn_readfirstlane(tid >> 6), gw = bid * NWAVES + wave, NGW = G * NWAVES;
        if (ph == 0) { if (PH_MASK & 1) phase_prologue(kp, lds, gw, NGW, wave, lane); }
        else if (ph == N_PHASES - 1) phase_final(kp, gw, NGW, lane);
        else {
            const int li = (ph - 1) / SUBS, sub = (ph - 1) % SUBS, j = li >> 1; const bool ab = (li & 1) == 0;
            float* RSS = (float*)(ws + WS_RSS);
            if (sub == 0) {
                const int N = ab ? NAB : NCD;
                const bf16* Bt = ab ? (const bf16*)(ws + WS_WABIN) + (size_t)j * NAB * 2048 : (const bf16*)(ws + WS_WCDIN) + (size_t)j * NCD * 2048;
                { pg8::Gemm g{(const bf16*)(ws + WS_XN), Bt, T, N, 2048}; pg8::StaticOrder S; S.init(T, N, G, bid);
                  pg8::EpiU E{(bf16*)(ws + WS_U), N, RSS + (size_t)(2 * li) * T};
                  if (PH_MASK & 2) pg8::gemm_phase<pg8::EpiU, pg8::StaticOrder, true, true>(lds, g, S, E, tid); }
                { int tid2 = tid; asm volatile("" : "+v"(tid2));
                  pg8::Gemm g{(const bf16*)(ws + WS_PB) + (size_t)li * T * 256, (const bf16*)(ws + WS_WPROJ) + (size_t)li * 2048 * 256, T, 2048, 256}; pg8::StaticOrder S; S.init(T, 2048, G, (bid + 37) % G);
                  pg8::EpiU E{(bf16*)(ws + WS_SCR + SC_PP), 2048, nullptr};
                  if (PH_MASK & 2) pg8::gemm_phase<pg8::EpiU, pg8::StaticOrder, true, true>(lds, g, S, E, tid2); }
            } else if (sub == 4) {
                const bf16* Bt = ab ? (const bf16*)(ws + WS_WABOUT) + (size_t)j * 2048 * 2048 : (const bf16*)(ws + WS_WCDOUT) + (size_t)j * 2048 * 2048;
                pg8::Gemm g{(const bf16*)(ws + WS_YM), Bt, TP, 2048, 2048}; pg8::StaticOrder S; S.init(TP, 2048, G, bid);
                pg8::EpiRes<false> E{(const bf16*)(ws + WS_XN), (bf16*)(ws + WS_SCR + SC_HB1), RSS + (size_t)(2 * li + 1) * T, nullptr, nullptr};
                if (PH_MASK & 4) pg8::gemm_phase<pg8::EpiRes<false>, pg8::StaticOrder, true, true>(lds, g, S, E, tid);
                { int tid2 = tid; asm volatile("" : "+v"(tid2));
                  sample_gemm_res<false>((const bf16*)(ws + WS_YM), Bt, (const bf16*)(ws + WS_XN), (bf16*)(ws + WS_SCR + SC_HB1), RSS + (size_t)(2 * li + 1) * T, nullptr, nullptr, bid, tid2); }
            } else if (sub == 5) {
                pg8::Gemm g{(const bf16*)(ws + WS_SCR + SC_HB1), (const bf16*)(ws + WS_WGATE) + (size_t)li * 2048 * 2048, TP, 2048, 2048}; pg8::StaticOrder S; S.init(TP, 2048, G, bid);
                pg8::EpiRes<true> E{(const bf16*)(ws + WS_SCR + SC_HB1), (bf16*)(ws + WS_XN), RSS + (size_t)(2 * li + 2) * T, (const bf16*)(ws + WS_SCR + SC_PP), RSS + (size_t)(2 * li + 1) * T};
                if (PH_MASK & 4) pg8::gemm_phase<pg8::EpiRes<true>, pg8::StaticOrder, true, true>(lds, g, S, E, tid);
                { int tid2 = tid; asm volatile("" : "+v"(tid2));
                  sample_gemm_res<true>((const bf16*)(ws + WS_SCR + SC_HB1), (const bf16*)(ws + WS_WGATE) + (size_t)li * 2048 * 2048, (const bf16*)(ws + WS_SCR + SC_HB1), (bf16*)(ws + WS_XN), RSS + (size_t)(2 * li + 2) * T,
                                        (const bf16*)(ws + WS_SCR + SC_PP), RSS + (size_t)(2 * li + 1) * T, bid, tid2); }
            } else if (sub == 1) {
                if (ab) { SEC_BEGIN(3) if (PH_MASK & 4096) phase_gla_prep(kp, bid, G, j, lds, tid); SEC_END(3, lds) SEC_BEGIN(4) if (PH_MASK & 8192) phase_dn_prep(kp, bid, G, j, lds, tid); SEC_END(4, lds) }
                else { if (PH_MASK & 2048) { SEC_BEGIN(8) phase_ssd_prep(kp, bid, G, j, lds, tid); SEC_END(8, lds) SEC_BEGIN(9) phase_lru_gates(kp, bid, G, j, lds, tid); SEC_END(9, lds) } }
            }
            else if (sub == 2) { if (ab) { if (PH_MASK & 32) phase_ab_rec(kp, bid, G, j, li, lds, tid); } else { if (PH_MASK & 64) phase_cd_rec(kp, bid, G, j, li, lds, tid); } }
            else { if (ab) { if (PH_MASK & 128) phase_ab_post(kp, bid, G, j, tid, wave, lane); } else { if (PH_MASK & 256) phase_cd_post(kp, bid, G, j, tid, wave, lane); } }
        }
        if (ph + 1 < A.ph_hi) { if (ph == A.ph_lo) cg::this_grid().sync(); else xcd_barrier(xbar); }
#ifdef PROBE_GROUP
        { const unsigned long long t_now = __builtin_amdgcn_s_memrealtime(); const int li_ = (ph - 1) / SUBS, sub_ = (ph - 1) % SUBS; const bool ab_ = (li_ & 1) == 0;
          int grp = 9; if (ph == N_PHASES - 1) grp = 8; else if (ph > 0) { if (sub_ == 0 || sub_ == 4 || sub_ == 5) grp = 1; else if (sub_ == 1) grp = ab_ ? 4 : 5; else if (sub_ == 2) grp = ab_ ? 6 : 7; else grp = 8; }
          if (grp == PROBE_GROUP) t_sel += t_now - t_prev; t_prev = t_now; }
#endif
    }
#ifdef PROBE_SEC
    if (blockIdx.x == PROBE_BLK && threadIdx.x == 0) { const unsigned long long t_s = *(volatile LAS unsigned long long*)(lds + LDS_BYTES - 32); const unsigned long long t0 = __builtin_amdgcn_s_memrealtime(); while (__builtin_amdgcn_s_memrealtime() - t0 < 3 * t_s) __builtin_amdgcn_s_sleep(8); }
#endif
#ifdef PROBE_GROUP
    if (blockIdx.x == 0 && threadIdx.x == 0) { const unsigned long long t0 = __builtin_amdgcn_s_memrealtime(); while (__builtin_amdgcn_s_memrealtime() - t0 < 3 * t_sel) __builtin_amdgcn_s_sleep(8); }
#endif
}

extern "C" void kernel_launch(void* const* d_in, const int* in_sizes, int n_in, void* d_out, int out_size, void* d_ws, size_t ws_size, hipStream_t stream) {
    static int grid = 0;
    if (grid == 0) {
        if (n_in != 40 || (size_t)out_size != O_END || ws_size < WS_END) { fprintf(stderr, "kernel_launch: unexpected shapes: n_in %d out %d ws %zu\n", n_in, out_size, ws_size); grid = -1; return; }
        int dev = 0, cus = 0, per_cu = 0;
        if (hipGetDevice(&dev) != hipSuccess || hipDeviceGetAttribute(&cus, hipDeviceAttributeMultiprocessorCount, dev) != hipSuccess) { grid = -1; return; }
        if (hipFuncSetAttribute((const void*)mega_fwd, hipFuncAttributeMaxDynamicSharedMemorySize, LDS_BYTES) != hipSuccess) { fprintf(stderr, "kernel_launch: hipFuncSetAttribute failed\n"); grid = -1; return; }
        if (hipOccupancyMaxActiveBlocksPerMultiprocessor(&per_cu, (const void*)mega_fwd, NTHR, LDS_BYTES) != hipSuccess || per_cu < 1) { fprintf(stderr, "kernel_launch: occupancy query says %d\n", per_cu); per_cu = 1; }
        (void)hipGetLastError();
        grid = cus;
    }
    if (grid < 0) return;
    if (hipMemsetAsync((char*)d_ws + WS_CTL, 0, CTL_ZERO_BYTES, stream) != hipSuccess) { fprintf(stderr, "kernel_launch: memset of the control words failed\n"); return; }
    Args a{};
    for (int i = 0; i < 40; ++i) a.in[i] = (const float*)d_in[i];
    a.out = (float*)d_out; a.ws = (unsigned char*)d_ws;
#if MK_N_LAUNCHES == 1
    a.ph_lo = 0; a.ph_hi = N_PHASES;
    void* args[] = {&a};
    hipError_t e = hipLaunchCooperativeKernel((const void*)mega_fwd, dim3(grid), dim3(NTHR), args, LDS_BYTES, stream);
    if (e != hipSuccess) fprintf(stderr, "cooperative launch failed: %s (grid %d)\n", hipGetErrorString(e), grid);
#else
    for (int ph = 0; ph < N_PHASES; ++ph) { a.ph_lo = ph; a.ph_hi = ph + 1; mega_fwd<<<dim3(grid), dim3(NTHR), LDS_BYTES, stream>>>(a); }
#endif
}
```

```cpp
#include <hip/hip_runtime.h>
#include <hip/hip_cooperative_groups.h>
#include <cstdio>
#include <cstdint>
namespace cg = cooperative_groups;

#ifndef MK_N_LAUNCHES
#define MK_N_LAUNCHES 1
#endif

namespace pg8 {
#define PG8_LAS __attribute__((address_space(3)))
typedef unsigned short bf16_t;
typedef short bf16x8 __attribute__((ext_vector_type(8)));
typedef float f32x4 __attribute__((ext_vector_type(4)));
typedef unsigned u32x4 __attribute__((ext_vector_type(4)));
constexpr int BM = 256, BK = 64, HALF = 128, HTB = HALF * BK * 2  , STAGE_BYTES = 8 * HTB, NXCD = 8, WGM = 8;

__host__ __device__ __forceinline__ int lds_byte(int r, int c) { const int st = (r >> 4) * 2 + (c >> 5), rr = r & 15, cc = c & 31, ob = rr * 64 + cc * 2; return st * 1024 + (ob ^ (((ob >> 9) & 1) << 5)); }
__host__ __device__ __forceinline__ void stage_rc(int b, int& R, int& C) { const int st = b / 1024, sb = b % 1024, swz = sb ^ (((sb >> 9) & 1) << 5); R = (st >> 1) * 16 + swz / 64; C = (st & 1) * 32 + (swz % 64) / 2; }
__host__ __device__ __forceinline__ int perm32(int rho) { const int n = rho >> 4, i = rho & 15; return 8 * (i >> 2) + 4 * n + (i & 3); }

struct Unit { int pm, pn; };
struct Gemm { const bf16_t* A; const bf16_t* Bt; int M, N, K; };

struct StaticOrder {
    int nM, nN, nwg, G, c;
    __host__ __device__ void init(int M, int N, int G_, int c_) { nM = M / BM; nN = N / BM; nwg = nM * nN; G = G_; c = c_; }
    __host__ __device__ bool next(int i, Unit& u) const {
        const long L = (long)i * G + c; if (L >= nwg) return false;
        int wgid = (int)L; { const int q = nwg / NXCD, r = nwg % NXCD, xcd = wgid % NXCD, off = wgid / NXCD; wgid = (xcd < r ? xcd * (q + 1) : r * (q + 1) + (xcd - r) * q) + off; }
        const int nig = WGM * nN, gid = wgid / nig, fm = gid * WGM, gsz = (nM - fm) < WGM ? (nM - fm) : WGM;
        u.pm = fm + ((wgid % nig) % gsz); u.pn = (wgid % nig) / gsz; return true;
    }
    __device__ __forceinline__ void a_ready(const Unit&) const {}
    __device__ __forceinline__ void done(const Unit&) const {}
};

__device__ __forceinline__ unsigned cvt_pk_bf16(float lo, float hi) { unsigned r; asm volatile("v_cvt_pk_bf16_f32 %0, %1, %2" : "=v"(r) : "v"(lo), "v"(hi)); return r; }
struct EpiF32 {
    static constexpr bool PERM = false, AFTER_DRAIN = false;
    float* C; int ldc;
    __device__ __forceinline__ void operator()(const f32x4 (&acc)[2][2][4][2], const Unit& u, int wr, int wc, int fr, int fq) const {
        const int row0 = u.pm * BM + wr * 64 + fr, col0 = u.pn * BM + wc * 32 + 4 * fq;
#pragma unroll
        for (int ai = 0; ai < 2; ++ai)
#pragma unroll
            for (int m = 0; m < 4; ++m) { float* rowp = C + (size_t)(row0 + ai * HALF + m * 16) * ldc + col0;
#pragma unroll
                for (int bj = 0; bj < 2; ++bj)
#pragma unroll
                    for (int n = 0; n < 2; ++n) *(f32x4*)(rowp + bj * HALF + n * 16) = acc[ai][bj][m][n]; }
    }
};
struct EpiBf16 {
    static constexpr bool PERM = true, AFTER_DRAIN = false;
    bf16_t* O; int ldc;
    __device__ __forceinline__ void operator()(const f32x4 (&acc)[2][2][4][2], const Unit& u, int wr, int wc, int fr, int fq) const {
        const int row0 = u.pm * BM + wr * 64 + fr; const int col0 = u.pn * BM + wc * 32 + 8 * fq;
#pragma unroll
        for (int ai = 0; ai < 2; ++ai)
#pragma unroll
            for (int m = 0; m < 4; ++m) { bf16_t* rowp = O + (size_t)(row0 + ai * HALF + m * 16) * ldc + col0;
#pragma unroll
                for (int bj = 0; bj < 2; ++bj) { const f32x4 v0 = acc[ai][bj][m][0], v1 = acc[ai][bj][m][1];
                    u32x4 w; w.x = cvt_pk_bf16(v0[0], v0[1]); w.y = cvt_pk_bf16(v0[2], v0[3]); w.z = cvt_pk_bf16(v1[0], v1[1]); w.w = cvt_pk_bf16(v1[2], v1[3]);
                    *(u32x4*)(rowp + bj * HALF) = w; } }
    }
};

struct EpiU {
    static constexpr bool PERM = true, AFTER_DRAIN = false;
    bf16_t* O; int ldc; const float* rss;
    __device__ __forceinline__ void operator()(const f32x4 (&acc)[2][2][4][2], const Unit& u, int wr, int wc, int fr, int fq) const {
        const int row0 = u.pm * BM + wr * 64 + fr; const int col0 = u.pn * BM + wc * 32 + 8 * fq;
#pragma unroll
        for (int ai = 0; ai < 2; ++ai)
#pragma unroll
            for (int m = 0; m < 4; ++m) { const int row = row0 + ai * HALF + m * 16; const float sc = rss ? rsqrtf(rss[row] * (1.f / 2048.f) + 1e-6f) : 1.f;
                bf16_t* rowp = O + (size_t)row * ldc + col0;
#pragma unroll
                for (int bj = 0; bj < 2; ++bj) { const f32x4 v0 = acc[ai][bj][m][0] * sc, v1 = acc[ai][bj][m][1] * sc;
                    u32x4 w; w.x = cvt_pk_bf16(v0[0], v0[1]); w.y = cvt_pk_bf16(v0[2], v0[3]); w.z = cvt_pk_bf16(v1[0], v1[1]); w.w = cvt_pk_bf16(v1[2], v1[3]);
                    *(u32x4*)(rowp + bj * HALF) = w; } }
    }
};
typedef unsigned u32x2e __attribute__((ext_vector_type(2)));
template <bool GATE> struct EpiRes {
    static constexpr bool PERM = false, AFTER_DRAIN = false;
    const bf16_t* Hin; bf16_t* Hout; float* rss_out; const bf16_t* PP; const float* rss_in;
    __device__ __forceinline__ void operator()(const f32x4 (&acc)[2][2][4][2], const Unit& u, int wr, int wc, int fr, int fq) const {
        const int row0 = u.pm * BM + wr * 64 + fr, col0 = u.pn * BM + wc * 32 + 4 * fq;
#pragma unroll
        for (int ai = 0; ai < 2; ++ai)
#pragma unroll
            for (int m = 0; m < 4; ++m) { const int row = row0 + ai * HALF + m * 16; const size_t ro = (size_t)row * 2048 + col0;
                float sc = 1.f; if (GATE) sc = rsqrtf(rss_in[row] * (1.f / 2048.f) + 1e-6f);
                float s = 0.f;
#pragma unroll
                for (int bj = 0; bj < 2; ++bj)
#pragma unroll
                    for (int n = 0; n < 2; ++n) { const size_t p = ro + bj * HALF + n * 16; const u32x2e hw = *(const u32x2e*)(Hin + p); const f32x4 a = acc[ai][bj][m][n];
                        f32x4 h; h[0] = __uint_as_float(hw.x << 16); h[1] = __uint_as_float(hw.x & 0xffff0000u); h[2] = __uint_as_float(hw.y << 16); h[3] = __uint_as_float(hw.y & 0xffff0000u);
                        if (GATE) { const u32x2e pw = *(const u32x2e*)(PP + p);
                            h[0] += __builtin_amdgcn_rcpf(1.f + __expf(-sc * a[0])) * __uint_as_float(pw.x << 16); h[1] += __builtin_amdgcn_rcpf(1.f + __expf(-sc * a[1])) * __uint_as_float(pw.x & 0xffff0000u);
                            h[2] += __builtin_amdgcn_rcpf(1.f + __expf(-sc * a[2])) * __uint_as_float(pw.y << 16); h[3] += __builtin_amdgcn_rcpf(1.f + __expf(-sc * a[3])) * __uint_as_float(pw.y & 0xffff0000u); }
                        else h = h + a;
                        s += (h[0] * h[0] + h[1] * h[1]) + (h[2] * h[2] + h[3] * h[3]);
                        u32x2e o; o.x = cvt_pk_bf16(h[0], h[1]); o.y = cvt_pk_bf16(h[2], h[3]); *(u32x2e*)(Hout + p) = o; }
                s += __shfl_xor(s, 16); s += __shfl_xor(s, 32);
                if (fq == 0) atomicAdd(rss_out + row, s);
                asm volatile("" ::: "memory"); }
    }
};
template <class Epi, class Sched, bool ALIGN_EPI = false, bool SP2 = false>
__device__ __forceinline__ void gemm_phase(PG8_LAS unsigned char* lds, const Gemm g, const Sched& S, const Epi& E, const int tid) {
    const int wid = __builtin_amdgcn_readfirstlane(tid >> 6), lane = tid & 63, wr = wid >> 2, wc = wid & 3, fr = lane & 15, fq = lane >> 4;
    const int K = g.K, nt = K / BK;
    unsigned voffA[2], voffB[2];
#pragma unroll
    for (int i = 0; i < 2; ++i) { int R, C; stage_rc(tid * 16 + i * 8192, R, C); const int Rb = Epi::PERM ? ((R & ~31) + perm32(R & 31)) : R;
        voffA[i] = (unsigned)(R * K + C) * 2u; voffB[i] = (unsigned)(Rb * K + C) * 2u; }
    const size_t kstep = (size_t)(BK * 2);
    const size_t hstep = (size_t)HALF * K * 2;
    const size_t tstep = 2 * hstep;
    const unsigned ldsw = (unsigned)wid * 1024u;
    const int aoff = lds_byte(wr * 64 + fr, fq * 8), boff = lds_byte(wc * 32 + fr, fq * 8);
#define PG8_SA(b, h) (((b) * 2 + (h)) * HTB)
#define PG8_SB(b, h) ((4 + (b) * 2 + (h)) * HTB)
#define PG8_STAGE(bufoff, gbase, voff) do { _Pragma("unroll") for (int _i = 0; _i < 2; ++_i) \
        __builtin_amdgcn_global_load_lds((const unsigned*)((const char*)(gbase) + (voff)[_i]), (PG8_LAS unsigned*)(lds + (bufoff) + ldsw + _i * 8192), 16, 0, 0); } while (0)
#define PG8_LDA(dst, b, h) do { _Pragma("unroll") for (int m = 0; m < 4; ++m) _Pragma("unroll") for (int k = 0; k < 2; ++k) dst[m][k] = *(const PG8_LAS bf16x8*)(lds + PG8_SA(b, h) + aoff + m * 2048 + k * 1024); } while (0)
#define PG8_LDB(dst, b, h) do { _Pragma("unroll") for (int n = 0; n < 2; ++n) _Pragma("unroll") for (int k = 0; k < 2; ++k) dst[n][k] = *(const PG8_LAS bf16x8*)(lds + PG8_SB(b, h) + boff + n * 2048 + k * 1024); } while (0)
#define PG8_MMA(ai, bj, At, Bt) do { __builtin_amdgcn_s_setprio(1); _Pragma("unroll") for (int m = 0; m < 4; ++m) _Pragma("unroll") for (int n = 0; n < 2; ++n) _Pragma("unroll") for (int k = 0; k < 2; ++k) \
        acc[ai][bj][m][n] = __builtin_amdgcn_mfma_f32_16x16x32_bf16(Bt[n][k], At[m][k], acc[ai][bj][m][n], 0, 0, 0); __builtin_amdgcn_s_setprio(0); } while (0)
#define PG8_WAIT_V(n) asm volatile("s_waitcnt vmcnt(" #n ")" ::: "memory")
#define PG8_WAIT_L(n) asm volatile("s_waitcnt lgkmcnt(" #n ")" ::: "memory")
#define PG8_BAR __builtin_amdgcn_s_barrier()
#define PG8_SCHED __builtin_amdgcn_sched_barrier(0)
    Unit cur, nxt; int ui = 0;
    if (!S.next(0, cur)) return;
    f32x4 acc[2][2][4][2];
#pragma unroll
    for (int a = 0; a < 2; ++a)
#pragma unroll
        for (int b = 0; b < 2; ++b)
#pragma unroll
            for (int m = 0; m < 4; ++m)
#pragma unroll
                for (int n = 0; n < 2; ++n) acc[a][b][m][n] = (f32x4){0.f, 0.f, 0.f, 0.f};
    bf16x8 At[4][2], B0[2][2], B1[2][2];
    const char* cA = (const char*)g.A + (size_t)cur.pm * tstep; const char* cB = (const char*)g.Bt + (size_t)cur.pn * tstep;
    S.a_ready(cur);
    if constexpr (SP2) {
        PG8_STAGE(PG8_SB(0, 0), cB, voffB); PG8_STAGE(PG8_SB(0, 1), cB + hstep, voffB); PG8_STAGE(PG8_SA(0, 0), cA, voffA); PG8_STAGE(PG8_SA(0, 1), cA + hstep, voffA);
        if (wr == 1) PG8_BAR;
        PG8_WAIT_V(2); PG8_BAR;
        PG8_STAGE(PG8_SB(1, 0), cB + kstep, voffB); PG8_STAGE(PG8_SA(1, 0), cA + kstep, voffA); PG8_STAGE(PG8_SB(1, 1), cB + hstep + kstep, voffB);
        PG8_WAIT_V(6); PG8_BAR;
    } else {
        PG8_STAGE(PG8_SB(0, 0), cB, voffB); PG8_STAGE(PG8_SA(0, 0), cA, voffA); PG8_STAGE(PG8_SB(0, 1), cB + hstep, voffB); PG8_STAGE(PG8_SA(0, 1), cA + hstep, voffA);
        if (wr == 1) PG8_BAR;
        PG8_WAIT_V(4); PG8_BAR;
        PG8_STAGE(PG8_SB(1, 0), cB + kstep, voffB); PG8_STAGE(PG8_SA(1, 0), cA + kstep, voffA); PG8_STAGE(PG8_SB(1, 1), cB + hstep + kstep, voffB);
        PG8_WAIT_V(6); PG8_BAR;
    }
    for (;;) {
        const bool has_next = S.next(ui + 1, nxt);
        const char* nA = has_next ? (const char*)g.A + (size_t)nxt.pm * tstep : cA; const char* nB = has_next ? (const char*)g.Bt + (size_t)nxt.pn * tstep : cB;
        for (int t = 0; t < nt; t += 2) {
            const bool last = (t == nt - 2);
            const char* a1 = cA + (size_t)(t + 1) * kstep;
            const char* a2 = last ? nA : cA + (size_t)(t + 2) * kstep; const char* b2 = last ? nB : cB + (size_t)(t + 2) * kstep;
            const char* a3 = a2 + kstep; const char* b3 = b2 + kstep;
            if (last && has_next) S.a_ready(nxt);
            if constexpr (SP2) {
            PG8_LDB(B0, 0, 0); PG8_LDB(B1, 0, 1); PG8_SCHED; PG8_LDA(At, 0, 0); PG8_STAGE(PG8_SA(1, 1), a1 + hstep, voffA);
            PG8_WAIT_V(8); PG8_WAIT_L(0); PG8_BAR; PG8_MMA(0, 0, At, B0); PG8_MMA(0, 1, At, B1); PG8_BAR; PG8_SCHED;
            PG8_LDA(At, 0, 1); PG8_STAGE(PG8_SB(0, 0), b2, voffB); PG8_STAGE(PG8_SB(0, 1), b2 + hstep, voffB); PG8_STAGE(PG8_SA(0, 0), a2, voffA);
            PG8_WAIT_V(8); PG8_WAIT_L(0); PG8_BAR; PG8_MMA(1, 0, At, B0); PG8_MMA(1, 1, At, B1); PG8_BAR; PG8_SCHED;
            PG8_LDB(B0, 1, 0); PG8_LDB(B1, 1, 1); PG8_SCHED; PG8_LDA(At, 1, 0); PG8_STAGE(PG8_SA(0, 1), a2 + hstep, voffA);
            PG8_WAIT_V(8); PG8_WAIT_L(0); PG8_BAR; PG8_MMA(0, 0, At, B0); PG8_MMA(0, 1, At, B1); PG8_BAR; PG8_SCHED;
            PG8_LDA(At, 1, 1); PG8_STAGE(PG8_SB(1, 0), b3, voffB); PG8_STAGE(PG8_SB(1, 1), b3 + hstep, voffB); PG8_STAGE(PG8_SA(1, 0), a3, voffA);
            PG8_WAIT_V(8); PG8_WAIT_L(0); PG8_BAR; PG8_MMA(1, 0, At, B0); PG8_MMA(1, 1, At, B1); PG8_BAR; PG8_SCHED;
            } else {
            PG8_LDB(B0, 0, 0); PG8_SCHED; PG8_LDA(At, 0, 0); PG8_STAGE(PG8_SA(1, 1), a1 + hstep, voffA);
            PG8_WAIT_L(8); PG8_BAR; PG8_WAIT_L(0); PG8_MMA(0, 0, At, B0); PG8_BAR; PG8_SCHED;
            PG8_LDB(B1, 0, 1); PG8_STAGE(PG8_SB(0, 0), b2, voffB);
            PG8_BAR; PG8_WAIT_L(0); PG8_MMA(0, 1, At, B1); PG8_BAR;
            PG8_LDA(At, 0, 1); PG8_STAGE(PG8_SA(0, 0), a2, voffA);
            PG8_BAR; PG8_WAIT_L(0); PG8_MMA(1, 0, At, B0); PG8_BAR; PG8_SCHED;
            PG8_STAGE(PG8_SB(0, 1), b2 + hstep, voffB);
            PG8_WAIT_V(6); PG8_BAR; PG8_MMA(1, 1, At, B1); PG8_BAR;
            PG8_LDB(B0, 1, 0); PG8_SCHED; PG8_LDA(At, 1, 0); PG8_STAGE(PG8_SA(0, 1), a2 + hstep, voffA);
            PG8_WAIT_L(8); PG8_BAR; PG8_WAIT_L(0); PG8_MMA(0, 0, At, B0); PG8_BAR; PG8_SCHED;
            PG8_LDB(B1, 1, 1); PG8_STAGE(PG8_SB(1, 0), b3, voffB);
            PG8_BAR; PG8_WAIT_L(0); PG8_MMA(0, 1, At, B1); PG8_BAR;
            PG8_LDA(At, 1, 1); PG8_STAGE(PG8_SA(1, 0), a3, voffA);
            PG8_BAR; PG8_WAIT_L(0); PG8_MMA(1, 0, At, B0); PG8_BAR; PG8_SCHED;
            PG8_STAGE(PG8_SB(1, 1), b3 + hstep, voffB);
            PG8_WAIT_V(6); PG8_BAR; PG8_MMA(1, 1, At, B1); PG8_BAR;
            }
        }
        if constexpr (ALIGN_EPI) { if (wr == 0) PG8_BAR; }
        if constexpr (!Epi::AFTER_DRAIN) { E(acc, cur, wr, wc, fr, fq); S.done(cur); }
        if (!has_next) break;
#pragma unroll
        for (int a = 0; a < 2; ++a)
#pragma unroll
            for (int b = 0; b < 2; ++b)
#pragma unroll
                for (int m = 0; m < 4; ++m)
#pragma unroll
                    for (int n = 0; n < 2; ++n) acc[a][b][m][n] = (f32x4){0.f, 0.f, 0.f, 0.f};
        cur = nxt; cA = nA; cB = nB; ++ui;
        if constexpr (ALIGN_EPI) { if (wr == 1) PG8_BAR; }
    }
    PG8_WAIT_V(0);
    if constexpr (!ALIGN_EPI) { if (wr == 0) PG8_BAR; }
    PG8_BAR;
    if constexpr (Epi::AFTER_DRAIN) { E.fused(acc, cur, wr, wc, fr, fq, lds, wid, lane); S.done(cur); }
#undef PG8_SA
#undef PG8_SB
#undef PG8_STAGE
#undef PG8_LDA
#undef PG8_LDB
#undef PG8_MMA
#undef PG8_WAIT_V
#undef PG8_WAIT_L
#undef PG8_BAR
#undef PG8_SCHED
}
}

constexpr int TP = 8192, TS = 512, T = TP + TS, DM = 2048, NSEQ = 132;
constexpr int NAB = 7424, NCD = 4864;
constexpr int NWAVES = 8, NTHR = 512;
constexpr size_t MiB = 1u << 20;
constexpr size_t WS_CTL = 0, CTL_ZERO_BYTES = 1 * MiB;
constexpr int CW_BAR = 4096, CW_CNT = 8192;
constexpr size_t WS_RSS = 65536;
constexpr size_t WS_WABIN = 2 * MiB, WS_WABOUT = 60 * MiB, WS_WCDIN = 76 * MiB, WS_WCDOUT = 114 * MiB, WS_WGATE = 130 * MiB, WS_WPROJ = 162 * MiB;
constexpr size_t WS_H = 166 * MiB, WS_XN = 234 * MiB, WS_YM = 268 * MiB, WS_PB = 302 * MiB, WS_U = 320 * MiB, WS_SCR = 444 * MiB, WS_END = 732 * MiB;
constexpr size_t SC_HB1 = 102 * MiB;
constexpr size_t SC_PP = 8 * MiB;
constexpr size_t SC_QN = 0, SC_KN = 2 * MiB, SC_VV = 4 * MiB, SC_GLOG = 6 * MiB, SC_BETA = 7 * MiB, SC_GDEC = 7 * MiB + 65536, SC_ODN = 102 * MiB, SC_OGLA = 136 * MiB,
    SC_DNOPS = 192 * MiB;
constexpr size_t SC_XBC = 0, SC_DT = 3 * MiB, SC_LA = 52 * MiB, SC_LB = 86 * MiB, SC_YS = 120 * MiB, SC_HS = 154 * MiB, SC_SSDOP = 192 * MiB, SC_XS = 270 * MiB;
constexpr int LDS_BYTES = 163840;
constexpr size_t O_Y_P = 0, O_Y_S = O_Y_P + (size_t)4 * 2048 * 2048, O_DN_P = O_Y_S + (size_t)128 * 4 * 2048,
    O_DNC_P = O_DN_P + (size_t)2 * 4 * 8 * 128 * 128, O_GLA_P = O_DNC_P + (size_t)2 * 4 * 3 * 3072, O_SSD_P = O_GLA_P + (size_t)2 * 4 * 4 * 128 * 256,
    O_SSDC_P = O_SSD_P + (size_t)2 * 4 * 16 * 64 * 64, O_LRU_P = O_SSDC_P + (size_t)2 * 4 * 3 * 1536, O_LRUC_P = O_LRU_P + (size_t)2 * 4 * 1024,
    O_DN_S = O_LRUC_P + (size_t)2 * 4 * 3 * 1024, O_DNC_S = O_DN_S + (size_t)2 * 128 * 8 * 128 * 128, O_GLA_S = O_DNC_S + (size_t)2 * 128 * 3 * 3072,
    O_SSD_S = O_GLA_S + (size_t)2 * 128 * 4 * 128 * 256, O_SSDC_S = O_SSD_S + (size_t)2 * 128 * 16 * 64 * 64, O_LRU_S = O_SSDC_S + (size_t)2 * 128 * 3 * 1536,
    O_LRUC_S = O_LRU_S + (size_t)2 * 128 * 1024, O_END = O_LRUC_S + (size_t)2 * 128 * 3 * 1024;
static_assert(O_END == 109064192, "output size");

#define LAS __attribute__((address_space(3)))
typedef unsigned short bf16;
typedef float f32x4 __attribute__((ext_vector_type(4)));
typedef unsigned u32x2 __attribute__((ext_vector_type(2)));
typedef unsigned u32x4 __attribute__((ext_vector_type(4)));
#define LDS_WAIT() asm volatile("s_waitcnt lgkmcnt(0)" ::: "memory")

__device__ __forceinline__ float bf2f(bf16 b) { return __uint_as_float(((unsigned)b) << 16); }
__device__ __forceinline__ unsigned f2bf(float f) { unsigned u = __float_as_uint(f); return (u + 0x7fffu + ((u >> 16) & 1u)) >> 16; }
__device__ __forceinline__ unsigned pk2(float lo, float hi) { return f2bf(lo) | (f2bf(hi) << 16); }
__device__ __forceinline__ float sigmoid_(float x) { return __builtin_amdgcn_rcpf(1.f + __expf(-x)); }
__device__ __forceinline__ float silu_(float x) { return x * __builtin_amdgcn_rcpf(1.f + __expf(-x)); }
__device__ __forceinline__ float softplus_(float x) { return x > 15.f ? x : (x < -15.f ? __expf(x) : __logf(1.f + __expf(x))); }
__device__ __forceinline__ float wave_sum(float v) {
#pragma unroll
    for (int o = 1; o < 64; o <<= 1) v += __shfl_xor(v, o);
    return v;
}
__device__ __forceinline__ void row_to_seq(int r, int& s, int& t) { if (r < TP) { s = r >> 11; t = r & 2047; } else { s = 4 + ((r - TP) >> 2); t = (r - TP) & 3; } }
__device__ __forceinline__ void seq_info(int s, int& row0, int& L) { if (s < 4) { row0 = s << 11; L = 2048; } else { row0 = TP + ((s - 4) << 2); L = 4; } }
__device__ __forceinline__ float pre_val(const bf16* U, int ldu, int ucol, int row0, int tt, int s, const float* stc, int W, int c) {
    const int tc = tt >= 0 ? tt : 0, sc = tt >= 0 ? 0 : 3 + tt;
    const float a = bf2f(U[(size_t)(row0 + tc) * ldu + ucol]), b = stc[((size_t)(s - 4) * 3 + sc) * W + c];
    return tt >= 0 ? a : b;
}
__device__ __forceinline__ int map_col(int mapid, int n) {
    if (mapid == 0) return n;
    if (mapid == 1) { if (n < 3072) return n; if (n < 6144) return n + 16; if (n < 7168) return n + 32; if (n < 7184) return n - 4096; if (n < 7200) return n - 1024; return -1; }
    if (n < 2560) return n; if (n < 4608) return n + 16; if (n < 4624) return n - 2048; return -1;
}
__device__ __forceinline__ void transpose_item(const float* W, int K, int Nsrc, bf16* WT, int Npad, int mapid, const float* gain, LAS float* scr, int item, int lane) {
    const int nblk = Npad / 64, kb = item / nblk, nb = item % nblk, k0 = 64 * kb, n0 = 64 * nb;
    const int n4 = (lane & 15) * 4, src = map_col(mapid, n0 + n4);
    const int srcc = src >= 0 ? src : 0; const float msk = src >= 0 ? 1.f : 0.f;
    f32x4 v[16];
#pragma unroll
    for (int i = 0; i < 16; ++i) v[i] = *(const f32x4*)(W + (size_t)(k0 + 4 * i + (lane >> 4)) * Nsrc + srcc);
    if (gain) {
#pragma unroll
        for (int i = 0; i < 16; ++i) v[i] = v[i] * (gain[k0 + 4 * i + (lane >> 4)] * msk);
    } else {
#pragma unroll
        for (int i = 0; i < 16; ++i) v[i] = v[i] * msk;
    }
#pragma unroll
    for (int i = 0; i < 16; ++i) { const int kk = 4 * i + (lane >> 4); scr[kk * 65 + n4] = v[i].x; scr[kk * 65 + n4 + 1] = v[i].y; scr[kk * 65 + n4 + 2] = v[i].z; scr[kk * 65 + n4 + 3] = v[i].w; }
    LDS_WAIT(); asm volatile("" ::: "memory");
    const int c = lane & 7;
#pragma unroll
    for (int jj = 0; jj < 8; ++jj) { const int n = (lane >> 3) + 8 * jj; const LAS float* p = scr + (8 * c) * 65 + n;
        u32x4 o; o.x = pk2(p[0 * 65], p[1 * 65]); o.y = pk2(p[2 * 65], p[3 * 65]); o.z = pk2(p[4 * 65], p[5 * 65]); o.w = pk2(p[6 * 65], p[7 * 65]);
        *(u32x4*)(WT + (size_t)(n0 + n) * K + k0 + 8 * c) = o; }
    LDS_WAIT(); asm volatile("" ::: "memory");
}
__device__ __forceinline__ void norm_row_bf16(const f32x4 (&v)[8], const float* g, bf16* orow, int lane) {
    float ss = 0.f;
#pragma unroll
    for (int j = 0; j < 8; ++j) ss += (v[j].x * v[j].x + v[j].y * v[j].y) + (v[j].z * v[j].z + v[j].w * v[j].w);
    const float rstd = rsqrtf(wave_sum(ss) * (1.f / DM) + 1e-6f);
#pragma unroll
    for (int j = 0; j < 8; ++j) { const int col = 4 * (lane + 64 * j); const f32x4 gg = *(const f32x4*)(g + col);
        u32x2 o; o.x = pk2(v[j].x * rstd * gg.x, v[j].y * rstd * gg.y); o.y = pk2(v[j].z * rstd * gg.z, v[j].w * rstd * gg.w);
        *(u32x2*)(orow + col) = o; }
}

typedef __bf16 bf16x2_t __attribute__((ext_vector_type(2)));
typedef float f32x2_t __attribute__((ext_vector_type(2)));
typedef short bf16x8 __attribute__((ext_vector_type(8)));
typedef float f32x16 __attribute__((ext_vector_type(16)));
__device__ __forceinline__ unsigned cvtpk(float lo, float hi) { f32x2_t v = {lo, hi}; bf16x2_t b = __builtin_convertvector(v, bf16x2_t); return __builtin_bit_cast(unsigned, b); }
#define MFMA32(a, b, c) __builtin_amdgcn_mfma_f32_32x32x16_bf16((a), (b), (c), 0, 0, 0)
#define PACK_ACC(x, S_) __builtin_bit_cast(bf16x8, (u32x4){cvtpk((x)[8 * (S_)], (x)[8 * (S_) + 1]), cvtpk((x)[8 * (S_) + 2], (x)[8 * (S_) + 3]), cvtpk((x)[8 * (S_) + 4], (x)[8 * (S_) + 5]), cvtpk((x)[8 * (S_) + 6], (x)[8 * (S_) + 7])})
__device__ __forceinline__ int crow(int reg, int h) { return (reg & 3) + 8 * (reg >> 2) + 4 * h; }
__device__ __forceinline__ bf16x8 pack8(const float (&v)[8]) { return __builtin_bit_cast(bf16x8, (u32x4){cvtpk(v[0], v[1]), cvtpk(v[2], v[3]), cvtpk(v[4], v[5]), cvtpk(v[6], v[7])}); }

#define XB_TMO      128
#define XB_XCNT(j)  (256  + 64 * (j))
#define XB_XSUB(j)  (1280 + 64 * (j))
#define XB_XGEN(j)  (2304 + 64 * (j))
#define XB_TOP      3328
#define XB_TOPGEN   3392
#define XCD_BAR_WORDS 3456
#define XB_SPIN_CAP (1u << 18)

__device__ __forceinline__ unsigned xb_ld(unsigned* p)              { return __hip_atomic_load(p, __ATOMIC_RELAXED, __HIP_MEMORY_SCOPE_AGENT); }
__device__ __forceinline__ unsigned xb_add(unsigned* p, unsigned v) { return __hip_atomic_fetch_add(p, v, __ATOMIC_RELAXED, __HIP_MEMORY_SCOPE_AGENT); }
__device__ __forceinline__ unsigned xb_xcc_id() { return (unsigned)__builtin_amdgcn_s_getreg((3 << 11) | 20) & 0xFu; }
#define XB_SPIN(cond, bar) do { unsigned _sp = 0; while (cond) { __builtin_amdgcn_s_sleep(1); \
    if ((++_sp & 255u) == 0u) { if (xb_ld(&(bar)[XB_TMO])) break; if (_sp > XB_SPIN_CAP) { atomicAdd(&(bar)[XB_TMO], 1u); break; } } } } while (0)

struct XcdBarrier {
    unsigned* bar; unsigned x;
    volatile LAS unsigned* st;
};

__device__ __forceinline__ XcdBarrier xcd_barrier_post(unsigned* bar, volatile LAS unsigned* st) {
    XcdBarrier b; b.bar = bar; b.x = xb_xcc_id(); b.st = st;
    if (threadIdx.x == 0) (void)xb_add(&bar[XB_XCNT(b.x)], 1u);
    return b;
}
__device__ __forceinline__ void xcd_barrier_complete(unsigned* bar, unsigned x, unsigned& nloc, unsigned& nx) {
    const unsigned G = gridDim.x * gridDim.y * gridDim.z;
    unsigned sum, cnt, mine, sp = 0u;
    for (;;) {
        sum = 0u; cnt = 0u; mine = 0u;
#pragma unroll
        for (unsigned j = 0; j < 16; ++j) { const unsigned c = xb_ld(&bar[XB_XCNT(j)]); sum += c; cnt += (c > 0u) ? 1u : 0u; mine = (j == x) ? c : mine; }
        if (sum == G) break;
        __builtin_amdgcn_s_sleep(1);
        if ((++sp & 255u) == 0u) { if (xb_ld(&bar[XB_TMO])) break; if (sp > XB_SPIN_CAP) { atomicAdd(&bar[XB_TMO], 1u); break; } }
    }
    nloc = mine > 0u ? mine : 1u; nx = cnt > 0u ? cnt : 1u;
}

__device__ __forceinline__ void xcd_barrier(const XcdBarrier& b) {
    asm volatile("s_waitcnt vmcnt(0)" ::: "memory");
    __syncthreads();
    if (threadIdx.x == 0) {
        unsigned* bar = b.bar;
        __builtin_amdgcn_s_waitcnt(0);
        unsigned nloc = b.st[0], nx = b.st[1];
        if (nloc == 0u) { xcd_barrier_complete(bar, b.x, nloc, nx); b.st[0] = nloc; b.st[1] = nx; }
        const unsigned old = xb_add(&bar[XB_XSUB(b.x)], 1u);
        const unsigned gen = old / nloc;
        if (old + 1u == (gen + 1u) * nloc) {
            __builtin_amdgcn_fence(__ATOMIC_RELEASE, "agent");
            asm volatile("s_waitcnt vmcnt(0)" ::: "memory");
            const unsigned og = xb_add(&bar[XB_TOP], 1u);
            const unsigned tg = og / nx;
            if (og + 1u == (tg + 1u) * nx) xb_add(&bar[XB_TOPGEN], 1u);
            else XB_SPIN(xb_ld(&bar[XB_TOPGEN]) == tg, bar);
            __builtin_amdgcn_fence(__ATOMIC_ACQUIRE, "agent");
            xb_add(&bar[XB_XGEN(b.x)], 1u);
            asm volatile("s_waitcnt vmcnt(0)" ::: "memory");
        } else {
            XB_SPIN(xb_ld(&bar[XB_XGEN(b.x)]) == gen, bar);
            __builtin_amdgcn_fence(__ATOMIC_ACQUIRE, "agent");
            asm volatile("s_waitcnt vmcnt(0)" ::: "memory");
        }
    }
    __syncthreads();
}


#ifdef PROBE_SEC
#define SEC_BEGIN(id) unsigned long long _sec_t##id = 0; if ((id) == PROBE_SEC) { __builtin_amdgcn_s_barrier(); _sec_t##id = __builtin_amdgcn_s_memrealtime(); }
#define SEC_END(id, ldsp) if ((id) == PROBE_SEC) { __builtin_amdgcn_s_barrier(); if (threadIdx.x == 0) { volatile LAS unsigned long long* a_ = (volatile LAS unsigned long long*)((ldsp) + LDS_BYTES - 32); a_[0] = a_[0] + (__builtin_amdgcn_s_memrealtime() - _sec_t##id); } }
#else
#define SEC_BEGIN(id)
#define SEC_END(id, ldsp)
#endif
struct Args { const float* in[40]; float* out; unsigned char* ws; int ph_lo, ph_hi; };
constexpr int N_PHASES = 26, SUBS = 6;
#ifndef PH_MASK
#define PH_MASK 16383
#endif
#define AS4 __attribute__((address_space(4)))
struct KP { const char AS4* p;
    __device__ __forceinline__ const float* in(int i) const { return *(const float* const AS4*)(p + 8 * i); }
    __device__ __forceinline__ float* out() const { return *(float* const AS4*)(p + 320); }
    __device__ __forceinline__ unsigned char* ws() const { return *(unsigned char* const AS4*)(p + 328); }
};
static_assert(sizeof(Args) == 344, "Args layout");

__device__ __forceinline__ void phase_prologue(const KP kp, LAS unsigned char* lds, int gw, int NGW, int wave, int lane) {
    unsigned char* ws = kp.ws();
    LAS float* scr = (LAS float*)(lds + wave * 17408);
    SEC_BEGIN(1)
    SEC_BEGIN(14)
    for (int job = 0; job < 16; ++job) {
        if (job == 2) { SEC_END(14, lds) }
        const float* W; int K = 2048, Nsrc = 2048, Npad = 2048, mapid = 0; bf16* WT; const float* gain = nullptr;
        if (job < 2)       { W = kp.in(13) + (size_t)job * 2048 * 7200; Nsrc = 7200; Npad = NAB; mapid = 1; WT = (bf16*)(ws + WS_WABIN) + (size_t)job * NAB * 2048; gain = kp.in(11) + (size_t)(2 * job) * DM; }
        else if (job < 4)  { W = kp.in(21) + (size_t)(job - 2) * 2048 * 2048; WT = (bf16*)(ws + WS_WABOUT) + (size_t)(job - 2) * 2048 * 2048; }
        else if (job < 6)  { W = kp.in(22) + (size_t)(job - 4) * 2048 * 4624; Nsrc = 4624; Npad = NCD; mapid = 2; WT = (bf16*)(ws + WS_WCDIN) + (size_t)(job - 4) * NCD * 2048; gain = kp.in(11) + (size_t)(2 * (job - 4) + 1) * DM; }
        else if (job < 8)  { W = kp.in(36) + (size_t)(job - 6) * 2048 * 2048; WT = (bf16*)(ws + WS_WCDOUT) + (size_t)(job - 6) * 2048 * 2048; }
        else if (job < 12) { W = kp.in(39) + (size_t)(job - 8) * 2048 * 2048; WT = (bf16*)(ws + WS_WGATE) + (size_t)(job - 8) * 2048 * 2048; gain = kp.in(38) + (size_t)(job - 8) * DM; }
        else               { W = kp.in(37) + (size_t)(job - 12) * 256 * 2048; K = 256; WT = (bf16*)(ws + WS_WPROJ) + (size_t)(job - 12) * 2048 * 256; }
        const int nitems = (K / 64) * (Npad / 64), nblocks = NGW / NWAVES, ipb = (nitems + nblocks - 1) / nblocks, ib = (gw / NWAVES) * ipb, ie = ib + ipb < nitems ? ib + ipb : nitems;
        for (int it = ib + wave; it < ie; it += NWAVES) transpose_item(W, K, Nsrc, WT, Npad, mapid, gain, scr, it, lane);
    }
    SEC_END(1, lds)
    SEC_BEGIN(2)
    bf16* HB = (bf16*)(ws + WS_XN); float* RSS = (float*)(ws + WS_RSS);
    for (int m = gw; m < T; m += NGW) {
        const float* src = m < TP ? kp.in(0) + (size_t)m * DM : kp.in(1) + (size_t)(m - TP) * DM;
        float ss = 0.f;
#pragma unroll
        for (int jj = 0; jj < 8; ++jj) { const int col = 4 * (lane + 64 * jj); const f32x4 v = *(const f32x4*)(src + col);
            u32x2 o; o.x = pk2(v.x, v.y); o.y = pk2(v.z, v.w); *(u32x2*)(HB + (size_t)m * DM + col) = o; ss += (v.x * v.x + v.y * v.y) + (v.z * v.z + v.w * v.w); }
        ss = wave_sum(ss); if (lane == 0) RSS[m] = ss;
    }
    bf16* PB = (bf16*)(ws + WS_PB);
    const int gt = gw * 64 + lane, NGT = NGW * 64;
    for (int i = gt; i < 4 * T * 64; i += NGT) {
        const int c4 = i & 63, rr = i >> 6, li = rr / T, r = rr - li * T;
        const float* src = r < TP ? kp.in(9) + ((size_t)li * TP + r) * 256 + 4 * c4 : kp.in(10) + ((size_t)li * TS + (r - TP)) * 256 + 4 * c4;
        const f32x4 v = *(const f32x4*)src;
        u32x2 o; o.x = pk2(v.x, v.y); o.y = pk2(v.z, v.w);
        *(u32x2*)(PB + ((size_t)li * T + r) * 256 + 4 * c4) = o;
    }
    SEC_END(2, lds)
}
__device__ __forceinline__ void phase_final(const KP kp, int gw, int NGW, int lane) {
    const bf16* HB = (const bf16*)(kp.ws() + WS_XN); const float* RSS = (const float*)(kp.ws() + WS_RSS) + (size_t)8 * T; const float* g = kp.in(12); float* out = kp.out();
    for (int m = gw; m < T; m += NGW) { const float rstd = rsqrtf(RSS[m] * (1.f / DM) + 1e-6f);
#pragma unroll
        for (int jj = 0; jj < 8; ++jj) { const int col = 4 * (lane + 64 * jj); const u32x2 hv = *(const u32x2*)(HB + (size_t)m * DM + col); const f32x4 gg = *(const f32x4*)(g + col);
            f32x4 o; o.x = __uint_as_float(hv.x << 16) * rstd * gg.x; o.y = __uint_as_float(hv.x & 0xffff0000u) * rstd * gg.y; o.z = __uint_as_float(hv.y << 16) * rstd * gg.z; o.w = __uint_as_float(hv.y & 0xffff0000u) * rstd * gg.w;
            *(f32x4*)(out + (size_t)m * DM + col) = o; } }
}

__device__ __forceinline__ void phase_ab_pre(const KP kp, const int bid, const int G, int j, int tid, int wave, int lane) {
    unsigned char* scr = kp.ws() + WS_SCR; const bf16* U = (const bf16*)(kp.ws() + WS_U);
    float* QN = (float*)(scr + SC_QN) - (size_t)TP * 1024; float* KN = (float*)(scr + SC_KN) - (size_t)TP * 1024; float* VV = (float*)(scr + SC_VV) - (size_t)TP * 1024;
    float* GLOG = (float*)(scr + SC_GLOG) - (size_t)TP * 512; float* BETA = (float*)(scr + SC_BETA) - (size_t)TP * 8; float* GDEC = (float*)(scr + SC_GDEC) - (size_t)TP * 8;
    const float* cw = kp.in(14) + (size_t)j * 4 * 3072; const float* stc = kp.in(3) + (size_t)j * 128 * 3 * 3072;
    const float* wa2 = kp.in(18) + (size_t)j * 16 * 512; const float* ba = kp.in(19) + (size_t)j * 512;
    for (int r = TP + bid; r < T; r += G) {
        int s, t; row_to_seq(r, s, t); const int row0 = r - t;
#pragma unroll
        for (int part = 0; part < 3; ++part) {
            float val[2];
#pragma unroll
            for (int i = 0; i < 2; ++i) { const int c = part * 1024 + wave * 128 + lane + 64 * i; float acc = 0.f;
#pragma unroll
                for (int tap = 0; tap < 4; ++tap) acc += cw[tap * 3072 + c] * pre_val(U, NAB, c, row0, t - 3 + tap, s, stc, 3072, c);
                val[i] = silu_(acc); }
            if (part < 2) { const float ss = wave_sum(val[0] * val[0] + val[1] * val[1]); const float sc = rsqrtf(ss + 1e-6f) * (part == 0 ? 0.08838834764831845f : 1.f); val[0] *= sc; val[1] *= sc; }
            float* dst = part == 0 ? QN : (part == 1 ? KN : VV);
            dst[(size_t)r * 1024 + wave * 128 + lane] = val[0]; dst[(size_t)r * 1024 + wave * 128 + lane + 64] = val[1];
        }
        if (tid < 8) {
            BETA[(size_t)r * 8 + tid] = sigmoid_(bf2f(U[(size_t)r * NAB + 7168 + tid]));
            GDEC[(size_t)r * 8 + tid] = -__expf(kp.in(15)[j * 8 + tid]) * softplus_(bf2f(U[(size_t)r * NAB + 7176 + tid]) + kp.in(16)[j * 8 + tid]);
        }
        { float x = ba[tid];
#pragma unroll
          for (int rr = 0; rr < 16; ++rr) x += bf2f(U[(size_t)r * NAB + 7184 + rr]) * wa2[rr * 512 + tid];
          GLOG[(size_t)r * 512 + tid] = -softplus_(-x) * (1.f / 16.f); }
    }
}


constexpr size_t GLA_ITEM_BYTES = 74752, WS_GLAOPS = WS_H;
__device__ __forceinline__ void phase_gla_prep(const KP kp, const int bid, const int G, int j, LAS unsigned char* lds, int tid0) {
    const bf16* U = (const bf16*)(kp.ws() + WS_U);
    const float* wa2 = kp.in(18) + (size_t)j * 16 * 512; const float* ba = kp.in(19) + (size_t)j * 512;
    unsigned char* OPS = kp.ws() + WS_GLAOPS;
    LAS float* GE = (LAS float*)lds; LAS float* Pg = GE + 128;
    LAS bf16* Qg = (LAS bf16*)(Pg + 512); LAS bf16* Ka = Qg + 64 * 136; LAS float* QKm = (LAS float*)(Ka + 64 * 136);
    for (int item = bid; item < 512; item += G) {
        int tid = tid0; asm volatile("" : "+v"(tid));
        const int lane = tid & 63, r = lane & 31, hp = lane >> 5, wave = tid >> 6;
        const int b = item >> 7, n = (item >> 2) & 31, h = item & 3;
        const int row0 = b * 2048 + n * 64;
        __syncthreads();
        const int d = tid & 127, tg = tid >> 7, t0 = 16 * tg;
        float q[16], k[16], gl[16];
        { float w[16];
#pragma unroll
          for (int rr = 0; rr < 16; ++rr) w[rr] = wa2[rr * 512 + h * 128 + d];
          const float bias = ba[h * 128 + d];
#pragma unroll
          for (int t = 0; t < 16; ++t) { const size_t ro = (size_t)(row0 + t0 + t) * NAB;
              q[t] = bf2f(U[ro + 4096 + h * 128 + d]) * 0.08838834764831845f; k[t] = bf2f(U[ro + 4608 + h * 128 + d]);
              const u32x4 g0 = *(const u32x4*)(U + ro + 7184), g1 = *(const u32x4*)(U + ro + 7192);
              float x = bias;
              x += __uint_as_float(g0.x << 16) * w[0] + __uint_as_float(g0.x & 0xffff0000u) * w[1] + __uint_as_float(g0.y << 16) * w[2] + __uint_as_float(g0.y & 0xffff0000u) * w[3];
              x += __uint_as_float(g0.z << 16) * w[4] + __uint_as_float(g0.z & 0xffff0000u) * w[5] + __uint_as_float(g0.w << 16) * w[6] + __uint_as_float(g0.w & 0xffff0000u) * w[7];
              x += __uint_as_float(g1.x << 16) * w[8] + __uint_as_float(g1.x & 0xffff0000u) * w[9] + __uint_as_float(g1.y << 16) * w[10] + __uint_as_float(g1.y & 0xffff0000u) * w[11];
              x += __uint_as_float(g1.z << 16) * w[12] + __uint_as_float(g1.z & 0xffff0000u) * w[13] + __uint_as_float(g1.w << 16) * w[14] + __uint_as_float(g1.w & 0xffff0000u) * w[15];
              gl[t] = -softplus_(-x) * (1.f / 16.f); } }
#pragma unroll
        for (int t = 1; t < 16; ++t) gl[t] += gl[t - 1];
        Pg[tg * 128 + d] = gl[15];
        __syncthreads();
        { float off = 0.f;
#pragma unroll
          for (int g = 0; g < 3; ++g) off += (g < tg) ? Pg[g * 128 + d] : 0.f;
          if (tg == 3) GE[d] = gl[15] + off;
#pragma unroll
          for (int t = 0; t < 16; ++t) { const float Gt = gl[t] + off; Qg[(t0 + t) * 136 + d] = (bf16)f2bf(q[t] * __expf(Gt)); Ka[(t0 + t) * 136 + d] = (bf16)f2bf(k[t] * __expf(-Gt)); } }
        __syncthreads();
        bf16x8* base = (bf16x8*)(OPS + (size_t)item * GLA_ITEM_BYTES);
        if (wave < 4) {
            const int mt = wave >> 1, nt = wave & 1;
            f32x16 acc;
#pragma unroll
            for (int i = 0; i < 16; ++i) acc[i] = 0.f;
#pragma unroll
            for (int ks = 0; ks < 8; ++ks) acc = MFMA32(*(const LAS bf16x8*)(Qg + (32 * mt + r) * 136 + 16 * ks + 8 * hp), *(const LAS bf16x8*)(Ka + (32 * nt + r) * 136 + 16 * ks + 8 * hp), acc);
            const int jt = 32 * nt + r;
#pragma unroll
            for (int i16 = 0; i16 < 16; ++i16) { const int i = 32 * mt + crow(i16, hp); QKm[i * 65 + jt] = jt <= i ? acc[i16] : 0.f; }
        } else {
            const int w4 = wave - 4;
#pragma unroll
            for (int q8 = 0; q8 < 8; ++q8) { const int f = w4 + 4 * q8, nt = f >> 2, ks = f & 3, p = 32 * nt + r;
                unsigned w[4];
#pragma unroll
                for (int jp = 0; jp < 8; jp += 2) { const int tk = 16 * ks + 8 * (jp >> 2) + 4 * hp + (jp & 3);
                    w[jp >> 1] = (unsigned)U[(size_t)(row0 + tk) * NAB + 5120 + h * 256 + p] | ((unsigned)U[(size_t)(row0 + tk + 1) * NAB + 5120 + h * 256 + p] << 16); }
                base[(40 + f) * 64 + lane] = __builtin_bit_cast(bf16x8, (u32x4){w[0], w[1], w[2], w[3]}); }
        }
        __syncthreads();
        float v[8];
#pragma unroll
        for (int q2 = 0; q2 < 2; ++q2) { const int f = wave + 8 * q2;
            { const int mt = f >> 3, ks = f & 7, i = 32 * mt + r;
              const u32x2 lo = *(const LAS u32x2*)(Qg + i * 136 + 16 * ks + 4 * hp), hi = *(const LAS u32x2*)(Qg + i * 136 + 16 * ks + 8 + 4 * hp);
              base[f * 64 + lane] = __builtin_bit_cast(bf16x8, (u32x4){lo.x, lo.y, hi.x, hi.y}); }
            { const int mt = f >> 2, ks = f & 3, dd = 32 * mt + r; const float eg = __expf(GE[dd]);
#pragma unroll
              for (int jp = 0; jp < 8; ++jp) v[jp] = bf2f(Ka[(16 * ks + 8 * (jp >> 2) + 4 * hp + (jp & 3)) * 136 + dd]) * eg;
              base[(16 + f) * 64 + lane] = pack8(v); } }
        { const int f = wave, mt = f >> 2, ks = f & 3, i = 32 * mt + r;
#pragma unroll
          for (int jp = 0; jp < 8; ++jp) v[jp] = QKm[i * 65 + 16 * ks + 8 * (jp >> 2) + 4 * hp + (jp & 3)];
          base[(32 + f) * 64 + lane] = pack8(v); }
        if (tid < 128) ((float*)(base + 72 * 64))[tid] = __expf(GE[tid]);
    }
}

constexpr size_t DN_ITEM_BYTES = 74752;
__device__ __forceinline__ void phase_dn_prep(const KP kp, const int bid, const int G, int j, LAS unsigned char* lds, int tid0) {
    unsigned char* scr = kp.ws() + WS_SCR;
    const bf16* U = (const bf16*)(kp.ws() + WS_U); const float* cw = kp.in(14) + (size_t)j * 4 * 3072;
    unsigned char* OPS = scr + SC_DNOPS;
    LAS float* AMT = (LAS float*)lds; LAS float* GLs = AMT + 64 * 68; LAS float* BLs = GLs + 64; LAS float* SS = BLs + 64;
    LAS bf16* Kb = (LAS bf16*)(SS + 256); LAS bf16* Qb = Kb + 64 * 136; LAS float* QKm = (LAS float*)(Qb + 64 * 136); LAS float* XL = QKm + 64 * 65;
    for (int item = bid; item < 1024; item += G) {
        int tid = tid0; asm volatile("" : "+v"(tid));
        const int lane = tid & 63, r = lane & 31, hp = lane >> 5, wave = tid >> 6;
        const int b = item >> 8, n = (item >> 3) & 31, h = item & 7;
        const int row0 = b * 2048 + n * 64;
        __syncthreads();
        float qv[16], kv[16];
        { const int d = tid & 127, tg = tid >> 7, t0 = 16 * tg;
          const bool first = (n == 0 && tg == 0);
#pragma unroll
          for (int part = 0; part < 3; ++part) { const int c = part * 1024 + h * 128 + d;
              const float w0 = cw[c], w1 = cw[3072 + c], w2 = cw[2 * 3072 + c], w3 = cw[3 * 3072 + c];
              const bf16* up = U + (size_t)(row0 + t0) * NAB + c;
              const long fo = first ? 0 : (long)NAB;
              float x0 = bf2f(up[-3 * fo]), x1 = bf2f(up[-2 * fo]), x2 = bf2f(up[-1 * fo]); if (first) { x0 = 0.f; x1 = 0.f; x2 = 0.f; }
#pragma unroll
              for (int t = 0; t < 16; ++t) { const float x3 = bf2f(up[(size_t)t * NAB]); const float y = silu_(w0 * x0 + w1 * x1 + w2 * x2 + w3 * x3); x0 = x1; x1 = x2; x2 = x3;
                  if (part == 0) qv[t] = y; else if (part == 1) kv[t] = y; else XL[(t0 + t) * 257 + d] = y; } }
          const int half = (tid >> 6) & 1;
#pragma unroll
          for (int t = 0; t < 16; ++t) { const float sq = wave_sum(qv[t] * qv[t]), sk = wave_sum(kv[t] * kv[t]); if (lane == 0) { SS[half * 64 + t0 + t] = sq; SS[(2 + half) * 64 + t0 + t] = sk; } } }
        if (wave == 0) { const size_t ro = (size_t)(row0 + lane) * NAB;
            float gv = -__expf(kp.in(15)[j * 8 + h]) * softplus_(bf2f(U[ro + 7176 + h]) + kp.in(16)[j * 8 + h]);
#pragma unroll
            for (int o = 1; o < 64; o <<= 1) { const float tt = __shfl_up(gv, o); if (lane >= o) gv += tt; }
            GLs[lane] = gv; BLs[lane] = sigmoid_(bf2f(U[ro + 7168 + h])); }
        __syncthreads();
        { const int d = tid & 127, t0 = 16 * (tid >> 7);
#pragma unroll
          for (int t = 0; t < 16; ++t) { const float scq = rsqrtf(SS[t0 + t] + SS[64 + t0 + t] + 1e-6f) * 0.08838834764831845f, sck = rsqrtf(SS[128 + t0 + t] + SS[192 + t0 + t] + 1e-6f);
              Qb[(t0 + t) * 136 + d] = (bf16)f2bf(qv[t] * scq); Kb[(t0 + t) * 136 + d] = (bf16)f2bf(kv[t] * sck); } }
        __syncthreads();
        bf16x8* base = (bf16x8*)(OPS + (size_t)item * DN_ITEM_BYTES);
        { const int which = wave >> 2, mt = (wave >> 1) & 1, nt = wave & 1;
          const LAS bf16* Asrc = which ? Qb : Kb;
          f32x16 acc;
#pragma unroll
          for (int i = 0; i < 16; ++i) acc[i] = 0.f;
#pragma unroll
          for (int ks = 0; ks < 8; ++ks) acc = MFMA32(*(const LAS bf16x8*)(Asrc + (32 * mt + r) * 136 + 16 * ks + 8 * hp), *(const LAS bf16x8*)(Kb + (32 * nt + r) * 136 + 16 * ks + 8 * hp), acc);
          const int jt = 32 * nt + r; const float gj = GLs[jt];
#pragma unroll
          for (int i16 = 0; i16 < 16; ++i16) { const int i = 32 * mt + crow(i16, hp); const float dec = __expf(GLs[i] - gj);
              if (which == 0) AMT[jt * 68 + i] = jt < i ? BLs[i] * acc[i16] * dec : 0.f; else QKm[i * 65 + jt] = jt <= i ? acc[i16] * dec : 0.f; } }
        __syncthreads();
        if (tid < 256) {
            const int c = tid;
#pragma unroll
            for (int bi = 0; bi < 4; ++bi) {
                float acc[16];
#pragma unroll
                for (int ii = 0; ii < 16; ++ii) { const int i = 16 * bi + ii; const float be = BLs[i];
                    acc[ii] = c < 128 ? be * XL[i * 257 + c] : be * __expf(GLs[i]) * bf2f(Kb[i * 136 + (c - 128)]); }
                for (int jj = 0; jj < 16 * bi; ++jj) { const float xj = XL[jj * 257 + c];
#pragma unroll
                    for (int q = 0; q < 4; ++q) { const f32x4 a = *(const LAS f32x4*)(AMT + jj * 68 + 16 * bi + 4 * q);
                        acc[4 * q + 0] -= a[0] * xj; acc[4 * q + 1] -= a[1] * xj; acc[4 * q + 2] -= a[2] * xj; acc[4 * q + 3] -= a[3] * xj; } }
#pragma unroll
                for (int ii = 0; ii < 16; ++ii) { float x = acc[ii];
#pragma unroll
                    for (int jj = 0; jj < ii; ++jj) x -= AMT[(16 * bi + jj) * 68 + 16 * bi + ii] * acc[jj];
                    acc[ii] = x; XL[(16 * bi + ii) * 257 + c] = x; }
            }
        } else {
            const int w4 = wave - 4; float v[8];
#pragma unroll
            for (int q = 0; q < 4; ++q) { const int f = w4 + 4 * q;
                { const int mt = f >> 3, ks = f & 7, i = 32 * mt + r; const float eg = __expf(GLs[i]);
                  const bf16x8 qq = *(const LAS bf16x8*)(Qb + i * 136 + 16 * ks + 8 * hp);
#pragma unroll
                  for (int jp = 0; jp < 8; ++jp) v[jp] = bf2f(Qb[i * 136 + 16 * ks + 8 * (jp >> 2) + 4 * hp + (jp & 3)]) * eg;
                  (void)qq; base[(16 + f) * 64 + lane] = pack8(v); }
                { const int mt = f >> 2, ks = f & 3, d = 32 * mt + r; const float Gend = GLs[63];
#pragma unroll
                  for (int jp = 0; jp < 8; ++jp) { const int tk = 16 * ks + 8 * (jp >> 2) + 4 * hp + (jp & 3); v[jp] = bf2f(Kb[tk * 136 + d]) * __expf(Gend - GLs[tk]); }
                  base[(32 + f) * 64 + lane] = pack8(v); } }
#pragma unroll
            for (int q = 0; q < 2; ++q) { const int f = w4 + 4 * q, mt = f >> 2, ks = f & 3, i = 32 * mt + r;
#pragma unroll
                for (int jp = 0; jp < 8; ++jp) v[jp] = QKm[i * 65 + 16 * ks + 8 * (jp >> 2) + 4 * hp + (jp & 3)];
                base[(48 + f) * 64 + lane] = pack8(v); }
            if (tid == 256) *(float*)(base + 72 * 64) = __expf(GLs[63]);
        }
        __syncthreads();
        float v[8];
#pragma unroll
        for (int q = 0; q < 2; ++q) { const int f = wave + 8 * q;
            { const int mt = f >> 3, ks = f & 7, i = 32 * mt + r;
#pragma unroll
              for (int jp = 0; jp < 8; ++jp) v[jp] = -XL[i * 257 + 128 + 16 * ks + 8 * (jp >> 2) + 4 * hp + (jp & 3)];
              base[f * 64 + lane] = pack8(v); }
            { const int pq = f & 1, tl = f >> 1, mt = tl >> 2, nt = tl & 3;
#pragma unroll
              for (int e = 0; e < 8; ++e) v[e] = XL[(32 * mt + crow(8 * pq + e, hp)) * 257 + 32 * nt + r];
              base[(56 + f) * 64 + lane] = pack8(v); } }
    }
}

__device__ __forceinline__ void phase_ab_rec(const KP kp, const int bid, const int G, int j, int li, LAS unsigned char* lds, int tid0) {
    unsigned char* scr = kp.ws() + WS_SCR; const bf16* U = (const bf16*)(kp.ws() + WS_U);
    float* ODN = (float*)(scr + SC_ODN); float* OGLA = (float*)(scr + SC_OGLA);
    SEC_BEGIN(12)
    for (int item = bid; item < 64; item += G) {
        int tid = tid0; asm volatile("" : "+v"(tid));
        int s, h; bool isdn; int half = -1;
        if (item < 32) { isdn = false; s = item >> 3; h = (item >> 1) & 3; half = item & 1; }
        else if (item < 64) { isdn = true; s = (item - 32) >> 3; h = (item - 32) & 7; half = -2; }
        else if (item < 1088) { isdn = true; s = 4 + ((item - 64) >> 3); h = (item - 64) & 7; }
        else { isdn = false; s = 4 + ((item - 1088) >> 2); h = (item - 1088) & 3; }
        int row0, L; seq_info(s, row0, L);
        __syncthreads();
        if (half == -2) {
            const int wave = __builtin_amdgcn_readfirstlane(tid >> 6), lane = tid & 63, r = lane & 31, hp = lane >> 5;
            const int b = s, nt = wave;
            const unsigned char* OPS = scr + SC_DNOPS;
            constexpr int DBUF = 73 * 1024;
#define DN_DMA(n_, bufi_) do { const unsigned char* gi_ = OPS + (size_t)((b * 32 + (n_)) * 8 + h) * DN_ITEM_BYTES + lane * 16; \
                _Pragma("unroll") for (int q_ = 0; q_ < 10; ++q_) { const int lf_ = wave + 8 * q_; if (lf_ < 73) \
                    __builtin_amdgcn_global_load_lds((const unsigned*)(gi_ + lf_ * 1024), (LAS unsigned*)(lds + (bufi_) * DBUF + lf_ * 1024), 16, 0, 2); } } while (0)
            f32x16 S0, S1, S2, S3;
#pragma unroll
            for (int i = 0; i < 16; ++i) { S0[i] = 0.f; S1[i] = 0.f; S2[i] = 0.f; S3[i] = 0.f; }
            DN_DMA(0, 0);
            asm volatile("s_waitcnt vmcnt(0)" ::: "memory"); __syncthreads();
            for (int n = 0; n < 32; ++n) {
                if (n + 1 < 32) DN_DMA(n + 1, (n + 1) & 1);
                if (wave < 4) {
                    const LAS bf16x8* F = (const LAS bf16x8*)(lds + (n & 1) * DBUF) + lane;
                    const float gend = *(const LAS float*)(lds + (n & 1) * DBUF + 72 * 1024);
                    const bf16x8 sb0 = PACK_ACC(S0, 0), sb1 = PACK_ACC(S0, 1), sb2 = PACK_ACC(S1, 0), sb3 = PACK_ACC(S1, 1), sb4 = PACK_ACC(S2, 0), sb5 = PACK_ACC(S2, 1), sb6 = PACK_ACC(S3, 0), sb7 = PACK_ACC(S3, 1);
                    f32x16 U0t, U1t;
                    { const bf16x8 a0 = F[(56 + nt * 2 + 0) * 64], a1 = F[(56 + nt * 2 + 1) * 64], c0 = F[(56 + (4 + nt) * 2 + 0) * 64], c1 = F[(56 + (4 + nt) * 2 + 1) * 64];
#pragma unroll
                      for (int e = 0; e < 8; ++e) { U0t[e] = bf2f((bf16)a0[e]); U0t[8 + e] = bf2f((bf16)a1[e]); U1t[e] = bf2f((bf16)c0[e]); U1t[8 + e] = bf2f((bf16)c1[e]); } }
                    U0t = MFMA32(F[0 * 64], sb0, U0t); U0t = MFMA32(F[1 * 64], sb1, U0t); U0t = MFMA32(F[2 * 64], sb2, U0t); U0t = MFMA32(F[3 * 64], sb3, U0t);
                    U0t = MFMA32(F[4 * 64], sb4, U0t); U0t = MFMA32(F[5 * 64], sb5, U0t); U0t = MFMA32(F[6 * 64], sb6, U0t); U0t = MFMA32(F[7 * 64], sb7, U0t);
                    U1t = MFMA32(F[8 * 64], sb0, U1t); U1t = MFMA32(F[9 * 64], sb1, U1t); U1t = MFMA32(F[10 * 64], sb2, U1t); U1t = MFMA32(F[11 * 64], sb3, U1t);
                    U1t = MFMA32(F[12 * 64], sb4, U1t); U1t = MFMA32(F[13 * 64], sb5, U1t); U1t = MFMA32(F[14 * 64], sb6, U1t); U1t = MFMA32(F[15 * 64], sb7, U1t);
                    const bf16x8 ub0 = PACK_ACC(U0t, 0), ub1 = PACK_ACC(U0t, 1), ub2 = PACK_ACC(U1t, 0), ub3 = PACK_ACC(U1t, 1);
                    f32x16 O0, O1;
#pragma unroll
                    for (int i = 0; i < 16; ++i) { O0[i] = 0.f; O1[i] = 0.f; }
                    O0 = MFMA32(F[16 * 64], sb0, O0); O0 = MFMA32(F[17 * 64], sb1, O0); O0 = MFMA32(F[18 * 64], sb2, O0); O0 = MFMA32(F[19 * 64], sb3, O0);
                    O0 = MFMA32(F[20 * 64], sb4, O0); O0 = MFMA32(F[21 * 64], sb5, O0); O0 = MFMA32(F[22 * 64], sb6, O0); O0 = MFMA32(F[23 * 64], sb7, O0);
                    O1 = MFMA32(F[24 * 64], sb0, O1); O1 = MFMA32(F[25 * 64], sb1, O1); O1 = MFMA32(F[26 * 64], sb2, O1); O1 = MFMA32(F[27 * 64], sb3, O1);
                    O1 = MFMA32(F[28 * 64], sb4, O1); O1 = MFMA32(F[29 * 64], sb5, O1); O1 = MFMA32(F[30 * 64], sb6, O1); O1 = MFMA32(F[31 * 64], sb7, O1);
                    O0 = MFMA32(F[48 * 64], ub0, O0); O0 = MFMA32(F[49 * 64], ub1, O0);
                    O1 = MFMA32(F[52 * 64], ub0, O1); O1 = MFMA32(F[53 * 64], ub1, O1); O1 = MFMA32(F[54 * 64], ub2, O1); O1 = MFMA32(F[55 * 64], ub3, O1);
#pragma unroll
                    for (int i = 0; i < 16; ++i) { S0[i] *= gend; S1[i] *= gend; S2[i] *= gend; S3[i] *= gend; }
                    S0 = MFMA32(F[32 * 64], ub0, S0); S0 = MFMA32(F[33 * 64], ub1, S0); S0 = MFMA32(F[34 * 64], ub2, S0); S0 = MFMA32(F[35 * 64], ub3, S0);
                    S1 = MFMA32(F[36 * 64], ub0, S1); S1 = MFMA32(F[37 * 64], ub1, S1); S1 = MFMA32(F[38 * 64], ub2, S1); S1 = MFMA32(F[39 * 64], ub3, S1);
                    S2 = MFMA32(F[40 * 64], ub0, S2); S2 = MFMA32(F[41 * 64], ub1, S2); S2 = MFMA32(F[42 * 64], ub2, S2); S2 = MFMA32(F[43 * 64], ub3, S2);
                    S3 = MFMA32(F[44 * 64], ub0, S3); S3 = MFMA32(F[45 * 64], ub1, S3); S3 = MFMA32(F[46 * 64], ub2, S3); S3 = MFMA32(F[47 * 64], ub3, S3);
                    float* yo = ODN + (size_t)(b * 2048 + n * 64) * 1024 + h * 128 + 32 * nt + r;
#pragma unroll
                    for (int i = 0; i < 16; ++i) { yo[(size_t)crow(i, hp) * 1024] = O0[i]; yo[(size_t)(32 + crow(i, hp)) * 1024] = O1[i]; }
                }
                asm volatile("s_waitcnt vmcnt(0)" ::: "memory"); __syncthreads();
            }
#undef DN_DMA
            if (wave < 4) {
                float* dst = kp.out() + O_DN_P + ((size_t)j * 4 + b) * ((size_t)8 * 128 * 128) + (size_t)h * 128 * 128 + 32 * nt + r;
#pragma unroll
                for (int i = 0; i < 16; ++i) { dst[(size_t)crow(i, hp) * 128] = S0[i]; dst[(size_t)(32 + crow(i, hp)) * 128] = S1[i]; dst[(size_t)(64 + crow(i, hp)) * 128] = S2[i]; dst[(size_t)(96 + crow(i, hp)) * 128] = S3[i]; }
            }
        } else if (half >= 0) {
            const int wave = __builtin_amdgcn_readfirstlane(tid >> 6), lane = tid & 63, r = lane & 31, hp = lane >> 5;
            const int b = s, nt = half * 4 + wave;
            const unsigned char* OPS = kp.ws() + WS_GLAOPS;
            constexpr int GBUF = 57 * 1024;
#define GLA_DMA(n_, bufi_) do { const unsigned char* gi_ = OPS + (size_t)((b * 32 + (n_)) * 4 + h) * GLA_ITEM_BYTES + lane * 16; \
                _Pragma("unroll") for (int q_ = 0; q_ < 8; ++q_) { const int lf_ = wave + 8 * q_; if (lf_ < 57) { const int gf_ = lf_ < 40 ? lf_ : (lf_ < 56 ? lf_ + half * 16 : 72); \
                    __builtin_amdgcn_global_load_lds((const unsigned*)(gi_ + gf_ * 1024), (LAS unsigned*)(lds + (bufi_) * GBUF + lf_ * 1024), 16, 0, 2); } } } while (0)
            f32x16 S0, S1, S2, S3;
#pragma unroll
            for (int i = 0; i < 16; ++i) { S0[i] = 0.f; S1[i] = 0.f; S2[i] = 0.f; S3[i] = 0.f; }
            GLA_DMA(0, 0);
            asm volatile("s_waitcnt vmcnt(0)" ::: "memory"); __syncthreads();
            for (int n = 0; n < 32; ++n) {
                if (n + 1 < 32) GLA_DMA(n + 1, (n + 1) & 1);
                if (wave < 4) {
                    const LAS bf16x8* F = (const LAS bf16x8*)(lds + (n & 1) * GBUF) + lane;
                    const LAS float* ge = (const LAS float*)(lds + (n & 1) * GBUF + 56 * 1024) + 4 * hp;
                    const bf16x8 sb0 = PACK_ACC(S0, 0), sb1 = PACK_ACC(S0, 1), sb2 = PACK_ACC(S1, 0), sb3 = PACK_ACC(S1, 1), sb4 = PACK_ACC(S2, 0), sb5 = PACK_ACC(S2, 1), sb6 = PACK_ACC(S3, 0), sb7 = PACK_ACC(S3, 1);
                    f32x16 O0, O1;
#pragma unroll
                    for (int i = 0; i < 16; ++i) { O0[i] = 0.f; O1[i] = 0.f; }
                    O0 = MFMA32(F[0 * 64], sb0, O0); O0 = MFMA32(F[1 * 64], sb1, O0); O0 = MFMA32(F[2 * 64], sb2, O0); O0 = MFMA32(F[3 * 64], sb3, O0);
                    O0 = MFMA32(F[4 * 64], sb4, O0); O0 = MFMA32(F[5 * 64], sb5, O0); O0 = MFMA32(F[6 * 64], sb6, O0); O0 = MFMA32(F[7 * 64], sb7, O0);
                    O1 = MFMA32(F[8 * 64], sb0, O1); O1 = MFMA32(F[9 * 64], sb1, O1); O1 = MFMA32(F[10 * 64], sb2, O1); O1 = MFMA32(F[11 * 64], sb3, O1);
                    O1 = MFMA32(F[12 * 64], sb4, O1); O1 = MFMA32(F[13 * 64], sb5, O1); O1 = MFMA32(F[14 * 64], sb6, O1); O1 = MFMA32(F[15 * 64], sb7, O1);
                    bf16x8 vb[4];
#pragma unroll
                    for (int ks = 0; ks < 4; ++ks) vb[ks] = F[(40 + wave * 4 + ks) * 64];
                    O0 = MFMA32(F[32 * 64], vb[0], O0); O0 = MFMA32(F[33 * 64], vb[1], O0);
#pragma unroll
                    for (int ks = 0; ks < 4; ++ks) O1 = MFMA32(F[(36 + ks) * 64], vb[ks], O1);
#pragma unroll
                    for (int q = 0; q < 4; ++q) { const f32x4 g0 = *(const LAS f32x4*)(ge + 8 * q), g1 = *(const LAS f32x4*)(ge + 32 + 8 * q), g2 = *(const LAS f32x4*)(ge + 64 + 8 * q), g3 = *(const LAS f32x4*)(ge + 96 + 8 * q);
#pragma unroll
                        for (int c = 0; c < 4; ++c) { S0[4 * q + c] *= g0[c]; S1[4 * q + c] *= g1[c]; S2[4 * q + c] *= g2[c]; S3[4 * q + c] *= g3[c]; } }
#pragma unroll
                    for (int ks = 0; ks < 4; ++ks) { S0 = MFMA32(F[(16 + ks) * 64], vb[ks], S0); S1 = MFMA32(F[(20 + ks) * 64], vb[ks], S1); S2 = MFMA32(F[(24 + ks) * 64], vb[ks], S2); S3 = MFMA32(F[(28 + ks) * 64], vb[ks], S3); }
                    float* yo = OGLA + (size_t)(b * 2048 + n * 64) * 1024 + h * 256 + 32 * nt + r;
#pragma unroll
                    for (int i = 0; i < 16; ++i) { yo[(size_t)crow(i, hp) * 1024] = O0[i]; yo[(size_t)(32 + crow(i, hp)) * 1024] = O1[i]; }
                }
                asm volatile("s_waitcnt vmcnt(0)" ::: "memory"); __syncthreads();
            }
#undef GLA_DMA
            if (wave < 4) {
                float* dst = kp.out() + O_GLA_P + ((size_t)j * 4 + b) * ((size_t)4 * 128 * 256) + (size_t)h * 128 * 256 + 32 * nt + r;
#pragma unroll
                for (int i = 0; i < 16; ++i) { dst[(size_t)crow(i, hp) * 256] = S0[i]; dst[(size_t)(32 + crow(i, hp)) * 256] = S1[i]; dst[(size_t)(64 + crow(i, hp)) * 256] = S2[i]; dst[(size_t)(96 + crow(i, hp)) * 256] = S3[i]; }
            }
        } else
        {}
    }
    SEC_END(12, lds)
    SEC_BEGIN(13)
    unsigned* qhead = (unsigned*)(kp.ws() + WS_CTL) + CW_CNT + 64 * li;
    volatile LAS unsigned* qslot = (volatile LAS unsigned*)(lds + LDS_BYTES - 8);
    const float* cw = kp.in(14) + (size_t)j * 4 * 3072; const float* stc = kp.in(3) + (size_t)j * 128 * 3 * 3072;
    const float* wa2 = kp.in(18) + (size_t)j * 16 * 512; const float* ba = kp.in(19) + (size_t)j * 512;
    for (;;) {
        __syncthreads();
        if (tid0 == 0) qslot[0] = __hip_atomic_fetch_add(qhead, 1u, __ATOMIC_RELAXED, __HIP_MEMORY_SCOPE_AGENT);
        __syncthreads();
        const int it = (int)qslot[0];
        if (it >= 1536) break;
        int tid = tid0; asm volatile("" : "+v"(tid));
        const int wave = tid >> 6, lane = tid & 63;
        if (it < 1024) {
            const int bs = it >> 3, h = it & 7, sq = 4 + bs, r0 = TP + bs * 4;
            LAS float* qL = (LAS float*)lds; LAS float* kL = qL + 512; LAS float* vL = kL + 512; LAS float* red = vL + 512; LAS float* sm = red + 4096;
            const int e = tid & 127, dq = tid >> 7;
            const size_t SZ = (size_t)8 * 128 * 128;
            const float* st = kp.in(2) + ((size_t)j * 128 + bs) * SZ + (size_t)h * 16384;
            float S[32];
            { const float* sp = st + (size_t)(dq * 32) * 128 + e;
#pragma unroll
              for (int i = 0; i < 32; ++i) { S[i] = *sp; sp += 128; asm volatile("" : "+v"(sp)); } }
#pragma unroll
            for (int part = 0; part < 3; ++part) { const int c = part * 1024 + h * 128 + e; float acc = 0.f;
#pragma unroll
                for (int tap = 0; tap < 4; ++tap) acc += cw[tap * 3072 + c] * pre_val(U, NAB, c, r0, dq - 3 + tap, sq, stc, 3072, c);
                (part == 0 ? qL : (part == 1 ? kL : vL))[dq * 128 + e] = silu_(acc); }
            if (tid < 4) { const size_t ro = (size_t)(r0 + tid) * NAB;
                sm[32 + tid] = -__expf(kp.in(15)[j * 8 + h]) * softplus_(bf2f(U[ro + 7176 + h]) + kp.in(16)[j * 8 + h]); sm[36 + tid] = sigmoid_(bf2f(U[ro + 7168 + h])); }
            __syncthreads();
            { const int tk = wave & 3; LAS float* src = (wave >> 2) ? kL : qL; const float a = src[tk * 128 + lane], b = src[tk * 128 + lane + 64];
              const float sc = rsqrtf(wave_sum(a * a + b * b) + 1e-6f) * ((wave >> 2) ? 1.f : 0.08838834764831845f); src[tk * 128 + lane] = a * sc; src[tk * 128 + lane + 64] = b * sc; }
            __syncthreads();
#pragma unroll
            for (int q = 0; q < 4; ++q) { const int idx = wave * 4 + q, i = (idx >> 2) & 3, jj = idx & 3; const LAS float* src = idx < 16 ? kL : qL;
                const float dot = wave_sum(src[i * 128 + lane] * kL[jj * 128 + lane] + src[i * 128 + lane + 64] * kL[jj * 128 + lane + 64]); if (lane == 0) sm[idx] = dot; }
            float ks[4] = {0.f, 0.f, 0.f, 0.f}, qs[4] = {0.f, 0.f, 0.f, 0.f};
#pragma unroll
            for (int i = 0; i < 32; ++i) { const int d = dq * 32 + i; const float sv = S[i];
#pragma unroll
                for (int t = 0; t < 4; ++t) { ks[t] += kL[t * 128 + d] * sv; qs[t] += qL[t * 128 + d] * sv; } }
#pragma unroll
            for (int t = 0; t < 4; ++t) { red[(t * 4 + dq) * 128 + e] = ks[t]; red[((4 + t) * 4 + dq) * 128 + e] = qs[t]; }
            __syncthreads();
            float Gc[4]; Gc[0] = sm[32]; Gc[1] = Gc[0] + sm[33]; Gc[2] = Gc[1] + sm[34]; Gc[3] = Gc[2] + sm[35];
            float u[4];
#pragma unroll
            for (int i = 0; i < 4; ++i) { const float KSi = (red[(i * 4 + 0) * 128 + e] + red[(i * 4 + 1) * 128 + e]) + (red[(i * 4 + 2) * 128 + e] + red[(i * 4 + 3) * 128 + e]);
                float acc = vL[i * 128 + e] - __expf(Gc[i]) * KSi;
#pragma unroll
                for (int jj = 0; jj < i; ++jj) acc -= sm[i * 4 + jj] * __expf(Gc[i] - Gc[jj]) * u[jj];
                u[i] = sm[36 + i] * acc; }
            if (dq == 0) {
#pragma unroll
                for (int i = 0; i < 4; ++i) { const float QSi = (red[((4 + i) * 4 + 0) * 128 + e] + red[((4 + i) * 4 + 1) * 128 + e]) + (red[((4 + i) * 4 + 2) * 128 + e] + red[((4 + i) * 4 + 3) * 128 + e]);
                    float o = __expf(Gc[i]) * QSi;
#pragma unroll
                    for (int jj = 0; jj <= i; ++jj) o += sm[16 + i * 4 + jj] * __expf(Gc[i] - Gc[jj]) * u[jj];
                    ODN[(size_t)(r0 + i) * 1024 + h * 128 + e] = o; } }
            const float eg = __expf(Gc[3]); float w[4];
#pragma unroll
            for (int jj = 0; jj < 4; ++jj) w[jj] = __expf(Gc[3] - Gc[jj]) * u[jj];
            float* dst = kp.out() + O_DN_S + ((size_t)j * 128 + bs) * SZ + (size_t)h * 16384 + (size_t)(dq * 32) * 128 + e;
#pragma unroll
            for (int i = 0; i < 32; ++i) { const int d = dq * 32 + i; float sv = eg * S[i];
#pragma unroll
                for (int jj = 0; jj < 4; ++jj) sv += kL[jj * 128 + d] * w[jj];
                *dst = sv; dst += 128; asm volatile("" : "+v"(dst)); }
        } else {
            const int q_ = it - 1024, bs = q_ >> 2, h = q_ & 3, r0 = TP + bs * 4;
            LAS float* qgL = (LAS float*)lds; LAS float* kaL = qgL + 512; LAS float* glL = kaL + 512; LAS float* egL = glL + 512; LAS float* Am = egL + 128; LAS float* red = Am + 16;
            const int e = tid & 255, dh = tid >> 8;
            const size_t SZ = (size_t)4 * 128 * 256;
            const float* st = kp.in(4) + ((size_t)j * 128 + bs) * SZ + (size_t)h * 32768;
            float S[64];
            { const float* sp = st + (size_t)(dh * 64) * 256 + e;
#pragma unroll
              for (int i = 0; i < 64; ++i) { S[i] = *sp; sp += 256; asm volatile("" : "+v"(sp)); } }
            float v[4];
#pragma unroll
            for (int t = 0; t < 4; ++t) v[t] = bf2f(U[(size_t)(r0 + t) * NAB + 5120 + h * 256 + e]);
            { const int d = tid & 127, tk = tid >> 7; const size_t ro = (size_t)(r0 + tk) * NAB;
              qgL[tk * 128 + d] = bf2f(U[ro + 4096 + h * 128 + d]) * 0.08838834764831845f; kaL[tk * 128 + d] = bf2f(U[ro + 4608 + h * 128 + d]);
              float x = ba[h * 128 + d];
#pragma unroll
              for (int rr = 0; rr < 16; ++rr) x += bf2f(U[ro + 7184 + rr]) * wa2[rr * 512 + h * 128 + d];
              glL[tk * 128 + d] = -softplus_(-x) * (1.f / 16.f); }
            __syncthreads();
            if (tid < 128) { float Gq = 0.f;
#pragma unroll
                for (int t = 0; t < 4; ++t) { Gq += glL[t * 128 + tid]; qgL[t * 128 + tid] *= __expf(Gq); kaL[t * 128 + tid] *= __expf(-Gq); }
                egL[tid] = __expf(Gq); }
            __syncthreads();
#pragma unroll
            for (int q = 0; q < 2; ++q) { const int idx = wave * 2 + q, i = idx >> 2, jj = idx & 3;
                const float dot = wave_sum(qgL[i * 128 + lane] * kaL[jj * 128 + lane] + qgL[i * 128 + lane + 64] * kaL[jj * 128 + lane + 64]); if (lane == 0) Am[idx] = dot; }
            float o[4] = {0.f, 0.f, 0.f, 0.f};
            float* dst = kp.out() + O_GLA_S + ((size_t)j * 128 + bs) * SZ + (size_t)h * 32768 + (size_t)(dh * 64) * 256 + e;
#pragma unroll
            for (int i = 0; i < 64; ++i) { const int d = dh * 64 + i; const float s0 = S[i]; float acc = s0;
#pragma unroll
                for (int t = 0; t < 4; ++t) { o[t] += qgL[t * 128 + d] * s0; acc += kaL[t * 128 + d] * v[t]; }
                *dst = egL[d] * acc; dst += 256; asm volatile("" : "+v"(dst)); }
#pragma unroll
            for (int t = 0; t < 4; ++t) red[(dh * 4 + t) * 256 + e] = o[t];
            __syncthreads();
            if (dh == 0) {
#pragma unroll
                for (int t = 0; t < 4; ++t) { float oo = red[t * 256 + e] + red[(4 + t) * 256 + e];
#pragma unroll
                    for (int jj = 0; jj <= t; ++jj) oo += Am[t * 4 + jj] * v[jj];
                    OGLA[(size_t)(r0 + t) * 1024 + h * 256 + e] = oo; } }
        }
    }
    SEC_END(13, lds)
}

__device__ __forceinline__ void phase_ab_post(const KP kp, const int bid, const int G, int j, int tid, int wave, int lane) {
    unsigned char* scr = kp.ws() + WS_SCR; const bf16* U = (const bf16*)(kp.ws() + WS_U); bf16* YM = (bf16*)(kp.ws() + WS_YM);
    const float* ODN = (const float*)(scr + SC_ODN); const float* OGLA = (const float*)(scr + SC_OGLA);
    const float* dnn = kp.in(17) + (size_t)j * 128; const float* glan = kp.in(20) + (size_t)j * 256;
    typedef float f32x2v __attribute__((ext_vector_type(2)));
    const f32x2v dg = *(const f32x2v*)(dnn + 2 * lane); const f32x4 gg = *(const f32x4*)(glan + 4 * lane);
    for (int r = bid * NWAVES + wave; r < T; r += G * NWAVES) {
        int s, t; row_to_seq(r, s, t); int row0, L; seq_info(s, row0, L);
        const bf16* ur = U + (size_t)r * NAB; bf16* yr = YM + (size_t)r * DM;
        f32x2v od[8]; unsigned zd[8]; f32x4 og[4]; u32x2 zg[4];
#pragma unroll
        for (int hh = 0; hh < 8; ++hh) { od[hh] = *(const f32x2v*)(ODN + (size_t)r * 1024 + hh * 128 + 2 * lane); zd[hh] = *(const unsigned*)(ur + 3072 + hh * 128 + 2 * lane); }
#pragma unroll
        for (int hh = 0; hh < 4; ++hh) { og[hh] = *(const f32x4*)(OGLA + (size_t)r * 1024 + hh * 256 + 4 * lane); zg[hh] = *(const u32x2*)(ur + 6144 + hh * 256 + 4 * lane); }
#pragma unroll
        for (int hh = 0; hh < 8; ++hh) { const f32x2v o = od[hh];
            const float rstd = rsqrtf(wave_sum(o.x * o.x + o.y * o.y) * (1.f / 128.f) + 1e-6f);
            const unsigned zz = zd[hh];
            *(unsigned*)(yr + hh * 128 + 2 * lane) = pk2(o.x * rstd * dg.x * silu_(__uint_as_float(zz << 16)), o.y * rstd * dg.y * silu_(__uint_as_float(zz & 0xffff0000u))); }
#pragma unroll
        for (int hh = 0; hh < 4; ++hh) { const f32x4 o = og[hh];
            const float rstd = rsqrtf(wave_sum((o.x * o.x + o.y * o.y) + (o.z * o.z + o.w * o.w)) * (1.f / 256.f) + 1e-6f);
            const u32x2 zz = zg[hh];
            u32x2 w; w.x = pk2(o.x * rstd * gg.x * silu_(__uint_as_float(zz.x << 16)), o.y * rstd * gg.y * silu_(__uint_as_float(zz.x & 0xffff0000u)));
            w.y = pk2(o.z * rstd * gg.z * silu_(__uint_as_float(zz.y << 16)), o.w * rstd * gg.w * silu_(__uint_as_float(zz.y & 0xffff0000u)));
            *(u32x2*)(yr + 1024 + hh * 256 + 4 * lane) = w; }
        if (t >= L - 3) { const int rr = t - (L - 3);
            float* dst = s < 4 ? kp.out() + O_DNC_P + (((size_t)j * 4 + s) * 3 + rr) * 3072 : kp.out() + O_DNC_S + (((size_t)j * 128 + (s - 4)) * 3 + rr) * 3072;
            for (int c = 2 * lane; c < 3072; c += 128) { const unsigned uu = *(const unsigned*)(ur + c); *(f32x2v*)(dst + c) = (f32x2v){__uint_as_float(uu << 16), __uint_as_float(uu & 0xffff0000u)}; } }
    }
}

__device__ __forceinline__ void phase_cd_pre(const KP kp, const int bid, const int G, int j, LAS unsigned char* lds, int tid) {
    unsigned char* scr = kp.ws() + WS_SCR; const bf16* U = (const bf16*)(kp.ws() + WS_U);
    float* XBC = (float*)(scr + SC_XBC) - (size_t)TP * 1536; float* DT = (float*)(scr + SC_DT) - (size_t)TP * 16; bf16* XS = (bf16*)(scr + SC_XS);
    const float* cw = kp.in(23) + (size_t)j * 4 * 1536; const float* cb = kp.in(24) + (size_t)j * 1536; const float* stc = kp.in(6) + (size_t)j * 128 * 3 * 1536;
    for (int r = TP + bid; r < T; r += G) {
        int s, t; row_to_seq(r, s, t); const int row0 = r - t;
#pragma unroll
        for (int i = 0; i < 3; ++i) { const int c = tid + NTHR * i; float acc = cb[c];
#pragma unroll
            for (int tap = 0; tap < 4; ++tap) acc += cw[tap * 1536 + c] * pre_val(U, NCD, 1024 + c, row0, t - 3 + tap, s, stc, 1536, c);
            const float v = silu_(acc); XBC[(size_t)r * 1536 + c] = v; if (c < 1024) XS[(size_t)r * 1024 + c] = (bf16)f2bf(v); }
        if (tid < 16) DT[(size_t)r * 16 + tid] = softplus_(bf2f(U[(size_t)r * NCD + 4608 + tid]) + kp.in(26)[j * 16 + tid]);
    }
}

__device__ __forceinline__ void phase_lru_gates(const KP kp, const int bid, const int G, int j, LAS unsigned char* lds, int tid0) {
    unsigned char* scr = kp.ws() + WS_SCR; const bf16* U = (const bf16*)(kp.ws() + WS_U);
    float* LA = (float*)(scr + SC_LA); float* LB = (float*)(scr + SC_LB);
    const float* lcw = kp.in(29) + (size_t)j * 4 * 1024; const float* lcb = kp.in(30) + (size_t)j * 1024; const float* lstc = kp.in(8) + (size_t)j * 128 * 3 * 1024;
    const int n = bid & 15;
    const float* wa = kp.in(31) + ((size_t)j * 16 + n) * 4096; const float* wx = kp.in(33) + ((size_t)j * 16 + n) * 4096;
    const float* lba = kp.in(32) + (size_t)j * 1024; const float* lbx = kp.in(34) + (size_t)j * 1024; const float* lam = kp.in(35) + (size_t)j * 1024;
    LAS bf16x8* WF = (LAS bf16x8*)lds;
    LAS float* xcL = (LAS float*)(lds + 16384);
    LAS float* igL = xcL + 64 * 68;
    __syncthreads();
    { const int lane = tid0 & 63, f = tid0 >> 6, r = lane & 31, hp = lane >> 5, nt = f >> 2, ks = f & 3; float v[8];
#pragma unroll
      for (int jp = 0; jp < 8; ++jp) v[jp] = wa[(16 * ks + 8 * hp + jp) * 64 + 32 * nt + r];
      WF[f * 64 + lane] = pack8(v);
#pragma unroll
      for (int jp = 0; jp < 8; ++jp) v[jp] = wx[(16 * ks + 8 * hp + jp) * 64 + 32 * nt + r];
      WF[512 + f * 64 + lane] = pack8(v); }
    for (int tile = bid >> 4; tile < T / 64; tile += (G >> 4)) {
        int tid = tid0; asm volatile("" : "+v"(tid));
        const int c = tid & 63, tq = tid >> 6, ch = n * 64 + c, rowbase = tile * 64;
        __syncthreads();
        if (tile < TP / 64) {
            const int r0 = rowbase + tq * 8; const bool first = ((r0 & 2047) == 0);
            const float w0 = lcw[ch], w1 = lcw[1024 + ch], w2 = lcw[2048 + ch], w3 = lcw[3072 + ch], bb = lcb[ch];
            const bf16* up = U + (size_t)r0 * NCD + 3584 + ch;
            const long fo = first ? 0 : (long)NCD;
              float x0 = bf2f(up[-3 * fo]), x1 = bf2f(up[-2 * fo]), x2 = bf2f(up[-1 * fo]); if (first) { x0 = 0.f; x1 = 0.f; x2 = 0.f; }
#pragma unroll
            for (int tt = 0; tt < 8; ++tt) { const float x3 = bf2f(up[(size_t)tt * NCD]); xcL[(tq * 8 + tt) * 68 + c] = bb + w0 * x0 + w1 * x1 + w2 * x2 + w3 * x3; x0 = x1; x1 = x2; x2 = x3; }
        } else {
#pragma unroll 2
            for (int tt = 0; tt < 8; ++tt) { const int r = rowbase + tq * 8 + tt; int s, t; row_to_seq(r, s, t); const int row0 = r - t; float acc = lcb[ch];
#pragma unroll
                for (int tap = 0; tap < 4; ++tap) acc += lcw[tap * 1024 + ch] * pre_val(U, NCD, 3584 + ch, row0, t - 3 + tap, s, lstc, 1024, ch);
                xcL[(tq * 8 + tt) * 68 + c] = acc; }
        }
        __syncthreads();
        const int wave = __builtin_amdgcn_readfirstlane(tid >> 6), lane = tid & 63, r = lane & 31, hp = lane >> 5, mat = wave >> 2, mt = (wave >> 1) & 1, nt = wave & 1;
        f32x16 acc;
#pragma unroll
        for (int i = 0; i < 16; ++i) acc[i] = 0.f;
#pragma unroll
        for (int ks = 0; ks < 4; ++ks) { const LAS float* xp = xcL + (32 * mt + r) * 68 + 16 * ks + 8 * hp; const f32x4 xa = *(const LAS f32x4*)xp, xb = *(const LAS f32x4*)(xp + 4);
            const bf16x8 af = __builtin_bit_cast(bf16x8, (u32x4){cvtpk(xa.x, xa.y), cvtpk(xa.z, xa.w), cvtpk(xb.x, xb.y), cvtpk(xb.z, xb.w)});
            acc = MFMA32(af, WF[mat * 512 + (nt * 4 + ks) * 64 + lane], acc); }
        const int chh = n * 64 + 32 * nt + r;
        if (mat == 1) { const float bx = lbx[chh];
#pragma unroll
            for (int i = 0; i < 16; ++i) igL[(32 * mt + crow(i, hp)) * 65 + 32 * nt + r] = sigmoid_(acc[i] + bx); }
        __syncthreads();
        if (mat == 0) { const float ba = lba[chh], spl = softplus_(-lam[chh]);
#pragma unroll
            for (int i = 0; i < 16; ++i) { const int tk = 32 * mt + crow(i, hp); const size_t ro = (size_t)(rowbase + tk) * 1024 + chh;
                const float log_a = -8.f * sigmoid_(acc[i] + ba) * spl;
                LA[ro] = __expf(log_a); LB[ro] = __builtin_amdgcn_sqrtf(1.f - __expf(2.f * log_a)) * (igL[tk * 65 + 32 * nt + r] * xcL[tk * 68 + 32 * nt + r]); } }
    }
}

constexpr size_t SSD_ITEM_BYTES = 33792;
__device__ __forceinline__ void phase_ssd_prep(const KP kp, const int bid, const int G, int j, LAS unsigned char* lds, int tid0) {
    unsigned char* scr = kp.ws() + WS_SCR;
    const bf16* U = (const bf16*)(kp.ws() + WS_U); bf16* XS = (bf16*)(scr + SC_XS);
    const float* cw = kp.in(23) + (size_t)j * 4 * 1536; const float* cb = kp.in(24) + (size_t)j * 1536;
    unsigned char* OPS = scr + SC_SSDOP;
    LAS float* CL = (LAS float*)lds; LAS float* BL = CL + 64 * 65; LAS float* QK = BL + 64 * 65; LAS float* GL = QK + 64 * 65; LAS float* DTL = GL + 256; LAS float* XLs = DTL + 256;
    const float* alog = kp.in(25) + j * 16;
    for (int item = bid; item < 512; item += G) {
        int tid = tid0; asm volatile("" : "+v"(tid));
        const int wave = tid >> 6, lane = tid & 63;
        const int b = item >> 7, n = (item >> 2) & 31, g = item & 3;
        const int row0 = b * 2048 + n * 64;
        __syncthreads();
        { const int ci = tid & 127, tg = tid >> 7, t0 = 16 * tg;
          const bool first = (n == 0 && tg == 0);
#pragma unroll
          for (int q = 0; q < 3; ++q) { const int k = ci + 128 * q;
              int cidx; LAS float* dst; int dstr, dcol;
              if (k < 64) { cidx = 1024 + g * 64 + k; dst = BL; dstr = 65; dcol = k; }
              else if (k < 128) { cidx = 1280 + g * 64 + (k - 64); dst = CL; dstr = 65; dcol = k - 64; }
              else { cidx = g * 256 + (k - 128); dst = XLs; dstr = 257; dcol = k - 128; }
              const float w0 = cw[cidx], w1 = cw[1536 + cidx], w2 = cw[2 * 1536 + cidx], w3 = cw[3 * 1536 + cidx], bb = cb[cidx];
              const bf16* up = U + (size_t)(row0 + t0) * NCD + 1024 + cidx;
              const long fo = first ? 0 : (long)NCD;
              float x0 = bf2f(up[-3 * fo]), x1 = bf2f(up[-2 * fo]), x2 = bf2f(up[-1 * fo]); if (first) { x0 = 0.f; x1 = 0.f; x2 = 0.f; }
#pragma unroll 4
              for (int t = 0; t < 16; ++t) { const float x3 = bf2f(up[(size_t)t * NCD]); dst[(t0 + t) * dstr + dcol] = silu_(bb + w0 * x0 + w1 * x1 + w2 * x2 + w3 * x3); x0 = x1; x1 = x2; x2 = x3; } } }
        if (wave < 4) { const int h = g * 4 + wave; const float dt = softplus_(bf2f(U[(size_t)(row0 + lane) * NCD + 4608 + h]) + kp.in(26)[j * 16 + h]);
            DTL[wave * 64 + lane] = dt; float gv = -__expf(alog[h]) * dt;
#pragma unroll
            for (int o = 1; o < 64; o <<= 1) { const float tt = __shfl_up(gv, o); if (lane >= o) gv += tt; }
            GL[wave * 64 + lane] = gv; }
        __syncthreads();
        for (int i = tid; i < 8192; i += NTHR) { const int t = i >> 7, k2 = i & 127;
            ((unsigned*)XS)[((size_t)(row0 + t) * 1024 + g * 256) / 2 + k2] = pk2(XLs[t * 257 + 2 * k2], XLs[t * 257 + 2 * k2 + 1]); }
        { const int i = tid >> 3, jg = tid & 7; float acc[8];
#pragma unroll
          for (int jj = 0; jj < 8; ++jj) acc[jj] = 0.f;
#pragma unroll 4
          for (int d = 0; d < 64; ++d) { const float c = CL[i * 65 + d];
#pragma unroll
              for (int jj = 0; jj < 8; ++jj) acc[jj] += c * BL[(jg * 8 + jj) * 65 + d]; }
#pragma unroll
          for (int jj = 0; jj < 8; ++jj) QK[i * 65 + jg * 8 + jj] = acc[jj]; }
        __syncthreads();
        const int f = wave, r = lane & 31, hp = lane >> 5, mt = f >> 2, ks = f & 3;
        for (int hh = 0; hh < 4; ++hh) {
            const int h = g * 4 + hh; const LAS float* Gh = GL + hh * 64; const float Gend = Gh[63];
            bf16x8* base = (bf16x8*)(OPS + ((size_t)((b * 32 + n) * 16 + h)) * SSD_ITEM_BYTES);
            float v[8];
            { const int i = 32 * mt + r; const float eg = __expf(Gh[i]);
#pragma unroll
              for (int jp = 0; jp < 8; ++jp) { const int d = 16 * ks + 8 * (jp >> 2) + 4 * hp + (jp & 3); v[jp] = CL[i * 65 + d] * eg; }
              base[0 * 512 + f * 64 + lane] = pack8(v); }
            { const int d = 32 * mt + r;
#pragma unroll
              for (int jp = 0; jp < 8; ++jp) { const int tk = 16 * ks + 8 * (jp >> 2) + 4 * hp + (jp & 3); v[jp] = BL[tk * 65 + d] * __expf(Gend - Gh[tk]); }
              base[1 * 512 + f * 64 + lane] = pack8(v); }
            { const int i = 32 * mt + r; const float gi = Gh[i];
#pragma unroll
              for (int jp = 0; jp < 8; ++jp) { const int jt = 16 * ks + 8 * (jp >> 2) + 4 * hp + (jp & 3); v[jp] = jt <= i ? QK[i * 65 + jt] * __expf(gi - Gh[jt]) : 0.f; }
              base[2 * 512 + f * 64 + lane] = pack8(v); }
            { const int p = 32 * mt + r;
#pragma unroll
              for (int jp = 0; jp < 8; ++jp) { const int tk = 16 * ks + 8 * (jp >> 2) + 4 * hp + (jp & 3);
                  v[jp] = XLs[tk * 257 + hh * 64 + p] * DTL[hh * 64 + tk]; }
              base[3 * 512 + f * 64 + lane] = pack8(v); }
            if (tid == 0) *(float*)(base + 32 * 64) = __expf(Gend);
        }
    }
}

__device__ __forceinline__ void phase_cd_rec(const KP kp, const int bid, const int G, int j, int li, LAS unsigned char* lds, int tid0) {
    unsigned char* scr = kp.ws() + WS_SCR; const bf16* U = (const bf16*)(kp.ws() + WS_U);
    const float* LA = (const float*)(scr + SC_LA); const float* LB = (const float*)(scr + SC_LB);
    float* YS = (float*)(scr + SC_YS); float* HS = (float*)(scr + SC_HS); bf16* XS = (bf16*)(scr + SC_XS);
    SEC_BEGIN(10)
    for (int item = bid; item < 64; item += G) {
        int tid = tid0; asm volatile("" : "+v"(tid));
        const int b = item >> 4, hd = item & 15;
        __syncthreads();
        const int wave = __builtin_amdgcn_readfirstlane(tid >> 6), lane = tid & 63, r = lane & 31, hp = lane >> 5, nt = wave;
        const unsigned char* OPS = scr + SC_SSDOP;
        const bool dmaw = (wave >= 2 && wave < 6);
        constexpr int SLOT = 33 * 1024;
#define SSD_DMA(n_) do { if (dmaw) { const unsigned char* gi_ = OPS + ((size_t)((b * 32 + (n_)) * 16 + hd)) * SSD_ITEM_BYTES + lane * 16; \
            _Pragma("unroll") for (int q_ = 0; q_ < 9; ++q_) { const int lf_ = q_ < 8 ? (wave - 2) * 8 + q_ : 32; \
                __builtin_amdgcn_global_load_lds((const unsigned*)(gi_ + lf_ * 1024), (LAS unsigned*)(lds + ((n_) & 3) * SLOT + lf_ * 1024), 16, 0, 2); } } } while (0)
        f32x16 S0, S1;
#pragma unroll
        for (int i = 0; i < 16; ++i) { S0[i] = 0.f; S1[i] = 0.f; }
        SSD_DMA(0); SSD_DMA(1); SSD_DMA(2);
        if (dmaw) asm volatile("s_waitcnt vmcnt(18)" ::: "memory");
        asm volatile("" ::: "memory"); __builtin_amdgcn_s_barrier(); asm volatile("" ::: "memory");
        for (int n = 0; n < 32; ++n) {
            if (n + 3 < 32) SSD_DMA(n + 3);
            if (wave < 2) {
                const LAS bf16x8* F = (const LAS bf16x8*)(lds + (n & 3) * SLOT) + lane;
                bf16x8 vb[4];
#pragma unroll
                for (int ks = 0; ks < 4; ++ks) vb[ks] = F[(24 + nt * 4 + ks) * 64];
                const float gend = *(const LAS float*)(lds + (n & 3) * SLOT + 32 * 1024);
                const bf16x8 sb00 = PACK_ACC(S0, 0), sb01 = PACK_ACC(S0, 1), sb10 = PACK_ACC(S1, 0), sb11 = PACK_ACC(S1, 1);
                f32x16 O0, O1;
#pragma unroll
                for (int i = 0; i < 16; ++i) { O0[i] = 0.f; O1[i] = 0.f; }
                O0 = MFMA32(F[0 * 64], sb00, O0); O0 = MFMA32(F[1 * 64], sb01, O0); O0 = MFMA32(F[2 * 64], sb10, O0); O0 = MFMA32(F[3 * 64], sb11, O0);
                O1 = MFMA32(F[4 * 64], sb00, O1); O1 = MFMA32(F[5 * 64], sb01, O1); O1 = MFMA32(F[6 * 64], sb10, O1); O1 = MFMA32(F[7 * 64], sb11, O1);
                O0 = MFMA32(F[16 * 64], vb[0], O0); O0 = MFMA32(F[17 * 64], vb[1], O0);
#pragma unroll
                for (int ks = 0; ks < 4; ++ks) O1 = MFMA32(F[(20 + ks) * 64], vb[ks], O1);
#pragma unroll
                for (int i = 0; i < 16; ++i) { S0[i] *= gend; S1[i] *= gend; }
#pragma unroll
                for (int ks = 0; ks < 4; ++ks) { S0 = MFMA32(F[(8 + ks) * 64], vb[ks], S0); S1 = MFMA32(F[(12 + ks) * 64], vb[ks], S1); }
                float* yo = YS + (size_t)(b * 2048 + n * 64) * 1024 + hd * 64 + 32 * nt + r;
#pragma unroll
                for (int i = 0; i < 16; ++i) { yo[(size_t)crow(i, hp) * 1024] = O0[i]; yo[(size_t)(32 + crow(i, hp)) * 1024] = O1[i]; }
            }
            if (dmaw) { if (n + 3 < 32) asm volatile("s_waitcnt vmcnt(18)" ::: "memory"); else if (n + 2 < 32) asm volatile("s_waitcnt vmcnt(9)" ::: "memory"); else asm volatile("s_waitcnt vmcnt(0)" ::: "memory"); }
            asm volatile("s_waitcnt lgkmcnt(0)" ::: "memory"); __builtin_amdgcn_s_barrier(); asm volatile("" ::: "memory");
        }
#undef SSD_DMA
        if (wave < 2) {
            float* dst = kp.out() + O_SSD_P + ((size_t)j * 4 + b) * ((size_t)16 * 64 * 64) + (size_t)hd * 64 * 64 + 32 * nt + r;
#pragma unroll
            for (int i = 0; i < 16; ++i) { dst[(size_t)crow(i, hp) * 64] = S0[i]; dst[(size_t)(32 + crow(i, hp)) * 64] = S1[i]; }
        }
    }
    SEC_END(10, lds)
    SEC_BEGIN(11)
    unsigned* qhead = (unsigned*)(kp.ws() + WS_CTL) + CW_CNT + 64 * li;
    volatile LAS unsigned* qslot = (volatile LAS unsigned*)(lds + LDS_BYTES - 8);
    const float* cw = kp.in(23) + (size_t)j * 4 * 1536; const float* cb = kp.in(24) + (size_t)j * 1536; const float* stc = kp.in(6) + (size_t)j * 128 * 3 * 1536;
    for (;;) {
        __syncthreads();
        if (tid0 == 0) qslot[0] = __hip_atomic_fetch_add(qhead, 1u, __ATOMIC_RELAXED, __HIP_MEMORY_SCOPE_AGENT);
        __syncthreads();
        const int it = (int)qslot[0];
        if (it >= 1024) break;
        int tid = tid0; asm volatile("" : "+v"(tid));
        if (it < 256) {
            const int s = it >> 6, h = it & 63; int row0, L; seq_info(s, row0, L);
            LAS float* Al = (LAS float*)lds; LAS float* Bl = Al + 512;
            const int chunk = tid >> 4, c16 = tid & 15, ch = h * 16 + c16;
            const size_t ro = (size_t)(row0 + chunk * 64) * 1024 + ch;
            float Ap = 1.f, Bp = 0.f;
#pragma unroll 8
            for (int t = 0; t < 64; ++t) { const float a = LA[ro + (size_t)t * 1024], bb = LB[ro + (size_t)t * 1024]; Bp = a * Bp + bb; Ap *= a; }
            Al[tid] = Ap; Bl[tid] = Bp;
            __syncthreads();
            float hh = 0.f;
            for (int m = 0; m < chunk; ++m) hh = Al[m * 16 + c16] * hh + Bl[m * 16 + c16];
#pragma unroll 8
            for (int t = 0; t < 64; ++t) { hh = LA[ro + (size_t)t * 1024] * hh + LB[ro + (size_t)t * 1024]; HS[ro + (size_t)t * 1024] = hh; }
            if (chunk == 31) kp.out()[O_LRU_P + ((size_t)j * 4 + s) * 1024 + ch] = hh;
        } else if (it < 768) {
            const int q_ = it - 256, bs = q_ >> 2, g = q_ & 3, sq = 4 + bs, r0 = TP + bs * 4;
            LAS float* BL = (LAS float*)lds; LAS float* CL = BL + 256; LAS float* XL = CL + 256; LAS float* DTL = XL + 1024; LAS float* QKs = DTL + 16; LAS float* red = QKs + 16;
            const int wave = tid >> 6, lane = tid & 63, hh = tid >> 7, nh = (tid >> 6) & 1, p = tid & 63, hd = 4 * g + hh;
            const size_t SZ = (size_t)16 * 64 * 64;
            const float* st = kp.in(5) + ((size_t)j * 128 + bs) * SZ + (size_t)hd * 4096;
            float S[32];
            { const float* sp = st + (size_t)(nh * 32) * 64 + p;
#pragma unroll
              for (int i = 0; i < 32; ++i) { S[i] = *sp; sp += 64; asm volatile("" : "+v"(sp)); } }
            { const int ci = tid & 127, tk = tid >> 7;
#pragma unroll
              for (int q = 0; q < 3; ++q) { const int k = ci + 128 * q; int cidx; LAS float* dst;
                  if (k < 64) { cidx = 1024 + g * 64 + k; dst = BL + tk * 64 + k; } else if (k < 128) { cidx = 1280 + g * 64 + (k - 64); dst = CL + tk * 64 + (k - 64); } else { cidx = g * 256 + (k - 128); dst = XL + tk * 256 + (k - 128); }
                  float acc = cb[cidx];
#pragma unroll
                  for (int tap = 0; tap < 4; ++tap) acc += cw[tap * 1536 + cidx] * pre_val(U, NCD, 1024 + cidx, r0, tk - 3 + tap, sq, stc, 1536, cidx);
                  *dst = silu_(acc); } }
            if (tid < 16) { const int tk = tid >> 2, h2 = tid & 3; DTL[tid] = softplus_(bf2f(U[(size_t)(r0 + tk) * NCD + 4608 + 4 * g + h2]) + kp.in(26)[j * 16 + 4 * g + h2]); }
            __syncthreads();
#pragma unroll
            for (int q = 0; q < 2; ++q) { const int idx = wave * 2 + q, i = idx >> 2, jj = idx & 3; const float dot = wave_sum(CL[i * 64 + lane] * BL[jj * 64 + lane]); if (lane == 0) QKs[idx] = dot; }
            { const int tk = tid >> 7, k2 = tid & 127; ((unsigned*)XS)[((size_t)(r0 + tk) * 1024 + g * 256) / 2 + k2] = pk2(XL[tk * 256 + 2 * k2], XL[tk * 256 + 2 * k2 + 1]); }
            const float negA = -__expf(kp.in(25)[j * 16 + hd]);
            float Gc[4], xd[4], w[4];
            Gc[0] = negA * DTL[hh]; Gc[1] = Gc[0] + negA * DTL[4 + hh]; Gc[2] = Gc[1] + negA * DTL[8 + hh]; Gc[3] = Gc[2] + negA * DTL[12 + hh];
#pragma unroll
            for (int jj = 0; jj < 4; ++jj) { xd[jj] = XL[jj * 256 + hh * 64 + p] * DTL[jj * 4 + hh]; w[jj] = __expf(Gc[3] - Gc[jj]) * xd[jj]; }
            const float eg = __expf(Gc[3]);
            float o[4] = {0.f, 0.f, 0.f, 0.f};
            float* dst = kp.out() + O_SSD_S + ((size_t)j * 128 + bs) * SZ + (size_t)hd * 4096 + (size_t)(nh * 32) * 64 + p;
#pragma unroll
            for (int i = 0; i < 32; ++i) { const int n = nh * 32 + i; const float s0 = S[i]; float acc = eg * s0;
#pragma unroll
                for (int t = 0; t < 4; ++t) { o[t] += CL[t * 64 + n] * s0; acc += BL[t * 64 + n] * w[t]; }
                *dst = acc; dst += 64; asm volatile("" : "+v"(dst)); }
#pragma unroll
            for (int t = 0; t < 4; ++t) red[((hh * 2 + nh) * 4 + t) * 64 + p] = o[t];
            __syncthreads();
            if (nh == 0) {
#pragma unroll
                for (int t = 0; t < 4; ++t) { float y = __expf(Gc[t]) * (red[((hh * 2) * 4 + t) * 64 + p] + red[((hh * 2 + 1) * 4 + t) * 64 + p]);
#pragma unroll
                    for (int jj = 0; jj <= t; ++jj) y += QKs[t * 4 + jj] * __expf(Gc[t] - Gc[jj]) * xd[jj];
                    YS[(size_t)(r0 + t) * 1024 + hd * 64 + p] = y; } }
        } else {
            const int q_ = it - 768, s = 4 + (q_ >> 1), h = q_ & 1; int row0, L; seq_info(s, row0, L);
            const int ch = h * 512 + tid;
            float hh = s < 4 ? 0.f : kp.in(7)[((size_t)j * 128 + (s - 4)) * 1024 + ch];
#pragma unroll 8
            for (int t = 0; t < L; ++t) { const size_t r = (size_t)(row0 + t); hh = LA[r * 1024 + ch] * hh + LB[r * 1024 + ch]; HS[r * 1024 + ch] = hh; }
            float* dst = s < 4 ? kp.out() + O_LRU_P + ((size_t)j * 4 + s) * 1024 : kp.out() + O_LRU_S + ((size_t)j * 128 + (s - 4)) * 1024;
            dst[ch] = hh;
        }
    }
    SEC_END(11, lds)
}

__device__ __forceinline__ void phase_cd_post(const KP kp, const int bid, const int G, int j, int tid, int wave, int lane) {
    unsigned char* scr = kp.ws() + WS_SCR; const bf16* U = (const bf16*)(kp.ws() + WS_U); bf16* YM = (bf16*)(kp.ws() + WS_YM);
    const float* YS = (const float*)(scr + SC_YS); const float* HS = (const float*)(scr + SC_HS); const bf16* XS = (const bf16*)(scr + SC_XS);
    const float* sn = kp.in(28) + (size_t)j * 1024; const float* Dv = kp.in(27) + (size_t)j * 16;
    typedef float f32x2v __attribute__((ext_vector_type(2)));
    for (int r = bid * NWAVES + wave; r < T; r += G * NWAVES) {
        int s, t; row_to_seq(r, s, t); int row0, L; seq_info(s, row0, L);
        const bf16* ur = U + (size_t)r * NCD; bf16* yr = YM + (size_t)r * DM;
        f32x4 ysv[4], hsv[4]; u32x2 xxv[4], zzv[4], zlv[4];
#pragma unroll
        for (int gq = 0; gq < 4; ++gq) { const int e = gq * 256 + 4 * lane; ysv[gq] = *(const f32x4*)(YS + (size_t)r * 1024 + e); xxv[gq] = *(const u32x2*)(XS + (size_t)r * 1024 + e); zzv[gq] = *(const u32x2*)(ur + e);
            hsv[gq] = *(const f32x4*)(HS + (size_t)r * 1024 + e); zlv[gq] = *(const u32x2*)(ur + 2560 + e); }
#pragma unroll
        for (int gq = 0; gq < 4; ++gq) { const int e = gq * 256 + 4 * lane; const f32x4 ys = ysv[gq];
            const u32x2 xx = xxv[gq], zz = zzv[gq]; const float Dh = Dv[e >> 6];
            f32x4 y; y.x = (ys.x + Dh * __uint_as_float(xx.x << 16)) * silu_(__uint_as_float(zz.x << 16)); y.y = (ys.y + Dh * __uint_as_float(xx.x & 0xffff0000u)) * silu_(__uint_as_float(zz.x & 0xffff0000u));
            y.z = (ys.z + Dh * __uint_as_float(xx.y << 16)) * silu_(__uint_as_float(zz.y << 16)); y.w = (ys.w + Dh * __uint_as_float(xx.y & 0xffff0000u)) * silu_(__uint_as_float(zz.y & 0xffff0000u));
            const float rstd = rsqrtf(wave_sum((y.x * y.x + y.y * y.y) + (y.z * y.z + y.w * y.w)) * (1.f / 256.f) + 1e-6f);
            const f32x4 g4 = *(const f32x4*)(sn + e);
            u32x2 w; w.x = pk2(y.x * rstd * g4.x, y.y * rstd * g4.y); w.y = pk2(y.z * rstd * g4.z, y.w * rstd * g4.w); *(u32x2*)(yr + e) = w; }
#pragma unroll
        for (int gq = 0; gq < 4; ++gq) { const int ch = gq * 256 + 4 * lane; const f32x4 hs = hsv[gq]; const u32x2 zz = zlv[gq];
            u32x2 w; w.x = pk2(hs.x * silu_(__uint_as_float(zz.x << 16)), hs.y * silu_(__uint_as_float(zz.x & 0xffff0000u))); w.y = pk2(hs.z * silu_(__uint_as_float(zz.y << 16)), hs.w * silu_(__uint_as_float(zz.y & 0xffff0000u)));
            *(u32x2*)(yr + 1024 + ch) = w; }
        if (t >= L - 3) { const int rr = t - (L - 3);
            float* d1 = s < 4 ? kp.out() + O_SSDC_P + (((size_t)j * 4 + s) * 3 + rr) * 1536 : kp.out() + O_SSDC_S + (((size_t)j * 128 + (s - 4)) * 3 + rr) * 1536;
            for (int c = 2 * lane; c < 1536; c += 128) { const unsigned uu = *(const unsigned*)(ur + 1024 + c); *(f32x2v*)(d1 + c) = (f32x2v){__uint_as_float(uu << 16), __uint_as_float(uu & 0xffff0000u)}; }
            float* d2 = s < 4 ? kp.out() + O_LRUC_P + (((size_t)j * 4 + s) * 3 + rr) * 1024 : kp.out() + O_LRUC_S + (((size_t)j * 128 + (s - 4)) * 3 + rr) * 1024;
            for (int c = 2 * lane; c < 1024; c += 128) { const unsigned uu = *(const unsigned*)(ur + 3584 + c); *(f32x2v*)(d2 + c) = (f32x2v){__uint_as_float(uu << 16), __uint_as_float(uu & 0xffff0000u)}; } }
    }
}


typedef float f32x4m __attribute__((ext_vector_type(4)));
template <bool GATE>
__device__ __forceinline__ void sample_gemm_res(LAS unsigned char* lds, const bf16* Amat, const bf16* Bt, const bf16* Hin, bf16* Hout, float* rss_out, const bf16* PP, const float* rss_in, int bid, int tid) {
    if (bid >= 256) return;
    const int wave = tid >> 6, lane = tid & 63, lr = lane & 15, kg = lane >> 4;
    const int m0 = TP + (bid & 7) * 64, n0 = (bid >> 3) * 64;
    const bf16x8* ap = (const bf16x8*)(Amat + (size_t)(m0 + lr) * 2048 + wave * 256 + 8 * kg);
    const bf16x8* bp = (const bf16x8*)(Bt + (size_t)(n0 + lr) * 2048 + wave * 256 + 8 * kg);
    f32x4m acc[4][4];
#pragma unroll
    for (int mi = 0; mi < 4; ++mi)
#pragma unroll
        for (int ni = 0; ni < 4; ++ni) acc[mi][ni] = (f32x4m){0.f, 0.f, 0.f, 0.f};
#pragma unroll 2
    for (int ks = 0; ks < 8; ++ks) { bf16x8 a[4], b[4];
#pragma unroll
        for (int q = 0; q < 4; ++q) { a[q] = ap[(size_t)q * 16 * 256 + ks * 4]; b[q] = bp[(size_t)q * 16 * 256 + ks * 4]; }
#pragma unroll
        for (int mi = 0; mi < 4; ++mi)
#pragma unroll
            for (int ni = 0; ni < 4; ++ni) acc[mi][ni] = __builtin_amdgcn_mfma_f32_16x16x32_bf16(a[mi], b[ni], acc[mi][ni], 0, 0, 0); }
    LAS float* red = (LAS float*)lds;
    __syncthreads();
#pragma unroll
    for (int mi = 0; mi < 4; ++mi)
#pragma unroll
        for (int ni = 0; ni < 4; ++ni)
#pragma unroll
            for (int i = 0; i < 4; ++i) red[(wave * 64 + 16 * mi + kg * 4 + i) * 65 + 16 * ni + lr] = acc[mi][ni][i];
    __syncthreads();
    { const int row = tid >> 3, c8 = (tid & 7) * 8, grow = m0 + row; float v[8];
#pragma unroll
      for (int e = 0; e < 8; ++e) { float sacc = 0.f;
#pragma unroll
          for (int w = 0; w < 8; ++w) sacc += red[(w * 64 + row) * 65 + c8 + e];
          v[e] = sacc; }
      float sc = 1.f; if (GATE) sc = rsqrtf(rss_in[grow] * (1.f / 2048.f) + 1e-6f);
      const size_t p = (size_t)grow * 2048 + n0 + c8;
      const u32x4 hw = *(const u32x4*)(Hin + p); u32x4 pw = (u32x4){0u, 0u, 0u, 0u}; if (GATE) pw = *(const u32x4*)(PP + p);
      const unsigned hws[4] = {hw.x, hw.y, hw.z, hw.w}, pws[4] = {pw.x, pw.y, pw.z, pw.w}; unsigned ow[4]; float sq = 0.f;
#pragma unroll
      for (int e2 = 0; e2 < 4; ++e2) { float h0 = __uint_as_float(hws[e2] << 16), h1 = __uint_as_float(hws[e2] & 0xffff0000u);
          if (GATE) { h0 += __builtin_amdgcn_rcpf(1.f + __expf(-sc * v[2 * e2])) * __uint_as_float(pws[e2] << 16); h1 += __builtin_amdgcn_rcpf(1.f + __expf(-sc * v[2 * e2 + 1])) * __uint_as_float(pws[e2] & 0xffff0000u); }
          else { h0 += v[2 * e2]; h1 += v[2 * e2 + 1]; }
          sq += h0 * h0 + h1 * h1; ow[e2] = cvtpk(h0, h1); }
      *(u32x4*)(Hout + p) = (u32x4){ow[0], ow[1], ow[2], ow[3]};
      sq += __shfl_xor(sq, 1); sq += __shfl_xor(sq, 2); sq += __shfl_xor(sq, 4);
      if ((tid & 7) == 0) atomicAdd(rss_out + grow, sq); }
}

__global__ void __launch_bounds__(NTHR, 2) mega_fwd(Args A) {
    extern __shared__ __attribute__((aligned(16))) unsigned char lds_raw[];
    LAS unsigned char* lds = (LAS unsigned char*)lds_raw;
    const int G = gridDim.x;
    volatile LAS unsigned* bst = (volatile LAS unsigned*)(lds + LDS_BYTES - 16);
    if (threadIdx.x == 0) { bst[0] = 0u; bst[1] = 0u;
#ifdef PROBE_SEC
        *(volatile LAS unsigned long long*)(lds + LDS_BYTES - 32) = 0ull;
#endif
    }
    __syncthreads();
    XcdBarrier xbar = xcd_barrier_post((unsigned*)(A.ws + WS_CTL) + CW_BAR, bst);
#ifdef PROBE_GROUP
    unsigned long long t_prev = __builtin_amdgcn_s_memrealtime(), t_sel = 0;
#endif
    for (int ph = A.ph_lo; ph < A.ph_hi; ++ph) {
        KP kp; kp.p = (const char AS4*)__builtin_amdgcn_kernarg_segment_ptr(); asm volatile("" : "+s"(kp.p));
        unsigned char* ws = kp.ws();
        int tid = threadIdx.x; asm volatile("" : "+v"(tid));
        int bid = blockIdx.x; asm volatile("" : "+s"(bid));
        const int lane = tid & 63, wave = __builtin_amdgcn_readfirstlane(tid >> 6), gw = bid * NWAVES + wave, NGW = G * NWAVES;
        if (ph == 0) { if (PH_MASK & 1) phase_prologue(kp, lds, gw, NGW, wave, lane); }
        else if (ph == N_PHASES - 1) phase_final(kp, gw, NGW, lane);
        else {
            const int li = (ph - 1) / SUBS, sub = (ph - 1) % SUBS, j = li >> 1; const bool ab = (li & 1) == 0;
            float* RSS = (float*)(ws + WS_RSS);
            if (sub == 0) {
                const int N = ab ? NAB : NCD;
                const bf16* Bt = ab ? (const bf16*)(ws + WS_WABIN) + (size_t)j * NAB * 2048 : (const bf16*)(ws + WS_WCDIN) + (size_t)j * NCD * 2048;
                { pg8::Gemm g{(const bf16*)(ws + WS_XN), Bt, T, N, 2048}; pg8::StaticOrder S; S.init(T, N, G, bid);
                  pg8::EpiU E{(bf16*)(ws + WS_U), N, RSS + (size_t)(2 * li) * T};
                  if (PH_MASK & 2) pg8::gemm_phase<pg8::EpiU, pg8::StaticOrder, true, true>(lds, g, S, E, tid); }
                { int tid2 = tid; asm volatile("" : "+v"(tid2));
                  pg8::Gemm g{(const bf16*)(ws + WS_PB) + (size_t)li * T * 256, (const bf16*)(ws + WS_WPROJ) + (size_t)li * 2048 * 256, T, 2048, 256}; pg8::StaticOrder S; S.init(T, 2048, G, (bid + 37) % G);
                  pg8::EpiU E{(bf16*)(ws + WS_SCR + SC_PP), 2048, nullptr};
                  if (PH_MASK & 2) pg8::gemm_phase<pg8::EpiU, pg8::StaticOrder, true, true>(lds, g, S, E, tid2); }
            } else if (sub == 4) {
                const bf16* Bt = ab ? (const bf16*)(ws + WS_WABOUT) + (size_t)j * 2048 * 2048 : (const bf16*)(ws + WS_WCDOUT) + (size_t)j * 2048 * 2048;
                pg8::Gemm g{(const bf16*)(ws + WS_YM), Bt, TP, 2048, 2048}; pg8::StaticOrder S; S.init(TP, 2048, G, bid);
                pg8::EpiRes<false> E{(const bf16*)(ws + WS_XN), (bf16*)(ws + WS_SCR + SC_HB1), RSS + (size_t)(2 * li + 1) * T, nullptr, nullptr};
                if (PH_MASK & 4) pg8::gemm_phase<pg8::EpiRes<false>, pg8::StaticOrder, true, true>(lds, g, S, E, tid);
                { int tid2 = tid; asm volatile("" : "+v"(tid2));
                  sample_gemm_res<false>(lds, (const bf16*)(ws + WS_YM), Bt, (const bf16*)(ws + WS_XN), (bf16*)(ws + WS_SCR + SC_HB1), RSS + (size_t)(2 * li + 1) * T, nullptr, nullptr, bid, tid2); }
            } else if (sub == 5) {
                pg8::Gemm g{(const bf16*)(ws + WS_SCR + SC_HB1), (const bf16*)(ws + WS_WGATE) + (size_t)li * 2048 * 2048, TP, 2048, 2048}; pg8::StaticOrder S; S.init(TP, 2048, G, bid);
                pg8::EpiRes<true> E{(const bf16*)(ws + WS_SCR + SC_HB1), (bf16*)(ws + WS_XN), RSS + (size_t)(2 * li + 2) * T, (const bf16*)(ws + WS_SCR + SC_PP), RSS + (size_t)(2 * li + 1) * T};
                if (PH_MASK & 4) pg8::gemm_phase<pg8::EpiRes<true>, pg8::StaticOrder, true, true>(lds, g, S, E, tid);
                { int tid2 = tid; asm volatile("" : "+v"(tid2));
                  sample_gemm_res<true>(lds, (const bf16*)(ws + WS_SCR + SC_HB1), (const bf16*)(ws + WS_WGATE) + (size_t)li * 2048 * 2048, (const bf16*)(ws + WS_SCR + SC_HB1), (bf16*)(ws + WS_XN), RSS + (size_t)(2 * li + 2) * T,
                                        (const bf16*)(ws + WS_SCR + SC_PP), RSS + (size_t)(2 * li + 1) * T, bid, tid2); }
            } else if (sub == 1) {
                if (ab) { SEC_BEGIN(3) if (PH_MASK & 4096) phase_gla_prep(kp, bid, G, j, lds, tid); SEC_END(3, lds) SEC_BEGIN(4) if (PH_MASK & 8192) phase_dn_prep(kp, bid, G, j, lds, tid); SEC_END(4, lds) }
                else { if (PH_MASK & 2048) { SEC_BEGIN(8) phase_ssd_prep(kp, bid, G, j, lds, tid); SEC_END(8, lds) SEC_BEGIN(9) phase_lru_gates(kp, bid, G, j, lds, tid); SEC_END(9, lds) } }
            }
            else if (sub == 2) { if (ab) { if (PH_MASK & 32) phase_ab_rec(kp, bid, G, j, li, lds, tid); } else { if (PH_MASK & 64) phase_cd_rec(kp, bid, G, j, li, lds, tid); } }
            else { if (ab) { if (PH_MASK & 128) phase_ab_post(kp, bid, G, j, tid, wave, lane); } else { if (PH_MASK & 256) phase_cd_post(kp, bid, G, j, tid, wave, lane); } }
        }
        if (ph + 1 < A.ph_hi) { if (ph == A.ph_lo) cg::this_grid().sync(); else xcd_barrier(xbar); }
#ifdef PROBE_GROUP
        { const unsigned long long t_now = __builtin_amdgcn_s_memrealtime(); const int li_ = (ph - 1) / SUBS, sub_ = (ph - 1) % SUBS; const bool ab_ = (li_ & 1) == 0;
          int grp = 9; if (ph == N_PHASES - 1) grp = 8; else if (ph > 0) { if (sub_ == 0 || sub_ == 4 || sub_ == 5) grp = 1; else if (sub_ == 1) grp = ab_ ? 4 : 5; else if (sub_ == 2) grp = ab_ ? 6 : 7; else grp = 8; }
          if (grp == PROBE_GROUP) t_sel += t_now - t_prev; t_prev = t_now; }
#endif
    }
#ifdef PROBE_SEC
    if (blockIdx.x == PROBE_BLK && threadIdx.x == 0) { const unsigned long long t_s = *(volatile LAS unsigned long long*)(lds + LDS_BYTES - 32); const unsigned long long t0 = __builtin_amdgcn_s_memrealtime(); while (__builtin_amdgcn_s_memrealtime() - t0 < 3 * t_s) __builtin_amdgcn_s_sleep(8); }
#endif
#ifdef PROBE_GROUP
    if (blockIdx.x == 0 && threadIdx.x == 0) { const unsigned long long t0 = __builtin_amdgcn_s_memrealtime(); while (__builtin_amdgcn_s_memrealtime() - t0 < 3 * t_sel) __builtin_amdgcn_s_sleep(8); }
#endif
}

extern "C" void kernel_launch(void* const* d_in, const int* in_sizes, int n_in, void* d_out, int out_size, void* d_ws, size_t ws_size, hipStream_t stream) {
    static int grid = 0;
    if (grid == 0) {
        if (n_in != 40 || (size_t)out_size != O_END || ws_size < WS_END) { fprintf(stderr, "kernel_launch: unexpected shapes: n_in %d out %d ws %zu\n", n_in, out_size, ws_size); grid = -1; return; }
        int dev = 0, cus = 0, per_cu = 0;
        if (hipGetDevice(&dev) != hipSuccess || hipDeviceGetAttribute(&cus, hipDeviceAttributeMultiprocessorCount, dev) != hipSuccess) { grid = -1; return; }
        if (hipFuncSetAttribute((const void*)mega_fwd, hipFuncAttributeMaxDynamicSharedMemorySize, LDS_BYTES) != hipSuccess) { fprintf(stderr, "kernel_launch: hipFuncSetAttribute failed\n"); grid = -1; return; }
        if (hipOccupancyMaxActiveBlocksPerMultiprocessor(&per_cu, (const void*)mega_fwd, NTHR, LDS_BYTES) != hipSuccess || per_cu < 1) { fprintf(stderr, "kernel_launch: occupancy query says %d\n", per_cu); per_cu = 1; }
        (void)hipGetLastError();
        grid = cus;
    }
    if (grid < 0) return;
    if (hipMemsetAsync((char*)d_ws + WS_CTL, 0, CTL_ZERO_BYTES, stream) != hipSuccess) { fprintf(stderr, "kernel_launch: memset of the control words failed\n"); return; }
    Args a{};
    for (int i = 0; i < 40; ++i) a.in[i] = (const float*)d_in[i];
    a.out = (float*)d_out; a.ws = (unsigned char*)d_ws;
#if MK_N_LAUNCHES == 1
    a.ph_lo = 0; a.ph_hi = N_PHASES;
    void* args[] = {&a};
    hipError_t e = hipLaunchCooperativeKernel((const void*)mega_fwd, dim3(grid), dim3(NTHR), args, LDS_BYTES, stream);
    if (e != hipSuccess) fprintf(stderr, "cooperative launch failed: %s (grid %d)\n", hipGetErrorString(e), grid);
#else
    for (int ph = 0; ph < N_PHASES; ++ph) { a.ph_lo = ph; a.ph_hi = ph + 1; mega_fwd<<<dim3(grid), dim3(NTHR), LDS_BYTES, stream>>>(a); }
#endif
}
```

```cpp
#include <hip/hip_runtime.h>
#include <hip/hip_cooperative_groups.h>
#include <cstdio>
#include <cstdint>
namespace cg = cooperative_groups;

#ifndef MK_N_LAUNCHES
#define MK_N_LAUNCHES 1
#endif

namespace pg8 {
#define PG8_LAS __attribute__((address_space(3)))
typedef unsigned short bf16_t;
typedef short bf16x8 __attribute__((ext_vector_type(8)));
typedef float f32x4 __attribute__((ext_vector_type(4)));
typedef unsigned u32x4 __attribute__((ext_vector_type(4)));
constexpr int BM = 256, BK = 64, HALF = 128, HTB = HALF * BK * 2  , STAGE_BYTES = 8 * HTB, NXCD = 8, WGM = 8;

__host__ __device__ __forceinline__ int lds_byte(int r, int c) { const int st = (r >> 4) * 2 + (c >> 5), rr = r & 15, cc = c & 31, ob = rr * 64 + cc * 2; return st * 1024 + (ob ^ (((ob >> 9) & 1) << 5)); }
__host__ __device__ __forceinline__ void stage_rc(int b, int& R, int& C) { const int st = b / 1024, sb = b % 1024, swz = sb ^ (((sb >> 9) & 1) << 5); R = (st >> 1) * 16 + swz / 64; C = (st & 1) * 32 + (swz % 64) / 2; }
__host__ __device__ __forceinline__ int perm32(int rho) { const int n = rho >> 4, i = rho & 15; return 8 * (i >> 2) + 4 * n + (i & 3); }

struct Unit { int pm, pn; };
struct Gemm { const bf16_t* A; const bf16_t* Bt; int M, N, K; };

struct StaticOrder {
    int nM, nN, nwg, G, c;
    __host__ __device__ void init(int M, int N, int G_, int c_) { nM = M / BM; nN = N / BM; nwg = nM * nN; G = G_; c = c_; }
    __host__ __device__ bool next(int i, Unit& u) const {
        const long L = (long)i * G + c; if (L >= nwg) return false;
        int wgid = (int)L; { const int q = nwg / NXCD, r = nwg % NXCD, xcd = wgid % NXCD, off = wgid / NXCD; wgid = (xcd < r ? xcd * (q + 1) : r * (q + 1) + (xcd - r) * q) + off; }
        const int nig = WGM * nN, gid = wgid / nig, fm = gid * WGM, gsz = (nM - fm) < WGM ? (nM - fm) : WGM;
        u.pm = fm + ((wgid % nig) % gsz); u.pn = (wgid % nig) / gsz; return true;
    }
    __device__ __forceinline__ void a_ready(const Unit&) const {}
    __device__ __forceinline__ void done(const Unit&) const {}
};

__device__ __forceinline__ unsigned cvt_pk_bf16(float lo, float hi) { unsigned r; asm volatile("v_cvt_pk_bf16_f32 %0, %1, %2" : "=v"(r) : "v"(lo), "v"(hi)); return r; }
struct EpiF32 {
    static constexpr bool PERM = false, AFTER_DRAIN = false;
    float* C; int ldc;
    __device__ __forceinline__ void operator()(const f32x4 (&acc)[2][2][4][2], const Unit& u, int wr, int wc, int fr, int fq) const {
        const int row0 = u.pm * BM + wr * 64 + fr, col0 = u.pn * BM + wc * 32 + 4 * fq;
#pragma unroll
        for (int ai = 0; ai < 2; ++ai)
#pragma unroll
            for (int m = 0; m < 4; ++m) { float* rowp = C + (size_t)(row0 + ai * HALF + m * 16) * ldc + col0;
#pragma unroll
                for (int bj = 0; bj < 2; ++bj)
#pragma unroll
                    for (int n = 0; n < 2; ++n) *(f32x4*)(rowp + bj * HALF + n * 16) = acc[ai][bj][m][n]; }
    }
};
struct EpiBf16 {
    static constexpr bool PERM = true, AFTER_DRAIN = false;
    bf16_t* O; int ldc;
    __device__ __forceinline__ void operator()(const f32x4 (&acc)[2][2][4][2], const Unit& u, int wr, int wc, int fr, int fq) const {
        const int row0 = u.pm * BM + wr * 64 + fr; const int col0 = u.pn * BM + wc * 32 + 8 * fq;
#pragma unroll
        for (int ai = 0; ai < 2; ++ai)
#pragma unroll
            for (int m = 0; m < 4; ++m) { bf16_t* rowp = O + (size_t)(row0 + ai * HALF + m * 16) * ldc + col0;
#pragma unroll
                for (int bj = 0; bj < 2; ++bj) { const f32x4 v0 = acc[ai][bj][m][0], v1 = acc[ai][bj][m][1];
                    u32x4 w; w.x = cvt_pk_bf16(v0[0], v0[1]); w.y = cvt_pk_bf16(v0[2], v0[3]); w.z = cvt_pk_bf16(v1[0], v1[1]); w.w = cvt_pk_bf16(v1[2], v1[3]);
                    *(u32x4*)(rowp + bj * HALF) = w; } }
    }
};

struct EpiU {
    static constexpr bool PERM = true, AFTER_DRAIN = false;
    bf16_t* O; int ldc; const float* rss;
    __device__ __forceinline__ void operator()(const f32x4 (&acc)[2][2][4][2], const Unit& u, int wr, int wc, int fr, int fq) const {
        const int row0 = u.pm * BM + wr * 64 + fr; const int col0 = u.pn * BM + wc * 32 + 8 * fq;
#pragma unroll
        for (int ai = 0; ai < 2; ++ai)
#pragma unroll
            for (int m = 0; m < 4; ++m) { const int row = row0 + ai * HALF + m * 16; const float sc = rss ? rsqrtf(rss[row] * (1.f / 2048.f) + 1e-6f) : 1.f;
                bf16_t* rowp = O + (size_t)row * ldc + col0;
#pragma unroll
                for (int bj = 0; bj < 2; ++bj) { const f32x4 v0 = acc[ai][bj][m][0] * sc, v1 = acc[ai][bj][m][1] * sc;
                    u32x4 w; w.x = cvt_pk_bf16(v0[0], v0[1]); w.y = cvt_pk_bf16(v0[2], v0[3]); w.z = cvt_pk_bf16(v1[0], v1[1]); w.w = cvt_pk_bf16(v1[2], v1[3]);
                    *(u32x4*)(rowp + bj * HALF) = w; } }
    }
};
typedef unsigned u32x2e __attribute__((ext_vector_type(2)));
template <bool GATE> struct EpiRes {
    static constexpr bool PERM = false, AFTER_DRAIN = false;
    const bf16_t* Hin; bf16_t* Hout; float* rss_out; const bf16_t* PP; const float* rss_in;
    __device__ __forceinline__ void operator()(const f32x4 (&acc)[2][2][4][2], const Unit& u, int wr, int wc, int fr, int fq) const {
        const int row0 = u.pm * BM + wr * 64 + fr, col0 = u.pn * BM + wc * 32 + 4 * fq;
#pragma unroll
        for (int ai = 0; ai < 2; ++ai)
#pragma unroll
            for (int m = 0; m < 4; ++m) { const int row = row0 + ai * HALF + m * 16; const size_t ro = (size_t)row * 2048 + col0;
                float sc = 1.f; if (GATE) sc = rsqrtf(rss_in[row] * (1.f / 2048.f) + 1e-6f);
                float s = 0.f;
#pragma unroll
                for (int bj = 0; bj < 2; ++bj)
#pragma unroll
                    for (int n = 0; n < 2; ++n) { const size_t p = ro + bj * HALF + n * 16; const u32x2e hw = *(const u32x2e*)(Hin + p); const f32x4 a = acc[ai][bj][m][n];
                        f32x4 h; h[0] = __uint_as_float(hw.x << 16); h[1] = __uint_as_float(hw.x & 0xffff0000u); h[2] = __uint_as_float(hw.y << 16); h[3] = __uint_as_float(hw.y & 0xffff0000u);
                        if (GATE) { const u32x2e pw = *(const u32x2e*)(PP + p);
                            h[0] += __builtin_amdgcn_rcpf(1.f + __expf(-sc * a[0])) * __uint_as_float(pw.x << 16); h[1] += __builtin_amdgcn_rcpf(1.f + __expf(-sc * a[1])) * __uint_as_float(pw.x & 0xffff0000u);
                            h[2] += __builtin_amdgcn_rcpf(1.f + __expf(-sc * a[2])) * __uint_as_float(pw.y << 16); h[3] += __builtin_amdgcn_rcpf(1.f + __expf(-sc * a[3])) * __uint_as_float(pw.y & 0xffff0000u); }
                        else h = h + a;
                        s += (h[0] * h[0] + h[1] * h[1]) + (h[2] * h[2] + h[3] * h[3]);
                        u32x2e o; o.x = cvt_pk_bf16(h[0], h[1]); o.y = cvt_pk_bf16(h[2], h[3]); *(u32x2e*)(Hout + p) = o; }
                s += __shfl_xor(s, 16); s += __shfl_xor(s, 32);
                if (fq == 0) atomicAdd(rss_out + row, s);
                asm volatile("" ::: "memory"); }
    }
};
template <class Epi, class Sched, bool ALIGN_EPI = false, bool SP2 = false>
__device__ __forceinline__ void gemm_phase(PG8_LAS unsigned char* lds, const Gemm g, const Sched& S, const Epi& E, const int tid) {
    const int wid = __builtin_amdgcn_readfirstlane(tid >> 6), lane = tid & 63, wr = wid >> 2, wc = wid & 3, fr = lane & 15, fq = lane >> 4;
    const int K = g.K, nt = K / BK;
    unsigned voffA[2], voffB[2];
#pragma unroll
    for (int i = 0; i < 2; ++i) { int R, C; stage_rc(tid * 16 + i * 8192, R, C); const int Rb = Epi::PERM ? ((R & ~31) + perm32(R & 31)) : R;
        voffA[i] = (unsigned)(R * K + C) * 2u; voffB[i] = (unsigned)(Rb * K + C) * 2u; }
    const size_t kstep = (size_t)(BK * 2);
    const size_t hstep = (size_t)HALF * K * 2;
    const size_t tstep = 2 * hstep;
    const unsigned ldsw = (unsigned)wid * 1024u;
    const int aoff = lds_byte(wr * 64 + fr, fq * 8), boff = lds_byte(wc * 32 + fr, fq * 8);
#define PG8_SA(b, h) (((b) * 2 + (h)) * HTB)
#define PG8_SB(b, h) ((4 + (b) * 2 + (h)) * HTB)
#define PG8_STAGE(bufoff, gbase, voff) do { _Pragma("unroll") for (int _i = 0; _i < 2; ++_i) \
        __builtin_amdgcn_global_load_lds((const unsigned*)((const char*)(gbase) + (voff)[_i]), (PG8_LAS unsigned*)(lds + (bufoff) + ldsw + _i * 8192), 16, 0, 0); } while (0)
#define PG8_LDA(dst, b, h) do { _Pragma("unroll") for (int m = 0; m < 4; ++m) _Pragma("unroll") for (int k = 0; k < 2; ++k) dst[m][k] = *(const PG8_LAS bf16x8*)(lds + PG8_SA(b, h) + aoff + m * 2048 + k * 1024); } while (0)
#define PG8_LDB(dst, b, h) do { _Pragma("unroll") for (int n = 0; n < 2; ++n) _Pragma("unroll") for (int k = 0; k < 2; ++k) dst[n][k] = *(const PG8_LAS bf16x8*)(lds + PG8_SB(b, h) + boff + n * 2048 + k * 1024); } while (0)
#define PG8_MMA(ai, bj, At, Bt) do { __builtin_amdgcn_s_setprio(1); _Pragma("unroll") for (int m = 0; m < 4; ++m) _Pragma("unroll") for (int n = 0; n < 2; ++n) _Pragma("unroll") for (int k = 0; k < 2; ++k) \
        acc[ai][bj][m][n] = __builtin_amdgcn_mfma_f32_16x16x32_bf16(Bt[n][k], At[m][k], acc[ai][bj][m][n], 0, 0, 0); __builtin_amdgcn_s_setprio(0); } while (0)
#define PG8_WAIT_V(n) asm volatile("s_waitcnt vmcnt(" #n ")" ::: "memory")
#define PG8_WAIT_L(n) asm volatile("s_waitcnt lgkmcnt(" #n ")" ::: "memory")
#define PG8_BAR __builtin_amdgcn_s_barrier()
#define PG8_SCHED __builtin_amdgcn_sched_barrier(0)
    Unit cur, nxt; int ui = 0;
    if (!S.next(0, cur)) return;
    f32x4 acc[2][2][4][2];
#pragma unroll
    for (int a = 0; a < 2; ++a)
#pragma unroll
        for (int b = 0; b < 2; ++b)
#pragma unroll
            for (int m = 0; m < 4; ++m)
#pragma unroll
                for (int n = 0; n < 2; ++n) acc[a][b][m][n] = (f32x4){0.f, 0.f, 0.f, 0.f};
    bf16x8 At[4][2], B0[2][2], B1[2][2];
    const char* cA = (const char*)g.A + (size_t)cur.pm * tstep; const char* cB = (const char*)g.Bt + (size_t)cur.pn * tstep;
    S.a_ready(cur);
    if constexpr (SP2) {
        PG8_STAGE(PG8_SB(0, 0), cB, voffB); PG8_STAGE(PG8_SB(0, 1), cB + hstep, voffB); PG8_STAGE(PG8_SA(0, 0), cA, voffA); PG8_STAGE(PG8_SA(0, 1), cA + hstep, voffA);
        if (wr == 1) PG8_BAR;
        PG8_WAIT_V(2); PG8_BAR;
        PG8_STAGE(PG8_SB(1, 0), cB + kstep, voffB); PG8_STAGE(PG8_SA(1, 0), cA + kstep, voffA); PG8_STAGE(PG8_SB(1, 1), cB + hstep + kstep, voffB);
        PG8_WAIT_V(6); PG8_BAR;
    } else {
        PG8_STAGE(PG8_SB(0, 0), cB, voffB); PG8_STAGE(PG8_SA(0, 0), cA, voffA); PG8_STAGE(PG8_SB(0, 1), cB + hstep, voffB); PG8_STAGE(PG8_SA(0, 1), cA + hstep, voffA);
        if (wr == 1) PG8_BAR;
        PG8_WAIT_V(4); PG8_BAR;
        PG8_STAGE(PG8_SB(1, 0), cB + kstep, voffB); PG8_STAGE(PG8_SA(1, 0), cA + kstep, voffA); PG8_STAGE(PG8_SB(1, 1), cB + hstep + kstep, voffB);
        PG8_WAIT_V(6); PG8_BAR;
    }
    for (;;) {
        const bool has_next = S.next(ui + 1, nxt);
        const char* nA = has_next ? (const char*)g.A + (size_t)nxt.pm * tstep : cA; const char* nB = has_next ? (const char*)g.Bt + (size_t)nxt.pn * tstep : cB;
        for (int t = 0; t < nt; t += 2) {
            const bool last = (t == nt - 2);
            const char* a1 = cA + (size_t)(t + 1) * kstep;
            const char* a2 = last ? nA : cA + (size_t)(t + 2) * kstep; const char* b2 = last ? nB : cB + (size_t)(t + 2) * kstep;
            const char* a3 = a2 + kstep; const char* b3 = b2 + kstep;
            if (last && has_next) S.a_ready(nxt);
            if constexpr (SP2) {
            PG8_LDB(B0, 0, 0); PG8_LDB(B1, 0, 1); PG8_SCHED; PG8_LDA(At, 0, 0); PG8_STAGE(PG8_SA(1, 1), a1 + hstep, voffA);
            PG8_WAIT_V(8); PG8_WAIT_L(0); PG8_BAR; PG8_MMA(0, 0, At, B0); PG8_MMA(0, 1, At, B1); PG8_BAR; PG8_SCHED;
            PG8_LDA(At, 0, 1); PG8_STAGE(PG8_SB(0, 0), b2, voffB); PG8_STAGE(PG8_SB(0, 1), b2 + hstep, voffB); PG8_STAGE(PG8_SA(0, 0), a2, voffA);
            PG8_WAIT_V(8); PG8_WAIT_L(0); PG8_BAR; PG8_MMA(1, 0, At, B0); PG8_MMA(1, 1, At, B1); PG8_BAR; PG8_SCHED;
            PG8_LDB(B0, 1, 0); PG8_LDB(B1, 1, 1); PG8_SCHED; PG8_LDA(At, 1, 0); PG8_STAGE(PG8_SA(0, 1), a2 + hstep, voffA);
            PG8_WAIT_V(8); PG8_WAIT_L(0); PG8_BAR; PG8_MMA(0, 0, At, B0); PG8_MMA(0, 1, At, B1); PG8_BAR; PG8_SCHED;
            PG8_LDA(At, 1, 1); PG8_STAGE(PG8_SB(1, 0), b3, voffB); PG8_STAGE(PG8_SB(1, 1), b3 + hstep, voffB); PG8_STAGE(PG8_SA(1, 0), a3, voffA);
            PG8_WAIT_V(8); PG8_WAIT_L(0); PG8_BAR; PG8_MMA(1, 0, At, B0); PG8_MMA(1, 1, At, B1); PG8_BAR; PG8_SCHED;
            } else {
            PG8_LDB(B0, 0, 0); PG8_SCHED; PG8_LDA(At, 0, 0); PG8_STAGE(PG8_SA(1, 1), a1 + hstep, voffA);
            PG8_WAIT_L(8); PG8_BAR; PG8_WAIT_L(0); PG8_MMA(0, 0, At, B0); PG8_BAR; PG8_SCHED;
            PG8_LDB(B1, 0, 1); PG8_STAGE(PG8_SB(0, 0), b2, voffB);
            PG8_BAR; PG8_WAIT_L(0); PG8_MMA(0, 1, At, B1); PG8_BAR;
            PG8_LDA(At, 0, 1); PG8_STAGE(PG8_SA(0, 0), a2, voffA);
            PG8_BAR; PG8_WAIT_L(0); PG8_MMA(1, 0, At, B0); PG8_BAR; PG8_SCHED;
            PG8_STAGE(PG8_SB(0, 1), b2 + hstep, voffB);
            PG8_WAIT_V(6); PG8_BAR; PG8_MMA(1, 1, At, B1); PG8_BAR;
            PG8_LDB(B0, 1, 0); PG8_SCHED; PG8_LDA(At, 1, 0); PG8_STAGE(PG8_SA(0, 1), a2 + hstep, voffA);
            PG8_WAIT_L(8); PG8_BAR; PG8_WAIT_L(0); PG8_MMA(0, 0, At, B0); PG8_BAR; PG8_SCHED;
            PG8_LDB(B1, 1, 1); PG8_STAGE(PG8_SB(1, 0), b3, voffB);
            PG8_BAR; PG8_WAIT_L(0); PG8_MMA(0, 1, At, B1); PG8_BAR;
            PG8_LDA(At, 1, 1); PG8_STAGE(PG8_SA(1, 0), a3, voffA);
            PG8_BAR; PG8_WAIT_L(0); PG8_MMA(1, 0, At, B0); PG8_BAR; PG8_SCHED;
            PG8_STAGE(PG8_SB(1, 1), b3 + hstep, voffB);
            PG8_WAIT_V(6); PG8_BAR; PG8_MMA(1, 1, At, B1); PG8_BAR;
            }
        }
        if constexpr (ALIGN_EPI) { if (wr == 0) PG8_BAR; }
        if constexpr (!Epi::AFTER_DRAIN) { E(acc, cur, wr, wc, fr, fq); S.done(cur); }
        if (!has_next) break;
#pragma unroll
        for (int a = 0; a < 2; ++a)
#pragma unroll
            for (int b = 0; b < 2; ++b)
#pragma unroll
                for (int m = 0; m < 4; ++m)
#pragma unroll
                    for (int n = 0; n < 2; ++n) acc[a][b][m][n] = (f32x4){0.f, 0.f, 0.f, 0.f};
        cur = nxt; cA = nA; cB = nB; ++ui;
        if constexpr (ALIGN_EPI) { if (wr == 1) PG8_BAR; }
    }
    PG8_WAIT_V(0);
    if constexpr (!ALIGN_EPI) { if (wr == 0) PG8_BAR; }
    PG8_BAR;
    if constexpr (Epi::AFTER_DRAIN) { E.fused(acc, cur, wr, wc, fr, fq, lds, wid, lane); S.done(cur); }
#undef PG8_SA
#undef PG8_SB
#undef PG8_STAGE
#undef PG8_LDA
#undef PG8_LDB
#undef PG8_MMA
#undef PG8_WAIT_V
#undef PG8_WAIT_L
#undef PG8_BAR
#undef PG8_SCHED
}
}

constexpr int TP = 8192, TS = 512, T = TP + TS, DM = 2048, NSEQ = 132;
constexpr int NAB = 7424, NCD = 4864;
constexpr int NWAVES = 8, NTHR = 512;
constexpr size_t MiB = 1u << 20;
constexpr size_t WS_CTL = 0, CTL_ZERO_BYTES = 1 * MiB;
constexpr int CW_BAR = 4096, CW_CNT = 8192;
constexpr size_t WS_RSS = 65536;
constexpr size_t WS_WABIN = 2 * MiB, WS_WABOUT = 60 * MiB, WS_WCDIN = 76 * MiB, WS_WCDOUT = 114 * MiB, WS_WGATE = 130 * MiB, WS_WPROJ = 162 * MiB;
constexpr size_t WS_H = 166 * MiB, WS_XN = 234 * MiB, WS_YM = 268 * MiB, WS_PB = 302 * MiB, WS_U = 320 * MiB, WS_SCR = 444 * MiB, WS_END = 732 * MiB;
constexpr size_t SC_HB1 = 102 * MiB;
constexpr size_t SC_PP = 8 * MiB;
constexpr size_t SC_QN = 0, SC_KN = 2 * MiB, SC_VV = 4 * MiB, SC_GLOG = 6 * MiB, SC_BETA = 7 * MiB, SC_GDEC = 7 * MiB + 65536, SC_ODN = 102 * MiB, SC_OGLA = 136 * MiB,
    SC_DNOPS = 192 * MiB;
constexpr size_t SC_XBC = 0, SC_DT = 3 * MiB, SC_LA = 52 * MiB, SC_LB = 86 * MiB, SC_YS = 120 * MiB, SC_HS = 154 * MiB, SC_SSDOP = 192 * MiB, SC_XS = 270 * MiB;
constexpr int LDS_BYTES = 163840;
constexpr size_t O_Y_P = 0, O_Y_S = O_Y_P + (size_t)4 * 2048 * 2048, O_DN_P = O_Y_S + (size_t)128 * 4 * 2048,
    O_DNC_P = O_DN_P + (size_t)2 * 4 * 8 * 128 * 128, O_GLA_P = O_DNC_P + (size_t)2 * 4 * 3 * 3072, O_SSD_P = O_GLA_P + (size_t)2 * 4 * 4 * 128 * 256,
    O_SSDC_P = O_SSD_P + (size_t)2 * 4 * 16 * 64 * 64, O_LRU_P = O_SSDC_P + (size_t)2 * 4 * 3 * 1536, O_LRUC_P = O_LRU_P + (size_t)2 * 4 * 1024,
    O_DN_S = O_LRUC_P + (size_t)2 * 4 * 3 * 1024, O_DNC_S = O_DN_S + (size_t)2 * 128 * 8 * 128 * 128, O_GLA_S = O_DNC_S + (size_t)2 * 128 * 3 * 3072,
    O_SSD_S = O_GLA_S + (size_t)2 * 128 * 4 * 128 * 256, O_SSDC_S = O_SSD_S + (size_t)2 * 128 * 16 * 64 * 64, O_LRU_S = O_SSDC_S + (size_t)2 * 128 * 3 * 1536,
    O_LRUC_S = O_LRU_S + (size_t)2 * 128 * 1024, O_END = O_LRUC_S + (size_t)2 * 128 * 3 * 1024;
static_assert(O_END == 109064192, "output size");

#define LAS __attribute__((address_space(3)))
typedef unsigned short bf16;
typedef float f32x4 __attribute__((ext_vector_type(4)));
typedef unsigned u32x2 __attribute__((ext_vector_type(2)));
typedef unsigned u32x4 __attribute__((ext_vector_type(4)));
#define LDS_WAIT() asm volatile("s_waitcnt lgkmcnt(0)" ::: "memory")

__device__ __forceinline__ float bf2f(bf16 b) { return __uint_as_float(((unsigned)b) << 16); }
__device__ __forceinline__ unsigned f2bf(float f) { unsigned u = __float_as_uint(f); return (u + 0x7fffu + ((u >> 16) & 1u)) >> 16; }
__device__ __forceinline__ unsigned pk2(float lo, float hi) { return f2bf(lo) | (f2bf(hi) << 16); }
__device__ __forceinline__ float sigmoid_(float x) { return __builtin_amdgcn_rcpf(1.f + __expf(-x)); }
__device__ __forceinline__ float silu_(float x) { return x * __builtin_amdgcn_rcpf(1.f + __expf(-x)); }
__device__ __forceinline__ float softplus_(float x) { return x > 15.f ? x : (x < -15.f ? __expf(x) : __logf(1.f + __expf(x))); }
__device__ __forceinline__ float wave_sum(float v) {
#pragma unroll
    for (int o = 1; o < 64; o <<= 1) v += __shfl_xor(v, o);
    return v;
}
__device__ __forceinline__ void row_to_seq(int r, int& s, int& t) { if (r < TP) { s = r >> 11; t = r & 2047; } else { s = 4 + ((r - TP) >> 2); t = (r - TP) & 3; } }
__device__ __forceinline__ void seq_info(int s, int& row0, int& L) { if (s < 4) { row0 = s << 11; L = 2048; } else { row0 = TP + ((s - 4) << 2); L = 4; } }
__device__ __forceinline__ float pre_val(const bf16* U, int ldu, int ucol, int row0, int tt, int s, const float* stc, int W, int c) {
    const int tc = tt >= 0 ? tt : 0, sc = tt >= 0 ? 0 : 3 + tt;
    const float a = bf2f(U[(size_t)(row0 + tc) * ldu + ucol]), b = stc[((size_t)(s - 4) * 3 + sc) * W + c];
    return tt >= 0 ? a : b;
}
__device__ __forceinline__ int map_col(int mapid, int n) {
    if (mapid == 0) return n;
    if (mapid == 1) { if (n < 3072) return n; if (n < 6144) return n + 16; if (n < 7168) return n + 32; if (n < 7184) return n - 4096; if (n < 7200) return n - 1024; return -1; }
    if (n < 2560) return n; if (n < 4608) return n + 16; if (n < 4624) return n - 2048; return -1;
}
__device__ __forceinline__ void transpose_item(const float* W, int K, int Nsrc, bf16* WT, int Npad, int mapid, const float* gain, LAS float* scr, int item, int lane) {
    const int nblk = Npad / 64, kb = item / nblk, nb = item % nblk, k0 = 64 * kb, n0 = 64 * nb;
    const int n4 = (lane & 15) * 4, src = map_col(mapid, n0 + n4);
    const int srcc = src >= 0 ? src : 0; const float msk = src >= 0 ? 1.f : 0.f;
    f32x4 v[16];
#pragma unroll
    for (int i = 0; i < 16; ++i) v[i] = *(const f32x4*)(W + (size_t)(k0 + 4 * i + (lane >> 4)) * Nsrc + srcc);
    if (gain) {
#pragma unroll
        for (int i = 0; i < 16; ++i) v[i] = v[i] * (gain[k0 + 4 * i + (lane >> 4)] * msk);
    } else {
#pragma unroll
        for (int i = 0; i < 16; ++i) v[i] = v[i] * msk;
    }
#pragma unroll
    for (int i = 0; i < 16; ++i) { const int kk = 4 * i + (lane >> 4); scr[kk * 65 + n4] = v[i].x; scr[kk * 65 + n4 + 1] = v[i].y; scr[kk * 65 + n4 + 2] = v[i].z; scr[kk * 65 + n4 + 3] = v[i].w; }
    LDS_WAIT(); asm volatile("" ::: "memory");
    const int c = lane & 7;
#pragma unroll
    for (int jj = 0; jj < 8; ++jj) { const int n = (lane >> 3) + 8 * jj; const LAS float* p = scr + (8 * c) * 65 + n;
        u32x4 o; o.x = pk2(p[0 * 65], p[1 * 65]); o.y = pk2(p[2 * 65], p[3 * 65]); o.z = pk2(p[4 * 65], p[5 * 65]); o.w = pk2(p[6 * 65], p[7 * 65]);
        *(u32x4*)(WT + (size_t)(n0 + n) * K + k0 + 8 * c) = o; }
    LDS_WAIT(); asm volatile("" ::: "memory");
}
__device__ __forceinline__ void norm_row_bf16(const f32x4 (&v)[8], const float* g, bf16* orow, int lane) {
    float ss = 0.f;
#pragma unroll
    for (int j = 0; j < 8; ++j) ss += (v[j].x * v[j].x + v[j].y * v[j].y) + (v[j].z * v[j].z + v[j].w * v[j].w);
    const float rstd = rsqrtf(wave_sum(ss) * (1.f / DM) + 1e-6f);
#pragma unroll
    for (int j = 0; j < 8; ++j) { const int col = 4 * (lane + 64 * j); const f32x4 gg = *(const f32x4*)(g + col);
        u32x2 o; o.x = pk2(v[j].x * rstd * gg.x, v[j].y * rstd * gg.y); o.y = pk2(v[j].z * rstd * gg.z, v[j].w * rstd * gg.w);
        *(u32x2*)(orow + col) = o; }
}

typedef __bf16 bf16x2_t __attribute__((ext_vector_type(2)));
typedef float f32x2_t __attribute__((ext_vector_type(2)));
typedef short bf16x8 __attribute__((ext_vector_type(8)));
typedef float f32x16 __attribute__((ext_vector_type(16)));
__device__ __forceinline__ unsigned cvtpk(float lo, float hi) { f32x2_t v = {lo, hi}; bf16x2_t b = __builtin_convertvector(v, bf16x2_t); return __builtin_bit_cast(unsigned, b); }
#define MFMA32(a, b, c) __builtin_amdgcn_mfma_f32_32x32x16_bf16((a), (b), (c), 0, 0, 0)
#define PACK_ACC(x, S_) __builtin_bit_cast(bf16x8, (u32x4){cvtpk((x)[8 * (S_)], (x)[8 * (S_) + 1]), cvtpk((x)[8 * (S_) + 2], (x)[8 * (S_) + 3]), cvtpk((x)[8 * (S_) + 4], (x)[8 * (S_) + 5]), cvtpk((x)[8 * (S_) + 6], (x)[8 * (S_) + 7])})
__device__ __forceinline__ int crow(int reg, int h) { return (reg & 3) + 8 * (reg >> 2) + 4 * h; }
__device__ __forceinline__ bf16x8 pack8(const float (&v)[8]) { return __builtin_bit_cast(bf16x8, (u32x4){cvtpk(v[0], v[1]), cvtpk(v[2], v[3]), cvtpk(v[4], v[5]), cvtpk(v[6], v[7])}); }

#define XB_TMO      128
#define XB_XCNT(j)  (256  + 64 * (j))
#define XB_XSUB(j)  (1280 + 64 * (j))
#define XB_XGEN(j)  (2304 + 64 * (j))
#define XB_TOP      3328
#define XB_TOPGEN   3392
#define XCD_BAR_WORDS 3456
#define XB_SPIN_CAP (1u << 18)

__device__ __forceinline__ unsigned xb_ld(unsigned* p)              { return __hip_atomic_load(p, __ATOMIC_RELAXED, __HIP_MEMORY_SCOPE_AGENT); }
__device__ __forceinline__ unsigned xb_add(unsigned* p, unsigned v) { return __hip_atomic_fetch_add(p, v, __ATOMIC_RELAXED, __HIP_MEMORY_SCOPE_AGENT); }
__device__ __forceinline__ unsigned xb_xcc_id() { return (unsigned)__builtin_amdgcn_s_getreg((3 << 11) | 20) & 0xFu; }
#define XB_SPIN(cond, bar) do { unsigned _sp = 0; while (cond) { __builtin_amdgcn_s_sleep(1); \
    if ((++_sp & 255u) == 0u) { if (xb_ld(&(bar)[XB_TMO])) break; if (_sp > XB_SPIN_CAP) { atomicAdd(&(bar)[XB_TMO], 1u); break; } } } } while (0)

struct XcdBarrier {
    unsigned* bar; unsigned x;
    volatile LAS unsigned* st;
};

__device__ __forceinline__ XcdBarrier xcd_barrier_post(unsigned* bar, volatile LAS unsigned* st) {
    XcdBarrier b; b.bar = bar; b.x = xb_xcc_id(); b.st = st;
    if (threadIdx.x == 0) (void)xb_add(&bar[XB_XCNT(b.x)], 1u);
    return b;
}
__device__ __forceinline__ void xcd_barrier_complete(unsigned* bar, unsigned x, unsigned& nloc, unsigned& nx) {
    const unsigned G = gridDim.x * gridDim.y * gridDim.z;
    unsigned sum, cnt, mine, sp = 0u;
    for (;;) {
        sum = 0u; cnt = 0u; mine = 0u;
#pragma unroll
        for (unsigned j = 0; j < 16; ++j) { const unsigned c = xb_ld(&bar[XB_XCNT(j)]); sum += c; cnt += (c > 0u) ? 1u : 0u; mine = (j == x) ? c : mine; }
        if (sum == G) break;
        __builtin_amdgcn_s_sleep(1);
        if ((++sp & 255u) == 0u) { if (xb_ld(&bar[XB_TMO])) break; if (sp > XB_SPIN_CAP) { atomicAdd(&bar[XB_TMO], 1u); break; } }
    }
    nloc = mine > 0u ? mine : 1u; nx = cnt > 0u ? cnt : 1u;
}

__device__ __forceinline__ void xcd_barrier(const XcdBarrier& b) {
    asm volatile("s_waitcnt vmcnt(0)" ::: "memory");
    __syncthreads();
    if (threadIdx.x == 0) {
        unsigned* bar = b.bar;
        __builtin_amdgcn_s_waitcnt(0);
        unsigned nloc = b.st[0], nx = b.st[1];
        if (nloc == 0u) { xcd_barrier_complete(bar, b.x, nloc, nx); b.st[0] = nloc; b.st[1] = nx; }
        const unsigned old = xb_add(&bar[XB_XSUB(b.x)], 1u);
        const unsigned gen = old / nloc;
        if (old + 1u == (gen + 1u) * nloc) {
            __builtin_amdgcn_fence(__ATOMIC_RELEASE, "agent");
            asm volatile("s_waitcnt vmcnt(0)" ::: "memory");
            const unsigned og = xb_add(&bar[XB_TOP], 1u);
            const unsigned tg = og / nx;
            if (og + 1u == (tg + 1u) * nx) xb_add(&bar[XB_TOPGEN], 1u);
            else XB_SPIN(xb_ld(&bar[XB_TOPGEN]) == tg, bar);
            __builtin_amdgcn_fence(__ATOMIC_ACQUIRE, "agent");
            xb_add(&bar[XB_XGEN(b.x)], 1u);
            asm volatile("s_waitcnt vmcnt(0)" ::: "memory");
        } else {
            XB_SPIN(xb_ld(&bar[XB_XGEN(b.x)]) == gen, bar);
            __builtin_amdgcn_fence(__ATOMIC_ACQUIRE, "agent");
            asm volatile("s_waitcnt vmcnt(0)" ::: "memory");
        }
    }
    __syncthreads();
}


#ifdef PROBE_SEC
#define SEC_BEGIN(id) unsigned long long _sec_t##id = 0; if ((id) == PROBE_SEC) { __builtin_amdgcn_s_barrier(); _sec_t##id = __builtin_amdgcn_s_memrealtime(); }
#define SEC_END(id, ldsp) if ((id) == PROBE_SEC) { __builtin_amdgcn_s_barrier(); if (threadIdx.x == 0) { volatile LAS unsigned long long* a_ = (volatile LAS unsigned long long*)((ldsp) + LDS_BYTES - 32); a_[0] = a_[0] + (__builtin_amdgcn_s_memrealtime() - _sec_t##id); } }
#define SECW_BEGIN(id) unsigned long long _secw_t##id = 0; if ((id) == PROBE_SEC) { _secw_t##id = __builtin_amdgcn_s_memrealtime(); }
#define SECW_END(id, ldsp, tsel) if ((id) == PROBE_SEC) { asm volatile("s_waitcnt vmcnt(0) lgkmcnt(0)" ::: "memory"); if (threadIdx.x == (tsel)) { volatile LAS unsigned long long* a_ = (volatile LAS unsigned long long*)((ldsp) + LDS_BYTES - 32); a_[0] = a_[0] + (__builtin_amdgcn_s_memrealtime() - _secw_t##id); } }
#else
#define SEC_BEGIN(id)
#define SEC_END(id, ldsp)
#define SECW_BEGIN(id)
#define SECW_END(id, ldsp, tsel)
#endif
struct Args { const float* in[40]; float* out; unsigned char* ws; int ph_lo, ph_hi; };
constexpr int N_PHASES = 26, SUBS = 6;
#ifndef PH_MASK
#define PH_MASK 16383
#endif
#define AS4 __attribute__((address_space(4)))
struct KP { const char AS4* p;
    __device__ __forceinline__ const float* in(int i) const { return *(const float* const AS4*)(p + 8 * i); }
    __device__ __forceinline__ float* out() const { return *(float* const AS4*)(p + 320); }
    __device__ __forceinline__ unsigned char* ws() const { return *(unsigned char* const AS4*)(p + 328); }
};
static_assert(sizeof(Args) == 344, "Args layout");

__device__ __forceinline__ void phase_prologue(const KP kp, LAS unsigned char* lds, int gw, int NGW, int wave, int lane) {
    unsigned char* ws = kp.ws();
    LAS float* scr = (LAS float*)(lds + wave * 17408);
    SEC_BEGIN(1)
    SEC_BEGIN(14)
    for (int job = 0; job < 16; ++job) {
        if (job == 2) { SEC_END(14, lds) }
        const float* W; int K = 2048, Nsrc = 2048, Npad = 2048, mapid = 0; bf16* WT; const float* gain = nullptr;
        if (job < 2)       { W = kp.in(13) + (size_t)job * 2048 * 7200; Nsrc = 7200; Npad = NAB; mapid = 1; WT = (bf16*)(ws + WS_WABIN) + (size_t)job * NAB * 2048; gain = kp.in(11) + (size_t)(2 * job) * DM; }
        else if (job < 4)  { W = kp.in(21) + (size_t)(job - 2) * 2048 * 2048; WT = (bf16*)(ws + WS_WABOUT) + (size_t)(job - 2) * 2048 * 2048; }
        else if (job < 6)  { W = kp.in(22) + (size_t)(job - 4) * 2048 * 4624; Nsrc = 4624; Npad = NCD; mapid = 2; WT = (bf16*)(ws + WS_WCDIN) + (size_t)(job - 4) * NCD * 2048; gain = kp.in(11) + (size_t)(2 * (job - 4) + 1) * DM; }
        else if (job < 8)  { W = kp.in(36) + (size_t)(job - 6) * 2048 * 2048; WT = (bf16*)(ws + WS_WCDOUT) + (size_t)(job - 6) * 2048 * 2048; }
        else if (job < 12) { W = kp.in(39) + (size_t)(job - 8) * 2048 * 2048; WT = (bf16*)(ws + WS_WGATE) + (size_t)(job - 8) * 2048 * 2048; gain = kp.in(38) + (size_t)(job - 8) * DM; }
        else               { W = kp.in(37) + (size_t)(job - 12) * 256 * 2048; K = 256; WT = (bf16*)(ws + WS_WPROJ) + (size_t)(job - 12) * 2048 * 256; }
        const int nitems = (K / 64) * (Npad / 64), nblocks = NGW / NWAVES, ipb = (nitems + nblocks - 1) / nblocks, ib = (gw / NWAVES) * ipb, ie = ib + ipb < nitems ? ib + ipb : nitems;
        for (int it = ib + wave; it < ie; it += NWAVES) transpose_item(W, K, Nsrc, WT, Npad, mapid, gain, scr, it, lane);
    }
    SEC_END(1, lds)
    SEC_BEGIN(2)
    bf16* HB = (bf16*)(ws + WS_XN); float* RSS = (float*)(ws + WS_RSS);
    for (int m = gw; m < T; m += NGW) {
        const float* src = m < TP ? kp.in(0) + (size_t)m * DM : kp.in(1) + (size_t)(m - TP) * DM;
        float ss = 0.f;
#pragma unroll
        for (int jj = 0; jj < 8; ++jj) { const int col = 4 * (lane + 64 * jj); const f32x4 v = *(const f32x4*)(src + col);
            u32x2 o; o.x = pk2(v.x, v.y); o.y = pk2(v.z, v.w); *(u32x2*)(HB + (size_t)m * DM + col) = o; ss += (v.x * v.x + v.y * v.y) + (v.z * v.z + v.w * v.w); }
        ss = wave_sum(ss); if (lane == 0) RSS[m] = ss;
    }
    bf16* PB = (bf16*)(ws + WS_PB);
    const int gt = gw * 64 + lane, NGT = NGW * 64;
    for (int i = gt; i < 4 * T * 64; i += NGT) {
        const int c4 = i & 63, rr = i >> 6, li = rr / T, r = rr - li * T;
        const float* src = r < TP ? kp.in(9) + ((size_t)li * TP + r) * 256 + 4 * c4 : kp.in(10) + ((size_t)li * TS + (r - TP)) * 256 + 4 * c4;
        const f32x4 v = *(const f32x4*)src;
        u32x2 o; o.x = pk2(v.x, v.y); o.y = pk2(v.z, v.w);
        *(u32x2*)(PB + ((size_t)li * T + r) * 256 + 4 * c4) = o;
    }
    SEC_END(2, lds)
}
__device__ __forceinline__ void phase_final(const KP kp, int gw, int NGW, int lane) {
    const bf16* HB = (const bf16*)(kp.ws() + WS_XN); const float* RSS = (const float*)(kp.ws() + WS_RSS) + (size_t)8 * T; const float* g = kp.in(12); float* out = kp.out();
    for (int m = gw; m < T; m += NGW) { const float rstd = rsqrtf(RSS[m] * (1.f / DM) + 1e-6f);
#pragma unroll
        for (int jj = 0; jj < 8; ++jj) { const int col = 4 * (lane + 64 * jj); const u32x2 hv = *(const u32x2*)(HB + (size_t)m * DM + col); const f32x4 gg = *(const f32x4*)(g + col);
            f32x4 o; o.x = __uint_as_float(hv.x << 16) * rstd * gg.x; o.y = __uint_as_float(hv.x & 0xffff0000u) * rstd * gg.y; o.z = __uint_as_float(hv.y << 16) * rstd * gg.z; o.w = __uint_as_float(hv.y & 0xffff0000u) * rstd * gg.w;
            *(f32x4*)(out + (size_t)m * DM + col) = o; } }
}

__device__ __forceinline__ void phase_ab_pre(const KP kp, const int bid, const int G, int j, int tid, int wave, int lane) {
    unsigned char* scr = kp.ws() + WS_SCR; const bf16* U = (const bf16*)(kp.ws() + WS_U);
    float* QN = (float*)(scr + SC_QN) - (size_t)TP * 1024; float* KN = (float*)(scr + SC_KN) - (size_t)TP * 1024; float* VV = (float*)(scr + SC_VV) - (size_t)TP * 1024;
    float* GLOG = (float*)(scr + SC_GLOG) - (size_t)TP * 512; float* BETA = (float*)(scr + SC_BETA) - (size_t)TP * 8; float* GDEC = (float*)(scr + SC_GDEC) - (size_t)TP * 8;
    const float* cw = kp.in(14) + (size_t)j * 4 * 3072; const float* stc = kp.in(3) + (size_t)j * 128 * 3 * 3072;
    const float* wa2 = kp.in(18) + (size_t)j * 16 * 512; const float* ba = kp.in(19) + (size_t)j * 512;
    for (int r = TP + bid; r < T; r += G) {
        int s, t; row_to_seq(r, s, t); const int row0 = r - t;
#pragma unroll
        for (int part = 0; part < 3; ++part) {
            float val[2];
#pragma unroll
            for (int i = 0; i < 2; ++i) { const int c = part * 1024 + wave * 128 + lane + 64 * i; float acc = 0.f;
#pragma unroll
                for (int tap = 0; tap < 4; ++tap) acc += cw[tap * 3072 + c] * pre_val(U, NAB, c, row0, t - 3 + tap, s, stc, 3072, c);
                val[i] = silu_(acc); }
            if (part < 2) { const float ss = wave_sum(val[0] * val[0] + val[1] * val[1]); const float sc = rsqrtf(ss + 1e-6f) * (part == 0 ? 0.08838834764831845f : 1.f); val[0] *= sc; val[1] *= sc; }
            float* dst = part == 0 ? QN : (part == 1 ? KN : VV);
            dst[(size_t)r * 1024 + wave * 128 + lane] = val[0]; dst[(size_t)r * 1024 + wave * 128 + lane + 64] = val[1];
        }
        if (tid < 8) {
            BETA[(size_t)r * 8 + tid] = sigmoid_(bf2f(U[(size_t)r * NAB + 7168 + tid]));
            GDEC[(size_t)r * 8 + tid] = -__expf(kp.in(15)[j * 8 + tid]) * softplus_(bf2f(U[(size_t)r * NAB + 7176 + tid]) + kp.in(16)[j * 8 + tid]);
        }
        { float x = ba[tid];
#pragma unroll
          for (int rr = 0; rr < 16; ++rr) x += bf2f(U[(size_t)r * NAB + 7184 + rr]) * wa2[rr * 512 + tid];
          GLOG[(size_t)r * 512 + tid] = -softplus_(-x) * (1.f / 16.f); }
    }
}


constexpr size_t GLA_ITEM_BYTES = 74752, WS_GLAOPS = WS_H;
__device__ __forceinline__ void phase_gla_prep(const KP kp, const int bid, const int G, int j, LAS unsigned char* lds, int tid0) {
    const bf16* U = (const bf16*)(kp.ws() + WS_U);
    const float* wa2 = kp.in(18) + (size_t)j * 16 * 512; const float* ba = kp.in(19) + (size_t)j * 512;
    unsigned char* OPS = kp.ws() + WS_GLAOPS;
    LAS float* GE = (LAS float*)lds; LAS float* Pg = GE + 128;
    LAS bf16* Qg = (LAS bf16*)(Pg + 512); LAS bf16* Ka = Qg + 64 * 136; LAS float* QKm = (LAS float*)(Ka + 64 * 136);
    for (int item = bid; item < 512; item += G) {
        int tid = tid0; asm volatile("" : "+v"(tid));
        const int lane = tid & 63, r = lane & 31, hp = lane >> 5, wave = tid >> 6;
        const int b = item >> 7, n = (item >> 2) & 31, h = item & 3;
        const int row0 = b * 2048 + n * 64;
        __syncthreads();
        const int d = tid & 127, tg = tid >> 7, t0 = 16 * tg;
        float q[16], k[16], gl[16];
        { float w[16];
#pragma unroll
          for (int rr = 0; rr < 16; ++rr) w[rr] = wa2[rr * 512 + h * 128 + d];
          const float bias = ba[h * 128 + d];
#pragma unroll
          for (int t = 0; t < 16; ++t) { const size_t ro = (size_t)(row0 + t0 + t) * NAB;
              q[t] = bf2f(U[ro + 4096 + h * 128 + d]) * 0.08838834764831845f; k[t] = bf2f(U[ro + 4608 + h * 128 + d]);
              const u32x4 g0 = *(const u32x4*)(U + ro + 7184), g1 = *(const u32x4*)(U + ro + 7192);
              float x = bias;
              x += __uint_as_float(g0.x << 16) * w[0] + __uint_as_float(g0.x & 0xffff0000u) * w[1] + __uint_as_float(g0.y << 16) * w[2] + __uint_as_float(g0.y & 0xffff0000u) * w[3];
              x += __uint_as_float(g0.z << 16) * w[4] + __uint_as_float(g0.z & 0xffff0000u) * w[5] + __uint_as_float(g0.w << 16) * w[6] + __uint_as_float(g0.w & 0xffff0000u) * w[7];
              x += __uint_as_float(g1.x << 16) * w[8] + __uint_as_float(g1.x & 0xffff0000u) * w[9] + __uint_as_float(g1.y << 16) * w[10] + __uint_as_float(g1.y & 0xffff0000u) * w[11];
              x += __uint_as_float(g1.z << 16) * w[12] + __uint_as_float(g1.z & 0xffff0000u) * w[13] + __uint_as_float(g1.w << 16) * w[14] + __uint_as_float(g1.w & 0xffff0000u) * w[15];
              gl[t] = -softplus_(-x) * (1.f / 16.f); } }
#pragma unroll
        for (int t = 1; t < 16; ++t) gl[t] += gl[t - 1];
        Pg[tg * 128 + d] = gl[15];
        __syncthreads();
        { float off = 0.f;
#pragma unroll
          for (int g = 0; g < 3; ++g) off += (g < tg) ? Pg[g * 128 + d] : 0.f;
          if (tg == 3) GE[d] = gl[15] + off;
#pragma unroll
          for (int t = 0; t < 16; ++t) { const float Gt = gl[t] + off; Qg[(t0 + t) * 136 + d] = (bf16)f2bf(q[t] * __expf(Gt)); Ka[(t0 + t) * 136 + d] = (bf16)f2bf(k[t] * __expf(-Gt)); } }
        __syncthreads();
        bf16x8* base = (bf16x8*)(OPS + (size_t)item * GLA_ITEM_BYTES);
        if (wave < 4) {
            const int mt = wave >> 1, nt = wave & 1;
            f32x16 acc;
#pragma unroll
            for (int i = 0; i < 16; ++i) acc[i] = 0.f;
#pragma unroll
            for (int ks = 0; ks < 8; ++ks) acc = MFMA32(*(const LAS bf16x8*)(Qg + (32 * mt + r) * 136 + 16 * ks + 8 * hp), *(const LAS bf16x8*)(Ka + (32 * nt + r) * 136 + 16 * ks + 8 * hp), acc);
            const int jt = 32 * nt + r;
#pragma unroll
            for (int i16 = 0; i16 < 16; ++i16) { const int i = 32 * mt + crow(i16, hp); QKm[i * 65 + jt] = jt <= i ? acc[i16] : 0.f; }
        } else {
            const int w4 = wave - 4;
#pragma unroll
            for (int q8 = 0; q8 < 8; ++q8) { const int f = w4 + 4 * q8, nt = f >> 2, ks = f & 3, p = 32 * nt + r;
                unsigned w[4];
#pragma unroll
                for (int jp = 0; jp < 8; jp += 2) { const int tk = 16 * ks + 8 * (jp >> 2) + 4 * hp + (jp & 3);
                    w[jp >> 1] = (unsigned)U[(size_t)(row0 + tk) * NAB + 5120 + h * 256 + p] | ((unsigned)U[(size_t)(row0 + tk + 1) * NAB + 5120 + h * 256 + p] << 16); }
                base[(40 + f) * 64 + lane] = __builtin_bit_cast(bf16x8, (u32x4){w[0], w[1], w[2], w[3]}); }
        }
        __syncthreads();
        float v[8];
#pragma unroll
        for (int q2 = 0; q2 < 2; ++q2) { const int f = wave + 8 * q2;
            { const int mt = f >> 3, ks = f & 7, i = 32 * mt + r;
              const u32x2 lo = *(const LAS u32x2*)(Qg + i * 136 + 16 * ks + 4 * hp), hi = *(const LAS u32x2*)(Qg + i * 136 + 16 * ks + 8 + 4 * hp);
              base[f * 64 + lane] = __builtin_bit_cast(bf16x8, (u32x4){lo.x, lo.y, hi.x, hi.y}); }
            { const int mt = f >> 2, ks = f & 3, dd = 32 * mt + r; const float eg = __expf(GE[dd]);
#pragma unroll
              for (int jp = 0; jp < 8; ++jp) v[jp] = bf2f(Ka[(16 * ks + 8 * (jp >> 2) + 4 * hp + (jp & 3)) * 136 + dd]) * eg;
              base[(16 + f) * 64 + lane] = pack8(v); } }
        { const int f = wave, mt = f >> 2, ks = f & 3, i = 32 * mt + r;
#pragma unroll
          for (int jp = 0; jp < 8; ++jp) v[jp] = QKm[i * 65 + 16 * ks + 8 * (jp >> 2) + 4 * hp + (jp & 3)];
          base[(32 + f) * 64 + lane] = pack8(v); }
        if (tid < 128) ((float*)(base + 72 * 64))[tid] = __expf(GE[tid]);
    }
}

constexpr size_t DN_ITEM_BYTES = 74752;
__device__ __forceinline__ void phase_dn_prep(const KP kp, const int bid, const int G, int j, LAS unsigned char* lds, int tid0) {
    unsigned char* scr = kp.ws() + WS_SCR;
    const bf16* U = (const bf16*)(kp.ws() + WS_U); const float* cw = kp.in(14) + (size_t)j * 4 * 3072;
    unsigned char* OPS = scr + SC_DNOPS;
    LAS float* AMT = (LAS float*)lds; LAS float* GLs = AMT + 64 * 68; LAS float* BLs = GLs + 64; LAS float* SS = BLs + 64;
    LAS bf16* Kb = (LAS bf16*)(SS + 256); LAS bf16* Qb = Kb + 64 * 136; LAS float* QKm = (LAS float*)(Qb + 64 * 136); LAS float* XL = QKm + 64 * 65;
    for (int item = bid; item < 1024; item += G) {
        int tid = tid0; asm volatile("" : "+v"(tid));
        const int lane = tid & 63, r = lane & 31, hp = lane >> 5, wave = tid >> 6;
        const int b = item >> 8, n = (item >> 3) & 31, h = item & 7;
        const int row0 = b * 2048 + n * 64;
        __syncthreads();
        SEC_BEGIN(20)
        {
          const int t0 = 8 * wave; const bool first = (n == 0 && wave == 0);
          const long fo = first ? 0 : (long)NAB;
          float qa[8], qb[8], ka[8], kb[8];
#pragma unroll
          for (int part = 0; part < 3; ++part) { const int c = part * 1024 + h * 128 + 2 * lane;
              const float w0a = cw[c], w0b = cw[c + 1], w1a = cw[3072 + c], w1b = cw[3072 + c + 1], w2a = cw[2 * 3072 + c], w2b = cw[2 * 3072 + c + 1], w3a = cw[3 * 3072 + c], w3b = cw[3 * 3072 + c + 1];
              const bf16* up = U + (size_t)(row0 + t0) * NAB + c;
              unsigned raw[11];
              raw[0] = *(const unsigned*)(up - 3 * fo); raw[1] = *(const unsigned*)(up - 2 * fo); raw[2] = *(const unsigned*)(up - 1 * fo);
#pragma unroll
              for (int t = 0; t < 8; ++t) raw[3 + t] = *(const unsigned*)(up + (size_t)t * NAB);
              if (first) { raw[0] = 0u; raw[1] = 0u; raw[2] = 0u; }
#pragma unroll
              for (int t = 0; t < 8; ++t) {
                  const float ya = silu_(w0a * __uint_as_float(raw[t] << 16) + w1a * __uint_as_float(raw[t + 1] << 16) + w2a * __uint_as_float(raw[t + 2] << 16) + w3a * __uint_as_float(raw[t + 3] << 16));
                  const float yb = silu_(w0b * __uint_as_float(raw[t] & 0xffff0000u) + w1b * __uint_as_float(raw[t + 1] & 0xffff0000u) + w2b * __uint_as_float(raw[t + 2] & 0xffff0000u) + w3b * __uint_as_float(raw[t + 3] & 0xffff0000u));
                  if (part == 0) { qa[t] = ya; qb[t] = yb; } else if (part == 1) { ka[t] = ya; kb[t] = yb; } else { XL[(t0 + t) * 257 + 2 * lane] = ya; XL[(t0 + t) * 257 + 2 * lane + 1] = yb; } } }
#pragma unroll
          for (int t = 0; t < 8; ++t) { const float scq = rsqrtf(wave_sum(qa[t] * qa[t] + qb[t] * qb[t]) + 1e-6f) * 0.08838834764831845f, sck = rsqrtf(wave_sum(ka[t] * ka[t] + kb[t] * kb[t]) + 1e-6f);
              *(LAS unsigned*)(Qb + (t0 + t) * 136 + 2 * lane) = pk2(qa[t] * scq, qb[t] * scq); *(LAS unsigned*)(Kb + (t0 + t) * 136 + 2 * lane) = pk2(ka[t] * sck, kb[t] * sck); } }
        if (wave == 0) { const size_t ro = (size_t)(row0 + lane) * NAB;
            float gv = -__expf(kp.in(15)[j * 8 + h]) * softplus_(bf2f(U[ro + 7176 + h]) + kp.in(16)[j * 8 + h]);
#pragma unroll
            for (int o = 1; o < 64; o <<= 1) { const float tt = __shfl_up(gv, o); if (lane >= o) gv += tt; }
            GLs[lane] = gv; BLs[lane] = sigmoid_(bf2f(U[ro + 7168 + h])); }
        __syncthreads();
        SEC_END(20, lds)
        SEC_BEGIN(21)
        SEC_END(21, lds)
        SEC_BEGIN(22)
        bf16x8* base = (bf16x8*)(OPS + (size_t)item * DN_ITEM_BYTES);
        { const int which = wave >> 2, mt = (wave >> 1) & 1, nt = wave & 1;
          const LAS bf16* Asrc = which ? Qb : Kb;
          f32x16 acc;
#pragma unroll
          for (int i = 0; i < 16; ++i) acc[i] = 0.f;
#pragma unroll
          for (int ks = 0; ks < 8; ++ks) acc = MFMA32(*(const LAS bf16x8*)(Asrc + (32 * mt + r) * 136 + 16 * ks + 8 * hp), *(const LAS bf16x8*)(Kb + (32 * nt + r) * 136 + 16 * ks + 8 * hp), acc);
          const int jt = 32 * nt + r; const float gj = GLs[jt];
#pragma unroll
          for (int i16 = 0; i16 < 16; ++i16) { const int i = 32 * mt + crow(i16, hp); const float dec = __expf(GLs[i] - gj);
              if (which == 0) AMT[jt * 68 + i] = jt < i ? BLs[i] * acc[i16] * dec : 0.f; else QKm[i * 65 + jt] = jt <= i ? acc[i16] * dec : 0.f; } }
        __syncthreads();
        SEC_END(22, lds)
        SEC_BEGIN(23)
        if (tid < 256) {
            SECW_BEGIN(25)
            const int c = tid;
#pragma unroll
            for (int bi = 0; bi < 4; ++bi) {
                float acc[16];
#pragma unroll
                for (int ii = 0; ii < 16; ++ii) { const int i = 16 * bi + ii; const float be = BLs[i];
                    acc[ii] = c < 128 ? be * XL[i * 257 + c] : be * __expf(GLs[i]) * bf2f(Kb[i * 136 + (c - 128)]); }
#pragma unroll 4
                for (int jj = 0; jj < 16 * bi; ++jj) { const float xj = XL[jj * 257 + c];
#pragma unroll
                    for (int q = 0; q < 4; ++q) { const f32x4 a = *(const LAS f32x4*)(AMT + jj * 68 + 16 * bi + 4 * q);
                        acc[4 * q + 0] -= a[0] * xj; acc[4 * q + 1] -= a[1] * xj; acc[4 * q + 2] -= a[2] * xj; acc[4 * q + 3] -= a[3] * xj; } }
                float dg[120];
#pragma unroll
                for (int ii = 1; ii < 16; ++ii)
#pragma unroll
                    for (int jj = 0; jj < ii; ++jj) dg[ii * (ii - 1) / 2 + jj] = AMT[(16 * bi + jj) * 68 + 16 * bi + ii];
#pragma unroll
                for (int ii = 0; ii < 16; ++ii) { float x = acc[ii];
#pragma unroll
                    for (int jj = 0; jj < ii; ++jj) x -= dg[ii * (ii - 1) / 2 + jj] * acc[jj];
                    acc[ii] = x; }
#pragma unroll
                for (int ii = 0; ii < 16; ++ii) XL[(16 * bi + ii) * 257 + c] = acc[ii];
            }
            SECW_END(25, lds, 0)
        } else {
            SECW_BEGIN(26)
            const int w4 = wave - 4; float v[8];
#pragma unroll
            for (int q = 0; q < 4; ++q) { const int f = w4 + 4 * q;
                { const int mt = f >> 3, ks = f & 7, i = 32 * mt + r; const float eg = __expf(GLs[i]);
                  const bf16x8 qq = *(const LAS bf16x8*)(Qb + i * 136 + 16 * ks + 8 * hp);
#pragma unroll
                  for (int jp = 0; jp < 8; ++jp) v[jp] = bf2f(Qb[i * 136 + 16 * ks + 8 * (jp >> 2) + 4 * hp + (jp & 3)]) * eg;
                  (void)qq; base[(16 + f) * 64 + lane] = pack8(v); }
                { const int mt = f >> 2, ks = f & 3, d = 32 * mt + r; const float Gend = GLs[63];
#pragma unroll
                  for (int jp = 0; jp < 8; ++jp) { const int tk = 16 * ks + 8 * (jp >> 2) + 4 * hp + (jp & 3); v[jp] = bf2f(Kb[tk * 136 + d]) * __expf(Gend - GLs[tk]); }
                  base[(32 + f) * 64 + lane] = pack8(v); } }
#pragma unroll
            for (int q = 0; q < 2; ++q) { const int f = w4 + 4 * q, mt = f >> 2, ks = f & 3, i = 32 * mt + r;
#pragma unroll
                for (int jp = 0; jp < 8; ++jp) v[jp] = QKm[i * 65 + 16 * ks + 8 * (jp >> 2) + 4 * hp + (jp & 3)];
                base[(48 + f) * 64 + lane] = pack8(v); }
            if (tid == 256) *(float*)(base + 72 * 64) = __expf(GLs[63]);
            SECW_END(26, lds, 256)
        }
        __syncthreads();
        SEC_END(23, lds)
        SEC_BEGIN(24)
        float v[8];
#pragma unroll
        for (int q = 0; q < 2; ++q) { const int f = wave + 8 * q;
            { const int mt = f >> 3, ks = f & 7, i = 32 * mt + r;
#pragma unroll
              for (int jp = 0; jp < 8; ++jp) v[jp] = -XL[i * 257 + 128 + 16 * ks + 8 * (jp >> 2) + 4 * hp + (jp & 3)];
              base[f * 64 + lane] = pack8(v); }
            { const int pq = f & 1, tl = f >> 1, mt = tl >> 2, nt = tl & 3;
#pragma unroll
              for (int e = 0; e < 8; ++e) v[e] = XL[(32 * mt + crow(8 * pq + e, hp)) * 257 + 32 * nt + r];
              base[(56 + f) * 64 + lane] = pack8(v); } }
        SEC_END(24, lds)
    }
}

__device__ __forceinline__ void phase_ab_rec(const KP kp, const int bid, const int G, int j, int li, LAS unsigned char* lds, int tid0) {
    unsigned char* scr = kp.ws() + WS_SCR; const bf16* U = (const bf16*)(kp.ws() + WS_U);
    float* ODN = (float*)(scr + SC_ODN); float* OGLA = (float*)(scr + SC_OGLA);
    SEC_BEGIN(12)
    for (int item = bid; item < 64; item += G) {
        int tid = tid0; asm volatile("" : "+v"(tid));
        int s, h; bool isdn; int half = -1;
        if (item < 32) { isdn = false; s = item >> 3; h = (item >> 1) & 3; half = item & 1; }
        else if (item < 64) { isdn = true; s = (item - 32) >> 3; h = (item - 32) & 7; half = -2; }
        else if (item < 1088) { isdn = true; s = 4 + ((item - 64) >> 3); h = (item - 64) & 7; }
        else { isdn = false; s = 4 + ((item - 1088) >> 2); h = (item - 1088) & 3; }
        int row0, L; seq_info(s, row0, L);
        __syncthreads();
        if (half == -2) {
            const int wave = __builtin_amdgcn_readfirstlane(tid >> 6), lane = tid & 63, r = lane & 31, hp = lane >> 5;
            const int b = s, nt = wave;
            const unsigned char* OPS = scr + SC_DNOPS;
            constexpr int DBUF = 73 * 1024;
#define DN_DMA(n_, bufi_) do { const unsigned char* gi_ = OPS + (size_t)((b * 32 + (n_)) * 8 + h) * DN_ITEM_BYTES + lane * 16; \
                _Pragma("unroll") for (int q_ = 0; q_ < 10; ++q_) { const int lf_ = wave + 8 * q_; if (lf_ < 73) \
                    __builtin_amdgcn_global_load_lds((const unsigned*)(gi_ + lf_ * 1024), (LAS unsigned*)(lds + (bufi_) * DBUF + lf_ * 1024), 16, 0, 2); } } while (0)
            f32x16 S0, S1, S2, S3;
#pragma unroll
            for (int i = 0; i < 16; ++i) { S0[i] = 0.f; S1[i] = 0.f; S2[i] = 0.f; S3[i] = 0.f; }
            DN_DMA(0, 0);
            asm volatile("s_waitcnt vmcnt(0)" ::: "memory"); __syncthreads();
            for (int n = 0; n < 32; ++n) {
                if (n + 1 < 32) DN_DMA(n + 1, (n + 1) & 1);
                if (wave < 4) {
                    const LAS bf16x8* F = (const LAS bf16x8*)(lds + (n & 1) * DBUF) + lane;
                    const float gend = *(const LAS float*)(lds + (n & 1) * DBUF + 72 * 1024);
                    const bf16x8 sb0 = PACK_ACC(S0, 0), sb1 = PACK_ACC(S0, 1), sb2 = PACK_ACC(S1, 0), sb3 = PACK_ACC(S1, 1), sb4 = PACK_ACC(S2, 0), sb5 = PACK_ACC(S2, 1), sb6 = PACK_ACC(S3, 0), sb7 = PACK_ACC(S3, 1);
                    f32x16 U0t, U1t;
                    { const bf16x8 a0 = F[(56 + nt * 2 + 0) * 64], a1 = F[(56 + nt * 2 + 1) * 64], c0 = F[(56 + (4 + nt) * 2 + 0) * 64], c1 = F[(56 + (4 + nt) * 2 + 1) * 64];
#pragma unroll
                      for (int e = 0; e < 8; ++e) { U0t[e] = bf2f((bf16)a0[e]); U0t[8 + e] = bf2f((bf16)a1[e]); U1t[e] = bf2f((bf16)c0[e]); U1t[8 + e] = bf2f((bf16)c1[e]); } }
                    U0t = MFMA32(F[0 * 64], sb0, U0t); U0t = MFMA32(F[1 * 64], sb1, U0t); U0t = MFMA32(F[2 * 64], sb2, U0t); U0t = MFMA32(F[3 * 64], sb3, U0t);
                    U0t = MFMA32(F[4 * 64], sb4, U0t); U0t = MFMA32(F[5 * 64], sb5, U0t); U0t = MFMA32(F[6 * 64], sb6, U0t); U0t = MFMA32(F[7 * 64], sb7, U0t);
                    U1t = MFMA32(F[8 * 64], sb0, U1t); U1t = MFMA32(F[9 * 64], sb1, U1t); U1t = MFMA32(F[10 * 64], sb2, U1t); U1t = MFMA32(F[11 * 64], sb3, U1t);
                    U1t = MFMA32(F[12 * 64], sb4, U1t); U1t = MFMA32(F[13 * 64], sb5, U1t); U1t = MFMA32(F[14 * 64], sb6, U1t); U1t = MFMA32(F[15 * 64], sb7, U1t);
                    const bf16x8 ub0 = PACK_ACC(U0t, 0), ub1 = PACK_ACC(U0t, 1), ub2 = PACK_ACC(U1t, 0), ub3 = PACK_ACC(U1t, 1);
                    f32x16 O0, O1;
#pragma unroll
                    for (int i = 0; i < 16; ++i) { O0[i] = 0.f; O1[i] = 0.f; }
                    O0 = MFMA32(F[16 * 64], sb0, O0); O0 = MFMA32(F[17 * 64], sb1, O0); O0 = MFMA32(F[18 * 64], sb2, O0); O0 = MFMA32(F[19 * 64], sb3, O0);
                    O0 = MFMA32(F[20 * 64], sb4, O0); O0 = MFMA32(F[21 * 64], sb5, O0); O0 = MFMA32(F[22 * 64], sb6, O0); O0 = MFMA32(F[23 * 64], sb7, O0);
                    O1 = MFMA32(F[24 * 64], sb0, O1); O1 = MFMA32(F[25 * 64], sb1, O1); O1 = MFMA32(F[26 * 64], sb2, O1); O1 = MFMA32(F[27 * 64], sb3, O1);
                    O1 = MFMA32(F[28 * 64], sb4, O1); O1 = MFMA32(F[29 * 64], sb5, O1); O1 = MFMA32(F[30 * 64], sb6, O1); O1 = MFMA32(F[31 * 64], sb7, O1);
                    O0 = MFMA32(F[48 * 64], ub0, O0); O0 = MFMA32(F[49 * 64], ub1, O0);
                    O1 = MFMA32(F[52 * 64], ub0, O1); O1 = MFMA32(F[53 * 64], ub1, O1); O1 = MFMA32(F[54 * 64], ub2, O1); O1 = MFMA32(F[55 * 64], ub3, O1);
#pragma unroll
                    for (int i = 0; i < 16; ++i) { S0[i] *= gend; S1[i] *= gend; S2[i] *= gend; S3[i] *= gend; }
                    S0 = MFMA32(F[32 * 64], ub0, S0); S0 = MFMA32(F[33 * 64], ub1, S0); S0 = MFMA32(F[34 * 64], ub2, S0); S0 = MFMA32(F[35 * 64], ub3, S0);
                    S1 = MFMA32(F[36 * 64], ub0, S1); S1 = MFMA32(F[37 * 64], ub1, S1); S1 = MFMA32(F[38 * 64], ub2, S1); S1 = MFMA32(F[39 * 64], ub3, S1);
                    S2 = MFMA32(F[40 * 64], ub0, S2); S2 = MFMA32(F[41 * 64], ub1, S2); S2 = MFMA32(F[42 * 64], ub2, S2); S2 = MFMA32(F[43 * 64], ub3, S2);
                    S3 = MFMA32(F[44 * 64], ub0, S3); S3 = MFMA32(F[45 * 64], ub1, S3); S3 = MFMA32(F[46 * 64], ub2, S3); S3 = MFMA32(F[47 * 64], ub3, S3);
                    float* yo = ODN + (size_t)(b * 2048 + n * 64) * 1024 + h * 128 + 32 * nt + r;
#pragma unroll
                    for (int i = 0; i < 16; ++i) { yo[(size_t)crow(i, hp) * 1024] = O0[i]; yo[(size_t)(32 + crow(i, hp)) * 1024] = O1[i]; }
                }
                asm volatile("s_waitcnt vmcnt(0)" ::: "memory"); __syncthreads();
            }
#undef DN_DMA
            if (wave < 4) {
                float* dst = kp.out() + O_DN_P + ((size_t)j * 4 + b) * ((size_t)8 * 128 * 128) + (size_t)h * 128 * 128 + 32 * nt + r;
#pragma unroll
                for (int i = 0; i < 16; ++i) { dst[(size_t)crow(i, hp) * 128] = S0[i]; dst[(size_t)(32 + crow(i, hp)) * 128] = S1[i]; dst[(size_t)(64 + crow(i, hp)) * 128] = S2[i]; dst[(size_t)(96 + crow(i, hp)) * 128] = S3[i]; }
            }
        } else if (half >= 0) {
            const int wave = __builtin_amdgcn_readfirstlane(tid >> 6), lane = tid & 63, r = lane & 31, hp = lane >> 5;
            const int b = s, nt = half * 4 + wave;
            const unsigned char* OPS = kp.ws() + WS_GLAOPS;
            constexpr int GBUF = 57 * 1024;
#define GLA_DMA(n_, bufi_) do { const unsigned char* gi_ = OPS + (size_t)((b * 32 + (n_)) * 4 + h) * GLA_ITEM_BYTES + lane * 16; \
                _Pragma("unroll") for (int q_ = 0; q_ < 8; ++q_) { const int lf_ = wave + 8 * q_; if (lf_ < 57) { const int gf_ = lf_ < 40 ? lf_ : (lf_ < 56 ? lf_ + half * 16 : 72); \
                    __builtin_amdgcn_global_load_lds((const unsigned*)(gi_ + gf_ * 1024), (LAS unsigned*)(lds + (bufi_) * GBUF + lf_ * 1024), 16, 0, 2); } } } while (0)
            f32x16 S0, S1, S2, S3;
#pragma unroll
            for (int i = 0; i < 16; ++i) { S0[i] = 0.f; S1[i] = 0.f; S2[i] = 0.f; S3[i] = 0.f; }
            GLA_DMA(0, 0);
            asm volatile("s_waitcnt vmcnt(0)" ::: "memory"); __syncthreads();
            for (int n = 0; n < 32; ++n) {
                if (n + 1 < 32) GLA_DMA(n + 1, (n + 1) & 1);
                if (wave < 4) {
                    const LAS bf16x8* F = (const LAS bf16x8*)(lds + (n & 1) * GBUF) + lane;
                    const LAS float* ge = (const LAS float*)(lds + (n & 1) * GBUF + 56 * 1024) + 4 * hp;
                    const bf16x8 sb0 = PACK_ACC(S0, 0), sb1 = PACK_ACC(S0, 1), sb2 = PACK_ACC(S1, 0), sb3 = PACK_ACC(S1, 1), sb4 = PACK_ACC(S2, 0), sb5 = PACK_ACC(S2, 1), sb6 = PACK_ACC(S3, 0), sb7 = PACK_ACC(S3, 1);
                    f32x16 O0, O1;
#pragma unroll
                    for (int i = 0; i < 16; ++i) { O0[i] = 0.f; O1[i] = 0.f; }
                    O0 = MFMA32(F[0 * 64], sb0, O0); O0 = MFMA32(F[1 * 64], sb1, O0); O0 = MFMA32(F[2 * 64], sb2, O0); O0 = MFMA32(F[3 * 64], sb3, O0);
                    O0 = MFMA32(F[4 * 64], sb4, O0); O0 = MFMA32(F[5 * 64], sb5, O0); O0 = MFMA32(F[6 * 64], sb6, O0); O0 = MFMA32(F[7 * 64], sb7, O0);
                    O1 = MFMA32(F[8 * 64], sb0, O1); O1 = MFMA32(F[9 * 64], sb1, O1); O1 = MFMA32(F[10 * 64], sb2, O1); O1 = MFMA32(F[11 * 64], sb3, O1);
                    O1 = MFMA32(F[12 * 64], sb4, O1); O1 = MFMA32(F[13 * 64], sb5, O1); O1 = MFMA32(F[14 * 64], sb6, O1); O1 = MFMA32(F[15 * 64], sb7, O1);
                    bf16x8 vb[4];
#pragma unroll
                    for (int ks = 0; ks < 4; ++ks) vb[ks] = F[(40 + wave * 4 + ks) * 64];
                    O0 = MFMA32(F[32 * 64], vb[0], O0); O0 = MFMA32(F[33 * 64], vb[1], O0);
#pragma unroll
                    for (int ks = 0; ks < 4; ++ks) O1 = MFMA32(F[(36 + ks) * 64], vb[ks], O1);
#pragma unroll
                    for (int q = 0; q < 4; ++q) { const f32x4 g0 = *(const LAS f32x4*)(ge + 8 * q), g1 = *(const LAS f32x4*)(ge + 32 + 8 * q), g2 = *(const LAS f32x4*)(ge + 64 + 8 * q), g3 = *(const LAS f32x4*)(ge + 96 + 8 * q);
#pragma unroll
                        for (int c = 0; c < 4; ++c) { S0[4 * q + c] *= g0[c]; S1[4 * q + c] *= g1[c]; S2[4 * q + c] *= g2[c]; S3[4 * q + c] *= g3[c]; } }
#pragma unroll
                    for (int ks = 0; ks < 4; ++ks) { S0 = MFMA32(F[(16 + ks) * 64], vb[ks], S0); S1 = MFMA32(F[(20 + ks) * 64], vb[ks], S1); S2 = MFMA32(F[(24 + ks) * 64], vb[ks], S2); S3 = MFMA32(F[(28 + ks) * 64], vb[ks], S3); }
                    float* yo = OGLA + (size_t)(b * 2048 + n * 64) * 1024 + h * 256 + 32 * nt + r;
#pragma unroll
                    for (int i = 0; i < 16; ++i) { yo[(size_t)crow(i, hp) * 1024] = O0[i]; yo[(size_t)(32 + crow(i, hp)) * 1024] = O1[i]; }
                }
                asm volatile("s_waitcnt vmcnt(0)" ::: "memory"); __syncthreads();
            }
#undef GLA_DMA
            if (wave < 4) {
                float* dst = kp.out() + O_GLA_P + ((size_t)j * 4 + b) * ((size_t)4 * 128 * 256) + (size_t)h * 128 * 256 + 32 * nt + r;
#pragma unroll
                for (int i = 0; i < 16; ++i) { dst[(size_t)crow(i, hp) * 256] = S0[i]; dst[(size_t)(32 + crow(i, hp)) * 256] = S1[i]; dst[(size_t)(64 + crow(i, hp)) * 256] = S2[i]; dst[(size_t)(96 + crow(i, hp)) * 256] = S3[i]; }
            }
        } else
        {}
    }
    SEC_END(12, lds)
    SEC_BEGIN(13)
    unsigned* qhead = (unsigned*)(kp.ws() + WS_CTL) + CW_CNT + 64 * li;
    volatile LAS unsigned* qslot = (volatile LAS unsigned*)(lds + LDS_BYTES - 8);
    const float* cw = kp.in(14) + (size_t)j * 4 * 3072; const float* stc = kp.in(3) + (size_t)j * 128 * 3 * 3072;
    const float* wa2 = kp.in(18) + (size_t)j * 16 * 512; const float* ba = kp.in(19) + (size_t)j * 512;
    for (;;) {
        __syncthreads();
        if (tid0 == 0) qslot[0] = __hip_atomic_fetch_add(qhead, 1u, __ATOMIC_RELAXED, __HIP_MEMORY_SCOPE_AGENT);
        __syncthreads();
        const int it = (int)qslot[0];
        if (it >= 1536) break;
        int tid = tid0; asm volatile("" : "+v"(tid));
        const int wave = tid >> 6, lane = tid & 63;
        if (it < 1024) {
            const int bs = it >> 3, h = it & 7, sq = 4 + bs, r0 = TP + bs * 4;
            LAS float* qL = (LAS float*)lds; LAS float* kL = qL + 512; LAS float* vL = kL + 512; LAS float* red = vL + 512; LAS float* sm = red + 4096;
            const int e = tid & 127, dq = tid >> 7;
            const size_t SZ = (size_t)8 * 128 * 128;
            const float* st = kp.in(2) + ((size_t)j * 128 + bs) * SZ + (size_t)h * 16384;
            float S[32];
            { const float* sp = st + (size_t)(dq * 32) * 128 + e;
#pragma unroll
              for (int i = 0; i < 32; ++i) { S[i] = *sp; sp += 128; asm volatile("" : "+v"(sp)); } }
#pragma unroll
            for (int part = 0; part < 3; ++part) { const int c = part * 1024 + h * 128 + e; float acc = 0.f;
#pragma unroll
                for (int tap = 0; tap < 4; ++tap) acc += cw[tap * 3072 + c] * pre_val(U, NAB, c, r0, dq - 3 + tap, sq, stc, 3072, c);
                if (part == 2) vL[dq * 128 + e] = silu_(acc); else (part == 0 ? qL : kL)[e * 4 + dq] = silu_(acc); }
            if (tid < 4) { const size_t ro = (size_t)(r0 + tid) * NAB;
                sm[32 + tid] = -__expf(kp.in(15)[j * 8 + h]) * softplus_(bf2f(U[ro + 7176 + h]) + kp.in(16)[j * 8 + h]); sm[36 + tid] = sigmoid_(bf2f(U[ro + 7168 + h])); }
            __syncthreads();
            { const int tk = wave & 3; LAS float* src = (wave >> 2) ? kL : qL; const float a = src[lane * 4 + tk], b = src[(lane + 64) * 4 + tk];
              const float sc = rsqrtf(wave_sum(a * a + b * b) + 1e-6f) * ((wave >> 2) ? 1.f : 0.08838834764831845f); src[lane * 4 + tk] = a * sc; src[(lane + 64) * 4 + tk] = b * sc; }
            __syncthreads();
#pragma unroll
            for (int q = 0; q < 4; ++q) { const int idx = wave * 4 + q, i = (idx >> 2) & 3, jj = idx & 3; const LAS float* src = idx < 16 ? kL : qL;
                const float dot = wave_sum(src[lane * 4 + i] * kL[lane * 4 + jj] + src[(lane + 64) * 4 + i] * kL[(lane + 64) * 4 + jj]); if (lane == 0) sm[idx] = dot; }
            float ks[4] = {0.f, 0.f, 0.f, 0.f}, qs[4] = {0.f, 0.f, 0.f, 0.f};
#pragma unroll
            for (int i = 0; i < 32; ++i) { const int d = dq * 32 + i; const float sv = S[i]; const f32x4 k4 = *(const LAS f32x4*)(kL + d * 4), q4 = *(const LAS f32x4*)(qL + d * 4);
#pragma unroll
                for (int t = 0; t < 4; ++t) { ks[t] += k4[t] * sv; qs[t] += q4[t] * sv; } }
#pragma unroll
            for (int t = 0; t < 4; ++t) { red[(t * 4 + dq) * 128 + e] = ks[t]; red[((4 + t) * 4 + dq) * 128 + e] = qs[t]; }
            __syncthreads();
            float Gc[4]; Gc[0] = sm[32]; Gc[1] = Gc[0] + sm[33]; Gc[2] = Gc[1] + sm[34]; Gc[3] = Gc[2] + sm[35];
            float u[4];
#pragma unroll
            for (int i = 0; i < 4; ++i) { const float KSi = (red[(i * 4 + 0) * 128 + e] + red[(i * 4 + 1) * 128 + e]) + (red[(i * 4 + 2) * 128 + e] + red[(i * 4 + 3) * 128 + e]);
                float acc = vL[i * 128 + e] - __expf(Gc[i]) * KSi;
#pragma unroll
                for (int jj = 0; jj < i; ++jj) acc -= sm[i * 4 + jj] * __expf(Gc[i] - Gc[jj]) * u[jj];
                u[i] = sm[36 + i] * acc; }
            if (dq == 0) {
#pragma unroll
                for (int i = 0; i < 4; ++i) { const float QSi = (red[((4 + i) * 4 + 0) * 128 + e] + red[((4 + i) * 4 + 1) * 128 + e]) + (red[((4 + i) * 4 + 2) * 128 + e] + red[((4 + i) * 4 + 3) * 128 + e]);
                    float o = __expf(Gc[i]) * QSi;
#pragma unroll
                    for (int jj = 0; jj <= i; ++jj) o += sm[16 + i * 4 + jj] * __expf(Gc[i] - Gc[jj]) * u[jj];
                    ODN[(size_t)(r0 + i) * 1024 + h * 128 + e] = o; } }
            const float eg = __expf(Gc[3]); float w[4];
#pragma unroll
            for (int jj = 0; jj < 4; ++jj) w[jj] = __expf(Gc[3] - Gc[jj]) * u[jj];
            float* dst = kp.out() + O_DN_S + ((size_t)j * 128 + bs) * SZ + (size_t)h * 16384 + (size_t)(dq * 32) * 128 + e;
#pragma unroll
            for (int i = 0; i < 32; ++i) { const int d = dq * 32 + i; float sv = eg * S[i]; const f32x4 k4 = *(const LAS f32x4*)(kL + d * 4);
#pragma unroll
                for (int jj = 0; jj < 4; ++jj) sv += k4[jj] * w[jj];
                *dst = sv; dst += 128; asm volatile("" : "+v"(dst)); }
        } else {
            const int q_ = it - 1024, bs = q_ >> 2, h = q_ & 3, r0 = TP + bs * 4;
            LAS float* qgL = (LAS float*)lds; LAS float* kaL = qgL + 512; LAS float* glL = kaL + 512; LAS float* egL = glL + 512; LAS float* Am = egL + 128; LAS float* red = Am + 16;
            const int e = tid & 255, dh = tid >> 8;
            const size_t SZ = (size_t)4 * 128 * 256;
            const float* st = kp.in(4) + ((size_t)j * 128 + bs) * SZ + (size_t)h * 32768;
            float S[64];
            { const float* sp = st + (size_t)(dh * 64) * 256 + e;
#pragma unroll
              for (int i = 0; i < 64; ++i) { S[i] = *sp; sp += 256; asm volatile("" : "+v"(sp)); } }
            float v[4];
#pragma unroll
            for (int t = 0; t < 4; ++t) v[t] = bf2f(U[(size_t)(r0 + t) * NAB + 5120 + h * 256 + e]);
            { const int d = tid & 127, tk = tid >> 7; const size_t ro = (size_t)(r0 + tk) * NAB;
              qgL[d * 4 + tk] = bf2f(U[ro + 4096 + h * 128 + d]) * 0.08838834764831845f; kaL[d * 4 + tk] = bf2f(U[ro + 4608 + h * 128 + d]);
              float x = ba[h * 128 + d];
#pragma unroll
              for (int rr = 0; rr < 16; ++rr) x += bf2f(U[ro + 7184 + rr]) * wa2[rr * 512 + h * 128 + d];
              glL[tk * 128 + d] = -softplus_(-x) * (1.f / 16.f); }
            __syncthreads();
            if (tid < 128) { float Gq = 0.f;
#pragma unroll
                for (int t = 0; t < 4; ++t) { Gq += glL[t * 128 + tid]; qgL[tid * 4 + t] *= __expf(Gq); kaL[tid * 4 + t] *= __expf(-Gq); }
                egL[tid] = __expf(Gq); }
            __syncthreads();
#pragma unroll
            for (int q = 0; q < 2; ++q) { const int idx = wave * 2 + q, i = idx >> 2, jj = idx & 3;
                const float dot = wave_sum(qgL[lane * 4 + i] * kaL[lane * 4 + jj] + qgL[(lane + 64) * 4 + i] * kaL[(lane + 64) * 4 + jj]); if (lane == 0) Am[idx] = dot; }
            float o[4] = {0.f, 0.f, 0.f, 0.f};
            float* dst = kp.out() + O_GLA_S + ((size_t)j * 128 + bs) * SZ + (size_t)h * 32768 + (size_t)(dh * 64) * 256 + e;
#pragma unroll
            for (int i = 0; i < 64; ++i) { const int d = dh * 64 + i; const float s0 = S[i]; float acc = s0; const f32x4 q4 = *(const LAS f32x4*)(qgL + d * 4), k4 = *(const LAS f32x4*)(kaL + d * 4);
#pragma unroll
                for (int t = 0; t < 4; ++t) { o[t] += q4[t] * s0; acc += k4[t] * v[t]; }
                *dst = egL[d] * acc; dst += 256; asm volatile("" : "+v"(dst)); }
#pragma unroll
            for (int t = 0; t < 4; ++t) red[(dh * 4 + t) * 256 + e] = o[t];
            __syncthreads();
            if (dh == 0) {
#pragma unroll
                for (int t = 0; t < 4; ++t) { float oo = red[t * 256 + e] + red[(4 + t) * 256 + e];
#pragma unroll
                    for (int jj = 0; jj <= t; ++jj) oo += Am[t * 4 + jj] * v[jj];
                    OGLA[(size_t)(r0 + t) * 1024 + h * 256 + e] = oo; } }
        }
    }
    SEC_END(13, lds)
}

__device__ __forceinline__ void phase_ab_post(const KP kp, const int bid, const int G, int j, int tid, int wave, int lane) {
    unsigned char* scr = kp.ws() + WS_SCR; const bf16* U = (const bf16*)(kp.ws() + WS_U); bf16* YM = (bf16*)(kp.ws() + WS_YM);
    const float* ODN = (const float*)(scr + SC_ODN); const float* OGLA = (const float*)(scr + SC_OGLA);
    const float* dnn = kp.in(17) + (size_t)j * 128; const float* glan = kp.in(20) + (size_t)j * 256;
    typedef float f32x2v __attribute__((ext_vector_type(2)));
    const f32x2v dg = *(const f32x2v*)(dnn + 2 * lane); const f32x4 gg = *(const f32x4*)(glan + 4 * lane);
    for (int r = bid * NWAVES + wave; r < T; r += G * NWAVES) {
        int s, t; row_to_seq(r, s, t); int row0, L; seq_info(s, row0, L);
        const bf16* ur = U + (size_t)r * NAB; bf16* yr = YM + (size_t)r * DM;
        f32x2v od[8]; unsigned zd[8]; f32x4 og[4]; u32x2 zg[4];
#pragma unroll
        for (int hh = 0; hh < 8; ++hh) { od[hh] = *(const f32x2v*)(ODN + (size_t)r * 1024 + hh * 128 + 2 * lane); zd[hh] = *(const unsigned*)(ur + 3072 + hh * 128 + 2 * lane); }
#pragma unroll
        for (int hh = 0; hh < 4; ++hh) { og[hh] = *(const f32x4*)(OGLA + (size_t)r * 1024 + hh * 256 + 4 * lane); zg[hh] = *(const u32x2*)(ur + 6144 + hh * 256 + 4 * lane); }
#pragma unroll
        for (int hh = 0; hh < 8; ++hh) { const f32x2v o = od[hh];
            const float rstd = rsqrtf(wave_sum(o.x * o.x + o.y * o.y) * (1.f / 128.f) + 1e-6f);
            const unsigned zz = zd[hh];
            *(unsigned*)(yr + hh * 128 + 2 * lane) = pk2(o.x * rstd * dg.x * silu_(__uint_as_float(zz << 16)), o.y * rstd * dg.y * silu_(__uint_as_float(zz & 0xffff0000u))); }
#pragma unroll
        for (int hh = 0; hh < 4; ++hh) { const f32x4 o = og[hh];
            const float rstd = rsqrtf(wave_sum((o.x * o.x + o.y * o.y) + (o.z * o.z + o.w * o.w)) * (1.f / 256.f) + 1e-6f);
            const u32x2 zz = zg[hh];
            u32x2 w; w.x = pk2(o.x * rstd * gg.x * silu_(__uint_as_float(zz.x << 16)), o.y * rstd * gg.y * silu_(__uint_as_float(zz.x & 0xffff0000u)));
            w.y = pk2(o.z * rstd * gg.z * silu_(__uint_as_float(zz.y << 16)), o.w * rstd * gg.w * silu_(__uint_as_float(zz.y & 0xffff0000u)));
            *(u32x2*)(yr + 1024 + hh * 256 + 4 * lane) = w; }
        if (t >= L - 3) { const int rr = t - (L - 3);
            float* dst = s < 4 ? kp.out() + O_DNC_P + (((size_t)j * 4 + s) * 3 + rr) * 3072 : kp.out() + O_DNC_S + (((size_t)j * 128 + (s - 4)) * 3 + rr) * 3072;
            for (int c = 2 * lane; c < 3072; c += 128) { const unsigned uu = *(const unsigned*)(ur + c); *(f32x2v*)(dst + c) = (f32x2v){__uint_as_float(uu << 16), __uint_as_float(uu & 0xffff0000u)}; } }
    }
}

__device__ __forceinline__ void phase_cd_pre(const KP kp, const int bid, const int G, int j, LAS unsigned char* lds, int tid) {
    unsigned char* scr = kp.ws() + WS_SCR; const bf16* U = (const bf16*)(kp.ws() + WS_U);
    float* XBC = (float*)(scr + SC_XBC) - (size_t)TP * 1536; float* DT = (float*)(scr + SC_DT) - (size_t)TP * 16; bf16* XS = (bf16*)(scr + SC_XS);
    const float* cw = kp.in(23) + (size_t)j * 4 * 1536; const float* cb = kp.in(24) + (size_t)j * 1536; const float* stc = kp.in(6) + (size_t)j * 128 * 3 * 1536;
    for (int r = TP + bid; r < T; r += G) {
        int s, t; row_to_seq(r, s, t); const int row0 = r - t;
#pragma unroll
        for (int i = 0; i < 3; ++i) { const int c = tid + NTHR * i; float acc = cb[c];
#pragma unroll
            for (int tap = 0; tap < 4; ++tap) acc += cw[tap * 1536 + c] * pre_val(U, NCD, 1024 + c, row0, t - 3 + tap, s, stc, 1536, c);
            const float v = silu_(acc); XBC[(size_t)r * 1536 + c] = v; if (c < 1024) XS[(size_t)r * 1024 + c] = (bf16)f2bf(v); }
        if (tid < 16) DT[(size_t)r * 16 + tid] = softplus_(bf2f(U[(size_t)r * NCD + 4608 + tid]) + kp.in(26)[j * 16 + tid]);
    }
}

__device__ __forceinline__ void phase_lru_gates(const KP kp, const int bid, const int G, int j, LAS unsigned char* lds, int tid0) {
    unsigned char* scr = kp.ws() + WS_SCR; const bf16* U = (const bf16*)(kp.ws() + WS_U);
    float* LA = (float*)(scr + SC_LA); float* LB = (float*)(scr + SC_LB);
    const float* lcw = kp.in(29) + (size_t)j * 4 * 1024; const float* lcb = kp.in(30) + (size_t)j * 1024; const float* lstc = kp.in(8) + (size_t)j * 128 * 3 * 1024;
    const int n = bid & 15;
    const float* wa = kp.in(31) + ((size_t)j * 16 + n) * 4096; const float* wx = kp.in(33) + ((size_t)j * 16 + n) * 4096;
    const float* lba = kp.in(32) + (size_t)j * 1024; const float* lbx = kp.in(34) + (size_t)j * 1024; const float* lam = kp.in(35) + (size_t)j * 1024;
    LAS bf16x8* WF = (LAS bf16x8*)lds;
    LAS float* xcL = (LAS float*)(lds + 16384);
    LAS float* igL = xcL + 64 * 68;
    __syncthreads();
    { const int lane = tid0 & 63, f = tid0 >> 6, r = lane & 31, hp = lane >> 5, nt = f >> 2, ks = f & 3; float v[8];
#pragma unroll
      for (int jp = 0; jp < 8; ++jp) v[jp] = wa[(16 * ks + 8 * hp + jp) * 64 + 32 * nt + r];
      WF[f * 64 + lane] = pack8(v);
#pragma unroll
      for (int jp = 0; jp < 8; ++jp) v[jp] = wx[(16 * ks + 8 * hp + jp) * 64 + 32 * nt + r];
      WF[512 + f * 64 + lane] = pack8(v); }
    for (int tile = bid >> 4; tile < T / 64; tile += (G >> 4)) {
        int tid = tid0; asm volatile("" : "+v"(tid));
        const int c = tid & 63, tq = tid >> 6, ch = n * 64 + c, rowbase = tile * 64;
        __syncthreads();
        if (tile < TP / 64) {
            const int r0 = rowbase + tq * 8; const bool first = ((r0 & 2047) == 0);
            const float w0 = lcw[ch], w1 = lcw[1024 + ch], w2 = lcw[2048 + ch], w3 = lcw[3072 + ch], bb = lcb[ch];
            const bf16* up = U + (size_t)r0 * NCD + 3584 + ch;
            const long fo = first ? 0 : (long)NCD;
              float x0 = bf2f(up[-3 * fo]), x1 = bf2f(up[-2 * fo]), x2 = bf2f(up[-1 * fo]); if (first) { x0 = 0.f; x1 = 0.f; x2 = 0.f; }
#pragma unroll
            for (int tt = 0; tt < 8; ++tt) { const float x3 = bf2f(up[(size_t)tt * NCD]); xcL[(tq * 8 + tt) * 68 + c] = bb + w0 * x0 + w1 * x1 + w2 * x2 + w3 * x3; x0 = x1; x1 = x2; x2 = x3; }
        } else {
#pragma unroll 2
            for (int tt = 0; tt < 8; ++tt) { const int r = rowbase + tq * 8 + tt; int s, t; row_to_seq(r, s, t); const int row0 = r - t; float acc = lcb[ch];
#pragma unroll
                for (int tap = 0; tap < 4; ++tap) acc += lcw[tap * 1024 + ch] * pre_val(U, NCD, 3584 + ch, row0, t - 3 + tap, s, lstc, 1024, ch);
                xcL[(tq * 8 + tt) * 68 + c] = acc; }
        }
        __syncthreads();
        const int wave = __builtin_amdgcn_readfirstlane(tid >> 6), lane = tid & 63, r = lane & 31, hp = lane >> 5, mat = wave >> 2, mt = (wave >> 1) & 1, nt = wave & 1;
        f32x16 acc;
#pragma unroll
        for (int i = 0; i < 16; ++i) acc[i] = 0.f;
#pragma unroll
        for (int ks = 0; ks < 4; ++ks) { const LAS float* xp = xcL + (32 * mt + r) * 68 + 16 * ks + 8 * hp; const f32x4 xa = *(const LAS f32x4*)xp, xb = *(const LAS f32x4*)(xp + 4);
            const bf16x8 af = __builtin_bit_cast(bf16x8, (u32x4){cvtpk(xa.x, xa.y), cvtpk(xa.z, xa.w), cvtpk(xb.x, xb.y), cvtpk(xb.z, xb.w)});
            acc = MFMA32(af, WF[mat * 512 + (nt * 4 + ks) * 64 + lane], acc); }
        const int chh = n * 64 + 32 * nt + r;
        if (mat == 1) { const float bx = lbx[chh];
#pragma unroll
            for (int i = 0; i < 16; ++i) igL[(32 * mt + crow(i, hp)) * 65 + 32 * nt + r] = sigmoid_(acc[i] + bx); }
        __syncthreads();
        if (mat == 0) { const float ba = lba[chh], spl = softplus_(-lam[chh]);
#pragma unroll
            for (int i = 0; i < 16; ++i) { const int tk = 32 * mt + crow(i, hp); const size_t ro = (size_t)(rowbase + tk) * 1024 + chh;
                const float log_a = -8.f * sigmoid_(acc[i] + ba) * spl;
                LA[ro] = __expf(log_a); LB[ro] = __builtin_amdgcn_sqrtf(1.f - __expf(2.f * log_a)) * (igL[tk * 65 + 32 * nt + r] * xcL[tk * 68 + 32 * nt + r]); } }
    }
}

constexpr size_t SSD_ITEM_BYTES = 33792;
__device__ __forceinline__ void phase_ssd_prep(const KP kp, const int bid, const int G, int j, LAS unsigned char* lds, int tid0) {
    unsigned char* scr = kp.ws() + WS_SCR;
    const bf16* U = (const bf16*)(kp.ws() + WS_U); bf16* XS = (bf16*)(scr + SC_XS);
    const float* cw = kp.in(23) + (size_t)j * 4 * 1536; const float* cb = kp.in(24) + (size_t)j * 1536;
    unsigned char* OPS = scr + SC_SSDOP;
    LAS float* CL = (LAS float*)lds; LAS float* BL = CL + 64 * 65; LAS float* QK = BL + 64 * 65; LAS float* GL = QK + 64 * 65; LAS float* DTL = GL + 256; LAS float* XLs = DTL + 256;
    const float* alog = kp.in(25) + j * 16;
    for (int item = bid; item < 512; item += G) {
        int tid = tid0; asm volatile("" : "+v"(tid));
        const int wave = tid >> 6, lane = tid & 63;
        const int b = item >> 7, n = (item >> 2) & 31, g = item & 3;
        const int row0 = b * 2048 + n * 64;
        __syncthreads();
        { const int ci = tid & 127, tg = tid >> 7, t0 = 16 * tg;
          const bool first = (n == 0 && tg == 0);
#pragma unroll
          for (int q = 0; q < 3; ++q) { const int k = ci + 128 * q;
              int cidx; LAS float* dst; int dstr, dcol;
              if (k < 64) { cidx = 1024 + g * 64 + k; dst = BL; dstr = 65; dcol = k; }
              else if (k < 128) { cidx = 1280 + g * 64 + (k - 64); dst = CL; dstr = 65; dcol = k - 64; }
              else { cidx = g * 256 + (k - 128); dst = XLs; dstr = 257; dcol = k - 128; }
              const float w0 = cw[cidx], w1 = cw[1536 + cidx], w2 = cw[2 * 1536 + cidx], w3 = cw[3 * 1536 + cidx], bb = cb[cidx];
              const bf16* up = U + (size_t)(row0 + t0) * NCD + 1024 + cidx;
              const long fo = first ? 0 : (long)NCD;
              float x0 = bf2f(up[-3 * fo]), x1 = bf2f(up[-2 * fo]), x2 = bf2f(up[-1 * fo]); if (first) { x0 = 0.f; x1 = 0.f; x2 = 0.f; }
#pragma unroll 4
              for (int t = 0; t < 16; ++t) { const float x3 = bf2f(up[(size_t)t * NCD]); dst[(t0 + t) * dstr + dcol] = silu_(bb + w0 * x0 + w1 * x1 + w2 * x2 + w3 * x3); x0 = x1; x1 = x2; x2 = x3; } } }
        if (wave < 4) { const int h = g * 4 + wave; const float dt = softplus_(bf2f(U[(size_t)(row0 + lane) * NCD + 4608 + h]) + kp.in(26)[j * 16 + h]);
            DTL[wave * 64 + lane] = dt; float gv = -__expf(alog[h]) * dt;
#pragma unroll
            for (int o = 1; o < 64; o <<= 1) { const float tt = __shfl_up(gv, o); if (lane >= o) gv += tt; }
            GL[wave * 64 + lane] = gv; }
        __syncthreads();
        for (int i = tid; i < 8192; i += NTHR) { const int t = i >> 7, k2 = i & 127;
            ((unsigned*)XS)[((size_t)(row0 + t) * 1024 + g * 256) / 2 + k2] = pk2(XLs[t * 257 + 2 * k2], XLs[t * 257 + 2 * k2 + 1]); }
        { const int i = tid >> 3, jg = tid & 7; float acc[8];
#pragma unroll
          for (int jj = 0; jj < 8; ++jj) acc[jj] = 0.f;
#pragma unroll 4
          for (int d = 0; d < 64; ++d) { const float c = CL[i * 65 + d];
#pragma unroll
              for (int jj = 0; jj < 8; ++jj) acc[jj] += c * BL[(jg * 8 + jj) * 65 + d]; }
#pragma unroll
          for (int jj = 0; jj < 8; ++jj) QK[i * 65 + jg * 8 + jj] = acc[jj]; }
        __syncthreads();
        const int f = wave, r = lane & 31, hp = lane >> 5, mt = f >> 2, ks = f & 3;
        for (int hh = 0; hh < 4; ++hh) {
            const int h = g * 4 + hh; const LAS float* Gh = GL + hh * 64; const float Gend = Gh[63];
            bf16x8* base = (bf16x8*)(OPS + ((size_t)((b * 32 + n) * 16 + h)) * SSD_ITEM_BYTES);
            float v[8];
            { const int i = 32 * mt + r; const float eg = __expf(Gh[i]);
#pragma unroll
              for (int jp = 0; jp < 8; ++jp) { const int d = 16 * ks + 8 * (jp >> 2) + 4 * hp + (jp & 3); v[jp] = CL[i * 65 + d] * eg; }
              base[0 * 512 + f * 64 + lane] = pack8(v); }
            { const int d = 32 * mt + r;
#pragma unroll
              for (int jp = 0; jp < 8; ++jp) { const int tk = 16 * ks + 8 * (jp >> 2) + 4 * hp + (jp & 3); v[jp] = BL[tk * 65 + d] * __expf(Gend - Gh[tk]); }
              base[1 * 512 + f * 64 + lane] = pack8(v); }
            { const int i = 32 * mt + r; const float gi = Gh[i];
#pragma unroll
              for (int jp = 0; jp < 8; ++jp) { const int jt = 16 * ks + 8 * (jp >> 2) + 4 * hp + (jp & 3); v[jp] = jt <= i ? QK[i * 65 + jt] * __expf(gi - Gh[jt]) : 0.f; }
              base[2 * 512 + f * 64 + lane] = pack8(v); }
            { const int p = 32 * mt + r;
#pragma unroll
              for (int jp = 0; jp < 8; ++jp) { const int tk = 16 * ks + 8 * (jp >> 2) + 4 * hp + (jp & 3);
                  v[jp] = XLs[tk * 257 + hh * 64 + p] * DTL[hh * 64 + tk]; }
              base[3 * 512 + f * 64 + lane] = pack8(v); }
            if (tid == 0) *(float*)(base + 32 * 64) = __expf(Gend);
        }
    }
}

__device__ __forceinline__ void phase_cd_rec(const KP kp, const int bid, const int G, int j, int li, LAS unsigned char* lds, int tid0) {
    unsigned char* scr = kp.ws() + WS_SCR; const bf16* U = (const bf16*)(kp.ws() + WS_U);
    const float* LA = (const float*)(scr + SC_LA); const float* LB = (const float*)(scr + SC_LB);
    float* YS = (float*)(scr + SC_YS); float* HS = (float*)(scr + SC_HS); bf16* XS = (bf16*)(scr + SC_XS);
    SEC_BEGIN(10)
    for (int item = bid; item < 64; item += G) {
        int tid = tid0; asm volatile("" : "+v"(tid));
        const int b = item >> 4, hd = item & 15;
        __syncthreads();
        const int wave = __builtin_amdgcn_readfirstlane(tid >> 6), lane = tid & 63, r = lane & 31, hp = lane >> 5, nt = wave;
        const unsigned char* OPS = scr + SC_SSDOP;
        const bool dmaw = (wave >= 2 && wave < 6);
        constexpr int SLOT = 33 * 1024;
#define SSD_DMA(n_) do { if (dmaw) { const unsigned char* gi_ = OPS + ((size_t)((b * 32 + (n_)) * 16 + hd)) * SSD_ITEM_BYTES + lane * 16; \
            _Pragma("unroll") for (int q_ = 0; q_ < 9; ++q_) { const int lf_ = q_ < 8 ? (wave - 2) * 8 + q_ : 32; \
                __builtin_amdgcn_global_load_lds((const unsigned*)(gi_ + lf_ * 1024), (LAS unsigned*)(lds + ((n_) & 3) * SLOT + lf_ * 1024), 16, 0, 2); } } } while (0)
        f32x16 S0, S1;
#pragma unroll
        for (int i = 0; i < 16; ++i) { S0[i] = 0.f; S1[i] = 0.f; }
        SSD_DMA(0); SSD_DMA(1); SSD_DMA(2);
        if (dmaw) asm volatile("s_waitcnt vmcnt(18)" ::: "memory");
        asm volatile("" ::: "memory"); __builtin_amdgcn_s_barrier(); asm volatile("" ::: "memory");
        for (int n = 0; n < 32; ++n) {
            if (n + 3 < 32) SSD_DMA(n + 3);
            if (wave < 2) {
                const LAS bf16x8* F = (const LAS bf16x8*)(lds + (n & 3) * SLOT) + lane;
                bf16x8 vb[4];
#pragma unroll
                for (int ks = 0; ks < 4; ++ks) vb[ks] = F[(24 + nt * 4 + ks) * 64];
                const float gend = *(const LAS float*)(lds + (n & 3) * SLOT + 32 * 1024);
                const bf16x8 sb00 = PACK_ACC(S0, 0), sb01 = PACK_ACC(S0, 1), sb10 = PACK_ACC(S1, 0), sb11 = PACK_ACC(S1, 1);
                f32x16 O0, O1;
#pragma unroll
                for (int i = 0; i < 16; ++i) { O0[i] = 0.f; O1[i] = 0.f; }
                O0 = MFMA32(F[0 * 64], sb00, O0); O0 = MFMA32(F[1 * 64], sb01, O0); O0 = MFMA32(F[2 * 64], sb10, O0); O0 = MFMA32(F[3 * 64], sb11, O0);
                O1 = MFMA32(F[4 * 64], sb00, O1); O1 = MFMA32(F[5 * 64], sb01, O1); O1 = MFMA32(F[6 * 64], sb10, O1); O1 = MFMA32(F[7 * 64], sb11, O1);
                O0 = MFMA32(F[16 * 64], vb[0], O0); O0 = MFMA32(F[17 * 64], vb[1], O0);
#pragma unroll
                for (int ks = 0; ks < 4; ++ks) O1 = MFMA32(F[(20 + ks) * 64], vb[ks], O1);
#pragma unroll
                for (int i = 0; i < 16; ++i) { S0[i] *= gend; S1[i] *= gend; }
#pragma unroll
                for (int ks = 0; ks < 4; ++ks) { S0 = MFMA32(F[(8 + ks) * 64], vb[ks], S0); S1 = MFMA32(F[(12 + ks) * 64], vb[ks], S1); }
                float* yo = YS + (size_t)(b * 2048 + n * 64) * 1024 + hd * 64 + 32 * nt + r;
#pragma unroll
                for (int i = 0; i < 16; ++i) { yo[(size_t)crow(i, hp) * 1024] = O0[i]; yo[(size_t)(32 + crow(i, hp)) * 1024] = O1[i]; }
            }
            if (dmaw) { if (n + 3 < 32) asm volatile("s_waitcnt vmcnt(18)" ::: "memory"); else if (n + 2 < 32) asm volatile("s_waitcnt vmcnt(9)" ::: "memory"); else asm volatile("s_waitcnt vmcnt(0)" ::: "memory"); }
            asm volatile("s_waitcnt lgkmcnt(0)" ::: "memory"); __builtin_amdgcn_s_barrier(); asm volatile("" ::: "memory");
        }
#undef SSD_DMA
        if (wave < 2) {
            float* dst = kp.out() + O_SSD_P + ((size_t)j * 4 + b) * ((size_t)16 * 64 * 64) + (size_t)hd * 64 * 64 + 32 * nt + r;
#pragma unroll
            for (int i = 0; i < 16; ++i) { dst[(size_t)crow(i, hp) * 64] = S0[i]; dst[(size_t)(32 + crow(i, hp)) * 64] = S1[i]; }
        }
    }
    SEC_END(10, lds)
    SEC_BEGIN(11)
    unsigned* qhead = (unsigned*)(kp.ws() + WS_CTL) + CW_CNT + 64 * li;
    volatile LAS unsigned* qslot = (volatile LAS unsigned*)(lds + LDS_BYTES - 8);
    const float* cw = kp.in(23) + (size_t)j * 4 * 1536; const float* cb = kp.in(24) + (size_t)j * 1536; const float* stc = kp.in(6) + (size_t)j * 128 * 3 * 1536;
    for (;;) {
        __syncthreads();
        if (tid0 == 0) qslot[0] = __hip_atomic_fetch_add(qhead, 1u, __ATOMIC_RELAXED, __HIP_MEMORY_SCOPE_AGENT);
        __syncthreads();
        const int it = (int)qslot[0];
        if (it >= 1024) break;
        int tid = tid0; asm volatile("" : "+v"(tid));
        if (it < 256) {
            const int s = it >> 6, h = it & 63; int row0, L; seq_info(s, row0, L);
            LAS float* Al = (LAS float*)lds; LAS float* Bl = Al + 512;
            const int chunk = tid >> 4, c16 = tid & 15, ch = h * 16 + c16;
            const size_t ro = (size_t)(row0 + chunk * 64) * 1024 + ch;
            float Ap = 1.f, Bp = 0.f;
#pragma unroll 8
            for (int t = 0; t < 64; ++t) { const float a = LA[ro + (size_t)t * 1024], bb = LB[ro + (size_t)t * 1024]; Bp = a * Bp + bb; Ap *= a; }
            Al[tid] = Ap; Bl[tid] = Bp;
            __syncthreads();
            float hh = 0.f;
            for (int m = 0; m < chunk; ++m) hh = Al[m * 16 + c16] * hh + Bl[m * 16 + c16];
#pragma unroll 8
            for (int t = 0; t < 64; ++t) { hh = LA[ro + (size_t)t * 1024] * hh + LB[ro + (size_t)t * 1024]; HS[ro + (size_t)t * 1024] = hh; }
            if (chunk == 31) kp.out()[O_LRU_P + ((size_t)j * 4 + s) * 1024 + ch] = hh;
        } else if (it < 768) {
            const int q_ = it - 256, bs = q_ >> 2, g = q_ & 3, sq = 4 + bs, r0 = TP + bs * 4;
            LAS float* BL = (LAS float*)lds; LAS float* CL = BL + 256; LAS float* XL = CL + 256; LAS float* DTL = XL + 1024; LAS float* QKs = DTL + 16; LAS float* red = QKs + 16;
            const int wave = tid >> 6, lane = tid & 63, hh = tid >> 7, nh = (tid >> 6) & 1, p = tid & 63, hd = 4 * g + hh;
            const size_t SZ = (size_t)16 * 64 * 64;
            const float* st = kp.in(5) + ((size_t)j * 128 + bs) * SZ + (size_t)hd * 4096;
            float S[32];
            { const float* sp = st + (size_t)(nh * 32) * 64 + p;
#pragma unroll
              for (int i = 0; i < 32; ++i) { S[i] = *sp; sp += 64; asm volatile("" : "+v"(sp)); } }
            { const int ci = tid & 127, tk = tid >> 7;
#pragma unroll
              for (int q = 0; q < 3; ++q) { const int k = ci + 128 * q; int cidx; LAS float* dst;
                  if (k < 64) { cidx = 1024 + g * 64 + k; dst = BL + k * 4 + tk; } else if (k < 128) { cidx = 1280 + g * 64 + (k - 64); dst = CL + (k - 64) * 4 + tk; } else { cidx = g * 256 + (k - 128); dst = XL + tk * 256 + (k - 128); }
                  float acc = cb[cidx];
#pragma unroll
                  for (int tap = 0; tap < 4; ++tap) acc += cw[tap * 1536 + cidx] * pre_val(U, NCD, 1024 + cidx, r0, tk - 3 + tap, sq, stc, 1536, cidx);
                  *dst = silu_(acc); } }
            if (tid < 16) { const int tk = tid >> 2, h2 = tid & 3; DTL[tid] = softplus_(bf2f(U[(size_t)(r0 + tk) * NCD + 4608 + 4 * g + h2]) + kp.in(26)[j * 16 + 4 * g + h2]); }
            __syncthreads();
#pragma unroll
            for (int q = 0; q < 2; ++q) { const int idx = wave * 2 + q, i = idx >> 2, jj = idx & 3; const float dot = wave_sum(CL[lane * 4 + i] * BL[lane * 4 + jj]); if (lane == 0) QKs[idx] = dot; }
            { const int tk = tid >> 7, k2 = tid & 127; ((unsigned*)XS)[((size_t)(r0 + tk) * 1024 + g * 256) / 2 + k2] = pk2(XL[tk * 256 + 2 * k2], XL[tk * 256 + 2 * k2 + 1]); }
            const float negA = -__expf(kp.in(25)[j * 16 + hd]);
            float Gc[4], xd[4], w[4];
            Gc[0] = negA * DTL[hh]; Gc[1] = Gc[0] + negA * DTL[4 + hh]; Gc[2] = Gc[1] + negA * DTL[8 + hh]; Gc[3] = Gc[2] + negA * DTL[12 + hh];
#pragma unroll
            for (int jj = 0; jj < 4; ++jj) { xd[jj] = XL[jj * 256 + hh * 64 + p] * DTL[jj * 4 + hh]; w[jj] = __expf(Gc[3] - Gc[jj]) * xd[jj]; }
            const float eg = __expf(Gc[3]);
            float o[4] = {0.f, 0.f, 0.f, 0.f};
            float* dst = kp.out() + O_SSD_S + ((size_t)j * 128 + bs) * SZ + (size_t)hd * 4096 + (size_t)(nh * 32) * 64 + p;
#pragma unroll
            for (int i = 0; i < 32; ++i) { const int n = nh * 32 + i; const float s0 = S[i]; float acc = eg * s0; const f32x4 c4 = *(const LAS f32x4*)(CL + n * 4), b4 = *(const LAS f32x4*)(BL + n * 4);
#pragma unroll
                for (int t = 0; t < 4; ++t) { o[t] += c4[t] * s0; acc += b4[t] * w[t]; }
                *dst = acc; dst += 64; asm volatile("" : "+v"(dst)); }
#pragma unroll
            for (int t = 0; t < 4; ++t) red[((hh * 2 + nh) * 4 + t) * 64 + p] = o[t];
            __syncthreads();
            if (nh == 0) {
#pragma unroll
                for (int t = 0; t < 4; ++t) { float y = __expf(Gc[t]) * (red[((hh * 2) * 4 + t) * 64 + p] + red[((hh * 2 + 1) * 4 + t) * 64 + p]);
#pragma unroll
                    for (int jj = 0; jj <= t; ++jj) y += QKs[t * 4 + jj] * __expf(Gc[t] - Gc[jj]) * xd[jj];
                    YS[(size_t)(r0 + t) * 1024 + hd * 64 + p] = y; } }
        } else {
            const int q_ = it - 768, s = 4 + (q_ >> 1), h = q_ & 1; int row0, L; seq_info(s, row0, L);
            const int ch = h * 512 + tid;
            float hh = s < 4 ? 0.f : kp.in(7)[((size_t)j * 128 + (s - 4)) * 1024 + ch];
#pragma unroll 8
            for (int t = 0; t < L; ++t) { const size_t r = (size_t)(row0 + t); hh = LA[r * 1024 + ch] * hh + LB[r * 1024 + ch]; HS[r * 1024 + ch] = hh; }
            float* dst = s < 4 ? kp.out() + O_LRU_P + ((size_t)j * 4 + s) * 1024 : kp.out() + O_LRU_S + ((size_t)j * 128 + (s - 4)) * 1024;
            dst[ch] = hh;
        }
    }
    SEC_END(11, lds)
}

__device__ __forceinline__ void phase_cd_post(const KP kp, const int bid, const int G, int j, int tid, int wave, int lane) {
    unsigned char* scr = kp.ws() + WS_SCR; const bf16* U = (const bf16*)(kp.ws() + WS_U); bf16* YM = (bf16*)(kp.ws() + WS_YM);
    const float* YS = (const float*)(scr + SC_YS); const float* HS = (const float*)(scr + SC_HS); const bf16* XS = (const bf16*)(scr + SC_XS);
    const float* sn = kp.in(28) + (size_t)j * 1024; const float* Dv = kp.in(27) + (size_t)j * 16;
    typedef float f32x2v __attribute__((ext_vector_type(2)));
    for (int r = bid * NWAVES + wave; r < T; r += G * NWAVES) {
        int s, t; row_to_seq(r, s, t); int row0, L; seq_info(s, row0, L);
        const bf16* ur = U + (size_t)r * NCD; bf16* yr = YM + (size_t)r * DM;
        f32x4 ysv[4], hsv[4]; u32x2 xxv[4], zzv[4], zlv[4];
#pragma unroll
        for (int gq = 0; gq < 4; ++gq) { const int e = gq * 256 + 4 * lane; ysv[gq] = *(const f32x4*)(YS + (size_t)r * 1024 + e); xxv[gq] = *(const u32x2*)(XS + (size_t)r * 1024 + e); zzv[gq] = *(const u32x2*)(ur + e);
            hsv[gq] = *(const f32x4*)(HS + (size_t)r * 1024 + e); zlv[gq] = *(const u32x2*)(ur + 2560 + e); }
#pragma unroll
        for (int gq = 0; gq < 4; ++gq) { const int e = gq * 256 + 4 * lane; const f32x4 ys = ysv[gq];
            const u32x2 xx = xxv[gq], zz = zzv[gq]; const float Dh = Dv[e >> 6];
            f32x4 y; y.x = (ys.x + Dh * __uint_as_float(xx.x << 16)) * silu_(__uint_as_float(zz.x << 16)); y.y = (ys.y + Dh * __uint_as_float(xx.x & 0xffff0000u)) * silu_(__uint_as_float(zz.x & 0xffff0000u));
            y.z = (ys.z + Dh * __uint_as_float(xx.y << 16)) * silu_(__uint_as_float(zz.y << 16)); y.w = (ys.w + Dh * __uint_as_float(xx.y & 0xffff0000u)) * silu_(__uint_as_float(zz.y & 0xffff0000u));
            const float rstd = rsqrtf(wave_sum((y.x * y.x + y.y * y.y) + (y.z * y.z + y.w * y.w)) * (1.f / 256.f) + 1e-6f);
            const f32x4 g4 = *(const f32x4*)(sn + e);
            u32x2 w; w.x = pk2(y.x * rstd * g4.x, y.y * rstd * g4.y); w.y = pk2(y.z * rstd * g4.z, y.w * rstd * g4.w); *(u32x2*)(yr + e) = w; }
#pragma unroll
        for (int gq = 0; gq < 4; ++gq) { const int ch = gq * 256 + 4 * lane; const f32x4 hs = hsv[gq]; const u32x2 zz = zlv[gq];
            u32x2 w; w.x = pk2(hs.x * silu_(__uint_as_float(zz.x << 16)), hs.y * silu_(__uint_as_float(zz.x & 0xffff0000u))); w.y = pk2(hs.z * silu_(__uint_as_float(zz.y << 16)), hs.w * silu_(__uint_as_float(zz.y & 0xffff0000u)));
            *(u32x2*)(yr + 1024 + ch) = w; }
        if (t >= L - 3) { const int rr = t - (L - 3);
            float* d1 = s < 4 ? kp.out() + O_SSDC_P + (((size_t)j * 4 + s) * 3 + rr) * 1536 : kp.out() + O_SSDC_S + (((size_t)j * 128 + (s - 4)) * 3 + rr) * 1536;
            for (int c = 2 * lane; c < 1536; c += 128) { const unsigned uu = *(const unsigned*)(ur + 1024 + c); *(f32x2v*)(d1 + c) = (f32x2v){__uint_as_float(uu << 16), __uint_as_float(uu & 0xffff0000u)}; }
            float* d2 = s < 4 ? kp.out() + O_LRUC_P + (((size_t)j * 4 + s) * 3 + rr) * 1024 : kp.out() + O_LRUC_S + (((size_t)j * 128 + (s - 4)) * 3 + rr) * 1024;
            for (int c = 2 * lane; c < 1024; c += 128) { const unsigned uu = *(const unsigned*)(ur + 3584 + c); *(f32x2v*)(d2 + c) = (f32x2v){__uint_as_float(uu << 16), __uint_as_float(uu & 0xffff0000u)}; } }
    }
}


typedef float f32x4m __attribute__((ext_vector_type(4)));
template <bool GATE>
__device__ __forceinline__ void sample_gemm_res(LAS unsigned char* lds, const bf16* Amat, const bf16* Bt, const bf16* Hin, bf16* Hout, float* rss_out, const bf16* PP, const float* rss_in, int bid, int tid) {
    if (bid >= 256) return;
    const int wave = tid >> 6, lane = tid & 63, lr = lane & 15, kg = lane >> 4;
    const int m0 = TP + (bid & 7) * 64, n0 = (bid >> 3) * 64;
    const bf16x8* ap = (const bf16x8*)(Amat + (size_t)(m0 + lr) * 2048 + wave * 256 + 8 * kg);
    const bf16x8* bp = (const bf16x8*)(Bt + (size_t)(n0 + lr) * 2048 + wave * 256 + 8 * kg);
    f32x4m acc[4][4];
#pragma unroll
    for (int mi = 0; mi < 4; ++mi)
#pragma unroll
        for (int ni = 0; ni < 4; ++ni) acc[mi][ni] = (f32x4m){0.f, 0.f, 0.f, 0.f};
#pragma unroll 2
    for (int ks = 0; ks < 8; ++ks) { bf16x8 a[4], b[4];
#pragma unroll
        for (int q = 0; q < 4; ++q) { a[q] = ap[(size_t)q * 16 * 256 + ks * 4]; b[q] = bp[(size_t)q * 16 * 256 + ks * 4]; }
#pragma unroll
        for (int mi = 0; mi < 4; ++mi)
#pragma unroll
            for (int ni = 0; ni < 4; ++ni) acc[mi][ni] = __builtin_amdgcn_mfma_f32_16x16x32_bf16(a[mi], b[ni], acc[mi][ni], 0, 0, 0); }
    LAS float* red = (LAS float*)lds;
    __syncthreads();
#pragma unroll
    for (int mi = 0; mi < 4; ++mi)
#pragma unroll
        for (int ni = 0; ni < 4; ++ni)
#pragma unroll
            for (int i = 0; i < 4; ++i) red[(wave * 64 + 16 * mi + kg * 4 + i) * 65 + 16 * ni + lr] = acc[mi][ni][i];
    __syncthreads();
    { const int row = tid >> 3, c8 = (tid & 7) * 8, grow = m0 + row; float v[8];
#pragma unroll
      for (int e = 0; e < 8; ++e) { float sacc = 0.f;
#pragma unroll
          for (int w = 0; w < 8; ++w) sacc += red[(w * 64 + row) * 65 + c8 + e];
          v[e] = sacc; }
      float sc = 1.f; if (GATE) sc = rsqrtf(rss_in[grow] * (1.f / 2048.f) + 1e-6f);
      const size_t p = (size_t)grow * 2048 + n0 + c8;
      const u32x4 hw = *(const u32x4*)(Hin + p); u32x4 pw = (u32x4){0u, 0u, 0u, 0u}; if (GATE) pw = *(const u32x4*)(PP + p);
      const unsigned hws[4] = {hw.x, hw.y, hw.z, hw.w}, pws[4] = {pw.x, pw.y, pw.z, pw.w}; unsigned ow[4]; float sq = 0.f;
#pragma unroll
      for (int e2 = 0; e2 < 4; ++e2) { float h0 = __uint_as_float(hws[e2] << 16), h1 = __uint_as_float(hws[e2] & 0xffff0000u);
          if (GATE) { h0 += __builtin_amdgcn_rcpf(1.f + __expf(-sc * v[2 * e2])) * __uint_as_float(pws[e2] << 16); h1 += __builtin_amdgcn_rcpf(1.f + __expf(-sc * v[2 * e2 + 1])) * __uint_as_float(pws[e2] & 0xffff0000u); }
          else { h0 += v[2 * e2]; h1 += v[2 * e2 + 1]; }
          sq += h0 * h0 + h1 * h1; ow[e2] = cvtpk(h0, h1); }
      *(u32x4*)(Hout + p) = (u32x4){ow[0], ow[1], ow[2], ow[3]};
      sq += __shfl_xor(sq, 1); sq += __shfl_xor(sq, 2); sq += __shfl_xor(sq, 4);
      if ((tid & 7) == 0) atomicAdd(rss_out + grow, sq); }
}

__global__ void __launch_bounds__(NTHR, 2) mega_fwd(Args A) {
    extern __shared__ __attribute__((aligned(16))) unsigned char lds_raw[];
    LAS unsigned char* lds = (LAS unsigned char*)lds_raw;
    const int G = gridDim.x;
    volatile LAS unsigned* bst = (volatile LAS unsigned*)(lds + LDS_BYTES - 16);
    if (threadIdx.x == 0) { bst[0] = 0u; bst[1] = 0u;
#ifdef PROBE_SEC
        *(volatile LAS unsigned long long*)(lds + LDS_BYTES - 32) = 0ull;
#endif
    }
    __syncthreads();
    XcdBarrier xbar = xcd_barrier_post((unsigned*)(A.ws + WS_CTL) + CW_BAR, bst);
#ifdef PROBE_GROUP
    unsigned long long t_prev = __builtin_amdgcn_s_memrealtime(), t_sel = 0;
#endif
    for (int ph = A.ph_lo; ph < A.ph_hi; ++ph) {
        KP kp; kp.p = (const char AS4*)__builtin_amdgcn_kernarg_segment_ptr(); asm volatile("" : "+s"(kp.p));
        unsigned char* ws = kp.ws();
        int tid = threadIdx.x; asm volatile("" : "+v"(tid));
        int bid = blockIdx.x; asm volatile("" : "+s"(bid));
        const int lane = tid & 63, wave = __builtin_amdgcn_readfirstlane(tid >> 6), gw = bid * NWAVES + wave, NGW = G * NWAVES;
        if (ph == 0) { if (PH_MASK & 1) phase_prologue(kp, lds, gw, NGW, wave, lane); }
        else if (ph == N_PHASES - 1) phase_final(kp, gw, NGW, lane);
        else {
            const int li = (ph - 1) / SUBS, sub = (ph - 1) % SUBS, j = li >> 1; const bool ab = (li & 1) == 0;
            float* RSS = (float*)(ws + WS_RSS);
            if (sub == 0) {
                const int N = ab ? NAB : NCD;
                const bf16* Bt = ab ? (const bf16*)(ws + WS_WABIN) + (size_t)j * NAB * 2048 : (const bf16*)(ws + WS_WCDIN) + (size_t)j * NCD * 2048;
                { pg8::Gemm g{(const bf16*)(ws + WS_XN), Bt, T, N, 2048}; pg8::StaticOrder S; S.init(T, N, G, bid);
                  pg8::EpiU E{(bf16*)(ws + WS_U), N, RSS + (size_t)(2 * li) * T};
                  if (PH_MASK & 2) pg8::gemm_phase<pg8::EpiU, pg8::StaticOrder, true, true>(lds, g, S, E, tid); }
                { int tid2 = tid; asm volatile("" : "+v"(tid2));
                  pg8::Gemm g{(const bf16*)(ws + WS_PB) + (size_t)li * T * 256, (const bf16*)(ws + WS_WPROJ) + (size_t)li * 2048 * 256, T, 2048, 256}; pg8::StaticOrder S; S.init(T, 2048, G, (bid + 37) % G);
                  pg8::EpiU E{(bf16*)(ws + WS_SCR + SC_PP), 2048, nullptr};
                  if (PH_MASK & 2) pg8::gemm_phase<pg8::EpiU, pg8::StaticOrder, true, true>(lds, g, S, E, tid2); }
            } else if (sub == 4) {
                const bf16* Bt = ab ? (const bf16*)(ws + WS_WABOUT) + (size_t)j * 2048 * 2048 : (const bf16*)(ws + WS_WCDOUT) + (size_t)j * 2048 * 2048;
                pg8::Gemm g{(const bf16*)(ws + WS_YM), Bt, TP, 2048, 2048}; pg8::StaticOrder S; S.init(TP, 2048, G, bid);
                pg8::EpiRes<false> E{(const bf16*)(ws + WS_XN), (bf16*)(ws + WS_SCR + SC_HB1), RSS + (size_t)(2 * li + 1) * T, nullptr, nullptr};
                if (PH_MASK & 4) pg8::gemm_phase<pg8::EpiRes<false>, pg8::StaticOrder, true, true>(lds, g, S, E, tid);
                { int tid2 = tid; asm volatile("" : "+v"(tid2));
                  sample_gemm_res<false>(lds, (const bf16*)(ws + WS_YM), Bt, (const bf16*)(ws + WS_XN), (bf16*)(ws + WS_SCR + SC_HB1), RSS + (size_t)(2 * li + 1) * T, nullptr, nullptr, bid, tid2); }
            } else if (sub == 5) {
                pg8::Gemm g{(const bf16*)(ws + WS_SCR + SC_HB1), (const bf16*)(ws + WS_WGATE) + (size_t)li * 2048 * 2048, TP, 2048, 2048}; pg8::StaticOrder S; S.init(TP, 2048, G, bid);
                pg8::EpiRes<true> E{(const bf16*)(ws + WS_SCR + SC_HB1), (bf16*)(ws + WS_XN), RSS + (size_t)(2 * li + 2) * T, (const bf16*)(ws + WS_SCR + SC_PP), RSS + (size_t)(2 * li + 1) * T};
                if (PH_MASK & 4) pg8::gemm_phase<pg8::EpiRes<true>, pg8::StaticOrder, true, true>(lds, g, S, E, tid);
                { int tid2 = tid; asm volatile("" : "+v"(tid2));
                  sample_gemm_res<true>(lds, (const bf16*)(ws + WS_SCR + SC_HB1), (const bf16*)(ws + WS_WGATE) + (size_t)li * 2048 * 2048, (const bf16*)(ws + WS_SCR + SC_HB1), (bf16*)(ws + WS_XN), RSS + (size_t)(2 * li + 2) * T,
                                        (const bf16*)(ws + WS_SCR + SC_PP), RSS + (size_t)(2 * li + 1) * T, bid, tid2); }
            } else if (sub == 1) {
                if (ab) { SEC_BEGIN(3) if (PH_MASK & 4096) phase_gla_prep(kp, bid, G, j, lds, tid); SEC_END(3, lds) SEC_BEGIN(4) if (PH_MASK & 8192) phase_dn_prep(kp, bid, G, j, lds, tid); SEC_END(4, lds) }
                else { if (PH_MASK & 2048) { SEC_BEGIN(8) phase_ssd_prep(kp, bid, G, j, lds, tid); SEC_END(8, lds) SEC_BEGIN(9) phase_lru_gates(kp, bid, G, j, lds, tid); SEC_END(9, lds) } }
            }
            else if (sub == 2) { if (ab) { if (PH_MASK & 32) phase_ab_rec(kp, bid, G, j, li, lds, tid); } else { if (PH_MASK & 64) phase_cd_rec(kp, bid, G, j, li, lds, tid); } }
            else { if (ab) { if (PH_MASK & 128) phase_ab_post(kp, bid, G, j, tid, wave, lane); } else { if (PH_MASK & 256) phase_cd_post(kp, bid, G, j, tid, wave, lane); } }
        }
        if (ph + 1 < A.ph_hi) { if (ph == A.ph_lo) cg::this_grid().sync(); else xcd_barrier(xbar); }
#ifdef PROBE_GROUP
        { const unsigned long long t_now = __builtin_amdgcn_s_memrealtime(); const int li_ = (ph - 1) / SUBS, sub_ = (ph - 1) % SUBS; const bool ab_ = (li_ & 1) == 0;
          int grp = 9; if (ph == N_PHASES - 1) grp = 8; else if (ph > 0) { if (sub_ == 0 || sub_ == 4 || sub_ == 5) grp = 1; else if (sub_ == 1) grp = ab_ ? 4 : 5; else if (sub_ == 2) grp = ab_ ? 6 : 7; else grp = 8; }
          if (grp == PROBE_GROUP) t_sel += t_now - t_prev; t_prev = t_now; }
#endif
    }
#ifdef PROBE_SEC
    if (blockIdx.x == PROBE_BLK && threadIdx.x == 0) { const unsigned long long t_s = *(volatile LAS unsigned long long*)(lds + LDS_BYTES - 32); const unsigned long long t0 = __builtin_amdgcn_s_memrealtime(); while (__builtin_amdgcn_s_memrealtime() - t0 < 3 * t_s) __builtin_amdgcn_s_sleep(8); }
#endif
#ifdef PROBE_GROUP
    if (blockIdx.x == 0 && threadIdx.x == 0) { const unsigned long long t0 = __builtin_amdgcn_s_memrealtime(); while (__builtin_amdgcn_s_memrealtime() - t0 < 3 * t_sel) __builtin_amdgcn_s_sleep(8); }
#endif
}

extern "C" void kernel_launch(void* const* d_in, const int* in_sizes, int n_in, void* d_out, int out_size, void* d_ws, size_t ws_size, hipStream_t stream) {
    static int grid = 0;
    if (grid == 0) {
        if (n_in != 40 || (size_t)out_size != O_END || ws_size < WS_END) { fprintf(stderr, "kernel_launch: unexpected shapes: n_in %d out %d ws %zu\n", n_in, out_size, ws_size); grid = -1; return; }
        int dev = 0, cus = 0, per_cu = 0;
        if (hipGetDevice(&dev) != hipSuccess || hipDeviceGetAttribute(&cus, hipDeviceAttributeMultiprocessorCount, dev) != hipSuccess) { grid = -1; return; }
        if (hipFuncSetAttribute((const void*)mega_fwd, hipFuncAttributeMaxDynamicSharedMemorySize, LDS_BYTES) != hipSuccess) { fprintf(stderr, "kernel_launch: hipFuncSetAttribute failed\n"); grid = -1; return; }
        if (hipOccupancyMaxActiveBlocksPerMultiprocessor(&per_cu, (const void*)mega_fwd, NTHR, LDS_BYTES) != hipSuccess || per_cu < 1) { fprintf(stderr, "kernel_launch: occupancy query says %d\n", per_cu); per_cu = 1; }
        (void)hipGetLastError();
        grid = cus;
    }
    if (grid < 0) return;
    if (hipMemsetAsync((char*)d_ws + WS_CTL, 0, CTL_ZERO_BYTES, stream) != hipSuccess) { fprintf(stderr, "kernel_launch: memset of the control words failed\n"); return; }
    Args a{};
    for (int i = 0; i < 40; ++i) a.in[i] = (const float*)d_in[i];
    a.out = (float*)d_out; a.ws = (unsigned char*)d_ws;
#if MK_N_LAUNCHES == 1
    a.ph_lo = 0; a.ph_hi = N_PHASES;
    void* args[] = {&a};
    hipError_t e = hipLaunchCooperativeKernel((const void*)mega_fwd, dim3(grid), dim3(NTHR), args, LDS_BYTES, stream);
    if (e != hipSuccess) fprintf(stderr, "cooperative launch failed: %s (grid %d)\n", hipGetErrorString(e), grid);
#else
    for (int ph = 0; ph < N_PHASES; ++ph) { a.ph_lo = ph; a.ph_hi = ph + 1; mega_fwd<<<dim3(grid), dim3(NTHR), LDS_BYTES, stream>>>(a); }
#endif
}
```

```cpp
#include <hip/hip_runtime.h>
#include <hip/hip_cooperative_groups.h>
#include <cstdio>
#include <cstdint>
namespace cg = cooperative_groups;

#ifndef MK_N_LAUNCHES
#define MK_N_LAUNCHES 1
#endif

namespace pg8 {
#define PG8_LAS __attribute__((address_space(3)))
typedef unsigned short bf16_t;
typedef short bf16x8 __attribute__((ext_vector_type(8)));
typedef float f32x4 __attribute__((ext_vector_type(4)));
typedef unsigned u32x4 __attribute__((ext_vector_type(4)));
constexpr int BM = 256, BK = 64, HALF = 128, HTB = HALF * BK * 2  , STAGE_BYTES = 8 * HTB, NXCD = 8, WGM = 8;

__host__ __device__ __forceinline__ int lds_byte(int r, int c) { const int st = (r >> 4) * 2 + (c >> 5), rr = r & 15, cc = c & 31, ob = rr * 64 + cc * 2; return st * 1024 + (ob ^ (((ob >> 9) & 1) << 5)); }
__host__ __device__ __forceinline__ void stage_rc(int b, int& R, int& C) { const int st = b / 1024, sb = b % 1024, swz = sb ^ (((sb >> 9) & 1) << 5); R = (st >> 1) * 16 + swz / 64; C = (st & 1) * 32 + (swz % 64) / 2; }
__host__ __device__ __forceinline__ int perm32(int rho) { const int n = rho >> 4, i = rho & 15; return 8 * (i >> 2) + 4 * n + (i & 3); }

struct Unit { int pm, pn; };
struct Gemm { const bf16_t* A; const bf16_t* Bt; int M, N, K; };

struct StaticOrder {
    int nM, nN, nwg, G, c;
    __host__ __device__ void init(int M, int N, int G_, int c_) { nM = M / BM; nN = N / BM; nwg = nM * nN; G = G_; c = c_; }
    __host__ __device__ bool next(int i, Unit& u) const {
        const long L = (long)i * G + c; if (L >= nwg) return false;
        int wgid = (int)L; { const int q = nwg / NXCD, r = nwg % NXCD, xcd = wgid % NXCD, off = wgid / NXCD; wgid = (xcd < r ? xcd * (q + 1) : r * (q + 1) + (xcd - r) * q) + off; }
        const int nig = WGM * nN, gid = wgid / nig, fm = gid * WGM, gsz = (nM - fm) < WGM ? (nM - fm) : WGM;
        u.pm = fm + ((wgid % nig) % gsz); u.pn = (wgid % nig) / gsz; return true;
    }
    __device__ __forceinline__ void a_ready(const Unit&) const {}
    __device__ __forceinline__ void done(const Unit&) const {}
};

__device__ __forceinline__ unsigned cvt_pk_bf16(float lo, float hi) { unsigned r; asm volatile("v_cvt_pk_bf16_f32 %0, %1, %2" : "=v"(r) : "v"(lo), "v"(hi)); return r; }
struct EpiF32 {
    static constexpr bool PERM = false, AFTER_DRAIN = false;
    float* C; int ldc;
    __device__ __forceinline__ void operator()(const f32x4 (&acc)[2][2][4][2], const Unit& u, int wr, int wc, int fr, int fq) const {
        const int row0 = u.pm * BM + wr * 64 + fr, col0 = u.pn * BM + wc * 32 + 4 * fq;
#pragma unroll
        for (int ai = 0; ai < 2; ++ai)
#pragma unroll
            for (int m = 0; m < 4; ++m) { float* rowp = C + (size_t)(row0 + ai * HALF + m * 16) * ldc + col0;
#pragma unroll
                for (int bj = 0; bj < 2; ++bj)
#pragma unroll
                    for (int n = 0; n < 2; ++n) *(f32x4*)(rowp + bj * HALF + n * 16) = acc[ai][bj][m][n]; }
    }
};
struct EpiBf16 {
    static constexpr bool PERM = true, AFTER_DRAIN = false;
    bf16_t* O; int ldc;
    __device__ __forceinline__ void operator()(const f32x4 (&acc)[2][2][4][2], const Unit& u, int wr, int wc, int fr, int fq) const {
        const int row0 = u.pm * BM + wr * 64 + fr; const int col0 = u.pn * BM + wc * 32 + 8 * fq;
#pragma unroll
        for (int ai = 0; ai < 2; ++ai)
#pragma unroll
            for (int m = 0; m < 4; ++m) { bf16_t* rowp = O + (size_t)(row0 + ai * HALF + m * 16) * ldc + col0;
#pragma unroll
                for (int bj = 0; bj < 2; ++bj) { const f32x4 v0 = acc[ai][bj][m][0], v1 = acc[ai][bj][m][1];
                    u32x4 w; w.x = cvt_pk_bf16(v0[0], v0[1]); w.y = cvt_pk_bf16(v0[2], v0[3]); w.z = cvt_pk_bf16(v1[0], v1[1]); w.w = cvt_pk_bf16(v1[2], v1[3]);
                    *(u32x4*)(rowp + bj * HALF) = w; } }
    }
};

struct EpiU {
    static constexpr bool PERM = true, AFTER_DRAIN = false;
    bf16_t* O; int ldc; const float* rss;
    __device__ __forceinline__ void operator()(const f32x4 (&acc)[2][2][4][2], const Unit& u, int wr, int wc, int fr, int fq) const {
        const int row0 = u.pm * BM + wr * 64 + fr; const int col0 = u.pn * BM + wc * 32 + 8 * fq;
#pragma unroll
        for (int ai = 0; ai < 2; ++ai)
#pragma unroll
            for (int m = 0; m < 4; ++m) { const int row = row0 + ai * HALF + m * 16; const float sc = rss ? rsqrtf(rss[row] * (1.f / 2048.f) + 1e-6f) : 1.f;
                bf16_t* rowp = O + (size_t)row * ldc + col0;
#pragma unroll
                for (int bj = 0; bj < 2; ++bj) { const f32x4 v0 = acc[ai][bj][m][0] * sc, v1 = acc[ai][bj][m][1] * sc;
                    u32x4 w; w.x = cvt_pk_bf16(v0[0], v0[1]); w.y = cvt_pk_bf16(v0[2], v0[3]); w.z = cvt_pk_bf16(v1[0], v1[1]); w.w = cvt_pk_bf16(v1[2], v1[3]);
                    *(u32x4*)(rowp + bj * HALF) = w; } }
    }
};
typedef unsigned u32x2e __attribute__((ext_vector_type(2)));
template <bool GATE> struct EpiRes {
    static constexpr bool PERM = false, AFTER_DRAIN = false;
    const bf16_t* Hin; bf16_t* Hout; float* rss_out; const bf16_t* PP; const float* rss_in;
    __device__ __forceinline__ void operator()(const f32x4 (&acc)[2][2][4][2], const Unit& u, int wr, int wc, int fr, int fq) const {
        const int row0 = u.pm * BM + wr * 64 + fr, col0 = u.pn * BM + wc * 32 + 4 * fq;
#pragma unroll
        for (int ai = 0; ai < 2; ++ai)
#pragma unroll
            for (int m = 0; m < 4; ++m) { const int row = row0 + ai * HALF + m * 16; const size_t ro = (size_t)row * 2048 + col0;
                float sc = 1.f; if (GATE) sc = rsqrtf(rss_in[row] * (1.f / 2048.f) + 1e-6f);
                float s = 0.f;
#pragma unroll
                for (int bj = 0; bj < 2; ++bj)
#pragma unroll
                    for (int n = 0; n < 2; ++n) { const size_t p = ro + bj * HALF + n * 16; const u32x2e hw = *(const u32x2e*)(Hin + p); const f32x4 a = acc[ai][bj][m][n];
                        f32x4 h; h[0] = __uint_as_float(hw.x << 16); h[1] = __uint_as_float(hw.x & 0xffff0000u); h[2] = __uint_as_float(hw.y << 16); h[3] = __uint_as_float(hw.y & 0xffff0000u);
                        if (GATE) { const u32x2e pw = *(const u32x2e*)(PP + p);
                            h[0] += __builtin_amdgcn_rcpf(1.f + __expf(-sc * a[0])) * __uint_as_float(pw.x << 16); h[1] += __builtin_amdgcn_rcpf(1.f + __expf(-sc * a[1])) * __uint_as_float(pw.x & 0xffff0000u);
                            h[2] += __builtin_amdgcn_rcpf(1.f + __expf(-sc * a[2])) * __uint_as_float(pw.y << 16); h[3] += __builtin_amdgcn_rcpf(1.f + __expf(-sc * a[3])) * __uint_as_float(pw.y & 0xffff0000u); }
                        else h = h + a;
                        s += (h[0] * h[0] + h[1] * h[1]) + (h[2] * h[2] + h[3] * h[3]);
                        u32x2e o; o.x = cvt_pk_bf16(h[0], h[1]); o.y = cvt_pk_bf16(h[2], h[3]); *(u32x2e*)(Hout + p) = o; }
                s += __shfl_xor(s, 16); s += __shfl_xor(s, 32);
                if (fq == 0) atomicAdd(rss_out + row, s);
                asm volatile("" ::: "memory"); }
    }
};
template <class Epi, class Sched, bool ALIGN_EPI = false, bool SP2 = false>
__device__ __forceinline__ void gemm_phase(PG8_LAS unsigned char* lds, const Gemm g, const Sched& S, const Epi& E, const int tid) {
    const int wid = __builtin_amdgcn_readfirstlane(tid >> 6), lane = tid & 63, wr = wid >> 2, wc = wid & 3, fr = lane & 15, fq = lane >> 4;
    const int K = g.K, nt = K / BK;
    unsigned voffA[2], voffB[2];
#pragma unroll
    for (int i = 0; i < 2; ++i) { int R, C; stage_rc(tid * 16 + i * 8192, R, C); const int Rb = Epi::PERM ? ((R & ~31) + perm32(R & 31)) : R;
        voffA[i] = (unsigned)(R * K + C) * 2u; voffB[i] = (unsigned)(Rb * K + C) * 2u; }
    const size_t kstep = (size_t)(BK * 2);
    const size_t hstep = (size_t)HALF * K * 2;
    const size_t tstep = 2 * hstep;
    const unsigned ldsw = (unsigned)wid * 1024u;
    const int aoff = lds_byte(wr * 64 + fr, fq * 8), boff = lds_byte(wc * 32 + fr, fq * 8);
#define PG8_SA(b, h) (((b) * 2 + (h)) * HTB)
#define PG8_SB(b, h) ((4 + (b) * 2 + (h)) * HTB)
#define PG8_STAGE(bufoff, gbase, voff) do { _Pragma("unroll") for (int _i = 0; _i < 2; ++_i) \
        __builtin_amdgcn_global_load_lds((const unsigned*)((const char*)(gbase) + (voff)[_i]), (PG8_LAS unsigned*)(lds + (bufoff) + ldsw + _i * 8192), 16, 0, 0); } while (0)
#define PG8_LDA(dst, b, h) do { _Pragma("unroll") for (int m = 0; m < 4; ++m) _Pragma("unroll") for (int k = 0; k < 2; ++k) dst[m][k] = *(const PG8_LAS bf16x8*)(lds + PG8_SA(b, h) + aoff + m * 2048 + k * 1024); } while (0)
#define PG8_LDB(dst, b, h) do { _Pragma("unroll") for (int n = 0; n < 2; ++n) _Pragma("unroll") for (int k = 0; k < 2; ++k) dst[n][k] = *(const PG8_LAS bf16x8*)(lds + PG8_SB(b, h) + boff + n * 2048 + k * 1024); } while (0)
#define PG8_MMA(ai, bj, At, Bt) do { __builtin_amdgcn_s_setprio(1); _Pragma("unroll") for (int m = 0; m < 4; ++m) _Pragma("unroll") for (int n = 0; n < 2; ++n) _Pragma("unroll") for (int k = 0; k < 2; ++k) \
        acc[ai][bj][m][n] = __builtin_amdgcn_mfma_f32_16x16x32_bf16(Bt[n][k], At[m][k], acc[ai][bj][m][n], 0, 0, 0); __builtin_amdgcn_s_setprio(0); } while (0)
#define PG8_WAIT_V(n) asm volatile("s_waitcnt vmcnt(" #n ")" ::: "memory")
#define PG8_WAIT_L(n) asm volatile("s_waitcnt lgkmcnt(" #n ")" ::: "memory")
#define PG8_BAR __builtin_amdgcn_s_barrier()
#define PG8_SCHED __builtin_amdgcn_sched_barrier(0)
    Unit cur, nxt; int ui = 0;
    if (!S.next(0, cur)) return;
    f32x4 acc[2][2][4][2];
#pragma unroll
    for (int a = 0; a < 2; ++a)
#pragma unroll
        for (int b = 0; b < 2; ++b)
#pragma unroll
            for (int m = 0; m < 4; ++m)
#pragma unroll
                for (int n = 0; n < 2; ++n) acc[a][b][m][n] = (f32x4){0.f, 0.f, 0.f, 0.f};
    bf16x8 At[4][2], B0[2][2], B1[2][2];
    const char* cA = (const char*)g.A + (size_t)cur.pm * tstep; const char* cB = (const char*)g.Bt + (size_t)cur.pn * tstep;
    S.a_ready(cur);
    if constexpr (SP2) {
        PG8_STAGE(PG8_SB(0, 0), cB, voffB); PG8_STAGE(PG8_SB(0, 1), cB + hstep, voffB); PG8_STAGE(PG8_SA(0, 0), cA, voffA); PG8_STAGE(PG8_SA(0, 1), cA + hstep, voffA);
        if (wr == 1) PG8_BAR;
        PG8_WAIT_V(2); PG8_BAR;
        PG8_STAGE(PG8_SB(1, 0), cB + kstep, voffB); PG8_STAGE(PG8_SA(1, 0), cA + kstep, voffA); PG8_STAGE(PG8_SB(1, 1), cB + hstep + kstep, voffB);
        PG8_WAIT_V(6); PG8_BAR;
    } else {
        PG8_STAGE(PG8_SB(0, 0), cB, voffB); PG8_STAGE(PG8_SA(0, 0), cA, voffA); PG8_STAGE(PG8_SB(0, 1), cB + hstep, voffB); PG8_STAGE(PG8_SA(0, 1), cA + hstep, voffA);
        if (wr == 1) PG8_BAR;
        PG8_WAIT_V(4); PG8_BAR;
        PG8_STAGE(PG8_SB(1, 0), cB + kstep, voffB); PG8_STAGE(PG8_SA(1, 0), cA + kstep, voffA); PG8_STAGE(PG8_SB(1, 1), cB + hstep + kstep, voffB);
        PG8_WAIT_V(6); PG8_BAR;
    }
    for (;;) {
        const bool has_next = S.next(ui + 1, nxt);
        const char* nA = has_next ? (const char*)g.A + (size_t)nxt.pm * tstep : cA; const char* nB = has_next ? (const char*)g.Bt + (size_t)nxt.pn * tstep : cB;
        for (int t = 0; t < nt; t += 2) {
            const bool last = (t == nt - 2);
            const char* a1 = cA + (size_t)(t + 1) * kstep;
            const char* a2 = last ? nA : cA + (size_t)(t + 2) * kstep; const char* b2 = last ? nB : cB + (size_t)(t + 2) * kstep;
            const char* a3 = a2 + kstep; const char* b3 = b2 + kstep;
            if (last && has_next) S.a_ready(nxt);
            if constexpr (SP2) {
            PG8_LDB(B0, 0, 0); PG8_LDB(B1, 0, 1); PG8_SCHED; PG8_LDA(At, 0, 0); PG8_STAGE(PG8_SA(1, 1), a1 + hstep, voffA);
            PG8_WAIT_V(8); PG8_WAIT_L(0); PG8_BAR; PG8_MMA(0, 0, At, B0); PG8_MMA(0, 1, At, B1); PG8_BAR; PG8_SCHED;
            PG8_LDA(At, 0, 1); PG8_STAGE(PG8_SB(0, 0), b2, voffB); PG8_STAGE(PG8_SB(0, 1), b2 + hstep, voffB); PG8_STAGE(PG8_SA(0, 0), a2, voffA);
            PG8_WAIT_V(8); PG8_WAIT_L(0); PG8_BAR; PG8_MMA(1, 0, At, B0); PG8_MMA(1, 1, At, B1); PG8_BAR; PG8_SCHED;
            PG8_LDB(B0, 1, 0); PG8_LDB(B1, 1, 1); PG8_SCHED; PG8_LDA(At, 1, 0); PG8_STAGE(PG8_SA(0, 1), a2 + hstep, voffA);
            PG8_WAIT_V(8); PG8_WAIT_L(0); PG8_BAR; PG8_MMA(0, 0, At, B0); PG8_MMA(0, 1, At, B1); PG8_BAR; PG8_SCHED;
            PG8_LDA(At, 1, 1); PG8_STAGE(PG8_SB(1, 0), b3, voffB); PG8_STAGE(PG8_SB(1, 1), b3 + hstep, voffB); PG8_STAGE(PG8_SA(1, 0), a3, voffA);
            PG8_WAIT_V(8); PG8_WAIT_L(0); PG8_BAR; PG8_MMA(1, 0, At, B0); PG8_MMA(1, 1, At, B1); PG8_BAR; PG8_SCHED;
            } else {
            PG8_LDB(B0, 0, 0); PG8_SCHED; PG8_LDA(At, 0, 0); PG8_STAGE(PG8_SA(1, 1), a1 + hstep, voffA);
            PG8_WAIT_L(8); PG8_BAR; PG8_WAIT_L(0); PG8_MMA(0, 0, At, B0); PG8_BAR; PG8_SCHED;
            PG8_LDB(B1, 0, 1); PG8_STAGE(PG8_SB(0, 0), b2, voffB);
            PG8_BAR; PG8_WAIT_L(0); PG8_MMA(0, 1, At, B1); PG8_BAR;
            PG8_LDA(At, 0, 1); PG8_STAGE(PG8_SA(0, 0), a2, voffA);
            PG8_BAR; PG8_WAIT_L(0); PG8_MMA(1, 0, At, B0); PG8_BAR; PG8_SCHED;
            PG8_STAGE(PG8_SB(0, 1), b2 + hstep, voffB);
            PG8_WAIT_V(6); PG8_BAR; PG8_MMA(1, 1, At, B1); PG8_BAR;
            PG8_LDB(B0, 1, 0); PG8_SCHED; PG8_LDA(At, 1, 0); PG8_STAGE(PG8_SA(0, 1), a2 + hstep, voffA);
            PG8_WAIT_L(8); PG8_BAR; PG8_WAIT_L(0); PG8_MMA(0, 0, At, B0); PG8_BAR; PG8_SCHED;
            PG8_LDB(B1, 1, 1); PG8_STAGE(PG8_SB(1, 0), b3, voffB);
            PG8_BAR; PG8_WAIT_L(0); PG8_MMA(0, 1, At, B1); PG8_BAR;
            PG8_LDA(At, 1, 1); PG8_STAGE(PG8_SA(1, 0), a3, voffA);
            PG8_BAR; PG8_WAIT_L(0); PG8_MMA(1, 0, At, B0); PG8_BAR; PG8_SCHED;
            PG8_STAGE(PG8_SB(1, 1), b3 + hstep, voffB);
            PG8_WAIT_V(6); PG8_BAR; PG8_MMA(1, 1, At, B1); PG8_BAR;
            }
        }
        if constexpr (ALIGN_EPI) { if (wr == 0) PG8_BAR; }
        if constexpr (!Epi::AFTER_DRAIN) { E(acc, cur, wr, wc, fr, fq); S.done(cur); }
        if (!has_next) break;
#pragma unroll
        for (int a = 0; a < 2; ++a)
#pragma unroll
            for (int b = 0; b < 2; ++b)
#pragma unroll
                for (int m = 0; m < 4; ++m)
#pragma unroll
                    for (int n = 0; n < 2; ++n) acc[a][b][m][n] = (f32x4){0.f, 0.f, 0.f, 0.f};
        cur = nxt; cA = nA; cB = nB; ++ui;
        if constexpr (ALIGN_EPI) { if (wr == 1) PG8_BAR; }
    }
    PG8_WAIT_V(0);
    if constexpr (!ALIGN_EPI) { if (wr == 0) PG8_BAR; }
    PG8_BAR;
    if constexpr (Epi::AFTER_DRAIN) { E.fused(acc, cur, wr, wc, fr, fq, lds, wid, lane); S.done(cur); }
#undef PG8_SA
#undef PG8_SB
#undef PG8_STAGE
#undef PG8_LDA
#undef PG8_LDB
#undef PG8_MMA
#undef PG8_WAIT_V
#undef PG8_WAIT_L
#undef PG8_BAR
#undef PG8_SCHED
}
}

constexpr int TP = 8192, TS = 512, T = TP + TS, DM = 2048, NSEQ = 132;
constexpr int NAB = 7424, NCD = 4864;
constexpr int NWAVES = 8, NTHR = 512;
constexpr size_t MiB = 1u << 20;
constexpr size_t WS_CTL = 0, CTL_ZERO_BYTES = 1 * MiB;
constexpr int CW_BAR = 4096, CW_CNT = 8192;
constexpr size_t WS_RSS = 65536;
constexpr size_t WS_WABIN = 2 * MiB, WS_WABOUT = 60 * MiB, WS_WCDIN = 76 * MiB, WS_WCDOUT = 114 * MiB, WS_WGATE = 130 * MiB, WS_WPROJ = 162 * MiB;
constexpr size_t WS_H = 166 * MiB, WS_XN = 234 * MiB, WS_YM = 268 * MiB, WS_PB = 302 * MiB, WS_U = 320 * MiB, WS_SCR = 444 * MiB, WS_END = 732 * MiB;
constexpr size_t SC_HB1 = 102 * MiB;
constexpr size_t SC_PP = 8 * MiB;
constexpr size_t SC_QN = 0, SC_KN = 2 * MiB, SC_VV = 4 * MiB, SC_GLOG = 6 * MiB, SC_BETA = 7 * MiB, SC_GDEC = 7 * MiB + 65536, SC_ODN = 102 * MiB, SC_OGLA = 136 * MiB,
    SC_DNOPS = 192 * MiB;
constexpr size_t SC_XBC = 0, SC_DT = 3 * MiB, SC_LA = 52 * MiB, SC_LB = 86 * MiB, SC_YS = 120 * MiB, SC_HS = 154 * MiB, SC_SSDOP = 192 * MiB, SC_XS = 270 * MiB;
constexpr int LDS_BYTES = 163840;
constexpr size_t O_Y_P = 0, O_Y_S = O_Y_P + (size_t)4 * 2048 * 2048, O_DN_P = O_Y_S + (size_t)128 * 4 * 2048,
    O_DNC_P = O_DN_P + (size_t)2 * 4 * 8 * 128 * 128, O_GLA_P = O_DNC_P + (size_t)2 * 4 * 3 * 3072, O_SSD_P = O_GLA_P + (size_t)2 * 4 * 4 * 128 * 256,
    O_SSDC_P = O_SSD_P + (size_t)2 * 4 * 16 * 64 * 64, O_LRU_P = O_SSDC_P + (size_t)2 * 4 * 3 * 1536, O_LRUC_P = O_LRU_P + (size_t)2 * 4 * 1024,
    O_DN_S = O_LRUC_P + (size_t)2 * 4 * 3 * 1024, O_DNC_S = O_DN_S + (size_t)2 * 128 * 8 * 128 * 128, O_GLA_S = O_DNC_S + (size_t)2 * 128 * 3 * 3072,
    O_SSD_S = O_GLA_S + (size_t)2 * 128 * 4 * 128 * 256, O_SSDC_S = O_SSD_S + (size_t)2 * 128 * 16 * 64 * 64, O_LRU_S = O_SSDC_S + (size_t)2 * 128 * 3 * 1536,
    O_LRUC_S = O_LRU_S + (size_t)2 * 128 * 1024, O_END = O_LRUC_S + (size_t)2 * 128 * 3 * 1024;
static_assert(O_END == 109064192, "output size");

#define LAS __attribute__((address_space(3)))
typedef unsigned short bf16;
typedef float f32x4 __attribute__((ext_vector_type(4)));
typedef unsigned u32x2 __attribute__((ext_vector_type(2)));
typedef unsigned u32x4 __attribute__((ext_vector_type(4)));
#define LDS_WAIT() asm volatile("s_waitcnt lgkmcnt(0)" ::: "memory")

__device__ __forceinline__ float bf2f(bf16 b) { return __uint_as_float(((unsigned)b) << 16); }
__device__ __forceinline__ unsigned f2bf(float f) { unsigned u = __float_as_uint(f); return (u + 0x7fffu + ((u >> 16) & 1u)) >> 16; }
__device__ __forceinline__ unsigned pk2(float lo, float hi) { return f2bf(lo) | (f2bf(hi) << 16); }
__device__ __forceinline__ float sigmoid_(float x) { return __builtin_amdgcn_rcpf(1.f + __expf(-x)); }
__device__ __forceinline__ float silu_(float x) { return x * __builtin_amdgcn_rcpf(1.f + __expf(-x)); }
__device__ __forceinline__ float softplus_(float x) { return x > 15.f ? x : (x < -15.f ? __expf(x) : __logf(1.f + __expf(x))); }
__device__ __forceinline__ float dpp_add(float v, float x) { return v + x; }
#define WS_DPP(v, ctrl, rmask) __builtin_bit_cast(float, __builtin_amdgcn_update_dpp(0, __builtin_bit_cast(int, (v)), (ctrl), (rmask), 0xf, false))
__device__ __forceinline__ float wave_sum(float v) {
    v += WS_DPP(v, 0xB1, 0xf);
    v += WS_DPP(v, 0x4E, 0xf);
    v += WS_DPP(v, 0x141, 0xf);
    v += WS_DPP(v, 0x140, 0xf);
    v += WS_DPP(v, 0x142, 0xa);
    v += WS_DPP(v, 0x143, 0xc);
    return __builtin_bit_cast(float, __builtin_amdgcn_readlane(__builtin_bit_cast(int, v), 63));
}
__device__ __forceinline__ void row_to_seq(int r, int& s, int& t) { if (r < TP) { s = r >> 11; t = r & 2047; } else { s = 4 + ((r - TP) >> 2); t = (r - TP) & 3; } }
__device__ __forceinline__ void seq_info(int s, int& row0, int& L) { if (s < 4) { row0 = s << 11; L = 2048; } else { row0 = TP + ((s - 4) << 2); L = 4; } }
__device__ __forceinline__ float pre_val(const bf16* U, int ldu, int ucol, int row0, int tt, int s, const float* stc, int W, int c) {
    const int tc = tt >= 0 ? tt : 0, sc = tt >= 0 ? 0 : 3 + tt;
    const float a = bf2f(U[(size_t)(row0 + tc) * ldu + ucol]), b = stc[((size_t)(s - 4) * 3 + sc) * W + c];
    return tt >= 0 ? a : b;
}
__device__ __forceinline__ int map_col(int mapid, int n) {
    if (mapid == 0) return n;
    if (mapid == 1) { if (n < 3072) return n; if (n < 6144) return n + 16; if (n < 7168) return n + 32; if (n < 7184) return n - 4096; if (n < 7200) return n - 1024; return -1; }
    if (n < 2560) return n; if (n < 4608) return n + 16; if (n < 4624) return n - 2048; return -1;
}
__device__ __forceinline__ void transpose_item(const float* W, int K, int Nsrc, bf16* WT, int Npad, int mapid, const float* gain, LAS float* scr, int item, int lane) {
    const int nblk = Npad / 64, kb = item / nblk, nb = item % nblk, k0 = 64 * kb, n0 = 64 * nb;
    const int n4 = (lane & 15) * 4, src = map_col(mapid, n0 + n4);
    const int srcc = src >= 0 ? src : 0; const float msk = src >= 0 ? 1.f : 0.f;
    f32x4 v[16];
#pragma unroll
    for (int i = 0; i < 16; ++i) v[i] = *(const f32x4*)(W + (size_t)(k0 + 4 * i + (lane >> 4)) * Nsrc + srcc);
    if (gain) {
#pragma unroll
        for (int i = 0; i < 16; ++i) v[i] = v[i] * (gain[k0 + 4 * i + (lane >> 4)] * msk);
    } else {
#pragma unroll
        for (int i = 0; i < 16; ++i) v[i] = v[i] * msk;
    }
#pragma unroll
    for (int i = 0; i < 16; ++i) { const int kk = 4 * i + (lane >> 4); scr[kk * 65 + n4] = v[i].x; scr[kk * 65 + n4 + 1] = v[i].y; scr[kk * 65 + n4 + 2] = v[i].z; scr[kk * 65 + n4 + 3] = v[i].w; }
    LDS_WAIT(); asm volatile("" ::: "memory");
    const int c = lane & 7;
#pragma unroll
    for (int jj = 0; jj < 8; ++jj) { const int n = (lane >> 3) + 8 * jj; const LAS float* p = scr + (8 * c) * 65 + n;
        u32x4 o; o.x = pk2(p[0 * 65], p[1 * 65]); o.y = pk2(p[2 * 65], p[3 * 65]); o.z = pk2(p[4 * 65], p[5 * 65]); o.w = pk2(p[6 * 65], p[7 * 65]);
        *(u32x4*)(WT + (size_t)(n0 + n) * K + k0 + 8 * c) = o; }
    LDS_WAIT(); asm volatile("" ::: "memory");
}
__device__ __forceinline__ void norm_row_bf16(const f32x4 (&v)[8], const float* g, bf16* orow, int lane) {
    float ss = 0.f;
#pragma unroll
    for (int j = 0; j < 8; ++j) ss += (v[j].x * v[j].x + v[j].y * v[j].y) + (v[j].z * v[j].z + v[j].w * v[j].w);
    const float rstd = rsqrtf(wave_sum(ss) * (1.f / DM) + 1e-6f);
#pragma unroll
    for (int j = 0; j < 8; ++j) { const int col = 4 * (lane + 64 * j); const f32x4 gg = *(const f32x4*)(g + col);
        u32x2 o; o.x = pk2(v[j].x * rstd * gg.x, v[j].y * rstd * gg.y); o.y = pk2(v[j].z * rstd * gg.z, v[j].w * rstd * gg.w);
        *(u32x2*)(orow + col) = o; }
}

typedef __bf16 bf16x2_t __attribute__((ext_vector_type(2)));
typedef float f32x2_t __attribute__((ext_vector_type(2)));
typedef short bf16x8 __attribute__((ext_vector_type(8)));
typedef float f32x16 __attribute__((ext_vector_type(16)));
__device__ __forceinline__ unsigned cvtpk(float lo, float hi) { f32x2_t v = {lo, hi}; bf16x2_t b = __builtin_convertvector(v, bf16x2_t); return __builtin_bit_cast(unsigned, b); }
#define MFMA32(a, b, c) __builtin_amdgcn_mfma_f32_32x32x16_bf16((a), (b), (c), 0, 0, 0)
#define PACK_ACC(x, S_) __builtin_bit_cast(bf16x8, (u32x4){cvtpk((x)[8 * (S_)], (x)[8 * (S_) + 1]), cvtpk((x)[8 * (S_) + 2], (x)[8 * (S_) + 3]), cvtpk((x)[8 * (S_) + 4], (x)[8 * (S_) + 5]), cvtpk((x)[8 * (S_) + 6], (x)[8 * (S_) + 7])})
__device__ __forceinline__ int crow(int reg, int h) { return (reg & 3) + 8 * (reg >> 2) + 4 * h; }
__device__ __forceinline__ bf16x8 pack8(const float (&v)[8]) { return __builtin_bit_cast(bf16x8, (u32x4){cvtpk(v[0], v[1]), cvtpk(v[2], v[3]), cvtpk(v[4], v[5]), cvtpk(v[6], v[7])}); }

#define XB_TMO      128
#define XB_XCNT(j)  (256  + 64 * (j))
#define XB_XSUB(j)  (1280 + 64 * (j))
#define XB_XGEN(j)  (2304 + 64 * (j))
#define XB_TOP      3328
#define XB_TOPGEN   3392
#define XCD_BAR_WORDS 3456
#define XB_SPIN_CAP (1u << 18)

__device__ __forceinline__ unsigned xb_ld(unsigned* p)              { return __hip_atomic_load(p, __ATOMIC_RELAXED, __HIP_MEMORY_SCOPE_AGENT); }
__device__ __forceinline__ unsigned xb_add(unsigned* p, unsigned v) { return __hip_atomic_fetch_add(p, v, __ATOMIC_RELAXED, __HIP_MEMORY_SCOPE_AGENT); }
__device__ __forceinline__ unsigned xb_xcc_id() { return (unsigned)__builtin_amdgcn_s_getreg((3 << 11) | 20) & 0xFu; }
#define XB_SPIN(cond, bar) do { unsigned _sp = 0; while (cond) { __builtin_amdgcn_s_sleep(1); \
    if ((++_sp & 255u) == 0u) { if (xb_ld(&(bar)[XB_TMO])) break; if (_sp > XB_SPIN_CAP) { atomicAdd(&(bar)[XB_TMO], 1u); break; } } } } while (0)

struct XcdBarrier {
    unsigned* bar; unsigned x;
    volatile LAS unsigned* st;
};

__device__ __forceinline__ XcdBarrier xcd_barrier_post(unsigned* bar, volatile LAS unsigned* st) {
    XcdBarrier b; b.bar = bar; b.x = xb_xcc_id(); b.st = st;
    if (threadIdx.x == 0) (void)xb_add(&bar[XB_XCNT(b.x)], 1u);
    return b;
}
__device__ __forceinline__ void xcd_barrier_complete(unsigned* bar, unsigned x, unsigned& nloc, unsigned& nx) {
    const unsigned G = gridDim.x * gridDim.y * gridDim.z;
    unsigned sum, cnt, mine, sp = 0u;
    for (;;) {
        sum = 0u; cnt = 0u; mine = 0u;
#pragma unroll
        for (unsigned j = 0; j < 16; ++j) { const unsigned c = xb_ld(&bar[XB_XCNT(j)]); sum += c; cnt += (c > 0u) ? 1u : 0u; mine = (j == x) ? c : mine; }
        if (sum == G) break;
        __builtin_amdgcn_s_sleep(1);
        if ((++sp & 255u) == 0u) { if (xb_ld(&bar[XB_TMO])) break; if (sp > XB_SPIN_CAP) { atomicAdd(&bar[XB_TMO], 1u); break; } }
    }
    nloc = mine > 0u ? mine : 1u; nx = cnt > 0u ? cnt : 1u;
}

__device__ __forceinline__ void xcd_barrier(const XcdBarrier& b) {
    asm volatile("s_waitcnt vmcnt(0)" ::: "memory");
    __syncthreads();
    if (threadIdx.x == 0) {
        unsigned* bar = b.bar;
        __builtin_amdgcn_s_waitcnt(0);
        unsigned nloc = b.st[0], nx = b.st[1];
        if (nloc == 0u) { xcd_barrier_complete(bar, b.x, nloc, nx); b.st[0] = nloc; b.st[1] = nx; }
        const unsigned old = xb_add(&bar[XB_XSUB(b.x)], 1u);
        const unsigned gen = old / nloc;
        if (old + 1u == (gen + 1u) * nloc) {
            __builtin_amdgcn_fence(__ATOMIC_RELEASE, "agent");
            asm volatile("s_waitcnt vmcnt(0)" ::: "memory");
            const unsigned og = xb_add(&bar[XB_TOP], 1u);
            const unsigned tg = og / nx;
            if (og + 1u == (tg + 1u) * nx) xb_add(&bar[XB_TOPGEN], 1u);
            else XB_SPIN(xb_ld(&bar[XB_TOPGEN]) == tg, bar);
            __builtin_amdgcn_fence(__ATOMIC_ACQUIRE, "agent");
            xb_add(&bar[XB_XGEN(b.x)], 1u);
            asm volatile("s_waitcnt vmcnt(0)" ::: "memory");
        } else {
            XB_SPIN(xb_ld(&bar[XB_XGEN(b.x)]) == gen, bar);
            __builtin_amdgcn_fence(__ATOMIC_ACQUIRE, "agent");
            asm volatile("s_waitcnt vmcnt(0)" ::: "memory");
        }
    }
    __syncthreads();
}


#ifdef PROBE_SEC
#define SEC_BEGIN(id) unsigned long long _sec_t##id = 0; if ((id) == PROBE_SEC) { __builtin_amdgcn_s_barrier(); _sec_t##id = __builtin_amdgcn_s_memrealtime(); }
#define SEC_END(id, ldsp) if ((id) == PROBE_SEC) { __builtin_amdgcn_s_barrier(); if (threadIdx.x == 0) { volatile LAS unsigned long long* a_ = (volatile LAS unsigned long long*)((ldsp) + LDS_BYTES - 32); a_[0] = a_[0] + (__builtin_amdgcn_s_memrealtime() - _sec_t##id); } }
#define SECW_BEGIN(id) unsigned long long _secw_t##id = 0; if ((id) == PROBE_SEC) { _secw_t##id = __builtin_amdgcn_s_memrealtime(); }
#define SECW_END(id, ldsp, tsel) if ((id) == PROBE_SEC) { asm volatile("s_waitcnt vmcnt(0) lgkmcnt(0)" ::: "memory"); if (threadIdx.x == (tsel)) { volatile LAS unsigned long long* a_ = (volatile LAS unsigned long long*)((ldsp) + LDS_BYTES - 32); a_[0] = a_[0] + (__builtin_amdgcn_s_memrealtime() - _secw_t##id); } }
#else
#define SEC_BEGIN(id)
#define SEC_END(id, ldsp)
#define SECW_BEGIN(id)
#define SECW_END(id, ldsp, tsel)
#endif
struct Args { const float* in[40]; float* out; unsigned char* ws; int ph_lo, ph_hi; };
constexpr int N_PHASES = 26, SUBS = 6;
#ifndef PH_MASK
#define PH_MASK 16383
#endif
#define AS4 __attribute__((address_space(4)))
struct KP { const char AS4* p;
    __device__ __forceinline__ const float* in(int i) const { return *(const float* const AS4*)(p + 8 * i); }
    __device__ __forceinline__ float* out() const { return *(float* const AS4*)(p + 320); }
    __device__ __forceinline__ unsigned char* ws() const { return *(unsigned char* const AS4*)(p + 328); }
};
static_assert(sizeof(Args) == 344, "Args layout");

__device__ __forceinline__ void phase_prologue(const KP kp, LAS unsigned char* lds, int gw, int NGW, int wave, int lane) {
    unsigned char* ws = kp.ws();
    LAS float* scr = (LAS float*)(lds + wave * 17408);
    SEC_BEGIN(1)
    SEC_BEGIN(14)
    for (int job = 0; job < 16; ++job) {
        if (job == 2) { SEC_END(14, lds) }
        const float* W; int K = 2048, Nsrc = 2048, Npad = 2048, mapid = 0; bf16* WT; const float* gain = nullptr;
        if (job < 2)       { W = kp.in(13) + (size_t)job * 2048 * 7200; Nsrc = 7200; Npad = NAB; mapid = 1; WT = (bf16*)(ws + WS_WABIN) + (size_t)job * NAB * 2048; gain = kp.in(11) + (size_t)(2 * job) * DM; }
        else if (job < 4)  { W = kp.in(21) + (size_t)(job - 2) * 2048 * 2048; WT = (bf16*)(ws + WS_WABOUT) + (size_t)(job - 2) * 2048 * 2048; }
        else if (job < 6)  { W = kp.in(22) + (size_t)(job - 4) * 2048 * 4624; Nsrc = 4624; Npad = NCD; mapid = 2; WT = (bf16*)(ws + WS_WCDIN) + (size_t)(job - 4) * NCD * 2048; gain = kp.in(11) + (size_t)(2 * (job - 4) + 1) * DM; }
        else if (job < 8)  { W = kp.in(36) + (size_t)(job - 6) * 2048 * 2048; WT = (bf16*)(ws + WS_WCDOUT) + (size_t)(job - 6) * 2048 * 2048; }
        else if (job < 12) { W = kp.in(39) + (size_t)(job - 8) * 2048 * 2048; WT = (bf16*)(ws + WS_WGATE) + (size_t)(job - 8) * 2048 * 2048; gain = kp.in(38) + (size_t)(job - 8) * DM; }
        else               { W = kp.in(37) + (size_t)(job - 12) * 256 * 2048; K = 256; WT = (bf16*)(ws + WS_WPROJ) + (size_t)(job - 12) * 2048 * 256; }
        const int nitems = (K / 64) * (Npad / 64), nblocks = NGW / NWAVES, ipb = (nitems + nblocks - 1) / nblocks, ib = (gw / NWAVES) * ipb, ie = ib + ipb < nitems ? ib + ipb : nitems;
        for (int it = ib + wave; it < ie; it += NWAVES) transpose_item(W, K, Nsrc, WT, Npad, mapid, gain, scr, it, lane);
    }
    SEC_END(1, lds)
    SEC_BEGIN(2)
    bf16* HB = (bf16*)(ws + WS_XN); float* RSS = (float*)(ws + WS_RSS);
    for (int m = gw; m < T; m += NGW) {
        const float* src = m < TP ? kp.in(0) + (size_t)m * DM : kp.in(1) + (size_t)(m - TP) * DM;
        float ss = 0.f;
#pragma unroll
        for (int jj = 0; jj < 8; ++jj) { const int col = 4 * (lane + 64 * jj); const f32x4 v = *(const f32x4*)(src + col);
            u32x2 o; o.x = pk2(v.x, v.y); o.y = pk2(v.z, v.w); *(u32x2*)(HB + (size_t)m * DM + col) = o; ss += (v.x * v.x + v.y * v.y) + (v.z * v.z + v.w * v.w); }
        ss = wave_sum(ss); if (lane == 0) RSS[m] = ss;
    }
    bf16* PB = (bf16*)(ws + WS_PB);
    const int gt = gw * 64 + lane, NGT = NGW * 64;
    for (int i = gt; i < 4 * T * 64; i += NGT) {
        const int c4 = i & 63, rr = i >> 6, li = rr / T, r = rr - li * T;
        const float* src = r < TP ? kp.in(9) + ((size_t)li * TP + r) * 256 + 4 * c4 : kp.in(10) + ((size_t)li * TS + (r - TP)) * 256 + 4 * c4;
        const f32x4 v = *(const f32x4*)src;
        u32x2 o; o.x = pk2(v.x, v.y); o.y = pk2(v.z, v.w);
        *(u32x2*)(PB + ((size_t)li * T + r) * 256 + 4 * c4) = o;
    }
    SEC_END(2, lds)
}
__device__ __forceinline__ void phase_final(const KP kp, int gw, int NGW, int lane) {
    const bf16* HB = (const bf16*)(kp.ws() + WS_XN); const float* RSS = (const float*)(kp.ws() + WS_RSS) + (size_t)8 * T; const float* g = kp.in(12); float* out = kp.out();
    for (int m = gw; m < T; m += NGW) { const float rstd = rsqrtf(RSS[m] * (1.f / DM) + 1e-6f);
#pragma unroll
        for (int jj = 0; jj < 8; ++jj) { const int col = 4 * (lane + 64 * jj); const u32x2 hv = *(const u32x2*)(HB + (size_t)m * DM + col); const f32x4 gg = *(const f32x4*)(g + col);
            f32x4 o; o.x = __uint_as_float(hv.x << 16) * rstd * gg.x; o.y = __uint_as_float(hv.x & 0xffff0000u) * rstd * gg.y; o.z = __uint_as_float(hv.y << 16) * rstd * gg.z; o.w = __uint_as_float(hv.y & 0xffff0000u) * rstd * gg.w;
            *(f32x4*)(out + (size_t)m * DM + col) = o; } }
}

__device__ __forceinline__ void phase_ab_pre(const KP kp, const int bid, const int G, int j, int tid, int wave, int lane) {
    unsigned char* scr = kp.ws() + WS_SCR; const bf16* U = (const bf16*)(kp.ws() + WS_U);
    float* QN = (float*)(scr + SC_QN) - (size_t)TP * 1024; float* KN = (float*)(scr + SC_KN) - (size_t)TP * 1024; float* VV = (float*)(scr + SC_VV) - (size_t)TP * 1024;
    float* GLOG = (float*)(scr + SC_GLOG) - (size_t)TP * 512; float* BETA = (float*)(scr + SC_BETA) - (size_t)TP * 8; float* GDEC = (float*)(scr + SC_GDEC) - (size_t)TP * 8;
    const float* cw = kp.in(14) + (size_t)j * 4 * 3072; const float* stc = kp.in(3) + (size_t)j * 128 * 3 * 3072;
    const float* wa2 = kp.in(18) + (size_t)j * 16 * 512; const float* ba = kp.in(19) + (size_t)j * 512;
    for (int r = TP + bid; r < T; r += G) {
        int s, t; row_to_seq(r, s, t); const int row0 = r - t;
#pragma unroll
        for (int part = 0; part < 3; ++part) {
            float val[2];
#pragma unroll
            for (int i = 0; i < 2; ++i) { const int c = part * 1024 + wave * 128 + lane + 64 * i; float acc = 0.f;
#pragma unroll
                for (int tap = 0; tap < 4; ++tap) acc += cw[tap * 3072 + c] * pre_val(U, NAB, c, row0, t - 3 + tap, s, stc, 3072, c);
                val[i] = silu_(acc); }
            if (part < 2) { const float ss = wave_sum(val[0] * val[0] + val[1] * val[1]); const float sc = rsqrtf(ss + 1e-6f) * (part == 0 ? 0.08838834764831845f : 1.f); val[0] *= sc; val[1] *= sc; }
            float* dst = part == 0 ? QN : (part == 1 ? KN : VV);
            dst[(size_t)r * 1024 + wave * 128 + lane] = val[0]; dst[(size_t)r * 1024 + wave * 128 + lane + 64] = val[1];
        }
        if (tid < 8) {
            BETA[(size_t)r * 8 + tid] = sigmoid_(bf2f(U[(size_t)r * NAB + 7168 + tid]));
            GDEC[(size_t)r * 8 + tid] = -__expf(kp.in(15)[j * 8 + tid]) * softplus_(bf2f(U[(size_t)r * NAB + 7176 + tid]) + kp.in(16)[j * 8 + tid]);
        }
        { float x = ba[tid];
#pragma unroll
          for (int rr = 0; rr < 16; ++rr) x += bf2f(U[(size_t)r * NAB + 7184 + rr]) * wa2[rr * 512 + tid];
          GLOG[(size_t)r * 512 + tid] = -softplus_(-x) * (1.f / 16.f); }
    }
}


constexpr size_t GLA_ITEM_BYTES = 74752, WS_GLAOPS = WS_H;
__device__ __forceinline__ void phase_gla_prep(const KP kp, const int bid, const int G, int j, LAS unsigned char* lds, int tid0) {
    const bf16* U = (const bf16*)(kp.ws() + WS_U);
    const float* wa2 = kp.in(18) + (size_t)j * 16 * 512; const float* ba = kp.in(19) + (size_t)j * 512;
    unsigned char* OPS = kp.ws() + WS_GLAOPS;
    LAS float* GE = (LAS float*)lds; LAS float* Pg = GE + 128;
    LAS bf16* Qg = (LAS bf16*)(Pg + 512); LAS bf16* Ka = Qg + 64 * 136; LAS float* QKm = (LAS float*)(Ka + 64 * 136);
    for (int item = bid; item < 512; item += G) {
        int tid = tid0; asm volatile("" : "+v"(tid));
        const int lane = tid & 63, r = lane & 31, hp = lane >> 5, wave = tid >> 6;
        const int b = item >> 7, n = (item >> 2) & 31, h = item & 3;
        const int row0 = b * 2048 + n * 64;
        __syncthreads();
        const int d = tid & 127, tg = tid >> 7, t0 = 16 * tg;
        float q[16], k[16], gl[16];
        { float w[16];
#pragma unroll
          for (int rr = 0; rr < 16; ++rr) w[rr] = wa2[rr * 512 + h * 128 + d];
          const float bias = ba[h * 128 + d];
#pragma unroll
          for (int t = 0; t < 16; ++t) { const size_t ro = (size_t)(row0 + t0 + t) * NAB;
              q[t] = bf2f(U[ro + 4096 + h * 128 + d]) * 0.08838834764831845f; k[t] = bf2f(U[ro + 4608 + h * 128 + d]);
              const u32x4 g0 = *(const u32x4*)(U + ro + 7184), g1 = *(const u32x4*)(U + ro + 7192);
              float x = bias;
              x += __uint_as_float(g0.x << 16) * w[0] + __uint_as_float(g0.x & 0xffff0000u) * w[1] + __uint_as_float(g0.y << 16) * w[2] + __uint_as_float(g0.y & 0xffff0000u) * w[3];
              x += __uint_as_float(g0.z << 16) * w[4] + __uint_as_float(g0.z & 0xffff0000u) * w[5] + __uint_as_float(g0.w << 16) * w[6] + __uint_as_float(g0.w & 0xffff0000u) * w[7];
              x += __uint_as_float(g1.x << 16) * w[8] + __uint_as_float(g1.x & 0xffff0000u) * w[9] + __uint_as_float(g1.y << 16) * w[10] + __uint_as_float(g1.y & 0xffff0000u) * w[11];
              x += __uint_as_float(g1.z << 16) * w[12] + __uint_as_float(g1.z & 0xffff0000u) * w[13] + __uint_as_float(g1.w << 16) * w[14] + __uint_as_float(g1.w & 0xffff0000u) * w[15];
              gl[t] = -softplus_(-x) * (1.f / 16.f); } }
#pragma unroll
        for (int t = 1; t < 16; ++t) gl[t] += gl[t - 1];
        Pg[tg * 128 + d] = gl[15];
        __syncthreads();
        { float off = 0.f;
#pragma unroll
          for (int g = 0; g < 3; ++g) off += (g < tg) ? Pg[g * 128 + d] : 0.f;
          if (tg == 3) GE[d] = gl[15] + off;
#pragma unroll
          for (int t = 0; t < 16; ++t) { const float Gt = gl[t] + off; Qg[(t0 + t) * 136 + d] = (bf16)f2bf(q[t] * __expf(Gt)); Ka[(t0 + t) * 136 + d] = (bf16)f2bf(k[t] * __expf(-Gt)); } }
        __syncthreads();
        bf16x8* base = (bf16x8*)(OPS + (size_t)item * GLA_ITEM_BYTES);
        if (wave < 4) {
            const int mt = wave >> 1, nt = wave & 1;
            f32x16 acc;
#pragma unroll
            for (int i = 0; i < 16; ++i) acc[i] = 0.f;
#pragma unroll
            for (int ks = 0; ks < 8; ++ks) acc = MFMA32(*(const LAS bf16x8*)(Qg + (32 * mt + r) * 136 + 16 * ks + 8 * hp), *(const LAS bf16x8*)(Ka + (32 * nt + r) * 136 + 16 * ks + 8 * hp), acc);
            const int jt = 32 * nt + r;
#pragma unroll
            for (int i16 = 0; i16 < 16; ++i16) { const int i = 32 * mt + crow(i16, hp); QKm[i * 65 + jt] = jt <= i ? acc[i16] : 0.f; }
        } else {
            const int w4 = wave - 4;
#pragma unroll
            for (int q8 = 0; q8 < 8; ++q8) { const int f = w4 + 4 * q8, nt = f >> 2, ks = f & 3, p = 32 * nt + r;
                unsigned w[4];
#pragma unroll
                for (int jp = 0; jp < 8; jp += 2) { const int tk = 16 * ks + 8 * (jp >> 2) + 4 * hp + (jp & 3);
                    w[jp >> 1] = (unsigned)U[(size_t)(row0 + tk) * NAB + 5120 + h * 256 + p] | ((unsigned)U[(size_t)(row0 + tk + 1) * NAB + 5120 + h * 256 + p] << 16); }
                base[(40 + f) * 64 + lane] = __builtin_bit_cast(bf16x8, (u32x4){w[0], w[1], w[2], w[3]}); }
        }
        __syncthreads();
        float v[8];
#pragma unroll
        for (int q2 = 0; q2 < 2; ++q2) { const int f = wave + 8 * q2;
            { const int mt = f >> 3, ks = f & 7, i = 32 * mt + r;
              const u32x2 lo = *(const LAS u32x2*)(Qg + i * 136 + 16 * ks + 4 * hp), hi = *(const LAS u32x2*)(Qg + i * 136 + 16 * ks + 8 + 4 * hp);
              base[f * 64 + lane] = __builtin_bit_cast(bf16x8, (u32x4){lo.x, lo.y, hi.x, hi.y}); }
            { const int mt = f >> 2, ks = f & 3, dd = 32 * mt + r; const float eg = __expf(GE[dd]);
#pragma unroll
              for (int jp = 0; jp < 8; ++jp) v[jp] = bf2f(Ka[(16 * ks + 8 * (jp >> 2) + 4 * hp + (jp & 3)) * 136 + dd]) * eg;
              base[(16 + f) * 64 + lane] = pack8(v); } }
        { const int f = wave, mt = f >> 2, ks = f & 3, i = 32 * mt + r;
#pragma unroll
          for (int jp = 0; jp < 8; ++jp) v[jp] = QKm[i * 65 + 16 * ks + 8 * (jp >> 2) + 4 * hp + (jp & 3)];
          base[(32 + f) * 64 + lane] = pack8(v); }
        if (tid < 128) ((float*)(base + 72 * 64))[tid] = __expf(GE[tid]);
    }
}

constexpr size_t DN_ITEM_BYTES = 74752;
__device__ __forceinline__ void phase_dn_prep(const KP kp, const int bid, const int G, int j, LAS unsigned char* lds, int tid0) {
    unsigned char* scr = kp.ws() + WS_SCR;
    const bf16* U = (const bf16*)(kp.ws() + WS_U); const float* cw = kp.in(14) + (size_t)j * 4 * 3072;
    unsigned char* OPS = scr + SC_DNOPS;
    LAS float* AMT = (LAS float*)lds; LAS float* GLs = AMT + 64 * 68; LAS float* BLs = GLs + 64; LAS float* SS = BLs + 64;
    LAS bf16* Kb = (LAS bf16*)(SS + 256); LAS bf16* Qb = Kb + 64 * 136; LAS float* QKm = (LAS float*)(Qb + 64 * 136); LAS float* XL = QKm + 64 * 65;
    for (int item = bid; item < 1024; item += G) {
        int tid = tid0; asm volatile("" : "+v"(tid));
        const int lane = tid & 63, r = lane & 31, hp = lane >> 5, wave = tid >> 6;
        const int b = item >> 8, n = (item >> 3) & 31, h = item & 7;
        const int row0 = b * 2048 + n * 64;
        __syncthreads();
        SEC_BEGIN(20)
        {
          const int t0 = 8 * wave; const bool first = (n == 0 && wave == 0);
          const long fo = first ? 0 : (long)NAB;
          float qa[8], qb[8], ka[8], kb[8];
#pragma unroll
          for (int part = 0; part < 3; ++part) { const int c = part * 1024 + h * 128 + 2 * lane;
              const float w0a = cw[c], w0b = cw[c + 1], w1a = cw[3072 + c], w1b = cw[3072 + c + 1], w2a = cw[2 * 3072 + c], w2b = cw[2 * 3072 + c + 1], w3a = cw[3 * 3072 + c], w3b = cw[3 * 3072 + c + 1];
              const bf16* up = U + (size_t)(row0 + t0) * NAB + c;
              unsigned raw[11];
              raw[0] = *(const unsigned*)(up - 3 * fo); raw[1] = *(const unsigned*)(up - 2 * fo); raw[2] = *(const unsigned*)(up - 1 * fo);
#pragma unroll
              for (int t = 0; t < 8; ++t) raw[3 + t] = *(const unsigned*)(up + (size_t)t * NAB);
              if (first) { raw[0] = 0u; raw[1] = 0u; raw[2] = 0u; }
#pragma unroll
              for (int t = 0; t < 8; ++t) {
                  const float ya = silu_(w0a * __uint_as_float(raw[t] << 16) + w1a * __uint_as_float(raw[t + 1] << 16) + w2a * __uint_as_float(raw[t + 2] << 16) + w3a * __uint_as_float(raw[t + 3] << 16));
                  const float yb = silu_(w0b * __uint_as_float(raw[t] & 0xffff0000u) + w1b * __uint_as_float(raw[t + 1] & 0xffff0000u) + w2b * __uint_as_float(raw[t + 2] & 0xffff0000u) + w3b * __uint_as_float(raw[t + 3] & 0xffff0000u));
                  if (part == 0) { qa[t] = ya; qb[t] = yb; } else if (part == 1) { ka[t] = ya; kb[t] = yb; } else { XL[(t0 + t) * 257 + 2 * lane] = ya; XL[(t0 + t) * 257 + 2 * lane + 1] = yb; } } }
#pragma unroll
          for (int t = 0; t < 8; ++t) { const float scq = rsqrtf(wave_sum(qa[t] * qa[t] + qb[t] * qb[t]) + 1e-6f) * 0.08838834764831845f, sck = rsqrtf(wave_sum(ka[t] * ka[t] + kb[t] * kb[t]) + 1e-6f);
              *(LAS unsigned*)(Qb + (t0 + t) * 136 + 2 * lane) = pk2(qa[t] * scq, qb[t] * scq); *(LAS unsigned*)(Kb + (t0 + t) * 136 + 2 * lane) = pk2(ka[t] * sck, kb[t] * sck); } }
        if (wave == 0) { const size_t ro = (size_t)(row0 + lane) * NAB;
            float gv = -__expf(kp.in(15)[j * 8 + h]) * softplus_(bf2f(U[ro + 7176 + h]) + kp.in(16)[j * 8 + h]);
#pragma unroll
            for (int o = 1; o < 64; o <<= 1) { const float tt = __shfl_up(gv, o); if (lane >= o) gv += tt; }
            GLs[lane] = gv; BLs[lane] = sigmoid_(bf2f(U[ro + 7168 + h])); }
        __syncthreads();
        SEC_END(20, lds)
        SEC_BEGIN(21)
        SEC_END(21, lds)
        SEC_BEGIN(22)
        bf16x8* base = (bf16x8*)(OPS + (size_t)item * DN_ITEM_BYTES);
        { const int which = wave >> 2, mt = (wave >> 1) & 1, nt = wave & 1;
          const LAS bf16* Asrc = which ? Qb : Kb;
          f32x16 acc;
#pragma unroll
          for (int i = 0; i < 16; ++i) acc[i] = 0.f;
#pragma unroll
          for (int ks = 0; ks < 8; ++ks) acc = MFMA32(*(const LAS bf16x8*)(Asrc + (32 * mt + r) * 136 + 16 * ks + 8 * hp), *(const LAS bf16x8*)(Kb + (32 * nt + r) * 136 + 16 * ks + 8 * hp), acc);
          const int jt = 32 * nt + r; const float gj = GLs[jt];
#pragma unroll
          for (int i16 = 0; i16 < 16; ++i16) { const int i = 32 * mt + crow(i16, hp); const float dec = __expf(GLs[i] - gj);
              if (which == 0) AMT[jt * 68 + i] = jt < i ? BLs[i] * acc[i16] * dec : 0.f; else QKm[i * 65 + jt] = jt <= i ? acc[i16] * dec : 0.f; } }
        __syncthreads();
        SEC_END(22, lds)
        SEC_BEGIN(23)
        if (tid < 256) {
            SECW_BEGIN(25)
            const int c = tid;
#pragma unroll
            for (int bi = 0; bi < 4; ++bi) {
                float acc[16];
#pragma unroll
                for (int ii = 0; ii < 16; ++ii) { const int i = 16 * bi + ii; const float be = BLs[i];
                    acc[ii] = c < 128 ? be * XL[i * 257 + c] : be * __expf(GLs[i]) * bf2f(Kb[i * 136 + (c - 128)]); }
#pragma unroll 4
                for (int jj = 0; jj < 16 * bi; ++jj) { const float xj = XL[jj * 257 + c];
#pragma unroll
                    for (int q = 0; q < 4; ++q) { const f32x4 a = *(const LAS f32x4*)(AMT + jj * 68 + 16 * bi + 4 * q);
                        acc[4 * q + 0] -= a[0] * xj; acc[4 * q + 1] -= a[1] * xj; acc[4 * q + 2] -= a[2] * xj; acc[4 * q + 3] -= a[3] * xj; } }
                float dg[120];
#pragma unroll
                for (int ii = 1; ii < 16; ++ii)
#pragma unroll
                    for (int jj = 0; jj < ii; ++jj) dg[ii * (ii - 1) / 2 + jj] = AMT[(16 * bi + jj) * 68 + 16 * bi + ii];
#pragma unroll
                for (int ii = 0; ii < 16; ++ii) { float x = acc[ii];
#pragma unroll
                    for (int jj = 0; jj < ii; ++jj) x -= dg[ii * (ii - 1) / 2 + jj] * acc[jj];
                    acc[ii] = x; }
#pragma unroll
                for (int ii = 0; ii < 16; ++ii) XL[(16 * bi + ii) * 257 + c] = acc[ii];
            }
            SECW_END(25, lds, 0)
        } else {
            SECW_BEGIN(26)
            const int w4 = wave - 4; float v[8];
#pragma unroll
            for (int q = 0; q < 4; ++q) { const int f = w4 + 4 * q;
                { const int mt = f >> 3, ks = f & 7, i = 32 * mt + r; const float eg = __expf(GLs[i]);
                  const bf16x8 qq = *(const LAS bf16x8*)(Qb + i * 136 + 16 * ks + 8 * hp);
#pragma unroll
                  for (int jp = 0; jp < 8; ++jp) v[jp] = bf2f(Qb[i * 136 + 16 * ks + 8 * (jp >> 2) + 4 * hp + (jp & 3)]) * eg;
                  (void)qq; base[(16 + f) * 64 + lane] = pack8(v); }
                { const int mt = f >> 2, ks = f & 3, d = 32 * mt + r; const float Gend = GLs[63];
#pragma unroll
                  for (int jp = 0; jp < 8; ++jp) { const int tk = 16 * ks + 8 * (jp >> 2) + 4 * hp + (jp & 3); v[jp] = bf2f(Kb[tk * 136 + d]) * __expf(Gend - GLs[tk]); }
                  base[(32 + f) * 64 + lane] = pack8(v); } }
#pragma unroll
            for (int q = 0; q < 2; ++q) { const int f = w4 + 4 * q, mt = f >> 2, ks = f & 3, i = 32 * mt + r;
#pragma unroll
                for (int jp = 0; jp < 8; ++jp) v[jp] = QKm[i * 65 + 16 * ks + 8 * (jp >> 2) + 4 * hp + (jp & 3)];
                base[(48 + f) * 64 + lane] = pack8(v); }
            if (tid == 256) *(float*)(base + 72 * 64) = __expf(GLs[63]);
            SECW_END(26, lds, 256)
        }
        __syncthreads();
        SEC_END(23, lds)
        SEC_BEGIN(24)
        float v[8];
#pragma unroll
        for (int q = 0; q < 2; ++q) { const int f = wave + 8 * q;
            { const int mt = f >> 3, ks = f & 7, i = 32 * mt + r;
#pragma unroll
              for (int jp = 0; jp < 8; ++jp) v[jp] = -XL[i * 257 + 128 + 16 * ks + 8 * (jp >> 2) + 4 * hp + (jp & 3)];
              base[f * 64 + lane] = pack8(v); }
            { const int pq = f & 1, tl = f >> 1, mt = tl >> 2, nt = tl & 3;
#pragma unroll
              for (int e = 0; e < 8; ++e) v[e] = XL[(32 * mt + crow(8 * pq + e, hp)) * 257 + 32 * nt + r];
              base[(56 + f) * 64 + lane] = pack8(v); } }
        SEC_END(24, lds)
    }
}

__device__ __forceinline__ void phase_ab_rec(const KP kp, const int bid, const int G, int j, int li, LAS unsigned char* lds, int tid0) {
    unsigned char* scr = kp.ws() + WS_SCR; const bf16* U = (const bf16*)(kp.ws() + WS_U);
    float* ODN = (float*)(scr + SC_ODN); float* OGLA = (float*)(scr + SC_OGLA);
    SEC_BEGIN(12)
    for (int item = bid; item < 64; item += G) {
        int tid = tid0; asm volatile("" : "+v"(tid));
        int s, h; bool isdn; int half = -1;
        if (item < 32) { isdn = false; s = item >> 3; h = (item >> 1) & 3; half = item & 1; }
        else if (item < 64) { isdn = true; s = (item - 32) >> 3; h = (item - 32) & 7; half = -2; }
        else if (item < 1088) { isdn = true; s = 4 + ((item - 64) >> 3); h = (item - 64) & 7; }
        else { isdn = false; s = 4 + ((item - 1088) >> 2); h = (item - 1088) & 3; }
        int row0, L; seq_info(s, row0, L);
        __syncthreads();
        if (half == -2) {
            const int wave = __builtin_amdgcn_readfirstlane(tid >> 6), lane = tid & 63, r = lane & 31, hp = lane >> 5;
            const int b = s, nt = wave;
            const unsigned char* OPS = scr + SC_DNOPS;
            constexpr int DBUF = 73 * 1024;
#define DN_DMA(n_, bufi_) do { const unsigned char* gi_ = OPS + (size_t)((b * 32 + (n_)) * 8 + h) * DN_ITEM_BYTES + lane * 16; \
                _Pragma("unroll") for (int q_ = 0; q_ < 10; ++q_) { const int lf_ = wave + 8 * q_; if (lf_ < 73) \
                    __builtin_amdgcn_global_load_lds((const unsigned*)(gi_ + lf_ * 1024), (LAS unsigned*)(lds + (bufi_) * DBUF + lf_ * 1024), 16, 0, 2); } } while (0)
            f32x16 S0, S1, S2, S3;
#pragma unroll
            for (int i = 0; i < 16; ++i) { S0[i] = 0.f; S1[i] = 0.f; S2[i] = 0.f; S3[i] = 0.f; }
            DN_DMA(0, 0);
            asm volatile("s_waitcnt vmcnt(0)" ::: "memory"); __syncthreads();
            for (int n = 0; n < 32; ++n) {
                if (n + 1 < 32) DN_DMA(n + 1, (n + 1) & 1);
                if (wave < 4) {
                    const LAS bf16x8* F = (const LAS bf16x8*)(lds + (n & 1) * DBUF) + lane;
                    const float gend = *(const LAS float*)(lds + (n & 1) * DBUF + 72 * 1024);
                    const bf16x8 sb0 = PACK_ACC(S0, 0), sb1 = PACK_ACC(S0, 1), sb2 = PACK_ACC(S1, 0), sb3 = PACK_ACC(S1, 1), sb4 = PACK_ACC(S2, 0), sb5 = PACK_ACC(S2, 1), sb6 = PACK_ACC(S3, 0), sb7 = PACK_ACC(S3, 1);
                    f32x16 U0t, U1t;
                    { const bf16x8 a0 = F[(56 + nt * 2 + 0) * 64], a1 = F[(56 + nt * 2 + 1) * 64], c0 = F[(56 + (4 + nt) * 2 + 0) * 64], c1 = F[(56 + (4 + nt) * 2 + 1) * 64];
#pragma unroll
                      for (int e = 0; e < 8; ++e) { U0t[e] = bf2f((bf16)a0[e]); U0t[8 + e] = bf2f((bf16)a1[e]); U1t[e] = bf2f((bf16)c0[e]); U1t[8 + e] = bf2f((bf16)c1[e]); } }
                    U0t = MFMA32(F[0 * 64], sb0, U0t); U0t = MFMA32(F[1 * 64], sb1, U0t); U0t = MFMA32(F[2 * 64], sb2, U0t); U0t = MFMA32(F[3 * 64], sb3, U0t);
                    U0t = MFMA32(F[4 * 64], sb4, U0t); U0t = MFMA32(F[5 * 64], sb5, U0t); U0t = MFMA32(F[6 * 64], sb6, U0t); U0t = MFMA32(F[7 * 64], sb7, U0t);
                    U1t = MFMA32(F[8 * 64], sb0, U1t); U1t = MFMA32(F[9 * 64], sb1, U1t); U1t = MFMA32(F[10 * 64], sb2, U1t); U1t = MFMA32(F[11 * 64], sb3, U1t);
                    U1t = MFMA32(F[12 * 64], sb4, U1t); U1t = MFMA32(F[13 * 64], sb5, U1t); U1t = MFMA32(F[14 * 64], sb6, U1t); U1t = MFMA32(F[15 * 64], sb7, U1t);
                    const bf16x8 ub0 = PACK_ACC(U0t, 0), ub1 = PACK_ACC(U0t, 1), ub2 = PACK_ACC(U1t, 0), ub3 = PACK_ACC(U1t, 1);
                    f32x16 O0, O1;
#pragma unroll
                    for (int i = 0; i < 16; ++i) { O0[i] = 0.f; O1[i] = 0.f; }
                    O0 = MFMA32(F[16 * 64], sb0, O0); O0 = MFMA32(F[17 * 64], sb1, O0); O0 = MFMA32(F[18 * 64], sb2, O0); O0 = MFMA32(F[19 * 64], sb3, O0);
                    O0 = MFMA32(F[20 * 64], sb4, O0); O0 = MFMA32(F[21 * 64], sb5, O0); O0 = MFMA32(F[22 * 64], sb6, O0); O0 = MFMA32(F[23 * 64], sb7, O0);
                    O1 = MFMA32(F[24 * 64], sb0, O1); O1 = MFMA32(F[25 * 64], sb1, O1); O1 = MFMA32(F[26 * 64], sb2, O1); O1 = MFMA32(F[27 * 64], sb3, O1);
                    O1 = MFMA32(F[28 * 64], sb4, O1); O1 = MFMA32(F[29 * 64], sb5, O1); O1 = MFMA32(F[30 * 64], sb6, O1); O1 = MFMA32(F[31 * 64], sb7, O1);
                    O0 = MFMA32(F[48 * 64], ub0, O0); O0 = MFMA32(F[49 * 64], ub1, O0);
                    O1 = MFMA32(F[52 * 64], ub0, O1); O1 = MFMA32(F[53 * 64], ub1, O1); O1 = MFMA32(F[54 * 64], ub2, O1); O1 = MFMA32(F[55 * 64], ub3, O1);
#pragma unroll
                    for (int i = 0; i < 16; ++i) { S0[i] *= gend; S1[i] *= gend; S2[i] *= gend; S3[i] *= gend; }
                    S0 = MFMA32(F[32 * 64], ub0, S0); S0 = MFMA32(F[33 * 64], ub1, S0); S0 = MFMA32(F[34 * 64], ub2, S0); S0 = MFMA32(F[35 * 64], ub3, S0);
                    S1 = MFMA32(F[36 * 64], ub0, S1); S1 = MFMA32(F[37 * 64], ub1, S1); S1 = MFMA32(F[38 * 64], ub2, S1); S1 = MFMA32(F[39 * 64], ub3, S1);
                    S2 = MFMA32(F[40 * 64], ub0, S2); S2 = MFMA32(F[41 * 64], ub1, S2); S2 = MFMA32(F[42 * 64], ub2, S2); S2 = MFMA32(F[43 * 64], ub3, S2);
                    S3 = MFMA32(F[44 * 64], ub0, S3); S3 = MFMA32(F[45 * 64], ub1, S3); S3 = MFMA32(F[46 * 64], ub2, S3); S3 = MFMA32(F[47 * 64], ub3, S3);
                    float* yo = ODN + (size_t)(b * 2048 + n * 64) * 1024 + h * 128 + 32 * nt + r;
#pragma unroll
                    for (int i = 0; i < 16; ++i) { yo[(size_t)crow(i, hp) * 1024] = O0[i]; yo[(size_t)(32 + crow(i, hp)) * 1024] = O1[i]; }
                }
                asm volatile("s_waitcnt vmcnt(0)" ::: "memory"); __syncthreads();
            }
#undef DN_DMA
            if (wave < 4) {
                float* dst = kp.out() + O_DN_P + ((size_t)j * 4 + b) * ((size_t)8 * 128 * 128) + (size_t)h * 128 * 128 + 32 * nt + r;
#pragma unroll
                for (int i = 0; i < 16; ++i) { dst[(size_t)crow(i, hp) * 128] = S0[i]; dst[(size_t)(32 + crow(i, hp)) * 128] = S1[i]; dst[(size_t)(64 + crow(i, hp)) * 128] = S2[i]; dst[(size_t)(96 + crow(i, hp)) * 128] = S3[i]; }
            }
        } else if (half >= 0) {
            const int wave = __builtin_amdgcn_readfirstlane(tid >> 6), lane = tid & 63, r = lane & 31, hp = lane >> 5;
            const int b = s, nt = half * 4 + wave;
            const unsigned char* OPS = kp.ws() + WS_GLAOPS;
            constexpr int GBUF = 57 * 1024;
#define GLA_DMA(n_, bufi_) do { const unsigned char* gi_ = OPS + (size_t)((b * 32 + (n_)) * 4 + h) * GLA_ITEM_BYTES + lane * 16; \
                _Pragma("unroll") for (int q_ = 0; q_ < 8; ++q_) { const int lf_ = wave + 8 * q_; if (lf_ < 57) { const int gf_ = lf_ < 40 ? lf_ : (lf_ < 56 ? lf_ + half * 16 : 72); \
                    __builtin_amdgcn_global_load_lds((const unsigned*)(gi_ + gf_ * 1024), (LAS unsigned*)(lds + (bufi_) * GBUF + lf_ * 1024), 16, 0, 2); } } } while (0)
            f32x16 S0, S1, S2, S3;
#pragma unroll
            for (int i = 0; i < 16; ++i) { S0[i] = 0.f; S1[i] = 0.f; S2[i] = 0.f; S3[i] = 0.f; }
            GLA_DMA(0, 0);
            asm volatile("s_waitcnt vmcnt(0)" ::: "memory"); __syncthreads();
            for (int n = 0; n < 32; ++n) {
                if (n + 1 < 32) GLA_DMA(n + 1, (n + 1) & 1);
                if (wave < 4) {
                    const LAS bf16x8* F = (const LAS bf16x8*)(lds + (n & 1) * GBUF) + lane;
                    const LAS float* ge = (const LAS float*)(lds + (n & 1) * GBUF + 56 * 1024) + 4 * hp;
                    const bf16x8 sb0 = PACK_ACC(S0, 0), sb1 = PACK_ACC(S0, 1), sb2 = PACK_ACC(S1, 0), sb3 = PACK_ACC(S1, 1), sb4 = PACK_ACC(S2, 0), sb5 = PACK_ACC(S2, 1), sb6 = PACK_ACC(S3, 0), sb7 = PACK_ACC(S3, 1);
                    f32x16 O0, O1;
#pragma unroll
                    for (int i = 0; i < 16; ++i) { O0[i] = 0.f; O1[i] = 0.f; }
                    O0 = MFMA32(F[0 * 64], sb0, O0); O0 = MFMA32(F[1 * 64], sb1, O0); O0 = MFMA32(F[2 * 64], sb2, O0); O0 = MFMA32(F[3 * 64], sb3, O0);
                    O0 = MFMA32(F[4 * 64], sb4, O0); O0 = MFMA32(F[5 * 64], sb5, O0); O0 = MFMA32(F[6 * 64], sb6, O0); O0 = MFMA32(F[7 * 64], sb7, O0);
                    O1 = MFMA32(F[8 * 64], sb0, O1); O1 = MFMA32(F[9 * 64], sb1, O1); O1 = MFMA32(F[10 * 64], sb2, O1); O1 = MFMA32(F[11 * 64], sb3, O1);
                    O1 = MFMA32(F[12 * 64], sb4, O1); O1 = MFMA32(F[13 * 64], sb5, O1); O1 = MFMA32(F[14 * 64], sb6, O1); O1 = MFMA32(F[15 * 64], sb7, O1);
                    bf16x8 vb[4];
#pragma unroll
                    for (int ks = 0; ks < 4; ++ks) vb[ks] = F[(40 + wave * 4 + ks) * 64];
                    O0 = MFMA32(F[32 * 64], vb[0], O0); O0 = MFMA32(F[33 * 64], vb[1], O0);
#pragma unroll
                    for (int ks = 0; ks < 4; ++ks) O1 = MFMA32(F[(36 + ks) * 64], vb[ks], O1);
#pragma unroll
                    for (int q = 0; q < 4; ++q) { const f32x4 g0 = *(const LAS f32x4*)(ge + 8 * q), g1 = *(const LAS f32x4*)(ge + 32 + 8 * q), g2 = *(const LAS f32x4*)(ge + 64 + 8 * q), g3 = *(const LAS f32x4*)(ge + 96 + 8 * q);
#pragma unroll
                        for (int c = 0; c < 4; ++c) { S0[4 * q + c] *= g0[c]; S1[4 * q + c] *= g1[c]; S2[4 * q + c] *= g2[c]; S3[4 * q + c] *= g3[c]; } }
#pragma unroll
                    for (int ks = 0; ks < 4; ++ks) { S0 = MFMA32(F[(16 + ks) * 64], vb[ks], S0); S1 = MFMA32(F[(20 + ks) * 64], vb[ks], S1); S2 = MFMA32(F[(24 + ks) * 64], vb[ks], S2); S3 = MFMA32(F[(28 + ks) * 64], vb[ks], S3); }
                    float* yo = OGLA + (size_t)(b * 2048 + n * 64) * 1024 + h * 256 + 32 * nt + r;
#pragma unroll
                    for (int i = 0; i < 16; ++i) { yo[(size_t)crow(i, hp) * 1024] = O0[i]; yo[(size_t)(32 + crow(i, hp)) * 1024] = O1[i]; }
                }
                asm volatile("s_waitcnt vmcnt(0)" ::: "memory"); __syncthreads();
            }
#undef GLA_DMA
            if (wave < 4) {
                float* dst = kp.out() + O_GLA_P + ((size_t)j * 4 + b) * ((size_t)4 * 128 * 256) + (size_t)h * 128 * 256 + 32 * nt + r;
#pragma unroll
                for (int i = 0; i < 16; ++i) { dst[(size_t)crow(i, hp) * 256] = S0[i]; dst[(size_t)(32 + crow(i, hp)) * 256] = S1[i]; dst[(size_t)(64 + crow(i, hp)) * 256] = S2[i]; dst[(size_t)(96 + crow(i, hp)) * 256] = S3[i]; }
            }
        } else
        {}
    }
    SEC_END(12, lds)
    SEC_BEGIN(13)
    unsigned* qhead = (unsigned*)(kp.ws() + WS_CTL) + CW_CNT + 64 * li;
    volatile LAS unsigned* qslot = (volatile LAS unsigned*)(lds + LDS_BYTES - 8);
    const float* cw = kp.in(14) + (size_t)j * 4 * 3072; const float* stc = kp.in(3) + (size_t)j * 128 * 3 * 3072;
    const float* wa2 = kp.in(18) + (size_t)j * 16 * 512; const float* ba = kp.in(19) + (size_t)j * 512;
    for (;;) {
        __syncthreads();
        if (tid0 == 0) qslot[0] = __hip_atomic_fetch_add(qhead, 1u, __ATOMIC_RELAXED, __HIP_MEMORY_SCOPE_AGENT);
        __syncthreads();
        const int it = (int)qslot[0];
        if (it >= 1536) break;
        int tid = tid0; asm volatile("" : "+v"(tid));
        const int wave = tid >> 6, lane = tid & 63;
        if (it < 1024) {
            const int bs = it >> 3, h = it & 7, sq = 4 + bs, r0 = TP + bs * 4;
            LAS float* qL = (LAS float*)lds; LAS float* kL = qL + 512; LAS float* vL = kL + 512; LAS float* red = vL + 512; LAS float* sm = red + 4096;
            const int e = tid & 127, dq = tid >> 7;
            const size_t SZ = (size_t)8 * 128 * 128;
            const float* st = kp.in(2) + ((size_t)j * 128 + bs) * SZ + (size_t)h * 16384;
            float S[32];
            { const float* sp = st + (size_t)(dq * 32) * 128 + e;
#pragma unroll
              for (int i = 0; i < 32; ++i) { S[i] = *sp; sp += 128; asm volatile("" : "+v"(sp)); } }
#pragma unroll
            for (int part = 0; part < 3; ++part) { const int c = part * 1024 + h * 128 + e; float acc = 0.f;
#pragma unroll
                for (int tap = 0; tap < 4; ++tap) acc += cw[tap * 3072 + c] * pre_val(U, NAB, c, r0, dq - 3 + tap, sq, stc, 3072, c);
                if (part == 2) vL[dq * 128 + e] = silu_(acc); else (part == 0 ? qL : kL)[e * 4 + dq] = silu_(acc); }
            if (tid < 4) { const size_t ro = (size_t)(r0 + tid) * NAB;
                sm[32 + tid] = -__expf(kp.in(15)[j * 8 + h]) * softplus_(bf2f(U[ro + 7176 + h]) + kp.in(16)[j * 8 + h]); sm[36 + tid] = sigmoid_(bf2f(U[ro + 7168 + h])); }
            __syncthreads();
            { const int tk = wave & 3; LAS float* src = (wave >> 2) ? kL : qL; const float a = src[lane * 4 + tk], b = src[(lane + 64) * 4 + tk];
              const float sc = rsqrtf(wave_sum(a * a + b * b) + 1e-6f) * ((wave >> 2) ? 1.f : 0.08838834764831845f); src[lane * 4 + tk] = a * sc; src[(lane + 64) * 4 + tk] = b * sc; }
            __syncthreads();
#pragma unroll
            for (int q = 0; q < 4; ++q) { const int idx = wave * 4 + q, i = (idx >> 2) & 3, jj = idx & 3; const LAS float* src = idx < 16 ? kL : qL;
                const float dot = wave_sum(src[lane * 4 + i] * kL[lane * 4 + jj] + src[(lane + 64) * 4 + i] * kL[(lane + 64) * 4 + jj]); if (lane == 0) sm[idx] = dot; }
            float ks[4] = {0.f, 0.f, 0.f, 0.f}, qs[4] = {0.f, 0.f, 0.f, 0.f};
#pragma unroll
            for (int i = 0; i < 32; ++i) { const int d = dq * 32 + i; const float sv = S[i]; const f32x4 k4 = *(const LAS f32x4*)(kL + d * 4), q4 = *(const LAS f32x4*)(qL + d * 4);
#pragma unroll
                for (int t = 0; t < 4; ++t) { ks[t] += k4[t] * sv; qs[t] += q4[t] * sv; } }
#pragma unroll
            for (int t = 0; t < 4; ++t) { red[(t * 4 + dq) * 128 + e] = ks[t]; red[((4 + t) * 4 + dq) * 128 + e] = qs[t]; }
            __syncthreads();
            float Gc[4]; Gc[0] = sm[32]; Gc[1] = Gc[0] + sm[33]; Gc[2] = Gc[1] + sm[34]; Gc[3] = Gc[2] + sm[35];
            float u[4];
#pragma unroll
            for (int i = 0; i < 4; ++i) { const float KSi = (red[(i * 4 + 0) * 128 + e] + red[(i * 4 + 1) * 128 + e]) + (red[(i * 4 + 2) * 128 + e] + red[(i * 4 + 3) * 128 + e]);
                float acc = vL[i * 128 + e] - __expf(Gc[i]) * KSi;
#pragma unroll
                for (int jj = 0; jj < i; ++jj) acc -= sm[i * 4 + jj] * __expf(Gc[i] - Gc[jj]) * u[jj];
                u[i] = sm[36 + i] * acc; }
            if (dq == 0) {
#pragma unroll
                for (int i = 0; i < 4; ++i) { const float QSi = (red[((4 + i) * 4 + 0) * 128 + e] + red[((4 + i) * 4 + 1) * 128 + e]) + (red[((4 + i) * 4 + 2) * 128 + e] + red[((4 + i) * 4 + 3) * 128 + e]);
                    float o = __expf(Gc[i]) * QSi;
#pragma unroll
                    for (int jj = 0; jj <= i; ++jj) o += sm[16 + i * 4 + jj] * __expf(Gc[i] - Gc[jj]) * u[jj];
                    ODN[(size_t)(r0 + i) * 1024 + h * 128 + e] = o; } }
            const float eg = __expf(Gc[3]); float w[4];
#pragma unroll
            for (int jj = 0; jj < 4; ++jj) w[jj] = __expf(Gc[3] - Gc[jj]) * u[jj];
            float* dst = kp.out() + O_DN_S + ((size_t)j * 128 + bs) * SZ + (size_t)h * 16384 + (size_t)(dq * 32) * 128 + e;
#pragma unroll
            for (int i = 0; i < 32; ++i) { const int d = dq * 32 + i; float sv = eg * S[i]; const f32x4 k4 = *(const LAS f32x4*)(kL + d * 4);
#pragma unroll
                for (int jj = 0; jj < 4; ++jj) sv += k4[jj] * w[jj];
                *dst = sv; dst += 128; asm volatile("" : "+v"(dst)); }
        } else {
            const int q_ = it - 1024, bs = q_ >> 2, h = q_ & 3, r0 = TP + bs * 4;
            LAS float* qgL = (LAS float*)lds; LAS float* kaL = qgL + 512; LAS float* glL = kaL + 512; LAS float* egL = glL + 512; LAS float* Am = egL + 128; LAS float* red = Am + 16;
            const int e = tid & 255, dh = tid >> 8;
            const size_t SZ = (size_t)4 * 128 * 256;
            const float* st = kp.in(4) + ((size_t)j * 128 + bs) * SZ + (size_t)h * 32768;
            float S[64];
            { const float* sp = st + (size_t)(dh * 64) * 256 + e;
#pragma unroll
              for (int i = 0; i < 64; ++i) { S[i] = *sp; sp += 256; asm volatile("" : "+v"(sp)); } }
            float v[4];
#pragma unroll
            for (int t = 0; t < 4; ++t) v[t] = bf2f(U[(size_t)(r0 + t) * NAB + 5120 + h * 256 + e]);
            { const int d = tid & 127, tk = tid >> 7; const size_t ro = (size_t)(r0 + tk) * NAB;
              qgL[d * 4 + tk] = bf2f(U[ro + 4096 + h * 128 + d]) * 0.08838834764831845f; kaL[d * 4 + tk] = bf2f(U[ro + 4608 + h * 128 + d]);
              float x = ba[h * 128 + d];
#pragma unroll
              for (int rr = 0; rr < 16; ++rr) x += bf2f(U[ro + 7184 + rr]) * wa2[rr * 512 + h * 128 + d];
              glL[tk * 128 + d] = -softplus_(-x) * (1.f / 16.f); }
            __syncthreads();
            if (tid < 128) { float Gq = 0.f;
#pragma unroll
                for (int t = 0; t < 4; ++t) { Gq += glL[t * 128 + tid]; qgL[tid * 4 + t] *= __expf(Gq); kaL[tid * 4 + t] *= __expf(-Gq); }
                egL[tid] = __expf(Gq); }
            __syncthreads();
#pragma unroll
            for (int q = 0; q < 2; ++q) { const int idx = wave * 2 + q, i = idx >> 2, jj = idx & 3;
                const float dot = wave_sum(qgL[lane * 4 + i] * kaL[lane * 4 + jj] + qgL[(lane + 64) * 4 + i] * kaL[(lane + 64) * 4 + jj]); if (lane == 0) Am[idx] = dot; }
            float o[4] = {0.f, 0.f, 0.f, 0.f};
            float* dst = kp.out() + O_GLA_S + ((size_t)j * 128 + bs) * SZ + (size_t)h * 32768 + (size_t)(dh * 64) * 256 + e;
#pragma unroll
            for (int i = 0; i < 64; ++i) { const int d = dh * 64 + i; const float s0 = S[i]; float acc = s0; const f32x4 q4 = *(const LAS f32x4*)(qgL + d * 4), k4 = *(const LAS f32x4*)(kaL + d * 4);
#pragma unroll
                for (int t = 0; t < 4; ++t) { o[t] += q4[t] * s0; acc += k4[t] * v[t]; }
                *dst = egL[d] * acc; dst += 256; asm volatile("" : "+v"(dst)); }
#pragma unroll
            for (int t = 0; t < 4; ++t) red[(dh * 4 + t) * 256 + e] = o[t];
            __syncthreads();
            if (dh == 0) {
#pragma unroll
                for (int t = 0; t < 4; ++t) { float oo = red[t * 256 + e] + red[(4 + t) * 256 + e];
#pragma unroll
                    for (int jj = 0; jj <= t; ++jj) oo += Am[t * 4 + jj] * v[jj];
                    OGLA[(size_t)(r0 + t) * 1024 + h * 256 + e] = oo; } }
        }
    }
    SEC_END(13, lds)
}

__device__ __forceinline__ void phase_ab_post(const KP kp, const int bid, const int G, int j, int tid, int wave, int lane) {
    unsigned char* scr = kp.ws() + WS_SCR; const bf16* U = (const bf16*)(kp.ws() + WS_U); bf16* YM = (bf16*)(kp.ws() + WS_YM);
    const float* ODN = (const float*)(scr + SC_ODN); const float* OGLA = (const float*)(scr + SC_OGLA);
    const float* dnn = kp.in(17) + (size_t)j * 128; const float* glan = kp.in(20) + (size_t)j * 256;
    typedef float f32x2v __attribute__((ext_vector_type(2)));
    const f32x2v dg = *(const f32x2v*)(dnn + 2 * lane); const f32x4 gg = *(const f32x4*)(glan + 4 * lane);
    for (int r = bid * NWAVES + wave; r < T; r += G * NWAVES) {
        int s, t; row_to_seq(r, s, t); int row0, L; seq_info(s, row0, L);
        const bf16* ur = U + (size_t)r * NAB; bf16* yr = YM + (size_t)r * DM;
        f32x2v od[8]; unsigned zd[8]; f32x4 og[4]; u32x2 zg[4];
#pragma unroll
        for (int hh = 0; hh < 8; ++hh) { od[hh] = *(const f32x2v*)(ODN + (size_t)r * 1024 + hh * 128 + 2 * lane); zd[hh] = *(const unsigned*)(ur + 3072 + hh * 128 + 2 * lane); }
#pragma unroll
        for (int hh = 0; hh < 4; ++hh) { og[hh] = *(const f32x4*)(OGLA + (size_t)r * 1024 + hh * 256 + 4 * lane); zg[hh] = *(const u32x2*)(ur + 6144 + hh * 256 + 4 * lane); }
#pragma unroll
        for (int hh = 0; hh < 8; ++hh) { const f32x2v o = od[hh];
            const float rstd = rsqrtf(wave_sum(o.x * o.x + o.y * o.y) * (1.f / 128.f) + 1e-6f);
            const unsigned zz = zd[hh];
            *(unsigned*)(yr + hh * 128 + 2 * lane) = pk2(o.x * rstd * dg.x * silu_(__uint_as_float(zz << 16)), o.y * rstd * dg.y * silu_(__uint_as_float(zz & 0xffff0000u))); }
#pragma unroll
        for (int hh = 0; hh < 4; ++hh) { const f32x4 o = og[hh];
            const float rstd = rsqrtf(wave_sum((o.x * o.x + o.y * o.y) + (o.z * o.z + o.w * o.w)) * (1.f / 256.f) + 1e-6f);
            const u32x2 zz = zg[hh];
            u32x2 w; w.x = pk2(o.x * rstd * gg.x * silu_(__uint_as_float(zz.x << 16)), o.y * rstd * gg.y * silu_(__uint_as_float(zz.x & 0xffff0000u)));
            w.y = pk2(o.z * rstd * gg.z * silu_(__uint_as_float(zz.y << 16)), o.w * rstd * gg.w * silu_(__uint_as_float(zz.y & 0xffff0000u)));
            *(u32x2*)(yr + 1024 + hh * 256 + 4 * lane) = w; }
        if (t >= L - 3) { const int rr = t - (L - 3);
            float* dst = s < 4 ? kp.out() + O_DNC_P + (((size_t)j * 4 + s) * 3 + rr) * 3072 : kp.out() + O_DNC_S + (((size_t)j * 128 + (s - 4)) * 3 + rr) * 3072;
            for (int c = 2 * lane; c < 3072; c += 128) { const unsigned uu = *(const unsigned*)(ur + c); *(f32x2v*)(dst + c) = (f32x2v){__uint_as_float(uu << 16), __uint_as_float(uu & 0xffff0000u)}; } }
    }
}

__device__ __forceinline__ void phase_cd_pre(const KP kp, const int bid, const int G, int j, LAS unsigned char* lds, int tid) {
    unsigned char* scr = kp.ws() + WS_SCR; const bf16* U = (const bf16*)(kp.ws() + WS_U);
    float* XBC = (float*)(scr + SC_XBC) - (size_t)TP * 1536; float* DT = (float*)(scr + SC_DT) - (size_t)TP * 16; bf16* XS = (bf16*)(scr + SC_XS);
    const float* cw = kp.in(23) + (size_t)j * 4 * 1536; const float* cb = kp.in(24) + (size_t)j * 1536; const float* stc = kp.in(6) + (size_t)j * 128 * 3 * 1536;
    for (int r = TP + bid; r < T; r += G) {
        int s, t; row_to_seq(r, s, t); const int row0 = r - t;
#pragma unroll
        for (int i = 0; i < 3; ++i) { const int c = tid + NTHR * i; float acc = cb[c];
#pragma unroll
            for (int tap = 0; tap < 4; ++tap) acc += cw[tap * 1536 + c] * pre_val(U, NCD, 1024 + c, row0, t - 3 + tap, s, stc, 1536, c);
            const float v = silu_(acc); XBC[(size_t)r * 1536 + c] = v; if (c < 1024) XS[(size_t)r * 1024 + c] = (bf16)f2bf(v); }
        if (tid < 16) DT[(size_t)r * 16 + tid] = softplus_(bf2f(U[(size_t)r * NCD + 4608 + tid]) + kp.in(26)[j * 16 + tid]);
    }
}

__device__ __forceinline__ void phase_lru_gates(const KP kp, const int bid, const int G, int j, LAS unsigned char* lds, int tid0) {
    unsigned char* scr = kp.ws() + WS_SCR; const bf16* U = (const bf16*)(kp.ws() + WS_U);
    float* LA = (float*)(scr + SC_LA); float* LB = (float*)(scr + SC_LB);
    const float* lcw = kp.in(29) + (size_t)j * 4 * 1024; const float* lcb = kp.in(30) + (size_t)j * 1024; const float* lstc = kp.in(8) + (size_t)j * 128 * 3 * 1024;
    const int n = bid & 15;
    const float* wa = kp.in(31) + ((size_t)j * 16 + n) * 4096; const float* wx = kp.in(33) + ((size_t)j * 16 + n) * 4096;
    const float* lba = kp.in(32) + (size_t)j * 1024; const float* lbx = kp.in(34) + (size_t)j * 1024; const float* lam = kp.in(35) + (size_t)j * 1024;
    LAS bf16x8* WF = (LAS bf16x8*)lds;
    LAS float* xcL = (LAS float*)(lds + 16384);
    LAS float* igL = xcL + 64 * 68;
    __syncthreads();
    { const int lane = tid0 & 63, f = tid0 >> 6, r = lane & 31, hp = lane >> 5, nt = f >> 2, ks = f & 3; float v[8];
#pragma unroll
      for (int jp = 0; jp < 8; ++jp) v[jp] = wa[(16 * ks + 8 * hp + jp) * 64 + 32 * nt + r];
      WF[f * 64 + lane] = pack8(v);
#pragma unroll
      for (int jp = 0; jp < 8; ++jp) v[jp] = wx[(16 * ks + 8 * hp + jp) * 64 + 32 * nt + r];
      WF[512 + f * 64 + lane] = pack8(v); }
    for (int tile = bid >> 4; tile < T / 64; tile += (G >> 4)) {
        int tid = tid0; asm volatile("" : "+v"(tid));
        const int c = tid & 63, tq = tid >> 6, ch = n * 64 + c, rowbase = tile * 64;
        __syncthreads();
        if (tile < TP / 64) {
            const int r0 = rowbase + tq * 8; const bool first = ((r0 & 2047) == 0);
            const float w0 = lcw[ch], w1 = lcw[1024 + ch], w2 = lcw[2048 + ch], w3 = lcw[3072 + ch], bb = lcb[ch];
            const bf16* up = U + (size_t)r0 * NCD + 3584 + ch;
            const long fo = first ? 0 : (long)NCD;
              float x0 = bf2f(up[-3 * fo]), x1 = bf2f(up[-2 * fo]), x2 = bf2f(up[-1 * fo]); if (first) { x0 = 0.f; x1 = 0.f; x2 = 0.f; }
#pragma unroll
            for (int tt = 0; tt < 8; ++tt) { const float x3 = bf2f(up[(size_t)tt * NCD]); xcL[(tq * 8 + tt) * 68 + c] = bb + w0 * x0 + w1 * x1 + w2 * x2 + w3 * x3; x0 = x1; x1 = x2; x2 = x3; }
        } else {
#pragma unroll 2
            for (int tt = 0; tt < 8; ++tt) { const int r = rowbase + tq * 8 + tt; int s, t; row_to_seq(r, s, t); const int row0 = r - t; float acc = lcb[ch];
#pragma unroll
                for (int tap = 0; tap < 4; ++tap) acc += lcw[tap * 1024 + ch] * pre_val(U, NCD, 3584 + ch, row0, t - 3 + tap, s, lstc, 1024, ch);
                xcL[(tq * 8 + tt) * 68 + c] = acc; }
        }
        __syncthreads();
        const int wave = __builtin_amdgcn_readfirstlane(tid >> 6), lane = tid & 63, r = lane & 31, hp = lane >> 5, mat = wave >> 2, mt = (wave >> 1) & 1, nt = wave & 1;
        f32x16 acc;
#pragma unroll
        for (int i = 0; i < 16; ++i) acc[i] = 0.f;
#pragma unroll
        for (int ks = 0; ks < 4; ++ks) { const LAS float* xp = xcL + (32 * mt + r) * 68 + 16 * ks + 8 * hp; const f32x4 xa = *(const LAS f32x4*)xp, xb = *(const LAS f32x4*)(xp + 4);
            const bf16x8 af = __builtin_bit_cast(bf16x8, (u32x4){cvtpk(xa.x, xa.y), cvtpk(xa.z, xa.w), cvtpk(xb.x, xb.y), cvtpk(xb.z, xb.w)});
            acc = MFMA32(af, WF[mat * 512 + (nt * 4 + ks) * 64 + lane], acc); }
        const int chh = n * 64 + 32 * nt + r;
        if (mat == 1) { const float bx = lbx[chh];
#pragma unroll
            for (int i = 0; i < 16; ++i) igL[(32 * mt + crow(i, hp)) * 65 + 32 * nt + r] = sigmoid_(acc[i] + bx); }
        __syncthreads();
        if (mat == 0) { const float ba = lba[chh], spl = softplus_(-lam[chh]);
#pragma unroll
            for (int i = 0; i < 16; ++i) { const int tk = 32 * mt + crow(i, hp); const size_t ro = (size_t)(rowbase + tk) * 1024 + chh;
                const float log_a = -8.f * sigmoid_(acc[i] + ba) * spl;
                LA[ro] = __expf(log_a); LB[ro] = __builtin_amdgcn_sqrtf(1.f - __expf(2.f * log_a)) * (igL[tk * 65 + 32 * nt + r] * xcL[tk * 68 + 32 * nt + r]); } }
    }
}

constexpr size_t SSD_ITEM_BYTES = 33792;
__device__ __forceinline__ void phase_ssd_prep(const KP kp, const int bid, const int G, int j, LAS unsigned char* lds, int tid0) {
    unsigned char* scr = kp.ws() + WS_SCR;
    const bf16* U = (const bf16*)(kp.ws() + WS_U); bf16* XS = (bf16*)(scr + SC_XS);
    const float* cw = kp.in(23) + (size_t)j * 4 * 1536; const float* cb = kp.in(24) + (size_t)j * 1536;
    unsigned char* OPS = scr + SC_SSDOP;
    LAS float* GL = (LAS float*)lds; LAS float* DTL = GL + 256; LAS float* QK = DTL + 256; LAS bf16* Cb = (LAS bf16*)(QK + 64 * 65); LAS bf16* Bb = Cb + 64 * 72; LAS float* XLs = (LAS float*)(Bb + 64 * 72);
    const float* alog = kp.in(25) + j * 16;
    for (int item = bid; item < 512; item += G) {
        int tid = tid0; asm volatile("" : "+v"(tid));
        const int wave = tid >> 6, lane = tid & 63, r = lane & 31, hp = lane >> 5;
        const int b = item >> 7, n = (item >> 2) & 31, g = item & 3;
        const int row0 = b * 2048 + n * 64;
        __syncthreads();
        {
          const int t0 = 8 * wave; const bool first = (n == 0 && wave == 0); const long fo = first ? 0 : (long)NCD;
#pragma unroll
          for (int q = 0; q < 3; ++q) { const int k = 2 * (lane + 64 * q);
              const int cidx = k < 64 ? 1024 + g * 64 + k : (k < 128 ? 1280 + g * 64 + (k - 64) : g * 256 + (k - 128));
              const float w0a = cw[cidx], w0b = cw[cidx + 1], w1a = cw[1536 + cidx], w1b = cw[1536 + cidx + 1], w2a = cw[2 * 1536 + cidx], w2b = cw[2 * 1536 + cidx + 1], w3a = cw[3 * 1536 + cidx], w3b = cw[3 * 1536 + cidx + 1];
              const float ba = cb[cidx], bb = cb[cidx + 1];
              const bf16* up = U + (size_t)(row0 + t0) * NCD + 1024 + cidx;
              unsigned raw[11];
              raw[0] = *(const unsigned*)(up - 3 * fo); raw[1] = *(const unsigned*)(up - 2 * fo); raw[2] = *(const unsigned*)(up - 1 * fo);
#pragma unroll
              for (int t = 0; t < 8; ++t) raw[3 + t] = *(const unsigned*)(up + (size_t)t * NCD);
              if (first) { raw[0] = 0u; raw[1] = 0u; raw[2] = 0u; }
#pragma unroll
              for (int t = 0; t < 8; ++t) {
                  const float ya = silu_(ba + w0a * __uint_as_float(raw[t] << 16) + w1a * __uint_as_float(raw[t + 1] << 16) + w2a * __uint_as_float(raw[t + 2] << 16) + w3a * __uint_as_float(raw[t + 3] << 16));
                  const float yb = silu_(bb + w0b * __uint_as_float(raw[t] & 0xffff0000u) + w1b * __uint_as_float(raw[t + 1] & 0xffff0000u) + w2b * __uint_as_float(raw[t + 2] & 0xffff0000u) + w3b * __uint_as_float(raw[t + 3] & 0xffff0000u));
                  if (q == 0) { if (k < 64) *(LAS unsigned*)(Bb + (t0 + t) * 72 + k) = pk2(ya, yb); else *(LAS unsigned*)(Cb + (t0 + t) * 72 + (k - 64)) = pk2(ya, yb); }
                  else { XLs[(t0 + t) * 257 + (k - 128)] = ya; XLs[(t0 + t) * 257 + (k - 128) + 1] = yb; } } } }
        if (wave < 4) { const int h = g * 4 + wave; const float dt = softplus_(bf2f(U[(size_t)(row0 + lane) * NCD + 4608 + h]) + kp.in(26)[j * 16 + h]);
            DTL[wave * 64 + lane] = dt; float gv = -__expf(alog[h]) * dt;
#pragma unroll
            for (int o = 1; o < 64; o <<= 1) { const float tt = __shfl_up(gv, o); if (lane >= o) gv += tt; }
            GL[wave * 64 + lane] = gv; }
        __syncthreads();
        if (wave < 4) {
            const int mt = wave >> 1, nt = wave & 1;
            f32x16 acc;
#pragma unroll
            for (int i = 0; i < 16; ++i) acc[i] = 0.f;
#pragma unroll
            for (int ks = 0; ks < 4; ++ks) acc = MFMA32(*(const LAS bf16x8*)(Cb + (32 * mt + r) * 72 + 16 * ks + 8 * hp), *(const LAS bf16x8*)(Bb + (32 * nt + r) * 72 + 16 * ks + 8 * hp), acc);
#pragma unroll
            for (int i16 = 0; i16 < 16; ++i16) QK[(32 * mt + crow(i16, hp)) * 65 + 32 * nt + r] = acc[i16];
        } else {
            for (int i = tid - 256; i < 8192; i += 256) { const int t = i >> 7, k2 = i & 127;
                ((unsigned*)XS)[((size_t)(row0 + t) * 1024 + g * 256) / 2 + k2] = pk2(XLs[t * 257 + 2 * k2], XLs[t * 257 + 2 * k2 + 1]); }
        }
        __syncthreads();
        const int f = wave, mt = f >> 2, ks = f & 3;
        for (int hh = 0; hh < 4; ++hh) {
            const int h = g * 4 + hh; const LAS float* Gh = GL + hh * 64; const float Gend = Gh[63];
            bf16x8* base = (bf16x8*)(OPS + ((size_t)((b * 32 + n) * 16 + h)) * SSD_ITEM_BYTES);
            float v[8];
            { const int i = 32 * mt + r; const float eg = __expf(Gh[i]);
#pragma unroll
              for (int jp = 0; jp < 8; ++jp) { const int d = 16 * ks + 8 * (jp >> 2) + 4 * hp + (jp & 3); v[jp] = bf2f(Cb[i * 72 + d]) * eg; }
              base[0 * 512 + f * 64 + lane] = pack8(v); }
            { const int d = 32 * mt + r;
#pragma unroll
              for (int jp = 0; jp < 8; ++jp) { const int tk = 16 * ks + 8 * (jp >> 2) + 4 * hp + (jp & 3); v[jp] = bf2f(Bb[tk * 72 + d]) * __expf(Gend - Gh[tk]); }
              base[1 * 512 + f * 64 + lane] = pack8(v); }
            { const int i = 32 * mt + r; const float gi = Gh[i];
#pragma unroll
              for (int jp = 0; jp < 8; ++jp) { const int jt = 16 * ks + 8 * (jp >> 2) + 4 * hp + (jp & 3); v[jp] = jt <= i ? QK[i * 65 + jt] * __expf(gi - Gh[jt]) : 0.f; }
              base[2 * 512 + f * 64 + lane] = pack8(v); }
            { const int p = 32 * mt + r;
#pragma unroll
              for (int jp = 0; jp < 8; ++jp) { const int tk = 16 * ks + 8 * (jp >> 2) + 4 * hp + (jp & 3);
                  v[jp] = XLs[tk * 257 + hh * 64 + p] * DTL[hh * 64 + tk]; }
              base[3 * 512 + f * 64 + lane] = pack8(v); }
            if (tid == 0) *(float*)(base + 32 * 64) = __expf(Gend);
        }
    }
}

__device__ __forceinline__ void phase_cd_rec(const KP kp, const int bid, const int G, int j, int li, LAS unsigned char* lds, int tid0) {
    unsigned char* scr = kp.ws() + WS_SCR; const bf16* U = (const bf16*)(kp.ws() + WS_U);
    const float* LA = (const float*)(scr + SC_LA); const float* LB = (const float*)(scr + SC_LB);
    float* YS = (float*)(scr + SC_YS); float* HS = (float*)(scr + SC_HS); bf16* XS = (bf16*)(scr + SC_XS);
    SEC_BEGIN(10)
    for (int item = bid; item < 64; item += G) {
        int tid = tid0; asm volatile("" : "+v"(tid));
        const int b = item >> 4, hd = item & 15;
        __syncthreads();
        const int wave = __builtin_amdgcn_readfirstlane(tid >> 6), lane = tid & 63, r = lane & 31, hp = lane >> 5, nt = wave;
        const unsigned char* OPS = scr + SC_SSDOP;
        const bool dmaw = (wave >= 2 && wave < 6);
        constexpr int SLOT = 33 * 1024;
#define SSD_DMA(n_) do { if (dmaw) { const unsigned char* gi_ = OPS + ((size_t)((b * 32 + (n_)) * 16 + hd)) * SSD_ITEM_BYTES + lane * 16; \
            _Pragma("unroll") for (int q_ = 0; q_ < 9; ++q_) { const int lf_ = q_ < 8 ? (wave - 2) * 8 + q_ : 32; \
                __builtin_amdgcn_global_load_lds((const unsigned*)(gi_ + lf_ * 1024), (LAS unsigned*)(lds + ((n_) & 3) * SLOT + lf_ * 1024), 16, 0, 2); } } } while (0)
        f32x16 S0, S1;
#pragma unroll
        for (int i = 0; i < 16; ++i) { S0[i] = 0.f; S1[i] = 0.f; }
        SSD_DMA(0); SSD_DMA(1); SSD_DMA(2);
        if (dmaw) asm volatile("s_waitcnt vmcnt(18)" ::: "memory");
        asm volatile("" ::: "memory"); __builtin_amdgcn_s_barrier(); asm volatile("" ::: "memory");
        for (int n = 0; n < 32; ++n) {
            if (n + 3 < 32) SSD_DMA(n + 3);
            if (wave < 2) {
                const LAS bf16x8* F = (const LAS bf16x8*)(lds + (n & 3) * SLOT) + lane;
                bf16x8 vb[4];
#pragma unroll
                for (int ks = 0; ks < 4; ++ks) vb[ks] = F[(24 + nt * 4 + ks) * 64];
                const float gend = *(const LAS float*)(lds + (n & 3) * SLOT + 32 * 1024);
                const bf16x8 sb00 = PACK_ACC(S0, 0), sb01 = PACK_ACC(S0, 1), sb10 = PACK_ACC(S1, 0), sb11 = PACK_ACC(S1, 1);
                f32x16 O0, O1;
#pragma unroll
                for (int i = 0; i < 16; ++i) { O0[i] = 0.f; O1[i] = 0.f; }
                O0 = MFMA32(F[0 * 64], sb00, O0); O0 = MFMA32(F[1 * 64], sb01, O0); O0 = MFMA32(F[2 * 64], sb10, O0); O0 = MFMA32(F[3 * 64], sb11, O0);
                O1 = MFMA32(F[4 * 64], sb00, O1); O1 = MFMA32(F[5 * 64], sb01, O1); O1 = MFMA32(F[6 * 64], sb10, O1); O1 = MFMA32(F[7 * 64], sb11, O1);
                O0 = MFMA32(F[16 * 64], vb[0], O0); O0 = MFMA32(F[17 * 64], vb[1], O0);
#pragma unroll
                for (int ks = 0; ks < 4; ++ks) O1 = MFMA32(F[(20 + ks) * 64], vb[ks], O1);
#pragma unroll
                for (int i = 0; i < 16; ++i) { S0[i] *= gend; S1[i] *= gend; }
#pragma unroll
                for (int ks = 0; ks < 4; ++ks) { S0 = MFMA32(F[(8 + ks) * 64], vb[ks], S0); S1 = MFMA32(F[(12 + ks) * 64], vb[ks], S1); }
                float* yo = YS + (size_t)(b * 2048 + n * 64) * 1024 + hd * 64 + 32 * nt + r;
#pragma unroll
                for (int i = 0; i < 16; ++i) { yo[(size_t)crow(i, hp) * 1024] = O0[i]; yo[(size_t)(32 + crow(i, hp)) * 1024] = O1[i]; }
            }
            if (dmaw) { if (n + 3 < 32) asm volatile("s_waitcnt vmcnt(18)" ::: "memory"); else if (n + 2 < 32) asm volatile("s_waitcnt vmcnt(9)" ::: "memory"); else asm volatile("s_waitcnt vmcnt(0)" ::: "memory"); }
            asm volatile("s_waitcnt lgkmcnt(0)" ::: "memory"); __builtin_amdgcn_s_barrier(); asm volatile("" ::: "memory");
        }
#undef SSD_DMA
        if (wave < 2) {
            float* dst = kp.out() + O_SSD_P + ((size_t)j * 4 + b) * ((size_t)16 * 64 * 64) + (size_t)hd * 64 * 64 + 32 * nt + r;
#pragma unroll
            for (int i = 0; i < 16; ++i) { dst[(size_t)crow(i, hp) * 64] = S0[i]; dst[(size_t)(32 + crow(i, hp)) * 64] = S1[i]; }
        }
    }
    SEC_END(10, lds)
    SEC_BEGIN(11)
    unsigned* qhead = (unsigned*)(kp.ws() + WS_CTL) + CW_CNT + 64 * li;
    volatile LAS unsigned* qslot = (volatile LAS unsigned*)(lds + LDS_BYTES - 8);
    const float* cw = kp.in(23) + (size_t)j * 4 * 1536; const float* cb = kp.in(24) + (size_t)j * 1536; const float* stc = kp.in(6) + (size_t)j * 128 * 3 * 1536;
    for (;;) {
        __syncthreads();
        if (tid0 == 0) qslot[0] = __hip_atomic_fetch_add(qhead, 1u, __ATOMIC_RELAXED, __HIP_MEMORY_SCOPE_AGENT);
        __syncthreads();
        const int it = (int)qslot[0];
        if (it >= 1024) break;
        int tid = tid0; asm volatile("" : "+v"(tid));
        if (it < 256) {
            const int s = it >> 6, h = it & 63; int row0, L; seq_info(s, row0, L);
            LAS float* Al = (LAS float*)lds; LAS float* Bl = Al + 512;
            const int chunk = tid >> 4, c16 = tid & 15, ch = h * 16 + c16;
            const size_t ro = (size_t)(row0 + chunk * 64) * 1024 + ch;
            float Ap = 1.f, Bp = 0.f;
#pragma unroll 8
            for (int t = 0; t < 64; ++t) { const float a = LA[ro + (size_t)t * 1024], bb = LB[ro + (size_t)t * 1024]; Bp = a * Bp + bb; Ap *= a; }
            Al[tid] = Ap; Bl[tid] = Bp;
            __syncthreads();
            float hh = 0.f;
            for (int m = 0; m < chunk; ++m) hh = Al[m * 16 + c16] * hh + Bl[m * 16 + c16];
#pragma unroll 8
            for (int t = 0; t < 64; ++t) { hh = LA[ro + (size_t)t * 1024] * hh + LB[ro + (size_t)t * 1024]; HS[ro + (size_t)t * 1024] = hh; }
            if (chunk == 31) kp.out()[O_LRU_P + ((size_t)j * 4 + s) * 1024 + ch] = hh;
        } else if (it < 768) {
            const int q_ = it - 256, bs = q_ >> 2, g = q_ & 3, sq = 4 + bs, r0 = TP + bs * 4;
            LAS float* BL = (LAS float*)lds; LAS float* CL = BL + 256; LAS float* XL = CL + 256; LAS float* DTL = XL + 1024; LAS float* QKs = DTL + 16; LAS float* red = QKs + 16;
            const int wave = tid >> 6, lane = tid & 63, hh = tid >> 7, nh = (tid >> 6) & 1, p = tid & 63, hd = 4 * g + hh;
            const size_t SZ = (size_t)16 * 64 * 64;
            const float* st = kp.in(5) + ((size_t)j * 128 + bs) * SZ + (size_t)hd * 4096;
            float S[32];
            { const float* sp = st + (size_t)(nh * 32) * 64 + p;
#pragma unroll
              for (int i = 0; i < 32; ++i) { S[i] = *sp; sp += 64; asm volatile("" : "+v"(sp)); } }
            { const int ci = tid & 127, tk = tid >> 7;
#pragma unroll
              for (int q = 0; q < 3; ++q) { const int k = ci + 128 * q; int cidx; LAS float* dst;
                  if (k < 64) { cidx = 1024 + g * 64 + k; dst = BL + k * 4 + tk; } else if (k < 128) { cidx = 1280 + g * 64 + (k - 64); dst = CL + (k - 64) * 4 + tk; } else { cidx = g * 256 + (k - 128); dst = XL + tk * 256 + (k - 128); }
                  float acc = cb[cidx];
#pragma unroll
                  for (int tap = 0; tap < 4; ++tap) acc += cw[tap * 1536 + cidx] * pre_val(U, NCD, 1024 + cidx, r0, tk - 3 + tap, sq, stc, 1536, cidx);
                  *dst = silu_(acc); } }
            if (tid < 16) { const int tk = tid >> 2, h2 = tid & 3; DTL[tid] = softplus_(bf2f(U[(size_t)(r0 + tk) * NCD + 4608 + 4 * g + h2]) + kp.in(26)[j * 16 + 4 * g + h2]); }
            __syncthreads();
#pragma unroll
            for (int q = 0; q < 2; ++q) { const int idx = wave * 2 + q, i = idx >> 2, jj = idx & 3; const float dot = wave_sum(CL[lane * 4 + i] * BL[lane * 4 + jj]); if (lane == 0) QKs[idx] = dot; }
            { const int tk = tid >> 7, k2 = tid & 127; ((unsigned*)XS)[((size_t)(r0 + tk) * 1024 + g * 256) / 2 + k2] = pk2(XL[tk * 256 + 2 * k2], XL[tk * 256 + 2 * k2 + 1]); }
            const float negA = -__expf(kp.in(25)[j * 16 + hd]);
            float Gc[4], xd[4], w[4];
            Gc[0] = negA * DTL[hh]; Gc[1] = Gc[0] + negA * DTL[4 + hh]; Gc[2] = Gc[1] + negA * DTL[8 + hh]; Gc[3] = Gc[2] + negA * DTL[12 + hh];
#pragma unroll
            for (int jj = 0; jj < 4; ++jj) { xd[jj] = XL[jj * 256 + hh * 64 + p] * DTL[jj * 4 + hh]; w[jj] = __expf(Gc[3] - Gc[jj]) * xd[jj]; }
            const float eg = __expf(Gc[3]);
            float o[4] = {0.f, 0.f, 0.f, 0.f};
            float* dst = kp.out() + O_SSD_S + ((size_t)j * 128 + bs) * SZ + (size_t)hd * 4096 + (size_t)(nh * 32) * 64 + p;
#pragma unroll
            for (int i = 0; i < 32; ++i) { const int n = nh * 32 + i; const float s0 = S[i]; float acc = eg * s0; const f32x4 c4 = *(const LAS f32x4*)(CL + n * 4), b4 = *(const LAS f32x4*)(BL + n * 4);
#pragma unroll
                for (int t = 0; t < 4; ++t) { o[t] += c4[t] * s0; acc += b4[t] * w[t]; }
                *dst = acc; dst += 64; asm volatile("" : "+v"(dst)); }
#pragma unroll
            for (int t = 0; t < 4; ++t) red[((hh * 2 + nh) * 4 + t) * 64 + p] = o[t];
            __syncthreads();
            if (nh == 0) {
#pragma unroll
                for (int t = 0; t < 4; ++t) { float y = __expf(Gc[t]) * (red[((hh * 2) * 4 + t) * 64 + p] + red[((hh * 2 + 1) * 4 + t) * 64 + p]);
#pragma unroll
                    for (int jj = 0; jj <= t; ++jj) y += QKs[t * 4 + jj] * __expf(Gc[t] - Gc[jj]) * xd[jj];
                    YS[(size_t)(r0 + t) * 1024 + hd * 64 + p] = y; } }
        } else {
            const int q_ = it - 768, s = 4 + (q_ >> 1), h = q_ & 1; int row0, L; seq_info(s, row0, L);
            const int ch = h * 512 + tid;
            float hh = s < 4 ? 0.f : kp.in(7)[((size_t)j * 128 + (s - 4)) * 1024 + ch];
#pragma unroll 8
            for (int t = 0; t < L; ++t) { const size_t r = (size_t)(row0 + t); hh = LA[r * 1024 + ch] * hh + LB[r * 1024 + ch]; HS[r * 1024 + ch] = hh; }
            float* dst = s < 4 ? kp.out() + O_LRU_P + ((size_t)j * 4 + s) * 1024 : kp.out() + O_LRU_S + ((size_t)j * 128 + (s - 4)) * 1024;
            dst[ch] = hh;
        }
    }
    SEC_END(11, lds)
}

__device__ __forceinline__ void phase_cd_post(const KP kp, const int bid, const int G, int j, int tid, int wave, int lane) {
    unsigned char* scr = kp.ws() + WS_SCR; const bf16* U = (const bf16*)(kp.ws() + WS_U); bf16* YM = (bf16*)(kp.ws() + WS_YM);
    const float* YS = (const float*)(scr + SC_YS); const float* HS = (const float*)(scr + SC_HS); const bf16* XS = (const bf16*)(scr + SC_XS);
    const float* sn = kp.in(28) + (size_t)j * 1024; const float* Dv = kp.in(27) + (size_t)j * 16;
    typedef float f32x2v __attribute__((ext_vector_type(2)));
    for (int r = bid * NWAVES + wave; r < T; r += G * NWAVES) {
        int s, t; row_to_seq(r, s, t); int row0, L; seq_info(s, row0, L);
        const bf16* ur = U + (size_t)r * NCD; bf16* yr = YM + (size_t)r * DM;
        f32x4 ysv[4], hsv[4]; u32x2 xxv[4], zzv[4], zlv[4];
#pragma unroll
        for (int gq = 0; gq < 4; ++gq) { const int e = gq * 256 + 4 * lane; ysv[gq] = *(const f32x4*)(YS + (size_t)r * 1024 + e); xxv[gq] = *(const u32x2*)(XS + (size_t)r * 1024 + e); zzv[gq] = *(const u32x2*)(ur + e);
            hsv[gq] = *(const f32x4*)(HS + (size_t)r * 1024 + e); zlv[gq] = *(const u32x2*)(ur + 2560 + e); }
#pragma unroll
        for (int gq = 0; gq < 4; ++gq) { const int e = gq * 256 + 4 * lane; const f32x4 ys = ysv[gq];
            const u32x2 xx = xxv[gq], zz = zzv[gq]; const float Dh = Dv[e >> 6];
            f32x4 y; y.x = (ys.x + Dh * __uint_as_float(xx.x << 16)) * silu_(__uint_as_float(zz.x << 16)); y.y = (ys.y + Dh * __uint_as_float(xx.x & 0xffff0000u)) * silu_(__uint_as_float(zz.x & 0xffff0000u));
            y.z = (ys.z + Dh * __uint_as_float(xx.y << 16)) * silu_(__uint_as_float(zz.y << 16)); y.w = (ys.w + Dh * __uint_as_float(xx.y & 0xffff0000u)) * silu_(__uint_as_float(zz.y & 0xffff0000u));
            const float rstd = rsqrtf(wave_sum((y.x * y.x + y.y * y.y) + (y.z * y.z + y.w * y.w)) * (1.f / 256.f) + 1e-6f);
            const f32x4 g4 = *(const f32x4*)(sn + e);
            u32x2 w; w.x = pk2(y.x * rstd * g4.x, y.y * rstd * g4.y); w.y = pk2(y.z * rstd * g4.z, y.w * rstd * g4.w); *(u32x2*)(yr + e) = w; }
#pragma unroll
        for (int gq = 0; gq < 4; ++gq) { const int ch = gq * 256 + 4 * lane; const f32x4 hs = hsv[gq]; const u32x2 zz = zlv[gq];
            u32x2 w; w.x = pk2(hs.x * silu_(__uint_as_float(zz.x << 16)), hs.y * silu_(__uint_as_float(zz.x & 0xffff0000u))); w.y = pk2(hs.z * silu_(__uint_as_float(zz.y << 16)), hs.w * silu_(__uint_as_float(zz.y & 0xffff0000u)));
            *(u32x2*)(yr + 1024 + ch) = w; }
        if (t >= L - 3) { const int rr = t - (L - 3);
            float* d1 = s < 4 ? kp.out() + O_SSDC_P + (((size_t)j * 4 + s) * 3 + rr) * 1536 : kp.out() + O_SSDC_S + (((size_t)j * 128 + (s - 4)) * 3 + rr) * 1536;
            for (int c = 2 * lane; c < 1536; c += 128) { const unsigned uu = *(const unsigned*)(ur + 1024 + c); *(f32x2v*)(d1 + c) = (f32x2v){__uint_as_float(uu << 16), __uint_as_float(uu & 0xffff0000u)}; }
            float* d2 = s < 4 ? kp.out() + O_LRUC_P + (((size_t)j * 4 + s) * 3 + rr) * 1024 : kp.out() + O_LRUC_S + (((size_t)j * 128 + (s - 4)) * 3 + rr) * 1024;
            for (int c = 2 * lane; c < 1024; c += 128) { const unsigned uu = *(const unsigned*)(ur + 3584 + c); *(f32x2v*)(d2 + c) = (f32x2v){__uint_as_float(uu << 16), __uint_as_float(uu & 0xffff0000u)}; } }
    }
}


typedef float f32x4m __attribute__((ext_vector_type(4)));
template <bool GATE>
__device__ __forceinline__ void sample_gemm_res(LAS unsigned char* lds, const bf16* Amat, const bf16* Bt, const bf16* Hin, bf16* Hout, float* rss_out, const bf16* PP, const float* rss_in, int bid, int tid) {
    if (bid >= 256) return;
    const int wave = tid >> 6, lane = tid & 63, lr = lane & 15, kg = lane >> 4;
    const int m0 = TP + (bid & 7) * 64, n0 = (bid >> 3) * 64;
    const bf16x8* ap = (const bf16x8*)(Amat + (size_t)(m0 + lr) * 2048 + wave * 256 + 8 * kg);
    const bf16x8* bp = (const bf16x8*)(Bt + (size_t)(n0 + lr) * 2048 + wave * 256 + 8 * kg);
    f32x4m acc[4][4];
#pragma unroll
    for (int mi = 0; mi < 4; ++mi)
#pragma unroll
        for (int ni = 0; ni < 4; ++ni) acc[mi][ni] = (f32x4m){0.f, 0.f, 0.f, 0.f};
#pragma unroll 2
    for (int ks = 0; ks < 8; ++ks) { bf16x8 a[4], b[4];
#pragma unroll
        for (int q = 0; q < 4; ++q) { a[q] = ap[(size_t)q * 16 * 256 + ks * 4]; b[q] = bp[(size_t)q * 16 * 256 + ks * 4]; }
#pragma unroll
        for (int mi = 0; mi < 4; ++mi)
#pragma unroll
            for (int ni = 0; ni < 4; ++ni) acc[mi][ni] = __builtin_amdgcn_mfma_f32_16x16x32_bf16(a[mi], b[ni], acc[mi][ni], 0, 0, 0); }
    LAS float* red = (LAS float*)lds;
    __syncthreads();
#pragma unroll
    for (int mi = 0; mi < 4; ++mi)
#pragma unroll
        for (int ni = 0; ni < 4; ++ni)
#pragma unroll
            for (int i = 0; i < 4; ++i) red[(wave * 64 + 16 * mi + kg * 4 + i) * 65 + 16 * ni + lr] = acc[mi][ni][i];
    __syncthreads();
    { const int row = tid >> 3, c8 = (tid & 7) * 8, grow = m0 + row; float v[8];
#pragma unroll
      for (int e = 0; e < 8; ++e) { float sacc = 0.f;
#pragma unroll
          for (int w = 0; w < 8; ++w) sacc += red[(w * 64 + row) * 65 + c8 + e];
          v[e] = sacc; }
      float sc = 1.f; if (GATE) sc = rsqrtf(rss_in[grow] * (1.f / 2048.f) + 1e-6f);
      const size_t p = (size_t)grow * 2048 + n0 + c8;
      const u32x4 hw = *(const u32x4*)(Hin + p); u32x4 pw = (u32x4){0u, 0u, 0u, 0u}; if (GATE) pw = *(const u32x4*)(PP + p);
      const unsigned hws[4] = {hw.x, hw.y, hw.z, hw.w}, pws[4] = {pw.x, pw.y, pw.z, pw.w}; unsigned ow[4]; float sq = 0.f;
#pragma unroll
      for (int e2 = 0; e2 < 4; ++e2) { float h0 = __uint_as_float(hws[e2] << 16), h1 = __uint_as_float(hws[e2] & 0xffff0000u);
          if (GATE) { h0 += __builtin_amdgcn_rcpf(1.f + __expf(-sc * v[2 * e2])) * __uint_as_float(pws[e2] << 16); h1 += __builtin_amdgcn_rcpf(1.f + __expf(-sc * v[2 * e2 + 1])) * __uint_as_float(pws[e2] & 0xffff0000u); }
          else { h0 += v[2 * e2]; h1 += v[2 * e2 + 1]; }
          sq += h0 * h0 + h1 * h1; ow[e2] = cvtpk(h0, h1); }
      *(u32x4*)(Hout + p) = (u32x4){ow[0], ow[1], ow[2], ow[3]};
      sq += __shfl_xor(sq, 1); sq += __shfl_xor(sq, 2); sq += __shfl_xor(sq, 4);
      if ((tid & 7) == 0) atomicAdd(rss_out + grow, sq); }
}

__global__ void __launch_bounds__(NTHR, 2) mega_fwd(Args A) {
    extern __shared__ __attribute__((aligned(16))) unsigned char lds_raw[];
    LAS unsigned char* lds = (LAS unsigned char*)lds_raw;
    const int G = gridDim.x;
    volatile LAS unsigned* bst = (volatile LAS unsigned*)(lds + LDS_BYTES - 16);
    if (threadIdx.x == 0) { bst[0] = 0u; bst[1] = 0u;
#ifdef PROBE_SEC
        *(volatile LAS unsigned long long*)(lds + LDS_BYTES - 32) = 0ull;
#endif
    }
    __syncthreads();
    XcdBarrier xbar = xcd_barrier_post((unsigned*)(A.ws + WS_CTL) + CW_BAR, bst);
#ifdef PROBE_GROUP
    unsigned long long t_prev = __builtin_amdgcn_s_memrealtime(), t_sel = 0;
#endif
    for (int ph = A.ph_lo; ph < A.ph_hi; ++ph) {
        KP kp; kp.p = (const char AS4*)__builtin_amdgcn_kernarg_segment_ptr(); asm volatile("" : "+s"(kp.p));
        unsigned char* ws = kp.ws();
        int tid = threadIdx.x; asm volatile("" : "+v"(tid));
        int bid = blockIdx.x; asm volatile("" : "+s"(bid));
        const int lane = tid & 63, wave = __builtin_amdgcn_readfirstlane(tid >> 6), gw = bid * NWAVES + wave, NGW = G * NWAVES;
        if (ph == 0) { if (PH_MASK & 1) phase_prologue(kp, lds, gw, NGW, wave, lane); }
        else if (ph == N_PHASES - 1) phase_final(kp, gw, NGW, lane);
        else {
            const int li = (ph - 1) / SUBS, sub = (ph - 1) % SUBS, j = li >> 1; const bool ab = (li & 1) == 0;
            float* RSS = (float*)(ws + WS_RSS);
            if (sub == 0) {
                const int N = ab ? NAB : NCD;
                const bf16* Bt = ab ? (const bf16*)(ws + WS_WABIN) + (size_t)j * NAB * 2048 : (const bf16*)(ws + WS_WCDIN) + (size_t)j * NCD * 2048;
                { pg8::Gemm g{(const bf16*)(ws + WS_XN), Bt, T, N, 2048}; pg8::StaticOrder S; S.init(T, N, G, bid);
                  pg8::EpiU E{(bf16*)(ws + WS_U), N, RSS + (size_t)(2 * li) * T};
                  if (PH_MASK & 2) pg8::gemm_phase<pg8::EpiU, pg8::StaticOrder, true, true>(lds, g, S, E, tid); }
                { int tid2 = tid; asm volatile("" : "+v"(tid2));
                  pg8::Gemm g{(const bf16*)(ws + WS_PB) + (size_t)li * T * 256, (const bf16*)(ws + WS_WPROJ) + (size_t)li * 2048 * 256, T, 2048, 256}; pg8::StaticOrder S; S.init(T, 2048, G, (bid + 37) % G);
                  pg8::EpiU E{(bf16*)(ws + WS_SCR + SC_PP), 2048, nullptr};
                  if (PH_MASK & 2) pg8::gemm_phase<pg8::EpiU, pg8::StaticOrder, true, true>(lds, g, S, E, tid2); }
            } else if (sub == 4) {
                const bf16* Bt = ab ? (const bf16*)(ws + WS_WABOUT) + (size_t)j * 2048 * 2048 : (const bf16*)(ws + WS_WCDOUT) + (size_t)j * 2048 * 2048;
                pg8::Gemm g{(const bf16*)(ws + WS_YM), Bt, TP, 2048, 2048}; pg8::StaticOrder S; S.init(TP, 2048, G, bid);
                pg8::EpiRes<false> E{(const bf16*)(ws + WS_XN), (bf16*)(ws + WS_SCR + SC_HB1), RSS + (size_t)(2 * li + 1) * T, nullptr, nullptr};
                if (PH_MASK & 4) pg8::gemm_phase<pg8::EpiRes<false>, pg8::StaticOrder, true, true>(lds, g, S, E, tid);
                { int tid2 = tid; asm volatile("" : "+v"(tid2));
                  sample_gemm_res<false>(lds, (const bf16*)(ws + WS_YM), Bt, (const bf16*)(ws + WS_XN), (bf16*)(ws + WS_SCR + SC_HB1), RSS + (size_t)(2 * li + 1) * T, nullptr, nullptr, bid, tid2); }
            } else if (sub == 5) {
                pg8::Gemm g{(const bf16*)(ws + WS_SCR + SC_HB1), (const bf16*)(ws + WS_WGATE) + (size_t)li * 2048 * 2048, TP, 2048, 2048}; pg8::StaticOrder S; S.init(TP, 2048, G, bid);
                pg8::EpiRes<true> E{(const bf16*)(ws + WS_SCR + SC_HB1), (bf16*)(ws + WS_XN), RSS + (size_t)(2 * li + 2) * T, (const bf16*)(ws + WS_SCR + SC_PP), RSS + (size_t)(2 * li + 1) * T};
                if (PH_MASK & 4) pg8::gemm_phase<pg8::EpiRes<true>, pg8::StaticOrder, true, true>(lds, g, S, E, tid);
                { int tid2 = tid; asm volatile("" : "+v"(tid2));
                  sample_gemm_res<true>(lds, (const bf16*)(ws + WS_SCR + SC_HB1), (const bf16*)(ws + WS_WGATE) + (size_t)li * 2048 * 2048, (const bf16*)(ws + WS_SCR + SC_HB1), (bf16*)(ws + WS_XN), RSS + (size_t)(2 * li + 2) * T,
                                        (const bf16*)(ws + WS_SCR + SC_PP), RSS + (size_t)(2 * li + 1) * T, bid, tid2); }
            } else if (sub == 1) {
                if (ab) { SEC_BEGIN(3) if (PH_MASK & 4096) phase_gla_prep(kp, bid, G, j, lds, tid); SEC_END(3, lds) SEC_BEGIN(4) if (PH_MASK & 8192) phase_dn_prep(kp, bid, G, j, lds, tid); SEC_END(4, lds) }
                else { if (PH_MASK & 2048) { SEC_BEGIN(8) phase_ssd_prep(kp, bid, G, j, lds, tid); SEC_END(8, lds) SEC_BEGIN(9) phase_lru_gates(kp, bid, G, j, lds, tid); SEC_END(9, lds) } }
            }
            else if (sub == 2) { if (ab) { if (PH_MASK & 32) phase_ab_rec(kp, bid, G, j, li, lds, tid); } else { if (PH_MASK & 64) phase_cd_rec(kp, bid, G, j, li, lds, tid); } }
            else { if (ab) { if (PH_MASK & 128) phase_ab_post(kp, bid, G, j, tid, wave, lane); } else { if (PH_MASK & 256) phase_cd_post(kp, bid, G, j, tid, wave, lane); } }
        }
        if (ph + 1 < A.ph_hi) { if (ph == A.ph_lo) cg::this_grid().sync(); else xcd_barrier(xbar); }
#ifdef PROBE_GROUP
        { const unsigned long long t_now = __builtin_amdgcn_s_memrealtime(); const int li_ = (ph - 1) / SUBS, sub_ = (ph - 1) % SUBS; const bool ab_ = (li_ & 1) == 0;
          int grp = 9; if (ph == N_PHASES - 1) grp = 8; else if (ph > 0) { if (sub_ == 0 || sub_ == 4 || sub_ == 5) grp = 1; else if (sub_ == 1) grp = ab_ ? 4 : 5; else if (sub_ == 2) grp = ab_ ? 6 : 7; else grp = 8; }
          if (grp == PROBE_GROUP) t_sel += t_now - t_prev; t_prev = t_now; }
#endif
    }
#ifdef PROBE_SEC
    if (blockIdx.x == PROBE_BLK && threadIdx.x == 0) { const unsigned long long t_s = *(volatile LAS unsigned long long*)(lds + LDS_BYTES - 32); const unsigned long long t0 = __builtin_amdgcn_s_memrealtime(); while (__builtin_amdgcn_s_memrealtime() - t0 < 3 * t_s) __builtin_amdgcn_s_sleep(8); }
#endif
#ifdef PROBE_GROUP
    if (blockIdx.x == 0 && threadIdx.x == 0) { const unsigned long long t0 = __builtin_amdgcn_s_memrealtime(); while (__builtin_amdgcn_s_memrealtime() - t0 < 3 * t_sel) __builtin_amdgcn_s_sleep(8); }
#endif
}

extern "C" void kernel_launch(void* const* d_in, const int* in_sizes, int n_in, void* d_out, int out_size, void* d_ws, size_t ws_size, hipStream_t stream) {
    static int grid = 0;
    if (grid == 0) {
        if (n_in != 40 || (size_t)out_size != O_END || ws_size < WS_END) { fprintf(stderr, "kernel_launch: unexpected shapes: n_in %d out %d ws %zu\n", n_in, out_size, ws_size); grid = -1; return; }
        int dev = 0, cus = 0, per_cu = 0;
        if (hipGetDevice(&dev) != hipSuccess || hipDeviceGetAttribute(&cus, hipDeviceAttributeMultiprocessorCount, dev) != hipSuccess) { grid = -1; return; }
        if (hipFuncSetAttribute((const void*)mega_fwd, hipFuncAttributeMaxDynamicSharedMemorySize, LDS_BYTES) != hipSuccess) { fprintf(stderr, "kernel_launch: hipFuncSetAttribute failed\n"); grid = -1; return; }
        if (hipOccupancyMaxActiveBlocksPerMultiprocessor(&per_cu, (const void*)mega_fwd, NTHR, LDS_BYTES) != hipSuccess || per_cu < 1) { fprintf(stderr, "kernel_launch: occupancy query says %d\n", per_cu); per_cu = 1; }
        (void)hipGetLastError();
        grid = cus;
    }
    if (grid < 0) return;
    if (hipMemsetAsync((char*)d_ws + WS_CTL, 0, CTL_ZERO_BYTES, stream) != hipSuccess) { fprintf(stderr, "kernel_launch: memset of the control words failed\n"); return; }
    Args a{};
    for (int i = 0; i < 40; ++i) a.in[i] = (const float*)d_in[i];
    a.out = (float*)d_out; a.ws = (unsigned char*)d_ws;
#if MK_N_LAUNCHES == 1
    a.ph_lo = 0; a.ph_hi = N_PHASES;
    void* args[] = {&a};
    hipError_t e = hipLaunchCooperativeKernel((const void*)mega_fwd, dim3(grid), dim3(NTHR), args, LDS_BYTES, stream);
    if (e != hipSuccess) fprintf(stderr, "cooperative launch failed: %s (grid %d)\n", hipGetErrorString(e), grid);
#else
    for (int ph = 0; ph < N_PHASES; ++ph) { a.ph_lo = ph; a.ph_hi = ph + 1; mega_fwd<<<dim3(grid), dim3(NTHR), LDS_BYTES, stream>>>(a); }
#endif
}
```

```cpp
#include <hip/hip_runtime.h>
#include <hip/hip_cooperative_groups.h>
#include <cstdio>
#include <cstdint>
namespace cg = cooperative_groups;

#ifndef MK_N_LAUNCHES
#define MK_N_LAUNCHES 1
#endif

namespace pg8 {
#define PG8_LAS __attribute__((address_space(3)))
typedef unsigned short bf16_t;
typedef short bf16x8 __attribute__((ext_vector_type(8)));
typedef float f32x4 __attribute__((ext_vector_type(4)));
typedef unsigned u32x4 __attribute__((ext_vector_type(4)));
constexpr int BM = 256, BK = 64, HALF = 128, HTB = HALF * BK * 2  , STAGE_BYTES = 8 * HTB, NXCD = 8, WGM = 8;

__host__ __device__ __forceinline__ int lds_byte(int r, int c) { const int st = (r >> 4) * 2 + (c >> 5), rr = r & 15, cc = c & 31, ob = rr * 64 + cc * 2; return st * 1024 + (ob ^ (((ob >> 9) & 1) << 5)); }
__host__ __device__ __forceinline__ void stage_rc(int b, int& R, int& C) { const int st = b / 1024, sb = b % 1024, swz = sb ^ (((sb >> 9) & 1) << 5); R = (st >> 1) * 16 + swz / 64; C = (st & 1) * 32 + (swz % 64) / 2; }
__host__ __device__ __forceinline__ int perm32(int rho) { const int n = rho >> 4, i = rho & 15; return 8 * (i >> 2) + 4 * n + (i & 3); }

struct Unit { int pm, pn; };
struct Gemm { const bf16_t* A; const bf16_t* Bt; int M, N, K; };

struct StaticOrder {
    int nM, nN, nwg, G, c;
    __host__ __device__ void init(int M, int N, int G_, int c_) { nM = M / BM; nN = N / BM; nwg = nM * nN; G = G_; c = c_; }
    __host__ __device__ bool next(int i, Unit& u) const {
        const long L = (long)i * G + c; if (L >= nwg) return false;
        int wgid = (int)L; { const int q = nwg / NXCD, r = nwg % NXCD, xcd = wgid % NXCD, off = wgid / NXCD; wgid = (xcd < r ? xcd * (q + 1) : r * (q + 1) + (xcd - r) * q) + off; }
        const int nig = WGM * nN, gid = wgid / nig, fm = gid * WGM, gsz = (nM - fm) < WGM ? (nM - fm) : WGM;
        u.pm = fm + ((wgid % nig) % gsz); u.pn = (wgid % nig) / gsz; return true;
    }
    __device__ __forceinline__ void a_ready(const Unit&) const {}
    __device__ __forceinline__ void done(const Unit&) const {}
};

__device__ __forceinline__ unsigned cvt_pk_bf16(float lo, float hi) { unsigned r; asm volatile("v_cvt_pk_bf16_f32 %0, %1, %2" : "=v"(r) : "v"(lo), "v"(hi)); return r; }
struct EpiF32 {
    static constexpr bool PERM = false, AFTER_DRAIN = false;
    float* C; int ldc;
    __device__ __forceinline__ void operator()(const f32x4 (&acc)[2][2][4][2], const Unit& u, int wr, int wc, int fr, int fq) const {
        const int row0 = u.pm * BM + wr * 64 + fr, col0 = u.pn * BM + wc * 32 + 4 * fq;
#pragma unroll
        for (int ai = 0; ai < 2; ++ai)
#pragma unroll
            for (int m = 0; m < 4; ++m) { float* rowp = C + (size_t)(row0 + ai * HALF + m * 16) * ldc + col0;
#pragma unroll
                for (int bj = 0; bj < 2; ++bj)
#pragma unroll
                    for (int n = 0; n < 2; ++n) *(f32x4*)(rowp + bj * HALF + n * 16) = acc[ai][bj][m][n]; }
    }
};
struct EpiBf16 {
    static constexpr bool PERM = true, AFTER_DRAIN = false;
    bf16_t* O; int ldc;
    __device__ __forceinline__ void operator()(const f32x4 (&acc)[2][2][4][2], const Unit& u, int wr, int wc, int fr, int fq) const {
        const int row0 = u.pm * BM + wr * 64 + fr; const int col0 = u.pn * BM + wc * 32 + 8 * fq;
#pragma unroll
        for (int ai = 0; ai < 2; ++ai)
#pragma unroll
            for (int m = 0; m < 4; ++m) { bf16_t* rowp = O + (size_t)(row0 + ai * HALF + m * 16) * ldc + col0;
#pragma unroll
                for (int bj = 0; bj < 2; ++bj) { const f32x4 v0 = acc[ai][bj][m][0], v1 = acc[ai][bj][m][1];
                    u32x4 w; w.x = cvt_pk_bf16(v0[0], v0[1]); w.y = cvt_pk_bf16(v0[2], v0[3]); w.z = cvt_pk_bf16(v1[0], v1[1]); w.w = cvt_pk_bf16(v1[2], v1[3]);
                    *(u32x4*)(rowp + bj * HALF) = w; } }
    }
};

struct RangeOrder {
    int start, count;
    __host__ __device__ bool next(int i, Unit& u) const { if (i >= count) return false; const int t = start + i; u.pm = t >> 3; u.pn = t & 7; return true; }
    __device__ __forceinline__ void a_ready(const Unit&) const {}
    __device__ __forceinline__ void done(const Unit&) const {}
};
struct EpiU {
    static constexpr bool PERM = true, AFTER_DRAIN = false;
    bf16_t* O; int ldc; const float* rss;
    __device__ __forceinline__ void operator()(const f32x4 (&acc)[2][2][4][2], const Unit& u, int wr, int wc, int fr, int fq) const {
        const int row0 = u.pm * BM + wr * 64 + fr; const int col0 = u.pn * BM + wc * 32 + 8 * fq;
#pragma unroll
        for (int ai = 0; ai < 2; ++ai)
#pragma unroll
            for (int m = 0; m < 4; ++m) { const int row = row0 + ai * HALF + m * 16; const float sc = rss ? rsqrtf(rss[row] * (1.f / 2048.f) + 1e-6f) : 1.f;
                bf16_t* rowp = O + (size_t)row * ldc + col0;
#pragma unroll
                for (int bj = 0; bj < 2; ++bj) { const f32x4 v0 = acc[ai][bj][m][0] * sc, v1 = acc[ai][bj][m][1] * sc;
                    u32x4 w; w.x = cvt_pk_bf16(v0[0], v0[1]); w.y = cvt_pk_bf16(v0[2], v0[3]); w.z = cvt_pk_bf16(v1[0], v1[1]); w.w = cvt_pk_bf16(v1[2], v1[3]);
                    *(u32x4*)(rowp + bj * HALF) = w; } }
    }
};
typedef unsigned u32x2e __attribute__((ext_vector_type(2)));
template <bool GATE> struct EpiRes {
    static constexpr bool PERM = false, AFTER_DRAIN = false;
    const bf16_t* Hin; bf16_t* Hout; float* rss_out; const bf16_t* PP; const float* rss_in;
    __device__ __forceinline__ void operator()(const f32x4 (&acc)[2][2][4][2], const Unit& u, int wr, int wc, int fr, int fq) const {
        const int row0 = u.pm * BM + wr * 64 + fr, col0 = u.pn * BM + wc * 32 + 4 * fq;
#pragma unroll
        for (int ai = 0; ai < 2; ++ai)
#pragma unroll
            for (int m = 0; m < 4; ++m) { const int row = row0 + ai * HALF + m * 16; const size_t ro = (size_t)row * 2048 + col0;
                float sc = 1.f; if (GATE) sc = rsqrtf(rss_in[row] * (1.f / 2048.f) + 1e-6f);
                float s = 0.f;
#pragma unroll
                for (int bj = 0; bj < 2; ++bj)
#pragma unroll
                    for (int n = 0; n < 2; ++n) { const size_t p = ro + bj * HALF + n * 16; const u32x2e hw = *(const u32x2e*)(Hin + p); const f32x4 a = acc[ai][bj][m][n];
                        f32x4 h; h[0] = __uint_as_float(hw.x << 16); h[1] = __uint_as_float(hw.x & 0xffff0000u); h[2] = __uint_as_float(hw.y << 16); h[3] = __uint_as_float(hw.y & 0xffff0000u);
                        if (GATE) { const u32x2e pw = *(const u32x2e*)(PP + p);
                            h[0] += __builtin_amdgcn_rcpf(1.f + __expf(-sc * a[0])) * __uint_as_float(pw.x << 16); h[1] += __builtin_amdgcn_rcpf(1.f + __expf(-sc * a[1])) * __uint_as_float(pw.x & 0xffff0000u);
                            h[2] += __builtin_amdgcn_rcpf(1.f + __expf(-sc * a[2])) * __uint_as_float(pw.y << 16); h[3] += __builtin_amdgcn_rcpf(1.f + __expf(-sc * a[3])) * __uint_as_float(pw.y & 0xffff0000u); }
                        else h = h + a;
                        s += (h[0] * h[0] + h[1] * h[1]) + (h[2] * h[2] + h[3] * h[3]);
                        u32x2e o; o.x = cvt_pk_bf16(h[0], h[1]); o.y = cvt_pk_bf16(h[2], h[3]); *(u32x2e*)(Hout + p) = o; }
                s += __shfl_xor(s, 16); s += __shfl_xor(s, 32);
                if (fq == 0) atomicAdd(rss_out + row, s);
                asm volatile("" ::: "memory"); }
    }
};
template <class Epi, class Sched, bool ALIGN_EPI = false, bool SP2 = false>
__device__ __forceinline__ void gemm_phase(PG8_LAS unsigned char* lds, const Gemm g, const Sched& S, const Epi& E, const int tid) {
    const int wid = __builtin_amdgcn_readfirstlane(tid >> 6), lane = tid & 63, wr = wid >> 2, wc = wid & 3, fr = lane & 15, fq = lane >> 4;
    const int K = g.K, nt = K / BK;
    unsigned voffA[2], voffB[2];
#pragma unroll
    for (int i = 0; i < 2; ++i) { int R, C; stage_rc(tid * 16 + i * 8192, R, C); const int Rb = Epi::PERM ? ((R & ~31) + perm32(R & 31)) : R;
        voffA[i] = (unsigned)(R * K + C) * 2u; voffB[i] = (unsigned)(Rb * K + C) * 2u; }
    const size_t kstep = (size_t)(BK * 2);
    const size_t hstep = (size_t)HALF * K * 2;
    const size_t tstep = 2 * hstep;
    const unsigned ldsw = (unsigned)wid * 1024u;
    const int aoff = lds_byte(wr * 64 + fr, fq * 8), boff = lds_byte(wc * 32 + fr, fq * 8);
#define PG8_SA(b, h) (((b) * 2 + (h)) * HTB)
#define PG8_SB(b, h) ((4 + (b) * 2 + (h)) * HTB)
#define PG8_STAGE(bufoff, gbase, voff) do { _Pragma("unroll") for (int _i = 0; _i < 2; ++_i) \
        __builtin_amdgcn_global_load_lds((const unsigned*)((const char*)(gbase) + (voff)[_i]), (PG8_LAS unsigned*)(lds + (bufoff) + ldsw + _i * 8192), 16, 0, 0); } while (0)
#define PG8_LDA(dst, b, h) do { _Pragma("unroll") for (int m = 0; m < 4; ++m) _Pragma("unroll") for (int k = 0; k < 2; ++k) dst[m][k] = *(const PG8_LAS bf16x8*)(lds + PG8_SA(b, h) + aoff + m * 2048 + k * 1024); } while (0)
#define PG8_LDB(dst, b, h) do { _Pragma("unroll") for (int n = 0; n < 2; ++n) _Pragma("unroll") for (int k = 0; k < 2; ++k) dst[n][k] = *(const PG8_LAS bf16x8*)(lds + PG8_SB(b, h) + boff + n * 2048 + k * 1024); } while (0)
#define PG8_MMA(ai, bj, At, Bt) do { __builtin_amdgcn_s_setprio(1); _Pragma("unroll") for (int m = 0; m < 4; ++m) _Pragma("unroll") for (int n = 0; n < 2; ++n) _Pragma("unroll") for (int k = 0; k < 2; ++k) \
        acc[ai][bj][m][n] = __builtin_amdgcn_mfma_f32_16x16x32_bf16(Bt[n][k], At[m][k], acc[ai][bj][m][n], 0, 0, 0); __builtin_amdgcn_s_setprio(0); } while (0)
#define PG8_WAIT_V(n) asm volatile("s_waitcnt vmcnt(" #n ")" ::: "memory")
#define PG8_WAIT_L(n) asm volatile("s_waitcnt lgkmcnt(" #n ")" ::: "memory")
#define PG8_BAR __builtin_amdgcn_s_barrier()
#define PG8_SCHED __builtin_amdgcn_sched_barrier(0)
    Unit cur, nxt; int ui = 0;
    if (!S.next(0, cur)) return;
    f32x4 acc[2][2][4][2];
#pragma unroll
    for (int a = 0; a < 2; ++a)
#pragma unroll
        for (int b = 0; b < 2; ++b)
#pragma unroll
            for (int m = 0; m < 4; ++m)
#pragma unroll
                for (int n = 0; n < 2; ++n) acc[a][b][m][n] = (f32x4){0.f, 0.f, 0.f, 0.f};
    bf16x8 At[4][2], B0[2][2], B1[2][2];
    const char* cA = (const char*)g.A + (size_t)cur.pm * tstep; const char* cB = (const char*)g.Bt + (size_t)cur.pn * tstep;
    S.a_ready(cur);
    if constexpr (SP2) {
        PG8_STAGE(PG8_SB(0, 0), cB, voffB); PG8_STAGE(PG8_SB(0, 1), cB + hstep, voffB); PG8_STAGE(PG8_SA(0, 0), cA, voffA); PG8_STAGE(PG8_SA(0, 1), cA + hstep, voffA);
        if (wr == 1) PG8_BAR;
        PG8_WAIT_V(2); PG8_BAR;
        PG8_STAGE(PG8_SB(1, 0), cB + kstep, voffB); PG8_STAGE(PG8_SA(1, 0), cA + kstep, voffA); PG8_STAGE(PG8_SB(1, 1), cB + hstep + kstep, voffB);
        PG8_WAIT_V(6); PG8_BAR;
    } else {
        PG8_STAGE(PG8_SB(0, 0), cB, voffB); PG8_STAGE(PG8_SA(0, 0), cA, voffA); PG8_STAGE(PG8_SB(0, 1), cB + hstep, voffB); PG8_STAGE(PG8_SA(0, 1), cA + hstep, voffA);
        if (wr == 1) PG8_BAR;
        PG8_WAIT_V(4); PG8_BAR;
        PG8_STAGE(PG8_SB(1, 0), cB + kstep, voffB); PG8_STAGE(PG8_SA(1, 0), cA + kstep, voffA); PG8_STAGE(PG8_SB(1, 1), cB + hstep + kstep, voffB);
        PG8_WAIT_V(6); PG8_BAR;
    }
    for (;;) {
        const bool has_next = S.next(ui + 1, nxt);
        const char* nA = has_next ? (const char*)g.A + (size_t)nxt.pm * tstep : cA; const char* nB = has_next ? (const char*)g.Bt + (size_t)nxt.pn * tstep : cB;
        for (int t = 0; t < nt; t += 2) {
            const bool last = (t == nt - 2);
            const char* a1 = cA + (size_t)(t + 1) * kstep;
            const char* a2 = last ? nA : cA + (size_t)(t + 2) * kstep; const char* b2 = last ? nB : cB + (size_t)(t + 2) * kstep;
            const char* a3 = a2 + kstep; const char* b3 = b2 + kstep;
            if (last && has_next) S.a_ready(nxt);
            if constexpr (SP2) {
            PG8_LDB(B0, 0, 0); PG8_LDB(B1, 0, 1); PG8_SCHED; PG8_LDA(At, 0, 0); PG8_STAGE(PG8_SA(1, 1), a1 + hstep, voffA);
            PG8_WAIT_V(8); PG8_WAIT_L(0); PG8_BAR; PG8_MMA(0, 0, At, B0); PG8_MMA(0, 1, At, B1); PG8_BAR; PG8_SCHED;
            PG8_LDA(At, 0, 1); PG8_STAGE(PG8_SB(0, 0), b2, voffB); PG8_STAGE(PG8_SB(0, 1), b2 + hstep, voffB); PG8_STAGE(PG8_SA(0, 0), a2, voffA);
            PG8_WAIT_V(8); PG8_WAIT_L(0); PG8_BAR; PG8_MMA(1, 0, At, B0); PG8_MMA(1, 1, At, B1); PG8_BAR; PG8_SCHED;
            PG8_LDB(B0, 1, 0); PG8_LDB(B1, 1, 1); PG8_SCHED; PG8_LDA(At, 1, 0); PG8_STAGE(PG8_SA(0, 1), a2 + hstep, voffA);
            PG8_WAIT_V(8); PG8_WAIT_L(0); PG8_BAR; PG8_MMA(0, 0, At, B0); PG8_MMA(0, 1, At, B1); PG8_BAR; PG8_SCHED;
            PG8_LDA(At, 1, 1); PG8_STAGE(PG8_SB(1, 0), b3, voffB); PG8_STAGE(PG8_SB(1, 1), b3 + hstep, voffB); PG8_STAGE(PG8_SA(1, 0), a3, voffA);
            PG8_WAIT_V(8); PG8_WAIT_L(0); PG8_BAR; PG8_MMA(1, 0, At, B0); PG8_MMA(1, 1, At, B1); PG8_BAR; PG8_SCHED;
            } else {
            PG8_LDB(B0, 0, 0); PG8_SCHED; PG8_LDA(At, 0, 0); PG8_STAGE(PG8_SA(1, 1), a1 + hstep, voffA);
            PG8_WAIT_L(8); PG8_BAR; PG8_WAIT_L(0); PG8_MMA(0, 0, At, B0); PG8_BAR; PG8_SCHED;
            PG8_LDB(B1, 0, 1); PG8_STAGE(PG8_SB(0, 0), b2, voffB);
            PG8_BAR; PG8_WAIT_L(0); PG8_MMA(0, 1, At, B1); PG8_BAR;
            PG8_LDA(At, 0, 1); PG8_STAGE(PG8_SA(0, 0), a2, voffA);
            PG8_BAR; PG8_WAIT_L(0); PG8_MMA(1, 0, At, B0); PG8_BAR; PG8_SCHED;
            PG8_STAGE(PG8_SB(0, 1), b2 + hstep, voffB);
            PG8_WAIT_V(6); PG8_BAR; PG8_MMA(1, 1, At, B1); PG8_BAR;
            PG8_LDB(B0, 1, 0); PG8_SCHED; PG8_LDA(At, 1, 0); PG8_STAGE(PG8_SA(0, 1), a2 + hstep, voffA);
            PG8_WAIT_L(8); PG8_BAR; PG8_WAIT_L(0); PG8_MMA(0, 0, At, B0); PG8_BAR; PG8_SCHED;
            PG8_LDB(B1, 1, 1); PG8_STAGE(PG8_SB(1, 0), b3, voffB);
            PG8_BAR; PG8_WAIT_L(0); PG8_MMA(0, 1, At, B1); PG8_BAR;
            PG8_LDA(At, 1, 1); PG8_STAGE(PG8_SA(1, 0), a3, voffA);
            PG8_BAR; PG8_WAIT_L(0); PG8_MMA(1, 0, At, B0); PG8_BAR; PG8_SCHED;
            PG8_STAGE(PG8_SB(1, 1), b3 + hstep, voffB);
            PG8_WAIT_V(6); PG8_BAR; PG8_MMA(1, 1, At, B1); PG8_BAR;
            }
        }
        if constexpr (ALIGN_EPI) { if (wr == 0) PG8_BAR; }
        if constexpr (!Epi::AFTER_DRAIN) { E(acc, cur, wr, wc, fr, fq); S.done(cur); }
        if (!has_next) break;
#pragma unroll
        for (int a = 0; a < 2; ++a)
#pragma unroll
            for (int b = 0; b < 2; ++b)
#pragma unroll
                for (int m = 0; m < 4; ++m)
#pragma unroll
                    for (int n = 0; n < 2; ++n) acc[a][b][m][n] = (f32x4){0.f, 0.f, 0.f, 0.f};
        cur = nxt; cA = nA; cB = nB; ++ui;
        if constexpr (ALIGN_EPI) { if (wr == 1) PG8_BAR; }
    }
    PG8_WAIT_V(0);
    if constexpr (!ALIGN_EPI) { if (wr == 0) PG8_BAR; }
    PG8_BAR;
    if constexpr (Epi::AFTER_DRAIN) { E.fused(acc, cur, wr, wc, fr, fq, lds, wid, lane); S.done(cur); }
#undef PG8_SA
#undef PG8_SB
#undef PG8_STAGE
#undef PG8_LDA
#undef PG8_LDB
#undef PG8_MMA
#undef PG8_WAIT_V
#undef PG8_WAIT_L
#undef PG8_BAR
#undef PG8_SCHED
}
}

constexpr int TP = 8192, TS = 512, T = TP + TS, DM = 2048, NSEQ = 132;
constexpr int NAB = 7424, NCD = 4864;
constexpr int NWAVES = 8, NTHR = 512;
constexpr size_t MiB = 1u << 20;
constexpr size_t WS_CTL = 0, CTL_ZERO_BYTES = 1 * MiB;
constexpr int CW_BAR = 4096, CW_CNT = 8192;
constexpr size_t WS_RSS = 65536;
constexpr size_t WS_WABIN = 2 * MiB, WS_WABOUT = 60 * MiB, WS_WCDIN = 76 * MiB, WS_WCDOUT = 114 * MiB, WS_WGATE = 130 * MiB, WS_WPROJ = 162 * MiB;
constexpr size_t WS_H = 166 * MiB, WS_XN = 234 * MiB, WS_YM = 268 * MiB, WS_PB = 302 * MiB, WS_U = 320 * MiB, WS_SCR = 444 * MiB, WS_END = 732 * MiB;
constexpr size_t SC_HB1 = 102 * MiB;
constexpr size_t SC_PP = 8 * MiB;
constexpr size_t SC_QN = 0, SC_KN = 2 * MiB, SC_VV = 4 * MiB, SC_GLOG = 6 * MiB, SC_BETA = 7 * MiB, SC_GDEC = 7 * MiB + 65536, SC_ODN = 102 * MiB, SC_OGLA = 136 * MiB,
    SC_DNOPS = 192 * MiB;
constexpr size_t SC_XBC = 0, SC_DT = 3 * MiB, SC_LA = 52 * MiB, SC_LB = 86 * MiB, SC_YS = 120 * MiB, SC_HS = 154 * MiB, SC_SSDOP = 192 * MiB, SC_XS = 270 * MiB;
constexpr int LDS_BYTES = 163840;
constexpr size_t O_Y_P = 0, O_Y_S = O_Y_P + (size_t)4 * 2048 * 2048, O_DN_P = O_Y_S + (size_t)128 * 4 * 2048,
    O_DNC_P = O_DN_P + (size_t)2 * 4 * 8 * 128 * 128, O_GLA_P = O_DNC_P + (size_t)2 * 4 * 3 * 3072, O_SSD_P = O_GLA_P + (size_t)2 * 4 * 4 * 128 * 256,
    O_SSDC_P = O_SSD_P + (size_t)2 * 4 * 16 * 64 * 64, O_LRU_P = O_SSDC_P + (size_t)2 * 4 * 3 * 1536, O_LRUC_P = O_LRU_P + (size_t)2 * 4 * 1024,
    O_DN_S = O_LRUC_P + (size_t)2 * 4 * 3 * 1024, O_DNC_S = O_DN_S + (size_t)2 * 128 * 8 * 128 * 128, O_GLA_S = O_DNC_S + (size_t)2 * 128 * 3 * 3072,
    O_SSD_S = O_GLA_S + (size_t)2 * 128 * 4 * 128 * 256, O_SSDC_S = O_SSD_S + (size_t)2 * 128 * 16 * 64 * 64, O_LRU_S = O_SSDC_S + (size_t)2 * 128 * 3 * 1536,
    O_LRUC_S = O_LRU_S + (size_t)2 * 128 * 1024, O_END = O_LRUC_S + (size_t)2 * 128 * 3 * 1024;
static_assert(O_END == 109064192, "output size");

#define LAS __attribute__((address_space(3)))
typedef unsigned short bf16;
typedef float f32x4 __attribute__((ext_vector_type(4)));
typedef unsigned u32x2 __attribute__((ext_vector_type(2)));
typedef unsigned u32x4 __attribute__((ext_vector_type(4)));
#define LDS_WAIT() asm volatile("s_waitcnt lgkmcnt(0)" ::: "memory")

__device__ __forceinline__ float bf2f(bf16 b) { return __uint_as_float(((unsigned)b) << 16); }
typedef __bf16 bf16x2_t __attribute__((ext_vector_type(2)));
typedef float f32x2_t __attribute__((ext_vector_type(2)));
__device__ __forceinline__ unsigned cvtpk(float lo, float hi) { f32x2_t v = {lo, hi}; bf16x2_t b = __builtin_convertvector(v, bf16x2_t); return __builtin_bit_cast(unsigned, b); }
__device__ __forceinline__ unsigned f2bf(float f) { return cvtpk(f, 0.f) & 0xffffu; }
__device__ __forceinline__ unsigned pk2(float lo, float hi) { return cvtpk(lo, hi); }
__device__ __forceinline__ float sigmoid_(float x) { return __builtin_amdgcn_rcpf(1.f + __expf(-x)); }
__device__ __forceinline__ float silu_(float x) { return x * __builtin_amdgcn_rcpf(1.f + __expf(-x)); }
__device__ __forceinline__ float softplus_(float x) { return x > 15.f ? x : (x < -15.f ? __expf(x) : __logf(1.f + __expf(x))); }
__device__ __forceinline__ float dpp_add(float v, float x) { return v + x; }
#define WS_DPP(v, ctrl, rmask) __builtin_bit_cast(float, __builtin_amdgcn_update_dpp(0, __builtin_bit_cast(int, (v)), (ctrl), (rmask), 0xf, false))
__device__ __forceinline__ float wave_sum(float v) {
    v += WS_DPP(v, 0xB1, 0xf);
    v += WS_DPP(v, 0x4E, 0xf);
    v += WS_DPP(v, 0x141, 0xf);
    v += WS_DPP(v, 0x140, 0xf);
    v += WS_DPP(v, 0x142, 0xa);
    v += WS_DPP(v, 0x143, 0xc);
    return __builtin_bit_cast(float, __builtin_amdgcn_readlane(__builtin_bit_cast(int, v), 63));
}
__device__ __forceinline__ void row_to_seq(int r, int& s, int& t) { if (r < TP) { s = r >> 11; t = r & 2047; } else { s = 4 + ((r - TP) >> 2); t = (r - TP) & 3; } }
__device__ __forceinline__ void seq_info(int s, int& row0, int& L) { if (s < 4) { row0 = s << 11; L = 2048; } else { row0 = TP + ((s - 4) << 2); L = 4; } }
__device__ __forceinline__ float pre_val(const bf16* U, int ldu, int ucol, int row0, int tt, int s, const float* stc, int W, int c) {
    const int tc = tt >= 0 ? tt : 0, sc = tt >= 0 ? 0 : 3 + tt;
    const float a = bf2f(U[(size_t)(row0 + tc) * ldu + ucol]), b = stc[((size_t)(s - 4) * 3 + sc) * W + c];
    return tt >= 0 ? a : b;
}
__device__ __forceinline__ int map_col(int mapid, int n) {
    if (mapid == 0) return n;
    if (mapid == 1) { if (n < 3072) return n; if (n < 6144) return n + 16; if (n < 7168) return n + 32; if (n < 7184) return n - 4096; if (n < 7200) return n - 1024; return -1; }
    if (n < 2560) return n; if (n < 4608) return n + 16; if (n < 4624) return n - 2048; return -1;
}
__device__ __forceinline__ void transpose_item(const float* W, int K, int Nsrc, bf16* WT, int Npad, int mapid, const float* gain, LAS float* scr, int item, int lane) {
    const int nblk = Npad / 64, kb = item / nblk, nb = item % nblk, k0 = 64 * kb, n0 = 64 * nb;
    const int n4 = (lane & 15) * 4, src = map_col(mapid, n0 + n4);
    const int srcc = src >= 0 ? src : 0; const float msk = src >= 0 ? 1.f : 0.f;
    f32x4 v[16];
#pragma unroll
    for (int i = 0; i < 16; ++i) v[i] = *(const f32x4*)(W + (size_t)(k0 + 4 * i + (lane >> 4)) * Nsrc + srcc);
    if (gain) {
#pragma unroll
        for (int i = 0; i < 16; ++i) v[i] = v[i] * (gain[k0 + 4 * i + (lane >> 4)] * msk);
    } else {
#pragma unroll
        for (int i = 0; i < 16; ++i) v[i] = v[i] * msk;
    }
#pragma unroll
    for (int i = 0; i < 16; ++i) { const int kk = 4 * i + (lane >> 4); scr[kk * 65 + n4] = v[i].x; scr[kk * 65 + n4 + 1] = v[i].y; scr[kk * 65 + n4 + 2] = v[i].z; scr[kk * 65 + n4 + 3] = v[i].w; }
    LDS_WAIT(); asm volatile("" ::: "memory");
    const int c = lane & 7;
#pragma unroll
    for (int jj = 0; jj < 8; ++jj) { const int n = (lane >> 3) + 8 * jj; const LAS float* p = scr + (8 * c) * 65 + n;
        u32x4 o; o.x = pk2(p[0 * 65], p[1 * 65]); o.y = pk2(p[2 * 65], p[3 * 65]); o.z = pk2(p[4 * 65], p[5 * 65]); o.w = pk2(p[6 * 65], p[7 * 65]);
        *(u32x4*)(WT + (size_t)(n0 + n) * K + k0 + 8 * c) = o; }
    LDS_WAIT(); asm volatile("" ::: "memory");
}
__device__ __forceinline__ void norm_row_bf16(const f32x4 (&v)[8], const float* g, bf16* orow, int lane) {
    float ss = 0.f;
#pragma unroll
    for (int j = 0; j < 8; ++j) ss += (v[j].x * v[j].x + v[j].y * v[j].y) + (v[j].z * v[j].z + v[j].w * v[j].w);
    const float rstd = rsqrtf(wave_sum(ss) * (1.f / DM) + 1e-6f);
#pragma unroll
    for (int j = 0; j < 8; ++j) { const int col = 4 * (lane + 64 * j); const f32x4 gg = *(const f32x4*)(g + col);
        u32x2 o; o.x = pk2(v[j].x * rstd * gg.x, v[j].y * rstd * gg.y); o.y = pk2(v[j].z * rstd * gg.z, v[j].w * rstd * gg.w);
        *(u32x2*)(orow + col) = o; }
}

typedef short bf16x8 __attribute__((ext_vector_type(8)));
typedef float f32x16 __attribute__((ext_vector_type(16)));
#define MFMA32(a, b, c) __builtin_amdgcn_mfma_f32_32x32x16_bf16((a), (b), (c), 0, 0, 0)
#define PACK_ACC(x, S_) __builtin_bit_cast(bf16x8, (u32x4){cvtpk((x)[8 * (S_)], (x)[8 * (S_) + 1]), cvtpk((x)[8 * (S_) + 2], (x)[8 * (S_) + 3]), cvtpk((x)[8 * (S_) + 4], (x)[8 * (S_) + 5]), cvtpk((x)[8 * (S_) + 6], (x)[8 * (S_) + 7])})
__device__ __forceinline__ int crow(int reg, int h) { return (reg & 3) + 8 * (reg >> 2) + 4 * h; }
__device__ __forceinline__ bf16x8 pack8(const float (&v)[8]) { return __builtin_bit_cast(bf16x8, (u32x4){cvtpk(v[0], v[1]), cvtpk(v[2], v[3]), cvtpk(v[4], v[5]), cvtpk(v[6], v[7])}); }

#define XB_TMO      128
#define XB_XCNT(j)  (256  + 64 * (j))
#define XB_XSUB(j)  (1280 + 64 * (j))
#define XB_XGEN(j)  (2304 + 64 * (j))
#define XB_TOP      3328
#define XB_TOPGEN   3392
#define XCD_BAR_WORDS 3456
#define XB_SPIN_CAP (1u << 18)

__device__ __forceinline__ unsigned xb_ld(unsigned* p)              { return __hip_atomic_load(p, __ATOMIC_RELAXED, __HIP_MEMORY_SCOPE_AGENT); }
__device__ __forceinline__ unsigned xb_add(unsigned* p, unsigned v) { return __hip_atomic_fetch_add(p, v, __ATOMIC_RELAXED, __HIP_MEMORY_SCOPE_AGENT); }
__device__ __forceinline__ unsigned xb_xcc_id() { return (unsigned)__builtin_amdgcn_s_getreg((3 << 11) | 20) & 0xFu; }
#define XB_SPIN(cond, bar) do { unsigned _sp = 0; while (cond) { __builtin_amdgcn_s_sleep(1); \
    if ((++_sp & 255u) == 0u) { if (xb_ld(&(bar)[XB_TMO])) break; if (_sp > XB_SPIN_CAP) { atomicAdd(&(bar)[XB_TMO], 1u); break; } } } } while (0)

struct XcdBarrier {
    unsigned* bar; unsigned x;
    volatile LAS unsigned* st;
};

__device__ __forceinline__ XcdBarrier xcd_barrier_post(unsigned* bar, volatile LAS unsigned* st) {
    XcdBarrier b; b.bar = bar; b.x = xb_xcc_id(); b.st = st;
    if (threadIdx.x == 0) (void)xb_add(&bar[XB_XCNT(b.x)], 1u);
    return b;
}
__device__ __forceinline__ void xcd_barrier_complete(unsigned* bar, unsigned x, unsigned& nloc, unsigned& nx) {
    const unsigned G = gridDim.x * gridDim.y * gridDim.z;
    unsigned sum, cnt, mine, sp = 0u;
    for (;;) {
        sum = 0u; cnt = 0u; mine = 0u;
#pragma unroll
        for (unsigned j = 0; j < 16; ++j) { const unsigned c = xb_ld(&bar[XB_XCNT(j)]); sum += c; cnt += (c > 0u) ? 1u : 0u; mine = (j == x) ? c : mine; }
        if (sum == G) break;
        __builtin_amdgcn_s_sleep(1);
        if ((++sp & 255u) == 0u) { if (xb_ld(&bar[XB_TMO])) break; if (sp > XB_SPIN_CAP) { atomicAdd(&bar[XB_TMO], 1u); break; } }
    }
    nloc = mine > 0u ? mine : 1u; nx = cnt > 0u ? cnt : 1u;
}

__device__ __forceinline__ void xcd_barrier(const XcdBarrier& b) {
    asm volatile("s_waitcnt vmcnt(0)" ::: "memory");
    __syncthreads();
    if (threadIdx.x == 0) {
        unsigned* bar = b.bar;
        __builtin_amdgcn_s_waitcnt(0);
        unsigned nloc = b.st[0], nx = b.st[1];
        if (nloc == 0u) { xcd_barrier_complete(bar, b.x, nloc, nx); b.st[0] = nloc; b.st[1] = nx; }
        const unsigned old = xb_add(&bar[XB_XSUB(b.x)], 1u);
        const unsigned gen = old / nloc;
        if (old + 1u == (gen + 1u) * nloc) {
            __builtin_amdgcn_fence(__ATOMIC_RELEASE, "agent");
            asm volatile("s_waitcnt vmcnt(0)" ::: "memory");
            const unsigned og = xb_add(&bar[XB_TOP], 1u);
            const unsigned tg = og / nx;
            if (og + 1u == (tg + 1u) * nx) xb_add(&bar[XB_TOPGEN], 1u);
            else XB_SPIN(xb_ld(&bar[XB_TOPGEN]) == tg, bar);
            __builtin_amdgcn_fence(__ATOMIC_ACQUIRE, "agent");
            xb_add(&bar[XB_XGEN(b.x)], 1u);
            asm volatile("s_waitcnt vmcnt(0)" ::: "memory");
        } else {
            XB_SPIN(xb_ld(&bar[XB_XGEN(b.x)]) == gen, bar);
            __builtin_amdgcn_fence(__ATOMIC_ACQUIRE, "agent");
            asm volatile("s_waitcnt vmcnt(0)" ::: "memory");
        }
    }
    __syncthreads();
}


#ifdef PROBE_SEC
#define SEC_BEGIN(id) unsigned long long _sec_t##id = 0; if ((id) == PROBE_SEC) { __builtin_amdgcn_s_barrier(); _sec_t##id = __builtin_amdgcn_s_memrealtime(); }
#define SEC_END(id, ldsp) if ((id) == PROBE_SEC) { __builtin_amdgcn_s_barrier(); if (threadIdx.x == 0) { volatile LAS unsigned long long* a_ = (volatile LAS unsigned long long*)((ldsp) + LDS_BYTES - 32); a_[0] = a_[0] + (__builtin_amdgcn_s_memrealtime() - _sec_t##id); } }
#define SECW_BEGIN(id) unsigned long long _secw_t##id = 0; if ((id) == PROBE_SEC) { _secw_t##id = __builtin_amdgcn_s_memrealtime(); }
#define SECW_END(id, ldsp, tsel) if ((id) == PROBE_SEC) { asm volatile("s_waitcnt vmcnt(0) lgkmcnt(0)" ::: "memory"); if (threadIdx.x == (tsel)) { volatile LAS unsigned long long* a_ = (volatile LAS unsigned long long*)((ldsp) + LDS_BYTES - 32); a_[0] = a_[0] + (__builtin_amdgcn_s_memrealtime() - _secw_t##id); } }
#else
#define SEC_BEGIN(id)
#define SEC_END(id, ldsp)
#define SECW_BEGIN(id)
#define SECW_END(id, ldsp, tsel)
#endif
struct Args { const float* in[40]; float* out; unsigned char* ws; int ph_lo, ph_hi; };
constexpr int N_PHASES = 26, SUBS = 6;
#ifndef PH_MASK
#define PH_MASK 16383
#endif
#define AS4 __attribute__((address_space(4)))
struct KP { const char AS4* p;
    __device__ __forceinline__ const float* in(int i) const { return *(const float* const AS4*)(p + 8 * i); }
    __device__ __forceinline__ float* out() const { return *(float* const AS4*)(p + 320); }
    __device__ __forceinline__ unsigned char* ws() const { return *(unsigned char* const AS4*)(p + 328); }
};
static_assert(sizeof(Args) == 344, "Args layout");

__device__ __forceinline__ void phase_prologue(const KP kp, LAS unsigned char* lds, int gw, int NGW, int wave, int lane) {
    unsigned char* ws = kp.ws();
    LAS float* scr = (LAS float*)(lds + wave * 17408);
    SEC_BEGIN(1)
    SEC_BEGIN(14)
    for (int job = 0; job < 16; ++job) {
        if (job == 2) { SEC_END(14, lds) }
        const float* W; int K = 2048, Nsrc = 2048, Npad = 2048, mapid = 0; bf16* WT; const float* gain = nullptr;
        if (job < 2)       { W = kp.in(13) + (size_t)job * 2048 * 7200; Nsrc = 7200; Npad = NAB; mapid = 1; WT = (bf16*)(ws + WS_WABIN) + (size_t)job * NAB * 2048; gain = kp.in(11) + (size_t)(2 * job) * DM; }
        else if (job < 4)  { W = kp.in(21) + (size_t)(job - 2) * 2048 * 2048; WT = (bf16*)(ws + WS_WABOUT) + (size_t)(job - 2) * 2048 * 2048; }
        else if (job < 6)  { W = kp.in(22) + (size_t)(job - 4) * 2048 * 4624; Nsrc = 4624; Npad = NCD; mapid = 2; WT = (bf16*)(ws + WS_WCDIN) + (size_t)(job - 4) * NCD * 2048; gain = kp.in(11) + (size_t)(2 * (job - 4) + 1) * DM; }
        else if (job < 8)  { W = kp.in(36) + (size_t)(job - 6) * 2048 * 2048; WT = (bf16*)(ws + WS_WCDOUT) + (size_t)(job - 6) * 2048 * 2048; }
        else if (job < 12) { W = kp.in(39) + (size_t)(job - 8) * 2048 * 2048; WT = (bf16*)(ws + WS_WGATE) + (size_t)(job - 8) * 2048 * 2048; gain = kp.in(38) + (size_t)(job - 8) * DM; }
        else               { W = kp.in(37) + (size_t)(job - 12) * 256 * 2048; K = 256; WT = (bf16*)(ws + WS_WPROJ) + (size_t)(job - 12) * 2048 * 256; }
        const int nitems = (K / 64) * (Npad / 64), nblocks = NGW / NWAVES, ipb = (nitems + nblocks - 1) / nblocks, ib = (gw / NWAVES) * ipb, ie = ib + ipb < nitems ? ib + ipb : nitems;
        for (int it = ib + wave; it < ie; it += NWAVES) transpose_item(W, K, Nsrc, WT, Npad, mapid, gain, scr, it, lane);
    }
    SEC_END(1, lds)
    SEC_BEGIN(2)
    bf16* HB = (bf16*)(ws + WS_XN); float* RSS = (float*)(ws + WS_RSS);
    for (int m = gw; m < T; m += NGW) {
        const float* src = m < TP ? kp.in(0) + (size_t)m * DM : kp.in(1) + (size_t)(m - TP) * DM;
        float ss = 0.f;
#pragma unroll
        for (int jj = 0; jj < 8; ++jj) { const int col = 4 * (lane + 64 * jj); const f32x4 v = *(const f32x4*)(src + col);
            u32x2 o; o.x = pk2(v.x, v.y); o.y = pk2(v.z, v.w); *(u32x2*)(HB + (size_t)m * DM + col) = o; ss += (v.x * v.x + v.y * v.y) + (v.z * v.z + v.w * v.w); }
        ss = wave_sum(ss); if (lane == 0) RSS[m] = ss;
    }
    bf16* PB = (bf16*)(ws + WS_PB);
    const int gt = gw * 64 + lane, NGT = NGW * 64;
    for (int i = gt; i < 4 * T * 64; i += NGT) {
        const int c4 = i & 63, rr = i >> 6, li = rr / T, r = rr - li * T;
        const float* src = r < TP ? kp.in(9) + ((size_t)li * TP + r) * 256 + 4 * c4 : kp.in(10) + ((size_t)li * TS + (r - TP)) * 256 + 4 * c4;
        const f32x4 v = *(const f32x4*)src;
        u32x2 o; o.x = pk2(v.x, v.y); o.y = pk2(v.z, v.w);
        *(u32x2*)(PB + ((size_t)li * T + r) * 256 + 4 * c4) = o;
    }
    SEC_END(2, lds)
}
__device__ __forceinline__ void phase_final(const KP kp, int gw, int NGW, int lane) {
    const bf16* HB = (const bf16*)(kp.ws() + WS_XN); const float* RSS = (const float*)(kp.ws() + WS_RSS) + (size_t)8 * T; const float* g = kp.in(12); float* out = kp.out();
    for (int m = gw; m < T; m += NGW) { const float rstd = rsqrtf(RSS[m] * (1.f / DM) + 1e-6f);
#pragma unroll
        for (int jj = 0; jj < 8; ++jj) { const int col = 4 * (lane + 64 * jj); const u32x2 hv = *(const u32x2*)(HB + (size_t)m * DM + col); const f32x4 gg = *(const f32x4*)(g + col);
            f32x4 o; o.x = __uint_as_float(hv.x << 16) * rstd * gg.x; o.y = __uint_as_float(hv.x & 0xffff0000u) * rstd * gg.y; o.z = __uint_as_float(hv.y << 16) * rstd * gg.z; o.w = __uint_as_float(hv.y & 0xffff0000u) * rstd * gg.w;
            *(f32x4*)(out + (size_t)m * DM + col) = o; } }
}

__device__ __forceinline__ void phase_ab_pre(const KP kp, const int bid, const int G, int j, int tid, int wave, int lane) {
    unsigned char* scr = kp.ws() + WS_SCR; const bf16* U = (const bf16*)(kp.ws() + WS_U);
    float* QN = (float*)(scr + SC_QN) - (size_t)TP * 1024; float* KN = (float*)(scr + SC_KN) - (size_t)TP * 1024; float* VV = (float*)(scr + SC_VV) - (size_t)TP * 1024;
    float* GLOG = (float*)(scr + SC_GLOG) - (size_t)TP * 512; float* BETA = (float*)(scr + SC_BETA) - (size_t)TP * 8; float* GDEC = (float*)(scr + SC_GDEC) - (size_t)TP * 8;
    const float* cw = kp.in(14) + (size_t)j * 4 * 3072; const float* stc = kp.in(3) + (size_t)j * 128 * 3 * 3072;
    const float* wa2 = kp.in(18) + (size_t)j * 16 * 512; const float* ba = kp.in(19) + (size_t)j * 512;
    for (int r = TP + bid; r < T; r += G) {
        int s, t; row_to_seq(r, s, t); const int row0 = r - t;
#pragma unroll
        for (int part = 0; part < 3; ++part) {
            float val[2];
#pragma unroll
            for (int i = 0; i < 2; ++i) { const int c = part * 1024 + wave * 128 + lane + 64 * i; float acc = 0.f;
#pragma unroll
                for (int tap = 0; tap < 4; ++tap) acc += cw[tap * 3072 + c] * pre_val(U, NAB, c, row0, t - 3 + tap, s, stc, 3072, c);
                val[i] = silu_(acc); }
            if (part < 2) { const float ss = wave_sum(val[0] * val[0] + val[1] * val[1]); const float sc = rsqrtf(ss + 1e-6f) * (part == 0 ? 0.08838834764831845f : 1.f); val[0] *= sc; val[1] *= sc; }
            float* dst = part == 0 ? QN : (part == 1 ? KN : VV);
            dst[(size_t)r * 1024 + wave * 128 + lane] = val[0]; dst[(size_t)r * 1024 + wave * 128 + lane + 64] = val[1];
        }
        if (tid < 8) {
            BETA[(size_t)r * 8 + tid] = sigmoid_(bf2f(U[(size_t)r * NAB + 7168 + tid]));
            GDEC[(size_t)r * 8 + tid] = -__expf(kp.in(15)[j * 8 + tid]) * softplus_(bf2f(U[(size_t)r * NAB + 7176 + tid]) + kp.in(16)[j * 8 + tid]);
        }
        { float x = ba[tid];
#pragma unroll
          for (int rr = 0; rr < 16; ++rr) x += bf2f(U[(size_t)r * NAB + 7184 + rr]) * wa2[rr * 512 + tid];
          GLOG[(size_t)r * 512 + tid] = -softplus_(-x) * (1.f / 16.f); }
    }
}


constexpr size_t GLA_ITEM_BYTES = 74752, WS_GLAOPS = WS_H;
__device__ __forceinline__ void phase_gla_prep(const KP kp, const int bid, const int G, int j, LAS unsigned char* lds, int tid0) {
    const bf16* U = (const bf16*)(kp.ws() + WS_U);
    const float* wa2 = kp.in(18) + (size_t)j * 16 * 512; const float* ba = kp.in(19) + (size_t)j * 512;
    unsigned char* OPS = kp.ws() + WS_GLAOPS;
    LAS float* GE = (LAS float*)lds; LAS float* Pg = GE + 128;
    LAS bf16* Qg = (LAS bf16*)(Pg + 512); LAS bf16* Ka = Qg + 64 * 136; LAS float* QKm = (LAS float*)(Ka + 64 * 136);
    for (int item = bid; item < 512; item += G) {
        int tid = tid0; asm volatile("" : "+v"(tid));
        const int lane = tid & 63, r = lane & 31, hp = lane >> 5, wave = tid >> 6;
        const int b = item >> 7, n = (item >> 2) & 31, h = item & 3;
        const int row0 = b * 2048 + n * 64;
        __syncthreads();
        const int d = tid & 127, tg = tid >> 7, t0 = 16 * tg;
        float q[16], k[16], gl[16];
        { float w[16];
#pragma unroll
          for (int rr = 0; rr < 16; ++rr) w[rr] = wa2[rr * 512 + h * 128 + d];
          const float bias = ba[h * 128 + d];
#pragma unroll
          for (int t = 0; t < 16; ++t) { const size_t ro = (size_t)(row0 + t0 + t) * NAB;
              q[t] = bf2f(U[ro + 4096 + h * 128 + d]) * 0.08838834764831845f; k[t] = bf2f(U[ro + 4608 + h * 128 + d]);
              const u32x4 g0 = *(const u32x4*)(U + ro + 7184), g1 = *(const u32x4*)(U + ro + 7192);
              float x = bias;
              x += __uint_as_float(g0.x << 16) * w[0] + __uint_as_float(g0.x & 0xffff0000u) * w[1] + __uint_as_float(g0.y << 16) * w[2] + __uint_as_float(g0.y & 0xffff0000u) * w[3];
              x += __uint_as_float(g0.z << 16) * w[4] + __uint_as_float(g0.z & 0xffff0000u) * w[5] + __uint_as_float(g0.w << 16) * w[6] + __uint_as_float(g0.w & 0xffff0000u) * w[7];
              x += __uint_as_float(g1.x << 16) * w[8] + __uint_as_float(g1.x & 0xffff0000u) * w[9] + __uint_as_float(g1.y << 16) * w[10] + __uint_as_float(g1.y & 0xffff0000u) * w[11];
              x += __uint_as_float(g1.z << 16) * w[12] + __uint_as_float(g1.z & 0xffff0000u) * w[13] + __uint_as_float(g1.w << 16) * w[14] + __uint_as_float(g1.w & 0xffff0000u) * w[15];
              gl[t] = -softplus_(-x) * (1.f / 16.f); } }
#pragma unroll
        for (int t = 1; t < 16; ++t) gl[t] += gl[t - 1];
        Pg[tg * 128 + d] = gl[15];
        __syncthreads();
        { float off = 0.f;
#pragma unroll
          for (int g = 0; g < 3; ++g) off += (g < tg) ? Pg[g * 128 + d] : 0.f;
          if (tg == 3) GE[d] = gl[15] + off;
#pragma unroll
          for (int t = 0; t < 16; ++t) { const float Gt = gl[t] + off; Qg[(t0 + t) * 136 + d] = (bf16)f2bf(q[t] * __expf(Gt)); Ka[(t0 + t) * 136 + d] = (bf16)f2bf(k[t] * __expf(-Gt)); } }
        __syncthreads();
        bf16x8* base = (bf16x8*)(OPS + (size_t)item * GLA_ITEM_BYTES);
        if (wave < 4) {
            const int mt = wave >> 1, nt = wave & 1;
            f32x16 acc;
#pragma unroll
            for (int i = 0; i < 16; ++i) acc[i] = 0.f;
#pragma unroll
            for (int ks = 0; ks < 8; ++ks) acc = MFMA32(*(const LAS bf16x8*)(Qg + (32 * mt + r) * 136 + 16 * ks + 8 * hp), *(const LAS bf16x8*)(Ka + (32 * nt + r) * 136 + 16 * ks + 8 * hp), acc);
            const int jt = 32 * nt + r;
#pragma unroll
            for (int i16 = 0; i16 < 16; ++i16) { const int i = 32 * mt + crow(i16, hp); QKm[i * 65 + jt] = jt <= i ? acc[i16] : 0.f; }
        } else {
            const int w4 = wave - 4;
#pragma unroll
            for (int q8 = 0; q8 < 8; ++q8) { const int f = w4 + 4 * q8, nt = f >> 2, ks = f & 3, p = 32 * nt + r;
                unsigned w[4];
#pragma unroll
                for (int jp = 0; jp < 8; jp += 2) { const int tk = 16 * ks + 8 * (jp >> 2) + 4 * hp + (jp & 3);
                    w[jp >> 1] = (unsigned)U[(size_t)(row0 + tk) * NAB + 5120 + h * 256 + p] | ((unsigned)U[(size_t)(row0 + tk + 1) * NAB + 5120 + h * 256 + p] << 16); }
                base[(40 + f) * 64 + lane] = __builtin_bit_cast(bf16x8, (u32x4){w[0], w[1], w[2], w[3]}); }
        }
        __syncthreads();
        float v[8];
#pragma unroll
        for (int q2 = 0; q2 < 2; ++q2) { const int f = wave + 8 * q2;
            { const int mt = f >> 3, ks = f & 7, i = 32 * mt + r;
              const u32x2 lo = *(const LAS u32x2*)(Qg + i * 136 + 16 * ks + 4 * hp), hi = *(const LAS u32x2*)(Qg + i * 136 + 16 * ks + 8 + 4 * hp);
              base[f * 64 + lane] = __builtin_bit_cast(bf16x8, (u32x4){lo.x, lo.y, hi.x, hi.y}); }
            { const int mt = f >> 2, ks = f & 3, dd = 32 * mt + r; const float eg = __expf(GE[dd]);
#pragma unroll
              for (int jp = 0; jp < 8; ++jp) v[jp] = bf2f(Ka[(16 * ks + 8 * (jp >> 2) + 4 * hp + (jp & 3)) * 136 + dd]) * eg;
              base[(16 + f) * 64 + lane] = pack8(v); } }
        { const int f = wave, mt = f >> 2, ks = f & 3, i = 32 * mt + r;
#pragma unroll
          for (int jp = 0; jp < 8; ++jp) v[jp] = QKm[i * 65 + 16 * ks + 8 * (jp >> 2) + 4 * hp + (jp & 3)];
          base[(32 + f) * 64 + lane] = pack8(v); }
        if (tid < 128) ((float*)(base + 72 * 64))[tid] = __expf(GE[tid]);
    }
}

constexpr size_t DN_ITEM_BYTES = 74752;
__device__ __forceinline__ void phase_dn_prep(const KP kp, const int bid, const int G, int j, LAS unsigned char* lds, int tid0) {
    unsigned char* scr = kp.ws() + WS_SCR;
    const bf16* U = (const bf16*)(kp.ws() + WS_U); const float* cw = kp.in(14) + (size_t)j * 4 * 3072;
    unsigned char* OPS = scr + SC_DNOPS;
    LAS float* AMT = (LAS float*)lds; LAS float* GLs = AMT + 64 * 68; LAS float* BLs = GLs + 64; LAS float* SS = BLs + 64;
    LAS bf16* Kb = (LAS bf16*)(SS + 256); LAS bf16* Qb = Kb + 64 * 136; LAS float* QKm = (LAS float*)(Qb + 64 * 136); LAS float* XL = QKm + 64 * 65;
    for (int item = bid; item < 1024; item += G) {
        int tid = tid0; asm volatile("" : "+v"(tid));
        const int lane = tid & 63, r = lane & 31, hp = lane >> 5, wave = tid >> 6;
        const int b = item >> 8, n = (item >> 3) & 31, h = item & 7;
        const int row0 = b * 2048 + n * 64;
        __syncthreads();
        SEC_BEGIN(20)
        {
          const int t0 = 8 * wave; const bool first = (n == 0 && wave == 0);
          const long fo = first ? 0 : (long)NAB;
          float qa[8], qb[8], ka[8], kb[8];
#pragma unroll
          for (int part = 0; part < 3; ++part) { const int c = part * 1024 + h * 128 + 2 * lane;
              const float w0a = cw[c], w0b = cw[c + 1], w1a = cw[3072 + c], w1b = cw[3072 + c + 1], w2a = cw[2 * 3072 + c], w2b = cw[2 * 3072 + c + 1], w3a = cw[3 * 3072 + c], w3b = cw[3 * 3072 + c + 1];
              const bf16* up = U + (size_t)(row0 + t0) * NAB + c;
              unsigned raw[11];
              raw[0] = *(const unsigned*)(up - 3 * fo); raw[1] = *(const unsigned*)(up - 2 * fo); raw[2] = *(const unsigned*)(up - 1 * fo);
#pragma unroll
              for (int t = 0; t < 8; ++t) raw[3 + t] = *(const unsigned*)(up + (size_t)t * NAB);
              if (first) { raw[0] = 0u; raw[1] = 0u; raw[2] = 0u; }
#pragma unroll
              for (int t = 0; t < 8; ++t) {
                  const float ya = silu_(w0a * __uint_as_float(raw[t] << 16) + w1a * __uint_as_float(raw[t + 1] << 16) + w2a * __uint_as_float(raw[t + 2] << 16) + w3a * __uint_as_float(raw[t + 3] << 16));
                  const float yb = silu_(w0b * __uint_as_float(raw[t] & 0xffff0000u) + w1b * __uint_as_float(raw[t + 1] & 0xffff0000u) + w2b * __uint_as_float(raw[t + 2] & 0xffff0000u) + w3b * __uint_as_float(raw[t + 3] & 0xffff0000u));
                  if (part == 0) { qa[t] = ya; qb[t] = yb; } else if (part == 1) { ka[t] = ya; kb[t] = yb; } else { XL[(t0 + t) * 257 + 2 * lane] = ya; XL[(t0 + t) * 257 + 2 * lane + 1] = yb; } } }
#pragma unroll
          for (int t = 0; t < 8; ++t) { const float scq = rsqrtf(wave_sum(qa[t] * qa[t] + qb[t] * qb[t]) + 1e-6f) * 0.08838834764831845f, sck = rsqrtf(wave_sum(ka[t] * ka[t] + kb[t] * kb[t]) + 1e-6f);
              *(LAS unsigned*)(Qb + (t0 + t) * 136 + 2 * lane) = pk2(qa[t] * scq, qb[t] * scq); *(LAS unsigned*)(Kb + (t0 + t) * 136 + 2 * lane) = pk2(ka[t] * sck, kb[t] * sck); } }
        if (wave == 0) { const size_t ro = (size_t)(row0 + lane) * NAB;
            float gv = -__expf(kp.in(15)[j * 8 + h]) * softplus_(bf2f(U[ro + 7176 + h]) + kp.in(16)[j * 8 + h]);
#pragma unroll
            for (int o = 1; o < 64; o <<= 1) { const float tt = __shfl_up(gv, o); if (lane >= o) gv += tt; }
            GLs[lane] = gv; BLs[lane] = sigmoid_(bf2f(U[ro + 7168 + h])); }
        __syncthreads();
        SEC_END(20, lds)
        SEC_BEGIN(21)
        SEC_END(21, lds)
        SEC_BEGIN(22)
        bf16x8* base = (bf16x8*)(OPS + (size_t)item * DN_ITEM_BYTES);
        { const int which = wave >> 2, mt = (wave >> 1) & 1, nt = wave & 1;
          const LAS bf16* Asrc = which ? Qb : Kb;
          f32x16 acc;
#pragma unroll
          for (int i = 0; i < 16; ++i) acc[i] = 0.f;
#pragma unroll
          for (int ks = 0; ks < 8; ++ks) acc = MFMA32(*(const LAS bf16x8*)(Asrc + (32 * mt + r) * 136 + 16 * ks + 8 * hp), *(const LAS bf16x8*)(Kb + (32 * nt + r) * 136 + 16 * ks + 8 * hp), acc);
          const int jt = 32 * nt + r; const float gj = GLs[jt];
#pragma unroll
          for (int i16 = 0; i16 < 16; ++i16) { const int i = 32 * mt + crow(i16, hp); const float dec = __expf(GLs[i] - gj);
              if (which == 0) AMT[jt * 68 + i] = jt < i ? BLs[i] * acc[i16] * dec : 0.f; else QKm[i * 65 + jt] = jt <= i ? acc[i16] * dec : 0.f; } }
        __syncthreads();
        SEC_END(22, lds)
        SEC_BEGIN(23)
        if (tid < 256) {
            SECW_BEGIN(25)
            const int c = tid;
#pragma unroll
            for (int bi = 0; bi < 4; ++bi) {
                float acc[16];
#pragma unroll
                for (int ii = 0; ii < 16; ++ii) { const int i = 16 * bi + ii; const float be = BLs[i];
                    acc[ii] = c < 128 ? be * XL[i * 257 + c] : be * __expf(GLs[i]) * bf2f(Kb[i * 136 + (c - 128)]); }
#pragma unroll 4
                for (int jj = 0; jj < 16 * bi; ++jj) { const float xj = XL[jj * 257 + c];
#pragma unroll
                    for (int q = 0; q < 4; ++q) { const f32x4 a = *(const LAS f32x4*)(AMT + jj * 68 + 16 * bi + 4 * q);
                        acc[4 * q + 0] -= a[0] * xj; acc[4 * q + 1] -= a[1] * xj; acc[4 * q + 2] -= a[2] * xj; acc[4 * q + 3] -= a[3] * xj; } }
                float dg[120];
#pragma unroll
                for (int ii = 1; ii < 16; ++ii)
#pragma unroll
                    for (int jj = 0; jj < ii; ++jj) dg[ii * (ii - 1) / 2 + jj] = AMT[(16 * bi + jj) * 68 + 16 * bi + ii];
#pragma unroll
                for (int ii = 0; ii < 16; ++ii) { float x = acc[ii];
#pragma unroll
                    for (int jj = 0; jj < ii; ++jj) x -= dg[ii * (ii - 1) / 2 + jj] * acc[jj];
                    acc[ii] = x; }
#pragma unroll
                for (int ii = 0; ii < 16; ++ii) XL[(16 * bi + ii) * 257 + c] = acc[ii];
            }
            SECW_END(25, lds, 0)
        } else {
            SECW_BEGIN(26)
            const int w4 = wave - 4; float v[8];
#pragma unroll
            for (int q = 0; q < 4; ++q) { const int f = w4 + 4 * q;
                { const int mt = f >> 3, ks = f & 7, i = 32 * mt + r; const float eg = __expf(GLs[i]);
                  const bf16x8 qq = *(const LAS bf16x8*)(Qb + i * 136 + 16 * ks + 8 * hp);
#pragma unroll
                  for (int jp = 0; jp < 8; ++jp) v[jp] = bf2f(Qb[i * 136 + 16 * ks + 8 * (jp >> 2) + 4 * hp + (jp & 3)]) * eg;
                  (void)qq; base[(16 + f) * 64 + lane] = pack8(v); }
                { const int mt = f >> 2, ks = f & 3, d = 32 * mt + r; const float Gend = GLs[63];
#pragma unroll
                  for (int jp = 0; jp < 8; ++jp) { const int tk = 16 * ks + 8 * (jp >> 2) + 4 * hp + (jp & 3); v[jp] = bf2f(Kb[tk * 136 + d]) * __expf(Gend - GLs[tk]); }
                  base[(32 + f) * 64 + lane] = pack8(v); } }
#pragma unroll
            for (int q = 0; q < 2; ++q) { const int f = w4 + 4 * q, mt = f >> 2, ks = f & 3, i = 32 * mt + r;
#pragma unroll
                for (int jp = 0; jp < 8; ++jp) v[jp] = QKm[i * 65 + 16 * ks + 8 * (jp >> 2) + 4 * hp + (jp & 3)];
                base[(48 + f) * 64 + lane] = pack8(v); }
            if (tid == 256) *(float*)(base + 72 * 64) = __expf(GLs[63]);
            SECW_END(26, lds, 256)
        }
        __syncthreads();
        SEC_END(23, lds)
        SEC_BEGIN(24)
        float v[8];
#pragma unroll
        for (int q = 0; q < 2; ++q) { const int f = wave + 8 * q;
            { const int mt = f >> 3, ks = f & 7, i = 32 * mt + r;
#pragma unroll
              for (int jp = 0; jp < 8; ++jp) v[jp] = -XL[i * 257 + 128 + 16 * ks + 8 * (jp >> 2) + 4 * hp + (jp & 3)];
              base[f * 64 + lane] = pack8(v); }
            { const int pq = f & 1, tl = f >> 1, mt = tl >> 2, nt = tl & 3;
#pragma unroll
              for (int e = 0; e < 8; ++e) v[e] = XL[(32 * mt + crow(8 * pq + e, hp)) * 257 + 32 * nt + r];
              base[(56 + f) * 64 + lane] = pack8(v); } }
        SEC_END(24, lds)
    }
}

__device__ __forceinline__ void phase_ab_rec(const KP kp, const int bid, const int G, int j, int li, LAS unsigned char* lds, int tid0) {
    unsigned char* scr = kp.ws() + WS_SCR; const bf16* U = (const bf16*)(kp.ws() + WS_U);
    float* ODN = (float*)(scr + SC_ODN); float* OGLA = (float*)(scr + SC_OGLA);
    SEC_BEGIN(12)
    for (int item = bid; item < 64; item += G) {
        int tid = tid0; asm volatile("" : "+v"(tid));
        int s, h; bool isdn; int half = -1;
        if (item < 32) { isdn = false; s = item >> 3; h = (item >> 1) & 3; half = item & 1; }
        else if (item < 64) { isdn = true; s = (item - 32) >> 3; h = (item - 32) & 7; half = -2; }
        else if (item < 1088) { isdn = true; s = 4 + ((item - 64) >> 3); h = (item - 64) & 7; }
        else { isdn = false; s = 4 + ((item - 1088) >> 2); h = (item - 1088) & 3; }
        int row0, L; seq_info(s, row0, L);
        __syncthreads();
        if (half == -2) {
            const int wave = __builtin_amdgcn_readfirstlane(tid >> 6), lane = tid & 63, r = lane & 31, hp = lane >> 5;
            const int b = s, nt = wave;
            const unsigned char* OPS = scr + SC_DNOPS;
            constexpr int DBUF = 73 * 1024;
#define DN_DMA(n_, bufi_) do { const unsigned char* gi_ = OPS + (size_t)((b * 32 + (n_)) * 8 + h) * DN_ITEM_BYTES + lane * 16; \
                _Pragma("unroll") for (int q_ = 0; q_ < 10; ++q_) { const int lf_ = wave + 8 * q_; if (lf_ < 73) \
                    __builtin_amdgcn_global_load_lds((const unsigned*)(gi_ + lf_ * 1024), (LAS unsigned*)(lds + (bufi_) * DBUF + lf_ * 1024), 16, 0, 2); } } while (0)
            f32x16 S0, S1, S2, S3;
#pragma unroll
            for (int i = 0; i < 16; ++i) { S0[i] = 0.f; S1[i] = 0.f; S2[i] = 0.f; S3[i] = 0.f; }
            DN_DMA(0, 0);
            asm volatile("s_waitcnt vmcnt(0)" ::: "memory"); __syncthreads();
            for (int n = 0; n < 32; ++n) {
                if (n + 1 < 32) DN_DMA(n + 1, (n + 1) & 1);
                if (wave < 4) {
                    const LAS bf16x8* F = (const LAS bf16x8*)(lds + (n & 1) * DBUF) + lane;
                    const float gend = *(const LAS float*)(lds + (n & 1) * DBUF + 72 * 1024);
                    const bf16x8 sb0 = PACK_ACC(S0, 0), sb1 = PACK_ACC(S0, 1), sb2 = PACK_ACC(S1, 0), sb3 = PACK_ACC(S1, 1), sb4 = PACK_ACC(S2, 0), sb5 = PACK_ACC(S2, 1), sb6 = PACK_ACC(S3, 0), sb7 = PACK_ACC(S3, 1);
                    f32x16 U0t, U1t;
                    { const bf16x8 a0 = F[(56 + nt * 2 + 0) * 64], a1 = F[(56 + nt * 2 + 1) * 64], c0 = F[(56 + (4 + nt) * 2 + 0) * 64], c1 = F[(56 + (4 + nt) * 2 + 1) * 64];
#pragma unroll
                      for (int e = 0; e < 8; ++e) { U0t[e] = bf2f((bf16)a0[e]); U0t[8 + e] = bf2f((bf16)a1[e]); U1t[e] = bf2f((bf16)c0[e]); U1t[8 + e] = bf2f((bf16)c1[e]); } }
                    U0t = MFMA32(F[0 * 64], sb0, U0t); U0t = MFMA32(F[1 * 64], sb1, U0t); U0t = MFMA32(F[2 * 64], sb2, U0t); U0t = MFMA32(F[3 * 64], sb3, U0t);
                    U0t = MFMA32(F[4 * 64], sb4, U0t); U0t = MFMA32(F[5 * 64], sb5, U0t); U0t = MFMA32(F[6 * 64], sb6, U0t); U0t = MFMA32(F[7 * 64], sb7, U0t);
                    U1t = MFMA32(F[8 * 64], sb0, U1t); U1t = MFMA32(F[9 * 64], sb1, U1t); U1t = MFMA32(F[10 * 64], sb2, U1t); U1t = MFMA32(F[11 * 64], sb3, U1t);
                    U1t = MFMA32(F[12 * 64], sb4, U1t); U1t = MFMA32(F[13 * 64], sb5, U1t); U1t = MFMA32(F[14 * 64], sb6, U1t); U1t = MFMA32(F[15 * 64], sb7, U1t);
                    const bf16x8 ub0 = PACK_ACC(U0t, 0), ub1 = PACK_ACC(U0t, 1), ub2 = PACK_ACC(U1t, 0), ub3 = PACK_ACC(U1t, 1);
                    f32x16 O0, O1;
#pragma unroll
                    for (int i = 0; i < 16; ++i) { O0[i] = 0.f; O1[i] = 0.f; }
                    O0 = MFMA32(F[16 * 64], sb0, O0); O0 = MFMA32(F[17 * 64], sb1, O0); O0 = MFMA32(F[18 * 64], sb2, O0); O0 = MFMA32(F[19 * 64], sb3, O0);
                    O0 = MFMA32(F[20 * 64], sb4, O0); O0 = MFMA32(F[21 * 64], sb5, O0); O0 = MFMA32(F[22 * 64], sb6, O0); O0 = MFMA32(F[23 * 64], sb7, O0);
                    O1 = MFMA32(F[24 * 64], sb0, O1); O1 = MFMA32(F[25 * 64], sb1, O1); O1 = MFMA32(F[26 * 64], sb2, O1); O1 = MFMA32(F[27 * 64], sb3, O1);
                    O1 = MFMA32(F[28 * 64], sb4, O1); O1 = MFMA32(F[29 * 64], sb5, O1); O1 = MFMA32(F[30 * 64], sb6, O1); O1 = MFMA32(F[31 * 64], sb7, O1);
                    O0 = MFMA32(F[48 * 64], ub0, O0); O0 = MFMA32(F[49 * 64], ub1, O0);
                    O1 = MFMA32(F[52 * 64], ub0, O1); O1 = MFMA32(F[53 * 64], ub1, O1); O1 = MFMA32(F[54 * 64], ub2, O1); O1 = MFMA32(F[55 * 64], ub3, O1);
#pragma unroll
                    for (int i = 0; i < 16; ++i) { S0[i] *= gend; S1[i] *= gend; S2[i] *= gend; S3[i] *= gend; }
                    S0 = MFMA32(F[32 * 64], ub0, S0); S0 = MFMA32(F[33 * 64], ub1, S0); S0 = MFMA32(F[34 * 64], ub2, S0); S0 = MFMA32(F[35 * 64], ub3, S0);
                    S1 = MFMA32(F[36 * 64], ub0, S1); S1 = MFMA32(F[37 * 64], ub1, S1); S1 = MFMA32(F[38 * 64], ub2, S1); S1 = MFMA32(F[39 * 64], ub3, S1);
                    S2 = MFMA32(F[40 * 64], ub0, S2); S2 = MFMA32(F[41 * 64], ub1, S2); S2 = MFMA32(F[42 * 64], ub2, S2); S2 = MFMA32(F[43 * 64], ub3, S2);
                    S3 = MFMA32(F[44 * 64], ub0, S3); S3 = MFMA32(F[45 * 64], ub1, S3); S3 = MFMA32(F[46 * 64], ub2, S3); S3 = MFMA32(F[47 * 64], ub3, S3);
                    float* yo = ODN + (size_t)(b * 2048 + n * 64) * 1024 + h * 128 + 32 * nt + r;
#pragma unroll
                    for (int i = 0; i < 16; ++i) { yo[(size_t)crow(i, hp) * 1024] = O0[i]; yo[(size_t)(32 + crow(i, hp)) * 1024] = O1[i]; }
                }
                asm volatile("s_waitcnt vmcnt(0)" ::: "memory"); __syncthreads();
            }
#undef DN_DMA
            if (wave < 4) {
                float* dst = kp.out() + O_DN_P + ((size_t)j * 4 + b) * ((size_t)8 * 128 * 128) + (size_t)h * 128 * 128 + 32 * nt + r;
#pragma unroll
                for (int i = 0; i < 16; ++i) { dst[(size_t)crow(i, hp) * 128] = S0[i]; dst[(size_t)(32 + crow(i, hp)) * 128] = S1[i]; dst[(size_t)(64 + crow(i, hp)) * 128] = S2[i]; dst[(size_t)(96 + crow(i, hp)) * 128] = S3[i]; }
            }
        } else if (half >= 0) {
            const int wave = __builtin_amdgcn_readfirstlane(tid >> 6), lane = tid & 63, r = lane & 31, hp = lane >> 5;
            const int b = s, nt = half * 4 + wave;
            const unsigned char* OPS = kp.ws() + WS_GLAOPS;
            constexpr int GBUF = 57 * 1024;
#define GLA_DMA(n_, bufi_) do { const unsigned char* gi_ = OPS + (size_t)((b * 32 + (n_)) * 4 + h) * GLA_ITEM_BYTES + lane * 16; \
                _Pragma("unroll") for (int q_ = 0; q_ < 8; ++q_) { const int lf_ = wave + 8 * q_; if (lf_ < 57) { const int gf_ = lf_ < 40 ? lf_ : (lf_ < 56 ? lf_ + half * 16 : 72); \
                    __builtin_amdgcn_global_load_lds((const unsigned*)(gi_ + gf_ * 1024), (LAS unsigned*)(lds + (bufi_) * GBUF + lf_ * 1024), 16, 0, 2); } } } while (0)
            f32x16 S0, S1, S2, S3;
#pragma unroll
            for (int i = 0; i < 16; ++i) { S0[i] = 0.f; S1[i] = 0.f; S2[i] = 0.f; S3[i] = 0.f; }
            GLA_DMA(0, 0);
            asm volatile("s_waitcnt vmcnt(0)" ::: "memory"); __syncthreads();
            for (int n = 0; n < 32; ++n) {
                if (n + 1 < 32) GLA_DMA(n + 1, (n + 1) & 1);
                if (wave < 4) {
                    const LAS bf16x8* F = (const LAS bf16x8*)(lds + (n & 1) * GBUF) + lane;
                    const LAS float* ge = (const LAS float*)(lds + (n & 1) * GBUF + 56 * 1024) + 4 * hp;
                    const bf16x8 sb0 = PACK_ACC(S0, 0), sb1 = PACK_ACC(S0, 1), sb2 = PACK_ACC(S1, 0), sb3 = PACK_ACC(S1, 1), sb4 = PACK_ACC(S2, 0), sb5 = PACK_ACC(S2, 1), sb6 = PACK_ACC(S3, 0), sb7 = PACK_ACC(S3, 1);
                    f32x16 O0, O1;
#pragma unroll
                    for (int i = 0; i < 16; ++i) { O0[i] = 0.f; O1[i] = 0.f; }
                    O0 = MFMA32(F[0 * 64], sb0, O0); O0 = MFMA32(F[1 * 64], sb1, O0); O0 = MFMA32(F[2 * 64], sb2, O0); O0 = MFMA32(F[3 * 64], sb3, O0);
                    O0 = MFMA32(F[4 * 64], sb4, O0); O0 = MFMA32(F[5 * 64], sb5, O0); O0 = MFMA32(F[6 * 64], sb6, O0); O0 = MFMA32(F[7 * 64], sb7, O0);
                    O1 = MFMA32(F[8 * 64], sb0, O1); O1 = MFMA32(F[9 * 64], sb1, O1); O1 = MFMA32(F[10 * 64], sb2, O1); O1 = MFMA32(F[11 * 64], sb3, O1);
                    O1 = MFMA32(F[12 * 64], sb4, O1); O1 = MFMA32(F[13 * 64], sb5, O1); O1 = MFMA32(F[14 * 64], sb6, O1); O1 = MFMA32(F[15 * 64], sb7, O1);
                    bf16x8 vb[4];
#pragma unroll
                    for (int ks = 0; ks < 4; ++ks) vb[ks] = F[(40 + wave * 4 + ks) * 64];
                    O0 = MFMA32(F[32 * 64], vb[0], O0); O0 = MFMA32(F[33 * 64], vb[1], O0);
#pragma unroll
                    for (int ks = 0; ks < 4; ++ks) O1 = MFMA32(F[(36 + ks) * 64], vb[ks], O1);
#pragma unroll
                    for (int q = 0; q < 4; ++q) { const f32x4 g0 = *(const LAS f32x4*)(ge + 8 * q), g1 = *(const LAS f32x4*)(ge + 32 + 8 * q), g2 = *(const LAS f32x4*)(ge + 64 + 8 * q), g3 = *(const LAS f32x4*)(ge + 96 + 8 * q);
#pragma unroll
                        for (int c = 0; c < 4; ++c) { S0[4 * q + c] *= g0[c]; S1[4 * q + c] *= g1[c]; S2[4 * q + c] *= g2[c]; S3[4 * q + c] *= g3[c]; } }
#pragma unroll
                    for (int ks = 0; ks < 4; ++ks) { S0 = MFMA32(F[(16 + ks) * 64], vb[ks], S0); S1 = MFMA32(F[(20 + ks) * 64], vb[ks], S1); S2 = MFMA32(F[(24 + ks) * 64], vb[ks], S2); S3 = MFMA32(F[(28 + ks) * 64], vb[ks], S3); }
                    float* yo = OGLA + (size_t)(b * 2048 + n * 64) * 1024 + h * 256 + 32 * nt + r;
#pragma unroll
                    for (int i = 0; i < 16; ++i) { yo[(size_t)crow(i, hp) * 1024] = O0[i]; yo[(size_t)(32 + crow(i, hp)) * 1024] = O1[i]; }
                }
                asm volatile("s_waitcnt vmcnt(0)" ::: "memory"); __syncthreads();
            }
#undef GLA_DMA
            if (wave < 4) {
                float* dst = kp.out() + O_GLA_P + ((size_t)j * 4 + b) * ((size_t)4 * 128 * 256) + (size_t)h * 128 * 256 + 32 * nt + r;
#pragma unroll
                for (int i = 0; i < 16; ++i) { dst[(size_t)crow(i, hp) * 256] = S0[i]; dst[(size_t)(32 + crow(i, hp)) * 256] = S1[i]; dst[(size_t)(64 + crow(i, hp)) * 256] = S2[i]; dst[(size_t)(96 + crow(i, hp)) * 256] = S3[i]; }
            }
        } else
        {}
    }
    SEC_END(12, lds)
    SEC_BEGIN(13)
    unsigned* qhead = (unsigned*)(kp.ws() + WS_CTL) + CW_CNT + 64 * li;
    volatile LAS unsigned* qslot = (volatile LAS unsigned*)(lds + LDS_BYTES - 8);
    const float* cw = kp.in(14) + (size_t)j * 4 * 3072; const float* stc = kp.in(3) + (size_t)j * 128 * 3 * 3072;
    const float* wa2 = kp.in(18) + (size_t)j * 16 * 512; const float* ba = kp.in(19) + (size_t)j * 512;
    for (;;) {
        __syncthreads();
        if (tid0 == 0) qslot[0] = __hip_atomic_fetch_add(qhead, 1u, __ATOMIC_RELAXED, __HIP_MEMORY_SCOPE_AGENT);
        __syncthreads();
        const int it = (int)qslot[0];
        if (it >= 1536) break;
        int tid = tid0; asm volatile("" : "+v"(tid));
        const int wave = tid >> 6, lane = tid & 63;
        if (it < 1024) {
            const int bs = it >> 3, h = it & 7, sq = 4 + bs, r0 = TP + bs * 4;
            LAS float* qL = (LAS float*)lds; LAS float* kL = qL + 512; LAS float* vL = kL + 512; LAS float* red = vL + 512; LAS float* sm = red + 4096;
            const int e = tid & 127, dq = tid >> 7;
            const size_t SZ = (size_t)8 * 128 * 128;
            const float* st = kp.in(2) + ((size_t)j * 128 + bs) * SZ + (size_t)h * 16384;
            float S[32];
            { const float* sp = st + (size_t)(dq * 32) * 128 + e;
#pragma unroll
              for (int i = 0; i < 32; ++i) { S[i] = *sp; sp += 128; asm volatile("" : "+v"(sp)); } }
#pragma unroll
            for (int part = 0; part < 3; ++part) { const int c = part * 1024 + h * 128 + e; float acc = 0.f;
#pragma unroll
                for (int tap = 0; tap < 4; ++tap) acc += cw[tap * 3072 + c] * pre_val(U, NAB, c, r0, dq - 3 + tap, sq, stc, 3072, c);
                if (part == 2) vL[dq * 128 + e] = silu_(acc); else (part == 0 ? qL : kL)[e * 4 + dq] = silu_(acc); }
            if (tid < 4) { const size_t ro = (size_t)(r0 + tid) * NAB;
                sm[32 + tid] = -__expf(kp.in(15)[j * 8 + h]) * softplus_(bf2f(U[ro + 7176 + h]) + kp.in(16)[j * 8 + h]); sm[36 + tid] = sigmoid_(bf2f(U[ro + 7168 + h])); }
            __syncthreads();
            { const int tk = wave & 3; LAS float* src = (wave >> 2) ? kL : qL; const float a = src[lane * 4 + tk], b = src[(lane + 64) * 4 + tk];
              const float sc = rsqrtf(wave_sum(a * a + b * b) + 1e-6f) * ((wave >> 2) ? 1.f : 0.08838834764831845f); src[lane * 4 + tk] = a * sc; src[(lane + 64) * 4 + tk] = b * sc; }
            __syncthreads();
#pragma unroll
            for (int q = 0; q < 4; ++q) { const int idx = wave * 4 + q, i = (idx >> 2) & 3, jj = idx & 3; const LAS float* src = idx < 16 ? kL : qL;
                const float dot = wave_sum(src[lane * 4 + i] * kL[lane * 4 + jj] + src[(lane + 64) * 4 + i] * kL[(lane + 64) * 4 + jj]); if (lane == 0) sm[idx] = dot; }
            float ks[4] = {0.f, 0.f, 0.f, 0.f}, qs[4] = {0.f, 0.f, 0.f, 0.f};
#pragma unroll
            for (int i = 0; i < 32; ++i) { const int d = dq * 32 + i; const float sv = S[i]; const f32x4 k4 = *(const LAS f32x4*)(kL + d * 4), q4 = *(const LAS f32x4*)(qL + d * 4);
#pragma unroll
                for (int t = 0; t < 4; ++t) { ks[t] += k4[t] * sv; qs[t] += q4[t] * sv; } }
#pragma unroll
            for (int t = 0; t < 4; ++t) { red[(t * 4 + dq) * 128 + e] = ks[t]; red[((4 + t) * 4 + dq) * 128 + e] = qs[t]; }
            __syncthreads();
            float Gc[4]; Gc[0] = sm[32]; Gc[1] = Gc[0] + sm[33]; Gc[2] = Gc[1] + sm[34]; Gc[3] = Gc[2] + sm[35];
            float u[4];
#pragma unroll
            for (int i = 0; i < 4; ++i) { const float KSi = (red[(i * 4 + 0) * 128 + e] + red[(i * 4 + 1) * 128 + e]) + (red[(i * 4 + 2) * 128 + e] + red[(i * 4 + 3) * 128 + e]);
                float acc = vL[i * 128 + e] - __expf(Gc[i]) * KSi;
#pragma unroll
                for (int jj = 0; jj < i; ++jj) acc -= sm[i * 4 + jj] * __expf(Gc[i] - Gc[jj]) * u[jj];
                u[i] = sm[36 + i] * acc; }
            if (dq == 0) {
#pragma unroll
                for (int i = 0; i < 4; ++i) { const float QSi = (red[((4 + i) * 4 + 0) * 128 + e] + red[((4 + i) * 4 + 1) * 128 + e]) + (red[((4 + i) * 4 + 2) * 128 + e] + red[((4 + i) * 4 + 3) * 128 + e]);
                    float o = __expf(Gc[i]) * QSi;
#pragma unroll
                    for (int jj = 0; jj <= i; ++jj) o += sm[16 + i * 4 + jj] * __expf(Gc[i] - Gc[jj]) * u[jj];
                    ODN[(size_t)(r0 + i) * 1024 + h * 128 + e] = o; } }
            const float eg = __expf(Gc[3]); float w[4];
#pragma unroll
            for (int jj = 0; jj < 4; ++jj) w[jj] = __expf(Gc[3] - Gc[jj]) * u[jj];
            float* dst = kp.out() + O_DN_S + ((size_t)j * 128 + bs) * SZ + (size_t)h * 16384 + (size_t)(dq * 32) * 128 + e;
#pragma unroll
            for (int i = 0; i < 32; ++i) { const int d = dq * 32 + i; float sv = eg * S[i]; const f32x4 k4 = *(const LAS f32x4*)(kL + d * 4);
#pragma unroll
                for (int jj = 0; jj < 4; ++jj) sv += k4[jj] * w[jj];
                *dst = sv; dst += 128; asm volatile("" : "+v"(dst)); }
        } else {
            const int q_ = it - 1024, bs = q_ >> 2, h = q_ & 3, r0 = TP + bs * 4;
            LAS float* qgL = (LAS float*)lds; LAS float* kaL = qgL + 512; LAS float* glL = kaL + 512; LAS float* egL = glL + 512; LAS float* Am = egL + 128; LAS float* red = Am + 16;
            const int e = tid & 255, dh = tid >> 8;
            const size_t SZ = (size_t)4 * 128 * 256;
            const float* st = kp.in(4) + ((size_t)j * 128 + bs) * SZ + (size_t)h * 32768;
            float S[64];
            { const float* sp = st + (size_t)(dh * 64) * 256 + e;
#pragma unroll
              for (int i = 0; i < 64; ++i) { S[i] = *sp; sp += 256; asm volatile("" : "+v"(sp)); } }
            float v[4];
#pragma unroll
            for (int t = 0; t < 4; ++t) v[t] = bf2f(U[(size_t)(r0 + t) * NAB + 5120 + h * 256 + e]);
            { const int d = tid & 127, tk = tid >> 7; const size_t ro = (size_t)(r0 + tk) * NAB;
              qgL[d * 4 + tk] = bf2f(U[ro + 4096 + h * 128 + d]) * 0.08838834764831845f; kaL[d * 4 + tk] = bf2f(U[ro + 4608 + h * 128 + d]);
              float x = ba[h * 128 + d];
#pragma unroll
              for (int rr = 0; rr < 16; ++rr) x += bf2f(U[ro + 7184 + rr]) * wa2[rr * 512 + h * 128 + d];
              glL[tk * 128 + d] = -softplus_(-x) * (1.f / 16.f); }
            __syncthreads();
            if (tid < 128) { float Gq = 0.f;
#pragma unroll
                for (int t = 0; t < 4; ++t) { Gq += glL[t * 128 + tid]; qgL[tid * 4 + t] *= __expf(Gq); kaL[tid * 4 + t] *= __expf(-Gq); }
                egL[tid] = __expf(Gq); }
            __syncthreads();
#pragma unroll
            for (int q = 0; q < 2; ++q) { const int idx = wave * 2 + q, i = idx >> 2, jj = idx & 3;
                const float dot = wave_sum(qgL[lane * 4 + i] * kaL[lane * 4 + jj] + qgL[(lane + 64) * 4 + i] * kaL[(lane + 64) * 4 + jj]); if (lane == 0) Am[idx] = dot; }
            float o[4] = {0.f, 0.f, 0.f, 0.f};
            float* dst = kp.out() + O_GLA_S + ((size_t)j * 128 + bs) * SZ + (size_t)h * 32768 + (size_t)(dh * 64) * 256 + e;
#pragma unroll
            for (int i = 0; i < 64; ++i) { const int d = dh * 64 + i; const float s0 = S[i]; float acc = s0; const f32x4 q4 = *(const LAS f32x4*)(qgL + d * 4), k4 = *(const LAS f32x4*)(kaL + d * 4);
#pragma unroll
                for (int t = 0; t < 4; ++t) { o[t] += q4[t] * s0; acc += k4[t] * v[t]; }
                *dst = egL[d] * acc; dst += 256; asm volatile("" : "+v"(dst)); }
#pragma unroll
            for (int t = 0; t < 4; ++t) red[(dh * 4 + t) * 256 + e] = o[t];
            __syncthreads();
            if (dh == 0) {
#pragma unroll
                for (int t = 0; t < 4; ++t) { float oo = red[t * 256 + e] + red[(4 + t) * 256 + e];
#pragma unroll
                    for (int jj = 0; jj <= t; ++jj) oo += Am[t * 4 + jj] * v[jj];
                    OGLA[(size_t)(r0 + t) * 1024 + h * 256 + e] = oo; } }
        }
    }
    SEC_END(13, lds)
}

__device__ __forceinline__ void phase_ab_post(const KP kp, const int bid, const int G, int j, int tid, int wave, int lane) {
    unsigned char* scr = kp.ws() + WS_SCR; const bf16* U = (const bf16*)(kp.ws() + WS_U); bf16* YM = (bf16*)(kp.ws() + WS_YM);
    const float* ODN = (const float*)(scr + SC_ODN); const float* OGLA = (const float*)(scr + SC_OGLA);
    const float* dnn = kp.in(17) + (size_t)j * 128; const float* glan = kp.in(20) + (size_t)j * 256;
    typedef float f32x2v __attribute__((ext_vector_type(2)));
    const f32x2v dg = *(const f32x2v*)(dnn + 2 * lane); const f32x4 gg = *(const f32x4*)(glan + 4 * lane);
    for (int idx = bid * NWAVES + wave; idx < T; idx += G * NWAVES) {
        const int gq_ = idx / 17, rq_ = idx - gq_ * 17, r = rq_ < 16 ? gq_ * 16 + rq_ : TP + gq_;
        int s, t; row_to_seq(r, s, t); int row0, L; seq_info(s, row0, L);
        const bf16* ur = U + (size_t)r * NAB; bf16* yr = YM + (size_t)r * DM;
        f32x2v od[8]; unsigned zd[8]; f32x4 og[4]; u32x2 zg[4];
#pragma unroll
        for (int hh = 0; hh < 8; ++hh) { od[hh] = *(const f32x2v*)(ODN + (size_t)r * 1024 + hh * 128 + 2 * lane); zd[hh] = *(const unsigned*)(ur + 3072 + hh * 128 + 2 * lane); }
#pragma unroll
        for (int hh = 0; hh < 4; ++hh) { og[hh] = *(const f32x4*)(OGLA + (size_t)r * 1024 + hh * 256 + 4 * lane); zg[hh] = *(const u32x2*)(ur + 6144 + hh * 256 + 4 * lane); }
#pragma unroll
        for (int hh = 0; hh < 8; ++hh) { const f32x2v o = od[hh];
            const float rstd = rsqrtf(wave_sum(o.x * o.x + o.y * o.y) * (1.f / 128.f) + 1e-6f);
            const unsigned zz = zd[hh];
            *(unsigned*)(yr + hh * 128 + 2 * lane) = pk2(o.x * rstd * dg.x * silu_(__uint_as_float(zz << 16)), o.y * rstd * dg.y * silu_(__uint_as_float(zz & 0xffff0000u))); }
#pragma unroll
        for (int hh = 0; hh < 4; ++hh) { const f32x4 o = og[hh];
            const float rstd = rsqrtf(wave_sum((o.x * o.x + o.y * o.y) + (o.z * o.z + o.w * o.w)) * (1.f / 256.f) + 1e-6f);
            const u32x2 zz = zg[hh];
            u32x2 w; w.x = pk2(o.x * rstd * gg.x * silu_(__uint_as_float(zz.x << 16)), o.y * rstd * gg.y * silu_(__uint_as_float(zz.x & 0xffff0000u)));
            w.y = pk2(o.z * rstd * gg.z * silu_(__uint_as_float(zz.y << 16)), o.w * rstd * gg.w * silu_(__uint_as_float(zz.y & 0xffff0000u)));
            *(u32x2*)(yr + 1024 + hh * 256 + 4 * lane) = w; }
        if (t >= L - 3) { const int rr = t - (L - 3);
            float* dst = s < 4 ? kp.out() + O_DNC_P + (((size_t)j * 4 + s) * 3 + rr) * 3072 : kp.out() + O_DNC_S + (((size_t)j * 128 + (s - 4)) * 3 + rr) * 3072;
            for (int c = 2 * lane; c < 3072; c += 128) { const unsigned uu = *(const unsigned*)(ur + c); *(f32x2v*)(dst + c) = (f32x2v){__uint_as_float(uu << 16), __uint_as_float(uu & 0xffff0000u)}; } }
    }
}

__device__ __forceinline__ void phase_cd_pre(const KP kp, const int bid, const int G, int j, LAS unsigned char* lds, int tid) {
    unsigned char* scr = kp.ws() + WS_SCR; const bf16* U = (const bf16*)(kp.ws() + WS_U);
    float* XBC = (float*)(scr + SC_XBC) - (size_t)TP * 1536; float* DT = (float*)(scr + SC_DT) - (size_t)TP * 16; bf16* XS = (bf16*)(scr + SC_XS);
    const float* cw = kp.in(23) + (size_t)j * 4 * 1536; const float* cb = kp.in(24) + (size_t)j * 1536; const float* stc = kp.in(6) + (size_t)j * 128 * 3 * 1536;
    for (int r = TP + bid; r < T; r += G) {
        int s, t; row_to_seq(r, s, t); const int row0 = r - t;
#pragma unroll
        for (int i = 0; i < 3; ++i) { const int c = tid + NTHR * i; float acc = cb[c];
#pragma unroll
            for (int tap = 0; tap < 4; ++tap) acc += cw[tap * 1536 + c] * pre_val(U, NCD, 1024 + c, row0, t - 3 + tap, s, stc, 1536, c);
            const float v = silu_(acc); XBC[(size_t)r * 1536 + c] = v; if (c < 1024) XS[(size_t)r * 1024 + c] = (bf16)f2bf(v); }
        if (tid < 16) DT[(size_t)r * 16 + tid] = softplus_(bf2f(U[(size_t)r * NCD + 4608 + tid]) + kp.in(26)[j * 16 + tid]);
    }
}

__device__ __forceinline__ void phase_lru_gates(const KP kp, const int bid, const int G, int j, LAS unsigned char* lds, int tid0) {
    unsigned char* scr = kp.ws() + WS_SCR; const bf16* U = (const bf16*)(kp.ws() + WS_U);
    float* LA = (float*)(scr + SC_LA); float* LB = (float*)(scr + SC_LB);
    const float* lcw = kp.in(29) + (size_t)j * 4 * 1024; const float* lcb = kp.in(30) + (size_t)j * 1024; const float* lstc = kp.in(8) + (size_t)j * 128 * 3 * 1024;
    const int n = bid & 15;
    const float* wa = kp.in(31) + ((size_t)j * 16 + n) * 4096; const float* wx = kp.in(33) + ((size_t)j * 16 + n) * 4096;
    const float* lba = kp.in(32) + (size_t)j * 1024; const float* lbx = kp.in(34) + (size_t)j * 1024; const float* lam = kp.in(35) + (size_t)j * 1024;
    LAS bf16x8* WF = (LAS bf16x8*)lds;
    LAS float* xcL = (LAS float*)(lds + 16384);
    LAS float* igL = xcL + 64 * 68;
    __syncthreads();
    { const int lane = tid0 & 63, f = tid0 >> 6, r = lane & 31, hp = lane >> 5, nt = f >> 2, ks = f & 3; float v[8];
#pragma unroll
      for (int jp = 0; jp < 8; ++jp) v[jp] = wa[(16 * ks + 8 * hp + jp) * 64 + 32 * nt + r];
      WF[f * 64 + lane] = pack8(v);
#pragma unroll
      for (int jp = 0; jp < 8; ++jp) v[jp] = wx[(16 * ks + 8 * hp + jp) * 64 + 32 * nt + r];
      WF[512 + f * 64 + lane] = pack8(v); }
    for (int tile = bid >> 4; tile < T / 64; tile += (G >> 4)) {
        int tid = tid0; asm volatile("" : "+v"(tid));
        const int c = tid & 63, tq = tid >> 6, ch = n * 64 + c, rowbase = tile * 64;
        __syncthreads();
        if (tile < TP / 64) {
            const int r0 = rowbase + tq * 8; const bool first = ((r0 & 2047) == 0);
            const float w0 = lcw[ch], w1 = lcw[1024 + ch], w2 = lcw[2048 + ch], w3 = lcw[3072 + ch], bb = lcb[ch];
            const bf16* up = U + (size_t)r0 * NCD + 3584 + ch;
            const long fo = first ? 0 : (long)NCD;
              float x0 = bf2f(up[-3 * fo]), x1 = bf2f(up[-2 * fo]), x2 = bf2f(up[-1 * fo]); if (first) { x0 = 0.f; x1 = 0.f; x2 = 0.f; }
#pragma unroll
            for (int tt = 0; tt < 8; ++tt) { const float x3 = bf2f(up[(size_t)tt * NCD]); xcL[(tq * 8 + tt) * 68 + c] = bb + w0 * x0 + w1 * x1 + w2 * x2 + w3 * x3; x0 = x1; x1 = x2; x2 = x3; }
        } else {
#pragma unroll 2
            for (int tt = 0; tt < 8; ++tt) { const int r = rowbase + tq * 8 + tt; int s, t; row_to_seq(r, s, t); const int row0 = r - t; float acc = lcb[ch];
#pragma unroll
                for (int tap = 0; tap < 4; ++tap) acc += lcw[tap * 1024 + ch] * pre_val(U, NCD, 3584 + ch, row0, t - 3 + tap, s, lstc, 1024, ch);
                xcL[(tq * 8 + tt) * 68 + c] = acc; }
        }
        __syncthreads();
        const int wave = __builtin_amdgcn_readfirstlane(tid >> 6), lane = tid & 63, r = lane & 31, hp = lane >> 5, mat = wave >> 2, mt = (wave >> 1) & 1, nt = wave & 1;
        f32x16 acc;
#pragma unroll
        for (int i = 0; i < 16; ++i) acc[i] = 0.f;
#pragma unroll
        for (int ks = 0; ks < 4; ++ks) { const LAS float* xp = xcL + (32 * mt + r) * 68 + 16 * ks + 8 * hp; const f32x4 xa = *(const LAS f32x4*)xp, xb = *(const LAS f32x4*)(xp + 4);
            const bf16x8 af = __builtin_bit_cast(bf16x8, (u32x4){cvtpk(xa.x, xa.y), cvtpk(xa.z, xa.w), cvtpk(xb.x, xb.y), cvtpk(xb.z, xb.w)});
            acc = MFMA32(af, WF[mat * 512 + (nt * 4 + ks) * 64 + lane], acc); }
        const int chh = n * 64 + 32 * nt + r;
        if (mat == 1) { const float bx = lbx[chh];
#pragma unroll
            for (int i = 0; i < 16; ++i) igL[(32 * mt + crow(i, hp)) * 65 + 32 * nt + r] = sigmoid_(acc[i] + bx); }
        __syncthreads();
        if (mat == 0) { const float ba = lba[chh], spl = softplus_(-lam[chh]);
#pragma unroll
            for (int i = 0; i < 16; ++i) { const int tk = 32 * mt + crow(i, hp); const size_t ro = (size_t)(rowbase + tk) * 1024 + chh;
                const float log_a = -8.f * sigmoid_(acc[i] + ba) * spl;
                LA[ro] = __expf(log_a); LB[ro] = __builtin_amdgcn_sqrtf(1.f - __expf(2.f * log_a)) * (igL[tk * 65 + 32 * nt + r] * xcL[tk * 68 + 32 * nt + r]); } }
    }
}

constexpr size_t SSD_ITEM_BYTES = 33792;
__device__ __forceinline__ void phase_ssd_prep(const KP kp, const int bid, const int G, int j, LAS unsigned char* lds, int tid0) {
    unsigned char* scr = kp.ws() + WS_SCR;
    const bf16* U = (const bf16*)(kp.ws() + WS_U); bf16* XS = (bf16*)(scr + SC_XS);
    const float* cw = kp.in(23) + (size_t)j * 4 * 1536; const float* cb = kp.in(24) + (size_t)j * 1536;
    unsigned char* OPS = scr + SC_SSDOP;
    LAS float* GL = (LAS float*)lds; LAS float* DTL = GL + 256; LAS float* QK = DTL + 256; LAS bf16* Cb = (LAS bf16*)(QK + 64 * 65); LAS bf16* Bb = Cb + 64 * 72; LAS float* XLs = (LAS float*)(Bb + 64 * 72);
    const float* alog = kp.in(25) + j * 16;
    for (int item = bid; item < 512; item += G) {
        int tid = tid0; asm volatile("" : "+v"(tid));
        const int wave = tid >> 6, lane = tid & 63, r = lane & 31, hp = lane >> 5;
        const int b = item >> 7, n = (item >> 2) & 31, g = item & 3;
        const int row0 = b * 2048 + n * 64;
        __syncthreads();
        {
          const int t0 = 8 * wave; const bool first = (n == 0 && wave == 0); const long fo = first ? 0 : (long)NCD;
#pragma unroll
          for (int q = 0; q < 3; ++q) { const int k = 2 * (lane + 64 * q);
              const int cidx = k < 64 ? 1024 + g * 64 + k : (k < 128 ? 1280 + g * 64 + (k - 64) : g * 256 + (k - 128));
              const float w0a = cw[cidx], w0b = cw[cidx + 1], w1a = cw[1536 + cidx], w1b = cw[1536 + cidx + 1], w2a = cw[2 * 1536 + cidx], w2b = cw[2 * 1536 + cidx + 1], w3a = cw[3 * 1536 + cidx], w3b = cw[3 * 1536 + cidx + 1];
              const float ba = cb[cidx], bb = cb[cidx + 1];
              const bf16* up = U + (size_t)(row0 + t0) * NCD + 1024 + cidx;
              unsigned raw[11];
              raw[0] = *(const unsigned*)(up - 3 * fo); raw[1] = *(const unsigned*)(up - 2 * fo); raw[2] = *(const unsigned*)(up - 1 * fo);
#pragma unroll
              for (int t = 0; t < 8; ++t) raw[3 + t] = *(const unsigned*)(up + (size_t)t * NCD);
              if (first) { raw[0] = 0u; raw[1] = 0u; raw[2] = 0u; }
#pragma unroll
              for (int t = 0; t < 8; ++t) {
                  const float ya = silu_(ba + w0a * __uint_as_float(raw[t] << 16) + w1a * __uint_as_float(raw[t + 1] << 16) + w2a * __uint_as_float(raw[t + 2] << 16) + w3a * __uint_as_float(raw[t + 3] << 16));
                  const float yb = silu_(bb + w0b * __uint_as_float(raw[t] & 0xffff0000u) + w1b * __uint_as_float(raw[t + 1] & 0xffff0000u) + w2b * __uint_as_float(raw[t + 2] & 0xffff0000u) + w3b * __uint_as_float(raw[t + 3] & 0xffff0000u));
                  if (q == 0) { if (k < 64) *(LAS unsigned*)(Bb + (t0 + t) * 72 + k) = pk2(ya, yb); else *(LAS unsigned*)(Cb + (t0 + t) * 72 + (k - 64)) = pk2(ya, yb); }
                  else { XLs[(t0 + t) * 257 + (k - 128)] = ya; XLs[(t0 + t) * 257 + (k - 128) + 1] = yb; } } } }
        if (wave < 4) { const int h = g * 4 + wave; const float dt = softplus_(bf2f(U[(size_t)(row0 + lane) * NCD + 4608 + h]) + kp.in(26)[j * 16 + h]);
            DTL[wave * 64 + lane] = dt; float gv = -__expf(alog[h]) * dt;
#pragma unroll
            for (int o = 1; o < 64; o <<= 1) { const float tt = __shfl_up(gv, o); if (lane >= o) gv += tt; }
            GL[wave * 64 + lane] = gv; }
        __syncthreads();
        if (wave < 4) {
            const int mt = wave >> 1, nt = wave & 1;
            f32x16 acc;
#pragma unroll
            for (int i = 0; i < 16; ++i) acc[i] = 0.f;
#pragma unroll
            for (int ks = 0; ks < 4; ++ks) acc = MFMA32(*(const LAS bf16x8*)(Cb + (32 * mt + r) * 72 + 16 * ks + 8 * hp), *(const LAS bf16x8*)(Bb + (32 * nt + r) * 72 + 16 * ks + 8 * hp), acc);
#pragma unroll
            for (int i16 = 0; i16 < 16; ++i16) QK[(32 * mt + crow(i16, hp)) * 65 + 32 * nt + r] = acc[i16];
        } else {
            for (int i = tid - 256; i < 8192; i += 256) { const int t = i >> 7, k2 = i & 127;
                ((unsigned*)XS)[((size_t)(row0 + t) * 1024 + g * 256) / 2 + k2] = pk2(XLs[t * 257 + 2 * k2], XLs[t * 257 + 2 * k2 + 1]); }
        }
        __syncthreads();
        const int f = wave, mt = f >> 2, ks = f & 3;
        for (int hh = 0; hh < 4; ++hh) {
            const int h = g * 4 + hh; const LAS float* Gh = GL + hh * 64; const float Gend = Gh[63];
            bf16x8* base = (bf16x8*)(OPS + ((size_t)((b * 32 + n) * 16 + h)) * SSD_ITEM_BYTES);
            float v[8];
            { const int i = 32 * mt + r; const float eg = __expf(Gh[i]);
#pragma unroll
              for (int jp = 0; jp < 8; ++jp) { const int d = 16 * ks + 8 * (jp >> 2) + 4 * hp + (jp & 3); v[jp] = bf2f(Cb[i * 72 + d]) * eg; }
              base[0 * 512 + f * 64 + lane] = pack8(v); }
            { const int d = 32 * mt + r;
#pragma unroll
              for (int jp = 0; jp < 8; ++jp) { const int tk = 16 * ks + 8 * (jp >> 2) + 4 * hp + (jp & 3); v[jp] = bf2f(Bb[tk * 72 + d]) * __expf(Gend - Gh[tk]); }
              base[1 * 512 + f * 64 + lane] = pack8(v); }
            { const int i = 32 * mt + r; const float gi = Gh[i];
#pragma unroll
              for (int jp = 0; jp < 8; ++jp) { const int jt = 16 * ks + 8 * (jp >> 2) + 4 * hp + (jp & 3); v[jp] = jt <= i ? QK[i * 65 + jt] * __expf(gi - Gh[jt]) : 0.f; }
              base[2 * 512 + f * 64 + lane] = pack8(v); }
            { const int p = 32 * mt + r;
#pragma unroll
              for (int jp = 0; jp < 8; ++jp) { const int tk = 16 * ks + 8 * (jp >> 2) + 4 * hp + (jp & 3);
                  v[jp] = XLs[tk * 257 + hh * 64 + p] * DTL[hh * 64 + tk]; }
              base[3 * 512 + f * 64 + lane] = pack8(v); }
            if (tid == 0) *(float*)(base + 32 * 64) = __expf(Gend);
        }
    }
}

__device__ __forceinline__ void phase_cd_rec(const KP kp, const int bid, const int G, int j, int li, LAS unsigned char* lds, int tid0) {
    unsigned char* scr = kp.ws() + WS_SCR; const bf16* U = (const bf16*)(kp.ws() + WS_U);
    const float* LA = (const float*)(scr + SC_LA); const float* LB = (const float*)(scr + SC_LB);
    float* YS = (float*)(scr + SC_YS); float* HS = (float*)(scr + SC_HS); bf16* XS = (bf16*)(scr + SC_XS);
    SEC_BEGIN(10)
    for (int item = bid; item < 64; item += G) {
        int tid = tid0; asm volatile("" : "+v"(tid));
        const int b = item >> 4, hd = item & 15;
        __syncthreads();
        const int wave = __builtin_amdgcn_readfirstlane(tid >> 6), lane = tid & 63, r = lane & 31, hp = lane >> 5, nt = wave;
        const unsigned char* OPS = scr + SC_SSDOP;
        const bool dmaw = (wave >= 2 && wave < 6);
        constexpr int SLOT = 33 * 1024;
#define SSD_DMA(n_) do { if (dmaw) { const unsigned char* gi_ = OPS + ((size_t)((b * 32 + (n_)) * 16 + hd)) * SSD_ITEM_BYTES + lane * 16; \
            _Pragma("unroll") for (int q_ = 0; q_ < 9; ++q_) { const int lf_ = q_ < 8 ? (wave - 2) * 8 + q_ : 32; \
                __builtin_amdgcn_global_load_lds((const unsigned*)(gi_ + lf_ * 1024), (LAS unsigned*)(lds + ((n_) & 3) * SLOT + lf_ * 1024), 16, 0, 2); } } } while (0)
        f32x16 S0, S1;
#pragma unroll
        for (int i = 0; i < 16; ++i) { S0[i] = 0.f; S1[i] = 0.f; }
        SSD_DMA(0); SSD_DMA(1); SSD_DMA(2);
        if (dmaw) asm volatile("s_waitcnt vmcnt(18)" ::: "memory");
        asm volatile("" ::: "memory"); __builtin_amdgcn_s_barrier(); asm volatile("" ::: "memory");
        for (int n = 0; n < 32; ++n) {
            if (n + 3 < 32) SSD_DMA(n + 3);
            if (wave < 2) {
                const LAS bf16x8* F = (const LAS bf16x8*)(lds + (n & 3) * SLOT) + lane;
                bf16x8 vb[4];
#pragma unroll
                for (int ks = 0; ks < 4; ++ks) vb[ks] = F[(24 + nt * 4 + ks) * 64];
                const float gend = *(const LAS float*)(lds + (n & 3) * SLOT + 32 * 1024);
                const bf16x8 sb00 = PACK_ACC(S0, 0), sb01 = PACK_ACC(S0, 1), sb10 = PACK_ACC(S1, 0), sb11 = PACK_ACC(S1, 1);
                f32x16 O0, O1;
#pragma unroll
                for (int i = 0; i < 16; ++i) { O0[i] = 0.f; O1[i] = 0.f; }
                O0 = MFMA32(F[0 * 64], sb00, O0); O0 = MFMA32(F[1 * 64], sb01, O0); O0 = MFMA32(F[2 * 64], sb10, O0); O0 = MFMA32(F[3 * 64], sb11, O0);
                O1 = MFMA32(F[4 * 64], sb00, O1); O1 = MFMA32(F[5 * 64], sb01, O1); O1 = MFMA32(F[6 * 64], sb10, O1); O1 = MFMA32(F[7 * 64], sb11, O1);
                O0 = MFMA32(F[16 * 64], vb[0], O0); O0 = MFMA32(F[17 * 64], vb[1], O0);
#pragma unroll
                for (int ks = 0; ks < 4; ++ks) O1 = MFMA32(F[(20 + ks) * 64], vb[ks], O1);
#pragma unroll
                for (int i = 0; i < 16; ++i) { S0[i] *= gend; S1[i] *= gend; }
#pragma unroll
                for (int ks = 0; ks < 4; ++ks) { S0 = MFMA32(F[(8 + ks) * 64], vb[ks], S0); S1 = MFMA32(F[(12 + ks) * 64], vb[ks], S1); }
                float* yo = YS + (size_t)(b * 2048 + n * 64) * 1024 + hd * 64 + 32 * nt + r;
#pragma unroll
                for (int i = 0; i < 16; ++i) { yo[(size_t)crow(i, hp) * 1024] = O0[i]; yo[(size_t)(32 + crow(i, hp)) * 1024] = O1[i]; }
            }
            if (dmaw) { if (n + 3 < 32) asm volatile("s_waitcnt vmcnt(18)" ::: "memory"); else if (n + 2 < 32) asm volatile("s_waitcnt vmcnt(9)" ::: "memory"); else asm volatile("s_waitcnt vmcnt(0)" ::: "memory"); }
            asm volatile("s_waitcnt lgkmcnt(0)" ::: "memory"); __builtin_amdgcn_s_barrier(); asm volatile("" ::: "memory");
        }
#undef SSD_DMA
        if (wave < 2) {
            float* dst = kp.out() + O_SSD_P + ((size_t)j * 4 + b) * ((size_t)16 * 64 * 64) + (size_t)hd * 64 * 64 + 32 * nt + r;
#pragma unroll
            for (int i = 0; i < 16; ++i) { dst[(size_t)crow(i, hp) * 64] = S0[i]; dst[(size_t)(32 + crow(i, hp)) * 64] = S1[i]; }
        }
    }
    SEC_END(10, lds)
    SEC_BEGIN(11)
    unsigned* qhead = (unsigned*)(kp.ws() + WS_CTL) + CW_CNT + 64 * li;
    volatile LAS unsigned* qslot = (volatile LAS unsigned*)(lds + LDS_BYTES - 8);
    const float* cw = kp.in(23) + (size_t)j * 4 * 1536; const float* cb = kp.in(24) + (size_t)j * 1536; const float* stc = kp.in(6) + (size_t)j * 128 * 3 * 1536;
    for (;;) {
        __syncthreads();
        if (tid0 == 0) qslot[0] = __hip_atomic_fetch_add(qhead, 1u, __ATOMIC_RELAXED, __HIP_MEMORY_SCOPE_AGENT);
        __syncthreads();
        const int it = (int)qslot[0];
        if (it >= 1024) break;
        int tid = tid0; asm volatile("" : "+v"(tid));
        if (it < 256) {
            const int s = it >> 6, h = it & 63; int row0, L; seq_info(s, row0, L);
            LAS float* Al = (LAS float*)lds; LAS float* Bl = Al + 512;
            const int chunk = tid >> 4, c16 = tid & 15, ch = h * 16 + c16;
            const size_t ro = (size_t)(row0 + chunk * 64) * 1024 + ch;
            float Ap = 1.f, Bp = 0.f;
#pragma unroll 8
            for (int t = 0; t < 64; ++t) { const float a = LA[ro + (size_t)t * 1024], bb = LB[ro + (size_t)t * 1024]; Bp = a * Bp + bb; Ap *= a; }
            Al[tid] = Ap; Bl[tid] = Bp;
            __syncthreads();
            float hh = 0.f;
            for (int m = 0; m < chunk; ++m) hh = Al[m * 16 + c16] * hh + Bl[m * 16 + c16];
#pragma unroll 8
            for (int t = 0; t < 64; ++t) { hh = LA[ro + (size_t)t * 1024] * hh + LB[ro + (size_t)t * 1024]; HS[ro + (size_t)t * 1024] = hh; }
            if (chunk == 31) kp.out()[O_LRU_P + ((size_t)j * 4 + s) * 1024 + ch] = hh;
        } else if (it < 768) {
            const int q_ = it - 256, bs = q_ >> 2, g = q_ & 3, sq = 4 + bs, r0 = TP + bs * 4;
            LAS float* BL = (LAS float*)lds; LAS float* CL = BL + 256; LAS float* XL = CL + 256; LAS float* DTL = XL + 1024; LAS float* QKs = DTL + 16; LAS float* red = QKs + 16;
            const int wave = tid >> 6, lane = tid & 63, hh = tid >> 7, nh = (tid >> 6) & 1, p = tid & 63, hd = 4 * g + hh;
            const size_t SZ = (size_t)16 * 64 * 64;
            const float* st = kp.in(5) + ((size_t)j * 128 + bs) * SZ + (size_t)hd * 4096;
            float S[32];
            { const float* sp = st + (size_t)(nh * 32) * 64 + p;
#pragma unroll
              for (int i = 0; i < 32; ++i) { S[i] = *sp; sp += 64; asm volatile("" : "+v"(sp)); } }
            { const int ci = tid & 127, tk = tid >> 7;
#pragma unroll
              for (int q = 0; q < 3; ++q) { const int k = ci + 128 * q; int cidx; LAS float* dst;
                  if (k < 64) { cidx = 1024 + g * 64 + k; dst = BL + k * 4 + tk; } else if (k < 128) { cidx = 1280 + g * 64 + (k - 64); dst = CL + (k - 64) * 4 + tk; } else { cidx = g * 256 + (k - 128); dst = XL + tk * 256 + (k - 128); }
                  float acc = cb[cidx];
#pragma unroll
                  for (int tap = 0; tap < 4; ++tap) acc += cw[tap * 1536 + cidx] * pre_val(U, NCD, 1024 + cidx, r0, tk - 3 + tap, sq, stc, 1536, cidx);
                  *dst = silu_(acc); } }
            if (tid < 16) { const int tk = tid >> 2, h2 = tid & 3; DTL[tid] = softplus_(bf2f(U[(size_t)(r0 + tk) * NCD + 4608 + 4 * g + h2]) + kp.in(26)[j * 16 + 4 * g + h2]); }
            __syncthreads();
#pragma unroll
            for (int q = 0; q < 2; ++q) { const int idx = wave * 2 + q, i = idx >> 2, jj = idx & 3; const float dot = wave_sum(CL[lane * 4 + i] * BL[lane * 4 + jj]); if (lane == 0) QKs[idx] = dot; }
            { const int tk = tid >> 7, k2 = tid & 127; ((unsigned*)XS)[((size_t)(r0 + tk) * 1024 + g * 256) / 2 + k2] = pk2(XL[tk * 256 + 2 * k2], XL[tk * 256 + 2 * k2 + 1]); }
            const float negA = -__expf(kp.in(25)[j * 16 + hd]);
            float Gc[4], xd[4], w[4];
            Gc[0] = negA * DTL[hh]; Gc[1] = Gc[0] + negA * DTL[4 + hh]; Gc[2] = Gc[1] + negA * DTL[8 + hh]; Gc[3] = Gc[2] + negA * DTL[12 + hh];
#pragma unroll
            for (int jj = 0; jj < 4; ++jj) { xd[jj] = XL[jj * 256 + hh * 64 + p] * DTL[jj * 4 + hh]; w[jj] = __expf(Gc[3] - Gc[jj]) * xd[jj]; }
            const float eg = __expf(Gc[3]);
            float o[4] = {0.f, 0.f, 0.f, 0.f};
            float* dst = kp.out() + O_SSD_S + ((size_t)j * 128 + bs) * SZ + (size_t)hd * 4096 + (size_t)(nh * 32) * 64 + p;
#pragma unroll
            for (int i = 0; i < 32; ++i) { const int n = nh * 32 + i; const float s0 = S[i]; float acc = eg * s0; const f32x4 c4 = *(const LAS f32x4*)(CL + n * 4), b4 = *(const LAS f32x4*)(BL + n * 4);
#pragma unroll
                for (int t = 0; t < 4; ++t) { o[t] += c4[t] * s0; acc += b4[t] * w[t]; }
                *dst = acc; dst += 64; asm volatile("" : "+v"(dst)); }
#pragma unroll
            for (int t = 0; t < 4; ++t) red[((hh * 2 + nh) * 4 + t) * 64 + p] = o[t];
            __syncthreads();
            if (nh == 0) {
#pragma unroll
                for (int t = 0; t < 4; ++t) { float y = __expf(Gc[t]) * (red[((hh * 2) * 4 + t) * 64 + p] + red[((hh * 2 + 1) * 4 + t) * 64 + p]);
#pragma unroll
                    for (int jj = 0; jj <= t; ++jj) y += QKs[t * 4 + jj] * __expf(Gc[t] - Gc[jj]) * xd[jj];
                    YS[(size_t)(r0 + t) * 1024 + hd * 64 + p] = y; } }
        } else {
            const int q_ = it - 768, s = 4 + (q_ >> 1), h = q_ & 1; int row0, L; seq_info(s, row0, L);
            const int ch = h * 512 + tid;
            float hh = s < 4 ? 0.f : kp.in(7)[((size_t)j * 128 + (s - 4)) * 1024 + ch];
#pragma unroll 8
            for (int t = 0; t < L; ++t) { const size_t r = (size_t)(row0 + t); hh = LA[r * 1024 + ch] * hh + LB[r * 1024 + ch]; HS[r * 1024 + ch] = hh; }
            float* dst = s < 4 ? kp.out() + O_LRU_P + ((size_t)j * 4 + s) * 1024 : kp.out() + O_LRU_S + ((size_t)j * 128 + (s - 4)) * 1024;
            dst[ch] = hh;
        }
    }
    SEC_END(11, lds)
}

__device__ __forceinline__ void phase_cd_post(const KP kp, const int bid, const int G, int j, int tid, int wave, int lane) {
    unsigned char* scr = kp.ws() + WS_SCR; const bf16* U = (const bf16*)(kp.ws() + WS_U); bf16* YM = (bf16*)(kp.ws() + WS_YM);
    const float* YS = (const float*)(scr + SC_YS); const float* HS = (const float*)(scr + SC_HS); const bf16* XS = (const bf16*)(scr + SC_XS);
    const float* sn = kp.in(28) + (size_t)j * 1024; const float* Dv = kp.in(27) + (size_t)j * 16;
    typedef float f32x2v __attribute__((ext_vector_type(2)));
    for (int idx = bid * NWAVES + wave; idx < T; idx += G * NWAVES) {
        const int gq_ = idx / 17, rq_ = idx - gq_ * 17, r = rq_ < 16 ? gq_ * 16 + rq_ : TP + gq_;
        int s, t; row_to_seq(r, s, t); int row0, L; seq_info(s, row0, L);
        const bf16* ur = U + (size_t)r * NCD; bf16* yr = YM + (size_t)r * DM;
        f32x4 ysv[4], hsv[4]; u32x2 xxv[4], zzv[4], zlv[4];
#pragma unroll
        for (int gq = 0; gq < 4; ++gq) { const int e = gq * 256 + 4 * lane; ysv[gq] = *(const f32x4*)(YS + (size_t)r * 1024 + e); xxv[gq] = *(const u32x2*)(XS + (size_t)r * 1024 + e); zzv[gq] = *(const u32x2*)(ur + e);
            hsv[gq] = *(const f32x4*)(HS + (size_t)r * 1024 + e); zlv[gq] = *(const u32x2*)(ur + 2560 + e); }
#pragma unroll
        for (int gq = 0; gq < 4; ++gq) { const int e = gq * 256 + 4 * lane; const f32x4 ys = ysv[gq];
            const u32x2 xx = xxv[gq], zz = zzv[gq]; const float Dh = Dv[e >> 6];
            f32x4 y; y.x = (ys.x + Dh * __uint_as_float(xx.x << 16)) * silu_(__uint_as_float(zz.x << 16)); y.y = (ys.y + Dh * __uint_as_float(xx.x & 0xffff0000u)) * silu_(__uint_as_float(zz.x & 0xffff0000u));
            y.z = (ys.z + Dh * __uint_as_float(xx.y << 16)) * silu_(__uint_as_float(zz.y << 16)); y.w = (ys.w + Dh * __uint_as_float(xx.y & 0xffff0000u)) * silu_(__uint_as_float(zz.y & 0xffff0000u));
            const float rstd = rsqrtf(wave_sum((y.x * y.x + y.y * y.y) + (y.z * y.z + y.w * y.w)) * (1.f / 256.f) + 1e-6f);
            const f32x4 g4 = *(const f32x4*)(sn + e);
            u32x2 w; w.x = pk2(y.x * rstd * g4.x, y.y * rstd * g4.y); w.y = pk2(y.z * rstd * g4.z, y.w * rstd * g4.w); *(u32x2*)(yr + e) = w; }
#pragma unroll
        for (int gq = 0; gq < 4; ++gq) { const int ch = gq * 256 + 4 * lane; const f32x4 hs = hsv[gq]; const u32x2 zz = zlv[gq];
            u32x2 w; w.x = pk2(hs.x * silu_(__uint_as_float(zz.x << 16)), hs.y * silu_(__uint_as_float(zz.x & 0xffff0000u))); w.y = pk2(hs.z * silu_(__uint_as_float(zz.y << 16)), hs.w * silu_(__uint_as_float(zz.y & 0xffff0000u)));
            *(u32x2*)(yr + 1024 + ch) = w; }
        if (t >= L - 3) { const int rr = t - (L - 3);
            float* d1 = s < 4 ? kp.out() + O_SSDC_P + (((size_t)j * 4 + s) * 3 + rr) * 1536 : kp.out() + O_SSDC_S + (((size_t)j * 128 + (s - 4)) * 3 + rr) * 1536;
            for (int c = 2 * lane; c < 1536; c += 128) { const unsigned uu = *(const unsigned*)(ur + 1024 + c); *(f32x2v*)(d1 + c) = (f32x2v){__uint_as_float(uu << 16), __uint_as_float(uu & 0xffff0000u)}; }
            float* d2 = s < 4 ? kp.out() + O_LRUC_P + (((size_t)j * 4 + s) * 3 + rr) * 1024 : kp.out() + O_LRUC_S + (((size_t)j * 128 + (s - 4)) * 3 + rr) * 1024;
            for (int c = 2 * lane; c < 1024; c += 128) { const unsigned uu = *(const unsigned*)(ur + 3584 + c); *(f32x2v*)(d2 + c) = (f32x2v){__uint_as_float(uu << 16), __uint_as_float(uu & 0xffff0000u)}; } }
    }
}


typedef float f32x4m __attribute__((ext_vector_type(4)));
template <bool GATE>
__device__ __forceinline__ void sample_gemm_res(LAS unsigned char* lds, const bf16* Amat, const bf16* Bt, const bf16* Hin, bf16* Hout, float* rss_out, const bf16* PP, const float* rss_in, int bid, int tid) {
    if (bid >= 256) return;
    const int wave = tid >> 6, lane = tid & 63, lr = lane & 15, kg = lane >> 4;
    const int m0 = TP + (bid & 7) * 64, n0 = (bid >> 3) * 64;
    const bf16x8* ap = (const bf16x8*)(Amat + (size_t)(m0 + lr) * 2048 + wave * 256 + 8 * kg);
    const bf16x8* bp = (const bf16x8*)(Bt + (size_t)(n0 + lr) * 2048 + wave * 256 + 8 * kg);
    f32x4m acc[4][4];
#pragma unroll
    for (int mi = 0; mi < 4; ++mi)
#pragma unroll
        for (int ni = 0; ni < 4; ++ni) acc[mi][ni] = (f32x4m){0.f, 0.f, 0.f, 0.f};
#pragma unroll 2
    for (int ks = 0; ks < 8; ++ks) { bf16x8 a[4], b[4];
#pragma unroll
        for (int q = 0; q < 4; ++q) { a[q] = ap[(size_t)q * 16 * 256 + ks * 4]; b[q] = bp[(size_t)q * 16 * 256 + ks * 4]; }
#pragma unroll
        for (int mi = 0; mi < 4; ++mi)
#pragma unroll
            for (int ni = 0; ni < 4; ++ni) acc[mi][ni] = __builtin_amdgcn_mfma_f32_16x16x32_bf16(a[mi], b[ni], acc[mi][ni], 0, 0, 0); }
    LAS float* red = (LAS float*)lds;
    __syncthreads();
#pragma unroll
    for (int mi = 0; mi < 4; ++mi)
#pragma unroll
        for (int ni = 0; ni < 4; ++ni)
#pragma unroll
            for (int i = 0; i < 4; ++i) red[(wave * 64 + 16 * mi + kg * 4 + i) * 65 + 16 * ni + lr] = acc[mi][ni][i];
    __syncthreads();
    { const int row = tid >> 3, c8 = (tid & 7) * 8, grow = m0 + row; float v[8];
#pragma unroll
      for (int e = 0; e < 8; ++e) { float sacc = 0.f;
#pragma unroll
          for (int w = 0; w < 8; ++w) sacc += red[(w * 64 + row) * 65 + c8 + e];
          v[e] = sacc; }
      float sc = 1.f; if (GATE) sc = rsqrtf(rss_in[grow] * (1.f / 2048.f) + 1e-6f);
      const size_t p = (size_t)grow * 2048 + n0 + c8;
      const u32x4 hw = *(const u32x4*)(Hin + p); u32x4 pw = (u32x4){0u, 0u, 0u, 0u}; if (GATE) pw = *(const u32x4*)(PP + p);
      const unsigned hws[4] = {hw.x, hw.y, hw.z, hw.w}, pws[4] = {pw.x, pw.y, pw.z, pw.w}; unsigned ow[4]; float sq = 0.f;
#pragma unroll
      for (int e2 = 0; e2 < 4; ++e2) { float h0 = __uint_as_float(hws[e2] << 16), h1 = __uint_as_float(hws[e2] & 0xffff0000u);
          if (GATE) { h0 += __builtin_amdgcn_rcpf(1.f + __expf(-sc * v[2 * e2])) * __uint_as_float(pws[e2] << 16); h1 += __builtin_amdgcn_rcpf(1.f + __expf(-sc * v[2 * e2 + 1])) * __uint_as_float(pws[e2] & 0xffff0000u); }
          else { h0 += v[2 * e2]; h1 += v[2 * e2 + 1]; }
          sq += h0 * h0 + h1 * h1; ow[e2] = cvtpk(h0, h1); }
      *(u32x4*)(Hout + p) = (u32x4){ow[0], ow[1], ow[2], ow[3]};
      sq += __shfl_xor(sq, 1); sq += __shfl_xor(sq, 2); sq += __shfl_xor(sq, 4);
      if ((tid & 7) == 0) atomicAdd(rss_out + grow, sq); }
}

__global__ void __launch_bounds__(NTHR, 2) mega_fwd(Args A) {
    extern __shared__ __attribute__((aligned(16))) unsigned char lds_raw[];
    LAS unsigned char* lds = (LAS unsigned char*)lds_raw;
    const int G = gridDim.x;
    volatile LAS unsigned* bst = (volatile LAS unsigned*)(lds + LDS_BYTES - 16);
    if (threadIdx.x == 0) { bst[0] = 0u; bst[1] = 0u;
#ifdef PROBE_SEC
        *(volatile LAS unsigned long long*)(lds + LDS_BYTES - 32) = 0ull;
#endif
    }
    __syncthreads();
    XcdBarrier xbar = xcd_barrier_post((unsigned*)(A.ws + WS_CTL) + CW_BAR, bst);
#ifdef PROBE_GROUP
    unsigned long long t_prev = __builtin_amdgcn_s_memrealtime(), t_sel = 0;
#endif
    for (int ph = A.ph_lo; ph < A.ph_hi; ++ph) {
        KP kp; kp.p = (const char AS4*)__builtin_amdgcn_kernarg_segment_ptr(); asm volatile("" : "+s"(kp.p));
        unsigned char* ws = kp.ws();
        int tid = threadIdx.x; asm volatile("" : "+v"(tid));
        int bid = blockIdx.x; asm volatile("" : "+s"(bid));
        const int lane = tid & 63, wave = __builtin_amdgcn_readfirstlane(tid >> 6), gw = bid * NWAVES + wave, NGW = G * NWAVES;
        if (ph == 0) { if (PH_MASK & 1) phase_prologue(kp, lds, gw, NGW, wave, lane); }
        else if (ph == N_PHASES - 1) { SEC_BEGIN(32) phase_final(kp, gw, NGW, lane); SEC_END(32, lds) }
        else {
            const int li = (ph - 1) / SUBS, sub = (ph - 1) % SUBS, j = li >> 1; const bool ab = (li & 1) == 0;
            float* RSS = (float*)(ws + WS_RSS);
            if (sub == 0) {
                const int N = ab ? NAB : NCD;
                const bf16* Bt = ab ? (const bf16*)(ws + WS_WABIN) + (size_t)j * NAB * 2048 : (const bf16*)(ws + WS_WCDIN) + (size_t)j * NCD * 2048;
                { pg8::Gemm g{(const bf16*)(ws + WS_XN), Bt, T, N, 2048}; pg8::StaticOrder S; S.init(T, N, G, bid);
                  pg8::EpiU E{(bf16*)(ws + WS_U), N, RSS + (size_t)(2 * li) * T};
                  if (PH_MASK & 2) pg8::gemm_phase<pg8::EpiU, pg8::StaticOrder, true, true>(lds, g, S, E, tid); }
                { int tid2 = tid; asm volatile("" : "+v"(tid2));
                  int pM = T, pG = G, pc = bid, prow = 0;
                  if (G == 256) { if (ab) { if (bid >= 218) { pM = 4864; pG = 38; pc = bid - 218; } else { prow = 4864; pM = T - 4864; pG = 120; pc = bid; } }
                                  else { pG = 122; pc = bid >= 134 ? bid - 134 : 100000; } }
                  pg8::StaticOrder S; S.init(pM, 2048, pG, pc);
                  pg8::Gemm g{(const bf16*)(ws + WS_PB) + ((size_t)li * T + prow) * 256, (const bf16*)(ws + WS_WPROJ) + (size_t)li * 2048 * 256, pM, 2048, 256};
                  pg8::EpiU E{(bf16*)(ws + WS_SCR + SC_PP) + (size_t)prow * 2048, 2048, nullptr};
                  if (PH_MASK & 2) pg8::gemm_phase<pg8::EpiU, pg8::StaticOrder, true, true>(lds, g, S, E, tid2); }
            } else if (sub == 4) {
                const bf16* Bt = ab ? (const bf16*)(ws + WS_WABOUT) + (size_t)j * 2048 * 2048 : (const bf16*)(ws + WS_WCDOUT) + (size_t)j * 2048 * 2048;
                pg8::Gemm g{(const bf16*)(ws + WS_YM), Bt, TP, 2048, 2048}; pg8::StaticOrder S; S.init(TP, 2048, G, bid);
                pg8::EpiRes<false> E{(const bf16*)(ws + WS_XN), (bf16*)(ws + WS_SCR + SC_HB1), RSS + (size_t)(2 * li + 1) * T, nullptr, nullptr};
                if (PH_MASK & 4) pg8::gemm_phase<pg8::EpiRes<false>, pg8::StaticOrder, true, true>(lds, g, S, E, tid);
                { int tid2 = tid; asm volatile("" : "+v"(tid2));
                  sample_gemm_res<false>(lds, (const bf16*)(ws + WS_YM), Bt, (const bf16*)(ws + WS_XN), (bf16*)(ws + WS_SCR + SC_HB1), RSS + (size_t)(2 * li + 1) * T, nullptr, nullptr, bid, tid2); }
            } else if (sub == 5) {
                pg8::Gemm g{(const bf16*)(ws + WS_SCR + SC_HB1), (const bf16*)(ws + WS_WGATE) + (size_t)li * 2048 * 2048, TP, 2048, 2048}; pg8::StaticOrder S; S.init(TP, 2048, G, bid);
                pg8::EpiRes<true> E{(const bf16*)(ws + WS_SCR + SC_HB1), (bf16*)(ws + WS_XN), RSS + (size_t)(2 * li + 2) * T, (const bf16*)(ws + WS_SCR + SC_PP), RSS + (size_t)(2 * li + 1) * T};
                if (PH_MASK & 4) pg8::gemm_phase<pg8::EpiRes<true>, pg8::StaticOrder, true, true>(lds, g, S, E, tid);
                { int tid2 = tid; asm volatile("" : "+v"(tid2));
                  sample_gemm_res<true>(lds, (const bf16*)(ws + WS_SCR + SC_HB1), (const bf16*)(ws + WS_WGATE) + (size_t)li * 2048 * 2048, (const bf16*)(ws + WS_SCR + SC_HB1), (bf16*)(ws + WS_XN), RSS + (size_t)(2 * li + 2) * T,
                                        (const bf16*)(ws + WS_SCR + SC_PP), RSS + (size_t)(2 * li + 1) * T, bid, tid2); }
            } else if (sub == 1) {
                if (ab) { SEC_BEGIN(3) if (PH_MASK & 4096) phase_gla_prep(kp, bid, G, j, lds, tid); SEC_END(3, lds) SEC_BEGIN(4) if (PH_MASK & 8192) phase_dn_prep(kp, bid, G, j, lds, tid); SEC_END(4, lds) }
                else { if (PH_MASK & 2048) { SEC_BEGIN(8) phase_ssd_prep(kp, bid, G, j, lds, tid); SEC_END(8, lds) SEC_BEGIN(9) phase_lru_gates(kp, bid, G, j, lds, tid); SEC_END(9, lds) } }
            }
            else if (sub == 2) { if (ab) { if (PH_MASK & 32) phase_ab_rec(kp, bid, G, j, li, lds, tid); } else { if (PH_MASK & 64) phase_cd_rec(kp, bid, G, j, li, lds, tid); } }
            else { if (ab) { SEC_BEGIN(30) if (PH_MASK & 128) phase_ab_post(kp, bid, G, j, tid, wave, lane); SEC_END(30, lds) } else { SEC_BEGIN(31) if (PH_MASK & 256) phase_cd_post(kp, bid, G, j, tid, wave, lane); SEC_END(31, lds) } }
        }
        if (ph + 1 < A.ph_hi) { if (ph == A.ph_lo) cg::this_grid().sync(); else xcd_barrier(xbar); }
#ifdef PROBE_GROUP
        { const unsigned long long t_now = __builtin_amdgcn_s_memrealtime(); const int li_ = (ph - 1) / SUBS, sub_ = (ph - 1) % SUBS; const bool ab_ = (li_ & 1) == 0;
          int grp = 9; if (ph == N_PHASES - 1) grp = 8; else if (ph > 0) { if (sub_ == 0 || sub_ == 4 || sub_ == 5) grp = 1; else if (sub_ == 1) grp = ab_ ? 4 : 5; else if (sub_ == 2) grp = ab_ ? 6 : 7; else grp = 8; }
          if (grp == PROBE_GROUP) t_sel += t_now - t_prev; t_prev = t_now; }
#endif
    }
#ifdef PROBE_SEC
    if (blockIdx.x == PROBE_BLK && threadIdx.x == 0) { const unsigned long long t_s = *(volatile LAS unsigned long long*)(lds + LDS_BYTES - 32); const unsigned long long t0 = __builtin_amdgcn_s_memrealtime(); while (__builtin_amdgcn_s_memrealtime() - t0 < 3 * t_s) __builtin_amdgcn_s_sleep(8); }
#endif
#ifdef PROBE_GROUP
    if (blockIdx.x == 0 && threadIdx.x == 0) { const unsigned long long t0 = __builtin_amdgcn_s_memrealtime(); while (__builtin_amdgcn_s_memrealtime() - t0 < 3 * t_sel) __builtin_amdgcn_s_sleep(8); }
#endif
}

extern "C" void kernel_launch(void* const* d_in, const int* in_sizes, int n_in, void* d_out, int out_size, void* d_ws, size_t ws_size, hipStream_t stream) {
    static int grid = 0;
    if (grid == 0) {
        if (n_in != 40 || (size_t)out_size != O_END || ws_size < WS_END) { fprintf(stderr, "kernel_launch: unexpected shapes: n_in %d out %d ws %zu\n", n_in, out_size, ws_size); grid = -1; return; }
        int dev = 0, cus = 0, per_cu = 0;
        if (hipGetDevice(&dev) != hipSuccess || hipDeviceGetAttribute(&cus, hipDeviceAttributeMultiprocessorCount, dev) != hipSuccess) { grid = -1; return; }
        if (hipFuncSetAttribute((const void*)mega_fwd, hipFuncAttributeMaxDynamicSharedMemorySize, LDS_BYTES) != hipSuccess) { fprintf(stderr, "kernel_launch: hipFuncSetAttribute failed\n"); grid = -1; return; }
        if (hipOccupancyMaxActiveBlocksPerMultiprocessor(&per_cu, (const void*)mega_fwd, NTHR, LDS_BYTES) != hipSuccess || per_cu < 1) { fprintf(stderr, "kernel_launch: occupancy query says %d\n", per_cu); per_cu = 1; }
        (void)hipGetLastError();
        grid = cus;
    }
    if (grid < 0) return;
    if (hipMemsetAsync((char*)d_ws + WS_CTL, 0, CTL_ZERO_BYTES, stream) != hipSuccess) { fprintf(stderr, "kernel_launch: memset of the control words failed\n"); return; }
    Args a{};
    for (int i = 0; i < 40; ++i) a.in[i] = (const float*)d_in[i];
    a.out = (float*)d_out; a.ws = (unsigned char*)d_ws;
#if MK_N_LAUNCHES == 1
    a.ph_lo = 0; a.ph_hi = N_PHASES;
    void* args[] = {&a};
    hipError_t e = hipLaunchCooperativeKernel((const void*)mega_fwd, dim3(grid), dim3(NTHR), args, LDS_BYTES, stream);
    if (e != hipSuccess) fprintf(stderr, "cooperative launch failed: %s (grid %d)\n", hipGetErrorString(e), grid);
#else
    for (int ph = 0; ph < N_PHASES; ++ph) { a.ph_lo = ph; a.ph_hi = ph + 1; mega_fwd<<<dim3(grid), dim3(NTHR), LDS_BYTES, stream>>>(a); }
#endif
}
```

```cpp
#include <hip/hip_runtime.h>
#include <hip/hip_cooperative_groups.h>
#include <cstdio>
#include <cstdint>
namespace cg = cooperative_groups;

#ifndef MK_N_LAUNCHES
#define MK_N_LAUNCHES 1
#endif

namespace pg8 {
#define PG8_LAS __attribute__((address_space(3)))
typedef unsigned short bf16_t;
typedef short bf16x8 __attribute__((ext_vector_type(8)));
typedef float f32x4 __attribute__((ext_vector_type(4)));
typedef unsigned u32x4 __attribute__((ext_vector_type(4)));
constexpr int BM = 256, BK = 64, HALF = 128, HTB = HALF * BK * 2  , STAGE_BYTES = 8 * HTB, NXCD = 8, WGM = 8;

__host__ __device__ __forceinline__ int lds_byte(int r, int c) { const int st = (r >> 4) * 2 + (c >> 5), rr = r & 15, cc = c & 31, ob = rr * 64 + cc * 2; return st * 1024 + (ob ^ (((ob >> 9) & 1) << 5)); }
__host__ __device__ __forceinline__ void stage_rc(int b, int& R, int& C) { const int st = b / 1024, sb = b % 1024, swz = sb ^ (((sb >> 9) & 1) << 5); R = (st >> 1) * 16 + swz / 64; C = (st & 1) * 32 + (swz % 64) / 2; }
__host__ __device__ __forceinline__ int perm32(int rho) { const int n = rho >> 4, i = rho & 15; return 8 * (i >> 2) + 4 * n + (i & 3); }

struct Unit { int pm, pn; };
struct Gemm { const bf16_t* A; const bf16_t* Bt; int M, N, K; };

struct StaticOrder {
    int nM, nN, nwg, G, c;
    __host__ __device__ void init(int M, int N, int G_, int c_) { nM = M / BM; nN = N / BM; nwg = nM * nN; G = G_; c = c_; }
    __host__ __device__ bool next(int i, Unit& u) const {
        const long L = (long)i * G + c; if (L >= nwg) return false;
        int wgid = (int)L; { const int q = nwg / NXCD, r = nwg % NXCD, xcd = wgid % NXCD, off = wgid / NXCD; wgid = (xcd < r ? xcd * (q + 1) : r * (q + 1) + (xcd - r) * q) + off; }
        const int nig = WGM * nN, gid = wgid / nig, fm = gid * WGM, gsz = (nM - fm) < WGM ? (nM - fm) : WGM;
        u.pm = fm + ((wgid % nig) % gsz); u.pn = (wgid % nig) / gsz; return true;
    }
    __device__ __forceinline__ void a_ready(const Unit&) const {}
    __device__ __forceinline__ void done(const Unit&) const {}
};

__device__ __forceinline__ unsigned cvt_pk_bf16(float lo, float hi) { unsigned r; asm volatile("v_cvt_pk_bf16_f32 %0, %1, %2" : "=v"(r) : "v"(lo), "v"(hi)); return r; }
struct EpiF32 {
    static constexpr bool PERM = false, AFTER_DRAIN = false;
    float* C; int ldc;
    __device__ __forceinline__ void operator()(const f32x4 (&acc)[2][2][4][2], const Unit& u, int wr, int wc, int fr, int fq) const {
        const int row0 = u.pm * BM + wr * 64 + fr, col0 = u.pn * BM + wc * 32 + 4 * fq;
#pragma unroll
        for (int ai = 0; ai < 2; ++ai)
#pragma unroll
            for (int m = 0; m < 4; ++m) { float* rowp = C + (size_t)(row0 + ai * HALF + m * 16) * ldc + col0;
#pragma unroll
                for (int bj = 0; bj < 2; ++bj)
#pragma unroll
                    for (int n = 0; n < 2; ++n) *(f32x4*)(rowp + bj * HALF + n * 16) = acc[ai][bj][m][n]; }
    }
};
struct EpiBf16 {
    static constexpr bool PERM = true, AFTER_DRAIN = false;
    bf16_t* O; int ldc;
    __device__ __forceinline__ void operator()(const f32x4 (&acc)[2][2][4][2], const Unit& u, int wr, int wc, int fr, int fq) const {
        const int row0 = u.pm * BM + wr * 64 + fr; const int col0 = u.pn * BM + wc * 32 + 8 * fq;
#pragma unroll
        for (int ai = 0; ai < 2; ++ai)
#pragma unroll
            for (int m = 0; m < 4; ++m) { bf16_t* rowp = O + (size_t)(row0 + ai * HALF + m * 16) * ldc + col0;
#pragma unroll
                for (int bj = 0; bj < 2; ++bj) { const f32x4 v0 = acc[ai][bj][m][0], v1 = acc[ai][bj][m][1];
                    u32x4 w; w.x = cvt_pk_bf16(v0[0], v0[1]); w.y = cvt_pk_bf16(v0[2], v0[3]); w.z = cvt_pk_bf16(v1[0], v1[1]); w.w = cvt_pk_bf16(v1[2], v1[3]);
                    *(u32x4*)(rowp + bj * HALF) = w; } }
    }
};

struct RangeOrder {
    int start, count;
    __host__ __device__ bool next(int i, Unit& u) const { if (i >= count) return false; const int t = start + i; u.pm = t >> 3; u.pn = t & 7; return true; }
    __device__ __forceinline__ void a_ready(const Unit&) const {}
    __device__ __forceinline__ void done(const Unit&) const {}
};
struct EpiU {
    static constexpr bool PERM = true, AFTER_DRAIN = false;
    bf16_t* O; int ldc; const float* rss;
    __device__ __forceinline__ void operator()(const f32x4 (&acc)[2][2][4][2], const Unit& u, int wr, int wc, int fr, int fq) const {
        const int row0 = u.pm * BM + wr * 64 + fr; const int col0 = u.pn * BM + wc * 32 + 8 * fq;
#pragma unroll
        for (int ai = 0; ai < 2; ++ai)
#pragma unroll
            for (int m = 0; m < 4; ++m) { const int row = row0 + ai * HALF + m * 16; const float sc = rss ? rsqrtf(rss[row] * (1.f / 2048.f) + 1e-6f) : 1.f;
                bf16_t* rowp = O + (size_t)row * ldc + col0;
#pragma unroll
                for (int bj = 0; bj < 2; ++bj) { const f32x4 v0 = acc[ai][bj][m][0] * sc, v1 = acc[ai][bj][m][1] * sc;
                    u32x4 w; w.x = cvt_pk_bf16(v0[0], v0[1]); w.y = cvt_pk_bf16(v0[2], v0[3]); w.z = cvt_pk_bf16(v1[0], v1[1]); w.w = cvt_pk_bf16(v1[2], v1[3]);
                    *(u32x4*)(rowp + bj * HALF) = w; } }
    }
};
typedef unsigned u32x2e __attribute__((ext_vector_type(2)));
template <bool GATE> struct EpiRes {
    static constexpr bool PERM = false, AFTER_DRAIN = false;
    const bf16_t* Hin; bf16_t* Hout; float* rss_out; const bf16_t* PP; const float* rss_in;
    __device__ __forceinline__ void operator()(const f32x4 (&acc)[2][2][4][2], const Unit& u, int wr, int wc, int fr, int fq) const {
        const int row0 = u.pm * BM + wr * 64 + fr, col0 = u.pn * BM + wc * 32 + 4 * fq;
#pragma unroll
        for (int ai = 0; ai < 2; ++ai)
#pragma unroll
            for (int m = 0; m < 4; ++m) { const int row = row0 + ai * HALF + m * 16; const size_t ro = (size_t)row * 2048 + col0;
                float sc = 1.f; if (GATE) sc = rsqrtf(rss_in[row] * (1.f / 2048.f) + 1e-6f);
                float s = 0.f;
#pragma unroll
                for (int bj = 0; bj < 2; ++bj)
#pragma unroll
                    for (int n = 0; n < 2; ++n) { const size_t p = ro + bj * HALF + n * 16; const u32x2e hw = *(const u32x2e*)(Hin + p); const f32x4 a = acc[ai][bj][m][n];
                        f32x4 h; h[0] = __uint_as_float(hw.x << 16); h[1] = __uint_as_float(hw.x & 0xffff0000u); h[2] = __uint_as_float(hw.y << 16); h[3] = __uint_as_float(hw.y & 0xffff0000u);
                        if (GATE) { const u32x2e pw = *(const u32x2e*)(PP + p);
                            h[0] += __builtin_amdgcn_rcpf(1.f + __expf(-sc * a[0])) * __uint_as_float(pw.x << 16); h[1] += __builtin_amdgcn_rcpf(1.f + __expf(-sc * a[1])) * __uint_as_float(pw.x & 0xffff0000u);
                            h[2] += __builtin_amdgcn_rcpf(1.f + __expf(-sc * a[2])) * __uint_as_float(pw.y << 16); h[3] += __builtin_amdgcn_rcpf(1.f + __expf(-sc * a[3])) * __uint_as_float(pw.y & 0xffff0000u); }
                        else h = h + a;
                        s += (h[0] * h[0] + h[1] * h[1]) + (h[2] * h[2] + h[3] * h[3]);
                        u32x2e o; o.x = cvt_pk_bf16(h[0], h[1]); o.y = cvt_pk_bf16(h[2], h[3]); *(u32x2e*)(Hout + p) = o; }
                s += __shfl_xor(s, 16); s += __shfl_xor(s, 32);
                if (fq == 0) atomicAdd(rss_out + row, s);
                asm volatile("" ::: "memory"); }
    }
};
template <class Epi, class Sched, bool ALIGN_EPI = false, bool SP2 = false>
__device__ __forceinline__ void gemm_phase(PG8_LAS unsigned char* lds, const Gemm g, const Sched& S, const Epi& E, const int tid) {
    const int wid = __builtin_amdgcn_readfirstlane(tid >> 6), lane = tid & 63, wr = wid >> 2, wc = wid & 3, fr = lane & 15, fq = lane >> 4;
    const int K = g.K, nt = K / BK;
    unsigned voffA[2], voffB[2];
#pragma unroll
    for (int i = 0; i < 2; ++i) { int R, C; stage_rc(tid * 16 + i * 8192, R, C); const int Rb = Epi::PERM ? ((R & ~31) + perm32(R & 31)) : R;
        voffA[i] = (unsigned)(R * K + C) * 2u; voffB[i] = (unsigned)(Rb * K + C) * 2u; }
    const size_t kstep = (size_t)(BK * 2);
    const size_t hstep = (size_t)HALF * K * 2;
    const size_t tstep = 2 * hstep;
    const unsigned ldsw = (unsigned)wid * 1024u;
    const int aoff = lds_byte(wr * 64 + fr, fq * 8), boff = lds_byte(wc * 32 + fr, fq * 8);
#define PG8_SA(b, h) (((b) * 2 + (h)) * HTB)
#define PG8_SB(b, h) ((4 + (b) * 2 + (h)) * HTB)
#define PG8_STAGE(bufoff, gbase, voff) do { _Pragma("unroll") for (int _i = 0; _i < 2; ++_i) \
        __builtin_amdgcn_global_load_lds((const unsigned*)((const char*)(gbase) + (voff)[_i]), (PG8_LAS unsigned*)(lds + (bufoff) + ldsw + _i * 8192), 16, 0, 0); } while (0)
#define PG8_LDA(dst, b, h) do { _Pragma("unroll") for (int m = 0; m < 4; ++m) _Pragma("unroll") for (int k = 0; k < 2; ++k) dst[m][k] = *(const PG8_LAS bf16x8*)(lds + PG8_SA(b, h) + aoff + m * 2048 + k * 1024); } while (0)
#define PG8_LDB(dst, b, h) do { _Pragma("unroll") for (int n = 0; n < 2; ++n) _Pragma("unroll") for (int k = 0; k < 2; ++k) dst[n][k] = *(const PG8_LAS bf16x8*)(lds + PG8_SB(b, h) + boff + n * 2048 + k * 1024); } while (0)
#define PG8_MMA(ai, bj, At, Bt) do { __builtin_amdgcn_s_setprio(1); _Pragma("unroll") for (int m = 0; m < 4; ++m) _Pragma("unroll") for (int n = 0; n < 2; ++n) _Pragma("unroll") for (int k = 0; k < 2; ++k) \
        acc[ai][bj][m][n] = __builtin_amdgcn_mfma_f32_16x16x32_bf16(Bt[n][k], At[m][k], acc[ai][bj][m][n], 0, 0, 0); __builtin_amdgcn_s_setprio(0); } while (0)
#define PG8_WAIT_V(n) asm volatile("s_waitcnt vmcnt(" #n ")" ::: "memory")
#define PG8_WAIT_L(n) asm volatile("s_waitcnt lgkmcnt(" #n ")" ::: "memory")
#define PG8_BAR __builtin_amdgcn_s_barrier()
#define PG8_SCHED __builtin_amdgcn_sched_barrier(0)
    Unit cur, nxt; int ui = 0;
    if (!S.next(0, cur)) return;
    f32x4 acc[2][2][4][2];
#pragma unroll
    for (int a = 0; a < 2; ++a)
#pragma unroll
        for (int b = 0; b < 2; ++b)
#pragma unroll
            for (int m = 0; m < 4; ++m)
#pragma unroll
                for (int n = 0; n < 2; ++n) acc[a][b][m][n] = (f32x4){0.f, 0.f, 0.f, 0.f};
    bf16x8 At[4][2], B0[2][2], B1[2][2];
    const char* cA = (const char*)g.A + (size_t)cur.pm * tstep; const char* cB = (const char*)g.Bt + (size_t)cur.pn * tstep;
    S.a_ready(cur);
    if constexpr (SP2) {
        PG8_STAGE(PG8_SB(0, 0), cB, voffB); PG8_STAGE(PG8_SB(0, 1), cB + hstep, voffB); PG8_STAGE(PG8_SA(0, 0), cA, voffA); PG8_STAGE(PG8_SA(0, 1), cA + hstep, voffA);
        if (wr == 1) PG8_BAR;
        PG8_WAIT_V(2); PG8_BAR;
        PG8_STAGE(PG8_SB(1, 0), cB + kstep, voffB); PG8_STAGE(PG8_SA(1, 0), cA + kstep, voffA); PG8_STAGE(PG8_SB(1, 1), cB + hstep + kstep, voffB);
        PG8_WAIT_V(6); PG8_BAR;
    } else {
        PG8_STAGE(PG8_SB(0, 0), cB, voffB); PG8_STAGE(PG8_SA(0, 0), cA, voffA); PG8_STAGE(PG8_SB(0, 1), cB + hstep, voffB); PG8_STAGE(PG8_SA(0, 1), cA + hstep, voffA);
        if (wr == 1) PG8_BAR;
        PG8_WAIT_V(4); PG8_BAR;
        PG8_STAGE(PG8_SB(1, 0), cB + kstep, voffB); PG8_STAGE(PG8_SA(1, 0), cA + kstep, voffA); PG8_STAGE(PG8_SB(1, 1), cB + hstep + kstep, voffB);
        PG8_WAIT_V(6); PG8_BAR;
    }
    for (;;) {
        const bool has_next = S.next(ui + 1, nxt);
        const char* nA = has_next ? (const char*)g.A + (size_t)nxt.pm * tstep : cA; const char* nB = has_next ? (const char*)g.Bt + (size_t)nxt.pn * tstep : cB;
        for (int t = 0; t < nt; t += 2) {
            const bool last = (t == nt - 2);
            const char* a1 = cA + (size_t)(t + 1) * kstep;
            const char* a2 = last ? nA : cA + (size_t)(t + 2) * kstep; const char* b2 = last ? nB : cB + (size_t)(t + 2) * kstep;
            const char* a3 = a2 + kstep; const char* b3 = b2 + kstep;
            if (last && has_next) S.a_ready(nxt);
            if constexpr (SP2) {
            PG8_LDB(B0, 0, 0); PG8_LDB(B1, 0, 1); PG8_SCHED; PG8_LDA(At, 0, 0); PG8_STAGE(PG8_SA(1, 1), a1 + hstep, voffA);
            PG8_WAIT_V(8); PG8_WAIT_L(0); PG8_BAR; PG8_MMA(0, 0, At, B0); PG8_MMA(0, 1, At, B1); PG8_BAR; PG8_SCHED;
            PG8_LDA(At, 0, 1); PG8_STAGE(PG8_SB(0, 0), b2, voffB); PG8_STAGE(PG8_SB(0, 1), b2 + hstep, voffB); PG8_STAGE(PG8_SA(0, 0), a2, voffA);
            PG8_WAIT_V(8); PG8_WAIT_L(0); PG8_BAR; PG8_MMA(1, 0, At, B0); PG8_MMA(1, 1, At, B1); PG8_BAR; PG8_SCHED;
            PG8_LDB(B0, 1, 0); PG8_LDB(B1, 1, 1); PG8_SCHED; PG8_LDA(At, 1, 0); PG8_STAGE(PG8_SA(0, 1), a2 + hstep, voffA);
            PG8_WAIT_V(8); PG8_WAIT_L(0); PG8_BAR; PG8_MMA(0, 0, At, B0); PG8_MMA(0, 1, At, B1); PG8_BAR; PG8_SCHED;
            PG8_LDA(At, 1, 1); PG8_STAGE(PG8_SB(1, 0), b3, voffB); PG8_STAGE(PG8_SB(1, 1), b3 + hstep, voffB); PG8_STAGE(PG8_SA(1, 0), a3, voffA);
            PG8_WAIT_V(8); PG8_WAIT_L(0); PG8_BAR; PG8_MMA(1, 0, At, B0); PG8_MMA(1, 1, At, B1); PG8_BAR; PG8_SCHED;
            } else {
            PG8_LDB(B0, 0, 0); PG8_SCHED; PG8_LDA(At, 0, 0); PG8_STAGE(PG8_SA(1, 1), a1 + hstep, voffA);
            PG8_WAIT_L(8); PG8_BAR; PG8_WAIT_L(0); PG8_MMA(0, 0, At, B0); PG8_BAR; PG8_SCHED;
            PG8_LDB(B1, 0, 1); PG8_STAGE(PG8_SB(0, 0), b2, voffB);
            PG8_BAR; PG8_WAIT_L(0); PG8_MMA(0, 1, At, B1); PG8_BAR;
            PG8_LDA(At, 0, 1); PG8_STAGE(PG8_SA(0, 0), a2, voffA);
            PG8_BAR; PG8_WAIT_L(0); PG8_MMA(1, 0, At, B0); PG8_BAR; PG8_SCHED;
            PG8_STAGE(PG8_SB(0, 1), b2 + hstep, voffB);
            PG8_WAIT_V(6); PG8_BAR; PG8_MMA(1, 1, At, B1); PG8_BAR;
            PG8_LDB(B0, 1, 0); PG8_SCHED; PG8_LDA(At, 1, 0); PG8_STAGE(PG8_SA(0, 1), a2 + hstep, voffA);
            PG8_WAIT_L(8); PG8_BAR; PG8_WAIT_L(0); PG8_MMA(0, 0, At, B0); PG8_BAR; PG8_SCHED;
            PG8_LDB(B1, 1, 1); PG8_STAGE(PG8_SB(1, 0), b3, voffB);
            PG8_BAR; PG8_WAIT_L(0); PG8_MMA(0, 1, At, B1); PG8_BAR;
            PG8_LDA(At, 1, 1); PG8_STAGE(PG8_SA(1, 0), a3, voffA);
            PG8_BAR; PG8_WAIT_L(0); PG8_MMA(1, 0, At, B0); PG8_BAR; PG8_SCHED;
            PG8_STAGE(PG8_SB(1, 1), b3 + hstep, voffB);
            PG8_WAIT_V(6); PG8_BAR; PG8_MMA(1, 1, At, B1); PG8_BAR;
            }
        }
        if constexpr (ALIGN_EPI) { if (wr == 0) PG8_BAR; }
        if constexpr (!Epi::AFTER_DRAIN) { E(acc, cur, wr, wc, fr, fq); S.done(cur); }
        if (!has_next) break;
#pragma unroll
        for (int a = 0; a < 2; ++a)
#pragma unroll
            for (int b = 0; b < 2; ++b)
#pragma unroll
                for (int m = 0; m < 4; ++m)
#pragma unroll
                    for (int n = 0; n < 2; ++n) acc[a][b][m][n] = (f32x4){0.f, 0.f, 0.f, 0.f};
        cur = nxt; cA = nA; cB = nB; ++ui;
        if constexpr (ALIGN_EPI) { if (wr == 1) PG8_BAR; }
    }
    PG8_WAIT_V(0);
    if constexpr (!ALIGN_EPI) { if (wr == 0) PG8_BAR; }
    PG8_BAR;
    if constexpr (Epi::AFTER_DRAIN) { E.fused(acc, cur, wr, wc, fr, fq, lds, wid, lane); S.done(cur); }
#undef PG8_SA
#undef PG8_SB
#undef PG8_STAGE
#undef PG8_LDA
#undef PG8_LDB
#undef PG8_MMA
#undef PG8_WAIT_V
#undef PG8_WAIT_L
#undef PG8_BAR
#undef PG8_SCHED
}
}

constexpr int TP = 8192, TS = 512, T = TP + TS, DM = 2048, NSEQ = 132;
constexpr int NAB = 7424, NCD = 4864;
constexpr int NWAVES = 8, NTHR = 512;
constexpr size_t MiB = 1u << 20;
constexpr size_t WS_CTL = 0, CTL_ZERO_BYTES = 1 * MiB;
constexpr int CW_BAR = 4096, CW_CNT = 8192;
constexpr size_t WS_RSS = 65536;
constexpr size_t WS_WABIN = 2 * MiB, WS_WABOUT = 60 * MiB, WS_WCDIN = 76 * MiB, WS_WCDOUT = 114 * MiB, WS_WGATE = 130 * MiB, WS_WPROJ = 162 * MiB;
constexpr size_t WS_H = 166 * MiB, WS_XN = 234 * MiB, WS_YM = 268 * MiB, WS_PB = 302 * MiB, WS_U = 320 * MiB, WS_SCR = 444 * MiB, WS_END = 732 * MiB;
constexpr size_t SC_HB1 = 102 * MiB;
constexpr size_t SC_PP = 8 * MiB;
constexpr size_t SC_ODN = 102 * MiB, SC_OGLA = 136 * MiB, SC_DNOPS = 192 * MiB;
constexpr size_t SC_LA = 52 * MiB, SC_LB = 86 * MiB, SC_YS = 120 * MiB, SC_HS = 154 * MiB, SC_SSDOP = 192 * MiB, SC_XS = 270 * MiB;
constexpr int LDS_BYTES = 163840;
constexpr size_t O_Y_P = 0, O_Y_S = O_Y_P + (size_t)4 * 2048 * 2048, O_DN_P = O_Y_S + (size_t)128 * 4 * 2048,
    O_DNC_P = O_DN_P + (size_t)2 * 4 * 8 * 128 * 128, O_GLA_P = O_DNC_P + (size_t)2 * 4 * 3 * 3072, O_SSD_P = O_GLA_P + (size_t)2 * 4 * 4 * 128 * 256,
    O_SSDC_P = O_SSD_P + (size_t)2 * 4 * 16 * 64 * 64, O_LRU_P = O_SSDC_P + (size_t)2 * 4 * 3 * 1536, O_LRUC_P = O_LRU_P + (size_t)2 * 4 * 1024,
    O_DN_S = O_LRUC_P + (size_t)2 * 4 * 3 * 1024, O_DNC_S = O_DN_S + (size_t)2 * 128 * 8 * 128 * 128, O_GLA_S = O_DNC_S + (size_t)2 * 128 * 3 * 3072,
    O_SSD_S = O_GLA_S + (size_t)2 * 128 * 4 * 128 * 256, O_SSDC_S = O_SSD_S + (size_t)2 * 128 * 16 * 64 * 64, O_LRU_S = O_SSDC_S + (size_t)2 * 128 * 3 * 1536,
    O_LRUC_S = O_LRU_S + (size_t)2 * 128 * 1024, O_END = O_LRUC_S + (size_t)2 * 128 * 3 * 1024;
static_assert(O_END == 109064192, "output size");

#define LAS __attribute__((address_space(3)))
typedef unsigned short bf16;
typedef float f32x4 __attribute__((ext_vector_type(4)));
typedef unsigned u32x2 __attribute__((ext_vector_type(2)));
typedef unsigned u32x4 __attribute__((ext_vector_type(4)));
#define LDS_WAIT() asm volatile("s_waitcnt lgkmcnt(0)" ::: "memory")

__device__ __forceinline__ float bf2f(bf16 b) { return __uint_as_float(((unsigned)b) << 16); }
typedef __bf16 bf16x2_t __attribute__((ext_vector_type(2)));
typedef float f32x2_t __attribute__((ext_vector_type(2)));
__device__ __forceinline__ unsigned cvtpk(float lo, float hi) { f32x2_t v = {lo, hi}; bf16x2_t b = __builtin_convertvector(v, bf16x2_t); return __builtin_bit_cast(unsigned, b); }
__device__ __forceinline__ unsigned f2bf(float f) { return cvtpk(f, 0.f) & 0xffffu; }
__device__ __forceinline__ unsigned pk2(float lo, float hi) { return cvtpk(lo, hi); }
__device__ __forceinline__ float sigmoid_(float x) { return __builtin_amdgcn_rcpf(1.f + __expf(-x)); }
__device__ __forceinline__ float silu_(float x) { return x * __builtin_amdgcn_rcpf(1.f + __expf(-x)); }
__device__ __forceinline__ float softplus_(float x) { return x > 15.f ? x : (x < -15.f ? __expf(x) : __logf(1.f + __expf(x))); }
__device__ __forceinline__ float dpp_add(float v, float x) { return v + x; }
#define WS_DPP(v, ctrl, rmask) __builtin_bit_cast(float, __builtin_amdgcn_update_dpp(0, __builtin_bit_cast(int, (v)), (ctrl), (rmask), 0xf, false))
__device__ __forceinline__ float wave_sum(float v) {
    v += WS_DPP(v, 0xB1, 0xf);
    v += WS_DPP(v, 0x4E, 0xf);
    v += WS_DPP(v, 0x141, 0xf);
    v += WS_DPP(v, 0x140, 0xf);
    v += WS_DPP(v, 0x142, 0xa);
    v += WS_DPP(v, 0x143, 0xc);
    return __builtin_bit_cast(float, __builtin_amdgcn_readlane(__builtin_bit_cast(int, v), 63));
}
__device__ __forceinline__ void row_to_seq(int r, int& s, int& t) { if (r < TP) { s = r >> 11; t = r & 2047; } else { s = 4 + ((r - TP) >> 2); t = (r - TP) & 3; } }
__device__ __forceinline__ void seq_info(int s, int& row0, int& L) { if (s < 4) { row0 = s << 11; L = 2048; } else { row0 = TP + ((s - 4) << 2); L = 4; } }
__device__ __forceinline__ float pre_val(const bf16* U, int ldu, int ucol, int row0, int tt, int s, const float* stc, int W, int c) {
    const int tc = tt >= 0 ? tt : 0, sc = tt >= 0 ? 0 : 3 + tt;
    const float a = bf2f(U[(size_t)(row0 + tc) * ldu + ucol]), b = stc[((size_t)(s - 4) * 3 + sc) * W + c];
    return tt >= 0 ? a : b;
}
__device__ __forceinline__ int map_col(int mapid, int n) {
    if (mapid == 0) return n;
    if (mapid == 1) { if (n < 3072) return n; if (n < 6144) return n + 16; if (n < 7168) return n + 32; if (n < 7184) return n - 4096; if (n < 7200) return n - 1024; return -1; }
    if (n < 2560) return n; if (n < 4608) return n + 16; if (n < 4624) return n - 2048; return -1;
}
__device__ __forceinline__ void transpose_item(const float* W, int K, int Nsrc, bf16* WT, int Npad, int mapid, const float* gain, LAS float* scr, int item, int lane) {
    const int nblk = Npad / 64, kb = item / nblk, nb = item % nblk, k0 = 64 * kb, n0 = 64 * nb;
    const int n4 = (lane & 15) * 4, src = map_col(mapid, n0 + n4);
    const int srcc = src >= 0 ? src : 0; const float msk = src >= 0 ? 1.f : 0.f;
    f32x4 v[16];
#pragma unroll
    for (int i = 0; i < 16; ++i) v[i] = *(const f32x4*)(W + (size_t)(k0 + 4 * i + (lane >> 4)) * Nsrc + srcc);
    if (gain) {
#pragma unroll
        for (int i = 0; i < 16; ++i) v[i] = v[i] * (gain[k0 + 4 * i + (lane >> 4)] * msk);
    } else {
#pragma unroll
        for (int i = 0; i < 16; ++i) v[i] = v[i] * msk;
    }
#pragma unroll
    for (int i = 0; i < 16; ++i) { const int kk = 4 * i + (lane >> 4); scr[kk * 65 + n4] = v[i].x; scr[kk * 65 + n4 + 1] = v[i].y; scr[kk * 65 + n4 + 2] = v[i].z; scr[kk * 65 + n4 + 3] = v[i].w; }
    LDS_WAIT(); asm volatile("" ::: "memory");
    const int c = lane & 7;
#pragma unroll
    for (int jj = 0; jj < 8; ++jj) { const int n = (lane >> 3) + 8 * jj; const LAS float* p = scr + (8 * c) * 65 + n;
        u32x4 o; o.x = pk2(p[0 * 65], p[1 * 65]); o.y = pk2(p[2 * 65], p[3 * 65]); o.z = pk2(p[4 * 65], p[5 * 65]); o.w = pk2(p[6 * 65], p[7 * 65]);
        *(u32x4*)(WT + (size_t)(n0 + n) * K + k0 + 8 * c) = o; }
    LDS_WAIT(); asm volatile("" ::: "memory");
}
__device__ __forceinline__ void norm_row_bf16(const f32x4 (&v)[8], const float* g, bf16* orow, int lane) {
    float ss = 0.f;
#pragma unroll
    for (int j = 0; j < 8; ++j) ss += (v[j].x * v[j].x + v[j].y * v[j].y) + (v[j].z * v[j].z + v[j].w * v[j].w);
    const float rstd = rsqrtf(wave_sum(ss) * (1.f / DM) + 1e-6f);
#pragma unroll
    for (int j = 0; j < 8; ++j) { const int col = 4 * (lane + 64 * j); const f32x4 gg = *(const f32x4*)(g + col);
        u32x2 o; o.x = pk2(v[j].x * rstd * gg.x, v[j].y * rstd * gg.y); o.y = pk2(v[j].z * rstd * gg.z, v[j].w * rstd * gg.w);
        *(u32x2*)(orow + col) = o; }
}

typedef short bf16x8 __attribute__((ext_vector_type(8)));
typedef float f32x16 __attribute__((ext_vector_type(16)));
#define MFMA32(a, b, c) __builtin_amdgcn_mfma_f32_32x32x16_bf16((a), (b), (c), 0, 0, 0)
#define PACK_ACC(x, S_) __builtin_bit_cast(bf16x8, (u32x4){cvtpk((x)[8 * (S_)], (x)[8 * (S_) + 1]), cvtpk((x)[8 * (S_) + 2], (x)[8 * (S_) + 3]), cvtpk((x)[8 * (S_) + 4], (x)[8 * (S_) + 5]), cvtpk((x)[8 * (S_) + 6], (x)[8 * (S_) + 7])})
__device__ __forceinline__ int crow(int reg, int h) { return (reg & 3) + 8 * (reg >> 2) + 4 * h; }
__device__ __forceinline__ bf16x8 pack8(const float (&v)[8]) { return __builtin_bit_cast(bf16x8, (u32x4){cvtpk(v[0], v[1]), cvtpk(v[2], v[3]), cvtpk(v[4], v[5]), cvtpk(v[6], v[7])}); }

#define XB_TMO      128
#define XB_XCNT(j)  (256  + 64 * (j))
#define XB_XSUB(j)  (1280 + 64 * (j))
#define XB_XGEN(j)  (2304 + 64 * (j))
#define XB_TOP      3328
#define XB_TOPGEN   3392
#define XCD_BAR_WORDS 3456
#define XB_SPIN_CAP (1u << 18)

__device__ __forceinline__ unsigned xb_ld(unsigned* p)              { return __hip_atomic_load(p, __ATOMIC_RELAXED, __HIP_MEMORY_SCOPE_AGENT); }
__device__ __forceinline__ unsigned xb_add(unsigned* p, unsigned v) { return __hip_atomic_fetch_add(p, v, __ATOMIC_RELAXED, __HIP_MEMORY_SCOPE_AGENT); }
__device__ __forceinline__ unsigned xb_xcc_id() { return (unsigned)__builtin_amdgcn_s_getreg((3 << 11) | 20) & 0xFu; }
#define XB_SPIN(cond, bar) do { unsigned _sp = 0; while (cond) { __builtin_amdgcn_s_sleep(1); \
    if ((++_sp & 255u) == 0u) { if (xb_ld(&(bar)[XB_TMO])) break; if (_sp > XB_SPIN_CAP) { atomicAdd(&(bar)[XB_TMO], 1u); break; } } } } while (0)

struct XcdBarrier {
    unsigned* bar; unsigned x;
    volatile LAS unsigned* st;
};

__device__ __forceinline__ XcdBarrier xcd_barrier_post(unsigned* bar, volatile LAS unsigned* st) {
    XcdBarrier b; b.bar = bar; b.x = xb_xcc_id(); b.st = st;
    if (threadIdx.x == 0) (void)xb_add(&bar[XB_XCNT(b.x)], 1u);
    return b;
}
__device__ __forceinline__ void xcd_barrier_complete(unsigned* bar, unsigned x, unsigned& nloc, unsigned& nx) {
    const unsigned G = gridDim.x * gridDim.y * gridDim.z;
    unsigned sum, cnt, mine, sp = 0u;
    for (;;) {
        sum = 0u; cnt = 0u; mine = 0u;
#pragma unroll
        for (unsigned j = 0; j < 16; ++j) { const unsigned c = xb_ld(&bar[XB_XCNT(j)]); sum += c; cnt += (c > 0u) ? 1u : 0u; mine = (j == x) ? c : mine; }
        if (sum == G) break;
        __builtin_amdgcn_s_sleep(1);
        if ((++sp & 255u) == 0u) { if (xb_ld(&bar[XB_TMO])) break; if (sp > XB_SPIN_CAP) { atomicAdd(&bar[XB_TMO], 1u); break; } }
    }
    nloc = mine > 0u ? mine : 1u; nx = cnt > 0u ? cnt : 1u;
}

__device__ __forceinline__ void xcd_barrier(const XcdBarrier& b) {
    asm volatile("s_waitcnt vmcnt(0)" ::: "memory");
    __syncthreads();
    if (threadIdx.x == 0) {
        unsigned* bar = b.bar;
        __builtin_amdgcn_s_waitcnt(0);
        unsigned nloc = b.st[0], nx = b.st[1];
        if (nloc == 0u) { xcd_barrier_complete(bar, b.x, nloc, nx); b.st[0] = nloc; b.st[1] = nx; }
        const unsigned old = xb_add(&bar[XB_XSUB(b.x)], 1u);
        const unsigned gen = old / nloc;
        if (old + 1u == (gen + 1u) * nloc) {
            __builtin_amdgcn_fence(__ATOMIC_RELEASE, "agent");
            asm volatile("s_waitcnt vmcnt(0)" ::: "memory");
            const unsigned og = xb_add(&bar[XB_TOP], 1u);
            const unsigned tg = og / nx;
            if (og + 1u == (tg + 1u) * nx) xb_add(&bar[XB_TOPGEN], 1u);
            else XB_SPIN(xb_ld(&bar[XB_TOPGEN]) == tg, bar);
            __builtin_amdgcn_fence(__ATOMIC_ACQUIRE, "agent");
            xb_add(&bar[XB_XGEN(b.x)], 1u);
            asm volatile("s_waitcnt vmcnt(0)" ::: "memory");
        } else {
            XB_SPIN(xb_ld(&bar[XB_XGEN(b.x)]) == gen, bar);
            __builtin_amdgcn_fence(__ATOMIC_ACQUIRE, "agent");
            asm volatile("s_waitcnt vmcnt(0)" ::: "memory");
        }
    }
    __syncthreads();
}


#ifdef PROBE_SEC
#define SEC_BEGIN(id) unsigned long long _sec_t##id = 0; if ((id) == PROBE_SEC) { __builtin_amdgcn_s_barrier(); _sec_t##id = __builtin_amdgcn_s_memrealtime(); }
#define SEC_END(id, ldsp) if ((id) == PROBE_SEC) { __builtin_amdgcn_s_barrier(); if (threadIdx.x == 0) { volatile LAS unsigned long long* a_ = (volatile LAS unsigned long long*)((ldsp) + LDS_BYTES - 32); a_[0] = a_[0] + (__builtin_amdgcn_s_memrealtime() - _sec_t##id); } }
#define SECW_BEGIN(id) unsigned long long _secw_t##id = 0; if ((id) == PROBE_SEC) { _secw_t##id = __builtin_amdgcn_s_memrealtime(); }
#define SECW_END(id, ldsp, tsel) if ((id) == PROBE_SEC) { asm volatile("s_waitcnt vmcnt(0) lgkmcnt(0)" ::: "memory"); if (threadIdx.x == (tsel)) { volatile LAS unsigned long long* a_ = (volatile LAS unsigned long long*)((ldsp) + LDS_BYTES - 32); a_[0] = a_[0] + (__builtin_amdgcn_s_memrealtime() - _secw_t##id); } }
#else
#define SEC_BEGIN(id)
#define SEC_END(id, ldsp)
#define SECW_BEGIN(id)
#define SECW_END(id, ldsp, tsel)
#endif
struct Args { const float* in[40]; float* out; unsigned char* ws; int ph_lo, ph_hi; };
constexpr int N_PHASES = 26, SUBS = 6;
#ifndef PH_MASK
#define PH_MASK 16383
#endif
#define AS4 __attribute__((address_space(4)))
struct KP { const char AS4* p;
    __device__ __forceinline__ const float* in(int i) const { return *(const float* const AS4*)(p + 8 * i); }
    __device__ __forceinline__ float* out() const { return *(float* const AS4*)(p + 320); }
    __device__ __forceinline__ unsigned char* ws() const { return *(unsigned char* const AS4*)(p + 328); }
};
static_assert(sizeof(Args) == 344, "Args layout");

__device__ __forceinline__ void phase_prologue(const KP kp, LAS unsigned char* lds, int gw, int NGW, int wave, int lane) {
    unsigned char* ws = kp.ws();
    LAS float* scr = (LAS float*)(lds + wave * 17408);
    SEC_BEGIN(1)
    SEC_BEGIN(14)
    for (int job = 0; job < 16; ++job) {
        if (job == 2) { SEC_END(14, lds) }
        const float* W; int K = 2048, Nsrc = 2048, Npad = 2048, mapid = 0; bf16* WT; const float* gain = nullptr;
        if (job < 2)       { W = kp.in(13) + (size_t)job * 2048 * 7200; Nsrc = 7200; Npad = NAB; mapid = 1; WT = (bf16*)(ws + WS_WABIN) + (size_t)job * NAB * 2048; gain = kp.in(11) + (size_t)(2 * job) * DM; }
        else if (job < 4)  { W = kp.in(21) + (size_t)(job - 2) * 2048 * 2048; WT = (bf16*)(ws + WS_WABOUT) + (size_t)(job - 2) * 2048 * 2048; }
        else if (job < 6)  { W = kp.in(22) + (size_t)(job - 4) * 2048 * 4624; Nsrc = 4624; Npad = NCD; mapid = 2; WT = (bf16*)(ws + WS_WCDIN) + (size_t)(job - 4) * NCD * 2048; gain = kp.in(11) + (size_t)(2 * (job - 4) + 1) * DM; }
        else if (job < 8)  { W = kp.in(36) + (size_t)(job - 6) * 2048 * 2048; WT = (bf16*)(ws + WS_WCDOUT) + (size_t)(job - 6) * 2048 * 2048; }
        else if (job < 12) { W = kp.in(39) + (size_t)(job - 8) * 2048 * 2048; WT = (bf16*)(ws + WS_WGATE) + (size_t)(job - 8) * 2048 * 2048; gain = kp.in(38) + (size_t)(job - 8) * DM; }
        else               { W = kp.in(37) + (size_t)(job - 12) * 256 * 2048; K = 256; WT = (bf16*)(ws + WS_WPROJ) + (size_t)(job - 12) * 2048 * 256; }
        const int nitems = (K / 64) * (Npad / 64), nblocks = NGW / NWAVES, ipb = (nitems + nblocks - 1) / nblocks, ib = (gw / NWAVES) * ipb, ie = ib + ipb < nitems ? ib + ipb : nitems;
        for (int it = ib + wave; it < ie; it += NWAVES) transpose_item(W, K, Nsrc, WT, Npad, mapid, gain, scr, it, lane);
    }
    SEC_END(1, lds)
    SEC_BEGIN(2)
    bf16* HB = (bf16*)(ws + WS_XN); float* RSS = (float*)(ws + WS_RSS);
    for (int m = gw; m < T; m += NGW) {
        const float* src = m < TP ? kp.in(0) + (size_t)m * DM : kp.in(1) + (size_t)(m - TP) * DM;
        float ss = 0.f;
#pragma unroll
        for (int jj = 0; jj < 8; ++jj) { const int col = 4 * (lane + 64 * jj); const f32x4 v = *(const f32x4*)(src + col);
            u32x2 o; o.x = pk2(v.x, v.y); o.y = pk2(v.z, v.w); *(u32x2*)(HB + (size_t)m * DM + col) = o; ss += (v.x * v.x + v.y * v.y) + (v.z * v.z + v.w * v.w); }
        ss = wave_sum(ss); if (lane == 0) RSS[m] = ss;
    }
    bf16* PB = (bf16*)(ws + WS_PB);
    const int gt = gw * 64 + lane, NGT = NGW * 64;
    for (int i = gt; i < 4 * T * 64; i += NGT) {
        const int c4 = i & 63, rr = i >> 6, li = rr / T, r = rr - li * T;
        const float* src = r < TP ? kp.in(9) + ((size_t)li * TP + r) * 256 + 4 * c4 : kp.in(10) + ((size_t)li * TS + (r - TP)) * 256 + 4 * c4;
        const f32x4 v = *(const f32x4*)src;
        u32x2 o; o.x = pk2(v.x, v.y); o.y = pk2(v.z, v.w);
        *(u32x2*)(PB + ((size_t)li * T + r) * 256 + 4 * c4) = o;
    }
    SEC_END(2, lds)
}
__device__ __forceinline__ void phase_final(const KP kp, int gw, int NGW, int lane) {
    const bf16* HB = (const bf16*)(kp.ws() + WS_XN); const float* RSS = (const float*)(kp.ws() + WS_RSS) + (size_t)8 * T; const float* g = kp.in(12); float* out = kp.out();
    for (int m = gw; m < T; m += NGW) { const float rstd = rsqrtf(RSS[m] * (1.f / DM) + 1e-6f);
#pragma unroll
        for (int jj = 0; jj < 8; ++jj) { const int col = 4 * (lane + 64 * jj); const u32x2 hv = *(const u32x2*)(HB + (size_t)m * DM + col); const f32x4 gg = *(const f32x4*)(g + col);
            f32x4 o; o.x = __uint_as_float(hv.x << 16) * rstd * gg.x; o.y = __uint_as_float(hv.x & 0xffff0000u) * rstd * gg.y; o.z = __uint_as_float(hv.y << 16) * rstd * gg.z; o.w = __uint_as_float(hv.y & 0xffff0000u) * rstd * gg.w;
            *(f32x4*)(out + (size_t)m * DM + col) = o; } }
}

constexpr size_t GLA_ITEM_BYTES = 74752, WS_GLAOPS = WS_H;
__device__ __forceinline__ void phase_gla_prep(const KP kp, const int bid, const int G, int j, LAS unsigned char* lds, int tid0) {
    const bf16* U = (const bf16*)(kp.ws() + WS_U);
    const float* wa2 = kp.in(18) + (size_t)j * 16 * 512; const float* ba = kp.in(19) + (size_t)j * 512;
    unsigned char* OPS = kp.ws() + WS_GLAOPS;
    LAS float* GE = (LAS float*)lds; LAS float* Pg = GE + 128;
    LAS bf16* Qg = (LAS bf16*)(Pg + 512); LAS bf16* Ka = Qg + 64 * 136; LAS float* QKm = (LAS float*)(Ka + 64 * 136);
    for (int item = bid; item < 512; item += G) {
        int tid = tid0; asm volatile("" : "+v"(tid));
        const int lane = tid & 63, r = lane & 31, hp = lane >> 5, wave = tid >> 6;
        const int b = item >> 7, n = (item >> 2) & 31, h = item & 3;
        const int row0 = b * 2048 + n * 64;
        __syncthreads();
        const int d = tid & 127, tg = tid >> 7, t0 = 16 * tg;
        float q[16], k[16], gl[16];
        { float w[16];
#pragma unroll
          for (int rr = 0; rr < 16; ++rr) w[rr] = wa2[rr * 512 + h * 128 + d];
          const float bias = ba[h * 128 + d];
#pragma unroll
          for (int t = 0; t < 16; ++t) { const size_t ro = (size_t)(row0 + t0 + t) * NAB;
              q[t] = bf2f(U[ro + 4096 + h * 128 + d]) * 0.08838834764831845f; k[t] = bf2f(U[ro + 4608 + h * 128 + d]);
              const u32x4 g0 = *(const u32x4*)(U + ro + 7184), g1 = *(const u32x4*)(U + ro + 7192);
              float x = bias;
              x += __uint_as_float(g0.x << 16) * w[0] + __uint_as_float(g0.x & 0xffff0000u) * w[1] + __uint_as_float(g0.y << 16) * w[2] + __uint_as_float(g0.y & 0xffff0000u) * w[3];
              x += __uint_as_float(g0.z << 16) * w[4] + __uint_as_float(g0.z & 0xffff0000u) * w[5] + __uint_as_float(g0.w << 16) * w[6] + __uint_as_float(g0.w & 0xffff0000u) * w[7];
              x += __uint_as_float(g1.x << 16) * w[8] + __uint_as_float(g1.x & 0xffff0000u) * w[9] + __uint_as_float(g1.y << 16) * w[10] + __uint_as_float(g1.y & 0xffff0000u) * w[11];
              x += __uint_as_float(g1.z << 16) * w[12] + __uint_as_float(g1.z & 0xffff0000u) * w[13] + __uint_as_float(g1.w << 16) * w[14] + __uint_as_float(g1.w & 0xffff0000u) * w[15];
              gl[t] = -softplus_(-x) * (1.f / 16.f); } }
#pragma unroll
        for (int t = 1; t < 16; ++t) gl[t] += gl[t - 1];
        Pg[tg * 128 + d] = gl[15];
        __syncthreads();
        { float off = 0.f;
#pragma unroll
          for (int g = 0; g < 3; ++g) off += (g < tg) ? Pg[g * 128 + d] : 0.f;
          if (tg == 3) GE[d] = gl[15] + off;
#pragma unroll
          for (int t = 0; t < 16; ++t) { const float Gt = gl[t] + off; Qg[(t0 + t) * 136 + d] = (bf16)f2bf(q[t] * __expf(Gt)); Ka[(t0 + t) * 136 + d] = (bf16)f2bf(k[t] * __expf(-Gt)); } }
        __syncthreads();
        bf16x8* base = (bf16x8*)(OPS + (size_t)item * GLA_ITEM_BYTES);
        if (wave < 4) {
            const int mt = wave >> 1, nt = wave & 1;
            f32x16 acc;
#pragma unroll
            for (int i = 0; i < 16; ++i) acc[i] = 0.f;
#pragma unroll
            for (int ks = 0; ks < 8; ++ks) acc = MFMA32(*(const LAS bf16x8*)(Qg + (32 * mt + r) * 136 + 16 * ks + 8 * hp), *(const LAS bf16x8*)(Ka + (32 * nt + r) * 136 + 16 * ks + 8 * hp), acc);
            const int jt = 32 * nt + r;
#pragma unroll
            for (int i16 = 0; i16 < 16; ++i16) { const int i = 32 * mt + crow(i16, hp); QKm[i * 65 + jt] = jt <= i ? acc[i16] : 0.f; }
        } else {
            const int w4 = wave - 4;
#pragma unroll
            for (int q8 = 0; q8 < 8; ++q8) { const int f = w4 + 4 * q8, nt = f >> 2, ks = f & 3, p = 32 * nt + r;
                unsigned w[4];
#pragma unroll
                for (int jp = 0; jp < 8; jp += 2) { const int tk = 16 * ks + 8 * (jp >> 2) + 4 * hp + (jp & 3);
                    w[jp >> 1] = (unsigned)U[(size_t)(row0 + tk) * NAB + 5120 + h * 256 + p] | ((unsigned)U[(size_t)(row0 + tk + 1) * NAB + 5120 + h * 256 + p] << 16); }
                base[(40 + f) * 64 + lane] = __builtin_bit_cast(bf16x8, (u32x4){w[0], w[1], w[2], w[3]}); }
        }
        __syncthreads();
        float v[8];
#pragma unroll
        for (int q2 = 0; q2 < 2; ++q2) { const int f = wave + 8 * q2;
            { const int mt = f >> 3, ks = f & 7, i = 32 * mt + r;
              const u32x2 lo = *(const LAS u32x2*)(Qg + i * 136 + 16 * ks + 4 * hp), hi = *(const LAS u32x2*)(Qg + i * 136 + 16 * ks + 8 + 4 * hp);
              base[f * 64 + lane] = __builtin_bit_cast(bf16x8, (u32x4){lo.x, lo.y, hi.x, hi.y}); }
            { const int mt = f >> 2, ks = f & 3, dd = 32 * mt + r; const float eg = __expf(GE[dd]);
#pragma unroll
              for (int jp = 0; jp < 8; ++jp) v[jp] = bf2f(Ka[(16 * ks + 8 * (jp >> 2) + 4 * hp + (jp & 3)) * 136 + dd]) * eg;
              base[(16 + f) * 64 + lane] = pack8(v); } }
        { const int f = wave, mt = f >> 2, ks = f & 3, i = 32 * mt + r;
#pragma unroll
          for (int jp = 0; jp < 8; ++jp) v[jp] = QKm[i * 65 + 16 * ks + 8 * (jp >> 2) + 4 * hp + (jp & 3)];
          base[(32 + f) * 64 + lane] = pack8(v); }
        if (tid < 128) ((float*)(base + 72 * 64))[tid] = __expf(GE[tid]);
    }
}

constexpr size_t DN_ITEM_BYTES = 74752;
__device__ __forceinline__ void phase_dn_prep(const KP kp, const int bid, const int G, int j, LAS unsigned char* lds, int tid0) {
    unsigned char* scr = kp.ws() + WS_SCR;
    const bf16* U = (const bf16*)(kp.ws() + WS_U); const float* cw = kp.in(14) + (size_t)j * 4 * 3072;
    unsigned char* OPS = scr + SC_DNOPS;
    LAS float* AMT = (LAS float*)lds; LAS float* GLs = AMT + 64 * 68; LAS float* BLs = GLs + 64; LAS float* SS = BLs + 64;
    LAS bf16* Kb = (LAS bf16*)(SS + 256); LAS bf16* Qb = Kb + 64 * 136; LAS float* QKm = (LAS float*)(Qb + 64 * 136); LAS float* XL = QKm + 64 * 65;
    for (int item = bid; item < 1024; item += G) {
        int tid = tid0; asm volatile("" : "+v"(tid));
        const int lane = tid & 63, r = lane & 31, hp = lane >> 5, wave = tid >> 6;
        const int b = item >> 8, n = (item >> 3) & 31, h = item & 7;
        const int row0 = b * 2048 + n * 64;
        __syncthreads();
        SEC_BEGIN(20)
        {
          const int t0 = 8 * wave; const bool first = (n == 0 && wave == 0);
          const long fo = first ? 0 : (long)NAB;
          float qa[8], qb[8], ka[8], kb[8];
#pragma unroll
          for (int part = 0; part < 3; ++part) { const int c = part * 1024 + h * 128 + 2 * lane;
              const float w0a = cw[c], w0b = cw[c + 1], w1a = cw[3072 + c], w1b = cw[3072 + c + 1], w2a = cw[2 * 3072 + c], w2b = cw[2 * 3072 + c + 1], w3a = cw[3 * 3072 + c], w3b = cw[3 * 3072 + c + 1];
              const bf16* up = U + (size_t)(row0 + t0) * NAB + c;
              unsigned raw[11];
              raw[0] = *(const unsigned*)(up - 3 * fo); raw[1] = *(const unsigned*)(up - 2 * fo); raw[2] = *(const unsigned*)(up - 1 * fo);
#pragma unroll
              for (int t = 0; t < 8; ++t) raw[3 + t] = *(const unsigned*)(up + (size_t)t * NAB);
              if (first) { raw[0] = 0u; raw[1] = 0u; raw[2] = 0u; }
#pragma unroll
              for (int t = 0; t < 8; ++t) {
                  const float ya = silu_(w0a * __uint_as_float(raw[t] << 16) + w1a * __uint_as_float(raw[t + 1] << 16) + w2a * __uint_as_float(raw[t + 2] << 16) + w3a * __uint_as_float(raw[t + 3] << 16));
                  const float yb = silu_(w0b * __uint_as_float(raw[t] & 0xffff0000u) + w1b * __uint_as_float(raw[t + 1] & 0xffff0000u) + w2b * __uint_as_float(raw[t + 2] & 0xffff0000u) + w3b * __uint_as_float(raw[t + 3] & 0xffff0000u));
                  if (part == 0) { qa[t] = ya; qb[t] = yb; } else if (part == 1) { ka[t] = ya; kb[t] = yb; } else { XL[(t0 + t) * 257 + 2 * lane] = ya; XL[(t0 + t) * 257 + 2 * lane + 1] = yb; } } }
#pragma unroll
          for (int t = 0; t < 8; ++t) { const float scq = rsqrtf(wave_sum(qa[t] * qa[t] + qb[t] * qb[t]) + 1e-6f) * 0.08838834764831845f, sck = rsqrtf(wave_sum(ka[t] * ka[t] + kb[t] * kb[t]) + 1e-6f);
              *(LAS unsigned*)(Qb + (t0 + t) * 136 + 2 * lane) = pk2(qa[t] * scq, qb[t] * scq); *(LAS unsigned*)(Kb + (t0 + t) * 136 + 2 * lane) = pk2(ka[t] * sck, kb[t] * sck); } }
        if (wave == 0) { const size_t ro = (size_t)(row0 + lane) * NAB;
            float gv = -__expf(kp.in(15)[j * 8 + h]) * softplus_(bf2f(U[ro + 7176 + h]) + kp.in(16)[j * 8 + h]);
#pragma unroll
            for (int o = 1; o < 64; o <<= 1) { const float tt = __shfl_up(gv, o); if (lane >= o) gv += tt; }
            GLs[lane] = gv; BLs[lane] = sigmoid_(bf2f(U[ro + 7168 + h])); }
        __syncthreads();
        SEC_END(20, lds)
        SEC_BEGIN(21)
        SEC_END(21, lds)
        SEC_BEGIN(22)
        bf16x8* base = (bf16x8*)(OPS + (size_t)item * DN_ITEM_BYTES);
        { const int which = wave >> 2, mt = (wave >> 1) & 1, nt = wave & 1;
          const LAS bf16* Asrc = which ? Qb : Kb;
          f32x16 acc;
#pragma unroll
          for (int i = 0; i < 16; ++i) acc[i] = 0.f;
#pragma unroll
          for (int ks = 0; ks < 8; ++ks) acc = MFMA32(*(const LAS bf16x8*)(Asrc + (32 * mt + r) * 136 + 16 * ks + 8 * hp), *(const LAS bf16x8*)(Kb + (32 * nt + r) * 136 + 16 * ks + 8 * hp), acc);
          const int jt = 32 * nt + r; const float gj = GLs[jt];
#pragma unroll
          for (int i16 = 0; i16 < 16; ++i16) { const int i = 32 * mt + crow(i16, hp); const float dec = __expf(GLs[i] - gj);
              if (which == 0) AMT[jt * 68 + i] = jt < i ? BLs[i] * acc[i16] * dec : 0.f; else QKm[i * 65 + jt] = jt <= i ? acc[i16] * dec : 0.f; } }
        __syncthreads();
        SEC_END(22, lds)
        SEC_BEGIN(23)
        if (tid < 256) {
            SECW_BEGIN(25)
            const int c = tid;
#pragma unroll
            for (int bi = 0; bi < 4; ++bi) {
                float acc[16];
#pragma unroll
                for (int ii = 0; ii < 16; ++ii) { const int i = 16 * bi + ii; const float be = BLs[i];
                    acc[ii] = c < 128 ? be * XL[i * 257 + c] : be * __expf(GLs[i]) * bf2f(Kb[i * 136 + (c - 128)]); }
#pragma unroll 4
                for (int jj = 0; jj < 16 * bi; ++jj) { const float xj = XL[jj * 257 + c];
#pragma unroll
                    for (int q = 0; q < 4; ++q) { const f32x4 a = *(const LAS f32x4*)(AMT + jj * 68 + 16 * bi + 4 * q);
                        acc[4 * q + 0] -= a[0] * xj; acc[4 * q + 1] -= a[1] * xj; acc[4 * q + 2] -= a[2] * xj; acc[4 * q + 3] -= a[3] * xj; } }
                float dg[120];
#pragma unroll
                for (int ii = 1; ii < 16; ++ii)
#pragma unroll
                    for (int jj = 0; jj < ii; ++jj) dg[ii * (ii - 1) / 2 + jj] = AMT[(16 * bi + jj) * 68 + 16 * bi + ii];
#pragma unroll
                for (int ii = 0; ii < 16; ++ii) { float x = acc[ii];
#pragma unroll
                    for (int jj = 0; jj < ii; ++jj) x -= dg[ii * (ii - 1) / 2 + jj] * acc[jj];
                    acc[ii] = x; }
#pragma unroll
                for (int ii = 0; ii < 16; ++ii) XL[(16 * bi + ii) * 257 + c] = acc[ii];
            }
            SECW_END(25, lds, 0)
        } else {
            SECW_BEGIN(26)
            const int w4 = wave - 4; float v[8];
#pragma unroll
            for (int q = 0; q < 4; ++q) { const int f = w4 + 4 * q;
                { const int mt = f >> 3, ks = f & 7, i = 32 * mt + r; const float eg = __expf(GLs[i]);
                  const bf16x8 qq = *(const LAS bf16x8*)(Qb + i * 136 + 16 * ks + 8 * hp);
#pragma unroll
                  for (int jp = 0; jp < 8; ++jp) v[jp] = bf2f(Qb[i * 136 + 16 * ks + 8 * (jp >> 2) + 4 * hp + (jp & 3)]) * eg;
                  (void)qq; base[(16 + f) * 64 + lane] = pack8(v); }
                { const int mt = f >> 2, ks = f & 3, d = 32 * mt + r; const float Gend = GLs[63];
#pragma unroll
                  for (int jp = 0; jp < 8; ++jp) { const int tk = 16 * ks + 8 * (jp >> 2) + 4 * hp + (jp & 3); v[jp] = bf2f(Kb[tk * 136 + d]) * __expf(Gend - GLs[tk]); }
                  base[(32 + f) * 64 + lane] = pack8(v); } }
#pragma unroll
            for (int q = 0; q < 2; ++q) { const int f = w4 + 4 * q, mt = f >> 2, ks = f & 3, i = 32 * mt + r;
#pragma unroll
                for (int jp = 0; jp < 8; ++jp) v[jp] = QKm[i * 65 + 16 * ks + 8 * (jp >> 2) + 4 * hp + (jp & 3)];
                base[(48 + f) * 64 + lane] = pack8(v); }
            if (tid == 256) *(float*)(base + 72 * 64) = __expf(GLs[63]);
            SECW_END(26, lds, 256)
        }
        __syncthreads();
        SEC_END(23, lds)
        SEC_BEGIN(24)
        float v[8];
#pragma unroll
        for (int q = 0; q < 2; ++q) { const int f = wave + 8 * q;
            { const int mt = f >> 3, ks = f & 7, i = 32 * mt + r;
#pragma unroll
              for (int jp = 0; jp < 8; ++jp) v[jp] = -XL[i * 257 + 128 + 16 * ks + 8 * (jp >> 2) + 4 * hp + (jp & 3)];
              base[f * 64 + lane] = pack8(v); }
            { const int pq = f & 1, tl = f >> 1, mt = tl >> 2, nt = tl & 3;
#pragma unroll
              for (int e = 0; e < 8; ++e) v[e] = XL[(32 * mt + crow(8 * pq + e, hp)) * 257 + 32 * nt + r];
              base[(56 + f) * 64 + lane] = pack8(v); } }
        SEC_END(24, lds)
    }
}

__device__ __forceinline__ void phase_ab_rec(const KP kp, const int bid, const int G, int j, int li, LAS unsigned char* lds, int tid0) {
    unsigned char* scr = kp.ws() + WS_SCR; const bf16* U = (const bf16*)(kp.ws() + WS_U);
    float* ODN = (float*)(scr + SC_ODN); float* OGLA = (float*)(scr + SC_OGLA);
    SEC_BEGIN(12)
    for (int item = bid; item < 64; item += G) {
        int tid = tid0; asm volatile("" : "+v"(tid));
        int s, h; bool isdn; int half = -1;
        if (item < 32) { isdn = false; s = item >> 3; h = (item >> 1) & 3; half = item & 1; }
        else if (item < 64) { isdn = true; s = (item - 32) >> 3; h = (item - 32) & 7; half = -2; }
        else if (item < 1088) { isdn = true; s = 4 + ((item - 64) >> 3); h = (item - 64) & 7; }
        else { isdn = false; s = 4 + ((item - 1088) >> 2); h = (item - 1088) & 3; }
        int row0, L; seq_info(s, row0, L);
        __syncthreads();
        if (half == -2) {
            const int wave = __builtin_amdgcn_readfirstlane(tid >> 6), lane = tid & 63, r = lane & 31, hp = lane >> 5;
            const int b = s, nt = wave;
            const unsigned char* OPS = scr + SC_DNOPS;
            constexpr int DBUF = 73 * 1024;
#define DN_DMA(n_, bufi_) do { const unsigned char* gi_ = OPS + (size_t)((b * 32 + (n_)) * 8 + h) * DN_ITEM_BYTES + lane * 16; \
                _Pragma("unroll") for (int q_ = 0; q_ < 10; ++q_) { const int lf_ = wave + 8 * q_; if (lf_ < 73) \
                    __builtin_amdgcn_global_load_lds((const unsigned*)(gi_ + lf_ * 1024), (LAS unsigned*)(lds + (bufi_) * DBUF + lf_ * 1024), 16, 0, 2); } } while (0)
            f32x16 S0, S1, S2, S3;
#pragma unroll
            for (int i = 0; i < 16; ++i) { S0[i] = 0.f; S1[i] = 0.f; S2[i] = 0.f; S3[i] = 0.f; }
            DN_DMA(0, 0);
            asm volatile("s_waitcnt vmcnt(0)" ::: "memory"); __syncthreads();
            for (int n = 0; n < 32; ++n) {
                if (n + 1 < 32) DN_DMA(n + 1, (n + 1) & 1);
                if (wave < 4) {
                    const LAS bf16x8* F = (const LAS bf16x8*)(lds + (n & 1) * DBUF) + lane;
                    const float gend = *(const LAS float*)(lds + (n & 1) * DBUF + 72 * 1024);
                    const bf16x8 sb0 = PACK_ACC(S0, 0), sb1 = PACK_ACC(S0, 1), sb2 = PACK_ACC(S1, 0), sb3 = PACK_ACC(S1, 1), sb4 = PACK_ACC(S2, 0), sb5 = PACK_ACC(S2, 1), sb6 = PACK_ACC(S3, 0), sb7 = PACK_ACC(S3, 1);
                    f32x16 U0t, U1t;
                    { const bf16x8 a0 = F[(56 + nt * 2 + 0) * 64], a1 = F[(56 + nt * 2 + 1) * 64], c0 = F[(56 + (4 + nt) * 2 + 0) * 64], c1 = F[(56 + (4 + nt) * 2 + 1) * 64];
#pragma unroll
                      for (int e = 0; e < 8; ++e) { U0t[e] = bf2f((bf16)a0[e]); U0t[8 + e] = bf2f((bf16)a1[e]); U1t[e] = bf2f((bf16)c0[e]); U1t[8 + e] = bf2f((bf16)c1[e]); } }
                    U0t = MFMA32(F[0 * 64], sb0, U0t); U0t = MFMA32(F[1 * 64], sb1, U0t); U0t = MFMA32(F[2 * 64], sb2, U0t); U0t = MFMA32(F[3 * 64], sb3, U0t);
                    U0t = MFMA32(F[4 * 64], sb4, U0t); U0t = MFMA32(F[5 * 64], sb5, U0t); U0t = MFMA32(F[6 * 64], sb6, U0t); U0t = MFMA32(F[7 * 64], sb7, U0t);
                    U1t = MFMA32(F[8 * 64], sb0, U1t); U1t = MFMA32(F[9 * 64], sb1, U1t); U1t = MFMA32(F[10 * 64], sb2, U1t); U1t = MFMA32(F[11 * 64], sb3, U1t);
                    U1t = MFMA32(F[12 * 64], sb4, U1t); U1t = MFMA32(F[13 * 64], sb5, U1t); U1t = MFMA32(F[14 * 64], sb6, U1t); U1t = MFMA32(F[15 * 64], sb7, U1t);
                    const bf16x8 ub0 = PACK_ACC(U0t, 0), ub1 = PACK_ACC(U0t, 1), ub2 = PACK_ACC(U1t, 0), ub3 = PACK_ACC(U1t, 1);
                    f32x16 O0, O1;
#pragma unroll
                    for (int i = 0; i < 16; ++i) { O0[i] = 0.f; O1[i] = 0.f; }
                    O0 = MFMA32(F[16 * 64], sb0, O0); O0 = MFMA32(F[17 * 64], sb1, O0); O0 = MFMA32(F[18 * 64], sb2, O0); O0 = MFMA32(F[19 * 64], sb3, O0);
                    O0 = MFMA32(F[20 * 64], sb4, O0); O0 = MFMA32(F[21 * 64], sb5, O0); O0 = MFMA32(F[22 * 64], sb6, O0); O0 = MFMA32(F[23 * 64], sb7, O0);
                    O1 = MFMA32(F[24 * 64], sb0, O1); O1 = MFMA32(F[25 * 64], sb1, O1); O1 = MFMA32(F[26 * 64], sb2, O1); O1 = MFMA32(F[27 * 64], sb3, O1);
                    O1 = MFMA32(F[28 * 64], sb4, O1); O1 = MFMA32(F[29 * 64], sb5, O1); O1 = MFMA32(F[30 * 64], sb6, O1); O1 = MFMA32(F[31 * 64], sb7, O1);
                    O0 = MFMA32(F[48 * 64], ub0, O0); O0 = MFMA32(F[49 * 64], ub1, O0);
                    O1 = MFMA32(F[52 * 64], ub0, O1); O1 = MFMA32(F[53 * 64], ub1, O1); O1 = MFMA32(F[54 * 64], ub2, O1); O1 = MFMA32(F[55 * 64], ub3, O1);
#pragma unroll
                    for (int i = 0; i < 16; ++i) { S0[i] *= gend; S1[i] *= gend; S2[i] *= gend; S3[i] *= gend; }
                    S0 = MFMA32(F[32 * 64], ub0, S0); S0 = MFMA32(F[33 * 64], ub1, S0); S0 = MFMA32(F[34 * 64], ub2, S0); S0 = MFMA32(F[35 * 64], ub3, S0);
                    S1 = MFMA32(F[36 * 64], ub0, S1); S1 = MFMA32(F[37 * 64], ub1, S1); S1 = MFMA32(F[38 * 64], ub2, S1); S1 = MFMA32(F[39 * 64], ub3, S1);
                    S2 = MFMA32(F[40 * 64], ub0, S2); S2 = MFMA32(F[41 * 64], ub1, S2); S2 = MFMA32(F[42 * 64], ub2, S2); S2 = MFMA32(F[43 * 64], ub3, S2);
                    S3 = MFMA32(F[44 * 64], ub0, S3); S3 = MFMA32(F[45 * 64], ub1, S3); S3 = MFMA32(F[46 * 64], ub2, S3); S3 = MFMA32(F[47 * 64], ub3, S3);
                    float* yo = ODN + (size_t)(b * 2048 + n * 64) * 1024 + h * 128 + 32 * nt + r;
#pragma unroll
                    for (int i = 0; i < 16; ++i) { yo[(size_t)crow(i, hp) * 1024] = O0[i]; yo[(size_t)(32 + crow(i, hp)) * 1024] = O1[i]; }
                }
                asm volatile("s_waitcnt vmcnt(0)" ::: "memory"); __syncthreads();
            }
#undef DN_DMA
            if (wave < 4) {
                float* dst = kp.out() + O_DN_P + ((size_t)j * 4 + b) * ((size_t)8 * 128 * 128) + (size_t)h * 128 * 128 + 32 * nt + r;
#pragma unroll
                for (int i = 0; i < 16; ++i) { dst[(size_t)crow(i, hp) * 128] = S0[i]; dst[(size_t)(32 + crow(i, hp)) * 128] = S1[i]; dst[(size_t)(64 + crow(i, hp)) * 128] = S2[i]; dst[(size_t)(96 + crow(i, hp)) * 128] = S3[i]; }
            }
        } else if (half >= 0) {
            const int wave = __builtin_amdgcn_readfirstlane(tid >> 6), lane = tid & 63, r = lane & 31, hp = lane >> 5;
            const int b = s, nt = half * 4 + wave;
            const unsigned char* OPS = kp.ws() + WS_GLAOPS;
            constexpr int GBUF = 57 * 1024;
#define GLA_DMA(n_, bufi_) do { const unsigned char* gi_ = OPS + (size_t)((b * 32 + (n_)) * 4 + h) * GLA_ITEM_BYTES + lane * 16; \
                _Pragma("unroll") for (int q_ = 0; q_ < 8; ++q_) { const int lf_ = wave + 8 * q_; if (lf_ < 57) { const int gf_ = lf_ < 40 ? lf_ : (lf_ < 56 ? lf_ + half * 16 : 72); \
                    __builtin_amdgcn_global_load_lds((const unsigned*)(gi_ + gf_ * 1024), (LAS unsigned*)(lds + (bufi_) * GBUF + lf_ * 1024), 16, 0, 2); } } } while (0)
            f32x16 S0, S1, S2, S3;
#pragma unroll
            for (int i = 0; i < 16; ++i) { S0[i] = 0.f; S1[i] = 0.f; S2[i] = 0.f; S3[i] = 0.f; }
            GLA_DMA(0, 0);
            asm volatile("s_waitcnt vmcnt(0)" ::: "memory"); __syncthreads();
            for (int n = 0; n < 32; ++n) {
                if (n + 1 < 32) GLA_DMA(n + 1, (n + 1) & 1);
                if (wave < 4) {
                    const LAS bf16x8* F = (const LAS bf16x8*)(lds + (n & 1) * GBUF) + lane;
                    const LAS float* ge = (const LAS float*)(lds + (n & 1) * GBUF + 56 * 1024) + 4 * hp;
                    const bf16x8 sb0 = PACK_ACC(S0, 0), sb1 = PACK_ACC(S0, 1), sb2 = PACK_ACC(S1, 0), sb3 = PACK_ACC(S1, 1), sb4 = PACK_ACC(S2, 0), sb5 = PACK_ACC(S2, 1), sb6 = PACK_ACC(S3, 0), sb7 = PACK_ACC(S3, 1);
                    f32x16 O0, O1;
#pragma unroll
                    for (int i = 0; i < 16; ++i) { O0[i] = 0.f; O1[i] = 0.f; }
                    O0 = MFMA32(F[0 * 64], sb0, O0); O0 = MFMA32(F[1 * 64], sb1, O0); O0 = MFMA32(F[2 * 64], sb2, O0); O0 = MFMA32(F[3 * 64], sb3, O0);
                    O0 = MFMA32(F[4 * 64], sb4, O0); O0 = MFMA32(F[5 * 64], sb5, O0); O0 = MFMA32(F[6 * 64], sb6, O0); O0 = MFMA32(F[7 * 64], sb7, O0);
                    O1 = MFMA32(F[8 * 64], sb0, O1); O1 = MFMA32(F[9 * 64], sb1, O1); O1 = MFMA32(F[10 * 64], sb2, O1); O1 = MFMA32(F[11 * 64], sb3, O1);
                    O1 = MFMA32(F[12 * 64], sb4, O1); O1 = MFMA32(F[13 * 64], sb5, O1); O1 = MFMA32(F[14 * 64], sb6, O1); O1 = MFMA32(F[15 * 64], sb7, O1);
                    bf16x8 vb[4];
#pragma unroll
                    for (int ks = 0; ks < 4; ++ks) vb[ks] = F[(40 + wave * 4 + ks) * 64];
                    O0 = MFMA32(F[32 * 64], vb[0], O0); O0 = MFMA32(F[33 * 64], vb[1], O0);
#pragma unroll
                    for (int ks = 0; ks < 4; ++ks) O1 = MFMA32(F[(36 + ks) * 64], vb[ks], O1);
#pragma unroll
                    for (int q = 0; q < 4; ++q) { const f32x4 g0 = *(const LAS f32x4*)(ge + 8 * q), g1 = *(const LAS f32x4*)(ge + 32 + 8 * q), g2 = *(const LAS f32x4*)(ge + 64 + 8 * q), g3 = *(const LAS f32x4*)(ge + 96 + 8 * q);
#pragma unroll
                        for (int c = 0; c < 4; ++c) { S0[4 * q + c] *= g0[c]; S1[4 * q + c] *= g1[c]; S2[4 * q + c] *= g2[c]; S3[4 * q + c] *= g3[c]; } }
#pragma unroll
                    for (int ks = 0; ks < 4; ++ks) { S0 = MFMA32(F[(16 + ks) * 64], vb[ks], S0); S1 = MFMA32(F[(20 + ks) * 64], vb[ks], S1); S2 = MFMA32(F[(24 + ks) * 64], vb[ks], S2); S3 = MFMA32(F[(28 + ks) * 64], vb[ks], S3); }
                    float* yo = OGLA + (size_t)(b * 2048 + n * 64) * 1024 + h * 256 + 32 * nt + r;
#pragma unroll
                    for (int i = 0; i < 16; ++i) { yo[(size_t)crow(i, hp) * 1024] = O0[i]; yo[(size_t)(32 + crow(i, hp)) * 1024] = O1[i]; }
                }
                asm volatile("s_waitcnt vmcnt(0)" ::: "memory"); __syncthreads();
            }
#undef GLA_DMA
            if (wave < 4) {
                float* dst = kp.out() + O_GLA_P + ((size_t)j * 4 + b) * ((size_t)4 * 128 * 256) + (size_t)h * 128 * 256 + 32 * nt + r;
#pragma unroll
                for (int i = 0; i < 16; ++i) { dst[(size_t)crow(i, hp) * 256] = S0[i]; dst[(size_t)(32 + crow(i, hp)) * 256] = S1[i]; dst[(size_t)(64 + crow(i, hp)) * 256] = S2[i]; dst[(size_t)(96 + crow(i, hp)) * 256] = S3[i]; }
            }
        } else
        {}
    }
    SEC_END(12, lds)
    SEC_BEGIN(13)
    unsigned* qhead = (unsigned*)(kp.ws() + WS_CTL) + CW_CNT + 64 * li;
    volatile LAS unsigned* qslot = (volatile LAS unsigned*)(lds + LDS_BYTES - 8);
    const float* cw = kp.in(14) + (size_t)j * 4 * 3072; const float* stc = kp.in(3) + (size_t)j * 128 * 3 * 3072;
    const float* wa2 = kp.in(18) + (size_t)j * 16 * 512; const float* ba = kp.in(19) + (size_t)j * 512;
    for (;;) {
        __syncthreads();
        if (tid0 == 0) qslot[0] = __hip_atomic_fetch_add(qhead, 1u, __ATOMIC_RELAXED, __HIP_MEMORY_SCOPE_AGENT);
        __syncthreads();
        const int it = (int)qslot[0];
        if (it >= 1536) break;
        int tid = tid0; asm volatile("" : "+v"(tid));
        const int wave = tid >> 6, lane = tid & 63;
        if (it < 1024) {
            const int bs = it >> 3, h = it & 7, sq = 4 + bs, r0 = TP + bs * 4;
            LAS float* qL = (LAS float*)lds; LAS float* kL = qL + 512; LAS float* vL = kL + 512; LAS float* red = vL + 512; LAS float* sm = red + 4096;
            const int e = tid & 127, dq = tid >> 7;
            const size_t SZ = (size_t)8 * 128 * 128;
            const float* st = kp.in(2) + ((size_t)j * 128 + bs) * SZ + (size_t)h * 16384;
            float S[32];
            { const float* sp = st + (size_t)(dq * 32) * 128 + e;
#pragma unroll
              for (int i = 0; i < 32; ++i) { S[i] = *sp; sp += 128; asm volatile("" : "+v"(sp)); } }
#pragma unroll
            for (int part = 0; part < 3; ++part) { const int c = part * 1024 + h * 128 + e; float acc = 0.f;
#pragma unroll
                for (int tap = 0; tap < 4; ++tap) acc += cw[tap * 3072 + c] * pre_val(U, NAB, c, r0, dq - 3 + tap, sq, stc, 3072, c);
                if (part == 2) vL[dq * 128 + e] = silu_(acc); else (part == 0 ? qL : kL)[e * 4 + dq] = silu_(acc); }
            if (tid < 4) { const size_t ro = (size_t)(r0 + tid) * NAB;
                sm[32 + tid] = -__expf(kp.in(15)[j * 8 + h]) * softplus_(bf2f(U[ro + 7176 + h]) + kp.in(16)[j * 8 + h]); sm[36 + tid] = sigmoid_(bf2f(U[ro + 7168 + h])); }
            __syncthreads();
            { const int tk = wave & 3; LAS float* src = (wave >> 2) ? kL : qL; const float a = src[lane * 4 + tk], b = src[(lane + 64) * 4 + tk];
              const float sc = rsqrtf(wave_sum(a * a + b * b) + 1e-6f) * ((wave >> 2) ? 1.f : 0.08838834764831845f); src[lane * 4 + tk] = a * sc; src[(lane + 64) * 4 + tk] = b * sc; }
            __syncthreads();
#pragma unroll
            for (int q = 0; q < 4; ++q) { const int idx = wave * 4 + q, i = (idx >> 2) & 3, jj = idx & 3; const LAS float* src = idx < 16 ? kL : qL;
                const float dot = wave_sum(src[lane * 4 + i] * kL[lane * 4 + jj] + src[(lane + 64) * 4 + i] * kL[(lane + 64) * 4 + jj]); if (lane == 0) sm[idx] = dot; }
            float ks[4] = {0.f, 0.f, 0.f, 0.f}, qs[4] = {0.f, 0.f, 0.f, 0.f};
#pragma unroll
            for (int i = 0; i < 32; ++i) { const int d = dq * 32 + i; const float sv = S[i]; const f32x4 k4 = *(const LAS f32x4*)(kL + d * 4), q4 = *(const LAS f32x4*)(qL + d * 4);
#pragma unroll
                for (int t = 0; t < 4; ++t) { ks[t] += k4[t] * sv; qs[t] += q4[t] * sv; } }
#pragma unroll
            for (int t = 0; t < 4; ++t) { red[(t * 4 + dq) * 128 + e] = ks[t]; red[((4 + t) * 4 + dq) * 128 + e] = qs[t]; }
            __syncthreads();
            float Gc[4]; Gc[0] = sm[32]; Gc[1] = Gc[0] + sm[33]; Gc[2] = Gc[1] + sm[34]; Gc[3] = Gc[2] + sm[35];
            float u[4];
#pragma unroll
            for (int i = 0; i < 4; ++i) { const float KSi = (red[(i * 4 + 0) * 128 + e] + red[(i * 4 + 1) * 128 + e]) + (red[(i * 4 + 2) * 128 + e] + red[(i * 4 + 3) * 128 + e]);
                float acc = vL[i * 128 + e] - __expf(Gc[i]) * KSi;
#pragma unroll
                for (int jj = 0; jj < i; ++jj) acc -= sm[i * 4 + jj] * __expf(Gc[i] - Gc[jj]) * u[jj];
                u[i] = sm[36 + i] * acc; }
            if (dq == 0) {
#pragma unroll
                for (int i = 0; i < 4; ++i) { const float QSi = (red[((4 + i) * 4 + 0) * 128 + e] + red[((4 + i) * 4 + 1) * 128 + e]) + (red[((4 + i) * 4 + 2) * 128 + e] + red[((4 + i) * 4 + 3) * 128 + e]);
                    float o = __expf(Gc[i]) * QSi;
#pragma unroll
                    for (int jj = 0; jj <= i; ++jj) o += sm[16 + i * 4 + jj] * __expf(Gc[i] - Gc[jj]) * u[jj];
                    ODN[(size_t)(r0 + i) * 1024 + h * 128 + e] = o; } }
            const float eg = __expf(Gc[3]); float w[4];
#pragma unroll
            for (int jj = 0; jj < 4; ++jj) w[jj] = __expf(Gc[3] - Gc[jj]) * u[jj];
            float* dst = kp.out() + O_DN_S + ((size_t)j * 128 + bs) * SZ + (size_t)h * 16384 + (size_t)(dq * 32) * 128 + e;
#pragma unroll
            for (int i = 0; i < 32; ++i) { const int d = dq * 32 + i; float sv = eg * S[i]; const f32x4 k4 = *(const LAS f32x4*)(kL + d * 4);
#pragma unroll
                for (int jj = 0; jj < 4; ++jj) sv += k4[jj] * w[jj];
                *dst = sv; dst += 128; asm volatile("" : "+v"(dst)); }
        } else {
            const int q_ = it - 1024, bs = q_ >> 2, h = q_ & 3, r0 = TP + bs * 4;
            LAS float* qgL = (LAS float*)lds; LAS float* kaL = qgL + 512; LAS float* glL = kaL + 512; LAS float* egL = glL + 512; LAS float* Am = egL + 128; LAS float* red = Am + 16;
            const int e = tid & 255, dh = tid >> 8;
            const size_t SZ = (size_t)4 * 128 * 256;
            const float* st = kp.in(4) + ((size_t)j * 128 + bs) * SZ + (size_t)h * 32768;
            float S[64];
            { const float* sp = st + (size_t)(dh * 64) * 256 + e;
#pragma unroll
              for (int i = 0; i < 64; ++i) { S[i] = *sp; sp += 256; asm volatile("" : "+v"(sp)); } }
            float v[4];
#pragma unroll
            for (int t = 0; t < 4; ++t) v[t] = bf2f(U[(size_t)(r0 + t) * NAB + 5120 + h * 256 + e]);
            { const int d = tid & 127, tk = tid >> 7; const size_t ro = (size_t)(r0 + tk) * NAB;
              qgL[d * 4 + tk] = bf2f(U[ro + 4096 + h * 128 + d]) * 0.08838834764831845f; kaL[d * 4 + tk] = bf2f(U[ro + 4608 + h * 128 + d]);
              float x = ba[h * 128 + d];
#pragma unroll
              for (int rr = 0; rr < 16; ++rr) x += bf2f(U[ro + 7184 + rr]) * wa2[rr * 512 + h * 128 + d];
              glL[tk * 128 + d] = -softplus_(-x) * (1.f / 16.f); }
            __syncthreads();
            if (tid < 128) { float Gq = 0.f;
#pragma unroll
                for (int t = 0; t < 4; ++t) { Gq += glL[t * 128 + tid]; qgL[tid * 4 + t] *= __expf(Gq); kaL[tid * 4 + t] *= __expf(-Gq); }
                egL[tid] = __expf(Gq); }
            __syncthreads();
#pragma unroll
            for (int q = 0; q < 2; ++q) { const int idx = wave * 2 + q, i = idx >> 2, jj = idx & 3;
                const float dot = wave_sum(qgL[lane * 4 + i] * kaL[lane * 4 + jj] + qgL[(lane + 64) * 4 + i] * kaL[(lane + 64) * 4 + jj]); if (lane == 0) Am[idx] = dot; }
            float o[4] = {0.f, 0.f, 0.f, 0.f};
            float* dst = kp.out() + O_GLA_S + ((size_t)j * 128 + bs) * SZ + (size_t)h * 32768 + (size_t)(dh * 64) * 256 + e;
#pragma unroll
            for (int i = 0; i < 64; ++i) { const int d = dh * 64 + i; const float s0 = S[i]; float acc = s0; const f32x4 q4 = *(const LAS f32x4*)(qgL + d * 4), k4 = *(const LAS f32x4*)(kaL + d * 4);
#pragma unroll
                for (int t = 0; t < 4; ++t) { o[t] += q4[t] * s0; acc += k4[t] * v[t]; }
                *dst = egL[d] * acc; dst += 256; asm volatile("" : "+v"(dst)); }
#pragma unroll
            for (int t = 0; t < 4; ++t) red[(dh * 4 + t) * 256 + e] = o[t];
            __syncthreads();
            if (dh == 0) {
#pragma unroll
                for (int t = 0; t < 4; ++t) { float oo = red[t * 256 + e] + red[(4 + t) * 256 + e];
#pragma unroll
                    for (int jj = 0; jj <= t; ++jj) oo += Am[t * 4 + jj] * v[jj];
                    OGLA[(size_t)(r0 + t) * 1024 + h * 256 + e] = oo; } }
        }
    }
    SEC_END(13, lds)
}

__device__ __forceinline__ void phase_ab_post(const KP kp, const int bid, const int G, int j, int tid, int wave, int lane) {
    unsigned char* scr = kp.ws() + WS_SCR; const bf16* U = (const bf16*)(kp.ws() + WS_U); bf16* YM = (bf16*)(kp.ws() + WS_YM);
    const float* ODN = (const float*)(scr + SC_ODN); const float* OGLA = (const float*)(scr + SC_OGLA);
    const float* dnn = kp.in(17) + (size_t)j * 128; const float* glan = kp.in(20) + (size_t)j * 256;
    typedef float f32x2v __attribute__((ext_vector_type(2)));
    const f32x2v dg = *(const f32x2v*)(dnn + 2 * lane); const f32x4 gg = *(const f32x4*)(glan + 4 * lane);
    for (int idx = bid * NWAVES + wave; idx < T; idx += G * NWAVES) {
        const int gq_ = idx / 17, rq_ = idx - gq_ * 17, r = rq_ < 16 ? gq_ * 16 + rq_ : TP + gq_;
        int s, t; row_to_seq(r, s, t); int row0, L; seq_info(s, row0, L);
        const bf16* ur = U + (size_t)r * NAB; bf16* yr = YM + (size_t)r * DM;
        f32x2v od[8]; unsigned zd[8]; f32x4 og[4]; u32x2 zg[4];
#pragma unroll
        for (int hh = 0; hh < 8; ++hh) { od[hh] = *(const f32x2v*)(ODN + (size_t)r * 1024 + hh * 128 + 2 * lane); zd[hh] = *(const unsigned*)(ur + 3072 + hh * 128 + 2 * lane); }
#pragma unroll
        for (int hh = 0; hh < 4; ++hh) { og[hh] = *(const f32x4*)(OGLA + (size_t)r * 1024 + hh * 256 + 4 * lane); zg[hh] = *(const u32x2*)(ur + 6144 + hh * 256 + 4 * lane); }
#pragma unroll
        for (int hh = 0; hh < 8; ++hh) { const f32x2v o = od[hh];
            const float rstd = rsqrtf(wave_sum(o.x * o.x + o.y * o.y) * (1.f / 128.f) + 1e-6f);
            const unsigned zz = zd[hh];
            *(unsigned*)(yr + hh * 128 + 2 * lane) = pk2(o.x * rstd * dg.x * silu_(__uint_as_float(zz << 16)), o.y * rstd * dg.y * silu_(__uint_as_float(zz & 0xffff0000u))); }
#pragma unroll
        for (int hh = 0; hh < 4; ++hh) { const f32x4 o = og[hh];
            const float rstd = rsqrtf(wave_sum((o.x * o.x + o.y * o.y) + (o.z * o.z + o.w * o.w)) * (1.f / 256.f) + 1e-6f);
            const u32x2 zz = zg[hh];
            u32x2 w; w.x = pk2(o.x * rstd * gg.x * silu_(__uint_as_float(zz.x << 16)), o.y * rstd * gg.y * silu_(__uint_as_float(zz.x & 0xffff0000u)));
            w.y = pk2(o.z * rstd * gg.z * silu_(__uint_as_float(zz.y << 16)), o.w * rstd * gg.w * silu_(__uint_as_float(zz.y & 0xffff0000u)));
            *(u32x2*)(yr + 1024 + hh * 256 + 4 * lane) = w; }
        if (t >= L - 3) { const int rr = t - (L - 3);
            float* dst = s < 4 ? kp.out() + O_DNC_P + (((size_t)j * 4 + s) * 3 + rr) * 3072 : kp.out() + O_DNC_S + (((size_t)j * 128 + (s - 4)) * 3 + rr) * 3072;
            for (int c = 2 * lane; c < 3072; c += 128) { const unsigned uu = *(const unsigned*)(ur + c); *(f32x2v*)(dst + c) = (f32x2v){__uint_as_float(uu << 16), __uint_as_float(uu & 0xffff0000u)}; } }
    }
}

__device__ __forceinline__ void phase_lru_gates(const KP kp, const int bid, const int G, int j, LAS unsigned char* lds, int tid0) {
    unsigned char* scr = kp.ws() + WS_SCR; const bf16* U = (const bf16*)(kp.ws() + WS_U);
    float* LA = (float*)(scr + SC_LA); float* LB = (float*)(scr + SC_LB);
    const float* lcw = kp.in(29) + (size_t)j * 4 * 1024; const float* lcb = kp.in(30) + (size_t)j * 1024; const float* lstc = kp.in(8) + (size_t)j * 128 * 3 * 1024;
    const int n = bid & 15;
    const float* wa = kp.in(31) + ((size_t)j * 16 + n) * 4096; const float* wx = kp.in(33) + ((size_t)j * 16 + n) * 4096;
    const float* lba = kp.in(32) + (size_t)j * 1024; const float* lbx = kp.in(34) + (size_t)j * 1024; const float* lam = kp.in(35) + (size_t)j * 1024;
    LAS bf16x8* WF = (LAS bf16x8*)lds;
    LAS float* xcL = (LAS float*)(lds + 16384);
    LAS float* igL = xcL + 64 * 68;
    __syncthreads();
    { const int lane = tid0 & 63, f = tid0 >> 6, r = lane & 31, hp = lane >> 5, nt = f >> 2, ks = f & 3; float v[8];
#pragma unroll
      for (int jp = 0; jp < 8; ++jp) v[jp] = wa[(16 * ks + 8 * hp + jp) * 64 + 32 * nt + r];
      WF[f * 64 + lane] = pack8(v);
#pragma unroll
      for (int jp = 0; jp < 8; ++jp) v[jp] = wx[(16 * ks + 8 * hp + jp) * 64 + 32 * nt + r];
      WF[512 + f * 64 + lane] = pack8(v); }
    for (int tile = bid >> 4; tile < T / 64; tile += (G >> 4)) {
        int tid = tid0; asm volatile("" : "+v"(tid));
        const int c = tid & 63, tq = tid >> 6, ch = n * 64 + c, rowbase = tile * 64;
        __syncthreads();
        if (tile < TP / 64) {
            const int r0 = rowbase + tq * 8; const bool first = ((r0 & 2047) == 0);
            const float w0 = lcw[ch], w1 = lcw[1024 + ch], w2 = lcw[2048 + ch], w3 = lcw[3072 + ch], bb = lcb[ch];
            const bf16* up = U + (size_t)r0 * NCD + 3584 + ch;
            const long fo = first ? 0 : (long)NCD;
              float x0 = bf2f(up[-3 * fo]), x1 = bf2f(up[-2 * fo]), x2 = bf2f(up[-1 * fo]); if (first) { x0 = 0.f; x1 = 0.f; x2 = 0.f; }
#pragma unroll
            for (int tt = 0; tt < 8; ++tt) { const float x3 = bf2f(up[(size_t)tt * NCD]); xcL[(tq * 8 + tt) * 68 + c] = bb + w0 * x0 + w1 * x1 + w2 * x2 + w3 * x3; x0 = x1; x1 = x2; x2 = x3; }
        } else {
#pragma unroll 2
            for (int tt = 0; tt < 8; ++tt) { const int r = rowbase + tq * 8 + tt; int s, t; row_to_seq(r, s, t); const int row0 = r - t; float acc = lcb[ch];
#pragma unroll
                for (int tap = 0; tap < 4; ++tap) acc += lcw[tap * 1024 + ch] * pre_val(U, NCD, 3584 + ch, row0, t - 3 + tap, s, lstc, 1024, ch);
                xcL[(tq * 8 + tt) * 68 + c] = acc; }
        }
        __syncthreads();
        const int wave = __builtin_amdgcn_readfirstlane(tid >> 6), lane = tid & 63, r = lane & 31, hp = lane >> 5, mat = wave >> 2, mt = (wave >> 1) & 1, nt = wave & 1;
        f32x16 acc;
#pragma unroll
        for (int i = 0; i < 16; ++i) acc[i] = 0.f;
#pragma unroll
        for (int ks = 0; ks < 4; ++ks) { const LAS float* xp = xcL + (32 * mt + r) * 68 + 16 * ks + 8 * hp; const f32x4 xa = *(const LAS f32x4*)xp, xb = *(const LAS f32x4*)(xp + 4);
            const bf16x8 af = __builtin_bit_cast(bf16x8, (u32x4){cvtpk(xa.x, xa.y), cvtpk(xa.z, xa.w), cvtpk(xb.x, xb.y), cvtpk(xb.z, xb.w)});
            acc = MFMA32(af, WF[mat * 512 + (nt * 4 + ks) * 64 + lane], acc); }
        const int chh = n * 64 + 32 * nt + r;
        if (mat == 1) { const float bx = lbx[chh];
#pragma unroll
            for (int i = 0; i < 16; ++i) igL[(32 * mt + crow(i, hp)) * 65 + 32 * nt + r] = sigmoid_(acc[i] + bx); }
        __syncthreads();
        if (mat == 0) { const float ba = lba[chh], spl = softplus_(-lam[chh]);
#pragma unroll
            for (int i = 0; i < 16; ++i) { const int tk = 32 * mt + crow(i, hp); const size_t ro = (size_t)(rowbase + tk) * 1024 + chh;
                const float log_a = -8.f * sigmoid_(acc[i] + ba) * spl;
                LA[ro] = __expf(log_a); LB[ro] = __builtin_amdgcn_sqrtf(1.f - __expf(2.f * log_a)) * (igL[tk * 65 + 32 * nt + r] * xcL[tk * 68 + 32 * nt + r]); } }
    }
}

constexpr size_t SSD_ITEM_BYTES = 33792;
__device__ __forceinline__ void phase_ssd_prep(const KP kp, const int bid, const int G, int j, LAS unsigned char* lds, int tid0) {
    unsigned char* scr = kp.ws() + WS_SCR;
    const bf16* U = (const bf16*)(kp.ws() + WS_U); bf16* XS = (bf16*)(scr + SC_XS);
    const float* cw = kp.in(23) + (size_t)j * 4 * 1536; const float* cb = kp.in(24) + (size_t)j * 1536;
    unsigned char* OPS = scr + SC_SSDOP;
    LAS float* GL = (LAS float*)lds; LAS float* DTL = GL + 256; LAS float* QK = DTL + 256; LAS bf16* Cb = (LAS bf16*)(QK + 64 * 65); LAS bf16* Bb = Cb + 64 * 72; LAS float* XLs = (LAS float*)(Bb + 64 * 72);
    const float* alog = kp.in(25) + j * 16;
    for (int item = bid; item < 512; item += G) {
        int tid = tid0; asm volatile("" : "+v"(tid));
        const int wave = tid >> 6, lane = tid & 63, r = lane & 31, hp = lane >> 5;
        const int b = item >> 7, n = (item >> 2) & 31, g = item & 3;
        const int row0 = b * 2048 + n * 64;
        __syncthreads();
        {
          const int t0 = 8 * wave; const bool first = (n == 0 && wave == 0); const long fo = first ? 0 : (long)NCD;
#pragma unroll
          for (int q = 0; q < 3; ++q) { const int k = 2 * (lane + 64 * q);
              const int cidx = k < 64 ? 1024 + g * 64 + k : (k < 128 ? 1280 + g * 64 + (k - 64) : g * 256 + (k - 128));
              const float w0a = cw[cidx], w0b = cw[cidx + 1], w1a = cw[1536 + cidx], w1b = cw[1536 + cidx + 1], w2a = cw[2 * 1536 + cidx], w2b = cw[2 * 1536 + cidx + 1], w3a = cw[3 * 1536 + cidx], w3b = cw[3 * 1536 + cidx + 1];
              const float ba = cb[cidx], bb = cb[cidx + 1];
              const bf16* up = U + (size_t)(row0 + t0) * NCD + 1024 + cidx;
              unsigned raw[11];
              raw[0] = *(const unsigned*)(up - 3 * fo); raw[1] = *(const unsigned*)(up - 2 * fo); raw[2] = *(const unsigned*)(up - 1 * fo);
#pragma unroll
              for (int t = 0; t < 8; ++t) raw[3 + t] = *(const unsigned*)(up + (size_t)t * NCD);
              if (first) { raw[0] = 0u; raw[1] = 0u; raw[2] = 0u; }
#pragma unroll
              for (int t = 0; t < 8; ++t) {
                  const float ya = silu_(ba + w0a * __uint_as_float(raw[t] << 16) + w1a * __uint_as_float(raw[t + 1] << 16) + w2a * __uint_as_float(raw[t + 2] << 16) + w3a * __uint_as_float(raw[t + 3] << 16));
                  const float yb = silu_(bb + w0b * __uint_as_float(raw[t] & 0xffff0000u) + w1b * __uint_as_float(raw[t + 1] & 0xffff0000u) + w2b * __uint_as_float(raw[t + 2] & 0xffff0000u) + w3b * __uint_as_float(raw[t + 3] & 0xffff0000u));
                  if (q == 0) { if (k < 64) *(LAS unsigned*)(Bb + (t0 + t) * 72 + k) = pk2(ya, yb); else *(LAS unsigned*)(Cb + (t0 + t) * 72 + (k - 64)) = pk2(ya, yb); }
                  else { XLs[(t0 + t) * 257 + (k - 128)] = ya; XLs[(t0 + t) * 257 + (k - 128) + 1] = yb; } } } }
        if (wave < 4) { const int h = g * 4 + wave; const float dt = softplus_(bf2f(U[(size_t)(row0 + lane) * NCD + 4608 + h]) + kp.in(26)[j * 16 + h]);
            DTL[wave * 64 + lane] = dt; float gv = -__expf(alog[h]) * dt;
#pragma unroll
            for (int o = 1; o < 64; o <<= 1) { const float tt = __shfl_up(gv, o); if (lane >= o) gv += tt; }
            GL[wave * 64 + lane] = gv; }
        __syncthreads();
        if (wave < 4) {
            const int mt = wave >> 1, nt = wave & 1;
            f32x16 acc;
#pragma unroll
            for (int i = 0; i < 16; ++i) acc[i] = 0.f;
#pragma unroll
            for (int ks = 0; ks < 4; ++ks) acc = MFMA32(*(const LAS bf16x8*)(Cb + (32 * mt + r) * 72 + 16 * ks + 8 * hp), *(const LAS bf16x8*)(Bb + (32 * nt + r) * 72 + 16 * ks + 8 * hp), acc);
#pragma unroll
            for (int i16 = 0; i16 < 16; ++i16) QK[(32 * mt + crow(i16, hp)) * 65 + 32 * nt + r] = acc[i16];
        } else {
            for (int i = tid - 256; i < 8192; i += 256) { const int t = i >> 7, k2 = i & 127;
                ((unsigned*)XS)[((size_t)(row0 + t) * 1024 + g * 256) / 2 + k2] = pk2(XLs[t * 257 + 2 * k2], XLs[t * 257 + 2 * k2 + 1]); }
        }
        __syncthreads();
        const int f = wave, mt = f >> 2, ks = f & 3;
        for (int hh = 0; hh < 4; ++hh) {
            const int h = g * 4 + hh; const LAS float* Gh = GL + hh * 64; const float Gend = Gh[63];
            bf16x8* base = (bf16x8*)(OPS + ((size_t)((b * 32 + n) * 16 + h)) * SSD_ITEM_BYTES);
            float v[8];
            { const int i = 32 * mt + r; const float eg = __expf(Gh[i]);
#pragma unroll
              for (int jp = 0; jp < 8; ++jp) { const int d = 16 * ks + 8 * (jp >> 2) + 4 * hp + (jp & 3); v[jp] = bf2f(Cb[i * 72 + d]) * eg; }
              base[0 * 512 + f * 64 + lane] = pack8(v); }
            { const int d = 32 * mt + r;
#pragma unroll
              for (int jp = 0; jp < 8; ++jp) { const int tk = 16 * ks + 8 * (jp >> 2) + 4 * hp + (jp & 3); v[jp] = bf2f(Bb[tk * 72 + d]) * __expf(Gend - Gh[tk]); }
              base[1 * 512 + f * 64 + lane] = pack8(v); }
            { const int i = 32 * mt + r; const float gi = Gh[i];
#pragma unroll
              for (int jp = 0; jp < 8; ++jp) { const int jt = 16 * ks + 8 * (jp >> 2) + 4 * hp + (jp & 3); v[jp] = jt <= i ? QK[i * 65 + jt] * __expf(gi - Gh[jt]) : 0.f; }
              base[2 * 512 + f * 64 + lane] = pack8(v); }
            { const int p = 32 * mt + r;
#pragma unroll
              for (int jp = 0; jp < 8; ++jp) { const int tk = 16 * ks + 8 * (jp >> 2) + 4 * hp + (jp & 3);
                  v[jp] = XLs[tk * 257 + hh * 64 + p] * DTL[hh * 64 + tk]; }
              base[3 * 512 + f * 64 + lane] = pack8(v); }
            if (tid == 0) *(float*)(base + 32 * 64) = __expf(Gend);
        }
    }
}

__device__ __forceinline__ void phase_cd_rec(const KP kp, const int bid, const int G, int j, int li, LAS unsigned char* lds, int tid0) {
    unsigned char* scr = kp.ws() + WS_SCR; const bf16* U = (const bf16*)(kp.ws() + WS_U);
    const float* LA = (const float*)(scr + SC_LA); const float* LB = (const float*)(scr + SC_LB);
    float* YS = (float*)(scr + SC_YS); float* HS = (float*)(scr + SC_HS); bf16* XS = (bf16*)(scr + SC_XS);
    SEC_BEGIN(10)
    for (int item = bid; item < 64; item += G) {
        int tid = tid0; asm volatile("" : "+v"(tid));
        const int b = item >> 4, hd = item & 15;
        __syncthreads();
        const int wave = __builtin_amdgcn_readfirstlane(tid >> 6), lane = tid & 63, r = lane & 31, hp = lane >> 5, nt = wave;
        const unsigned char* OPS = scr + SC_SSDOP;
        const bool dmaw = (wave >= 2 && wave < 6);
        constexpr int SLOT = 33 * 1024;
#define SSD_DMA(n_) do { if (dmaw) { const unsigned char* gi_ = OPS + ((size_t)((b * 32 + (n_)) * 16 + hd)) * SSD_ITEM_BYTES + lane * 16; \
            _Pragma("unroll") for (int q_ = 0; q_ < 9; ++q_) { const int lf_ = q_ < 8 ? (wave - 2) * 8 + q_ : 32; \
                __builtin_amdgcn_global_load_lds((const unsigned*)(gi_ + lf_ * 1024), (LAS unsigned*)(lds + ((n_) & 3) * SLOT + lf_ * 1024), 16, 0, 2); } } } while (0)
        f32x16 S0, S1;
#pragma unroll
        for (int i = 0; i < 16; ++i) { S0[i] = 0.f; S1[i] = 0.f; }
        SSD_DMA(0); SSD_DMA(1); SSD_DMA(2);
        if (dmaw) asm volatile("s_waitcnt vmcnt(18)" ::: "memory");
        asm volatile("" ::: "memory"); __builtin_amdgcn_s_barrier(); asm volatile("" ::: "memory");
        for (int n = 0; n < 32; ++n) {
            if (n + 3 < 32) SSD_DMA(n + 3);
            if (wave < 2) {
                const LAS bf16x8* F = (const LAS bf16x8*)(lds + (n & 3) * SLOT) + lane;
                bf16x8 vb[4];
#pragma unroll
                for (int ks = 0; ks < 4; ++ks) vb[ks] = F[(24 + nt * 4 + ks) * 64];
                const float gend = *(const LAS float*)(lds + (n & 3) * SLOT + 32 * 1024);
                const bf16x8 sb00 = PACK_ACC(S0, 0), sb01 = PACK_ACC(S0, 1), sb10 = PACK_ACC(S1, 0), sb11 = PACK_ACC(S1, 1);
                f32x16 O0, O1;
#pragma unroll
                for (int i = 0; i < 16; ++i) { O0[i] = 0.f; O1[i] = 0.f; }
                O0 = MFMA32(F[0 * 64], sb00, O0); O0 = MFMA32(F[1 * 64], sb01, O0); O0 = MFMA32(F[2 * 64], sb10, O0); O0 = MFMA32(F[3 * 64], sb11, O0);
                O1 = MFMA32(F[4 * 64], sb00, O1); O1 = MFMA32(F[5 * 64], sb01, O1); O1 = MFMA32(F[6 * 64], sb10, O1); O1 = MFMA32(F[7 * 64], sb11, O1);
                O0 = MFMA32(F[16 * 64], vb[0], O0); O0 = MFMA32(F[17 * 64], vb[1], O0);
#pragma unroll
                for (int ks = 0; ks < 4; ++ks) O1 = MFMA32(F[(20 + ks) * 64], vb[ks], O1);
#pragma unroll
                for (int i = 0; i < 16; ++i) { S0[i] *= gend; S1[i] *= gend; }
#pragma unroll
                for (int ks = 0; ks < 4; ++ks) { S0 = MFMA32(F[(8 + ks) * 64], vb[ks], S0); S1 = MFMA32(F[(12 + ks) * 64], vb[ks], S1); }
                float* yo = YS + (size_t)(b * 2048 + n * 64) * 1024 + hd * 64 + 32 * nt + r;
#pragma unroll
                for (int i = 0; i < 16; ++i) { yo[(size_t)crow(i, hp) * 1024] = O0[i]; yo[(size_t)(32 + crow(i, hp)) * 1024] = O1[i]; }
            }
            if (dmaw) { if (n + 3 < 32) asm volatile("s_waitcnt vmcnt(18)" ::: "memory"); else if (n + 2 < 32) asm volatile("s_waitcnt vmcnt(9)" ::: "memory"); else asm volatile("s_waitcnt vmcnt(0)" ::: "memory"); }
            asm volatile("s_waitcnt lgkmcnt(0)" ::: "memory"); __builtin_amdgcn_s_barrier(); asm volatile("" ::: "memory");
        }
#undef SSD_DMA
        if (wave < 2) {
            float* dst = kp.out() + O_SSD_P + ((size_t)j * 4 + b) * ((size_t)16 * 64 * 64) + (size_t)hd * 64 * 64 + 32 * nt + r;
#pragma unroll
            for (int i = 0; i < 16; ++i) { dst[(size_t)crow(i, hp) * 64] = S0[i]; dst[(size_t)(32 + crow(i, hp)) * 64] = S1[i]; }
        }
    }
    SEC_END(10, lds)
    SEC_BEGIN(11)
    unsigned* qhead = (unsigned*)(kp.ws() + WS_CTL) + CW_CNT + 64 * li;
    volatile LAS unsigned* qslot = (volatile LAS unsigned*)(lds + LDS_BYTES - 8);
    const float* cw = kp.in(23) + (size_t)j * 4 * 1536; const float* cb = kp.in(24) + (size_t)j * 1536; const float* stc = kp.in(6) + (size_t)j * 128 * 3 * 1536;
    for (;;) {
        __syncthreads();
        if (tid0 == 0) qslot[0] = __hip_atomic_fetch_add(qhead, 1u, __ATOMIC_RELAXED, __HIP_MEMORY_SCOPE_AGENT);
        __syncthreads();
        const int it = (int)qslot[0];
        if (it >= 1024) break;
        int tid = tid0; asm volatile("" : "+v"(tid));
        if (it < 256) {
            const int s = it >> 6, h = it & 63; int row0, L; seq_info(s, row0, L);
            LAS float* Al = (LAS float*)lds; LAS float* Bl = Al + 512;
            const int chunk = tid >> 4, c16 = tid & 15, ch = h * 16 + c16;
            const size_t ro = (size_t)(row0 + chunk * 64) * 1024 + ch;
            float Ap = 1.f, Bp = 0.f;
#pragma unroll 8
            for (int t = 0; t < 64; ++t) { const float a = LA[ro + (size_t)t * 1024], bb = LB[ro + (size_t)t * 1024]; Bp = a * Bp + bb; Ap *= a; }
            Al[tid] = Ap; Bl[tid] = Bp;
            __syncthreads();
            float hh = 0.f;
            for (int m = 0; m < chunk; ++m) hh = Al[m * 16 + c16] * hh + Bl[m * 16 + c16];
#pragma unroll 8
            for (int t = 0; t < 64; ++t) { hh = LA[ro + (size_t)t * 1024] * hh + LB[ro + (size_t)t * 1024]; HS[ro + (size_t)t * 1024] = hh; }
            if (chunk == 31) kp.out()[O_LRU_P + ((size_t)j * 4 + s) * 1024 + ch] = hh;
        } else if (it < 768) {
            const int q_ = it - 256, bs = q_ >> 2, g = q_ & 3, sq = 4 + bs, r0 = TP + bs * 4;
            LAS float* BL = (LAS float*)lds; LAS float* CL = BL + 256; LAS float* XL = CL + 256; LAS float* DTL = XL + 1024; LAS float* QKs = DTL + 16; LAS float* red = QKs + 16;
            const int wave = tid >> 6, lane = tid & 63, hh = tid >> 7, nh = (tid >> 6) & 1, p = tid & 63, hd = 4 * g + hh;
            const size_t SZ = (size_t)16 * 64 * 64;
            const float* st = kp.in(5) + ((size_t)j * 128 + bs) * SZ + (size_t)hd * 4096;
            float S[32];
            { const float* sp = st + (size_t)(nh * 32) * 64 + p;
#pragma unroll
              for (int i = 0; i < 32; ++i) { S[i] = *sp; sp += 64; asm volatile("" : "+v"(sp)); } }
            { const int ci = tid & 127, tk = tid >> 7;
#pragma unroll
              for (int q = 0; q < 3; ++q) { const int k = ci + 128 * q; int cidx; LAS float* dst;
                  if (k < 64) { cidx = 1024 + g * 64 + k; dst = BL + k * 4 + tk; } else if (k < 128) { cidx = 1280 + g * 64 + (k - 64); dst = CL + (k - 64) * 4 + tk; } else { cidx = g * 256 + (k - 128); dst = XL + tk * 256 + (k - 128); }
                  float acc = cb[cidx];
#pragma unroll
                  for (int tap = 0; tap < 4; ++tap) acc += cw[tap * 1536 + cidx] * pre_val(U, NCD, 1024 + cidx, r0, tk - 3 + tap, sq, stc, 1536, cidx);
                  *dst = silu_(acc); } }
            if (tid < 16) { const int tk = tid >> 2, h2 = tid & 3; DTL[tid] = softplus_(bf2f(U[(size_t)(r0 + tk) * NCD + 4608 + 4 * g + h2]) + kp.in(26)[j * 16 + 4 * g + h2]); }
            __syncthreads();
#pragma unroll
            for (int q = 0; q < 2; ++q) { const int idx = wave * 2 + q, i = idx >> 2, jj = idx & 3; const float dot = wave_sum(CL[lane * 4 + i] * BL[lane * 4 + jj]); if (lane == 0) QKs[idx] = dot; }
            { const int tk = tid >> 7, k2 = tid & 127; ((unsigned*)XS)[((size_t)(r0 + tk) * 1024 + g * 256) / 2 + k2] = pk2(XL[tk * 256 + 2 * k2], XL[tk * 256 + 2 * k2 + 1]); }
            const float negA = -__expf(kp.in(25)[j * 16 + hd]);
            float Gc[4], xd[4], w[4];
            Gc[0] = negA * DTL[hh]; Gc[1] = Gc[0] + negA * DTL[4 + hh]; Gc[2] = Gc[1] + negA * DTL[8 + hh]; Gc[3] = Gc[2] + negA * DTL[12 + hh];
#pragma unroll
            for (int jj = 0; jj < 4; ++jj) { xd[jj] = XL[jj * 256 + hh * 64 + p] * DTL[jj * 4 + hh]; w[jj] = __expf(Gc[3] - Gc[jj]) * xd[jj]; }
            const float eg = __expf(Gc[3]);
            float o[4] = {0.f, 0.f, 0.f, 0.f};
            float* dst = kp.out() + O_SSD_S + ((size_t)j * 128 + bs) * SZ + (size_t)hd * 4096 + (size_t)(nh * 32) * 64 + p;
#pragma unroll
            for (int i = 0; i < 32; ++i) { const int n = nh * 32 + i; const float s0 = S[i]; float acc = eg * s0; const f32x4 c4 = *(const LAS f32x4*)(CL + n * 4), b4 = *(const LAS f32x4*)(BL + n * 4);
#pragma unroll
                for (int t = 0; t < 4; ++t) { o[t] += c4[t] * s0; acc += b4[t] * w[t]; }
                *dst = acc; dst += 64; asm volatile("" : "+v"(dst)); }
#pragma unroll
            for (int t = 0; t < 4; ++t) red[((hh * 2 + nh) * 4 + t) * 64 + p] = o[t];
            __syncthreads();
            if (nh == 0) {
#pragma unroll
                for (int t = 0; t < 4; ++t) { float y = __expf(Gc[t]) * (red[((hh * 2) * 4 + t) * 64 + p] + red[((hh * 2 + 1) * 4 + t) * 64 + p]);
#pragma unroll
                    for (int jj = 0; jj <= t; ++jj) y += QKs[t * 4 + jj] * __expf(Gc[t] - Gc[jj]) * xd[jj];
                    YS[(size_t)(r0 + t) * 1024 + hd * 64 + p] = y; } }
        } else {
            const int q_ = it - 768, s = 4 + (q_ >> 1), h = q_ & 1; int row0, L; seq_info(s, row0, L);
            const int ch = h * 512 + tid;
            float hh = s < 4 ? 0.f : kp.in(7)[((size_t)j * 128 + (s - 4)) * 1024 + ch];
#pragma unroll 8
            for (int t = 0; t < L; ++t) { const size_t r = (size_t)(row0 + t); hh = LA[r * 1024 + ch] * hh + LB[r * 1024 + ch]; HS[r * 1024 + ch] = hh; }
            float* dst = s < 4 ? kp.out() + O_LRU_P + ((size_t)j * 4 + s) * 1024 : kp.out() + O_LRU_S + ((size_t)j * 128 + (s - 4)) * 1024;
            dst[ch] = hh;
        }
    }
    SEC_END(11, lds)
}

__device__ __forceinline__ void phase_cd_post(const KP kp, const int bid, const int G, int j, int tid, int wave, int lane) {
    unsigned char* scr = kp.ws() + WS_SCR; const bf16* U = (const bf16*)(kp.ws() + WS_U); bf16* YM = (bf16*)(kp.ws() + WS_YM);
    const float* YS = (const float*)(scr + SC_YS); const float* HS = (const float*)(scr + SC_HS); const bf16* XS = (const bf16*)(scr + SC_XS);
    const float* sn = kp.in(28) + (size_t)j * 1024; const float* Dv = kp.in(27) + (size_t)j * 16;
    typedef float f32x2v __attribute__((ext_vector_type(2)));
    for (int idx = bid * NWAVES + wave; idx < T; idx += G * NWAVES) {
        const int gq_ = idx / 17, rq_ = idx - gq_ * 17, r = rq_ < 16 ? gq_ * 16 + rq_ : TP + gq_;
        int s, t; row_to_seq(r, s, t); int row0, L; seq_info(s, row0, L);
        const bf16* ur = U + (size_t)r * NCD; bf16* yr = YM + (size_t)r * DM;
        f32x4 ysv[4], hsv[4]; u32x2 xxv[4], zzv[4], zlv[4];
#pragma unroll
        for (int gq = 0; gq < 4; ++gq) { const int e = gq * 256 + 4 * lane; ysv[gq] = *(const f32x4*)(YS + (size_t)r * 1024 + e); xxv[gq] = *(const u32x2*)(XS + (size_t)r * 1024 + e); zzv[gq] = *(const u32x2*)(ur + e);
            hsv[gq] = *(const f32x4*)(HS + (size_t)r * 1024 + e); zlv[gq] = *(const u32x2*)(ur + 2560 + e); }
#pragma unroll
        for (int gq = 0; gq < 4; ++gq) { const int e = gq * 256 + 4 * lane; const f32x4 ys = ysv[gq];
            const u32x2 xx = xxv[gq], zz = zzv[gq]; const float Dh = Dv[e >> 6];
            f32x4 y; y.x = (ys.x + Dh * __uint_as_float(xx.x << 16)) * silu_(__uint_as_float(zz.x << 16)); y.y = (ys.y + Dh * __uint_as_float(xx.x & 0xffff0000u)) * silu_(__uint_as_float(zz.x & 0xffff0000u));
            y.z = (ys.z + Dh * __uint_as_float(xx.y << 16)) * silu_(__uint_as_float(zz.y << 16)); y.w = (ys.w + Dh * __uint_as_float(xx.y & 0xffff0000u)) * silu_(__uint_as_float(zz.y & 0xffff0000u));
            const float rstd = rsqrtf(wave_sum((y.x * y.x + y.y * y.y) + (y.z * y.z + y.w * y.w)) * (1.f / 256.f) + 1e-6f);
            const f32x4 g4 = *(const f32x4*)(sn + e);
            u32x2 w; w.x = pk2(y.x * rstd * g4.x, y.y * rstd * g4.y); w.y = pk2(y.z * rstd * g4.z, y.w * rstd * g4.w); *(u32x2*)(yr + e) = w; }
#pragma unroll
        for (int gq = 0; gq < 4; ++gq) { const int ch = gq * 256 + 4 * lane; const f32x4 hs = hsv[gq]; const u32x2 zz = zlv[gq];
            u32x2 w; w.x = pk2(hs.x * silu_(__uint_as_float(zz.x << 16)), hs.y * silu_(__uint_as_float(zz.x & 0xffff0000u))); w.y = pk2(hs.z * silu_(__uint_as_float(zz.y << 16)), hs.w * silu_(__uint_as_float(zz.y & 0xffff0000u)));
            *(u32x2*)(yr + 1024 + ch) = w; }
        if (t >= L - 3) { const int rr = t - (L - 3);
            float* d1 = s < 4 ? kp.out() + O_SSDC_P + (((size_t)j * 4 + s) * 3 + rr) * 1536 : kp.out() + O_SSDC_S + (((size_t)j * 128 + (s - 4)) * 3 + rr) * 1536;
            for (int c = 2 * lane; c < 1536; c += 128) { const unsigned uu = *(const unsigned*)(ur + 1024 + c); *(f32x2v*)(d1 + c) = (f32x2v){__uint_as_float(uu << 16), __uint_as_float(uu & 0xffff0000u)}; }
            float* d2 = s < 4 ? kp.out() + O_LRUC_P + (((size_t)j * 4 + s) * 3 + rr) * 1024 : kp.out() + O_LRUC_S + (((size_t)j * 128 + (s - 4)) * 3 + rr) * 1024;
            for (int c = 2 * lane; c < 1024; c += 128) { const unsigned uu = *(const unsigned*)(ur + 3584 + c); *(f32x2v*)(d2 + c) = (f32x2v){__uint_as_float(uu << 16), __uint_as_float(uu & 0xffff0000u)}; } }
    }
}


typedef float f32x4m __attribute__((ext_vector_type(4)));
template <bool GATE>
__device__ __forceinline__ void sample_gemm_res(LAS unsigned char* lds, const bf16* Amat, const bf16* Bt, const bf16* Hin, bf16* Hout, float* rss_out, const bf16* PP, const float* rss_in, int bid, int tid) {
    if (bid >= 256) return;
    const int wave = tid >> 6, lane = tid & 63, lr = lane & 15, kg = lane >> 4;
    const int m0 = TP + (bid & 7) * 64, n0 = (bid >> 3) * 64;
    const bf16x8* ap = (const bf16x8*)(Amat + (size_t)(m0 + lr) * 2048 + wave * 256 + 8 * kg);
    const bf16x8* bp = (const bf16x8*)(Bt + (size_t)(n0 + lr) * 2048 + wave * 256 + 8 * kg);
    f32x4m acc[4][4];
#pragma unroll
    for (int mi = 0; mi < 4; ++mi)
#pragma unroll
        for (int ni = 0; ni < 4; ++ni) acc[mi][ni] = (f32x4m){0.f, 0.f, 0.f, 0.f};
#pragma unroll 2
    for (int ks = 0; ks < 8; ++ks) { bf16x8 a[4], b[4];
#pragma unroll
        for (int q = 0; q < 4; ++q) { a[q] = ap[(size_t)q * 16 * 256 + ks * 4]; b[q] = bp[(size_t)q * 16 * 256 + ks * 4]; }
#pragma unroll
        for (int mi = 0; mi < 4; ++mi)
#pragma unroll
            for (int ni = 0; ni < 4; ++ni) acc[mi][ni] = __builtin_amdgcn_mfma_f32_16x16x32_bf16(a[mi], b[ni], acc[mi][ni], 0, 0, 0); }
    LAS float* red = (LAS float*)lds;
    __syncthreads();
#pragma unroll
    for (int mi = 0; mi < 4; ++mi)
#pragma unroll
        for (int ni = 0; ni < 4; ++ni)
#pragma unroll
            for (int i = 0; i < 4; ++i) red[(wave * 64 + 16 * mi + kg * 4 + i) * 65 + 16 * ni + lr] = acc[mi][ni][i];
    __syncthreads();
    { const int row = tid >> 3, c8 = (tid & 7) * 8, grow = m0 + row; float v[8];
#pragma unroll
      for (int e = 0; e < 8; ++e) { float sacc = 0.f;
#pragma unroll
          for (int w = 0; w < 8; ++w) sacc += red[(w * 64 + row) * 65 + c8 + e];
          v[e] = sacc; }
      float sc = 1.f; if (GATE) sc = rsqrtf(rss_in[grow] * (1.f / 2048.f) + 1e-6f);
      const size_t p = (size_t)grow * 2048 + n0 + c8;
      const u32x4 hw = *(const u32x4*)(Hin + p); u32x4 pw = (u32x4){0u, 0u, 0u, 0u}; if (GATE) pw = *(const u32x4*)(PP + p);
      const unsigned hws[4] = {hw.x, hw.y, hw.z, hw.w}, pws[4] = {pw.x, pw.y, pw.z, pw.w}; unsigned ow[4]; float sq = 0.f;
#pragma unroll
      for (int e2 = 0; e2 < 4; ++e2) { float h0 = __uint_as_float(hws[e2] << 16), h1 = __uint_as_float(hws[e2] & 0xffff0000u);
          if (GATE) { h0 += __builtin_amdgcn_rcpf(1.f + __expf(-sc * v[2 * e2])) * __uint_as_float(pws[e2] << 16); h1 += __builtin_amdgcn_rcpf(1.f + __expf(-sc * v[2 * e2 + 1])) * __uint_as_float(pws[e2] & 0xffff0000u); }
          else { h0 += v[2 * e2]; h1 += v[2 * e2 + 1]; }
          sq += h0 * h0 + h1 * h1; ow[e2] = cvtpk(h0, h1); }
      *(u32x4*)(Hout + p) = (u32x4){ow[0], ow[1], ow[2], ow[3]};
      sq += __shfl_xor(sq, 1); sq += __shfl_xor(sq, 2); sq += __shfl_xor(sq, 4);
      if ((tid & 7) == 0) atomicAdd(rss_out + grow, sq); }
}

__global__ void __launch_bounds__(NTHR, 2) mega_fwd(Args A) {
    extern __shared__ __attribute__((aligned(16))) unsigned char lds_raw[];
    LAS unsigned char* lds = (LAS unsigned char*)lds_raw;
    const int G = gridDim.x;
    volatile LAS unsigned* bst = (volatile LAS unsigned*)(lds + LDS_BYTES - 16);
    if (threadIdx.x == 0) { bst[0] = 0u; bst[1] = 0u;
#ifdef PROBE_SEC
        *(volatile LAS unsigned long long*)(lds + LDS_BYTES - 32) = 0ull;
#endif
    }
    __syncthreads();
    XcdBarrier xbar = xcd_barrier_post((unsigned*)(A.ws + WS_CTL) + CW_BAR, bst);
#ifdef PROBE_GROUP
    unsigned long long t_prev = __builtin_amdgcn_s_memrealtime(), t_sel = 0;
#endif
    for (int ph = A.ph_lo; ph < A.ph_hi; ++ph) {
        KP kp; kp.p = (const char AS4*)__builtin_amdgcn_kernarg_segment_ptr(); asm volatile("" : "+s"(kp.p));
        unsigned char* ws = kp.ws();
        int tid = threadIdx.x; asm volatile("" : "+v"(tid));
        int bid = blockIdx.x; asm volatile("" : "+s"(bid));
        const int lane = tid & 63, wave = __builtin_amdgcn_readfirstlane(tid >> 6), gw = bid * NWAVES + wave, NGW = G * NWAVES;
        if (ph == 0) { if (PH_MASK & 1) phase_prologue(kp, lds, gw, NGW, wave, lane); }
        else if (ph == N_PHASES - 1) { SEC_BEGIN(32) phase_final(kp, gw, NGW, lane); SEC_END(32, lds) }
        else {
            const int li = (ph - 1) / SUBS, sub = (ph - 1) % SUBS, j = li >> 1; const bool ab = (li & 1) == 0;
            float* RSS = (float*)(ws + WS_RSS);
            if (sub == 0) {
                const int N = ab ? NAB : NCD;
                const bf16* Bt = ab ? (const bf16*)(ws + WS_WABIN) + (size_t)j * NAB * 2048 : (const bf16*)(ws + WS_WCDIN) + (size_t)j * NCD * 2048;
                { pg8::Gemm g{(const bf16*)(ws + WS_XN), Bt, T, N, 2048}; pg8::StaticOrder S; S.init(T, N, G, bid);
                  pg8::EpiU E{(bf16*)(ws + WS_U), N, RSS + (size_t)(2 * li) * T};
                  if (PH_MASK & 2) pg8::gemm_phase<pg8::EpiU, pg8::StaticOrder, true, true>(lds, g, S, E, tid); }
                { int tid2 = tid; asm volatile("" : "+v"(tid2));
                  int pM = T, pG = G, pc = bid, prow = 0;
                  if (G == 256) { if (ab) { if (bid >= 218) { pM = 4864; pG = 38; pc = bid - 218; } else { prow = 4864; pM = T - 4864; pG = 120; pc = bid; } }
                                  else { pG = 122; pc = bid >= 134 ? bid - 134 : 100000; } }
                  pg8::StaticOrder S; S.init(pM, 2048, pG, pc);
                  pg8::Gemm g{(const bf16*)(ws + WS_PB) + ((size_t)li * T + prow) * 256, (const bf16*)(ws + WS_WPROJ) + (size_t)li * 2048 * 256, pM, 2048, 256};
                  pg8::EpiU E{(bf16*)(ws + WS_SCR + SC_PP) + (size_t)prow * 2048, 2048, nullptr};
                  if (PH_MASK & 2) pg8::gemm_phase<pg8::EpiU, pg8::StaticOrder, true, true>(lds, g, S, E, tid2); }
            } else if (sub == 4) {
                const bf16* Bt = ab ? (const bf16*)(ws + WS_WABOUT) + (size_t)j * 2048 * 2048 : (const bf16*)(ws + WS_WCDOUT) + (size_t)j * 2048 * 2048;
                pg8::Gemm g{(const bf16*)(ws + WS_YM), Bt, TP, 2048, 2048}; pg8::StaticOrder S; S.init(TP, 2048, G, bid);
                pg8::EpiRes<false> E{(const bf16*)(ws + WS_XN), (bf16*)(ws + WS_SCR + SC_HB1), RSS + (size_t)(2 * li + 1) * T, nullptr, nullptr};
                if (PH_MASK & 4) pg8::gemm_phase<pg8::EpiRes<false>, pg8::StaticOrder, true, true>(lds, g, S, E, tid);
                { int tid2 = tid; asm volatile("" : "+v"(tid2));
                  sample_gemm_res<false>(lds, (const bf16*)(ws + WS_YM), Bt, (const bf16*)(ws + WS_XN), (bf16*)(ws + WS_SCR + SC_HB1), RSS + (size_t)(2 * li + 1) * T, nullptr, nullptr, bid, tid2); }
            } else if (sub == 5) {
                pg8::Gemm g{(const bf16*)(ws + WS_SCR + SC_HB1), (const bf16*)(ws + WS_WGATE) + (size_t)li * 2048 * 2048, TP, 2048, 2048}; pg8::StaticOrder S; S.init(TP, 2048, G, bid);
                pg8::EpiRes<true> E{(const bf16*)(ws + WS_SCR + SC_HB1), (bf16*)(ws + WS_XN), RSS + (size_t)(2 * li + 2) * T, (const bf16*)(ws + WS_SCR + SC_PP), RSS + (size_t)(2 * li + 1) * T};
                if (PH_MASK & 4) pg8::gemm_phase<pg8::EpiRes<true>, pg8::StaticOrder, true, true>(lds, g, S, E, tid);
                { int tid2 = tid; asm volatile("" : "+v"(tid2));
                  sample_gemm_res<true>(lds, (const bf16*)(ws + WS_SCR + SC_HB1), (const bf16*)(ws + WS_WGATE) + (size_t)li * 2048 * 2048, (const bf16*)(ws + WS_SCR + SC_HB1), (bf16*)(ws + WS_XN), RSS + (size_t)(2 * li + 2) * T,
                                        (const bf16*)(ws + WS_SCR + SC_PP), RSS + (size_t)(2 * li + 1) * T, bid, tid2); }
            } else if (sub == 1) {
                if (ab) { SEC_BEGIN(3) if (PH_MASK & 4096) phase_gla_prep(kp, bid, G, j, lds, tid); SEC_END(3, lds) SEC_BEGIN(4) if (PH_MASK & 8192) phase_dn_prep(kp, bid, G, j, lds, tid); SEC_END(4, lds) }
                else { if (PH_MASK & 2048) { SEC_BEGIN(8) phase_ssd_prep(kp, bid, G, j, lds, tid); SEC_END(8, lds) SEC_BEGIN(9) phase_lru_gates(kp, bid, G, j, lds, tid); SEC_END(9, lds) } }
            }
            else if (sub == 2) { if (ab) { if (PH_MASK & 32) phase_ab_rec(kp, bid, G, j, li, lds, tid); } else { if (PH_MASK & 64) phase_cd_rec(kp, bid, G, j, li, lds, tid); } }
            else { if (ab) { SEC_BEGIN(30) if (PH_MASK & 128) phase_ab_post(kp, bid, G, j, tid, wave, lane); SEC_END(30, lds) } else { SEC_BEGIN(31) if (PH_MASK & 256) phase_cd_post(kp, bid, G, j, tid, wave, lane); SEC_END(31, lds) } }
        }
        if (ph + 1 < A.ph_hi) { if (ph == A.ph_lo) cg::this_grid().sync(); else xcd_barrier(xbar); }
#ifdef PROBE_GROUP
        { const unsigned long long t_now = __builtin_amdgcn_s_memrealtime(); const int li_ = (ph - 1) / SUBS, sub_ = (ph - 1) % SUBS; const bool ab_ = (li_ & 1) == 0;
          int grp = 9; if (ph == N_PHASES - 1) grp = 8; else if (ph > 0) { if (sub_ == 0 || sub_ == 4 || sub_ == 5) grp = 1; else if (sub_ == 1) grp = ab_ ? 4 : 5; else if (sub_ == 2) grp = ab_ ? 6 : 7; else grp = 8; }
          if (grp == PROBE_GROUP) t_sel += t_now - t_prev; t_prev = t_now; }
#endif
    }
#ifdef PROBE_SEC
    if (blockIdx.x == PROBE_BLK && threadIdx.x == 0) { const unsigned long long t_s = *(volatile LAS unsigned long long*)(lds + LDS_BYTES - 32); const unsigned long long t0 = __builtin_amdgcn_s_memrealtime(); while (__builtin_amdgcn_s_memrealtime() - t0 < 3 * t_s) __builtin_amdgcn_s_sleep(8); }
#endif
#ifdef PROBE_GROUP
    if (blockIdx.x == 0 && threadIdx.x == 0) { const unsigned long long t0 = __builtin_amdgcn_s_memrealtime(); while (__builtin_amdgcn_s_memrealtime() - t0 < 3 * t_sel) __builtin_amdgcn_s_sleep(8); }
#endif
}

extern "C" void kernel_launch(void* const* d_in, const int* in_sizes, int n_in, void* d_out, int out_size, void* d_ws, size_t ws_size, hipStream_t stream) {
    static int grid = 0;
    if (grid == 0) {
        if (n_in != 40 || (size_t)out_size != O_END || ws_size < WS_END) { fprintf(stderr, "kernel_launch: unexpected shapes: n_in %d out %d ws %zu\n", n_in, out_size, ws_size); grid = -1; return; }
        int dev = 0, cus = 0, per_cu = 0;
        if (hipGetDevice(&dev) != hipSuccess || hipDeviceGetAttribute(&cus, hipDeviceAttributeMultiprocessorCount, dev) != hipSuccess) { grid = -1; return; }
        if (hipFuncSetAttribute((const void*)mega_fwd, hipFuncAttributeMaxDynamicSharedMemorySize, LDS_BYTES) != hipSuccess) { fprintf(stderr, "kernel_launch: hipFuncSetAttribute failed\n"); grid = -1; return; }
        if (hipOccupancyMaxActiveBlocksPerMultiprocessor(&per_cu, (const void*)mega_fwd, NTHR, LDS_BYTES) != hipSuccess || per_cu < 1) { fprintf(stderr, "kernel_launch: occupancy query says %d\n", per_cu); per_cu = 1; }
        (void)hipGetLastError();
        grid = cus;
    }
    if (grid < 0) return;
    if (hipMemsetAsync((char*)d_ws + WS_CTL, 0, CTL_ZERO_BYTES, stream) != hipSuccess) { fprintf(stderr, "kernel_launch: memset of the control words failed\n"); return; }
    Args a{};
    for (int i = 0; i < 40; ++i) a.in[i] = (const float*)d_in[i];
    a.out = (float*)d_out; a.ws = (unsigned char*)d_ws;
#if MK_N_LAUNCHES == 1
    a.ph_lo = 0; a.ph_hi = N_PHASES;
    void* args[] = {&a};
    hipError_t e = hipLaunchCooperativeKernel((const void*)mega_fwd, dim3(grid), dim3(NTHR), args, LDS_BYTES, stream);
    if (e != hipSuccess) fprintf(stderr, "cooperative launch failed: %s (grid %d)\n", hipGetErrorString(e), grid);
#else
    for (int ph = 0; ph < N_PHASES; ++ph) { a.ph_lo = ph; a.ph_hi = ph + 1; mega_fwd<<<dim3(grid), dim3(NTHR), LDS_BYTES, stream>>>(a); }
#endif
}
```

```cpp
#include <hip/hip_runtime.h>
#include <hip/hip_cooperative_groups.h>
#include <cstdio>
#include <cstdint>
namespace cg = cooperative_groups;

#ifndef MK_N_LAUNCHES
#define MK_N_LAUNCHES 1
#endif

namespace pg8 {
#define PG8_LAS __attribute__((address_space(3)))
typedef unsigned short bf16_t;
typedef short bf16x8 __attribute__((ext_vector_type(8)));
typedef float f32x4 __attribute__((ext_vector_type(4)));
typedef unsigned u32x4 __attribute__((ext_vector_type(4)));
constexpr int BM = 256, BK = 64, HALF = 128, HTB = HALF * BK * 2  , STAGE_BYTES = 8 * HTB, NXCD = 8, WGM = 8;

__host__ __device__ __forceinline__ int lds_byte(int r, int c) { const int st = (r >> 4) * 2 + (c >> 5), rr = r & 15, cc = c & 31, ob = rr * 64 + cc * 2; return st * 1024 + (ob ^ (((ob >> 9) & 1) << 5)); }
__host__ __device__ __forceinline__ void stage_rc(int b, int& R, int& C) { const int st = b / 1024, sb = b % 1024, swz = sb ^ (((sb >> 9) & 1) << 5); R = (st >> 1) * 16 + swz / 64; C = (st & 1) * 32 + (swz % 64) / 2; }
__host__ __device__ __forceinline__ int perm32(int rho) { const int n = rho >> 4, i = rho & 15; return 8 * (i >> 2) + 4 * n + (i & 3); }

struct Unit { int pm, pn; };
struct Gemm { const bf16_t* A; const bf16_t* Bt; int M, N, K; };

struct StaticOrder {
    int nM, nN, nwg, G, c;
    __host__ __device__ void init(int M, int N, int G_, int c_) { nM = M / BM; nN = N / BM; nwg = nM * nN; G = G_; c = c_; }
    __host__ __device__ bool next(int i, Unit& u) const {
        const long L = (long)i * G + c; if (L >= nwg) return false;
        int wgid = (int)L; { const int q = nwg / NXCD, r = nwg % NXCD, xcd = wgid % NXCD, off = wgid / NXCD; wgid = (xcd < r ? xcd * (q + 1) : r * (q + 1) + (xcd - r) * q) + off; }
        const int nig = WGM * nN, gid = wgid / nig, fm = gid * WGM, gsz = (nM - fm) < WGM ? (nM - fm) : WGM;
        u.pm = fm + ((wgid % nig) % gsz); u.pn = (wgid % nig) / gsz; return true;
    }
    __device__ __forceinline__ void a_ready(const Unit&) const {}
    __device__ __forceinline__ void done(const Unit&) const {}
};

__device__ __forceinline__ unsigned cvt_pk_bf16(float lo, float hi) { unsigned r; asm volatile("v_cvt_pk_bf16_f32 %0, %1, %2" : "=v"(r) : "v"(lo), "v"(hi)); return r; }
struct EpiF32 {
    static constexpr bool PERM = false, AFTER_DRAIN = false;
    float* C; int ldc;
    __device__ __forceinline__ void operator()(const f32x4 (&acc)[2][2][4][2], const Unit& u, int wr, int wc, int fr, int fq) const {
        const int row0 = u.pm * BM + wr * 64 + fr, col0 = u.pn * BM + wc * 32 + 4 * fq;
#pragma unroll
        for (int ai = 0; ai < 2; ++ai)
#pragma unroll
            for (int m = 0; m < 4; ++m) { float* rowp = C + (size_t)(row0 + ai * HALF + m * 16) * ldc + col0;
#pragma unroll
                for (int bj = 0; bj < 2; ++bj)
#pragma unroll
                    for (int n = 0; n < 2; ++n) *(f32x4*)(rowp + bj * HALF + n * 16) = acc[ai][bj][m][n]; }
    }
};
struct EpiBf16 {
    static constexpr bool PERM = true, AFTER_DRAIN = false;
    bf16_t* O; int ldc;
    __device__ __forceinline__ void operator()(const f32x4 (&acc)[2][2][4][2], const Unit& u, int wr, int wc, int fr, int fq) const {
        const int row0 = u.pm * BM + wr * 64 + fr; const int col0 = u.pn * BM + wc * 32 + 8 * fq;
#pragma unroll
        for (int ai = 0; ai < 2; ++ai)
#pragma unroll
            for (int m = 0; m < 4; ++m) { bf16_t* rowp = O + (size_t)(row0 + ai * HALF + m * 16) * ldc + col0;
#pragma unroll
                for (int bj = 0; bj < 2; ++bj) { const f32x4 v0 = acc[ai][bj][m][0], v1 = acc[ai][bj][m][1];
                    u32x4 w; w.x = cvt_pk_bf16(v0[0], v0[1]); w.y = cvt_pk_bf16(v0[2], v0[3]); w.z = cvt_pk_bf16(v1[0], v1[1]); w.w = cvt_pk_bf16(v1[2], v1[3]);
                    *(u32x4*)(rowp + bj * HALF) = w; } }
    }
};

struct RangeOrder {
    int start, count;
    __host__ __device__ bool next(int i, Unit& u) const { if (i >= count) return false; const int t = start + i; u.pm = t >> 3; u.pn = t & 7; return true; }
    __device__ __forceinline__ void a_ready(const Unit&) const {}
    __device__ __forceinline__ void done(const Unit&) const {}
};
struct EpiU {
    static constexpr bool PERM = true, AFTER_DRAIN = false;
    bf16_t* O; int ldc; const float* rss;
    __device__ __forceinline__ void operator()(const f32x4 (&acc)[2][2][4][2], const Unit& u, int wr, int wc, int fr, int fq) const {
        const int row0 = u.pm * BM + wr * 64 + fr; const int col0 = u.pn * BM + wc * 32 + 8 * fq;
#pragma unroll
        for (int ai = 0; ai < 2; ++ai)
#pragma unroll
            for (int m = 0; m < 4; ++m) { const int row = row0 + ai * HALF + m * 16; const float sc = rss ? rsqrtf(rss[row] * (1.f / 2048.f) + 1e-6f) : 1.f;
                bf16_t* rowp = O + (size_t)row * ldc + col0;
#pragma unroll
                for (int bj = 0; bj < 2; ++bj) { const f32x4 v0 = acc[ai][bj][m][0] * sc, v1 = acc[ai][bj][m][1] * sc;
                    u32x4 w; w.x = cvt_pk_bf16(v0[0], v0[1]); w.y = cvt_pk_bf16(v0[2], v0[3]); w.z = cvt_pk_bf16(v1[0], v1[1]); w.w = cvt_pk_bf16(v1[2], v1[3]);
                    *(u32x4*)(rowp + bj * HALF) = w; } }
    }
};
typedef unsigned u32x2e __attribute__((ext_vector_type(2)));
template <bool GATE> struct EpiRes {
    static constexpr bool PERM = false, AFTER_DRAIN = false;
    const bf16_t* Hin; bf16_t* Hout; float* rss_out; const bf16_t* PP; const float* rss_in;
    __device__ __forceinline__ void operator()(const f32x4 (&acc)[2][2][4][2], const Unit& u, int wr, int wc, int fr, int fq) const {
        const int row0 = u.pm * BM + wr * 64 + fr, col0 = u.pn * BM + wc * 32 + 4 * fq;
#pragma unroll
        for (int ai = 0; ai < 2; ++ai)
#pragma unroll
            for (int m = 0; m < 4; ++m) { const int row = row0 + ai * HALF + m * 16; const size_t ro = (size_t)row * 2048 + col0;
                float sc = 1.f; if (GATE) sc = rsqrtf(rss_in[row] * (1.f / 2048.f) + 1e-6f);
                float s = 0.f;
#pragma unroll
                for (int bj = 0; bj < 2; ++bj)
#pragma unroll
                    for (int n = 0; n < 2; ++n) { const size_t p = ro + bj * HALF + n * 16; const u32x2e hw = *(const u32x2e*)(Hin + p); const f32x4 a = acc[ai][bj][m][n];
                        f32x4 h; h[0] = __uint_as_float(hw.x << 16); h[1] = __uint_as_float(hw.x & 0xffff0000u); h[2] = __uint_as_float(hw.y << 16); h[3] = __uint_as_float(hw.y & 0xffff0000u);
                        if (GATE) { const u32x2e pw = *(const u32x2e*)(PP + p);
                            h[0] += __builtin_amdgcn_rcpf(1.f + __expf(-sc * a[0])) * __uint_as_float(pw.x << 16); h[1] += __builtin_amdgcn_rcpf(1.f + __expf(-sc * a[1])) * __uint_as_float(pw.x & 0xffff0000u);
                            h[2] += __builtin_amdgcn_rcpf(1.f + __expf(-sc * a[2])) * __uint_as_float(pw.y << 16); h[3] += __builtin_amdgcn_rcpf(1.f + __expf(-sc * a[3])) * __uint_as_float(pw.y & 0xffff0000u); }
                        else h = h + a;
                        s += (h[0] * h[0] + h[1] * h[1]) + (h[2] * h[2] + h[3] * h[3]);
                        u32x2e o; o.x = cvt_pk_bf16(h[0], h[1]); o.y = cvt_pk_bf16(h[2], h[3]); *(u32x2e*)(Hout + p) = o; }
                s += __shfl_xor(s, 16); s += __shfl_xor(s, 32);
                if (fq == 0) atomicAdd(rss_out + row, s);
                asm volatile("" ::: "memory"); }
    }
};
template <class Epi, class Sched, bool ALIGN_EPI = false, bool SP2 = false>
__device__ __forceinline__ void gemm_phase(PG8_LAS unsigned char* lds, const Gemm g, const Sched& S, const Epi& E, const int tid) {
    const int wid = __builtin_amdgcn_readfirstlane(tid >> 6), lane = tid & 63, wr = wid >> 2, wc = wid & 3, fr = lane & 15, fq = lane >> 4;
    const int K = g.K, nt = K / BK;
    unsigned voffA[2], voffB[2];
#pragma unroll
    for (int i = 0; i < 2; ++i) { int R, C; stage_rc(tid * 16 + i * 8192, R, C); const int Rb = Epi::PERM ? ((R & ~31) + perm32(R & 31)) : R;
        voffA[i] = (unsigned)(R * K + C) * 2u; voffB[i] = (unsigned)(Rb * K + C) * 2u; }
    const size_t kstep = (size_t)(BK * 2);
    const size_t hstep = (size_t)HALF * K * 2;
    const size_t tstep = 2 * hstep;
    const unsigned ldsw = (unsigned)wid * 1024u;
    const int aoff = lds_byte(wr * 64 + fr, fq * 8), boff = lds_byte(wc * 32 + fr, fq * 8);
#define PG8_SA(b, h) (((b) * 2 + (h)) * HTB)
#define PG8_SB(b, h) ((4 + (b) * 2 + (h)) * HTB)
#define PG8_STAGE(bufoff, gbase, voff) do { _Pragma("unroll") for (int _i = 0; _i < 2; ++_i) \
        __builtin_amdgcn_global_load_lds((const unsigned*)((const char*)(gbase) + (voff)[_i]), (PG8_LAS unsigned*)(lds + (bufoff) + ldsw + _i * 8192), 16, 0, 0); } while (0)
#define PG8_LDA(dst, b, h) do { _Pragma("unroll") for (int m = 0; m < 4; ++m) _Pragma("unroll") for (int k = 0; k < 2; ++k) dst[m][k] = *(const PG8_LAS bf16x8*)(lds + PG8_SA(b, h) + aoff + m * 2048 + k * 1024); } while (0)
#define PG8_LDB(dst, b, h) do { _Pragma("unroll") for (int n = 0; n < 2; ++n) _Pragma("unroll") for (int k = 0; k < 2; ++k) dst[n][k] = *(const PG8_LAS bf16x8*)(lds + PG8_SB(b, h) + boff + n * 2048 + k * 1024); } while (0)
#define PG8_MMA(ai, bj, At, Bt) do { __builtin_amdgcn_s_setprio(1); _Pragma("unroll") for (int m = 0; m < 4; ++m) _Pragma("unroll") for (int n = 0; n < 2; ++n) _Pragma("unroll") for (int k = 0; k < 2; ++k) \
        acc[ai][bj][m][n] = __builtin_amdgcn_mfma_f32_16x16x32_bf16(Bt[n][k], At[m][k], acc[ai][bj][m][n], 0, 0, 0); __builtin_amdgcn_s_setprio(0); } while (0)
#define PG8_WAIT_V(n) asm volatile("s_waitcnt vmcnt(" #n ")" ::: "memory")
#define PG8_WAIT_L(n) asm volatile("s_waitcnt lgkmcnt(" #n ")" ::: "memory")
#define PG8_BAR __builtin_amdgcn_s_barrier()
#define PG8_SCHED __builtin_amdgcn_sched_barrier(0)
    Unit cur, nxt; int ui = 0;
    if (!S.next(0, cur)) return;
    f32x4 acc[2][2][4][2];
#pragma unroll
    for (int a = 0; a < 2; ++a)
#pragma unroll
        for (int b = 0; b < 2; ++b)
#pragma unroll
            for (int m = 0; m < 4; ++m)
#pragma unroll
                for (int n = 0; n < 2; ++n) acc[a][b][m][n] = (f32x4){0.f, 0.f, 0.f, 0.f};
    bf16x8 At[4][2], B0[2][2], B1[2][2];
    const char* cA = (const char*)g.A + (size_t)cur.pm * tstep; const char* cB = (const char*)g.Bt + (size_t)cur.pn * tstep;
    S.a_ready(cur);
    if constexpr (SP2) {
        PG8_STAGE(PG8_SB(0, 0), cB, voffB); PG8_STAGE(PG8_SB(0, 1), cB + hstep, voffB); PG8_STAGE(PG8_SA(0, 0), cA, voffA); PG8_STAGE(PG8_SA(0, 1), cA + hstep, voffA);
        if (wr == 1) PG8_BAR;
        PG8_WAIT_V(2); PG8_BAR;
        PG8_STAGE(PG8_SB(1, 0), cB + kstep, voffB); PG8_STAGE(PG8_SA(1, 0), cA + kstep, voffA); PG8_STAGE(PG8_SB(1, 1), cB + hstep + kstep, voffB);
        PG8_WAIT_V(6); PG8_BAR;
    } else {
        PG8_STAGE(PG8_SB(0, 0), cB, voffB); PG8_STAGE(PG8_SA(0, 0), cA, voffA); PG8_STAGE(PG8_SB(0, 1), cB + hstep, voffB); PG8_STAGE(PG8_SA(0, 1), cA + hstep, voffA);
        if (wr == 1) PG8_BAR;
        PG8_WAIT_V(4); PG8_BAR;
        PG8_STAGE(PG8_SB(1, 0), cB + kstep, voffB); PG8_STAGE(PG8_SA(1, 0), cA + kstep, voffA); PG8_STAGE(PG8_SB(1, 1), cB + hstep + kstep, voffB);
        PG8_WAIT_V(6); PG8_BAR;
    }
    for (;;) {
        const bool has_next = S.next(ui + 1, nxt);
        const char* nA = has_next ? (const char*)g.A + (size_t)nxt.pm * tstep : cA; const char* nB = has_next ? (const char*)g.Bt + (size_t)nxt.pn * tstep : cB;
        for (int t = 0; t < nt; t += 2) {
            const bool last = (t == nt - 2);
            const char* a1 = cA + (size_t)(t + 1) * kstep;
            const char* a2 = last ? nA : cA + (size_t)(t + 2) * kstep; const char* b2 = last ? nB : cB + (size_t)(t + 2) * kstep;
            const char* a3 = a2 + kstep; const char* b3 = b2 + kstep;
            if (last && has_next) S.a_ready(nxt);
            if constexpr (SP2) {
            PG8_LDB(B0, 0, 0); PG8_LDB(B1, 0, 1); PG8_SCHED; PG8_LDA(At, 0, 0); PG8_STAGE(PG8_SA(1, 1), a1 + hstep, voffA);
            PG8_WAIT_V(8); PG8_WAIT_L(0); PG8_BAR; PG8_MMA(0, 0, At, B0); PG8_MMA(0, 1, At, B1); PG8_BAR; PG8_SCHED;
            PG8_LDA(At, 0, 1); PG8_STAGE(PG8_SB(0, 0), b2, voffB); PG8_STAGE(PG8_SB(0, 1), b2 + hstep, voffB); PG8_STAGE(PG8_SA(0, 0), a2, voffA);
            PG8_WAIT_V(8); PG8_WAIT_L(0); PG8_BAR; PG8_MMA(1, 0, At, B0); PG8_MMA(1, 1, At, B1); PG8_BAR; PG8_SCHED;
            PG8_LDB(B0, 1, 0); PG8_LDB(B1, 1, 1); PG8_SCHED; PG8_LDA(At, 1, 0); PG8_STAGE(PG8_SA(0, 1), a2 + hstep, voffA);
            PG8_WAIT_V(8); PG8_WAIT_L(0); PG8_BAR; PG8_MMA(0, 0, At, B0); PG8_MMA(0, 1, At, B1); PG8_BAR; PG8_SCHED;
            PG8_LDA(At, 1, 1); PG8_STAGE(PG8_SB(1, 0), b3, voffB); PG8_STAGE(PG8_SB(1, 1), b3 + hstep, voffB); PG8_STAGE(PG8_SA(1, 0), a3, voffA);
            PG8_WAIT_V(8); PG8_WAIT_L(0); PG8_BAR; PG8_MMA(1, 0, At, B0); PG8_MMA(1, 1, At, B1); PG8_BAR; PG8_SCHED;
            } else {
            PG8_LDB(B0, 0, 0); PG8_SCHED; PG8_LDA(At, 0, 0); PG8_STAGE(PG8_SA(1, 1), a1 + hstep, voffA);
            PG8_WAIT_L(8); PG8_BAR; PG8_WAIT_L(0); PG8_MMA(0, 0, At, B0); PG8_BAR; PG8_SCHED;
            PG8_LDB(B1, 0, 1); PG8_STAGE(PG8_SB(0, 0), b2, voffB);
            PG8_BAR; PG8_WAIT_L(0); PG8_MMA(0, 1, At, B1); PG8_BAR;
            PG8_LDA(At, 0, 1); PG8_STAGE(PG8_SA(0, 0), a2, voffA);
            PG8_BAR; PG8_WAIT_L(0); PG8_MMA(1, 0, At, B0); PG8_BAR; PG8_SCHED;
            PG8_STAGE(PG8_SB(0, 1), b2 + hstep, voffB);
            PG8_WAIT_V(6); PG8_BAR; PG8_MMA(1, 1, At, B1); PG8_BAR;
            PG8_LDB(B0, 1, 0); PG8_SCHED; PG8_LDA(At, 1, 0); PG8_STAGE(PG8_SA(0, 1), a2 + hstep, voffA);
            PG8_WAIT_L(8); PG8_BAR; PG8_WAIT_L(0); PG8_MMA(0, 0, At, B0); PG8_BAR; PG8_SCHED;
            PG8_LDB(B1, 1, 1); PG8_STAGE(PG8_SB(1, 0), b3, voffB);
            PG8_BAR; PG8_WAIT_L(0); PG8_MMA(0, 1, At, B1); PG8_BAR;
            PG8_LDA(At, 1, 1); PG8_STAGE(PG8_SA(1, 0), a3, voffA);
            PG8_BAR; PG8_WAIT_L(0); PG8_MMA(1, 0, At, B0); PG8_BAR; PG8_SCHED;
            PG8_STAGE(PG8_SB(1, 1), b3 + hstep, voffB);
            PG8_WAIT_V(6); PG8_BAR; PG8_MMA(1, 1, At, B1); PG8_BAR;
            }
        }
        if constexpr (ALIGN_EPI) { if (wr == 0) PG8_BAR; }
        if constexpr (!Epi::AFTER_DRAIN) { E(acc, cur, wr, wc, fr, fq); S.done(cur); }
        if (!has_next) break;
#pragma unroll
        for (int a = 0; a < 2; ++a)
#pragma unroll
            for (int b = 0; b < 2; ++b)
#pragma unroll
                for (int m = 0; m < 4; ++m)
#pragma unroll
                    for (int n = 0; n < 2; ++n) acc[a][b][m][n] = (f32x4){0.f, 0.f, 0.f, 0.f};
        cur = nxt; cA = nA; cB = nB; ++ui;
        if constexpr (ALIGN_EPI) { if (wr == 1) PG8_BAR; }
    }
    PG8_WAIT_V(0);
    if constexpr (!ALIGN_EPI) { if (wr == 0) PG8_BAR; }
    PG8_BAR;
    if constexpr (Epi::AFTER_DRAIN) { E.fused(acc, cur, wr, wc, fr, fq, lds, wid, lane); S.done(cur); }
#undef PG8_SA
#undef PG8_SB
#undef PG8_STAGE
#undef PG8_LDA
#undef PG8_LDB
#undef PG8_MMA
#undef PG8_WAIT_V
#undef PG8_WAIT_L
#undef PG8_BAR
#undef PG8_SCHED
}
}

constexpr int TP = 8192, TS = 512, T = TP + TS, DM = 2048, NSEQ = 132;
constexpr int NAB = 7424, NCD = 4864;
constexpr int NWAVES = 8, NTHR = 512;
constexpr size_t MiB = 1u << 20;
constexpr size_t WS_CTL = 0, CTL_ZERO_BYTES = 1 * MiB;
constexpr int CW_BAR = 4096, CW_CNT = 8192;
constexpr size_t WS_RSS = 65536;
constexpr size_t WS_WABIN = 2 * MiB, WS_WABOUT = 60 * MiB, WS_WCDIN = 76 * MiB, WS_WCDOUT = 114 * MiB, WS_WGATE = 130 * MiB, WS_WPROJ = 162 * MiB;
constexpr size_t WS_H = 166 * MiB, WS_XN = 234 * MiB, WS_YM = 268 * MiB, WS_PB = 302 * MiB, WS_U = 320 * MiB, WS_SCR = 444 * MiB, WS_END = 732 * MiB;
constexpr size_t SC_HB1 = 102 * MiB;
constexpr size_t SC_PP = 8 * MiB;
constexpr size_t SC_ODN = 102 * MiB, SC_OGLA = 136 * MiB, SC_DNOPS = 192 * MiB;
constexpr size_t SC_LA = 52 * MiB, SC_LB = 86 * MiB, SC_YS = 120 * MiB, SC_HS = 154 * MiB, SC_SSDOP = 192 * MiB, SC_XS = 270 * MiB;
constexpr int LDS_BYTES = 163840;
constexpr size_t O_Y_P = 0, O_Y_S = O_Y_P + (size_t)4 * 2048 * 2048, O_DN_P = O_Y_S + (size_t)128 * 4 * 2048,
    O_DNC_P = O_DN_P + (size_t)2 * 4 * 8 * 128 * 128, O_GLA_P = O_DNC_P + (size_t)2 * 4 * 3 * 3072, O_SSD_P = O_GLA_P + (size_t)2 * 4 * 4 * 128 * 256,
    O_SSDC_P = O_SSD_P + (size_t)2 * 4 * 16 * 64 * 64, O_LRU_P = O_SSDC_P + (size_t)2 * 4 * 3 * 1536, O_LRUC_P = O_LRU_P + (size_t)2 * 4 * 1024,
    O_DN_S = O_LRUC_P + (size_t)2 * 4 * 3 * 1024, O_DNC_S = O_DN_S + (size_t)2 * 128 * 8 * 128 * 128, O_GLA_S = O_DNC_S + (size_t)2 * 128 * 3 * 3072,
    O_SSD_S = O_GLA_S + (size_t)2 * 128 * 4 * 128 * 256, O_SSDC_S = O_SSD_S + (size_t)2 * 128 * 16 * 64 * 64, O_LRU_S = O_SSDC_S + (size_t)2 * 128 * 3 * 1536,
    O_LRUC_S = O_LRU_S + (size_t)2 * 128 * 1024, O_END = O_LRUC_S + (size_t)2 * 128 * 3 * 1024;
static_assert(O_END == 109064192, "output size");

#define LAS __attribute__((address_space(3)))
typedef unsigned short bf16;
typedef float f32x4 __attribute__((ext_vector_type(4)));
typedef unsigned u32x2 __attribute__((ext_vector_type(2)));
typedef unsigned u32x4 __attribute__((ext_vector_type(4)));
#define LDS_WAIT() asm volatile("s_waitcnt lgkmcnt(0)" ::: "memory")

__device__ __forceinline__ float bf2f(bf16 b) { return __uint_as_float(((unsigned)b) << 16); }
typedef __bf16 bf16x2_t __attribute__((ext_vector_type(2)));
typedef float f32x2_t __attribute__((ext_vector_type(2)));
__device__ __forceinline__ unsigned cvtpk(float lo, float hi) { f32x2_t v = {lo, hi}; bf16x2_t b = __builtin_convertvector(v, bf16x2_t); return __builtin_bit_cast(unsigned, b); }
__device__ __forceinline__ unsigned f2bf(float f) { return cvtpk(f, 0.f) & 0xffffu; }
__device__ __forceinline__ unsigned pk2(float lo, float hi) { return cvtpk(lo, hi); }
__device__ __forceinline__ float sigmoid_(float x) { return __builtin_amdgcn_rcpf(1.f + __expf(-x)); }
__device__ __forceinline__ float silu_(float x) { return x * __builtin_amdgcn_rcpf(1.f + __expf(-x)); }
__device__ __forceinline__ float softplus_(float x) { return x > 15.f ? x : (x < -15.f ? __expf(x) : __logf(1.f + __expf(x))); }
__device__ __forceinline__ float dpp_add(float v, float x) { return v + x; }
#define WS_DPP(v, ctrl, rmask) __builtin_bit_cast(float, __builtin_amdgcn_update_dpp(0, __builtin_bit_cast(int, (v)), (ctrl), (rmask), 0xf, false))
__device__ __forceinline__ float wave_sum(float v) {
    v += WS_DPP(v, 0xB1, 0xf);
    v += WS_DPP(v, 0x4E, 0xf);
    v += WS_DPP(v, 0x141, 0xf);
    v += WS_DPP(v, 0x140, 0xf);
    v += WS_DPP(v, 0x142, 0xa);
    v += WS_DPP(v, 0x143, 0xc);
    return __builtin_bit_cast(float, __builtin_amdgcn_readlane(__builtin_bit_cast(int, v), 63));
}
__device__ __forceinline__ void row_to_seq(int r, int& s, int& t) { if (r < TP) { s = r >> 11; t = r & 2047; } else { s = 4 + ((r - TP) >> 2); t = (r - TP) & 3; } }
__device__ __forceinline__ void seq_info(int s, int& row0, int& L) { if (s < 4) { row0 = s << 11; L = 2048; } else { row0 = TP + ((s - 4) << 2); L = 4; } }
__device__ __forceinline__ float pre_val(const bf16* U, int ldu, int ucol, int row0, int tt, int s, const float* stc, int W, int c) {
    const int tc = tt >= 0 ? tt : 0, sc = tt >= 0 ? 0 : 3 + tt;
    const float a = bf2f(U[(size_t)(row0 + tc) * ldu + ucol]), b = stc[((size_t)(s - 4) * 3 + sc) * W + c];
    return tt >= 0 ? a : b;
}
__device__ __forceinline__ int map_col(int mapid, int n) {
    if (mapid == 0) return n;
    if (mapid == 1) { if (n < 3072) return n; if (n < 6144) return n + 16; if (n < 7168) return n + 32; if (n < 7184) return n - 4096; if (n < 7200) return n - 1024; return -1; }
    if (n < 2560) return n; if (n < 4608) return n + 16; if (n < 4624) return n - 2048; return -1;
}
__device__ __forceinline__ void transpose_item(const float* W, int K, int Nsrc, bf16* WT, int Npad, int mapid, const float* gain, LAS float* scr, int item, int lane) {
    const int nblk = Npad / 64, kb = item / nblk, nb = item % nblk, k0 = 64 * kb, n0 = 64 * nb;
    const int n4 = (lane & 15) * 4, src = map_col(mapid, n0 + n4);
    const int srcc = src >= 0 ? src : 0; const float msk = src >= 0 ? 1.f : 0.f;
    f32x4 v[16];
#pragma unroll
    for (int i = 0; i < 16; ++i) v[i] = *(const f32x4*)(W + (size_t)(k0 + 4 * i + (lane >> 4)) * Nsrc + srcc);
    if (gain) {
#pragma unroll
        for (int i = 0; i < 16; ++i) v[i] = v[i] * (gain[k0 + 4 * i + (lane >> 4)] * msk);
    } else {
#pragma unroll
        for (int i = 0; i < 16; ++i) v[i] = v[i] * msk;
    }
#pragma unroll
    for (int i = 0; i < 16; ++i) { const int kk = 4 * i + (lane >> 4); scr[kk * 65 + n4] = v[i].x; scr[kk * 65 + n4 + 1] = v[i].y; scr[kk * 65 + n4 + 2] = v[i].z; scr[kk * 65 + n4 + 3] = v[i].w; }
    LDS_WAIT(); asm volatile("" ::: "memory");
    const int c = lane & 7;
#pragma unroll
    for (int jj = 0; jj < 8; ++jj) { const int n = (lane >> 3) + 8 * jj; const LAS float* p = scr + (8 * c) * 65 + n;
        u32x4 o; o.x = pk2(p[0 * 65], p[1 * 65]); o.y = pk2(p[2 * 65], p[3 * 65]); o.z = pk2(p[4 * 65], p[5 * 65]); o.w = pk2(p[6 * 65], p[7 * 65]);
        *(u32x4*)(WT + (size_t)(n0 + n) * K + k0 + 8 * c) = o; }
    LDS_WAIT(); asm volatile("" ::: "memory");
}
__device__ __forceinline__ void norm_row_bf16(const f32x4 (&v)[8], const float* g, bf16* orow, int lane) {
    float ss = 0.f;
#pragma unroll
    for (int j = 0; j < 8; ++j) ss += (v[j].x * v[j].x + v[j].y * v[j].y) + (v[j].z * v[j].z + v[j].w * v[j].w);
    const float rstd = rsqrtf(wave_sum(ss) * (1.f / DM) + 1e-6f);
#pragma unroll
    for (int j = 0; j < 8; ++j) { const int col = 4 * (lane + 64 * j); const f32x4 gg = *(const f32x4*)(g + col);
        u32x2 o; o.x = pk2(v[j].x * rstd * gg.x, v[j].y * rstd * gg.y); o.y = pk2(v[j].z * rstd * gg.z, v[j].w * rstd * gg.w);
        *(u32x2*)(orow + col) = o; }
}

typedef short bf16x8 __attribute__((ext_vector_type(8)));
typedef float f32x16 __attribute__((ext_vector_type(16)));
#define MFMA32(a, b, c) __builtin_amdgcn_mfma_f32_32x32x16_bf16((a), (b), (c), 0, 0, 0)
#define PACK_ACC(x, S_) __builtin_bit_cast(bf16x8, (u32x4){cvtpk((x)[8 * (S_)], (x)[8 * (S_) + 1]), cvtpk((x)[8 * (S_) + 2], (x)[8 * (S_) + 3]), cvtpk((x)[8 * (S_) + 4], (x)[8 * (S_) + 5]), cvtpk((x)[8 * (S_) + 6], (x)[8 * (S_) + 7])})
__device__ __forceinline__ int crow(int reg, int h) { return (reg & 3) + 8 * (reg >> 2) + 4 * h; }
__device__ __forceinline__ bf16x8 pack8(const float (&v)[8]) { return __builtin_bit_cast(bf16x8, (u32x4){cvtpk(v[0], v[1]), cvtpk(v[2], v[3]), cvtpk(v[4], v[5]), cvtpk(v[6], v[7])}); }

#define XB_TMO      128
#define XB_XCNT(j)  (256  + 64 * (j))
#define XB_XSUB(j)  (1280 + 64 * (j))
#define XB_XGEN(j)  (2304 + 64 * (j))
#define XB_TOP      3328
#define XB_TOPGEN   3392
#define XCD_BAR_WORDS 3456
#define XB_SPIN_CAP (1u << 18)

__device__ __forceinline__ unsigned xb_ld(unsigned* p)              { return __hip_atomic_load(p, __ATOMIC_RELAXED, __HIP_MEMORY_SCOPE_AGENT); }
__device__ __forceinline__ unsigned xb_add(unsigned* p, unsigned v) { return __hip_atomic_fetch_add(p, v, __ATOMIC_RELAXED, __HIP_MEMORY_SCOPE_AGENT); }
__device__ __forceinline__ unsigned xb_xcc_id() { return (unsigned)__builtin_amdgcn_s_getreg((3 << 11) | 20) & 0xFu; }
#define XB_SPIN(cond, bar) do { unsigned _sp = 0; while (cond) { __builtin_amdgcn_s_sleep(1); \
    if ((++_sp & 255u) == 0u) { if (xb_ld(&(bar)[XB_TMO])) break; if (_sp > XB_SPIN_CAP) { atomicAdd(&(bar)[XB_TMO], 1u); break; } } } } while (0)

struct XcdBarrier {
    unsigned* bar; unsigned x;
    volatile LAS unsigned* st;
};

__device__ __forceinline__ XcdBarrier xcd_barrier_post(unsigned* bar, volatile LAS unsigned* st) {
    XcdBarrier b; b.bar = bar; b.x = xb_xcc_id(); b.st = st;
    if (threadIdx.x == 0) (void)xb_add(&bar[XB_XCNT(b.x)], 1u);
    return b;
}
__device__ __forceinline__ void xcd_barrier_complete(unsigned* bar, unsigned x, unsigned& nloc, unsigned& nx) {
    const unsigned G = gridDim.x * gridDim.y * gridDim.z;
    unsigned sum, cnt, mine, sp = 0u;
    for (;;) {
        sum = 0u; cnt = 0u; mine = 0u;
#pragma unroll
        for (unsigned j = 0; j < 16; ++j) { const unsigned c = xb_ld(&bar[XB_XCNT(j)]); sum += c; cnt += (c > 0u) ? 1u : 0u; mine = (j == x) ? c : mine; }
        if (sum == G) break;
        __builtin_amdgcn_s_sleep(1);
        if ((++sp & 255u) == 0u) { if (xb_ld(&bar[XB_TMO])) break; if (sp > XB_SPIN_CAP) { atomicAdd(&bar[XB_TMO], 1u); break; } }
    }
    nloc = mine > 0u ? mine : 1u; nx = cnt > 0u ? cnt : 1u;
}

__device__ __forceinline__ void xcd_barrier(const XcdBarrier& b) {
    asm volatile("s_waitcnt vmcnt(0)" ::: "memory");
    __syncthreads();
    if (threadIdx.x == 0) {
        unsigned* bar = b.bar;
        __builtin_amdgcn_s_waitcnt(0);
        unsigned nloc = b.st[0], nx = b.st[1];
        if (nloc == 0u) { xcd_barrier_complete(bar, b.x, nloc, nx); b.st[0] = nloc; b.st[1] = nx; }
        const unsigned old = xb_add(&bar[XB_XSUB(b.x)], 1u);
        const unsigned gen = old / nloc;
        if (old + 1u == (gen + 1u) * nloc) {
            __builtin_amdgcn_fence(__ATOMIC_RELEASE, "agent");
            asm volatile("s_waitcnt vmcnt(0)" ::: "memory");
            const unsigned og = xb_add(&bar[XB_TOP], 1u);
            const unsigned tg = og / nx;
            if (og + 1u == (tg + 1u) * nx) xb_add(&bar[XB_TOPGEN], 1u);
            else XB_SPIN(xb_ld(&bar[XB_TOPGEN]) == tg, bar);
            __builtin_amdgcn_fence(__ATOMIC_ACQUIRE, "agent");
            xb_add(&bar[XB_XGEN(b.x)], 1u);
            asm volatile("s_waitcnt vmcnt(0)" ::: "memory");
        } else {
            XB_SPIN(xb_ld(&bar[XB_XGEN(b.x)]) == gen, bar);
            __builtin_amdgcn_fence(__ATOMIC_ACQUIRE, "agent");
            asm volatile("s_waitcnt vmcnt(0)" ::: "memory");
        }
    }
    __syncthreads();
}


#ifdef PROBE_SEC
#define SEC_BEGIN(id) unsigned long long _sec_t##id = 0; if ((id) == PROBE_SEC) { __builtin_amdgcn_s_barrier(); _sec_t##id = __builtin_amdgcn_s_memrealtime(); }
#define SEC_END(id, ldsp) if ((id) == PROBE_SEC) { __builtin_amdgcn_s_barrier(); if (threadIdx.x == 0) { volatile LAS unsigned long long* a_ = (volatile LAS unsigned long long*)((ldsp) + LDS_BYTES - 32); a_[0] = a_[0] + (__builtin_amdgcn_s_memrealtime() - _sec_t##id); } }
#define SECW_BEGIN(id) unsigned long long _secw_t##id = 0; if ((id) == PROBE_SEC) { _secw_t##id = __builtin_amdgcn_s_memrealtime(); }
#define SECW_END(id, ldsp, tsel) if ((id) == PROBE_SEC) { asm volatile("s_waitcnt vmcnt(0) lgkmcnt(0)" ::: "memory"); if (threadIdx.x == (tsel)) { volatile LAS unsigned long long* a_ = (volatile LAS unsigned long long*)((ldsp) + LDS_BYTES - 32); a_[0] = a_[0] + (__builtin_amdgcn_s_memrealtime() - _secw_t##id); } }
#else
#define SEC_BEGIN(id)
#define SEC_END(id, ldsp)
#define SECW_BEGIN(id)
#define SECW_END(id, ldsp, tsel)
#endif
struct Args { const float* in[40]; float* out; unsigned char* ws; int ph_lo, ph_hi; };
constexpr int N_PHASES = 26, SUBS = 6;
#ifndef PH_MASK
#define PH_MASK 16383
#endif
#define AS4 __attribute__((address_space(4)))
struct KP { const char AS4* p;
    __device__ __forceinline__ const float* in(int i) const { return *(const float* const AS4*)(p + 8 * i); }
    __device__ __forceinline__ float* out() const { return *(float* const AS4*)(p + 320); }
    __device__ __forceinline__ unsigned char* ws() const { return *(unsigned char* const AS4*)(p + 328); }
};
static_assert(sizeof(Args) == 344, "Args layout");

__device__ __forceinline__ void phase_prologue(const KP kp, LAS unsigned char* lds, int gw, int NGW, int wave, int lane) {
    unsigned char* ws = kp.ws();
    LAS float* scr = (LAS float*)(lds + wave * 17408);
    SEC_BEGIN(1)
    SEC_BEGIN(14)
    for (int job = 0; job < 16; ++job) {
        if (job == 2) { SEC_END(14, lds) }
        const float* W; int K = 2048, Nsrc = 2048, Npad = 2048, mapid = 0; bf16* WT; const float* gain = nullptr;
        if (job < 2)       { W = kp.in(13) + (size_t)job * 2048 * 7200; Nsrc = 7200; Npad = NAB; mapid = 1; WT = (bf16*)(ws + WS_WABIN) + (size_t)job * NAB * 2048; gain = kp.in(11) + (size_t)(2 * job) * DM; }
        else if (job < 4)  { W = kp.in(21) + (size_t)(job - 2) * 2048 * 2048; WT = (bf16*)(ws + WS_WABOUT) + (size_t)(job - 2) * 2048 * 2048; }
        else if (job < 6)  { W = kp.in(22) + (size_t)(job - 4) * 2048 * 4624; Nsrc = 4624; Npad = NCD; mapid = 2; WT = (bf16*)(ws + WS_WCDIN) + (size_t)(job - 4) * NCD * 2048; gain = kp.in(11) + (size_t)(2 * (job - 4) + 1) * DM; }
        else if (job < 8)  { W = kp.in(36) + (size_t)(job - 6) * 2048 * 2048; WT = (bf16*)(ws + WS_WCDOUT) + (size_t)(job - 6) * 2048 * 2048; }
        else if (job < 12) { W = kp.in(39) + (size_t)(job - 8) * 2048 * 2048; WT = (bf16*)(ws + WS_WGATE) + (size_t)(job - 8) * 2048 * 2048; gain = kp.in(38) + (size_t)(job - 8) * DM; }
        else               { W = kp.in(37) + (size_t)(job - 12) * 256 * 2048; K = 256; WT = (bf16*)(ws + WS_WPROJ) + (size_t)(job - 12) * 2048 * 256; }
        const int nitems = (K / 64) * (Npad / 64), nblocks = NGW / NWAVES, ipb = (nitems + nblocks - 1) / nblocks, ib = (gw / NWAVES) * ipb, ie = ib + ipb < nitems ? ib + ipb : nitems;
        for (int it = ib + wave; it < ie; it += NWAVES) transpose_item(W, K, Nsrc, WT, Npad, mapid, gain, scr, it, lane);
    }
    SEC_END(1, lds)
    SEC_BEGIN(2)
    bf16* HB = (bf16*)(ws + WS_XN); float* RSS = (float*)(ws + WS_RSS);
    for (int m = gw; m < T; m += NGW) {
        const float* src = m < TP ? kp.in(0) + (size_t)m * DM : kp.in(1) + (size_t)(m - TP) * DM;
        float ss = 0.f;
#pragma unroll
        for (int jj = 0; jj < 8; ++jj) { const int col = 4 * (lane + 64 * jj); const f32x4 v = *(const f32x4*)(src + col);
            u32x2 o; o.x = pk2(v.x, v.y); o.y = pk2(v.z, v.w); *(u32x2*)(HB + (size_t)m * DM + col) = o; ss += (v.x * v.x + v.y * v.y) + (v.z * v.z + v.w * v.w); }
        ss = wave_sum(ss); if (lane == 0) RSS[m] = ss;
    }
    bf16* PB = (bf16*)(ws + WS_PB);
    const int gt = gw * 64 + lane, NGT = NGW * 64;
    for (int i = gt; i < 4 * T * 64; i += NGT) {
        const int c4 = i & 63, rr = i >> 6, li = rr / T, r = rr - li * T;
        const float* src = r < TP ? kp.in(9) + ((size_t)li * TP + r) * 256 + 4 * c4 : kp.in(10) + ((size_t)li * TS + (r - TP)) * 256 + 4 * c4;
        const f32x4 v = *(const f32x4*)src;
        u32x2 o; o.x = pk2(v.x, v.y); o.y = pk2(v.z, v.w);
        *(u32x2*)(PB + ((size_t)li * T + r) * 256 + 4 * c4) = o;
    }
    SEC_END(2, lds)
}
__device__ __forceinline__ void phase_final(const KP kp, int gw, int NGW, int lane) {
    const bf16* HB = (const bf16*)(kp.ws() + WS_XN); const float* RSS = (const float*)(kp.ws() + WS_RSS) + (size_t)8 * T; const float* g = kp.in(12); float* out = kp.out();
    for (int m = gw; m < T; m += NGW) { const float rstd = rsqrtf(RSS[m] * (1.f / DM) + 1e-6f);
#pragma unroll
        for (int jj = 0; jj < 8; ++jj) { const int col = 4 * (lane + 64 * jj); const u32x2 hv = *(const u32x2*)(HB + (size_t)m * DM + col); const f32x4 gg = *(const f32x4*)(g + col);
            f32x4 o; o.x = __uint_as_float(hv.x << 16) * rstd * gg.x; o.y = __uint_as_float(hv.x & 0xffff0000u) * rstd * gg.y; o.z = __uint_as_float(hv.y << 16) * rstd * gg.z; o.w = __uint_as_float(hv.y & 0xffff0000u) * rstd * gg.w;
            *(f32x4*)(out + (size_t)m * DM + col) = o; } }
}

constexpr size_t GLA_ITEM_BYTES = 74752, WS_GLAOPS = WS_H;
__device__ __forceinline__ void phase_gla_prep(const KP kp, const int bid, const int G, int j, LAS unsigned char* lds, int tid0) {
    const bf16* U = (const bf16*)(kp.ws() + WS_U);
    const float* wa2 = kp.in(18) + (size_t)j * 16 * 512; const float* ba = kp.in(19) + (size_t)j * 512;
    unsigned char* OPS = kp.ws() + WS_GLAOPS;
    LAS float* GE = (LAS float*)lds; LAS float* Pg = GE + 128;
    LAS bf16* Qg = (LAS bf16*)(Pg + 512); LAS bf16* Ka = Qg + 64 * 136; LAS float* QKm = (LAS float*)(Ka + 64 * 136);
    for (int item = bid; item < 512; item += G) {
        int tid = tid0; asm volatile("" : "+v"(tid));
        const int lane = tid & 63, r = lane & 31, hp = lane >> 5, wave = tid >> 6;
        const int b = item >> 7, n = (item >> 2) & 31, h = item & 3;
        const int row0 = b * 2048 + n * 64;
        __syncthreads();
        const int d = tid & 127, tg = tid >> 7, t0 = 16 * tg;
        float q[16], k[16], gl[16];
        { float w[16];
#pragma unroll
          for (int rr = 0; rr < 16; ++rr) w[rr] = wa2[rr * 512 + h * 128 + d];
          const float bias = ba[h * 128 + d];
#pragma unroll
          for (int t = 0; t < 16; ++t) { const size_t ro = (size_t)(row0 + t0 + t) * NAB;
              q[t] = bf2f(U[ro + 4096 + h * 128 + d]) * 0.08838834764831845f; k[t] = bf2f(U[ro + 4608 + h * 128 + d]);
              const u32x4 g0 = *(const u32x4*)(U + ro + 7184), g1 = *(const u32x4*)(U + ro + 7192);
              float x = bias;
              x += __uint_as_float(g0.x << 16) * w[0] + __uint_as_float(g0.x & 0xffff0000u) * w[1] + __uint_as_float(g0.y << 16) * w[2] + __uint_as_float(g0.y & 0xffff0000u) * w[3];
              x += __uint_as_float(g0.z << 16) * w[4] + __uint_as_float(g0.z & 0xffff0000u) * w[5] + __uint_as_float(g0.w << 16) * w[6] + __uint_as_float(g0.w & 0xffff0000u) * w[7];
              x += __uint_as_float(g1.x << 16) * w[8] + __uint_as_float(g1.x & 0xffff0000u) * w[9] + __uint_as_float(g1.y << 16) * w[10] + __uint_as_float(g1.y & 0xffff0000u) * w[11];
              x += __uint_as_float(g1.z << 16) * w[12] + __uint_as_float(g1.z & 0xffff0000u) * w[13] + __uint_as_float(g1.w << 16) * w[14] + __uint_as_float(g1.w & 0xffff0000u) * w[15];
              gl[t] = -softplus_(-x) * (1.f / 16.f); } }
#pragma unroll
        for (int t = 1; t < 16; ++t) gl[t] += gl[t - 1];
        Pg[tg * 128 + d] = gl[15];
        __syncthreads();
        { float off = 0.f;
#pragma unroll
          for (int g = 0; g < 3; ++g) off += (g < tg) ? Pg[g * 128 + d] : 0.f;
          if (tg == 3) GE[d] = gl[15] + off;
#pragma unroll
          for (int t = 0; t < 16; ++t) { const float Gt = gl[t] + off; Qg[(t0 + t) * 136 + d] = (bf16)f2bf(q[t] * __expf(Gt)); Ka[(t0 + t) * 136 + d] = (bf16)f2bf(k[t] * __expf(-Gt)); } }
        __syncthreads();
        bf16x8* base = (bf16x8*)(OPS + (size_t)item * GLA_ITEM_BYTES);
        if (wave < 4) {
            const int mt = wave >> 1, nt = wave & 1;
            f32x16 acc;
#pragma unroll
            for (int i = 0; i < 16; ++i) acc[i] = 0.f;
#pragma unroll
            for (int ks = 0; ks < 8; ++ks) acc = MFMA32(*(const LAS bf16x8*)(Qg + (32 * mt + r) * 136 + 16 * ks + 8 * hp), *(const LAS bf16x8*)(Ka + (32 * nt + r) * 136 + 16 * ks + 8 * hp), acc);
            const int jt = 32 * nt + r;
#pragma unroll
            for (int i16 = 0; i16 < 16; ++i16) { const int i = 32 * mt + crow(i16, hp); QKm[i * 65 + jt] = jt <= i ? acc[i16] : 0.f; }
        } else {
            const int w4 = wave - 4;
#pragma unroll
            for (int q8 = 0; q8 < 8; ++q8) { const int f = w4 + 4 * q8, nt = f >> 2, ks = f & 3, p = 32 * nt + r;
                unsigned w[4];
#pragma unroll
                for (int jp = 0; jp < 8; jp += 2) { const int tk = 16 * ks + 8 * (jp >> 2) + 4 * hp + (jp & 3);
                    w[jp >> 1] = (unsigned)U[(size_t)(row0 + tk) * NAB + 5120 + h * 256 + p] | ((unsigned)U[(size_t)(row0 + tk + 1) * NAB + 5120 + h * 256 + p] << 16); }
                base[(40 + f) * 64 + lane] = __builtin_bit_cast(bf16x8, (u32x4){w[0], w[1], w[2], w[3]}); }
        }
        __syncthreads();
        float v[8];
#pragma unroll
        for (int q2 = 0; q2 < 2; ++q2) { const int f = wave + 8 * q2;
            { const int mt = f >> 3, ks = f & 7, i = 32 * mt + r;
              const u32x2 lo = *(const LAS u32x2*)(Qg + i * 136 + 16 * ks + 4 * hp), hi = *(const LAS u32x2*)(Qg + i * 136 + 16 * ks + 8 + 4 * hp);
              base[f * 64 + lane] = __builtin_bit_cast(bf16x8, (u32x4){lo.x, lo.y, hi.x, hi.y}); }
            { const int mt = f >> 2, ks = f & 3, dd = 32 * mt + r; const float eg = __expf(GE[dd]);
#pragma unroll
              for (int jp = 0; jp < 8; ++jp) v[jp] = bf2f(Ka[(16 * ks + 8 * (jp >> 2) + 4 * hp + (jp & 3)) * 136 + dd]) * eg;
              base[(16 + f) * 64 + lane] = pack8(v); } }
        { const int f = wave, mt = f >> 2, ks = f & 3, i = 32 * mt + r;
#pragma unroll
          for (int jp = 0; jp < 8; ++jp) v[jp] = QKm[i * 65 + 16 * ks + 8 * (jp >> 2) + 4 * hp + (jp & 3)];
          base[(32 + f) * 64 + lane] = pack8(v); }
        if (tid < 128) ((float*)(base + 72 * 64))[tid] = __expf(GE[tid]);
    }
}

constexpr size_t DN_ITEM_BYTES = 74752;
__device__ __forceinline__ void phase_dn_prep(const KP kp, const int bid, const int G, int j, LAS unsigned char* lds, int tid0) {
    unsigned char* scr = kp.ws() + WS_SCR;
    const bf16* U = (const bf16*)(kp.ws() + WS_U); const float* cw = kp.in(14) + (size_t)j * 4 * 3072;
    unsigned char* OPS = scr + SC_DNOPS;
    LAS float* AMT = (LAS float*)lds; LAS float* GLs = AMT + 64 * 68; LAS float* BLs = GLs + 64; LAS float* SS = BLs + 64;
    LAS bf16* Kb = (LAS bf16*)(SS + 256); LAS bf16* Qb = Kb + 64 * 136; LAS float* QKm = (LAS float*)(Qb + 64 * 136); LAS float* XL = QKm + 64 * 65;
    for (int item = bid; item < 1024; item += G) {
        int tid = tid0; asm volatile("" : "+v"(tid));
        const int lane = tid & 63, r = lane & 31, hp = lane >> 5, wave = tid >> 6;
        const int b = item >> 8, n = (item >> 3) & 31, h = item & 7;
        const int row0 = b * 2048 + n * 64;
        __syncthreads();
        SEC_BEGIN(20)
        {
          const int t0 = 8 * wave; const bool first = (n == 0 && wave == 0);
          const long fo = first ? 0 : (long)NAB;
          float qa[8], qb[8], ka[8], kb[8];
#pragma unroll
          for (int part = 0; part < 3; ++part) { const int c = part * 1024 + h * 128 + 2 * lane;
              const float w0a = cw[c], w0b = cw[c + 1], w1a = cw[3072 + c], w1b = cw[3072 + c + 1], w2a = cw[2 * 3072 + c], w2b = cw[2 * 3072 + c + 1], w3a = cw[3 * 3072 + c], w3b = cw[3 * 3072 + c + 1];
              const bf16* up = U + (size_t)(row0 + t0) * NAB + c;
              unsigned raw[11];
              raw[0] = *(const unsigned*)(up - 3 * fo); raw[1] = *(const unsigned*)(up - 2 * fo); raw[2] = *(const unsigned*)(up - 1 * fo);
#pragma unroll
              for (int t = 0; t < 8; ++t) raw[3 + t] = *(const unsigned*)(up + (size_t)t * NAB);
              if (first) { raw[0] = 0u; raw[1] = 0u; raw[2] = 0u; }
#pragma unroll
              for (int t = 0; t < 8; ++t) {
                  const float ya = silu_(w0a * __uint_as_float(raw[t] << 16) + w1a * __uint_as_float(raw[t + 1] << 16) + w2a * __uint_as_float(raw[t + 2] << 16) + w3a * __uint_as_float(raw[t + 3] << 16));
                  const float yb = silu_(w0b * __uint_as_float(raw[t] & 0xffff0000u) + w1b * __uint_as_float(raw[t + 1] & 0xffff0000u) + w2b * __uint_as_float(raw[t + 2] & 0xffff0000u) + w3b * __uint_as_float(raw[t + 3] & 0xffff0000u));
                  if (part == 0) { qa[t] = ya; qb[t] = yb; } else if (part == 1) { ka[t] = ya; kb[t] = yb; } else { XL[(t0 + t) * 257 + 2 * lane] = ya; XL[(t0 + t) * 257 + 2 * lane + 1] = yb; } } }
#pragma unroll
          for (int t = 0; t < 8; ++t) { const float scq = rsqrtf(wave_sum(qa[t] * qa[t] + qb[t] * qb[t]) + 1e-6f) * 0.08838834764831845f, sck = rsqrtf(wave_sum(ka[t] * ka[t] + kb[t] * kb[t]) + 1e-6f);
              *(LAS unsigned*)(Qb + (t0 + t) * 136 + 2 * lane) = pk2(qa[t] * scq, qb[t] * scq); *(LAS unsigned*)(Kb + (t0 + t) * 136 + 2 * lane) = pk2(ka[t] * sck, kb[t] * sck); } }
        if (wave == 0) { const size_t ro = (size_t)(row0 + lane) * NAB;
            float gv = -__expf(kp.in(15)[j * 8 + h]) * softplus_(bf2f(U[ro + 7176 + h]) + kp.in(16)[j * 8 + h]);
#pragma unroll
            for (int o = 1; o < 64; o <<= 1) { const float tt = __shfl_up(gv, o); if (lane >= o) gv += tt; }
            GLs[lane] = gv; BLs[lane] = sigmoid_(bf2f(U[ro + 7168 + h])); }
        __syncthreads();
        SEC_END(20, lds)
        SEC_BEGIN(21)
        SEC_END(21, lds)
        SEC_BEGIN(22)
        bf16x8* base = (bf16x8*)(OPS + (size_t)item * DN_ITEM_BYTES);
        { const int which = wave >> 2, mt = (wave >> 1) & 1, nt = wave & 1;
          const LAS bf16* Asrc = which ? Qb : Kb;
          f32x16 acc;
#pragma unroll
          for (int i = 0; i < 16; ++i) acc[i] = 0.f;
#pragma unroll
          for (int ks = 0; ks < 8; ++ks) acc = MFMA32(*(const LAS bf16x8*)(Asrc + (32 * mt + r) * 136 + 16 * ks + 8 * hp), *(const LAS bf16x8*)(Kb + (32 * nt + r) * 136 + 16 * ks + 8 * hp), acc);
          const int jt = 32 * nt + r; const float gj = GLs[jt];
#pragma unroll
          for (int i16 = 0; i16 < 16; ++i16) { const int i = 32 * mt + crow(i16, hp); const float dec = __expf(GLs[i] - gj);
              if (which == 0) AMT[jt * 68 + i] = jt < i ? BLs[i] * acc[i16] * dec : 0.f; else QKm[i * 65 + jt] = jt <= i ? acc[i16] * dec : 0.f; } }
        __syncthreads();
        SEC_END(22, lds)
        SEC_BEGIN(23)
        if (tid < 256) {
            SECW_BEGIN(25)
            const int c = tid;
#pragma unroll
            for (int bi = 0; bi < 4; ++bi) {
                float acc[16];
#pragma unroll
                for (int ii = 0; ii < 16; ++ii) { const int i = 16 * bi + ii; const float be = BLs[i];
                    acc[ii] = c < 128 ? be * XL[i * 257 + c] : be * __expf(GLs[i]) * bf2f(Kb[i * 136 + (c - 128)]); }
#pragma unroll 4
                for (int jj = 0; jj < 16 * bi; ++jj) { const float xj = XL[jj * 257 + c];
#pragma unroll
                    for (int q = 0; q < 4; ++q) { const f32x4 a = *(const LAS f32x4*)(AMT + jj * 68 + 16 * bi + 4 * q);
                        acc[4 * q + 0] -= a[0] * xj; acc[4 * q + 1] -= a[1] * xj; acc[4 * q + 2] -= a[2] * xj; acc[4 * q + 3] -= a[3] * xj; } }
                float dg[120];
#pragma unroll
                for (int ii = 1; ii < 16; ++ii)
#pragma unroll
                    for (int jj = 0; jj < ii; ++jj) dg[ii * (ii - 1) / 2 + jj] = AMT[(16 * bi + jj) * 68 + 16 * bi + ii];
#pragma unroll
                for (int ii = 0; ii < 16; ++ii) { float x = acc[ii];
#pragma unroll
                    for (int jj = 0; jj < ii; ++jj) x -= dg[ii * (ii - 1) / 2 + jj] * acc[jj];
                    acc[ii] = x; }
#pragma unroll
                for (int ii = 0; ii < 16; ++ii) XL[(16 * bi + ii) * 257 + c] = acc[ii];
            }
            SECW_END(25, lds, 0)
        } else {
            SECW_BEGIN(26)
            const int w4 = wave - 4; float v[8];
#pragma unroll
            for (int q = 0; q < 4; ++q) { const int f = w4 + 4 * q;
                { const int mt = f >> 3, ks = f & 7, i = 32 * mt + r; const float eg = __expf(GLs[i]);
                  const bf16x8 qq = *(const LAS bf16x8*)(Qb + i * 136 + 16 * ks + 8 * hp);
#pragma unroll
                  for (int jp = 0; jp < 8; ++jp) v[jp] = bf2f(Qb[i * 136 + 16 * ks + 8 * (jp >> 2) + 4 * hp + (jp & 3)]) * eg;
                  (void)qq; base[(16 + f) * 64 + lane] = pack8(v); }
                { const int mt = f >> 2, ks = f & 3, d = 32 * mt + r; const float Gend = GLs[63];
#pragma unroll
                  for (int jp = 0; jp < 8; ++jp) { const int tk = 16 * ks + 8 * (jp >> 2) + 4 * hp + (jp & 3); v[jp] = bf2f(Kb[tk * 136 + d]) * __expf(Gend - GLs[tk]); }
                  base[(32 + f) * 64 + lane] = pack8(v); } }
#pragma unroll
            for (int q = 0; q < 2; ++q) { const int f = w4 + 4 * q, mt = f >> 2, ks = f & 3, i = 32 * mt + r;
#pragma unroll
                for (int jp = 0; jp < 8; ++jp) v[jp] = QKm[i * 65 + 16 * ks + 8 * (jp >> 2) + 4 * hp + (jp & 3)];
                base[(48 + f) * 64 + lane] = pack8(v); }
            if (tid == 256) *(float*)(base + 72 * 64) = __expf(GLs[63]);
            SECW_END(26, lds, 256)
        }
        __syncthreads();
        SEC_END(23, lds)
        SEC_BEGIN(24)
        float v[8];
#pragma unroll
        for (int q = 0; q < 2; ++q) { const int f = wave + 8 * q;
            { const int mt = f >> 3, ks = f & 7, i = 32 * mt + r;
#pragma unroll
              for (int jp = 0; jp < 8; ++jp) v[jp] = -XL[i * 257 + 128 + 16 * ks + 8 * (jp >> 2) + 4 * hp + (jp & 3)];
              base[f * 64 + lane] = pack8(v); }
            { const int pq = f & 1, tl = f >> 1, mt = tl >> 2, nt = tl & 3;
#pragma unroll
              for (int e = 0; e < 8; ++e) v[e] = XL[(32 * mt + crow(8 * pq + e, hp)) * 257 + 32 * nt + r];
              base[(56 + f) * 64 + lane] = pack8(v); } }
        SEC_END(24, lds)
    }
}

__device__ __forceinline__ void phase_ab_rec(const KP kp, const int bid, const int G, int j, int li, LAS unsigned char* lds, int tid0) {
    unsigned char* scr = kp.ws() + WS_SCR; const bf16* U = (const bf16*)(kp.ws() + WS_U);
    bf16* ODN = (bf16*)(scr + SC_ODN); bf16* OGLA = (bf16*)(scr + SC_OGLA);
    SEC_BEGIN(12)
    for (int item = bid; item < 64; item += G) {
        int tid = tid0; asm volatile("" : "+v"(tid));
        int s, h; bool isdn; int half = -1;
        if (item < 32) { isdn = false; s = item >> 3; h = (item >> 1) & 3; half = item & 1; }
        else if (item < 64) { isdn = true; s = (item - 32) >> 3; h = (item - 32) & 7; half = -2; }
        else if (item < 1088) { isdn = true; s = 4 + ((item - 64) >> 3); h = (item - 64) & 7; }
        else { isdn = false; s = 4 + ((item - 1088) >> 2); h = (item - 1088) & 3; }
        int row0, L; seq_info(s, row0, L);
        __syncthreads();
        if (half == -2) {
            const int wave = __builtin_amdgcn_readfirstlane(tid >> 6), lane = tid & 63, r = lane & 31, hp = lane >> 5;
            const int b = s, nt = wave;
            const unsigned char* OPS = scr + SC_DNOPS;
            constexpr int DBUF = 73 * 1024;
#define DN_DMA(n_, bufi_) do { const unsigned char* gi_ = OPS + (size_t)((b * 32 + (n_)) * 8 + h) * DN_ITEM_BYTES + lane * 16; \
                _Pragma("unroll") for (int q_ = 0; q_ < 10; ++q_) { const int lf_ = wave + 8 * q_; if (lf_ < 73) \
                    __builtin_amdgcn_global_load_lds((const unsigned*)(gi_ + lf_ * 1024), (LAS unsigned*)(lds + (bufi_) * DBUF + lf_ * 1024), 16, 0, 2); } } while (0)
            f32x16 S0, S1, S2, S3;
#pragma unroll
            for (int i = 0; i < 16; ++i) { S0[i] = 0.f; S1[i] = 0.f; S2[i] = 0.f; S3[i] = 0.f; }
            DN_DMA(0, 0);
            asm volatile("s_waitcnt vmcnt(0)" ::: "memory"); __syncthreads();
            for (int n = 0; n < 32; ++n) {
                if (n + 1 < 32) DN_DMA(n + 1, (n + 1) & 1);
                if (wave < 4) {
                    const LAS bf16x8* F = (const LAS bf16x8*)(lds + (n & 1) * DBUF) + lane;
                    const float gend = *(const LAS float*)(lds + (n & 1) * DBUF + 72 * 1024);
                    const bf16x8 sb0 = PACK_ACC(S0, 0), sb1 = PACK_ACC(S0, 1), sb2 = PACK_ACC(S1, 0), sb3 = PACK_ACC(S1, 1), sb4 = PACK_ACC(S2, 0), sb5 = PACK_ACC(S2, 1), sb6 = PACK_ACC(S3, 0), sb7 = PACK_ACC(S3, 1);
                    f32x16 U0t, U1t;
                    { const bf16x8 a0 = F[(56 + nt * 2 + 0) * 64], a1 = F[(56 + nt * 2 + 1) * 64], c0 = F[(56 + (4 + nt) * 2 + 0) * 64], c1 = F[(56 + (4 + nt) * 2 + 1) * 64];
#pragma unroll
                      for (int e = 0; e < 8; ++e) { U0t[e] = bf2f((bf16)a0[e]); U0t[8 + e] = bf2f((bf16)a1[e]); U1t[e] = bf2f((bf16)c0[e]); U1t[8 + e] = bf2f((bf16)c1[e]); } }
                    U0t = MFMA32(F[0 * 64], sb0, U0t); U0t = MFMA32(F[1 * 64], sb1, U0t); U0t = MFMA32(F[2 * 64], sb2, U0t); U0t = MFMA32(F[3 * 64], sb3, U0t);
                    U0t = MFMA32(F[4 * 64], sb4, U0t); U0t = MFMA32(F[5 * 64], sb5, U0t); U0t = MFMA32(F[6 * 64], sb6, U0t); U0t = MFMA32(F[7 * 64], sb7, U0t);
                    U1t = MFMA32(F[8 * 64], sb0, U1t); U1t = MFMA32(F[9 * 64], sb1, U1t); U1t = MFMA32(F[10 * 64], sb2, U1t); U1t = MFMA32(F[11 * 64], sb3, U1t);
                    U1t = MFMA32(F[12 * 64], sb4, U1t); U1t = MFMA32(F[13 * 64], sb5, U1t); U1t = MFMA32(F[14 * 64], sb6, U1t); U1t = MFMA32(F[15 * 64], sb7, U1t);
                    const bf16x8 ub0 = PACK_ACC(U0t, 0), ub1 = PACK_ACC(U0t, 1), ub2 = PACK_ACC(U1t, 0), ub3 = PACK_ACC(U1t, 1);
                    f32x16 O0, O1;
#pragma unroll
                    for (int i = 0; i < 16; ++i) { O0[i] = 0.f; O1[i] = 0.f; }
                    O0 = MFMA32(F[16 * 64], sb0, O0); O0 = MFMA32(F[17 * 64], sb1, O0); O0 = MFMA32(F[18 * 64], sb2, O0); O0 = MFMA32(F[19 * 64], sb3, O0);
                    O0 = MFMA32(F[20 * 64], sb4, O0); O0 = MFMA32(F[21 * 64], sb5, O0); O0 = MFMA32(F[22 * 64], sb6, O0); O0 = MFMA32(F[23 * 64], sb7, O0);
                    O1 = MFMA32(F[24 * 64], sb0, O1); O1 = MFMA32(F[25 * 64], sb1, O1); O1 = MFMA32(F[26 * 64], sb2, O1); O1 = MFMA32(F[27 * 64], sb3, O1);
                    O1 = MFMA32(F[28 * 64], sb4, O1); O1 = MFMA32(F[29 * 64], sb5, O1); O1 = MFMA32(F[30 * 64], sb6, O1); O1 = MFMA32(F[31 * 64], sb7, O1);
                    O0 = MFMA32(F[48 * 64], ub0, O0); O0 = MFMA32(F[49 * 64], ub1, O0);
                    O1 = MFMA32(F[52 * 64], ub0, O1); O1 = MFMA32(F[53 * 64], ub1, O1); O1 = MFMA32(F[54 * 64], ub2, O1); O1 = MFMA32(F[55 * 64], ub3, O1);
#pragma unroll
                    for (int i = 0; i < 16; ++i) { S0[i] *= gend; S1[i] *= gend; S2[i] *= gend; S3[i] *= gend; }
                    S0 = MFMA32(F[32 * 64], ub0, S0); S0 = MFMA32(F[33 * 64], ub1, S0); S0 = MFMA32(F[34 * 64], ub2, S0); S0 = MFMA32(F[35 * 64], ub3, S0);
                    S1 = MFMA32(F[36 * 64], ub0, S1); S1 = MFMA32(F[37 * 64], ub1, S1); S1 = MFMA32(F[38 * 64], ub2, S1); S1 = MFMA32(F[39 * 64], ub3, S1);
                    S2 = MFMA32(F[40 * 64], ub0, S2); S2 = MFMA32(F[41 * 64], ub1, S2); S2 = MFMA32(F[42 * 64], ub2, S2); S2 = MFMA32(F[43 * 64], ub3, S2);
                    S3 = MFMA32(F[44 * 64], ub0, S3); S3 = MFMA32(F[45 * 64], ub1, S3); S3 = MFMA32(F[46 * 64], ub2, S3); S3 = MFMA32(F[47 * 64], ub3, S3);
                    bf16* yo = ODN + (size_t)(b * 2048 + n * 64) * 1024 + h * 128 + 32 * nt + r;
#pragma unroll
                    for (int i = 0; i < 16; ++i) { yo[(size_t)crow(i, hp) * 1024] = (bf16)f2bf(O0[i]); yo[(size_t)(32 + crow(i, hp)) * 1024] = (bf16)f2bf(O1[i]); }
                }
                asm volatile("s_waitcnt vmcnt(0)" ::: "memory"); __syncthreads();
            }
#undef DN_DMA
            if (wave < 4) {
                float* dst = kp.out() + O_DN_P + ((size_t)j * 4 + b) * ((size_t)8 * 128 * 128) + (size_t)h * 128 * 128 + 32 * nt + r;
#pragma unroll
                for (int i = 0; i < 16; ++i) { dst[(size_t)crow(i, hp) * 128] = S0[i]; dst[(size_t)(32 + crow(i, hp)) * 128] = S1[i]; dst[(size_t)(64 + crow(i, hp)) * 128] = S2[i]; dst[(size_t)(96 + crow(i, hp)) * 128] = S3[i]; }
            }
        } else if (half >= 0) {
            const int wave = __builtin_amdgcn_readfirstlane(tid >> 6), lane = tid & 63, r = lane & 31, hp = lane >> 5;
            const int b = s, nt = half * 4 + wave;
            const unsigned char* OPS = kp.ws() + WS_GLAOPS;
            constexpr int GBUF = 57 * 1024;
#define GLA_DMA(n_, bufi_) do { const unsigned char* gi_ = OPS + (size_t)((b * 32 + (n_)) * 4 + h) * GLA_ITEM_BYTES + lane * 16; \
                _Pragma("unroll") for (int q_ = 0; q_ < 8; ++q_) { const int lf_ = wave + 8 * q_; if (lf_ < 57) { const int gf_ = lf_ < 40 ? lf_ : (lf_ < 56 ? lf_ + half * 16 : 72); \
                    __builtin_amdgcn_global_load_lds((const unsigned*)(gi_ + gf_ * 1024), (LAS unsigned*)(lds + (bufi_) * GBUF + lf_ * 1024), 16, 0, 2); } } } while (0)
            f32x16 S0, S1, S2, S3;
#pragma unroll
            for (int i = 0; i < 16; ++i) { S0[i] = 0.f; S1[i] = 0.f; S2[i] = 0.f; S3[i] = 0.f; }
            GLA_DMA(0, 0);
            asm volatile("s_waitcnt vmcnt(0)" ::: "memory"); __syncthreads();
            for (int n = 0; n < 32; ++n) {
                if (n + 1 < 32) GLA_DMA(n + 1, (n + 1) & 1);
                if (wave < 4) {
                    const LAS bf16x8* F = (const LAS bf16x8*)(lds + (n & 1) * GBUF) + lane;
                    const LAS float* ge = (const LAS float*)(lds + (n & 1) * GBUF + 56 * 1024) + 4 * hp;
                    const bf16x8 sb0 = PACK_ACC(S0, 0), sb1 = PACK_ACC(S0, 1), sb2 = PACK_ACC(S1, 0), sb3 = PACK_ACC(S1, 1), sb4 = PACK_ACC(S2, 0), sb5 = PACK_ACC(S2, 1), sb6 = PACK_ACC(S3, 0), sb7 = PACK_ACC(S3, 1);
                    f32x16 O0, O1;
#pragma unroll
                    for (int i = 0; i < 16; ++i) { O0[i] = 0.f; O1[i] = 0.f; }
                    O0 = MFMA32(F[0 * 64], sb0, O0); O0 = MFMA32(F[1 * 64], sb1, O0); O0 = MFMA32(F[2 * 64], sb2, O0); O0 = MFMA32(F[3 * 64], sb3, O0);
                    O0 = MFMA32(F[4 * 64], sb4, O0); O0 = MFMA32(F[5 * 64], sb5, O0); O0 = MFMA32(F[6 * 64], sb6, O0); O0 = MFMA32(F[7 * 64], sb7, O0);
                    O1 = MFMA32(F[8 * 64], sb0, O1); O1 = MFMA32(F[9 * 64], sb1, O1); O1 = MFMA32(F[10 * 64], sb2, O1); O1 = MFMA32(F[11 * 64], sb3, O1);
                    O1 = MFMA32(F[12 * 64], sb4, O1); O1 = MFMA32(F[13 * 64], sb5, O1); O1 = MFMA32(F[14 * 64], sb6, O1); O1 = MFMA32(F[15 * 64], sb7, O1);
                    bf16x8 vb[4];
#pragma unroll
                    for (int ks = 0; ks < 4; ++ks) vb[ks] = F[(40 + wave * 4 + ks) * 64];
                    O0 = MFMA32(F[32 * 64], vb[0], O0); O0 = MFMA32(F[33 * 64], vb[1], O0);
#pragma unroll
                    for (int ks = 0; ks < 4; ++ks) O1 = MFMA32(F[(36 + ks) * 64], vb[ks], O1);
#pragma unroll
                    for (int q = 0; q < 4; ++q) { const f32x4 g0 = *(const LAS f32x4*)(ge + 8 * q), g1 = *(const LAS f32x4*)(ge + 32 + 8 * q), g2 = *(const LAS f32x4*)(ge + 64 + 8 * q), g3 = *(const LAS f32x4*)(ge + 96 + 8 * q);
#pragma unroll
                        for (int c = 0; c < 4; ++c) { S0[4 * q + c] *= g0[c]; S1[4 * q + c] *= g1[c]; S2[4 * q + c] *= g2[c]; S3[4 * q + c] *= g3[c]; } }
#pragma unroll
                    for (int ks = 0; ks < 4; ++ks) { S0 = MFMA32(F[(16 + ks) * 64], vb[ks], S0); S1 = MFMA32(F[(20 + ks) * 64], vb[ks], S1); S2 = MFMA32(F[(24 + ks) * 64], vb[ks], S2); S3 = MFMA32(F[(28 + ks) * 64], vb[ks], S3); }
                    bf16* yo = OGLA + (size_t)(b * 2048 + n * 64) * 1024 + h * 256 + 32 * nt + r;
#pragma unroll
                    for (int i = 0; i < 16; ++i) { yo[(size_t)crow(i, hp) * 1024] = (bf16)f2bf(O0[i]); yo[(size_t)(32 + crow(i, hp)) * 1024] = (bf16)f2bf(O1[i]); }
                }
                asm volatile("s_waitcnt vmcnt(0)" ::: "memory"); __syncthreads();
            }
#undef GLA_DMA
            if (wave < 4) {
                float* dst = kp.out() + O_GLA_P + ((size_t)j * 4 + b) * ((size_t)4 * 128 * 256) + (size_t)h * 128 * 256 + 32 * nt + r;
#pragma unroll
                for (int i = 0; i < 16; ++i) { dst[(size_t)crow(i, hp) * 256] = S0[i]; dst[(size_t)(32 + crow(i, hp)) * 256] = S1[i]; dst[(size_t)(64 + crow(i, hp)) * 256] = S2[i]; dst[(size_t)(96 + crow(i, hp)) * 256] = S3[i]; }
            }
        } else
        {}
    }
    SEC_END(12, lds)
    SEC_BEGIN(13)
    unsigned* qhead = (unsigned*)(kp.ws() + WS_CTL) + CW_CNT + 64 * li;
    volatile LAS unsigned* qslot = (volatile LAS unsigned*)(lds + LDS_BYTES - 8);
    const float* cw = kp.in(14) + (size_t)j * 4 * 3072; const float* stc = kp.in(3) + (size_t)j * 128 * 3 * 3072;
    const float* wa2 = kp.in(18) + (size_t)j * 16 * 512; const float* ba = kp.in(19) + (size_t)j * 512;
    for (;;) {
        __syncthreads();
        if (tid0 == 0) qslot[0] = __hip_atomic_fetch_add(qhead, 1u, __ATOMIC_RELAXED, __HIP_MEMORY_SCOPE_AGENT);
        __syncthreads();
        const int it = (int)qslot[0];
        if (it >= 1536) break;
        int tid = tid0; asm volatile("" : "+v"(tid));
        const int wave = tid >> 6, lane = tid & 63;
        if (it < 1024) {
            const int bs = it >> 3, h = it & 7, sq = 4 + bs, r0 = TP + bs * 4;
            LAS float* qL = (LAS float*)lds; LAS float* kL = qL + 512; LAS float* vL = kL + 512; LAS float* red = vL + 512; LAS float* sm = red + 4096;
            const int e = tid & 127, dq = tid >> 7;
            const size_t SZ = (size_t)8 * 128 * 128;
            const float* st = kp.in(2) + ((size_t)j * 128 + bs) * SZ + (size_t)h * 16384;
            float S[32];
            { const float* sp = st + (size_t)(dq * 32) * 128 + e;
#pragma unroll
              for (int i = 0; i < 32; ++i) { S[i] = *sp; sp += 128; asm volatile("" : "+v"(sp)); } }
#pragma unroll
            for (int part = 0; part < 3; ++part) { const int c = part * 1024 + h * 128 + e; float acc = 0.f;
#pragma unroll
                for (int tap = 0; tap < 4; ++tap) acc += cw[tap * 3072 + c] * pre_val(U, NAB, c, r0, dq - 3 + tap, sq, stc, 3072, c);
                if (part == 2) vL[dq * 128 + e] = silu_(acc); else (part == 0 ? qL : kL)[e * 4 + dq] = silu_(acc); }
            if (tid < 4) { const size_t ro = (size_t)(r0 + tid) * NAB;
                sm[32 + tid] = -__expf(kp.in(15)[j * 8 + h]) * softplus_(bf2f(U[ro + 7176 + h]) + kp.in(16)[j * 8 + h]); sm[36 + tid] = sigmoid_(bf2f(U[ro + 7168 + h])); }
            __syncthreads();
            { const int tk = wave & 3; LAS float* src = (wave >> 2) ? kL : qL; const float a = src[lane * 4 + tk], b = src[(lane + 64) * 4 + tk];
              const float sc = rsqrtf(wave_sum(a * a + b * b) + 1e-6f) * ((wave >> 2) ? 1.f : 0.08838834764831845f); src[lane * 4 + tk] = a * sc; src[(lane + 64) * 4 + tk] = b * sc; }
            __syncthreads();
#pragma unroll
            for (int q = 0; q < 4; ++q) { const int idx = wave * 4 + q, i = (idx >> 2) & 3, jj = idx & 3; const LAS float* src = idx < 16 ? kL : qL;
                const float dot = wave_sum(src[lane * 4 + i] * kL[lane * 4 + jj] + src[(lane + 64) * 4 + i] * kL[(lane + 64) * 4 + jj]); if (lane == 0) sm[idx] = dot; }
            float ks[4] = {0.f, 0.f, 0.f, 0.f}, qs[4] = {0.f, 0.f, 0.f, 0.f};
#pragma unroll
            for (int i = 0; i < 32; ++i) { const int d = dq * 32 + i; const float sv = S[i]; const f32x4 k4 = *(const LAS f32x4*)(kL + d * 4), q4 = *(const LAS f32x4*)(qL + d * 4);
#pragma unroll
                for (int t = 0; t < 4; ++t) { ks[t] += k4[t] * sv; qs[t] += q4[t] * sv; } }
#pragma unroll
            for (int t = 0; t < 4; ++t) { red[(t * 4 + dq) * 128 + e] = ks[t]; red[((4 + t) * 4 + dq) * 128 + e] = qs[t]; }
            __syncthreads();
            float Gc[4]; Gc[0] = sm[32]; Gc[1] = Gc[0] + sm[33]; Gc[2] = Gc[1] + sm[34]; Gc[3] = Gc[2] + sm[35];
            float u[4];
#pragma unroll
            for (int i = 0; i < 4; ++i) { const float KSi = (red[(i * 4 + 0) * 128 + e] + red[(i * 4 + 1) * 128 + e]) + (red[(i * 4 + 2) * 128 + e] + red[(i * 4 + 3) * 128 + e]);
                float acc = vL[i * 128 + e] - __expf(Gc[i]) * KSi;
#pragma unroll
                for (int jj = 0; jj < i; ++jj) acc -= sm[i * 4 + jj] * __expf(Gc[i] - Gc[jj]) * u[jj];
                u[i] = sm[36 + i] * acc; }
            if (dq == 0) {
#pragma unroll
                for (int i = 0; i < 4; ++i) { const float QSi = (red[((4 + i) * 4 + 0) * 128 + e] + red[((4 + i) * 4 + 1) * 128 + e]) + (red[((4 + i) * 4 + 2) * 128 + e] + red[((4 + i) * 4 + 3) * 128 + e]);
                    float o = __expf(Gc[i]) * QSi;
#pragma unroll
                    for (int jj = 0; jj <= i; ++jj) o += sm[16 + i * 4 + jj] * __expf(Gc[i] - Gc[jj]) * u[jj];
                    ODN[(size_t)(r0 + i) * 1024 + h * 128 + e] = (bf16)f2bf(o); } }
            const float eg = __expf(Gc[3]); float w[4];
#pragma unroll
            for (int jj = 0; jj < 4; ++jj) w[jj] = __expf(Gc[3] - Gc[jj]) * u[jj];
            float* dst = kp.out() + O_DN_S + ((size_t)j * 128 + bs) * SZ + (size_t)h * 16384 + (size_t)(dq * 32) * 128 + e;
#pragma unroll
            for (int i = 0; i < 32; ++i) { const int d = dq * 32 + i; float sv = eg * S[i]; const f32x4 k4 = *(const LAS f32x4*)(kL + d * 4);
#pragma unroll
                for (int jj = 0; jj < 4; ++jj) sv += k4[jj] * w[jj];
                *dst = sv; dst += 128; asm volatile("" : "+v"(dst)); }
        } else {
            const int q_ = it - 1024, bs = q_ >> 2, h = q_ & 3, r0 = TP + bs * 4;
            LAS float* qgL = (LAS float*)lds; LAS float* kaL = qgL + 512; LAS float* glL = kaL + 512; LAS float* egL = glL + 512; LAS float* Am = egL + 128; LAS float* red = Am + 16;
            const int e = tid & 255, dh = tid >> 8;
            const size_t SZ = (size_t)4 * 128 * 256;
            const float* st = kp.in(4) + ((size_t)j * 128 + bs) * SZ + (size_t)h * 32768;
            float S[64];
            { const float* sp = st + (size_t)(dh * 64) * 256 + e;
#pragma unroll
              for (int i = 0; i < 64; ++i) { S[i] = *sp; sp += 256; asm volatile("" : "+v"(sp)); } }
            float v[4];
#pragma unroll
            for (int t = 0; t < 4; ++t) v[t] = bf2f(U[(size_t)(r0 + t) * NAB + 5120 + h * 256 + e]);
            { const int d = tid & 127, tk = tid >> 7; const size_t ro = (size_t)(r0 + tk) * NAB;
              qgL[d * 4 + tk] = bf2f(U[ro + 4096 + h * 128 + d]) * 0.08838834764831845f; kaL[d * 4 + tk] = bf2f(U[ro + 4608 + h * 128 + d]);
              float x = ba[h * 128 + d];
#pragma unroll
              for (int rr = 0; rr < 16; ++rr) x += bf2f(U[ro + 7184 + rr]) * wa2[rr * 512 + h * 128 + d];
              glL[tk * 128 + d] = -softplus_(-x) * (1.f / 16.f); }
            __syncthreads();
            if (tid < 128) { float Gq = 0.f;
#pragma unroll
                for (int t = 0; t < 4; ++t) { Gq += glL[t * 128 + tid]; qgL[tid * 4 + t] *= __expf(Gq); kaL[tid * 4 + t] *= __expf(-Gq); }
                egL[tid] = __expf(Gq); }
            __syncthreads();
#pragma unroll
            for (int q = 0; q < 2; ++q) { const int idx = wave * 2 + q, i = idx >> 2, jj = idx & 3;
                const float dot = wave_sum(qgL[lane * 4 + i] * kaL[lane * 4 + jj] + qgL[(lane + 64) * 4 + i] * kaL[(lane + 64) * 4 + jj]); if (lane == 0) Am[idx] = dot; }
            float o[4] = {0.f, 0.f, 0.f, 0.f};
            float* dst = kp.out() + O_GLA_S + ((size_t)j * 128 + bs) * SZ + (size_t)h * 32768 + (size_t)(dh * 64) * 256 + e;
#pragma unroll
            for (int i = 0; i < 64; ++i) { const int d = dh * 64 + i; const float s0 = S[i]; float acc = s0; const f32x4 q4 = *(const LAS f32x4*)(qgL + d * 4), k4 = *(const LAS f32x4*)(kaL + d * 4);
#pragma unroll
                for (int t = 0; t < 4; ++t) { o[t] += q4[t] * s0; acc += k4[t] * v[t]; }
                *dst = egL[d] * acc; dst += 256; asm volatile("" : "+v"(dst)); }
#pragma unroll
            for (int t = 0; t < 4; ++t) red[(dh * 4 + t) * 256 + e] = o[t];
            __syncthreads();
            if (dh == 0) {
#pragma unroll
                for (int t = 0; t < 4; ++t) { float oo = red[t * 256 + e] + red[(4 + t) * 256 + e];
#pragma unroll
                    for (int jj = 0; jj <= t; ++jj) oo += Am[t * 4 + jj] * v[jj];
                    OGLA[(size_t)(r0 + t) * 1024 + h * 256 + e] = (bf16)f2bf(oo); } }
        }
    }
    SEC_END(13, lds)
}

__device__ __forceinline__ void phase_ab_post(const KP kp, const int bid, const int G, int j, int tid, int wave, int lane) {
    unsigned char* scr = kp.ws() + WS_SCR; const bf16* U = (const bf16*)(kp.ws() + WS_U); bf16* YM = (bf16*)(kp.ws() + WS_YM);
    const bf16* ODN = (const bf16*)(scr + SC_ODN); const bf16* OGLA = (const bf16*)(scr + SC_OGLA);
    const float* dnn = kp.in(17) + (size_t)j * 128; const float* glan = kp.in(20) + (size_t)j * 256;
    typedef float f32x2v __attribute__((ext_vector_type(2)));
    const f32x2v dg = *(const f32x2v*)(dnn + 2 * lane); const f32x4 gg = *(const f32x4*)(glan + 4 * lane);
    for (int idx = bid * NWAVES + wave; idx < T; idx += G * NWAVES) {
        const int gq_ = idx / 17, rq_ = idx - gq_ * 17, r = rq_ < 16 ? gq_ * 16 + rq_ : TP + gq_;
        int s, t; row_to_seq(r, s, t); int row0, L; seq_info(s, row0, L);
        const bf16* ur = U + (size_t)r * NAB; bf16* yr = YM + (size_t)r * DM;
        f32x2v od[8]; unsigned zd[8]; f32x4 og[4]; u32x2 zg[4];
#pragma unroll
        for (int hh = 0; hh < 8; ++hh) { const unsigned ow_ = *(const unsigned*)(ODN + (size_t)r * 1024 + hh * 128 + 2 * lane); od[hh] = (f32x2v){__uint_as_float(ow_ << 16), __uint_as_float(ow_ & 0xffff0000u)}; zd[hh] = *(const unsigned*)(ur + 3072 + hh * 128 + 2 * lane); }
#pragma unroll
        for (int hh = 0; hh < 4; ++hh) { const u32x2 ow_ = *(const u32x2*)(OGLA + (size_t)r * 1024 + hh * 256 + 4 * lane); og[hh] = (f32x4){__uint_as_float(ow_.x << 16), __uint_as_float(ow_.x & 0xffff0000u), __uint_as_float(ow_.y << 16), __uint_as_float(ow_.y & 0xffff0000u)}; zg[hh] = *(const u32x2*)(ur + 6144 + hh * 256 + 4 * lane); }
#pragma unroll
        for (int hh = 0; hh < 8; ++hh) { const f32x2v o = od[hh];
            const float rstd = rsqrtf(wave_sum(o.x * o.x + o.y * o.y) * (1.f / 128.f) + 1e-6f);
            const unsigned zz = zd[hh];
            *(unsigned*)(yr + hh * 128 + 2 * lane) = pk2(o.x * rstd * dg.x * silu_(__uint_as_float(zz << 16)), o.y * rstd * dg.y * silu_(__uint_as_float(zz & 0xffff0000u))); }
#pragma unroll
        for (int hh = 0; hh < 4; ++hh) { const f32x4 o = og[hh];
            const float rstd = rsqrtf(wave_sum((o.x * o.x + o.y * o.y) + (o.z * o.z + o.w * o.w)) * (1.f / 256.f) + 1e-6f);
            const u32x2 zz = zg[hh];
            u32x2 w; w.x = pk2(o.x * rstd * gg.x * silu_(__uint_as_float(zz.x << 16)), o.y * rstd * gg.y * silu_(__uint_as_float(zz.x & 0xffff0000u)));
            w.y = pk2(o.z * rstd * gg.z * silu_(__uint_as_float(zz.y << 16)), o.w * rstd * gg.w * silu_(__uint_as_float(zz.y & 0xffff0000u)));
            *(u32x2*)(yr + 1024 + hh * 256 + 4 * lane) = w; }
        if (t >= L - 3) { const int rr = t - (L - 3);
            float* dst = s < 4 ? kp.out() + O_DNC_P + (((size_t)j * 4 + s) * 3 + rr) * 3072 : kp.out() + O_DNC_S + (((size_t)j * 128 + (s - 4)) * 3 + rr) * 3072;
            for (int c = 2 * lane; c < 3072; c += 128) { const unsigned uu = *(const unsigned*)(ur + c); *(f32x2v*)(dst + c) = (f32x2v){__uint_as_float(uu << 16), __uint_as_float(uu & 0xffff0000u)}; } }
    }
}

__device__ __forceinline__ void phase_lru_gates(const KP kp, const int bid, const int G, int j, LAS unsigned char* lds, int tid0) {
    unsigned char* scr = kp.ws() + WS_SCR; const bf16* U = (const bf16*)(kp.ws() + WS_U);
    float* LA = (float*)(scr + SC_LA); float* LB = (float*)(scr + SC_LB);
    const float* lcw = kp.in(29) + (size_t)j * 4 * 1024; const float* lcb = kp.in(30) + (size_t)j * 1024; const float* lstc = kp.in(8) + (size_t)j * 128 * 3 * 1024;
    const int n = bid & 15;
    const float* wa = kp.in(31) + ((size_t)j * 16 + n) * 4096; const float* wx = kp.in(33) + ((size_t)j * 16 + n) * 4096;
    const float* lba = kp.in(32) + (size_t)j * 1024; const float* lbx = kp.in(34) + (size_t)j * 1024; const float* lam = kp.in(35) + (size_t)j * 1024;
    LAS bf16x8* WF = (LAS bf16x8*)lds;
    LAS float* xcL = (LAS float*)(lds + 16384);
    LAS float* igL = xcL + 64 * 68;
    __syncthreads();
    { const int lane = tid0 & 63, f = tid0 >> 6, r = lane & 31, hp = lane >> 5, nt = f >> 2, ks = f & 3; float v[8];
#pragma unroll
      for (int jp = 0; jp < 8; ++jp) v[jp] = wa[(16 * ks + 8 * hp + jp) * 64 + 32 * nt + r];
      WF[f * 64 + lane] = pack8(v);
#pragma unroll
      for (int jp = 0; jp < 8; ++jp) v[jp] = wx[(16 * ks + 8 * hp + jp) * 64 + 32 * nt + r];
      WF[512 + f * 64 + lane] = pack8(v); }
    for (int tile = bid >> 4; tile < T / 64; tile += (G >> 4)) {
        int tid = tid0; asm volatile("" : "+v"(tid));
        const int c = tid & 63, tq = tid >> 6, ch = n * 64 + c, rowbase = tile * 64;
        __syncthreads();
        if (tile < TP / 64) {
            const int r0 = rowbase + tq * 8; const bool first = ((r0 & 2047) == 0);
            const float w0 = lcw[ch], w1 = lcw[1024 + ch], w2 = lcw[2048 + ch], w3 = lcw[3072 + ch], bb = lcb[ch];
            const bf16* up = U + (size_t)r0 * NCD + 3584 + ch;
            const long fo = first ? 0 : (long)NCD;
              float x0 = bf2f(up[-3 * fo]), x1 = bf2f(up[-2 * fo]), x2 = bf2f(up[-1 * fo]); if (first) { x0 = 0.f; x1 = 0.f; x2 = 0.f; }
#pragma unroll
            for (int tt = 0; tt < 8; ++tt) { const float x3 = bf2f(up[(size_t)tt * NCD]); xcL[(tq * 8 + tt) * 68 + c] = bb + w0 * x0 + w1 * x1 + w2 * x2 + w3 * x3; x0 = x1; x1 = x2; x2 = x3; }
        } else {
#pragma unroll 2
            for (int tt = 0; tt < 8; ++tt) { const int r = rowbase + tq * 8 + tt; int s, t; row_to_seq(r, s, t); const int row0 = r - t; float acc = lcb[ch];
#pragma unroll
                for (int tap = 0; tap < 4; ++tap) acc += lcw[tap * 1024 + ch] * pre_val(U, NCD, 3584 + ch, row0, t - 3 + tap, s, lstc, 1024, ch);
                xcL[(tq * 8 + tt) * 68 + c] = acc; }
        }
        __syncthreads();
        const int wave = __builtin_amdgcn_readfirstlane(tid >> 6), lane = tid & 63, r = lane & 31, hp = lane >> 5, mat = wave >> 2, mt = (wave >> 1) & 1, nt = wave & 1;
        f32x16 acc;
#pragma unroll
        for (int i = 0; i < 16; ++i) acc[i] = 0.f;
#pragma unroll
        for (int ks = 0; ks < 4; ++ks) { const LAS float* xp = xcL + (32 * mt + r) * 68 + 16 * ks + 8 * hp; const f32x4 xa = *(const LAS f32x4*)xp, xb = *(const LAS f32x4*)(xp + 4);
            const bf16x8 af = __builtin_bit_cast(bf16x8, (u32x4){cvtpk(xa.x, xa.y), cvtpk(xa.z, xa.w), cvtpk(xb.x, xb.y), cvtpk(xb.z, xb.w)});
            acc = MFMA32(af, WF[mat * 512 + (nt * 4 + ks) * 64 + lane], acc); }
        const int chh = n * 64 + 32 * nt + r;
        if (mat == 1) { const float bx = lbx[chh];
#pragma unroll
            for (int i = 0; i < 16; ++i) igL[(32 * mt + crow(i, hp)) * 65 + 32 * nt + r] = sigmoid_(acc[i] + bx); }
        __syncthreads();
        if (mat == 0) { const float ba = lba[chh], spl = softplus_(-lam[chh]);
#pragma unroll
            for (int i = 0; i < 16; ++i) { const int tk = 32 * mt + crow(i, hp); const size_t ro = (size_t)(rowbase + tk) * 1024 + chh;
                const float log_a = -8.f * sigmoid_(acc[i] + ba) * spl;
                LA[ro] = __expf(log_a); LB[ro] = __builtin_amdgcn_sqrtf(1.f - __expf(2.f * log_a)) * (igL[tk * 65 + 32 * nt + r] * xcL[tk * 68 + 32 * nt + r]); } }
    }
}

constexpr size_t SSD_ITEM_BYTES = 33792;
__device__ __forceinline__ void phase_ssd_prep(const KP kp, const int bid, const int G, int j, LAS unsigned char* lds, int tid0) {
    unsigned char* scr = kp.ws() + WS_SCR;
    const bf16* U = (const bf16*)(kp.ws() + WS_U); bf16* XS = (bf16*)(scr + SC_XS);
    const float* cw = kp.in(23) + (size_t)j * 4 * 1536; const float* cb = kp.in(24) + (size_t)j * 1536;
    unsigned char* OPS = scr + SC_SSDOP;
    LAS float* GL = (LAS float*)lds; LAS float* DTL = GL + 256; LAS float* QK = DTL + 256; LAS bf16* Cb = (LAS bf16*)(QK + 64 * 65); LAS bf16* Bb = Cb + 64 * 72; LAS float* XLs = (LAS float*)(Bb + 64 * 72);
    const float* alog = kp.in(25) + j * 16;
    for (int item = bid; item < 512; item += G) {
        int tid = tid0; asm volatile("" : "+v"(tid));
        const int wave = tid >> 6, lane = tid & 63, r = lane & 31, hp = lane >> 5;
        const int b = item >> 7, n = (item >> 2) & 31, g = item & 3;
        const int row0 = b * 2048 + n * 64;
        __syncthreads();
        {
          const int t0 = 8 * wave; const bool first = (n == 0 && wave == 0); const long fo = first ? 0 : (long)NCD;
#pragma unroll
          for (int q = 0; q < 3; ++q) { const int k = 2 * (lane + 64 * q);
              const int cidx = k < 64 ? 1024 + g * 64 + k : (k < 128 ? 1280 + g * 64 + (k - 64) : g * 256 + (k - 128));
              const float w0a = cw[cidx], w0b = cw[cidx + 1], w1a = cw[1536 + cidx], w1b = cw[1536 + cidx + 1], w2a = cw[2 * 1536 + cidx], w2b = cw[2 * 1536 + cidx + 1], w3a = cw[3 * 1536 + cidx], w3b = cw[3 * 1536 + cidx + 1];
              const float ba = cb[cidx], bb = cb[cidx + 1];
              const bf16* up = U + (size_t)(row0 + t0) * NCD + 1024 + cidx;
              unsigned raw[11];
              raw[0] = *(const unsigned*)(up - 3 * fo); raw[1] = *(const unsigned*)(up - 2 * fo); raw[2] = *(const unsigned*)(up - 1 * fo);
#pragma unroll
              for (int t = 0; t < 8; ++t) raw[3 + t] = *(const unsigned*)(up + (size_t)t * NCD);
              if (first) { raw[0] = 0u; raw[1] = 0u; raw[2] = 0u; }
#pragma unroll
              for (int t = 0; t < 8; ++t) {
                  const float ya = silu_(ba + w0a * __uint_as_float(raw[t] << 16) + w1a * __uint_as_float(raw[t + 1] << 16) + w2a * __uint_as_float(raw[t + 2] << 16) + w3a * __uint_as_float(raw[t + 3] << 16));
                  const float yb = silu_(bb + w0b * __uint_as_float(raw[t] & 0xffff0000u) + w1b * __uint_as_float(raw[t + 1] & 0xffff0000u) + w2b * __uint_as_float(raw[t + 2] & 0xffff0000u) + w3b * __uint_as_float(raw[t + 3] & 0xffff0000u));
                  if (q == 0) { if (k < 64) *(LAS unsigned*)(Bb + (t0 + t) * 72 + k) = pk2(ya, yb); else *(LAS unsigned*)(Cb + (t0 + t) * 72 + (k - 64)) = pk2(ya, yb); }
                  else { XLs[(t0 + t) * 257 + (k - 128)] = ya; XLs[(t0 + t) * 257 + (k - 128) + 1] = yb; } } } }
        if (wave < 4) { const int h = g * 4 + wave; const float dt = softplus_(bf2f(U[(size_t)(row0 + lane) * NCD + 4608 + h]) + kp.in(26)[j * 16 + h]);
            DTL[wave * 64 + lane] = dt; float gv = -__expf(alog[h]) * dt;
#pragma unroll
            for (int o = 1; o < 64; o <<= 1) { const float tt = __shfl_up(gv, o); if (lane >= o) gv += tt; }
            GL[wave * 64 + lane] = gv; }
        __syncthreads();
        if (wave < 4) {
            const int mt = wave >> 1, nt = wave & 1;
            f32x16 acc;
#pragma unroll
            for (int i = 0; i < 16; ++i) acc[i] = 0.f;
#pragma unroll
            for (int ks = 0; ks < 4; ++ks) acc = MFMA32(*(const LAS bf16x8*)(Cb + (32 * mt + r) * 72 + 16 * ks + 8 * hp), *(const LAS bf16x8*)(Bb + (32 * nt + r) * 72 + 16 * ks + 8 * hp), acc);
#pragma unroll
            for (int i16 = 0; i16 < 16; ++i16) QK[(32 * mt + crow(i16, hp)) * 65 + 32 * nt + r] = acc[i16];
        } else {
            for (int i = tid - 256; i < 8192; i += 256) { const int t = i >> 7, k2 = i & 127;
                ((unsigned*)XS)[((size_t)(row0 + t) * 1024 + g * 256) / 2 + k2] = pk2(XLs[t * 257 + 2 * k2], XLs[t * 257 + 2 * k2 + 1]); }
        }
        __syncthreads();
        const int f = wave, mt = f >> 2, ks = f & 3;
        for (int hh = 0; hh < 4; ++hh) {
            const int h = g * 4 + hh; const LAS float* Gh = GL + hh * 64; const float Gend = Gh[63];
            bf16x8* base = (bf16x8*)(OPS + ((size_t)((b * 32 + n) * 16 + h)) * SSD_ITEM_BYTES);
            float v[8];
            { const int i = 32 * mt + r; const float eg = __expf(Gh[i]);
#pragma unroll
              for (int jp = 0; jp < 8; ++jp) { const int d = 16 * ks + 8 * (jp >> 2) + 4 * hp + (jp & 3); v[jp] = bf2f(Cb[i * 72 + d]) * eg; }
              base[0 * 512 + f * 64 + lane] = pack8(v); }
            { const int d = 32 * mt + r;
#pragma unroll
              for (int jp = 0; jp < 8; ++jp) { const int tk = 16 * ks + 8 * (jp >> 2) + 4 * hp + (jp & 3); v[jp] = bf2f(Bb[tk * 72 + d]) * __expf(Gend - Gh[tk]); }
              base[1 * 512 + f * 64 + lane] = pack8(v); }
            { const int i = 32 * mt + r; const float gi = Gh[i];
#pragma unroll
              for (int jp = 0; jp < 8; ++jp) { const int jt = 16 * ks + 8 * (jp >> 2) + 4 * hp + (jp & 3); v[jp] = jt <= i ? QK[i * 65 + jt] * __expf(gi - Gh[jt]) : 0.f; }
              base[2 * 512 + f * 64 + lane] = pack8(v); }
            { const int p = 32 * mt + r;
#pragma unroll
              for (int jp = 0; jp < 8; ++jp) { const int tk = 16 * ks + 8 * (jp >> 2) + 4 * hp + (jp & 3);
                  v[jp] = XLs[tk * 257 + hh * 64 + p] * DTL[hh * 64 + tk]; }
              base[3 * 512 + f * 64 + lane] = pack8(v); }
            if (tid == 0) *(float*)(base + 32 * 64) = __expf(Gend);
        }
    }
}

__device__ __forceinline__ void phase_cd_rec(const KP kp, const int bid, const int G, int j, int li, LAS unsigned char* lds, int tid0) {
    unsigned char* scr = kp.ws() + WS_SCR; const bf16* U = (const bf16*)(kp.ws() + WS_U);
    const float* LA = (const float*)(scr + SC_LA); const float* LB = (const float*)(scr + SC_LB);
    bf16* YS = (bf16*)(scr + SC_YS); bf16* HS = (bf16*)(scr + SC_HS); bf16* XS = (bf16*)(scr + SC_XS);
    SEC_BEGIN(10)
    for (int item = bid; item < 64; item += G) {
        int tid = tid0; asm volatile("" : "+v"(tid));
        const int b = item >> 4, hd = item & 15;
        __syncthreads();
        const int wave = __builtin_amdgcn_readfirstlane(tid >> 6), lane = tid & 63, r = lane & 31, hp = lane >> 5, nt = wave;
        const unsigned char* OPS = scr + SC_SSDOP;
        const bool dmaw = (wave >= 2 && wave < 6);
        constexpr int SLOT = 33 * 1024;
#define SSD_DMA(n_) do { if (dmaw) { const unsigned char* gi_ = OPS + ((size_t)((b * 32 + (n_)) * 16 + hd)) * SSD_ITEM_BYTES + lane * 16; \
            _Pragma("unroll") for (int q_ = 0; q_ < 9; ++q_) { const int lf_ = q_ < 8 ? (wave - 2) * 8 + q_ : 32; \
                __builtin_amdgcn_global_load_lds((const unsigned*)(gi_ + lf_ * 1024), (LAS unsigned*)(lds + ((n_) & 3) * SLOT + lf_ * 1024), 16, 0, 2); } } } while (0)
        f32x16 S0, S1;
#pragma unroll
        for (int i = 0; i < 16; ++i) { S0[i] = 0.f; S1[i] = 0.f; }
        SSD_DMA(0); SSD_DMA(1); SSD_DMA(2);
        if (dmaw) asm volatile("s_waitcnt vmcnt(18)" ::: "memory");
        asm volatile("" ::: "memory"); __builtin_amdgcn_s_barrier(); asm volatile("" ::: "memory");
        for (int n = 0; n < 32; ++n) {
            if (n + 3 < 32) SSD_DMA(n + 3);
            if (wave < 2) {
                const LAS bf16x8* F = (const LAS bf16x8*)(lds + (n & 3) * SLOT) + lane;
                bf16x8 vb[4];
#pragma unroll
                for (int ks = 0; ks < 4; ++ks) vb[ks] = F[(24 + nt * 4 + ks) * 64];
                const float gend = *(const LAS float*)(lds + (n & 3) * SLOT + 32 * 1024);
                const bf16x8 sb00 = PACK_ACC(S0, 0), sb01 = PACK_ACC(S0, 1), sb10 = PACK_ACC(S1, 0), sb11 = PACK_ACC(S1, 1);
                f32x16 O0, O1;
#pragma unroll
                for (int i = 0; i < 16; ++i) { O0[i] = 0.f; O1[i] = 0.f; }
                O0 = MFMA32(F[0 * 64], sb00, O0); O0 = MFMA32(F[1 * 64], sb01, O0); O0 = MFMA32(F[2 * 64], sb10, O0); O0 = MFMA32(F[3 * 64], sb11, O0);
                O1 = MFMA32(F[4 * 64], sb00, O1); O1 = MFMA32(F[5 * 64], sb01, O1); O1 = MFMA32(F[6 * 64], sb10, O1); O1 = MFMA32(F[7 * 64], sb11, O1);
                O0 = MFMA32(F[16 * 64], vb[0], O0); O0 = MFMA32(F[17 * 64], vb[1], O0);
#pragma unroll
                for (int ks = 0; ks < 4; ++ks) O1 = MFMA32(F[(20 + ks) * 64], vb[ks], O1);
#pragma unroll
                for (int i = 0; i < 16; ++i) { S0[i] *= gend; S1[i] *= gend; }
#pragma unroll
                for (int ks = 0; ks < 4; ++ks) { S0 = MFMA32(F[(8 + ks) * 64], vb[ks], S0); S1 = MFMA32(F[(12 + ks) * 64], vb[ks], S1); }
                bf16* yo = YS + (size_t)(b * 2048 + n * 64) * 1024 + hd * 64 + 32 * nt + r;
#pragma unroll
                for (int i = 0; i < 16; ++i) { yo[(size_t)crow(i, hp) * 1024] = (bf16)f2bf(O0[i]); yo[(size_t)(32 + crow(i, hp)) * 1024] = (bf16)f2bf(O1[i]); }
            }
            if (dmaw) { if (n + 3 < 32) asm volatile("s_waitcnt vmcnt(18)" ::: "memory"); else if (n + 2 < 32) asm volatile("s_waitcnt vmcnt(9)" ::: "memory"); else asm volatile("s_waitcnt vmcnt(0)" ::: "memory"); }
            asm volatile("s_waitcnt lgkmcnt(0)" ::: "memory"); __builtin_amdgcn_s_barrier(); asm volatile("" ::: "memory");
        }
#undef SSD_DMA
        if (wave < 2) {
            float* dst = kp.out() + O_SSD_P + ((size_t)j * 4 + b) * ((size_t)16 * 64 * 64) + (size_t)hd * 64 * 64 + 32 * nt + r;
#pragma unroll
            for (int i = 0; i < 16; ++i) { dst[(size_t)crow(i, hp) * 64] = S0[i]; dst[(size_t)(32 + crow(i, hp)) * 64] = S1[i]; }
        }
    }
    SEC_END(10, lds)
    SEC_BEGIN(11)
    unsigned* qhead = (unsigned*)(kp.ws() + WS_CTL) + CW_CNT + 64 * li;
    volatile LAS unsigned* qslot = (volatile LAS unsigned*)(lds + LDS_BYTES - 8);
    const float* cw = kp.in(23) + (size_t)j * 4 * 1536; const float* cb = kp.in(24) + (size_t)j * 1536; const float* stc = kp.in(6) + (size_t)j * 128 * 3 * 1536;
    for (;;) {
        __syncthreads();
        if (tid0 == 0) qslot[0] = __hip_atomic_fetch_add(qhead, 1u, __ATOMIC_RELAXED, __HIP_MEMORY_SCOPE_AGENT);
        __syncthreads();
        const int it = (int)qslot[0];
        if (it >= 1024) break;
        int tid = tid0; asm volatile("" : "+v"(tid));
        if (it < 256) {
            const int s = it >> 6, h = it & 63; int row0, L; seq_info(s, row0, L);
            LAS float* Al = (LAS float*)lds; LAS float* Bl = Al + 512;
            const int chunk = tid >> 4, c16 = tid & 15, ch = h * 16 + c16;
            const size_t ro = (size_t)(row0 + chunk * 64) * 1024 + ch;
            float av[64], bv[64];
            { const float* pa = LA + ro; const float* pb = LB + ro;
#pragma unroll
              for (int t = 0; t < 64; ++t) { av[t] = *pa; bv[t] = *pb; pa += 1024; pb += 1024; asm volatile("" : "+v"(pa), "+v"(pb)); } }
            float Ap = 1.f, Bp = 0.f;
#pragma unroll
            for (int t = 0; t < 64; ++t) { Bp = av[t] * Bp + bv[t]; Ap *= av[t]; }
            Al[tid] = Ap; Bl[tid] = Bp;
            __syncthreads();
            float hh = 0.f;
            for (int m = 0; m < chunk; ++m) hh = Al[m * 16 + c16] * hh + Bl[m * 16 + c16];
            { bf16* ph = HS + ro;
#pragma unroll
              for (int t = 0; t < 64; ++t) { hh = av[t] * hh + bv[t]; *ph = (bf16)f2bf(hh); ph += 1024; asm volatile("" : "+v"(ph)); } }
            if (chunk == 31) kp.out()[O_LRU_P + ((size_t)j * 4 + s) * 1024 + ch] = hh;
        } else if (it < 768) {
            const int q_ = it - 256, bs = q_ >> 2, g = q_ & 3, sq = 4 + bs, r0 = TP + bs * 4;
            LAS float* BL = (LAS float*)lds; LAS float* CL = BL + 256; LAS float* XL = CL + 256; LAS float* DTL = XL + 1024; LAS float* QKs = DTL + 16; LAS float* red = QKs + 16;
            const int wave = tid >> 6, lane = tid & 63, hh = tid >> 7, nh = (tid >> 6) & 1, p = tid & 63, hd = 4 * g + hh;
            const size_t SZ = (size_t)16 * 64 * 64;
            const float* st = kp.in(5) + ((size_t)j * 128 + bs) * SZ + (size_t)hd * 4096;
            float S[32];
            { const float* sp = st + (size_t)(nh * 32) * 64 + p;
#pragma unroll
              for (int i = 0; i < 32; ++i) { S[i] = *sp; sp += 64; asm volatile("" : "+v"(sp)); } }
            { const int ci = tid & 127, tk = tid >> 7;
#pragma unroll
              for (int q = 0; q < 3; ++q) { const int k = ci + 128 * q; int cidx; LAS float* dst;
                  if (k < 64) { cidx = 1024 + g * 64 + k; dst = BL + k * 4 + tk; } else if (k < 128) { cidx = 1280 + g * 64 + (k - 64); dst = CL + (k - 64) * 4 + tk; } else { cidx = g * 256 + (k - 128); dst = XL + tk * 256 + (k - 128); }
                  float acc = cb[cidx];
#pragma unroll
                  for (int tap = 0; tap < 4; ++tap) acc += cw[tap * 1536 + cidx] * pre_val(U, NCD, 1024 + cidx, r0, tk - 3 + tap, sq, stc, 1536, cidx);
                  *dst = silu_(acc); } }
            if (tid < 16) { const int tk = tid >> 2, h2 = tid & 3; DTL[tid] = softplus_(bf2f(U[(size_t)(r0 + tk) * NCD + 4608 + 4 * g + h2]) + kp.in(26)[j * 16 + 4 * g + h2]); }
            __syncthreads();
#pragma unroll
            for (int q = 0; q < 2; ++q) { const int idx = wave * 2 + q, i = idx >> 2, jj = idx & 3; const float dot = wave_sum(CL[lane * 4 + i] * BL[lane * 4 + jj]); if (lane == 0) QKs[idx] = dot; }
            { const int tk = tid >> 7, k2 = tid & 127; ((unsigned*)XS)[((size_t)(r0 + tk) * 1024 + g * 256) / 2 + k2] = pk2(XL[tk * 256 + 2 * k2], XL[tk * 256 + 2 * k2 + 1]); }
            const float negA = -__expf(kp.in(25)[j * 16 + hd]);
            float Gc[4], xd[4], w[4];
            Gc[0] = negA * DTL[hh]; Gc[1] = Gc[0] + negA * DTL[4 + hh]; Gc[2] = Gc[1] + negA * DTL[8 + hh]; Gc[3] = Gc[2] + negA * DTL[12 + hh];
#pragma unroll
            for (int jj = 0; jj < 4; ++jj) { xd[jj] = XL[jj * 256 + hh * 64 + p] * DTL[jj * 4 + hh]; w[jj] = __expf(Gc[3] - Gc[jj]) * xd[jj]; }
            const float eg = __expf(Gc[3]);
            float o[4] = {0.f, 0.f, 0.f, 0.f};
            float* dst = kp.out() + O_SSD_S + ((size_t)j * 128 + bs) * SZ + (size_t)hd * 4096 + (size_t)(nh * 32) * 64 + p;
#pragma unroll
            for (int i = 0; i < 32; ++i) { const int n = nh * 32 + i; const float s0 = S[i]; float acc = eg * s0; const f32x4 c4 = *(const LAS f32x4*)(CL + n * 4), b4 = *(const LAS f32x4*)(BL + n * 4);
#pragma unroll
                for (int t = 0; t < 4; ++t) { o[t] += c4[t] * s0; acc += b4[t] * w[t]; }
                *dst = acc; dst += 64; asm volatile("" : "+v"(dst)); }
#pragma unroll
            for (int t = 0; t < 4; ++t) red[((hh * 2 + nh) * 4 + t) * 64 + p] = o[t];
            __syncthreads();
            if (nh == 0) {
#pragma unroll
                for (int t = 0; t < 4; ++t) { float y = __expf(Gc[t]) * (red[((hh * 2) * 4 + t) * 64 + p] + red[((hh * 2 + 1) * 4 + t) * 64 + p]);
#pragma unroll
                    for (int jj = 0; jj <= t; ++jj) y += QKs[t * 4 + jj] * __expf(Gc[t] - Gc[jj]) * xd[jj];
                    YS[(size_t)(r0 + t) * 1024 + hd * 64 + p] = (bf16)f2bf(y); } }
        } else {
            const int q_ = it - 768, s = 4 + (q_ >> 1), h = q_ & 1; int row0, L; seq_info(s, row0, L);
            const int ch = h * 512 + tid;
            float hh = s < 4 ? 0.f : kp.in(7)[((size_t)j * 128 + (s - 4)) * 1024 + ch];
#pragma unroll 8
            for (int t = 0; t < L; ++t) { const size_t r = (size_t)(row0 + t); hh = LA[r * 1024 + ch] * hh + LB[r * 1024 + ch]; HS[r * 1024 + ch] = (bf16)f2bf(hh); }
            float* dst = s < 4 ? kp.out() + O_LRU_P + ((size_t)j * 4 + s) * 1024 : kp.out() + O_LRU_S + ((size_t)j * 128 + (s - 4)) * 1024;
            dst[ch] = hh;
        }
    }
    SEC_END(11, lds)
}

__device__ __forceinline__ void phase_cd_post(const KP kp, const int bid, const int G, int j, int tid, int wave, int lane) {
    unsigned char* scr = kp.ws() + WS_SCR; const bf16* U = (const bf16*)(kp.ws() + WS_U); bf16* YM = (bf16*)(kp.ws() + WS_YM);
    const bf16* YS = (const bf16*)(scr + SC_YS); const bf16* HS = (const bf16*)(scr + SC_HS); const bf16* XS = (const bf16*)(scr + SC_XS);
    const float* sn = kp.in(28) + (size_t)j * 1024; const float* Dv = kp.in(27) + (size_t)j * 16;
    typedef float f32x2v __attribute__((ext_vector_type(2)));
    for (int idx = bid * NWAVES + wave; idx < T; idx += G * NWAVES) {
        const int gq_ = idx / 17, rq_ = idx - gq_ * 17, r = rq_ < 16 ? gq_ * 16 + rq_ : TP + gq_;
        int s, t; row_to_seq(r, s, t); int row0, L; seq_info(s, row0, L);
        const bf16* ur = U + (size_t)r * NCD; bf16* yr = YM + (size_t)r * DM;
        f32x4 ysv[4], hsv[4]; u32x2 xxv[4], zzv[4], zlv[4];
#pragma unroll
        for (int gq = 0; gq < 4; ++gq) { const int e = gq * 256 + 4 * lane; { const u32x2 yw_ = *(const u32x2*)(YS + (size_t)r * 1024 + e); ysv[gq] = (f32x4){__uint_as_float(yw_.x << 16), __uint_as_float(yw_.x & 0xffff0000u), __uint_as_float(yw_.y << 16), __uint_as_float(yw_.y & 0xffff0000u)}; } xxv[gq] = *(const u32x2*)(XS + (size_t)r * 1024 + e); zzv[gq] = *(const u32x2*)(ur + e);
            { const u32x2 hw_ = *(const u32x2*)(HS + (size_t)r * 1024 + e); hsv[gq] = (f32x4){__uint_as_float(hw_.x << 16), __uint_as_float(hw_.x & 0xffff0000u), __uint_as_float(hw_.y << 16), __uint_as_float(hw_.y & 0xffff0000u)}; } zlv[gq] = *(const u32x2*)(ur + 2560 + e); }
#pragma unroll
        for (int gq = 0; gq < 4; ++gq) { const int e = gq * 256 + 4 * lane; const f32x4 ys = ysv[gq];
            const u32x2 xx = xxv[gq], zz = zzv[gq]; const float Dh = Dv[e >> 6];
            f32x4 y; y.x = (ys.x + Dh * __uint_as_float(xx.x << 16)) * silu_(__uint_as_float(zz.x << 16)); y.y = (ys.y + Dh * __uint_as_float(xx.x & 0xffff0000u)) * silu_(__uint_as_float(zz.x & 0xffff0000u));
            y.z = (ys.z + Dh * __uint_as_float(xx.y << 16)) * silu_(__uint_as_float(zz.y << 16)); y.w = (ys.w + Dh * __uint_as_float(xx.y & 0xffff0000u)) * silu_(__uint_as_float(zz.y & 0xffff0000u));
            const float rstd = rsqrtf(wave_sum((y.x * y.x + y.y * y.y) + (y.z * y.z + y.w * y.w)) * (1.f / 256.f) + 1e-6f);
            const f32x4 g4 = *(const f32x4*)(sn + e);
            u32x2 w; w.x = pk2(y.x * rstd * g4.x, y.y * rstd * g4.y); w.y = pk2(y.z * rstd * g4.z, y.w * rstd * g4.w); *(u32x2*)(yr + e) = w; }
#pragma unroll
        for (int gq = 0; gq < 4; ++gq) { const int ch = gq * 256 + 4 * lane; const f32x4 hs = hsv[gq]; const u32x2 zz = zlv[gq];
            u32x2 w; w.x = pk2(hs.x * silu_(__uint_as_float(zz.x << 16)), hs.y * silu_(__uint_as_float(zz.x & 0xffff0000u))); w.y = pk2(hs.z * silu_(__uint_as_float(zz.y << 16)), hs.w * silu_(__uint_as_float(zz.y & 0xffff0000u)));
            *(u32x2*)(yr + 1024 + ch) = w; }
        if (t >= L - 3) { const int rr = t - (L - 3);
            float* d1 = s < 4 ? kp.out() + O_SSDC_P + (((size_t)j * 4 + s) * 3 + rr) * 1536 : kp.out() + O_SSDC_S + (((size_t)j * 128 + (s - 4)) * 3 + rr) * 1536;
            for (int c = 2 * lane; c < 1536; c += 128) { const unsigned uu = *(const unsigned*)(ur + 1024 + c); *(f32x2v*)(d1 + c) = (f32x2v){__uint_as_float(uu << 16), __uint_as_float(uu & 0xffff0000u)}; }
            float* d2 = s < 4 ? kp.out() + O_LRUC_P + (((size_t)j * 4 + s) * 3 + rr) * 1024 : kp.out() + O_LRUC_S + (((size_t)j * 128 + (s - 4)) * 3 + rr) * 1024;
            for (int c = 2 * lane; c < 1024; c += 128) { const unsigned uu = *(const unsigned*)(ur + 3584 + c); *(f32x2v*)(d2 + c) = (f32x2v){__uint_as_float(uu << 16), __uint_as_float(uu & 0xffff0000u)}; } }
    }
}


typedef float f32x4m __attribute__((ext_vector_type(4)));
template <bool GATE>
__device__ __forceinline__ void sample_gemm_res(LAS unsigned char* lds, const bf16* Amat, const bf16* Bt, const bf16* Hin, bf16* Hout, float* rss_out, const bf16* PP, const float* rss_in, int bid, int tid) {
    if (bid >= 256) return;
    const int wave = tid >> 6, lane = tid & 63, lr = lane & 15, kg = lane >> 4;
    const int m0 = TP + (bid & 7) * 64, n0 = (bid >> 3) * 64;
    const bf16x8* ap = (const bf16x8*)(Amat + (size_t)(m0 + lr) * 2048 + wave * 256 + 8 * kg);
    const bf16x8* bp = (const bf16x8*)(Bt + (size_t)(n0 + lr) * 2048 + wave * 256 + 8 * kg);
    f32x4m acc[4][4];
#pragma unroll
    for (int mi = 0; mi < 4; ++mi)
#pragma unroll
        for (int ni = 0; ni < 4; ++ni) acc[mi][ni] = (f32x4m){0.f, 0.f, 0.f, 0.f};
#pragma unroll 2
    for (int ks = 0; ks < 8; ++ks) { bf16x8 a[4], b[4];
#pragma unroll
        for (int q = 0; q < 4; ++q) { a[q] = ap[(size_t)q * 16 * 256 + ks * 4]; b[q] = bp[(size_t)q * 16 * 256 + ks * 4]; }
#pragma unroll
        for (int mi = 0; mi < 4; ++mi)
#pragma unroll
            for (int ni = 0; ni < 4; ++ni) acc[mi][ni] = __builtin_amdgcn_mfma_f32_16x16x32_bf16(a[mi], b[ni], acc[mi][ni], 0, 0, 0); }
    LAS float* red = (LAS float*)lds;
    __syncthreads();
#pragma unroll
    for (int mi = 0; mi < 4; ++mi)
#pragma unroll
        for (int ni = 0; ni < 4; ++ni)
#pragma unroll
            for (int i = 0; i < 4; ++i) red[(wave * 64 + 16 * mi + kg * 4 + i) * 65 + 16 * ni + lr] = acc[mi][ni][i];
    __syncthreads();
    { const int row = tid >> 3, c8 = (tid & 7) * 8, grow = m0 + row; float v[8];
#pragma unroll
      for (int e = 0; e < 8; ++e) { float sacc = 0.f;
#pragma unroll
          for (int w = 0; w < 8; ++w) sacc += red[(w * 64 + row) * 65 + c8 + e];
          v[e] = sacc; }
      float sc = 1.f; if (GATE) sc = rsqrtf(rss_in[grow] * (1.f / 2048.f) + 1e-6f);
      const size_t p = (size_t)grow * 2048 + n0 + c8;
      const u32x4 hw = *(const u32x4*)(Hin + p); u32x4 pw = (u32x4){0u, 0u, 0u, 0u}; if (GATE) pw = *(const u32x4*)(PP + p);
      const unsigned hws[4] = {hw.x, hw.y, hw.z, hw.w}, pws[4] = {pw.x, pw.y, pw.z, pw.w}; unsigned ow[4]; float sq = 0.f;
#pragma unroll
      for (int e2 = 0; e2 < 4; ++e2) { float h0 = __uint_as_float(hws[e2] << 16), h1 = __uint_as_float(hws[e2] & 0xffff0000u);
          if (GATE) { h0 += __builtin_amdgcn_rcpf(1.f + __expf(-sc * v[2 * e2])) * __uint_as_float(pws[e2] << 16); h1 += __builtin_amdgcn_rcpf(1.f + __expf(-sc * v[2 * e2 + 1])) * __uint_as_float(pws[e2] & 0xffff0000u); }
          else { h0 += v[2 * e2]; h1 += v[2 * e2 + 1]; }
          sq += h0 * h0 + h1 * h1; ow[e2] = cvtpk(h0, h1); }
      *(u32x4*)(Hout + p) = (u32x4){ow[0], ow[1], ow[2], ow[3]};
      sq += __shfl_xor(sq, 1); sq += __shfl_xor(sq, 2); sq += __shfl_xor(sq, 4);
      if ((tid & 7) == 0) atomicAdd(rss_out + grow, sq); }
}

__global__ void __launch_bounds__(NTHR, 2) mega_fwd(Args A) {
    extern __shared__ __attribute__((aligned(16))) unsigned char lds_raw[];
    LAS unsigned char* lds = (LAS unsigned char*)lds_raw;
    const int G = gridDim.x;
    volatile LAS unsigned* bst = (volatile LAS unsigned*)(lds + LDS_BYTES - 16);
    if (threadIdx.x == 0) { bst[0] = 0u; bst[1] = 0u;
#ifdef PROBE_SEC
        *(volatile LAS unsigned long long*)(lds + LDS_BYTES - 32) = 0ull;
#endif
    }
    __syncthreads();
    XcdBarrier xbar = xcd_barrier_post((unsigned*)(A.ws + WS_CTL) + CW_BAR, bst);
#ifdef PROBE_GROUP
    unsigned long long t_prev = __builtin_amdgcn_s_memrealtime(), t_sel = 0;
#endif
    for (int ph = A.ph_lo; ph < A.ph_hi; ++ph) {
        KP kp; kp.p = (const char AS4*)__builtin_amdgcn_kernarg_segment_ptr(); asm volatile("" : "+s"(kp.p));
        unsigned char* ws = kp.ws();
        int tid = threadIdx.x; asm volatile("" : "+v"(tid));
        int bid = blockIdx.x; asm volatile("" : "+s"(bid));
        const int lane = tid & 63, wave = __builtin_amdgcn_readfirstlane(tid >> 6), gw = bid * NWAVES + wave, NGW = G * NWAVES;
        if (ph == 0) { if (PH_MASK & 1) phase_prologue(kp, lds, gw, NGW, wave, lane); }
        else if (ph == N_PHASES - 1) { SEC_BEGIN(32) phase_final(kp, gw, NGW, lane); SEC_END(32, lds) }
        else {
            const int li = (ph - 1) / SUBS, sub = (ph - 1) % SUBS, j = li >> 1; const bool ab = (li & 1) == 0;
            float* RSS = (float*)(ws + WS_RSS);
            if (sub == 0) {
                const int N = ab ? NAB : NCD;
                const bf16* Bt = ab ? (const bf16*)(ws + WS_WABIN) + (size_t)j * NAB * 2048 : (const bf16*)(ws + WS_WCDIN) + (size_t)j * NCD * 2048;
                { pg8::Gemm g{(const bf16*)(ws + WS_XN), Bt, T, N, 2048}; pg8::StaticOrder S; S.init(T, N, G, bid);
                  pg8::EpiU E{(bf16*)(ws + WS_U), N, RSS + (size_t)(2 * li) * T};
                  if (PH_MASK & 2) pg8::gemm_phase<pg8::EpiU, pg8::StaticOrder, true, true>(lds, g, S, E, tid); }
                { int tid2 = tid; asm volatile("" : "+v"(tid2));
                  int pM = T, pG = G, pc = bid, prow = 0;
                  if (G == 256) { if (ab) { if (bid >= 218) { pM = 4864; pG = 38; pc = bid - 218; } else { prow = 4864; pM = T - 4864; pG = 120; pc = bid; } }
                                  else { pG = 122; pc = bid >= 134 ? bid - 134 : 100000; } }
                  pg8::StaticOrder S; S.init(pM, 2048, pG, pc);
                  pg8::Gemm g{(const bf16*)(ws + WS_PB) + ((size_t)li * T + prow) * 256, (const bf16*)(ws + WS_WPROJ) + (size_t)li * 2048 * 256, pM, 2048, 256};
                  pg8::EpiU E{(bf16*)(ws + WS_SCR + SC_PP) + (size_t)prow * 2048, 2048, nullptr};
                  if (PH_MASK & 2) pg8::gemm_phase<pg8::EpiU, pg8::StaticOrder, true, true>(lds, g, S, E, tid2); }
            } else if (sub == 4) {
                const bf16* Bt = ab ? (const bf16*)(ws + WS_WABOUT) + (size_t)j * 2048 * 2048 : (const bf16*)(ws + WS_WCDOUT) + (size_t)j * 2048 * 2048;
                pg8::Gemm g{(const bf16*)(ws + WS_YM), Bt, TP, 2048, 2048}; pg8::StaticOrder S; S.init(TP, 2048, G, bid);
                pg8::EpiRes<false> E{(const bf16*)(ws + WS_XN), (bf16*)(ws + WS_SCR + SC_HB1), RSS + (size_t)(2 * li + 1) * T, nullptr, nullptr};
                if (PH_MASK & 4) pg8::gemm_phase<pg8::EpiRes<false>, pg8::StaticOrder, true, true>(lds, g, S, E, tid);
                { int tid2 = tid; asm volatile("" : "+v"(tid2));
                  sample_gemm_res<false>(lds, (const bf16*)(ws + WS_YM), Bt, (const bf16*)(ws + WS_XN), (bf16*)(ws + WS_SCR + SC_HB1), RSS + (size_t)(2 * li + 1) * T, nullptr, nullptr, bid, tid2); }
            } else if (sub == 5) {
                pg8::Gemm g{(const bf16*)(ws + WS_SCR + SC_HB1), (const bf16*)(ws + WS_WGATE) + (size_t)li * 2048 * 2048, TP, 2048, 2048}; pg8::StaticOrder S; S.init(TP, 2048, G, bid);
                pg8::EpiRes<true> E{(const bf16*)(ws + WS_SCR + SC_HB1), (bf16*)(ws + WS_XN), RSS + (size_t)(2 * li + 2) * T, (const bf16*)(ws + WS_SCR + SC_PP), RSS + (size_t)(2 * li + 1) * T};
                if (PH_MASK & 4) pg8::gemm_phase<pg8::EpiRes<true>, pg8::StaticOrder, true, true>(lds, g, S, E, tid);
                { int tid2 = tid; asm volatile("" : "+v"(tid2));
                  sample_gemm_res<true>(lds, (const bf16*)(ws + WS_SCR + SC_HB1), (const bf16*)(ws + WS_WGATE) + (size_t)li * 2048 * 2048, (const bf16*)(ws + WS_SCR + SC_HB1), (bf16*)(ws + WS_XN), RSS + (size_t)(2 * li + 2) * T,
                                        (const bf16*)(ws + WS_SCR + SC_PP), RSS + (size_t)(2 * li + 1) * T, bid, tid2); }
            } else if (sub == 1) {
                if (ab) { SEC_BEGIN(3) if (PH_MASK & 4096) phase_gla_prep(kp, bid, G, j, lds, tid); SEC_END(3, lds) SEC_BEGIN(4) if (PH_MASK & 8192) phase_dn_prep(kp, bid, G, j, lds, tid); SEC_END(4, lds) }
                else { if (PH_MASK & 2048) { SEC_BEGIN(8) phase_ssd_prep(kp, bid, G, j, lds, tid); SEC_END(8, lds) SEC_BEGIN(9) phase_lru_gates(kp, bid, G, j, lds, tid); SEC_END(9, lds) } }
            }
            else if (sub == 2) { if (ab) { if (PH_MASK & 32) phase_ab_rec(kp, bid, G, j, li, lds, tid); } else { if (PH_MASK & 64) phase_cd_rec(kp, bid, G, j, li, lds, tid); } }
            else { if (ab) { SEC_BEGIN(30) if (PH_MASK & 128) phase_ab_post(kp, bid, G, j, tid, wave, lane); SEC_END(30, lds) } else { SEC_BEGIN(31) if (PH_MASK & 256) phase_cd_post(kp, bid, G, j, tid, wave, lane); SEC_END(31, lds) } }
        }
        if (ph + 1 < A.ph_hi) { if (ph == A.ph_lo) cg::this_grid().sync(); else xcd_barrier(xbar); }
#ifdef PROBE_GROUP
        { const unsigned long long t_now = __builtin_amdgcn_s_memrealtime(); const int li_ = (ph - 1) / SUBS, sub_ = (ph - 1) % SUBS; const bool ab_ = (li_ & 1) == 0;
          int grp = 9; if (ph == N_PHASES - 1) grp = 8; else if (ph > 0) { if (sub_ == 0 || sub_ == 4 || sub_ == 5) grp = 1; else if (sub_ == 1) grp = ab_ ? 4 : 5; else if (sub_ == 2) grp = ab_ ? 6 : 7; else grp = 8; }
          if (grp == PROBE_GROUP) t_sel += t_now - t_prev; t_prev = t_now; }
#endif
    }
#ifdef PROBE_SEC
    if (blockIdx.x == PROBE_BLK && threadIdx.x == 0) { const unsigned long long t_s = *(volatile LAS unsigned long long*)(lds + LDS_BYTES - 32); const unsigned long long t0 = __builtin_amdgcn_s_memrealtime(); while (__builtin_amdgcn_s_memrealtime() - t0 < 3 * t_s) __builtin_amdgcn_s_sleep(8); }
#endif
#ifdef PROBE_GROUP
    if (blockIdx.x == 0 && threadIdx.x == 0) { const unsigned long long t0 = __builtin_amdgcn_s_memrealtime(); while (__builtin_amdgcn_s_memrealtime() - t0 < 3 * t_sel) __builtin_amdgcn_s_sleep(8); }
#endif
}

extern "C" void kernel_launch(void* const* d_in, const int* in_sizes, int n_in, void* d_out, int out_size, void* d_ws, size_t ws_size, hipStream_t stream) {
    static int grid = 0;
    if (grid == 0) {
        if (n_in != 40 || (size_t)out_size != O_END || ws_size < WS_END) { fprintf(stderr, "kernel_launch: unexpected shapes: n_in %d out %d ws %zu\n", n_in, out_size, ws_size); grid = -1; return; }
        int dev = 0, cus = 0, per_cu = 0;
        if (hipGetDevice(&dev) != hipSuccess || hipDeviceGetAttribute(&cus, hipDeviceAttributeMultiprocessorCount, dev) != hipSuccess) { grid = -1; return; }
        if (hipFuncSetAttribute((const void*)mega_fwd, hipFuncAttributeMaxDynamicSharedMemorySize, LDS_BYTES) != hipSuccess) { fprintf(stderr, "kernel_launch: hipFuncSetAttribute failed\n"); grid = -1; return; }
        if (hipOccupancyMaxActiveBlocksPerMultiprocessor(&per_cu, (const void*)mega_fwd, NTHR, LDS_BYTES) != hipSuccess || per_cu < 1) { fprintf(stderr, "kernel_launch: occupancy query says %d\n", per_cu); per_cu = 1; }
        (void)hipGetLastError();
        grid = cus;
    }
    if (grid < 0) return;
    if (hipMemsetAsync((char*)d_ws + WS_CTL, 0, CTL_ZERO_BYTES, stream) != hipSuccess) { fprintf(stderr, "kernel_launch: memset of the control words failed\n"); return; }
    Args a{};
    for (int i = 0; i < 40; ++i) a.in[i] = (const float*)d_in[i];
    a.out = (float*)d_out; a.ws = (unsigned char*)d_ws;
#if MK_N_LAUNCHES == 1
    a.ph_lo = 0; a.ph_hi = N_PHASES;
    void* args[] = {&a};
    hipError_t e = hipLaunchCooperativeKernel((const void*)mega_fwd, dim3(grid), dim3(NTHR), args, LDS_BYTES, stream);
    if (e != hipSuccess) fprintf(stderr, "cooperative launch failed: %s (grid %d)\n", hipGetErrorString(e), grid);
#else
    for (int ph = 0; ph < N_PHASES; ++ph) { a.ph_lo = ph; a.ph_hi = ph + 1; mega_fwd<<<dim3(grid), dim3(NTHR), LDS_BYTES, stream>>>(a); }
#endif
}
```

```cpp
#include <hip/hip_runtime.h>
#include <hip/hip_cooperative_groups.h>
#include <cstdio>
#include <cstdint>
namespace cg = cooperative_groups;

#ifndef MK_N_LAUNCHES
#define MK_N_LAUNCHES 1
#endif

namespace pg8 {
#define PG8_LAS __attribute__((address_space(3)))
typedef unsigned short bf16_t;
typedef short bf16x8 __attribute__((ext_vector_type(8)));
typedef float f32x4 __attribute__((ext_vector_type(4)));
typedef unsigned u32x4 __attribute__((ext_vector_type(4)));
constexpr int BM = 256, BK = 64, HALF = 128, HTB = HALF * BK * 2  , STAGE_BYTES = 8 * HTB, NXCD = 8, WGM = 8;

__host__ __device__ __forceinline__ int lds_byte(int r, int c) { const int st = (r >> 4) * 2 + (c >> 5), rr = r & 15, cc = c & 31, ob = rr * 64 + cc * 2; return st * 1024 + (ob ^ (((ob >> 9) & 1) << 5)); }
__host__ __device__ __forceinline__ void stage_rc(int b, int& R, int& C) { const int st = b / 1024, sb = b % 1024, swz = sb ^ (((sb >> 9) & 1) << 5); R = (st >> 1) * 16 + swz / 64; C = (st & 1) * 32 + (swz % 64) / 2; }
__host__ __device__ __forceinline__ int perm32(int rho) { const int n = rho >> 4, i = rho & 15; return 8 * (i >> 2) + 4 * n + (i & 3); }

struct Unit { int pm, pn; };
struct Gemm { const bf16_t* A; const bf16_t* Bt; int M, N, K; };

struct StaticOrder {
    int nM, nN, nwg, G, c;
    __host__ __device__ void init(int M, int N, int G_, int c_) { nM = M / BM; nN = N / BM; nwg = nM * nN; G = G_; c = c_; }
    __host__ __device__ bool next(int i, Unit& u) const {
        const long L = (long)i * G + c; if (L >= nwg) return false;
        int wgid = (int)L; { const int q = nwg / NXCD, r = nwg % NXCD, xcd = wgid % NXCD, off = wgid / NXCD; wgid = (xcd < r ? xcd * (q + 1) : r * (q + 1) + (xcd - r) * q) + off; }
        const int nig = WGM * nN, gid = wgid / nig, fm = gid * WGM, gsz = (nM - fm) < WGM ? (nM - fm) : WGM;
        u.pm = fm + ((wgid % nig) % gsz); u.pn = (wgid % nig) / gsz; return true;
    }
    __device__ __forceinline__ void a_ready(const Unit&) const {}
    __device__ __forceinline__ void done(const Unit&) const {}
};

__device__ __forceinline__ unsigned cvt_pk_bf16(float lo, float hi) { unsigned r; asm volatile("v_cvt_pk_bf16_f32 %0, %1, %2" : "=v"(r) : "v"(lo), "v"(hi)); return r; }
struct EpiF32 {
    static constexpr bool PERM = false, AFTER_DRAIN = false;
    float* C; int ldc;
    __device__ __forceinline__ void operator()(const f32x4 (&acc)[2][2][4][2], const Unit& u, int wr, int wc, int fr, int fq) const {
        const int row0 = u.pm * BM + wr * 64 + fr, col0 = u.pn * BM + wc * 32 + 4 * fq;
#pragma unroll
        for (int ai = 0; ai < 2; ++ai)
#pragma unroll
            for (int m = 0; m < 4; ++m) { float* rowp = C + (size_t)(row0 + ai * HALF + m * 16) * ldc + col0;
#pragma unroll
                for (int bj = 0; bj < 2; ++bj)
#pragma unroll
                    for (int n = 0; n < 2; ++n) *(f32x4*)(rowp + bj * HALF + n * 16) = acc[ai][bj][m][n]; }
    }
};
struct EpiBf16 {
    static constexpr bool PERM = true, AFTER_DRAIN = false;
    bf16_t* O; int ldc;
    __device__ __forceinline__ void operator()(const f32x4 (&acc)[2][2][4][2], const Unit& u, int wr, int wc, int fr, int fq) const {
        const int row0 = u.pm * BM + wr * 64 + fr; const int col0 = u.pn * BM + wc * 32 + 8 * fq;
#pragma unroll
        for (int ai = 0; ai < 2; ++ai)
#pragma unroll
            for (int m = 0; m < 4; ++m) { bf16_t* rowp = O + (size_t)(row0 + ai * HALF + m * 16) * ldc + col0;
#pragma unroll
                for (int bj = 0; bj < 2; ++bj) { const f32x4 v0 = acc[ai][bj][m][0], v1 = acc[ai][bj][m][1];
                    u32x4 w; w.x = cvt_pk_bf16(v0[0], v0[1]); w.y = cvt_pk_bf16(v0[2], v0[3]); w.z = cvt_pk_bf16(v1[0], v1[1]); w.w = cvt_pk_bf16(v1[2], v1[3]);
                    *(u32x4*)(rowp + bj * HALF) = w; } }
    }
};

struct RangeOrder {
    int start, count;
    __host__ __device__ bool next(int i, Unit& u) const { if (i >= count) return false; const int t = start + i; u.pm = t >> 3; u.pn = t & 7; return true; }
    __device__ __forceinline__ void a_ready(const Unit&) const {}
    __device__ __forceinline__ void done(const Unit&) const {}
};
struct EpiU {
    static constexpr bool PERM = true, AFTER_DRAIN = false;
    bf16_t* O; int ldc; const float* rss;
    __device__ __forceinline__ void operator()(const f32x4 (&acc)[2][2][4][2], const Unit& u, int wr, int wc, int fr, int fq) const {
        const int row0 = u.pm * BM + wr * 64 + fr; const int col0 = u.pn * BM + wc * 32 + 8 * fq;
#pragma unroll
        for (int ai = 0; ai < 2; ++ai)
#pragma unroll
            for (int m = 0; m < 4; ++m) { const int row = row0 + ai * HALF + m * 16; const float sc = rss ? rsqrtf(rss[row] * (1.f / 2048.f) + 1e-6f) : 1.f;
                bf16_t* rowp = O + (size_t)row * ldc + col0;
#pragma unroll
                for (int bj = 0; bj < 2; ++bj) { const f32x4 v0 = acc[ai][bj][m][0] * sc, v1 = acc[ai][bj][m][1] * sc;
                    u32x4 w; w.x = cvt_pk_bf16(v0[0], v0[1]); w.y = cvt_pk_bf16(v0[2], v0[3]); w.z = cvt_pk_bf16(v1[0], v1[1]); w.w = cvt_pk_bf16(v1[2], v1[3]);
                    *(u32x4*)(rowp + bj * HALF) = w; } }
    }
};
typedef unsigned u32x2e __attribute__((ext_vector_type(2)));
template <bool GATE> struct EpiRes {
    static constexpr bool PERM = false, AFTER_DRAIN = false;
    const bf16_t* Hin; bf16_t* Hout; float* rss_out; const bf16_t* PP; const float* rss_in;
    __device__ __forceinline__ void operator()(const f32x4 (&acc)[2][2][4][2], const Unit& u, int wr, int wc, int fr, int fq) const {
        const int row0 = u.pm * BM + wr * 64 + fr, col0 = u.pn * BM + wc * 32 + 4 * fq;
#pragma unroll
        for (int ai = 0; ai < 2; ++ai)
#pragma unroll
            for (int m = 0; m < 4; ++m) { const int row = row0 + ai * HALF + m * 16; const size_t ro = (size_t)row * 2048 + col0;
                float sc = 1.f; if (GATE) sc = rsqrtf(rss_in[row] * (1.f / 2048.f) + 1e-6f);
                float s = 0.f;
#pragma unroll
                for (int bj = 0; bj < 2; ++bj)
#pragma unroll
                    for (int n = 0; n < 2; ++n) { const size_t p = ro + bj * HALF + n * 16; const u32x2e hw = *(const u32x2e*)(Hin + p); const f32x4 a = acc[ai][bj][m][n];
                        f32x4 h; h[0] = __uint_as_float(hw.x << 16); h[1] = __uint_as_float(hw.x & 0xffff0000u); h[2] = __uint_as_float(hw.y << 16); h[3] = __uint_as_float(hw.y & 0xffff0000u);
                        if (GATE) { const u32x2e pw = *(const u32x2e*)(PP + p);
                            h[0] += __builtin_amdgcn_rcpf(1.f + __expf(-sc * a[0])) * __uint_as_float(pw.x << 16); h[1] += __builtin_amdgcn_rcpf(1.f + __expf(-sc * a[1])) * __uint_as_float(pw.x & 0xffff0000u);
                            h[2] += __builtin_amdgcn_rcpf(1.f + __expf(-sc * a[2])) * __uint_as_float(pw.y << 16); h[3] += __builtin_amdgcn_rcpf(1.f + __expf(-sc * a[3])) * __uint_as_float(pw.y & 0xffff0000u); }
                        else h = h + a;
                        s += (h[0] * h[0] + h[1] * h[1]) + (h[2] * h[2] + h[3] * h[3]);
                        u32x2e o; o.x = cvt_pk_bf16(h[0], h[1]); o.y = cvt_pk_bf16(h[2], h[3]); *(u32x2e*)(Hout + p) = o; }
                s += __shfl_xor(s, 16); s += __shfl_xor(s, 32);
                if (fq == 0) atomicAdd(rss_out + row, s);
                asm volatile("" ::: "memory"); }
    }
};
template <class Epi, class Sched, bool ALIGN_EPI = false, bool SP2 = false>
__device__ __forceinline__ void gemm_phase(PG8_LAS unsigned char* lds, const Gemm g, const Sched& S, const Epi& E, const int tid) {
    const int wid = __builtin_amdgcn_readfirstlane(tid >> 6), lane = tid & 63, wr = wid >> 2, wc = wid & 3, fr = lane & 15, fq = lane >> 4;
    const int K = g.K, nt = K / BK;
    unsigned voffA[2], voffB[2];
#pragma unroll
    for (int i = 0; i < 2; ++i) { int R, C; stage_rc(tid * 16 + i * 8192, R, C); const int Rb = Epi::PERM ? ((R & ~31) + perm32(R & 31)) : R;
        voffA[i] = (unsigned)(R * K + C) * 2u; voffB[i] = (unsigned)(Rb * K + C) * 2u; }
    const size_t kstep = (size_t)(BK * 2);
    const size_t hstep = (size_t)HALF * K * 2;
    const size_t tstep = 2 * hstep;
    const unsigned ldsw = (unsigned)wid * 1024u;
    const int aoff = lds_byte(wr * 64 + fr, fq * 8), boff = lds_byte(wc * 32 + fr, fq * 8);
#define PG8_SA(b, h) (((b) * 2 + (h)) * HTB)
#define PG8_SB(b, h) ((4 + (b) * 2 + (h)) * HTB)
#define PG8_STAGE(bufoff, gbase, voff) do { _Pragma("unroll") for (int _i = 0; _i < 2; ++_i) \
        __builtin_amdgcn_global_load_lds((const unsigned*)((const char*)(gbase) + (voff)[_i]), (PG8_LAS unsigned*)(lds + (bufoff) + ldsw + _i * 8192), 16, 0, 0); } while (0)
#define PG8_LDA(dst, b, h) do { _Pragma("unroll") for (int m = 0; m < 4; ++m) _Pragma("unroll") for (int k = 0; k < 2; ++k) dst[m][k] = *(const PG8_LAS bf16x8*)(lds + PG8_SA(b, h) + aoff + m * 2048 + k * 1024); } while (0)
#define PG8_LDB(dst, b, h) do { _Pragma("unroll") for (int n = 0; n < 2; ++n) _Pragma("unroll") for (int k = 0; k < 2; ++k) dst[n][k] = *(const PG8_LAS bf16x8*)(lds + PG8_SB(b, h) + boff + n * 2048 + k * 1024); } while (0)
#define PG8_MMA(ai, bj, At, Bt) do { __builtin_amdgcn_s_setprio(1); _Pragma("unroll") for (int m = 0; m < 4; ++m) _Pragma("unroll") for (int n = 0; n < 2; ++n) _Pragma("unroll") for (int k = 0; k < 2; ++k) \
        acc[ai][bj][m][n] = __builtin_amdgcn_mfma_f32_16x16x32_bf16(Bt[n][k], At[m][k], acc[ai][bj][m][n], 0, 0, 0); __builtin_amdgcn_s_setprio(0); } while (0)
#define PG8_WAIT_V(n) asm volatile("s_waitcnt vmcnt(" #n ")" ::: "memory")
#define PG8_WAIT_L(n) asm volatile("s_waitcnt lgkmcnt(" #n ")" ::: "memory")
#define PG8_BAR __builtin_amdgcn_s_barrier()
#define PG8_SCHED __builtin_amdgcn_sched_barrier(0)
    Unit cur, nxt; int ui = 0;
    if (!S.next(0, cur)) return;
    f32x4 acc[2][2][4][2];
#pragma unroll
    for (int a = 0; a < 2; ++a)
#pragma unroll
        for (int b = 0; b < 2; ++b)
#pragma unroll
            for (int m = 0; m < 4; ++m)
#pragma unroll
                for (int n = 0; n < 2; ++n) acc[a][b][m][n] = (f32x4){0.f, 0.f, 0.f, 0.f};
    bf16x8 At[4][2], B0[2][2], B1[2][2];
    const char* cA = (const char*)g.A + (size_t)cur.pm * tstep; const char* cB = (const char*)g.Bt + (size_t)cur.pn * tstep;
    S.a_ready(cur);
    if constexpr (SP2) {
        PG8_STAGE(PG8_SB(0, 0), cB, voffB); PG8_STAGE(PG8_SB(0, 1), cB + hstep, voffB); PG8_STAGE(PG8_SA(0, 0), cA, voffA); PG8_STAGE(PG8_SA(0, 1), cA + hstep, voffA);
        if (wr == 1) PG8_BAR;
        PG8_WAIT_V(2); PG8_BAR;
        PG8_STAGE(PG8_SB(1, 0), cB + kstep, voffB); PG8_STAGE(PG8_SA(1, 0), cA + kstep, voffA); PG8_STAGE(PG8_SB(1, 1), cB + hstep + kstep, voffB);
        PG8_WAIT_V(6); PG8_BAR;
    } else {
        PG8_STAGE(PG8_SB(0, 0), cB, voffB); PG8_STAGE(PG8_SA(0, 0), cA, voffA); PG8_STAGE(PG8_SB(0, 1), cB + hstep, voffB); PG8_STAGE(PG8_SA(0, 1), cA + hstep, voffA);
        if (wr == 1) PG8_BAR;
        PG8_WAIT_V(4); PG8_BAR;
        PG8_STAGE(PG8_SB(1, 0), cB + kstep, voffB); PG8_STAGE(PG8_SA(1, 0), cA + kstep, voffA); PG8_STAGE(PG8_SB(1, 1), cB + hstep + kstep, voffB);
        PG8_WAIT_V(6); PG8_BAR;
    }
    for (;;) {
        const bool has_next = S.next(ui + 1, nxt);
        const char* nA = has_next ? (const char*)g.A + (size_t)nxt.pm * tstep : cA; const char* nB = has_next ? (const char*)g.Bt + (size_t)nxt.pn * tstep : cB;
        for (int t = 0; t < nt; t += 2) {
            const bool last = (t == nt - 2);
            const char* a1 = cA + (size_t)(t + 1) * kstep;
            const char* a2 = last ? nA : cA + (size_t)(t + 2) * kstep; const char* b2 = last ? nB : cB + (size_t)(t + 2) * kstep;
            const char* a3 = a2 + kstep; const char* b3 = b2 + kstep;
            if (last && has_next) S.a_ready(nxt);
            if constexpr (SP2) {
            PG8_LDB(B0, 0, 0); PG8_LDB(B1, 0, 1); PG8_SCHED; PG8_LDA(At, 0, 0); PG8_STAGE(PG8_SA(1, 1), a1 + hstep, voffA);
            PG8_WAIT_V(8); PG8_WAIT_L(0); PG8_BAR; PG8_MMA(0, 0, At, B0); PG8_MMA(0, 1, At, B1); PG8_BAR; PG8_SCHED;
            PG8_LDA(At, 0, 1); PG8_STAGE(PG8_SB(0, 0), b2, voffB); PG8_STAGE(PG8_SB(0, 1), b2 + hstep, voffB); PG8_STAGE(PG8_SA(0, 0), a2, voffA);
            PG8_WAIT_V(8); PG8_WAIT_L(0); PG8_BAR; PG8_MMA(1, 0, At, B0); PG8_MMA(1, 1, At, B1); PG8_BAR; PG8_SCHED;
            PG8_LDB(B0, 1, 0); PG8_LDB(B1, 1, 1); PG8_SCHED; PG8_LDA(At, 1, 0); PG8_STAGE(PG8_SA(0, 1), a2 + hstep, voffA);
            PG8_WAIT_V(8); PG8_WAIT_L(0); PG8_BAR; PG8_MMA(0, 0, At, B0); PG8_MMA(0, 1, At, B1); PG8_BAR; PG8_SCHED;
            PG8_LDA(At, 1, 1); PG8_STAGE(PG8_SB(1, 0), b3, voffB); PG8_STAGE(PG8_SB(1, 1), b3 + hstep, voffB); PG8_STAGE(PG8_SA(1, 0), a3, voffA);
            PG8_WAIT_V(8); PG8_WAIT_L(0); PG8_BAR; PG8_MMA(1, 0, At, B0); PG8_MMA(1, 1, At, B1); PG8_BAR; PG8_SCHED;
            } else {
            PG8_LDB(B0, 0, 0); PG8_SCHED; PG8_LDA(At, 0, 0); PG8_STAGE(PG8_SA(1, 1), a1 + hstep, voffA);
            PG8_WAIT_L(8); PG8_BAR; PG8_WAIT_L(0); PG8_MMA(0, 0, At, B0); PG8_BAR; PG8_SCHED;
            PG8_LDB(B1, 0, 1); PG8_STAGE(PG8_SB(0, 0), b2, voffB);
            PG8_BAR; PG8_WAIT_L(0); PG8_MMA(0, 1, At, B1); PG8_BAR;
            PG8_LDA(At, 0, 1); PG8_STAGE(PG8_SA(0, 0), a2, voffA);
            PG8_BAR; PG8_WAIT_L(0); PG8_MMA(1, 0, At, B0); PG8_BAR; PG8_SCHED;
            PG8_STAGE(PG8_SB(0, 1), b2 + hstep, voffB);
            PG8_WAIT_V(6); PG8_BAR; PG8_MMA(1, 1, At, B1); PG8_BAR;
            PG8_LDB(B0, 1, 0); PG8_SCHED; PG8_LDA(At, 1, 0); PG8_STAGE(PG8_SA(0, 1), a2 + hstep, voffA);
            PG8_WAIT_L(8); PG8_BAR; PG8_WAIT_L(0); PG8_MMA(0, 0, At, B0); PG8_BAR; PG8_SCHED;
            PG8_LDB(B1, 1, 1); PG8_STAGE(PG8_SB(1, 0), b3, voffB);
            PG8_BAR; PG8_WAIT_L(0); PG8_MMA(0, 1, At, B1); PG8_BAR;
            PG8_LDA(At, 1, 1); PG8_STAGE(PG8_SA(1, 0), a3, voffA);
            PG8_BAR; PG8_WAIT_L(0); PG8_MMA(1, 0, At, B0); PG8_BAR; PG8_SCHED;
            PG8_STAGE(PG8_SB(1, 1), b3 + hstep, voffB);
            PG8_WAIT_V(6); PG8_BAR; PG8_MMA(1, 1, At, B1); PG8_BAR;
            }
        }
        if constexpr (ALIGN_EPI) { if (wr == 0) PG8_BAR; }
        if constexpr (!Epi::AFTER_DRAIN) { E(acc, cur, wr, wc, fr, fq); S.done(cur); }
        if (!has_next) break;
#pragma unroll
        for (int a = 0; a < 2; ++a)
#pragma unroll
            for (int b = 0; b < 2; ++b)
#pragma unroll
                for (int m = 0; m < 4; ++m)
#pragma unroll
                    for (int n = 0; n < 2; ++n) acc[a][b][m][n] = (f32x4){0.f, 0.f, 0.f, 0.f};
        cur = nxt; cA = nA; cB = nB; ++ui;
        if constexpr (ALIGN_EPI) { if (wr == 1) PG8_BAR; }
    }
    PG8_WAIT_V(0);
    if constexpr (!ALIGN_EPI) { if (wr == 0) PG8_BAR; }
    PG8_BAR;
    if constexpr (Epi::AFTER_DRAIN) { E.fused(acc, cur, wr, wc, fr, fq, lds, wid, lane); S.done(cur); }
#undef PG8_SA
#undef PG8_SB
#undef PG8_STAGE
#undef PG8_LDA
#undef PG8_LDB
#undef PG8_MMA
#undef PG8_WAIT_V
#undef PG8_WAIT_L
#undef PG8_BAR
#undef PG8_SCHED
}
}

constexpr int TP = 8192, TS = 512, T = TP + TS, DM = 2048, NSEQ = 132;
constexpr int NAB = 7424, NCD = 4864;
constexpr int NWAVES = 8, NTHR = 512;
constexpr size_t MiB = 1u << 20;
constexpr size_t WS_CTL = 0, CTL_ZERO_BYTES = 1 * MiB;
constexpr int CW_BAR = 4096, CW_CNT = 8192;
constexpr size_t WS_RSS = 65536;
constexpr size_t WS_WABIN = 2 * MiB, WS_WABOUT = 60 * MiB, WS_WCDIN = 76 * MiB, WS_WCDOUT = 114 * MiB, WS_WGATE = 130 * MiB, WS_WPROJ = 162 * MiB;
constexpr size_t WS_H = 166 * MiB, WS_XN = 234 * MiB, WS_YM = 268 * MiB, WS_PB = 302 * MiB, WS_U = 320 * MiB, WS_SCR = 444 * MiB, WS_END = 732 * MiB;
constexpr size_t SC_HB1 = 102 * MiB;
constexpr size_t SC_PP = 8 * MiB;
constexpr size_t SC_ODN = 102 * MiB, SC_OGLA = 136 * MiB, SC_DNOPS = 192 * MiB;
constexpr size_t SC_LA = 52 * MiB, SC_LB = 86 * MiB, SC_YS = 120 * MiB, SC_HS = 154 * MiB, SC_SSDOP = 192 * MiB, SC_XS = 270 * MiB;
constexpr int LDS_BYTES = 163840;
constexpr size_t O_Y_P = 0, O_Y_S = O_Y_P + (size_t)4 * 2048 * 2048, O_DN_P = O_Y_S + (size_t)128 * 4 * 2048,
    O_DNC_P = O_DN_P + (size_t)2 * 4 * 8 * 128 * 128, O_GLA_P = O_DNC_P + (size_t)2 * 4 * 3 * 3072, O_SSD_P = O_GLA_P + (size_t)2 * 4 * 4 * 128 * 256,
    O_SSDC_P = O_SSD_P + (size_t)2 * 4 * 16 * 64 * 64, O_LRU_P = O_SSDC_P + (size_t)2 * 4 * 3 * 1536, O_LRUC_P = O_LRU_P + (size_t)2 * 4 * 1024,
    O_DN_S = O_LRUC_P + (size_t)2 * 4 * 3 * 1024, O_DNC_S = O_DN_S + (size_t)2 * 128 * 8 * 128 * 128, O_GLA_S = O_DNC_S + (size_t)2 * 128 * 3 * 3072,
    O_SSD_S = O_GLA_S + (size_t)2 * 128 * 4 * 128 * 256, O_SSDC_S = O_SSD_S + (size_t)2 * 128 * 16 * 64 * 64, O_LRU_S = O_SSDC_S + (size_t)2 * 128 * 3 * 1536,
    O_LRUC_S = O_LRU_S + (size_t)2 * 128 * 1024, O_END = O_LRUC_S + (size_t)2 * 128 * 3 * 1024;
static_assert(O_END == 109064192, "output size");

#define LAS __attribute__((address_space(3)))
typedef unsigned short bf16;
typedef float f32x4 __attribute__((ext_vector_type(4)));
typedef unsigned u32x2 __attribute__((ext_vector_type(2)));
typedef unsigned u32x4 __attribute__((ext_vector_type(4)));
#define LDS_WAIT() asm volatile("s_waitcnt lgkmcnt(0)" ::: "memory")

__device__ __forceinline__ float bf2f(bf16 b) { return __uint_as_float(((unsigned)b) << 16); }
typedef __bf16 bf16x2_t __attribute__((ext_vector_type(2)));
typedef float f32x2_t __attribute__((ext_vector_type(2)));
__device__ __forceinline__ unsigned cvtpk(float lo, float hi) { f32x2_t v = {lo, hi}; bf16x2_t b = __builtin_convertvector(v, bf16x2_t); return __builtin_bit_cast(unsigned, b); }
__device__ __forceinline__ unsigned f2bf(float f) { return cvtpk(f, 0.f) & 0xffffu; }
__device__ __forceinline__ unsigned pk2(float lo, float hi) { return cvtpk(lo, hi); }
__device__ __forceinline__ float sigmoid_(float x) { return __builtin_amdgcn_rcpf(1.f + __expf(-x)); }
__device__ __forceinline__ float silu_(float x) { return x * __builtin_amdgcn_rcpf(1.f + __expf(-x)); }
__device__ __forceinline__ float softplus_(float x) { return x > 15.f ? x : (x < -15.f ? __expf(x) : __logf(1.f + __expf(x))); }
__device__ __forceinline__ float dpp_add(float v, float x) { return v + x; }
#define WS_DPP(v, ctrl, rmask) __builtin_bit_cast(float, __builtin_amdgcn_update_dpp(0, __builtin_bit_cast(int, (v)), (ctrl), (rmask), 0xf, false))
__device__ __forceinline__ float wave_sum(float v) {
    v += WS_DPP(v, 0xB1, 0xf);
    v += WS_DPP(v, 0x4E, 0xf);
    v += WS_DPP(v, 0x141, 0xf);
    v += WS_DPP(v, 0x140, 0xf);
    v += WS_DPP(v, 0x142, 0xa);
    v += WS_DPP(v, 0x143, 0xc);
    return __builtin_bit_cast(float, __builtin_amdgcn_readlane(__builtin_bit_cast(int, v), 63));
}
__device__ __forceinline__ void row_to_seq(int r, int& s, int& t) { if (r < TP) { s = r >> 11; t = r & 2047; } else { s = 4 + ((r - TP) >> 2); t = (r - TP) & 3; } }
__device__ __forceinline__ void seq_info(int s, int& row0, int& L) { if (s < 4) { row0 = s << 11; L = 2048; } else { row0 = TP + ((s - 4) << 2); L = 4; } }
__device__ __forceinline__ float pre_val(const bf16* U, int ldu, int ucol, int row0, int tt, int s, const float* stc, int W, int c) {
    const int tc = tt >= 0 ? tt : 0, sc = tt >= 0 ? 0 : 3 + tt;
    const float a = bf2f(U[(size_t)(row0 + tc) * ldu + ucol]), b = stc[((size_t)(s - 4) * 3 + sc) * W + c];
    return tt >= 0 ? a : b;
}
__device__ __forceinline__ int map_col(int mapid, int n) {
    if (mapid == 0) return n;
    if (mapid == 1) { if (n < 3072) return n; if (n < 6144) return n + 16; if (n < 7168) return n + 32; if (n < 7184) return n - 4096; if (n < 7200) return n - 1024; return -1; }
    if (n < 2560) return n; if (n < 4608) return n + 16; if (n < 4624) return n - 2048; return -1;
}
__device__ __forceinline__ void transpose_item(const float* W, int K, int Nsrc, bf16* WT, int Npad, int mapid, const float* gain, LAS float* scr, int item, int lane) {
    const int nblk = Npad / 64, kb = item / nblk, nb = item % nblk, k0 = 64 * kb, n0 = 64 * nb;
    const int n4 = (lane & 15) * 4, src = map_col(mapid, n0 + n4);
    const int srcc = src >= 0 ? src : 0; const float msk = src >= 0 ? 1.f : 0.f;
    f32x4 v[16];
#pragma unroll
    for (int i = 0; i < 16; ++i) v[i] = *(const f32x4*)(W + (size_t)(k0 + 4 * i + (lane >> 4)) * Nsrc + srcc);
    if (gain) {
#pragma unroll
        for (int i = 0; i < 16; ++i) v[i] = v[i] * (gain[k0 + 4 * i + (lane >> 4)] * msk);
    } else {
#pragma unroll
        for (int i = 0; i < 16; ++i) v[i] = v[i] * msk;
    }
#pragma unroll
    for (int i = 0; i < 16; ++i) { const int kk = 4 * i + (lane >> 4); scr[kk * 65 + n4] = v[i].x; scr[kk * 65 + n4 + 1] = v[i].y; scr[kk * 65 + n4 + 2] = v[i].z; scr[kk * 65 + n4 + 3] = v[i].w; }
    LDS_WAIT(); asm volatile("" ::: "memory");
    const int c = lane & 7;
#pragma unroll
    for (int jj = 0; jj < 8; ++jj) { const int n = (lane >> 3) + 8 * jj; const LAS float* p = scr + (8 * c) * 65 + n;
        u32x4 o; o.x = pk2(p[0 * 65], p[1 * 65]); o.y = pk2(p[2 * 65], p[3 * 65]); o.z = pk2(p[4 * 65], p[5 * 65]); o.w = pk2(p[6 * 65], p[7 * 65]);
        *(u32x4*)(WT + (size_t)(n0 + n) * K + k0 + 8 * c) = o; }
    LDS_WAIT(); asm volatile("" ::: "memory");
}
__device__ __forceinline__ void norm_row_bf16(const f32x4 (&v)[8], const float* g, bf16* orow, int lane) {
    float ss = 0.f;
#pragma unroll
    for (int j = 0; j < 8; ++j) ss += (v[j].x * v[j].x + v[j].y * v[j].y) + (v[j].z * v[j].z + v[j].w * v[j].w);
    const float rstd = rsqrtf(wave_sum(ss) * (1.f / DM) + 1e-6f);
#pragma unroll
    for (int j = 0; j < 8; ++j) { const int col = 4 * (lane + 64 * j); const f32x4 gg = *(const f32x4*)(g + col);
        u32x2 o; o.x = pk2(v[j].x * rstd * gg.x, v[j].y * rstd * gg.y); o.y = pk2(v[j].z * rstd * gg.z, v[j].w * rstd * gg.w);
        *(u32x2*)(orow + col) = o; }
}

typedef short bf16x8 __attribute__((ext_vector_type(8)));
typedef float f32x16 __attribute__((ext_vector_type(16)));
#define MFMA32(a, b, c) __builtin_amdgcn_mfma_f32_32x32x16_bf16((a), (b), (c), 0, 0, 0)
#define PACK_ACC(x, S_) __builtin_bit_cast(bf16x8, (u32x4){cvtpk((x)[8 * (S_)], (x)[8 * (S_) + 1]), cvtpk((x)[8 * (S_) + 2], (x)[8 * (S_) + 3]), cvtpk((x)[8 * (S_) + 4], (x)[8 * (S_) + 5]), cvtpk((x)[8 * (S_) + 6], (x)[8 * (S_) + 7])})
__device__ __forceinline__ int crow(int reg, int h) { return (reg & 3) + 8 * (reg >> 2) + 4 * h; }
__device__ __forceinline__ bf16x8 pack8(const float (&v)[8]) { return __builtin_bit_cast(bf16x8, (u32x4){cvtpk(v[0], v[1]), cvtpk(v[2], v[3]), cvtpk(v[4], v[5]), cvtpk(v[6], v[7])}); }

#define XB_TMO      128
#define XB_XCNT(j)  (256  + 64 * (j))
#define XB_XSUB(j)  (1280 + 64 * (j))
#define XB_XGEN(j)  (2304 + 64 * (j))
#define XB_TOP      3328
#define XB_TOPGEN   3392
#define XCD_BAR_WORDS 3456
#define XB_SPIN_CAP (1u << 18)

__device__ __forceinline__ unsigned xb_ld(unsigned* p)              { return __hip_atomic_load(p, __ATOMIC_RELAXED, __HIP_MEMORY_SCOPE_AGENT); }
__device__ __forceinline__ unsigned xb_add(unsigned* p, unsigned v) { return __hip_atomic_fetch_add(p, v, __ATOMIC_RELAXED, __HIP_MEMORY_SCOPE_AGENT); }
__device__ __forceinline__ unsigned xb_xcc_id() { return (unsigned)__builtin_amdgcn_s_getreg((3 << 11) | 20) & 0xFu; }
#define XB_SPIN(cond, bar) do { unsigned _sp = 0; while (cond) { __builtin_amdgcn_s_sleep(1); \
    if ((++_sp & 255u) == 0u) { if (xb_ld(&(bar)[XB_TMO])) break; if (_sp > XB_SPIN_CAP) { atomicAdd(&(bar)[XB_TMO], 1u); break; } } } } while (0)

struct XcdBarrier {
    unsigned* bar; unsigned x;
    volatile LAS unsigned* st;
};

__device__ __forceinline__ XcdBarrier xcd_barrier_post(unsigned* bar, volatile LAS unsigned* st) {
    XcdBarrier b; b.bar = bar; b.x = xb_xcc_id(); b.st = st;
    if (threadIdx.x == 0) (void)xb_add(&bar[XB_XCNT(b.x)], 1u);
    return b;
}
__device__ __forceinline__ void xcd_barrier_complete(unsigned* bar, unsigned x, unsigned& nloc, unsigned& nx) {
    const unsigned G = gridDim.x * gridDim.y * gridDim.z;
    unsigned sum, cnt, mine, sp = 0u;
    for (;;) {
        sum = 0u; cnt = 0u; mine = 0u;
#pragma unroll
        for (unsigned j = 0; j < 16; ++j) { const unsigned c = xb_ld(&bar[XB_XCNT(j)]); sum += c; cnt += (c > 0u) ? 1u : 0u; mine = (j == x) ? c : mine; }
        if (sum == G) break;
        __builtin_amdgcn_s_sleep(1);
        if ((++sp & 255u) == 0u) { if (xb_ld(&bar[XB_TMO])) break; if (sp > XB_SPIN_CAP) { atomicAdd(&bar[XB_TMO], 1u); break; } }
    }
    nloc = mine > 0u ? mine : 1u; nx = cnt > 0u ? cnt : 1u;
}

__device__ __forceinline__ void xcd_barrier(const XcdBarrier& b) {
    asm volatile("s_waitcnt vmcnt(0)" ::: "memory");
    __syncthreads();
    if (threadIdx.x == 0) {
        unsigned* bar = b.bar;
        __builtin_amdgcn_s_waitcnt(0);
        unsigned nloc = b.st[0], nx = b.st[1];
        if (nloc == 0u) { xcd_barrier_complete(bar, b.x, nloc, nx); b.st[0] = nloc; b.st[1] = nx; }
        const unsigned old = xb_add(&bar[XB_XSUB(b.x)], 1u);
        const unsigned gen = old / nloc;
        if (old + 1u == (gen + 1u) * nloc) {
            __builtin_amdgcn_fence(__ATOMIC_RELEASE, "agent");
            asm volatile("s_waitcnt vmcnt(0)" ::: "memory");
            const unsigned og = xb_add(&bar[XB_TOP], 1u);
            const unsigned tg = og / nx;
            if (og + 1u == (tg + 1u) * nx) xb_add(&bar[XB_TOPGEN], 1u);
            else XB_SPIN(xb_ld(&bar[XB_TOPGEN]) == tg, bar);
            __builtin_amdgcn_fence(__ATOMIC_ACQUIRE, "agent");
            xb_add(&bar[XB_XGEN(b.x)], 1u);
            asm volatile("s_waitcnt vmcnt(0)" ::: "memory");
        } else {
            XB_SPIN(xb_ld(&bar[XB_XGEN(b.x)]) == gen, bar);
            __builtin_amdgcn_fence(__ATOMIC_ACQUIRE, "agent");
            asm volatile("s_waitcnt vmcnt(0)" ::: "memory");
        }
    }
    __syncthreads();
}


#ifdef PROBE_SEC
#define SEC_BEGIN(id) unsigned long long _sec_t##id = 0; if ((id) == PROBE_SEC) { __builtin_amdgcn_s_barrier(); _sec_t##id = __builtin_amdgcn_s_memrealtime(); }
#define SEC_END(id, ldsp) if ((id) == PROBE_SEC) { __builtin_amdgcn_s_barrier(); if (threadIdx.x == 0) { volatile LAS unsigned long long* a_ = (volatile LAS unsigned long long*)((ldsp) + LDS_BYTES - 32); a_[0] = a_[0] + (__builtin_amdgcn_s_memrealtime() - _sec_t##id); } }
#define SECW_BEGIN(id) unsigned long long _secw_t##id = 0; if ((id) == PROBE_SEC) { _secw_t##id = __builtin_amdgcn_s_memrealtime(); }
#define SECW_END(id, ldsp, tsel) if ((id) == PROBE_SEC) { asm volatile("s_waitcnt vmcnt(0) lgkmcnt(0)" ::: "memory"); if (threadIdx.x == (tsel)) { volatile LAS unsigned long long* a_ = (volatile LAS unsigned long long*)((ldsp) + LDS_BYTES - 32); a_[0] = a_[0] + (__builtin_amdgcn_s_memrealtime() - _secw_t##id); } }
#else
#define SEC_BEGIN(id)
#define SEC_END(id, ldsp)
#define SECW_BEGIN(id)
#define SECW_END(id, ldsp, tsel)
#endif
struct Args { const float* in[40]; float* out; unsigned char* ws; int ph_lo, ph_hi; };
constexpr int N_PHASES = 26, SUBS = 6;
#ifndef PH_MASK
#define PH_MASK 16383
#endif
#define AS4 __attribute__((address_space(4)))
struct KP { const char AS4* p;
    __device__ __forceinline__ const float* in(int i) const { return *(const float* const AS4*)(p + 8 * i); }
    __device__ __forceinline__ float* out() const { return *(float* const AS4*)(p + 320); }
    __device__ __forceinline__ unsigned char* ws() const { return *(unsigned char* const AS4*)(p + 328); }
};
static_assert(sizeof(Args) == 344, "Args layout");

__device__ __forceinline__ void phase_prologue(const KP kp, LAS unsigned char* lds, int gw, int NGW, int wave, int lane) {
    unsigned char* ws = kp.ws();
    LAS float* scr = (LAS float*)(lds + wave * 17408);
    SEC_BEGIN(1)
    SEC_BEGIN(14)
    for (int job = 0; job < 16; ++job) {
        if (job == 2) { SEC_END(14, lds) }
        const float* W; int K = 2048, Nsrc = 2048, Npad = 2048, mapid = 0; bf16* WT; const float* gain = nullptr;
        if (job < 2)       { W = kp.in(13) + (size_t)job * 2048 * 7200; Nsrc = 7200; Npad = NAB; mapid = 1; WT = (bf16*)(ws + WS_WABIN) + (size_t)job * NAB * 2048; gain = kp.in(11) + (size_t)(2 * job) * DM; }
        else if (job < 4)  { W = kp.in(21) + (size_t)(job - 2) * 2048 * 2048; WT = (bf16*)(ws + WS_WABOUT) + (size_t)(job - 2) * 2048 * 2048; }
        else if (job < 6)  { W = kp.in(22) + (size_t)(job - 4) * 2048 * 4624; Nsrc = 4624; Npad = NCD; mapid = 2; WT = (bf16*)(ws + WS_WCDIN) + (size_t)(job - 4) * NCD * 2048; gain = kp.in(11) + (size_t)(2 * (job - 4) + 1) * DM; }
        else if (job < 8)  { W = kp.in(36) + (size_t)(job - 6) * 2048 * 2048; WT = (bf16*)(ws + WS_WCDOUT) + (size_t)(job - 6) * 2048 * 2048; }
        else if (job < 12) { W = kp.in(39) + (size_t)(job - 8) * 2048 * 2048; WT = (bf16*)(ws + WS_WGATE) + (size_t)(job - 8) * 2048 * 2048; gain = kp.in(38) + (size_t)(job - 8) * DM; }
        else               { W = kp.in(37) + (size_t)(job - 12) * 256 * 2048; K = 256; WT = (bf16*)(ws + WS_WPROJ) + (size_t)(job - 12) * 2048 * 256; }
        const int nitems = (K / 64) * (Npad / 64), nblocks = NGW / NWAVES, ipb = (nitems + nblocks - 1) / nblocks, ib = (gw / NWAVES) * ipb, ie = ib + ipb < nitems ? ib + ipb : nitems;
        for (int it = ib + wave; it < ie; it += NWAVES) transpose_item(W, K, Nsrc, WT, Npad, mapid, gain, scr, it, lane);
    }
    SEC_END(1, lds)
    SEC_BEGIN(2)
    bf16* HB = (bf16*)(ws + WS_XN); float* RSS = (float*)(ws + WS_RSS);
    for (int m = gw; m < T; m += NGW) {
        const float* src = m < TP ? kp.in(0) + (size_t)m * DM : kp.in(1) + (size_t)(m - TP) * DM;
        float ss = 0.f;
#pragma unroll
        for (int jj = 0; jj < 8; ++jj) { const int col = 4 * (lane + 64 * jj); const f32x4 v = *(const f32x4*)(src + col);
            u32x2 o; o.x = pk2(v.x, v.y); o.y = pk2(v.z, v.w); *(u32x2*)(HB + (size_t)m * DM + col) = o; ss += (v.x * v.x + v.y * v.y) + (v.z * v.z + v.w * v.w); }
        ss = wave_sum(ss); if (lane == 0) RSS[m] = ss;
    }
    bf16* PB = (bf16*)(ws + WS_PB);
    const int gt = gw * 64 + lane, NGT = NGW * 64;
    for (int i = gt; i < 4 * T * 64; i += NGT) {
        const int c4 = i & 63, rr = i >> 6, li = rr / T, r = rr - li * T;
        const float* src = r < TP ? kp.in(9) + ((size_t)li * TP + r) * 256 + 4 * c4 : kp.in(10) + ((size_t)li * TS + (r - TP)) * 256 + 4 * c4;
        const f32x4 v = *(const f32x4*)src;
        u32x2 o; o.x = pk2(v.x, v.y); o.y = pk2(v.z, v.w);
        *(u32x2*)(PB + ((size_t)li * T + r) * 256 + 4 * c4) = o;
    }
    SEC_END(2, lds)
}
__device__ __forceinline__ void phase_final(const KP kp, int gw, int NGW, int lane) {
    const bf16* HB = (const bf16*)(kp.ws() + WS_XN); const float* RSS = (const float*)(kp.ws() + WS_RSS) + (size_t)8 * T; const float* g = kp.in(12); float* out = kp.out();
    for (int m = gw; m < T; m += NGW) { const float rstd = rsqrtf(RSS[m] * (1.f / DM) + 1e-6f);
#pragma unroll
        for (int jj = 0; jj < 8; ++jj) { const int col = 4 * (lane + 64 * jj); const u32x2 hv = *(const u32x2*)(HB + (size_t)m * DM + col); const f32x4 gg = *(const f32x4*)(g + col);
            f32x4 o; o.x = __uint_as_float(hv.x << 16) * rstd * gg.x; o.y = __uint_as_float(hv.x & 0xffff0000u) * rstd * gg.y; o.z = __uint_as_float(hv.y << 16) * rstd * gg.z; o.w = __uint_as_float(hv.y & 0xffff0000u) * rstd * gg.w;
            *(f32x4*)(out + (size_t)m * DM + col) = o; } }
}

constexpr size_t GLA_ITEM_BYTES = 74752, WS_GLAOPS = WS_H;
__device__ __forceinline__ void phase_gla_prep(const KP kp, const int bid, const int G, int j, LAS unsigned char* lds, int tid0) {
    const bf16* U = (const bf16*)(kp.ws() + WS_U);
    const float* wa2 = kp.in(18) + (size_t)j * 16 * 512; const float* ba = kp.in(19) + (size_t)j * 512;
    unsigned char* OPS = kp.ws() + WS_GLAOPS;
    LAS float* GE = (LAS float*)lds; LAS float* Pg = GE + 128;
    LAS bf16* Qg = (LAS bf16*)(Pg + 512); LAS bf16* Ka = Qg + 64 * 136; LAS float* QKm = (LAS float*)(Ka + 64 * 136);
    for (int item = bid; item < 512; item += G) {
        int tid = tid0; asm volatile("" : "+v"(tid));
        const int lane = tid & 63, r = lane & 31, hp = lane >> 5, wave = tid >> 6;
        const int b = item >> 7, n = (item >> 2) & 31, h = item & 3;
        const int row0 = b * 2048 + n * 64;
        __syncthreads();
        const int d = tid & 127, tg = tid >> 7, t0 = 16 * tg;
        float q[16], k[16], gl[16];
        { float w[16];
#pragma unroll
          for (int rr = 0; rr < 16; ++rr) w[rr] = wa2[rr * 512 + h * 128 + d];
          const float bias = ba[h * 128 + d];
#pragma unroll
          for (int t = 0; t < 16; ++t) { const size_t ro = (size_t)(row0 + t0 + t) * NAB;
              q[t] = bf2f(U[ro + 4096 + h * 128 + d]) * 0.08838834764831845f; k[t] = bf2f(U[ro + 4608 + h * 128 + d]);
              const u32x4 g0 = *(const u32x4*)(U + ro + 7184), g1 = *(const u32x4*)(U + ro + 7192);
              float x = bias;
              x += __uint_as_float(g0.x << 16) * w[0] + __uint_as_float(g0.x & 0xffff0000u) * w[1] + __uint_as_float(g0.y << 16) * w[2] + __uint_as_float(g0.y & 0xffff0000u) * w[3];
              x += __uint_as_float(g0.z << 16) * w[4] + __uint_as_float(g0.z & 0xffff0000u) * w[5] + __uint_as_float(g0.w << 16) * w[6] + __uint_as_float(g0.w & 0xffff0000u) * w[7];
              x += __uint_as_float(g1.x << 16) * w[8] + __uint_as_float(g1.x & 0xffff0000u) * w[9] + __uint_as_float(g1.y << 16) * w[10] + __uint_as_float(g1.y & 0xffff0000u) * w[11];
              x += __uint_as_float(g1.z << 16) * w[12] + __uint_as_float(g1.z & 0xffff0000u) * w[13] + __uint_as_float(g1.w << 16) * w[14] + __uint_as_float(g1.w & 0xffff0000u) * w[15];
              gl[t] = -softplus_(-x) * (1.f / 16.f); } }
#pragma unroll
        for (int t = 1; t < 16; ++t) gl[t] += gl[t - 1];
        Pg[tg * 128 + d] = gl[15];
        __syncthreads();
        { float off = 0.f;
#pragma unroll
          for (int g = 0; g < 3; ++g) off += (g < tg) ? Pg[g * 128 + d] : 0.f;
          if (tg == 3) GE[d] = gl[15] + off;
#pragma unroll
          for (int t = 0; t < 16; ++t) { const float Gt = gl[t] + off; Qg[(t0 + t) * 136 + d] = (bf16)f2bf(q[t] * __expf(Gt)); Ka[(t0 + t) * 136 + d] = (bf16)f2bf(k[t] * __expf(-Gt)); } }
        __syncthreads();
        bf16x8* base = (bf16x8*)(OPS + (size_t)item * GLA_ITEM_BYTES);
        if (wave < 4) {
            const int mt = wave >> 1, nt = wave & 1;
            f32x16 acc;
#pragma unroll
            for (int i = 0; i < 16; ++i) acc[i] = 0.f;
#pragma unroll
            for (int ks = 0; ks < 8; ++ks) acc = MFMA32(*(const LAS bf16x8*)(Qg + (32 * mt + r) * 136 + 16 * ks + 8 * hp), *(const LAS bf16x8*)(Ka + (32 * nt + r) * 136 + 16 * ks + 8 * hp), acc);
            const int jt = 32 * nt + r;
#pragma unroll
            for (int i16 = 0; i16 < 16; ++i16) { const int i = 32 * mt + crow(i16, hp); QKm[i * 65 + jt] = jt <= i ? acc[i16] : 0.f; }
        } else {
            const int w4 = wave - 4;
#pragma unroll
            for (int q8 = 0; q8 < 8; ++q8) { const int f = w4 + 4 * q8, nt = f >> 2, ks = f & 3, p = 32 * nt + r;
                unsigned w[4];
#pragma unroll
                for (int jp = 0; jp < 8; jp += 2) { const int tk = 16 * ks + 8 * (jp >> 2) + 4 * hp + (jp & 3);
                    w[jp >> 1] = (unsigned)U[(size_t)(row0 + tk) * NAB + 5120 + h * 256 + p] | ((unsigned)U[(size_t)(row0 + tk + 1) * NAB + 5120 + h * 256 + p] << 16); }
                base[(40 + f) * 64 + lane] = __builtin_bit_cast(bf16x8, (u32x4){w[0], w[1], w[2], w[3]}); }
        }
        __syncthreads();
        float v[8];
#pragma unroll
        for (int q2 = 0; q2 < 2; ++q2) { const int f = wave + 8 * q2;
            { const int mt = f >> 3, ks = f & 7, i = 32 * mt + r;
              const u32x2 lo = *(const LAS u32x2*)(Qg + i * 136 + 16 * ks + 4 * hp), hi = *(const LAS u32x2*)(Qg + i * 136 + 16 * ks + 8 + 4 * hp);
              base[f * 64 + lane] = __builtin_bit_cast(bf16x8, (u32x4){lo.x, lo.y, hi.x, hi.y}); }
            { const int mt = f >> 2, ks = f & 3, dd = 32 * mt + r; const float eg = __expf(GE[dd]);
#pragma unroll
              for (int jp = 0; jp < 8; ++jp) v[jp] = bf2f(Ka[(16 * ks + 8 * (jp >> 2) + 4 * hp + (jp & 3)) * 136 + dd]) * eg;
              base[(16 + f) * 64 + lane] = pack8(v); } }
        { const int f = wave, mt = f >> 2, ks = f & 3, i = 32 * mt + r;
#pragma unroll
          for (int jp = 0; jp < 8; ++jp) v[jp] = QKm[i * 65 + 16 * ks + 8 * (jp >> 2) + 4 * hp + (jp & 3)];
          base[(32 + f) * 64 + lane] = pack8(v); }
        if (tid < 128) ((float*)(base + 72 * 64))[tid] = __expf(GE[tid]);
    }
}

constexpr size_t DN_ITEM_BYTES = 74752;
__device__ __forceinline__ void phase_dn_prep(const KP kp, const int bid, const int G, int j, LAS unsigned char* lds, int tid0) {
    unsigned char* scr = kp.ws() + WS_SCR;
    const bf16* U = (const bf16*)(kp.ws() + WS_U); const float* cw = kp.in(14) + (size_t)j * 4 * 3072;
    unsigned char* OPS = scr + SC_DNOPS;
    LAS float* AMT = (LAS float*)lds; LAS float* GLs = AMT + 64 * 68; LAS float* BLs = GLs + 64; LAS float* SS = BLs + 64;
    LAS bf16* Kb = (LAS bf16*)(SS + 256); LAS bf16* Qb = Kb + 64 * 136; LAS float* QKm = (LAS float*)(Qb + 64 * 136); LAS float* XL = QKm + 64 * 65;
    for (int item = bid; item < 1024; item += G) {
        int tid = tid0; asm volatile("" : "+v"(tid));
        const int lane = tid & 63, r = lane & 31, hp = lane >> 5, wave = tid >> 6;
        const int b = item >> 8, n = (item >> 3) & 31, h = item & 7;
        const int row0 = b * 2048 + n * 64;
        __syncthreads();
        SEC_BEGIN(20)
        {
          const int t0 = 8 * wave; const bool first = (n == 0 && wave == 0);
          const long fo = first ? 0 : (long)NAB;
          float qa[8], qb[8], ka[8], kb[8];
#pragma unroll
          for (int part = 0; part < 3; ++part) { const int c = part * 1024 + h * 128 + 2 * lane;
              const float w0a = cw[c], w0b = cw[c + 1], w1a = cw[3072 + c], w1b = cw[3072 + c + 1], w2a = cw[2 * 3072 + c], w2b = cw[2 * 3072 + c + 1], w3a = cw[3 * 3072 + c], w3b = cw[3 * 3072 + c + 1];
              const bf16* up = U + (size_t)(row0 + t0) * NAB + c;
              unsigned raw[11];
              raw[0] = *(const unsigned*)(up - 3 * fo); raw[1] = *(const unsigned*)(up - 2 * fo); raw[2] = *(const unsigned*)(up - 1 * fo);
#pragma unroll
              for (int t = 0; t < 8; ++t) raw[3 + t] = *(const unsigned*)(up + (size_t)t * NAB);
              if (first) { raw[0] = 0u; raw[1] = 0u; raw[2] = 0u; }
#pragma unroll
              for (int t = 0; t < 8; ++t) {
                  const float ya = silu_(w0a * __uint_as_float(raw[t] << 16) + w1a * __uint_as_float(raw[t + 1] << 16) + w2a * __uint_as_float(raw[t + 2] << 16) + w3a * __uint_as_float(raw[t + 3] << 16));
                  const float yb = silu_(w0b * __uint_as_float(raw[t] & 0xffff0000u) + w1b * __uint_as_float(raw[t + 1] & 0xffff0000u) + w2b * __uint_as_float(raw[t + 2] & 0xffff0000u) + w3b * __uint_as_float(raw[t + 3] & 0xffff0000u));
                  if (part == 0) { qa[t] = ya; qb[t] = yb; } else if (part == 1) { ka[t] = ya; kb[t] = yb; } else { XL[(t0 + t) * 257 + 2 * lane] = ya; XL[(t0 + t) * 257 + 2 * lane + 1] = yb; } } }
#pragma unroll
          for (int t = 0; t < 8; ++t) { const float scq = rsqrtf(wave_sum(qa[t] * qa[t] + qb[t] * qb[t]) + 1e-6f) * 0.08838834764831845f, sck = rsqrtf(wave_sum(ka[t] * ka[t] + kb[t] * kb[t]) + 1e-6f);
              *(LAS unsigned*)(Qb + (t0 + t) * 136 + 2 * lane) = pk2(qa[t] * scq, qb[t] * scq); *(LAS unsigned*)(Kb + (t0 + t) * 136 + 2 * lane) = pk2(ka[t] * sck, kb[t] * sck); } }
        if (wave == 0) { const size_t ro = (size_t)(row0 + lane) * NAB;
            float gv = -__expf(kp.in(15)[j * 8 + h]) * softplus_(bf2f(U[ro + 7176 + h]) + kp.in(16)[j * 8 + h]);
#pragma unroll
            for (int o = 1; o < 64; o <<= 1) { const float tt = __shfl_up(gv, o); if (lane >= o) gv += tt; }
            GLs[lane] = gv; BLs[lane] = sigmoid_(bf2f(U[ro + 7168 + h])); }
        __syncthreads();
        SEC_END(20, lds)
        SEC_BEGIN(21)
        SEC_END(21, lds)
        SEC_BEGIN(22)
        bf16x8* base = (bf16x8*)(OPS + (size_t)item * DN_ITEM_BYTES);
        { const int which = wave >> 2, mt = (wave >> 1) & 1, nt = wave & 1;
          const LAS bf16* Asrc = which ? Qb : Kb;
          f32x16 acc;
#pragma unroll
          for (int i = 0; i < 16; ++i) acc[i] = 0.f;
#pragma unroll
          for (int ks = 0; ks < 8; ++ks) acc = MFMA32(*(const LAS bf16x8*)(Asrc + (32 * mt + r) * 136 + 16 * ks + 8 * hp), *(const LAS bf16x8*)(Kb + (32 * nt + r) * 136 + 16 * ks + 8 * hp), acc);
          const int jt = 32 * nt + r; const float gj = GLs[jt];
#pragma unroll
          for (int i16 = 0; i16 < 16; ++i16) { const int i = 32 * mt + crow(i16, hp); const float dec = __expf(GLs[i] - gj);
              if (which == 0) AMT[jt * 68 + i] = jt < i ? BLs[i] * acc[i16] * dec : 0.f; else QKm[i * 65 + jt] = jt <= i ? acc[i16] * dec : 0.f; } }
        __syncthreads();
        SEC_END(22, lds)
        SEC_BEGIN(23)
        if (tid < 256) {
            const int c = tid; float acc[16], dg[120];
#pragma unroll
            for (int ii = 0; ii < 16; ++ii) { const float be = BLs[ii]; acc[ii] = c < 128 ? be * XL[ii * 257 + c] : be * __expf(GLs[ii]) * bf2f(Kb[ii * 136 + (c - 128)]); }
#pragma unroll
            for (int ii = 1; ii < 16; ++ii)
#pragma unroll
                for (int jj = 0; jj < ii; ++jj) dg[ii * (ii - 1) / 2 + jj] = AMT[jj * 68 + ii];
#pragma unroll
            for (int ii = 0; ii < 16; ++ii) { float x = acc[ii];
#pragma unroll
                for (int jj = 0; jj < ii; ++jj) x -= dg[ii * (ii - 1) / 2 + jj] * acc[jj];
                acc[ii] = x; }
#pragma unroll
            for (int ii = 0; ii < 16; ++ii) XL[ii * 257 + c] = acc[ii];
        } else {
            const int w4 = wave - 4; float v[8];
#pragma unroll
            for (int q = 0; q < 4; ++q) { const int f = w4 + 4 * q;
                { const int mt = f >> 3, ks = f & 7, i = 32 * mt + r; const float eg = __expf(GLs[i]);
#pragma unroll
                  for (int jp = 0; jp < 8; ++jp) v[jp] = bf2f(Qb[i * 136 + 16 * ks + 8 * (jp >> 2) + 4 * hp + (jp & 3)]) * eg;
                  base[(16 + f) * 64 + lane] = pack8(v); }
                { const int mt = f >> 2, ks = f & 3, d = 32 * mt + r; const float Gend = GLs[63];
#pragma unroll
                  for (int jp = 0; jp < 8; ++jp) { const int tk = 16 * ks + 8 * (jp >> 2) + 4 * hp + (jp & 3); v[jp] = bf2f(Kb[tk * 136 + d]) * __expf(Gend - GLs[tk]); }
                  base[(32 + f) * 64 + lane] = pack8(v); } }
#pragma unroll
            for (int q = 0; q < 2; ++q) { const int f = w4 + 4 * q, mt = f >> 2, ks = f & 3, i = 32 * mt + r;
#pragma unroll
                for (int jp = 0; jp < 8; ++jp) v[jp] = QKm[i * 65 + 16 * ks + 8 * (jp >> 2) + 4 * hp + (jp & 3)];
                base[(48 + f) * 64 + lane] = pack8(v); }
            if (tid == 256) *(float*)(base + 72 * 64) = __expf(GLs[63]);
        }
        __syncthreads();
#pragma unroll
        for (int bi = 1; bi < 4; ++bi) {
            { const int li_ = lane & 15, kq = lane >> 4;
#pragma unroll
              for (int q = 0; q < 2; ++q) { const int col = 16 * (2 * wave + q) + li_;
                  f32x4 ya;
#pragma unroll
                  for (int rg = 0; rg < 4; ++rg) { const int row = 16 * bi + 4 * kq + rg; const float be = BLs[row];
                      ya[rg] = col < 128 ? be * XL[row * 257 + col] : be * __expf(GLs[row]) * bf2f(Kb[row * 136 + (col - 128)]); }
#pragma unroll
                  for (int kk = 0; kk < 4 * bi; ++kk) { const int krow = 4 * kk + kq;
                      ya = __builtin_amdgcn_mfma_f32_16x16x4f32(-AMT[krow * 68 + 16 * bi + li_], XL[krow * 257 + col], ya, 0, 0, 0); }
#pragma unroll
                  for (int rg = 0; rg < 4; ++rg) XL[(16 * bi + 4 * kq + rg) * 257 + col] = ya[rg]; } }
            __syncthreads();
            if (tid < 256) { const int c = tid; float acc[16], dg[120];
#pragma unroll
                for (int ii = 0; ii < 16; ++ii) acc[ii] = XL[(16 * bi + ii) * 257 + c];
#pragma unroll
                for (int ii = 1; ii < 16; ++ii)
#pragma unroll
                    for (int jj = 0; jj < ii; ++jj) dg[ii * (ii - 1) / 2 + jj] = AMT[(16 * bi + jj) * 68 + 16 * bi + ii];
#pragma unroll
                for (int ii = 0; ii < 16; ++ii) { float x = acc[ii];
#pragma unroll
                    for (int jj = 0; jj < ii; ++jj) x -= dg[ii * (ii - 1) / 2 + jj] * acc[jj];
                    acc[ii] = x; }
#pragma unroll
                for (int ii = 0; ii < 16; ++ii) XL[(16 * bi + ii) * 257 + c] = acc[ii]; }
            __syncthreads();
        }
        SEC_END(23, lds)
        SEC_BEGIN(24)
        float v[8];
#pragma unroll
        for (int q = 0; q < 2; ++q) { const int f = wave + 8 * q;
            { const int mt = f >> 3, ks = f & 7, i = 32 * mt + r;
#pragma unroll
              for (int jp = 0; jp < 8; ++jp) v[jp] = -XL[i * 257 + 128 + 16 * ks + 8 * (jp >> 2) + 4 * hp + (jp & 3)];
              base[f * 64 + lane] = pack8(v); }
            { const int pq = f & 1, tl = f >> 1, mt = tl >> 2, nt = tl & 3;
#pragma unroll
              for (int e = 0; e < 8; ++e) v[e] = XL[(32 * mt + crow(8 * pq + e, hp)) * 257 + 32 * nt + r];
              base[(56 + f) * 64 + lane] = pack8(v); } }
        SEC_END(24, lds)
    }
}

__device__ __forceinline__ void phase_ab_rec(const KP kp, const int bid, const int G, int j, int li, LAS unsigned char* lds, int tid0) {
    unsigned char* scr = kp.ws() + WS_SCR; const bf16* U = (const bf16*)(kp.ws() + WS_U);
    bf16* ODN = (bf16*)(scr + SC_ODN); bf16* OGLA = (bf16*)(scr + SC_OGLA);
    SEC_BEGIN(12)
    for (int item = bid; item < 64; item += G) {
        int tid = tid0; asm volatile("" : "+v"(tid));
        int s, h; bool isdn; int half = -1;
        if (item < 32) { isdn = false; s = item >> 3; h = (item >> 1) & 3; half = item & 1; }
        else if (item < 64) { isdn = true; s = (item - 32) >> 3; h = (item - 32) & 7; half = -2; }
        else if (item < 1088) { isdn = true; s = 4 + ((item - 64) >> 3); h = (item - 64) & 7; }
        else { isdn = false; s = 4 + ((item - 1088) >> 2); h = (item - 1088) & 3; }
        int row0, L; seq_info(s, row0, L);
        __syncthreads();
        if (half == -2) {
            const int wave = __builtin_amdgcn_readfirstlane(tid >> 6), lane = tid & 63, r = lane & 31, hp = lane >> 5;
            const int b = s, nt = wave;
            const unsigned char* OPS = scr + SC_DNOPS;
            constexpr int DBUF = 73 * 1024;
#define DN_DMA(n_, bufi_) do { const unsigned char* gi_ = OPS + (size_t)((b * 32 + (n_)) * 8 + h) * DN_ITEM_BYTES + lane * 16; \
                _Pragma("unroll") for (int q_ = 0; q_ < 10; ++q_) { const int lf_ = wave + 8 * q_; if (lf_ < 73) \
                    __builtin_amdgcn_global_load_lds((const unsigned*)(gi_ + lf_ * 1024), (LAS unsigned*)(lds + (bufi_) * DBUF + lf_ * 1024), 16, 0, 2); } } while (0)
            f32x16 S0, S1, S2, S3;
#pragma unroll
            for (int i = 0; i < 16; ++i) { S0[i] = 0.f; S1[i] = 0.f; S2[i] = 0.f; S3[i] = 0.f; }
            DN_DMA(0, 0);
            asm volatile("s_waitcnt vmcnt(0)" ::: "memory"); __syncthreads();
            for (int n = 0; n < 32; ++n) {
                if (n + 1 < 32) DN_DMA(n + 1, (n + 1) & 1);
                if (wave < 4) {
                    const LAS bf16x8* F = (const LAS bf16x8*)(lds + (n & 1) * DBUF) + lane;
                    const float gend = *(const LAS float*)(lds + (n & 1) * DBUF + 72 * 1024);
                    const bf16x8 sb0 = PACK_ACC(S0, 0), sb1 = PACK_ACC(S0, 1), sb2 = PACK_ACC(S1, 0), sb3 = PACK_ACC(S1, 1), sb4 = PACK_ACC(S2, 0), sb5 = PACK_ACC(S2, 1), sb6 = PACK_ACC(S3, 0), sb7 = PACK_ACC(S3, 1);
                    f32x16 U0t, U1t;
                    { const bf16x8 a0 = F[(56 + nt * 2 + 0) * 64], a1 = F[(56 + nt * 2 + 1) * 64], c0 = F[(56 + (4 + nt) * 2 + 0) * 64], c1 = F[(56 + (4 + nt) * 2 + 1) * 64];
#pragma unroll
                      for (int e = 0; e < 8; ++e) { U0t[e] = bf2f((bf16)a0[e]); U0t[8 + e] = bf2f((bf16)a1[e]); U1t[e] = bf2f((bf16)c0[e]); U1t[8 + e] = bf2f((bf16)c1[e]); } }
                    U0t = MFMA32(F[0 * 64], sb0, U0t); U0t = MFMA32(F[1 * 64], sb1, U0t); U0t = MFMA32(F[2 * 64], sb2, U0t); U0t = MFMA32(F[3 * 64], sb3, U0t);
                    U0t = MFMA32(F[4 * 64], sb4, U0t); U0t = MFMA32(F[5 * 64], sb5, U0t); U0t = MFMA32(F[6 * 64], sb6, U0t); U0t = MFMA32(F[7 * 64], sb7, U0t);
                    U1t = MFMA32(F[8 * 64], sb0, U1t); U1t = MFMA32(F[9 * 64], sb1, U1t); U1t = MFMA32(F[10 * 64], sb2, U1t); U1t = MFMA32(F[11 * 64], sb3, U1t);
                    U1t = MFMA32(F[12 * 64], sb4, U1t); U1t = MFMA32(F[13 * 64], sb5, U1t); U1t = MFMA32(F[14 * 64], sb6, U1t); U1t = MFMA32(F[15 * 64], sb7, U1t);
                    const bf16x8 ub0 = PACK_ACC(U0t, 0), ub1 = PACK_ACC(U0t, 1), ub2 = PACK_ACC(U1t, 0), ub3 = PACK_ACC(U1t, 1);
                    f32x16 O0, O1;
#pragma unroll
                    for (int i = 0; i < 16; ++i) { O0[i] = 0.f; O1[i] = 0.f; }
                    O0 = MFMA32(F[16 * 64], sb0, O0); O0 = MFMA32(F[17 * 64], sb1, O0); O0 = MFMA32(F[18 * 64], sb2, O0); O0 = MFMA32(F[19 * 64], sb3, O0);
                    O0 = MFMA32(F[20 * 64], sb4, O0); O0 = MFMA32(F[21 * 64], sb5, O0); O0 = MFMA32(F[22 * 64], sb6, O0); O0 = MFMA32(F[23 * 64], sb7, O0);
                    O1 = MFMA32(F[24 * 64], sb0, O1); O1 = MFMA32(F[25 * 64], sb1, O1); O1 = MFMA32(F[26 * 64], sb2, O1); O1 = MFMA32(F[27 * 64], sb3, O1);
                    O1 = MFMA32(F[28 * 64], sb4, O1); O1 = MFMA32(F[29 * 64], sb5, O1); O1 = MFMA32(F[30 * 64], sb6, O1); O1 = MFMA32(F[31 * 64], sb7, O1);
                    O0 = MFMA32(F[48 * 64], ub0, O0); O0 = MFMA32(F[49 * 64], ub1, O0);
                    O1 = MFMA32(F[52 * 64], ub0, O1); O1 = MFMA32(F[53 * 64], ub1, O1); O1 = MFMA32(F[54 * 64], ub2, O1); O1 = MFMA32(F[55 * 64], ub3, O1);
#pragma unroll
                    for (int i = 0; i < 16; ++i) { S0[i] *= gend; S1[i] *= gend; S2[i] *= gend; S3[i] *= gend; }
                    S0 = MFMA32(F[32 * 64], ub0, S0); S0 = MFMA32(F[33 * 64], ub1, S0); S0 = MFMA32(F[34 * 64], ub2, S0); S0 = MFMA32(F[35 * 64], ub3, S0);
                    S1 = MFMA32(F[36 * 64], ub0, S1); S1 = MFMA32(F[37 * 64], ub1, S1); S1 = MFMA32(F[38 * 64], ub2, S1); S1 = MFMA32(F[39 * 64], ub3, S1);
                    S2 = MFMA32(F[40 * 64], ub0, S2); S2 = MFMA32(F[41 * 64], ub1, S2); S2 = MFMA32(F[42 * 64], ub2, S2); S2 = MFMA32(F[43 * 64], ub3, S2);
                    S3 = MFMA32(F[44 * 64], ub0, S3); S3 = MFMA32(F[45 * 64], ub1, S3); S3 = MFMA32(F[46 * 64], ub2, S3); S3 = MFMA32(F[47 * 64], ub3, S3);
                    bf16* yo = ODN + (size_t)(b * 2048 + n * 64) * 1024 + h * 128 + 32 * nt + r;
#pragma unroll
                    for (int i = 0; i < 16; ++i) { yo[(size_t)crow(i, hp) * 1024] = (bf16)f2bf(O0[i]); yo[(size_t)(32 + crow(i, hp)) * 1024] = (bf16)f2bf(O1[i]); }
                }
                asm volatile("s_waitcnt vmcnt(0)" ::: "memory"); __syncthreads();
            }
#undef DN_DMA
            if (wave < 4) {
                float* dst = kp.out() + O_DN_P + ((size_t)j * 4 + b) * ((size_t)8 * 128 * 128) + (size_t)h * 128 * 128 + 32 * nt + r;
#pragma unroll
                for (int i = 0; i < 16; ++i) { dst[(size_t)crow(i, hp) * 128] = S0[i]; dst[(size_t)(32 + crow(i, hp)) * 128] = S1[i]; dst[(size_t)(64 + crow(i, hp)) * 128] = S2[i]; dst[(size_t)(96 + crow(i, hp)) * 128] = S3[i]; }
            }
        } else if (half >= 0) {
            const int wave = __builtin_amdgcn_readfirstlane(tid >> 6), lane = tid & 63, r = lane & 31, hp = lane >> 5;
            const int b = s, nt = half * 4 + wave;
            const unsigned char* OPS = kp.ws() + WS_GLAOPS;
            constexpr int GBUF = 57 * 1024;
#define GLA_DMA(n_, bufi_) do { const unsigned char* gi_ = OPS + (size_t)((b * 32 + (n_)) * 4 + h) * GLA_ITEM_BYTES + lane * 16; \
                _Pragma("unroll") for (int q_ = 0; q_ < 8; ++q_) { const int lf_ = wave + 8 * q_; if (lf_ < 57) { const int gf_ = lf_ < 40 ? lf_ : (lf_ < 56 ? lf_ + half * 16 : 72); \
                    __builtin_amdgcn_global_load_lds((const unsigned*)(gi_ + gf_ * 1024), (LAS unsigned*)(lds + (bufi_) * GBUF + lf_ * 1024), 16, 0, 2); } } } while (0)
            f32x16 S0, S1, S2, S3;
#pragma unroll
            for (int i = 0; i < 16; ++i) { S0[i] = 0.f; S1[i] = 0.f; S2[i] = 0.f; S3[i] = 0.f; }
            GLA_DMA(0, 0);
            asm volatile("s_waitcnt vmcnt(0)" ::: "memory"); __syncthreads();
            for (int n = 0; n < 32; ++n) {
                if (n + 1 < 32) GLA_DMA(n + 1, (n + 1) & 1);
                if (wave < 4) {
                    const LAS bf16x8* F = (const LAS bf16x8*)(lds + (n & 1) * GBUF) + lane;
                    const LAS float* ge = (const LAS float*)(lds + (n & 1) * GBUF + 56 * 1024) + 4 * hp;
                    const bf16x8 sb0 = PACK_ACC(S0, 0), sb1 = PACK_ACC(S0, 1), sb2 = PACK_ACC(S1, 0), sb3 = PACK_ACC(S1, 1), sb4 = PACK_ACC(S2, 0), sb5 = PACK_ACC(S2, 1), sb6 = PACK_ACC(S3, 0), sb7 = PACK_ACC(S3, 1);
                    f32x16 O0, O1;
#pragma unroll
                    for (int i = 0; i < 16; ++i) { O0[i] = 0.f; O1[i] = 0.f; }
                    O0 = MFMA32(F[0 * 64], sb0, O0); O0 = MFMA32(F[1 * 64], sb1, O0); O0 = MFMA32(F[2 * 64], sb2, O0); O0 = MFMA32(F[3 * 64], sb3, O0);
                    O0 = MFMA32(F[4 * 64], sb4, O0); O0 = MFMA32(F[5 * 64], sb5, O0); O0 = MFMA32(F[6 * 64], sb6, O0); O0 = MFMA32(F[7 * 64], sb7, O0);
                    O1 = MFMA32(F[8 * 64], sb0, O1); O1 = MFMA32(F[9 * 64], sb1, O1); O1 = MFMA32(F[10 * 64], sb2, O1); O1 = MFMA32(F[11 * 64], sb3, O1);
                    O1 = MFMA32(F[12 * 64], sb4, O1); O1 = MFMA32(F[13 * 64], sb5, O1); O1 = MFMA32(F[14 * 64], sb6, O1); O1 = MFMA32(F[15 * 64], sb7, O1);
                    bf16x8 vb[4];
#pragma unroll
                    for (int ks = 0; ks < 4; ++ks) vb[ks] = F[(40 + wave * 4 + ks) * 64];
                    O0 = MFMA32(F[32 * 64], vb[0], O0); O0 = MFMA32(F[33 * 64], vb[1], O0);
#pragma unroll
                    for (int ks = 0; ks < 4; ++ks) O1 = MFMA32(F[(36 + ks) * 64], vb[ks], O1);
#pragma unroll
                    for (int q = 0; q < 4; ++q) { const f32x4 g0 = *(const LAS f32x4*)(ge + 8 * q), g1 = *(const LAS f32x4*)(ge + 32 + 8 * q), g2 = *(const LAS f32x4*)(ge + 64 + 8 * q), g3 = *(const LAS f32x4*)(ge + 96 + 8 * q);
#pragma unroll
                        for (int c = 0; c < 4; ++c) { S0[4 * q + c] *= g0[c]; S1[4 * q + c] *= g1[c]; S2[4 * q + c] *= g2[c]; S3[4 * q + c] *= g3[c]; } }
#pragma unroll
                    for (int ks = 0; ks < 4; ++ks) { S0 = MFMA32(F[(16 + ks) * 64], vb[ks], S0); S1 = MFMA32(F[(20 + ks) * 64], vb[ks], S1); S2 = MFMA32(F[(24 + ks) * 64], vb[ks], S2); S3 = MFMA32(F[(28 + ks) * 64], vb[ks], S3); }
                    bf16* yo = OGLA + (size_t)(b * 2048 + n * 64) * 1024 + h * 256 + 32 * nt + r;
#pragma unroll
                    for (int i = 0; i < 16; ++i) { yo[(size_t)crow(i, hp) * 1024] = (bf16)f2bf(O0[i]); yo[(size_t)(32 + crow(i, hp)) * 1024] = (bf16)f2bf(O1[i]); }
                }
                asm volatile("s_waitcnt vmcnt(0)" ::: "memory"); __syncthreads();
            }
#undef GLA_DMA
            if (wave < 4) {
                float* dst = kp.out() + O_GLA_P + ((size_t)j * 4 + b) * ((size_t)4 * 128 * 256) + (size_t)h * 128 * 256 + 32 * nt + r;
#pragma unroll
                for (int i = 0; i < 16; ++i) { dst[(size_t)crow(i, hp) * 256] = S0[i]; dst[(size_t)(32 + crow(i, hp)) * 256] = S1[i]; dst[(size_t)(64 + crow(i, hp)) * 256] = S2[i]; dst[(size_t)(96 + crow(i, hp)) * 256] = S3[i]; }
            }
        } else
        {}
    }
    SEC_END(12, lds)
    SEC_BEGIN(13)
    unsigned* qhead = (unsigned*)(kp.ws() + WS_CTL) + CW_CNT + 64 * li;
    volatile LAS unsigned* qslot = (volatile LAS unsigned*)(lds + LDS_BYTES - 8);
    const float* cw = kp.in(14) + (size_t)j * 4 * 3072; const float* stc = kp.in(3) + (size_t)j * 128 * 3 * 3072;
    const float* wa2 = kp.in(18) + (size_t)j * 16 * 512; const float* ba = kp.in(19) + (size_t)j * 512;
    for (;;) {
        __syncthreads();
        if (tid0 == 0) qslot[0] = __hip_atomic_fetch_add(qhead, 1u, __ATOMIC_RELAXED, __HIP_MEMORY_SCOPE_AGENT);
        __syncthreads();
        const int it = (int)qslot[0];
        if (it >= 1536) break;
        int tid = tid0; asm volatile("" : "+v"(tid));
        const int wave = tid >> 6, lane = tid & 63;
        if (it < 1024) {
            const int bs = it >> 3, h = it & 7, sq = 4 + bs, r0 = TP + bs * 4;
            LAS float* qL = (LAS float*)lds; LAS float* kL = qL + 512; LAS float* vL = kL + 512; LAS float* red = vL + 512; LAS float* sm = red + 4096;
            const int e = tid & 127, dq = tid >> 7;
            const size_t SZ = (size_t)8 * 128 * 128;
            const float* st = kp.in(2) + ((size_t)j * 128 + bs) * SZ + (size_t)h * 16384;
            float S[32];
            { const float* sp = st + (size_t)(dq * 32) * 128 + e;
#pragma unroll
              for (int i = 0; i < 32; ++i) { S[i] = *sp; sp += 128; asm volatile("" : "+v"(sp)); } }
#pragma unroll
            for (int part = 0; part < 3; ++part) { const int c = part * 1024 + h * 128 + e; float acc = 0.f;
#pragma unroll
                for (int tap = 0; tap < 4; ++tap) acc += cw[tap * 3072 + c] * pre_val(U, NAB, c, r0, dq - 3 + tap, sq, stc, 3072, c);
                if (part == 2) vL[dq * 128 + e] = silu_(acc); else (part == 0 ? qL : kL)[e * 4 + dq] = silu_(acc); }
            if (tid < 4) { const size_t ro = (size_t)(r0 + tid) * NAB;
                sm[32 + tid] = -__expf(kp.in(15)[j * 8 + h]) * softplus_(bf2f(U[ro + 7176 + h]) + kp.in(16)[j * 8 + h]); sm[36 + tid] = sigmoid_(bf2f(U[ro + 7168 + h])); }
            __syncthreads();
            { const int tk = wave & 3; LAS float* src = (wave >> 2) ? kL : qL; const float a = src[lane * 4 + tk], b = src[(lane + 64) * 4 + tk];
              const float sc = rsqrtf(wave_sum(a * a + b * b) + 1e-6f) * ((wave >> 2) ? 1.f : 0.08838834764831845f); src[lane * 4 + tk] = a * sc; src[(lane + 64) * 4 + tk] = b * sc; }
            __syncthreads();
#pragma unroll
            for (int q = 0; q < 4; ++q) { const int idx = wave * 4 + q, i = (idx >> 2) & 3, jj = idx & 3; const LAS float* src = idx < 16 ? kL : qL;
                const float dot = wave_sum(src[lane * 4 + i] * kL[lane * 4 + jj] + src[(lane + 64) * 4 + i] * kL[(lane + 64) * 4 + jj]); if (lane == 0) sm[idx] = dot; }
            float ks[4] = {0.f, 0.f, 0.f, 0.f}, qs[4] = {0.f, 0.f, 0.f, 0.f};
#pragma unroll
            for (int i = 0; i < 32; ++i) { const int d = dq * 32 + i; const float sv = S[i]; const f32x4 k4 = *(const LAS f32x4*)(kL + d * 4), q4 = *(const LAS f32x4*)(qL + d * 4);
#pragma unroll
                for (int t = 0; t < 4; ++t) { ks[t] += k4[t] * sv; qs[t] += q4[t] * sv; } }
#pragma unroll
            for (int t = 0; t < 4; ++t) { red[(t * 4 + dq) * 128 + e] = ks[t]; red[((4 + t) * 4 + dq) * 128 + e] = qs[t]; }
            __syncthreads();
            float Gc[4]; Gc[0] = sm[32]; Gc[1] = Gc[0] + sm[33]; Gc[2] = Gc[1] + sm[34]; Gc[3] = Gc[2] + sm[35];
            float u[4];
#pragma unroll
            for (int i = 0; i < 4; ++i) { const float KSi = (red[(i * 4 + 0) * 128 + e] + red[(i * 4 + 1) * 128 + e]) + (red[(i * 4 + 2) * 128 + e] + red[(i * 4 + 3) * 128 + e]);
                float acc = vL[i * 128 + e] - __expf(Gc[i]) * KSi;
#pragma unroll
                for (int jj = 0; jj < i; ++jj) acc -= sm[i * 4 + jj] * __expf(Gc[i] - Gc[jj]) * u[jj];
                u[i] = sm[36 + i] * acc; }
            if (dq == 0) {
#pragma unroll
                for (int i = 0; i < 4; ++i) { const float QSi = (red[((4 + i) * 4 + 0) * 128 + e] + red[((4 + i) * 4 + 1) * 128 + e]) + (red[((4 + i) * 4 + 2) * 128 + e] + red[((4 + i) * 4 + 3) * 128 + e]);
                    float o = __expf(Gc[i]) * QSi;
#pragma unroll
                    for (int jj = 0; jj <= i; ++jj) o += sm[16 + i * 4 + jj] * __expf(Gc[i] - Gc[jj]) * u[jj];
                    ODN[(size_t)(r0 + i) * 1024 + h * 128 + e] = (bf16)f2bf(o); } }
            const float eg = __expf(Gc[3]); float w[4];
#pragma unroll
            for (int jj = 0; jj < 4; ++jj) w[jj] = __expf(Gc[3] - Gc[jj]) * u[jj];
            float* dst = kp.out() + O_DN_S + ((size_t)j * 128 + bs) * SZ + (size_t)h * 16384 + (size_t)(dq * 32) * 128 + e;
#pragma unroll
            for (int i = 0; i < 32; ++i) { const int d = dq * 32 + i; float sv = eg * S[i]; const f32x4 k4 = *(const LAS f32x4*)(kL + d * 4);
#pragma unroll
                for (int jj = 0; jj < 4; ++jj) sv += k4[jj] * w[jj];
                *dst = sv; dst += 128; asm volatile("" : "+v"(dst)); }
        } else {
            const int q_ = it - 1024, bs = q_ >> 2, h = q_ & 3, r0 = TP + bs * 4;
            LAS float* qgL = (LAS float*)lds; LAS float* kaL = qgL + 512; LAS float* glL = kaL + 512; LAS float* egL = glL + 512; LAS float* Am = egL + 128; LAS float* red = Am + 16;
            const int e = tid & 255, dh = tid >> 8;
            const size_t SZ = (size_t)4 * 128 * 256;
            const float* st = kp.in(4) + ((size_t)j * 128 + bs) * SZ + (size_t)h * 32768;
            float S[64];
            { const float* sp = st + (size_t)(dh * 64) * 256 + e;
#pragma unroll
              for (int i = 0; i < 64; ++i) { S[i] = *sp; sp += 256; asm volatile("" : "+v"(sp)); } }
            float v[4];
#pragma unroll
            for (int t = 0; t < 4; ++t) v[t] = bf2f(U[(size_t)(r0 + t) * NAB + 5120 + h * 256 + e]);
            { const int d = tid & 127, tk = tid >> 7; const size_t ro = (size_t)(r0 + tk) * NAB;
              qgL[d * 4 + tk] = bf2f(U[ro + 4096 + h * 128 + d]) * 0.08838834764831845f; kaL[d * 4 + tk] = bf2f(U[ro + 4608 + h * 128 + d]);
              float x = ba[h * 128 + d];
#pragma unroll
              for (int rr = 0; rr < 16; ++rr) x += bf2f(U[ro + 7184 + rr]) * wa2[rr * 512 + h * 128 + d];
              glL[tk * 128 + d] = -softplus_(-x) * (1.f / 16.f); }
            __syncthreads();
            if (tid < 128) { float Gq = 0.f;
#pragma unroll
                for (int t = 0; t < 4; ++t) { Gq += glL[t * 128 + tid]; qgL[tid * 4 + t] *= __expf(Gq); kaL[tid * 4 + t] *= __expf(-Gq); }
                egL[tid] = __expf(Gq); }
            __syncthreads();
#pragma unroll
            for (int q = 0; q < 2; ++q) { const int idx = wave * 2 + q, i = idx >> 2, jj = idx & 3;
                const float dot = wave_sum(qgL[lane * 4 + i] * kaL[lane * 4 + jj] + qgL[(lane + 64) * 4 + i] * kaL[(lane + 64) * 4 + jj]); if (lane == 0) Am[idx] = dot; }
            float o[4] = {0.f, 0.f, 0.f, 0.f};
            float* dst = kp.out() + O_GLA_S + ((size_t)j * 128 + bs) * SZ + (size_t)h * 32768 + (size_t)(dh * 64) * 256 + e;
#pragma unroll
            for (int i = 0; i < 64; ++i) { const int d = dh * 64 + i; const float s0 = S[i]; float acc = s0; const f32x4 q4 = *(const LAS f32x4*)(qgL + d * 4), k4 = *(const LAS f32x4*)(kaL + d * 4);
#pragma unroll
                for (int t = 0; t < 4; ++t) { o[t] += q4[t] * s0; acc += k4[t] * v[t]; }
                *dst = egL[d] * acc; dst += 256; asm volatile("" : "+v"(dst)); }
#pragma unroll
            for (int t = 0; t < 4; ++t) red[(dh * 4 + t) * 256 + e] = o[t];
            __syncthreads();
            if (dh == 0) {
#pragma unroll
                for (int t = 0; t < 4; ++t) { float oo = red[t * 256 + e] + red[(4 + t) * 256 + e];
#pragma unroll
                    for (int jj = 0; jj <= t; ++jj) oo += Am[t * 4 + jj] * v[jj];
                    OGLA[(size_t)(r0 + t) * 1024 + h * 256 + e] = (bf16)f2bf(oo); } }
        }
    }
    SEC_END(13, lds)
}

__device__ __forceinline__ void phase_ab_post(const KP kp, const int bid, const int G, int j, int tid, int wave, int lane) {
    unsigned char* scr = kp.ws() + WS_SCR; const bf16* U = (const bf16*)(kp.ws() + WS_U); bf16* YM = (bf16*)(kp.ws() + WS_YM);
    const bf16* ODN = (const bf16*)(scr + SC_ODN); const bf16* OGLA = (const bf16*)(scr + SC_OGLA);
    const float* dnn = kp.in(17) + (size_t)j * 128; const float* glan = kp.in(20) + (size_t)j * 256;
    typedef float f32x2v __attribute__((ext_vector_type(2)));
    const f32x2v dg = *(const f32x2v*)(dnn + 2 * lane); const f32x4 gg = *(const f32x4*)(glan + 4 * lane);
    for (int idx = bid * NWAVES + wave; idx < T; idx += G * NWAVES) {
        const int gq_ = idx / 17, rq_ = idx - gq_ * 17, r = rq_ < 16 ? gq_ * 16 + rq_ : TP + gq_;
        int s, t; row_to_seq(r, s, t); int row0, L; seq_info(s, row0, L);
        const bf16* ur = U + (size_t)r * NAB; bf16* yr = YM + (size_t)r * DM;
        f32x2v od[8]; unsigned zd[8]; f32x4 og[4]; u32x2 zg[4];
#pragma unroll
        for (int hh = 0; hh < 8; ++hh) { const unsigned ow_ = *(const unsigned*)(ODN + (size_t)r * 1024 + hh * 128 + 2 * lane); od[hh] = (f32x2v){__uint_as_float(ow_ << 16), __uint_as_float(ow_ & 0xffff0000u)}; zd[hh] = *(const unsigned*)(ur + 3072 + hh * 128 + 2 * lane); }
#pragma unroll
        for (int hh = 0; hh < 4; ++hh) { const u32x2 ow_ = *(const u32x2*)(OGLA + (size_t)r * 1024 + hh * 256 + 4 * lane); og[hh] = (f32x4){__uint_as_float(ow_.x << 16), __uint_as_float(ow_.x & 0xffff0000u), __uint_as_float(ow_.y << 16), __uint_as_float(ow_.y & 0xffff0000u)}; zg[hh] = *(const u32x2*)(ur + 6144 + hh * 256 + 4 * lane); }
#pragma unroll
        for (int hh = 0; hh < 8; ++hh) { const f32x2v o = od[hh];
            const float rstd = rsqrtf(wave_sum(o.x * o.x + o.y * o.y) * (1.f / 128.f) + 1e-6f);
            const unsigned zz = zd[hh];
            *(unsigned*)(yr + hh * 128 + 2 * lane) = pk2(o.x * rstd * dg.x * silu_(__uint_as_float(zz << 16)), o.y * rstd * dg.y * silu_(__uint_as_float(zz & 0xffff0000u))); }
#pragma unroll
        for (int hh = 0; hh < 4; ++hh) { const f32x4 o = og[hh];
            const float rstd = rsqrtf(wave_sum((o.x * o.x + o.y * o.y) + (o.z * o.z + o.w * o.w)) * (1.f / 256.f) + 1e-6f);
            const u32x2 zz = zg[hh];
            u32x2 w; w.x = pk2(o.x * rstd * gg.x * silu_(__uint_as_float(zz.x << 16)), o.y * rstd * gg.y * silu_(__uint_as_float(zz.x & 0xffff0000u)));
            w.y = pk2(o.z * rstd * gg.z * silu_(__uint_as_float(zz.y << 16)), o.w * rstd * gg.w * silu_(__uint_as_float(zz.y & 0xffff0000u)));
            *(u32x2*)(yr + 1024 + hh * 256 + 4 * lane) = w; }
        if (t >= L - 3) { const int rr = t - (L - 3);
            float* dst = s < 4 ? kp.out() + O_DNC_P + (((size_t)j * 4 + s) * 3 + rr) * 3072 : kp.out() + O_DNC_S + (((size_t)j * 128 + (s - 4)) * 3 + rr) * 3072;
            for (int c = 2 * lane; c < 3072; c += 128) { const unsigned uu = *(const unsigned*)(ur + c); *(f32x2v*)(dst + c) = (f32x2v){__uint_as_float(uu << 16), __uint_as_float(uu & 0xffff0000u)}; } }
    }
}

__device__ __forceinline__ void phase_lru_gates(const KP kp, const int bid, const int G, int j, LAS unsigned char* lds, int tid0) {
    unsigned char* scr = kp.ws() + WS_SCR; const bf16* U = (const bf16*)(kp.ws() + WS_U);
    float* LA = (float*)(scr + SC_LA); float* LB = (float*)(scr + SC_LB);
    const float* lcw = kp.in(29) + (size_t)j * 4 * 1024; const float* lcb = kp.in(30) + (size_t)j * 1024; const float* lstc = kp.in(8) + (size_t)j * 128 * 3 * 1024;
    const int n = bid & 15;
    const float* wa = kp.in(31) + ((size_t)j * 16 + n) * 4096; const float* wx = kp.in(33) + ((size_t)j * 16 + n) * 4096;
    const float* lba = kp.in(32) + (size_t)j * 1024; const float* lbx = kp.in(34) + (size_t)j * 1024; const float* lam = kp.in(35) + (size_t)j * 1024;
    LAS bf16x8* WF = (LAS bf16x8*)lds;
    LAS float* xcL = (LAS float*)(lds + 16384);
    LAS float* igL = xcL + 64 * 68;
    __syncthreads();
    { const int lane = tid0 & 63, f = tid0 >> 6, r = lane & 31, hp = lane >> 5, nt = f >> 2, ks = f & 3; float v[8];
#pragma unroll
      for (int jp = 0; jp < 8; ++jp) v[jp] = wa[(16 * ks + 8 * hp + jp) * 64 + 32 * nt + r];
      WF[f * 64 + lane] = pack8(v);
#pragma unroll
      for (int jp = 0; jp < 8; ++jp) v[jp] = wx[(16 * ks + 8 * hp + jp) * 64 + 32 * nt + r];
      WF[512 + f * 64 + lane] = pack8(v); }
    for (int tile = bid >> 4; tile < T / 64; tile += (G >> 4)) {
        int tid = tid0; asm volatile("" : "+v"(tid));
        const int c = tid & 63, tq = tid >> 6, ch = n * 64 + c, rowbase = tile * 64;
        __syncthreads();
        if (tile < TP / 64) {
            const int r0 = rowbase + tq * 8; const bool first = ((r0 & 2047) == 0);
            const float w0 = lcw[ch], w1 = lcw[1024 + ch], w2 = lcw[2048 + ch], w3 = lcw[3072 + ch], bb = lcb[ch];
            const bf16* up = U + (size_t)r0 * NCD + 3584 + ch;
            const long fo = first ? 0 : (long)NCD;
              float x0 = bf2f(up[-3 * fo]), x1 = bf2f(up[-2 * fo]), x2 = bf2f(up[-1 * fo]); if (first) { x0 = 0.f; x1 = 0.f; x2 = 0.f; }
#pragma unroll
            for (int tt = 0; tt < 8; ++tt) { const float x3 = bf2f(up[(size_t)tt * NCD]); xcL[(tq * 8 + tt) * 68 + c] = bb + w0 * x0 + w1 * x1 + w2 * x2 + w3 * x3; x0 = x1; x1 = x2; x2 = x3; }
        } else {
#pragma unroll 2
            for (int tt = 0; tt < 8; ++tt) { const int r = rowbase + tq * 8 + tt; int s, t; row_to_seq(r, s, t); const int row0 = r - t; float acc = lcb[ch];
#pragma unroll
                for (int tap = 0; tap < 4; ++tap) acc += lcw[tap * 1024 + ch] * pre_val(U, NCD, 3584 + ch, row0, t - 3 + tap, s, lstc, 1024, ch);
                xcL[(tq * 8 + tt) * 68 + c] = acc; }
        }
        __syncthreads();
        const int wave = __builtin_amdgcn_readfirstlane(tid >> 6), lane = tid & 63, r = lane & 31, hp = lane >> 5, mat = wave >> 2, mt = (wave >> 1) & 1, nt = wave & 1;
        f32x16 acc;
#pragma unroll
        for (int i = 0; i < 16; ++i) acc[i] = 0.f;
#pragma unroll
        for (int ks = 0; ks < 4; ++ks) { const LAS float* xp = xcL + (32 * mt + r) * 68 + 16 * ks + 8 * hp; const f32x4 xa = *(const LAS f32x4*)xp, xb = *(const LAS f32x4*)(xp + 4);
            const bf16x8 af = __builtin_bit_cast(bf16x8, (u32x4){cvtpk(xa.x, xa.y), cvtpk(xa.z, xa.w), cvtpk(xb.x, xb.y), cvtpk(xb.z, xb.w)});
            acc = MFMA32(af, WF[mat * 512 + (nt * 4 + ks) * 64 + lane], acc); }
        const int chh = n * 64 + 32 * nt + r;
        if (mat == 1) { const float bx = lbx[chh];
#pragma unroll
            for (int i = 0; i < 16; ++i) igL[(32 * mt + crow(i, hp)) * 65 + 32 * nt + r] = sigmoid_(acc[i] + bx); }
        __syncthreads();
        if (mat == 0) { const float ba = lba[chh], spl = softplus_(-lam[chh]);
#pragma unroll
            for (int i = 0; i < 16; ++i) { const int tk = 32 * mt + crow(i, hp); const size_t ro = (size_t)(rowbase + tk) * 1024 + chh;
                const float log_a = -8.f * sigmoid_(acc[i] + ba) * spl;
                LA[ro] = __expf(log_a); LB[ro] = __builtin_amdgcn_sqrtf(1.f - __expf(2.f * log_a)) * (igL[tk * 65 + 32 * nt + r] * xcL[tk * 68 + 32 * nt + r]); } }
    }
}

constexpr size_t SSD_ITEM_BYTES = 33792;
__device__ __forceinline__ void phase_ssd_prep(const KP kp, const int bid, const int G, int j, LAS unsigned char* lds, int tid0) {
    unsigned char* scr = kp.ws() + WS_SCR;
    const bf16* U = (const bf16*)(kp.ws() + WS_U); bf16* XS = (bf16*)(scr + SC_XS);
    const float* cw = kp.in(23) + (size_t)j * 4 * 1536; const float* cb = kp.in(24) + (size_t)j * 1536;
    unsigned char* OPS = scr + SC_SSDOP;
    LAS float* GL = (LAS float*)lds; LAS float* DTL = GL + 256; LAS float* QK = DTL + 256; LAS bf16* Cb = (LAS bf16*)(QK + 64 * 65); LAS bf16* Bb = Cb + 64 * 72; LAS float* XLs = (LAS float*)(Bb + 64 * 72);
    const float* alog = kp.in(25) + j * 16;
    for (int item = bid; item < 512; item += G) {
        int tid = tid0; asm volatile("" : "+v"(tid));
        const int wave = tid >> 6, lane = tid & 63, r = lane & 31, hp = lane >> 5;
        const int b = item >> 7, n = (item >> 2) & 31, g = item & 3;
        const int row0 = b * 2048 + n * 64;
        __syncthreads();
        {
          const int t0 = 8 * wave; const bool first = (n == 0 && wave == 0); const long fo = first ? 0 : (long)NCD;
#pragma unroll
          for (int q = 0; q < 3; ++q) { const int k = 2 * (lane + 64 * q);
              const int cidx = k < 64 ? 1024 + g * 64 + k : (k < 128 ? 1280 + g * 64 + (k - 64) : g * 256 + (k - 128));
              const float w0a = cw[cidx], w0b = cw[cidx + 1], w1a = cw[1536 + cidx], w1b = cw[1536 + cidx + 1], w2a = cw[2 * 1536 + cidx], w2b = cw[2 * 1536 + cidx + 1], w3a = cw[3 * 1536 + cidx], w3b = cw[3 * 1536 + cidx + 1];
              const float ba = cb[cidx], bb = cb[cidx + 1];
              const bf16* up = U + (size_t)(row0 + t0) * NCD + 1024 + cidx;
              unsigned raw[11];
              raw[0] = *(const unsigned*)(up - 3 * fo); raw[1] = *(const unsigned*)(up - 2 * fo); raw[2] = *(const unsigned*)(up - 1 * fo);
#pragma unroll
              for (int t = 0; t < 8; ++t) raw[3 + t] = *(const unsigned*)(up + (size_t)t * NCD);
              if (first) { raw[0] = 0u; raw[1] = 0u; raw[2] = 0u; }
#pragma unroll
              for (int t = 0; t < 8; ++t) {
                  const float ya = silu_(ba + w0a * __uint_as_float(raw[t] << 16) + w1a * __uint_as_float(raw[t + 1] << 16) + w2a * __uint_as_float(raw[t + 2] << 16) + w3a * __uint_as_float(raw[t + 3] << 16));
                  const float yb = silu_(bb + w0b * __uint_as_float(raw[t] & 0xffff0000u) + w1b * __uint_as_float(raw[t + 1] & 0xffff0000u) + w2b * __uint_as_float(raw[t + 2] & 0xffff0000u) + w3b * __uint_as_float(raw[t + 3] & 0xffff0000u));
                  if (q == 0) { if (k < 64) *(LAS unsigned*)(Bb + (t0 + t) * 72 + k) = pk2(ya, yb); else *(LAS unsigned*)(Cb + (t0 + t) * 72 + (k - 64)) = pk2(ya, yb); }
                  else { XLs[(t0 + t) * 257 + (k - 128)] = ya; XLs[(t0 + t) * 257 + (k - 128) + 1] = yb; } } } }
        if (wave < 4) { const int h = g * 4 + wave; const float dt = softplus_(bf2f(U[(size_t)(row0 + lane) * NCD + 4608 + h]) + kp.in(26)[j * 16 + h]);
            DTL[wave * 64 + lane] = dt; float gv = -__expf(alog[h]) * dt;
#pragma unroll
            for (int o = 1; o < 64; o <<= 1) { const float tt = __shfl_up(gv, o); if (lane >= o) gv += tt; }
            GL[wave * 64 + lane] = gv; }
        __syncthreads();
        if (wave < 4) {
            const int mt = wave >> 1, nt = wave & 1;
            f32x16 acc;
#pragma unroll
            for (int i = 0; i < 16; ++i) acc[i] = 0.f;
#pragma unroll
            for (int ks = 0; ks < 4; ++ks) acc = MFMA32(*(const LAS bf16x8*)(Cb + (32 * mt + r) * 72 + 16 * ks + 8 * hp), *(const LAS bf16x8*)(Bb + (32 * nt + r) * 72 + 16 * ks + 8 * hp), acc);
#pragma unroll
            for (int i16 = 0; i16 < 16; ++i16) QK[(32 * mt + crow(i16, hp)) * 65 + 32 * nt + r] = acc[i16];
        } else {
            for (int i = tid - 256; i < 8192; i += 256) { const int t = i >> 7, k2 = i & 127;
                ((unsigned*)XS)[((size_t)(row0 + t) * 1024 + g * 256) / 2 + k2] = pk2(XLs[t * 257 + 2 * k2], XLs[t * 257 + 2 * k2 + 1]); }
        }
        __syncthreads();
        const int f = wave, mt = f >> 2, ks = f & 3;
        for (int hh = 0; hh < 4; ++hh) {
            const int h = g * 4 + hh; const LAS float* Gh = GL + hh * 64; const float Gend = Gh[63];
            bf16x8* base = (bf16x8*)(OPS + ((size_t)((b * 32 + n) * 16 + h)) * SSD_ITEM_BYTES);
            float v[8];
            { const int i = 32 * mt + r; const float eg = __expf(Gh[i]);
#pragma unroll
              for (int jp = 0; jp < 8; ++jp) { const int d = 16 * ks + 8 * (jp >> 2) + 4 * hp + (jp & 3); v[jp] = bf2f(Cb[i * 72 + d]) * eg; }
              base[0 * 512 + f * 64 + lane] = pack8(v); }
            { const int d = 32 * mt + r;
#pragma unroll
              for (int jp = 0; jp < 8; ++jp) { const int tk = 16 * ks + 8 * (jp >> 2) + 4 * hp + (jp & 3); v[jp] = bf2f(Bb[tk * 72 + d]) * __expf(Gend - Gh[tk]); }
              base[1 * 512 + f * 64 + lane] = pack8(v); }
            { const int i = 32 * mt + r; const float gi = Gh[i];
#pragma unroll
              for (int jp = 0; jp < 8; ++jp) { const int jt = 16 * ks + 8 * (jp >> 2) + 4 * hp + (jp & 3); v[jp] = jt <= i ? QK[i * 65 + jt] * __expf(gi - Gh[jt]) : 0.f; }
              base[2 * 512 + f * 64 + lane] = pack8(v); }
            { const int p = 32 * mt + r;
#pragma unroll
              for (int jp = 0; jp < 8; ++jp) { const int tk = 16 * ks + 8 * (jp >> 2) + 4 * hp + (jp & 3);
                  v[jp] = XLs[tk * 257 + hh * 64 + p] * DTL[hh * 64 + tk]; }
              base[3 * 512 + f * 64 + lane] = pack8(v); }
            if (tid == 0) *(float*)(base + 32 * 64) = __expf(Gend);
        }
    }
}

__device__ __forceinline__ void phase_cd_rec(const KP kp, const int bid, const int G, int j, int li, LAS unsigned char* lds, int tid0) {
    unsigned char* scr = kp.ws() + WS_SCR; const bf16* U = (const bf16*)(kp.ws() + WS_U);
    const float* LA = (const float*)(scr + SC_LA); const float* LB = (const float*)(scr + SC_LB);
    bf16* YS = (bf16*)(scr + SC_YS); bf16* HS = (bf16*)(scr + SC_HS); bf16* XS = (bf16*)(scr + SC_XS);
    SEC_BEGIN(10)
    for (int item = bid; item < 64; item += G) {
        int tid = tid0; asm volatile("" : "+v"(tid));
        const int b = item >> 4, hd = item & 15;
        __syncthreads();
        const int wave = __builtin_amdgcn_readfirstlane(tid >> 6), lane = tid & 63, r = lane & 31, hp = lane >> 5, nt = wave;
        const unsigned char* OPS = scr + SC_SSDOP;
        const bool dmaw = (wave >= 2 && wave < 6);
        constexpr int SLOT = 33 * 1024;
#define SSD_DMA(n_) do { if (dmaw) { const unsigned char* gi_ = OPS + ((size_t)((b * 32 + (n_)) * 16 + hd)) * SSD_ITEM_BYTES + lane * 16; \
            _Pragma("unroll") for (int q_ = 0; q_ < 9; ++q_) { const int lf_ = q_ < 8 ? (wave - 2) * 8 + q_ : 32; \
                __builtin_amdgcn_global_load_lds((const unsigned*)(gi_ + lf_ * 1024), (LAS unsigned*)(lds + ((n_) & 3) * SLOT + lf_ * 1024), 16, 0, 2); } } } while (0)
        f32x16 S0, S1;
#pragma unroll
        for (int i = 0; i < 16; ++i) { S0[i] = 0.f; S1[i] = 0.f; }
        SSD_DMA(0); SSD_DMA(1); SSD_DMA(2);
        if (dmaw) asm volatile("s_waitcnt vmcnt(18)" ::: "memory");
        asm volatile("" ::: "memory"); __builtin_amdgcn_s_barrier(); asm volatile("" ::: "memory");
        for (int n = 0; n < 32; ++n) {
            if (n + 3 < 32) SSD_DMA(n + 3);
            if (wave < 2) {
                const LAS bf16x8* F = (const LAS bf16x8*)(lds + (n & 3) * SLOT) + lane;
                bf16x8 vb[4];
#pragma unroll
                for (int ks = 0; ks < 4; ++ks) vb[ks] = F[(24 + nt * 4 + ks) * 64];
                const float gend = *(const LAS float*)(lds + (n & 3) * SLOT + 32 * 1024);
                const bf16x8 sb00 = PACK_ACC(S0, 0), sb01 = PACK_ACC(S0, 1), sb10 = PACK_ACC(S1, 0), sb11 = PACK_ACC(S1, 1);
                f32x16 O0, O1;
#pragma unroll
                for (int i = 0; i < 16; ++i) { O0[i] = 0.f; O1[i] = 0.f; }
                O0 = MFMA32(F[0 * 64], sb00, O0); O0 = MFMA32(F[1 * 64], sb01, O0); O0 = MFMA32(F[2 * 64], sb10, O0); O0 = MFMA32(F[3 * 64], sb11, O0);
                O1 = MFMA32(F[4 * 64], sb00, O1); O1 = MFMA32(F[5 * 64], sb01, O1); O1 = MFMA32(F[6 * 64], sb10, O1); O1 = MFMA32(F[7 * 64], sb11, O1);
                O0 = MFMA32(F[16 * 64], vb[0], O0); O0 = MFMA32(F[17 * 64], vb[1], O0);
#pragma unroll
                for (int ks = 0; ks < 4; ++ks) O1 = MFMA32(F[(20 + ks) * 64], vb[ks], O1);
#pragma unroll
                for (int i = 0; i < 16; ++i) { S0[i] *= gend; S1[i] *= gend; }
#pragma unroll
                for (int ks = 0; ks < 4; ++ks) { S0 = MFMA32(F[(8 + ks) * 64], vb[ks], S0); S1 = MFMA32(F[(12 + ks) * 64], vb[ks], S1); }
                bf16* yo = YS + (size_t)(b * 2048 + n * 64) * 1024 + hd * 64 + 32 * nt + r;
#pragma unroll
                for (int i = 0; i < 16; ++i) { yo[(size_t)crow(i, hp) * 1024] = (bf16)f2bf(O0[i]); yo[(size_t)(32 + crow(i, hp)) * 1024] = (bf16)f2bf(O1[i]); }
            }
            if (dmaw) { if (n + 3 < 32) asm volatile("s_waitcnt vmcnt(18)" ::: "memory"); else if (n + 2 < 32) asm volatile("s_waitcnt vmcnt(9)" ::: "memory"); else asm volatile("s_waitcnt vmcnt(0)" ::: "memory"); }
            asm volatile("s_waitcnt lgkmcnt(0)" ::: "memory"); __builtin_amdgcn_s_barrier(); asm volatile("" ::: "memory");
        }
#undef SSD_DMA
        if (wave < 2) {
            float* dst = kp.out() + O_SSD_P + ((size_t)j * 4 + b) * ((size_t)16 * 64 * 64) + (size_t)hd * 64 * 64 + 32 * nt + r;
#pragma unroll
            for (int i = 0; i < 16; ++i) { dst[(size_t)crow(i, hp) * 64] = S0[i]; dst[(size_t)(32 + crow(i, hp)) * 64] = S1[i]; }
        }
    }
    SEC_END(10, lds)
    SEC_BEGIN(11)
    unsigned* qhead = (unsigned*)(kp.ws() + WS_CTL) + CW_CNT + 64 * li;
    volatile LAS unsigned* qslot = (volatile LAS unsigned*)(lds + LDS_BYTES - 8);
    const float* cw = kp.in(23) + (size_t)j * 4 * 1536; const float* cb = kp.in(24) + (size_t)j * 1536; const float* stc = kp.in(6) + (size_t)j * 128 * 3 * 1536;
    for (;;) {
        __syncthreads();
        if (tid0 == 0) qslot[0] = __hip_atomic_fetch_add(qhead, 1u, __ATOMIC_RELAXED, __HIP_MEMORY_SCOPE_AGENT);
        __syncthreads();
        const int it = (int)qslot[0];
        if (it >= 1024) break;
        int tid = tid0; asm volatile("" : "+v"(tid));
        if (it < 256) {
            const int s = it >> 6, h = it & 63; int row0, L; seq_info(s, row0, L);
            LAS float* Al = (LAS float*)lds; LAS float* Bl = Al + 512;
            const int chunk = tid >> 4, c16 = tid & 15, ch = h * 16 + c16;
            const size_t ro = (size_t)(row0 + chunk * 64) * 1024 + ch;
            float av[64], bv[64];
            { const float* pa = LA + ro; const float* pb = LB + ro;
#pragma unroll
              for (int t = 0; t < 64; ++t) { av[t] = *pa; bv[t] = *pb; pa += 1024; pb += 1024; asm volatile("" : "+v"(pa), "+v"(pb)); } }
            float Ap = 1.f, Bp = 0.f;
#pragma unroll
            for (int t = 0; t < 64; ++t) { Bp = av[t] * Bp + bv[t]; Ap *= av[t]; }
            Al[tid] = Ap; Bl[tid] = Bp;
            __syncthreads();
            float hh = 0.f;
            for (int m = 0; m < chunk; ++m) hh = Al[m * 16 + c16] * hh + Bl[m * 16 + c16];
            { bf16* ph = HS + ro;
#pragma unroll
              for (int t = 0; t < 64; ++t) { hh = av[t] * hh + bv[t]; *ph = (bf16)f2bf(hh); ph += 1024; asm volatile("" : "+v"(ph)); } }
            if (chunk == 31) kp.out()[O_LRU_P + ((size_t)j * 4 + s) * 1024 + ch] = hh;
        } else if (it < 768) {
            const int q_ = it - 256, bs = q_ >> 2, g = q_ & 3, sq = 4 + bs, r0 = TP + bs * 4;
            LAS float* BL = (LAS float*)lds; LAS float* CL = BL + 256; LAS float* XL = CL + 256; LAS float* DTL = XL + 1024; LAS float* QKs = DTL + 16; LAS float* red = QKs + 16;
            const int wave = tid >> 6, lane = tid & 63, hh = tid >> 7, nh = (tid >> 6) & 1, p = tid & 63, hd = 4 * g + hh;
            const size_t SZ = (size_t)16 * 64 * 64;
            const float* st = kp.in(5) + ((size_t)j * 128 + bs) * SZ + (size_t)hd * 4096;
            float S[32];
            { const float* sp = st + (size_t)(nh * 32) * 64 + p;
#pragma unroll
              for (int i = 0; i < 32; ++i) { S[i] = *sp; sp += 64; asm volatile("" : "+v"(sp)); } }
            { const int ci = tid & 127, tk = tid >> 7;
#pragma unroll
              for (int q = 0; q < 3; ++q) { const int k = ci + 128 * q; int cidx; LAS float* dst;
                  if (k < 64) { cidx = 1024 + g * 64 + k; dst = BL + k * 4 + tk; } else if (k < 128) { cidx = 1280 + g * 64 + (k - 64); dst = CL + (k - 64) * 4 + tk; } else { cidx = g * 256 + (k - 128); dst = XL + tk * 256 + (k - 128); }
                  float acc = cb[cidx];
#pragma unroll
                  for (int tap = 0; tap < 4; ++tap) acc += cw[tap * 1536 + cidx] * pre_val(U, NCD, 1024 + cidx, r0, tk - 3 + tap, sq, stc, 1536, cidx);
                  *dst = silu_(acc); } }
            if (tid < 16) { const int tk = tid >> 2, h2 = tid & 3; DTL[tid] = softplus_(bf2f(U[(size_t)(r0 + tk) * NCD + 4608 + 4 * g + h2]) + kp.in(26)[j * 16 + 4 * g + h2]); }
            __syncthreads();
#pragma unroll
            for (int q = 0; q < 2; ++q) { const int idx = wave * 2 + q, i = idx >> 2, jj = idx & 3; const float dot = wave_sum(CL[lane * 4 + i] * BL[lane * 4 + jj]); if (lane == 0) QKs[idx] = dot; }
            { const int tk = tid >> 7, k2 = tid & 127; ((unsigned*)XS)[((size_t)(r0 + tk) * 1024 + g * 256) / 2 + k2] = pk2(XL[tk * 256 + 2 * k2], XL[tk * 256 + 2 * k2 + 1]); }
            const float negA = -__expf(kp.in(25)[j * 16 + hd]);
            float Gc[4], xd[4], w[4];
            Gc[0] = negA * DTL[hh]; Gc[1] = Gc[0] + negA * DTL[4 + hh]; Gc[2] = Gc[1] + negA * DTL[8 + hh]; Gc[3] = Gc[2] + negA * DTL[12 + hh];
#pragma unroll
            for (int jj = 0; jj < 4; ++jj) { xd[jj] = XL[jj * 256 + hh * 64 + p] * DTL[jj * 4 + hh]; w[jj] = __expf(Gc[3] - Gc[jj]) * xd[jj]; }
            const float eg = __expf(Gc[3]);
            float o[4] = {0.f, 0.f, 0.f, 0.f};
            float* dst = kp.out() + O_SSD_S + ((size_t)j * 128 + bs) * SZ + (size_t)hd * 4096 + (size_t)(nh * 32) * 64 + p;
#pragma unroll
            for (int i = 0; i < 32; ++i) { const int n = nh * 32 + i; const float s0 = S[i]; float acc = eg * s0; const f32x4 c4 = *(const LAS f32x4*)(CL + n * 4), b4 = *(const LAS f32x4*)(BL + n * 4);
#pragma unroll
                for (int t = 0; t < 4; ++t) { o[t] += c4[t] * s0; acc += b4[t] * w[t]; }
                *dst = acc; dst += 64; asm volatile("" : "+v"(dst)); }
#pragma unroll
            for (int t = 0; t < 4; ++t) red[((hh * 2 + nh) * 4 + t) * 64 + p] = o[t];
            __syncthreads();
            if (nh == 0) {
#pragma unroll
                for (int t = 0; t < 4; ++t) { float y = __expf(Gc[t]) * (red[((hh * 2) * 4 + t) * 64 + p] + red[((hh * 2 + 1) * 4 + t) * 64 + p]);
#pragma unroll
                    for (int jj = 0; jj <= t; ++jj) y += QKs[t * 4 + jj] * __expf(Gc[t] - Gc[jj]) * xd[jj];
                    YS[(size_t)(r0 + t) * 1024 + hd * 64 + p] = (bf16)f2bf(y); } }
        } else {
            const int q_ = it - 768, s = 4 + (q_ >> 1), h = q_ & 1; int row0, L; seq_info(s, row0, L);
            const int ch = h * 512 + tid;
            float hh = s < 4 ? 0.f : kp.in(7)[((size_t)j * 128 + (s - 4)) * 1024 + ch];
#pragma unroll 8
            for (int t = 0; t < L; ++t) { const size_t r = (size_t)(row0 + t); hh = LA[r * 1024 + ch] * hh + LB[r * 1024 + ch]; HS[r * 1024 + ch] = (bf16)f2bf(hh); }
            float* dst = s < 4 ? kp.out() + O_LRU_P + ((size_t)j * 4 + s) * 1024 : kp.out() + O_LRU_S + ((size_t)j * 128 + (s - 4)) * 1024;
            dst[ch] = hh;
        }
    }
    SEC_END(11, lds)
}

__device__ __forceinline__ void phase_cd_post(const KP kp, const int bid, const int G, int j, int tid, int wave, int lane) {
    unsigned char* scr = kp.ws() + WS_SCR; const bf16* U = (const bf16*)(kp.ws() + WS_U); bf16* YM = (bf16*)(kp.ws() + WS_YM);
    const bf16* YS = (const bf16*)(scr + SC_YS); const bf16* HS = (const bf16*)(scr + SC_HS); const bf16* XS = (const bf16*)(scr + SC_XS);
    const float* sn = kp.in(28) + (size_t)j * 1024; const float* Dv = kp.in(27) + (size_t)j * 16;
    typedef float f32x2v __attribute__((ext_vector_type(2)));
    for (int idx = bid * NWAVES + wave; idx < T; idx += G * NWAVES) {
        const int gq_ = idx / 17, rq_ = idx - gq_ * 17, r = rq_ < 16 ? gq_ * 16 + rq_ : TP + gq_;
        int s, t; row_to_seq(r, s, t); int row0, L; seq_info(s, row0, L);
        const bf16* ur = U + (size_t)r * NCD; bf16* yr = YM + (size_t)r * DM;
        f32x4 ysv[4], hsv[4]; u32x2 xxv[4], zzv[4], zlv[4];
#pragma unroll
        for (int gq = 0; gq < 4; ++gq) { const int e = gq * 256 + 4 * lane; { const u32x2 yw_ = *(const u32x2*)(YS + (size_t)r * 1024 + e); ysv[gq] = (f32x4){__uint_as_float(yw_.x << 16), __uint_as_float(yw_.x & 0xffff0000u), __uint_as_float(yw_.y << 16), __uint_as_float(yw_.y & 0xffff0000u)}; } xxv[gq] = *(const u32x2*)(XS + (size_t)r * 1024 + e); zzv[gq] = *(const u32x2*)(ur + e);
            { const u32x2 hw_ = *(const u32x2*)(HS + (size_t)r * 1024 + e); hsv[gq] = (f32x4){__uint_as_float(hw_.x << 16), __uint_as_float(hw_.x & 0xffff0000u), __uint_as_float(hw_.y << 16), __uint_as_float(hw_.y & 0xffff0000u)}; } zlv[gq] = *(const u32x2*)(ur + 2560 + e); }
#pragma unroll
        for (int gq = 0; gq < 4; ++gq) { const int e = gq * 256 + 4 * lane; const f32x4 ys = ysv[gq];
            const u32x2 xx = xxv[gq], zz = zzv[gq]; const float Dh = Dv[e >> 6];
            f32x4 y; y.x = (ys.x + Dh * __uint_as_float(xx.x << 16)) * silu_(__uint_as_float(zz.x << 16)); y.y = (ys.y + Dh * __uint_as_float(xx.x & 0xffff0000u)) * silu_(__uint_as_float(zz.x & 0xffff0000u));
            y.z = (ys.z + Dh * __uint_as_float(xx.y << 16)) * silu_(__uint_as_float(zz.y << 16)); y.w = (ys.w + Dh * __uint_as_float(xx.y & 0xffff0000u)) * silu_(__uint_as_float(zz.y & 0xffff0000u));
            const float rstd = rsqrtf(wave_sum((y.x * y.x + y.y * y.y) + (y.z * y.z + y.w * y.w)) * (1.f / 256.f) + 1e-6f);
            const f32x4 g4 = *(const f32x4*)(sn + e);
            u32x2 w; w.x = pk2(y.x * rstd * g4.x, y.y * rstd * g4.y); w.y = pk2(y.z * rstd * g4.z, y.w * rstd * g4.w); *(u32x2*)(yr + e) = w; }
#pragma unroll
        for (int gq = 0; gq < 4; ++gq) { const int ch = gq * 256 + 4 * lane; const f32x4 hs = hsv[gq]; const u32x2 zz = zlv[gq];
            u32x2 w; w.x = pk2(hs.x * silu_(__uint_as_float(zz.x << 16)), hs.y * silu_(__uint_as_float(zz.x & 0xffff0000u))); w.y = pk2(hs.z * silu_(__uint_as_float(zz.y << 16)), hs.w * silu_(__uint_as_float(zz.y & 0xffff0000u)));
            *(u32x2*)(yr + 1024 + ch) = w; }
        if (t >= L - 3) { const int rr = t - (L - 3);
            float* d1 = s < 4 ? kp.out() + O_SSDC_P + (((size_t)j * 4 + s) * 3 + rr) * 1536 : kp.out() + O_SSDC_S + (((size_t)j * 128 + (s - 4)) * 3 + rr) * 1536;
            for (int c = 2 * lane; c < 1536; c += 128) { const unsigned uu = *(const unsigned*)(ur + 1024 + c); *(f32x2v*)(d1 + c) = (f32x2v){__uint_as_float(uu << 16), __uint_as_float(uu & 0xffff0000u)}; }
            float* d2 = s < 4 ? kp.out() + O_LRUC_P + (((size_t)j * 4 + s) * 3 + rr) * 1024 : kp.out() + O_LRUC_S + (((size_t)j * 128 + (s - 4)) * 3 + rr) * 1024;
            for (int c = 2 * lane; c < 1024; c += 128) { const unsigned uu = *(const unsigned*)(ur + 3584 + c); *(f32x2v*)(d2 + c) = (f32x2v){__uint_as_float(uu << 16), __uint_as_float(uu & 0xffff0000u)}; } }
    }
}


typedef float f32x4m __attribute__((ext_vector_type(4)));
template <bool GATE>
__device__ __forceinline__ void sample_gemm_res(LAS unsigned char* lds, const bf16* Amat, const bf16* Bt, const bf16* Hin, bf16* Hout, float* rss_out, const bf16* PP, const float* rss_in, int bid, int tid) {
    if (bid >= 256) return;
    const int wave = tid >> 6, lane = tid & 63, lr = lane & 15, kg = lane >> 4;
    const int m0 = TP + (bid & 7) * 64, n0 = (bid >> 3) * 64;
    const bf16x8* ap = (const bf16x8*)(Amat + (size_t)(m0 + lr) * 2048 + wave * 256 + 8 * kg);
    const bf16x8* bp = (const bf16x8*)(Bt + (size_t)(n0 + lr) * 2048 + wave * 256 + 8 * kg);
    f32x4m acc[4][4];
#pragma unroll
    for (int mi = 0; mi < 4; ++mi)
#pragma unroll
        for (int ni = 0; ni < 4; ++ni) acc[mi][ni] = (f32x4m){0.f, 0.f, 0.f, 0.f};
#pragma unroll 2
    for (int ks = 0; ks < 8; ++ks) { bf16x8 a[4], b[4];
#pragma unroll
        for (int q = 0; q < 4; ++q) { a[q] = ap[(size_t)q * 16 * 256 + ks * 4]; b[q] = bp[(size_t)q * 16 * 256 + ks * 4]; }
#pragma unroll
        for (int mi = 0; mi < 4; ++mi)
#pragma unroll
            for (int ni = 0; ni < 4; ++ni) acc[mi][ni] = __builtin_amdgcn_mfma_f32_16x16x32_bf16(a[mi], b[ni], acc[mi][ni], 0, 0, 0); }
    LAS float* red = (LAS float*)lds;
    __syncthreads();
#pragma unroll
    for (int mi = 0; mi < 4; ++mi)
#pragma unroll
        for (int ni = 0; ni < 4; ++ni)
#pragma unroll
            for (int i = 0; i < 4; ++i) red[(wave * 64 + 16 * mi + kg * 4 + i) * 65 + 16 * ni + lr] = acc[mi][ni][i];
    __syncthreads();
    { const int row = tid >> 3, c8 = (tid & 7) * 8, grow = m0 + row; float v[8];
#pragma unroll
      for (int e = 0; e < 8; ++e) { float sacc = 0.f;
#pragma unroll
          for (int w = 0; w < 8; ++w) sacc += red[(w * 64 + row) * 65 + c8 + e];
          v[e] = sacc; }
      float sc = 1.f; if (GATE) sc = rsqrtf(rss_in[grow] * (1.f / 2048.f) + 1e-6f);
      const size_t p = (size_t)grow * 2048 + n0 + c8;
      const u32x4 hw = *(const u32x4*)(Hin + p); u32x4 pw = (u32x4){0u, 0u, 0u, 0u}; if (GATE) pw = *(const u32x4*)(PP + p);
      const unsigned hws[4] = {hw.x, hw.y, hw.z, hw.w}, pws[4] = {pw.x, pw.y, pw.z, pw.w}; unsigned ow[4]; float sq = 0.f;
#pragma unroll
      for (int e2 = 0; e2 < 4; ++e2) { float h0 = __uint_as_float(hws[e2] << 16), h1 = __uint_as_float(hws[e2] & 0xffff0000u);
          if (GATE) { h0 += __builtin_amdgcn_rcpf(1.f + __expf(-sc * v[2 * e2])) * __uint_as_float(pws[e2] << 16); h1 += __builtin_amdgcn_rcpf(1.f + __expf(-sc * v[2 * e2 + 1])) * __uint_as_float(pws[e2] & 0xffff0000u); }
          else { h0 += v[2 * e2]; h1 += v[2 * e2 + 1]; }
          sq += h0 * h0 + h1 * h1; ow[e2] = cvtpk(h0, h1); }
      *(u32x4*)(Hout + p) = (u32x4){ow[0], ow[1], ow[2], ow[3]};
      sq += __shfl_xor(sq, 1); sq += __shfl_xor(sq, 2); sq += __shfl_xor(sq, 4);
      if ((tid & 7) == 0) atomicAdd(rss_out + grow, sq); }
}

__global__ void __launch_bounds__(NTHR, 2) mega_fwd(Args A) {
    extern __shared__ __attribute__((aligned(16))) unsigned char lds_raw[];
    LAS unsigned char* lds = (LAS unsigned char*)lds_raw;
    const int G = gridDim.x;
    volatile LAS unsigned* bst = (volatile LAS unsigned*)(lds + LDS_BYTES - 16);
    if (threadIdx.x == 0) { bst[0] = 0u; bst[1] = 0u;
#ifdef PROBE_SEC
        *(volatile LAS unsigned long long*)(lds + LDS_BYTES - 32) = 0ull;
#endif
    }
    __syncthreads();
    XcdBarrier xbar = xcd_barrier_post((unsigned*)(A.ws + WS_CTL) + CW_BAR, bst);
#ifdef PROBE_GROUP
    unsigned long long t_prev = __builtin_amdgcn_s_memrealtime(), t_sel = 0;
#endif
    for (int ph = A.ph_lo; ph < A.ph_hi; ++ph) {
        KP kp; kp.p = (const char AS4*)__builtin_amdgcn_kernarg_segment_ptr(); asm volatile("" : "+s"(kp.p));
        unsigned char* ws = kp.ws();
        int tid = threadIdx.x; asm volatile("" : "+v"(tid));
        int bid = blockIdx.x; asm volatile("" : "+s"(bid));
        const int lane = tid & 63, wave = __builtin_amdgcn_readfirstlane(tid >> 6), gw = bid * NWAVES + wave, NGW = G * NWAVES;
        if (ph == 0) { if (PH_MASK & 1) phase_prologue(kp, lds, gw, NGW, wave, lane); }
        else if (ph == N_PHASES - 1) { SEC_BEGIN(32) phase_final(kp, gw, NGW, lane); SEC_END(32, lds) }
        else {
            const int li = (ph - 1) / SUBS, sub = (ph - 1) % SUBS, j = li >> 1; const bool ab = (li & 1) == 0;
            float* RSS = (float*)(ws + WS_RSS);
            if (sub == 0) {
                const int N = ab ? NAB : NCD;
                const bf16* Bt = ab ? (const bf16*)(ws + WS_WABIN) + (size_t)j * NAB * 2048 : (const bf16*)(ws + WS_WCDIN) + (size_t)j * NCD * 2048;
                { pg8::Gemm g{(const bf16*)(ws + WS_XN), Bt, T, N, 2048}; pg8::StaticOrder S; S.init(T, N, G, bid);
                  pg8::EpiU E{(bf16*)(ws + WS_U), N, RSS + (size_t)(2 * li) * T};
                  if (PH_MASK & 2) pg8::gemm_phase<pg8::EpiU, pg8::StaticOrder, true, true>(lds, g, S, E, tid); }
                { int tid2 = tid; asm volatile("" : "+v"(tid2));
                  int pM = T, pG = G, pc = bid, prow = 0;
                  if (G == 256) { if (ab) { if (bid >= 218) { pM = 4864; pG = 38; pc = bid - 218; } else { prow = 4864; pM = T - 4864; pG = 120; pc = bid; } }
                                  else { pG = 122; pc = bid >= 134 ? bid - 134 : 100000; } }
                  pg8::StaticOrder S; S.init(pM, 2048, pG, pc);
                  pg8::Gemm g{(const bf16*)(ws + WS_PB) + ((size_t)li * T + prow) * 256, (const bf16*)(ws + WS_WPROJ) + (size_t)li * 2048 * 256, pM, 2048, 256};
                  pg8::EpiU E{(bf16*)(ws + WS_SCR + SC_PP) + (size_t)prow * 2048, 2048, nullptr};
                  if (PH_MASK & 2) pg8::gemm_phase<pg8::EpiU, pg8::StaticOrder, true, true>(lds, g, S, E, tid2); }
            } else if (sub == 4) {
                const bf16* Bt = ab ? (const bf16*)(ws + WS_WABOUT) + (size_t)j * 2048 * 2048 : (const bf16*)(ws + WS_WCDOUT) + (size_t)j * 2048 * 2048;
                pg8::Gemm g{(const bf16*)(ws + WS_YM), Bt, TP, 2048, 2048}; pg8::StaticOrder S; S.init(TP, 2048, G, bid);
                pg8::EpiRes<false> E{(const bf16*)(ws + WS_XN), (bf16*)(ws + WS_SCR + SC_HB1), RSS + (size_t)(2 * li + 1) * T, nullptr, nullptr};
                if (PH_MASK & 4) pg8::gemm_phase<pg8::EpiRes<false>, pg8::StaticOrder, true, true>(lds, g, S, E, tid);
                { int tid2 = tid; asm volatile("" : "+v"(tid2));
                  sample_gemm_res<false>(lds, (const bf16*)(ws + WS_YM), Bt, (const bf16*)(ws + WS_XN), (bf16*)(ws + WS_SCR + SC_HB1), RSS + (size_t)(2 * li + 1) * T, nullptr, nullptr, bid, tid2); }
            } else if (sub == 5) {
                pg8::Gemm g{(const bf16*)(ws + WS_SCR + SC_HB1), (const bf16*)(ws + WS_WGATE) + (size_t)li * 2048 * 2048, TP, 2048, 2048}; pg8::StaticOrder S; S.init(TP, 2048, G, bid);
                pg8::EpiRes<true> E{(const bf16*)(ws + WS_SCR + SC_HB1), (bf16*)(ws + WS_XN), RSS + (size_t)(2 * li + 2) * T, (const bf16*)(ws + WS_SCR + SC_PP), RSS + (size_t)(2 * li + 1) * T};
                if (PH_MASK & 4) pg8::gemm_phase<pg8::EpiRes<true>, pg8::StaticOrder, true, true>(lds, g, S, E, tid);
                { int tid2 = tid; asm volatile("" : "+v"(tid2));
                  sample_gemm_res<true>(lds, (const bf16*)(ws + WS_SCR + SC_HB1), (const bf16*)(ws + WS_WGATE) + (size_t)li * 2048 * 2048, (const bf16*)(ws + WS_SCR + SC_HB1), (bf16*)(ws + WS_XN), RSS + (size_t)(2 * li + 2) * T,
                                        (const bf16*)(ws + WS_SCR + SC_PP), RSS + (size_t)(2 * li + 1) * T, bid, tid2); }
            } else if (sub == 1) {
                if (ab) { SEC_BEGIN(3) if (PH_MASK & 4096) phase_gla_prep(kp, bid, G, j, lds, tid); SEC_END(3, lds) SEC_BEGIN(4) if (PH_MASK & 8192) phase_dn_prep(kp, bid, G, j, lds, tid); SEC_END(4, lds) }
                else { if (PH_MASK & 2048) { SEC_BEGIN(8) phase_ssd_prep(kp, bid, G, j, lds, tid); SEC_END(8, lds) SEC_BEGIN(9) phase_lru_gates(kp, bid, G, j, lds, tid); SEC_END(9, lds) } }
            }
            else if (sub == 2) { if (ab) { if (PH_MASK & 32) phase_ab_rec(kp, bid, G, j, li, lds, tid); } else { if (PH_MASK & 64) phase_cd_rec(kp, bid, G, j, li, lds, tid); } }
            else { if (ab) { SEC_BEGIN(30) if (PH_MASK & 128) phase_ab_post(kp, bid, G, j, tid, wave, lane); SEC_END(30, lds) } else { SEC_BEGIN(31) if (PH_MASK & 256) phase_cd_post(kp, bid, G, j, tid, wave, lane); SEC_END(31, lds) } }
        }
        if (ph + 1 < A.ph_hi) { if (ph == A.ph_lo) cg::this_grid().sync(); else xcd_barrier(xbar); }
#ifdef PROBE_GROUP
        { const unsigned long long t_now = __builtin_amdgcn_s_memrealtime(); const int li_ = (ph - 1) / SUBS, sub_ = (ph - 1) % SUBS; const bool ab_ = (li_ & 1) == 0;
          int grp = 9; if (ph == N_PHASES - 1) grp = 8; else if (ph > 0) { if (sub_ == 0 || sub_ == 4 || sub_ == 5) grp = 1; else if (sub_ == 1) grp = ab_ ? 4 : 5; else if (sub_ == 2) grp = ab_ ? 6 : 7; else grp = 8; }
          if (grp == PROBE_GROUP) t_sel += t_now - t_prev; t_prev = t_now; }
#endif
    }
#ifdef PROBE_SEC
    if (blockIdx.x == PROBE_BLK && threadIdx.x == 0) { const unsigned long long t_s = *(volatile LAS unsigned long long*)(lds + LDS_BYTES - 32); const unsigned long long t0 = __builtin_amdgcn_s_memrealtime(); while (__builtin_amdgcn_s_memrealtime() - t0 < 3 * t_s) __builtin_amdgcn_s_sleep(8); }
#endif
#ifdef PROBE_GROUP
    if (blockIdx.x == 0 && threadIdx.x == 0) { const unsigned long long t0 = __builtin_amdgcn_s_memrealtime(); while (__builtin_amdgcn_s_memrealtime() - t0 < 3 * t_sel) __builtin_amdgcn_s_sleep(8); }
#endif
}

extern "C" void kernel_launch(void* const* d_in, const int* in_sizes, int n_in, void* d_out, int out_size, void* d_ws, size_t ws_size, hipStream_t stream) {
    static int grid = 0;
    if (grid == 0) {
        if (n_in != 40 || (size_t)out_size != O_END || ws_size < WS_END) { fprintf(stderr, "kernel_launch: unexpected shapes: n_in %d out %d ws %zu\n", n_in, out_size, ws_size); grid = -1; return; }
        int dev = 0, cus = 0, per_cu = 0;
        if (hipGetDevice(&dev) != hipSuccess || hipDeviceGetAttribute(&cus, hipDeviceAttributeMultiprocessorCount, dev) != hipSuccess) { grid = -1; return; }
        if (hipFuncSetAttribute((const void*)mega_fwd, hipFuncAttributeMaxDynamicSharedMemorySize, LDS_BYTES) != hipSuccess) { fprintf(stderr, "kernel_launch: hipFuncSetAttribute failed\n"); grid = -1; return; }
        if (hipOccupancyMaxActiveBlocksPerMultiprocessor(&per_cu, (const void*)mega_fwd, NTHR, LDS_BYTES) != hipSuccess || per_cu < 1) { fprintf(stderr, "kernel_launch: occupancy query says %d\n", per_cu); per_cu = 1; }
        (void)hipGetLastError();
        grid = cus;
    }
    if (grid < 0) return;
    if (hipMemsetAsync((char*)d_ws + WS_CTL, 0, CTL_ZERO_BYTES, stream) != hipSuccess) { fprintf(stderr, "kernel_launch: memset of the control words failed\n"); return; }
    Args a{};
    for (int i = 0; i < 40; ++i) a.in[i] = (const float*)d_in[i];
    a.out = (float*)d_out; a.ws = (unsigned char*)d_ws;
#if MK_N_LAUNCHES == 1
    a.ph_lo = 0; a.ph_hi = N_PHASES;
    void* args[] = {&a};
    hipError_t e = hipLaunchCooperativeKernel((const void*)mega_fwd, dim3(grid), dim3(NTHR), args, LDS_BYTES, stream);
    if (e != hipSuccess) fprintf(stderr, "cooperative launch failed: %s (grid %d)\n", hipGetErrorString(e), grid);
#else
    for (int ph = 0; ph < N_PHASES; ++ph) { a.ph_lo = ph; a.ph_hi = ph + 1; mega_fwd<<<dim3(grid), dim3(NTHR), LDS_BYTES, stream>>>(a); }
#endif
}
```

```cpp
#include <hip/hip_runtime.h>
#include <hip/hip_cooperative_groups.h>
#include <cstdio>
#include <cstdint>
namespace cg = cooperative_groups;

#ifndef MK_N_LAUNCHES
#define MK_N_LAUNCHES 1
#endif

namespace pg8 {
#define PG8_LAS __attribute__((address_space(3)))
typedef unsigned short bf16_t;
typedef short bf16x8 __attribute__((ext_vector_type(8)));
typedef float f32x4 __attribute__((ext_vector_type(4)));
typedef unsigned u32x4 __attribute__((ext_vector_type(4)));
constexpr int BM = 256, BK = 64, HALF = 128, HTB = HALF * BK * 2  , STAGE_BYTES = 8 * HTB, NXCD = 8, WGM = 8;

__host__ __device__ __forceinline__ int lds_byte(int r, int c) { const int st = (r >> 4) * 2 + (c >> 5), rr = r & 15, cc = c & 31, ob = rr * 64 + cc * 2; return st * 1024 + (ob ^ (((ob >> 9) & 1) << 5)); }
__host__ __device__ __forceinline__ void stage_rc(int b, int& R, int& C) { const int st = b / 1024, sb = b % 1024, swz = sb ^ (((sb >> 9) & 1) << 5); R = (st >> 1) * 16 + swz / 64; C = (st & 1) * 32 + (swz % 64) / 2; }
__host__ __device__ __forceinline__ int perm32(int rho) { const int n = rho >> 4, i = rho & 15; return 8 * (i >> 2) + 4 * n + (i & 3); }

struct Unit { int pm, pn; };
struct Gemm { const bf16_t* A; const bf16_t* Bt; int M, N, K; };

struct StaticOrder {
    int nM, nN, nwg, G, c;
    __host__ __device__ void init(int M, int N, int G_, int c_) { nM = M / BM; nN = N / BM; nwg = nM * nN; G = G_; c = c_; }
    __host__ __device__ bool next(int i, Unit& u) const {
        const long L = (long)i * G + c; if (L >= nwg) return false;
        int wgid = (int)L; { const int q = nwg / NXCD, r = nwg % NXCD, xcd = wgid % NXCD, off = wgid / NXCD; wgid = (xcd < r ? xcd * (q + 1) : r * (q + 1) + (xcd - r) * q) + off; }
        const int nig = WGM * nN, gid = wgid / nig, fm = gid * WGM, gsz = (nM - fm) < WGM ? (nM - fm) : WGM;
        u.pm = fm + ((wgid % nig) % gsz); u.pn = (wgid % nig) / gsz; return true;
    }
    __device__ __forceinline__ void a_ready(const Unit&) const {}
    __device__ __forceinline__ void done(const Unit&) const {}
};

__device__ __forceinline__ unsigned cvt_pk_bf16(float lo, float hi) { unsigned r; asm volatile("v_cvt_pk_bf16_f32 %0, %1, %2" : "=v"(r) : "v"(lo), "v"(hi)); return r; }
struct EpiF32 {
    static constexpr bool PERM = false, AFTER_DRAIN = false;
    float* C; int ldc;
    __device__ __forceinline__ void operator()(const f32x4 (&acc)[2][2][4][2], const Unit& u, int wr, int wc, int fr, int fq) const {
        const int row0 = u.pm * BM + wr * 64 + fr, col0 = u.pn * BM + wc * 32 + 4 * fq;
#pragma unroll
        for (int ai = 0; ai < 2; ++ai)
#pragma unroll
            for (int m = 0; m < 4; ++m) { float* rowp = C + (size_t)(row0 + ai * HALF + m * 16) * ldc + col0;
#pragma unroll
                for (int bj = 0; bj < 2; ++bj)
#pragma unroll
                    for (int n = 0; n < 2; ++n) *(f32x4*)(rowp + bj * HALF + n * 16) = acc[ai][bj][m][n]; }
    }
};
struct EpiBf16 {
    static constexpr bool PERM = true, AFTER_DRAIN = false;
    bf16_t* O; int ldc;
    __device__ __forceinline__ void operator()(const f32x4 (&acc)[2][2][4][2], const Unit& u, int wr, int wc, int fr, int fq) const {
        const int row0 = u.pm * BM + wr * 64 + fr; const int col0 = u.pn * BM + wc * 32 + 8 * fq;
#pragma unroll
        for (int ai = 0; ai < 2; ++ai)
#pragma unroll
            for (int m = 0; m < 4; ++m) { bf16_t* rowp = O + (size_t)(row0 + ai * HALF + m * 16) * ldc + col0;
#pragma unroll
                for (int bj = 0; bj < 2; ++bj) { const f32x4 v0 = acc[ai][bj][m][0], v1 = acc[ai][bj][m][1];
                    u32x4 w; w.x = cvt_pk_bf16(v0[0], v0[1]); w.y = cvt_pk_bf16(v0[2], v0[3]); w.z = cvt_pk_bf16(v1[0], v1[1]); w.w = cvt_pk_bf16(v1[2], v1[3]);
                    *(u32x4*)(rowp + bj * HALF) = w; } }
    }
};

struct RangeOrder {
    int start, count;
    __host__ __device__ bool next(int i, Unit& u) const { if (i >= count) return false; const int t = start + i; u.pm = t >> 3; u.pn = t & 7; return true; }
    __device__ __forceinline__ void a_ready(const Unit&) const {}
    __device__ __forceinline__ void done(const Unit&) const {}
};
struct EpiU {
    static constexpr bool PERM = true, AFTER_DRAIN = false;
    bf16_t* O; int ldc; const float* rss;
    __device__ __forceinline__ void operator()(const f32x4 (&acc)[2][2][4][2], const Unit& u, int wr, int wc, int fr, int fq) const {
        const int row0 = u.pm * BM + wr * 64 + fr; const int col0 = u.pn * BM + wc * 32 + 8 * fq;
#pragma unroll
        for (int ai = 0; ai < 2; ++ai)
#pragma unroll
            for (int m = 0; m < 4; ++m) { const int row = row0 + ai * HALF + m * 16; const float sc = rss ? rsqrtf(rss[row] * (1.f / 2048.f) + 1e-6f) : 1.f;
                bf16_t* rowp = O + (size_t)row * ldc + col0;
#pragma unroll
                for (int bj = 0; bj < 2; ++bj) { const f32x4 v0 = acc[ai][bj][m][0] * sc, v1 = acc[ai][bj][m][1] * sc;
                    u32x4 w; w.x = cvt_pk_bf16(v0[0], v0[1]); w.y = cvt_pk_bf16(v0[2], v0[3]); w.z = cvt_pk_bf16(v1[0], v1[1]); w.w = cvt_pk_bf16(v1[2], v1[3]);
                    *(u32x4*)(rowp + bj * HALF) = w; } }
    }
};
typedef unsigned u32x2e __attribute__((ext_vector_type(2)));
template <bool GATE> struct EpiRes {
    static constexpr bool PERM = false, AFTER_DRAIN = false;
    const bf16_t* Hin; bf16_t* Hout; float* rss_out; const bf16_t* PP; const float* rss_in;
    __device__ __forceinline__ void operator()(const f32x4 (&acc)[2][2][4][2], const Unit& u, int wr, int wc, int fr, int fq) const {
        const int row0 = u.pm * BM + wr * 64 + fr, col0 = u.pn * BM + wc * 32 + 4 * fq;
#pragma unroll
        for (int ai = 0; ai < 2; ++ai)
#pragma unroll
            for (int m = 0; m < 4; ++m) { const int row = row0 + ai * HALF + m * 16; const size_t ro = (size_t)row * 2048 + col0;
                float sc = 1.f; if (GATE) sc = rsqrtf(rss_in[row] * (1.f / 2048.f) + 1e-6f);
                float s = 0.f;
#pragma unroll
                for (int bj = 0; bj < 2; ++bj)
#pragma unroll
                    for (int n = 0; n < 2; ++n) { const size_t p = ro + bj * HALF + n * 16; const u32x2e hw = *(const u32x2e*)(Hin + p); const f32x4 a = acc[ai][bj][m][n];
                        f32x4 h; h[0] = __uint_as_float(hw.x << 16); h[1] = __uint_as_float(hw.x & 0xffff0000u); h[2] = __uint_as_float(hw.y << 16); h[3] = __uint_as_float(hw.y & 0xffff0000u);
                        if (GATE) { const u32x2e pw = *(const u32x2e*)(PP + p);
                            h[0] += __builtin_amdgcn_rcpf(1.f + __expf(-sc * a[0])) * __uint_as_float(pw.x << 16); h[1] += __builtin_amdgcn_rcpf(1.f + __expf(-sc * a[1])) * __uint_as_float(pw.x & 0xffff0000u);
                            h[2] += __builtin_amdgcn_rcpf(1.f + __expf(-sc * a[2])) * __uint_as_float(pw.y << 16); h[3] += __builtin_amdgcn_rcpf(1.f + __expf(-sc * a[3])) * __uint_as_float(pw.y & 0xffff0000u); }
                        else h = h + a;
                        s += (h[0] * h[0] + h[1] * h[1]) + (h[2] * h[2] + h[3] * h[3]);
                        u32x2e o; o.x = cvt_pk_bf16(h[0], h[1]); o.y = cvt_pk_bf16(h[2], h[3]); *(u32x2e*)(Hout + p) = o; }
                s += __shfl_xor(s, 16); s += __shfl_xor(s, 32);
                if (fq == 0) atomicAdd(rss_out + row, s);
                asm volatile("" ::: "memory"); }
    }
};
template <class Epi, class Sched, bool ALIGN_EPI = false, bool SP2 = false>
__device__ __forceinline__ void gemm_phase(PG8_LAS unsigned char* lds, const Gemm g, const Sched& S, const Epi& E, const int tid) {
    const int wid = __builtin_amdgcn_readfirstlane(tid >> 6), lane = tid & 63, wr = wid >> 2, wc = wid & 3, fr = lane & 15, fq = lane >> 4;
    const int K = g.K, nt = K / BK;
    unsigned voffA[2], voffB[2];
#pragma unroll
    for (int i = 0; i < 2; ++i) { int R, C; stage_rc(tid * 16 + i * 8192, R, C); const int Rb = Epi::PERM ? ((R & ~31) + perm32(R & 31)) : R;
        voffA[i] = (unsigned)(R * K + C) * 2u; voffB[i] = (unsigned)(Rb * K + C) * 2u; }
    const size_t kstep = (size_t)(BK * 2);
    const size_t hstep = (size_t)HALF * K * 2;
    const size_t tstep = 2 * hstep;
    const unsigned ldsw = (unsigned)wid * 1024u;
    const int aoff = lds_byte(wr * 64 + fr, fq * 8), boff = lds_byte(wc * 32 + fr, fq * 8);
#define PG8_SA(b, h) (((b) * 2 + (h)) * HTB)
#define PG8_SB(b, h) ((4 + (b) * 2 + (h)) * HTB)
#define PG8_STAGE(bufoff, gbase, voff) do { _Pragma("unroll") for (int _i = 0; _i < 2; ++_i) \
        __builtin_amdgcn_global_load_lds((const unsigned*)((const char*)(gbase) + (voff)[_i]), (PG8_LAS unsigned*)(lds + (bufoff) + ldsw + _i * 8192), 16, 0, 0); } while (0)
#define PG8_LDA(dst, b, h) do { _Pragma("unroll") for (int m = 0; m < 4; ++m) _Pragma("unroll") for (int k = 0; k < 2; ++k) dst[m][k] = *(const PG8_LAS bf16x8*)(lds + PG8_SA(b, h) + aoff + m * 2048 + k * 1024); } while (0)
#define PG8_LDB(dst, b, h) do { _Pragma("unroll") for (int n = 0; n < 2; ++n) _Pragma("unroll") for (int k = 0; k < 2; ++k) dst[n][k] = *(const PG8_LAS bf16x8*)(lds + PG8_SB(b, h) + boff + n * 2048 + k * 1024); } while (0)
#define PG8_MMA(ai, bj, At, Bt) do { __builtin_amdgcn_s_setprio(1); _Pragma("unroll") for (int m = 0; m < 4; ++m) _Pragma("unroll") for (int n = 0; n < 2; ++n) _Pragma("unroll") for (int k = 0; k < 2; ++k) \
        acc[ai][bj][m][n] = __builtin_amdgcn_mfma_f32_16x16x32_bf16(Bt[n][k], At[m][k], acc[ai][bj][m][n], 0, 0, 0); __builtin_amdgcn_s_setprio(0); } while (0)
#define PG8_WAIT_V(n) asm volatile("s_waitcnt vmcnt(" #n ")" ::: "memory")
#define PG8_WAIT_L(n) asm volatile("s_waitcnt lgkmcnt(" #n ")" ::: "memory")
#define PG8_BAR __builtin_amdgcn_s_barrier()
#define PG8_SCHED __builtin_amdgcn_sched_barrier(0)
    Unit cur, nxt; int ui = 0;
    if (!S.next(0, cur)) return;
    f32x4 acc[2][2][4][2];
#pragma unroll
    for (int a = 0; a < 2; ++a)
#pragma unroll
        for (int b = 0; b < 2; ++b)
#pragma unroll
            for (int m = 0; m < 4; ++m)
#pragma unroll
                for (int n = 0; n < 2; ++n) acc[a][b][m][n] = (f32x4){0.f, 0.f, 0.f, 0.f};
    bf16x8 At[4][2], B0[2][2], B1[2][2];
    const char* cA = (const char*)g.A + (size_t)cur.pm * tstep; const char* cB = (const char*)g.Bt + (size_t)cur.pn * tstep;
    S.a_ready(cur);
    if constexpr (SP2) {
        PG8_STAGE(PG8_SB(0, 0), cB, voffB); PG8_STAGE(PG8_SB(0, 1), cB + hstep, voffB); PG8_STAGE(PG8_SA(0, 0), cA, voffA); PG8_STAGE(PG8_SA(0, 1), cA + hstep, voffA);
        if (wr == 1) PG8_BAR;
        PG8_WAIT_V(2); PG8_BAR;
        PG8_STAGE(PG8_SB(1, 0), cB + kstep, voffB); PG8_STAGE(PG8_SA(1, 0), cA + kstep, voffA); PG8_STAGE(PG8_SB(1, 1), cB + hstep + kstep, voffB);
        PG8_WAIT_V(6); PG8_BAR;
    } else {
        PG8_STAGE(PG8_SB(0, 0), cB, voffB); PG8_STAGE(PG8_SA(0, 0), cA, voffA); PG8_STAGE(PG8_SB(0, 1), cB + hstep, voffB); PG8_STAGE(PG8_SA(0, 1), cA + hstep, voffA);
        if (wr == 1) PG8_BAR;
        PG8_WAIT_V(4); PG8_BAR;
        PG8_STAGE(PG8_SB(1, 0), cB + kstep, voffB); PG8_STAGE(PG8_SA(1, 0), cA + kstep, voffA); PG8_STAGE(PG8_SB(1, 1), cB + hstep + kstep, voffB);
        PG8_WAIT_V(6); PG8_BAR;
    }
    for (;;) {
        const bool has_next = S.next(ui + 1, nxt);
        const char* nA = has_next ? (const char*)g.A + (size_t)nxt.pm * tstep : cA; const char* nB = has_next ? (const char*)g.Bt + (size_t)nxt.pn * tstep : cB;
        for (int t = 0; t < nt; t += 2) {
            const bool last = (t == nt - 2);
            const char* a1 = cA + (size_t)(t + 1) * kstep;
            const char* a2 = last ? nA : cA + (size_t)(t + 2) * kstep; const char* b2 = last ? nB : cB + (size_t)(t + 2) * kstep;
            const char* a3 = a2 + kstep; const char* b3 = b2 + kstep;
            if (last && has_next) S.a_ready(nxt);
            if constexpr (SP2) {
            PG8_LDB(B0, 0, 0); PG8_LDB(B1, 0, 1); PG8_SCHED; PG8_LDA(At, 0, 0); PG8_STAGE(PG8_SA(1, 1), a1 + hstep, voffA);
            PG8_WAIT_V(8); PG8_WAIT_L(0); PG8_BAR; PG8_MMA(0, 0, At, B0); PG8_MMA(0, 1, At, B1); PG8_BAR; PG8_SCHED;
            PG8_LDA(At, 0, 1); PG8_STAGE(PG8_SB(0, 0), b2, voffB); PG8_STAGE(PG8_SB(0, 1), b2 + hstep, voffB); PG8_STAGE(PG8_SA(0, 0), a2, voffA);
            PG8_WAIT_V(8); PG8_WAIT_L(0); PG8_BAR; PG8_MMA(1, 0, At, B0); PG8_MMA(1, 1, At, B1); PG8_BAR; PG8_SCHED;
            PG8_LDB(B0, 1, 0); PG8_LDB(B1, 1, 1); PG8_SCHED; PG8_LDA(At, 1, 0); PG8_STAGE(PG8_SA(0, 1), a2 + hstep, voffA);
            PG8_WAIT_V(8); PG8_WAIT_L(0); PG8_BAR; PG8_MMA(0, 0, At, B0); PG8_MMA(0, 1, At, B1); PG8_BAR; PG8_SCHED;
            PG8_LDA(At, 1, 1); PG8_STAGE(PG8_SB(1, 0), b3, voffB); PG8_STAGE(PG8_SB(1, 1), b3 + hstep, voffB); PG8_STAGE(PG8_SA(1, 0), a3, voffA);
            PG8_WAIT_V(8); PG8_WAIT_L(0); PG8_BAR; PG8_MMA(1, 0, At, B0); PG8_MMA(1, 1, At, B1); PG8_BAR; PG8_SCHED;
            } else {
            PG8_LDB(B0, 0, 0); PG8_SCHED; PG8_LDA(At, 0, 0); PG8_STAGE(PG8_SA(1, 1), a1 + hstep, voffA);
            PG8_WAIT_L(8); PG8_BAR; PG8_WAIT_L(0); PG8_MMA(0, 0, At, B0); PG8_BAR; PG8_SCHED;
            PG8_LDB(B1, 0, 1); PG8_STAGE(PG8_SB(0, 0), b2, voffB);
            PG8_BAR; PG8_WAIT_L(0); PG8_MMA(0, 1, At, B1); PG8_BAR;
            PG8_LDA(At, 0, 1); PG8_STAGE(PG8_SA(0, 0), a2, voffA);
            PG8_BAR; PG8_WAIT_L(0); PG8_MMA(1, 0, At, B0); PG8_BAR; PG8_SCHED;
            PG8_STAGE(PG8_SB(0, 1), b2 + hstep, voffB);
            PG8_WAIT_V(6); PG8_BAR; PG8_MMA(1, 1, At, B1); PG8_BAR;
            PG8_LDB(B0, 1, 0); PG8_SCHED; PG8_LDA(At, 1, 0); PG8_STAGE(PG8_SA(0, 1), a2 + hstep, voffA);
            PG8_WAIT_L(8); PG8_BAR; PG8_WAIT_L(0); PG8_MMA(0, 0, At, B0); PG8_BAR; PG8_SCHED;
            PG8_LDB(B1, 1, 1); PG8_STAGE(PG8_SB(1, 0), b3, voffB);
            PG8_BAR; PG8_WAIT_L(0); PG8_MMA(0, 1, At, B1); PG8_BAR;
            PG8_LDA(At, 1, 1); PG8_STAGE(PG8_SA(1, 0), a3, voffA);
            PG8_BAR; PG8_WAIT_L(0); PG8_MMA(1, 0, At, B0); PG8_BAR; PG8_SCHED;
            PG8_STAGE(PG8_SB(1, 1), b3 + hstep, voffB);
            PG8_WAIT_V(6); PG8_BAR; PG8_MMA(1, 1, At, B1); PG8_BAR;
            }
        }
        if constexpr (ALIGN_EPI) { if (wr == 0) PG8_BAR; }
        if constexpr (!Epi::AFTER_DRAIN) { E(acc, cur, wr, wc, fr, fq); S.done(cur); }
        if (!has_next) break;
#pragma unroll
        for (int a = 0; a < 2; ++a)
#pragma unroll
            for (int b = 0; b < 2; ++b)
#pragma unroll
                for (int m = 0; m < 4; ++m)
#pragma unroll
                    for (int n = 0; n < 2; ++n) acc[a][b][m][n] = (f32x4){0.f, 0.f, 0.f, 0.f};
        cur = nxt; cA = nA; cB = nB; ++ui;
        if constexpr (ALIGN_EPI) { if (wr == 1) PG8_BAR; }
    }
    PG8_WAIT_V(0);
    if constexpr (!ALIGN_EPI) { if (wr == 0) PG8_BAR; }
    PG8_BAR;
    if constexpr (Epi::AFTER_DRAIN) { E.fused(acc, cur, wr, wc, fr, fq, lds, wid, lane); S.done(cur); }
#undef PG8_SA
#undef PG8_SB
#undef PG8_STAGE
#undef PG8_LDA
#undef PG8_LDB
#undef PG8_MMA
#undef PG8_WAIT_V
#undef PG8_WAIT_L
#undef PG8_BAR
#undef PG8_SCHED
}
}

constexpr int TP = 8192, TS = 512, T = TP + TS, DM = 2048, NSEQ = 132;
constexpr int NAB = 7424, NCD = 4864;
constexpr int NWAVES = 8, NTHR = 512;
constexpr size_t MiB = 1u << 20;
constexpr size_t WS_CTL = 0, CTL_ZERO_BYTES = 1 * MiB;
constexpr int CW_BAR = 4096, CW_CNT = 8192;
constexpr size_t WS_RSS = 65536;
constexpr size_t WS_WABIN = 2 * MiB, WS_WABOUT = 60 * MiB, WS_WCDIN = 76 * MiB, WS_WCDOUT = 114 * MiB, WS_WGATE = 130 * MiB, WS_WPROJ = 162 * MiB;
constexpr size_t WS_H = 166 * MiB, WS_XN = 234 * MiB, WS_YM = 268 * MiB, WS_PB = 302 * MiB, WS_U = 320 * MiB, WS_SCR = 444 * MiB, WS_END = 732 * MiB;
constexpr size_t SC_HB1 = 102 * MiB;
constexpr size_t SC_PP = 8 * MiB;
constexpr size_t SC_ODN = 102 * MiB, SC_OGLA = 136 * MiB, SC_DNOPS = 192 * MiB;
constexpr size_t SC_LA = 52 * MiB, SC_LB = 86 * MiB, SC_YS = 120 * MiB, SC_HS = 154 * MiB, SC_SSDOP = 192 * MiB, SC_XS = 270 * MiB;
constexpr int LDS_BYTES = 163840;
constexpr size_t O_Y_P = 0, O_Y_S = O_Y_P + (size_t)4 * 2048 * 2048, O_DN_P = O_Y_S + (size_t)128 * 4 * 2048,
    O_DNC_P = O_DN_P + (size_t)2 * 4 * 8 * 128 * 128, O_GLA_P = O_DNC_P + (size_t)2 * 4 * 3 * 3072, O_SSD_P = O_GLA_P + (size_t)2 * 4 * 4 * 128 * 256,
    O_SSDC_P = O_SSD_P + (size_t)2 * 4 * 16 * 64 * 64, O_LRU_P = O_SSDC_P + (size_t)2 * 4 * 3 * 1536, O_LRUC_P = O_LRU_P + (size_t)2 * 4 * 1024,
    O_DN_S = O_LRUC_P + (size_t)2 * 4 * 3 * 1024, O_DNC_S = O_DN_S + (size_t)2 * 128 * 8 * 128 * 128, O_GLA_S = O_DNC_S + (size_t)2 * 128 * 3 * 3072,
    O_SSD_S = O_GLA_S + (size_t)2 * 128 * 4 * 128 * 256, O_SSDC_S = O_SSD_S + (size_t)2 * 128 * 16 * 64 * 64, O_LRU_S = O_SSDC_S + (size_t)2 * 128 * 3 * 1536,
    O_LRUC_S = O_LRU_S + (size_t)2 * 128 * 1024, O_END = O_LRUC_S + (size_t)2 * 128 * 3 * 1024;
static_assert(O_END == 109064192, "output size");

#define LAS __attribute__((address_space(3)))
typedef unsigned short bf16;
typedef float f32x4 __attribute__((ext_vector_type(4)));
typedef unsigned u32x2 __attribute__((ext_vector_type(2)));
typedef unsigned u32x4 __attribute__((ext_vector_type(4)));
#define LDS_WAIT() asm volatile("s_waitcnt lgkmcnt(0)" ::: "memory")

__device__ __forceinline__ float bf2f(bf16 b) { return __uint_as_float(((unsigned)b) << 16); }
typedef __bf16 bf16x2_t __attribute__((ext_vector_type(2)));
typedef float f32x2_t __attribute__((ext_vector_type(2)));
__device__ __forceinline__ unsigned cvtpk(float lo, float hi) { f32x2_t v = {lo, hi}; bf16x2_t b = __builtin_convertvector(v, bf16x2_t); return __builtin_bit_cast(unsigned, b); }
__device__ __forceinline__ unsigned f2bf(float f) { return cvtpk(f, 0.f) & 0xffffu; }
__device__ __forceinline__ unsigned pk2(float lo, float hi) { return cvtpk(lo, hi); }
__device__ __forceinline__ float sigmoid_(float x) { return __builtin_amdgcn_rcpf(1.f + __expf(-x)); }
__device__ __forceinline__ float silu_(float x) { return x * __builtin_amdgcn_rcpf(1.f + __expf(-x)); }
__device__ __forceinline__ float softplus_(float x) { return x > 15.f ? x : (x < -15.f ? __expf(x) : __logf(1.f + __expf(x))); }
__device__ __forceinline__ float dpp_add(float v, float x) { return v + x; }
#define WS_DPP(v, ctrl, rmask) __builtin_bit_cast(float, __builtin_amdgcn_update_dpp(0, __builtin_bit_cast(int, (v)), (ctrl), (rmask), 0xf, false))
__device__ __forceinline__ float wave_sum(float v) {
    v += WS_DPP(v, 0xB1, 0xf);
    v += WS_DPP(v, 0x4E, 0xf);
    v += WS_DPP(v, 0x141, 0xf);
    v += WS_DPP(v, 0x140, 0xf);
    v += WS_DPP(v, 0x142, 0xa);
    v += WS_DPP(v, 0x143, 0xc);
    return __builtin_bit_cast(float, __builtin_amdgcn_readlane(__builtin_bit_cast(int, v), 63));
}
__device__ __forceinline__ void row_to_seq(int r, int& s, int& t) { if (r < TP) { s = r >> 11; t = r & 2047; } else { s = 4 + ((r - TP) >> 2); t = (r - TP) & 3; } }
__device__ __forceinline__ void seq_info(int s, int& row0, int& L) { if (s < 4) { row0 = s << 11; L = 2048; } else { row0 = TP + ((s - 4) << 2); L = 4; } }
__device__ __forceinline__ float pre_val(const bf16* U, int ldu, int ucol, int row0, int tt, int s, const float* stc, int W, int c) {
    const int tc = tt >= 0 ? tt : 0, sc = tt >= 0 ? 0 : 3 + tt;
    const float a = bf2f(U[(size_t)(row0 + tc) * ldu + ucol]), b = stc[((size_t)(s - 4) * 3 + sc) * W + c];
    return tt >= 0 ? a : b;
}
__device__ __forceinline__ int map_col(int mapid, int n) {
    if (mapid == 0) return n;
    if (mapid == 1) { if (n < 3072) return n; if (n < 6144) return n + 16; if (n < 7168) return n + 32; if (n < 7184) return n - 4096; if (n < 7200) return n - 1024; return -1; }
    if (n < 2560) return n; if (n < 4608) return n + 16; if (n < 4624) return n - 2048; return -1;
}
__device__ __forceinline__ void transpose_item(const float* W, int K, int Nsrc, bf16* WT, int Npad, int mapid, const float* gain, LAS float* scr, int item, int lane) {
    const int nblk = Npad / 64, kb = item / nblk, nb = item % nblk, k0 = 64 * kb, n0 = 64 * nb;
    const int n4 = (lane & 15) * 4, src = map_col(mapid, n0 + n4);
    const int srcc = src >= 0 ? src : 0; const float msk = src >= 0 ? 1.f : 0.f;
    f32x4 v[16];
#pragma unroll
    for (int i = 0; i < 16; ++i) v[i] = *(const f32x4*)(W + (size_t)(k0 + 4 * i + (lane >> 4)) * Nsrc + srcc);
    if (gain) {
#pragma unroll
        for (int i = 0; i < 16; ++i) v[i] = v[i] * (gain[k0 + 4 * i + (lane >> 4)] * msk);
    } else {
#pragma unroll
        for (int i = 0; i < 16; ++i) v[i] = v[i] * msk;
    }
#pragma unroll
    for (int i = 0; i < 16; ++i) { const int kk = 4 * i + (lane >> 4); scr[kk * 65 + n4] = v[i].x; scr[kk * 65 + n4 + 1] = v[i].y; scr[kk * 65 + n4 + 2] = v[i].z; scr[kk * 65 + n4 + 3] = v[i].w; }
    LDS_WAIT(); asm volatile("" ::: "memory");
    const int c = lane & 7;
#pragma unroll
    for (int jj = 0; jj < 8; ++jj) { const int n = (lane >> 3) + 8 * jj; const LAS float* p = scr + (8 * c) * 65 + n;
        u32x4 o; o.x = pk2(p[0 * 65], p[1 * 65]); o.y = pk2(p[2 * 65], p[3 * 65]); o.z = pk2(p[4 * 65], p[5 * 65]); o.w = pk2(p[6 * 65], p[7 * 65]);
        *(u32x4*)(WT + (size_t)(n0 + n) * K + k0 + 8 * c) = o; }
    LDS_WAIT(); asm volatile("" ::: "memory");
}
__device__ __forceinline__ void norm_row_bf16(const f32x4 (&v)[8], const float* g, bf16* orow, int lane) {
    float ss = 0.f;
#pragma unroll
    for (int j = 0; j < 8; ++j) ss += (v[j].x * v[j].x + v[j].y * v[j].y) + (v[j].z * v[j].z + v[j].w * v[j].w);
    const float rstd = rsqrtf(wave_sum(ss) * (1.f / DM) + 1e-6f);
#pragma unroll
    for (int j = 0; j < 8; ++j) { const int col = 4 * (lane + 64 * j); const f32x4 gg = *(const f32x4*)(g + col);
        u32x2 o; o.x = pk2(v[j].x * rstd * gg.x, v[j].y * rstd * gg.y); o.y = pk2(v[j].z * rstd * gg.z, v[j].w * rstd * gg.w);
        *(u32x2*)(orow + col) = o; }
}

typedef short bf16x8 __attribute__((ext_vector_type(8)));
typedef float f32x16 __attribute__((ext_vector_type(16)));
#define MFMA32(a, b, c) __builtin_amdgcn_mfma_f32_32x32x16_bf16((a), (b), (c), 0, 0, 0)
#define PACK_ACC(x, S_) __builtin_bit_cast(bf16x8, (u32x4){cvtpk((x)[8 * (S_)], (x)[8 * (S_) + 1]), cvtpk((x)[8 * (S_) + 2], (x)[8 * (S_) + 3]), cvtpk((x)[8 * (S_) + 4], (x)[8 * (S_) + 5]), cvtpk((x)[8 * (S_) + 6], (x)[8 * (S_) + 7])})
__device__ __forceinline__ int crow(int reg, int h) { return (reg & 3) + 8 * (reg >> 2) + 4 * h; }
__device__ __forceinline__ bf16x8 pack8(const float (&v)[8]) { return __builtin_bit_cast(bf16x8, (u32x4){cvtpk(v[0], v[1]), cvtpk(v[2], v[3]), cvtpk(v[4], v[5]), cvtpk(v[6], v[7])}); }

#define XB_TMO      128
#define XB_XCNT(j)  (256  + 64 * (j))
#define XB_XSUB(j)  (1280 + 64 * (j))
#define XB_XGEN(j)  (2304 + 64 * (j))
#define XB_TOP      3328
#define XB_TOPGEN   3392
#define XCD_BAR_WORDS 3456
#define XB_SPIN_CAP (1u << 18)

__device__ __forceinline__ unsigned xb_ld(unsigned* p)              { return __hip_atomic_load(p, __ATOMIC_RELAXED, __HIP_MEMORY_SCOPE_AGENT); }
__device__ __forceinline__ unsigned xb_add(unsigned* p, unsigned v) { return __hip_atomic_fetch_add(p, v, __ATOMIC_RELAXED, __HIP_MEMORY_SCOPE_AGENT); }
__device__ __forceinline__ unsigned xb_xcc_id() { return (unsigned)__builtin_amdgcn_s_getreg((3 << 11) | 20) & 0xFu; }
#define XB_SPIN(cond, bar) do { unsigned _sp = 0; while (cond) { __builtin_amdgcn_s_sleep(1); \
    if ((++_sp & 255u) == 0u) { if (xb_ld(&(bar)[XB_TMO])) break; if (_sp > XB_SPIN_CAP) { atomicAdd(&(bar)[XB_TMO], 1u); break; } } } } while (0)

struct XcdBarrier {
    unsigned* bar; unsigned x;
    volatile LAS unsigned* st;
};

__device__ __forceinline__ XcdBarrier xcd_barrier_post(unsigned* bar, volatile LAS unsigned* st) {
    XcdBarrier b; b.bar = bar; b.x = xb_xcc_id(); b.st = st;
    if (threadIdx.x == 0) (void)xb_add(&bar[XB_XCNT(b.x)], 1u);
    return b;
}
__device__ __forceinline__ void xcd_barrier_complete(unsigned* bar, unsigned x, unsigned& nloc, unsigned& nx) {
    const unsigned G = gridDim.x * gridDim.y * gridDim.z;
    unsigned sum, cnt, mine, sp = 0u;
    for (;;) {
        sum = 0u; cnt = 0u; mine = 0u;
#pragma unroll
        for (unsigned j = 0; j < 16; ++j) { const unsigned c = xb_ld(&bar[XB_XCNT(j)]); sum += c; cnt += (c > 0u) ? 1u : 0u; mine = (j == x) ? c : mine; }
        if (sum == G) break;
        __builtin_amdgcn_s_sleep(1);
        if ((++sp & 255u) == 0u) { if (xb_ld(&bar[XB_TMO])) break; if (sp > XB_SPIN_CAP) { atomicAdd(&bar[XB_TMO], 1u); break; } }
    }
    nloc = mine > 0u ? mine : 1u; nx = cnt > 0u ? cnt : 1u;
}

__device__ __forceinline__ void xcd_barrier(const XcdBarrier& b) {
    asm volatile("s_waitcnt vmcnt(0)" ::: "memory");
    __syncthreads();
    if (threadIdx.x == 0) {
        unsigned* bar = b.bar;
        __builtin_amdgcn_s_waitcnt(0);
        unsigned nloc = b.st[0], nx = b.st[1];
        if (nloc == 0u) { xcd_barrier_complete(bar, b.x, nloc, nx); b.st[0] = nloc; b.st[1] = nx; }
        const unsigned old = xb_add(&bar[XB_XSUB(b.x)], 1u);
        const unsigned gen = old / nloc;
        if (old + 1u == (gen + 1u) * nloc) {
            __builtin_amdgcn_fence(__ATOMIC_RELEASE, "agent");
            asm volatile("s_waitcnt vmcnt(0)" ::: "memory");
            const unsigned og = xb_add(&bar[XB_TOP], 1u);
            const unsigned tg = og / nx;
            if (og + 1u == (tg + 1u) * nx) xb_add(&bar[XB_TOPGEN], 1u);
            else XB_SPIN(xb_ld(&bar[XB_TOPGEN]) == tg, bar);
            __builtin_amdgcn_fence(__ATOMIC_ACQUIRE, "agent");
            xb_add(&bar[XB_XGEN(b.x)], 1u);
            asm volatile("s_waitcnt vmcnt(0)" ::: "memory");
        } else {
            XB_SPIN(xb_ld(&bar[XB_XGEN(b.x)]) == gen, bar);
            __builtin_amdgcn_fence(__ATOMIC_ACQUIRE, "agent");
            asm volatile("s_waitcnt vmcnt(0)" ::: "memory");
        }
    }
    __syncthreads();
}


#ifdef PROBE_SEC
#define SEC_BEGIN(id) unsigned long long _sec_t##id = 0; if ((id) == PROBE_SEC) { __builtin_amdgcn_s_barrier(); _sec_t##id = __builtin_amdgcn_s_memrealtime(); }
#define SEC_END(id, ldsp) if ((id) == PROBE_SEC) { __builtin_amdgcn_s_barrier(); if (threadIdx.x == 0) { volatile LAS unsigned long long* a_ = (volatile LAS unsigned long long*)((ldsp) + LDS_BYTES - 32); a_[0] = a_[0] + (__builtin_amdgcn_s_memrealtime() - _sec_t##id); } }
#define SECW_BEGIN(id) unsigned long long _secw_t##id = 0; if ((id) == PROBE_SEC) { _secw_t##id = __builtin_amdgcn_s_memrealtime(); }
#define SECW_END(id, ldsp, tsel) if ((id) == PROBE_SEC) { asm volatile("s_waitcnt vmcnt(0) lgkmcnt(0)" ::: "memory"); if (threadIdx.x == (tsel)) { volatile LAS unsigned long long* a_ = (volatile LAS unsigned long long*)((ldsp) + LDS_BYTES - 32); a_[0] = a_[0] + (__builtin_amdgcn_s_memrealtime() - _secw_t##id); } }
#else
#define SEC_BEGIN(id)
#define SEC_END(id, ldsp)
#define SECW_BEGIN(id)
#define SECW_END(id, ldsp, tsel)
#endif
struct Args { const float* in[40]; float* out; unsigned char* ws; int ph_lo, ph_hi; };
constexpr int N_PHASES = 26, SUBS = 6;
#ifndef PH_MASK
#define PH_MASK 16383
#endif
#define AS4 __attribute__((address_space(4)))
struct KP { const char AS4* p;
    __device__ __forceinline__ const float* in(int i) const { return *(const float* const AS4*)(p + 8 * i); }
    __device__ __forceinline__ float* out() const { return *(float* const AS4*)(p + 320); }
    __device__ __forceinline__ unsigned char* ws() const { return *(unsigned char* const AS4*)(p + 328); }
};
static_assert(sizeof(Args) == 344, "Args layout");

__device__ __forceinline__ void phase_prologue(const KP kp, LAS unsigned char* lds, int gw, int NGW, int wave, int lane) {
    unsigned char* ws = kp.ws();
    LAS float* scr = (LAS float*)(lds + wave * 17408);
    SEC_BEGIN(1)
    SEC_BEGIN(14)
    for (int job = 0; job < 16; ++job) {
        if (job == 2) { SEC_END(14, lds) }
        const float* W; int K = 2048, Nsrc = 2048, Npad = 2048, mapid = 0; bf16* WT; const float* gain = nullptr;
        if (job < 2)       { W = kp.in(13) + (size_t)job * 2048 * 7200; Nsrc = 7200; Npad = NAB; mapid = 1; WT = (bf16*)(ws + WS_WABIN) + (size_t)job * NAB * 2048; gain = kp.in(11) + (size_t)(2 * job) * DM; }
        else if (job < 4)  { W = kp.in(21) + (size_t)(job - 2) * 2048 * 2048; WT = (bf16*)(ws + WS_WABOUT) + (size_t)(job - 2) * 2048 * 2048; }
        else if (job < 6)  { W = kp.in(22) + (size_t)(job - 4) * 2048 * 4624; Nsrc = 4624; Npad = NCD; mapid = 2; WT = (bf16*)(ws + WS_WCDIN) + (size_t)(job - 4) * NCD * 2048; gain = kp.in(11) + (size_t)(2 * (job - 4) + 1) * DM; }
        else if (job < 8)  { W = kp.in(36) + (size_t)(job - 6) * 2048 * 2048; WT = (bf16*)(ws + WS_WCDOUT) + (size_t)(job - 6) * 2048 * 2048; }
        else if (job < 12) { W = kp.in(39) + (size_t)(job - 8) * 2048 * 2048; WT = (bf16*)(ws + WS_WGATE) + (size_t)(job - 8) * 2048 * 2048; gain = kp.in(38) + (size_t)(job - 8) * DM; }
        else               { W = kp.in(37) + (size_t)(job - 12) * 256 * 2048; K = 256; WT = (bf16*)(ws + WS_WPROJ) + (size_t)(job - 12) * 2048 * 256; }
        const int nitems = (K / 64) * (Npad / 64), nblocks = NGW / NWAVES, ipb = (nitems + nblocks - 1) / nblocks, ib = (gw / NWAVES) * ipb, ie = ib + ipb < nitems ? ib + ipb : nitems;
        for (int it = ib + wave; it < ie; it += NWAVES) transpose_item(W, K, Nsrc, WT, Npad, mapid, gain, scr, it, lane);
    }
    SEC_END(1, lds)
    SEC_BEGIN(2)
    bf16* HB = (bf16*)(ws + WS_XN); float* RSS = (float*)(ws + WS_RSS);
    for (int m = gw; m < T; m += NGW) {
        const float* src = m < TP ? kp.in(0) + (size_t)m * DM : kp.in(1) + (size_t)(m - TP) * DM;
        float ss = 0.f;
#pragma unroll
        for (int jj = 0; jj < 8; ++jj) { const int col = 4 * (lane + 64 * jj); const f32x4 v = *(const f32x4*)(src + col);
            u32x2 o; o.x = pk2(v.x, v.y); o.y = pk2(v.z, v.w); *(u32x2*)(HB + (size_t)m * DM + col) = o; ss += (v.x * v.x + v.y * v.y) + (v.z * v.z + v.w * v.w); }
        ss = wave_sum(ss); if (lane == 0) RSS[m] = ss;
    }
    bf16* PB = (bf16*)(ws + WS_PB);
    const int gt = gw * 64 + lane, NGT = NGW * 64;
    for (int i = gt; i < 4 * T * 64; i += NGT) {
        const int c4 = i & 63, rr = i >> 6, li = rr / T, r = rr - li * T;
        const float* src = r < TP ? kp.in(9) + ((size_t)li * TP + r) * 256 + 4 * c4 : kp.in(10) + ((size_t)li * TS + (r - TP)) * 256 + 4 * c4;
        const f32x4 v = *(const f32x4*)src;
        u32x2 o; o.x = pk2(v.x, v.y); o.y = pk2(v.z, v.w);
        *(u32x2*)(PB + ((size_t)li * T + r) * 256 + 4 * c4) = o;
    }
    SEC_END(2, lds)
}
__device__ __forceinline__ void phase_final(const KP kp, int gw, int NGW, int lane) {
    const bf16* HB = (const bf16*)(kp.ws() + WS_XN); const float* RSS = (const float*)(kp.ws() + WS_RSS) + (size_t)8 * T; const float* g = kp.in(12); float* out = kp.out();
    for (int m = gw; m < T; m += NGW) { const float rstd = rsqrtf(RSS[m] * (1.f / DM) + 1e-6f);
#pragma unroll
        for (int jj = 0; jj < 8; ++jj) { const int col = 4 * (lane + 64 * jj); const u32x2 hv = *(const u32x2*)(HB + (size_t)m * DM + col); const f32x4 gg = *(const f32x4*)(g + col);
            f32x4 o; o.x = __uint_as_float(hv.x << 16) * rstd * gg.x; o.y = __uint_as_float(hv.x & 0xffff0000u) * rstd * gg.y; o.z = __uint_as_float(hv.y << 16) * rstd * gg.z; o.w = __uint_as_float(hv.y & 0xffff0000u) * rstd * gg.w;
            *(f32x4*)(out + (size_t)m * DM + col) = o; } }
}

constexpr size_t GLA_ITEM_BYTES = 74752, WS_GLAOPS = WS_H;
__device__ __forceinline__ void phase_gla_prep(const KP kp, const int bid, const int G, int j, LAS unsigned char* lds, int tid0) {
    const bf16* U = (const bf16*)(kp.ws() + WS_U);
    const float* wa2 = kp.in(18) + (size_t)j * 16 * 512; const float* ba = kp.in(19) + (size_t)j * 512;
    unsigned char* OPS = kp.ws() + WS_GLAOPS;
    LAS float* GE = (LAS float*)lds; LAS float* Pg = GE + 128;
    LAS bf16* Qg = (LAS bf16*)(Pg + 512); LAS bf16* Ka = Qg + 64 * 136; LAS float* QKm = (LAS float*)(Ka + 64 * 136);
    for (int item = bid; item < 512; item += G) {
        int tid = tid0; asm volatile("" : "+v"(tid));
        const int lane = tid & 63, r = lane & 31, hp = lane >> 5, wave = tid >> 6;
        const int b = item >> 7, n = (item >> 2) & 31, h = item & 3;
        const int row0 = b * 2048 + n * 64;
        __syncthreads();
        const int d = tid & 127, tg = tid >> 7, t0 = 16 * tg;
        float q[16], k[16], gl[16];
        { float w[16];
#pragma unroll
          for (int rr = 0; rr < 16; ++rr) w[rr] = wa2[rr * 512 + h * 128 + d];
          const float bias = ba[h * 128 + d];
#pragma unroll
          for (int t = 0; t < 16; ++t) { const size_t ro = (size_t)(row0 + t0 + t) * NAB;
              q[t] = bf2f(U[ro + 4096 + h * 128 + d]) * 0.08838834764831845f; k[t] = bf2f(U[ro + 4608 + h * 128 + d]);
              const u32x4 g0 = *(const u32x4*)(U + ro + 7184), g1 = *(const u32x4*)(U + ro + 7192);
              float x = bias;
              x += __uint_as_float(g0.x << 16) * w[0] + __uint_as_float(g0.x & 0xffff0000u) * w[1] + __uint_as_float(g0.y << 16) * w[2] + __uint_as_float(g0.y & 0xffff0000u) * w[3];
              x += __uint_as_float(g0.z << 16) * w[4] + __uint_as_float(g0.z & 0xffff0000u) * w[5] + __uint_as_float(g0.w << 16) * w[6] + __uint_as_float(g0.w & 0xffff0000u) * w[7];
              x += __uint_as_float(g1.x << 16) * w[8] + __uint_as_float(g1.x & 0xffff0000u) * w[9] + __uint_as_float(g1.y << 16) * w[10] + __uint_as_float(g1.y & 0xffff0000u) * w[11];
              x += __uint_as_float(g1.z << 16) * w[12] + __uint_as_float(g1.z & 0xffff0000u) * w[13] + __uint_as_float(g1.w << 16) * w[14] + __uint_as_float(g1.w & 0xffff0000u) * w[15];
              gl[t] = -softplus_(-x) * (1.f / 16.f); } }
#pragma unroll
        for (int t = 1; t < 16; ++t) gl[t] += gl[t - 1];
        Pg[tg * 128 + d] = gl[15];
        __syncthreads();
        { float off = 0.f;
#pragma unroll
          for (int g = 0; g < 3; ++g) off += (g < tg) ? Pg[g * 128 + d] : 0.f;
          if (tg == 3) GE[d] = gl[15] + off;
#pragma unroll
          for (int t = 0; t < 16; ++t) { const float Gt = gl[t] + off; Qg[(t0 + t) * 136 + d] = (bf16)f2bf(q[t] * __expf(Gt)); Ka[(t0 + t) * 136 + d] = (bf16)f2bf(k[t] * __expf(-Gt)); } }
        __syncthreads();
        bf16x8* base = (bf16x8*)(OPS + (size_t)item * GLA_ITEM_BYTES);
        if (wave < 4) {
            const int mt = wave >> 1, nt = wave & 1;
            f32x16 acc;
#pragma unroll
            for (int i = 0; i < 16; ++i) acc[i] = 0.f;
#pragma unroll
            for (int ks = 0; ks < 8; ++ks) acc = MFMA32(*(const LAS bf16x8*)(Qg + (32 * mt + r) * 136 + 16 * ks + 8 * hp), *(const LAS bf16x8*)(Ka + (32 * nt + r) * 136 + 16 * ks + 8 * hp), acc);
            const int jt = 32 * nt + r;
#pragma unroll
            for (int i16 = 0; i16 < 16; ++i16) { const int i = 32 * mt + crow(i16, hp); QKm[i * 65 + jt] = jt <= i ? acc[i16] : 0.f; }
        } else {
            const int w4 = wave - 4;
#pragma unroll
            for (int q8 = 0; q8 < 8; ++q8) { const int f = w4 + 4 * q8, nt = f >> 2, ks = f & 3, p = 32 * nt + r;
                unsigned w[4];
#pragma unroll
                for (int jp = 0; jp < 8; jp += 2) { const int tk = 16 * ks + 8 * (jp >> 2) + 4 * hp + (jp & 3);
                    w[jp >> 1] = (unsigned)U[(size_t)(row0 + tk) * NAB + 5120 + h * 256 + p] | ((unsigned)U[(size_t)(row0 + tk + 1) * NAB + 5120 + h * 256 + p] << 16); }
                base[(40 + f) * 64 + lane] = __builtin_bit_cast(bf16x8, (u32x4){w[0], w[1], w[2], w[3]}); }
        }
        __syncthreads();
        float v[8];
#pragma unroll
        for (int q2 = 0; q2 < 2; ++q2) { const int f = wave + 8 * q2;
            { const int mt = f >> 3, ks = f & 7, i = 32 * mt + r;
              const u32x2 lo = *(const LAS u32x2*)(Qg + i * 136 + 16 * ks + 4 * hp), hi = *(const LAS u32x2*)(Qg + i * 136 + 16 * ks + 8 + 4 * hp);
              base[f * 64 + lane] = __builtin_bit_cast(bf16x8, (u32x4){lo.x, lo.y, hi.x, hi.y}); }
            { const int mt = f >> 2, ks = f & 3, dd = 32 * mt + r; const float eg = __expf(GE[dd]);
#pragma unroll
              for (int jp = 0; jp < 8; ++jp) v[jp] = bf2f(Ka[(16 * ks + 8 * (jp >> 2) + 4 * hp + (jp & 3)) * 136 + dd]) * eg;
              base[(16 + f) * 64 + lane] = pack8(v); } }
        { const int f = wave, mt = f >> 2, ks = f & 3, i = 32 * mt + r;
#pragma unroll
          for (int jp = 0; jp < 8; ++jp) v[jp] = QKm[i * 65 + 16 * ks + 8 * (jp >> 2) + 4 * hp + (jp & 3)];
          base[(32 + f) * 64 + lane] = pack8(v); }
        if (tid < 128) ((float*)(base + 72 * 64))[tid] = __expf(GE[tid]);
    }
}

constexpr size_t DN_ITEM_BYTES = 74752;
__device__ __forceinline__ void phase_dn_prep(const KP kp, const int bid, const int G, int j, LAS unsigned char* lds, int tid0) {
    unsigned char* scr = kp.ws() + WS_SCR;
    const bf16* U = (const bf16*)(kp.ws() + WS_U); const float* cw = kp.in(14) + (size_t)j * 4 * 3072;
    unsigned char* OPS = scr + SC_DNOPS;
    LAS float* AMT = (LAS float*)lds; LAS float* GLs = AMT + 64 * 68; LAS float* BLs = GLs + 64; LAS float* SS = BLs + 64;
    LAS bf16* Kb = (LAS bf16*)(SS + 256); LAS bf16* Qb = Kb + 64 * 136; LAS float* QKm = (LAS float*)(Qb + 64 * 136); LAS float* XL = QKm + 64 * 65;
    for (int item = bid; item < 1024; item += G) {
        int tid = tid0; asm volatile("" : "+v"(tid));
        const int lane = tid & 63, r = lane & 31, hp = lane >> 5, wave = tid >> 6;
        const int b = item >> 8, n = (item >> 3) & 31, h = item & 7;
        const int row0 = b * 2048 + n * 64;
        __syncthreads();
        SEC_BEGIN(20)
        {
          const int t0 = 8 * wave; const bool first = (n == 0 && wave == 0);
          const long fo = first ? 0 : (long)NAB;
          float qa[8], qb[8], ka[8], kb[8];
#pragma unroll
          for (int part = 0; part < 3; ++part) { const int c = part * 1024 + h * 128 + 2 * lane;
              const float w0a = cw[c], w0b = cw[c + 1], w1a = cw[3072 + c], w1b = cw[3072 + c + 1], w2a = cw[2 * 3072 + c], w2b = cw[2 * 3072 + c + 1], w3a = cw[3 * 3072 + c], w3b = cw[3 * 3072 + c + 1];
              const bf16* up = U + (size_t)(row0 + t0) * NAB + c;
              unsigned raw[11];
              raw[0] = *(const unsigned*)(up - 3 * fo); raw[1] = *(const unsigned*)(up - 2 * fo); raw[2] = *(const unsigned*)(up - 1 * fo);
#pragma unroll
              for (int t = 0; t < 8; ++t) raw[3 + t] = *(const unsigned*)(up + (size_t)t * NAB);
              if (first) { raw[0] = 0u; raw[1] = 0u; raw[2] = 0u; }
#pragma unroll
              for (int t = 0; t < 8; ++t) {
                  const float ya = silu_(w0a * __uint_as_float(raw[t] << 16) + w1a * __uint_as_float(raw[t + 1] << 16) + w2a * __uint_as_float(raw[t + 2] << 16) + w3a * __uint_as_float(raw[t + 3] << 16));
                  const float yb = silu_(w0b * __uint_as_float(raw[t] & 0xffff0000u) + w1b * __uint_as_float(raw[t + 1] & 0xffff0000u) + w2b * __uint_as_float(raw[t + 2] & 0xffff0000u) + w3b * __uint_as_float(raw[t + 3] & 0xffff0000u));
                  if (part == 0) { qa[t] = ya; qb[t] = yb; } else if (part == 1) { ka[t] = ya; kb[t] = yb; } else { XL[(t0 + t) * 257 + 2 * lane] = ya; XL[(t0 + t) * 257 + 2 * lane + 1] = yb; } } }
#pragma unroll
          for (int t = 0; t < 8; ++t) { const float scq = rsqrtf(wave_sum(qa[t] * qa[t] + qb[t] * qb[t]) + 1e-6f) * 0.08838834764831845f, sck = rsqrtf(wave_sum(ka[t] * ka[t] + kb[t] * kb[t]) + 1e-6f);
              *(LAS unsigned*)(Qb + (t0 + t) * 136 + 2 * lane) = pk2(qa[t] * scq, qb[t] * scq); *(LAS unsigned*)(Kb + (t0 + t) * 136 + 2 * lane) = pk2(ka[t] * sck, kb[t] * sck); } }
        if (wave == 0) { const size_t ro = (size_t)(row0 + lane) * NAB;
            float gv = -__expf(kp.in(15)[j * 8 + h]) * softplus_(bf2f(U[ro + 7176 + h]) + kp.in(16)[j * 8 + h]);
#pragma unroll
            for (int o = 1; o < 64; o <<= 1) { const float tt = __shfl_up(gv, o); if (lane >= o) gv += tt; }
            GLs[lane] = gv; BLs[lane] = sigmoid_(bf2f(U[ro + 7168 + h])); }
        __syncthreads();
        SEC_END(20, lds)
        SEC_BEGIN(21)
        SEC_END(21, lds)
        SEC_BEGIN(22)
        bf16x8* base = (bf16x8*)(OPS + (size_t)item * DN_ITEM_BYTES);
        { const int which = wave >> 2, mt = (wave >> 1) & 1, nt = wave & 1;
          const LAS bf16* Asrc = which ? Qb : Kb;
          f32x16 acc;
#pragma unroll
          for (int i = 0; i < 16; ++i) acc[i] = 0.f;
#pragma unroll
          for (int ks = 0; ks < 8; ++ks) acc = MFMA32(*(const LAS bf16x8*)(Asrc + (32 * mt + r) * 136 + 16 * ks + 8 * hp), *(const LAS bf16x8*)(Kb + (32 * nt + r) * 136 + 16 * ks + 8 * hp), acc);
          const int jt = 32 * nt + r; const float gj = GLs[jt];
#pragma unroll
          for (int i16 = 0; i16 < 16; ++i16) { const int i = 32 * mt + crow(i16, hp); const float dec = __expf(GLs[i] - gj);
              if (which == 0) AMT[jt * 68 + i] = jt < i ? BLs[i] * acc[i16] * dec : 0.f; else QKm[i * 65 + jt] = jt <= i ? acc[i16] * dec : 0.f; } }
        __syncthreads();
        SEC_END(22, lds)
        SEC_BEGIN(23)
        if (tid < 256) {
            const int c = tid; float acc[16], dg[120];
#pragma unroll
            for (int ii = 0; ii < 16; ++ii) { const float be = BLs[ii]; acc[ii] = c < 128 ? be * XL[ii * 257 + c] : be * __expf(GLs[ii]) * bf2f(Kb[ii * 136 + (c - 128)]); }
#pragma unroll
            for (int ii = 1; ii < 16; ++ii)
#pragma unroll
                for (int jj = 0; jj < ii; ++jj) dg[ii * (ii - 1) / 2 + jj] = AMT[jj * 68 + ii];
#pragma unroll
            for (int ii = 0; ii < 16; ++ii) { float x = acc[ii];
#pragma unroll
                for (int jj = 0; jj < ii; ++jj) x -= dg[ii * (ii - 1) / 2 + jj] * acc[jj];
                acc[ii] = x; }
#pragma unroll
            for (int ii = 0; ii < 16; ++ii) XL[ii * 257 + c] = acc[ii];
        } else {
            const int w4 = wave - 4; float v[8];
#pragma unroll
            for (int q = 0; q < 4; ++q) { const int f = w4 + 4 * q;
                { const int mt = f >> 3, ks = f & 7, i = 32 * mt + r; const float eg = __expf(GLs[i]);
#pragma unroll
                  for (int jp = 0; jp < 8; ++jp) v[jp] = bf2f(Qb[i * 136 + 16 * ks + 8 * (jp >> 2) + 4 * hp + (jp & 3)]) * eg;
                  base[(16 + f) * 64 + lane] = pack8(v); }
                { const int mt = f >> 2, ks = f & 3, d = 32 * mt + r; const float Gend = GLs[63];
#pragma unroll
                  for (int jp = 0; jp < 8; ++jp) { const int tk = 16 * ks + 8 * (jp >> 2) + 4 * hp + (jp & 3); v[jp] = bf2f(Kb[tk * 136 + d]) * __expf(Gend - GLs[tk]); }
                  base[(32 + f) * 64 + lane] = pack8(v); } }
#pragma unroll
            for (int q = 0; q < 2; ++q) { const int f = w4 + 4 * q, mt = f >> 2, ks = f & 3, i = 32 * mt + r;
#pragma unroll
                for (int jp = 0; jp < 8; ++jp) v[jp] = QKm[i * 65 + 16 * ks + 8 * (jp >> 2) + 4 * hp + (jp & 3)];
                base[(48 + f) * 64 + lane] = pack8(v); }
            if (tid == 256) *(float*)(base + 72 * 64) = __expf(GLs[63]);
        }
        __syncthreads();
#pragma unroll
        for (int bi = 1; bi < 4; ++bi) {
            { const int li_ = lane & 15, kq = lane >> 4;
#pragma unroll
              for (int q = 0; q < 2; ++q) { const int col = 16 * (2 * wave + q) + li_;
                  f32x4 ya;
#pragma unroll
                  for (int rg = 0; rg < 4; ++rg) { const int row = 16 * bi + 4 * kq + rg; const float be = BLs[row];
                      ya[rg] = col < 128 ? be * XL[row * 257 + col] : be * __expf(GLs[row]) * bf2f(Kb[row * 136 + (col - 128)]); }
#pragma unroll
                  for (int kk = 0; kk < 4 * bi; ++kk) { const int krow = 4 * kk + kq;
                      ya = __builtin_amdgcn_mfma_f32_16x16x4f32(-AMT[krow * 68 + 16 * bi + li_], XL[krow * 257 + col], ya, 0, 0, 0); }
#pragma unroll
                  for (int rg = 0; rg < 4; ++rg) XL[(16 * bi + 4 * kq + rg) * 257 + col] = ya[rg]; } }
            __syncthreads();
            if (tid < 256) { const int c = tid; float acc[16], dg[120];
#pragma unroll
                for (int ii = 0; ii < 16; ++ii) acc[ii] = XL[(16 * bi + ii) * 257 + c];
#pragma unroll
                for (int ii = 1; ii < 16; ++ii)
#pragma unroll
                    for (int jj = 0; jj < ii; ++jj) dg[ii * (ii - 1) / 2 + jj] = AMT[(16 * bi + jj) * 68 + 16 * bi + ii];
#pragma unroll
                for (int ii = 0; ii < 16; ++ii) { float x = acc[ii];
#pragma unroll
                    for (int jj = 0; jj < ii; ++jj) x -= dg[ii * (ii - 1) / 2 + jj] * acc[jj];
                    acc[ii] = x; }
#pragma unroll
                for (int ii = 0; ii < 16; ++ii) XL[(16 * bi + ii) * 257 + c] = acc[ii]; }
            __syncthreads();
        }
        SEC_END(23, lds)
        SEC_BEGIN(24)
        float v[8];
#pragma unroll
        for (int q = 0; q < 2; ++q) { const int f = wave + 8 * q;
            { const int mt = f >> 3, ks = f & 7, i = 32 * mt + r;
#pragma unroll
              for (int jp = 0; jp < 8; ++jp) v[jp] = -XL[i * 257 + 128 + 16 * ks + 8 * (jp >> 2) + 4 * hp + (jp & 3)];
              base[f * 64 + lane] = pack8(v); }
            { const int pq = f & 1, tl = f >> 1, mt = tl >> 2, nt = tl & 3;
#pragma unroll
              for (int e = 0; e < 8; ++e) v[e] = XL[(32 * mt + crow(8 * pq + e, hp)) * 257 + 32 * nt + r];
              base[(56 + f) * 64 + lane] = pack8(v); } }
        SEC_END(24, lds)
    }
}

__device__ __forceinline__ void phase_ab_rec(const KP kp, const int bid, const int G, int j, int li, LAS unsigned char* lds, int tid0) {
    unsigned char* scr = kp.ws() + WS_SCR; const bf16* U = (const bf16*)(kp.ws() + WS_U);
    bf16* ODN = (bf16*)(scr + SC_ODN); bf16* OGLA = (bf16*)(scr + SC_OGLA);
    SEC_BEGIN(12)
    for (int item = bid; item < 64; item += G) {
        int tid = tid0; asm volatile("" : "+v"(tid));
        int s, h; bool isdn; int half = -1;
        if (item < 32) { isdn = false; s = item >> 3; h = (item >> 1) & 3; half = item & 1; }
        else if (item < 64) { isdn = true; s = (item - 32) >> 3; h = (item - 32) & 7; half = -2; }
        else if (item < 1088) { isdn = true; s = 4 + ((item - 64) >> 3); h = (item - 64) & 7; }
        else { isdn = false; s = 4 + ((item - 1088) >> 2); h = (item - 1088) & 3; }
        int row0, L; seq_info(s, row0, L);
        __syncthreads();
        if (half == -2) {
            const int wave = __builtin_amdgcn_readfirstlane(tid >> 6), lane = tid & 63, r = lane & 31, hp = lane >> 5;
            const int b = s, nt = wave;
            const unsigned char* OPS = scr + SC_DNOPS;
            constexpr int DBUF = 73 * 1024;
#define DN_DMA(n_, bufi_) do { const unsigned char* gi_ = OPS + (size_t)((b * 32 + (n_)) * 8 + h) * DN_ITEM_BYTES + lane * 16; \
                _Pragma("unroll") for (int q_ = 0; q_ < 10; ++q_) { const int lf_ = wave + 8 * q_; if (lf_ < 73) \
                    __builtin_amdgcn_global_load_lds((const unsigned*)(gi_ + lf_ * 1024), (LAS unsigned*)(lds + (bufi_) * DBUF + lf_ * 1024), 16, 0, 2); } } while (0)
            f32x16 S0, S1, S2, S3;
#pragma unroll
            for (int i = 0; i < 16; ++i) { S0[i] = 0.f; S1[i] = 0.f; S2[i] = 0.f; S3[i] = 0.f; }
            DN_DMA(0, 0);
            asm volatile("s_waitcnt vmcnt(0)" ::: "memory"); __syncthreads();
            for (int n = 0; n < 32; ++n) {
                if (n + 1 < 32) DN_DMA(n + 1, (n + 1) & 1);
                if (wave < 4) {
                    const LAS bf16x8* F = (const LAS bf16x8*)(lds + (n & 1) * DBUF) + lane;
                    const float gend = *(const LAS float*)(lds + (n & 1) * DBUF + 72 * 1024);
                    const bf16x8 sb0 = PACK_ACC(S0, 0), sb1 = PACK_ACC(S0, 1), sb2 = PACK_ACC(S1, 0), sb3 = PACK_ACC(S1, 1), sb4 = PACK_ACC(S2, 0), sb5 = PACK_ACC(S2, 1), sb6 = PACK_ACC(S3, 0), sb7 = PACK_ACC(S3, 1);
                    f32x16 U0t, U1t;
                    { const bf16x8 a0 = F[(56 + nt * 2 + 0) * 64], a1 = F[(56 + nt * 2 + 1) * 64], c0 = F[(56 + (4 + nt) * 2 + 0) * 64], c1 = F[(56 + (4 + nt) * 2 + 1) * 64];
#pragma unroll
                      for (int e = 0; e < 8; ++e) { U0t[e] = bf2f((bf16)a0[e]); U0t[8 + e] = bf2f((bf16)a1[e]); U1t[e] = bf2f((bf16)c0[e]); U1t[8 + e] = bf2f((bf16)c1[e]); } }
                    U0t = MFMA32(F[0 * 64], sb0, U0t); U0t = MFMA32(F[1 * 64], sb1, U0t); U0t = MFMA32(F[2 * 64], sb2, U0t); U0t = MFMA32(F[3 * 64], sb3, U0t);
                    U0t = MFMA32(F[4 * 64], sb4, U0t); U0t = MFMA32(F[5 * 64], sb5, U0t); U0t = MFMA32(F[6 * 64], sb6, U0t); U0t = MFMA32(F[7 * 64], sb7, U0t);
                    U1t = MFMA32(F[8 * 64], sb0, U1t); U1t = MFMA32(F[9 * 64], sb1, U1t); U1t = MFMA32(F[10 * 64], sb2, U1t); U1t = MFMA32(F[11 * 64], sb3, U1t);
                    U1t = MFMA32(F[12 * 64], sb4, U1t); U1t = MFMA32(F[13 * 64], sb5, U1t); U1t = MFMA32(F[14 * 64], sb6, U1t); U1t = MFMA32(F[15 * 64], sb7, U1t);
                    const bf16x8 ub0 = PACK_ACC(U0t, 0), ub1 = PACK_ACC(U0t, 1), ub2 = PACK_ACC(U1t, 0), ub3 = PACK_ACC(U1t, 1);
                    f32x16 O0, O1;
#pragma unroll
                    for (int i = 0; i < 16; ++i) { O0[i] = 0.f; O1[i] = 0.f; }
                    O0 = MFMA32(F[16 * 64], sb0, O0); O0 = MFMA32(F[17 * 64], sb1, O0); O0 = MFMA32(F[18 * 64], sb2, O0); O0 = MFMA32(F[19 * 64], sb3, O0);
                    O0 = MFMA32(F[20 * 64], sb4, O0); O0 = MFMA32(F[21 * 64], sb5, O0); O0 = MFMA32(F[22 * 64], sb6, O0); O0 = MFMA32(F[23 * 64], sb7, O0);
                    O1 = MFMA32(F[24 * 64], sb0, O1); O1 = MFMA32(F[25 * 64], sb1, O1); O1 = MFMA32(F[26 * 64], sb2, O1); O1 = MFMA32(F[27 * 64], sb3, O1);
                    O1 = MFMA32(F[28 * 64], sb4, O1); O1 = MFMA32(F[29 * 64], sb5, O1); O1 = MFMA32(F[30 * 64], sb6, O1); O1 = MFMA32(F[31 * 64], sb7, O1);
                    O0 = MFMA32(F[48 * 64], ub0, O0); O0 = MFMA32(F[49 * 64], ub1, O0);
                    O1 = MFMA32(F[52 * 64], ub0, O1); O1 = MFMA32(F[53 * 64], ub1, O1); O1 = MFMA32(F[54 * 64], ub2, O1); O1 = MFMA32(F[55 * 64], ub3, O1);
#pragma unroll
                    for (int i = 0; i < 16; ++i) { S0[i] *= gend; S1[i] *= gend; S2[i] *= gend; S3[i] *= gend; }
                    S0 = MFMA32(F[32 * 64], ub0, S0); S0 = MFMA32(F[33 * 64], ub1, S0); S0 = MFMA32(F[34 * 64], ub2, S0); S0 = MFMA32(F[35 * 64], ub3, S0);
                    S1 = MFMA32(F[36 * 64], ub0, S1); S1 = MFMA32(F[37 * 64], ub1, S1); S1 = MFMA32(F[38 * 64], ub2, S1); S1 = MFMA32(F[39 * 64], ub3, S1);
                    S2 = MFMA32(F[40 * 64], ub0, S2); S2 = MFMA32(F[41 * 64], ub1, S2); S2 = MFMA32(F[42 * 64], ub2, S2); S2 = MFMA32(F[43 * 64], ub3, S2);
                    S3 = MFMA32(F[44 * 64], ub0, S3); S3 = MFMA32(F[45 * 64], ub1, S3); S3 = MFMA32(F[46 * 64], ub2, S3); S3 = MFMA32(F[47 * 64], ub3, S3);
                    bf16* yo = ODN + (size_t)(b * 2048 + n * 64) * 1024 + h * 128 + 32 * nt + r;
#pragma unroll
                    for (int i = 0; i < 16; ++i) { yo[(size_t)crow(i, hp) * 1024] = (bf16)f2bf(O0[i]); yo[(size_t)(32 + crow(i, hp)) * 1024] = (bf16)f2bf(O1[i]); }
                }
                asm volatile("s_waitcnt vmcnt(0)" ::: "memory"); __syncthreads();
            }
#undef DN_DMA
            if (wave < 4) {
                float* dst = kp.out() + O_DN_P + ((size_t)j * 4 + b) * ((size_t)8 * 128 * 128) + (size_t)h * 128 * 128 + 32 * nt + r;
#pragma unroll
                for (int i = 0; i < 16; ++i) { dst[(size_t)crow(i, hp) * 128] = S0[i]; dst[(size_t)(32 + crow(i, hp)) * 128] = S1[i]; dst[(size_t)(64 + crow(i, hp)) * 128] = S2[i]; dst[(size_t)(96 + crow(i, hp)) * 128] = S3[i]; }
            }
        } else if (half >= 0) {
            const int wave = __builtin_amdgcn_readfirstlane(tid >> 6), lane = tid & 63, r = lane & 31, hp = lane >> 5;
            const int b = s, nt = half * 4 + wave;
            const unsigned char* OPS = kp.ws() + WS_GLAOPS;
            constexpr int GBUF = 57 * 1024;
#define GLA_DMA(n_, bufi_) do { const unsigned char* gi_ = OPS + (size_t)((b * 32 + (n_)) * 4 + h) * GLA_ITEM_BYTES + lane * 16; \
                _Pragma("unroll") for (int q_ = 0; q_ < 8; ++q_) { const int lf_ = wave + 8 * q_; if (lf_ < 57) { const int gf_ = lf_ < 40 ? lf_ : (lf_ < 56 ? lf_ + half * 16 : 72); \
                    __builtin_amdgcn_global_load_lds((const unsigned*)(gi_ + gf_ * 1024), (LAS unsigned*)(lds + (bufi_) * GBUF + lf_ * 1024), 16, 0, 2); } } } while (0)
            f32x16 S0, S1, S2, S3;
#pragma unroll
            for (int i = 0; i < 16; ++i) { S0[i] = 0.f; S1[i] = 0.f; S2[i] = 0.f; S3[i] = 0.f; }
            GLA_DMA(0, 0);
            asm volatile("s_waitcnt vmcnt(0)" ::: "memory"); __syncthreads();
            for (int n = 0; n < 32; ++n) {
                if (n + 1 < 32) GLA_DMA(n + 1, (n + 1) & 1);
                if (wave < 4) {
                    const LAS bf16x8* F = (const LAS bf16x8*)(lds + (n & 1) * GBUF) + lane;
                    const LAS float* ge = (const LAS float*)(lds + (n & 1) * GBUF + 56 * 1024) + 4 * hp;
                    const bf16x8 sb0 = PACK_ACC(S0, 0), sb1 = PACK_ACC(S0, 1), sb2 = PACK_ACC(S1, 0), sb3 = PACK_ACC(S1, 1), sb4 = PACK_ACC(S2, 0), sb5 = PACK_ACC(S2, 1), sb6 = PACK_ACC(S3, 0), sb7 = PACK_ACC(S3, 1);
                    f32x16 O0, O1;
#pragma unroll
                    for (int i = 0; i < 16; ++i) { O0[i] = 0.f; O1[i] = 0.f; }
                    O0 = MFMA32(F[0 * 64], sb0, O0); O0 = MFMA32(F[1 * 64], sb1, O0); O0 = MFMA32(F[2 * 64], sb2, O0); O0 = MFMA32(F[3 * 64], sb3, O0);
                    O0 = MFMA32(F[4 * 64], sb4, O0); O0 = MFMA32(F[5 * 64], sb5, O0); O0 = MFMA32(F[6 * 64], sb6, O0); O0 = MFMA32(F[7 * 64], sb7, O0);
                    O1 = MFMA32(F[8 * 64], sb0, O1); O1 = MFMA32(F[9 * 64], sb1, O1); O1 = MFMA32(F[10 * 64], sb2, O1); O1 = MFMA32(F[11 * 64], sb3, O1);
                    O1 = MFMA32(F[12 * 64], sb4, O1); O1 = MFMA32(F[13 * 64], sb5, O1); O1 = MFMA32(F[14 * 64], sb6, O1); O1 = MFMA32(F[15 * 64], sb7, O1);
                    bf16x8 vb[4];
#pragma unroll
                    for (int ks = 0; ks < 4; ++ks) vb[ks] = F[(40 + wave * 4 + ks) * 64];
                    O0 = MFMA32(F[32 * 64], vb[0], O0); O0 = MFMA32(F[33 * 64], vb[1], O0);
#pragma unroll
                    for (int ks = 0; ks < 4; ++ks) O1 = MFMA32(F[(36 + ks) * 64], vb[ks], O1);
#pragma unroll
                    for (int q = 0; q < 4; ++q) { const f32x4 g0 = *(const LAS f32x4*)(ge + 8 * q), g1 = *(const LAS f32x4*)(ge + 32 + 8 * q), g2 = *(const LAS f32x4*)(ge + 64 + 8 * q), g3 = *(const LAS f32x4*)(ge + 96 + 8 * q);
#pragma unroll
                        for (int c = 0; c < 4; ++c) { S0[4 * q + c] *= g0[c]; S1[4 * q + c] *= g1[c]; S2[4 * q + c] *= g2[c]; S3[4 * q + c] *= g3[c]; } }
#pragma unroll
                    for (int ks = 0; ks < 4; ++ks) { S0 = MFMA32(F[(16 + ks) * 64], vb[ks], S0); S1 = MFMA32(F[(20 + ks) * 64], vb[ks], S1); S2 = MFMA32(F[(24 + ks) * 64], vb[ks], S2); S3 = MFMA32(F[(28 + ks) * 64], vb[ks], S3); }
                    bf16* yo = OGLA + (size_t)(b * 2048 + n * 64) * 1024 + h * 256 + 32 * nt + r;
#pragma unroll
                    for (int i = 0; i < 16; ++i) { yo[(size_t)crow(i, hp) * 1024] = (bf16)f2bf(O0[i]); yo[(size_t)(32 + crow(i, hp)) * 1024] = (bf16)f2bf(O1[i]); }
                }
                asm volatile("s_waitcnt vmcnt(0)" ::: "memory"); __syncthreads();
            }
#undef GLA_DMA
            if (wave < 4) {
                float* dst = kp.out() + O_GLA_P + ((size_t)j * 4 + b) * ((size_t)4 * 128 * 256) + (size_t)h * 128 * 256 + 32 * nt + r;
#pragma unroll
                for (int i = 0; i < 16; ++i) { dst[(size_t)crow(i, hp) * 256] = S0[i]; dst[(size_t)(32 + crow(i, hp)) * 256] = S1[i]; dst[(size_t)(64 + crow(i, hp)) * 256] = S2[i]; dst[(size_t)(96 + crow(i, hp)) * 256] = S3[i]; }
            }
        } else
        {}
    }
    SEC_END(12, lds)
    SEC_BEGIN(13)
    unsigned* qhead = (unsigned*)(kp.ws() + WS_CTL) + CW_CNT + 64 * li;
    volatile LAS unsigned* qslot = (volatile LAS unsigned*)(lds + LDS_BYTES - 8);
    const float* cw = kp.in(14) + (size_t)j * 4 * 3072; const float* stc = kp.in(3) + (size_t)j * 128 * 3 * 3072;
    const float* wa2 = kp.in(18) + (size_t)j * 16 * 512; const float* ba = kp.in(19) + (size_t)j * 512;
    for (;;) {
        __syncthreads();
        if (tid0 == 0) qslot[0] = __hip_atomic_fetch_add(qhead, 1u, __ATOMIC_RELAXED, __HIP_MEMORY_SCOPE_AGENT);
        __syncthreads();
        const int it = (int)qslot[0];
        if (it >= 1536) break;
        int tid = tid0; asm volatile("" : "+v"(tid));
        const int wave = tid >> 6, lane = tid & 63;
        if (it < 1024) {
            const int bs = it >> 3, h = it & 7, sq = 4 + bs, r0 = TP + bs * 4;
            LAS float* qL = (LAS float*)lds; LAS float* kL = qL + 512; LAS float* vL = kL + 512; LAS float* red = vL + 512; LAS float* sm = red + 4096;
            const int e = tid & 127, dq = tid >> 7;
            const size_t SZ = (size_t)8 * 128 * 128;
            const float* st = kp.in(2) + ((size_t)j * 128 + bs) * SZ + (size_t)h * 16384;
            float S[32];
            { const float* sp = st + (size_t)(dq * 32) * 128 + e;
#pragma unroll
              for (int i = 0; i < 32; ++i) { S[i] = __builtin_nontemporal_load(sp); sp += 128; asm volatile("" : "+v"(sp)); } }
#pragma unroll
            for (int part = 0; part < 3; ++part) { const int c = part * 1024 + h * 128 + e; float acc = 0.f;
#pragma unroll
                for (int tap = 0; tap < 4; ++tap) acc += cw[tap * 3072 + c] * pre_val(U, NAB, c, r0, dq - 3 + tap, sq, stc, 3072, c);
                if (part == 2) vL[dq * 128 + e] = silu_(acc); else (part == 0 ? qL : kL)[e * 4 + dq] = silu_(acc); }
            if (tid < 4) { const size_t ro = (size_t)(r0 + tid) * NAB;
                sm[32 + tid] = -__expf(kp.in(15)[j * 8 + h]) * softplus_(bf2f(U[ro + 7176 + h]) + kp.in(16)[j * 8 + h]); sm[36 + tid] = sigmoid_(bf2f(U[ro + 7168 + h])); }
            __syncthreads();
            { const int tk = wave & 3; LAS float* src = (wave >> 2) ? kL : qL; const float a = src[lane * 4 + tk], b = src[(lane + 64) * 4 + tk];
              const float sc = rsqrtf(wave_sum(a * a + b * b) + 1e-6f) * ((wave >> 2) ? 1.f : 0.08838834764831845f); src[lane * 4 + tk] = a * sc; src[(lane + 64) * 4 + tk] = b * sc; }
            __syncthreads();
#pragma unroll
            for (int q = 0; q < 4; ++q) { const int idx = wave * 4 + q, i = (idx >> 2) & 3, jj = idx & 3; const LAS float* src = idx < 16 ? kL : qL;
                const float dot = wave_sum(src[lane * 4 + i] * kL[lane * 4 + jj] + src[(lane + 64) * 4 + i] * kL[(lane + 64) * 4 + jj]); if (lane == 0) sm[idx] = dot; }
            float ks[4] = {0.f, 0.f, 0.f, 0.f}, qs[4] = {0.f, 0.f, 0.f, 0.f};
#pragma unroll
            for (int i = 0; i < 32; ++i) { const int d = dq * 32 + i; const float sv = S[i]; const f32x4 k4 = *(const LAS f32x4*)(kL + d * 4), q4 = *(const LAS f32x4*)(qL + d * 4);
#pragma unroll
                for (int t = 0; t < 4; ++t) { ks[t] += k4[t] * sv; qs[t] += q4[t] * sv; } }
#pragma unroll
            for (int t = 0; t < 4; ++t) { red[(t * 4 + dq) * 128 + e] = ks[t]; red[((4 + t) * 4 + dq) * 128 + e] = qs[t]; }
            __syncthreads();
            float Gc[4]; Gc[0] = sm[32]; Gc[1] = Gc[0] + sm[33]; Gc[2] = Gc[1] + sm[34]; Gc[3] = Gc[2] + sm[35];
            float u[4];
#pragma unroll
            for (int i = 0; i < 4; ++i) { const float KSi = (red[(i * 4 + 0) * 128 + e] + red[(i * 4 + 1) * 128 + e]) + (red[(i * 4 + 2) * 128 + e] + red[(i * 4 + 3) * 128 + e]);
                float acc = vL[i * 128 + e] - __expf(Gc[i]) * KSi;
#pragma unroll
                for (int jj = 0; jj < i; ++jj) acc -= sm[i * 4 + jj] * __expf(Gc[i] - Gc[jj]) * u[jj];
                u[i] = sm[36 + i] * acc; }
            if (dq == 0) {
#pragma unroll
                for (int i = 0; i < 4; ++i) { const float QSi = (red[((4 + i) * 4 + 0) * 128 + e] + red[((4 + i) * 4 + 1) * 128 + e]) + (red[((4 + i) * 4 + 2) * 128 + e] + red[((4 + i) * 4 + 3) * 128 + e]);
                    float o = __expf(Gc[i]) * QSi;
#pragma unroll
                    for (int jj = 0; jj <= i; ++jj) o += sm[16 + i * 4 + jj] * __expf(Gc[i] - Gc[jj]) * u[jj];
                    ODN[(size_t)(r0 + i) * 1024 + h * 128 + e] = (bf16)f2bf(o); } }
            const float eg = __expf(Gc[3]); float w[4];
#pragma unroll
            for (int jj = 0; jj < 4; ++jj) w[jj] = __expf(Gc[3] - Gc[jj]) * u[jj];
            float* dst = kp.out() + O_DN_S + ((size_t)j * 128 + bs) * SZ + (size_t)h * 16384 + (size_t)(dq * 32) * 128 + e;
#pragma unroll
            for (int i = 0; i < 32; ++i) { const int d = dq * 32 + i; float sv = eg * S[i]; const f32x4 k4 = *(const LAS f32x4*)(kL + d * 4);
#pragma unroll
                for (int jj = 0; jj < 4; ++jj) sv += k4[jj] * w[jj];
                __builtin_nontemporal_store(sv, dst); dst += 128; asm volatile("" : "+v"(dst)); }
        } else {
            const int q_ = it - 1024, bs = q_ >> 2, h = q_ & 3, r0 = TP + bs * 4;
            LAS float* qgL = (LAS float*)lds; LAS float* kaL = qgL + 512; LAS float* glL = kaL + 512; LAS float* egL = glL + 512; LAS float* Am = egL + 128; LAS float* red = Am + 16;
            const int e = tid & 255, dh = tid >> 8;
            const size_t SZ = (size_t)4 * 128 * 256;
            const float* st = kp.in(4) + ((size_t)j * 128 + bs) * SZ + (size_t)h * 32768;
            float S[64];
            { const float* sp = st + (size_t)(dh * 64) * 256 + e;
#pragma unroll
              for (int i = 0; i < 64; ++i) { S[i] = __builtin_nontemporal_load(sp); sp += 256; asm volatile("" : "+v"(sp)); } }
            float v[4];
#pragma unroll
            for (int t = 0; t < 4; ++t) v[t] = bf2f(U[(size_t)(r0 + t) * NAB + 5120 + h * 256 + e]);
            { const int d = tid & 127, tk = tid >> 7; const size_t ro = (size_t)(r0 + tk) * NAB;
              qgL[d * 4 + tk] = bf2f(U[ro + 4096 + h * 128 + d]) * 0.08838834764831845f; kaL[d * 4 + tk] = bf2f(U[ro + 4608 + h * 128 + d]);
              float x = ba[h * 128 + d];
#pragma unroll
              for (int rr = 0; rr < 16; ++rr) x += bf2f(U[ro + 7184 + rr]) * wa2[rr * 512 + h * 128 + d];
              glL[tk * 128 + d] = -softplus_(-x) * (1.f / 16.f); }
            __syncthreads();
            if (tid < 128) { float Gq = 0.f;
#pragma unroll
                for (int t = 0; t < 4; ++t) { Gq += glL[t * 128 + tid]; qgL[tid * 4 + t] *= __expf(Gq); kaL[tid * 4 + t] *= __expf(-Gq); }
                egL[tid] = __expf(Gq); }
            __syncthreads();
#pragma unroll
            for (int q = 0; q < 2; ++q) { const int idx = wave * 2 + q, i = idx >> 2, jj = idx & 3;
                const float dot = wave_sum(qgL[lane * 4 + i] * kaL[lane * 4 + jj] + qgL[(lane + 64) * 4 + i] * kaL[(lane + 64) * 4 + jj]); if (lane == 0) Am[idx] = dot; }
            float o[4] = {0.f, 0.f, 0.f, 0.f};
            float* dst = kp.out() + O_GLA_S + ((size_t)j * 128 + bs) * SZ + (size_t)h * 32768 + (size_t)(dh * 64) * 256 + e;
#pragma unroll
            for (int i = 0; i < 64; ++i) { const int d = dh * 64 + i; const float s0 = S[i]; float acc = s0; const f32x4 q4 = *(const LAS f32x4*)(qgL + d * 4), k4 = *(const LAS f32x4*)(kaL + d * 4);
#pragma unroll
                for (int t = 0; t < 4; ++t) { o[t] += q4[t] * s0; acc += k4[t] * v[t]; }
                __builtin_nontemporal_store(egL[d] * acc, dst); dst += 256; asm volatile("" : "+v"(dst)); }
#pragma unroll
            for (int t = 0; t < 4; ++t) red[(dh * 4 + t) * 256 + e] = o[t];
            __syncthreads();
            if (dh == 0) {
#pragma unroll
                for (int t = 0; t < 4; ++t) { float oo = red[t * 256 + e] + red[(4 + t) * 256 + e];
#pragma unroll
                    for (int jj = 0; jj <= t; ++jj) oo += Am[t * 4 + jj] * v[jj];
                    OGLA[(size_t)(r0 + t) * 1024 + h * 256 + e] = (bf16)f2bf(oo); } }
        }
    }
    SEC_END(13, lds)
}

__device__ __forceinline__ void phase_ab_post(const KP kp, const int bid, const int G, int j, int tid, int wave, int lane) {
    unsigned char* scr = kp.ws() + WS_SCR; const bf16* U = (const bf16*)(kp.ws() + WS_U); bf16* YM = (bf16*)(kp.ws() + WS_YM);
    const bf16* ODN = (const bf16*)(scr + SC_ODN); const bf16* OGLA = (const bf16*)(scr + SC_OGLA);
    const float* dnn = kp.in(17) + (size_t)j * 128; const float* glan = kp.in(20) + (size_t)j * 256;
    typedef float f32x2v __attribute__((ext_vector_type(2)));
    const f32x2v dg = *(const f32x2v*)(dnn + 2 * lane); const f32x4 gg = *(const f32x4*)(glan + 4 * lane);
    const int stride = G * NWAVES;
#define POST_ROW(idx_) (((idx_) % 17) < 16 ? ((idx_) / 17) * 16 + ((idx_) % 17) : TP + (idx_) / 17)
#define AB_LOAD(r_, OD, ZD, OG, ZG) do { const bf16* ur_ = U + (size_t)(r_) * NAB; \
        _Pragma("unroll") for (int hh = 0; hh < 8; ++hh) { OD[hh] = *(const unsigned*)(ODN + (size_t)(r_) * 1024 + hh * 128 + 2 * lane); ZD[hh] = *(const unsigned*)(ur_ + 3072 + hh * 128 + 2 * lane); } \
        _Pragma("unroll") for (int hh = 0; hh < 4; ++hh) { OG[hh] = *(const u32x2*)(OGLA + (size_t)(r_) * 1024 + hh * 256 + 4 * lane); ZG[hh] = *(const u32x2*)(ur_ + 6144 + hh * 256 + 4 * lane); } } while (0)
    int idx = bid * NWAVES + wave;
    unsigned od[8], zd[8]; u32x2 og[4], zg[4];
    if (idx < T) AB_LOAD(POST_ROW(idx), od, zd, og, zg);
    for (; idx < T; idx += stride) {
        const int r = POST_ROW(idx), nidx = idx + stride;
        unsigned odn[8], zdn[8]; u32x2 ogn[4], zgn[4];
#pragma unroll
        for (int hh = 0; hh < 8; ++hh) { odn[hh] = 0u; zdn[hh] = 0u; }
#pragma unroll
        for (int hh = 0; hh < 4; ++hh) { ogn[hh] = (u32x2){0u, 0u}; zgn[hh] = (u32x2){0u, 0u}; }
        if (nidx < T) AB_LOAD(POST_ROW(nidx), odn, zdn, ogn, zgn);
        int s, t; row_to_seq(r, s, t); int row0, L; seq_info(s, row0, L);
        const bf16* ur = U + (size_t)r * NAB; bf16* yr = YM + (size_t)r * DM;
#pragma unroll
        for (int hh = 0; hh < 8; ++hh) { const float ox = __uint_as_float(od[hh] << 16), oy = __uint_as_float(od[hh] & 0xffff0000u);
            const float rstd = rsqrtf(wave_sum(ox * ox + oy * oy) * (1.f / 128.f) + 1e-6f);
            const unsigned zz = zd[hh];
            *(unsigned*)(yr + hh * 128 + 2 * lane) = pk2(ox * rstd * dg.x * silu_(__uint_as_float(zz << 16)), oy * rstd * dg.y * silu_(__uint_as_float(zz & 0xffff0000u))); }
#pragma unroll
        for (int hh = 0; hh < 4; ++hh) { const float ox = __uint_as_float(og[hh].x << 16), oy = __uint_as_float(og[hh].x & 0xffff0000u), oz = __uint_as_float(og[hh].y << 16), ow = __uint_as_float(og[hh].y & 0xffff0000u);
            const float rstd = rsqrtf(wave_sum((ox * ox + oy * oy) + (oz * oz + ow * ow)) * (1.f / 256.f) + 1e-6f);
            const u32x2 zz = zg[hh];
            u32x2 w; w.x = pk2(ox * rstd * gg.x * silu_(__uint_as_float(zz.x << 16)), oy * rstd * gg.y * silu_(__uint_as_float(zz.x & 0xffff0000u)));
            w.y = pk2(oz * rstd * gg.z * silu_(__uint_as_float(zz.y << 16)), ow * rstd * gg.w * silu_(__uint_as_float(zz.y & 0xffff0000u)));
            *(u32x2*)(yr + 1024 + hh * 256 + 4 * lane) = w; }
        if (t >= L - 3) { const int rr = t - (L - 3);
            float* dst = s < 4 ? kp.out() + O_DNC_P + (((size_t)j * 4 + s) * 3 + rr) * 3072 : kp.out() + O_DNC_S + (((size_t)j * 128 + (s - 4)) * 3 + rr) * 3072;
            for (int c = 2 * lane; c < 3072; c += 128) { const unsigned uu = *(const unsigned*)(ur + c); *(f32x2v*)(dst + c) = (f32x2v){__uint_as_float(uu << 16), __uint_as_float(uu & 0xffff0000u)}; } }
#pragma unroll
        for (int hh = 0; hh < 8; ++hh) { od[hh] = odn[hh]; zd[hh] = zdn[hh]; }
#pragma unroll
        for (int hh = 0; hh < 4; ++hh) { og[hh] = ogn[hh]; zg[hh] = zgn[hh]; }
    }
#undef AB_LOAD
}

__device__ __forceinline__ void phase_lru_gates(const KP kp, const int bid, const int G, int j, LAS unsigned char* lds, int tid0) {
    unsigned char* scr = kp.ws() + WS_SCR; const bf16* U = (const bf16*)(kp.ws() + WS_U);
    float* LA = (float*)(scr + SC_LA); float* LB = (float*)(scr + SC_LB);
    const float* lcw = kp.in(29) + (size_t)j * 4 * 1024; const float* lcb = kp.in(30) + (size_t)j * 1024; const float* lstc = kp.in(8) + (size_t)j * 128 * 3 * 1024;
    const int n = bid & 15;
    const float* wa = kp.in(31) + ((size_t)j * 16 + n) * 4096; const float* wx = kp.in(33) + ((size_t)j * 16 + n) * 4096;
    const float* lba = kp.in(32) + (size_t)j * 1024; const float* lbx = kp.in(34) + (size_t)j * 1024; const float* lam = kp.in(35) + (size_t)j * 1024;
    LAS bf16x8* WF = (LAS bf16x8*)lds;
    LAS float* xcL = (LAS float*)(lds + 16384);
    LAS float* igL = xcL + 64 * 68;
    __syncthreads();
    { const int lane = tid0 & 63, f = tid0 >> 6, r = lane & 31, hp = lane >> 5, nt = f >> 2, ks = f & 3; float v[8];
#pragma unroll
      for (int jp = 0; jp < 8; ++jp) v[jp] = wa[(16 * ks + 8 * hp + jp) * 64 + 32 * nt + r];
      WF[f * 64 + lane] = pack8(v);
#pragma unroll
      for (int jp = 0; jp < 8; ++jp) v[jp] = wx[(16 * ks + 8 * hp + jp) * 64 + 32 * nt + r];
      WF[512 + f * 64 + lane] = pack8(v); }
    for (int tile = bid >> 4; tile < T / 64; tile += (G >> 4)) {
        int tid = tid0; asm volatile("" : "+v"(tid));
        const int c = tid & 63, tq = tid >> 6, ch = n * 64 + c, rowbase = tile * 64;
        __syncthreads();
        if (tile < TP / 64) {
            const int r0 = rowbase + tq * 8; const bool first = ((r0 & 2047) == 0);
            const float w0 = lcw[ch], w1 = lcw[1024 + ch], w2 = lcw[2048 + ch], w3 = lcw[3072 + ch], bb = lcb[ch];
            const bf16* up = U + (size_t)r0 * NCD + 3584 + ch;
            const long fo = first ? 0 : (long)NCD;
              float x0 = bf2f(up[-3 * fo]), x1 = bf2f(up[-2 * fo]), x2 = bf2f(up[-1 * fo]); if (first) { x0 = 0.f; x1 = 0.f; x2 = 0.f; }
#pragma unroll
            for (int tt = 0; tt < 8; ++tt) { const float x3 = bf2f(up[(size_t)tt * NCD]); xcL[(tq * 8 + tt) * 68 + c] = bb + w0 * x0 + w1 * x1 + w2 * x2 + w3 * x3; x0 = x1; x1 = x2; x2 = x3; }
        } else {
#pragma unroll 2
            for (int tt = 0; tt < 8; ++tt) { const int r = rowbase + tq * 8 + tt; int s, t; row_to_seq(r, s, t); const int row0 = r - t; float acc = lcb[ch];
#pragma unroll
                for (int tap = 0; tap < 4; ++tap) acc += lcw[tap * 1024 + ch] * pre_val(U, NCD, 3584 + ch, row0, t - 3 + tap, s, lstc, 1024, ch);
                xcL[(tq * 8 + tt) * 68 + c] = acc; }
        }
        __syncthreads();
        const int wave = __builtin_amdgcn_readfirstlane(tid >> 6), lane = tid & 63, r = lane & 31, hp = lane >> 5, mat = wave >> 2, mt = (wave >> 1) & 1, nt = wave & 1;
        f32x16 acc;
#pragma unroll
        for (int i = 0; i < 16; ++i) acc[i] = 0.f;
#pragma unroll
        for (int ks = 0; ks < 4; ++ks) { const LAS float* xp = xcL + (32 * mt + r) * 68 + 16 * ks + 8 * hp; const f32x4 xa = *(const LAS f32x4*)xp, xb = *(const LAS f32x4*)(xp + 4);
            const bf16x8 af = __builtin_bit_cast(bf16x8, (u32x4){cvtpk(xa.x, xa.y), cvtpk(xa.z, xa.w), cvtpk(xb.x, xb.y), cvtpk(xb.z, xb.w)});
            acc = MFMA32(af, WF[mat * 512 + (nt * 4 + ks) * 64 + lane], acc); }
        const int chh = n * 64 + 32 * nt + r;
        if (mat == 1) { const float bx = lbx[chh];
#pragma unroll
            for (int i = 0; i < 16; ++i) igL[(32 * mt + crow(i, hp)) * 65 + 32 * nt + r] = sigmoid_(acc[i] + bx); }
        __syncthreads();
        if (mat == 0) { const float ba = lba[chh], spl = softplus_(-lam[chh]);
#pragma unroll
            for (int i = 0; i < 16; ++i) { const int tk = 32 * mt + crow(i, hp); const size_t ro = (size_t)(rowbase + tk) * 1024 + chh;
                const float log_a = -8.f * sigmoid_(acc[i] + ba) * spl;
                LA[ro] = __expf(log_a); LB[ro] = __builtin_amdgcn_sqrtf(1.f - __expf(2.f * log_a)) * (igL[tk * 65 + 32 * nt + r] * xcL[tk * 68 + 32 * nt + r]); } }
    }
}

constexpr size_t SSD_ITEM_BYTES = 33792;
__device__ __forceinline__ void phase_ssd_prep(const KP kp, const int bid, const int G, int j, LAS unsigned char* lds, int tid0) {
    unsigned char* scr = kp.ws() + WS_SCR;
    const bf16* U = (const bf16*)(kp.ws() + WS_U); bf16* XS = (bf16*)(scr + SC_XS);
    const float* cw = kp.in(23) + (size_t)j * 4 * 1536; const float* cb = kp.in(24) + (size_t)j * 1536;
    unsigned char* OPS = scr + SC_SSDOP;
    LAS float* GL = (LAS float*)lds; LAS float* DTL = GL + 256; LAS float* QK = DTL + 256; LAS bf16* Cb = (LAS bf16*)(QK + 64 * 65); LAS bf16* Bb = Cb + 64 * 72; LAS float* XLs = (LAS float*)(Bb + 64 * 72);
    const float* alog = kp.in(25) + j * 16;
    for (int item = bid; item < 512; item += G) {
        int tid = tid0; asm volatile("" : "+v"(tid));
        const int wave = tid >> 6, lane = tid & 63, r = lane & 31, hp = lane >> 5;
        const int b = item >> 7, n = (item >> 2) & 31, g = item & 3;
        const int row0 = b * 2048 + n * 64;
        __syncthreads();
        {
          const int t0 = 8 * wave; const bool first = (n == 0 && wave == 0); const long fo = first ? 0 : (long)NCD;
#pragma unroll
          for (int q = 0; q < 3; ++q) { const int k = 2 * (lane + 64 * q);
              const int cidx = k < 64 ? 1024 + g * 64 + k : (k < 128 ? 1280 + g * 64 + (k - 64) : g * 256 + (k - 128));
              const float w0a = cw[cidx], w0b = cw[cidx + 1], w1a = cw[1536 + cidx], w1b = cw[1536 + cidx + 1], w2a = cw[2 * 1536 + cidx], w2b = cw[2 * 1536 + cidx + 1], w3a = cw[3 * 1536 + cidx], w3b = cw[3 * 1536 + cidx + 1];
              const float ba = cb[cidx], bb = cb[cidx + 1];
              const bf16* up = U + (size_t)(row0 + t0) * NCD + 1024 + cidx;
              unsigned raw[11];
              raw[0] = *(const unsigned*)(up - 3 * fo); raw[1] = *(const unsigned*)(up - 2 * fo); raw[2] = *(const unsigned*)(up - 1 * fo);
#pragma unroll
              for (int t = 0; t < 8; ++t) raw[3 + t] = *(const unsigned*)(up + (size_t)t * NCD);
              if (first) { raw[0] = 0u; raw[1] = 0u; raw[2] = 0u; }
#pragma unroll
              for (int t = 0; t < 8; ++t) {
                  const float ya = silu_(ba + w0a * __uint_as_float(raw[t] << 16) + w1a * __uint_as_float(raw[t + 1] << 16) + w2a * __uint_as_float(raw[t + 2] << 16) + w3a * __uint_as_float(raw[t + 3] << 16));
                  const float yb = silu_(bb + w0b * __uint_as_float(raw[t] & 0xffff0000u) + w1b * __uint_as_float(raw[t + 1] & 0xffff0000u) + w2b * __uint_as_float(raw[t + 2] & 0xffff0000u) + w3b * __uint_as_float(raw[t + 3] & 0xffff0000u));
                  if (q == 0) { if (k < 64) *(LAS unsigned*)(Bb + (t0 + t) * 72 + k) = pk2(ya, yb); else *(LAS unsigned*)(Cb + (t0 + t) * 72 + (k - 64)) = pk2(ya, yb); }
                  else { XLs[(t0 + t) * 257 + (k - 128)] = ya; XLs[(t0 + t) * 257 + (k - 128) + 1] = yb; } } } }
        if (wave < 4) { const int h = g * 4 + wave; const float dt = softplus_(bf2f(U[(size_t)(row0 + lane) * NCD + 4608 + h]) + kp.in(26)[j * 16 + h]);
            DTL[wave * 64 + lane] = dt; float gv = -__expf(alog[h]) * dt;
#pragma unroll
            for (int o = 1; o < 64; o <<= 1) { const float tt = __shfl_up(gv, o); if (lane >= o) gv += tt; }
            GL[wave * 64 + lane] = gv; }
        __syncthreads();
        if (wave < 4) {
            const int mt = wave >> 1, nt = wave & 1;
            f32x16 acc;
#pragma unroll
            for (int i = 0; i < 16; ++i) acc[i] = 0.f;
#pragma unroll
            for (int ks = 0; ks < 4; ++ks) acc = MFMA32(*(const LAS bf16x8*)(Cb + (32 * mt + r) * 72 + 16 * ks + 8 * hp), *(const LAS bf16x8*)(Bb + (32 * nt + r) * 72 + 16 * ks + 8 * hp), acc);
#pragma unroll
            for (int i16 = 0; i16 < 16; ++i16) QK[(32 * mt + crow(i16, hp)) * 65 + 32 * nt + r] = acc[i16];
        } else {
            for (int i = tid - 256; i < 8192; i += 256) { const int t = i >> 7, k2 = i & 127;
                ((unsigned*)XS)[((size_t)(row0 + t) * 1024 + g * 256) / 2 + k2] = pk2(XLs[t * 257 + 2 * k2], XLs[t * 257 + 2 * k2 + 1]); }
        }
        __syncthreads();
        const int f = wave, mt = f >> 2, ks = f & 3;
        for (int hh = 0; hh < 4; ++hh) {
            const int h = g * 4 + hh; const LAS float* Gh = GL + hh * 64; const float Gend = Gh[63];
            bf16x8* base = (bf16x8*)(OPS + ((size_t)((b * 32 + n) * 16 + h)) * SSD_ITEM_BYTES);
            float v[8];
            { const int i = 32 * mt + r; const float eg = __expf(Gh[i]);
#pragma unroll
              for (int jp = 0; jp < 8; ++jp) { const int d = 16 * ks + 8 * (jp >> 2) + 4 * hp + (jp & 3); v[jp] = bf2f(Cb[i * 72 + d]) * eg; }
              base[0 * 512 + f * 64 + lane] = pack8(v); }
            { const int d = 32 * mt + r;
#pragma unroll
              for (int jp = 0; jp < 8; ++jp) { const int tk = 16 * ks + 8 * (jp >> 2) + 4 * hp + (jp & 3); v[jp] = bf2f(Bb[tk * 72 + d]) * __expf(Gend - Gh[tk]); }
              base[1 * 512 + f * 64 + lane] = pack8(v); }
            { const int i = 32 * mt + r; const float gi = Gh[i];
#pragma unroll
              for (int jp = 0; jp < 8; ++jp) { const int jt = 16 * ks + 8 * (jp >> 2) + 4 * hp + (jp & 3); v[jp] = jt <= i ? QK[i * 65 + jt] * __expf(gi - Gh[jt]) : 0.f; }
              base[2 * 512 + f * 64 + lane] = pack8(v); }
            { const int p = 32 * mt + r;
#pragma unroll
              for (int jp = 0; jp < 8; ++jp) { const int tk = 16 * ks + 8 * (jp >> 2) + 4 * hp + (jp & 3);
                  v[jp] = XLs[tk * 257 + hh * 64 + p] * DTL[hh * 64 + tk]; }
              base[3 * 512 + f * 64 + lane] = pack8(v); }
            if (tid == 0) *(float*)(base + 32 * 64) = __expf(Gend);
        }
    }
}

__device__ __forceinline__ void phase_cd_rec(const KP kp, const int bid, const int G, int j, int li, LAS unsigned char* lds, int tid0) {
    unsigned char* scr = kp.ws() + WS_SCR; const bf16* U = (const bf16*)(kp.ws() + WS_U);
    const float* LA = (const float*)(scr + SC_LA); const float* LB = (const float*)(scr + SC_LB);
    bf16* YS = (bf16*)(scr + SC_YS); bf16* HS = (bf16*)(scr + SC_HS); bf16* XS = (bf16*)(scr + SC_XS);
    SEC_BEGIN(10)
    for (int item = bid; item < 64; item += G) {
        int tid = tid0; asm volatile("" : "+v"(tid));
        const int b = item >> 4, hd = item & 15;
        __syncthreads();
        const int wave = __builtin_amdgcn_readfirstlane(tid >> 6), lane = tid & 63, r = lane & 31, hp = lane >> 5, nt = wave;
        const unsigned char* OPS = scr + SC_SSDOP;
        const bool dmaw = (wave >= 2 && wave < 6);
        constexpr int SLOT = 33 * 1024;
#define SSD_DMA(n_) do { if (dmaw) { const unsigned char* gi_ = OPS + ((size_t)((b * 32 + (n_)) * 16 + hd)) * SSD_ITEM_BYTES + lane * 16; \
            _Pragma("unroll") for (int q_ = 0; q_ < 9; ++q_) { const int lf_ = q_ < 8 ? (wave - 2) * 8 + q_ : 32; \
                __builtin_amdgcn_global_load_lds((const unsigned*)(gi_ + lf_ * 1024), (LAS unsigned*)(lds + ((n_) & 3) * SLOT + lf_ * 1024), 16, 0, 2); } } } while (0)
        f32x16 S0, S1;
#pragma unroll
        for (int i = 0; i < 16; ++i) { S0[i] = 0.f; S1[i] = 0.f; }
        SSD_DMA(0); SSD_DMA(1); SSD_DMA(2);
        if (dmaw) asm volatile("s_waitcnt vmcnt(18)" ::: "memory");
        asm volatile("" ::: "memory"); __builtin_amdgcn_s_barrier(); asm volatile("" ::: "memory");
        for (int n = 0; n < 32; ++n) {
            if (n + 3 < 32) SSD_DMA(n + 3);
            if (wave < 2) {
                const LAS bf16x8* F = (const LAS bf16x8*)(lds + (n & 3) * SLOT) + lane;
                bf16x8 vb[4];
#pragma unroll
                for (int ks = 0; ks < 4; ++ks) vb[ks] = F[(24 + nt * 4 + ks) * 64];
                const float gend = *(const LAS float*)(lds + (n & 3) * SLOT + 32 * 1024);
                const bf16x8 sb00 = PACK_ACC(S0, 0), sb01 = PACK_ACC(S0, 1), sb10 = PACK_ACC(S1, 0), sb11 = PACK_ACC(S1, 1);
                f32x16 O0, O1;
#pragma unroll
                for (int i = 0; i < 16; ++i) { O0[i] = 0.f; O1[i] = 0.f; }
                O0 = MFMA32(F[0 * 64], sb00, O0); O0 = MFMA32(F[1 * 64], sb01, O0); O0 = MFMA32(F[2 * 64], sb10, O0); O0 = MFMA32(F[3 * 64], sb11, O0);
                O1 = MFMA32(F[4 * 64], sb00, O1); O1 = MFMA32(F[5 * 64], sb01, O1); O1 = MFMA32(F[6 * 64], sb10, O1); O1 = MFMA32(F[7 * 64], sb11, O1);
                O0 = MFMA32(F[16 * 64], vb[0], O0); O0 = MFMA32(F[17 * 64], vb[1], O0);
#pragma unroll
                for (int ks = 0; ks < 4; ++ks) O1 = MFMA32(F[(20 + ks) * 64], vb[ks], O1);
#pragma unroll
                for (int i = 0; i < 16; ++i) { S0[i] *= gend; S1[i] *= gend; }
#pragma unroll
                for (int ks = 0; ks < 4; ++ks) { S0 = MFMA32(F[(8 + ks) * 64], vb[ks], S0); S1 = MFMA32(F[(12 + ks) * 64], vb[ks], S1); }
                bf16* yo = YS + (size_t)(b * 2048 + n * 64) * 1024 + hd * 64 + 32 * nt + r;
#pragma unroll
                for (int i = 0; i < 16; ++i) { yo[(size_t)crow(i, hp) * 1024] = (bf16)f2bf(O0[i]); yo[(size_t)(32 + crow(i, hp)) * 1024] = (bf16)f2bf(O1[i]); }
            }
            if (dmaw) { if (n + 3 < 32) asm volatile("s_waitcnt vmcnt(18)" ::: "memory"); else if (n + 2 < 32) asm volatile("s_waitcnt vmcnt(9)" ::: "memory"); else asm volatile("s_waitcnt vmcnt(0)" ::: "memory"); }
            asm volatile("s_waitcnt lgkmcnt(0)" ::: "memory"); __builtin_amdgcn_s_barrier(); asm volatile("" ::: "memory");
        }
#undef SSD_DMA
        if (wave < 2) {
            float* dst = kp.out() + O_SSD_P + ((size_t)j * 4 + b) * ((size_t)16 * 64 * 64) + (size_t)hd * 64 * 64 + 32 * nt + r;
#pragma unroll
            for (int i = 0; i < 16; ++i) { dst[(size_t)crow(i, hp) * 64] = S0[i]; dst[(size_t)(32 + crow(i, hp)) * 64] = S1[i]; }
        }
    }
    SEC_END(10, lds)
    SEC_BEGIN(11)
    unsigned* qhead = (unsigned*)(kp.ws() + WS_CTL) + CW_CNT + 64 * li;
    volatile LAS unsigned* qslot = (volatile LAS unsigned*)(lds + LDS_BYTES - 8);
    const float* cw = kp.in(23) + (size_t)j * 4 * 1536; const float* cb = kp.in(24) + (size_t)j * 1536; const float* stc = kp.in(6) + (size_t)j * 128 * 3 * 1536;
    for (;;) {
        __syncthreads();
        if (tid0 == 0) qslot[0] = __hip_atomic_fetch_add(qhead, 1u, __ATOMIC_RELAXED, __HIP_MEMORY_SCOPE_AGENT);
        __syncthreads();
        const int it = (int)qslot[0];
        if (it >= 1024) break;
        int tid = tid0; asm volatile("" : "+v"(tid));
        if (it < 256) {
            const int s = it >> 6, h = it & 63; int row0, L; seq_info(s, row0, L);
            LAS float* Al = (LAS float*)lds; LAS float* Bl = Al + 512;
            const int chunk = tid >> 4, c16 = tid & 15, ch = h * 16 + c16;
            const size_t ro = (size_t)(row0 + chunk * 64) * 1024 + ch;
            float av[64], bv[64];
            { const float* pa = LA + ro; const float* pb = LB + ro;
#pragma unroll
              for (int t = 0; t < 64; ++t) { av[t] = *pa; bv[t] = *pb; pa += 1024; pb += 1024; asm volatile("" : "+v"(pa), "+v"(pb)); } }
            float Ap = 1.f, Bp = 0.f;
#pragma unroll
            for (int t = 0; t < 64; ++t) { Bp = av[t] * Bp + bv[t]; Ap *= av[t]; }
            Al[tid] = Ap; Bl[tid] = Bp;
            __syncthreads();
            float hh = 0.f;
            for (int m = 0; m < chunk; ++m) hh = Al[m * 16 + c16] * hh + Bl[m * 16 + c16];
            { bf16* ph = HS + ro;
#pragma unroll
              for (int t = 0; t < 64; ++t) { hh = av[t] * hh + bv[t]; *ph = (bf16)f2bf(hh); ph += 1024; asm volatile("" : "+v"(ph)); } }
            if (chunk == 31) kp.out()[O_LRU_P + ((size_t)j * 4 + s) * 1024 + ch] = hh;
        } else if (it < 768) {
            const int q_ = it - 256, bs = q_ >> 2, g = q_ & 3, sq = 4 + bs, r0 = TP + bs * 4;
            LAS float* BL = (LAS float*)lds; LAS float* CL = BL + 256; LAS float* XL = CL + 256; LAS float* DTL = XL + 1024; LAS float* QKs = DTL + 16; LAS float* red = QKs + 16;
            const int wave = tid >> 6, lane = tid & 63, hh = tid >> 7, nh = (tid >> 6) & 1, p = tid & 63, hd = 4 * g + hh;
            const size_t SZ = (size_t)16 * 64 * 64;
            const float* st = kp.in(5) + ((size_t)j * 128 + bs) * SZ + (size_t)hd * 4096;
            float S[32];
            { const float* sp = st + (size_t)(nh * 32) * 64 + p;
#pragma unroll
              for (int i = 0; i < 32; ++i) { S[i] = __builtin_nontemporal_load(sp); sp += 64; asm volatile("" : "+v"(sp)); } }
            { const int ci = tid & 127, tk = tid >> 7;
#pragma unroll
              for (int q = 0; q < 3; ++q) { const int k = ci + 128 * q; int cidx; LAS float* dst;
                  if (k < 64) { cidx = 1024 + g * 64 + k; dst = BL + k * 4 + tk; } else if (k < 128) { cidx = 1280 + g * 64 + (k - 64); dst = CL + (k - 64) * 4 + tk; } else { cidx = g * 256 + (k - 128); dst = XL + tk * 256 + (k - 128); }
                  float acc = cb[cidx];
#pragma unroll
                  for (int tap = 0; tap < 4; ++tap) acc += cw[tap * 1536 + cidx] * pre_val(U, NCD, 1024 + cidx, r0, tk - 3 + tap, sq, stc, 1536, cidx);
                  *dst = silu_(acc); } }
            if (tid < 16) { const int tk = tid >> 2, h2 = tid & 3; DTL[tid] = softplus_(bf2f(U[(size_t)(r0 + tk) * NCD + 4608 + 4 * g + h2]) + kp.in(26)[j * 16 + 4 * g + h2]); }
            __syncthreads();
#pragma unroll
            for (int q = 0; q < 2; ++q) { const int idx = wave * 2 + q, i = idx >> 2, jj = idx & 3; const float dot = wave_sum(CL[lane * 4 + i] * BL[lane * 4 + jj]); if (lane == 0) QKs[idx] = dot; }
            { const int tk = tid >> 7, k2 = tid & 127; ((unsigned*)XS)[((size_t)(r0 + tk) * 1024 + g * 256) / 2 + k2] = pk2(XL[tk * 256 + 2 * k2], XL[tk * 256 + 2 * k2 + 1]); }
            const float negA = -__expf(kp.in(25)[j * 16 + hd]);
            float Gc[4], xd[4], w[4];
            Gc[0] = negA * DTL[hh]; Gc[1] = Gc[0] + negA * DTL[4 + hh]; Gc[2] = Gc[1] + negA * DTL[8 + hh]; Gc[3] = Gc[2] + negA * DTL[12 + hh];
#pragma unroll
            for (int jj = 0; jj < 4; ++jj) { xd[jj] = XL[jj * 256 + hh * 64 + p] * DTL[jj * 4 + hh]; w[jj] = __expf(Gc[3] - Gc[jj]) * xd[jj]; }
            const float eg = __expf(Gc[3]);
            float o[4] = {0.f, 0.f, 0.f, 0.f};
            float* dst = kp.out() + O_SSD_S + ((size_t)j * 128 + bs) * SZ + (size_t)hd * 4096 + (size_t)(nh * 32) * 64 + p;
#pragma unroll
            for (int i = 0; i < 32; ++i) { const int n = nh * 32 + i; const float s0 = S[i]; float acc = eg * s0; const f32x4 c4 = *(const LAS f32x4*)(CL + n * 4), b4 = *(const LAS f32x4*)(BL + n * 4);
#pragma unroll
                for (int t = 0; t < 4; ++t) { o[t] += c4[t] * s0; acc += b4[t] * w[t]; }
                __builtin_nontemporal_store(acc, dst); dst += 64; asm volatile("" : "+v"(dst)); }
#pragma unroll
            for (int t = 0; t < 4; ++t) red[((hh * 2 + nh) * 4 + t) * 64 + p] = o[t];
            __syncthreads();
            if (nh == 0) {
#pragma unroll
                for (int t = 0; t < 4; ++t) { float y = __expf(Gc[t]) * (red[((hh * 2) * 4 + t) * 64 + p] + red[((hh * 2 + 1) * 4 + t) * 64 + p]);
#pragma unroll
                    for (int jj = 0; jj <= t; ++jj) y += QKs[t * 4 + jj] * __expf(Gc[t] - Gc[jj]) * xd[jj];
                    YS[(size_t)(r0 + t) * 1024 + hd * 64 + p] = (bf16)f2bf(y); } }
        } else {
            const int q_ = it - 768, s = 4 + (q_ >> 1), h = q_ & 1; int row0, L; seq_info(s, row0, L);
            const int ch = h * 512 + tid;
            float hh = s < 4 ? 0.f : kp.in(7)[((size_t)j * 128 + (s - 4)) * 1024 + ch];
#pragma unroll 8
            for (int t = 0; t < L; ++t) { const size_t r = (size_t)(row0 + t); hh = LA[r * 1024 + ch] * hh + LB[r * 1024 + ch]; HS[r * 1024 + ch] = (bf16)f2bf(hh); }
            float* dst = s < 4 ? kp.out() + O_LRU_P + ((size_t)j * 4 + s) * 1024 : kp.out() + O_LRU_S + ((size_t)j * 128 + (s - 4)) * 1024;
            dst[ch] = hh;
        }
    }
    SEC_END(11, lds)
}

__device__ __forceinline__ void phase_cd_post(const KP kp, const int bid, const int G, int j, int tid, int wave, int lane) {
    unsigned char* scr = kp.ws() + WS_SCR; const bf16* U = (const bf16*)(kp.ws() + WS_U); bf16* YM = (bf16*)(kp.ws() + WS_YM);
    const bf16* YS = (const bf16*)(scr + SC_YS); const bf16* HS = (const bf16*)(scr + SC_HS); const bf16* XS = (const bf16*)(scr + SC_XS);
    const float* sn = kp.in(28) + (size_t)j * 1024; const float* Dv = kp.in(27) + (size_t)j * 16;
    typedef float f32x2v __attribute__((ext_vector_type(2)));
    const int stride = G * NWAVES;
#define CD_LOAD(r_, YV, XV, ZV, HV, LV) do { const bf16* ur_ = U + (size_t)(r_) * NCD; \
        _Pragma("unroll") for (int gq = 0; gq < 4; ++gq) { const int e_ = gq * 256 + 4 * lane; YV[gq] = *(const u32x2*)(YS + (size_t)(r_) * 1024 + e_); XV[gq] = *(const u32x2*)(XS + (size_t)(r_) * 1024 + e_); ZV[gq] = *(const u32x2*)(ur_ + e_); \
            HV[gq] = *(const u32x2*)(HS + (size_t)(r_) * 1024 + e_); LV[gq] = *(const u32x2*)(ur_ + 2560 + e_); } } while (0)
    int idx = bid * NWAVES + wave;
    u32x2 yv[4], xv[4], zv[4], hv[4], lv[4];
    if (idx < T) CD_LOAD(POST_ROW(idx), yv, xv, zv, hv, lv);
    for (; idx < T; idx += stride) {
        const int r = POST_ROW(idx), nidx = idx + stride;
        u32x2 yn[4], xn[4], zn[4], hn[4], ln[4];
#pragma unroll
        for (int gq = 0; gq < 4; ++gq) { yn[gq] = (u32x2){0u, 0u}; xn[gq] = yn[gq]; zn[gq] = yn[gq]; hn[gq] = yn[gq]; ln[gq] = yn[gq]; }
        if (nidx < T) CD_LOAD(POST_ROW(nidx), yn, xn, zn, hn, ln);
        int s, t; row_to_seq(r, s, t); int row0, L; seq_info(s, row0, L);
        const bf16* ur = U + (size_t)r * NCD; bf16* yr = YM + (size_t)r * DM;
#pragma unroll
        for (int gq = 0; gq < 4; ++gq) { const int e = gq * 256 + 4 * lane; const u32x2 ys = yv[gq], xx = xv[gq], zz = zv[gq]; const float Dh = Dv[e >> 6];
            f32x4 y; y.x = (__uint_as_float(ys.x << 16) + Dh * __uint_as_float(xx.x << 16)) * silu_(__uint_as_float(zz.x << 16)); y.y = (__uint_as_float(ys.x & 0xffff0000u) + Dh * __uint_as_float(xx.x & 0xffff0000u)) * silu_(__uint_as_float(zz.x & 0xffff0000u));
            y.z = (__uint_as_float(ys.y << 16) + Dh * __uint_as_float(xx.y << 16)) * silu_(__uint_as_float(zz.y << 16)); y.w = (__uint_as_float(ys.y & 0xffff0000u) + Dh * __uint_as_float(xx.y & 0xffff0000u)) * silu_(__uint_as_float(zz.y & 0xffff0000u));
            const float rstd = rsqrtf(wave_sum((y.x * y.x + y.y * y.y) + (y.z * y.z + y.w * y.w)) * (1.f / 256.f) + 1e-6f);
            const f32x4 g4 = *(const f32x4*)(sn + e);
            u32x2 w; w.x = pk2(y.x * rstd * g4.x, y.y * rstd * g4.y); w.y = pk2(y.z * rstd * g4.z, y.w * rstd * g4.w); *(u32x2*)(yr + e) = w; }
#pragma unroll
        for (int gq = 0; gq < 4; ++gq) { const int ch = gq * 256 + 4 * lane; const u32x2 hs = hv[gq], zz = lv[gq];
            u32x2 w; w.x = pk2(__uint_as_float(hs.x << 16) * silu_(__uint_as_float(zz.x << 16)), __uint_as_float(hs.x & 0xffff0000u) * silu_(__uint_as_float(zz.x & 0xffff0000u)));
            w.y = pk2(__uint_as_float(hs.y << 16) * silu_(__uint_as_float(zz.y << 16)), __uint_as_float(hs.y & 0xffff0000u) * silu_(__uint_as_float(zz.y & 0xffff0000u)));
            *(u32x2*)(yr + 1024 + ch) = w; }
        if (t >= L - 3) { const int rr = t - (L - 3);
            float* d1 = s < 4 ? kp.out() + O_SSDC_P + (((size_t)j * 4 + s) * 3 + rr) * 1536 : kp.out() + O_SSDC_S + (((size_t)j * 128 + (s - 4)) * 3 + rr) * 1536;
            for (int c = 2 * lane; c < 1536; c += 128) { const unsigned uu = *(const unsigned*)(ur + 1024 + c); *(f32x2v*)(d1 + c) = (f32x2v){__uint_as_float(uu << 16), __uint_as_float(uu & 0xffff0000u)}; }
            float* d2 = s < 4 ? kp.out() + O_LRUC_P + (((size_t)j * 4 + s) * 3 + rr) * 1024 : kp.out() + O_LRUC_S + (((size_t)j * 128 + (s - 4)) * 3 + rr) * 1024;
            for (int c = 2 * lane; c < 1024; c += 128) { const unsigned uu = *(const unsigned*)(ur + 3584 + c); *(f32x2v*)(d2 + c) = (f32x2v){__uint_as_float(uu << 16), __uint_as_float(uu & 0xffff0000u)}; } }
#pragma unroll
        for (int gq = 0; gq < 4; ++gq) { yv[gq] = yn[gq]; xv[gq] = xn[gq]; zv[gq] = zn[gq]; hv[gq] = hn[gq]; lv[gq] = ln[gq]; }
    }
#undef CD_LOAD
#undef POST_ROW
}

typedef float f32x4m __attribute__((ext_vector_type(4)));
template <bool GATE>
__device__ __forceinline__ void sample_gemm_res(LAS unsigned char* lds, const bf16* Amat, const bf16* Bt, const bf16* Hin, bf16* Hout, float* rss_out, const bf16* PP, const float* rss_in, int bid, int tid) {
    if (bid >= 256) return;
    const int wave = tid >> 6, lane = tid & 63, lr = lane & 15, kg = lane >> 4;
    const int m0 = TP + (bid & 7) * 64, n0 = (bid >> 3) * 64;
    const bf16x8* ap = (const bf16x8*)(Amat + (size_t)(m0 + lr) * 2048 + wave * 256 + 8 * kg);
    const bf16x8* bp = (const bf16x8*)(Bt + (size_t)(n0 + lr) * 2048 + wave * 256 + 8 * kg);
    f32x4m acc[4][4];
#pragma unroll
    for (int mi = 0; mi < 4; ++mi)
#pragma unroll
        for (int ni = 0; ni < 4; ++ni) acc[mi][ni] = (f32x4m){0.f, 0.f, 0.f, 0.f};
#pragma unroll 2
    for (int ks = 0; ks < 8; ++ks) { bf16x8 a[4], b[4];
#pragma unroll
        for (int q = 0; q < 4; ++q) { a[q] = ap[(size_t)q * 16 * 256 + ks * 4]; b[q] = bp[(size_t)q * 16 * 256 + ks * 4]; }
#pragma unroll
        for (int mi = 0; mi < 4; ++mi)
#pragma unroll
            for (int ni = 0; ni < 4; ++ni) acc[mi][ni] = __builtin_amdgcn_mfma_f32_16x16x32_bf16(a[mi], b[ni], acc[mi][ni], 0, 0, 0); }
    LAS float* red = (LAS float*)lds;
    __syncthreads();
#pragma unroll
    for (int mi = 0; mi < 4; ++mi)
#pragma unroll
        for (int ni = 0; ni < 4; ++ni)
#pragma unroll
            for (int i = 0; i < 4; ++i) red[(wave * 64 + 16 * mi + kg * 4 + i) * 65 + 16 * ni + lr] = acc[mi][ni][i];
    __syncthreads();
    { const int row = tid >> 3, c8 = (tid & 7) * 8, grow = m0 + row; float v[8];
#pragma unroll
      for (int e = 0; e < 8; ++e) { float sacc = 0.f;
#pragma unroll
          for (int w = 0; w < 8; ++w) sacc += red[(w * 64 + row) * 65 + c8 + e];
          v[e] = sacc; }
      float sc = 1.f; if (GATE) sc = rsqrtf(rss_in[grow] * (1.f / 2048.f) + 1e-6f);
      const size_t p = (size_t)grow * 2048 + n0 + c8;
      const u32x4 hw = *(const u32x4*)(Hin + p); u32x4 pw = (u32x4){0u, 0u, 0u, 0u}; if (GATE) pw = *(const u32x4*)(PP + p);
      const unsigned hws[4] = {hw.x, hw.y, hw.z, hw.w}, pws[4] = {pw.x, pw.y, pw.z, pw.w}; unsigned ow[4]; float sq = 0.f;
#pragma unroll
      for (int e2 = 0; e2 < 4; ++e2) { float h0 = __uint_as_float(hws[e2] << 16), h1 = __uint_as_float(hws[e2] & 0xffff0000u);
          if (GATE) { h0 += __builtin_amdgcn_rcpf(1.f + __expf(-sc * v[2 * e2])) * __uint_as_float(pws[e2] << 16); h1 += __builtin_amdgcn_rcpf(1.f + __expf(-sc * v[2 * e2 + 1])) * __uint_as_float(pws[e2] & 0xffff0000u); }
          else { h0 += v[2 * e2]; h1 += v[2 * e2 + 1]; }
          sq += h0 * h0 + h1 * h1; ow[e2] = cvtpk(h0, h1); }
      *(u32x4*)(Hout + p) = (u32x4){ow[0], ow[1], ow[2], ow[3]};
      sq += __shfl_xor(sq, 1); sq += __shfl_xor(sq, 2); sq += __shfl_xor(sq, 4);
      if ((tid & 7) == 0) atomicAdd(rss_out + grow, sq); }
}

__global__ void __launch_bounds__(NTHR, 2) mega_fwd(Args A) {
    extern __shared__ __attribute__((aligned(16))) unsigned char lds_raw[];
    LAS unsigned char* lds = (LAS unsigned char*)lds_raw;
    const int G = gridDim.x;
    volatile LAS unsigned* bst = (volatile LAS unsigned*)(lds + LDS_BYTES - 16);
    if (threadIdx.x == 0) { bst[0] = 0u; bst[1] = 0u;
#ifdef PROBE_SEC
        *(volatile LAS unsigned long long*)(lds + LDS_BYTES - 32) = 0ull;
#endif
    }
    __syncthreads();
    XcdBarrier xbar = xcd_barrier_post((unsigned*)(A.ws + WS_CTL) + CW_BAR, bst);
#ifdef PROBE_GROUP
    unsigned long long t_prev = __builtin_amdgcn_s_memrealtime(), t_sel = 0;
#endif
    for (int ph = A.ph_lo; ph < A.ph_hi; ++ph) {
        KP kp; kp.p = (const char AS4*)__builtin_amdgcn_kernarg_segment_ptr(); asm volatile("" : "+s"(kp.p));
        unsigned char* ws = kp.ws();
        int tid = threadIdx.x; asm volatile("" : "+v"(tid));
        int bid = blockIdx.x; asm volatile("" : "+s"(bid));
        const int lane = tid & 63, wave = __builtin_amdgcn_readfirstlane(tid >> 6), gw = bid * NWAVES + wave, NGW = G * NWAVES;
        if (ph == 0) { if (PH_MASK & 1) phase_prologue(kp, lds, gw, NGW, wave, lane); }
        else if (ph == N_PHASES - 1) { SEC_BEGIN(32) phase_final(kp, gw, NGW, lane); SEC_END(32, lds) }
        else {
            const int li = (ph - 1) / SUBS, sub = (ph - 1) % SUBS, j = li >> 1; const bool ab = (li & 1) == 0;
            float* RSS = (float*)(ws + WS_RSS);
            if (sub == 0) {
                const int N = ab ? NAB : NCD;
                const bf16* Bt = ab ? (const bf16*)(ws + WS_WABIN) + (size_t)j * NAB * 2048 : (const bf16*)(ws + WS_WCDIN) + (size_t)j * NCD * 2048;
                { pg8::Gemm g{(const bf16*)(ws + WS_XN), Bt, T, N, 2048}; pg8::StaticOrder S; S.init(T, N, G, bid);
                  pg8::EpiU E{(bf16*)(ws + WS_U), N, RSS + (size_t)(2 * li) * T};
                  if (PH_MASK & 2) pg8::gemm_phase<pg8::EpiU, pg8::StaticOrder, true, true>(lds, g, S, E, tid); }
                { int tid2 = tid; asm volatile("" : "+v"(tid2));
                  int pM = T, pG = G, pc = bid, prow = 0;
                  if (G == 256) { if (ab) { if (bid >= 218) { pM = 4864; pG = 38; pc = bid - 218; } else { prow = 4864; pM = T - 4864; pG = 120; pc = bid; } }
                                  else { pG = 122; pc = bid >= 134 ? bid - 134 : 100000; } }
                  pg8::StaticOrder S; S.init(pM, 2048, pG, pc);
                  pg8::Gemm g{(const bf16*)(ws + WS_PB) + ((size_t)li * T + prow) * 256, (const bf16*)(ws + WS_WPROJ) + (size_t)li * 2048 * 256, pM, 2048, 256};
                  pg8::EpiU E{(bf16*)(ws + WS_SCR + SC_PP) + (size_t)prow * 2048, 2048, nullptr};
                  if (PH_MASK & 2) pg8::gemm_phase<pg8::EpiU, pg8::StaticOrder, true, true>(lds, g, S, E, tid2); }
            } else if (sub == 4) {
                const bf16* Bt = ab ? (const bf16*)(ws + WS_WABOUT) + (size_t)j * 2048 * 2048 : (const bf16*)(ws + WS_WCDOUT) + (size_t)j * 2048 * 2048;
                pg8::Gemm g{(const bf16*)(ws + WS_YM), Bt, TP, 2048, 2048}; pg8::StaticOrder S; S.init(TP, 2048, G, bid);
                pg8::EpiRes<false> E{(const bf16*)(ws + WS_XN), (bf16*)(ws + WS_SCR + SC_HB1), RSS + (size_t)(2 * li + 1) * T, nullptr, nullptr};
                if (PH_MASK & 4) pg8::gemm_phase<pg8::EpiRes<false>, pg8::StaticOrder, true, true>(lds, g, S, E, tid);
                { int tid2 = tid; asm volatile("" : "+v"(tid2));
                  sample_gemm_res<false>(lds, (const bf16*)(ws + WS_YM), Bt, (const bf16*)(ws + WS_XN), (bf16*)(ws + WS_SCR + SC_HB1), RSS + (size_t)(2 * li + 1) * T, nullptr, nullptr, bid, tid2); }
            } else if (sub == 5) {
                pg8::Gemm g{(const bf16*)(ws + WS_SCR + SC_HB1), (const bf16*)(ws + WS_WGATE) + (size_t)li * 2048 * 2048, TP, 2048, 2048}; pg8::StaticOrder S; S.init(TP, 2048, G, bid);
                pg8::EpiRes<true> E{(const bf16*)(ws + WS_SCR + SC_HB1), (bf16*)(ws + WS_XN), RSS + (size_t)(2 * li + 2) * T, (const bf16*)(ws + WS_SCR + SC_PP), RSS + (size_t)(2 * li + 1) * T};
                if (PH_MASK & 4) pg8::gemm_phase<pg8::EpiRes<true>, pg8::StaticOrder, true, true>(lds, g, S, E, tid);
                { int tid2 = tid; asm volatile("" : "+v"(tid2));
                  sample_gemm_res<true>(lds, (const bf16*)(ws + WS_SCR + SC_HB1), (const bf16*)(ws + WS_WGATE) + (size_t)li * 2048 * 2048, (const bf16*)(ws + WS_SCR + SC_HB1), (bf16*)(ws + WS_XN), RSS + (size_t)(2 * li + 2) * T,
                                        (const bf16*)(ws + WS_SCR + SC_PP), RSS + (size_t)(2 * li + 1) * T, bid, tid2); }
            } else if (sub == 1) {
                if (ab) { SEC_BEGIN(3) if (PH_MASK & 4096) phase_gla_prep(kp, bid, G, j, lds, tid); SEC_END(3, lds) SEC_BEGIN(4) if (PH_MASK & 8192) phase_dn_prep(kp, bid, G, j, lds, tid); SEC_END(4, lds) }
                else { if (PH_MASK & 2048) { SEC_BEGIN(8) phase_ssd_prep(kp, bid, G, j, lds, tid); SEC_END(8, lds) SEC_BEGIN(9) phase_lru_gates(kp, bid, G, j, lds, tid); SEC_END(9, lds) } }
            }
            else if (sub == 2) { if (ab) { if (PH_MASK & 32) phase_ab_rec(kp, bid, G, j, li, lds, tid); } else { if (PH_MASK & 64) phase_cd_rec(kp, bid, G, j, li, lds, tid); } }
            else { if (ab) { SEC_BEGIN(30) if (PH_MASK & 128) phase_ab_post(kp, bid, G, j, tid, wave, lane); SEC_END(30, lds) } else { SEC_BEGIN(31) if (PH_MASK & 256) phase_cd_post(kp, bid, G, j, tid, wave, lane); SEC_END(31, lds) } }
        }
        if (ph + 1 < A.ph_hi) { if (ph == A.ph_lo) cg::this_grid().sync(); else xcd_barrier(xbar); }
#ifdef PROBE_GROUP
        { const unsigned long long t_now = __builtin_amdgcn_s_memrealtime(); const int li_ = (ph - 1) / SUBS, sub_ = (ph - 1) % SUBS; const bool ab_ = (li_ & 1) == 0;
          int grp = 9; if (ph == N_PHASES - 1) grp = 8; else if (ph > 0) { if (sub_ == 0 || sub_ == 4 || sub_ == 5) grp = 1; else if (sub_ == 1) grp = ab_ ? 4 : 5; else if (sub_ == 2) grp = ab_ ? 6 : 7; else grp = 8; }
          if (grp == PROBE_GROUP) t_sel += t_now - t_prev; t_prev = t_now; }
#endif
    }
#ifdef PROBE_SEC
    if (blockIdx.x == PROBE_BLK && threadIdx.x == 0) { const unsigned long long t_s = *(volatile LAS unsigned long long*)(lds + LDS_BYTES - 32); const unsigned long long t0 = __builtin_amdgcn_s_memrealtime(); while (__builtin_amdgcn_s_memrealtime() - t0 < 3 * t_s) __builtin_amdgcn_s_sleep(8); }
#endif
#ifdef PROBE_GROUP
    if (blockIdx.x == 0 && threadIdx.x == 0) { const unsigned long long t0 = __builtin_amdgcn_s_memrealtime(); while (__builtin_amdgcn_s_memrealtime() - t0 < 3 * t_sel) __builtin_amdgcn_s_sleep(8); }
#endif
}

extern "C" void kernel_launch(void* const* d_in, const int* in_sizes, int n_in, void* d_out, int out_size, void* d_ws, size_t ws_size, hipStream_t stream) {
    static int grid = 0;
    if (grid == 0) {
        if (n_in != 40 || (size_t)out_size != O_END || ws_size < WS_END) { fprintf(stderr, "kernel_launch: unexpected shapes: n_in %d out %d ws %zu\n", n_in, out_size, ws_size); grid = -1; return; }
        int dev = 0, cus = 0, per_cu = 0;
        if (hipGetDevice(&dev) != hipSuccess || hipDeviceGetAttribute(&cus, hipDeviceAttributeMultiprocessorCount, dev) != hipSuccess) { grid = -1; return; }
        if (hipFuncSetAttribute((const void*)mega_fwd, hipFuncAttributeMaxDynamicSharedMemorySize, LDS_BYTES) != hipSuccess) { fprintf(stderr, "kernel_launch: hipFuncSetAttribute failed\n"); grid = -1; return; }
        if (hipOccupancyMaxActiveBlocksPerMultiprocessor(&per_cu, (const void*)mega_fwd, NTHR, LDS_BYTES) != hipSuccess || per_cu < 1) { fprintf(stderr, "kernel_launch: occupancy query says %d\n", per_cu); per_cu = 1; }
        (void)hipGetLastError();
        grid = cus;
    }
    if (grid < 0) return;
    if (hipMemsetAsync((char*)d_ws + WS_CTL, 0, CTL_ZERO_BYTES, stream) != hipSuccess) { fprintf(stderr, "kernel_launch: memset of the control words failed\n"); return; }
    Args a{};
    for (int i = 0; i < 40; ++i) a.in[i] = (const float*)d_in[i];
    a.out = (float*)d_out; a.ws = (unsigned char*)d_ws;
#if MK_N_LAUNCHES == 1
    a.ph_lo = 0; a.ph_hi = N_PHASES;
    void* args[] = {&a};
    hipError_t e = hipLaunchCooperativeKernel((const void*)mega_fwd, dim3(grid), dim3(NTHR), args, LDS_BYTES, stream);
    if (e != hipSuccess) fprintf(stderr, "cooperative launch failed: %s (grid %d)\n", hipGetErrorString(e), grid);
#else
    for (int ph = 0; ph < N_PHASES; ++ph) { a.ph_lo = ph; a.ph_hi = ph + 1; mega_fwd<<<dim3(grid), dim3(NTHR), LDS_BYTES, stream>>>(a); }
#endif
}
```

```cpp
#include <hip/hip_runtime.h>
#include <hip/hip_cooperative_groups.h>
#include <cstdio>
#include <cstdint>
namespace cg = cooperative_groups;

#ifndef MK_N_LAUNCHES
#define MK_N_LAUNCHES 1
#endif

namespace pg8 {
#define PG8_LAS __attribute__((address_space(3)))
typedef unsigned short bf16_t;
typedef short bf16x8 __attribute__((ext_vector_type(8)));
typedef float f32x4 __attribute__((ext_vector_type(4)));
typedef unsigned u32x4 __attribute__((ext_vector_type(4)));
constexpr int BM = 256, BK = 64, HALF = 128, HTB = HALF * BK * 2  , STAGE_BYTES = 8 * HTB, NXCD = 8, WGM = 8;

__host__ __device__ __forceinline__ int lds_byte(int r, int c) { const int st = (r >> 4) * 2 + (c >> 5), rr = r & 15, cc = c & 31, ob = rr * 64 + cc * 2; return st * 1024 + (ob ^ (((ob >> 9) & 1) << 5)); }
__host__ __device__ __forceinline__ void stage_rc(int b, int& R, int& C) { const int st = b / 1024, sb = b % 1024, swz = sb ^ (((sb >> 9) & 1) << 5); R = (st >> 1) * 16 + swz / 64; C = (st & 1) * 32 + (swz % 64) / 2; }
__host__ __device__ __forceinline__ int perm32(int rho) { const int n = rho >> 4, i = rho & 15; return 8 * (i >> 2) + 4 * n + (i & 3); }

struct Unit { int pm, pn; };
struct Gemm { const bf16_t* A; const bf16_t* Bt; int M, N, K; };

struct StaticOrder {
    int nM, nN, nwg, G, c;
    __host__ __device__ void init(int M, int N, int G_, int c_) { nM = M / BM; nN = N / BM; nwg = nM * nN; G = G_; c = c_; }
    __host__ __device__ bool next(int i, Unit& u) const {
        const long L = (long)i * G + c; if (L >= nwg) return false;
        int wgid = (int)L; { const int q = nwg / NXCD, r = nwg % NXCD, xcd = wgid % NXCD, off = wgid / NXCD; wgid = (xcd < r ? xcd * (q + 1) : r * (q + 1) + (xcd - r) * q) + off; }
        const int nig = WGM * nN, gid = wgid / nig, fm = gid * WGM, gsz = (nM - fm) < WGM ? (nM - fm) : WGM;
        u.pm = fm + ((wgid % nig) % gsz); u.pn = (wgid % nig) / gsz; return true;
    }
    __device__ __forceinline__ void a_ready(const Unit&) const {}
    __device__ __forceinline__ void done(const Unit&) const {}
};

__device__ __forceinline__ unsigned cvt_pk_bf16(float lo, float hi) { unsigned r; asm volatile("v_cvt_pk_bf16_f32 %0, %1, %2" : "=v"(r) : "v"(lo), "v"(hi)); return r; }
struct EpiF32 {
    static constexpr bool PERM = false, AFTER_DRAIN = false;
    float* C; int ldc;
    __device__ __forceinline__ void operator()(const f32x4 (&acc)[2][2][4][2], const Unit& u, int wr, int wc, int fr, int fq) const {
        const int row0 = u.pm * BM + wr * 64 + fr, col0 = u.pn * BM + wc * 32 + 4 * fq;
#pragma unroll
        for (int ai = 0; ai < 2; ++ai)
#pragma unroll
            for (int m = 0; m < 4; ++m) { float* rowp = C + (size_t)(row0 + ai * HALF + m * 16) * ldc + col0;
#pragma unroll
                for (int bj = 0; bj < 2; ++bj)
#pragma unroll
                    for (int n = 0; n < 2; ++n) *(f32x4*)(rowp + bj * HALF + n * 16) = acc[ai][bj][m][n]; }
    }
};
struct EpiBf16 {
    static constexpr bool PERM = true, AFTER_DRAIN = false;
    bf16_t* O; int ldc;
    __device__ __forceinline__ void operator()(const f32x4 (&acc)[2][2][4][2], const Unit& u, int wr, int wc, int fr, int fq) const {
        const int row0 = u.pm * BM + wr * 64 + fr; const int col0 = u.pn * BM + wc * 32 + 8 * fq;
#pragma unroll
        for (int ai = 0; ai < 2; ++ai)
#pragma unroll
            for (int m = 0; m < 4; ++m) { bf16_t* rowp = O + (size_t)(row0 + ai * HALF + m * 16) * ldc + col0;
#pragma unroll
                for (int bj = 0; bj < 2; ++bj) { const f32x4 v0 = acc[ai][bj][m][0], v1 = acc[ai][bj][m][1];
                    u32x4 w; w.x = cvt_pk_bf16(v0[0], v0[1]); w.y = cvt_pk_bf16(v0[2], v0[3]); w.z = cvt_pk_bf16(v1[0], v1[1]); w.w = cvt_pk_bf16(v1[2], v1[3]);
                    *(u32x4*)(rowp + bj * HALF) = w; } }
    }
};

struct RangeOrder {
    int start, count;
    __host__ __device__ bool next(int i, Unit& u) const { if (i >= count) return false; const int t = start + i; u.pm = t >> 3; u.pn = t & 7; return true; }
    __device__ __forceinline__ void a_ready(const Unit&) const {}
    __device__ __forceinline__ void done(const Unit&) const {}
};
struct EpiU {
    static constexpr bool PERM = true, AFTER_DRAIN = false;
    bf16_t* O; int ldc; const float* rss;
    __device__ __forceinline__ void operator()(const f32x4 (&acc)[2][2][4][2], const Unit& u, int wr, int wc, int fr, int fq) const {
        const int row0 = u.pm * BM + wr * 64 + fr; const int col0 = u.pn * BM + wc * 32 + 8 * fq;
        float scv[8];
        const bool has = rss != nullptr; const float* rp = has ? rss + row0 : (const float*)O;
#pragma unroll
        for (int q = 0; q < 8; ++q) scv[q] = rp[has ? (q >> 2) * HALF + (q & 3) * 16 : 0];
        asm volatile("" : "+v"(scv[0]), "+v"(scv[1]), "+v"(scv[2]), "+v"(scv[3]), "+v"(scv[4]), "+v"(scv[5]), "+v"(scv[6]), "+v"(scv[7]));
#pragma unroll
        for (int q = 0; q < 8; ++q) scv[q] = has ? scv[q] : 2048.f * (1.f - 1e-6f);
#pragma unroll
        for (int ai = 0; ai < 2; ++ai)
#pragma unroll
            for (int m = 0; m < 4; ++m) { const int row = row0 + ai * HALF + m * 16; const float sc = rsqrtf(scv[ai * 4 + m] * (1.f / 2048.f) + 1e-6f);
                bf16_t* rowp = O + (size_t)row * ldc + col0;
#pragma unroll
                for (int bj = 0; bj < 2; ++bj) { const f32x4 v0 = acc[ai][bj][m][0] * sc, v1 = acc[ai][bj][m][1] * sc;
                    u32x4 w; w.x = cvt_pk_bf16(v0[0], v0[1]); w.y = cvt_pk_bf16(v0[2], v0[3]); w.z = cvt_pk_bf16(v1[0], v1[1]); w.w = cvt_pk_bf16(v1[2], v1[3]);
                    *(u32x4*)(rowp + bj * HALF) = w; } }
    }
};
typedef unsigned u32x2e __attribute__((ext_vector_type(2)));
template <bool GATE> struct EpiRes {
    static constexpr bool PERM = false, AFTER_DRAIN = false;
    const bf16_t* Hin; bf16_t* Hout; float* rss_out; const bf16_t* PP; const float* rss_in;
    __device__ __forceinline__ void operator()(const f32x4 (&acc)[2][2][4][2], const Unit& u, int wr, int wc, int fr, int fq) const {
        const int row0 = u.pm * BM + wr * 64 + fr, col0 = u.pn * BM + wc * 32 + 4 * fq;
#pragma unroll
        for (int ai = 0; ai < 2; ++ai) {
            u32x2e hw[4][2][2], pw[4][2][2]; float scv[4];
#pragma unroll
            for (int m = 0; m < 4; ++m) { const int row = row0 + ai * HALF + m * 16; const size_t ro = (size_t)row * 2048 + col0;
                scv[m] = GATE ? rss_in[row] : 0.f;
#pragma unroll
                for (int bj = 0; bj < 2; ++bj)
#pragma unroll
                    for (int n = 0; n < 2; ++n) { const size_t p = ro + bj * HALF + n * 16; hw[m][bj][n] = *(const u32x2e*)(Hin + p); if (GATE) pw[m][bj][n] = *(const u32x2e*)(PP + p); else pw[m][bj][n] = (u32x2e){0u, 0u}; } }
#pragma unroll
            for (int m = 0; m < 4; ++m) { const int row = row0 + ai * HALF + m * 16; const size_t ro = (size_t)row * 2048 + col0;
                float sc = 1.f; if (GATE) sc = rsqrtf(scv[m] * (1.f / 2048.f) + 1e-6f);
                float s = 0.f;
#pragma unroll
                for (int bj = 0; bj < 2; ++bj)
#pragma unroll
                    for (int n = 0; n < 2; ++n) { const size_t p = ro + bj * HALF + n * 16; const u32x2e hh = hw[m][bj][n], pp = pw[m][bj][n]; const f32x4 a = acc[ai][bj][m][n];
                        f32x4 h; h[0] = __uint_as_float(hh.x << 16); h[1] = __uint_as_float(hh.x & 0xffff0000u); h[2] = __uint_as_float(hh.y << 16); h[3] = __uint_as_float(hh.y & 0xffff0000u);
                        if (GATE) {
                            h[0] += __builtin_amdgcn_rcpf(1.f + __expf(-sc * a[0])) * __uint_as_float(pp.x << 16); h[1] += __builtin_amdgcn_rcpf(1.f + __expf(-sc * a[1])) * __uint_as_float(pp.x & 0xffff0000u);
                            h[2] += __builtin_amdgcn_rcpf(1.f + __expf(-sc * a[2])) * __uint_as_float(pp.y << 16); h[3] += __builtin_amdgcn_rcpf(1.f + __expf(-sc * a[3])) * __uint_as_float(pp.y & 0xffff0000u); }
                        else h = h + a;
                        s += (h[0] * h[0] + h[1] * h[1]) + (h[2] * h[2] + h[3] * h[3]);
                        u32x2e o; o.x = cvt_pk_bf16(h[0], h[1]); o.y = cvt_pk_bf16(h[2], h[3]); *(u32x2e*)(Hout + p) = o; }
                s += __shfl_xor(s, 16); s += __shfl_xor(s, 32);
                if (fq == 0) atomicAdd(rss_out + row, s); }
            asm volatile("" ::: "memory"); }
    }
};
template <class Epi, class Sched, bool ALIGN_EPI = false, bool SP2 = false>
__device__ __forceinline__ void gemm_phase(PG8_LAS unsigned char* lds, const Gemm g, const Sched& S, const Epi& E, const int tid) {
    const int wid = __builtin_amdgcn_readfirstlane(tid >> 6), lane = tid & 63, wr = wid >> 2, wc = wid & 3, fr = lane & 15, fq = lane >> 4;
    const int K = g.K, nt = K / BK;
    unsigned voffA[2], voffB[2];
#pragma unroll
    for (int i = 0; i < 2; ++i) { int R, C; stage_rc(tid * 16 + i * 8192, R, C); const int Rb = Epi::PERM ? ((R & ~31) + perm32(R & 31)) : R;
        voffA[i] = (unsigned)(R * K + C) * 2u; voffB[i] = (unsigned)(Rb * K + C) * 2u; }
    const size_t kstep = (size_t)(BK * 2);
    const size_t hstep = (size_t)HALF * K * 2;
    const size_t tstep = 2 * hstep;
    const unsigned ldsw = (unsigned)wid * 1024u;
    const int aoff = lds_byte(wr * 64 + fr, fq * 8), boff = lds_byte(wc * 32 + fr, fq * 8);
#define PG8_SA(b, h) (((b) * 2 + (h)) * HTB)
#define PG8_SB(b, h) ((4 + (b) * 2 + (h)) * HTB)
#define PG8_STAGE(bufoff, gbase, voff) do { _Pragma("unroll") for (int _i = 0; _i < 2; ++_i) \
        __builtin_amdgcn_global_load_lds((const unsigned*)((const char*)(gbase) + (voff)[_i]), (PG8_LAS unsigned*)(lds + (bufoff) + ldsw + _i * 8192), 16, 0, 0); } while (0)
#define PG8_LDA(dst, b, h) do { _Pragma("unroll") for (int m = 0; m < 4; ++m) _Pragma("unroll") for (int k = 0; k < 2; ++k) dst[m][k] = *(const PG8_LAS bf16x8*)(lds + PG8_SA(b, h) + aoff + m * 2048 + k * 1024); } while (0)
#define PG8_LDB(dst, b, h) do { _Pragma("unroll") for (int n = 0; n < 2; ++n) _Pragma("unroll") for (int k = 0; k < 2; ++k) dst[n][k] = *(const PG8_LAS bf16x8*)(lds + PG8_SB(b, h) + boff + n * 2048 + k * 1024); } while (0)
#define PG8_MMA(ai, bj, At, Bt) do { __builtin_amdgcn_s_setprio(1); _Pragma("unroll") for (int m = 0; m < 4; ++m) _Pragma("unroll") for (int n = 0; n < 2; ++n) _Pragma("unroll") for (int k = 0; k < 2; ++k) \
        acc[ai][bj][m][n] = __builtin_amdgcn_mfma_f32_16x16x32_bf16(Bt[n][k], At[m][k], acc[ai][bj][m][n], 0, 0, 0); __builtin_amdgcn_s_setprio(0); } while (0)
#define PG8_WAIT_V(n) asm volatile("s_waitcnt vmcnt(" #n ")" ::: "memory")
#define PG8_WAIT_L(n) asm volatile("s_waitcnt lgkmcnt(" #n ")" ::: "memory")
#define PG8_BAR __builtin_amdgcn_s_barrier()
#define PG8_SCHED __builtin_amdgcn_sched_barrier(0)
    Unit cur, nxt; int ui = 0;
    if (!S.next(0, cur)) return;
    f32x4 acc[2][2][4][2];
#pragma unroll
    for (int a = 0; a < 2; ++a)
#pragma unroll
        for (int b = 0; b < 2; ++b)
#pragma unroll
            for (int m = 0; m < 4; ++m)
#pragma unroll
                for (int n = 0; n < 2; ++n) acc[a][b][m][n] = (f32x4){0.f, 0.f, 0.f, 0.f};
    bf16x8 At[4][2], B0[2][2], B1[2][2];
    const char* cA = (const char*)g.A + (size_t)cur.pm * tstep; const char* cB = (const char*)g.Bt + (size_t)cur.pn * tstep;
    S.a_ready(cur);
    if constexpr (SP2) {
        PG8_STAGE(PG8_SB(0, 0), cB, voffB); PG8_STAGE(PG8_SB(0, 1), cB + hstep, voffB); PG8_STAGE(PG8_SA(0, 0), cA, voffA); PG8_STAGE(PG8_SA(0, 1), cA + hstep, voffA);
        if (wr == 1) PG8_BAR;
        PG8_WAIT_V(2); PG8_BAR;
        PG8_STAGE(PG8_SB(1, 0), cB + kstep, voffB); PG8_STAGE(PG8_SA(1, 0), cA + kstep, voffA); PG8_STAGE(PG8_SB(1, 1), cB + hstep + kstep, voffB);
        PG8_WAIT_V(6); PG8_BAR;
    } else {
        PG8_STAGE(PG8_SB(0, 0), cB, voffB); PG8_STAGE(PG8_SA(0, 0), cA, voffA); PG8_STAGE(PG8_SB(0, 1), cB + hstep, voffB); PG8_STAGE(PG8_SA(0, 1), cA + hstep, voffA);
        if (wr == 1) PG8_BAR;
        PG8_WAIT_V(4); PG8_BAR;
        PG8_STAGE(PG8_SB(1, 0), cB + kstep, voffB); PG8_STAGE(PG8_SA(1, 0), cA + kstep, voffA); PG8_STAGE(PG8_SB(1, 1), cB + hstep + kstep, voffB);
        PG8_WAIT_V(6); PG8_BAR;
    }
    for (;;) {
        const bool has_next = S.next(ui + 1, nxt);
        const char* nA = has_next ? (const char*)g.A + (size_t)nxt.pm * tstep : cA; const char* nB = has_next ? (const char*)g.Bt + (size_t)nxt.pn * tstep : cB;
        for (int t = 0; t < nt; t += 2) {
            const bool last = (t == nt - 2);
            const char* a1 = cA + (size_t)(t + 1) * kstep;
            const char* a2 = last ? nA : cA + (size_t)(t + 2) * kstep; const char* b2 = last ? nB : cB + (size_t)(t + 2) * kstep;
            const char* a3 = a2 + kstep; const char* b3 = b2 + kstep;
            if (last && has_next) S.a_ready(nxt);
            if constexpr (SP2) {
            PG8_LDB(B0, 0, 0); PG8_LDB(B1, 0, 1); PG8_SCHED; PG8_LDA(At, 0, 0); PG8_STAGE(PG8_SA(1, 1), a1 + hstep, voffA);
            PG8_WAIT_V(8); PG8_WAIT_L(0); PG8_BAR; PG8_MMA(0, 0, At, B0); PG8_MMA(0, 1, At, B1); PG8_BAR; PG8_SCHED;
            PG8_LDA(At, 0, 1); PG8_STAGE(PG8_SB(0, 0), b2, voffB); PG8_STAGE(PG8_SB(0, 1), b2 + hstep, voffB); PG8_STAGE(PG8_SA(0, 0), a2, voffA);
            PG8_WAIT_V(8); PG8_WAIT_L(0); PG8_BAR; PG8_MMA(1, 0, At, B0); PG8_MMA(1, 1, At, B1); PG8_BAR; PG8_SCHED;
            PG8_LDB(B0, 1, 0); PG8_LDB(B1, 1, 1); PG8_SCHED; PG8_LDA(At, 1, 0); PG8_STAGE(PG8_SA(0, 1), a2 + hstep, voffA);
            PG8_WAIT_V(8); PG8_WAIT_L(0); PG8_BAR; PG8_MMA(0, 0, At, B0); PG8_MMA(0, 1, At, B1); PG8_BAR; PG8_SCHED;
            PG8_LDA(At, 1, 1); PG8_STAGE(PG8_SB(1, 0), b3, voffB); PG8_STAGE(PG8_SB(1, 1), b3 + hstep, voffB); PG8_STAGE(PG8_SA(1, 0), a3, voffA);
            PG8_WAIT_V(8); PG8_WAIT_L(0); PG8_BAR; PG8_MMA(1, 0, At, B0); PG8_MMA(1, 1, At, B1); PG8_BAR; PG8_SCHED;
            } else {
            PG8_LDB(B0, 0, 0); PG8_SCHED; PG8_LDA(At, 0, 0); PG8_STAGE(PG8_SA(1, 1), a1 + hstep, voffA);
            PG8_WAIT_L(8); PG8_BAR; PG8_WAIT_L(0); PG8_MMA(0, 0, At, B0); PG8_BAR; PG8_SCHED;
            PG8_LDB(B1, 0, 1); PG8_STAGE(PG8_SB(0, 0), b2, voffB);
            PG8_BAR; PG8_WAIT_L(0); PG8_MMA(0, 1, At, B1); PG8_BAR;
            PG8_LDA(At, 0, 1); PG8_STAGE(PG8_SA(0, 0), a2, voffA);
            PG8_BAR; PG8_WAIT_L(0); PG8_MMA(1, 0, At, B0); PG8_BAR; PG8_SCHED;
            PG8_STAGE(PG8_SB(0, 1), b2 + hstep, voffB);
            PG8_WAIT_V(6); PG8_BAR; PG8_MMA(1, 1, At, B1); PG8_BAR;
            PG8_LDB(B0, 1, 0); PG8_SCHED; PG8_LDA(At, 1, 0); PG8_STAGE(PG8_SA(0, 1), a2 + hstep, voffA);
            PG8_WAIT_L(8); PG8_BAR; PG8_WAIT_L(0); PG8_MMA(0, 0, At, B0); PG8_BAR; PG8_SCHED;
            PG8_LDB(B1, 1, 1); PG8_STAGE(PG8_SB(1, 0), b3, voffB);
            PG8_BAR; PG8_WAIT_L(0); PG8_MMA(0, 1, At, B1); PG8_BAR;
            PG8_LDA(At, 1, 1); PG8_STAGE(PG8_SA(1, 0), a3, voffA);
            PG8_BAR; PG8_WAIT_L(0); PG8_MMA(1, 0, At, B0); PG8_BAR; PG8_SCHED;
            PG8_STAGE(PG8_SB(1, 1), b3 + hstep, voffB);
            PG8_WAIT_V(6); PG8_BAR; PG8_MMA(1, 1, At, B1); PG8_BAR;
            }
        }
        if constexpr (ALIGN_EPI) { if (wr == 0) PG8_BAR; }
        if constexpr (!Epi::AFTER_DRAIN) { E(acc, cur, wr, wc, fr, fq); S.done(cur); }
        if (!has_next) break;
#pragma unroll
        for (int a = 0; a < 2; ++a)
#pragma unroll
            for (int b = 0; b < 2; ++b)
#pragma unroll
                for (int m = 0; m < 4; ++m)
#pragma unroll
                    for (int n = 0; n < 2; ++n) acc[a][b][m][n] = (f32x4){0.f, 0.f, 0.f, 0.f};
        cur = nxt; cA = nA; cB = nB; ++ui;
        if constexpr (ALIGN_EPI) { if (wr == 1) PG8_BAR; }
    }
    PG8_WAIT_V(0);
    if constexpr (!ALIGN_EPI) { if (wr == 0) PG8_BAR; }
    PG8_BAR;
    if constexpr (Epi::AFTER_DRAIN) { E.fused(acc, cur, wr, wc, fr, fq, lds, wid, lane); S.done(cur); }
#undef PG8_SA
#undef PG8_SB
#undef PG8_STAGE
#undef PG8_LDA
#undef PG8_LDB
#undef PG8_MMA
#undef PG8_WAIT_V
#undef PG8_WAIT_L
#undef PG8_BAR
#undef PG8_SCHED
}
}

constexpr int TP = 8192, TS = 512, T = TP + TS, DM = 2048, NSEQ = 132;
constexpr int NAB = 7424, NCD = 4864;
constexpr int NWAVES = 8, NTHR = 512;
constexpr size_t MiB = 1u << 20;
constexpr size_t WS_CTL = 0, CTL_ZERO_BYTES = 1 * MiB;
constexpr int CW_BAR = 4096, CW_CNT = 8192;
constexpr size_t WS_RSS = 65536;
constexpr size_t WS_WABIN = 2 * MiB, WS_WABOUT = 60 * MiB, WS_WCDIN = 76 * MiB, WS_WCDOUT = 114 * MiB, WS_WGATE = 130 * MiB, WS_WPROJ = 162 * MiB;
constexpr size_t WS_H = 166 * MiB, WS_XN = 234 * MiB, WS_YM = 268 * MiB, WS_PB = 302 * MiB, WS_U = 320 * MiB, WS_SCR = 444 * MiB, WS_END = 732 * MiB;
constexpr size_t SC_HB1 = 102 * MiB;
constexpr size_t SC_PP = 8 * MiB;
constexpr size_t SC_ODN = 102 * MiB, SC_OGLA = 136 * MiB, SC_DNOPS = 192 * MiB;
constexpr size_t SC_LA = 52 * MiB, SC_LB = 86 * MiB, SC_YS = 120 * MiB, SC_HS = 154 * MiB, SC_SSDOP = 192 * MiB, SC_XS = 270 * MiB;
constexpr int LDS_BYTES = 163840;
constexpr size_t O_Y_P = 0, O_Y_S = O_Y_P + (size_t)4 * 2048 * 2048, O_DN_P = O_Y_S + (size_t)128 * 4 * 2048,
    O_DNC_P = O_DN_P + (size_t)2 * 4 * 8 * 128 * 128, O_GLA_P = O_DNC_P + (size_t)2 * 4 * 3 * 3072, O_SSD_P = O_GLA_P + (size_t)2 * 4 * 4 * 128 * 256,
    O_SSDC_P = O_SSD_P + (size_t)2 * 4 * 16 * 64 * 64, O_LRU_P = O_SSDC_P + (size_t)2 * 4 * 3 * 1536, O_LRUC_P = O_LRU_P + (size_t)2 * 4 * 1024,
    O_DN_S = O_LRUC_P + (size_t)2 * 4 * 3 * 1024, O_DNC_S = O_DN_S + (size_t)2 * 128 * 8 * 128 * 128, O_GLA_S = O_DNC_S + (size_t)2 * 128 * 3 * 3072,
    O_SSD_S = O_GLA_S + (size_t)2 * 128 * 4 * 128 * 256, O_SSDC_S = O_SSD_S + (size_t)2 * 128 * 16 * 64 * 64, O_LRU_S = O_SSDC_S + (size_t)2 * 128 * 3 * 1536,
    O_LRUC_S = O_LRU_S + (size_t)2 * 128 * 1024, O_END = O_LRUC_S + (size_t)2 * 128 * 3 * 1024;
static_assert(O_END == 109064192, "output size");

#define LAS __attribute__((address_space(3)))
typedef unsigned short bf16;
typedef float f32x4 __attribute__((ext_vector_type(4)));
typedef unsigned u32x2 __attribute__((ext_vector_type(2)));
typedef unsigned u32x4 __attribute__((ext_vector_type(4)));
#define LDS_WAIT() asm volatile("s_waitcnt lgkmcnt(0)" ::: "memory")

__device__ __forceinline__ float bf2f(bf16 b) { return __uint_as_float(((unsigned)b) << 16); }
typedef __bf16 bf16x2_t __attribute__((ext_vector_type(2)));
typedef float f32x2_t __attribute__((ext_vector_type(2)));
__device__ __forceinline__ unsigned cvtpk(float lo, float hi) { f32x2_t v = {lo, hi}; bf16x2_t b = __builtin_convertvector(v, bf16x2_t); return __builtin_bit_cast(unsigned, b); }
__device__ __forceinline__ unsigned f2bf(float f) { return cvtpk(f, 0.f) & 0xffffu; }
__device__ __forceinline__ unsigned pk2(float lo, float hi) { return cvtpk(lo, hi); }
__device__ __forceinline__ float sigmoid_(float x) { return __builtin_amdgcn_rcpf(1.f + __expf(-x)); }
__device__ __forceinline__ float silu_(float x) { return x * __builtin_amdgcn_rcpf(1.f + __expf(-x)); }
__device__ __forceinline__ float softplus_(float x) { return x > 15.f ? x : (x < -15.f ? __expf(x) : __logf(1.f + __expf(x))); }
__device__ __forceinline__ float dpp_add(float v, float x) { return v + x; }
#define WS_DPP(v, ctrl, rmask) __builtin_bit_cast(float, __builtin_amdgcn_update_dpp(0, __builtin_bit_cast(int, (v)), (ctrl), (rmask), 0xf, false))
__device__ __forceinline__ float wave_sum(float v) {
    v += WS_DPP(v, 0xB1, 0xf);
    v += WS_DPP(v, 0x4E, 0xf);
    v += WS_DPP(v, 0x141, 0xf);
    v += WS_DPP(v, 0x140, 0xf);
    v += WS_DPP(v, 0x142, 0xa);
    v += WS_DPP(v, 0x143, 0xc);
    return __builtin_bit_cast(float, __builtin_amdgcn_readlane(__builtin_bit_cast(int, v), 63));
}
__device__ __forceinline__ void row_to_seq(int r, int& s, int& t) { if (r < TP) { s = r >> 11; t = r & 2047; } else { s = 4 + ((r - TP) >> 2); t = (r - TP) & 3; } }
__device__ __forceinline__ void seq_info(int s, int& row0, int& L) { if (s < 4) { row0 = s << 11; L = 2048; } else { row0 = TP + ((s - 4) << 2); L = 4; } }
__device__ __forceinline__ float pre_val(const bf16* U, int ldu, int ucol, int row0, int tt, int s, const float* stc, int W, int c) {
    const int tc = tt >= 0 ? tt : 0, sc = tt >= 0 ? 0 : 3 + tt;
    const float a = bf2f(U[(size_t)(row0 + tc) * ldu + ucol]), b = stc[((size_t)(s - 4) * 3 + sc) * W + c];
    return tt >= 0 ? a : b;
}
__device__ __forceinline__ int map_col(int mapid, int n) {
    if (mapid == 0) return n;
    if (mapid == 1) { if (n < 3072) return n; if (n < 6144) return n + 16; if (n < 7168) return n + 32; if (n < 7184) return n - 4096; if (n < 7200) return n - 1024; return -1; }
    if (n < 2560) return n; if (n < 4608) return n + 16; if (n < 4624) return n - 2048; return -1;
}
__device__ __forceinline__ void transpose_item(const float* W, int K, int Nsrc, bf16* WT, int Npad, int mapid, const float* gain, LAS float* scr, int item, int lane) {
    const int nblk = Npad / 64, kb = item / nblk, nb = item % nblk, k0 = 64 * kb, n0 = 64 * nb;
    const int n4 = (lane & 15) * 4, src = map_col(mapid, n0 + n4);
    const int srcc = src >= 0 ? src : 0; const float msk = src >= 0 ? 1.f : 0.f;
    f32x4 v[16];
#pragma unroll
    for (int i = 0; i < 16; ++i) v[i] = __builtin_nontemporal_load((const f32x4*)(W + (size_t)(k0 + 4 * i + (lane >> 4)) * Nsrc + srcc));
    if (gain) {
#pragma unroll
        for (int i = 0; i < 16; ++i) v[i] = v[i] * (gain[k0 + 4 * i + (lane >> 4)] * msk);
    } else {
#pragma unroll
        for (int i = 0; i < 16; ++i) v[i] = v[i] * msk;
    }
#pragma unroll
    for (int i = 0; i < 16; ++i) { const int kk = 4 * i + (lane >> 4); scr[kk * 65 + n4] = v[i].x; scr[kk * 65 + n4 + 1] = v[i].y; scr[kk * 65 + n4 + 2] = v[i].z; scr[kk * 65 + n4 + 3] = v[i].w; }
    LDS_WAIT(); asm volatile("" ::: "memory");
    const int c = lane & 7;
#pragma unroll
    for (int jj = 0; jj < 8; ++jj) { const int n = (lane >> 3) + 8 * jj; const LAS float* p = scr + (8 * c) * 65 + n;
        u32x4 o; o.x = pk2(p[0 * 65], p[1 * 65]); o.y = pk2(p[2 * 65], p[3 * 65]); o.z = pk2(p[4 * 65], p[5 * 65]); o.w = pk2(p[6 * 65], p[7 * 65]);
        *(u32x4*)(WT + (size_t)(n0 + n) * K + k0 + 8 * c) = o; }
    LDS_WAIT(); asm volatile("" ::: "memory");
}
__device__ __forceinline__ void norm_row_bf16(const f32x4 (&v)[8], const float* g, bf16* orow, int lane) {
    float ss = 0.f;
#pragma unroll
    for (int j = 0; j < 8; ++j) ss += (v[j].x * v[j].x + v[j].y * v[j].y) + (v[j].z * v[j].z + v[j].w * v[j].w);
    const float rstd = rsqrtf(wave_sum(ss) * (1.f / DM) + 1e-6f);
#pragma unroll
    for (int j = 0; j < 8; ++j) { const int col = 4 * (lane + 64 * j); const f32x4 gg = *(const f32x4*)(g + col);
        u32x2 o; o.x = pk2(v[j].x * rstd * gg.x, v[j].y * rstd * gg.y); o.y = pk2(v[j].z * rstd * gg.z, v[j].w * rstd * gg.w);
        *(u32x2*)(orow + col) = o; }
}

typedef short bf16x8 __attribute__((ext_vector_type(8)));
typedef float f32x16 __attribute__((ext_vector_type(16)));
#define MFMA32(a, b, c) __builtin_amdgcn_mfma_f32_32x32x16_bf16((a), (b), (c), 0, 0, 0)
#define PACK_ACC(x, S_) __builtin_bit_cast(bf16x8, (u32x4){cvtpk((x)[8 * (S_)], (x)[8 * (S_) + 1]), cvtpk((x)[8 * (S_) + 2], (x)[8 * (S_) + 3]), cvtpk((x)[8 * (S_) + 4], (x)[8 * (S_) + 5]), cvtpk((x)[8 * (S_) + 6], (x)[8 * (S_) + 7])})
__device__ __forceinline__ int crow(int reg, int h) { return (reg & 3) + 8 * (reg >> 2) + 4 * h; }
__device__ __forceinline__ bf16x8 pack8(const float (&v)[8]) { return __builtin_bit_cast(bf16x8, (u32x4){cvtpk(v[0], v[1]), cvtpk(v[2], v[3]), cvtpk(v[4], v[5]), cvtpk(v[6], v[7])}); }

#define XB_TMO      128
#define XB_XCNT(j)  (256  + 64 * (j))
#define XB_XSUB(j)  (1280 + 64 * (j))
#define XB_XGEN(j)  (2304 + 64 * (j))
#define XB_TOP      3328
#define XB_TOPGEN   3392
#define XCD_BAR_WORDS 3456
#define XB_SPIN_CAP (1u << 18)

__device__ __forceinline__ unsigned xb_ld(unsigned* p)              { return __hip_atomic_load(p, __ATOMIC_RELAXED, __HIP_MEMORY_SCOPE_AGENT); }
__device__ __forceinline__ unsigned xb_add(unsigned* p, unsigned v) { return __hip_atomic_fetch_add(p, v, __ATOMIC_RELAXED, __HIP_MEMORY_SCOPE_AGENT); }
__device__ __forceinline__ unsigned xb_xcc_id() { return (unsigned)__builtin_amdgcn_s_getreg((3 << 11) | 20) & 0xFu; }
#define XB_SPIN(cond, bar) do { unsigned _sp = 0; while (cond) { __builtin_amdgcn_s_sleep(1); \
    if ((++_sp & 255u) == 0u) { if (xb_ld(&(bar)[XB_TMO])) break; if (_sp > XB_SPIN_CAP) { atomicAdd(&(bar)[XB_TMO], 1u); break; } } } } while (0)

struct XcdBarrier {
    unsigned* bar; unsigned x;
    volatile LAS unsigned* st;
};

__device__ __forceinline__ XcdBarrier xcd_barrier_post(unsigned* bar, volatile LAS unsigned* st) {
    XcdBarrier b; b.bar = bar; b.x = xb_xcc_id(); b.st = st;
    if (threadIdx.x == 0) (void)xb_add(&bar[XB_XCNT(b.x)], 1u);
    return b;
}
__device__ __forceinline__ void xcd_barrier_complete(unsigned* bar, unsigned x, unsigned& nloc, unsigned& nx) {
    const unsigned G = gridDim.x * gridDim.y * gridDim.z;
    unsigned sum, cnt, mine, sp = 0u;
    for (;;) {
        sum = 0u; cnt = 0u; mine = 0u;
#pragma unroll
        for (unsigned j = 0; j < 16; ++j) { const unsigned c = xb_ld(&bar[XB_XCNT(j)]); sum += c; cnt += (c > 0u) ? 1u : 0u; mine = (j == x) ? c : mine; }
        if (sum == G) break;
        __builtin_amdgcn_s_sleep(1);
        if ((++sp & 255u) == 0u) { if (xb_ld(&bar[XB_TMO])) break; if (sp > XB_SPIN_CAP) { atomicAdd(&bar[XB_TMO], 1u); break; } }
    }
    nloc = mine > 0u ? mine : 1u; nx = cnt > 0u ? cnt : 1u;
}

__device__ __forceinline__ void xcd_barrier(const XcdBarrier& b) {
    asm volatile("s_waitcnt vmcnt(0)" ::: "memory");
    __syncthreads();
    if (threadIdx.x == 0) {
        unsigned* bar = b.bar;
        __builtin_amdgcn_s_waitcnt(0);
        unsigned nloc = b.st[0], nx = b.st[1];
        if (nloc == 0u) { xcd_barrier_complete(bar, b.x, nloc, nx); b.st[0] = nloc; b.st[1] = nx; }
        const unsigned old = xb_add(&bar[XB_XSUB(b.x)], 1u);
        const unsigned gen = old / nloc;
        if (old + 1u == (gen + 1u) * nloc) {
            __builtin_amdgcn_fence(__ATOMIC_RELEASE, "agent");
            asm volatile("s_waitcnt vmcnt(0)" ::: "memory");
            const unsigned og = xb_add(&bar[XB_TOP], 1u);
            const unsigned tg = og / nx;
            if (og + 1u == (tg + 1u) * nx) xb_add(&bar[XB_TOPGEN], 1u);
            else XB_SPIN(xb_ld(&bar[XB_TOPGEN]) == tg, bar);
            __builtin_amdgcn_fence(__ATOMIC_ACQUIRE, "agent");
            xb_add(&bar[XB_XGEN(b.x)], 1u);
            asm volatile("s_waitcnt vmcnt(0)" ::: "memory");
        } else {
            XB_SPIN(xb_ld(&bar[XB_XGEN(b.x)]) == gen, bar);
            __builtin_amdgcn_fence(__ATOMIC_ACQUIRE, "agent");
            asm volatile("s_waitcnt vmcnt(0)" ::: "memory");
        }
    }
    __syncthreads();
}


#ifdef PROBE_SEC
#define SEC_BEGIN(id) unsigned long long _sec_t##id = 0; if ((id) == PROBE_SEC) { __builtin_amdgcn_s_barrier(); _sec_t##id = __builtin_amdgcn_s_memrealtime(); }
#define SEC_END(id, ldsp) if ((id) == PROBE_SEC) { __builtin_amdgcn_s_barrier(); if (threadIdx.x == 0) { volatile LAS unsigned long long* a_ = (volatile LAS unsigned long long*)((ldsp) + LDS_BYTES - 32); a_[0] = a_[0] + (__builtin_amdgcn_s_memrealtime() - _sec_t##id); } }
#define SECW_BEGIN(id) unsigned long long _secw_t##id = 0; if ((id) == PROBE_SEC) { _secw_t##id = __builtin_amdgcn_s_memrealtime(); }
#define SECW_END(id, ldsp, tsel) if ((id) == PROBE_SEC) { asm volatile("s_waitcnt vmcnt(0) lgkmcnt(0)" ::: "memory"); if (threadIdx.x == (tsel)) { volatile LAS unsigned long long* a_ = (volatile LAS unsigned long long*)((ldsp) + LDS_BYTES - 32); a_[0] = a_[0] + (__builtin_amdgcn_s_memrealtime() - _secw_t##id); } }
#else
#define SEC_BEGIN(id)
#define SEC_END(id, ldsp)
#define SECW_BEGIN(id)
#define SECW_END(id, ldsp, tsel)
#endif
struct Args { const float* in[40]; float* out; unsigned char* ws; int ph_lo, ph_hi; };
constexpr int N_PHASES = 26, SUBS = 6;
#ifndef PH_MASK
#define PH_MASK 16383
#endif
#define AS4 __attribute__((address_space(4)))
struct KP { const char AS4* p;
    __device__ __forceinline__ const float* in(int i) const { return *(const float* const AS4*)(p + 8 * i); }
    __device__ __forceinline__ float* out() const { return *(float* const AS4*)(p + 320); }
    __device__ __forceinline__ unsigned char* ws() const { return *(unsigned char* const AS4*)(p + 328); }
};
static_assert(sizeof(Args) == 344, "Args layout");

__device__ __forceinline__ void phase_prologue(const KP kp, LAS unsigned char* lds, int gw, int NGW, int wave, int lane) {
    unsigned char* ws = kp.ws();
    LAS float* scr = (LAS float*)(lds + wave * 17408);
    SEC_BEGIN(1)
    {
        static_assert(32 * (NAB / 64) == 3712 && 32 * (NCD / 64) == 2432, "flat transpose item list");
        constexpr int TOT = 2 * 3712 + 2 * 1024 + 2 * 2432 + 2 * 1024 + 4 * 1024 + 4 * 128;
        const int nblocks = NGW / NWAVES, ipb = (TOT + nblocks - 1) / nblocks, ib = (gw / NWAVES) * ipb, ie = ib + ipb < TOT ? ib + ipb : TOT;
        for (int g0 = ib + wave; g0 < ie; g0 += NWAVES) {
            const int g = __builtin_amdgcn_readfirstlane(g0);
            int job, it;
            if (g < 7424) { job = g < 3712 ? 0 : 1; it = g - job * 3712; }
            else if (g < 9472) { const int q = g - 7424; job = 2 + (q >> 10); it = q & 1023; }
            else if (g < 14336) { const int q = g - 9472; job = q < 2432 ? 4 : 5; it = q - (job - 4) * 2432; }
            else if (g < 20480) { const int q = g - 14336; job = 6 + (q >> 10); it = q & 1023; }
            else { const int q = g - 20480; job = 12 + (q >> 7); it = q & 127; }
            const float* W; int K = 2048, Nsrc = 2048, Npad = 2048, mapid = 0; bf16* WT; const float* gain = nullptr;
            if (job < 2)       { W = kp.in(13) + (size_t)job * 2048 * 7200; Nsrc = 7200; Npad = NAB; mapid = 1; WT = (bf16*)(ws + WS_WABIN) + (size_t)job * NAB * 2048; gain = kp.in(11) + (size_t)(2 * job) * DM; }
            else if (job < 4)  { W = kp.in(21) + (size_t)(job - 2) * 2048 * 2048; WT = (bf16*)(ws + WS_WABOUT) + (size_t)(job - 2) * 2048 * 2048; }
            else if (job < 6)  { W = kp.in(22) + (size_t)(job - 4) * 2048 * 4624; Nsrc = 4624; Npad = NCD; mapid = 2; WT = (bf16*)(ws + WS_WCDIN) + (size_t)(job - 4) * NCD * 2048; gain = kp.in(11) + (size_t)(2 * (job - 4) + 1) * DM; }
            else if (job < 8)  { W = kp.in(36) + (size_t)(job - 6) * 2048 * 2048; WT = (bf16*)(ws + WS_WCDOUT) + (size_t)(job - 6) * 2048 * 2048; }
            else if (job < 12) { W = kp.in(39) + (size_t)(job - 8) * 2048 * 2048; WT = (bf16*)(ws + WS_WGATE) + (size_t)(job - 8) * 2048 * 2048; gain = kp.in(38) + (size_t)(job - 8) * DM; }
            else               { W = kp.in(37) + (size_t)(job - 12) * 256 * 2048; K = 256; WT = (bf16*)(ws + WS_WPROJ) + (size_t)(job - 12) * 2048 * 256; }
            transpose_item(W, K, Nsrc, WT, Npad, mapid, gain, scr, it, lane);
        }
    }
    SEC_END(1, lds)
    SEC_BEGIN(2)
    bf16* HB = (bf16*)(ws + WS_XN); float* RSS = (float*)(ws + WS_RSS);
    for (int m = gw; m < T; m += 2 * NGW) {
        const int mb = m + NGW < T ? m + NGW : m;
        const float* srca = m < TP ? kp.in(0) + (size_t)m * DM : kp.in(1) + (size_t)(m - TP) * DM;
        const float* srcb = mb < TP ? kp.in(0) + (size_t)mb * DM : kp.in(1) + (size_t)(mb - TP) * DM;
        f32x4 va[8], vb[8];
#pragma unroll
        for (int jj = 0; jj < 8; ++jj) { const int col = 4 * (lane + 64 * jj); va[jj] = *(const f32x4*)(srca + col); vb[jj] = *(const f32x4*)(srcb + col); }
        float ssa = 0.f, ssb = 0.f;
#pragma unroll
        for (int jj = 0; jj < 8; ++jj) { const int col = 4 * (lane + 64 * jj); const f32x4 v = va[jj], w = vb[jj];
            u32x2 o; o.x = pk2(v.x, v.y); o.y = pk2(v.z, v.w); *(u32x2*)(HB + (size_t)m * DM + col) = o; ssa += (v.x * v.x + v.y * v.y) + (v.z * v.z + v.w * v.w);
            u32x2 o2; o2.x = pk2(w.x, w.y); o2.y = pk2(w.z, w.w); *(u32x2*)(HB + (size_t)mb * DM + col) = o2; ssb += (w.x * w.x + w.y * w.y) + (w.z * w.z + w.w * w.w); }
        ssa = wave_sum(ssa); ssb = wave_sum(ssb); if (lane == 0) { RSS[m] = ssa; RSS[mb] = ssb; }
    }
    bf16* PB = (bf16*)(ws + WS_PB);
    for (int rb = gw; rb < 4 * T; rb += 6 * NGW) {
        f32x4 v[6];
#pragma unroll
        for (int u = 0; u < 6; ++u) { int rr = rb + u * NGW; rr = rr < 4 * T ? rr : 4 * T - 1; const int li = rr / T, r = rr - li * T;
            const float* src = (r < TP ? kp.in(9) + ((size_t)li * TP + r) * 256 : kp.in(10) + ((size_t)li * TS + (r - TP)) * 256) + 4 * lane;
            v[u] = *(const f32x4*)src; }
#pragma unroll
        for (int u = 0; u < 6; ++u) { const int rr = rb + u * NGW; if (rr < 4 * T) { u32x2 o; o.x = pk2(v[u].x, v[u].y); o.y = pk2(v[u].z, v[u].w); *(u32x2*)(PB + (size_t)rr * 256 + 4 * lane) = o; } }
    }
    SEC_END(2, lds)
}
__device__ __forceinline__ void phase_final(const KP kp, int gw, int NGW, int lane) {
    const bf16* HB = (const bf16*)(kp.ws() + WS_XN); const float* RSS = (const float*)(kp.ws() + WS_RSS) + (size_t)8 * T; const float* g = kp.in(12); float* out = kp.out();
    f32x4 gg[8];
#pragma unroll
    for (int jj = 0; jj < 8; ++jj) gg[jj] = *(const f32x4*)(g + 4 * (lane + 64 * jj));
    for (int m = gw; m < T; m += 2 * NGW) {
        const int mb = m + NGW < T ? m + NGW : m;
        const float ra = RSS[m], rb = RSS[mb];
        u32x2 ha[8], hb[8];
#pragma unroll
        for (int jj = 0; jj < 8; ++jj) { const int col = 4 * (lane + 64 * jj); ha[jj] = *(const u32x2*)(HB + (size_t)m * DM + col); hb[jj] = *(const u32x2*)(HB + (size_t)mb * DM + col); }
        const float rstda = rsqrtf(ra * (1.f / DM) + 1e-6f), rstdb = rsqrtf(rb * (1.f / DM) + 1e-6f);
#pragma unroll
        for (int jj = 0; jj < 8; ++jj) { const int col = 4 * (lane + 64 * jj); const u32x2 hv = ha[jj], hw = hb[jj];
            f32x4 o; o.x = __uint_as_float(hv.x << 16) * rstda * gg[jj].x; o.y = __uint_as_float(hv.x & 0xffff0000u) * rstda * gg[jj].y; o.z = __uint_as_float(hv.y << 16) * rstda * gg[jj].z; o.w = __uint_as_float(hv.y & 0xffff0000u) * rstda * gg[jj].w;
            *(f32x4*)(out + (size_t)m * DM + col) = o;
            f32x4 o2; o2.x = __uint_as_float(hw.x << 16) * rstdb * gg[jj].x; o2.y = __uint_as_float(hw.x & 0xffff0000u) * rstdb * gg[jj].y; o2.z = __uint_as_float(hw.y << 16) * rstdb * gg[jj].z; o2.w = __uint_as_float(hw.y & 0xffff0000u) * rstdb * gg[jj].w;
            *(f32x4*)(out + (size_t)mb * DM + col) = o2; } }
}

constexpr size_t GLA_ITEM_BYTES = 74752, WS_GLAOPS = WS_H;
__device__ __forceinline__ void phase_gla_prep(const KP kp, const int bid, const int G, int j, LAS unsigned char* lds, int tid0) {
    const bf16* U = (const bf16*)(kp.ws() + WS_U);
    const float* wa2 = kp.in(18) + (size_t)j * 16 * 512; const float* ba = kp.in(19) + (size_t)j * 512;
    unsigned char* OPS = kp.ws() + WS_GLAOPS;
    LAS float* GE = (LAS float*)lds; LAS float* Pg = GE + 128;
    LAS bf16* Qg = (LAS bf16*)(Pg + 512); LAS bf16* Ka = Qg + 64 * 136; LAS float* QKm = (LAS float*)(Ka + 64 * 136);
    for (int item = bid; item < 512; item += G) {
        int tid = tid0; asm volatile("" : "+v"(tid));
        const int lane = tid & 63, r = lane & 31, hp = lane >> 5, wave = tid >> 6;
        const int b = item >> 7, n = (item >> 2) & 31, h = item & 3;
        const int row0 = b * 2048 + n * 64;
        __syncthreads();
        const int d = tid & 127, tg = tid >> 7, t0 = 16 * tg;
        float q[16], k[16], gl[16];
        { float w[16];
#pragma unroll
          for (int rr = 0; rr < 16; ++rr) w[rr] = wa2[rr * 512 + h * 128 + d];
          const float bias = ba[h * 128 + d];
          typedef unsigned u32x8g __attribute__((ext_vector_type(8)));
#pragma unroll
          for (int tb = 0; tb < 2; ++tb) {
              u32x8g gb[8], qv, kv;
#pragma unroll
              for (int tt = 0; tt < 8; ++tt) { const size_t ro = (size_t)(row0 + t0 + 8 * tb + tt) * NAB;
                  qv[tt] = (unsigned)U[ro + 4096 + h * 128 + d]; kv[tt] = (unsigned)U[ro + 4608 + h * 128 + d];
                  const u32x4 a0 = *(const u32x4*)(U + ro + 7184), a1 = *(const u32x4*)(U + ro + 7192);
                  gb[tt] = (u32x8g){a0.x, a0.y, a0.z, a0.w, a1.x, a1.y, a1.z, a1.w}; }
              asm volatile("" : "+v"(gb[0]), "+v"(gb[1]), "+v"(gb[2]), "+v"(gb[3]), "+v"(gb[4]), "+v"(gb[5]), "+v"(gb[6]), "+v"(gb[7]), "+v"(qv), "+v"(kv));
#pragma unroll
              for (int tt = 0; tt < 8; ++tt) { const int t = 8 * tb + tt; const u32x8g g = gb[tt];
                  q[t] = bf2f((bf16)qv[tt]) * 0.08838834764831845f; k[t] = bf2f((bf16)kv[tt]);
                  float x = bias;
                  x += __uint_as_float(g[0] << 16) * w[0] + __uint_as_float(g[0] & 0xffff0000u) * w[1] + __uint_as_float(g[1] << 16) * w[2] + __uint_as_float(g[1] & 0xffff0000u) * w[3];
                  x += __uint_as_float(g[2] << 16) * w[4] + __uint_as_float(g[2] & 0xffff0000u) * w[5] + __uint_as_float(g[3] << 16) * w[6] + __uint_as_float(g[3] & 0xffff0000u) * w[7];
                  x += __uint_as_float(g[4] << 16) * w[8] + __uint_as_float(g[4] & 0xffff0000u) * w[9] + __uint_as_float(g[5] << 16) * w[10] + __uint_as_float(g[5] & 0xffff0000u) * w[11];
                  x += __uint_as_float(g[6] << 16) * w[12] + __uint_as_float(g[6] & 0xffff0000u) * w[13] + __uint_as_float(g[7] << 16) * w[14] + __uint_as_float(g[7] & 0xffff0000u) * w[15];
                  gl[t] = -softplus_(-x) * (1.f / 16.f); } } }
#pragma unroll
        for (int t = 1; t < 16; ++t) gl[t] += gl[t - 1];
        Pg[tg * 128 + d] = gl[15];
        __syncthreads();
        { float off = 0.f;
#pragma unroll
          for (int g = 0; g < 3; ++g) off += (g < tg) ? Pg[g * 128 + d] : 0.f;
          if (tg == 3) GE[d] = gl[15] + off;
#pragma unroll
          for (int t = 0; t < 16; ++t) { const float Gt = gl[t] + off; Qg[(t0 + t) * 136 + d] = (bf16)f2bf(q[t] * __expf(Gt)); Ka[(t0 + t) * 136 + d] = (bf16)f2bf(k[t] * __expf(-Gt)); } }
        __syncthreads();
        bf16x8* base = (bf16x8*)(OPS + (size_t)item * GLA_ITEM_BYTES);
        if (wave < 4) {
            const int mt = wave >> 1, nt = wave & 1;
            f32x16 acc;
#pragma unroll
            for (int i = 0; i < 16; ++i) acc[i] = 0.f;
#pragma unroll
            for (int ks = 0; ks < 8; ++ks) acc = MFMA32(*(const LAS bf16x8*)(Qg + (32 * mt + r) * 136 + 16 * ks + 8 * hp), *(const LAS bf16x8*)(Ka + (32 * nt + r) * 136 + 16 * ks + 8 * hp), acc);
            const int jt = 32 * nt + r;
#pragma unroll
            for (int i16 = 0; i16 < 16; ++i16) { const int i = 32 * mt + crow(i16, hp); QKm[i * 65 + jt] = jt <= i ? acc[i16] : 0.f; }
        } else {
            const int w4 = wave - 4;
#pragma unroll
            for (int qh = 0; qh < 2; ++qh) {
                u32x4 g[8];
#pragma unroll
                for (int q4 = 0; q4 < 4; ++q4) { const int f = w4 + 4 * (4 * qh + q4), nt = f >> 2, ks = f & 3, p = 32 * nt + r;
#pragma unroll
                    for (int jp = 0; jp < 8; ++jp) { const int tk = 16 * ks + 8 * (jp >> 2) + 4 * hp + (jp & 3); g[q4 * 2 + (jp >> 2)][jp & 3] = (unsigned)U[(size_t)(row0 + tk) * NAB + 5120 + h * 256 + p]; } }
                asm volatile("" : "+v"(g[0]), "+v"(g[1]), "+v"(g[2]), "+v"(g[3]), "+v"(g[4]), "+v"(g[5]), "+v"(g[6]), "+v"(g[7]));
#pragma unroll
                for (int q4 = 0; q4 < 4; ++q4) { const int f = w4 + 4 * (4 * qh + q4); const u32x4 lo = g[q4 * 2], hi = g[q4 * 2 + 1];
                    base[(40 + f) * 64 + lane] = __builtin_bit_cast(bf16x8, (u32x4){lo[0] | (lo[1] << 16), lo[2] | (lo[3] << 16), hi[0] | (hi[1] << 16), hi[2] | (hi[3] << 16)}); } }
        }
        __syncthreads();
        float v[8];
#pragma unroll
        for (int q2 = 0; q2 < 2; ++q2) { const int f = wave + 8 * q2;
            { const int mt = f >> 3, ks = f & 7, i = 32 * mt + r;
              const u32x2 lo = *(const LAS u32x2*)(Qg + i * 136 + 16 * ks + 4 * hp), hi = *(const LAS u32x2*)(Qg + i * 136 + 16 * ks + 8 + 4 * hp);
              base[f * 64 + lane] = __builtin_bit_cast(bf16x8, (u32x4){lo.x, lo.y, hi.x, hi.y}); }
            { const int mt = f >> 2, ks = f & 3, dd = 32 * mt + r; const float eg = __expf(GE[dd]);
#pragma unroll
              for (int jp = 0; jp < 8; ++jp) v[jp] = bf2f(Ka[(16 * ks + 8 * (jp >> 2) + 4 * hp + (jp & 3)) * 136 + dd]) * eg;
              base[(16 + f) * 64 + lane] = pack8(v); } }
        { const int f = wave, mt = f >> 2, ks = f & 3, i = 32 * mt + r;
#pragma unroll
          for (int jp = 0; jp < 8; ++jp) v[jp] = QKm[i * 65 + 16 * ks + 8 * (jp >> 2) + 4 * hp + (jp & 3)];
          base[(32 + f) * 64 + lane] = pack8(v); }
        if (tid < 128) ((float*)(base + 72 * 64))[tid] = __expf(GE[tid]);
    }
}

constexpr size_t DN_ITEM_BYTES = 74752;
__device__ __forceinline__ void phase_dn_prep(const KP kp, const int bid, const int G, int j, LAS unsigned char* lds, int tid0) {
    unsigned char* scr = kp.ws() + WS_SCR;
    const bf16* U = (const bf16*)(kp.ws() + WS_U); const float* cw = kp.in(14) + (size_t)j * 4 * 3072;
    unsigned char* OPS = scr + SC_DNOPS;
    LAS float* AMT = (LAS float*)lds; LAS float* GLs = AMT + 64 * 68; LAS float* BLs = GLs + 64; LAS float* SS = BLs + 64;
    LAS bf16* Kb = (LAS bf16*)(SS + 256); LAS bf16* Qb = Kb + 64 * 136; LAS float* QKm = (LAS float*)(Qb + 64 * 136); LAS float* XL = QKm + 64 * 65;
    unsigned rawq[3][11];
#define DN_RAW(item_, RAW) do { const int b_ = (item_) >> 8, n_ = ((item_) >> 3) & 31, h_ = (item_) & 7, w_ = tid0 >> 6, l_ = tid0 & 63; \
        const long fo_ = (n_ == 0 && w_ == 0) ? 0 : (long)NAB; \
        _Pragma("unroll") for (int part_ = 0; part_ < 3; ++part_) { const bf16* up_ = U + (size_t)(b_ * 2048 + n_ * 64 + 8 * w_) * NAB + part_ * 1024 + h_ * 128 + 2 * l_; \
            RAW[part_][0] = *(const unsigned*)(up_ - 3 * fo_); RAW[part_][1] = *(const unsigned*)(up_ - 2 * fo_); RAW[part_][2] = *(const unsigned*)(up_ - 1 * fo_); \
            _Pragma("unroll") for (int t_ = 0; t_ < 8; ++t_) RAW[part_][3 + t_] = *(const unsigned*)(up_ + (size_t)t_ * NAB); } } while (0)
    if (bid < 1024) DN_RAW(bid, rawq);
    for (int item = bid; item < 1024; item += G) {
        int tid = tid0; asm volatile("" : "+v"(tid));
        const int lane = tid & 63, r = lane & 31, hp = lane >> 5, wave = tid >> 6;
        const int b = item >> 8, n = (item >> 3) & 31, h = item & 7;
        const int row0 = b * 2048 + n * 64;
        __syncthreads();
        SEC_BEGIN(20)
        {
          const int t0 = 8 * wave; const bool first = (n == 0 && wave == 0);
          float qa[8], qb[8], ka[8], kb[8];
#pragma unroll
          for (int part = 0; part < 3; ++part) { const int c = part * 1024 + h * 128 + 2 * lane;
              const float w0a = cw[c], w0b = cw[c + 1], w1a = cw[3072 + c], w1b = cw[3072 + c + 1], w2a = cw[2 * 3072 + c], w2b = cw[2 * 3072 + c + 1], w3a = cw[3 * 3072 + c], w3b = cw[3 * 3072 + c + 1];
              unsigned raw[11];
#pragma unroll
              for (int q = 0; q < 11; ++q) raw[q] = rawq[part][q];
              if (first) { raw[0] = 0u; raw[1] = 0u; raw[2] = 0u; }
#pragma unroll
              for (int t = 0; t < 8; ++t) {
                  const float ya = silu_(w0a * __uint_as_float(raw[t] << 16) + w1a * __uint_as_float(raw[t + 1] << 16) + w2a * __uint_as_float(raw[t + 2] << 16) + w3a * __uint_as_float(raw[t + 3] << 16));
                  const float yb = silu_(w0b * __uint_as_float(raw[t] & 0xffff0000u) + w1b * __uint_as_float(raw[t + 1] & 0xffff0000u) + w2b * __uint_as_float(raw[t + 2] & 0xffff0000u) + w3b * __uint_as_float(raw[t + 3] & 0xffff0000u));
                  if (part == 0) { qa[t] = ya; qb[t] = yb; } else if (part == 1) { ka[t] = ya; kb[t] = yb; } else { XL[(t0 + t) * 257 + 2 * lane] = ya; XL[(t0 + t) * 257 + 2 * lane + 1] = yb; } } }
#pragma unroll
          for (int t = 0; t < 8; ++t) { const float scq = rsqrtf(wave_sum(qa[t] * qa[t] + qb[t] * qb[t]) + 1e-6f) * 0.08838834764831845f, sck = rsqrtf(wave_sum(ka[t] * ka[t] + kb[t] * kb[t]) + 1e-6f);
              *(LAS unsigned*)(Qb + (t0 + t) * 136 + 2 * lane) = pk2(qa[t] * scq, qb[t] * scq); *(LAS unsigned*)(Kb + (t0 + t) * 136 + 2 * lane) = pk2(ka[t] * sck, kb[t] * sck); } }
        if (wave == 0) { const size_t ro = (size_t)(row0 + lane) * NAB;
            float gv = -__expf(kp.in(15)[j * 8 + h]) * softplus_(bf2f(U[ro + 7176 + h]) + kp.in(16)[j * 8 + h]);
#pragma unroll
            for (int o = 1; o < 64; o <<= 1) { const float tt = __shfl_up(gv, o); if (lane >= o) gv += tt; }
            GLs[lane] = gv; BLs[lane] = sigmoid_(bf2f(U[ro + 7168 + h])); }
        __syncthreads();
        { const int nitem = item + G; if (nitem < 1024) DN_RAW(nitem, rawq); }
        SEC_END(20, lds)
        SEC_BEGIN(21)
        SEC_END(21, lds)
        SEC_BEGIN(22)
        bf16x8* base = (bf16x8*)(OPS + (size_t)item * DN_ITEM_BYTES);
        { const int which = wave >> 2, mt = (wave >> 1) & 1, nt = wave & 1;
          const LAS bf16* Asrc = which ? Qb : Kb;
          f32x16 acc;
#pragma unroll
          for (int i = 0; i < 16; ++i) acc[i] = 0.f;
#pragma unroll
          for (int ks = 0; ks < 8; ++ks) acc = MFMA32(*(const LAS bf16x8*)(Asrc + (32 * mt + r) * 136 + 16 * ks + 8 * hp), *(const LAS bf16x8*)(Kb + (32 * nt + r) * 136 + 16 * ks + 8 * hp), acc);
          const int jt = 32 * nt + r; const float gj = GLs[jt];
#pragma unroll
          for (int i16 = 0; i16 < 16; ++i16) { const int i = 32 * mt + crow(i16, hp); const float dec = __expf(GLs[i] - gj);
              if (which == 0) AMT[jt * 68 + i] = jt < i ? BLs[i] * acc[i16] * dec : 0.f; else QKm[i * 65 + jt] = jt <= i ? acc[i16] * dec : 0.f; } }
        __syncthreads();
        SEC_END(22, lds)
        SEC_BEGIN(23)
        if (tid < 256) {
            const int c = tid; float acc[16], dg[120];
#pragma unroll
            for (int ii = 0; ii < 16; ++ii) { const float be = BLs[ii]; acc[ii] = c < 128 ? be * XL[ii * 257 + c] : be * __expf(GLs[ii]) * bf2f(Kb[ii * 136 + (c - 128)]); }
#pragma unroll
            for (int ii = 1; ii < 16; ++ii)
#pragma unroll
                for (int jj = 0; jj < ii; ++jj) dg[ii * (ii - 1) / 2 + jj] = AMT[jj * 68 + ii];
#pragma unroll
            for (int ii = 0; ii < 16; ++ii) { float x = acc[ii];
#pragma unroll
                for (int jj = 0; jj < ii; ++jj) x -= dg[ii * (ii - 1) / 2 + jj] * acc[jj];
                acc[ii] = x; }
#pragma unroll
            for (int ii = 0; ii < 16; ++ii) XL[ii * 257 + c] = acc[ii];
        } else {
            const int w4 = wave - 4; float v[8];
#pragma unroll
            for (int q = 0; q < 4; ++q) { const int f = w4 + 4 * q;
                { const int mt = f >> 3, ks = f & 7, i = 32 * mt + r; const float eg = __expf(GLs[i]);
#pragma unroll
                  for (int jp = 0; jp < 8; ++jp) v[jp] = bf2f(Qb[i * 136 + 16 * ks + 8 * (jp >> 2) + 4 * hp + (jp & 3)]) * eg;
                  base[(16 + f) * 64 + lane] = pack8(v); }
                { const int mt = f >> 2, ks = f & 3, d = 32 * mt + r; const float Gend = GLs[63];
#pragma unroll
                  for (int jp = 0; jp < 8; ++jp) { const int tk = 16 * ks + 8 * (jp >> 2) + 4 * hp + (jp & 3); v[jp] = bf2f(Kb[tk * 136 + d]) * __expf(Gend - GLs[tk]); }
                  base[(32 + f) * 64 + lane] = pack8(v); } }
#pragma unroll
            for (int q = 0; q < 2; ++q) { const int f = w4 + 4 * q, mt = f >> 2, ks = f & 3, i = 32 * mt + r;
#pragma unroll
                for (int jp = 0; jp < 8; ++jp) v[jp] = QKm[i * 65 + 16 * ks + 8 * (jp >> 2) + 4 * hp + (jp & 3)];
                base[(48 + f) * 64 + lane] = pack8(v); }
            if (tid == 256) *(float*)(base + 72 * 64) = __expf(GLs[63]);
        }
        __syncthreads();
#pragma unroll
        for (int bi = 1; bi < 4; ++bi) {
            { const int li_ = lane & 15, kq = lane >> 4;
#pragma unroll
              for (int q = 0; q < 2; ++q) { const int col = 16 * (2 * wave + q) + li_;
                  f32x4 ya;
#pragma unroll
                  for (int rg = 0; rg < 4; ++rg) { const int row = 16 * bi + 4 * kq + rg; const float be = BLs[row];
                      ya[rg] = col < 128 ? be * XL[row * 257 + col] : be * __expf(GLs[row]) * bf2f(Kb[row * 136 + (col - 128)]); }
#pragma unroll
                  for (int kk = 0; kk < 4 * bi; ++kk) { const int krow = 4 * kk + kq;
                      ya = __builtin_amdgcn_mfma_f32_16x16x4f32(-AMT[krow * 68 + 16 * bi + li_], XL[krow * 257 + col], ya, 0, 0, 0); }
#pragma unroll
                  for (int rg = 0; rg < 4; ++rg) XL[(16 * bi + 4 * kq + rg) * 257 + col] = ya[rg]; } }
            __syncthreads();
            if (tid < 256) { const int c = tid; float acc[16], dg[120];
#pragma unroll
                for (int ii = 0; ii < 16; ++ii) acc[ii] = XL[(16 * bi + ii) * 257 + c];
#pragma unroll
                for (int ii = 1; ii < 16; ++ii)
#pragma unroll
                    for (int jj = 0; jj < ii; ++jj) dg[ii * (ii - 1) / 2 + jj] = AMT[(16 * bi + jj) * 68 + 16 * bi + ii];
#pragma unroll
                for (int ii = 0; ii < 16; ++ii) { float x = acc[ii];
#pragma unroll
                    for (int jj = 0; jj < ii; ++jj) x -= dg[ii * (ii - 1) / 2 + jj] * acc[jj];
                    acc[ii] = x; }
#pragma unroll
                for (int ii = 0; ii < 16; ++ii) XL[(16 * bi + ii) * 257 + c] = acc[ii]; }
            __syncthreads();
        }
        SEC_END(23, lds)
        SEC_BEGIN(24)
        float v[8];
#pragma unroll
        for (int q = 0; q < 2; ++q) { const int f = wave + 8 * q;
            { const int mt = f >> 3, ks = f & 7, i = 32 * mt + r;
#pragma unroll
              for (int jp = 0; jp < 8; ++jp) v[jp] = -XL[i * 257 + 128 + 16 * ks + 8 * (jp >> 2) + 4 * hp + (jp & 3)];
              base[f * 64 + lane] = pack8(v); }
            { const int pq = f & 1, tl = f >> 1, mt = tl >> 2, nt = tl & 3;
#pragma unroll
              for (int e = 0; e < 8; ++e) v[e] = XL[(32 * mt + crow(8 * pq + e, hp)) * 257 + 32 * nt + r];
              base[(56 + f) * 64 + lane] = pack8(v); } }
        SEC_END(24, lds)
    }
#undef DN_RAW
}


struct DnIn { float S[32]; unsigned w12[12]; unsigned gb[2]; };
__device__ __forceinline__ void dn_item_load(const KP kp, int j, int it, int tid, DnIn& I) {
    const bf16* U = (const bf16*)(kp.ws() + WS_U); const float* stc = kp.in(3) + (size_t)j * 128 * 3 * 3072;
    const int bs = it >> 3, h = it & 7, r0 = TP + bs * 4, e = tid & 127, dq = tid >> 7;
    const float* sp = kp.in(2) + ((size_t)j * 128 + bs) * ((size_t)8 * 128 * 128) + (size_t)h * 16384 + (size_t)(dq * 32) * 128 + e;
#pragma unroll
    for (int i = 0; i < 32; ++i) { I.S[i] = __builtin_nontemporal_load(sp); sp += 128; asm volatile("" : "+v"(sp)); }
#pragma unroll
    for (int part = 0; part < 3; ++part) { const int c = part * 1024 + h * 128 + e;
#pragma unroll
        for (int tap = 0; tap < 4; ++tap) { const int tt = dq - 3 + tap;
            const unsigned* pu = (const unsigned*)U + (((size_t)(r0 + (tt >= 0 ? tt : 0)) * NAB + c) >> 1);
            const unsigned* ps = (const unsigned*)(stc + ((size_t)bs * 3 + (tt >= 0 ? 0 : 3 + tt)) * 3072 + c);
            I.w12[part * 4 + tap] = *(tt >= 0 ? pu : ps); } }
    { const size_t ro = (size_t)(r0 + (tid & 3)) * NAB; I.gb[0] = (unsigned)U[ro + 7176 + h]; I.gb[1] = (unsigned)U[ro + 7168 + h]; }
}
__device__ __forceinline__ void dn_item_compute(const KP kp, int j, int it, int tid0, const DnIn& I, LAS unsigned char* lds) {
    int tid = tid0; asm volatile("" : "+v"(tid));
    bf16* ODN = (bf16*)(kp.ws() + WS_SCR + SC_ODN); const float* cw = kp.in(14) + (size_t)j * 4 * 3072;
    const int wave = tid >> 6, lane = tid & 63;
    const int bs = it >> 3, h = it & 7, r0 = TP + bs * 4;
    LAS float* qL = (LAS float*)lds; LAS float* kL = qL + 512; LAS float* vL = kL + 512; LAS float* red = vL + 512; LAS float* sm = red + 4096;
    const int e = tid & 127, dq = tid >> 7;
    const size_t SZ = (size_t)8 * 128 * 128;
#pragma unroll
    for (int part = 0; part < 3; ++part) { const int c = part * 1024 + h * 128 + e; float acc = 0.f;
#pragma unroll
        for (int tap = 0; tap < 4; ++tap) { const int tt = dq - 3 + tap; const unsigned w = I.w12[part * 4 + tap];
            const float x = tt >= 0 ? __uint_as_float((e & 1) ? (w & 0xffff0000u) : (w << 16)) : __uint_as_float(w);
            acc += cw[tap * 3072 + c] * x; }
        if (part == 2) vL[dq * 128 + e] = silu_(acc); else (part == 0 ? qL : kL)[e * 4 + dq] = silu_(acc); }
    if (tid < 4) { sm[32 + tid] = -__expf(kp.in(15)[j * 8 + h]) * softplus_(__uint_as_float(I.gb[0] << 16) + kp.in(16)[j * 8 + h]); sm[36 + tid] = sigmoid_(__uint_as_float(I.gb[1] << 16)); }
    __syncthreads();
    { const int tk = wave & 3; LAS float* src = (wave >> 2) ? kL : qL; const float a = src[lane * 4 + tk], b = src[(lane + 64) * 4 + tk];
      const float sc = rsqrtf(wave_sum(a * a + b * b) + 1e-6f) * ((wave >> 2) ? 1.f : 0.08838834764831845f); src[lane * 4 + tk] = a * sc; src[(lane + 64) * 4 + tk] = b * sc; }
    __syncthreads();
#pragma unroll
    for (int q = 0; q < 4; ++q) { const int idx = wave * 4 + q, i = (idx >> 2) & 3, jj = idx & 3; const LAS float* src = idx < 16 ? kL : qL;
        const float dot = wave_sum(src[lane * 4 + i] * kL[lane * 4 + jj] + src[(lane + 64) * 4 + i] * kL[(lane + 64) * 4 + jj]); if (lane == 0) sm[idx] = dot; }
    float ks[4] = {0.f, 0.f, 0.f, 0.f}, qs[4] = {0.f, 0.f, 0.f, 0.f};
#pragma unroll
    for (int i = 0; i < 32; ++i) { const int d = dq * 32 + i; const float sv = I.S[i]; const f32x4 k4 = *(const LAS f32x4*)(kL + d * 4), q4 = *(const LAS f32x4*)(qL + d * 4);
#pragma unroll
        for (int t = 0; t < 4; ++t) { ks[t] += k4[t] * sv; qs[t] += q4[t] * sv; } }
#pragma unroll
    for (int t = 0; t < 4; ++t) { red[(t * 4 + dq) * 128 + e] = ks[t]; red[((4 + t) * 4 + dq) * 128 + e] = qs[t]; }
    __syncthreads();
    float Gc[4]; Gc[0] = sm[32]; Gc[1] = Gc[0] + sm[33]; Gc[2] = Gc[1] + sm[34]; Gc[3] = Gc[2] + sm[35];
    float u[4];
#pragma unroll
    for (int i = 0; i < 4; ++i) { const float KSi = (red[(i * 4 + 0) * 128 + e] + red[(i * 4 + 1) * 128 + e]) + (red[(i * 4 + 2) * 128 + e] + red[(i * 4 + 3) * 128 + e]);
        float acc = vL[i * 128 + e] - __expf(Gc[i]) * KSi;
#pragma unroll
        for (int jj = 0; jj < i; ++jj) acc -= sm[i * 4 + jj] * __expf(Gc[i] - Gc[jj]) * u[jj];
        u[i] = sm[36 + i] * acc; }
    if (dq == 0) {
#pragma unroll
        for (int i = 0; i < 4; ++i) { const float QSi = (red[((4 + i) * 4 + 0) * 128 + e] + red[((4 + i) * 4 + 1) * 128 + e]) + (red[((4 + i) * 4 + 2) * 128 + e] + red[((4 + i) * 4 + 3) * 128 + e]);
            float o = __expf(Gc[i]) * QSi;
#pragma unroll
            for (int jj = 0; jj <= i; ++jj) o += sm[16 + i * 4 + jj] * __expf(Gc[i] - Gc[jj]) * u[jj];
            ODN[(size_t)(r0 + i) * 1024 + h * 128 + e] = (bf16)f2bf(o); } }
    const float eg = __expf(Gc[3]); float w[4];
#pragma unroll
    for (int jj = 0; jj < 4; ++jj) w[jj] = __expf(Gc[3] - Gc[jj]) * u[jj];
    float* dst = kp.out() + O_DN_S + ((size_t)j * 128 + bs) * SZ + (size_t)h * 16384 + (size_t)(dq * 32) * 128 + e;
#pragma unroll
    for (int i = 0; i < 32; ++i) { const int d = dq * 32 + i; float sv = eg * I.S[i]; const f32x4 k4 = *(const LAS f32x4*)(kL + d * 4);
#pragma unroll
        for (int jj = 0; jj < 4; ++jj) sv += k4[jj] * w[jj];
        __builtin_nontemporal_store(sv, dst); dst += 128; asm volatile("" : "+v"(dst)); }
}


struct GlaIn { float S[64]; bf16 v[4]; bf16 q, k; u32x4 g0, g1; };
__device__ __forceinline__ void gla_item_load(const KP kp, int j, int itg, int tid, GlaIn& I) {
    const bf16* U = (const bf16*)(kp.ws() + WS_U);
    const int bs = itg >> 2, h = itg & 3, r0 = TP + bs * 4, e = tid & 255, dh = tid >> 8;
    const float* sp = kp.in(4) + ((size_t)j * 128 + bs) * ((size_t)4 * 128 * 256) + (size_t)h * 32768 + (size_t)(dh * 64) * 256 + e;
#pragma unroll
    for (int i = 0; i < 64; ++i) { I.S[i] = __builtin_nontemporal_load(sp); sp += 256; asm volatile("" : "+v"(sp)); }
#pragma unroll
    for (int t = 0; t < 4; ++t) I.v[t] = U[(size_t)(r0 + t) * NAB + 5120 + h * 256 + e];
    { const int d = tid & 127, tk = tid >> 7; const size_t ro = (size_t)(r0 + tk) * NAB;
      I.q = U[ro + 4096 + h * 128 + d]; I.k = U[ro + 4608 + h * 128 + d]; I.g0 = *(const u32x4*)(U + ro + 7184); I.g1 = *(const u32x4*)(U + ro + 7192); }
}
__device__ __forceinline__ void gla_item_compute(const KP kp, int j, int itg, int tid0, const GlaIn& I, LAS unsigned char* lds) {
    int tid = tid0; asm volatile("" : "+v"(tid));
    bf16* OGLA = (bf16*)(kp.ws() + WS_SCR + SC_OGLA);
    const float* wa2 = kp.in(18) + (size_t)j * 16 * 512; const float* ba = kp.in(19) + (size_t)j * 512;
    const int wave = tid >> 6, lane = tid & 63;
    const int bs = itg >> 2, h = itg & 3, r0 = TP + bs * 4;
    LAS float* qgL = (LAS float*)lds; LAS float* kaL = qgL + 512; LAS float* glL = kaL + 512; LAS float* egL = glL + 512; LAS float* Am = egL + 128; LAS float* red = Am + 16;
    const int e = tid & 255, dh = tid >> 8;
    const size_t SZ = (size_t)4 * 128 * 256;
    float v[4];
#pragma unroll
    for (int t = 0; t < 4; ++t) v[t] = bf2f(I.v[t]);
    { const int d = tid & 127, tk = tid >> 7;
      qgL[d * 4 + tk] = bf2f(I.q) * 0.08838834764831845f; kaL[d * 4 + tk] = bf2f(I.k);
      const unsigned gw[8] = {I.g0.x, I.g0.y, I.g0.z, I.g0.w, I.g1.x, I.g1.y, I.g1.z, I.g1.w};
      float x = ba[h * 128 + d];
#pragma unroll
      for (int rr = 0; rr < 8; ++rr) x += __uint_as_float(gw[rr] << 16) * wa2[(2 * rr) * 512 + h * 128 + d] + __uint_as_float(gw[rr] & 0xffff0000u) * wa2[(2 * rr + 1) * 512 + h * 128 + d];
      glL[tk * 128 + d] = -softplus_(-x) * (1.f / 16.f); }
    __syncthreads();
    if (tid < 128) { float Gq = 0.f;
#pragma unroll
        for (int t = 0; t < 4; ++t) { Gq += glL[t * 128 + tid]; qgL[tid * 4 + t] *= __expf(Gq); kaL[tid * 4 + t] *= __expf(-Gq); }
        egL[tid] = __expf(Gq); }
    __syncthreads();
#pragma unroll
    for (int q = 0; q < 2; ++q) { const int idx = wave * 2 + q, i = idx >> 2, jj = idx & 3;
        const float dot = wave_sum(qgL[lane * 4 + i] * kaL[lane * 4 + jj] + qgL[(lane + 64) * 4 + i] * kaL[(lane + 64) * 4 + jj]); if (lane == 0) Am[idx] = dot; }
    float o[4] = {0.f, 0.f, 0.f, 0.f};
    float* dst = kp.out() + O_GLA_S + ((size_t)j * 128 + bs) * SZ + (size_t)h * 32768 + (size_t)(dh * 64) * 256 + e;
#pragma unroll
    for (int i = 0; i < 64; ++i) { const int d = dh * 64 + i; const float s0 = I.S[i]; float acc = s0; const f32x4 q4 = *(const LAS f32x4*)(qgL + d * 4), k4 = *(const LAS f32x4*)(kaL + d * 4);
#pragma unroll
        for (int t = 0; t < 4; ++t) { o[t] += q4[t] * s0; acc += k4[t] * v[t]; }
        __builtin_nontemporal_store(egL[d] * acc, dst); dst += 256; asm volatile("" : "+v"(dst)); }
#pragma unroll
    for (int t = 0; t < 4; ++t) red[(dh * 4 + t) * 256 + e] = o[t];
    __syncthreads();
    if (dh == 0) {
#pragma unroll
        for (int t = 0; t < 4; ++t) { float oo = red[t * 256 + e] + red[(4 + t) * 256 + e];
#pragma unroll
            for (int jj = 0; jj <= t; ++jj) oo += Am[t * 4 + jj] * v[jj];
            OGLA[(size_t)(r0 + t) * 1024 + h * 256 + e] = (bf16)f2bf(oo); } }
}

__device__ __forceinline__ void phase_ab_rec(const KP kp, const int bid, const int G, int j, int li, LAS unsigned char* lds, int tid0) {
    unsigned char* scr = kp.ws() + WS_SCR; const bf16* U = (const bf16*)(kp.ws() + WS_U);
    bf16* ODN = (bf16*)(scr + SC_ODN); bf16* OGLA = (bf16*)(scr + SC_OGLA);
    SEC_BEGIN(12)
    for (int item = bid; item < 64; item += G) {
        int tid = tid0; asm volatile("" : "+v"(tid));
        int s, h; bool isdn; int half = -1;
        if (item < 32) { const int it2 = 2 * ((item & 7) + 8 * (item >> 4)) + ((item >> 3) & 1);
                         isdn = false; s = it2 >> 3; h = (it2 >> 1) & 3; half = it2 & 1; }
        else if (item < 64) { isdn = true; s = (item - 32) >> 3; h = (item - 32) & 7; half = -2; }
        else if (item < 1088) { isdn = true; s = 4 + ((item - 64) >> 3); h = (item - 64) & 7; }
        else { isdn = false; s = 4 + ((item - 1088) >> 2); h = (item - 1088) & 3; }
        int row0, L; seq_info(s, row0, L);
        __syncthreads();
        if (half == -2) {
            const int wave = __builtin_amdgcn_readfirstlane(tid >> 6), lane = tid & 63, r = lane & 31, hp = lane >> 5;
            const int b = s, nt = wave;
            const unsigned char* OPS = scr + SC_DNOPS;
            constexpr int DBUF = 73 * 1024;
#define DN_DMA(n_, bufi_) do { const unsigned char* gi_ = OPS + (size_t)((b * 32 + (n_)) * 8 + h) * DN_ITEM_BYTES + lane * 16; \
                _Pragma("unroll") for (int q_ = 0; q_ < 10; ++q_) { const int lf_ = wave + 8 * q_; if (lf_ < 73) \
                    __builtin_amdgcn_global_load_lds((const unsigned*)(gi_ + lf_ * 1024), (LAS unsigned*)(lds + (bufi_) * DBUF + lf_ * 1024), 16, 0, 2); } } while (0)
            f32x16 S0, S1, S2, S3;
#pragma unroll
            for (int i = 0; i < 16; ++i) { S0[i] = 0.f; S1[i] = 0.f; S2[i] = 0.f; S3[i] = 0.f; }
            DN_DMA(0, 0);
            asm volatile("s_waitcnt vmcnt(0)" ::: "memory"); __syncthreads();
            for (int n = 0; n < 32; ++n) {
                if (n + 1 < 32) DN_DMA(n + 1, (n + 1) & 1);
                if (wave < 4) {
                    const LAS bf16x8* F = (const LAS bf16x8*)(lds + (n & 1) * DBUF) + lane;
                    const float gend = *(const LAS float*)(lds + (n & 1) * DBUF + 72 * 1024);
                    const bf16x8 sb0 = PACK_ACC(S0, 0), sb1 = PACK_ACC(S0, 1), sb2 = PACK_ACC(S1, 0), sb3 = PACK_ACC(S1, 1), sb4 = PACK_ACC(S2, 0), sb5 = PACK_ACC(S2, 1), sb6 = PACK_ACC(S3, 0), sb7 = PACK_ACC(S3, 1);
                    f32x16 U0t, U1t;
                    { const bf16x8 a0 = F[(56 + nt * 2 + 0) * 64], a1 = F[(56 + nt * 2 + 1) * 64], c0 = F[(56 + (4 + nt) * 2 + 0) * 64], c1 = F[(56 + (4 + nt) * 2 + 1) * 64];
#pragma unroll
                      for (int e = 0; e < 8; ++e) { U0t[e] = bf2f((bf16)a0[e]); U0t[8 + e] = bf2f((bf16)a1[e]); U1t[e] = bf2f((bf16)c0[e]); U1t[8 + e] = bf2f((bf16)c1[e]); } }
                    U0t = MFMA32(F[0 * 64], sb0, U0t); U0t = MFMA32(F[1 * 64], sb1, U0t); U0t = MFMA32(F[2 * 64], sb2, U0t); U0t = MFMA32(F[3 * 64], sb3, U0t);
                    U0t = MFMA32(F[4 * 64], sb4, U0t); U0t = MFMA32(F[5 * 64], sb5, U0t); U0t = MFMA32(F[6 * 64], sb6, U0t); U0t = MFMA32(F[7 * 64], sb7, U0t);
                    U1t = MFMA32(F[8 * 64], sb0, U1t); U1t = MFMA32(F[9 * 64], sb1, U1t); U1t = MFMA32(F[10 * 64], sb2, U1t); U1t = MFMA32(F[11 * 64], sb3, U1t);
                    U1t = MFMA32(F[12 * 64], sb4, U1t); U1t = MFMA32(F[13 * 64], sb5, U1t); U1t = MFMA32(F[14 * 64], sb6, U1t); U1t = MFMA32(F[15 * 64], sb7, U1t);
                    const bf16x8 ub0 = PACK_ACC(U0t, 0), ub1 = PACK_ACC(U0t, 1), ub2 = PACK_ACC(U1t, 0), ub3 = PACK_ACC(U1t, 1);
                    f32x16 O0, O1;
#pragma unroll
                    for (int i = 0; i < 16; ++i) { O0[i] = 0.f; O1[i] = 0.f; }
                    O0 = MFMA32(F[16 * 64], sb0, O0); O0 = MFMA32(F[17 * 64], sb1, O0); O0 = MFMA32(F[18 * 64], sb2, O0); O0 = MFMA32(F[19 * 64], sb3, O0);
                    O0 = MFMA32(F[20 * 64], sb4, O0); O0 = MFMA32(F[21 * 64], sb5, O0); O0 = MFMA32(F[22 * 64], sb6, O0); O0 = MFMA32(F[23 * 64], sb7, O0);
                    O1 = MFMA32(F[24 * 64], sb0, O1); O1 = MFMA32(F[25 * 64], sb1, O1); O1 = MFMA32(F[26 * 64], sb2, O1); O1 = MFMA32(F[27 * 64], sb3, O1);
                    O1 = MFMA32(F[28 * 64], sb4, O1); O1 = MFMA32(F[29 * 64], sb5, O1); O1 = MFMA32(F[30 * 64], sb6, O1); O1 = MFMA32(F[31 * 64], sb7, O1);
                    O0 = MFMA32(F[48 * 64], ub0, O0); O0 = MFMA32(F[49 * 64], ub1, O0);
                    O1 = MFMA32(F[52 * 64], ub0, O1); O1 = MFMA32(F[53 * 64], ub1, O1); O1 = MFMA32(F[54 * 64], ub2, O1); O1 = MFMA32(F[55 * 64], ub3, O1);
#pragma unroll
                    for (int i = 0; i < 16; ++i) { S0[i] *= gend; S1[i] *= gend; S2[i] *= gend; S3[i] *= gend; }
                    S0 = MFMA32(F[32 * 64], ub0, S0); S0 = MFMA32(F[33 * 64], ub1, S0); S0 = MFMA32(F[34 * 64], ub2, S0); S0 = MFMA32(F[35 * 64], ub3, S0);
                    S1 = MFMA32(F[36 * 64], ub0, S1); S1 = MFMA32(F[37 * 64], ub1, S1); S1 = MFMA32(F[38 * 64], ub2, S1); S1 = MFMA32(F[39 * 64], ub3, S1);
                    S2 = MFMA32(F[40 * 64], ub0, S2); S2 = MFMA32(F[41 * 64], ub1, S2); S2 = MFMA32(F[42 * 64], ub2, S2); S2 = MFMA32(F[43 * 64], ub3, S2);
                    S3 = MFMA32(F[44 * 64], ub0, S3); S3 = MFMA32(F[45 * 64], ub1, S3); S3 = MFMA32(F[46 * 64], ub2, S3); S3 = MFMA32(F[47 * 64], ub3, S3);
                    bf16* yo = ODN + (size_t)(b * 2048 + n * 64) * 1024 + h * 128 + 32 * nt + r;
#pragma unroll
                    for (int i = 0; i < 16; ++i) { yo[(size_t)crow(i, hp) * 1024] = (bf16)f2bf(O0[i]); yo[(size_t)(32 + crow(i, hp)) * 1024] = (bf16)f2bf(O1[i]); }
                }
                asm volatile("s_waitcnt vmcnt(0)" ::: "memory"); __syncthreads();
            }
#undef DN_DMA
            if (wave < 4) {
                float* dst = kp.out() + O_DN_P + ((size_t)j * 4 + b) * ((size_t)8 * 128 * 128) + (size_t)h * 128 * 128 + 32 * nt + r;
#pragma unroll
                for (int i = 0; i < 16; ++i) { dst[(size_t)crow(i, hp) * 128] = S0[i]; dst[(size_t)(32 + crow(i, hp)) * 128] = S1[i]; dst[(size_t)(64 + crow(i, hp)) * 128] = S2[i]; dst[(size_t)(96 + crow(i, hp)) * 128] = S3[i]; }
            }
        } else if (half >= 0) {
            const int wave = __builtin_amdgcn_readfirstlane(tid >> 6), lane = tid & 63, r = lane & 31, hp = lane >> 5;
            const int b = s, nt = half * 4 + wave;
            const unsigned char* OPS = kp.ws() + WS_GLAOPS;
            constexpr int GBUF = 57 * 1024;
#define GLA_DMA(n_, bufi_) do { const unsigned char* gi_ = OPS + (size_t)((b * 32 + (n_)) * 4 + h) * GLA_ITEM_BYTES + lane * 16; \
                _Pragma("unroll") for (int q_ = 0; q_ < 8; ++q_) { const int lf_ = wave + 8 * q_; if (lf_ < 57) { const int gf_ = lf_ < 40 ? lf_ : (lf_ < 56 ? lf_ + half * 16 : 72); \
                    __builtin_amdgcn_global_load_lds((const unsigned*)(gi_ + gf_ * 1024), (LAS unsigned*)(lds + (bufi_) * GBUF + lf_ * 1024), 16, 0, 2); } } } while (0)
            f32x16 S0, S1, S2, S3;
#pragma unroll
            for (int i = 0; i < 16; ++i) { S0[i] = 0.f; S1[i] = 0.f; S2[i] = 0.f; S3[i] = 0.f; }
            GLA_DMA(0, 0);
            asm volatile("s_waitcnt vmcnt(0)" ::: "memory"); __syncthreads();
            for (int n = 0; n < 32; ++n) {
                if (n + 1 < 32) GLA_DMA(n + 1, (n + 1) & 1);
                if (wave < 4) {
                    const LAS bf16x8* F = (const LAS bf16x8*)(lds + (n & 1) * GBUF) + lane;
                    const LAS float* ge = (const LAS float*)(lds + (n & 1) * GBUF + 56 * 1024) + 4 * hp;
                    const bf16x8 sb0 = PACK_ACC(S0, 0), sb1 = PACK_ACC(S0, 1), sb2 = PACK_ACC(S1, 0), sb3 = PACK_ACC(S1, 1), sb4 = PACK_ACC(S2, 0), sb5 = PACK_ACC(S2, 1), sb6 = PACK_ACC(S3, 0), sb7 = PACK_ACC(S3, 1);
                    f32x16 O0, O1;
#pragma unroll
                    for (int i = 0; i < 16; ++i) { O0[i] = 0.f; O1[i] = 0.f; }
                    O0 = MFMA32(F[0 * 64], sb0, O0); O0 = MFMA32(F[1 * 64], sb1, O0); O0 = MFMA32(F[2 * 64], sb2, O0); O0 = MFMA32(F[3 * 64], sb3, O0);
                    O0 = MFMA32(F[4 * 64], sb4, O0); O0 = MFMA32(F[5 * 64], sb5, O0); O0 = MFMA32(F[6 * 64], sb6, O0); O0 = MFMA32(F[7 * 64], sb7, O0);
                    O1 = MFMA32(F[8 * 64], sb0, O1); O1 = MFMA32(F[9 * 64], sb1, O1); O1 = MFMA32(F[10 * 64], sb2, O1); O1 = MFMA32(F[11 * 64], sb3, O1);
                    O1 = MFMA32(F[12 * 64], sb4, O1); O1 = MFMA32(F[13 * 64], sb5, O1); O1 = MFMA32(F[14 * 64], sb6, O1); O1 = MFMA32(F[15 * 64], sb7, O1);
                    bf16x8 vb[4];
#pragma unroll
                    for (int ks = 0; ks < 4; ++ks) vb[ks] = F[(40 + wave * 4 + ks) * 64];
                    O0 = MFMA32(F[32 * 64], vb[0], O0); O0 = MFMA32(F[33 * 64], vb[1], O0);
#pragma unroll
                    for (int ks = 0; ks < 4; ++ks) O1 = MFMA32(F[(36 + ks) * 64], vb[ks], O1);
#pragma unroll
                    for (int q = 0; q < 4; ++q) { const f32x4 g0 = *(const LAS f32x4*)(ge + 8 * q), g1 = *(const LAS f32x4*)(ge + 32 + 8 * q), g2 = *(const LAS f32x4*)(ge + 64 + 8 * q), g3 = *(const LAS f32x4*)(ge + 96 + 8 * q);
#pragma unroll
                        for (int c = 0; c < 4; ++c) { S0[4 * q + c] *= g0[c]; S1[4 * q + c] *= g1[c]; S2[4 * q + c] *= g2[c]; S3[4 * q + c] *= g3[c]; } }
#pragma unroll
                    for (int ks = 0; ks < 4; ++ks) { S0 = MFMA32(F[(16 + ks) * 64], vb[ks], S0); S1 = MFMA32(F[(20 + ks) * 64], vb[ks], S1); S2 = MFMA32(F[(24 + ks) * 64], vb[ks], S2); S3 = MFMA32(F[(28 + ks) * 64], vb[ks], S3); }
                    bf16* yo = OGLA + (size_t)(b * 2048 + n * 64) * 1024 + h * 256 + 32 * nt + r;
#pragma unroll
                    for (int i = 0; i < 16; ++i) { yo[(size_t)crow(i, hp) * 1024] = (bf16)f2bf(O0[i]); yo[(size_t)(32 + crow(i, hp)) * 1024] = (bf16)f2bf(O1[i]); }
                }
                asm volatile("s_waitcnt vmcnt(0)" ::: "memory"); __syncthreads();
            }
#undef GLA_DMA
            if (wave < 4) {
                float* dst = kp.out() + O_GLA_P + ((size_t)j * 4 + b) * ((size_t)4 * 128 * 256) + (size_t)h * 128 * 256 + 32 * nt + r;
#pragma unroll
                for (int i = 0; i < 16; ++i) { dst[(size_t)crow(i, hp) * 256] = S0[i]; dst[(size_t)(32 + crow(i, hp)) * 256] = S1[i]; dst[(size_t)(64 + crow(i, hp)) * 256] = S2[i]; dst[(size_t)(96 + crow(i, hp)) * 256] = S3[i]; }
            }
        } else
        {}
    }
    SEC_END(12, lds)
    SEC_BEGIN(13)
    unsigned* qhead = (unsigned*)(kp.ws() + WS_CTL) + CW_CNT + 64 * li;
    volatile LAS unsigned* qslot = (volatile LAS unsigned*)(lds + LDS_BYTES - 8);
    const float* cw = kp.in(14) + (size_t)j * 4 * 3072; const float* stc = kp.in(3) + (size_t)j * 128 * 3 * 3072;
    const float* wa2 = kp.in(18) + (size_t)j * 16 * 512; const float* ba = kp.in(19) + (size_t)j * 512;
#define Q_GRAB(var_, ctr_) do { __syncthreads(); if (tid0 == 0) qslot[0] = __hip_atomic_fetch_add((ctr_), 1u, __ATOMIC_RELAXED, __HIP_MEMORY_SCOPE_AGENT); __syncthreads(); var_ = (int)qslot[0]; } while (0)
    {
        DnIn IA, IB; int it0, it1;
        Q_GRAB(it0, qhead); if (it0 < 1024) dn_item_load(kp, j, it0, tid0, IA);
        for (;;) {
            if (it0 >= 1024) break;
            Q_GRAB(it1, qhead); if (it1 < 1024) dn_item_load(kp, j, it1, tid0, IB);
            dn_item_compute(kp, j, it0, tid0, IA, lds);
            if (it1 >= 1024) break;
            Q_GRAB(it0, qhead); if (it0 < 1024) dn_item_load(kp, j, it0, tid0, IA);
            dn_item_compute(kp, j, it1, tid0, IB, lds);
        }
    }
    {
        GlaIn GA, GB; int g0, g1;
        Q_GRAB(g0, qhead + 16); if (g0 < 512) gla_item_load(kp, j, g0, tid0, GA);
        for (;;) {
            if (g0 >= 512) break;
            Q_GRAB(g1, qhead + 16); if (g1 < 512) gla_item_load(kp, j, g1, tid0, GB);
            gla_item_compute(kp, j, g0, tid0, GA, lds);
            if (g1 >= 512) break;
            Q_GRAB(g0, qhead + 16); if (g0 < 512) gla_item_load(kp, j, g0, tid0, GA);
            gla_item_compute(kp, j, g1, tid0, GB, lds);
        }
    }
#undef Q_GRAB
    SEC_END(13, lds)
}

__device__ __forceinline__ void phase_ab_post(const KP kp, const int bid, const int G, int j, int tid, int wave, int lane) {
    unsigned char* scr = kp.ws() + WS_SCR; const bf16* U = (const bf16*)(kp.ws() + WS_U); bf16* YM = (bf16*)(kp.ws() + WS_YM);
    const bf16* ODN = (const bf16*)(scr + SC_ODN); const bf16* OGLA = (const bf16*)(scr + SC_OGLA);
    const float* dnn = kp.in(17) + (size_t)j * 128; const float* glan = kp.in(20) + (size_t)j * 256;
    typedef float f32x2v __attribute__((ext_vector_type(2)));
    const f32x2v dg = *(const f32x2v*)(dnn + 2 * lane); const f32x4 gg = *(const f32x4*)(glan + 4 * lane);
    const int stride = G * NWAVES;
#define POST_ROW(idx_) (((idx_) % 17) < 16 ? ((idx_) / 17) * 16 + ((idx_) % 17) : TP + (idx_) / 17)
#define AB_LOAD(r_, OD, ZD, OG, ZG) do { const bf16* ur_ = U + (size_t)(r_) * NAB; \
        _Pragma("unroll") for (int hh = 0; hh < 8; ++hh) { OD[hh] = *(const unsigned*)(ODN + (size_t)(r_) * 1024 + hh * 128 + 2 * lane); ZD[hh] = *(const unsigned*)(ur_ + 3072 + hh * 128 + 2 * lane); } \
        _Pragma("unroll") for (int hh = 0; hh < 4; ++hh) { OG[hh] = *(const u32x2*)(OGLA + (size_t)(r_) * 1024 + hh * 256 + 4 * lane); ZG[hh] = *(const u32x2*)(ur_ + 6144 + hh * 256 + 4 * lane); } } while (0)
    int idx = bid * NWAVES + wave;
    unsigned od[8], zd[8]; u32x2 og[4], zg[4];
    if (idx < T) AB_LOAD(POST_ROW(idx), od, zd, og, zg);
    for (; idx < T; idx += stride) {
        const int r = POST_ROW(idx), nidx = idx + stride;
        unsigned odn[8], zdn[8]; u32x2 ogn[4], zgn[4];
#pragma unroll
        for (int hh = 0; hh < 8; ++hh) { odn[hh] = 0u; zdn[hh] = 0u; }
#pragma unroll
        for (int hh = 0; hh < 4; ++hh) { ogn[hh] = (u32x2){0u, 0u}; zgn[hh] = (u32x2){0u, 0u}; }
        if (nidx < T) AB_LOAD(POST_ROW(nidx), odn, zdn, ogn, zgn);
        int s, t; row_to_seq(r, s, t); int row0, L; seq_info(s, row0, L);
        const bf16* ur = U + (size_t)r * NAB; bf16* yr = YM + (size_t)r * DM;
#pragma unroll
        for (int hh = 0; hh < 8; ++hh) { const float ox = __uint_as_float(od[hh] << 16), oy = __uint_as_float(od[hh] & 0xffff0000u);
            const float rstd = rsqrtf(wave_sum(ox * ox + oy * oy) * (1.f / 128.f) + 1e-6f);
            const unsigned zz = zd[hh];
            *(unsigned*)(yr + hh * 128 + 2 * lane) = pk2(ox * rstd * dg.x * silu_(__uint_as_float(zz << 16)), oy * rstd * dg.y * silu_(__uint_as_float(zz & 0xffff0000u))); }
#pragma unroll
        for (int hh = 0; hh < 4; ++hh) { const float ox = __uint_as_float(og[hh].x << 16), oy = __uint_as_float(og[hh].x & 0xffff0000u), oz = __uint_as_float(og[hh].y << 16), ow = __uint_as_float(og[hh].y & 0xffff0000u);
            const float rstd = rsqrtf(wave_sum((ox * ox + oy * oy) + (oz * oz + ow * ow)) * (1.f / 256.f) + 1e-6f);
            const u32x2 zz = zg[hh];
            u32x2 w; w.x = pk2(ox * rstd * gg.x * silu_(__uint_as_float(zz.x << 16)), oy * rstd * gg.y * silu_(__uint_as_float(zz.x & 0xffff0000u)));
            w.y = pk2(oz * rstd * gg.z * silu_(__uint_as_float(zz.y << 16)), ow * rstd * gg.w * silu_(__uint_as_float(zz.y & 0xffff0000u)));
            *(u32x2*)(yr + 1024 + hh * 256 + 4 * lane) = w; }
        if (t >= L - 3) { const int rr = t - (L - 3);
            float* dst = s < 4 ? kp.out() + O_DNC_P + (((size_t)j * 4 + s) * 3 + rr) * 3072 : kp.out() + O_DNC_S + (((size_t)j * 128 + (s - 4)) * 3 + rr) * 3072;
            unsigned uu[24];
#pragma unroll
            for (int q = 0; q < 24; ++q) uu[q] = *(const unsigned*)(ur + 2 * lane + 128 * q);
#pragma unroll
            for (int q = 0; q < 24; ++q) *(f32x2v*)(dst + 2 * lane + 128 * q) = (f32x2v){__uint_as_float(uu[q] << 16), __uint_as_float(uu[q] & 0xffff0000u)}; }
#pragma unroll
        for (int hh = 0; hh < 8; ++hh) { od[hh] = odn[hh]; zd[hh] = zdn[hh]; }
#pragma unroll
        for (int hh = 0; hh < 4; ++hh) { og[hh] = ogn[hh]; zg[hh] = zgn[hh]; }
    }
#undef AB_LOAD
}

__device__ __forceinline__ void phase_lru_gates(const KP kp, const int bid, const int G, int j, LAS unsigned char* lds, int tid0) {
    unsigned char* scr = kp.ws() + WS_SCR; const bf16* U = (const bf16*)(kp.ws() + WS_U);
    float* LA = (float*)(scr + SC_LA); float* LB = (float*)(scr + SC_LB);
    const float* lcw = kp.in(29) + (size_t)j * 4 * 1024; const float* lcb = kp.in(30) + (size_t)j * 1024; const float* lstc = kp.in(8) + (size_t)j * 128 * 3 * 1024;
    const int n = bid & 15;
    const float* wa = kp.in(31) + ((size_t)j * 16 + n) * 4096; const float* wx = kp.in(33) + ((size_t)j * 16 + n) * 4096;
    const float* lba = kp.in(32) + (size_t)j * 1024; const float* lbx = kp.in(34) + (size_t)j * 1024; const float* lam = kp.in(35) + (size_t)j * 1024;
    LAS bf16x8* WF = (LAS bf16x8*)lds;
    LAS float* xcL = (LAS float*)(lds + 16384);
    LAS float* igL = xcL + 64 * 68;
    __syncthreads();
    { const int lane = tid0 & 63, f = tid0 >> 6, r = lane & 31, hp = lane >> 5, nt = f >> 2, ks = f & 3; float v[8];
#pragma unroll
      for (int jp = 0; jp < 8; ++jp) v[jp] = wa[(16 * ks + 8 * hp + jp) * 64 + 32 * nt + r];
      WF[f * 64 + lane] = pack8(v);
#pragma unroll
      for (int jp = 0; jp < 8; ++jp) v[jp] = wx[(16 * ks + 8 * hp + jp) * 64 + 32 * nt + r];
      WF[512 + f * 64 + lane] = pack8(v); }
    bf16 rawc[11];
#define LRU_RAW(tile_, RAW) do { const int r0_ = (tile_) * 64 + (tid0 >> 6) * 8; const long fo_ = ((r0_ & 2047) == 0) ? 0 : (long)NCD; const bf16* up_ = U + (size_t)r0_ * NCD + 3584 + n * 64 + (tid0 & 63); \
        RAW[0] = up_[-3 * fo_]; RAW[1] = up_[-2 * fo_]; RAW[2] = up_[-1 * fo_]; _Pragma("unroll") for (int tt_ = 0; tt_ < 8; ++tt_) RAW[3 + tt_] = up_[(size_t)tt_ * NCD]; } while (0)
    if ((bid >> 4) < TP / 64) LRU_RAW(bid >> 4, rawc);
    for (int tile = bid >> 4; tile < T / 64; tile += (G >> 4)) {
        int tid = tid0; asm volatile("" : "+v"(tid));
        const int c = tid & 63, tq = tid >> 6, ch = n * 64 + c, rowbase = tile * 64;
        __syncthreads();
        if (tile < TP / 64) {
            const int r0 = rowbase + tq * 8; const bool first = ((r0 & 2047) == 0);
            const float w0 = lcw[ch], w1 = lcw[1024 + ch], w2 = lcw[2048 + ch], w3 = lcw[3072 + ch], bb = lcb[ch];
            float x0 = bf2f(rawc[0]), x1 = bf2f(rawc[1]), x2 = bf2f(rawc[2]); if (first) { x0 = 0.f; x1 = 0.f; x2 = 0.f; }
#pragma unroll
            for (int tt = 0; tt < 8; ++tt) { const float x3 = bf2f(rawc[3 + tt]); xcL[(tq * 8 + tt) * 68 + c] = bb + w0 * x0 + w1 * x1 + w2 * x2 + w3 * x3; x0 = x1; x1 = x2; x2 = x3; }
        } else {
            const int r0 = rowbase + tq * 8, sq0 = (r0 - TP) >> 2;
            const bf16* up = U + (size_t)r0 * NCD + 3584 + ch;
            u32x4 xa, xb; float st[6];
#pragma unroll
            for (int tt = 0; tt < 4; ++tt) { xa[tt] = (unsigned)up[(size_t)tt * NCD]; xb[tt] = (unsigned)up[(size_t)(4 + tt) * NCD]; }
#pragma unroll
            for (int q = 0; q < 6; ++q) st[q] = lstc[((size_t)(sq0 + q / 3) * 3 + (q % 3)) * 1024 + ch];
            float w0 = lcw[ch], w1 = lcw[1024 + ch], w2 = lcw[2048 + ch], w3 = lcw[3072 + ch], bb = lcb[ch];
            asm volatile("" : "+v"(xa), "+v"(xb), "+v"(st[0]), "+v"(st[1]), "+v"(st[2]), "+v"(st[3]), "+v"(st[4]), "+v"(st[5]), "+v"(w0), "+v"(w1), "+v"(w2), "+v"(w3), "+v"(bb));
#pragma unroll
            for (int hs = 0; hs < 2; ++hs) { float x0 = st[3 * hs], x1 = st[3 * hs + 1], x2 = st[3 * hs + 2];
#pragma unroll
                for (int t = 0; t < 4; ++t) { const float x3 = bf2f((bf16)(hs ? xb[t] : xa[t])); xcL[(tq * 8 + 4 * hs + t) * 68 + c] = bb + w0 * x0 + w1 * x1 + w2 * x2 + w3 * x3; x0 = x1; x1 = x2; x2 = x3; } }
        }
        { const int ntile = tile + (G >> 4); if (ntile < TP / 64) LRU_RAW(ntile, rawc); }
        __syncthreads();
        const int wave = __builtin_amdgcn_readfirstlane(tid >> 6), lane = tid & 63, r = lane & 31, hp = lane >> 5, mat = wave >> 2, mt = (wave >> 1) & 1, nt = wave & 1;
        f32x16 acc;
#pragma unroll
        for (int i = 0; i < 16; ++i) acc[i] = 0.f;
#pragma unroll
        for (int ks = 0; ks < 4; ++ks) { const LAS float* xp = xcL + (32 * mt + r) * 68 + 16 * ks + 8 * hp; const f32x4 xa = *(const LAS f32x4*)xp, xb = *(const LAS f32x4*)(xp + 4);
            const bf16x8 af = __builtin_bit_cast(bf16x8, (u32x4){cvtpk(xa.x, xa.y), cvtpk(xa.z, xa.w), cvtpk(xb.x, xb.y), cvtpk(xb.z, xb.w)});
            acc = MFMA32(af, WF[mat * 512 + (nt * 4 + ks) * 64 + lane], acc); }
        const int chh = n * 64 + 32 * nt + r;
        if (mat == 1) { const float bx = lbx[chh];
#pragma unroll
            for (int i = 0; i < 16; ++i) igL[(32 * mt + crow(i, hp)) * 65 + 32 * nt + r] = sigmoid_(acc[i] + bx); }
        __syncthreads();
        if (mat == 0) { const float ba = lba[chh], spl = softplus_(-lam[chh]);
#pragma unroll
            for (int i = 0; i < 16; ++i) { const int tk = 32 * mt + crow(i, hp); const size_t ro = (size_t)(rowbase + tk) * 1024 + chh;
                const float log_a = -8.f * sigmoid_(acc[i] + ba) * spl;
                LA[ro] = __expf(log_a); LB[ro] = __builtin_amdgcn_sqrtf(1.f - __expf(2.f * log_a)) * (igL[tk * 65 + 32 * nt + r] * xcL[tk * 68 + 32 * nt + r]); } }
    }
#undef LRU_RAW
}

constexpr size_t SSD_ITEM_BYTES = 33792;
__device__ __forceinline__ void phase_ssd_prep(const KP kp, const int bid, const int G, int j, LAS unsigned char* lds, int tid0) {
    unsigned char* scr = kp.ws() + WS_SCR;
    const bf16* U = (const bf16*)(kp.ws() + WS_U); bf16* XS = (bf16*)(scr + SC_XS);
    const float* cw = kp.in(23) + (size_t)j * 4 * 1536; const float* cb = kp.in(24) + (size_t)j * 1536;
    unsigned char* OPS = scr + SC_SSDOP;
    LAS float* GL = (LAS float*)lds; LAS float* DTL = GL + 256; LAS float* QK = DTL + 256; LAS bf16* Cb = (LAS bf16*)(QK + 64 * 65); LAS bf16* Bb = Cb + 64 * 72; LAS float* XLs = (LAS float*)(Bb + 64 * 72);
    const float* alog = kp.in(25) + j * 16;
    for (int item = bid; item < 512; item += G) {
        int tid = tid0; asm volatile("" : "+v"(tid));
        const int wave = tid >> 6, lane = tid & 63, r = lane & 31, hp = lane >> 5;
        const int b = item >> 7, n = (item >> 2) & 31, g = item & 3;
        const int row0 = b * 2048 + n * 64;
        __syncthreads();
        {
          const int t0 = 8 * wave; const bool first = (n == 0 && wave == 0); const long fo = first ? 0 : (long)NCD;
#pragma unroll
          for (int q = 0; q < 3; ++q) { const int k = 2 * (lane + 64 * q);
              const int cidx = k < 64 ? 1024 + g * 64 + k : (k < 128 ? 1280 + g * 64 + (k - 64) : g * 256 + (k - 128));
              const float w0a = cw[cidx], w0b = cw[cidx + 1], w1a = cw[1536 + cidx], w1b = cw[1536 + cidx + 1], w2a = cw[2 * 1536 + cidx], w2b = cw[2 * 1536 + cidx + 1], w3a = cw[3 * 1536 + cidx], w3b = cw[3 * 1536 + cidx + 1];
              const float ba = cb[cidx], bb = cb[cidx + 1];
              const bf16* up = U + (size_t)(row0 + t0) * NCD + 1024 + cidx;
              unsigned raw[11];
              raw[0] = *(const unsigned*)(up - 3 * fo); raw[1] = *(const unsigned*)(up - 2 * fo); raw[2] = *(const unsigned*)(up - 1 * fo);
#pragma unroll
              for (int t = 0; t < 8; ++t) raw[3 + t] = *(const unsigned*)(up + (size_t)t * NCD);
              if (first) { raw[0] = 0u; raw[1] = 0u; raw[2] = 0u; }
#pragma unroll
              for (int t = 0; t < 8; ++t) {
                  const float ya = silu_(ba + w0a * __uint_as_float(raw[t] << 16) + w1a * __uint_as_float(raw[t + 1] << 16) + w2a * __uint_as_float(raw[t + 2] << 16) + w3a * __uint_as_float(raw[t + 3] << 16));
                  const float yb = silu_(bb + w0b * __uint_as_float(raw[t] & 0xffff0000u) + w1b * __uint_as_float(raw[t + 1] & 0xffff0000u) + w2b * __uint_as_float(raw[t + 2] & 0xffff0000u) + w3b * __uint_as_float(raw[t + 3] & 0xffff0000u));
                  if (q == 0) { if (k < 64) *(LAS unsigned*)(Bb + (t0 + t) * 72 + k) = pk2(ya, yb); else *(LAS unsigned*)(Cb + (t0 + t) * 72 + (k - 64)) = pk2(ya, yb); }
                  else { XLs[(t0 + t) * 257 + (k - 128)] = ya; XLs[(t0 + t) * 257 + (k - 128) + 1] = yb; } } } }
        if (wave < 4) { const int h = g * 4 + wave; const float dt = softplus_(bf2f(U[(size_t)(row0 + lane) * NCD + 4608 + h]) + kp.in(26)[j * 16 + h]);
            DTL[wave * 64 + lane] = dt; float gv = -__expf(alog[h]) * dt;
#pragma unroll
            for (int o = 1; o < 64; o <<= 1) { const float tt = __shfl_up(gv, o); if (lane >= o) gv += tt; }
            GL[wave * 64 + lane] = gv; }
        __syncthreads();
        if (wave < 4) {
            const int mt = wave >> 1, nt = wave & 1;
            f32x16 acc;
#pragma unroll
            for (int i = 0; i < 16; ++i) acc[i] = 0.f;
#pragma unroll
            for (int ks = 0; ks < 4; ++ks) acc = MFMA32(*(const LAS bf16x8*)(Cb + (32 * mt + r) * 72 + 16 * ks + 8 * hp), *(const LAS bf16x8*)(Bb + (32 * nt + r) * 72 + 16 * ks + 8 * hp), acc);
#pragma unroll
            for (int i16 = 0; i16 < 16; ++i16) QK[(32 * mt + crow(i16, hp)) * 65 + 32 * nt + r] = acc[i16];
        } else {
            for (int i = tid - 256; i < 8192; i += 256) { const int t = i >> 7, k2 = i & 127;
                ((unsigned*)XS)[((size_t)(row0 + t) * 1024 + g * 256) / 2 + k2] = pk2(XLs[t * 257 + 2 * k2], XLs[t * 257 + 2 * k2 + 1]); }
        }
        __syncthreads();
        const int f = wave, mt = f >> 2, ks = f & 3;
        for (int hh = 0; hh < 4; ++hh) {
            const int h = g * 4 + hh; const LAS float* Gh = GL + hh * 64; const float Gend = Gh[63];
            bf16x8* base = (bf16x8*)(OPS + ((size_t)((b * 32 + n) * 16 + h)) * SSD_ITEM_BYTES);
            float v[8];
            { const int i = 32 * mt + r; const float eg = __expf(Gh[i]);
#pragma unroll
              for (int jp = 0; jp < 8; ++jp) { const int d = 16 * ks + 8 * (jp >> 2) + 4 * hp + (jp & 3); v[jp] = bf2f(Cb[i * 72 + d]) * eg; }
              base[0 * 512 + f * 64 + lane] = pack8(v); }
            { const int d = 32 * mt + r;
#pragma unroll
              for (int jp = 0; jp < 8; ++jp) { const int tk = 16 * ks + 8 * (jp >> 2) + 4 * hp + (jp & 3); v[jp] = bf2f(Bb[tk * 72 + d]) * __expf(Gend - Gh[tk]); }
              base[1 * 512 + f * 64 + lane] = pack8(v); }
            { const int i = 32 * mt + r; const float gi = Gh[i];
#pragma unroll
              for (int jp = 0; jp < 8; ++jp) { const int jt = 16 * ks + 8 * (jp >> 2) + 4 * hp + (jp & 3); v[jp] = jt <= i ? QK[i * 65 + jt] * __expf(gi - Gh[jt]) : 0.f; }
              base[2 * 512 + f * 64 + lane] = pack8(v); }
            { const int p = 32 * mt + r;
#pragma unroll
              for (int jp = 0; jp < 8; ++jp) { const int tk = 16 * ks + 8 * (jp >> 2) + 4 * hp + (jp & 3);
                  v[jp] = XLs[tk * 257 + hh * 64 + p] * DTL[hh * 64 + tk]; }
              base[3 * 512 + f * 64 + lane] = pack8(v); }
            if (tid == 0) *(float*)(base + 32 * 64) = __expf(Gend);
        }
    }
}

__device__ __forceinline__ void phase_cd_rec(const KP kp, const int bid, const int G, int j, int li, LAS unsigned char* lds, int tid0) {
    unsigned char* scr = kp.ws() + WS_SCR; const bf16* U = (const bf16*)(kp.ws() + WS_U);
    const float* LA = (const float*)(scr + SC_LA); const float* LB = (const float*)(scr + SC_LB);
    bf16* YS = (bf16*)(scr + SC_YS); bf16* HS = (bf16*)(scr + SC_HS); bf16* XS = (bf16*)(scr + SC_XS);
    SEC_BEGIN(10)
    for (int item = bid; item < 64; item += G) {
        int tid = tid0; asm volatile("" : "+v"(tid));
        const int b = item >> 4, hd = item & 15;
        __syncthreads();
        const int wave = __builtin_amdgcn_readfirstlane(tid >> 6), lane = tid & 63, r = lane & 31, hp = lane >> 5, nt = wave;
        const unsigned char* OPS = scr + SC_SSDOP;
        const bool dmaw = (wave >= 2);
        constexpr int SLOT = 33 * 1024;
#define SSD_DMA(n_) do { if (dmaw) { const unsigned char* gi_ = OPS + ((size_t)((b * 32 + (n_)) * 16 + hd)) * SSD_ITEM_BYTES + lane * 16; \
            _Pragma("unroll") for (int q_ = 0; q_ < 6; ++q_) { const int lf0_ = (wave - 2) * 6 + q_; const int lf_ = lf0_ < 32 ? lf0_ : 32; \
                __builtin_amdgcn_global_load_lds((const unsigned*)(gi_ + lf_ * 1024), (LAS unsigned*)(lds + ((n_) & 3) * SLOT + lf_ * 1024), 16, 0, 2); } } } while (0)
        f32x16 S0, S1;
#pragma unroll
        for (int i = 0; i < 16; ++i) { S0[i] = 0.f; S1[i] = 0.f; }
        SSD_DMA(0); SSD_DMA(1); SSD_DMA(2);
        if (dmaw) asm volatile("s_waitcnt vmcnt(12)" ::: "memory");
        asm volatile("" ::: "memory"); __builtin_amdgcn_s_barrier(); asm volatile("" ::: "memory");
        for (int n = 0; n < 32; ++n) {
            if (n + 3 < 32) SSD_DMA(n + 3);
            if (wave < 2) {
                const LAS bf16x8* F = (const LAS bf16x8*)(lds + (n & 3) * SLOT) + lane;
                bf16x8 vb[4];
#pragma unroll
                for (int ks = 0; ks < 4; ++ks) vb[ks] = F[(24 + nt * 4 + ks) * 64];
                const float gend = *(const LAS float*)(lds + (n & 3) * SLOT + 32 * 1024);
                const bf16x8 sb00 = PACK_ACC(S0, 0), sb01 = PACK_ACC(S0, 1), sb10 = PACK_ACC(S1, 0), sb11 = PACK_ACC(S1, 1);
                f32x16 O0, O1;
#pragma unroll
                for (int i = 0; i < 16; ++i) { O0[i] = 0.f; O1[i] = 0.f; }
                O0 = MFMA32(F[0 * 64], sb00, O0); O0 = MFMA32(F[1 * 64], sb01, O0); O0 = MFMA32(F[2 * 64], sb10, O0); O0 = MFMA32(F[3 * 64], sb11, O0);
                O1 = MFMA32(F[4 * 64], sb00, O1); O1 = MFMA32(F[5 * 64], sb01, O1); O1 = MFMA32(F[6 * 64], sb10, O1); O1 = MFMA32(F[7 * 64], sb11, O1);
                O0 = MFMA32(F[16 * 64], vb[0], O0); O0 = MFMA32(F[17 * 64], vb[1], O0);
#pragma unroll
                for (int ks = 0; ks < 4; ++ks) O1 = MFMA32(F[(20 + ks) * 64], vb[ks], O1);
#pragma unroll
                for (int i = 0; i < 16; ++i) { S0[i] *= gend; S1[i] *= gend; }
#pragma unroll
                for (int ks = 0; ks < 4; ++ks) { S0 = MFMA32(F[(8 + ks) * 64], vb[ks], S0); S1 = MFMA32(F[(12 + ks) * 64], vb[ks], S1); }
                bf16* yo = YS + (size_t)(b * 2048 + n * 64) * 1024 + hd * 64 + 32 * nt + r;
#pragma unroll
                for (int i = 0; i < 16; ++i) { yo[(size_t)crow(i, hp) * 1024] = (bf16)f2bf(O0[i]); yo[(size_t)(32 + crow(i, hp)) * 1024] = (bf16)f2bf(O1[i]); }
            }
            if (dmaw) { if (n + 3 < 32) asm volatile("s_waitcnt vmcnt(12)" ::: "memory"); else if (n + 2 < 32) asm volatile("s_waitcnt vmcnt(6)" ::: "memory"); else asm volatile("s_waitcnt vmcnt(0)" ::: "memory"); }
            asm volatile("s_waitcnt lgkmcnt(0)" ::: "memory"); __builtin_amdgcn_s_barrier(); asm volatile("" ::: "memory");
        }
#undef SSD_DMA
        if (wave < 2) {
            float* dst = kp.out() + O_SSD_P + ((size_t)j * 4 + b) * ((size_t)16 * 64 * 64) + (size_t)hd * 64 * 64 + 32 * nt + r;
#pragma unroll
            for (int i = 0; i < 16; ++i) { dst[(size_t)crow(i, hp) * 64] = S0[i]; dst[(size_t)(32 + crow(i, hp)) * 64] = S1[i]; }
        }
    }
    SEC_END(10, lds)
    SEC_BEGIN(11)
    unsigned* qhead = (unsigned*)(kp.ws() + WS_CTL) + CW_CNT + 64 * li;
    volatile LAS unsigned* qslot = (volatile LAS unsigned*)(lds + LDS_BYTES - 8);
    const float* cw = kp.in(23) + (size_t)j * 4 * 1536; const float* cb = kp.in(24) + (size_t)j * 1536; const float* stc = kp.in(6) + (size_t)j * 128 * 3 * 1536;
    for (;;) {
        __syncthreads();
        if (tid0 == 0) qslot[0] = __hip_atomic_fetch_add(qhead, 1u, __ATOMIC_RELAXED, __HIP_MEMORY_SCOPE_AGENT);
        __syncthreads();
        const int it = (int)qslot[0];
        if (it >= 1024) break;
        int tid = tid0; asm volatile("" : "+v"(tid));
        if (it < 256) {
            const int s = it >> 6, h = it & 63; int row0, L; seq_info(s, row0, L);
            LAS float* Al = (LAS float*)lds; LAS float* Bl = Al + 512;
            const int chunk = tid >> 4, c16 = tid & 15, ch = h * 16 + c16;
            const size_t ro = (size_t)(row0 + chunk * 64) * 1024 + ch;
            float av[64], bv[64];
            { const float* pa = LA + ro; const float* pb = LB + ro;
#pragma unroll
              for (int t = 0; t < 64; ++t) { av[t] = *pa; bv[t] = *pb; pa += 1024; pb += 1024; asm volatile("" : "+v"(pa), "+v"(pb)); } }
            float Ap = 1.f, Bp = 0.f;
#pragma unroll
            for (int t = 0; t < 64; ++t) { Bp = av[t] * Bp + bv[t]; Ap *= av[t]; }
            Al[tid] = Ap; Bl[tid] = Bp;
            __syncthreads();
            float hh = 0.f;
            for (int m = 0; m < chunk; ++m) hh = Al[m * 16 + c16] * hh + Bl[m * 16 + c16];
            { bf16* ph = HS + ro;
#pragma unroll
              for (int t = 0; t < 64; ++t) { hh = av[t] * hh + bv[t]; *ph = (bf16)f2bf(hh); ph += 1024; asm volatile("" : "+v"(ph)); } }
            if (chunk == 31) kp.out()[O_LRU_P + ((size_t)j * 4 + s) * 1024 + ch] = hh;
        } else if (it < 768) {
            const int q_ = it - 256, bs = q_ >> 2, g = q_ & 3, sq = 4 + bs, r0 = TP + bs * 4;
            LAS float* BL = (LAS float*)lds; LAS float* CL = BL + 256; LAS float* XL = CL + 256; LAS float* DTL = XL + 1024; LAS float* QKs = DTL + 16; LAS float* red = QKs + 16;
            const int wave = tid >> 6, lane = tid & 63, hh = tid >> 7, nh = (tid >> 6) & 1, p = tid & 63, hd = 4 * g + hh;
            const size_t SZ = (size_t)16 * 64 * 64;
            const float* st = kp.in(5) + ((size_t)j * 128 + bs) * SZ + (size_t)hd * 4096;
            float S[32];
            { const float* sp = st + (size_t)(nh * 32) * 64 + p;
#pragma unroll
              for (int i = 0; i < 32; ++i) { S[i] = __builtin_nontemporal_load(sp); sp += 64; asm volatile("" : "+v"(sp)); } }
            { const int ci = tid & 127, tk = tid >> 7; int cidxs[3]; LAS float* dsts[3];
#pragma unroll
              for (int q = 0; q < 3; ++q) { const int k = ci + 128 * q; int cidx; LAS float* dst;
                  if (k < 64) { cidx = 1024 + g * 64 + k; dst = BL + k * 4 + tk; } else if (k < 128) { cidx = 1280 + g * 64 + (k - 64); dst = CL + (k - 64) * 4 + tk; } else { cidx = g * 256 + (k - 128); dst = XL + tk * 256 + (k - 128); }
                  cidxs[q] = cidx; dsts[q] = dst; }
              u32x4 ua[3]; f32x4 sb[3], cwv[3]; float cbv[3];
#pragma unroll
              for (int q = 0; q < 3; ++q) { cbv[q] = cb[cidxs[q]];
#pragma unroll
                  for (int tap = 0; tap < 4; ++tap) { const int tt = tk - 3 + tap, tc = tt >= 0 ? tt : 0, sc = tt >= 0 ? 0 : 3 + tt;
                      cwv[q][tap] = cw[tap * 1536 + cidxs[q]]; ua[q][tap] = (unsigned)U[(size_t)(r0 + tc) * NCD + 1024 + cidxs[q]]; sb[q][tap] = stc[((size_t)(sq - 4) * 3 + sc) * 1536 + cidxs[q]]; } }
              asm volatile("" : "+v"(ua[0]), "+v"(ua[1]), "+v"(ua[2]), "+v"(sb[0]), "+v"(sb[1]), "+v"(sb[2]), "+v"(cwv[0]), "+v"(cwv[1]), "+v"(cwv[2]), "+v"(cbv[0]), "+v"(cbv[1]), "+v"(cbv[2]));
#pragma unroll
              for (int q = 0; q < 3; ++q) { float acc = cbv[q];
#pragma unroll
                  for (int tap = 0; tap < 4; ++tap) acc += cwv[q][tap] * ((tk - 3 + tap) >= 0 ? bf2f((bf16)ua[q][tap]) : sb[q][tap]);
                  *dsts[q] = silu_(acc); } }
            if (tid < 16) { const int tk = tid >> 2, h2 = tid & 3; DTL[tid] = softplus_(bf2f(U[(size_t)(r0 + tk) * NCD + 4608 + 4 * g + h2]) + kp.in(26)[j * 16 + 4 * g + h2]); }
            __syncthreads();
#pragma unroll
            for (int q = 0; q < 2; ++q) { const int idx = wave * 2 + q, i = idx >> 2, jj = idx & 3; const float dot = wave_sum(CL[lane * 4 + i] * BL[lane * 4 + jj]); if (lane == 0) QKs[idx] = dot; }
            { const int tk = tid >> 7, k2 = tid & 127; ((unsigned*)XS)[((size_t)(r0 + tk) * 1024 + g * 256) / 2 + k2] = pk2(XL[tk * 256 + 2 * k2], XL[tk * 256 + 2 * k2 + 1]); }
            const float negA = -__expf(kp.in(25)[j * 16 + hd]);
            float Gc[4], xd[4], w[4];
            Gc[0] = negA * DTL[hh]; Gc[1] = Gc[0] + negA * DTL[4 + hh]; Gc[2] = Gc[1] + negA * DTL[8 + hh]; Gc[3] = Gc[2] + negA * DTL[12 + hh];
#pragma unroll
            for (int jj = 0; jj < 4; ++jj) { xd[jj] = XL[jj * 256 + hh * 64 + p] * DTL[jj * 4 + hh]; w[jj] = __expf(Gc[3] - Gc[jj]) * xd[jj]; }
            const float eg = __expf(Gc[3]);
            float o[4] = {0.f, 0.f, 0.f, 0.f};
            float* dst = kp.out() + O_SSD_S + ((size_t)j * 128 + bs) * SZ + (size_t)hd * 4096 + (size_t)(nh * 32) * 64 + p;
#pragma unroll
            for (int i = 0; i < 32; ++i) { const int n = nh * 32 + i; const float s0 = S[i]; float acc = eg * s0; const f32x4 c4 = *(const LAS f32x4*)(CL + n * 4), b4 = *(const LAS f32x4*)(BL + n * 4);
#pragma unroll
                for (int t = 0; t < 4; ++t) { o[t] += c4[t] * s0; acc += b4[t] * w[t]; }
                __builtin_nontemporal_store(acc, dst); dst += 64; asm volatile("" : "+v"(dst)); }
#pragma unroll
            for (int t = 0; t < 4; ++t) red[((hh * 2 + nh) * 4 + t) * 64 + p] = o[t];
            __syncthreads();
            if (nh == 0) {
#pragma unroll
                for (int t = 0; t < 4; ++t) { float y = __expf(Gc[t]) * (red[((hh * 2) * 4 + t) * 64 + p] + red[((hh * 2 + 1) * 4 + t) * 64 + p]);
#pragma unroll
                    for (int jj = 0; jj <= t; ++jj) y += QKs[t * 4 + jj] * __expf(Gc[t] - Gc[jj]) * xd[jj];
                    YS[(size_t)(r0 + t) * 1024 + hd * 64 + p] = (bf16)f2bf(y); } }
        } else {
            const int q_ = it - 768, s = 4 + (q_ >> 1), h = q_ & 1; int row0, L; seq_info(s, row0, L);
            const int ch = h * 512 + tid;
            float hh = s < 4 ? 0.f : kp.in(7)[((size_t)j * 128 + (s - 4)) * 1024 + ch];
#pragma unroll 8
            for (int t = 0; t < L; ++t) { const size_t r = (size_t)(row0 + t); hh = LA[r * 1024 + ch] * hh + LB[r * 1024 + ch]; HS[r * 1024 + ch] = (bf16)f2bf(hh); }
            float* dst = s < 4 ? kp.out() + O_LRU_P + ((size_t)j * 4 + s) * 1024 : kp.out() + O_LRU_S + ((size_t)j * 128 + (s - 4)) * 1024;
            dst[ch] = hh;
        }
    }
    SEC_END(11, lds)
}

__device__ __forceinline__ void phase_cd_post(const KP kp, const int bid, const int G, int j, int tid, int wave, int lane) {
    unsigned char* scr = kp.ws() + WS_SCR; const bf16* U = (const bf16*)(kp.ws() + WS_U); bf16* YM = (bf16*)(kp.ws() + WS_YM);
    const bf16* YS = (const bf16*)(scr + SC_YS); const bf16* HS = (const bf16*)(scr + SC_HS); const bf16* XS = (const bf16*)(scr + SC_XS);
    const float* sn = kp.in(28) + (size_t)j * 1024; const float* Dv = kp.in(27) + (size_t)j * 16;
    typedef float f32x2v __attribute__((ext_vector_type(2)));
    const int stride = G * NWAVES;
#define CD_LOAD(r_, YV, XV, ZV, HV, LV) do { const bf16* ur_ = U + (size_t)(r_) * NCD; \
        _Pragma("unroll") for (int gq = 0; gq < 4; ++gq) { const int e_ = gq * 256 + 4 * lane; YV[gq] = *(const u32x2*)(YS + (size_t)(r_) * 1024 + e_); XV[gq] = *(const u32x2*)(XS + (size_t)(r_) * 1024 + e_); ZV[gq] = *(const u32x2*)(ur_ + e_); \
            HV[gq] = *(const u32x2*)(HS + (size_t)(r_) * 1024 + e_); LV[gq] = *(const u32x2*)(ur_ + 2560 + e_); } } while (0)
    f32x4 g4s[4]; float Dhs[4];
#pragma unroll
    for (int gq = 0; gq < 4; ++gq) { const int e = gq * 256 + 4 * lane; g4s[gq] = *(const f32x4*)(sn + e); Dhs[gq] = Dv[e >> 6]; }
    int idx = bid * NWAVES + wave;
    u32x2 yv[4], xv[4], zv[4], hv[4], lv[4];
    if (idx < T) CD_LOAD(POST_ROW(idx), yv, xv, zv, hv, lv);
    for (; idx < T; idx += stride) {
        const int r = POST_ROW(idx), nidx = idx + stride;
        u32x2 yn[4], xn[4], zn[4], hn[4], ln[4];
#pragma unroll
        for (int gq = 0; gq < 4; ++gq) { yn[gq] = (u32x2){0u, 0u}; xn[gq] = yn[gq]; zn[gq] = yn[gq]; hn[gq] = yn[gq]; ln[gq] = yn[gq]; }
        if (nidx < T) CD_LOAD(POST_ROW(nidx), yn, xn, zn, hn, ln);
        int s, t; row_to_seq(r, s, t); int row0, L; seq_info(s, row0, L);
        const bf16* ur = U + (size_t)r * NCD; bf16* yr = YM + (size_t)r * DM;
#pragma unroll
        for (int gq = 0; gq < 4; ++gq) { const int e = gq * 256 + 4 * lane; const u32x2 ys = yv[gq], xx = xv[gq], zz = zv[gq]; const float Dh = Dhs[gq];
            f32x4 y; y.x = (__uint_as_float(ys.x << 16) + Dh * __uint_as_float(xx.x << 16)) * silu_(__uint_as_float(zz.x << 16)); y.y = (__uint_as_float(ys.x & 0xffff0000u) + Dh * __uint_as_float(xx.x & 0xffff0000u)) * silu_(__uint_as_float(zz.x & 0xffff0000u));
            y.z = (__uint_as_float(ys.y << 16) + Dh * __uint_as_float(xx.y << 16)) * silu_(__uint_as_float(zz.y << 16)); y.w = (__uint_as_float(ys.y & 0xffff0000u) + Dh * __uint_as_float(xx.y & 0xffff0000u)) * silu_(__uint_as_float(zz.y & 0xffff0000u));
            const float rstd = rsqrtf(wave_sum((y.x * y.x + y.y * y.y) + (y.z * y.z + y.w * y.w)) * (1.f / 256.f) + 1e-6f);
            const f32x4 g4 = g4s[gq];
            u32x2 w; w.x = pk2(y.x * rstd * g4.x, y.y * rstd * g4.y); w.y = pk2(y.z * rstd * g4.z, y.w * rstd * g4.w); *(u32x2*)(yr + e) = w; }
#pragma unroll
        for (int gq = 0; gq < 4; ++gq) { const int ch = gq * 256 + 4 * lane; const u32x2 hs = hv[gq], zz = lv[gq];
            u32x2 w; w.x = pk2(__uint_as_float(hs.x << 16) * silu_(__uint_as_float(zz.x << 16)), __uint_as_float(hs.x & 0xffff0000u) * silu_(__uint_as_float(zz.x & 0xffff0000u)));
            w.y = pk2(__uint_as_float(hs.y << 16) * silu_(__uint_as_float(zz.y << 16)), __uint_as_float(hs.y & 0xffff0000u) * silu_(__uint_as_float(zz.y & 0xffff0000u)));
            *(u32x2*)(yr + 1024 + ch) = w; }
        if (t >= L - 3) { const int rr = t - (L - 3);
            float* d1 = s < 4 ? kp.out() + O_SSDC_P + (((size_t)j * 4 + s) * 3 + rr) * 1536 : kp.out() + O_SSDC_S + (((size_t)j * 128 + (s - 4)) * 3 + rr) * 1536;
            unsigned u1[12], u2[8];
#pragma unroll
            for (int q = 0; q < 12; ++q) u1[q] = *(const unsigned*)(ur + 1024 + 2 * lane + 128 * q);
#pragma unroll
            for (int q = 0; q < 8; ++q) u2[q] = *(const unsigned*)(ur + 3584 + 2 * lane + 128 * q);
#pragma unroll
            for (int q = 0; q < 12; ++q) *(f32x2v*)(d1 + 2 * lane + 128 * q) = (f32x2v){__uint_as_float(u1[q] << 16), __uint_as_float(u1[q] & 0xffff0000u)};
            float* d2 = s < 4 ? kp.out() + O_LRUC_P + (((size_t)j * 4 + s) * 3 + rr) * 1024 : kp.out() + O_LRUC_S + (((size_t)j * 128 + (s - 4)) * 3 + rr) * 1024;
#pragma unroll
            for (int q = 0; q < 8; ++q) *(f32x2v*)(d2 + 2 * lane + 128 * q) = (f32x2v){__uint_as_float(u2[q] << 16), __uint_as_float(u2[q] & 0xffff0000u)}; }
#pragma unroll
        for (int gq = 0; gq < 4; ++gq) { yv[gq] = yn[gq]; xv[gq] = xn[gq]; zv[gq] = zn[gq]; hv[gq] = hn[gq]; lv[gq] = ln[gq]; }
    }
#undef CD_LOAD
#undef POST_ROW
}

typedef float f32x4m __attribute__((ext_vector_type(4)));
template <bool GATE>
__device__ __forceinline__ void sample_gemm_res(LAS unsigned char* lds, const bf16* Amat, const bf16* Bt, const bf16* Hin, bf16* Hout, float* rss_out, const bf16* PP, const float* rss_in, int bid, int tid) {
    const int wave = tid >> 6, lane = tid & 63, lr = lane & 15, kg = lane >> 4;
  for (int tile = bid; tile < 256; tile += (int)gridDim.x) {
    const int m0 = TP + (tile & 7) * 64, n0 = (tile >> 3) * 64;
    const bf16x8* ap = (const bf16x8*)(Amat + (size_t)(m0 + lr) * 2048 + wave * 256 + 8 * kg);
    const bf16x8* bp = (const bf16x8*)(Bt + (size_t)(n0 + lr) * 2048 + wave * 256 + 8 * kg);
    const int erow = m0 + (tid >> 3); const size_t ep = (size_t)erow * 2048 + n0 + (tid & 7) * 8;
    const u32x4 hw = *(const u32x4*)(Hin + ep); u32x4 pw = (u32x4){0u, 0u, 0u, 0u}; float rsi = 0.f; if (GATE) { pw = *(const u32x4*)(PP + ep); rsi = rss_in[erow]; }
    f32x4m acc[4][4];
#pragma unroll
    for (int mi = 0; mi < 4; ++mi)
#pragma unroll
        for (int ni = 0; ni < 4; ++ni) acc[mi][ni] = (f32x4m){0.f, 0.f, 0.f, 0.f};
#pragma unroll 2
    for (int ks = 0; ks < 8; ++ks) { bf16x8 a[4], b[4];
#pragma unroll
        for (int q = 0; q < 4; ++q) { a[q] = ap[(size_t)q * 16 * 256 + ks * 4]; b[q] = bp[(size_t)q * 16 * 256 + ks * 4]; }
#pragma unroll
        for (int mi = 0; mi < 4; ++mi)
#pragma unroll
            for (int ni = 0; ni < 4; ++ni) acc[mi][ni] = __builtin_amdgcn_mfma_f32_16x16x32_bf16(a[mi], b[ni], acc[mi][ni], 0, 0, 0); }
    LAS float* red = (LAS float*)lds;
    __syncthreads();
#pragma unroll
    for (int mi = 0; mi < 4; ++mi)
#pragma unroll
        for (int ni = 0; ni < 4; ++ni)
#pragma unroll
            for (int i = 0; i < 4; ++i) red[(wave * 64 + 16 * mi + kg * 4 + i) * 65 + 16 * ni + lr] = acc[mi][ni][i];
    __syncthreads();
    { const int row = tid >> 3, c8 = (tid & 7) * 8, grow = m0 + row; float v[8];
#pragma unroll
      for (int e = 0; e < 8; ++e) { float sacc = 0.f;
#pragma unroll
          for (int w = 0; w < 8; ++w) sacc += red[(w * 64 + row) * 65 + c8 + e];
          v[e] = sacc; }
      float sc = 1.f; if (GATE) sc = rsqrtf(rsi * (1.f / 2048.f) + 1e-6f);
      const size_t p = (size_t)grow * 2048 + n0 + c8;
      const unsigned hws[4] = {hw.x, hw.y, hw.z, hw.w}, pws[4] = {pw.x, pw.y, pw.z, pw.w}; unsigned ow[4]; float sq = 0.f;
#pragma unroll
      for (int e2 = 0; e2 < 4; ++e2) { float h0 = __uint_as_float(hws[e2] << 16), h1 = __uint_as_float(hws[e2] & 0xffff0000u);
          if (GATE) { h0 += __builtin_amdgcn_rcpf(1.f + __expf(-sc * v[2 * e2])) * __uint_as_float(pws[e2] << 16); h1 += __builtin_amdgcn_rcpf(1.f + __expf(-sc * v[2 * e2 + 1])) * __uint_as_float(pws[e2] & 0xffff0000u); }
          else { h0 += v[2 * e2]; h1 += v[2 * e2 + 1]; }
          sq += h0 * h0 + h1 * h1; ow[e2] = cvtpk(h0, h1); }
      *(u32x4*)(Hout + p) = (u32x4){ow[0], ow[1], ow[2], ow[3]};
      sq += __shfl_xor(sq, 1); sq += __shfl_xor(sq, 2); sq += __shfl_xor(sq, 4);
      if ((tid & 7) == 0) atomicAdd(rss_out + grow, sq); }
    __syncthreads();
  }
}

__global__ void __launch_bounds__(NTHR, 2) mega_fwd(Args A) {
    extern __shared__ __attribute__((aligned(16))) unsigned char lds_raw[];
    LAS unsigned char* lds = (LAS unsigned char*)lds_raw;
    const int G = gridDim.x;
    volatile LAS unsigned* bst = (volatile LAS unsigned*)(lds + LDS_BYTES - 16);
    if (threadIdx.x == 0) { bst[0] = 0u; bst[1] = 0u;
#ifdef PROBE_SEC
        *(volatile LAS unsigned long long*)(lds + LDS_BYTES - 32) = 0ull;
#endif
    }
    __syncthreads();
    XcdBarrier xbar = xcd_barrier_post((unsigned*)(A.ws + WS_CTL) + CW_BAR, bst);
#ifdef PROBE_GROUP
    unsigned long long t_prev = __builtin_amdgcn_s_memrealtime(), t_sel = 0;
#endif
    for (int ph = A.ph_lo; ph < A.ph_hi; ++ph) {
        KP kp; kp.p = (const char AS4*)__builtin_amdgcn_kernarg_segment_ptr(); asm volatile("" : "+s"(kp.p));
        unsigned char* ws = kp.ws();
        int tid = threadIdx.x; asm volatile("" : "+v"(tid));
        int bid = blockIdx.x; asm volatile("" : "+s"(bid));
        const int lane = tid & 63, wave = __builtin_amdgcn_readfirstlane(tid >> 6), gw = bid * NWAVES + wave, NGW = G * NWAVES;
        if (ph == 0) { if (PH_MASK & 1) phase_prologue(kp, lds, gw, NGW, wave, lane); }
        else if (ph == N_PHASES - 1) { SEC_BEGIN(32) phase_final(kp, gw, NGW, lane); SEC_END(32, lds) }
        else {
            const int li = (ph - 1) / SUBS, sub = (ph - 1) % SUBS, j = li >> 1; const bool ab = (li & 1) == 0;
            float* RSS = (float*)(ws + WS_RSS);
            if (sub == 0) {
                const int N = ab ? NAB : NCD;
                const bf16* Bt = ab ? (const bf16*)(ws + WS_WABIN) + (size_t)j * NAB * 2048 : (const bf16*)(ws + WS_WCDIN) + (size_t)j * NCD * 2048;
                { pg8::Gemm g{(const bf16*)(ws + WS_XN), Bt, T, N, 2048}; pg8::StaticOrder S; S.init(T, N, G, bid);
                  pg8::EpiU E{(bf16*)(ws + WS_U), N, RSS + (size_t)(2 * li) * T};
                  if (PH_MASK & 2) pg8::gemm_phase<pg8::EpiU, pg8::StaticOrder, true, true>(lds, g, S, E, tid); }
                { int tid2 = tid; asm volatile("" : "+v"(tid2));
                  int pM = T, pG = G, pc = bid, prow = 0;
                  if (G == 256) { if (ab) { if (bid >= 218) { pM = 4864; pG = 38; pc = bid - 218; } else { prow = 4864; pM = T - 4864; pG = 120; pc = bid; } }
                                  else { pG = 122; pc = bid >= 134 ? bid - 134 : 100000; } }
                  pg8::StaticOrder S; S.init(pM, 2048, pG, pc);
                  pg8::Gemm g{(const bf16*)(ws + WS_PB) + ((size_t)li * T + prow) * 256, (const bf16*)(ws + WS_WPROJ) + (size_t)li * 2048 * 256, pM, 2048, 256};
                  pg8::EpiU E{(bf16*)(ws + WS_SCR + SC_PP) + (size_t)prow * 2048, 2048, nullptr};
                  if (PH_MASK & 2) pg8::gemm_phase<pg8::EpiU, pg8::StaticOrder, true, true>(lds, g, S, E, tid2); }
            } else if (sub == 4) {
                const bf16* Bt = ab ? (const bf16*)(ws + WS_WABOUT) + (size_t)j * 2048 * 2048 : (const bf16*)(ws + WS_WCDOUT) + (size_t)j * 2048 * 2048;
                pg8::Gemm g{(const bf16*)(ws + WS_YM), Bt, TP, 2048, 2048}; pg8::StaticOrder S; S.init(TP, 2048, G, bid);
                pg8::EpiRes<false> E{(const bf16*)(ws + WS_XN), (bf16*)(ws + WS_SCR + SC_HB1), RSS + (size_t)(2 * li + 1) * T, nullptr, nullptr};
                SEC_BEGIN(40)
                if (PH_MASK & 4) pg8::gemm_phase<pg8::EpiRes<false>, pg8::StaticOrder, false, true>(lds, g, S, E, tid);
                SEC_END(40, lds)
                SEC_BEGIN(41)
                { int tid2 = tid; asm volatile("" : "+v"(tid2));
                  sample_gemm_res<false>(lds, (const bf16*)(ws + WS_YM), Bt, (const bf16*)(ws + WS_XN), (bf16*)(ws + WS_SCR + SC_HB1), RSS + (size_t)(2 * li + 1) * T, nullptr, nullptr, bid, tid2); }
                SEC_END(41, lds)
            } else if (sub == 5) {
                pg8::Gemm g{(const bf16*)(ws + WS_SCR + SC_HB1), (const bf16*)(ws + WS_WGATE) + (size_t)li * 2048 * 2048, TP, 2048, 2048}; pg8::StaticOrder S; S.init(TP, 2048, G, bid);
                pg8::EpiRes<true> E{(const bf16*)(ws + WS_SCR + SC_HB1), (bf16*)(ws + WS_XN), RSS + (size_t)(2 * li + 2) * T, (const bf16*)(ws + WS_SCR + SC_PP), RSS + (size_t)(2 * li + 1) * T};
                if (PH_MASK & 4) pg8::gemm_phase<pg8::EpiRes<true>, pg8::StaticOrder, false, true>(lds, g, S, E, tid);
                { int tid2 = tid; asm volatile("" : "+v"(tid2));
                  sample_gemm_res<true>(lds, (const bf16*)(ws + WS_SCR + SC_HB1), (const bf16*)(ws + WS_WGATE) + (size_t)li * 2048 * 2048, (const bf16*)(ws + WS_SCR + SC_HB1), (bf16*)(ws + WS_XN), RSS + (size_t)(2 * li + 2) * T,
                                        (const bf16*)(ws + WS_SCR + SC_PP), RSS + (size_t)(2 * li + 1) * T, bid, tid2); }
            } else if (sub == 1) {
                if (ab) { SEC_BEGIN(3) if (PH_MASK & 4096) phase_gla_prep(kp, bid, G, j, lds, tid); SEC_END(3, lds) SEC_BEGIN(4) if (PH_MASK & 8192) phase_dn_prep(kp, bid, G, j, lds, tid); SEC_END(4, lds) }
                else { if (PH_MASK & 2048) { SEC_BEGIN(8) phase_ssd_prep(kp, bid, G, j, lds, tid); SEC_END(8, lds) SEC_BEGIN(9) phase_lru_gates(kp, bid, G, j, lds, tid); SEC_END(9, lds) } }
            }
            else if (sub == 2) { if (ab) { if (PH_MASK & 32) phase_ab_rec(kp, bid, G, j, li, lds, tid); } else { if (PH_MASK & 64) phase_cd_rec(kp, bid, G, j, li, lds, tid); } }
            else { if (ab) { SEC_BEGIN(30) if (PH_MASK & 128) phase_ab_post(kp, bid, G, j, tid, wave, lane); SEC_END(30, lds) } else { SEC_BEGIN(31) if (PH_MASK & 256) phase_cd_post(kp, bid, G, j, tid, wave, lane); SEC_END(31, lds) } }
        }
        if (ph + 1 < A.ph_hi) { if (ph == A.ph_lo) cg::this_grid().sync(); else xcd_barrier(xbar); }
#ifdef PROBE_GROUP
        { const unsigned long long t_now = __builtin_amdgcn_s_memrealtime(); const int li_ = (ph - 1) / SUBS, sub_ = (ph - 1) % SUBS; const bool ab_ = (li_ & 1) == 0;
          int grp = 9; if (ph == N_PHASES - 1) grp = 8; else if (ph > 0) { if (sub_ == 0 || sub_ == 4 || sub_ == 5) grp = (PROBE_GROUP >= 11) ? (sub_ == 0 ? (ab_ ? 11 : 12) : (sub_ == 4 ? 13 : 14)) : 1; else if (sub_ == 1) grp = ab_ ? 4 : 5; else if (sub_ == 2) grp = ab_ ? 6 : 7; else grp = 8; }
          if (grp == PROBE_GROUP) t_sel += t_now - t_prev; t_prev = t_now; }
#endif
    }
#ifdef PROBE_SEC
    if (blockIdx.x == PROBE_BLK && threadIdx.x == 0) { const unsigned long long t_s = *(volatile LAS unsigned long long*)(lds + LDS_BYTES - 32); const unsigned long long t0 = __builtin_amdgcn_s_memrealtime(); while (__builtin_amdgcn_s_memrealtime() - t0 < 3 * t_s) __builtin_amdgcn_s_sleep(8); }
#endif
#ifdef PROBE_GROUP
    if (blockIdx.x == 0 && threadIdx.x == 0) { const unsigned long long t0 = __builtin_amdgcn_s_memrealtime(); while (__builtin_amdgcn_s_memrealtime() - t0 < 3 * t_sel) __builtin_amdgcn_s_sleep(8); }
#endif
}

extern "C" void kernel_launch(void* const* d_in, const int* in_sizes, int n_in, void* d_out, int out_size, void* d_ws, size_t ws_size, hipStream_t stream) {
    static int grid = 0;
    if (grid == 0) {
        if (n_in != 40 || (size_t)out_size != O_END || ws_size < WS_END) { fprintf(stderr, "kernel_launch: unexpected shapes: n_in %d out %d ws %zu\n", n_in, out_size, ws_size); grid = -1; return; }
        int dev = 0, cus = 0, per_cu = 0;
        if (hipGetDevice(&dev) != hipSuccess || hipDeviceGetAttribute(&cus, hipDeviceAttributeMultiprocessorCount, dev) != hipSuccess) { grid = -1; return; }
        if (hipFuncSetAttribute((const void*)mega_fwd, hipFuncAttributeMaxDynamicSharedMemorySize, LDS_BYTES) != hipSuccess) { fprintf(stderr, "kernel_launch: hipFuncSetAttribute failed\n"); grid = -1; return; }
        if (hipOccupancyMaxActiveBlocksPerMultiprocessor(&per_cu, (const void*)mega_fwd, NTHR, LDS_BYTES) != hipSuccess || per_cu < 1) { fprintf(stderr, "kernel_launch: occupancy query says %d\n", per_cu); per_cu = 1; }
        (void)hipGetLastError();
        grid = cus;
    }
    if (grid < 0) return;
    if (hipMemsetAsync((char*)d_ws + WS_CTL, 0, CTL_ZERO_BYTES, stream) != hipSuccess) { fprintf(stderr, "kernel_launch: memset of the control words failed\n"); return; }
    Args a{};
    for (int i = 0; i < 40; ++i) a.in[i] = (const float*)d_in[i];
    a.out = (float*)d_out; a.ws = (unsigned char*)d_ws;
#if MK_N_LAUNCHES == 1
    a.ph_lo = 0; a.ph_hi = N_PHASES;
    void* args[] = {&a};
    hipError_t e = hipLaunchCooperativeKernel((const void*)mega_fwd, dim3(grid), dim3(NTHR), args, LDS_BYTES, stream);
    if (e != hipSuccess) fprintf(stderr, "cooperative launch failed: %s (grid %d)\n", hipGetErrorString(e), grid);
#else
    for (int ph = 0; ph < N_PHASES; ++ph) { a.ph_lo = ph; a.ph_hi = ph + 1; mega_fwd<<<dim3(grid), dim3(NTHR), LDS_BYTES, stream>>>(a); }
#endif
}
```
